# Optimizing an MI355X kernel written in HIP

```python
import jax, jax.numpy as jnp
from jax import lax
import numpy as np

D_MODEL = 1024
BATCH = 4
SEQ = 8192
DEPTH = 2

N_MEM = 256
N_MIXERS = 2
EPS = 1e-6
CONV_KERNEL = 31
GLA_HEADS = 4
GLA_DK = D_MODEL // 2
GLA_DV = D_MODEL
GLA_DKH = GLA_DK // GLA_HEADS
GLA_DVH = GLA_DV // GLA_HEADS
GLA_RANK = 16
GLA_TAU = 16.0
GLA_CHUNK = 64
XATTN_HEADS = 4
XATTN_HD = D_MODEL // XATTN_HEADS
N_GROUPS = 4
EXPERTS_PER_GROUP = 8
N_EXPERTS = N_GROUPS * EXPERTS_PER_GROUP
TOP_K = 2
D_EXPERT = D_MODEL // 2
MOE_BLOCK = 128

kernel_name = 'hybrid_conv_gla_memxattn_hmoe'


def rms_norm(x, g):
    xf = x.astype(jnp.float32)
    y = xf * lax.rsqrt(jnp.mean(xf * xf, axis=-1, keepdims=True) + EPS)
    return (y * g.astype(jnp.float32)).astype(x.dtype)


def conformer_conv(h, w_in, b_in, w_dw, b_dw, ln_g, ln_b, w_out, b_out):
    u = h @ w_in + b_in
    a, gt = jnp.split(u, 2, axis=-1)
    u = a * jax.nn.sigmoid(gt)
    u = lax.conv_general_dilated(
        u, w_dw[:, None, :], window_strides=(1,), padding=[(CONV_KERNEL - 1, 0)],
        dimension_numbers=('NWC', 'WIO', 'NWC'), feature_group_count=D_MODEL) + b_dw
    uf = u.astype(jnp.float32)
    mu = jnp.mean(uf, axis=-1, keepdims=True)
    var = jnp.mean(jnp.square(uf - mu), axis=-1, keepdims=True)
    un = ((uf - mu) * lax.rsqrt(var + EPS) * ln_g.astype(jnp.float32) + ln_b.astype(jnp.float32)).astype(h.dtype)
    return jax.nn.silu(un) @ w_out + b_out


def gla_mixer(h, w_in, w_a2, b_a, norm_g, w_o):
    B, S, _ = h.shape
    n_chunks = S // GLA_CHUNK
    proj = h @ w_in
    q, k, v, a_lr, r = jnp.split(
        proj, [GLA_DK, 2 * GLA_DK, 2 * GLA_DK + GLA_DV, 2 * GLA_DK + GLA_DV + GLA_RANK], axis=-1)
    log_a = jax.nn.log_sigmoid((a_lr @ w_a2 + b_a).astype(jnp.float32)) / GLA_TAU

    def chunks(t, d):
        return t.astype(jnp.float32).reshape(B, n_chunks, GLA_CHUNK, GLA_HEADS, d).transpose(1, 0, 3, 2, 4)

    qc = chunks(q, GLA_DKH) * (GLA_DKH ** -0.5)
    kc = chunks(k, GLA_DKH)
    vc = chunks(v, GLA_DVH)
    bc = jnp.cumsum(chunks(log_a, GLA_DKH), axis=3)
    causal = jnp.tril(jnp.ones((GLA_CHUNK, GLA_CHUNK), dtype=bool))[:, :, None]

    def step(state, inp):
        qi, ki, vi, bi = inp
        diff = bi[:, :, :, None, :] - bi[:, :, None, :, :]
        decay = jnp.exp(jnp.where(causal, diff, -jnp.inf))
        att = jnp.sum(qi[:, :, :, None, :] * ki[:, :, None, :, :] * decay, axis=-1)
        o = jnp.einsum('bhij,bhjv->bhiv', att, vi) + jnp.einsum('bhik,bhkv->bhiv', qi * jnp.exp(bi), state)
        b_last = bi[:, :, -1:, :]
        k_dec = ki * jnp.exp(b_last - bi)
        new_state = jnp.exp(b_last)[:, :, 0, :, None] * state + jnp.einsum('bhjk,bhjv->bhkv', k_dec, vi)
        return new_state, o

    state0 = jnp.zeros((B, GLA_HEADS, GLA_DKH, GLA_DVH), jnp.float32)
    _, o = lax.scan(step, state0, (qc, kc, vc, bc))
    o = o.transpose(1, 0, 3, 2, 4).reshape(B, S, GLA_HEADS, GLA_DVH)
    o = o * lax.rsqrt(jnp.mean(o * o, axis=-1, keepdims=True) + EPS) * norm_g.astype(jnp.float32)
    o = o.reshape(B, S, GLA_DV).astype(h.dtype) * jax.nn.silu(r)
    return o @ w_o


def mem_cross_attn(h, m, w_q, w_kv, w_o):
    B, S, _ = h.shape
    q = (h @ w_q).reshape(B, S, XATTN_HEADS, XATTN_HD)
    k, v = jnp.split(m @ w_kv, 2, axis=-1)
    k = k.reshape(B, N_MEM, XATTN_HEADS, XATTN_HD)
    v = v.reshape(B, N_MEM, XATTN_HEADS, XATTN_HD)
    s = jnp.einsum('bshd,bmhd->bhsm', q, k).astype(jnp.float32) * (XATTN_HD ** -0.5)
    p = jax.nn.softmax(s, axis=-1).astype(v.dtype)
    o = jnp.einsum('bhsm,bmhd->bshd', p, v).reshape(B, S, D_MODEL)
    return o @ w_o


def hier_moe(h, w_grp, b_grp, w_exp, b_exp, w_gate, w_up, w_down):
    B, S, D = h.shape
    T = B * S
    hf = h.reshape(T, D)
    gl = (hf @ w_grp + b_grp).astype(jnp.float32)
    pg = jax.nn.softmax(gl, axis=-1)
    g_sel = jnp.argmax(gl, axis=-1)
    pg_sel = jnp.take_along_axis(pg, g_sel[:, None], axis=1)
    el = (hf @ w_exp + b_exp).astype(jnp.float32).reshape(T, N_GROUPS, EXPERTS_PER_GROUP)
    el_sel = jnp.take_along_axis(el, g_sel[:, None, None], axis=1)[:, 0]
    pe = jax.nn.softmax(el_sel, axis=-1)
    top_p, top_i = lax.top_k(pe, TOP_K)
    gate = pg_sel * top_p / jnp.sum(top_p, axis=-1, keepdims=True)
    expert_id = g_sel[:, None].astype(jnp.int32) * EXPERTS_PER_GROUP + top_i.astype(jnp.int32)

    A = T * TOP_K
    e_flat = expert_id.reshape(A)
    g_flat = gate.reshape(A)
    order = jnp.argsort(e_flat)
    sorted_e = e_flat[order]
    token_idx = order // TOP_K
    counts = jnp.bincount(e_flat, length=N_EXPERTS)
    offsets = jnp.cumsum(counts) - counts
    padded = (counts + MOE_BLOCK - 1) // MOE_BLOCK * MOE_BLOCK
    pad_ends = jnp.cumsum(padded)
    pad_offsets = pad_ends - padded
    dest = pad_offsets[sorted_e] + jnp.arange(A) - offsets[sorted_e]
    n_blocks = -(-A // MOE_BLOCK) + N_EXPERTS
    x_buf = jnp.zeros((n_blocks * MOE_BLOCK, D), h.dtype).at[dest].set(hf[token_idx])
    block_expert = jnp.minimum(
        jnp.searchsorted(pad_ends, jnp.arange(n_blocks) * MOE_BLOCK, side='right'), N_EXPERTS - 1)

    def expert_block(args):
        xb, e = args
        return (jax.nn.silu(xb @ w_gate[e]) * (xb @ w_up[e])) @ w_down[e]

    y_buf = lax.map(expert_block, (x_buf.reshape(n_blocks, MOE_BLOCK, D), block_expert)).reshape(-1, D)
    y = y_buf[dest] * g_flat[order][:, None].astype(h.dtype)
    out = jnp.zeros((T, D), h.dtype).at[token_idx].add(y)
    return out.reshape(B, S, D)


def setup_inputs(seed: int = 0) -> dict:
    key = jax.random.key(seed)
    ks = iter(jax.random.split(key, 40))
    n_conv = (DEPTH + 1) // 2
    n_gla = DEPTH // 2
    D = D_MODEL

    def nrm(shape, scale):
        return jax.random.normal(next(ks), shape, jnp.float32) * scale

    def gain(shape):
        return 1.0 + 0.02 * jax.random.normal(next(ks), shape, jnp.float32)

    gla_in_cols = 2 * GLA_DK + GLA_DV + GLA_RANK + GLA_DV
    return {
        'x': nrm((BATCH, SEQ, D), 1.0),
        'mem': nrm((BATCH, N_MEM, D), 1.0),
        'norm_mix': gain((DEPTH, D)),
        'norm_xattn': gain((DEPTH, D)),
        'norm_ffn': gain((DEPTH, D)),
        'norm_mem': gain((D,)),
        'norm_final': gain((D,)),
        'conv_w_in': nrm((n_conv, D, 2 * D), D ** -0.5),
        'conv_b_in': nrm((n_conv, 2 * D), 0.02),
        'conv_w_dw': nrm((n_conv, CONV_KERNEL, D), CONV_KERNEL ** -0.5),
        'conv_b_dw': nrm((n_conv, D), 0.02),
        'conv_ln_g': gain((n_conv, D)),
        'conv_ln_b': nrm((n_conv, D), 0.02),
        'conv_w_out': nrm((n_conv, D, D), D ** -0.5),
        'conv_b_out': nrm((n_conv, D), 0.02),
        'gla_w_in': nrm((n_gla, D, gla_in_cols), D ** -0.5),
        'gla_w_a2': nrm((n_gla, GLA_RANK, GLA_DK), GLA_RANK ** -0.5),
        'gla_b_a': nrm((n_gla, GLA_DK), 0.1),
        'gla_norm_g': gain((n_gla, GLA_DVH)),
        'gla_w_o': nrm((n_gla, GLA_DV, D), GLA_DV ** -0.5),
        'xa_w_q': nrm((DEPTH, D, D), D ** -0.5),
        'xa_w_kv': nrm((DEPTH, D, 2 * D), D ** -0.5),
        'xa_w_o': nrm((DEPTH, D, D), D ** -0.5),
        'moe_w_grp': nrm((DEPTH, D, N_GROUPS), D ** -0.5),
        'moe_b_grp': nrm((DEPTH, N_GROUPS), 0.01),
        'moe_w_exp': nrm((DEPTH, D, N_EXPERTS), D ** -0.5),
        'moe_b_exp': nrm((DEPTH, N_EXPERTS), 0.01),
        'moe_w_gate': nrm((DEPTH, N_EXPERTS, D, D_EXPERT), D ** -0.5),
        'moe_w_up': nrm((DEPTH, N_EXPERTS, D, D_EXPERT), D ** -0.5),
        'moe_w_down': nrm((DEPTH, N_EXPERTS, D_EXPERT, D), D_EXPERT ** -0.5),
    }


def reference(x, mem, norm_mix, norm_xattn, norm_ffn, norm_mem, norm_final,
              conv_w_in, conv_b_in, conv_w_dw, conv_b_dw, conv_ln_g, conv_ln_b, conv_w_out, conv_b_out,
              gla_w_in, gla_w_a2, gla_b_a, gla_norm_g, gla_w_o,
              xa_w_q, xa_w_kv, xa_w_o,
              moe_w_grp, moe_b_grp, moe_w_exp, moe_b_exp, moe_w_gate, moe_w_up, moe_w_down):
    mem_n = rms_norm(mem, norm_mem)
    for i in range(DEPTH):
        h = rms_norm(x, norm_mix[i])
        j = i // N_MIXERS
        if i % N_MIXERS == 0:
            x = x + conformer_conv(h, conv_w_in[j], conv_b_in[j], conv_w_dw[j], conv_b_dw[j],
                                   conv_ln_g[j], conv_ln_b[j], conv_w_out[j], conv_b_out[j])
        else:
            x = x + gla_mixer(h, gla_w_in[j], gla_w_a2[j], gla_b_a[j], gla_norm_g[j], gla_w_o[j])
        x = x + mem_cross_attn(rms_norm(x, norm_xattn[i]), mem_n, xa_w_q[i], xa_w_kv[i], xa_w_o[i])
        x = x + hier_moe(rms_norm(x, norm_ffn[i]), moe_w_grp[i], moe_b_grp[i], moe_w_exp[i], moe_b_exp[i],
                         moe_w_gate[i], moe_w_up[i], moe_w_down[i])
    return rms_norm(x, norm_final)
```

```cpp
#include <hip/hip_runtime.h>
#include <hip/hip_cooperative_groups.h>
#include <cstdio>
#include <cstring>
namespace cg = cooperative_groups;

#ifndef MEGA
#define MEGA 0
#endif

constexpr int D = 1024, NB = 4, S = 8192, T = NB * S, NMEM = 256, DEPTH = 2;
constexpr int CONVK = 31;
constexpr int GH = 4, GDK = 512, GDV = 1024, GDKH = 128, GDVH = 256, GRANK = 16, GLA_COLS = 3088;
constexpr int XH = 4, XHD = 256;
constexpr int NG = 4, EPG = 8, NE = 32, DE = 512;
constexpr int NA = T * 2;
constexpr int NSLOT = NA + NE * 128;
constexpr float EPS = 1e-6f;

constexpr size_t MiB = 1u << 20;
constexpr size_t WS_HN = 0;
constexpr size_t WS_BIG = 128 * MiB;
constexpr size_t WS_SMALL = 528 * MiB;
constexpr size_t WS_MEMN = WS_SMALL;
constexpr size_t WS_KV = WS_MEMN + 4 * MiB;
constexpr size_t WS_EID = WS_KV + 16 * MiB;
constexpr size_t WS_GATE = WS_EID + NA * 4;
constexpr size_t WS_POS = WS_GATE + NA * 4;
constexpr size_t WS_SLOTTOK = WS_POS + NA * 4;
constexpr size_t WS_SLOTA = WS_SLOTTOK + NSLOT * 4;
constexpr size_t WS_TILEE = WS_SLOTA + NSLOT * 4;
constexpr size_t WS_CNT = WS_TILEE + 4096;
constexpr size_t WS_END = WS_CNT + 4096;

struct Ctx {
    const float* in[30];
    float* out;
    unsigned char* ws;
};

__device__ __forceinline__ float wave_sum(float v) {
#pragma unroll
    for (int o = 1; o < 64; o <<= 1) v += __shfl_xor(v, o);
    return v;
}
__device__ __forceinline__ float wave_max(float v) {
#pragma unroll
    for (int o = 1; o < 64; o <<= 1) v = fmaxf(v, __shfl_xor(v, o));
    return v;
}
__device__ __forceinline__ float sigmoidf_(float x) { return 1.0f / (1.0f + expf(-x)); }
__device__ __forceinline__ float siluf_(float x) { return x / (1.0f + expf(-x)); }

__device__ void n_rms(const float* x, const float* g, float* out, int rows) {
    const int lane = threadIdx.x & 63;
    const int gw = (blockIdx.x * blockDim.x + threadIdx.x) >> 6, ngw = (gridDim.x * blockDim.x) >> 6;
    for (int r = gw; r < rows; r += ngw) {
        const float4* xr = (const float4*)(x + (size_t)r * D);
        float4 v[4]; float s = 0.f;
#pragma unroll
        for (int j = 0; j < 4; ++j) { v[j] = xr[lane + 64 * j]; s += v[j].x * v[j].x + v[j].y * v[j].y + v[j].z * v[j].z + v[j].w * v[j].w; }
        s = wave_sum(s);
        const float rs = rsqrtf(s * (1.0f / D) + EPS);
        float4* o = (float4*)(out + (size_t)r * D);
#pragma unroll
        for (int j = 0; j < 4; ++j) { const float4 gg = ((const float4*)g)[lane + 64 * j];
            o[lane + 64 * j] = make_float4(v[j].x * rs * gg.x, v[j].y * rs * gg.y, v[j].z * rs * gg.z, v[j].w * rs * gg.w); }
    }
}
__device__ void n_copy4(const float* src, float* dst, size_t n4) {
    const size_t g = (size_t)blockIdx.x * blockDim.x + threadIdx.x, gs = (size_t)gridDim.x * blockDim.x;
    for (size_t i = g; i < n4; i += gs) ((float4*)dst)[i] = ((const float4*)src)[i];
}

struct EpiStore { float* C; int ldc; const float* bias;
    __device__ __forceinline__ void operator()(int m, int n, float acc) const { C[(size_t)m * ldc + n] = acc + (bias ? bias[n] : 0.f); } };
struct EpiResid { float* X; int ldc; const float* bias;
    __device__ __forceinline__ void operator()(int m, int n, float acc) const { X[(size_t)m * ldc + n] += acc + (bias ? bias[n] : 0.f); } };
struct EpiMoeDown { float* Y; const int* slot_a; const float* gate;
    __device__ __forceinline__ void operator()(int m, int n, float acc) const { const int a = slot_a[m]; if (a >= 0) Y[(size_t)a * D + n] = acc * gate[a]; } };

template <class Epi>
__device__ void n_gemm(float* sm, const float* A, int lda, const int* arow, const float* W, int ldw, size_t wstride, const int* tile_e,
                       int M, int N, int K, Epi epi) {
    float* As = sm;
    float* Bs = sm + 16 * 132;
    const int tid = threadIdx.x, ty = tid >> 5, tx = tid & 31;
    const int ntm = M / 128, ntn = (N + 255) / 256;
    for (int tile = blockIdx.x; tile < ntm * ntn; tile += gridDim.x) {
        const int mt = tile / ntn, nt = tile % ntn;
        const float* Wb = W;
        if (tile_e) { const int e = tile_e[mt]; if (e < 0) continue; Wb = W + (size_t)e * wstride; }
        const int m0 = mt * 128, n0 = nt * 256;
        float acc[8][8];
#pragma unroll
        for (int i = 0; i < 8; ++i)
#pragma unroll
            for (int j = 0; j < 8; ++j) acc[i][j] = 0.f;
        const int ar = tid >> 2, akq = (tid & 3) * 4;
        const int srow = arow ? arow[m0 + ar] : (m0 + ar);
        const float* ap = srow >= 0 ? A + (size_t)srow * lda : nullptr;
        const int bk = tid >> 6, bn = (tid & 63) * 4;
        for (int k0 = 0; k0 < K; k0 += 16) {
            float4 av = ap ? *(const float4*)(ap + k0 + akq) : make_float4(0.f, 0.f, 0.f, 0.f);
            As[(akq + 0) * 132 + ar] = av.x; As[(akq + 1) * 132 + ar] = av.y; As[(akq + 2) * 132 + ar] = av.z; As[(akq + 3) * 132 + ar] = av.w;
#pragma unroll
            for (int i = 0; i < 2; ++i) {
                const int kk = bk + 8 * i; const int n = n0 + bn;
                float4 bv = (n < N) ? *(const float4*)(Wb + (size_t)(k0 + kk) * ldw + n) : make_float4(0.f, 0.f, 0.f, 0.f);
                *(float4*)(Bs + kk * 260 + bn) = bv;
            }
            __syncthreads();
#pragma unroll
            for (int kk = 0; kk < 16; ++kk) {
                float a[8], b[8];
                *(float4*)(a) = *(const float4*)(As + kk * 132 + ty * 8); *(float4*)(a + 4) = *(const float4*)(As + kk * 132 + ty * 8 + 4);
                *(float4*)(b) = *(const float4*)(Bs + kk * 260 + tx * 8); *(float4*)(b + 4) = *(const float4*)(Bs + kk * 260 + tx * 8 + 4);
#pragma unroll
                for (int i = 0; i < 8; ++i)
#pragma unroll
                    for (int j = 0; j < 8; ++j) acc[i][j] = fmaf(a[i], b[j], acc[i][j]);
            }
            __syncthreads();
        }
#pragma unroll
        for (int i = 0; i < 8; ++i)
#pragma unroll
            for (int j = 0; j < 8; ++j) { const int m = m0 + ty * 8 + i, n = n0 + tx * 8 + j; if (n < N) epi(m, n, acc[i][j]); }
    }
}

__device__ void n_glu(const float* u, float* g) {
    const size_t gi = (size_t)blockIdx.x * blockDim.x + threadIdx.x, gs = (size_t)gridDim.x * blockDim.x;
    for (size_t i = gi; i < (size_t)T * D; i += gs) { const size_t t = i >> 10, c = i & 1023; g[i] = u[t * 2048 + c] * sigmoidf_(u[t * 2048 + 1024 + c]); }
}
__device__ void n_dwconv(const float* g, const float* wdw, const float* bdw, const float* lng, const float* lnb, float* out) {
    const int lane = threadIdx.x & 63;
    const int gw = (blockIdx.x * blockDim.x + threadIdx.x) >> 6, ngw = (gridDim.x * blockDim.x) >> 6;
    for (int t = gw; t < T; t += ngw) {
        const int s = t % S;
        float4 acc[4];
#pragma unroll
        for (int j = 0; j < 4; ++j) acc[j] = ((const float4*)bdw)[lane + 64 * j];
        for (int tap = 0; tap < CONVK; ++tap) {
            const int ss = s - (CONVK - 1) + tap; if (ss < 0) continue;
            const float4* gr = (const float4*)(g + (size_t)(t - (CONVK - 1) + tap) * D);
            const float4* wr = (const float4*)(wdw + (size_t)tap * D);
#pragma unroll
            for (int j = 0; j < 4; ++j) { const float4 a = gr[lane + 64 * j], w = wr[lane + 64 * j];
                acc[j].x = fmaf(a.x, w.x, acc[j].x); acc[j].y = fmaf(a.y, w.y, acc[j].y); acc[j].z = fmaf(a.z, w.z, acc[j].z); acc[j].w = fmaf(a.w, w.w, acc[j].w); }
        }
        float sm_ = 0.f;
#pragma unroll
        for (int j = 0; j < 4; ++j) sm_ += acc[j].x + acc[j].y + acc[j].z + acc[j].w;
        const float mu = wave_sum(sm_) * (1.0f / D);
        float q = 0.f;
#pragma unroll
        for (int j = 0; j < 4; ++j) { acc[j].x -= mu; acc[j].y -= mu; acc[j].z -= mu; acc[j].w -= mu; q += acc[j].x * acc[j].x + acc[j].y * acc[j].y + acc[j].z * acc[j].z + acc[j].w * acc[j].w; }
        const float rstd = rsqrtf(wave_sum(q) * (1.0f / D) + EPS);
        float4* o = (float4*)(out + (size_t)t * D);
#pragma unroll
        for (int j = 0; j < 4; ++j) { const float4 gg = ((const float4*)lng)[lane + 64 * j], bb = ((const float4*)lnb)[lane + 64 * j];
            o[lane + 64 * j] = make_float4(siluf_(acc[j].x * rstd * gg.x + bb.x), siluf_(acc[j].y * rstd * gg.y + bb.y), siluf_(acc[j].z * rstd * gg.z + bb.z), siluf_(acc[j].w * rstd * gg.w + bb.w)); }
    }
}
__device__ void n_attn(const float* q, const float* kv, float* o) {
    const int lane = threadIdx.x & 63;
    const int gw = (blockIdx.x * blockDim.x + threadIdx.x) >> 6, ngw = (gridDim.x * blockDim.x) >> 6;
    for (int it = gw; it < T * XH; it += ngw) {
        const int t = it >> 2, h = it & 3, b = t / S;
        const float4 qv = ((const float4*)(q + (size_t)t * D + h * XHD))[lane];
        const float* kb = kv + (size_t)b * NMEM * 2048 + h * XHD;
        float sc[4];
#pragma unroll
        for (int m4 = 0; m4 < 4; ++m4) {
            float mine = 0.f;
            for (int ml = 0; ml < 64; ++ml) {
                const float4 kk = ((const float4*)(kb + (size_t)(m4 * 64 + ml) * 2048))[lane];
                float p = qv.x * kk.x + qv.y * kk.y + qv.z * kk.z + qv.w * kk.w;
                p = wave_sum(p);
                if (ml == lane) mine = p;
            }
            sc[m4] = mine * 0.0625f;
        }
        float mx = fmaxf(fmaxf(sc[0], sc[1]), fmaxf(sc[2], sc[3])); mx = wave_max(mx);
        float se = 0.f;
#pragma unroll
        for (int m4 = 0; m4 < 4; ++m4) { sc[m4] = expf(sc[m4] - mx); se += sc[m4]; }
        se = wave_sum(se); const float inv = 1.0f / se;
        float4 acc = make_float4(0.f, 0.f, 0.f, 0.f);
        const float* vb = kb + 1024;
#pragma unroll
        for (int m4 = 0; m4 < 4; ++m4)
            for (int ml = 0; ml < 64; ++ml) {
                const float p = __shfl(sc[m4], ml) * inv;
                const float4 vv = ((const float4*)(vb + (size_t)(m4 * 64 + ml) * 2048))[lane];
                acc.x = fmaf(p, vv.x, acc.x); acc.y = fmaf(p, vv.y, acc.y); acc.z = fmaf(p, vv.z, acc.z); acc.w = fmaf(p, vv.w, acc.w);
            }
        ((float4*)(o + (size_t)t * D + h * XHD))[lane] = acc;
    }
}
__device__ void n_moe_init(int* cnt, int* slot_tok, int* slot_a, int* tile_e) {
    const int gi = blockIdx.x * blockDim.x + threadIdx.x, gs = gridDim.x * blockDim.x;
    for (int i = gi; i < NSLOT; i += gs) { slot_tok[i] = -1; slot_a[i] = -1; }
    for (int i = gi; i < NSLOT / 128; i += gs) tile_e[i] = -1;
    if (gi < 32) cnt[gi] = 0;
}
__device__ void n_route(const float* h, const float* wg, const float* bg, const float* we, const float* be, int* eid, float* gate, int* pos, int* cnt) {
    const int lane = threadIdx.x & 63;
    const int gw = (blockIdx.x * blockDim.x + threadIdx.x) >> 6, ngw = (gridDim.x * blockDim.x) >> 6;
    for (int t = gw; t < T; t += ngw) {
        float hv[16];
#pragma unroll
        for (int j = 0; j < 16; ++j) hv[j] = h[(size_t)t * D + j * 64 + lane];
        float gl[4];
#pragma unroll
        for (int o = 0; o < 4; ++o) { float p = 0.f;
#pragma unroll
            for (int j = 0; j < 16; ++j) p = fmaf(hv[j], wg[(size_t)(j * 64 + lane) * NG + o], p);
            gl[o] = wave_sum(p) + bg[o]; }
        int gs = 0; float gm = gl[0];
#pragma unroll
        for (int o = 1; o < 4; ++o) if (gl[o] > gm) { gm = gl[o]; gs = o; }
        float se = 0.f;
#pragma unroll
        for (int o = 0; o < 4; ++o) se += expf(gl[o] - gm);
        const float pg = 1.0f / se;
        float el[8];
#pragma unroll
        for (int o = 0; o < 8; ++o) { float p = 0.f;
#pragma unroll
            for (int j = 0; j < 16; ++j) p = fmaf(hv[j], we[(size_t)(j * 64 + lane) * NE + gs * 8 + o], p);
            el[o] = wave_sum(p) + be[gs * 8 + o]; }
        float em = el[0];
#pragma unroll
        for (int o = 1; o < 8; ++o) em = fmaxf(em, el[o]);
        float pe[8], ps = 0.f;
#pragma unroll
        for (int o = 0; o < 8; ++o) { pe[o] = expf(el[o] - em); ps += pe[o]; }
#pragma unroll
        for (int o = 0; o < 8; ++o) pe[o] = pe[o] / ps;
        int i1 = 0; float p1 = pe[0];
#pragma unroll
        for (int o = 1; o < 8; ++o) if (pe[o] > p1) { p1 = pe[o]; i1 = o; }
        int i2 = -1; float p2 = -1.f;
#pragma unroll
        for (int o = 0; o < 8; ++o) if (o != i1 && pe[o] > p2) { p2 = pe[o]; i2 = o; }
        if (lane == 0) {
            const float den = p1 + p2;
            const int e1 = gs * 8 + i1, e2 = gs * 8 + i2;
            eid[2 * t] = e1; eid[2 * t + 1] = e2;
            gate[2 * t] = pg * p1 / den; gate[2 * t + 1] = pg * p2 / den;
            pos[2 * t] = atomicAdd(&cnt[e1], 1); pos[2 * t + 1] = atomicAdd(&cnt[e2], 1);
        }
    }
}
__device__ void n_moe_build(const int* eid, const int* pos, const int* cnt, int* slot_tok, int* slot_a, int* tile_e) {
    __shared__ int poff[33];
    if (threadIdx.x == 0) { int o = 0; for (int e = 0; e < 32; ++e) { poff[e] = o; o += (cnt[e] + 127) / 128 * 128; } poff[32] = o; }
    __syncthreads();
    const int gi = blockIdx.x * blockDim.x + threadIdx.x, gs = gridDim.x * blockDim.x;
    for (int a = gi; a < NA; a += gs) { const int e = eid[a]; const int sl = poff[e] + pos[a]; slot_tok[sl] = a >> 1; slot_a[sl] = a; }
    for (int mt = gi; mt < NSLOT / 128; mt += gs) { const int r = mt * 128; int e = -1; for (int k = 0; k < 32; ++k) if (r >= poff[k] && r < poff[k + 1]) e = k; tile_e[mt] = e; }
    __syncthreads();
}
__device__ void n_moe_act(float* g, const float* u) {
    const size_t gi = (size_t)blockIdx.x * blockDim.x + threadIdx.x, gs = (size_t)gridDim.x * blockDim.x;
    for (size_t i = gi; i < (size_t)NSLOT * DE / 4; i += gs) { float4 a = ((float4*)g)[i]; const float4 b = ((const float4*)u)[i];
        a.x = siluf_(a.x) * b.x; a.y = siluf_(a.y) * b.y; a.z = siluf_(a.z) * b.z; a.w = siluf_(a.w) * b.w; ((float4*)g)[i] = a; }
}
__device__ void n_moe_combine(float* x, const float* y) {
    const size_t gi = (size_t)blockIdx.x * blockDim.x + threadIdx.x, gs = (size_t)gridDim.x * blockDim.x;
    for (size_t i = gi; i < (size_t)T * D / 4; i += gs) { const size_t t = i >> 8, c = i & 255; float4 a = ((float4*)x)[i];
        const float4 y0 = ((const float4*)y)[(2 * t) * 256 + c], y1 = ((const float4*)y)[(2 * t + 1) * 256 + c];
        a.x += y0.x + y1.x; a.y += y0.y + y1.y; a.z += y0.z + y1.z; a.w += y0.w + y1.w; ((float4*)x)[i] = a; }
}
__device__ void n_gla_decay(const float* proj, const float* wa2, const float* ba, float* dec) {
    const size_t gi = (size_t)blockIdx.x * blockDim.x + threadIdx.x, gs = (size_t)gridDim.x * blockDim.x;
    for (size_t i = gi; i < (size_t)T * GDK; i += gs) { const size_t t = i >> 9; const int j = (int)(i & 511);
        float a = ba[j];
#pragma unroll
        for (int r = 0; r < GRANK; ++r) a = fmaf(proj[t * GLA_COLS + 2048 + r], wa2[r * GDK + j], a);
        const float ls = fminf(a, 0.f) - log1pf(expf(-fabsf(a)));
        dec[i] = expf(ls * (1.0f / 16.0f)); }
}
__device__ void n_gla_rec(float* proj, const float* dec) {
    const int gi = blockIdx.x * blockDim.x + threadIdx.x, gs = gridDim.x * blockDim.x;
    for (int it = gi; it < NB * GH * GDVH; it += gs) {
        const int col = it & 255, h = (it >> 8) & 3, b = it >> 10;
        float st[GDKH];
#pragma unroll
        for (int k = 0; k < GDKH; ++k) st[k] = 0.f;
        const float qs = 0.08838834764831845f;
        for (int s = 0; s < S; ++s) {
            const size_t t = (size_t)b * S + s;
            float* pr = proj + t * GLA_COLS;
            const float v = pr[1024 + h * GDVH + col];
            const float* qq = pr + h * GDKH; const float* kk = pr + 512 + h * GDKH; const float* dd = dec + t * GDK + h * GDKH;
            float o = 0.f;
#pragma unroll
            for (int k = 0; k < GDKH; ++k) { st[k] = fmaf(st[k], dd[k], kk[k] * v); o = fmaf(qq[k], st[k], o); }
            pr[1024 + h * GDVH + col] = o * qs;
        }
    }
}
__device__ void n_gla_norm(const float* proj, const float* ng, float* go) {
    const int lane = threadIdx.x & 63;
    const int gw = (blockIdx.x * blockDim.x + threadIdx.x) >> 6, ngw = (gridDim.x * blockDim.x) >> 6;
    for (int it = gw; it < T * GH; it += ngw) {
        const int t = it >> 2, h = it & 3;
        const float4 ov = ((const float4*)(proj + (size_t)t * GLA_COLS + 1024 + h * GDVH))[lane];
        const float4 rv = ((const float4*)(proj + (size_t)t * GLA_COLS + 2064 + h * GDVH))[lane];
        const float4 gg = ((const float4*)ng)[lane];
        float s = ov.x * ov.x + ov.y * ov.y + ov.z * ov.z + ov.w * ov.w; s = wave_sum(s);
        const float rs = rsqrtf(s * (1.0f / GDVH) + EPS);
        ((float4*)(go + (size_t)t * D + h * GDVH))[lane] = make_float4(ov.x * rs * gg.x * siluf_(rv.x), ov.y * rs * gg.y * siluf_(rv.y), ov.z * rs * gg.z * siluf_(rv.z), ov.w * rs * gg.w * siluf_(rv.w));
    }
}

enum Op { OP_MEMN = 0, OP_MEMKV, OP_COPYX, OP_RMS_MIX, OP_CONV_IN, OP_GLU, OP_DWCONV, OP_CONV_OUT, OP_GLA_IN, OP_GLA_DECAY, OP_GLA_REC, OP_GLA_NORM, OP_GLA_OUT,
          OP_RMS_XA, OP_XA_Q, OP_XA_ATT, OP_XA_O, OP_RMS_FFN, OP_ROUTE, OP_BUILD, OP_MOE_GATE, OP_MOE_UP, OP_MOE_ACT, OP_MOE_DOWN, OP_MOE_COMBINE, OP_FINAL };

__device__ __forceinline__ void run_op(const Ctx& c, int op, int l, float* sm) {
    unsigned char* ws = c.ws;
    float* HN = (float*)(ws + WS_HN); float* BIG = (float*)(ws + WS_BIG);
    float* MEMN = (float*)(ws + WS_MEMN); float* KV = (float*)(ws + WS_KV) + (size_t)l * 1024 * 2048;
    int* eid = (int*)(ws + WS_EID); float* gate = (float*)(ws + WS_GATE); int* pos = (int*)(ws + WS_POS);
    int* slot_tok = (int*)(ws + WS_SLOTTOK); int* slot_a = (int*)(ws + WS_SLOTA); int* tile_e = (int*)(ws + WS_TILEE); int* cnt = (int*)(ws + WS_CNT);
    float* X = c.out;
    switch (op) {
    case OP_MEMN: n_rms(c.in[1], c.in[5], MEMN, NB * NMEM); break;
    case OP_MEMKV: n_gemm(sm, MEMN, D, nullptr, c.in[21] + (size_t)l * D * 2048, 2048, 0, nullptr, NB * NMEM, 2048, D, EpiStore{KV, 2048, nullptr}); break;
    case OP_COPYX: n_copy4(c.in[0], X, (size_t)T * D / 4); break;
    case OP_RMS_MIX: n_rms(X, c.in[2] + l * D, HN, T); break;
    case OP_CONV_IN: n_gemm(sm, HN, D, nullptr, c.in[7], 2048, 0, nullptr, T, 2048, D, EpiStore{BIG, 2048, c.in[8]}); break;
    case OP_GLU: n_glu(BIG, HN); break;
    case OP_DWCONV: n_dwconv(HN, c.in[9], c.in[10], c.in[11], c.in[12], BIG); break;
    case OP_CONV_OUT: n_gemm(sm, BIG, D, nullptr, c.in[13], D, 0, nullptr, T, D, D, EpiResid{X, D, c.in[14]}); break;
    case OP_GLA_IN: n_gemm(sm, HN, D, nullptr, c.in[15], GLA_COLS, 0, nullptr, T, GLA_COLS, D, EpiStore{BIG, GLA_COLS, nullptr}); break;
    case OP_GLA_DECAY: n_gla_decay(BIG, c.in[16], c.in[17], HN); break;
    case OP_GLA_REC: n_gla_rec(BIG, HN); break;
    case OP_GLA_NORM: n_gla_norm(BIG, c.in[18], HN); break;
    case OP_GLA_OUT: n_gemm(sm, HN, D, nullptr, c.in[19], D, 0, nullptr, T, D, D, EpiResid{X, D, nullptr}); break;
    case OP_RMS_XA: n_rms(X, c.in[3] + l * D, HN, T); break;
    case OP_XA_Q: n_gemm(sm, HN, D, nullptr, c.in[20] + (size_t)l * D * D, D, 0, nullptr, T, D, D, EpiStore{BIG, D, nullptr}); break;
    case OP_XA_ATT: n_attn(BIG, KV, BIG + (size_t)T * D); break;
    case OP_XA_O: n_gemm(sm, BIG + (size_t)T * D, D, nullptr, c.in[22] + (size_t)l * D * D, D, 0, nullptr, T, D, D, EpiResid{X, D, nullptr}); break;
    case OP_RMS_FFN: n_rms(X, c.in[4] + l * D, HN, T); n_moe_init(cnt, slot_tok, slot_a, tile_e); break;
    case OP_ROUTE: n_route(HN, c.in[23] + (size_t)l * D * NG, c.in[24] + l * NG, c.in[25] + (size_t)l * D * NE, c.in[26] + l * NE, eid, gate, pos, cnt); break;
    case OP_BUILD: n_moe_build(eid, pos, cnt, slot_tok, slot_a, tile_e); break;
    case OP_MOE_GATE: n_gemm(sm, HN, D, slot_tok, c.in[27] + (size_t)l * NE * D * DE, DE, (size_t)D * DE, tile_e, NSLOT, DE, D, EpiStore{BIG, DE, nullptr}); break;
    case OP_MOE_UP: n_gemm(sm, HN, D, slot_tok, c.in[28] + (size_t)l * NE * D * DE, DE, (size_t)D * DE, tile_e, NSLOT, DE, D, EpiStore{BIG + (size_t)NSLOT * DE, DE, nullptr}); break;
    case OP_MOE_ACT: n_moe_act(BIG, BIG + (size_t)NSLOT * DE); break;
    case OP_MOE_DOWN: n_gemm(sm, BIG, DE, nullptr, c.in[29] + (size_t)l * NE * DE * D, D, (size_t)DE * D, tile_e, NSLOT, D, DE, EpiMoeDown{BIG + (size_t)NSLOT * DE, slot_a, gate}); break;
    case OP_MOE_COMBINE: n_moe_combine(X, BIG + (size_t)NSLOT * DE); break;
    case OP_FINAL: n_rms(X, c.in[6], X, T); break;
    }
}

struct Step { int op, l; };
static const Step g_prog[] = {
    {OP_MEMN, 0}, {OP_MEMKV, 0}, {OP_MEMKV, 1}, {OP_COPYX, 0},
    {OP_RMS_MIX, 0}, {OP_CONV_IN, 0}, {OP_GLU, 0}, {OP_DWCONV, 0}, {OP_CONV_OUT, 0},
    {OP_RMS_XA, 0}, {OP_XA_Q, 0}, {OP_XA_ATT, 0}, {OP_XA_O, 0},
    {OP_RMS_FFN, 0}, {OP_ROUTE, 0}, {OP_BUILD, 0}, {OP_MOE_GATE, 0}, {OP_MOE_UP, 0}, {OP_MOE_ACT, 0}, {OP_MOE_DOWN, 0}, {OP_MOE_COMBINE, 0},
    {OP_RMS_MIX, 1}, {OP_GLA_IN, 0}, {OP_GLA_DECAY, 0}, {OP_GLA_REC, 0}, {OP_GLA_NORM, 0}, {OP_GLA_OUT, 0},
    {OP_RMS_XA, 1}, {OP_XA_Q, 1}, {OP_XA_ATT, 1}, {OP_XA_O, 1},
    {OP_RMS_FFN, 1}, {OP_ROUTE, 1}, {OP_BUILD, 1}, {OP_MOE_GATE, 1}, {OP_MOE_UP, 1}, {OP_MOE_ACT, 1}, {OP_MOE_DOWN, 1}, {OP_MOE_COMBINE, 1},
    {OP_FINAL, 0}};
constexpr int NSTEP = sizeof(g_prog) / sizeof(g_prog[0]);

template <int OP> __global__ void __launch_bounds__(512) k_stage(Ctx c, int l) {
    __shared__ float sm[16 * 132 + 16 * 260];
    run_op(c, OP, l, sm);
}
typedef void (*StageFn)(Ctx, int);
template <int... I> struct Seq {};
template <int N, int... I> struct MkSeq : MkSeq<N - 1, N - 1, I...> {};
template <int... I> struct MkSeq<0, I...> { typedef Seq<I...> type; };
template <int... I> static void fill_tab(StageFn* t, Seq<I...>) { StageFn f[] = {k_stage<I>...}; for (unsigned i = 0; i < sizeof...(I); ++i) t[i] = f[i]; }

#if MEGA
struct Prog { int op[64]; int l[64]; int n; int pad; };
__global__ void __launch_bounds__(512) k_mega(Ctx c, Prog p) {
    __shared__ float sm[16 * 132 + 16 * 260];
    cg::grid_group grid = cg::this_grid();
    for (int i = 0; i < p.n; ++i) {
        run_op(c, p.op[i], p.l[i], sm);
        if (i + 1 < p.n) grid.sync();
    }
}
#endif

extern "C" void kernel_launch(void* const* d_in, const int* in_sizes, int n_in, void* d_out, int out_size, void* d_ws, size_t ws_size, hipStream_t stream) {
    if (n_in != 30 || out_size != T * D || ws_size < WS_END) { fprintf(stderr, "kernel_launch: bad args n_in %d out %d ws %zu (need %zu)\n", n_in, out_size, ws_size, (size_t)WS_END); return; }
    Ctx c; memset(&c, 0, sizeof(c));
    for (int i = 0; i < 30; ++i) c.in[i] = (const float*)d_in[i];
    c.out = (float*)d_out; c.ws = (unsigned char*)d_ws;
#if MEGA
    static int grid_blocks = 0;
    if (!grid_blocks) {
        int dev = 0, cus = 0, per_cu = 0;
        hipGetDevice(&dev);
        hipDeviceGetAttribute(&cus, hipDeviceAttributeMultiprocessorCount, dev);
        hipOccupancyMaxActiveBlocksPerMultiprocessor(&per_cu, k_mega, 512, 0);
        if (per_cu < 1) per_cu = 1;
        grid_blocks = cus * per_cu;
        fprintf(stderr, "kernel_launch: cus %d per_cu %d grid %d\n", cus, per_cu, grid_blocks);
    }
    Prog p; memset(&p, 0, sizeof(p));
    p.n = NSTEP; for (int i = 0; i < NSTEP; ++i) { p.op[i] = g_prog[i].op; p.l[i] = g_prog[i].l; }
    void* args[] = {&c, &p};
    hipError_t e = hipLaunchCooperativeKernel((void*)k_mega, dim3(grid_blocks), dim3(512), args, 0, stream);
    if (e != hipSuccess) fprintf(stderr, "cooperative launch failed: %s (grid %d)\n", hipGetErrorString(e), grid_blocks);
#else
    static StageFn tab[OP_FINAL + 1];
    static bool init = false; if (!init) { fill_tab(tab, MkSeq<OP_FINAL + 1>::type()); init = true; }
    for (int i = 0; i < NSTEP; ++i) hipLaunchKernelGGL(tab[g_prog[i].op], dim3(1024), dim3(512), 0, stream, c, g_prog[i].l);
#endif
}
```

```cpp
#include <hip/hip_runtime.h>
#include <hip/hip_cooperative_groups.h>
#include <cstdio>
#include <cstring>
namespace cg = cooperative_groups;

#ifndef MEGA
#define MEGA 0
#endif

constexpr int D = 1024, NB = 4, S = 8192, T = NB * S, NMEM = 256, DEPTH = 2;
constexpr int CONVK = 31;
constexpr int GH = 4, GDK = 512, GDV = 1024, GDKH = 128, GDVH = 256, GRANK = 16, GLA_COLS = 3088;
constexpr int XH = 4, XHD = 256;
constexpr int NG = 4, EPG = 8, NE = 32, DE = 512;
constexpr int NA = T * 2;
constexpr int NSLOT = NA + NE * 128;
constexpr float EPS = 1e-6f;

constexpr size_t MiB = 1u << 20;
constexpr size_t WS_HN = 0;
constexpr size_t WS_BIG = 128 * MiB;
constexpr size_t WS_SMALL = 528 * MiB;
constexpr size_t WS_MEMN = WS_SMALL;
constexpr size_t WS_KV = WS_MEMN + 4 * MiB;
constexpr size_t WS_EID = WS_KV + 16 * MiB;
constexpr size_t WS_GATE = WS_EID + NA * 4;
constexpr size_t WS_POS = WS_GATE + NA * 4;
constexpr size_t WS_SLOTTOK = WS_POS + NA * 4;
constexpr size_t WS_SLOTA = WS_SLOTTOK + NSLOT * 4;
constexpr size_t WS_TILEE = WS_SLOTA + NSLOT * 4;
constexpr size_t WS_CNT = WS_TILEE + 4096;
constexpr size_t WS_END = WS_CNT + 4096;

struct Ctx {
    const float* in[30];
    float* out;
    unsigned char* ws;
};

__device__ __forceinline__ float wave_sum(float v) {
#pragma unroll
    for (int o = 1; o < 64; o <<= 1) v += __shfl_xor(v, o);
    return v;
}
__device__ __forceinline__ float wave_max(float v) {
#pragma unroll
    for (int o = 1; o < 64; o <<= 1) v = fmaxf(v, __shfl_xor(v, o));
    return v;
}
__device__ __forceinline__ float sigmoidf_(float x) { return 1.0f / (1.0f + expf(-x)); }
__device__ __forceinline__ float siluf_(float x) { return x / (1.0f + expf(-x)); }

__device__ void n_rms(const float* x, const float* g, float* out, int rows) {
    const int lane = threadIdx.x & 63;
    const int gw = (blockIdx.x * blockDim.x + threadIdx.x) >> 6, ngw = (gridDim.x * blockDim.x) >> 6;
    for (int r = gw; r < rows; r += ngw) {
        const float4* xr = (const float4*)(x + (size_t)r * D);
        float4 v[4]; float s = 0.f;
#pragma unroll
        for (int j = 0; j < 4; ++j) { v[j] = xr[lane + 64 * j]; s += v[j].x * v[j].x + v[j].y * v[j].y + v[j].z * v[j].z + v[j].w * v[j].w; }
        s = wave_sum(s);
        const float rs = rsqrtf(s * (1.0f / D) + EPS);
        float4* o = (float4*)(out + (size_t)r * D);
#pragma unroll
        for (int j = 0; j < 4; ++j) { const float4 gg = ((const float4*)g)[lane + 64 * j];
            o[lane + 64 * j] = make_float4(v[j].x * rs * gg.x, v[j].y * rs * gg.y, v[j].z * rs * gg.z, v[j].w * rs * gg.w); }
    }
}
__device__ void n_copy4(const float* src, float* dst, size_t n4) {
    const size_t g = (size_t)blockIdx.x * blockDim.x + threadIdx.x, gs = (size_t)gridDim.x * blockDim.x;
    for (size_t i = g; i < n4; i += gs) ((float4*)dst)[i] = ((const float4*)src)[i];
}

struct EpiStore { float* C; int ldc; const float* bias;
    __device__ __forceinline__ void operator()(int m, int n, float acc) const { C[(size_t)m * ldc + n] = acc + (bias ? bias[n] : 0.f); } };
struct EpiResid { float* X; int ldc; const float* bias;
    __device__ __forceinline__ void operator()(int m, int n, float acc) const { X[(size_t)m * ldc + n] += acc + (bias ? bias[n] : 0.f); } };
struct EpiMoeDown { float* Y; const int* slot_a; const float* gate;
    __device__ __forceinline__ void operator()(int m, int n, float acc) const { const int a = slot_a[m]; if (a >= 0) Y[(size_t)a * D + n] = acc * gate[a]; } };

template <class Epi>
__device__ void n_gemm(float* sm, const float* A, int lda, const int* arow, const float* W, int ldw, size_t wstride, const int* tile_e,
                       int M, int N, int K, Epi epi) {
    float* As = sm;
    float* Bs = sm + 16 * 132;
    const int tid = threadIdx.x, ty = tid >> 5, tx = tid & 31;
    const int ntm = M / 128, ntn = (N + 255) / 256;
    for (int tile = blockIdx.x; tile < ntm * ntn; tile += gridDim.x) {
        const int mt = tile / ntn, nt = tile % ntn;
        const float* Wb = W;
        if (tile_e) { const int e = tile_e[mt]; if (e < 0) continue; Wb = W + (size_t)e * wstride; }
        const int m0 = mt * 128, n0 = nt * 256;
        float acc[8][8];
#pragma unroll
        for (int i = 0; i < 8; ++i)
#pragma unroll
            for (int j = 0; j < 8; ++j) acc[i][j] = 0.f;
        const int ar = tid >> 2, akq = (tid & 3) * 4;
        const int srow = arow ? arow[m0 + ar] : (m0 + ar);
        const float* ap = srow >= 0 ? A + (size_t)srow * lda : nullptr;
        const int bk = tid >> 6, bn = (tid & 63) * 4;
        for (int k0 = 0; k0 < K; k0 += 16) {
            float4 av = ap ? *(const float4*)(ap + k0 + akq) : make_float4(0.f, 0.f, 0.f, 0.f);
            As[(akq + 0) * 132 + ar] = av.x; As[(akq + 1) * 132 + ar] = av.y; As[(akq + 2) * 132 + ar] = av.z; As[(akq + 3) * 132 + ar] = av.w;
#pragma unroll
            for (int i = 0; i < 2; ++i) {
                const int kk = bk + 8 * i; const int n = n0 + bn;
                float4 bv = (n < N) ? *(const float4*)(Wb + (size_t)(k0 + kk) * ldw + n) : make_float4(0.f, 0.f, 0.f, 0.f);
                *(float4*)(Bs + kk * 260 + bn) = bv;
            }
            __syncthreads();
#pragma unroll
            for (int kk = 0; kk < 16; ++kk) {
                float a[8], b[8];
                *(float4*)(a) = *(const float4*)(As + kk * 132 + ty * 8); *(float4*)(a + 4) = *(const float4*)(As + kk * 132 + ty * 8 + 4);
                *(float4*)(b) = *(const float4*)(Bs + kk * 260 + tx * 8); *(float4*)(b + 4) = *(const float4*)(Bs + kk * 260 + tx * 8 + 4);
#pragma unroll
                for (int i = 0; i < 8; ++i)
#pragma unroll
                    for (int j = 0; j < 8; ++j) acc[i][j] = fmaf(a[i], b[j], acc[i][j]);
            }
            __syncthreads();
        }
#pragma unroll
        for (int i = 0; i < 8; ++i)
#pragma unroll
            for (int j = 0; j < 8; ++j) { const int m = m0 + ty * 8 + i, n = n0 + tx * 8 + j; if (n < N) epi(m, n, acc[i][j]); }
    }
}

__device__ void n_glu(const float* u, float* g) {
    const size_t gi = (size_t)blockIdx.x * blockDim.x + threadIdx.x, gs = (size_t)gridDim.x * blockDim.x;
    for (size_t i = gi; i < (size_t)T * D; i += gs) { const size_t t = i >> 10, c = i & 1023; g[i] = u[t * 2048 + c] * sigmoidf_(u[t * 2048 + 1024 + c]); }
}
__device__ void n_dwconv(const float* g, const float* wdw, const float* bdw, const float* lng, const float* lnb, float* out) {
    const int lane = threadIdx.x & 63;
    const int gw = (blockIdx.x * blockDim.x + threadIdx.x) >> 6, ngw = (gridDim.x * blockDim.x) >> 6;
    for (int t = gw; t < T; t += ngw) {
        const int s = t % S;
        float4 acc[4];
#pragma unroll
        for (int j = 0; j < 4; ++j) acc[j] = ((const float4*)bdw)[lane + 64 * j];
        for (int tap = 0; tap < CONVK; ++tap) {
            const int ss = s - (CONVK - 1) + tap; if (ss < 0) continue;
            const float4* gr = (const float4*)(g + (size_t)(t - (CONVK - 1) + tap) * D);
            const float4* wr = (const float4*)(wdw + (size_t)tap * D);
#pragma unroll
            for (int j = 0; j < 4; ++j) { const float4 a = gr[lane + 64 * j], w = wr[lane + 64 * j];
                acc[j].x = fmaf(a.x, w.x, acc[j].x); acc[j].y = fmaf(a.y, w.y, acc[j].y); acc[j].z = fmaf(a.z, w.z, acc[j].z); acc[j].w = fmaf(a.w, w.w, acc[j].w); }
        }
        float sm_ = 0.f;
#pragma unroll
        for (int j = 0; j < 4; ++j) sm_ += acc[j].x + acc[j].y + acc[j].z + acc[j].w;
        const float mu = wave_sum(sm_) * (1.0f / D);
        float q = 0.f;
#pragma unroll
        for (int j = 0; j < 4; ++j) { acc[j].x -= mu; acc[j].y -= mu; acc[j].z -= mu; acc[j].w -= mu; q += acc[j].x * acc[j].x + acc[j].y * acc[j].y + acc[j].z * acc[j].z + acc[j].w * acc[j].w; }
        const float rstd = rsqrtf(wave_sum(q) * (1.0f / D) + EPS);
        float4* o = (float4*)(out + (size_t)t * D);
#pragma unroll
        for (int j = 0; j < 4; ++j) { const float4 gg = ((const float4*)lng)[lane + 64 * j], bb = ((const float4*)lnb)[lane + 64 * j];
            o[lane + 64 * j] = make_float4(siluf_(acc[j].x * rstd * gg.x + bb.x), siluf_(acc[j].y * rstd * gg.y + bb.y), siluf_(acc[j].z * rstd * gg.z + bb.z), siluf_(acc[j].w * rstd * gg.w + bb.w)); }
    }
}
__device__ void n_attn(const float* q, const float* kv, float* o) {
    const int lane = threadIdx.x & 63;
    const int gw = (blockIdx.x * blockDim.x + threadIdx.x) >> 6, ngw = (gridDim.x * blockDim.x) >> 6;
    for (int it = gw; it < T * XH; it += ngw) {
        const int t = it >> 2, h = it & 3, b = t / S;
        const float4 qv = ((const float4*)(q + (size_t)t * D + h * XHD))[lane];
        const float* kb = kv + (size_t)b * NMEM * 2048 + h * XHD;
        float sc[4];
#pragma unroll
        for (int m4 = 0; m4 < 4; ++m4) {
            float mine = 0.f;
            for (int ml = 0; ml < 64; ++ml) {
                const float4 kk = ((const float4*)(kb + (size_t)(m4 * 64 + ml) * 2048))[lane];
                float p = qv.x * kk.x + qv.y * kk.y + qv.z * kk.z + qv.w * kk.w;
                p = wave_sum(p);
                if (ml == lane) mine = p;
            }
            sc[m4] = mine * 0.0625f;
        }
        float mx = fmaxf(fmaxf(sc[0], sc[1]), fmaxf(sc[2], sc[3])); mx = wave_max(mx);
        float se = 0.f;
#pragma unroll
        for (int m4 = 0; m4 < 4; ++m4) { sc[m4] = expf(sc[m4] - mx); se += sc[m4]; }
        se = wave_sum(se); const float inv = 1.0f / se;
        float4 acc = make_float4(0.f, 0.f, 0.f, 0.f);
        const float* vb = kb + 1024;
#pragma unroll
        for (int m4 = 0; m4 < 4; ++m4)
            for (int ml = 0; ml < 64; ++ml) {
                const float p = __shfl(sc[m4], ml) * inv;
                const float4 vv = ((const float4*)(vb + (size_t)(m4 * 64 + ml) * 2048))[lane];
                acc.x = fmaf(p, vv.x, acc.x); acc.y = fmaf(p, vv.y, acc.y); acc.z = fmaf(p, vv.z, acc.z); acc.w = fmaf(p, vv.w, acc.w);
            }
        ((float4*)(o + (size_t)t * D + h * XHD))[lane] = acc;
    }
}
__device__ void n_moe_init(int* cnt, int* slot_tok, int* slot_a, int* tile_e) {
    const int gi = blockIdx.x * blockDim.x + threadIdx.x, gs = gridDim.x * blockDim.x;
    for (int i = gi; i < NSLOT; i += gs) { slot_tok[i] = -1; slot_a[i] = -1; }
    for (int i = gi; i < NSLOT / 128; i += gs) tile_e[i] = -1;
    if (gi < 32) cnt[gi] = 0;
}
__device__ void n_route(const float* h, const float* wg, const float* bg, const float* we, const float* be, int* eid, float* gate, int* pos, int* cnt) {
    const int lane = threadIdx.x & 63;
    const int gw = (blockIdx.x * blockDim.x + threadIdx.x) >> 6, ngw = (gridDim.x * blockDim.x) >> 6;
    for (int t = gw; t < T; t += ngw) {
        float hv[16];
#pragma unroll
        for (int j = 0; j < 16; ++j) hv[j] = h[(size_t)t * D + j * 64 + lane];
        float gl[4];
#pragma unroll
        for (int o = 0; o < 4; ++o) { float p = 0.f;
#pragma unroll
            for (int j = 0; j < 16; ++j) p = fmaf(hv[j], wg[(size_t)(j * 64 + lane) * NG + o], p);
            gl[o] = wave_sum(p) + bg[o]; }
        int gs = 0; float gm = gl[0];
#pragma unroll
        for (int o = 1; o < 4; ++o) if (gl[o] > gm) { gm = gl[o]; gs = o; }
        float se = 0.f;
#pragma unroll
        for (int o = 0; o < 4; ++o) se += expf(gl[o] - gm);
        const float pg = 1.0f / se;
        float el[8];
#pragma unroll
        for (int o = 0; o < 8; ++o) { float p = 0.f;
#pragma unroll
            for (int j = 0; j < 16; ++j) p = fmaf(hv[j], we[(size_t)(j * 64 + lane) * NE + gs * 8 + o], p);
            el[o] = wave_sum(p) + be[gs * 8 + o]; }
        float em = el[0];
#pragma unroll
        for (int o = 1; o < 8; ++o) em = fmaxf(em, el[o]);
        float pe[8], ps = 0.f;
#pragma unroll
        for (int o = 0; o < 8; ++o) { pe[o] = expf(el[o] - em); ps += pe[o]; }
#pragma unroll
        for (int o = 0; o < 8; ++o) pe[o] = pe[o] / ps;
        int i1 = 0; float p1 = pe[0];
#pragma unroll
        for (int o = 1; o < 8; ++o) if (pe[o] > p1) { p1 = pe[o]; i1 = o; }
        int i2 = -1; float p2 = -1.f;
#pragma unroll
        for (int o = 0; o < 8; ++o) if (o != i1 && pe[o] > p2) { p2 = pe[o]; i2 = o; }
        if (lane == 0) {
            const float den = p1 + p2;
            const int e1 = gs * 8 + i1, e2 = gs * 8 + i2;
            eid[2 * t] = e1; eid[2 * t + 1] = e2;
            gate[2 * t] = pg * p1 / den; gate[2 * t + 1] = pg * p2 / den;
            pos[2 * t] = atomicAdd(&cnt[e1], 1); pos[2 * t + 1] = atomicAdd(&cnt[e2], 1);
        }
    }
}
__device__ void n_moe_build(const int* eid, const int* pos, const int* cnt, int* slot_tok, int* slot_a, int* tile_e) {
    __shared__ int poff[33];
    if (threadIdx.x == 0) { int o = 0; for (int e = 0; e < 32; ++e) { poff[e] = o; o += (cnt[e] + 127) / 128 * 128; } poff[32] = o; }
    __syncthreads();
    const int gi = blockIdx.x * blockDim.x + threadIdx.x, gs = gridDim.x * blockDim.x;
    for (int a = gi; a < NA; a += gs) { const int e = eid[a]; const int sl = poff[e] + pos[a]; slot_tok[sl] = a >> 1; slot_a[sl] = a; }
    for (int mt = gi; mt < NSLOT / 128; mt += gs) { const int r = mt * 128; int e = -1; for (int k = 0; k < 32; ++k) if (r >= poff[k] && r < poff[k + 1]) e = k; tile_e[mt] = e; }
    __syncthreads();
}
__device__ void n_moe_act(float* g, const float* u) {
    const size_t gi = (size_t)blockIdx.x * blockDim.x + threadIdx.x, gs = (size_t)gridDim.x * blockDim.x;
    for (size_t i = gi; i < (size_t)NSLOT * DE / 4; i += gs) { float4 a = ((float4*)g)[i]; const float4 b = ((const float4*)u)[i];
        a.x = siluf_(a.x) * b.x; a.y = siluf_(a.y) * b.y; a.z = siluf_(a.z) * b.z; a.w = siluf_(a.w) * b.w; ((float4*)g)[i] = a; }
}
__device__ void n_moe_combine(float* x, const float* y) {
    const size_t gi = (size_t)blockIdx.x * blockDim.x + threadIdx.x, gs = (size_t)gridDim.x * blockDim.x;
    for (size_t i = gi; i < (size_t)T * D / 4; i += gs) { const size_t t = i >> 8, c = i & 255; float4 a = ((float4*)x)[i];
        const float4 y0 = ((const float4*)y)[(2 * t) * 256 + c], y1 = ((const float4*)y)[(2 * t + 1) * 256 + c];
        a.x += y0.x + y1.x; a.y += y0.y + y1.y; a.z += y0.z + y1.z; a.w += y0.w + y1.w; ((float4*)x)[i] = a; }
}
__device__ void n_gla_decay(const float* proj, const float* wa2, const float* ba, float* dec) {
    const size_t gi = (size_t)blockIdx.x * blockDim.x + threadIdx.x, gs = (size_t)gridDim.x * blockDim.x;
    for (size_t i = gi; i < (size_t)T * GDK; i += gs) { const size_t t = i >> 9; const int j = (int)(i & 511);
        float a = ba[j];
#pragma unroll
        for (int r = 0; r < GRANK; ++r) a = fmaf(proj[t * GLA_COLS + 2048 + r], wa2[r * GDK + j], a);
        const float ls = fminf(a, 0.f) - log1pf(expf(-fabsf(a)));
        dec[i] = expf(ls * (1.0f / 16.0f)); }
}
__device__ void n_gla_rec(float* proj, const float* dec) {
    const int gi = blockIdx.x * blockDim.x + threadIdx.x, gs = gridDim.x * blockDim.x;
    for (int it = gi; it < NB * GH * GDVH; it += gs) {
        const int col = it & 255, h = (it >> 8) & 3, b = it >> 10;
        float st[GDKH];
#pragma unroll
        for (int k = 0; k < GDKH; ++k) st[k] = 0.f;
        const float qs = 0.08838834764831845f;
        for (int s = 0; s < S; ++s) {
            const size_t t = (size_t)b * S + s;
            float* pr = proj + t * GLA_COLS;
            const float v = pr[1024 + h * GDVH + col];
            const float* qq = pr + h * GDKH; const float* kk = pr + 512 + h * GDKH; const float* dd = dec + t * GDK + h * GDKH;
            float o = 0.f;
#pragma unroll
            for (int k = 0; k < GDKH; ++k) { st[k] = fmaf(st[k], dd[k], kk[k] * v); o = fmaf(qq[k], st[k], o); }
            pr[1024 + h * GDVH + col] = o * qs;
        }
    }
}
__device__ void n_gla_norm(const float* proj, const float* ng, float* go) {
    const int lane = threadIdx.x & 63;
    const int gw = (blockIdx.x * blockDim.x + threadIdx.x) >> 6, ngw = (gridDim.x * blockDim.x) >> 6;
    for (int it = gw; it < T * GH; it += ngw) {
        const int t = it >> 2, h = it & 3;
        const float4 ov = ((const float4*)(proj + (size_t)t * GLA_COLS + 1024 + h * GDVH))[lane];
        const float4 rv = ((const float4*)(proj + (size_t)t * GLA_COLS + 2064 + h * GDVH))[lane];
        const float4 gg = ((const float4*)ng)[lane];
        float s = ov.x * ov.x + ov.y * ov.y + ov.z * ov.z + ov.w * ov.w; s = wave_sum(s);
        const float rs = rsqrtf(s * (1.0f / GDVH) + EPS);
        ((float4*)(go + (size_t)t * D + h * GDVH))[lane] = make_float4(ov.x * rs * gg.x * siluf_(rv.x), ov.y * rs * gg.y * siluf_(rv.y), ov.z * rs * gg.z * siluf_(rv.z), ov.w * rs * gg.w * siluf_(rv.w));
    }
}

#define LAS __attribute__((address_space(3)))
typedef unsigned short bf16_t;
typedef short bf16x8 __attribute__((ext_vector_type(8)));
typedef float f32x4 __attribute__((ext_vector_type(4)));
typedef float f32x2 __attribute__((ext_vector_type(2)));
typedef unsigned u32x4 __attribute__((ext_vector_type(4)));
typedef unsigned u32x2 __attribute__((ext_vector_type(2)));

constexpr int LDS_BYTES = 160 * 1024;
constexpr int NSLOT2 = NA + NE * 256;
constexpr int MAXRT = NSLOT2 / 256;
constexpr size_t OW_XB = 0;
constexpr size_t OW_SSP = 64 * MiB;
constexpr size_t OW_RS = 66 * MiB;
constexpr size_t OW_PSUM = 67 * MiB;
constexpr size_t OW_MOE = 69 * MiB;
constexpr size_t OW_ACTA = 72 * MiB, OW_ACTB = 136 * MiB, OW_ACTC = 200 * MiB;
constexpr size_t OW_H = 72 * MiB, OW_Y = 144 * MiB, OW_WMOE = 272 * MiB;
constexpr size_t OW_KVB = 368 * MiB;
constexpr size_t OW_MEMNB = 372 * MiB;
constexpr size_t OW_WCIN = 550 * MiB, OW_WCOUT = 554 * MiB, OW_WXQ = 556 * MiB, OW_WXKV = 560 * MiB, OW_WXO = 568 * MiB, OW_END = 572 * MiB;

__device__ __forceinline__ unsigned cvt_pk_bf16(float lo, float hi) { unsigned r; asm volatile("v_cvt_pk_bf16_f32 %0, %1, %2" : "=v"(r) : "v"(lo), "v"(hi)); return r; }
__device__ __forceinline__ u32x4 pack8(const f32x4& a, const f32x4& b) { u32x4 w; w.x = cvt_pk_bf16(a[0], a[1]); w.y = cvt_pk_bf16(a[2], a[3]); w.z = cvt_pk_bf16(b[0], b[1]); w.w = cvt_pk_bf16(b[2], b[3]); return w; }
__device__ __forceinline__ float bf_lo(unsigned w) { return __uint_as_float(w << 16); }
__device__ __forceinline__ float bf_hi(unsigned w) { return __uint_as_float(w & 0xffff0000u); }
__device__ __forceinline__ float fast_sigmoid(float x) { return __builtin_amdgcn_rcpf(1.0f + __builtin_amdgcn_exp2f(-1.4426950408889634f * x)); }

namespace g8 {
constexpr int BM = 256, BK = 64, HALF = 128, HTB = HALF * BK * 2, STAGE_BYTES = 8 * HTB;
__device__ __forceinline__ int lds_byte(int r, int c) { const int st = (r >> 4) * 2 + (c >> 5), rr = r & 15, cc = c & 31, ob = rr * 64 + cc * 2; return st * 1024 + (ob ^ (((ob >> 9) & 1) << 5)); }
__device__ __forceinline__ void stage_rc(int b, int& R, int& C) { const int st = b / 1024, sb = b % 1024, swz = sb ^ (((sb >> 9) & 1) << 5); R = (st >> 1) * 16 + swz / 64; C = (st & 1) * 32 + (swz % 64) / 2; }
__device__ __forceinline__ int perm32(int rho) { const int n = rho >> 4, i = rho & 15; return 8 * (i >> 2) + 4 * n + (i & 3); }
struct Unit { int pm, pn, e; };

template <class Epi, class Sched>
__device__ __forceinline__ void gemm_phase(LAS unsigned char* lds, const bf16_t* A, const Sched& S, const Epi& E) {
    const int tid = threadIdx.x, wid = __builtin_amdgcn_readfirstlane(tid >> 6), lane = tid & 63, wr = wid >> 2, wc = wid & 3, fr = lane & 15, fq = lane >> 4;
    const int K = S.K, lda = S.lda, ldb = S.ldb, nt = K / BK;
    int Rr[2], Cc[2]; unsigned voffB[2];
#pragma unroll
    for (int i = 0; i < 2; ++i) { int R, C; stage_rc(tid * 16 + i * 8192, R, C); Rr[i] = R; Cc[i] = C; const int Rb = (R & ~31) + perm32(R & 31); voffB[i] = (unsigned)(Rb * ldb + C) * 2u; }
    const size_t kstep = (size_t)(BK * 2);
    const size_t hstepB = (size_t)HALF * ldb * 2;
    const unsigned ldsw = (unsigned)wid * 1024u;
    const int aoff = lds_byte(wr * 64 + fr, fq * 8), boff = lds_byte(wc * 32 + fr, fq * 8);
#define G8_SA(b, h) (((b) * 2 + (h)) * HTB)
#define G8_SB(b, h) ((4 + (b) * 2 + (h)) * HTB)
#define G8_STAGEA(bufoff, gbase, vv) do { _Pragma("unroll") for (int _i = 0; _i < 2; ++_i) \
        __builtin_amdgcn_global_load_lds((const unsigned*)((const char*)(gbase) + (vv)[_i]), (LAS unsigned*)(lds + (bufoff) + ldsw + _i * 8192), 16, 0, 0); } while (0)
#define G8_STAGEB(bufoff, gbase) do { _Pragma("unroll") for (int _i = 0; _i < 2; ++_i) \
        __builtin_amdgcn_global_load_lds((const unsigned*)((const char*)(gbase) + voffB[_i]), (LAS unsigned*)(lds + (bufoff) + ldsw + _i * 8192), 16, 0, 0); } while (0)
#define G8_LDA(dst, b, h) do { _Pragma("unroll") for (int m = 0; m < 4; ++m) _Pragma("unroll") for (int k = 0; k < 2; ++k) dst[m][k] = *(const LAS bf16x8*)(lds + G8_SA(b, h) + aoff + m * 2048 + k * 1024); } while (0)
#define G8_LDB(dst, b, h) do { _Pragma("unroll") for (int n = 0; n < 2; ++n) _Pragma("unroll") for (int k = 0; k < 2; ++k) dst[n][k] = *(const LAS bf16x8*)(lds + G8_SB(b, h) + boff + n * 2048 + k * 1024); } while (0)
#define G8_MMA(ai, bj, At, Bt) do { __builtin_amdgcn_s_setprio(1); _Pragma("unroll") for (int m = 0; m < 4; ++m) _Pragma("unroll") for (int n = 0; n < 2; ++n) _Pragma("unroll") for (int k = 0; k < 2; ++k) \
        acc[ai][bj][m][n] = __builtin_amdgcn_mfma_f32_16x16x32_bf16(Bt[n][k], At[m][k], acc[ai][bj][m][n], 0, 0, 0); __builtin_amdgcn_s_setprio(0); } while (0)
#define G8_WAIT_V(n) asm volatile("s_waitcnt vmcnt(" #n ")" ::: "memory")
#define G8_WAIT_L(n) asm volatile("s_waitcnt lgkmcnt(" #n ")" ::: "memory")
#define G8_BAR __builtin_amdgcn_s_barrier()
#define G8_SCHED __builtin_amdgcn_sched_barrier(0)
#define G8_VA(dst, u) do { const int _ac = S.a_col(u); _Pragma("unroll") for (int _h = 0; _h < 2; ++_h) _Pragma("unroll") for (int _i = 0; _i < 2; ++_i) \
        dst[_h][_i] = (unsigned)(((size_t)S.a_row(u, _h * HALF + Rr[_i]) * lda + _ac + Cc[_i]) * 2); } while (0)
    Unit cur, nxt; int ui = 0;
    if (!S.next(0, cur)) return;
    f32x4 acc[2][2][4][2];
#pragma unroll
    for (int a = 0; a < 2; ++a)
#pragma unroll
        for (int b = 0; b < 2; ++b)
#pragma unroll
            for (int m = 0; m < 4; ++m)
#pragma unroll
                for (int n = 0; n < 2; ++n) acc[a][b][m][n] = (f32x4){0.f, 0.f, 0.f, 0.f};
    bf16x8 At[4][2], B0[2][2], B1[2][2];
    unsigned va[2][2], nva[2][2];
    G8_VA(va, cur);
    const char* Ab = (const char*)A;
    const char* cB = S.b_base(cur);
    G8_STAGEB(G8_SB(0, 0), cB); G8_STAGEA(G8_SA(0, 0), Ab, va[0]); G8_STAGEB(G8_SB(0, 1), cB + hstepB); G8_STAGEA(G8_SA(0, 1), Ab, va[1]);
    if (wr == 1) G8_BAR;
    G8_WAIT_V(4); G8_BAR;
    G8_STAGEB(G8_SB(1, 0), cB + kstep); G8_STAGEA(G8_SA(1, 0), Ab + kstep, va[0]); G8_STAGEB(G8_SB(1, 1), cB + hstepB + kstep);
    G8_WAIT_V(6); G8_BAR;
    for (;;) {
        const bool has_next = S.next(ui + 1, nxt);
        const char* nB = cB;
        if (has_next) { nB = S.b_base(nxt); G8_VA(nva, nxt); }
        else {
#pragma unroll
            for (int h = 0; h < 2; ++h)
#pragma unroll
                for (int i = 0; i < 2; ++i) nva[h][i] = va[h][i];
        }
        for (int t = 0; t < nt; t += 2) {
            const bool last = (t == nt - 2);
            const char* a1 = Ab + (size_t)(t + 1) * kstep;
            const char* a2 = last ? Ab : Ab + (size_t)(t + 2) * kstep;
            const char* b2 = last ? nB : cB + (size_t)(t + 2) * kstep;
            const char* a3 = a2 + kstep; const char* b3 = b2 + kstep;
            unsigned v2[2][2];
#pragma unroll
            for (int h = 0; h < 2; ++h)
#pragma unroll
                for (int i = 0; i < 2; ++i) v2[h][i] = last ? nva[h][i] : va[h][i];
            G8_LDB(B0, 0, 0); G8_SCHED; G8_LDA(At, 0, 0); G8_STAGEA(G8_SA(1, 1), a1, va[1]);
            G8_WAIT_L(8); G8_BAR; G8_WAIT_L(0); G8_MMA(0, 0, At, B0); G8_BAR; G8_SCHED;
            G8_LDB(B1, 0, 1); G8_STAGEB(G8_SB(0, 0), b2);
            G8_BAR; G8_WAIT_L(0); G8_MMA(0, 1, At, B1); G8_BAR;
            G8_LDA(At, 0, 1); G8_STAGEA(G8_SA(0, 0), a2, v2[0]);
            G8_BAR; G8_WAIT_L(0); G8_MMA(1, 0, At, B0); G8_BAR; G8_SCHED;
            G8_STAGEB(G8_SB(0, 1), b2 + hstepB);
            G8_WAIT_V(6); G8_BAR; G8_MMA(1, 1, At, B1); G8_BAR;
            G8_LDB(B0, 1, 0); G8_SCHED; G8_LDA(At, 1, 0); G8_STAGEA(G8_SA(0, 1), a2, v2[1]);
            G8_WAIT_L(8); G8_BAR; G8_WAIT_L(0); G8_MMA(0, 0, At, B0); G8_BAR; G8_SCHED;
            G8_LDB(B1, 1, 1); G8_STAGEB(G8_SB(1, 0), b3);
            G8_BAR; G8_WAIT_L(0); G8_MMA(0, 1, At, B1); G8_BAR;
            G8_LDA(At, 1, 1); G8_STAGEA(G8_SA(1, 0), a3, v2[0]);
            G8_BAR; G8_WAIT_L(0); G8_MMA(1, 0, At, B0); G8_BAR; G8_SCHED;
            G8_STAGEB(G8_SB(1, 1), b3 + hstepB);
            G8_WAIT_V(6); G8_BAR; G8_MMA(1, 1, At, B1); G8_BAR;
        }
        E(acc, cur, wr, wc, fr, fq);
        if (!has_next) break;
#pragma unroll
        for (int a = 0; a < 2; ++a)
#pragma unroll
            for (int b = 0; b < 2; ++b)
#pragma unroll
                for (int m = 0; m < 4; ++m)
#pragma unroll
                    for (int n = 0; n < 2; ++n) acc[a][b][m][n] = (f32x4){0.f, 0.f, 0.f, 0.f};
        cur = nxt; cB = nB; ++ui;
#pragma unroll
        for (int h = 0; h < 2; ++h)
#pragma unroll
            for (int i = 0; i < 2; ++i) va[h][i] = nva[h][i];
    }
    G8_WAIT_V(0);
    if (wr == 0) G8_BAR;
    G8_BAR;
#undef G8_SA
#undef G8_SB
#undef G8_STAGEA
#undef G8_STAGEB
#undef G8_LDA
#undef G8_LDB
#undef G8_MMA
#undef G8_WAIT_V
#undef G8_WAIT_L
#undef G8_BAR
#undef G8_SCHED
#undef G8_VA
}

struct DenseSched {
    int nN, nU, K, lda, ldb; const bf16_t* Bt;
    __device__ __forceinline__ bool next(int i, Unit& u) const {
        const int c = blockIdx.x, per = gridDim.x >> 3, x = c & 7, j = c >> 3;
        const int chunk = (nU + 7) >> 3, lu = i * per + j;
        if (lu >= chunk) return false;
        const int un = x * chunk + lu; if (un >= nU) return false;
        u.pm = un / nN; u.pn = un - u.pm * nN; u.e = 0; return true; }
    __device__ __forceinline__ int a_row(const Unit& u, int r) const { return u.pm * BM + r; }
    __device__ __forceinline__ int a_col(const Unit&) const { return 0; }
    __device__ __forceinline__ const char* b_base(const Unit& u) const { return (const char*)(Bt + (size_t)u.pn * BM * ldb); }
};

struct EpiGlu {
    bf16_t* U; const float* rs; const float* bias;
    __device__ __forceinline__ void operator()(const f32x4 (&acc)[2][2][4][2], const Unit& u, int wr, int wc, int fr, int fq) const {
        const int c0 = u.pn * 128 + wc * 32 + 8 * fq;
        const f32x4 ba0 = *(const f32x4*)(bias + c0), ba1 = *(const f32x4*)(bias + c0 + 4), bg0 = *(const f32x4*)(bias + 1024 + c0), bg1 = *(const f32x4*)(bias + 1024 + c0 + 4);
#pragma unroll
        for (int ai = 0; ai < 2; ++ai)
#pragma unroll
            for (int m = 0; m < 4; ++m) {
                const int row = u.pm * BM + ai * HALF + wr * 64 + m * 16 + fr; const float r = rs[row];
                f32x4 o0, o1;
#pragma unroll
                for (int j = 0; j < 4; ++j) {
                    o0[j] = (acc[ai][0][m][0][j] * r + ba0[j]) * fast_sigmoid(acc[ai][1][m][0][j] * r + bg0[j]);
                    o1[j] = (acc[ai][0][m][1][j] * r + ba1[j]) * fast_sigmoid(acc[ai][1][m][1][j] * r + bg1[j]); }
                *(u32x4*)(U + (size_t)row * D + c0) = pack8(o0, o1);
            }
    }
};
struct EpiXres {
    const float* Xin; float* Xout; bf16_t* XB; const float* bias; float* ssp;
    __device__ __forceinline__ void operator()(const f32x4 (&acc)[2][2][4][2], const Unit& u, int wr, int wc, int fr, int fq) const {
#pragma unroll
        for (int ai = 0; ai < 2; ++ai)
#pragma unroll
            for (int m = 0; m < 4; ++m) {
                const int row = u.pm * BM + ai * HALF + wr * 64 + m * 16 + fr; float ss = 0.f;
#pragma unroll
                for (int bj = 0; bj < 2; ++bj) {
                    const int c0 = u.pn * BM + bj * HALF + wc * 32 + 8 * fq; const size_t off = (size_t)row * D + c0;
                    f32x4 v0 = *(const f32x4*)(Xin + off) + acc[ai][bj][m][0], v1 = *(const f32x4*)(Xin + off + 4) + acc[ai][bj][m][1];
                    if (bias) { v0 += *(const f32x4*)(bias + c0); v1 += *(const f32x4*)(bias + c0 + 4); }
                    *(f32x4*)(Xout + off) = v0; *(f32x4*)(Xout + off + 4) = v1;
                    *(u32x4*)(XB + off) = pack8(v0, v1);
                    ss += (v0[0] * v0[0] + v0[1] * v0[1]) + (v0[2] * v0[2] + v0[3] * v0[3]) + (v1[0] * v1[0] + v1[1] * v1[1]) + (v1[2] * v1[2] + v1[3] * v1[3]);
                }
                if (ssp) { ss += __shfl_xor(ss, 16); ss += __shfl_xor(ss, 32); if (fq == 0) ssp[(size_t)row * 16 + u.pn * 4 + wc] = ss; }
            }
    }
};
}

__device__ __forceinline__ void cvt_item(const float* W, int ldw, int col0, int K, const float* g, bf16_t* Bt, int il, int half, LAS float* scr, int item, int nblk, int lane) {
    const int kb = item / nblk, nb = item - kb * nblk, k0 = 64 * kb, n0 = 32 * nb;
#pragma unroll 8
    for (int i = 0; i < 32; ++i) { const int kk = 2 * i + (lane >> 5); float v = W[(size_t)(k0 + kk) * ldw + col0 + n0 + (lane & 31)]; if (g) v *= g[k0 + kk]; scr[kk * 33 + (lane & 31)] = v; }
    asm volatile("s_waitcnt lgkmcnt(0)" ::: "memory");
    const int c = lane & 7;
#pragma unroll
    for (int j = 0; j < 4; ++j) { const int n = n0 + (lane >> 3) + 8 * j; const LAS float* s = scr + (8 * c) * 33 + (n - n0);
        u32x4 o; o.x = cvt_pk_bf16(s[0 * 33], s[1 * 33]); o.y = cvt_pk_bf16(s[2 * 33], s[3 * 33]); o.z = cvt_pk_bf16(s[4 * 33], s[5 * 33]); o.w = cvt_pk_bf16(s[6 * 33], s[7 * 33]);
        const int drow = il ? ((n >> 7) * 256 + half * 128 + (n & 127)) : n;
        *(u32x4*)(Bt + (size_t)drow * K + k0 + 8 * c) = o; }
    asm volatile("s_waitcnt lgkmcnt(0)" ::: "memory");
}
__device__ __forceinline__ void cvt_matrix(const float* W, int ldw, int col0, int ncols, int K, const float* g, bf16_t* Bt, int il, int half, LAS unsigned char* lds) {
    const int lane = threadIdx.x & 63, wv = threadIdx.x >> 6;
    LAS float* scr = (LAS float*)(lds + wv * 8704);
    const int gw = blockIdx.x * (blockDim.x >> 6) + wv, ngw = gridDim.x * (blockDim.x >> 6);
    const int nblk = ncols / 32, nitems = (K / 64) * nblk;
    for (int it = gw; it < nitems; it += ngw) cvt_item(W, ldw, col0, K, g, Bt, il, half, scr, it, nblk, lane);
}
__device__ __forceinline__ void rows_prep(const float* x, bf16_t* XB, float* rs, int rows) {
    const int lane = threadIdx.x & 63;
    const int gw = (blockIdx.x * blockDim.x + threadIdx.x) >> 6, ngw = (gridDim.x * blockDim.x) >> 6;
    for (int r = gw; r < rows; r += ngw) {
        const f32x4* xr = (const f32x4*)(x + (size_t)r * D);
        f32x4 v[4]; float s = 0.f;
#pragma unroll
        for (int j = 0; j < 4; ++j) { v[j] = xr[lane + 64 * j]; s += (v[j][0] * v[j][0] + v[j][1] * v[j][1]) + (v[j][2] * v[j][2] + v[j][3] * v[j][3]); }
        s = wave_sum(s);
        if (lane == 0) rs[r] = rsqrtf(s * (1.0f / D) + EPS);
        u32x2* o = (u32x2*)(XB + (size_t)r * D);
#pragma unroll
        for (int j = 0; j < 4; ++j) { u32x2 w; w.x = cvt_pk_bf16(v[j][0], v[j][1]); w.y = cvt_pk_bf16(v[j][2], v[j][3]); o[lane + 64 * j] = w; }
    }
}

__device__ __forceinline__ void conv_phase(const bf16_t* U, const float* wdw, const float* bdw, const float* lng, const float* lnb, bf16_t* CV, LAS unsigned char* lds) {
    const int tid = threadIdx.x, lane = tid & 63, wv = tid >> 6, c0 = 2 * tid;
    LAS float* red = (LAS float*)lds; LAS float* tot = red + 512;
    f32x2 w[CONVK];
#pragma unroll
    for (int j = 0; j < CONVK; ++j) w[j] = *(const f32x2*)(wdw + j * D + c0);
    const f32x2 bd = *(const f32x2*)(bdw + c0), lg = *(const f32x2*)(lng + c0), lb = *(const f32x2*)(lnb + c0);
    for (int item = blockIdx.x; item < T / 32; item += gridDim.x) {
        const int t0 = item * 32, s0 = t0 & (S - 1);
        f32x2 acc[32];
#pragma unroll
        for (int o = 0; o < 32; ++o) acc[o] = bd;
#pragma unroll
        for (int r = 0; r < 62; ++r) {
            unsigned raw = 0u;
            if (s0 - 30 + r >= 0) raw = *(const unsigned*)(U + (size_t)(t0 - 30 + r) * D + c0);
            const f32x2 uv = (f32x2){bf_lo(raw), bf_hi(raw)};
#pragma unroll
            for (int o = (r > 30 ? r - 30 : 0); o <= (r < 31 ? r : 31); ++o) acc[o] = __builtin_elementwise_fma(uv, w[r - o], acc[o]);
        }
        float v[64];
#pragma unroll
        for (int o = 0; o < 32; ++o) { v[o] = acc[o][0] + acc[o][1]; v[32 + o] = acc[o][0] * acc[o][0] + acc[o][1] * acc[o][1]; }
#pragma unroll
        for (int st = 0; st < 6; ++st) {
            const int half = 32 >> st, bit = 32 >> st; const bool up = (lane & bit) != 0;
#pragma unroll
            for (int k = 0; k < half; ++k) { const float send = up ? v[k] : v[k + half]; const float keep = up ? v[k + half] : v[k]; v[k] = keep + __shfl_xor(send, bit); }
        }
        red[wv * 64 + lane] = v[0];
        __syncthreads();
        if (tid < 64) { float s = 0.f;
#pragma unroll
            for (int q = 0; q < 8; ++q) s += red[q * 64 + tid];
            tot[tid] = s; }
        __syncthreads();
#pragma unroll
        for (int o = 0; o < 32; ++o) {
            const float mu = tot[o] * (1.0f / D), var = tot[32 + o] * (1.0f / D) - mu * mu, rstd = rsqrtf(var + EPS);
            const float y0 = (acc[o][0] - mu) * rstd * lg[0] + lb[0], y1 = (acc[o][1] - mu) * rstd * lg[1] + lb[1];
            *(unsigned*)(CV + (size_t)(t0 + o) * D + c0) = cvt_pk_bf16(y0 * fast_sigmoid(y0), y1 * fast_sigmoid(y1));
        }
        __syncthreads();
    }
}

enum Ph { PH_PREP0 = 0, PH_CONV_IN, PH_CONV_MID, PH_CONV_OUT, PH_N };

__device__ __forceinline__ void run_phase(const Ctx& c, int ph, int l, LAS unsigned char* lds) {
    unsigned char* ws = c.ws;
    bf16_t* XB = (bf16_t*)(ws + OW_XB); float* RS = (float*)(ws + OW_RS); float* SSP = (float*)(ws + OW_SSP);
    bf16_t* ACTA = (bf16_t*)(ws + OW_ACTA); bf16_t* ACTB = (bf16_t*)(ws + OW_ACTB);
    bf16_t* WCIN = (bf16_t*)(ws + OW_WCIN); bf16_t* WCOUT = (bf16_t*)(ws + OW_WCOUT);
    switch (ph) {
    case PH_PREP0:
        cvt_matrix(c.in[7], 2048, 0, 1024, D, c.in[2], WCIN, 1, 0, lds);
        cvt_matrix(c.in[7], 2048, 1024, 1024, D, c.in[2], WCIN, 1, 1, lds);
        cvt_matrix(c.in[13], D, 0, D, D, nullptr, WCOUT, 0, 0, lds);
        rows_prep(c.in[0], XB, RS, T);
        break;
    case PH_CONV_IN: { g8::DenseSched S{8, 128 * 8, D, D, D, WCIN}; g8::gemm_phase(lds, XB, S, g8::EpiGlu{ACTA, RS, c.in[8]}); } break;
    case PH_CONV_MID: conv_phase(ACTA, c.in[9], c.in[10], c.in[11], c.in[12], ACTB, lds); break;
    case PH_CONV_OUT: { g8::DenseSched S{4, 128 * 4, D, D, D, WCOUT}; g8::gemm_phase(lds, ACTB, S, g8::EpiXres{c.in[0], c.out, XB, c.in[14], SSP}); } break;
    }
}
template <int PH> __global__ void __launch_bounds__(512, 2) k_opt(Ctx c, int l) {
    extern __shared__ __attribute__((aligned(16))) unsigned char dynlds[];
    run_phase(c, PH, l, (LAS unsigned char*)dynlds);
}
enum Op { OP_MEMN = 0, OP_MEMKV, OP_COPYX, OP_RMS_MIX, OP_CONV_IN, OP_GLU, OP_DWCONV, OP_CONV_OUT, OP_GLA_IN, OP_GLA_DECAY, OP_GLA_REC, OP_GLA_NORM, OP_GLA_OUT,
          OP_RMS_XA, OP_XA_Q, OP_XA_ATT, OP_XA_O, OP_RMS_FFN, OP_ROUTE, OP_BUILD, OP_MOE_GATE, OP_MOE_UP, OP_MOE_ACT, OP_MOE_DOWN, OP_MOE_COMBINE, OP_FINAL };

__device__ __forceinline__ void run_op(const Ctx& c, int op, int l, float* sm) {
    unsigned char* ws = c.ws;
    float* HN = (float*)(ws + WS_HN); float* BIG = (float*)(ws + WS_BIG);
    float* MEMN = (float*)(ws + WS_MEMN); float* KV = (float*)(ws + WS_KV) + (size_t)l * 1024 * 2048;
    int* eid = (int*)(ws + WS_EID); float* gate = (float*)(ws + WS_GATE); int* pos = (int*)(ws + WS_POS);
    int* slot_tok = (int*)(ws + WS_SLOTTOK); int* slot_a = (int*)(ws + WS_SLOTA); int* tile_e = (int*)(ws + WS_TILEE); int* cnt = (int*)(ws + WS_CNT);
    float* X = c.out;
    switch (op) {
    case OP_MEMN: n_rms(c.in[1], c.in[5], MEMN, NB * NMEM); break;
    case OP_MEMKV: n_gemm(sm, MEMN, D, nullptr, c.in[21] + (size_t)l * D * 2048, 2048, 0, nullptr, NB * NMEM, 2048, D, EpiStore{KV, 2048, nullptr}); break;
    case OP_COPYX: n_copy4(c.in[0], X, (size_t)T * D / 4); break;
    case OP_RMS_MIX: n_rms(X, c.in[2] + l * D, HN, T); break;
    case OP_CONV_IN: n_gemm(sm, HN, D, nullptr, c.in[7], 2048, 0, nullptr, T, 2048, D, EpiStore{BIG, 2048, c.in[8]}); break;
    case OP_GLU: n_glu(BIG, HN); break;
    case OP_DWCONV: n_dwconv(HN, c.in[9], c.in[10], c.in[11], c.in[12], BIG); break;
    case OP_CONV_OUT: n_gemm(sm, BIG, D, nullptr, c.in[13], D, 0, nullptr, T, D, D, EpiResid{X, D, c.in[14]}); break;
    case OP_GLA_IN: n_gemm(sm, HN, D, nullptr, c.in[15], GLA_COLS, 0, nullptr, T, GLA_COLS, D, EpiStore{BIG, GLA_COLS, nullptr}); break;
    case OP_GLA_DECAY: n_gla_decay(BIG, c.in[16], c.in[17], HN); break;
    case OP_GLA_REC: n_gla_rec(BIG, HN); break;
    case OP_GLA_NORM: n_gla_norm(BIG, c.in[18], HN); break;
    case OP_GLA_OUT: n_gemm(sm, HN, D, nullptr, c.in[19], D, 0, nullptr, T, D, D, EpiResid{X, D, nullptr}); break;
    case OP_RMS_XA: n_rms(X, c.in[3] + l * D, HN, T); break;
    case OP_XA_Q: n_gemm(sm, HN, D, nullptr, c.in[20] + (size_t)l * D * D, D, 0, nullptr, T, D, D, EpiStore{BIG, D, nullptr}); break;
    case OP_XA_ATT: n_attn(BIG, KV, BIG + (size_t)T * D); break;
    case OP_XA_O: n_gemm(sm, BIG + (size_t)T * D, D, nullptr, c.in[22] + (size_t)l * D * D, D, 0, nullptr, T, D, D, EpiResid{X, D, nullptr}); break;
    case OP_RMS_FFN: n_rms(X, c.in[4] + l * D, HN, T); n_moe_init(cnt, slot_tok, slot_a, tile_e); break;
    case OP_ROUTE: n_route(HN, c.in[23] + (size_t)l * D * NG, c.in[24] + l * NG, c.in[25] + (size_t)l * D * NE, c.in[26] + l * NE, eid, gate, pos, cnt); break;
    case OP_BUILD: n_moe_build(eid, pos, cnt, slot_tok, slot_a, tile_e); break;
    case OP_MOE_GATE: n_gemm(sm, HN, D, slot_tok, c.in[27] + (size_t)l * NE * D * DE, DE, (size_t)D * DE, tile_e, NSLOT, DE, D, EpiStore{BIG, DE, nullptr}); break;
    case OP_MOE_UP: n_gemm(sm, HN, D, slot_tok, c.in[28] + (size_t)l * NE * D * DE, DE, (size_t)D * DE, tile_e, NSLOT, DE, D, EpiStore{BIG + (size_t)NSLOT * DE, DE, nullptr}); break;
    case OP_MOE_ACT: n_moe_act(BIG, BIG + (size_t)NSLOT * DE); break;
    case OP_MOE_DOWN: n_gemm(sm, BIG, DE, nullptr, c.in[29] + (size_t)l * NE * DE * D, D, (size_t)DE * D, tile_e, NSLOT, D, DE, EpiMoeDown{BIG + (size_t)NSLOT * DE, slot_a, gate}); break;
    case OP_MOE_COMBINE: n_moe_combine(X, BIG + (size_t)NSLOT * DE); break;
    case OP_FINAL: n_rms(X, c.in[6], X, T); break;
    }
}

template <int OP> __global__ void __launch_bounds__(512) k_stage(Ctx c, int l) {
    __shared__ float sm[16 * 132 + 16 * 260];
    run_op(c, OP, l, sm);
}
typedef void (*StageFn)(Ctx, int);
template <int... I> struct Seq {};
template <int N, int... I> struct MkSeq : MkSeq<N - 1, N - 1, I...> {};
template <int... I> struct MkSeq<0, I...> { typedef Seq<I...> type; };
template <int... I> static void fill_tab(StageFn* t, Seq<I...>) { StageFn f[] = {k_stage<I>...}; for (unsigned i = 0; i < sizeof...(I); ++i) t[i] = f[i]; }
template <int... I> static void fill_tab_opt(StageFn* t, Seq<I...>) { StageFn f[] = {k_opt<I>...}; for (unsigned i = 0; i < sizeof...(I); ++i) t[i] = f[i]; }

struct Step { int kind, op, l; };
static const Step g_prog[] = {
    {0, OP_MEMN, 0}, {0, OP_MEMKV, 0}, {0, OP_MEMKV, 1},
    {1, PH_PREP0, 0}, {1, PH_CONV_IN, 0}, {1, PH_CONV_MID, 0}, {1, PH_CONV_OUT, 0},
    {0, OP_RMS_XA, 0}, {0, OP_XA_Q, 0}, {0, OP_XA_ATT, 0}, {0, OP_XA_O, 0},
    {0, OP_RMS_FFN, 0}, {0, OP_ROUTE, 0}, {0, OP_BUILD, 0}, {0, OP_MOE_GATE, 0}, {0, OP_MOE_UP, 0}, {0, OP_MOE_ACT, 0}, {0, OP_MOE_DOWN, 0}, {0, OP_MOE_COMBINE, 0},
    {0, OP_RMS_MIX, 1}, {0, OP_GLA_IN, 0}, {0, OP_GLA_DECAY, 0}, {0, OP_GLA_REC, 0}, {0, OP_GLA_NORM, 0}, {0, OP_GLA_OUT, 0},
    {0, OP_RMS_XA, 1}, {0, OP_XA_Q, 1}, {0, OP_XA_ATT, 1}, {0, OP_XA_O, 1},
    {0, OP_RMS_FFN, 1}, {0, OP_ROUTE, 1}, {0, OP_BUILD, 1}, {0, OP_MOE_GATE, 1}, {0, OP_MOE_UP, 1}, {0, OP_MOE_ACT, 1}, {0, OP_MOE_DOWN, 1}, {0, OP_MOE_COMBINE, 1},
    {0, OP_FINAL, 0}};
constexpr int NSTEP = sizeof(g_prog) / sizeof(g_prog[0]);

extern "C" void kernel_launch(void* const* d_in, const int* in_sizes, int n_in, void* d_out, int out_size, void* d_ws, size_t ws_size, hipStream_t stream) {
    if (n_in != 30 || out_size != T * D || ws_size < OW_END || ws_size < WS_END) { fprintf(stderr, "kernel_launch: bad args n_in %d out %d ws %zu\n", n_in, out_size, ws_size); return; }
    Ctx c; memset(&c, 0, sizeof(c));
    for (int i = 0; i < 30; ++i) c.in[i] = (const float*)d_in[i];
    c.out = (float*)d_out; c.ws = (unsigned char*)d_ws;
    static StageFn tab[OP_FINAL + 1], tabo[PH_N];
    static bool init = false;
    if (!init) { fill_tab(tab, MkSeq<OP_FINAL + 1>::type()); fill_tab_opt(tabo, MkSeq<PH_N>::type());
        for (int i = 0; i < PH_N; ++i) hipFuncSetAttribute((const void*)tabo[i], hipFuncAttributeMaxDynamicSharedMemorySize, LDS_BYTES);
        init = true; }
    for (int i = 0; i < NSTEP; ++i) {
        if (g_prog[i].kind == 0) hipLaunchKernelGGL(tab[g_prog[i].op], dim3(1024), dim3(512), 0, stream, c, g_prog[i].l);
        else hipLaunchKernelGGL(tabo[g_prog[i].op], dim3(256), dim3(512), LDS_BYTES, stream, c, g_prog[i].l);
    }
}
```

```cpp
#include <hip/hip_runtime.h>
#include <hip/hip_cooperative_groups.h>
#include <cstdio>
#include <cstring>
namespace cg = cooperative_groups;

#ifndef MEGA
#define MEGA 0
#endif

constexpr int D = 1024, NB = 4, S = 8192, T = NB * S, NMEM = 256, DEPTH = 2;
constexpr int CONVK = 31;
constexpr int GH = 4, GDK = 512, GDV = 1024, GDKH = 128, GDVH = 256, GRANK = 16, GLA_COLS = 3088;
constexpr int XH = 4, XHD = 256;
constexpr int NG = 4, EPG = 8, NE = 32, DE = 512;
constexpr int NA = T * 2;
constexpr int NSLOT = NA + NE * 128;
constexpr float EPS = 1e-6f;

constexpr size_t MiB = 1u << 20;
constexpr size_t WS_HN = 0;
constexpr size_t WS_BIG = 128 * MiB;
constexpr size_t WS_SMALL = 528 * MiB;
constexpr size_t WS_MEMN = WS_SMALL;
constexpr size_t WS_KV = WS_MEMN + 4 * MiB;
constexpr size_t WS_EID = WS_KV + 16 * MiB;
constexpr size_t WS_GATE = WS_EID + NA * 4;
constexpr size_t WS_POS = WS_GATE + NA * 4;
constexpr size_t WS_SLOTTOK = WS_POS + NA * 4;
constexpr size_t WS_SLOTA = WS_SLOTTOK + NSLOT * 4;
constexpr size_t WS_TILEE = WS_SLOTA + NSLOT * 4;
constexpr size_t WS_CNT = WS_TILEE + 4096;
constexpr size_t WS_END = WS_CNT + 4096;

struct Ctx {
    const float* in[30];
    float* out;
    unsigned char* ws;
};

__device__ __forceinline__ float wave_sum(float v) {
#pragma unroll
    for (int o = 1; o < 64; o <<= 1) v += __shfl_xor(v, o);
    return v;
}
__device__ __forceinline__ float wave_max(float v) {
#pragma unroll
    for (int o = 1; o < 64; o <<= 1) v = fmaxf(v, __shfl_xor(v, o));
    return v;
}
__device__ __forceinline__ float sigmoidf_(float x) { return 1.0f / (1.0f + expf(-x)); }
__device__ __forceinline__ float siluf_(float x) { return x / (1.0f + expf(-x)); }

__device__ void n_rms(const float* x, const float* g, float* out, int rows) {
    const int lane = threadIdx.x & 63;
    const int gw = (blockIdx.x * blockDim.x + threadIdx.x) >> 6, ngw = (gridDim.x * blockDim.x) >> 6;
    for (int r = gw; r < rows; r += ngw) {
        const float4* xr = (const float4*)(x + (size_t)r * D);
        float4 v[4]; float s = 0.f;
#pragma unroll
        for (int j = 0; j < 4; ++j) { v[j] = xr[lane + 64 * j]; s += v[j].x * v[j].x + v[j].y * v[j].y + v[j].z * v[j].z + v[j].w * v[j].w; }
        s = wave_sum(s);
        const float rs = rsqrtf(s * (1.0f / D) + EPS);
        float4* o = (float4*)(out + (size_t)r * D);
#pragma unroll
        for (int j = 0; j < 4; ++j) { const float4 gg = ((const float4*)g)[lane + 64 * j];
            o[lane + 64 * j] = make_float4(v[j].x * rs * gg.x, v[j].y * rs * gg.y, v[j].z * rs * gg.z, v[j].w * rs * gg.w); }
    }
}
__device__ void n_copy4(const float* src, float* dst, size_t n4) {
    const size_t g = (size_t)blockIdx.x * blockDim.x + threadIdx.x, gs = (size_t)gridDim.x * blockDim.x;
    for (size_t i = g; i < n4; i += gs) ((float4*)dst)[i] = ((const float4*)src)[i];
}

struct EpiStore { float* C; int ldc; const float* bias;
    __device__ __forceinline__ void operator()(int m, int n, float acc) const { C[(size_t)m * ldc + n] = acc + (bias ? bias[n] : 0.f); } };
struct EpiResid { float* X; int ldc; const float* bias;
    __device__ __forceinline__ void operator()(int m, int n, float acc) const { X[(size_t)m * ldc + n] += acc + (bias ? bias[n] : 0.f); } };
struct EpiMoeDown { float* Y; const int* slot_a; const float* gate;
    __device__ __forceinline__ void operator()(int m, int n, float acc) const { const int a = slot_a[m]; if (a >= 0) Y[(size_t)a * D + n] = acc * gate[a]; } };

template <class Epi>
__device__ void n_gemm(float* sm, const float* A, int lda, const int* arow, const float* W, int ldw, size_t wstride, const int* tile_e,
                       int M, int N, int K, Epi epi) {
    float* As = sm;
    float* Bs = sm + 16 * 132;
    const int tid = threadIdx.x, ty = tid >> 5, tx = tid & 31;
    const int ntm = M / 128, ntn = (N + 255) / 256;
    for (int tile = blockIdx.x; tile < ntm * ntn; tile += gridDim.x) {
        const int mt = tile / ntn, nt = tile % ntn;
        const float* Wb = W;
        if (tile_e) { const int e = tile_e[mt]; if (e < 0) continue; Wb = W + (size_t)e * wstride; }
        const int m0 = mt * 128, n0 = nt * 256;
        float acc[8][8];
#pragma unroll
        for (int i = 0; i < 8; ++i)
#pragma unroll
            for (int j = 0; j < 8; ++j) acc[i][j] = 0.f;
        const int ar = tid >> 2, akq = (tid & 3) * 4;
        const int srow = arow ? arow[m0 + ar] : (m0 + ar);
        const float* ap = srow >= 0 ? A + (size_t)srow * lda : nullptr;
        const int bk = tid >> 6, bn = (tid & 63) * 4;
        for (int k0 = 0; k0 < K; k0 += 16) {
            float4 av = ap ? *(const float4*)(ap + k0 + akq) : make_float4(0.f, 0.f, 0.f, 0.f);
            As[(akq + 0) * 132 + ar] = av.x; As[(akq + 1) * 132 + ar] = av.y; As[(akq + 2) * 132 + ar] = av.z; As[(akq + 3) * 132 + ar] = av.w;
#pragma unroll
            for (int i = 0; i < 2; ++i) {
                const int kk = bk + 8 * i; const int n = n0 + bn;
                float4 bv = (n < N) ? *(const float4*)(Wb + (size_t)(k0 + kk) * ldw + n) : make_float4(0.f, 0.f, 0.f, 0.f);
                *(float4*)(Bs + kk * 260 + bn) = bv;
            }
            __syncthreads();
#pragma unroll
            for (int kk = 0; kk < 16; ++kk) {
                float a[8], b[8];
                *(float4*)(a) = *(const float4*)(As + kk * 132 + ty * 8); *(float4*)(a + 4) = *(const float4*)(As + kk * 132 + ty * 8 + 4);
                *(float4*)(b) = *(const float4*)(Bs + kk * 260 + tx * 8); *(float4*)(b + 4) = *(const float4*)(Bs + kk * 260 + tx * 8 + 4);
#pragma unroll
                for (int i = 0; i < 8; ++i)
#pragma unroll
                    for (int j = 0; j < 8; ++j) acc[i][j] = fmaf(a[i], b[j], acc[i][j]);
            }
            __syncthreads();
        }
#pragma unroll
        for (int i = 0; i < 8; ++i)
#pragma unroll
            for (int j = 0; j < 8; ++j) { const int m = m0 + ty * 8 + i, n = n0 + tx * 8 + j; if (n < N) epi(m, n, acc[i][j]); }
    }
}

__device__ void n_glu(const float* u, float* g) {
    const size_t gi = (size_t)blockIdx.x * blockDim.x + threadIdx.x, gs = (size_t)gridDim.x * blockDim.x;
    for (size_t i = gi; i < (size_t)T * D; i += gs) { const size_t t = i >> 10, c = i & 1023; g[i] = u[t * 2048 + c] * sigmoidf_(u[t * 2048 + 1024 + c]); }
}
__device__ void n_dwconv(const float* g, const float* wdw, const float* bdw, const float* lng, const float* lnb, float* out) {
    const int lane = threadIdx.x & 63;
    const int gw = (blockIdx.x * blockDim.x + threadIdx.x) >> 6, ngw = (gridDim.x * blockDim.x) >> 6;
    for (int t = gw; t < T; t += ngw) {
        const int s = t % S;
        float4 acc[4];
#pragma unroll
        for (int j = 0; j < 4; ++j) acc[j] = ((const float4*)bdw)[lane + 64 * j];
        for (int tap = 0; tap < CONVK; ++tap) {
            const int ss = s - (CONVK - 1) + tap; if (ss < 0) continue;
            const float4* gr = (const float4*)(g + (size_t)(t - (CONVK - 1) + tap) * D);
            const float4* wr = (const float4*)(wdw + (size_t)tap * D);
#pragma unroll
            for (int j = 0; j < 4; ++j) { const float4 a = gr[lane + 64 * j], w = wr[lane + 64 * j];
                acc[j].x = fmaf(a.x, w.x, acc[j].x); acc[j].y = fmaf(a.y, w.y, acc[j].y); acc[j].z = fmaf(a.z, w.z, acc[j].z); acc[j].w = fmaf(a.w, w.w, acc[j].w); }
        }
        float sm_ = 0.f;
#pragma unroll
        for (int j = 0; j < 4; ++j) sm_ += acc[j].x + acc[j].y + acc[j].z + acc[j].w;
        const float mu = wave_sum(sm_) * (1.0f / D);
        float q = 0.f;
#pragma unroll
        for (int j = 0; j < 4; ++j) { acc[j].x -= mu; acc[j].y -= mu; acc[j].z -= mu; acc[j].w -= mu; q += acc[j].x * acc[j].x + acc[j].y * acc[j].y + acc[j].z * acc[j].z + acc[j].w * acc[j].w; }
        const float rstd = rsqrtf(wave_sum(q) * (1.0f / D) + EPS);
        float4* o = (float4*)(out + (size_t)t * D);
#pragma unroll
        for (int j = 0; j < 4; ++j) { const float4 gg = ((const float4*)lng)[lane + 64 * j], bb = ((const float4*)lnb)[lane + 64 * j];
            o[lane + 64 * j] = make_float4(siluf_(acc[j].x * rstd * gg.x + bb.x), siluf_(acc[j].y * rstd * gg.y + bb.y), siluf_(acc[j].z * rstd * gg.z + bb.z), siluf_(acc[j].w * rstd * gg.w + bb.w)); }
    }
}
__device__ void n_attn(const float* q, const float* kv, float* o) {
    const int lane = threadIdx.x & 63;
    const int gw = (blockIdx.x * blockDim.x + threadIdx.x) >> 6, ngw = (gridDim.x * blockDim.x) >> 6;
    for (int it = gw; it < T * XH; it += ngw) {
        const int t = it >> 2, h = it & 3, b = t / S;
        const float4 qv = ((const float4*)(q + (size_t)t * D + h * XHD))[lane];
        const float* kb = kv + (size_t)b * NMEM * 2048 + h * XHD;
        float sc[4];
#pragma unroll
        for (int m4 = 0; m4 < 4; ++m4) {
            float mine = 0.f;
            for (int ml = 0; ml < 64; ++ml) {
                const float4 kk = ((const float4*)(kb + (size_t)(m4 * 64 + ml) * 2048))[lane];
                float p = qv.x * kk.x + qv.y * kk.y + qv.z * kk.z + qv.w * kk.w;
                p = wave_sum(p);
                if (ml == lane) mine = p;
            }
            sc[m4] = mine * 0.0625f;
        }
        float mx = fmaxf(fmaxf(sc[0], sc[1]), fmaxf(sc[2], sc[3])); mx = wave_max(mx);
        float se = 0.f;
#pragma unroll
        for (int m4 = 0; m4 < 4; ++m4) { sc[m4] = expf(sc[m4] - mx); se += sc[m4]; }
        se = wave_sum(se); const float inv = 1.0f / se;
        float4 acc = make_float4(0.f, 0.f, 0.f, 0.f);
        const float* vb = kb + 1024;
#pragma unroll
        for (int m4 = 0; m4 < 4; ++m4)
            for (int ml = 0; ml < 64; ++ml) {
                const float p = __shfl(sc[m4], ml) * inv;
                const float4 vv = ((const float4*)(vb + (size_t)(m4 * 64 + ml) * 2048))[lane];
                acc.x = fmaf(p, vv.x, acc.x); acc.y = fmaf(p, vv.y, acc.y); acc.z = fmaf(p, vv.z, acc.z); acc.w = fmaf(p, vv.w, acc.w);
            }
        ((float4*)(o + (size_t)t * D + h * XHD))[lane] = acc;
    }
}
__device__ void n_moe_init(int* cnt, int* slot_tok, int* slot_a, int* tile_e) {
    const int gi = blockIdx.x * blockDim.x + threadIdx.x, gs = gridDim.x * blockDim.x;
    for (int i = gi; i < NSLOT; i += gs) { slot_tok[i] = -1; slot_a[i] = -1; }
    for (int i = gi; i < NSLOT / 128; i += gs) tile_e[i] = -1;
    if (gi < 32) cnt[gi] = 0;
}
__device__ void n_route(const float* h, const float* wg, const float* bg, const float* we, const float* be, int* eid, float* gate, int* pos, int* cnt) {
    const int lane = threadIdx.x & 63;
    const int gw = (blockIdx.x * blockDim.x + threadIdx.x) >> 6, ngw = (gridDim.x * blockDim.x) >> 6;
    for (int t = gw; t < T; t += ngw) {
        float hv[16];
#pragma unroll
        for (int j = 0; j < 16; ++j) hv[j] = h[(size_t)t * D + j * 64 + lane];
        float gl[4];
#pragma unroll
        for (int o = 0; o < 4; ++o) { float p = 0.f;
#pragma unroll
            for (int j = 0; j < 16; ++j) p = fmaf(hv[j], wg[(size_t)(j * 64 + lane) * NG + o], p);
            gl[o] = wave_sum(p) + bg[o]; }
        int gs = 0; float gm = gl[0];
#pragma unroll
        for (int o = 1; o < 4; ++o) if (gl[o] > gm) { gm = gl[o]; gs = o; }
        float se = 0.f;
#pragma unroll
        for (int o = 0; o < 4; ++o) se += expf(gl[o] - gm);
        const float pg = 1.0f / se;
        float el[8];
#pragma unroll
        for (int o = 0; o < 8; ++o) { float p = 0.f;
#pragma unroll
            for (int j = 0; j < 16; ++j) p = fmaf(hv[j], we[(size_t)(j * 64 + lane) * NE + gs * 8 + o], p);
            el[o] = wave_sum(p) + be[gs * 8 + o]; }
        float em = el[0];
#pragma unroll
        for (int o = 1; o < 8; ++o) em = fmaxf(em, el[o]);
        float pe[8], ps = 0.f;
#pragma unroll
        for (int o = 0; o < 8; ++o) { pe[o] = expf(el[o] - em); ps += pe[o]; }
#pragma unroll
        for (int o = 0; o < 8; ++o) pe[o] = pe[o] / ps;
        int i1 = 0; float p1 = pe[0];
#pragma unroll
        for (int o = 1; o < 8; ++o) if (pe[o] > p1) { p1 = pe[o]; i1 = o; }
        int i2 = -1; float p2 = -1.f;
#pragma unroll
        for (int o = 0; o < 8; ++o) if (o != i1 && pe[o] > p2) { p2 = pe[o]; i2 = o; }
        if (lane == 0) {
            const float den = p1 + p2;
            const int e1 = gs * 8 + i1, e2 = gs * 8 + i2;
            eid[2 * t] = e1; eid[2 * t + 1] = e2;
            gate[2 * t] = pg * p1 / den; gate[2 * t + 1] = pg * p2 / den;
            pos[2 * t] = atomicAdd(&cnt[e1], 1); pos[2 * t + 1] = atomicAdd(&cnt[e2], 1);
        }
    }
}
__device__ void n_moe_build(const int* eid, const int* pos, const int* cnt, int* slot_tok, int* slot_a, int* tile_e) {
    __shared__ int poff[33];
    if (threadIdx.x == 0) { int o = 0; for (int e = 0; e < 32; ++e) { poff[e] = o; o += (cnt[e] + 127) / 128 * 128; } poff[32] = o; }
    __syncthreads();
    const int gi = blockIdx.x * blockDim.x + threadIdx.x, gs = gridDim.x * blockDim.x;
    for (int a = gi; a < NA; a += gs) { const int e = eid[a]; const int sl = poff[e] + pos[a]; slot_tok[sl] = a >> 1; slot_a[sl] = a; }
    for (int mt = gi; mt < NSLOT / 128; mt += gs) { const int r = mt * 128; int e = -1; for (int k = 0; k < 32; ++k) if (r >= poff[k] && r < poff[k + 1]) e = k; tile_e[mt] = e; }
    __syncthreads();
}
__device__ void n_moe_act(float* g, const float* u) {
    const size_t gi = (size_t)blockIdx.x * blockDim.x + threadIdx.x, gs = (size_t)gridDim.x * blockDim.x;
    for (size_t i = gi; i < (size_t)NSLOT * DE / 4; i += gs) { float4 a = ((float4*)g)[i]; const float4 b = ((const float4*)u)[i];
        a.x = siluf_(a.x) * b.x; a.y = siluf_(a.y) * b.y; a.z = siluf_(a.z) * b.z; a.w = siluf_(a.w) * b.w; ((float4*)g)[i] = a; }
}
__device__ void n_moe_combine(float* x, const float* y) {
    const size_t gi = (size_t)blockIdx.x * blockDim.x + threadIdx.x, gs = (size_t)gridDim.x * blockDim.x;
    for (size_t i = gi; i < (size_t)T * D / 4; i += gs) { const size_t t = i >> 8, c = i & 255; float4 a = ((float4*)x)[i];
        const float4 y0 = ((const float4*)y)[(2 * t) * 256 + c], y1 = ((const float4*)y)[(2 * t + 1) * 256 + c];
        a.x += y0.x + y1.x; a.y += y0.y + y1.y; a.z += y0.z + y1.z; a.w += y0.w + y1.w; ((float4*)x)[i] = a; }
}
__device__ void n_gla_decay(const float* proj, const float* wa2, const float* ba, float* dec) {
    const size_t gi = (size_t)blockIdx.x * blockDim.x + threadIdx.x, gs = (size_t)gridDim.x * blockDim.x;
    for (size_t i = gi; i < (size_t)T * GDK; i += gs) { const size_t t = i >> 9; const int j = (int)(i & 511);
        float a = ba[j];
#pragma unroll
        for (int r = 0; r < GRANK; ++r) a = fmaf(proj[t * GLA_COLS + 2048 + r], wa2[r * GDK + j], a);
        const float ls = fminf(a, 0.f) - log1pf(expf(-fabsf(a)));
        dec[i] = expf(ls * (1.0f / 16.0f)); }
}
__device__ void n_gla_rec(float* proj, const float* dec) {
    const int gi = blockIdx.x * blockDim.x + threadIdx.x, gs = gridDim.x * blockDim.x;
    for (int it = gi; it < NB * GH * GDVH; it += gs) {
        const int col = it & 255, h = (it >> 8) & 3, b = it >> 10;
        float st[GDKH];
#pragma unroll
        for (int k = 0; k < GDKH; ++k) st[k] = 0.f;
        const float qs = 0.08838834764831845f;
        for (int s = 0; s < S; ++s) {
            const size_t t = (size_t)b * S + s;
            float* pr = proj + t * GLA_COLS;
            const float v = pr[1024 + h * GDVH + col];
            const float* qq = pr + h * GDKH; const float* kk = pr + 512 + h * GDKH; const float* dd = dec + t * GDK + h * GDKH;
            float o = 0.f;
#pragma unroll
            for (int k = 0; k < GDKH; ++k) { st[k] = fmaf(st[k], dd[k], kk[k] * v); o = fmaf(qq[k], st[k], o); }
            pr[1024 + h * GDVH + col] = o * qs;
        }
    }
}
__device__ void n_gla_norm(const float* proj, const float* ng, float* go) {
    const int lane = threadIdx.x & 63;
    const int gw = (blockIdx.x * blockDim.x + threadIdx.x) >> 6, ngw = (gridDim.x * blockDim.x) >> 6;
    for (int it = gw; it < T * GH; it += ngw) {
        const int t = it >> 2, h = it & 3;
        const float4 ov = ((const float4*)(proj + (size_t)t * GLA_COLS + 1024 + h * GDVH))[lane];
        const float4 rv = ((const float4*)(proj + (size_t)t * GLA_COLS + 2064 + h * GDVH))[lane];
        const float4 gg = ((const float4*)ng)[lane];
        float s = ov.x * ov.x + ov.y * ov.y + ov.z * ov.z + ov.w * ov.w; s = wave_sum(s);
        const float rs = rsqrtf(s * (1.0f / GDVH) + EPS);
        ((float4*)(go + (size_t)t * D + h * GDVH))[lane] = make_float4(ov.x * rs * gg.x * siluf_(rv.x), ov.y * rs * gg.y * siluf_(rv.y), ov.z * rs * gg.z * siluf_(rv.z), ov.w * rs * gg.w * siluf_(rv.w));
    }
}

#define LAS __attribute__((address_space(3)))
typedef unsigned short bf16_t;
typedef short bf16x8 __attribute__((ext_vector_type(8)));
typedef float f32x4 __attribute__((ext_vector_type(4)));
typedef float f32x2 __attribute__((ext_vector_type(2)));
typedef unsigned u32x4 __attribute__((ext_vector_type(4)));
typedef unsigned u32x2 __attribute__((ext_vector_type(2)));

constexpr int LDS_BYTES = 160 * 1024;
constexpr int NSLOT2 = NA + NE * 256;
constexpr int MAXRT = NSLOT2 / 256;
constexpr size_t OW_XB = 0;
constexpr size_t OW_SSP = 64 * MiB;
constexpr size_t OW_RS = 66 * MiB;
constexpr size_t OW_PSUM = 67 * MiB;
constexpr size_t OW_MOE = 69 * MiB;
constexpr size_t OW_ACTA = 72 * MiB, OW_ACTB = 136 * MiB, OW_ACTC = 200 * MiB;
constexpr size_t OW_H = 72 * MiB, OW_Y = 144 * MiB, OW_WMOE = 272 * MiB;
constexpr size_t OW_KVB = 368 * MiB;
constexpr size_t OW_MEMNB = 372 * MiB;
constexpr size_t OW_WCIN = 550 * MiB, OW_WCOUT = 554 * MiB, OW_WXQ = 556 * MiB, OW_WXKV = 560 * MiB, OW_WXO = 568 * MiB, OW_END = 572 * MiB;

__device__ __forceinline__ unsigned cvt_pk_bf16(float lo, float hi) { unsigned r; asm volatile("v_cvt_pk_bf16_f32 %0, %1, %2" : "=v"(r) : "v"(lo), "v"(hi)); return r; }
__device__ __forceinline__ u32x4 pack8(const f32x4& a, const f32x4& b) { u32x4 w; w.x = cvt_pk_bf16(a[0], a[1]); w.y = cvt_pk_bf16(a[2], a[3]); w.z = cvt_pk_bf16(b[0], b[1]); w.w = cvt_pk_bf16(b[2], b[3]); return w; }
__device__ __forceinline__ float bf_lo(unsigned w) { return __uint_as_float(w << 16); }
__device__ __forceinline__ float bf_hi(unsigned w) { return __uint_as_float(w & 0xffff0000u); }
__device__ __forceinline__ float fast_sigmoid(float x) { return __builtin_amdgcn_rcpf(1.0f + __builtin_amdgcn_exp2f(-1.4426950408889634f * x)); }

namespace g8 {
constexpr int BM = 256, BK = 64, HALF = 128, HTB = HALF * BK * 2, STAGE_BYTES = 8 * HTB;
__device__ __forceinline__ int lds_byte(int r, int c) { const int st = (r >> 4) * 2 + (c >> 5), rr = r & 15, cc = c & 31, ob = rr * 64 + cc * 2; return st * 1024 + (ob ^ (((ob >> 9) & 1) << 5)); }
__device__ __forceinline__ void stage_rc(int b, int& R, int& C) { const int st = b / 1024, sb = b % 1024, swz = sb ^ (((sb >> 9) & 1) << 5); R = (st >> 1) * 16 + swz / 64; C = (st & 1) * 32 + (swz % 64) / 2; }
__device__ __forceinline__ int perm32(int rho) { const int n = rho >> 4, i = rho & 15; return 8 * (i >> 2) + 4 * n + (i & 3); }
struct Unit { int pm, pn, e; };

template <class Epi, class Sched>
__device__ __forceinline__ void gemm_phase(LAS unsigned char* lds, const Sched& S, const Epi& E) {
    int tid_ = threadIdx.x; asm volatile("" : "+v"(tid_));
    const int tid = tid_, wid = __builtin_amdgcn_readfirstlane(tid >> 6), lane = tid & 63, wr = wid >> 2, wc = wid & 3, fr = lane & 15, fq = lane >> 4;
    const int K = S.K, lda = S.lda, ldb = S.ldb, nt = K / BK;
    int Rr[2], Cc[2]; unsigned voffB[2];
#pragma unroll
    for (int i = 0; i < 2; ++i) { int R, C; stage_rc(tid * 16 + i * 8192, R, C); Rr[i] = R; Cc[i] = C; const int Rb = (R & ~31) + perm32(R & 31); voffB[i] = (unsigned)(Rb * ldb + C) * 2u; }
    const size_t kstep = (size_t)(BK * 2);
    const size_t hstepB = (size_t)HALF * ldb * 2;
    const unsigned ldsw = (unsigned)wid * 1024u;
    const int aoff = lds_byte(wr * 64 + fr, fq * 8), boff = lds_byte(wc * 32 + fr, fq * 8);
#define G8_SA(b, h) (((b) * 2 + (h)) * HTB)
#define G8_SB(b, h) ((4 + (b) * 2 + (h)) * HTB)
#define G8_STAGEA(bufoff, gbase, vv) do { _Pragma("unroll") for (int _i = 0; _i < 2; ++_i) \
        __builtin_amdgcn_global_load_lds((const unsigned*)((const char*)(gbase) + (vv)[_i]), (LAS unsigned*)(lds + (bufoff) + ldsw + _i * 8192), 16, 0, 0); } while (0)
#define G8_STAGEB(bufoff, gbase) do { _Pragma("unroll") for (int _i = 0; _i < 2; ++_i) \
        __builtin_amdgcn_global_load_lds((const unsigned*)((const char*)(gbase) + voffB[_i]), (LAS unsigned*)(lds + (bufoff) + ldsw + _i * 8192), 16, 0, 0); } while (0)
#define G8_LDA(dst, b, h) do { _Pragma("unroll") for (int m = 0; m < 4; ++m) _Pragma("unroll") for (int k = 0; k < 2; ++k) dst[m][k] = *(const LAS bf16x8*)(lds + G8_SA(b, h) + aoff + m * 2048 + k * 1024); } while (0)
#define G8_LDB(dst, b, h) do { _Pragma("unroll") for (int n = 0; n < 2; ++n) _Pragma("unroll") for (int k = 0; k < 2; ++k) dst[n][k] = *(const LAS bf16x8*)(lds + G8_SB(b, h) + boff + n * 2048 + k * 1024); } while (0)
#define G8_MMA(ai, bj, At, Bt) do { __builtin_amdgcn_s_setprio(1); _Pragma("unroll") for (int m = 0; m < 4; ++m) _Pragma("unroll") for (int n = 0; n < 2; ++n) _Pragma("unroll") for (int k = 0; k < 2; ++k) \
        acc[ai][bj][m][n] = __builtin_amdgcn_mfma_f32_16x16x32_bf16(Bt[n][k], At[m][k], acc[ai][bj][m][n], 0, 0, 0); __builtin_amdgcn_s_setprio(0); } while (0)
#define G8_WAIT_V(n) asm volatile("s_waitcnt vmcnt(" #n ")" ::: "memory")
#define G8_WAIT_L(n) asm volatile("s_waitcnt lgkmcnt(" #n ")" ::: "memory")
#define G8_BAR __builtin_amdgcn_s_barrier()
#define G8_SCHED __builtin_amdgcn_sched_barrier(0)
#define G8_VA(dst, u) do { const int _ac = S.a_col(u); _Pragma("unroll") for (int _h = 0; _h < 2; ++_h) _Pragma("unroll") for (int _i = 0; _i < 2; ++_i) \
        dst[_h][_i] = (unsigned)(((size_t)S.a_row(u, _h * HALF + Rr[_i]) * lda + _ac + Cc[_i]) * 2); } while (0)
    Unit cur, nxt; int ui = 0;
    if (!S.next(0, cur)) return;
    f32x4 acc[2][2][4][2];
#pragma unroll
    for (int a = 0; a < 2; ++a)
#pragma unroll
        for (int b = 0; b < 2; ++b)
#pragma unroll
            for (int m = 0; m < 4; ++m)
#pragma unroll
                for (int n = 0; n < 2; ++n) acc[a][b][m][n] = (f32x4){0.f, 0.f, 0.f, 0.f};
    bf16x8 At[4][2], B0[2][2], B1[2][2];
    unsigned va[2][2], nva[2][2];
    G8_VA(va, cur);
    const char* Ab = S.a_base(cur);
    const char* cB = S.b_base(cur);
    G8_STAGEB(G8_SB(0, 0), cB); G8_STAGEA(G8_SA(0, 0), Ab, va[0]); G8_STAGEB(G8_SB(0, 1), cB + hstepB); G8_STAGEA(G8_SA(0, 1), Ab, va[1]);
    if (wr == 1) G8_BAR;
    G8_WAIT_V(4); G8_BAR;
    G8_STAGEB(G8_SB(1, 0), cB + kstep); G8_STAGEA(G8_SA(1, 0), Ab + kstep, va[0]); G8_STAGEB(G8_SB(1, 1), cB + hstepB + kstep);
    G8_WAIT_V(6); G8_BAR;
    for (;;) {
        const bool has_next = S.next(ui + 1, nxt);
        const char* nB = cB; const char* nAb = Ab;
        if (has_next) { nB = S.b_base(nxt); nAb = S.a_base(nxt); G8_VA(nva, nxt); }
        else {
#pragma unroll
            for (int h = 0; h < 2; ++h)
#pragma unroll
                for (int i = 0; i < 2; ++i) nva[h][i] = va[h][i];
        }
        for (int t = 0; t < nt; t += 2) {
            const bool last = (t == nt - 2);
            const char* a1 = Ab + (size_t)(t + 1) * kstep;
            const char* a2 = last ? nAb : Ab + (size_t)(t + 2) * kstep;
            const char* b2 = last ? nB : cB + (size_t)(t + 2) * kstep;
            const char* a3 = a2 + kstep; const char* b3 = b2 + kstep;
            unsigned v2[2][2];
#pragma unroll
            for (int h = 0; h < 2; ++h)
#pragma unroll
                for (int i = 0; i < 2; ++i) v2[h][i] = last ? nva[h][i] : va[h][i];
            G8_LDB(B0, 0, 0); G8_SCHED; G8_LDA(At, 0, 0); G8_STAGEA(G8_SA(1, 1), a1, va[1]);
            G8_WAIT_L(8); G8_BAR; G8_WAIT_L(0); G8_MMA(0, 0, At, B0); G8_BAR; G8_SCHED;
            G8_LDB(B1, 0, 1); G8_STAGEB(G8_SB(0, 0), b2);
            G8_BAR; G8_WAIT_L(0); G8_MMA(0, 1, At, B1); G8_BAR;
            G8_LDA(At, 0, 1); G8_STAGEA(G8_SA(0, 0), a2, v2[0]);
            G8_BAR; G8_WAIT_L(0); G8_MMA(1, 0, At, B0); G8_BAR; G8_SCHED;
            G8_STAGEB(G8_SB(0, 1), b2 + hstepB);
            G8_WAIT_V(6); G8_BAR; G8_MMA(1, 1, At, B1); G8_BAR;
            G8_LDB(B0, 1, 0); G8_SCHED; G8_LDA(At, 1, 0); G8_STAGEA(G8_SA(0, 1), a2, v2[1]);
            G8_WAIT_L(8); G8_BAR; G8_WAIT_L(0); G8_MMA(0, 0, At, B0); G8_BAR; G8_SCHED;
            G8_LDB(B1, 1, 1); G8_STAGEB(G8_SB(1, 0), b3);
            G8_BAR; G8_WAIT_L(0); G8_MMA(0, 1, At, B1); G8_BAR;
            G8_LDA(At, 1, 1); G8_STAGEA(G8_SA(1, 0), a3, v2[0]);
            G8_BAR; G8_WAIT_L(0); G8_MMA(1, 0, At, B0); G8_BAR; G8_SCHED;
            G8_STAGEB(G8_SB(1, 1), b3 + hstepB);
            G8_WAIT_V(6); G8_BAR; G8_MMA(1, 1, At, B1); G8_BAR;
        }
        E(acc, cur, wr, wc, fr, fq);
        if (!has_next) break;
#pragma unroll
        for (int a = 0; a < 2; ++a)
#pragma unroll
            for (int b = 0; b < 2; ++b)
#pragma unroll
                for (int m = 0; m < 4; ++m)
#pragma unroll
                    for (int n = 0; n < 2; ++n) acc[a][b][m][n] = (f32x4){0.f, 0.f, 0.f, 0.f};
        cur = nxt; cB = nB; Ab = nAb; ++ui;
#pragma unroll
        for (int h = 0; h < 2; ++h)
#pragma unroll
            for (int i = 0; i < 2; ++i) va[h][i] = nva[h][i];
    }
    G8_WAIT_V(0);
    if (wr == 0) G8_BAR;
    G8_BAR;
#undef G8_SA
#undef G8_SB
#undef G8_STAGEA
#undef G8_STAGEB
#undef G8_LDA
#undef G8_LDB
#undef G8_MMA
#undef G8_WAIT_V
#undef G8_WAIT_L
#undef G8_BAR
#undef G8_SCHED
#undef G8_VA
}

struct DenseSched {
    int nN, nU, K, lda, ldb; const bf16_t* A; const bf16_t* Bt;
    __device__ __forceinline__ const char* a_base(const Unit&) const { return (const char*)A; }
    __device__ __forceinline__ bool next(int i, Unit& u) const {
        const int c = blockIdx.x, per = gridDim.x >> 3, x = c & 7, j = c >> 3;
        const int chunk = (nU + 7) >> 3, lu = i * per + j;
        if (lu >= chunk) return false;
        const int un = x * chunk + lu; if (un >= nU) return false;
        u.pm = un / nN; u.pn = un - u.pm * nN; u.e = 0; return true; }
    __device__ __forceinline__ int a_row(const Unit& u, int r) const { return u.pm * BM + r; }
    __device__ __forceinline__ int a_col(const Unit&) const { return 0; }
    __device__ __forceinline__ const char* b_base(const Unit& u) const { return (const char*)(Bt + (size_t)u.pn * BM * ldb); }
};

struct EpiGlu {
    bf16_t* U; const float* rs; const float* bias;
    __device__ __forceinline__ void operator()(const f32x4 (&acc)[2][2][4][2], const Unit& u, int wr, int wc, int fr, int fq) const {
        const int c0 = u.pn * 128 + wc * 32 + 8 * fq;
        const f32x4 ba0 = *(const f32x4*)(bias + c0), ba1 = *(const f32x4*)(bias + c0 + 4), bg0 = *(const f32x4*)(bias + 1024 + c0), bg1 = *(const f32x4*)(bias + 1024 + c0 + 4);
#pragma unroll
        for (int ai = 0; ai < 2; ++ai)
#pragma unroll
            for (int m = 0; m < 4; ++m) {
                const int row = u.pm * BM + ai * HALF + wr * 64 + m * 16 + fr; const float r = rs[row];
                f32x4 o0, o1;
#pragma unroll
                for (int j = 0; j < 4; ++j) {
                    o0[j] = (acc[ai][0][m][0][j] * r + ba0[j]) * fast_sigmoid(acc[ai][1][m][0][j] * r + bg0[j]);
                    o1[j] = (acc[ai][0][m][1][j] * r + ba1[j]) * fast_sigmoid(acc[ai][1][m][1][j] * r + bg1[j]); }
                *(u32x4*)(U + (size_t)row * D + c0) = pack8(o0, o1);
            }
    }
};
struct EpiXres {
    const float* Xin; float* Xout; bf16_t* XB; const float* bias; float* ssp;
    __device__ __forceinline__ void operator()(const f32x4 (&acc)[2][2][4][2], const Unit& u, int wr, int wc, int fr, int fq) const {
#pragma unroll
        for (int ai = 0; ai < 2; ++ai)
#pragma unroll
            for (int m = 0; m < 4; ++m) {
                const int row = u.pm * BM + ai * HALF + wr * 64 + m * 16 + fr; float ss = 0.f;
#pragma unroll
                for (int bj = 0; bj < 2; ++bj) {
                    const int c0 = u.pn * BM + bj * HALF + wc * 32 + 8 * fq; const size_t off = (size_t)row * D + c0;
                    f32x4 v0 = *(const f32x4*)(Xin + off) + acc[ai][bj][m][0], v1 = *(const f32x4*)(Xin + off + 4) + acc[ai][bj][m][1];
                    if (bias) { v0 += *(const f32x4*)(bias + c0); v1 += *(const f32x4*)(bias + c0 + 4); }
                    *(f32x4*)(Xout + off) = v0; *(f32x4*)(Xout + off + 4) = v1;
                    *(u32x4*)(XB + off) = pack8(v0, v1);
                    ss += (v0[0] * v0[0] + v0[1] * v0[1]) + (v0[2] * v0[2] + v0[3] * v0[3]) + (v1[0] * v1[0] + v1[1] * v1[1]) + (v1[2] * v1[2] + v1[3] * v1[3]);
                }
                if (ssp) { ss += __shfl_xor(ss, 16); ss += __shfl_xor(ss, 32); if (fq == 0) ssp[(size_t)row * 16 + u.pn * 4 + wc] = ss; }
            }
    }
};

struct AttnSched {
    int K, lda, ldb; const bf16_t* A; const bf16_t* Bm; int pv;
    __device__ __forceinline__ bool next(int i, Unit& u) const {
        const int c = blockIdx.x, per = gridDim.x >> 3, x = c & 7, j = c >> 3;
        const int lu = i * per + j; if (lu >= 64) return false;
        const int un = x * 64 + lu, bh = un >> 5, qb = un & 31;
        u.pm = (bh >> 2) * 32 + qb; u.pn = 0; u.e = bh & 3; return true; }
    __device__ __forceinline__ const char* a_base(const Unit&) const { return (const char*)A; }
    __device__ __forceinline__ int a_row(const Unit& u, int r) const { return u.pm * BM + r; }
    __device__ __forceinline__ int a_col(const Unit& u) const { return u.e * 256; }
    __device__ __forceinline__ const char* b_base(const Unit& u) const { const int b = u.pm >> 5;
        return pv ? (const char*)(Bm + (size_t)(b * 4 + u.e) * 65536) : (const char*)(Bm + (size_t)(b * 256) * 1024 + u.e * 256); }
};
struct KVSched {
    int K, lda, ldb; const bf16_t* MEMNB; const bf16_t* WKV;
    __device__ __forceinline__ bool next(int i, Unit& u) const {
        const int un = i * (int)gridDim.x + (int)blockIdx.x; if (un >= 32) return false;
        u.e = un >> 4; u.pm = (un & 15) >> 2; u.pn = un & 3; return true; }
    __device__ __forceinline__ const char* a_base(const Unit& u) const { return u.e ? (const char*)(WKV + (size_t)1024 * 1024) : (const char*)MEMNB; }
    __device__ __forceinline__ int a_row(const Unit& u, int r) const { return u.pm * BM + r; }
    __device__ __forceinline__ int a_col(const Unit&) const { return 0; }
    __device__ __forceinline__ const char* b_base(const Unit& u) const { return u.e ? (const char*)(MEMNB + (size_t)u.pn * BM * 1024) : (const char*)(WKV + (size_t)u.pn * BM * 1024); }
};
__device__ __forceinline__ float ssp_rs(const float* ssp, int row) {
    const f32x4 a = *(const f32x4*)(ssp + (size_t)row * 16), b = *(const f32x4*)(ssp + (size_t)row * 16 + 4), c = *(const f32x4*)(ssp + (size_t)row * 16 + 8), d = *(const f32x4*)(ssp + (size_t)row * 16 + 12);
    const float s = ((a[0] + a[1]) + (a[2] + a[3])) + ((b[0] + b[1]) + (b[2] + b[3])) + ((c[0] + c[1]) + (c[2] + c[3])) + ((d[0] + d[1]) + (d[2] + d[3]));
    return rsqrtf(s * (1.0f / D) + EPS);
}
struct EpiRowScale {
    bf16_t* O; int ldo; const float* ssp; const float* rs; float scale; int qtiles; float qscale;
    __device__ __forceinline__ void operator()(const f32x4 (&acc)[2][2][4][2], const Unit& u, int wr, int wc, int fr, int fq) const {
        const float cs = scale * (u.pn < qtiles ? qscale : 1.0f);
#pragma unroll
        for (int ai = 0; ai < 2; ++ai)
#pragma unroll
            for (int m = 0; m < 4; ++m) {
                const int row = u.pm * BM + ai * HALF + wr * 64 + m * 16 + fr;
                const float r = (rs ? rs[row] : ssp_rs(ssp, row)) * cs;
#pragma unroll
                for (int bj = 0; bj < 2; ++bj) { const int c0 = u.pn * BM + bj * HALF + wc * 32 + 8 * fq;
                    *(u32x4*)(O + (size_t)row * ldo + c0) = pack8(acc[ai][bj][m][0] * r, acc[ai][bj][m][1] * r); }
            }
    }
};
struct EpiKV {
    bf16_t* Kb; bf16_t* VT;
    __device__ __forceinline__ void operator()(const f32x4 (&acc)[2][2][4][2], const Unit& u, int wr, int wc, int fr, int fq) const {
        bf16_t* base = u.e ? VT + (size_t)(u.pn * 4 + u.pm) * 65536 : Kb + (size_t)u.pm * BM * 1024 + u.pn * BM;
        const int ld = u.e ? 256 : 1024;
#pragma unroll
        for (int ai = 0; ai < 2; ++ai)
#pragma unroll
            for (int m = 0; m < 4; ++m) { const int r = ai * HALF + wr * 64 + m * 16 + fr;
#pragma unroll
                for (int bj = 0; bj < 2; ++bj) { const int c0 = bj * HALF + wc * 32 + 8 * fq;
                    *(u32x4*)(base + (size_t)r * ld + c0) = pack8(acc[ai][bj][m][0], acc[ai][bj][m][1]); } }
    }
};
struct EpiS {
    bf16_t* P; float* psum;
    __device__ __forceinline__ void operator()(const f32x4 (&acc)[2][2][4][2], const Unit& u, int wr, int wc, int fr, int fq) const {
#pragma unroll
        for (int ai = 0; ai < 2; ++ai)
#pragma unroll
            for (int m = 0; m < 4; ++m) {
                const int row = u.pm * BM + ai * HALF + wr * 64 + m * 16 + fr; float ps = 0.f;
#pragma unroll
                for (int bj = 0; bj < 2; ++bj) { const int c0 = u.e * 256 + bj * HALF + wc * 32 + 8 * fq;
                    f32x4 e0, e1;
#pragma unroll
                    for (int j = 0; j < 4; ++j) { e0[j] = __builtin_amdgcn_exp2f(acc[ai][bj][m][0][j] * 1.4426950408889634f); e1[j] = __builtin_amdgcn_exp2f(acc[ai][bj][m][1][j] * 1.4426950408889634f); }
                    const u32x4 w = pack8(e0, e1);
                    *(u32x4*)(P + (size_t)row * D + c0) = w;
                    ps += (bf_lo(w.x) + bf_hi(w.x)) + (bf_lo(w.y) + bf_hi(w.y)) + (bf_lo(w.z) + bf_hi(w.z)) + (bf_lo(w.w) + bf_hi(w.w)); }
                ps += __shfl_xor(ps, 16); ps += __shfl_xor(ps, 32);
                if (fq == 0) psum[(size_t)row * 16 + u.e * 4 + wc] = ps;
            }
    }
};
struct EpiPV {
    bf16_t* O; const float* psum;
    __device__ __forceinline__ void operator()(const f32x4 (&acc)[2][2][4][2], const Unit& u, int wr, int wc, int fr, int fq) const {
#pragma unroll
        for (int ai = 0; ai < 2; ++ai)
#pragma unroll
            for (int m = 0; m < 4; ++m) {
                const int row = u.pm * BM + ai * HALF + wr * 64 + m * 16 + fr;
                const f32x4 s4 = *(const f32x4*)(psum + (size_t)row * 16 + u.e * 4);
                const float inv = 1.0f / ((s4[0] + s4[1]) + (s4[2] + s4[3]));
#pragma unroll
                for (int bj = 0; bj < 2; ++bj) { const int c0 = u.e * 256 + bj * HALF + wc * 32 + 8 * fq;
                    *(u32x4*)(O + (size_t)row * D + c0) = pack8(acc[ai][bj][m][0] * inv, acc[ai][bj][m][1] * inv); }
            }
    }
};
}

__device__ __forceinline__ void cvt_item(const float* W, int ldw, int col0, int K, const float* g, bf16_t* Bt, int il, int half, LAS float* scr, int item, int nblk, int lane) {
    const int kb = item / nblk, nb = item - kb * nblk, k0 = 64 * kb, n0 = 32 * nb;
#pragma unroll 8
    for (int i = 0; i < 32; ++i) { const int kk = 2 * i + (lane >> 5); float v = W[(size_t)(k0 + kk) * ldw + col0 + n0 + (lane & 31)]; if (g) v *= g[k0 + kk]; scr[kk * 33 + (lane & 31)] = v; }
    asm volatile("s_waitcnt lgkmcnt(0)" ::: "memory");
    const int c = lane & 7;
#pragma unroll
    for (int j = 0; j < 4; ++j) { const int n = n0 + (lane >> 3) + 8 * j; const LAS float* s = scr + (8 * c) * 33 + (n - n0);
        u32x4 o; o.x = cvt_pk_bf16(s[0 * 33], s[1 * 33]); o.y = cvt_pk_bf16(s[2 * 33], s[3 * 33]); o.z = cvt_pk_bf16(s[4 * 33], s[5 * 33]); o.w = cvt_pk_bf16(s[6 * 33], s[7 * 33]);
        const int drow = il ? ((n >> 7) * 256 + half * 128 + (n & 127)) : n;
        *(u32x4*)(Bt + (size_t)drow * K + k0 + 8 * c) = o; }
    asm volatile("s_waitcnt lgkmcnt(0)" ::: "memory");
}
__device__ __forceinline__ void cvt_matrix(const float* W, int ldw, int col0, int ncols, int K, const float* g, bf16_t* Bt, int il, int half, LAS unsigned char* lds) {
    const int lane = threadIdx.x & 63, wv = threadIdx.x >> 6;
    LAS float* scr = (LAS float*)(lds + wv * 8704);
    const int gw = blockIdx.x * (blockDim.x >> 6) + wv, ngw = gridDim.x * (blockDim.x >> 6);
    const int nblk = ncols / 32, nitems = (K / 64) * nblk;
    for (int it = gw; it < nitems; it += ngw) cvt_item(W, ldw, col0, K, g, Bt, il, half, scr, it, nblk, lane);
}
__device__ __forceinline__ void rows_prep(const float* x, bf16_t* XB, float* rs, float* ssp, int rows) {
    const int lane = threadIdx.x & 63;
    const int gw = (blockIdx.x * blockDim.x + threadIdx.x) >> 6, ngw = (gridDim.x * blockDim.x) >> 6;
    for (int r = gw; r < rows; r += ngw) {
        const f32x4* xr = (const f32x4*)(x + (size_t)r * D);
        f32x4 v[4]; float s = 0.f;
#pragma unroll
        for (int j = 0; j < 4; ++j) { v[j] = xr[lane + 64 * j]; s += (v[j][0] * v[j][0] + v[j][1] * v[j][1]) + (v[j][2] * v[j][2] + v[j][3] * v[j][3]); }
        s = wave_sum(s);
        if (lane == 0) rs[r] = rsqrtf(s * (1.0f / D) + EPS);
        if (ssp && lane < 16) ssp[(size_t)r * 16 + lane] = lane == 0 ? s : 0.f;
        u32x2* o = (u32x2*)(XB + (size_t)r * D);
#pragma unroll
        for (int j = 0; j < 4; ++j) { u32x2 w; w.x = cvt_pk_bf16(v[j][0], v[j][1]); w.y = cvt_pk_bf16(v[j][2], v[j][3]); o[lane + 64 * j] = w; }
    }
}

__device__ __forceinline__ void rows_norm_bf16(const float* x, const float* g, bf16_t* out, int rows) {
    const int lane = threadIdx.x & 63;
    const int gw = (blockIdx.x * blockDim.x + threadIdx.x) >> 6, ngw = (gridDim.x * blockDim.x) >> 6;
    for (int r = gw; r < rows; r += ngw) {
        const f32x4* xr = (const f32x4*)(x + (size_t)r * D);
        f32x4 v[4]; float s = 0.f;
#pragma unroll
        for (int j = 0; j < 4; ++j) { v[j] = xr[lane + 64 * j]; s += (v[j][0] * v[j][0] + v[j][1] * v[j][1]) + (v[j][2] * v[j][2] + v[j][3] * v[j][3]); }
        s = wave_sum(s); const float rs = rsqrtf(s * (1.0f / D) + EPS);
        u32x2* o = (u32x2*)(out + (size_t)r * D);
#pragma unroll
        for (int j = 0; j < 4; ++j) { const f32x4 gg = ((const f32x4*)g)[lane + 64 * j]; u32x2 w; w.x = cvt_pk_bf16(v[j][0] * rs * gg[0], v[j][1] * rs * gg[1]); w.y = cvt_pk_bf16(v[j][2] * rs * gg[2], v[j][3] * rs * gg[3]); o[lane + 64 * j] = w; }
    }
}

__device__ __forceinline__ void conv_phase(const bf16_t* U, const float* wdw, const float* bdw, const float* lng, const float* lnb, bf16_t* CV, LAS unsigned char* lds) {
    int tid_ = threadIdx.x; asm volatile("" : "+v"(tid_));
    const int tid = tid_, lane = tid & 63, wv = tid >> 6, c0 = 2 * tid;
    LAS float* red = (LAS float*)lds; LAS float* tot = red + 512;
    f32x2 w[CONVK];
#pragma unroll
    for (int j = 0; j < CONVK; ++j) w[j] = *(const f32x2*)(wdw + j * D + c0);
    const f32x2 bd = *(const f32x2*)(bdw + c0), lg = *(const f32x2*)(lng + c0), lb = *(const f32x2*)(lnb + c0);
    for (int item = blockIdx.x; item < T / 32; item += gridDim.x) {
        const int t0 = item * 32, s0 = t0 & (S - 1);
        f32x2 acc[32];
#pragma unroll
        for (int o = 0; o < 32; ++o) acc[o] = bd;
#pragma unroll
        for (int r = 0; r < 62; ++r) {
            unsigned raw = 0u;
            if (s0 - 30 + r >= 0) raw = *(const unsigned*)(U + (size_t)(t0 - 30 + r) * D + c0);
            const f32x2 uv = (f32x2){bf_lo(raw), bf_hi(raw)};
#pragma unroll
            for (int o = (r > 30 ? r - 30 : 0); o <= (r < 31 ? r : 31); ++o) acc[o] = __builtin_elementwise_fma(uv, w[r - o], acc[o]);
        }
        float v[64];
#pragma unroll
        for (int o = 0; o < 32; ++o) { v[o] = acc[o][0] + acc[o][1]; v[32 + o] = acc[o][0] * acc[o][0] + acc[o][1] * acc[o][1]; }
#pragma unroll
        for (int st = 0; st < 6; ++st) {
            const int half = 32 >> st, bit = 32 >> st; const bool up = (lane & bit) != 0;
#pragma unroll
            for (int k = 0; k < half; ++k) { const float send = up ? v[k] : v[k + half]; const float keep = up ? v[k + half] : v[k]; v[k] = keep + __shfl_xor(send, bit); }
        }
        red[wv * 64 + lane] = v[0];
        __syncthreads();
        if (tid < 64) { float s = 0.f;
#pragma unroll
            for (int q = 0; q < 8; ++q) s += red[q * 64 + tid];
            tot[tid] = s; }
        __syncthreads();
#pragma unroll
        for (int o = 0; o < 32; ++o) {
            const float mu = tot[o] * (1.0f / D), var = tot[32 + o] * (1.0f / D) - mu * mu, rstd = rsqrtf(var + EPS);
            const float y0 = (acc[o][0] - mu) * rstd * lg[0] + lb[0], y1 = (acc[o][1] - mu) * rstd * lg[1] + lb[1];
            *(unsigned*)(CV + (size_t)(t0 + o) * D + c0) = cvt_pk_bf16(y0 * fast_sigmoid(y0), y1 * fast_sigmoid(y1));
        }
        __syncthreads();
    }
}

enum Ph { PH_PREP0 = 0, PH_CONV_IN, PH_CONV_MID, PH_CONV_OUT, PH_ADAPT, PH_XA_PREP, PH_XA_Q, PH_XA_KV, PH_XA_S, PH_XA_PV, PH_XA_O, PH_N };

__device__ __forceinline__ void run_phase(const Ctx& c, int ph, int l, LAS unsigned char* lds) {
    unsigned char* ws = c.ws;
    bf16_t* XB = (bf16_t*)(ws + OW_XB); float* RS = (float*)(ws + OW_RS); float* SSP = (float*)(ws + OW_SSP);
    bf16_t* ACTA = (bf16_t*)(ws + OW_ACTA); bf16_t* ACTB = (bf16_t*)(ws + OW_ACTB);
    bf16_t* WCIN = (bf16_t*)(ws + OW_WCIN); bf16_t* WCOUT = (bf16_t*)(ws + OW_WCOUT);
    bf16_t* ACTC = (bf16_t*)(ws + OW_ACTC); float* PSUM = (float*)(ws + OW_PSUM);
    bf16_t* WXQ = (bf16_t*)(ws + OW_WXQ) + (size_t)l * D * D; bf16_t* WXKV = (bf16_t*)(ws + OW_WXKV) + (size_t)l * 2048 * D; bf16_t* WXO = (bf16_t*)(ws + OW_WXO) + (size_t)l * D * D;
    bf16_t* KB = (bf16_t*)(ws + OW_KVB); bf16_t* VT = KB + (size_t)1024 * 1024; bf16_t* MEMNB = (bf16_t*)(ws + OW_MEMNB);
    switch (ph) {
    case PH_PREP0:
        cvt_matrix(c.in[7], 2048, 0, 1024, D, c.in[2], WCIN, 1, 0, lds);
        cvt_matrix(c.in[7], 2048, 1024, 1024, D, c.in[2], WCIN, 1, 1, lds);
        cvt_matrix(c.in[13], D, 0, D, D, nullptr, WCOUT, 0, 0, lds);
        rows_prep(c.in[0], XB, RS, nullptr, T);
        break;
    case PH_CONV_IN: { g8::DenseSched S{8, 128 * 8, D, D, D, XB, WCIN}; g8::gemm_phase(lds, S, g8::EpiGlu{ACTA, RS, c.in[8]}); } break;
    case PH_CONV_MID: conv_phase(ACTA, c.in[9], c.in[10], c.in[11], c.in[12], ACTB, lds); break;
    case PH_CONV_OUT: { g8::DenseSched S{4, 128 * 4, D, D, D, ACTB, WCOUT}; g8::gemm_phase(lds, S, g8::EpiXres{c.in[0], c.out, XB, c.in[14], SSP}); } break;
    case PH_ADAPT: rows_prep(c.out, XB, RS, SSP, T); break;
    case PH_XA_PREP:
        cvt_matrix(c.in[20] + (size_t)l * D * D, D, 0, D, D, c.in[3] + l * D, WXQ, 0, 0, lds);
        cvt_matrix(c.in[21] + (size_t)l * D * 2048, 2048, 0, 2048, D, nullptr, WXKV, 0, 0, lds);
        cvt_matrix(c.in[22] + (size_t)l * D * D, D, 0, D, D, nullptr, WXO, 0, 0, lds);
        rows_norm_bf16(c.in[1], c.in[5], MEMNB, NB * NMEM);
        break;
    case PH_XA_Q: { g8::DenseSched S{4, 128 * 4, D, D, D, XB, WXQ}; g8::gemm_phase(lds, S, g8::EpiRowScale{ACTA, D, SSP, nullptr, 0.0625f, 0, 1.0f}); } break;
    case PH_XA_KV: { g8::KVSched S{D, D, D, MEMNB, WXKV}; g8::gemm_phase(lds, S, g8::EpiKV{KB, VT}); } break;
    case PH_XA_S: { g8::AttnSched S{256, D, D, ACTA, KB, 0}; g8::gemm_phase(lds, S, g8::EpiS{ACTB, PSUM}); } break;
    case PH_XA_PV: { g8::AttnSched S{256, D, 256, ACTB, VT, 1}; g8::gemm_phase(lds, S, g8::EpiPV{ACTC, PSUM}); } break;
    case PH_XA_O: { g8::DenseSched S{4, 128 * 4, D, D, D, ACTC, WXO}; g8::gemm_phase(lds, S, g8::EpiXres{c.out, c.out, XB, nullptr, nullptr}); } break;
    }
}
template <int PH> __global__ void __launch_bounds__(512, 2) k_opt(Ctx c, int l) {
    extern __shared__ __attribute__((aligned(16))) unsigned char dynlds[];
    run_phase(c, PH, l, (LAS unsigned char*)dynlds);
}
#ifndef COOP
#define COOP 1
#endif
enum Op { OP_MEMN = 0, OP_MEMKV, OP_COPYX, OP_RMS_MIX, OP_CONV_IN, OP_GLU, OP_DWCONV, OP_CONV_OUT, OP_GLA_IN, OP_GLA_DECAY, OP_GLA_REC, OP_GLA_NORM, OP_GLA_OUT,
          OP_RMS_XA, OP_XA_Q, OP_XA_ATT, OP_XA_O, OP_RMS_FFN, OP_ROUTE, OP_BUILD, OP_MOE_GATE, OP_MOE_UP, OP_MOE_ACT, OP_MOE_DOWN, OP_MOE_COMBINE, OP_FINAL };

__device__ __forceinline__ void run_op(const Ctx& c, int op, int l, float* sm) {
    unsigned char* ws = c.ws;
    float* HN = (float*)(ws + WS_HN); float* BIG = (float*)(ws + WS_BIG);
    float* MEMN = (float*)(ws + WS_MEMN); float* KV = (float*)(ws + WS_KV) + (size_t)l * 1024 * 2048;
    int* eid = (int*)(ws + WS_EID); float* gate = (float*)(ws + WS_GATE); int* pos = (int*)(ws + WS_POS);
    int* slot_tok = (int*)(ws + WS_SLOTTOK); int* slot_a = (int*)(ws + WS_SLOTA); int* tile_e = (int*)(ws + WS_TILEE); int* cnt = (int*)(ws + WS_CNT);
    float* X = c.out;
    switch (op) {
    case OP_MEMN: n_rms(c.in[1], c.in[5], MEMN, NB * NMEM); break;
    case OP_MEMKV: n_gemm(sm, MEMN, D, nullptr, c.in[21] + (size_t)l * D * 2048, 2048, 0, nullptr, NB * NMEM, 2048, D, EpiStore{KV, 2048, nullptr}); break;
    case OP_COPYX: n_copy4(c.in[0], X, (size_t)T * D / 4); break;
    case OP_RMS_MIX: n_rms(X, c.in[2] + l * D, HN, T); break;
    case OP_CONV_IN: n_gemm(sm, HN, D, nullptr, c.in[7], 2048, 0, nullptr, T, 2048, D, EpiStore{BIG, 2048, c.in[8]}); break;
    case OP_GLU: n_glu(BIG, HN); break;
    case OP_DWCONV: n_dwconv(HN, c.in[9], c.in[10], c.in[11], c.in[12], BIG); break;
    case OP_CONV_OUT: n_gemm(sm, BIG, D, nullptr, c.in[13], D, 0, nullptr, T, D, D, EpiResid{X, D, c.in[14]}); break;
    case OP_GLA_IN: n_gemm(sm, HN, D, nullptr, c.in[15], GLA_COLS, 0, nullptr, T, GLA_COLS, D, EpiStore{BIG, GLA_COLS, nullptr}); break;
    case OP_GLA_DECAY: n_gla_decay(BIG, c.in[16], c.in[17], HN); break;
    case OP_GLA_REC: n_gla_rec(BIG, HN); break;
    case OP_GLA_NORM: n_gla_norm(BIG, c.in[18], HN); break;
    case OP_GLA_OUT: n_gemm(sm, HN, D, nullptr, c.in[19], D, 0, nullptr, T, D, D, EpiResid{X, D, nullptr}); break;
    case OP_RMS_XA: n_rms(X, c.in[3] + l * D, HN, T); break;
    case OP_XA_Q: n_gemm(sm, HN, D, nullptr, c.in[20] + (size_t)l * D * D, D, 0, nullptr, T, D, D, EpiStore{BIG, D, nullptr}); break;
    case OP_XA_ATT: n_attn(BIG, KV, BIG + (size_t)T * D); break;
    case OP_XA_O: n_gemm(sm, BIG + (size_t)T * D, D, nullptr, c.in[22] + (size_t)l * D * D, D, 0, nullptr, T, D, D, EpiResid{X, D, nullptr}); break;
    case OP_RMS_FFN: n_rms(X, c.in[4] + l * D, HN, T); n_moe_init(cnt, slot_tok, slot_a, tile_e); break;
    case OP_ROUTE: n_route(HN, c.in[23] + (size_t)l * D * NG, c.in[24] + l * NG, c.in[25] + (size_t)l * D * NE, c.in[26] + l * NE, eid, gate, pos, cnt); break;
    case OP_BUILD: n_moe_build(eid, pos, cnt, slot_tok, slot_a, tile_e); break;
    case OP_MOE_GATE: n_gemm(sm, HN, D, slot_tok, c.in[27] + (size_t)l * NE * D * DE, DE, (size_t)D * DE, tile_e, NSLOT, DE, D, EpiStore{BIG, DE, nullptr}); break;
    case OP_MOE_UP: n_gemm(sm, HN, D, slot_tok, c.in[28] + (size_t)l * NE * D * DE, DE, (size_t)D * DE, tile_e, NSLOT, DE, D, EpiStore{BIG + (size_t)NSLOT * DE, DE, nullptr}); break;
    case OP_MOE_ACT: n_moe_act(BIG, BIG + (size_t)NSLOT * DE); break;
    case OP_MOE_DOWN: n_gemm(sm, BIG, DE, nullptr, c.in[29] + (size_t)l * NE * DE * D, D, (size_t)DE * D, tile_e, NSLOT, D, DE, EpiMoeDown{BIG + (size_t)NSLOT * DE, slot_a, gate}); break;
    case OP_MOE_COMBINE: n_moe_combine(X, BIG + (size_t)NSLOT * DE); break;
    case OP_FINAL: n_rms(X, c.in[6], X, T); break;
    }
}

template <int OP> __global__ void __launch_bounds__(512) k_stage(Ctx c, int l) {
    __shared__ float sm[16 * 132 + 16 * 260];
    run_op(c, OP, l, sm);
}
typedef void (*StageFn)(Ctx, int);
template <int... I> struct Seq {};
template <int N, int... I> struct MkSeq : MkSeq<N - 1, N - 1, I...> {};
template <int... I> struct MkSeq<0, I...> { typedef Seq<I...> type; };
template <int... I> static void fill_tab(StageFn* t, Seq<I...>) { StageFn f[] = {k_stage<I>...}; for (unsigned i = 0; i < sizeof...(I); ++i) t[i] = f[i]; }
template <int... I> static void fill_tab_opt(StageFn* t, Seq<I...>) { StageFn f[] = {k_opt<I>...}; for (unsigned i = 0; i < sizeof...(I); ++i) t[i] = f[i]; }

template <int CODE> __device__ __forceinline__ void coop_step(const Ctx& c, LAS unsigned char* lds, cg::grid_group& grid, bool sync_after) {
    run_phase(c, CODE >> 1, CODE & 1, lds);
    if (sync_after) {
        asm volatile("s_waitcnt vmcnt(0) lgkmcnt(0)" ::: "memory");
        grid.sync();
        if (threadIdx.x < 64) { __builtin_amdgcn_fence(__ATOMIC_ACQUIRE, "agent"); asm volatile("s_waitcnt vmcnt(0)" ::: "memory"); }
        __syncthreads();
    }
}
template <int... CODES> __global__ void __launch_bounds__(512, 2) k_coop(Ctx c) {
    extern __shared__ __attribute__((aligned(16))) unsigned char dynlds[];
    cg::grid_group grid = cg::this_grid();
    LAS unsigned char* lds = (LAS unsigned char*)dynlds;
    int idx = 0; constexpr int N = sizeof...(CODES);
    ((coop_step<CODES>(c, lds, grid, ++idx < N)), ...);
}
#define CODE(ph, l) ((ph) * 2 + (l))
typedef void (*CoopFn)(Ctx);
struct Step { int kind, op, l; };
static const Step g_prog[] = {
    {0, OP_MEMN, 0}, {0, OP_MEMKV, 0}, {0, OP_MEMKV, 1},
    {1, PH_PREP0, 0}, {1, PH_CONV_IN, 0}, {1, PH_CONV_MID, 0}, {1, PH_CONV_OUT, 0},
    {1, PH_XA_PREP, 0}, {1, PH_XA_Q, 0}, {1, PH_XA_KV, 0}, {1, PH_XA_S, 0}, {1, PH_XA_PV, 0}, {1, PH_XA_O, 0},
    {0, OP_RMS_FFN, 0}, {0, OP_ROUTE, 0}, {0, OP_BUILD, 0}, {0, OP_MOE_GATE, 0}, {0, OP_MOE_UP, 0}, {0, OP_MOE_ACT, 0}, {0, OP_MOE_DOWN, 0}, {0, OP_MOE_COMBINE, 0},
    {0, OP_RMS_MIX, 1}, {0, OP_GLA_IN, 0}, {0, OP_GLA_DECAY, 0}, {0, OP_GLA_REC, 0}, {0, OP_GLA_NORM, 0}, {0, OP_GLA_OUT, 0},
    {1, PH_ADAPT, 1}, {1, PH_XA_PREP, 1}, {1, PH_XA_Q, 1}, {1, PH_XA_KV, 1}, {1, PH_XA_S, 1}, {1, PH_XA_PV, 1}, {1, PH_XA_O, 1},
    {0, OP_RMS_FFN, 1}, {0, OP_ROUTE, 1}, {0, OP_BUILD, 1}, {0, OP_MOE_GATE, 1}, {0, OP_MOE_UP, 1}, {0, OP_MOE_ACT, 1}, {0, OP_MOE_DOWN, 1}, {0, OP_MOE_COMBINE, 1},
    {0, OP_FINAL, 0}};
constexpr int NSTEP = sizeof(g_prog) / sizeof(g_prog[0]);

extern "C" void kernel_launch(void* const* d_in, const int* in_sizes, int n_in, void* d_out, int out_size, void* d_ws, size_t ws_size, hipStream_t stream) {
    if (n_in != 30 || out_size != T * D || ws_size < OW_END || ws_size < WS_END) { fprintf(stderr, "kernel_launch: bad args n_in %d out %d ws %zu\n", n_in, out_size, ws_size); return; }
    Ctx c; memset(&c, 0, sizeof(c));
    for (int i = 0; i < 30; ++i) c.in[i] = (const float*)d_in[i];
    c.out = (float*)d_out; c.ws = (unsigned char*)d_ws;
    static StageFn tab[OP_FINAL + 1], tabo[PH_N];
    static bool init = false;
    if (!init) { fill_tab(tab, MkSeq<OP_FINAL + 1>::type()); fill_tab_opt(tabo, MkSeq<PH_N>::type());
        for (int i = 0; i < PH_N; ++i) hipFuncSetAttribute((const void*)tabo[i], hipFuncAttributeMaxDynamicSharedMemorySize, LDS_BYTES);
        init = true; }
#if COOP
    static int coop_grid = 0;
    static CoopFn coop_fns[2] = { k_coop<CODE(PH_PREP0, 0), CODE(PH_CONV_IN, 0), CODE(PH_CONV_MID, 0), CODE(PH_CONV_OUT, 0), CODE(PH_XA_PREP, 0), CODE(PH_XA_Q, 0), CODE(PH_XA_KV, 0), CODE(PH_XA_S, 0), CODE(PH_XA_PV, 0), CODE(PH_XA_O, 0)>,
                                  k_coop<CODE(PH_ADAPT, 1), CODE(PH_XA_PREP, 1), CODE(PH_XA_Q, 1), CODE(PH_XA_KV, 1), CODE(PH_XA_S, 1), CODE(PH_XA_PV, 1), CODE(PH_XA_O, 1)> };
    if (!coop_grid) { int dev = 0, cus = 0, per_cu = 0; hipGetDevice(&dev); hipDeviceGetAttribute(&cus, hipDeviceAttributeMultiprocessorCount, dev);
        for (int k = 0; k < 2; ++k) hipFuncSetAttribute((const void*)coop_fns[k], hipFuncAttributeMaxDynamicSharedMemorySize, LDS_BYTES);
        hipOccupancyMaxActiveBlocksPerMultiprocessor(&per_cu, coop_fns[0], 512, LDS_BYTES);
        coop_grid = cus * (per_cu < 1 ? 1 : per_cu); if (coop_grid > 256) coop_grid = 256;
        fprintf(stderr, "kernel_launch: cus %d per_cu %d grid %d\n", cus, per_cu, coop_grid); }
    int ncoop = 0;
#endif
    for (int i = 0; i < NSTEP; ++i) {
        if (g_prog[i].kind == 0) { hipLaunchKernelGGL(tab[g_prog[i].op], dim3(1024), dim3(512), 0, stream, c, g_prog[i].l); continue; }
#if COOP
        while (i < NSTEP && g_prog[i].kind == 1) ++i;
        --i;
        void* args[] = {&c};
        hipError_t e = hipLaunchCooperativeKernel((void*)coop_fns[ncoop++], dim3(coop_grid), dim3(512), args, LDS_BYTES, stream);
        if (e != hipSuccess) fprintf(stderr, "cooperative launch failed: %s\n", hipGetErrorString(e));
#else
        hipLaunchKernelGGL(tabo[g_prog[i].op], dim3(256), dim3(512), LDS_BYTES, stream, c, g_prog[i].l);
#endif
    }
}
```

```cpp
#include <hip/hip_runtime.h>
#include <hip/hip_cooperative_groups.h>
#include <cstdio>
#include <cstring>
namespace cg = cooperative_groups;

#ifndef MEGA
#define MEGA 0
#endif

constexpr int D = 1024, NB = 4, S = 8192, T = NB * S, NMEM = 256, DEPTH = 2;
constexpr int CONVK = 31;
constexpr int GH = 4, GDK = 512, GDV = 1024, GDKH = 128, GDVH = 256, GRANK = 16, GLA_COLS = 3088;
constexpr int XH = 4, XHD = 256;
constexpr int NG = 4, EPG = 8, NE = 32, DE = 512;
constexpr int NA = T * 2;
constexpr int NSLOT = NA + NE * 128;
constexpr float EPS = 1e-6f;

constexpr size_t MiB = 1u << 20;
constexpr size_t WS_HN = 0;
constexpr size_t WS_BIG = 128 * MiB;
constexpr size_t WS_SMALL = 528 * MiB;
constexpr size_t WS_MEMN = WS_SMALL;
constexpr size_t WS_KV = WS_MEMN + 4 * MiB;
constexpr size_t WS_EID = WS_KV + 16 * MiB;
constexpr size_t WS_GATE = WS_EID + NA * 4;
constexpr size_t WS_POS = WS_GATE + NA * 4;
constexpr size_t WS_SLOTTOK = WS_POS + NA * 4;
constexpr size_t WS_SLOTA = WS_SLOTTOK + NSLOT * 4;
constexpr size_t WS_TILEE = WS_SLOTA + NSLOT * 4;
constexpr size_t WS_CNT = WS_TILEE + 4096;
constexpr size_t WS_END = WS_CNT + 4096;

struct Ctx {
    const float* in[30];
    float* out;
    unsigned char* ws;
};

__device__ __forceinline__ float wave_sum(float v) {
#pragma unroll
    for (int o = 1; o < 64; o <<= 1) v += __shfl_xor(v, o);
    return v;
}
__device__ __forceinline__ float wave_max(float v) {
#pragma unroll
    for (int o = 1; o < 64; o <<= 1) v = fmaxf(v, __shfl_xor(v, o));
    return v;
}
__device__ __forceinline__ float sigmoidf_(float x) { return 1.0f / (1.0f + expf(-x)); }
__device__ __forceinline__ float siluf_(float x) { return x / (1.0f + expf(-x)); }

__device__ void n_rms(const float* x, const float* g, float* out, int rows) {
    const int lane = threadIdx.x & 63;
    const int gw = (blockIdx.x * blockDim.x + threadIdx.x) >> 6, ngw = (gridDim.x * blockDim.x) >> 6;
    for (int r = gw; r < rows; r += ngw) {
        const float4* xr = (const float4*)(x + (size_t)r * D);
        float4 v[4]; float s = 0.f;
#pragma unroll
        for (int j = 0; j < 4; ++j) { v[j] = xr[lane + 64 * j]; s += v[j].x * v[j].x + v[j].y * v[j].y + v[j].z * v[j].z + v[j].w * v[j].w; }
        s = wave_sum(s);
        const float rs = rsqrtf(s * (1.0f / D) + EPS);
        float4* o = (float4*)(out + (size_t)r * D);
#pragma unroll
        for (int j = 0; j < 4; ++j) { const float4 gg = ((const float4*)g)[lane + 64 * j];
            o[lane + 64 * j] = make_float4(v[j].x * rs * gg.x, v[j].y * rs * gg.y, v[j].z * rs * gg.z, v[j].w * rs * gg.w); }
    }
}
__device__ void n_copy4(const float* src, float* dst, size_t n4) {
    const size_t g = (size_t)blockIdx.x * blockDim.x + threadIdx.x, gs = (size_t)gridDim.x * blockDim.x;
    for (size_t i = g; i < n4; i += gs) ((float4*)dst)[i] = ((const float4*)src)[i];
}

struct EpiStore { float* C; int ldc; const float* bias;
    __device__ __forceinline__ void operator()(int m, int n, float acc) const { C[(size_t)m * ldc + n] = acc + (bias ? bias[n] : 0.f); } };
struct EpiResid { float* X; int ldc; const float* bias;
    __device__ __forceinline__ void operator()(int m, int n, float acc) const { X[(size_t)m * ldc + n] += acc + (bias ? bias[n] : 0.f); } };
struct EpiMoeDown { float* Y; const int* slot_a; const float* gate;
    __device__ __forceinline__ void operator()(int m, int n, float acc) const { const int a = slot_a[m]; if (a >= 0) Y[(size_t)a * D + n] = acc * gate[a]; } };

template <class Epi>
__device__ void n_gemm(float* sm, const float* A, int lda, const int* arow, const float* W, int ldw, size_t wstride, const int* tile_e,
                       int M, int N, int K, Epi epi) {
    float* As = sm;
    float* Bs = sm + 16 * 132;
    const int tid = threadIdx.x, ty = tid >> 5, tx = tid & 31;
    const int ntm = M / 128, ntn = (N + 255) / 256;
    for (int tile = blockIdx.x; tile < ntm * ntn; tile += gridDim.x) {
        const int mt = tile / ntn, nt = tile % ntn;
        const float* Wb = W;
        if (tile_e) { const int e = tile_e[mt]; if (e < 0) continue; Wb = W + (size_t)e * wstride; }
        const int m0 = mt * 128, n0 = nt * 256;
        float acc[8][8];
#pragma unroll
        for (int i = 0; i < 8; ++i)
#pragma unroll
            for (int j = 0; j < 8; ++j) acc[i][j] = 0.f;
        const int ar = tid >> 2, akq = (tid & 3) * 4;
        const int srow = arow ? arow[m0 + ar] : (m0 + ar);
        const float* ap = srow >= 0 ? A + (size_t)srow * lda : nullptr;
        const int bk = tid >> 6, bn = (tid & 63) * 4;
        for (int k0 = 0; k0 < K; k0 += 16) {
            float4 av = ap ? *(const float4*)(ap + k0 + akq) : make_float4(0.f, 0.f, 0.f, 0.f);
            As[(akq + 0) * 132 + ar] = av.x; As[(akq + 1) * 132 + ar] = av.y; As[(akq + 2) * 132 + ar] = av.z; As[(akq + 3) * 132 + ar] = av.w;
#pragma unroll
            for (int i = 0; i < 2; ++i) {
                const int kk = bk + 8 * i; const int n = n0 + bn;
                float4 bv = (n < N) ? *(const float4*)(Wb + (size_t)(k0 + kk) * ldw + n) : make_float4(0.f, 0.f, 0.f, 0.f);
                *(float4*)(Bs + kk * 260 + bn) = bv;
            }
            __syncthreads();
#pragma unroll
            for (int kk = 0; kk < 16; ++kk) {
                float a[8], b[8];
                *(float4*)(a) = *(const float4*)(As + kk * 132 + ty * 8); *(float4*)(a + 4) = *(const float4*)(As + kk * 132 + ty * 8 + 4);
                *(float4*)(b) = *(const float4*)(Bs + kk * 260 + tx * 8); *(float4*)(b + 4) = *(const float4*)(Bs + kk * 260 + tx * 8 + 4);
#pragma unroll
                for (int i = 0; i < 8; ++i)
#pragma unroll
                    for (int j = 0; j < 8; ++j) acc[i][j] = fmaf(a[i], b[j], acc[i][j]);
            }
            __syncthreads();
        }
#pragma unroll
        for (int i = 0; i < 8; ++i)
#pragma unroll
            for (int j = 0; j < 8; ++j) { const int m = m0 + ty * 8 + i, n = n0 + tx * 8 + j; if (n < N) epi(m, n, acc[i][j]); }
    }
}

__device__ void n_glu(const float* u, float* g) {
    const size_t gi = (size_t)blockIdx.x * blockDim.x + threadIdx.x, gs = (size_t)gridDim.x * blockDim.x;
    for (size_t i = gi; i < (size_t)T * D; i += gs) { const size_t t = i >> 10, c = i & 1023; g[i] = u[t * 2048 + c] * sigmoidf_(u[t * 2048 + 1024 + c]); }
}
__device__ void n_dwconv(const float* g, const float* wdw, const float* bdw, const float* lng, const float* lnb, float* out) {
    const int lane = threadIdx.x & 63;
    const int gw = (blockIdx.x * blockDim.x + threadIdx.x) >> 6, ngw = (gridDim.x * blockDim.x) >> 6;
    for (int t = gw; t < T; t += ngw) {
        const int s = t % S;
        float4 acc[4];
#pragma unroll
        for (int j = 0; j < 4; ++j) acc[j] = ((const float4*)bdw)[lane + 64 * j];
        for (int tap = 0; tap < CONVK; ++tap) {
            const int ss = s - (CONVK - 1) + tap; if (ss < 0) continue;
            const float4* gr = (const float4*)(g + (size_t)(t - (CONVK - 1) + tap) * D);
            const float4* wr = (const float4*)(wdw + (size_t)tap * D);
#pragma unroll
            for (int j = 0; j < 4; ++j) { const float4 a = gr[lane + 64 * j], w = wr[lane + 64 * j];
                acc[j].x = fmaf(a.x, w.x, acc[j].x); acc[j].y = fmaf(a.y, w.y, acc[j].y); acc[j].z = fmaf(a.z, w.z, acc[j].z); acc[j].w = fmaf(a.w, w.w, acc[j].w); }
        }
        float sm_ = 0.f;
#pragma unroll
        for (int j = 0; j < 4; ++j) sm_ += acc[j].x + acc[j].y + acc[j].z + acc[j].w;
        const float mu = wave_sum(sm_) * (1.0f / D);
        float q = 0.f;
#pragma unroll
        for (int j = 0; j < 4; ++j) { acc[j].x -= mu; acc[j].y -= mu; acc[j].z -= mu; acc[j].w -= mu; q += acc[j].x * acc[j].x + acc[j].y * acc[j].y + acc[j].z * acc[j].z + acc[j].w * acc[j].w; }
        const float rstd = rsqrtf(wave_sum(q) * (1.0f / D) + EPS);
        float4* o = (float4*)(out + (size_t)t * D);
#pragma unroll
        for (int j = 0; j < 4; ++j) { const float4 gg = ((const float4*)lng)[lane + 64 * j], bb = ((const float4*)lnb)[lane + 64 * j];
            o[lane + 64 * j] = make_float4(siluf_(acc[j].x * rstd * gg.x + bb.x), siluf_(acc[j].y * rstd * gg.y + bb.y), siluf_(acc[j].z * rstd * gg.z + bb.z), siluf_(acc[j].w * rstd * gg.w + bb.w)); }
    }
}
__device__ void n_attn(const float* q, const float* kv, float* o) {
    const int lane = threadIdx.x & 63;
    const int gw = (blockIdx.x * blockDim.x + threadIdx.x) >> 6, ngw = (gridDim.x * blockDim.x) >> 6;
    for (int it = gw; it < T * XH; it += ngw) {
        const int t = it >> 2, h = it & 3, b = t / S;
        const float4 qv = ((const float4*)(q + (size_t)t * D + h * XHD))[lane];
        const float* kb = kv + (size_t)b * NMEM * 2048 + h * XHD;
        float sc[4];
#pragma unroll
        for (int m4 = 0; m4 < 4; ++m4) {
            float mine = 0.f;
            for (int ml = 0; ml < 64; ++ml) {
                const float4 kk = ((const float4*)(kb + (size_t)(m4 * 64 + ml) * 2048))[lane];
                float p = qv.x * kk.x + qv.y * kk.y + qv.z * kk.z + qv.w * kk.w;
                p = wave_sum(p);
                if (ml == lane) mine = p;
            }
            sc[m4] = mine * 0.0625f;
        }
        float mx = fmaxf(fmaxf(sc[0], sc[1]), fmaxf(sc[2], sc[3])); mx = wave_max(mx);
        float se = 0.f;
#pragma unroll
        for (int m4 = 0; m4 < 4; ++m4) { sc[m4] = expf(sc[m4] - mx); se += sc[m4]; }
        se = wave_sum(se); const float inv = 1.0f / se;
        float4 acc = make_float4(0.f, 0.f, 0.f, 0.f);
        const float* vb = kb + 1024;
#pragma unroll
        for (int m4 = 0; m4 < 4; ++m4)
            for (int ml = 0; ml < 64; ++ml) {
                const float p = __shfl(sc[m4], ml) * inv;
                const float4 vv = ((const float4*)(vb + (size_t)(m4 * 64 + ml) * 2048))[lane];
                acc.x = fmaf(p, vv.x, acc.x); acc.y = fmaf(p, vv.y, acc.y); acc.z = fmaf(p, vv.z, acc.z); acc.w = fmaf(p, vv.w, acc.w);
            }
        ((float4*)(o + (size_t)t * D + h * XHD))[lane] = acc;
    }
}
__device__ void n_moe_init(int* cnt, int* slot_tok, int* slot_a, int* tile_e) {
    const int gi = blockIdx.x * blockDim.x + threadIdx.x, gs = gridDim.x * blockDim.x;
    for (int i = gi; i < NSLOT; i += gs) { slot_tok[i] = -1; slot_a[i] = -1; }
    for (int i = gi; i < NSLOT / 128; i += gs) tile_e[i] = -1;
    if (gi < 32) cnt[gi] = 0;
}
__device__ void n_route(const float* h, const float* wg, const float* bg, const float* we, const float* be, int* eid, float* gate, int* pos, int* cnt) {
    const int lane = threadIdx.x & 63;
    const int gw = (blockIdx.x * blockDim.x + threadIdx.x) >> 6, ngw = (gridDim.x * blockDim.x) >> 6;
    for (int t = gw; t < T; t += ngw) {
        float hv[16];
#pragma unroll
        for (int j = 0; j < 16; ++j) hv[j] = h[(size_t)t * D + j * 64 + lane];
        float gl[4];
#pragma unroll
        for (int o = 0; o < 4; ++o) { float p = 0.f;
#pragma unroll
            for (int j = 0; j < 16; ++j) p = fmaf(hv[j], wg[(size_t)(j * 64 + lane) * NG + o], p);
            gl[o] = wave_sum(p) + bg[o]; }
        int gs = 0; float gm = gl[0];
#pragma unroll
        for (int o = 1; o < 4; ++o) if (gl[o] > gm) { gm = gl[o]; gs = o; }
        float se = 0.f;
#pragma unroll
        for (int o = 0; o < 4; ++o) se += expf(gl[o] - gm);
        const float pg = 1.0f / se;
        float el[8];
#pragma unroll
        for (int o = 0; o < 8; ++o) { float p = 0.f;
#pragma unroll
            for (int j = 0; j < 16; ++j) p = fmaf(hv[j], we[(size_t)(j * 64 + lane) * NE + gs * 8 + o], p);
            el[o] = wave_sum(p) + be[gs * 8 + o]; }
        float em = el[0];
#pragma unroll
        for (int o = 1; o < 8; ++o) em = fmaxf(em, el[o]);
        float pe[8], ps = 0.f;
#pragma unroll
        for (int o = 0; o < 8; ++o) { pe[o] = expf(el[o] - em); ps += pe[o]; }
#pragma unroll
        for (int o = 0; o < 8; ++o) pe[o] = pe[o] / ps;
        int i1 = 0; float p1 = pe[0];
#pragma unroll
        for (int o = 1; o < 8; ++o) if (pe[o] > p1) { p1 = pe[o]; i1 = o; }
        int i2 = -1; float p2 = -1.f;
#pragma unroll
        for (int o = 0; o < 8; ++o) if (o != i1 && pe[o] > p2) { p2 = pe[o]; i2 = o; }
        if (lane == 0) {
            const float den = p1 + p2;
            const int e1 = gs * 8 + i1, e2 = gs * 8 + i2;
            eid[2 * t] = e1; eid[2 * t + 1] = e2;
            gate[2 * t] = pg * p1 / den; gate[2 * t + 1] = pg * p2 / den;
            pos[2 * t] = atomicAdd(&cnt[e1], 1); pos[2 * t + 1] = atomicAdd(&cnt[e2], 1);
        }
    }
}
__device__ void n_moe_build(const int* eid, const int* pos, const int* cnt, int* slot_tok, int* slot_a, int* tile_e) {
    __shared__ int poff[33];
    if (threadIdx.x == 0) { int o = 0; for (int e = 0; e < 32; ++e) { poff[e] = o; o += (cnt[e] + 127) / 128 * 128; } poff[32] = o; }
    __syncthreads();
    const int gi = blockIdx.x * blockDim.x + threadIdx.x, gs = gridDim.x * blockDim.x;
    for (int a = gi; a < NA; a += gs) { const int e = eid[a]; const int sl = poff[e] + pos[a]; slot_tok[sl] = a >> 1; slot_a[sl] = a; }
    for (int mt = gi; mt < NSLOT / 128; mt += gs) { const int r = mt * 128; int e = -1; for (int k = 0; k < 32; ++k) if (r >= poff[k] && r < poff[k + 1]) e = k; tile_e[mt] = e; }
    __syncthreads();
}
__device__ void n_moe_act(float* g, const float* u) {
    const size_t gi = (size_t)blockIdx.x * blockDim.x + threadIdx.x, gs = (size_t)gridDim.x * blockDim.x;
    for (size_t i = gi; i < (size_t)NSLOT * DE / 4; i += gs) { float4 a = ((float4*)g)[i]; const float4 b = ((const float4*)u)[i];
        a.x = siluf_(a.x) * b.x; a.y = siluf_(a.y) * b.y; a.z = siluf_(a.z) * b.z; a.w = siluf_(a.w) * b.w; ((float4*)g)[i] = a; }
}
__device__ void n_moe_combine(float* x, const float* y) {
    const size_t gi = (size_t)blockIdx.x * blockDim.x + threadIdx.x, gs = (size_t)gridDim.x * blockDim.x;
    for (size_t i = gi; i < (size_t)T * D / 4; i += gs) { const size_t t = i >> 8, c = i & 255; float4 a = ((float4*)x)[i];
        const float4 y0 = ((const float4*)y)[(2 * t) * 256 + c], y1 = ((const float4*)y)[(2 * t + 1) * 256 + c];
        a.x += y0.x + y1.x; a.y += y0.y + y1.y; a.z += y0.z + y1.z; a.w += y0.w + y1.w; ((float4*)x)[i] = a; }
}
__device__ void n_gla_decay(const float* proj, const float* wa2, const float* ba, float* dec) {
    const size_t gi = (size_t)blockIdx.x * blockDim.x + threadIdx.x, gs = (size_t)gridDim.x * blockDim.x;
    for (size_t i = gi; i < (size_t)T * GDK; i += gs) { const size_t t = i >> 9; const int j = (int)(i & 511);
        float a = ba[j];
#pragma unroll
        for (int r = 0; r < GRANK; ++r) a = fmaf(proj[t * GLA_COLS + 2048 + r], wa2[r * GDK + j], a);
        const float ls = fminf(a, 0.f) - log1pf(expf(-fabsf(a)));
        dec[i] = expf(ls * (1.0f / 16.0f)); }
}
__device__ void n_gla_rec(float* proj, const float* dec) {
    const int gi = blockIdx.x * blockDim.x + threadIdx.x, gs = gridDim.x * blockDim.x;
    for (int it = gi; it < NB * GH * GDVH; it += gs) {
        const int col = it & 255, h = (it >> 8) & 3, b = it >> 10;
        float st[GDKH];
#pragma unroll
        for (int k = 0; k < GDKH; ++k) st[k] = 0.f;
        const float qs = 0.08838834764831845f;
        for (int s = 0; s < S; ++s) {
            const size_t t = (size_t)b * S + s;
            float* pr = proj + t * GLA_COLS;
            const float v = pr[1024 + h * GDVH + col];
            const float* qq = pr + h * GDKH; const float* kk = pr + 512 + h * GDKH; const float* dd = dec + t * GDK + h * GDKH;
            float o = 0.f;
#pragma unroll
            for (int k = 0; k < GDKH; ++k) { st[k] = fmaf(st[k], dd[k], kk[k] * v); o = fmaf(qq[k], st[k], o); }
            pr[1024 + h * GDVH + col] = o * qs;
        }
    }
}
__device__ void n_gla_norm(const float* proj, const float* ng, float* go) {
    const int lane = threadIdx.x & 63;
    const int gw = (blockIdx.x * blockDim.x + threadIdx.x) >> 6, ngw = (gridDim.x * blockDim.x) >> 6;
    for (int it = gw; it < T * GH; it += ngw) {
        const int t = it >> 2, h = it & 3;
        const float4 ov = ((const float4*)(proj + (size_t)t * GLA_COLS + 1024 + h * GDVH))[lane];
        const float4 rv = ((const float4*)(proj + (size_t)t * GLA_COLS + 2064 + h * GDVH))[lane];
        const float4 gg = ((const float4*)ng)[lane];
        float s = ov.x * ov.x + ov.y * ov.y + ov.z * ov.z + ov.w * ov.w; s = wave_sum(s);
        const float rs = rsqrtf(s * (1.0f / GDVH) + EPS);
        ((float4*)(go + (size_t)t * D + h * GDVH))[lane] = make_float4(ov.x * rs * gg.x * siluf_(rv.x), ov.y * rs * gg.y * siluf_(rv.y), ov.z * rs * gg.z * siluf_(rv.z), ov.w * rs * gg.w * siluf_(rv.w));
    }
}

#define LAS __attribute__((address_space(3)))
typedef unsigned short bf16_t;
typedef short bf16x8 __attribute__((ext_vector_type(8)));
typedef float f32x4 __attribute__((ext_vector_type(4)));
typedef float f32x2 __attribute__((ext_vector_type(2)));
typedef unsigned u32x4 __attribute__((ext_vector_type(4)));
typedef unsigned u32x2 __attribute__((ext_vector_type(2)));

constexpr int LDS_BYTES = 160 * 1024;
constexpr int NSLOT2 = NA + NE * 256;
constexpr int MAXRT = NSLOT2 / 256;
constexpr size_t OW_XB = 0;
constexpr size_t OW_SSP = 64 * MiB;
constexpr size_t OW_RS = 66 * MiB;
constexpr size_t OW_PSUM = 67 * MiB;
constexpr size_t OW_MOE = 69 * MiB;
constexpr size_t OW_ACTA = 72 * MiB, OW_ACTB = 136 * MiB, OW_ACTC = 200 * MiB;
constexpr size_t OW_H = 72 * MiB, OW_Y = 144 * MiB, OW_WMOE = 272 * MiB;
constexpr size_t OW_KVB = 368 * MiB;
constexpr size_t OW_MEMNB = 372 * MiB;
constexpr size_t OW_WCIN = 550 * MiB, OW_WCOUT = 554 * MiB, OW_WXQ = 556 * MiB, OW_WXKV = 560 * MiB, OW_WXO = 568 * MiB, OW_WR = 572 * MiB, OW_END = 573 * MiB;
constexpr size_t OM_GCNT = OW_MOE, OM_NT = OW_MOE + 256, OM_TILEE = OW_MOE + 512, OM_AE = OW_MOE + 4096, OM_APOS = OM_AE + NA * 4, OM_GATE = OM_APOS + NA * 4,
                 OM_STOK = OM_GATE + NA * 4, OM_SA = OM_STOK + NSLOT2 * 4, OM_SRS = OM_SA + NSLOT2 * 4, OM_SGATE = OM_SRS + NSLOT2 * 4, OM_END = OM_SGATE + NSLOT2 * 4;
static_assert(OM_END <= OW_ACTA, "MoE small arrays");

__device__ __forceinline__ unsigned cvt_pk_bf16(float lo, float hi) { unsigned r; asm volatile("v_cvt_pk_bf16_f32 %0, %1, %2" : "=v"(r) : "v"(lo), "v"(hi)); return r; }
__device__ __forceinline__ int otid() { int t = threadIdx.x; asm volatile("" : "+v"(t)); return t; }
__device__ __forceinline__ u32x4 pack8(const f32x4& a, const f32x4& b) { u32x4 w; w.x = cvt_pk_bf16(a[0], a[1]); w.y = cvt_pk_bf16(a[2], a[3]); w.z = cvt_pk_bf16(b[0], b[1]); w.w = cvt_pk_bf16(b[2], b[3]); return w; }
__device__ __forceinline__ float bf_lo(unsigned w) { return __uint_as_float(w << 16); }
__device__ __forceinline__ float bf_hi(unsigned w) { return __uint_as_float(w & 0xffff0000u); }
__device__ __forceinline__ float fast_sigmoid(float x) { return __builtin_amdgcn_rcpf(1.0f + __builtin_amdgcn_exp2f(-1.4426950408889634f * x)); }

namespace g8 {
constexpr int BM = 256, BK = 64, HALF = 128, HTB = HALF * BK * 2, STAGE_BYTES = 8 * HTB;
__device__ __forceinline__ int lds_byte(int r, int c) { const int st = (r >> 4) * 2 + (c >> 5), rr = r & 15, cc = c & 31, ob = rr * 64 + cc * 2; return st * 1024 + (ob ^ (((ob >> 9) & 1) << 5)); }
__device__ __forceinline__ void stage_rc(int b, int& R, int& C) { const int st = b / 1024, sb = b % 1024, swz = sb ^ (((sb >> 9) & 1) << 5); R = (st >> 1) * 16 + swz / 64; C = (st & 1) * 32 + (swz % 64) / 2; }
__device__ __forceinline__ int perm32(int rho) { const int n = rho >> 4, i = rho & 15; return 8 * (i >> 2) + 4 * n + (i & 3); }
struct Unit { int pm, pn, e; };

template <class Epi, class Sched>
__device__ __forceinline__ void gemm_phase(LAS unsigned char* lds, const Sched& S, const Epi& E) {
    int tid_ = threadIdx.x; asm volatile("" : "+v"(tid_));
    const int tid = tid_, wid = __builtin_amdgcn_readfirstlane(tid >> 6), lane = tid & 63, wr = wid >> 2, wc = wid & 3, fr = lane & 15, fq = lane >> 4;
    const int K = S.K, lda = S.lda, ldb = S.ldb, nt = K / BK;
    int Rr[2], Cc[2]; unsigned voffB[2];
#pragma unroll
    for (int i = 0; i < 2; ++i) { int R, C; stage_rc(tid * 16 + i * 8192, R, C); Rr[i] = R; Cc[i] = C; const int Rb = (R & ~31) + perm32(R & 31); voffB[i] = (unsigned)(Rb * ldb + C) * 2u; }
    const size_t kstep = (size_t)(BK * 2);
    const size_t hstepB = (size_t)HALF * ldb * 2;
    const unsigned ldsw = (unsigned)wid * 1024u;
    const int aoff = lds_byte(wr * 64 + fr, fq * 8), boff = lds_byte(wc * 32 + fr, fq * 8);
#define G8_SA(b, h) (((b) * 2 + (h)) * HTB)
#define G8_SB(b, h) ((4 + (b) * 2 + (h)) * HTB)
#define G8_STAGEA(bufoff, gbase, vv) do { _Pragma("unroll") for (int _i = 0; _i < 2; ++_i) \
        __builtin_amdgcn_global_load_lds((const unsigned*)((const char*)(gbase) + (vv)[_i]), (LAS unsigned*)(lds + (bufoff) + ldsw + _i * 8192), 16, 0, 0); } while (0)
#define G8_STAGEB(bufoff, gbase) do { _Pragma("unroll") for (int _i = 0; _i < 2; ++_i) \
        __builtin_amdgcn_global_load_lds((const unsigned*)((const char*)(gbase) + voffB[_i]), (LAS unsigned*)(lds + (bufoff) + ldsw + _i * 8192), 16, 0, 0); } while (0)
#define G8_LDA(dst, b, h) do { _Pragma("unroll") for (int m = 0; m < 4; ++m) _Pragma("unroll") for (int k = 0; k < 2; ++k) dst[m][k] = *(const LAS bf16x8*)(lds + G8_SA(b, h) + aoff + m * 2048 + k * 1024); } while (0)
#define G8_LDB(dst, b, h) do { _Pragma("unroll") for (int n = 0; n < 2; ++n) _Pragma("unroll") for (int k = 0; k < 2; ++k) dst[n][k] = *(const LAS bf16x8*)(lds + G8_SB(b, h) + boff + n * 2048 + k * 1024); } while (0)
#define G8_MMA(ai, bj, At, Bt) do { __builtin_amdgcn_s_setprio(1); _Pragma("unroll") for (int m = 0; m < 4; ++m) _Pragma("unroll") for (int n = 0; n < 2; ++n) _Pragma("unroll") for (int k = 0; k < 2; ++k) \
        acc[ai][bj][m][n] = __builtin_amdgcn_mfma_f32_16x16x32_bf16(Bt[n][k], At[m][k], acc[ai][bj][m][n], 0, 0, 0); __builtin_amdgcn_s_setprio(0); } while (0)
#define G8_WAIT_V(n) asm volatile("s_waitcnt vmcnt(" #n ")" ::: "memory")
#define G8_WAIT_L(n) asm volatile("s_waitcnt lgkmcnt(" #n ")" ::: "memory")
#define G8_BAR __builtin_amdgcn_s_barrier()
#define G8_SCHED __builtin_amdgcn_sched_barrier(0)
#define G8_VA(dst, u) do { const int _ac = S.a_col(u); _Pragma("unroll") for (int _h = 0; _h < 2; ++_h) _Pragma("unroll") for (int _i = 0; _i < 2; ++_i) \
        dst[_h][_i] = (unsigned)(((size_t)S.a_row(u, _h * HALF + Rr[_i]) * lda + _ac + Cc[_i]) * 2); } while (0)
    Unit cur, nxt; int ui = 0;
    if (!S.next(0, cur)) return;
    f32x4 acc[2][2][4][2];
#pragma unroll
    for (int a = 0; a < 2; ++a)
#pragma unroll
        for (int b = 0; b < 2; ++b)
#pragma unroll
            for (int m = 0; m < 4; ++m)
#pragma unroll
                for (int n = 0; n < 2; ++n) acc[a][b][m][n] = (f32x4){0.f, 0.f, 0.f, 0.f};
    bf16x8 At[4][2], B0[2][2], B1[2][2];
    unsigned va[2][2], nva[2][2];
    G8_VA(va, cur);
    const char* Ab = S.a_base(cur);
    const char* cB = S.b_base(cur);
    G8_STAGEB(G8_SB(0, 0), cB); G8_STAGEA(G8_SA(0, 0), Ab, va[0]); G8_STAGEB(G8_SB(0, 1), cB + hstepB); G8_STAGEA(G8_SA(0, 1), Ab, va[1]);
    if (wr == 1) G8_BAR;
    G8_WAIT_V(4); G8_BAR;
    G8_STAGEB(G8_SB(1, 0), cB + kstep); G8_STAGEA(G8_SA(1, 0), Ab + kstep, va[0]); G8_STAGEB(G8_SB(1, 1), cB + hstepB + kstep);
    G8_WAIT_V(6); G8_BAR;
    for (;;) {
        const bool has_next = S.next(ui + 1, nxt);
        const char* nB = cB; const char* nAb = Ab;
        if (has_next) { nB = S.b_base(nxt); nAb = S.a_base(nxt); G8_VA(nva, nxt); }
        else {
#pragma unroll
            for (int h = 0; h < 2; ++h)
#pragma unroll
                for (int i = 0; i < 2; ++i) nva[h][i] = va[h][i];
        }
        for (int t = 0; t < nt; t += 2) {
            const bool last = (t == nt - 2);
            const char* a1 = Ab + (size_t)(t + 1) * kstep;
            const char* a2 = last ? nAb : Ab + (size_t)(t + 2) * kstep;
            const char* b2 = last ? nB : cB + (size_t)(t + 2) * kstep;
            const char* a3 = a2 + kstep; const char* b3 = b2 + kstep;
            unsigned v2[2][2];
#pragma unroll
            for (int h = 0; h < 2; ++h)
#pragma unroll
                for (int i = 0; i < 2; ++i) v2[h][i] = last ? nva[h][i] : va[h][i];
            G8_LDB(B0, 0, 0); G8_SCHED; G8_LDA(At, 0, 0); G8_STAGEA(G8_SA(1, 1), a1, va[1]);
            G8_WAIT_L(8); G8_BAR; G8_WAIT_L(0); G8_MMA(0, 0, At, B0); G8_BAR; G8_SCHED;
            G8_LDB(B1, 0, 1); G8_STAGEB(G8_SB(0, 0), b2);
            G8_BAR; G8_WAIT_L(0); G8_MMA(0, 1, At, B1); G8_BAR;
            G8_LDA(At, 0, 1); G8_STAGEA(G8_SA(0, 0), a2, v2[0]);
            G8_BAR; G8_WAIT_L(0); G8_MMA(1, 0, At, B0); G8_BAR; G8_SCHED;
            G8_STAGEB(G8_SB(0, 1), b2 + hstepB);
            G8_WAIT_V(6); G8_BAR; G8_MMA(1, 1, At, B1); G8_BAR;
            G8_LDB(B0, 1, 0); G8_SCHED; G8_LDA(At, 1, 0); G8_STAGEA(G8_SA(0, 1), a2, v2[1]);
            G8_WAIT_L(8); G8_BAR; G8_WAIT_L(0); G8_MMA(0, 0, At, B0); G8_BAR; G8_SCHED;
            G8_LDB(B1, 1, 1); G8_STAGEB(G8_SB(1, 0), b3);
            G8_BAR; G8_WAIT_L(0); G8_MMA(0, 1, At, B1); G8_BAR;
            G8_LDA(At, 1, 1); G8_STAGEA(G8_SA(1, 0), a3, v2[0]);
            G8_BAR; G8_WAIT_L(0); G8_MMA(1, 0, At, B0); G8_BAR; G8_SCHED;
            G8_STAGEB(G8_SB(1, 1), b3 + hstepB);
            G8_WAIT_V(6); G8_BAR; G8_MMA(1, 1, At, B1); G8_BAR;
        }
        E(acc, cur, wr, wc, fr, fq);
        if (!has_next) break;
#pragma unroll
        for (int a = 0; a < 2; ++a)
#pragma unroll
            for (int b = 0; b < 2; ++b)
#pragma unroll
                for (int m = 0; m < 4; ++m)
#pragma unroll
                    for (int n = 0; n < 2; ++n) acc[a][b][m][n] = (f32x4){0.f, 0.f, 0.f, 0.f};
        cur = nxt; cB = nB; Ab = nAb; ++ui;
#pragma unroll
        for (int h = 0; h < 2; ++h)
#pragma unroll
            for (int i = 0; i < 2; ++i) va[h][i] = nva[h][i];
    }
    G8_WAIT_V(0);
    if (wr == 0) G8_BAR;
    G8_BAR;
#undef G8_SA
#undef G8_SB
#undef G8_STAGEA
#undef G8_STAGEB
#undef G8_LDA
#undef G8_LDB
#undef G8_MMA
#undef G8_WAIT_V
#undef G8_WAIT_L
#undef G8_BAR
#undef G8_SCHED
#undef G8_VA
}

struct DenseSched {
    int nN, nU, K, lda, ldb; const bf16_t* A; const bf16_t* Bt;
    __device__ __forceinline__ const char* a_base(const Unit&) const { return (const char*)A; }
    __device__ __forceinline__ bool next(int i, Unit& u) const {
        const int c = blockIdx.x, per = gridDim.x >> 3, x = c & 7, j = c >> 3;
        const int chunk = (nU + 7) >> 3, lu = i * per + j;
        if (lu >= chunk) return false;
        const int un = x * chunk + lu; if (un >= nU) return false;
        u.pm = un / nN; u.pn = un - u.pm * nN; u.e = 0; return true; }
    __device__ __forceinline__ int a_row(const Unit& u, int r) const { return u.pm * BM + r; }
    __device__ __forceinline__ int a_col(const Unit&) const { return 0; }
    __device__ __forceinline__ const char* b_base(const Unit& u) const { return (const char*)(Bt + (size_t)u.pn * BM * ldb); }
};

struct EpiGlu {
    bf16_t* U; const float* rs; const float* bias;
    __device__ __forceinline__ void operator()(const f32x4 (&acc)[2][2][4][2], const Unit& u, int wr, int wc, int fr, int fq) const {
        const int c0 = u.pn * 128 + wc * 32 + 8 * fq;
        const f32x4 ba0 = *(const f32x4*)(bias + c0), ba1 = *(const f32x4*)(bias + c0 + 4), bg0 = *(const f32x4*)(bias + 1024 + c0), bg1 = *(const f32x4*)(bias + 1024 + c0 + 4);
#pragma unroll
        for (int ai = 0; ai < 2; ++ai)
#pragma unroll
            for (int m = 0; m < 4; ++m) {
                const int row = u.pm * BM + ai * HALF + wr * 64 + m * 16 + fr; const float r = rs[row];
                f32x4 o0, o1;
#pragma unroll
                for (int j = 0; j < 4; ++j) {
                    o0[j] = (acc[ai][0][m][0][j] * r + ba0[j]) * fast_sigmoid(acc[ai][1][m][0][j] * r + bg0[j]);
                    o1[j] = (acc[ai][0][m][1][j] * r + ba1[j]) * fast_sigmoid(acc[ai][1][m][1][j] * r + bg1[j]); }
                *(u32x4*)(U + (size_t)row * D + c0) = pack8(o0, o1);
            }
    }
};
struct EpiXres {
    const float* Xin; float* Xout; bf16_t* XB; const float* bias; float* ssp;
    __device__ __forceinline__ void operator()(const f32x4 (&acc)[2][2][4][2], const Unit& u, int wr, int wc, int fr, int fq) const {
#pragma unroll
        for (int ai = 0; ai < 2; ++ai)
#pragma unroll
            for (int m = 0; m < 4; ++m) {
                const int row = u.pm * BM + ai * HALF + wr * 64 + m * 16 + fr; float ss = 0.f;
#pragma unroll
                for (int bj = 0; bj < 2; ++bj) {
                    const int c0 = u.pn * BM + bj * HALF + wc * 32 + 8 * fq; const size_t off = (size_t)row * D + c0;
                    f32x4 v0 = *(const f32x4*)(Xin + off) + acc[ai][bj][m][0], v1 = *(const f32x4*)(Xin + off + 4) + acc[ai][bj][m][1];
                    if (bias) { v0 += *(const f32x4*)(bias + c0); v1 += *(const f32x4*)(bias + c0 + 4); }
                    *(f32x4*)(Xout + off) = v0; *(f32x4*)(Xout + off + 4) = v1;
                    *(u32x4*)(XB + off) = pack8(v0, v1);
                    ss += (v0[0] * v0[0] + v0[1] * v0[1]) + (v0[2] * v0[2] + v0[3] * v0[3]) + (v1[0] * v1[0] + v1[1] * v1[1]) + (v1[2] * v1[2] + v1[3] * v1[3]);
                }
                if (ssp) { ss += __shfl_xor(ss, 16); ss += __shfl_xor(ss, 32); if (fq == 0) ssp[(size_t)row * 16 + u.pn * 4 + wc] = ss; }
            }
    }
};

struct AttnSched {
    int K, lda, ldb; const bf16_t* A; const bf16_t* Bm; int pv;
    __device__ __forceinline__ bool next(int i, Unit& u) const {
        const int c = blockIdx.x, per = gridDim.x >> 3, x = c & 7, j = c >> 3;
        const int lu = i * per + j; if (lu >= 64) return false;
        const int un = x * 64 + lu, bh = un >> 5, qb = un & 31;
        u.pm = (bh >> 2) * 32 + qb; u.pn = 0; u.e = bh & 3; return true; }
    __device__ __forceinline__ const char* a_base(const Unit&) const { return (const char*)A; }
    __device__ __forceinline__ int a_row(const Unit& u, int r) const { return u.pm * BM + r; }
    __device__ __forceinline__ int a_col(const Unit& u) const { return u.e * 256; }
    __device__ __forceinline__ const char* b_base(const Unit& u) const { const int b = u.pm >> 5;
        return pv ? (const char*)(Bm + (size_t)(b * 4 + u.e) * 65536) : (const char*)(Bm + (size_t)(b * 256) * 1024 + u.e * 256); }
};
struct KVSched {
    int K, lda, ldb; const bf16_t* MEMNB; const bf16_t* WKV;
    __device__ __forceinline__ bool next(int i, Unit& u) const {
        const int un = i * (int)gridDim.x + (int)blockIdx.x; if (un >= 32) return false;
        u.e = un >> 4; u.pm = (un & 15) >> 2; u.pn = un & 3; return true; }
    __device__ __forceinline__ const char* a_base(const Unit& u) const { return u.e ? (const char*)(WKV + (size_t)1024 * 1024) : (const char*)MEMNB; }
    __device__ __forceinline__ int a_row(const Unit& u, int r) const { return u.pm * BM + r; }
    __device__ __forceinline__ int a_col(const Unit&) const { return 0; }
    __device__ __forceinline__ const char* b_base(const Unit& u) const { return u.e ? (const char*)(MEMNB + (size_t)u.pn * BM * 1024) : (const char*)(WKV + (size_t)u.pn * BM * 1024); }
};
__device__ __forceinline__ float ssp_rs(const float* ssp, int row) {
    const f32x4 a = *(const f32x4*)(ssp + (size_t)row * 16), b = *(const f32x4*)(ssp + (size_t)row * 16 + 4), c = *(const f32x4*)(ssp + (size_t)row * 16 + 8), d = *(const f32x4*)(ssp + (size_t)row * 16 + 12);
    const float s = ((a[0] + a[1]) + (a[2] + a[3])) + ((b[0] + b[1]) + (b[2] + b[3])) + ((c[0] + c[1]) + (c[2] + c[3])) + ((d[0] + d[1]) + (d[2] + d[3]));
    return rsqrtf(s * (1.0f / D) + EPS);
}
struct EpiRowScale {
    bf16_t* O; int ldo; const float* ssp; const float* rs; float scale; int qtiles; float qscale;
    __device__ __forceinline__ void operator()(const f32x4 (&acc)[2][2][4][2], const Unit& u, int wr, int wc, int fr, int fq) const {
        const float cs = scale * (u.pn < qtiles ? qscale : 1.0f);
#pragma unroll
        for (int ai = 0; ai < 2; ++ai)
#pragma unroll
            for (int m = 0; m < 4; ++m) {
                const int row = u.pm * BM + ai * HALF + wr * 64 + m * 16 + fr;
                const float r = (rs ? rs[row] : ssp_rs(ssp, row)) * cs;
#pragma unroll
                for (int bj = 0; bj < 2; ++bj) { const int c0 = u.pn * BM + bj * HALF + wc * 32 + 8 * fq;
                    *(u32x4*)(O + (size_t)row * ldo + c0) = pack8(acc[ai][bj][m][0] * r, acc[ai][bj][m][1] * r); }
            }
    }
};
struct EpiKV {
    bf16_t* Kb; bf16_t* VT;
    __device__ __forceinline__ void operator()(const f32x4 (&acc)[2][2][4][2], const Unit& u, int wr, int wc, int fr, int fq) const {
        bf16_t* base = u.e ? VT + (size_t)(u.pn * 4 + u.pm) * 65536 : Kb + (size_t)u.pm * BM * 1024 + u.pn * BM;
        const int ld = u.e ? 256 : 1024;
#pragma unroll
        for (int ai = 0; ai < 2; ++ai)
#pragma unroll
            for (int m = 0; m < 4; ++m) { const int r = ai * HALF + wr * 64 + m * 16 + fr;
#pragma unroll
                for (int bj = 0; bj < 2; ++bj) { const int c0 = bj * HALF + wc * 32 + 8 * fq;
                    *(u32x4*)(base + (size_t)r * ld + c0) = pack8(acc[ai][bj][m][0], acc[ai][bj][m][1]); } }
    }
};
struct EpiS {
    bf16_t* P; float* psum;
    __device__ __forceinline__ void operator()(const f32x4 (&acc)[2][2][4][2], const Unit& u, int wr, int wc, int fr, int fq) const {
#pragma unroll
        for (int ai = 0; ai < 2; ++ai)
#pragma unroll
            for (int m = 0; m < 4; ++m) {
                const int row = u.pm * BM + ai * HALF + wr * 64 + m * 16 + fr; float ps = 0.f;
#pragma unroll
                for (int bj = 0; bj < 2; ++bj) { const int c0 = u.e * 256 + bj * HALF + wc * 32 + 8 * fq;
                    f32x4 e0, e1;
#pragma unroll
                    for (int j = 0; j < 4; ++j) { e0[j] = __builtin_amdgcn_exp2f(acc[ai][bj][m][0][j] * 1.4426950408889634f); e1[j] = __builtin_amdgcn_exp2f(acc[ai][bj][m][1][j] * 1.4426950408889634f); }
                    const u32x4 w = pack8(e0, e1);
                    *(u32x4*)(P + (size_t)row * D + c0) = w;
                    ps += (bf_lo(w.x) + bf_hi(w.x)) + (bf_lo(w.y) + bf_hi(w.y)) + (bf_lo(w.z) + bf_hi(w.z)) + (bf_lo(w.w) + bf_hi(w.w)); }
                ps += __shfl_xor(ps, 16); ps += __shfl_xor(ps, 32);
                if (fq == 0) psum[(size_t)row * 16 + u.e * 4 + wc] = ps;
            }
    }
};
struct EpiPV {
    bf16_t* O; const float* psum;
    __device__ __forceinline__ void operator()(const f32x4 (&acc)[2][2][4][2], const Unit& u, int wr, int wc, int fr, int fq) const {
#pragma unroll
        for (int ai = 0; ai < 2; ++ai)
#pragma unroll
            for (int m = 0; m < 4; ++m) {
                const int row = u.pm * BM + ai * HALF + wr * 64 + m * 16 + fr;
                const f32x4 s4 = *(const f32x4*)(psum + (size_t)row * 16 + u.e * 4);
                const float inv = 1.0f / ((s4[0] + s4[1]) + (s4[2] + s4[3]));
#pragma unroll
                for (int bj = 0; bj < 2; ++bj) { const int c0 = u.e * 256 + bj * HALF + wc * 32 + 8 * fq;
                    *(u32x4*)(O + (size_t)row * D + c0) = pack8(acc[ai][bj][m][0] * inv, acc[ai][bj][m][1] * inv); }
            }
    }
};

__device__ __forceinline__ int ld_agent(const int* p) { return __hip_atomic_load(p, __ATOMIC_RELAXED, __HIP_MEMORY_SCOPE_AGENT); }
struct MoeSched {
    int K, lda, ldb; const bf16_t* A; const bf16_t* W; size_t wstride; const int* tile_e; const int* slot_tok; int NT;
    __device__ __forceinline__ bool next(int i, Unit& u) const {
        const int c = blockIdx.x, per = gridDim.x >> 3, x = c & 7, j = c >> 3;
        const int tpx = (NT + 7) >> 3, lu = i * per + j, lrt = lu >> 2;
        if (lrt >= tpx) return false;
        const int rt = x * tpx + lrt; if (rt >= NT) return false;
        u.pm = rt; u.pn = lu & 3; u.e = __builtin_amdgcn_readfirstlane(ld_agent(tile_e + rt)); return true; }
    __device__ __forceinline__ const char* a_base(const Unit&) const { return (const char*)A; }
    __device__ __forceinline__ int a_row(const Unit& u, int r) const { return slot_tok ? slot_tok[u.pm * BM + r] : u.pm * BM + r; }
    __device__ __forceinline__ int a_col(const Unit&) const { return 0; }
    __device__ __forceinline__ const char* b_base(const Unit& u) const { return (const char*)(W + (size_t)u.e * wstride + (size_t)u.pn * BM * ldb); }
};
struct EpiMoe1 {
    bf16_t* H; const float* slot_rs;
    __device__ __forceinline__ void operator()(const f32x4 (&acc)[2][2][4][2], const Unit& u, int wr, int wc, int fr, int fq) const {
        const int c0 = u.pn * 128 + wc * 32 + 8 * fq;
#pragma unroll
        for (int ai = 0; ai < 2; ++ai)
#pragma unroll
            for (int m = 0; m < 4; ++m) {
                const int row = u.pm * BM + ai * HALF + wr * 64 + m * 16 + fr; const float r = slot_rs[row];
                f32x4 o0, o1;
#pragma unroll
                for (int j = 0; j < 4; ++j) {
                    const float g0 = acc[ai][0][m][0][j] * r, g1 = acc[ai][0][m][1][j] * r;
                    o0[j] = g0 * fast_sigmoid(g0) * (acc[ai][1][m][0][j] * r);
                    o1[j] = g1 * fast_sigmoid(g1) * (acc[ai][1][m][1][j] * r); }
                *(u32x4*)(H + (size_t)row * DE + c0) = pack8(o0, o1);
            }
    }
};
struct EpiMoe2 {
    bf16_t* Y; const int* slot_a; const float* slot_gate;
    __device__ __forceinline__ void operator()(const f32x4 (&acc)[2][2][4][2], const Unit& u, int wr, int wc, int fr, int fq) const {
#pragma unroll
        for (int ai = 0; ai < 2; ++ai)
#pragma unroll
            for (int m = 0; m < 4; ++m) {
                const int row = u.pm * BM + ai * HALF + wr * 64 + m * 16 + fr; const int a = slot_a[row]; const float g = slot_gate[row];
                if (a >= 0) {
#pragma unroll
                    for (int bj = 0; bj < 2; ++bj) { const int c0 = u.pn * BM + bj * HALF + wc * 32 + 8 * fq;
                        *(u32x4*)(Y + (size_t)a * D + c0) = pack8(acc[ai][bj][m][0] * g, acc[ai][bj][m][1] * g); }
                }
            }
    }
};
}

__device__ __forceinline__ void cvt_item(const float* W, int ldw, int col0, int K, const float* g, bf16_t* Bt, int il, int half, LAS float* scr, int item, int nblk, int lane) {
    const int kb = item / nblk, nb = item - kb * nblk, k0 = 64 * kb, n0 = 32 * nb;
#pragma unroll 8
    for (int i = 0; i < 32; ++i) { const int kk = 2 * i + (lane >> 5); float v = W[(size_t)(k0 + kk) * ldw + col0 + n0 + (lane & 31)]; if (g) v *= g[k0 + kk]; scr[kk * 33 + (lane & 31)] = v; }
    asm volatile("s_waitcnt lgkmcnt(0)" ::: "memory");
    const int c = lane & 7;
#pragma unroll
    for (int j = 0; j < 4; ++j) { const int n = n0 + (lane >> 3) + 8 * j; const LAS float* s = scr + (8 * c) * 33 + (n - n0);
        u32x4 o; o.x = cvt_pk_bf16(s[0 * 33], s[1 * 33]); o.y = cvt_pk_bf16(s[2 * 33], s[3 * 33]); o.z = cvt_pk_bf16(s[4 * 33], s[5 * 33]); o.w = cvt_pk_bf16(s[6 * 33], s[7 * 33]);
        const int drow = il ? ((n >> 7) * 256 + half * 128 + (n & 127)) : n;
        *(u32x4*)(Bt + (size_t)drow * K + k0 + 8 * c) = o; }
    asm volatile("s_waitcnt lgkmcnt(0)" ::: "memory");
}
__device__ __forceinline__ void cvt_matrix(const float* W, int ldw, int col0, int ncols, int K, const float* g, bf16_t* Bt, int il, int half, LAS unsigned char* lds) {
    const int tix = otid();
    const int lane = tix & 63, wv = tix >> 6;
    LAS float* scr = (LAS float*)(lds + wv * 8704);
    const int gw = blockIdx.x * (blockDim.x >> 6) + wv, ngw = gridDim.x * (blockDim.x >> 6);
    const int nblk = ncols / 32, nitems = (K / 64) * nblk;
    for (int it = gw; it < nitems; it += ngw) cvt_item(W, ldw, col0, K, g, Bt, il, half, scr, it, nblk, lane);
}
__device__ __forceinline__ void rows_prep(const float* x, bf16_t* XB, float* rs, float* ssp, int rows) {
    const int tix = otid();
    const int lane = tix & 63;
    const int gw = (blockIdx.x * blockDim.x + tix) >> 6, ngw = (gridDim.x * blockDim.x) >> 6;
    for (int r = gw; r < rows; r += ngw) {
        const f32x4* xr = (const f32x4*)(x + (size_t)r * D);
        f32x4 v[4]; float s = 0.f;
#pragma unroll
        for (int j = 0; j < 4; ++j) { v[j] = xr[lane + 64 * j]; s += (v[j][0] * v[j][0] + v[j][1] * v[j][1]) + (v[j][2] * v[j][2] + v[j][3] * v[j][3]); }
        s = wave_sum(s);
        if (lane == 0) rs[r] = rsqrtf(s * (1.0f / D) + EPS);
        if (ssp && lane < 16) ssp[(size_t)r * 16 + lane] = lane == 0 ? s : 0.f;
        u32x2* o = (u32x2*)(XB + (size_t)r * D);
#pragma unroll
        for (int j = 0; j < 4; ++j) { u32x2 w; w.x = cvt_pk_bf16(v[j][0], v[j][1]); w.y = cvt_pk_bf16(v[j][2], v[j][3]); o[lane + 64 * j] = w; }
    }
}

__device__ __forceinline__ void rows_norm_bf16(const float* x, const float* g, bf16_t* out, int rows) {
    const int tix = otid();
    const int lane = tix & 63;
    const int gw = (blockIdx.x * blockDim.x + tix) >> 6, ngw = (gridDim.x * blockDim.x) >> 6;
    for (int r = gw; r < rows; r += ngw) {
        const f32x4* xr = (const f32x4*)(x + (size_t)r * D);
        f32x4 v[4]; float s = 0.f;
#pragma unroll
        for (int j = 0; j < 4; ++j) { v[j] = xr[lane + 64 * j]; s += (v[j][0] * v[j][0] + v[j][1] * v[j][1]) + (v[j][2] * v[j][2] + v[j][3] * v[j][3]); }
        s = wave_sum(s); const float rs = rsqrtf(s * (1.0f / D) + EPS);
        u32x2* o = (u32x2*)(out + (size_t)r * D);
#pragma unroll
        for (int j = 0; j < 4; ++j) { const f32x4 gg = ((const f32x4*)g)[lane + 64 * j]; u32x2 w; w.x = cvt_pk_bf16(v[j][0] * rs * gg[0], v[j][1] * rs * gg[1]); w.y = cvt_pk_bf16(v[j][2] * rs * gg[2], v[j][3] * rs * gg[3]); o[lane + 64 * j] = w; }
    }
}

__device__ __forceinline__ void route_prep(const float* wg, const float* we, const float* gain, float* WR) {
    const int tix = otid();
    const int gi = blockIdx.x * blockDim.x + tix, gs = gridDim.x * blockDim.x;
    for (int i = gi; i < 36 * 1024; i += gs) { const int j = i >> 10, k = i & 1023; WR[i] = (j < 32 ? we[k * NE + j] : wg[k * NG + (j - 32)]) * gain[k]; }
}
__device__ __forceinline__ float reduce16(float (&v)[18], int lane) {
#pragma unroll
    for (int st = 0; st < 4; ++st) { const int half = 8 >> st, bit = 32 >> st; const bool up = (lane & bit) != 0;
#pragma unroll
        for (int k = 0; k < half; ++k) { const float send = up ? v[k] : v[k + half]; const float keep = up ? v[k + half] : v[k]; v[k] = keep + __shfl_xor(send, bit); } }
    float r = v[0]; r += __shfl_xor(r, 2); r += __shfl_xor(r, 1); return r;
}
__device__ __forceinline__ float reduce2(const float (&v)[18], int lane) {
    const bool up = (lane & 32) != 0; const float send = up ? v[16] : v[17], keep = up ? v[17] : v[16];
    float r = keep + __shfl_xor(send, 32);
#pragma unroll
    for (int o = 16; o >= 1; o >>= 1) r += __shfl_xor(r, o);
    return r;
}
__device__ __forceinline__ void route_phase(const float* X, const float* WR, const float* bg, const float* be, float* RS, int* assign_e, int* assign_pos, float* gate, int* gcnt, LAS unsigned char* lds) {
    int tid_ = threadIdx.x; asm volatile("" : "+v"(tid_)); const int tid = tid_, lane = tid & 63, wv = tid >> 6;
    LAS float* Wr = (LAS float*)lds;
    LAS int* lcnt = (LAS int*)(lds + 36 * 4096); LAS int* lbase = lcnt + 32; LAS int* l_e = lbase + 32; LAS int* l_rank = l_e + 256;
    for (int i = tid; i < 36 * 256; i += 512) ((LAS f32x4*)Wr)[i] = ((const f32x4*)WR)[i];
    for (int tb = blockIdx.x; tb < T / 128; tb += gridDim.x) {
        if (tid < 32) lcnt[tid] = 0;
        __syncthreads();
#pragma unroll 1
        for (int it = 0; it < 8; ++it) {
            const int tl0 = wv * 16 + it * 2, t0 = tb * 128 + tl0;
            f32x4 xv[2][4]; float rsv[2];
#pragma unroll
            for (int r = 0; r < 2; ++r) { float s = 0.f;
#pragma unroll
                for (int c = 0; c < 4; ++c) { xv[r][c] = *(const f32x4*)(X + (size_t)(t0 + r) * D + 256 * c + 4 * lane); s += (xv[r][c][0] * xv[r][c][0] + xv[r][c][1] * xv[r][c][1]) + (xv[r][c][2] * xv[r][c][2] + xv[r][c][3] * xv[r][c][3]); }
                rsv[r] = rsqrtf(wave_sum(s) * (1.0f / D) + EPS); }
            LAS float* lg = (LAS float*)(lds + 36 * 4096 + 4096) + wv * 160;
#pragma unroll 1
            for (int q = 0; q < 4; ++q) {
                float acc[2][9];
#pragma unroll
                for (int r = 0; r < 2; ++r)
#pragma unroll
                    for (int j = 0; j < 9; ++j) acc[r][j] = 0.f;
                const unsigned be_ = (unsigned)(8 * q * 4096 + 16 * lane), bg_ = (unsigned)((32 + q) * 4096 + 16 * lane);
#pragma unroll
                for (int j = 0; j < 9; ++j) {
#pragma unroll
                    for (int c = 0; c < 4; ++c) {
                        const f32x4 w4 = j < 8 ? *(const LAS f32x4*)(lds + be_ + j * 4096 + c * 1024) : *(const LAS f32x4*)(lds + bg_ + c * 1024);
#pragma unroll
                        for (int r = 0; r < 2; ++r) acc[r][j] = fmaf(xv[r][c][3], w4[3], fmaf(xv[r][c][2], w4[2], fmaf(xv[r][c][1], w4[1], fmaf(xv[r][c][0], w4[0], acc[r][j])))); }
                    if (j % 3 == 2) __builtin_amdgcn_sched_barrier(0);
                }
#pragma unroll
                for (int r = 0; r < 2; ++r) {
                    const float g1 = wave_sum(acc[r][8]);
#pragma unroll
                    for (int st = 0; st < 3; ++st) { const int half = 4 >> st, bit = 32 >> st; const bool up = (lane & bit) != 0;
#pragma unroll
                        for (int k = 0; k < half; ++k) { const float send = up ? acc[r][k] : acc[r][k + half]; const float keep = up ? acc[r][k + half] : acc[r][k]; acc[r][k] = keep + __shfl_xor(send, bit); } }
                    float e8 = acc[r][0]; e8 += __shfl_xor(e8, 4); e8 += __shfl_xor(e8, 2); e8 += __shfl_xor(e8, 1);
                    if ((lane & 7) == 0) lg[r * 40 + 8 * q + (lane >> 3)] = e8;
                    if (lane == 0) lg[r * 40 + 32 + q] = g1;
                }
            }
            asm volatile("s_waitcnt lgkmcnt(0)" ::: "memory");
            {
                const int r = lane & 1; const LAS float* L = lg + r * 40;
                const float rs = r == 0 ? rsv[0] : rsv[1];
                float gl[4];
#pragma unroll
                for (int g = 0; g < 4; ++g) gl[g] = L[32 + g] * rs + bg[g];
                int gs = 0; float gm = gl[0];
#pragma unroll
                for (int g = 1; g < 4; ++g) if (gl[g] > gm) { gm = gl[g]; gs = g; }
                float se = 0.f;
#pragma unroll
                for (int g = 0; g < 4; ++g) se += expf(gl[g] - gm);
                const float pg = 1.0f / se;
                float el[8];
#pragma unroll
                for (int i = 0; i < 8; ++i) el[i] = L[gs * 8 + i] * rs + be[gs * 8 + i];
                float em = el[0];
#pragma unroll
                for (int i = 1; i < 8; ++i) em = fmaxf(em, el[i]);
                float pe[8], ps = 0.f;
#pragma unroll
                for (int i = 0; i < 8; ++i) { pe[i] = expf(el[i] - em); ps += pe[i]; }
#pragma unroll
                for (int i = 0; i < 8; ++i) pe[i] = pe[i] / ps;
                int i1 = 0; float p1 = pe[0];
#pragma unroll
                for (int i = 1; i < 8; ++i) if (pe[i] > p1) { p1 = pe[i]; i1 = i; }
                int i2 = -1; float p2 = -1.f;
#pragma unroll
                for (int i = 0; i < 8; ++i) if (i != i1 && pe[i] > p2) { p2 = pe[i]; i2 = i; }
                if (lane < 2) {
                    const int t = t0 + r, tl = tl0 + r; const float den = p1 + p2; const int e1 = gs * 8 + i1, e2 = gs * 8 + i2;
                    RS[t] = rs; gate[2 * t] = pg * p1 / den; gate[2 * t + 1] = pg * p2 / den;
                    l_e[2 * tl] = e1; l_e[2 * tl + 1] = e2;
                    l_rank[2 * tl] = atomicAdd((int*)(lcnt + e1), 1); l_rank[2 * tl + 1] = atomicAdd((int*)(lcnt + e2), 1);
                }
            }
        }
        __syncthreads();
        if (tid < 32) lbase[tid] = __hip_atomic_fetch_add(gcnt + tid, lcnt[tid], __ATOMIC_RELAXED, __HIP_MEMORY_SCOPE_AGENT);
        __syncthreads();
        if (tid < 256) { const int a = tb * 256 + tid, e = l_e[tid]; assign_e[a] = e; assign_pos[a] = lbase[e] + l_rank[tid]; }
        __syncthreads();
    }
}
__device__ __forceinline__ void build_phase(const int* gcnt, const int* assign_e, const int* assign_pos, const float* gate, const float* RS,
                                            int* ntiles, int* tile_e, int* slot_tok, int* slot_a, float* slot_rs, float* slot_gate, LAS unsigned char* lds) {
    const int tix = otid();
    LAS int* poff = (LAS int*)lds; LAS int* cn = poff + 40;
    if (tix == 0) { int o = 0; for (int e = 0; e < 32; ++e) { const int cc = g8::ld_agent(gcnt + e); cn[e] = cc; poff[e] = o; o += (cc + 255) / 256 * 256; } poff[32] = o; }
    __syncthreads();
    const int gi = blockIdx.x * blockDim.x + tix, gs = gridDim.x * blockDim.x;
    for (int a = gi; a < NA; a += gs) { const int e = assign_e[a]; const int sl = poff[e] + assign_pos[a]; slot_tok[sl] = a >> 1; slot_a[sl] = a; slot_rs[sl] = RS[a >> 1]; slot_gate[sl] = gate[a]; }
    for (int i = gi; i < 32 * 256; i += gs) { const int e = i >> 8, sl = poff[e] + cn[e] + (i & 255); if (sl < poff[e + 1]) { slot_tok[sl] = 0; slot_a[sl] = -1; slot_rs[sl] = 0.f; slot_gate[sl] = 0.f; } }
    if (blockIdx.x == 0) {
        const int NT = poff[32] >> 8;
        for (int rt = tix; rt < NT; rt += blockDim.x) { int e = 0; for (int k = 0; k < 32; ++k) if (rt * 256 >= poff[k] && rt * 256 < poff[k + 1]) e = k; tile_e[rt] = e; }
        if (tix == 0) *ntiles = NT;
    }
    __syncthreads();
}
__device__ __forceinline__ void cvt_moe(const float* wgate, const float* wup, const float* wdown, const float* gain, bf16_t* W1, bf16_t* W2, LAS unsigned char* lds) {
    const int tix = otid();
    const int lane = tix & 63, wv = tix >> 6;
    LAS float* scr = (LAS float*)(lds + 1024 + wv * 8704);
    const int gw = blockIdx.x * (blockDim.x >> 6) + wv, ngw = gridDim.x * (blockDim.x >> 6);
    for (int it = gw; it < 32 * 768; it += ngw) {
        const int e = it / 768, r = it - e * 768;
        if (r < 256) cvt_item(wgate + (size_t)e * D * DE, DE, 0, D, gain, W1 + (size_t)e * D * D, 1, 0, scr, r, 16, lane);
        else if (r < 512) cvt_item(wup + (size_t)e * D * DE, DE, 0, D, gain, W1 + (size_t)e * D * D, 1, 1, scr, r - 256, 16, lane);
        else cvt_item(wdown + (size_t)e * DE * D, D, 0, DE, nullptr, W2 + (size_t)e * D * DE, 0, 0, scr, r - 512, 32, lane);
    }
}
__device__ __forceinline__ void combine_phase(float* X, const bf16_t* Y, bf16_t* XB, float* RS, float* ssp, const float* gfinal, int fin) {
    const int tix = otid();
    const int lane = tix & 63;
    const int gw = (blockIdx.x * blockDim.x + tix) >> 6, ngw = (gridDim.x * blockDim.x) >> 6;
    for (int t = gw; t < T; t += ngw) {
        f32x4 v[4]; float s = 0.f;
#pragma unroll
        for (int j = 0; j < 4; ++j) {
            v[j] = ((const f32x4*)(X + (size_t)t * D))[lane + 64 * j];
            const u32x2 y0 = ((const u32x2*)(Y + (size_t)(2 * t) * D))[lane + 64 * j], y1 = ((const u32x2*)(Y + (size_t)(2 * t + 1) * D))[lane + 64 * j];
            v[j][0] += bf_lo(y0.x) + bf_lo(y1.x); v[j][1] += bf_hi(y0.x) + bf_hi(y1.x); v[j][2] += bf_lo(y0.y) + bf_lo(y1.y); v[j][3] += bf_hi(y0.y) + bf_hi(y1.y);
            s += (v[j][0] * v[j][0] + v[j][1] * v[j][1]) + (v[j][2] * v[j][2] + v[j][3] * v[j][3]); }
        s = wave_sum(s); const float rs = rsqrtf(s * (1.0f / D) + EPS);
        if (fin) {
#pragma unroll
            for (int j = 0; j < 4; ++j) { const f32x4 gg = ((const f32x4*)gfinal)[lane + 64 * j]; ((f32x4*)(X + (size_t)t * D))[lane + 64 * j] = v[j] * rs * gg; }
        } else {
            if (lane == 0) RS[t] = rs;
            if (lane < 16) ssp[(size_t)t * 16 + lane] = lane == 0 ? s : 0.f;
#pragma unroll
            for (int j = 0; j < 4; ++j) { ((f32x4*)(X + (size_t)t * D))[lane + 64 * j] = v[j];
                u32x2 w; w.x = cvt_pk_bf16(v[j][0], v[j][1]); w.y = cvt_pk_bf16(v[j][2], v[j][3]); ((u32x2*)(XB + (size_t)t * D))[lane + 64 * j] = w; }
        }
    }
}

__device__ __forceinline__ void conv_phase(const bf16_t* U, const float* wdw, const float* bdw, const float* lng, const float* lnb, bf16_t* CV, LAS unsigned char* lds) {
    int tid_ = threadIdx.x; asm volatile("" : "+v"(tid_));
    const int tid = tid_, lane = tid & 63, wv = tid >> 6, c0 = 2 * tid;
    LAS float* red = (LAS float*)lds; LAS float* tot = red + 512;
    f32x2 w[CONVK];
#pragma unroll
    for (int j = 0; j < CONVK; ++j) w[j] = *(const f32x2*)(wdw + j * D + c0);
    const f32x2 bd = *(const f32x2*)(bdw + c0), lg = *(const f32x2*)(lng + c0), lb = *(const f32x2*)(lnb + c0);
    for (int item = blockIdx.x; item < T / 32; item += gridDim.x) {
        const int t0 = item * 32, s0 = t0 & (S - 1);
        f32x2 acc[32];
#pragma unroll
        for (int o = 0; o < 32; ++o) acc[o] = bd;
#pragma unroll
        for (int r = 0; r < 62; ++r) {
            unsigned raw = 0u;
            if (s0 - 30 + r >= 0) raw = *(const unsigned*)(U + (size_t)(t0 - 30 + r) * D + c0);
            const f32x2 uv = (f32x2){bf_lo(raw), bf_hi(raw)};
#pragma unroll
            for (int o = (r > 30 ? r - 30 : 0); o <= (r < 31 ? r : 31); ++o) acc[o] = __builtin_elementwise_fma(uv, w[r - o], acc[o]);
        }
        float v[64];
#pragma unroll
        for (int o = 0; o < 32; ++o) { v[o] = acc[o][0] + acc[o][1]; v[32 + o] = acc[o][0] * acc[o][0] + acc[o][1] * acc[o][1]; }
#pragma unroll
        for (int st = 0; st < 6; ++st) {
            const int half = 32 >> st, bit = 32 >> st; const bool up = (lane & bit) != 0;
#pragma unroll
            for (int k = 0; k < half; ++k) { const float send = up ? v[k] : v[k + half]; const float keep = up ? v[k + half] : v[k]; v[k] = keep + __shfl_xor(send, bit); }
        }
        red[wv * 64 + lane] = v[0];
        __syncthreads();
        if (tid < 64) { float s = 0.f;
#pragma unroll
            for (int q = 0; q < 8; ++q) s += red[q * 64 + tid];
            tot[tid] = s; }
        __syncthreads();
#pragma unroll
        for (int o = 0; o < 32; ++o) {
            const float mu = tot[o] * (1.0f / D), var = tot[32 + o] * (1.0f / D) - mu * mu, rstd = rsqrtf(var + EPS);
            const float y0 = (acc[o][0] - mu) * rstd * lg[0] + lb[0], y1 = (acc[o][1] - mu) * rstd * lg[1] + lb[1];
            *(unsigned*)(CV + (size_t)(t0 + o) * D + c0) = cvt_pk_bf16(y0 * fast_sigmoid(y0), y1 * fast_sigmoid(y1));
        }
        __syncthreads();
    }
}

enum Ph { PH_PREP0 = 0, PH_CONV_IN, PH_CONV_MID, PH_CONV_OUT, PH_ADAPT, PH_XA_PREP, PH_XA_Q, PH_XA_KV, PH_XA_S, PH_XA_PV, PH_XA_O, PH_ROUTE_PREP, PH_ROUTE, PH_BUILD, PH_MOE1, PH_MOE2, PH_COMBINE, PH_COMBINE_FIN, PH_N };

__device__ __forceinline__ void run_phase(const Ctx& c, int ph, int l, LAS unsigned char* lds) {
    unsigned char* ws = c.ws;
    bf16_t* XB = (bf16_t*)(ws + OW_XB); float* RS = (float*)(ws + OW_RS); float* SSP = (float*)(ws + OW_SSP);
    bf16_t* ACTA = (bf16_t*)(ws + OW_ACTA); bf16_t* ACTB = (bf16_t*)(ws + OW_ACTB);
    bf16_t* WCIN = (bf16_t*)(ws + OW_WCIN); bf16_t* WCOUT = (bf16_t*)(ws + OW_WCOUT);
    bf16_t* ACTC = (bf16_t*)(ws + OW_ACTC); float* PSUM = (float*)(ws + OW_PSUM);
    bf16_t* WXQ = (bf16_t*)(ws + OW_WXQ) + (size_t)l * D * D; bf16_t* WXKV = (bf16_t*)(ws + OW_WXKV) + (size_t)l * 2048 * D; bf16_t* WXO = (bf16_t*)(ws + OW_WXO) + (size_t)l * D * D;
    float* WR = (float*)(ws + OW_WR) + (size_t)l * 36 * 1024;
    int* GCNT = (int*)(ws + OM_GCNT); int* NTP = (int*)(ws + OM_NT); int* TILEE = (int*)(ws + OM_TILEE); int* AE = (int*)(ws + OM_AE); int* APOS = (int*)(ws + OM_APOS); float* GATE = (float*)(ws + OM_GATE);
    int* STOK = (int*)(ws + OM_STOK); int* SA = (int*)(ws + OM_SA); float* SRS = (float*)(ws + OM_SRS); float* SGATE = (float*)(ws + OM_SGATE);
    bf16_t* HB = (bf16_t*)(ws + OW_H); bf16_t* YB = (bf16_t*)(ws + OW_Y); bf16_t* W1 = (bf16_t*)(ws + OW_WMOE); bf16_t* W2 = W1 + (size_t)NE * D * D;
    bf16_t* KB = (bf16_t*)(ws + OW_KVB); bf16_t* VT = KB + (size_t)1024 * 1024; bf16_t* MEMNB = (bf16_t*)(ws + OW_MEMNB);
    switch (ph) {
    case PH_PREP0:
        cvt_matrix(c.in[7], 2048, 0, 1024, D, c.in[2], WCIN, 1, 0, lds);
        cvt_matrix(c.in[7], 2048, 1024, 1024, D, c.in[2], WCIN, 1, 1, lds);
        cvt_matrix(c.in[13], D, 0, D, D, nullptr, WCOUT, 0, 0, lds);
        rows_prep(c.in[0], XB, RS, nullptr, T);
        break;
    case PH_CONV_IN: { g8::DenseSched S{8, 128 * 8, D, D, D, XB, WCIN}; g8::gemm_phase(lds, S, g8::EpiGlu{ACTA, RS, c.in[8]}); } break;
    case PH_CONV_MID: conv_phase(ACTA, c.in[9], c.in[10], c.in[11], c.in[12], ACTB, lds); break;
    case PH_CONV_OUT: { g8::DenseSched S{4, 128 * 4, D, D, D, ACTB, WCOUT}; g8::gemm_phase(lds, S, g8::EpiXres{c.in[0], c.out, XB, c.in[14], SSP}); } break;
    case PH_ADAPT: rows_prep(c.out, XB, RS, SSP, T); break;
    case PH_XA_PREP:
        cvt_matrix(c.in[20] + (size_t)l * D * D, D, 0, D, D, c.in[3] + l * D, WXQ, 0, 0, lds);
        cvt_matrix(c.in[21] + (size_t)l * D * 2048, 2048, 0, 2048, D, nullptr, WXKV, 0, 0, lds);
        cvt_matrix(c.in[22] + (size_t)l * D * D, D, 0, D, D, nullptr, WXO, 0, 0, lds);
        rows_norm_bf16(c.in[1], c.in[5], MEMNB, NB * NMEM);
        break;
    case PH_XA_Q: { g8::DenseSched S{4, 128 * 4, D, D, D, XB, WXQ}; g8::gemm_phase(lds, S, g8::EpiRowScale{ACTA, D, SSP, nullptr, 0.0625f, 0, 1.0f}); } break;
    case PH_XA_KV: { g8::KVSched S{D, D, D, MEMNB, WXKV}; g8::gemm_phase(lds, S, g8::EpiKV{KB, VT}); } break;
    case PH_XA_S: { g8::AttnSched S{256, D, D, ACTA, KB, 0}; g8::gemm_phase(lds, S, g8::EpiS{ACTB, PSUM}); } break;
    case PH_XA_PV: { g8::AttnSched S{256, D, 256, ACTB, VT, 1}; g8::gemm_phase(lds, S, g8::EpiPV{ACTC, PSUM}); } break;
    case PH_XA_O: { g8::DenseSched S{4, 128 * 4, D, D, D, ACTC, WXO}; g8::gemm_phase(lds, S, g8::EpiXres{c.out, c.out, XB, nullptr, nullptr}); } break;
    case PH_ROUTE_PREP: route_prep(c.in[23] + (size_t)l * D * NG, c.in[25] + (size_t)l * D * NE, c.in[4] + l * D, WR);
        { const int tix = otid(); if (blockIdx.x == 0 && tix < 32) GCNT[tix] = 0; }
        break;
    case PH_ROUTE: route_phase(c.out, WR, c.in[24] + l * NG, c.in[26] + l * NE, RS, AE, APOS, GATE, GCNT, lds); break;
    case PH_BUILD: build_phase(GCNT, AE, APOS, GATE, RS, NTP, TILEE, STOK, SA, SRS, SGATE, lds);
        cvt_moe(c.in[27] + (size_t)l * NE * D * DE, c.in[28] + (size_t)l * NE * D * DE, c.in[29] + (size_t)l * NE * DE * D, c.in[4] + l * D, W1, W2, lds);
        break;
    case PH_MOE1: { g8::MoeSched S{D, D, D, XB, W1, (size_t)D * D, TILEE, STOK, __builtin_amdgcn_readfirstlane(g8::ld_agent(NTP))}; g8::gemm_phase(lds, S, g8::EpiMoe1{HB, SRS}); } break;
    case PH_MOE2: { g8::MoeSched S{DE, DE, DE, HB, W2, (size_t)D * DE, TILEE, nullptr, __builtin_amdgcn_readfirstlane(g8::ld_agent(NTP))}; g8::gemm_phase(lds, S, g8::EpiMoe2{YB, SA, SGATE}); } break;
    case PH_COMBINE: combine_phase(c.out, YB, XB, RS, SSP, nullptr, 0); break;
    case PH_COMBINE_FIN: combine_phase(c.out, YB, XB, RS, SSP, c.in[6], 1); break;
    }
}
template <int PH> __global__ void __launch_bounds__(512, 2) k_opt(Ctx c, int l) {
    extern __shared__ __attribute__((aligned(16))) unsigned char dynlds[];
    run_phase(c, PH, l, (LAS unsigned char*)dynlds);
}
#ifndef COOP
#define COOP 1
#endif
enum Op { OP_MEMN = 0, OP_MEMKV, OP_COPYX, OP_RMS_MIX, OP_CONV_IN, OP_GLU, OP_DWCONV, OP_CONV_OUT, OP_GLA_IN, OP_GLA_DECAY, OP_GLA_REC, OP_GLA_NORM, OP_GLA_OUT,
          OP_RMS_XA, OP_XA_Q, OP_XA_ATT, OP_XA_O, OP_RMS_FFN, OP_ROUTE, OP_BUILD, OP_MOE_GATE, OP_MOE_UP, OP_MOE_ACT, OP_MOE_DOWN, OP_MOE_COMBINE, OP_FINAL };

__device__ __forceinline__ void run_op(const Ctx& c, int op, int l, float* sm) {
    unsigned char* ws = c.ws;
    float* HN = (float*)(ws + WS_HN); float* BIG = (float*)(ws + WS_BIG);
    float* MEMN = (float*)(ws + WS_MEMN); float* KV = (float*)(ws + WS_KV) + (size_t)l * 1024 * 2048;
    int* eid = (int*)(ws + WS_EID); float* gate = (float*)(ws + WS_GATE); int* pos = (int*)(ws + WS_POS);
    int* slot_tok = (int*)(ws + WS_SLOTTOK); int* slot_a = (int*)(ws + WS_SLOTA); int* tile_e = (int*)(ws + WS_TILEE); int* cnt = (int*)(ws + WS_CNT);
    float* X = c.out;
    switch (op) {
    case OP_MEMN: n_rms(c.in[1], c.in[5], MEMN, NB * NMEM); break;
    case OP_MEMKV: n_gemm(sm, MEMN, D, nullptr, c.in[21] + (size_t)l * D * 2048, 2048, 0, nullptr, NB * NMEM, 2048, D, EpiStore{KV, 2048, nullptr}); break;
    case OP_COPYX: n_copy4(c.in[0], X, (size_t)T * D / 4); break;
    case OP_RMS_MIX: n_rms(X, c.in[2] + l * D, HN, T); break;
    case OP_CONV_IN: n_gemm(sm, HN, D, nullptr, c.in[7], 2048, 0, nullptr, T, 2048, D, EpiStore{BIG, 2048, c.in[8]}); break;
    case OP_GLU: n_glu(BIG, HN); break;
    case OP_DWCONV: n_dwconv(HN, c.in[9], c.in[10], c.in[11], c.in[12], BIG); break;
    case OP_CONV_OUT: n_gemm(sm, BIG, D, nullptr, c.in[13], D, 0, nullptr, T, D, D, EpiResid{X, D, c.in[14]}); break;
    case OP_GLA_IN: n_gemm(sm, HN, D, nullptr, c.in[15], GLA_COLS, 0, nullptr, T, GLA_COLS, D, EpiStore{BIG, GLA_COLS, nullptr}); break;
    case OP_GLA_DECAY: n_gla_decay(BIG, c.in[16], c.in[17], HN); break;
    case OP_GLA_REC: n_gla_rec(BIG, HN); break;
    case OP_GLA_NORM: n_gla_norm(BIG, c.in[18], HN); break;
    case OP_GLA_OUT: n_gemm(sm, HN, D, nullptr, c.in[19], D, 0, nullptr, T, D, D, EpiResid{X, D, nullptr}); break;
    case OP_RMS_XA: n_rms(X, c.in[3] + l * D, HN, T); break;
    case OP_XA_Q: n_gemm(sm, HN, D, nullptr, c.in[20] + (size_t)l * D * D, D, 0, nullptr, T, D, D, EpiStore{BIG, D, nullptr}); break;
    case OP_XA_ATT: n_attn(BIG, KV, BIG + (size_t)T * D); break;
    case OP_XA_O: n_gemm(sm, BIG + (size_t)T * D, D, nullptr, c.in[22] + (size_t)l * D * D, D, 0, nullptr, T, D, D, EpiResid{X, D, nullptr}); break;
    case OP_RMS_FFN: n_rms(X, c.in[4] + l * D, HN, T); n_moe_init(cnt, slot_tok, slot_a, tile_e); break;
    case OP_ROUTE: n_route(HN, c.in[23] + (size_t)l * D * NG, c.in[24] + l * NG, c.in[25] + (size_t)l * D * NE, c.in[26] + l * NE, eid, gate, pos, cnt); break;
    case OP_BUILD: n_moe_build(eid, pos, cnt, slot_tok, slot_a, tile_e); break;
    case OP_MOE_GATE: n_gemm(sm, HN, D, slot_tok, c.in[27] + (size_t)l * NE * D * DE, DE, (size_t)D * DE, tile_e, NSLOT, DE, D, EpiStore{BIG, DE, nullptr}); break;
    case OP_MOE_UP: n_gemm(sm, HN, D, slot_tok, c.in[28] + (size_t)l * NE * D * DE, DE, (size_t)D * DE, tile_e, NSLOT, DE, D, EpiStore{BIG + (size_t)NSLOT * DE, DE, nullptr}); break;
    case OP_MOE_ACT: n_moe_act(BIG, BIG + (size_t)NSLOT * DE); break;
    case OP_MOE_DOWN: n_gemm(sm, BIG, DE, nullptr, c.in[29] + (size_t)l * NE * DE * D, D, (size_t)DE * D, tile_e, NSLOT, D, DE, EpiMoeDown{BIG + (size_t)NSLOT * DE, slot_a, gate}); break;
    case OP_MOE_COMBINE: n_moe_combine(X, BIG + (size_t)NSLOT * DE); break;
    case OP_FINAL: n_rms(X, c.in[6], X, T); break;
    }
}

template <int OP> __global__ void __launch_bounds__(512) k_stage(Ctx c, int l) {
    __shared__ float sm[16 * 132 + 16 * 260];
    run_op(c, OP, l, sm);
}
typedef void (*StageFn)(Ctx, int);
template <int... I> struct Seq {};
template <int N, int... I> struct MkSeq : MkSeq<N - 1, N - 1, I...> {};
template <int... I> struct MkSeq<0, I...> { typedef Seq<I...> type; };
template <int... I> static void fill_tab(StageFn* t, Seq<I...>) { StageFn f[] = {k_stage<I>...}; for (unsigned i = 0; i < sizeof...(I); ++i) t[i] = f[i]; }
template <int... I> static void fill_tab_opt(StageFn* t, Seq<I...>) { StageFn f[] = {k_opt<I>...}; for (unsigned i = 0; i < sizeof...(I); ++i) t[i] = f[i]; }

template <int CODE> __device__ __forceinline__ void coop_step(const Ctx& c, LAS unsigned char* lds, cg::grid_group& grid, bool sync_after) {
    run_phase(c, CODE >> 1, CODE & 1, lds);
    if (sync_after) {
        asm volatile("s_waitcnt vmcnt(0) lgkmcnt(0)" ::: "memory");
        grid.sync();
        if (threadIdx.x < 64) { __builtin_amdgcn_fence(__ATOMIC_ACQUIRE, "agent"); asm volatile("s_waitcnt vmcnt(0)" ::: "memory"); }
        __syncthreads();
    }
}
template <int... CODES> __global__ void __launch_bounds__(512, 2) k_coop(Ctx c) {
    extern __shared__ __attribute__((aligned(16))) unsigned char dynlds[];
    cg::grid_group grid = cg::this_grid();
    LAS unsigned char* lds = (LAS unsigned char*)dynlds;
    int idx = 0; constexpr int N = sizeof...(CODES);
    ((coop_step<CODES>(c, lds, grid, ++idx < N)), ...);
}
#define CODE(ph, l) ((ph) * 2 + (l))
typedef void (*CoopFn)(Ctx);
struct Step { int kind, op, l; };
static const Step g_prog[] = {
    {0, OP_MEMN, 0}, {0, OP_MEMKV, 0}, {0, OP_MEMKV, 1},
    {1, PH_PREP0, 0}, {1, PH_CONV_IN, 0}, {1, PH_CONV_MID, 0}, {1, PH_CONV_OUT, 0},
    {1, PH_XA_PREP, 0}, {1, PH_XA_Q, 0}, {1, PH_XA_KV, 0}, {1, PH_XA_S, 0}, {1, PH_XA_PV, 0}, {1, PH_XA_O, 0},
    {1, PH_ROUTE_PREP, 0}, {1, PH_ROUTE, 0}, {1, PH_BUILD, 0}, {1, PH_MOE1, 0}, {1, PH_MOE2, 0}, {1, PH_COMBINE, 0},
    {0, OP_RMS_MIX, 1}, {0, OP_GLA_IN, 0}, {0, OP_GLA_DECAY, 0}, {0, OP_GLA_REC, 0}, {0, OP_GLA_NORM, 0}, {0, OP_GLA_OUT, 0},
    {1, PH_ADAPT, 1}, {1, PH_XA_PREP, 1}, {1, PH_XA_Q, 1}, {1, PH_XA_KV, 1}, {1, PH_XA_S, 1}, {1, PH_XA_PV, 1}, {1, PH_XA_O, 1},
    {1, PH_ROUTE_PREP, 1}, {1, PH_ROUTE, 1}, {1, PH_BUILD, 1}, {1, PH_MOE1, 1}, {1, PH_MOE2, 1}, {1, PH_COMBINE_FIN, 1}};
constexpr int NSTEP = sizeof(g_prog) / sizeof(g_prog[0]);

extern "C" void kernel_launch(void* const* d_in, const int* in_sizes, int n_in, void* d_out, int out_size, void* d_ws, size_t ws_size, hipStream_t stream) {
    if (n_in != 30 || out_size != T * D || ws_size < OW_END || ws_size < WS_END) { fprintf(stderr, "kernel_launch: bad args n_in %d out %d ws %zu\n", n_in, out_size, ws_size); return; }
    Ctx c; memset(&c, 0, sizeof(c));
    for (int i = 0; i < 30; ++i) c.in[i] = (const float*)d_in[i];
    c.out = (float*)d_out; c.ws = (unsigned char*)d_ws;
    static StageFn tab[OP_FINAL + 1], tabo[PH_N];
    static bool init = false;
    if (!init) { fill_tab(tab, MkSeq<OP_FINAL + 1>::type()); fill_tab_opt(tabo, MkSeq<PH_N>::type());
        for (int i = 0; i < PH_N; ++i) hipFuncSetAttribute((const void*)tabo[i], hipFuncAttributeMaxDynamicSharedMemorySize, LDS_BYTES);
        init = true; }
#if COOP
    static int coop_grid = 0;
    static CoopFn coop_fns[2] = { k_coop<CODE(PH_PREP0, 0), CODE(PH_CONV_IN, 0), CODE(PH_CONV_MID, 0), CODE(PH_CONV_OUT, 0), CODE(PH_XA_PREP, 0), CODE(PH_XA_Q, 0), CODE(PH_XA_KV, 0), CODE(PH_XA_S, 0), CODE(PH_XA_PV, 0), CODE(PH_XA_O, 0), CODE(PH_ROUTE_PREP, 0), CODE(PH_ROUTE, 0), CODE(PH_BUILD, 0), CODE(PH_MOE1, 0), CODE(PH_MOE2, 0), CODE(PH_COMBINE, 0)>,
                                  k_coop<CODE(PH_ADAPT, 1), CODE(PH_XA_PREP, 1), CODE(PH_XA_Q, 1), CODE(PH_XA_KV, 1), CODE(PH_XA_S, 1), CODE(PH_XA_PV, 1), CODE(PH_XA_O, 1), CODE(PH_ROUTE_PREP, 1), CODE(PH_ROUTE, 1), CODE(PH_BUILD, 1), CODE(PH_MOE1, 1), CODE(PH_MOE2, 1), CODE(PH_COMBINE_FIN, 1)> };
    if (!coop_grid) { int dev = 0, cus = 0, per_cu = 0; hipGetDevice(&dev); hipDeviceGetAttribute(&cus, hipDeviceAttributeMultiprocessorCount, dev);
        for (int k = 0; k < 2; ++k) hipFuncSetAttribute((const void*)coop_fns[k], hipFuncAttributeMaxDynamicSharedMemorySize, LDS_BYTES);
        hipOccupancyMaxActiveBlocksPerMultiprocessor(&per_cu, coop_fns[0], 512, LDS_BYTES);
        coop_grid = cus * (per_cu < 1 ? 1 : per_cu); if (coop_grid > 256) coop_grid = 256;
        fprintf(stderr, "kernel_launch: cus %d per_cu %d grid %d\n", cus, per_cu, coop_grid); }
    int ncoop = 0;
#endif
    for (int i = 0; i < NSTEP; ++i) {
        if (g_prog[i].kind == 0) { hipLaunchKernelGGL(tab[g_prog[i].op], dim3(1024), dim3(512), 0, stream, c, g_prog[i].l); continue; }
#if COOP
        while (i < NSTEP && g_prog[i].kind == 1) ++i;
        --i;
        void* args[] = {&c};
        hipError_t e = hipLaunchCooperativeKernel((void*)coop_fns[ncoop++], dim3(coop_grid), dim3(512), args, LDS_BYTES, stream);
        if (e != hipSuccess) fprintf(stderr, "cooperative launch failed: %s\n", hipGetErrorString(e));
#else
        hipLaunchKernelGGL(tabo[g_prog[i].op], dim3(256), dim3(512), LDS_BYTES, stream, c, g_prog[i].l);
#endif
    }
}
```

```cpp
#include <hip/hip_runtime.h>
#include <hip/hip_cooperative_groups.h>
#include <cstdio>
#include <cstring>
namespace cg = cooperative_groups;

#ifndef MEGA
#define MEGA 0
#endif

constexpr int D = 1024, NB = 4, S = 8192, T = NB * S, NMEM = 256, DEPTH = 2;
constexpr int CONVK = 31;
constexpr int GH = 4, GDK = 512, GDV = 1024, GDKH = 128, GDVH = 256, GRANK = 16, GLA_COLS = 3088;
constexpr int XH = 4, XHD = 256;
constexpr int NG = 4, EPG = 8, NE = 32, DE = 512;
constexpr int NA = T * 2;
constexpr int NSLOT = NA + NE * 128;
constexpr float EPS = 1e-6f;

constexpr size_t MiB = 1u << 20;
constexpr size_t WS_HN = 0;
constexpr size_t WS_BIG = 128 * MiB;
constexpr size_t WS_SMALL = 528 * MiB;
constexpr size_t WS_MEMN = WS_SMALL;
constexpr size_t WS_KV = WS_MEMN + 4 * MiB;
constexpr size_t WS_EID = WS_KV + 16 * MiB;
constexpr size_t WS_GATE = WS_EID + NA * 4;
constexpr size_t WS_POS = WS_GATE + NA * 4;
constexpr size_t WS_SLOTTOK = WS_POS + NA * 4;
constexpr size_t WS_SLOTA = WS_SLOTTOK + NSLOT * 4;
constexpr size_t WS_TILEE = WS_SLOTA + NSLOT * 4;
constexpr size_t WS_CNT = WS_TILEE + 4096;
constexpr size_t WS_END = WS_CNT + 4096;

struct Ctx {
    const float* in[30];
    float* out;
    unsigned char* ws;
};

__device__ __forceinline__ float wave_sum(float v) {
#pragma unroll
    for (int o = 1; o < 64; o <<= 1) v += __shfl_xor(v, o);
    return v;
}
__device__ __forceinline__ float wave_max(float v) {
#pragma unroll
    for (int o = 1; o < 64; o <<= 1) v = fmaxf(v, __shfl_xor(v, o));
    return v;
}
__device__ __forceinline__ float sigmoidf_(float x) { return 1.0f / (1.0f + expf(-x)); }
__device__ __forceinline__ float siluf_(float x) { return x / (1.0f + expf(-x)); }

__device__ void n_rms(const float* x, const float* g, float* out, int rows) {
    const int lane = threadIdx.x & 63;
    const int gw = (blockIdx.x * blockDim.x + threadIdx.x) >> 6, ngw = (gridDim.x * blockDim.x) >> 6;
    for (int r = gw; r < rows; r += ngw) {
        const float4* xr = (const float4*)(x + (size_t)r * D);
        float4 v[4]; float s = 0.f;
#pragma unroll
        for (int j = 0; j < 4; ++j) { v[j] = xr[lane + 64 * j]; s += v[j].x * v[j].x + v[j].y * v[j].y + v[j].z * v[j].z + v[j].w * v[j].w; }
        s = wave_sum(s);
        const float rs = rsqrtf(s * (1.0f / D) + EPS);
        float4* o = (float4*)(out + (size_t)r * D);
#pragma unroll
        for (int j = 0; j < 4; ++j) { const float4 gg = ((const float4*)g)[lane + 64 * j];
            o[lane + 64 * j] = make_float4(v[j].x * rs * gg.x, v[j].y * rs * gg.y, v[j].z * rs * gg.z, v[j].w * rs * gg.w); }
    }
}
__device__ void n_copy4(const float* src, float* dst, size_t n4) {
    const size_t g = (size_t)blockIdx.x * blockDim.x + threadIdx.x, gs = (size_t)gridDim.x * blockDim.x;
    for (size_t i = g; i < n4; i += gs) ((float4*)dst)[i] = ((const float4*)src)[i];
}

struct EpiStore { float* C; int ldc; const float* bias;
    __device__ __forceinline__ void operator()(int m, int n, float acc) const { C[(size_t)m * ldc + n] = acc + (bias ? bias[n] : 0.f); } };
struct EpiResid { float* X; int ldc; const float* bias;
    __device__ __forceinline__ void operator()(int m, int n, float acc) const { X[(size_t)m * ldc + n] += acc + (bias ? bias[n] : 0.f); } };
struct EpiMoeDown { float* Y; const int* slot_a; const float* gate;
    __device__ __forceinline__ void operator()(int m, int n, float acc) const { const int a = slot_a[m]; if (a >= 0) Y[(size_t)a * D + n] = acc * gate[a]; } };

template <class Epi>
__device__ void n_gemm(float* sm, const float* A, int lda, const int* arow, const float* W, int ldw, size_t wstride, const int* tile_e,
                       int M, int N, int K, Epi epi) {
    float* As = sm;
    float* Bs = sm + 16 * 132;
    const int tid = threadIdx.x, ty = tid >> 5, tx = tid & 31;
    const int ntm = M / 128, ntn = (N + 255) / 256;
    for (int tile = blockIdx.x; tile < ntm * ntn; tile += gridDim.x) {
        const int mt = tile / ntn, nt = tile % ntn;
        const float* Wb = W;
        if (tile_e) { const int e = tile_e[mt]; if (e < 0) continue; Wb = W + (size_t)e * wstride; }
        const int m0 = mt * 128, n0 = nt * 256;
        float acc[8][8];
#pragma unroll
        for (int i = 0; i < 8; ++i)
#pragma unroll
            for (int j = 0; j < 8; ++j) acc[i][j] = 0.f;
        const int ar = tid >> 2, akq = (tid & 3) * 4;
        const int srow = arow ? arow[m0 + ar] : (m0 + ar);
        const float* ap = srow >= 0 ? A + (size_t)srow * lda : nullptr;
        const int bk = tid >> 6, bn = (tid & 63) * 4;
        for (int k0 = 0; k0 < K; k0 += 16) {
            float4 av = ap ? *(const float4*)(ap + k0 + akq) : make_float4(0.f, 0.f, 0.f, 0.f);
            As[(akq + 0) * 132 + ar] = av.x; As[(akq + 1) * 132 + ar] = av.y; As[(akq + 2) * 132 + ar] = av.z; As[(akq + 3) * 132 + ar] = av.w;
#pragma unroll
            for (int i = 0; i < 2; ++i) {
                const int kk = bk + 8 * i; const int n = n0 + bn;
                float4 bv = (n < N) ? *(const float4*)(Wb + (size_t)(k0 + kk) * ldw + n) : make_float4(0.f, 0.f, 0.f, 0.f);
                *(float4*)(Bs + kk * 260 + bn) = bv;
            }
            __syncthreads();
#pragma unroll
            for (int kk = 0; kk < 16; ++kk) {
                float a[8], b[8];
                *(float4*)(a) = *(const float4*)(As + kk * 132 + ty * 8); *(float4*)(a + 4) = *(const float4*)(As + kk * 132 + ty * 8 + 4);
                *(float4*)(b) = *(const float4*)(Bs + kk * 260 + tx * 8); *(float4*)(b + 4) = *(const float4*)(Bs + kk * 260 + tx * 8 + 4);
#pragma unroll
                for (int i = 0; i < 8; ++i)
#pragma unroll
                    for (int j = 0; j < 8; ++j) acc[i][j] = fmaf(a[i], b[j], acc[i][j]);
            }
            __syncthreads();
        }
#pragma unroll
        for (int i = 0; i < 8; ++i)
#pragma unroll
            for (int j = 0; j < 8; ++j) { const int m = m0 + ty * 8 + i, n = n0 + tx * 8 + j; if (n < N) epi(m, n, acc[i][j]); }
    }
}

__device__ void n_glu(const float* u, float* g) {
    const size_t gi = (size_t)blockIdx.x * blockDim.x + threadIdx.x, gs = (size_t)gridDim.x * blockDim.x;
    for (size_t i = gi; i < (size_t)T * D; i += gs) { const size_t t = i >> 10, c = i & 1023; g[i] = u[t * 2048 + c] * sigmoidf_(u[t * 2048 + 1024 + c]); }
}
__device__ void n_dwconv(const float* g, const float* wdw, const float* bdw, const float* lng, const float* lnb, float* out) {
    const int lane = threadIdx.x & 63;
    const int gw = (blockIdx.x * blockDim.x + threadIdx.x) >> 6, ngw = (gridDim.x * blockDim.x) >> 6;
    for (int t = gw; t < T; t += ngw) {
        const int s = t % S;
        float4 acc[4];
#pragma unroll
        for (int j = 0; j < 4; ++j) acc[j] = ((const float4*)bdw)[lane + 64 * j];
        for (int tap = 0; tap < CONVK; ++tap) {
            const int ss = s - (CONVK - 1) + tap; if (ss < 0) continue;
            const float4* gr = (const float4*)(g + (size_t)(t - (CONVK - 1) + tap) * D);
            const float4* wr = (const float4*)(wdw + (size_t)tap * D);
#pragma unroll
            for (int j = 0; j < 4; ++j) { const float4 a = gr[lane + 64 * j], w = wr[lane + 64 * j];
                acc[j].x = fmaf(a.x, w.x, acc[j].x); acc[j].y = fmaf(a.y, w.y, acc[j].y); acc[j].z = fmaf(a.z, w.z, acc[j].z); acc[j].w = fmaf(a.w, w.w, acc[j].w); }
        }
        float sm_ = 0.f;
#pragma unroll
        for (int j = 0; j < 4; ++j) sm_ += acc[j].x + acc[j].y + acc[j].z + acc[j].w;
        const float mu = wave_sum(sm_) * (1.0f / D);
        float q = 0.f;
#pragma unroll
        for (int j = 0; j < 4; ++j) { acc[j].x -= mu; acc[j].y -= mu; acc[j].z -= mu; acc[j].w -= mu; q += acc[j].x * acc[j].x + acc[j].y * acc[j].y + acc[j].z * acc[j].z + acc[j].w * acc[j].w; }
        const float rstd = rsqrtf(wave_sum(q) * (1.0f / D) + EPS);
        float4* o = (float4*)(out + (size_t)t * D);
#pragma unroll
        for (int j = 0; j < 4; ++j) { const float4 gg = ((const float4*)lng)[lane + 64 * j], bb = ((const float4*)lnb)[lane + 64 * j];
            o[lane + 64 * j] = make_float4(siluf_(acc[j].x * rstd * gg.x + bb.x), siluf_(acc[j].y * rstd * gg.y + bb.y), siluf_(acc[j].z * rstd * gg.z + bb.z), siluf_(acc[j].w * rstd * gg.w + bb.w)); }
    }
}
__device__ void n_attn(const float* q, const float* kv, float* o) {
    const int lane = threadIdx.x & 63;
    const int gw = (blockIdx.x * blockDim.x + threadIdx.x) >> 6, ngw = (gridDim.x * blockDim.x) >> 6;
    for (int it = gw; it < T * XH; it += ngw) {
        const int t = it >> 2, h = it & 3, b = t / S;
        const float4 qv = ((const float4*)(q + (size_t)t * D + h * XHD))[lane];
        const float* kb = kv + (size_t)b * NMEM * 2048 + h * XHD;
        float sc[4];
#pragma unroll
        for (int m4 = 0; m4 < 4; ++m4) {
            float mine = 0.f;
            for (int ml = 0; ml < 64; ++ml) {
                const float4 kk = ((const float4*)(kb + (size_t)(m4 * 64 + ml) * 2048))[lane];
                float p = qv.x * kk.x + qv.y * kk.y + qv.z * kk.z + qv.w * kk.w;
                p = wave_sum(p);
                if (ml == lane) mine = p;
            }
            sc[m4] = mine * 0.0625f;
        }
        float mx = fmaxf(fmaxf(sc[0], sc[1]), fmaxf(sc[2], sc[3])); mx = wave_max(mx);
        float se = 0.f;
#pragma unroll
        for (int m4 = 0; m4 < 4; ++m4) { sc[m4] = expf(sc[m4] - mx); se += sc[m4]; }
        se = wave_sum(se); const float inv = 1.0f / se;
        float4 acc = make_float4(0.f, 0.f, 0.f, 0.f);
        const float* vb = kb + 1024;
#pragma unroll
        for (int m4 = 0; m4 < 4; ++m4)
            for (int ml = 0; ml < 64; ++ml) {
                const float p = __shfl(sc[m4], ml) * inv;
                const float4 vv = ((const float4*)(vb + (size_t)(m4 * 64 + ml) * 2048))[lane];
                acc.x = fmaf(p, vv.x, acc.x); acc.y = fmaf(p, vv.y, acc.y); acc.z = fmaf(p, vv.z, acc.z); acc.w = fmaf(p, vv.w, acc.w);
            }
        ((float4*)(o + (size_t)t * D + h * XHD))[lane] = acc;
    }
}
__device__ void n_moe_init(int* cnt, int* slot_tok, int* slot_a, int* tile_e) {
    const int gi = blockIdx.x * blockDim.x + threadIdx.x, gs = gridDim.x * blockDim.x;
    for (int i = gi; i < NSLOT; i += gs) { slot_tok[i] = -1; slot_a[i] = -1; }
    for (int i = gi; i < NSLOT / 128; i += gs) tile_e[i] = -1;
    if (gi < 32) cnt[gi] = 0;
}
__device__ void n_route(const float* h, const float* wg, const float* bg, const float* we, const float* be, int* eid, float* gate, int* pos, int* cnt) {
    const int lane = threadIdx.x & 63;
    const int gw = (blockIdx.x * blockDim.x + threadIdx.x) >> 6, ngw = (gridDim.x * blockDim.x) >> 6;
    for (int t = gw; t < T; t += ngw) {
        float hv[16];
#pragma unroll
        for (int j = 0; j < 16; ++j) hv[j] = h[(size_t)t * D + j * 64 + lane];
        float gl[4];
#pragma unroll
        for (int o = 0; o < 4; ++o) { float p = 0.f;
#pragma unroll
            for (int j = 0; j < 16; ++j) p = fmaf(hv[j], wg[(size_t)(j * 64 + lane) * NG + o], p);
            gl[o] = wave_sum(p) + bg[o]; }
        int gs = 0; float gm = gl[0];
#pragma unroll
        for (int o = 1; o < 4; ++o) if (gl[o] > gm) { gm = gl[o]; gs = o; }
        float se = 0.f;
#pragma unroll
        for (int o = 0; o < 4; ++o) se += expf(gl[o] - gm);
        const float pg = 1.0f / se;
        float el[8];
#pragma unroll
        for (int o = 0; o < 8; ++o) { float p = 0.f;
#pragma unroll
            for (int j = 0; j < 16; ++j) p = fmaf(hv[j], we[(size_t)(j * 64 + lane) * NE + gs * 8 + o], p);
            el[o] = wave_sum(p) + be[gs * 8 + o]; }
        float em = el[0];
#pragma unroll
        for (int o = 1; o < 8; ++o) em = fmaxf(em, el[o]);
        float pe[8], ps = 0.f;
#pragma unroll
        for (int o = 0; o < 8; ++o) { pe[o] = expf(el[o] - em); ps += pe[o]; }
#pragma unroll
        for (int o = 0; o < 8; ++o) pe[o] = pe[o] / ps;
        int i1 = 0; float p1 = pe[0];
#pragma unroll
        for (int o = 1; o < 8; ++o) if (pe[o] > p1) { p1 = pe[o]; i1 = o; }
        int i2 = -1; float p2 = -1.f;
#pragma unroll
        for (int o = 0; o < 8; ++o) if (o != i1 && pe[o] > p2) { p2 = pe[o]; i2 = o; }
        if (lane == 0) {
            const float den = p1 + p2;
            const int e1 = gs * 8 + i1, e2 = gs * 8 + i2;
            eid[2 * t] = e1; eid[2 * t + 1] = e2;
            gate[2 * t] = pg * p1 / den; gate[2 * t + 1] = pg * p2 / den;
            pos[2 * t] = atomicAdd(&cnt[e1], 1); pos[2 * t + 1] = atomicAdd(&cnt[e2], 1);
        }
    }
}
__device__ void n_moe_build(const int* eid, const int* pos, const int* cnt, int* slot_tok, int* slot_a, int* tile_e) {
    __shared__ int poff[33];
    if (threadIdx.x == 0) { int o = 0; for (int e = 0; e < 32; ++e) { poff[e] = o; o += (cnt[e] + 127) / 128 * 128; } poff[32] = o; }
    __syncthreads();
    const int gi = blockIdx.x * blockDim.x + threadIdx.x, gs = gridDim.x * blockDim.x;
    for (int a = gi; a < NA; a += gs) { const int e = eid[a]; const int sl = poff[e] + pos[a]; slot_tok[sl] = a >> 1; slot_a[sl] = a; }
    for (int mt = gi; mt < NSLOT / 128; mt += gs) { const int r = mt * 128; int e = -1; for (int k = 0; k < 32; ++k) if (r >= poff[k] && r < poff[k + 1]) e = k; tile_e[mt] = e; }
    __syncthreads();
}
__device__ void n_moe_act(float* g, const float* u) {
    const size_t gi = (size_t)blockIdx.x * blockDim.x + threadIdx.x, gs = (size_t)gridDim.x * blockDim.x;
    for (size_t i = gi; i < (size_t)NSLOT * DE / 4; i += gs) { float4 a = ((float4*)g)[i]; const float4 b = ((const float4*)u)[i];
        a.x = siluf_(a.x) * b.x; a.y = siluf_(a.y) * b.y; a.z = siluf_(a.z) * b.z; a.w = siluf_(a.w) * b.w; ((float4*)g)[i] = a; }
}
__device__ void n_moe_combine(float* x, const float* y) {
    const size_t gi = (size_t)blockIdx.x * blockDim.x + threadIdx.x, gs = (size_t)gridDim.x * blockDim.x;
    for (size_t i = gi; i < (size_t)T * D / 4; i += gs) { const size_t t = i >> 8, c = i & 255; float4 a = ((float4*)x)[i];
        const float4 y0 = ((const float4*)y)[(2 * t) * 256 + c], y1 = ((const float4*)y)[(2 * t + 1) * 256 + c];
        a.x += y0.x + y1.x; a.y += y0.y + y1.y; a.z += y0.z + y1.z; a.w += y0.w + y1.w; ((float4*)x)[i] = a; }
}
__device__ void n_gla_decay(const float* proj, const float* wa2, const float* ba, float* dec) {
    const size_t gi = (size_t)blockIdx.x * blockDim.x + threadIdx.x, gs = (size_t)gridDim.x * blockDim.x;
    for (size_t i = gi; i < (size_t)T * GDK; i += gs) { const size_t t = i >> 9; const int j = (int)(i & 511);
        float a = ba[j];
#pragma unroll
        for (int r = 0; r < GRANK; ++r) a = fmaf(proj[t * GLA_COLS + 2048 + r], wa2[r * GDK + j], a);
        const float ls = fminf(a, 0.f) - log1pf(expf(-fabsf(a)));
        dec[i] = expf(ls * (1.0f / 16.0f)); }
}
__device__ void n_gla_rec(float* proj, const float* dec) {
    const int gi = blockIdx.x * blockDim.x + threadIdx.x, gs = gridDim.x * blockDim.x;
    for (int it = gi; it < NB * GH * GDVH; it += gs) {
        const int col = it & 255, h = (it >> 8) & 3, b = it >> 10;
        float st[GDKH];
#pragma unroll
        for (int k = 0; k < GDKH; ++k) st[k] = 0.f;
        const float qs = 0.08838834764831845f;
        for (int s = 0; s < S; ++s) {
            const size_t t = (size_t)b * S + s;
            float* pr = proj + t * GLA_COLS;
            const float v = pr[1024 + h * GDVH + col];
            const float* qq = pr + h * GDKH; const float* kk = pr + 512 + h * GDKH; const float* dd = dec + t * GDK + h * GDKH;
            float o = 0.f;
#pragma unroll
            for (int k = 0; k < GDKH; ++k) { st[k] = fmaf(st[k], dd[k], kk[k] * v); o = fmaf(qq[k], st[k], o); }
            pr[1024 + h * GDVH + col] = o * qs;
        }
    }
}
__device__ void n_gla_norm(const float* proj, const float* ng, float* go) {
    const int lane = threadIdx.x & 63;
    const int gw = (blockIdx.x * blockDim.x + threadIdx.x) >> 6, ngw = (gridDim.x * blockDim.x) >> 6;
    for (int it = gw; it < T * GH; it += ngw) {
        const int t = it >> 2, h = it & 3;
        const float4 ov = ((const float4*)(proj + (size_t)t * GLA_COLS + 1024 + h * GDVH))[lane];
        const float4 rv = ((const float4*)(proj + (size_t)t * GLA_COLS + 2064 + h * GDVH))[lane];
        const float4 gg = ((const float4*)ng)[lane];
        float s = ov.x * ov.x + ov.y * ov.y + ov.z * ov.z + ov.w * ov.w; s = wave_sum(s);
        const float rs = rsqrtf(s * (1.0f / GDVH) + EPS);
        ((float4*)(go + (size_t)t * D + h * GDVH))[lane] = make_float4(ov.x * rs * gg.x * siluf_(rv.x), ov.y * rs * gg.y * siluf_(rv.y), ov.z * rs * gg.z * siluf_(rv.z), ov.w * rs * gg.w * siluf_(rv.w));
    }
}

#define LAS __attribute__((address_space(3)))
typedef unsigned short bf16_t;
typedef short bf16x8 __attribute__((ext_vector_type(8)));
typedef float f32x4 __attribute__((ext_vector_type(4)));
typedef float f32x2 __attribute__((ext_vector_type(2)));
typedef unsigned u32x4 __attribute__((ext_vector_type(4)));
typedef unsigned u32x2 __attribute__((ext_vector_type(2)));

constexpr int LDS_BYTES = 160 * 1024;
constexpr int NSLOT2 = NA + NE * 256;
constexpr int MAXRT = NSLOT2 / 256;
constexpr size_t OW_XB = 0;
constexpr size_t OW_SSP = 64 * MiB;
constexpr size_t OW_RS = 66 * MiB;
constexpr size_t OW_PSUM = 67 * MiB;
constexpr size_t OW_MOE = 69 * MiB;
constexpr size_t OW_ACTA = 72 * MiB, OW_ACTB = 136 * MiB, OW_ACTC = 200 * MiB;
constexpr size_t OW_H = 72 * MiB, OW_Y = 144 * MiB, OW_WMOE = 272 * MiB;
constexpr size_t OW_KVB = 368 * MiB;
constexpr size_t OW_MEMNB = 372 * MiB;
constexpr size_t OW_WCIN = 550 * MiB, OW_WCOUT = 554 * MiB, OW_WXQ = 556 * MiB, OW_WXKV = 560 * MiB, OW_WXO = 568 * MiB, OW_WR = 572 * MiB, OW_END = 573 * MiB;
constexpr size_t OW_ATT = 0, OW_QKR = 72 * MiB, OW_KVT = 200 * MiB, OW_BTM = 296 * MiB, OW_O = 296 * MiB, OW_BFM = 360 * MiB, OW_UT = 424 * MiB, OW_SP = 456 * MiB,
                 OW_ALR = 488 * MiB, OW_DL = 490 * MiB, OW_GO = 200 * MiB, OW_WGTM = 492 * MiB, OW_WGFM = 496 * MiB, OW_WGO = 499 * MiB, OW_WA = 501 * MiB;
constexpr size_t OM_GCNT = OW_MOE, OM_NT = OW_MOE + 256, OM_TILEE = OW_MOE + 512, OM_AE = OW_MOE + 4096, OM_APOS = OM_AE + NA * 4, OM_GATE = OM_APOS + NA * 4,
                 OM_STOK = OM_GATE + NA * 4, OM_SA = OM_STOK + NSLOT2 * 4, OM_SRS = OM_SA + NSLOT2 * 4, OM_SGATE = OM_SRS + NSLOT2 * 4, OM_END = OM_SGATE + NSLOT2 * 4;
static_assert(OM_END <= OW_ACTA, "MoE small arrays");

__device__ __forceinline__ unsigned cvt_pk_bf16(float lo, float hi) { unsigned r; asm volatile("v_cvt_pk_bf16_f32 %0, %1, %2" : "=v"(r) : "v"(lo), "v"(hi)); return r; }
__device__ __forceinline__ int otid() { int t = threadIdx.x; asm volatile("" : "+v"(t)); return t; }
__device__ __forceinline__ u32x4 pack8(const f32x4& a, const f32x4& b) { u32x4 w; w.x = cvt_pk_bf16(a[0], a[1]); w.y = cvt_pk_bf16(a[2], a[3]); w.z = cvt_pk_bf16(b[0], b[1]); w.w = cvt_pk_bf16(b[2], b[3]); return w; }
__device__ __forceinline__ float bf_lo(unsigned w) { return __uint_as_float(w << 16); }
__device__ __forceinline__ float bf_hi(unsigned w) { return __uint_as_float(w & 0xffff0000u); }
__device__ __forceinline__ float fast_sigmoid(float x) { return __builtin_amdgcn_rcpf(1.0f + __builtin_amdgcn_exp2f(-1.4426950408889634f * x)); }

namespace g8 {
constexpr int BM = 256, BK = 64, HALF = 128, HTB = HALF * BK * 2, STAGE_BYTES = 8 * HTB;
__device__ __forceinline__ int lds_byte(int r, int c) { const int st = (r >> 4) * 2 + (c >> 5), rr = r & 15, cc = c & 31, ob = rr * 64 + cc * 2; return st * 1024 + (ob ^ (((ob >> 9) & 1) << 5)); }
__device__ __forceinline__ void stage_rc(int b, int& R, int& C) { const int st = b / 1024, sb = b % 1024, swz = sb ^ (((sb >> 9) & 1) << 5); R = (st >> 1) * 16 + swz / 64; C = (st & 1) * 32 + (swz % 64) / 2; }
__device__ __forceinline__ int perm32(int rho) { const int n = rho >> 4, i = rho & 15; return 8 * (i >> 2) + 4 * n + (i & 3); }
struct Unit { int pm, pn, e; };

template <class Epi, class Sched>
__device__ __forceinline__ void gemm_phase(LAS unsigned char* lds, const Sched& S, const Epi& E) {
    int tid_ = threadIdx.x; asm volatile("" : "+v"(tid_));
    const int tid = tid_, wid = __builtin_amdgcn_readfirstlane(tid >> 6), lane = tid & 63, wr = wid >> 2, wc = wid & 3, fr = lane & 15, fq = lane >> 4;
    const size_t kstep = (size_t)(BK * 2);
    const unsigned ldsw = (unsigned)wid * 1024u;
    const int aoff = lds_byte(wr * 64 + fr, fq * 8), boff = lds_byte(wc * 32 + fr, fq * 8);
#define G8_SA(b, h) (((b) * 2 + (h)) * HTB)
#define G8_SB(b, h) ((4 + (b) * 2 + (h)) * HTB)
#define G8_STAGE(bufoff, gbase, vv) do { _Pragma("unroll") for (int _i = 0; _i < 2; ++_i) \
        __builtin_amdgcn_global_load_lds((const unsigned*)((const char*)(gbase) + (vv)[_i]), (LAS unsigned*)(lds + (bufoff) + ldsw + _i * 8192), 16, 0, 0); } while (0)
#define G8_LDA(dst, b, h) do { _Pragma("unroll") for (int m = 0; m < 4; ++m) _Pragma("unroll") for (int k = 0; k < 2; ++k) dst[m][k] = *(const LAS bf16x8*)(lds + G8_SA(b, h) + aoff + m * 2048 + k * 1024); } while (0)
#define G8_LDB(dst, b, h) do { _Pragma("unroll") for (int n = 0; n < 2; ++n) _Pragma("unroll") for (int k = 0; k < 2; ++k) dst[n][k] = *(const LAS bf16x8*)(lds + G8_SB(b, h) + boff + n * 2048 + k * 1024); } while (0)
#define G8_MMA(ai, bj, At, Bt) do { __builtin_amdgcn_s_setprio(1); _Pragma("unroll") for (int m = 0; m < 4; ++m) _Pragma("unroll") for (int n = 0; n < 2; ++n) _Pragma("unroll") for (int k = 0; k < 2; ++k) \
        acc[ai][bj][m][n] = __builtin_amdgcn_mfma_f32_16x16x32_bf16(Bt[n][k], At[m][k], acc[ai][bj][m][n], 0, 0, 0); __builtin_amdgcn_s_setprio(0); } while (0)
#define G8_WAIT_V(n) asm volatile("s_waitcnt vmcnt(" #n ")" ::: "memory")
#define G8_WAIT_L(n) asm volatile("s_waitcnt lgkmcnt(" #n ")" ::: "memory")
#define G8_BAR __builtin_amdgcn_s_barrier()
#define G8_SCHED __builtin_amdgcn_sched_barrier(0)
#define G8_VA(dst, u) do { const int _ac = S.a_col(u), _lda = S.lda(u); _Pragma("unroll") for (int _i = 0; _i < 2; ++_i) { int _R, _C; stage_rc(tid * 16 + _i * 8192, _R, _C); \
        _Pragma("unroll") for (int _h = 0; _h < 2; ++_h) dst[_h][_i] = (unsigned)(((size_t)S.a_row(u, _h * HALF + _R) * _lda + _ac + _C) * 2); } } while (0)
#define G8_VB(dst, hs, u) do { const int _ldb = S.ldb(u); hs = (size_t)HALF * _ldb * 2; _Pragma("unroll") for (int _i = 0; _i < 2; ++_i) { int _R, _C; stage_rc(tid * 16 + _i * 8192, _R, _C); \
        dst[_i] = (unsigned)(((_R & ~31) + perm32(_R & 31)) * _ldb + _C) * 2u; } } while (0)
    Unit cur, nxt; int ui = 0;
    if (!S.next(0, cur)) return;
    f32x4 acc[2][2][4][2];
#pragma unroll
    for (int a = 0; a < 2; ++a)
#pragma unroll
        for (int b = 0; b < 2; ++b)
#pragma unroll
            for (int m = 0; m < 4; ++m)
#pragma unroll
                for (int n = 0; n < 2; ++n) acc[a][b][m][n] = (f32x4){0.f, 0.f, 0.f, 0.f};
    bf16x8 At[4][2], B0[2][2], B1[2][2];
    unsigned va[2][2], nva[2][2], vb[2], nvb[2]; size_t hsB, nhsB;
    G8_VA(va, cur); G8_VB(vb, hsB, cur);
    const char* Ab = S.a_base(cur);
    const char* cB = S.b_base(cur);
    G8_STAGE(G8_SB(0, 0), cB, vb); G8_STAGE(G8_SA(0, 0), Ab, va[0]); G8_STAGE(G8_SB(0, 1), cB + hsB, vb); G8_STAGE(G8_SA(0, 1), Ab, va[1]);
    if (wr == 1) G8_BAR;
    G8_WAIT_V(4); G8_BAR;
    G8_STAGE(G8_SB(1, 0), cB + kstep, vb); G8_STAGE(G8_SA(1, 0), Ab + kstep, va[0]); G8_STAGE(G8_SB(1, 1), cB + hsB + kstep, vb);
    G8_WAIT_V(6); G8_BAR;
    for (;;) {
        const bool has_next = S.next(ui + 1, nxt);
        const char* nB = cB; const char* nAb = Ab;
        if (has_next) { nB = S.b_base(nxt); nAb = S.a_base(nxt); G8_VA(nva, nxt); G8_VB(nvb, nhsB, nxt); }
        else {
            nhsB = hsB;
#pragma unroll
            for (int i = 0; i < 2; ++i) { nvb[i] = vb[i];
#pragma unroll
                for (int h = 0; h < 2; ++h) nva[h][i] = va[h][i]; }
        }
        const int nt = S.nt(cur);
        for (int t = 0; t < nt; t += 2) {
            const bool last = (t == nt - 2);
            const char* a1 = Ab + (size_t)(t + 1) * kstep;
            const char* a2 = last ? nAb : Ab + (size_t)(t + 2) * kstep;
            const char* b2 = last ? nB : cB + (size_t)(t + 2) * kstep;
            const char* a3 = a2 + kstep; const char* b3 = b2 + kstep;
            const size_t hs2 = last ? nhsB : hsB;
            unsigned v2[2][2], vb2[2];
#pragma unroll
            for (int i = 0; i < 2; ++i) { vb2[i] = last ? nvb[i] : vb[i];
#pragma unroll
                for (int h = 0; h < 2; ++h) v2[h][i] = last ? nva[h][i] : va[h][i]; }
            G8_LDB(B0, 0, 0); G8_SCHED; G8_LDA(At, 0, 0); G8_STAGE(G8_SA(1, 1), a1, va[1]);
            G8_WAIT_L(8); G8_BAR; G8_WAIT_L(0); G8_MMA(0, 0, At, B0); G8_BAR; G8_SCHED;
            G8_LDB(B1, 0, 1); G8_STAGE(G8_SB(0, 0), b2, vb2);
            G8_BAR; G8_WAIT_L(0); G8_MMA(0, 1, At, B1); G8_BAR;
            G8_LDA(At, 0, 1); G8_STAGE(G8_SA(0, 0), a2, v2[0]);
            G8_BAR; G8_WAIT_L(0); G8_MMA(1, 0, At, B0); G8_BAR; G8_SCHED;
            G8_STAGE(G8_SB(0, 1), b2 + hs2, vb2);
            G8_WAIT_V(6); G8_BAR; G8_MMA(1, 1, At, B1); G8_BAR;
            G8_LDB(B0, 1, 0); G8_SCHED; G8_LDA(At, 1, 0); G8_STAGE(G8_SA(0, 1), a2, v2[1]);
            G8_WAIT_L(8); G8_BAR; G8_WAIT_L(0); G8_MMA(0, 0, At, B0); G8_BAR; G8_SCHED;
            G8_LDB(B1, 1, 1); G8_STAGE(G8_SB(1, 0), b3, vb2);
            G8_BAR; G8_WAIT_L(0); G8_MMA(0, 1, At, B1); G8_BAR;
            G8_LDA(At, 1, 1); G8_STAGE(G8_SA(1, 0), a3, v2[0]);
            G8_BAR; G8_WAIT_L(0); G8_MMA(1, 0, At, B0); G8_BAR; G8_SCHED;
            G8_STAGE(G8_SB(1, 1), b3 + hs2, vb2);
            G8_WAIT_V(6); G8_BAR; G8_MMA(1, 1, At, B1); G8_BAR;
        }
        const bool keep = S.cont(cur);
        if (!keep) E(acc, cur, wr, wc, fr, fq);
        if (!has_next) break;
        if (!keep) {
#pragma unroll
            for (int a = 0; a < 2; ++a)
#pragma unroll
                for (int b = 0; b < 2; ++b)
#pragma unroll
                    for (int m = 0; m < 4; ++m)
#pragma unroll
                        for (int n = 0; n < 2; ++n) acc[a][b][m][n] = (f32x4){0.f, 0.f, 0.f, 0.f};
        }
        cur = nxt; cB = nB; Ab = nAb; hsB = nhsB; ++ui;
#pragma unroll
        for (int i = 0; i < 2; ++i) { vb[i] = nvb[i];
#pragma unroll
            for (int h = 0; h < 2; ++h) va[h][i] = nva[h][i]; }
    }
    G8_WAIT_V(0);
    if (wr == 0) G8_BAR;
    G8_BAR;
#undef G8_SA
#undef G8_SB
#undef G8_STAGE
#undef G8_LDA
#undef G8_LDB
#undef G8_MMA
#undef G8_WAIT_V
#undef G8_WAIT_L
#undef G8_BAR
#undef G8_SCHED
#undef G8_VA
#undef G8_VB
}

struct DenseSched {
    __device__ __forceinline__ int lda(const Unit&) const { return lda_; }
    __device__ __forceinline__ int ldb(const Unit&) const { return ldb_; }
    __device__ __forceinline__ int nt(const Unit&) const { return K / BK; }
    __device__ __forceinline__ bool cont(const Unit&) const { return false; }
    int nN, nU, K, lda_, ldb_; const bf16_t* A; const bf16_t* Bt;
    __device__ __forceinline__ const char* a_base(const Unit&) const { return (const char*)A; }
    __device__ __forceinline__ bool next(int i, Unit& u) const {
        const int c = blockIdx.x, per = gridDim.x >> 3, x = c & 7, j = c >> 3;
        const int chunk = (nU + 7) >> 3, lu = i * per + j;
        if (lu >= chunk) return false;
        const int un = x * chunk + lu; if (un >= nU) return false;
        u.pm = un / nN; u.pn = un - u.pm * nN; u.e = 0; return true; }
    __device__ __forceinline__ int a_row(const Unit& u, int r) const { return u.pm * BM + r; }
    __device__ __forceinline__ int a_col(const Unit&) const { return 0; }
    __device__ __forceinline__ const char* b_base(const Unit& u) const { return (const char*)(Bt + (size_t)u.pn * BM * ldb_); }
};

struct EpiGlu {
    bf16_t* U; const float* rs; const float* bias;
    __device__ __forceinline__ void operator()(const f32x4 (&acc)[2][2][4][2], const Unit& u, int wr, int wc, int fr, int fq) const {
        const int c0 = u.pn * 128 + wc * 32 + 8 * fq;
        const f32x4 ba0 = *(const f32x4*)(bias + c0), ba1 = *(const f32x4*)(bias + c0 + 4), bg0 = *(const f32x4*)(bias + 1024 + c0), bg1 = *(const f32x4*)(bias + 1024 + c0 + 4);
#pragma unroll
        for (int ai = 0; ai < 2; ++ai)
#pragma unroll
            for (int m = 0; m < 4; ++m) {
                const int row = u.pm * BM + ai * HALF + wr * 64 + m * 16 + fr; const float r = rs[row];
                f32x4 o0, o1;
#pragma unroll
                for (int j = 0; j < 4; ++j) {
                    o0[j] = (acc[ai][0][m][0][j] * r + ba0[j]) * fast_sigmoid(acc[ai][1][m][0][j] * r + bg0[j]);
                    o1[j] = (acc[ai][0][m][1][j] * r + ba1[j]) * fast_sigmoid(acc[ai][1][m][1][j] * r + bg1[j]); }
                *(u32x4*)(U + (size_t)row * D + c0) = pack8(o0, o1);
            }
    }
};
struct EpiXres {
    const float* Xin; float* Xout; bf16_t* XB; const float* bias; float* ssp;
    __device__ __forceinline__ void operator()(const f32x4 (&acc)[2][2][4][2], const Unit& u, int wr, int wc, int fr, int fq) const {
#pragma unroll
        for (int ai = 0; ai < 2; ++ai)
#pragma unroll
            for (int m = 0; m < 4; ++m) {
                const int row = u.pm * BM + ai * HALF + wr * 64 + m * 16 + fr; float ss = 0.f;
#pragma unroll
                for (int bj = 0; bj < 2; ++bj) {
                    const int c0 = u.pn * BM + bj * HALF + wc * 32 + 8 * fq; const size_t off = (size_t)row * D + c0;
                    f32x4 v0 = *(const f32x4*)(Xin + off) + acc[ai][bj][m][0], v1 = *(const f32x4*)(Xin + off + 4) + acc[ai][bj][m][1];
                    if (bias) { v0 += *(const f32x4*)(bias + c0); v1 += *(const f32x4*)(bias + c0 + 4); }
                    *(f32x4*)(Xout + off) = v0; *(f32x4*)(Xout + off + 4) = v1;
                    *(u32x4*)(XB + off) = pack8(v0, v1);
                    ss += (v0[0] * v0[0] + v0[1] * v0[1]) + (v0[2] * v0[2] + v0[3] * v0[3]) + (v1[0] * v1[0] + v1[1] * v1[1]) + (v1[2] * v1[2] + v1[3] * v1[3]);
                }
                if (ssp) { ss += __shfl_xor(ss, 16); ss += __shfl_xor(ss, 32); if (fq == 0) ssp[(size_t)row * 16 + u.pn * 4 + wc] = ss; }
            }
    }
};

struct AttnSched {
    __device__ __forceinline__ int lda(const Unit&) const { return lda_; }
    __device__ __forceinline__ int ldb(const Unit&) const { return ldb_; }
    __device__ __forceinline__ int nt(const Unit&) const { return K / BK; }
    __device__ __forceinline__ bool cont(const Unit&) const { return false; }
    int K, lda_, ldb_; const bf16_t* A; const bf16_t* Bm; int pv;
    __device__ __forceinline__ bool next(int i, Unit& u) const {
        const int c = blockIdx.x, per = gridDim.x >> 3, x = c & 7, j = c >> 3;
        const int lu = i * per + j; if (lu >= 64) return false;
        const int un = x * 64 + lu, bh = un >> 5, qb = un & 31;
        u.pm = (bh >> 2) * 32 + qb; u.pn = 0; u.e = bh & 3; return true; }
    __device__ __forceinline__ const char* a_base(const Unit&) const { return (const char*)A; }
    __device__ __forceinline__ int a_row(const Unit& u, int r) const { return u.pm * BM + r; }
    __device__ __forceinline__ int a_col(const Unit& u) const { return u.e * 256; }
    __device__ __forceinline__ const char* b_base(const Unit& u) const { const int b = u.pm >> 5;
        return pv ? (const char*)(Bm + (size_t)(b * 4 + u.e) * 65536) : (const char*)(Bm + (size_t)(b * 256) * 1024 + u.e * 256); }
};
struct KVSched {
    __device__ __forceinline__ int lda(const Unit&) const { return lda_; }
    __device__ __forceinline__ int ldb(const Unit&) const { return ldb_; }
    __device__ __forceinline__ int nt(const Unit&) const { return K / BK; }
    __device__ __forceinline__ bool cont(const Unit&) const { return false; }
    int K, lda_, ldb_; const bf16_t* MEMNB; const bf16_t* WKV;
    __device__ __forceinline__ bool next(int i, Unit& u) const {
        const int un = i * (int)gridDim.x + (int)blockIdx.x; if (un >= 32) return false;
        u.e = un >> 4; u.pm = (un & 15) >> 2; u.pn = un & 3; return true; }
    __device__ __forceinline__ const char* a_base(const Unit& u) const { return u.e ? (const char*)(WKV + (size_t)1024 * 1024) : (const char*)MEMNB; }
    __device__ __forceinline__ int a_row(const Unit& u, int r) const { return u.pm * BM + r; }
    __device__ __forceinline__ int a_col(const Unit&) const { return 0; }
    __device__ __forceinline__ const char* b_base(const Unit& u) const { return u.e ? (const char*)(MEMNB + (size_t)u.pn * BM * 1024) : (const char*)(WKV + (size_t)u.pn * BM * 1024); }
};
__device__ __forceinline__ float ssp_rs(const float* ssp, int row) {
    const f32x4 a = *(const f32x4*)(ssp + (size_t)row * 16), b = *(const f32x4*)(ssp + (size_t)row * 16 + 4), c = *(const f32x4*)(ssp + (size_t)row * 16 + 8), d = *(const f32x4*)(ssp + (size_t)row * 16 + 12);
    const float s = ((a[0] + a[1]) + (a[2] + a[3])) + ((b[0] + b[1]) + (b[2] + b[3])) + ((c[0] + c[1]) + (c[2] + c[3])) + ((d[0] + d[1]) + (d[2] + d[3]));
    return rsqrtf(s * (1.0f / D) + EPS);
}
struct EpiRowScale {
    bf16_t* O; int ldo; const float* ssp; const float* rs; float scale; int qtiles; float qscale;
    __device__ __forceinline__ void operator()(const f32x4 (&acc)[2][2][4][2], const Unit& u, int wr, int wc, int fr, int fq) const {
        const float cs = scale * (u.pn < qtiles ? qscale : 1.0f);
#pragma unroll
        for (int ai = 0; ai < 2; ++ai)
#pragma unroll
            for (int m = 0; m < 4; ++m) {
                const int row = u.pm * BM + ai * HALF + wr * 64 + m * 16 + fr;
                const float r = (rs ? rs[row] : ssp_rs(ssp, row)) * cs;
#pragma unroll
                for (int bj = 0; bj < 2; ++bj) { const int c0 = u.pn * BM + bj * HALF + wc * 32 + 8 * fq;
                    *(u32x4*)(O + (size_t)row * ldo + c0) = pack8(acc[ai][bj][m][0] * r, acc[ai][bj][m][1] * r); }
            }
    }
};
struct EpiKV {
    bf16_t* Kb; bf16_t* VT;
    __device__ __forceinline__ void operator()(const f32x4 (&acc)[2][2][4][2], const Unit& u, int wr, int wc, int fr, int fq) const {
        bf16_t* base = u.e ? VT + (size_t)(u.pn * 4 + u.pm) * 65536 : Kb + (size_t)u.pm * BM * 1024 + u.pn * BM;
        const int ld = u.e ? 256 : 1024;
#pragma unroll
        for (int ai = 0; ai < 2; ++ai)
#pragma unroll
            for (int m = 0; m < 4; ++m) { const int r = ai * HALF + wr * 64 + m * 16 + fr;
#pragma unroll
                for (int bj = 0; bj < 2; ++bj) { const int c0 = bj * HALF + wc * 32 + 8 * fq;
                    *(u32x4*)(base + (size_t)r * ld + c0) = pack8(acc[ai][bj][m][0], acc[ai][bj][m][1]); } }
    }
};
struct EpiS {
    bf16_t* P; float* psum;
    __device__ __forceinline__ void operator()(const f32x4 (&acc)[2][2][4][2], const Unit& u, int wr, int wc, int fr, int fq) const {
#pragma unroll
        for (int ai = 0; ai < 2; ++ai)
#pragma unroll
            for (int m = 0; m < 4; ++m) {
                const int row = u.pm * BM + ai * HALF + wr * 64 + m * 16 + fr; float ps = 0.f;
#pragma unroll
                for (int bj = 0; bj < 2; ++bj) { const int c0 = u.e * 256 + bj * HALF + wc * 32 + 8 * fq;
                    f32x4 e0, e1;
#pragma unroll
                    for (int j = 0; j < 4; ++j) { e0[j] = __builtin_amdgcn_exp2f(acc[ai][bj][m][0][j] * 1.4426950408889634f); e1[j] = __builtin_amdgcn_exp2f(acc[ai][bj][m][1][j] * 1.4426950408889634f); }
                    const u32x4 w = pack8(e0, e1);
                    *(u32x4*)(P + (size_t)row * D + c0) = w;
                    ps += (bf_lo(w.x) + bf_hi(w.x)) + (bf_lo(w.y) + bf_hi(w.y)) + (bf_lo(w.z) + bf_hi(w.z)) + (bf_lo(w.w) + bf_hi(w.w)); }
                ps += __shfl_xor(ps, 16); ps += __shfl_xor(ps, 32);
                if (fq == 0) psum[(size_t)row * 16 + u.e * 4 + wc] = ps;
            }
    }
};
struct EpiPV {
    bf16_t* O; const float* psum;
    __device__ __forceinline__ void operator()(const f32x4 (&acc)[2][2][4][2], const Unit& u, int wr, int wc, int fr, int fq) const {
#pragma unroll
        for (int ai = 0; ai < 2; ++ai)
#pragma unroll
            for (int m = 0; m < 4; ++m) {
                const int row = u.pm * BM + ai * HALF + wr * 64 + m * 16 + fr;
                const f32x4 s4 = *(const f32x4*)(psum + (size_t)row * 16 + u.e * 4);
                const float inv = 1.0f / ((s4[0] + s4[1]) + (s4[2] + s4[3]));
#pragma unroll
                for (int bj = 0; bj < 2; ++bj) { const int c0 = u.e * 256 + bj * HALF + wc * 32 + 8 * fq;
                    *(u32x4*)(O + (size_t)row * D + c0) = pack8(acc[ai][bj][m][0] * inv, acc[ai][bj][m][1] * inv); }
            }
    }
};

__device__ __forceinline__ int ld_agent(const int* p) { return __hip_atomic_load(p, __ATOMIC_RELAXED, __HIP_MEMORY_SCOPE_AGENT); }
struct MoeSched {
    __device__ __forceinline__ int lda(const Unit&) const { return lda_; }
    __device__ __forceinline__ int ldb(const Unit&) const { return ldb_; }
    __device__ __forceinline__ int nt(const Unit&) const { return K / BK; }
    __device__ __forceinline__ bool cont(const Unit&) const { return false; }
    int K, lda_, ldb_; const bf16_t* A; const bf16_t* W; size_t wstride; const int* tile_e; const int* slot_tok; int NT;
    __device__ __forceinline__ bool next(int i, Unit& u) const {
        const int c = blockIdx.x, per = gridDim.x >> 3, x = c & 7, j = c >> 3;
        const int tpx = (NT + 7) >> 3, lu = i * per + j, lrt = lu >> 2;
        if (lrt >= tpx) return false;
        const int rt = x * tpx + lrt; if (rt >= NT) return false;
        u.pm = rt; u.pn = lu & 3; u.e = __builtin_amdgcn_readfirstlane(ld_agent(tile_e + rt)); return true; }
    __device__ __forceinline__ const char* a_base(const Unit&) const { return (const char*)A; }
    __device__ __forceinline__ int a_row(const Unit& u, int r) const { return slot_tok ? slot_tok[u.pm * BM + r] : u.pm * BM + r; }
    __device__ __forceinline__ int a_col(const Unit&) const { return 0; }
    __device__ __forceinline__ const char* b_base(const Unit& u) const { return (const char*)(W + (size_t)u.e * wstride + (size_t)u.pn * BM * ldb_); }
};
struct EpiMoe1 {
    bf16_t* H; const float* slot_rs;
    __device__ __forceinline__ void operator()(const f32x4 (&acc)[2][2][4][2], const Unit& u, int wr, int wc, int fr, int fq) const {
        const int c0 = u.pn * 128 + wc * 32 + 8 * fq;
#pragma unroll
        for (int ai = 0; ai < 2; ++ai)
#pragma unroll
            for (int m = 0; m < 4; ++m) {
                const int row = u.pm * BM + ai * HALF + wr * 64 + m * 16 + fr; const float r = slot_rs[row];
                f32x4 o0, o1;
#pragma unroll
                for (int j = 0; j < 4; ++j) {
                    const float g0 = acc[ai][0][m][0][j] * r, g1 = acc[ai][0][m][1][j] * r;
                    o0[j] = g0 * fast_sigmoid(g0) * (acc[ai][1][m][0][j] * r);
                    o1[j] = g1 * fast_sigmoid(g1) * (acc[ai][1][m][1][j] * r); }
                *(u32x4*)(H + (size_t)row * DE + c0) = pack8(o0, o1);
            }
    }
};
struct EpiMoe2 {
    bf16_t* Y; const int* slot_a; const float* slot_gate;
    __device__ __forceinline__ void operator()(const f32x4 (&acc)[2][2][4][2], const Unit& u, int wr, int wc, int fr, int fq) const {
#pragma unroll
        for (int ai = 0; ai < 2; ++ai)
#pragma unroll
            for (int m = 0; m < 4; ++m) {
                const int row = u.pm * BM + ai * HALF + wr * 64 + m * 16 + fr; const int a = slot_a[row]; const float g = slot_gate[row];
                if (a >= 0) {
#pragma unroll
                    for (int bj = 0; bj < 2; ++bj) { const int c0 = u.pn * BM + bj * HALF + wc * 32 + 8 * fq;
                        *(u32x4*)(Y + (size_t)a * D + c0) = pack8(acc[ai][bj][m][0] * g, acc[ai][bj][m][1] * g); }
                }
            }
    }
};

struct GlaInSched {
    const bf16_t* XB; const bf16_t* WTM; const bf16_t* WFM;
    __device__ __forceinline__ int lda(const Unit&) const { return D; }
    __device__ __forceinline__ int ldb(const Unit&) const { return D; }
    __device__ __forceinline__ int nt(const Unit&) const { return D / BK; }
    __device__ __forceinline__ bool cont(const Unit&) const { return false; }
    __device__ __forceinline__ bool next(int i, Unit& u) const {
        const int c = blockIdx.x, per = gridDim.x >> 3, x = c & 7, j = c >> 3, lu = i * per + j;
        if (lu >= 224) return false;
        const int un = x * 224 + lu;
        if (un < 1024) { u.e = 0; u.pm = un >> 3; u.pn = un & 7; } else { const int v = un - 1024; u.e = 1; u.pn = v / 6; u.pm = v - u.pn * 6; }
        return true; }
    __device__ __forceinline__ const char* a_base(const Unit& u) const { return u.e ? (const char*)WFM : (const char*)XB; }
    __device__ __forceinline__ int a_row(const Unit& u, int r) const { return u.pm * BM + r; }
    __device__ __forceinline__ int a_col(const Unit&) const { return 0; }
    __device__ __forceinline__ const char* b_base(const Unit& u) const { return u.e ? (const char*)(XB + (size_t)u.pn * BM * D) : (const char*)(WTM + (size_t)u.pn * BM * D); }
};
__device__ __forceinline__ float fexp(float x) { return __builtin_amdgcn_exp2f(x * 1.4426950408889634f); }
struct EpiGlaIn {
    bf16_t* QKR; bf16_t* KVT; const float* RS; const float* BTM; const float* BFM;
    __device__ __forceinline__ void operator()(const f32x4 (&acc)[2][2][4][2], const Unit& u, int wr, int wc, int fr, int fq) const {
        if (u.e == 0) {
#pragma unroll
            for (int ai = 0; ai < 2; ++ai)
#pragma unroll
                for (int m = 0; m < 4; ++m) {
                    const int row = u.pm * BM + ai * HALF + wr * 64 + m * 16 + fr; const float r = RS[row];
#pragma unroll
                    for (int bj = 0; bj < 2; ++bj) { const int c0 = u.pn * BM + bj * HALF + wc * 32 + 8 * fq;
                        f32x4 s0 = (f32x4){r, r, r, r}, s1 = s0;
                        if (u.pn < 4) { const float sg = u.pn < 2 ? 1.0f : -1.0f, qs = u.pn < 2 ? 0.08838834764831845f : 1.0f; const int kf = c0 & 511;
                            const f32x4 b0 = *(const f32x4*)(BTM + (size_t)row * 512 + kf), b1 = *(const f32x4*)(BTM + (size_t)row * 512 + kf + 4);
#pragma unroll
                            for (int j = 0; j < 4; ++j) { s0[j] = r * qs * fexp(sg * b0[j]); s1[j] = r * qs * fexp(sg * b1[j]); } }
                        *(u32x4*)(QKR + (size_t)row * 2048 + c0) = pack8(acc[ai][bj][m][0] * s0, acc[ai][bj][m][1] * s1); }
                }
        } else {
#pragma unroll
            for (int bj = 0; bj < 2; ++bj) { const int t0 = u.pn * BM + bj * HALF + wc * 32 + 8 * fq;
                const f32x4 r0 = *(const f32x4*)(RS + t0), r1 = *(const f32x4*)(RS + t0 + 4);
#pragma unroll
                for (int ai = 0; ai < 2; ++ai)
#pragma unroll
                    for (int m = 0; m < 4; ++m) { const int f = u.pm * BM + ai * HALF + wr * 64 + m * 16 + fr;
                        f32x4 s0 = r0, s1 = r1;
                        if (u.pm < 2) { const f32x4 b0 = *(const f32x4*)(BFM + (size_t)f * T + t0), b1 = *(const f32x4*)(BFM + (size_t)f * T + t0 + 4);
#pragma unroll
                            for (int j = 0; j < 4; ++j) { s0[j] *= fexp(-b0[j]); s1[j] *= fexp(-b1[j]); } }
                        *(u32x4*)(KVT + (size_t)f * T + t0) = pack8(acc[ai][bj][m][0] * s0, acc[ai][bj][m][1] * s1); }
            }
        }
    }
};
template <int TYP> struct GlaAttSched {
    const bf16_t* QKR; const bf16_t* KVT;
    __device__ __forceinline__ bool next(int i, Unit& u) const {
        const int c = blockIdx.x, per = gridDim.x >> 3, x = c & 7, j = c >> 3, lu = i * per + j;
        if (lu >= 64) return false;
        const int un = x * 64 + lu, bh = un >> 5, cc = un & 31;
        u.e = TYP; u.pm = (bh >> 2) * 32 + cc; u.pn = bh & 3; return true; }
    __device__ __forceinline__ int lda(const Unit& u) const { return TYP ? T : 2048; }
    __device__ __forceinline__ int ldb(const Unit& u) const { return TYP ? T : 2048; }
    __device__ __forceinline__ int nt(const Unit& u) const { int n = TYP ? 4 : 2; asm volatile("" : "+s"(n)); return n; }
    __device__ __forceinline__ bool cont(const Unit&) const { return false; }
    __device__ __forceinline__ const char* a_base(const Unit& u) const { return TYP ? (const char*)KVT : (const char*)QKR; }
    __device__ __forceinline__ int a_row(const Unit& u, int r) const { return TYP ? 512 + u.pn * 256 + r : u.pm * BM + r; }
    __device__ __forceinline__ int a_col(const Unit& u) const { return TYP ? u.pm * BM : u.pn * 128; }
    __device__ __forceinline__ const char* b_base(const Unit& u) const {
        return TYP ? (const char*)(KVT + (size_t)(u.pn * 128) * T + (size_t)u.pm * BM) : (const char*)(QKR + (size_t)u.pm * BM * 2048 + 512 + u.pn * 128); }
};
template <int TYP> struct EpiGlaAtt {
    bf16_t* ATT; bf16_t* UT; const float* DL;
    __device__ __forceinline__ void operator()(const f32x4 (&acc)[2][2][4][2], const Unit& u, int wr, int wc, int fr, int fq) const {
        if (TYP == 0) {
#pragma unroll
            for (int ai = 0; ai < 2; ++ai)
#pragma unroll
                for (int m = 0; m < 4; ++m) { const int rit = ai * HALF + wr * 64 + m * 16 + fr;
#pragma unroll
                    for (int bj = 0; bj < 2; ++bj) { const int c0 = bj * HALF + wc * 32 + 8 * fq;
                        f32x4 v0 = acc[ai][bj][m][0], v1 = acc[ai][bj][m][1];
#pragma unroll
                        for (int j = 0; j < 4; ++j) { if (c0 + j > rit) v0[j] = 0.f; if (c0 + 4 + j > rit) v1[j] = 0.f; }
                        *(u32x4*)(ATT + (size_t)(u.pm * BM + rit) * D + u.pn * 256 + c0) = pack8(v0, v1); }
                }
        } else {
            const int k0 = wc * 32 + 8 * fq;
            const f32x4 d0 = *(const f32x4*)(DL + (size_t)u.pm * 512 + u.pn * 128 + k0), d1 = *(const f32x4*)(DL + (size_t)u.pm * 512 + u.pn * 128 + k0 + 4);
            const int b = u.pm >> 5, cc = u.pm & 31; bf16_t* base = UT + (size_t)((b * 4 + u.pn) * 32 + cc) * 32768;
#pragma unroll
            for (int ai = 0; ai < 2; ++ai)
#pragma unroll
                for (int m = 0; m < 4; ++m) { const int dv = ai * HALF + wr * 64 + m * 16 + fr;
                    *(u32x4*)(base + (size_t)dv * 128 + k0) = pack8(acc[ai][0][m][0] * d0, acc[ai][0][m][1] * d1); }
        }
    }
};
struct GlaOSched {
    const bf16_t* QKR; const bf16_t* KVT; const bf16_t* ATT; const bf16_t* SP;
    __device__ __forceinline__ bool next(int i, Unit& u) const {
        const int c = blockIdx.x, per = gridDim.x >> 3, x = c & 7, j = c >> 3, pl = (i >> 1) * per + j;
        if (pl >= 64) return false;
        const int w = x * 64 + pl, bh = w >> 5, cc = w & 31;
        u.e = i & 1; u.pm = (bh >> 2) * 32 + cc; u.pn = bh & 3; return true; }
    __device__ __forceinline__ int lda(const Unit& u) const { return u.e ? D : 2048; }
    __device__ __forceinline__ int ldb(const Unit& u) const { return u.e ? T : 128; }
    __device__ __forceinline__ int nt(const Unit& u) const { return u.e ? 4 : 2; }
    __device__ __forceinline__ bool cont(const Unit& u) const { return u.e == 0; }
    __device__ __forceinline__ const char* a_base(const Unit& u) const { return u.e ? (const char*)ATT : (const char*)QKR; }
    __device__ __forceinline__ int a_row(const Unit& u, int r) const { return u.pm * BM + r; }
    __device__ __forceinline__ int a_col(const Unit& u) const { return u.e ? u.pn * 256 : u.pn * 128; }
    __device__ __forceinline__ const char* b_base(const Unit& u) const { const int b = u.pm >> 5, cc = u.pm & 31;
        return u.e ? (const char*)(KVT + (size_t)(512 + u.pn * 256) * T + (size_t)u.pm * BM) : (const char*)(SP + (size_t)((b * 4 + u.pn) * 32 + cc) * 32768); }
};
struct EpiGlaO {
    bf16_t* O;
    __device__ __forceinline__ void operator()(const f32x4 (&acc)[2][2][4][2], const Unit& u, int wr, int wc, int fr, int fq) const {
#pragma unroll
        for (int ai = 0; ai < 2; ++ai)
#pragma unroll
            for (int m = 0; m < 4; ++m) { const int row = u.pm * BM + ai * HALF + wr * 64 + m * 16 + fr;
#pragma unroll
                for (int bj = 0; bj < 2; ++bj) { const int c0 = u.pn * 256 + bj * HALF + wc * 32 + 8 * fq;
                    *(u32x4*)(O + (size_t)row * D + c0) = pack8(acc[ai][bj][m][0], acc[ai][bj][m][1]); } }
    }
};
}

__device__ __forceinline__ void cvt_item(const float* W, int ldw, int col0, int K, const float* g, bf16_t* Bt, int il, int half, LAS float* scr, int item, int nblk, int lane) {
    const int kb = item / nblk, nb = item - kb * nblk, k0 = 64 * kb, n0 = 32 * nb;
#pragma unroll 8
    for (int i = 0; i < 32; ++i) { const int kk = 2 * i + (lane >> 5); float v = W[(size_t)(k0 + kk) * ldw + col0 + n0 + (lane & 31)]; if (g) v *= g[k0 + kk]; scr[kk * 33 + (lane & 31)] = v; }
    asm volatile("s_waitcnt lgkmcnt(0)" ::: "memory");
    const int c = lane & 7;
#pragma unroll
    for (int j = 0; j < 4; ++j) { const int n = n0 + (lane >> 3) + 8 * j; const LAS float* s = scr + (8 * c) * 33 + (n - n0);
        u32x4 o; o.x = cvt_pk_bf16(s[0 * 33], s[1 * 33]); o.y = cvt_pk_bf16(s[2 * 33], s[3 * 33]); o.z = cvt_pk_bf16(s[4 * 33], s[5 * 33]); o.w = cvt_pk_bf16(s[6 * 33], s[7 * 33]);
        const int drow = il ? ((n >> 7) * 256 + half * 128 + (n & 127)) : n;
        *(u32x4*)(Bt + (size_t)drow * K + k0 + 8 * c) = o; }
    asm volatile("s_waitcnt lgkmcnt(0)" ::: "memory");
}
__device__ __forceinline__ void cvt_matrix(const float* W, int ldw, int col0, int ncols, int K, const float* g, bf16_t* Bt, int il, int half, LAS unsigned char* lds) {
    const int tix = otid();
    const int lane = tix & 63, wv = tix >> 6;
    LAS float* scr = (LAS float*)(lds + wv * 8704);
    const int gw = blockIdx.x * (blockDim.x >> 6) + wv, ngw = gridDim.x * (blockDim.x >> 6);
    const int nblk = ncols / 32, nitems = (K / 64) * nblk;
    for (int it = gw; it < nitems; it += ngw) cvt_item(W, ldw, col0, K, g, Bt, il, half, scr, it, nblk, lane);
}
__device__ __forceinline__ void rows_prep(const float* x, bf16_t* XB, float* rs, float* ssp, int rows) {
    const int tix = otid();
    const int lane = tix & 63;
    const int gw = (blockIdx.x * blockDim.x + tix) >> 6, ngw = (gridDim.x * blockDim.x) >> 6;
    for (int r = gw; r < rows; r += ngw) {
        const f32x4* xr = (const f32x4*)(x + (size_t)r * D);
        f32x4 v[4]; float s = 0.f;
#pragma unroll
        for (int j = 0; j < 4; ++j) { v[j] = xr[lane + 64 * j]; s += (v[j][0] * v[j][0] + v[j][1] * v[j][1]) + (v[j][2] * v[j][2] + v[j][3] * v[j][3]); }
        s = wave_sum(s);
        if (lane == 0) rs[r] = rsqrtf(s * (1.0f / D) + EPS);
        if (ssp && lane < 16) ssp[(size_t)r * 16 + lane] = lane == 0 ? s : 0.f;
        u32x2* o = (u32x2*)(XB + (size_t)r * D);
#pragma unroll
        for (int j = 0; j < 4; ++j) { u32x2 w; w.x = cvt_pk_bf16(v[j][0], v[j][1]); w.y = cvt_pk_bf16(v[j][2], v[j][3]); o[lane + 64 * j] = w; }
    }
}

__device__ __forceinline__ void rows_norm_bf16(const float* x, const float* g, bf16_t* out, int rows) {
    const int tix = otid();
    const int lane = tix & 63;
    const int gw = (blockIdx.x * blockDim.x + tix) >> 6, ngw = (gridDim.x * blockDim.x) >> 6;
    for (int r = gw; r < rows; r += ngw) {
        const f32x4* xr = (const f32x4*)(x + (size_t)r * D);
        f32x4 v[4]; float s = 0.f;
#pragma unroll
        for (int j = 0; j < 4; ++j) { v[j] = xr[lane + 64 * j]; s += (v[j][0] * v[j][0] + v[j][1] * v[j][1]) + (v[j][2] * v[j][2] + v[j][3] * v[j][3]); }
        s = wave_sum(s); const float rs = rsqrtf(s * (1.0f / D) + EPS);
        u32x2* o = (u32x2*)(out + (size_t)r * D);
#pragma unroll
        for (int j = 0; j < 4; ++j) { const f32x4 gg = ((const f32x4*)g)[lane + 64 * j]; u32x2 w; w.x = cvt_pk_bf16(v[j][0] * rs * gg[0], v[j][1] * rs * gg[1]); w.y = cvt_pk_bf16(v[j][2] * rs * gg[2], v[j][3] * rs * gg[3]); o[lane + 64 * j] = w; }
    }
}

__device__ __forceinline__ void route_prep(const float* wg, const float* we, const float* gain, float* WR) {
    const int tix = otid();
    const int gi = blockIdx.x * blockDim.x + tix, gs = gridDim.x * blockDim.x;
    for (int i = gi; i < 36 * 1024; i += gs) { const int j = i >> 10, k = i & 1023; WR[i] = (j < 32 ? we[k * NE + j] : wg[k * NG + (j - 32)]) * gain[k]; }
}
__device__ __forceinline__ float reduce16(float (&v)[18], int lane) {
#pragma unroll
    for (int st = 0; st < 4; ++st) { const int half = 8 >> st, bit = 32 >> st; const bool up = (lane & bit) != 0;
#pragma unroll
        for (int k = 0; k < half; ++k) { const float send = up ? v[k] : v[k + half]; const float keep = up ? v[k + half] : v[k]; v[k] = keep + __shfl_xor(send, bit); } }
    float r = v[0]; r += __shfl_xor(r, 2); r += __shfl_xor(r, 1); return r;
}
__device__ __forceinline__ float reduce2(const float (&v)[18], int lane) {
    const bool up = (lane & 32) != 0; const float send = up ? v[16] : v[17], keep = up ? v[17] : v[16];
    float r = keep + __shfl_xor(send, 32);
#pragma unroll
    for (int o = 16; o >= 1; o >>= 1) r += __shfl_xor(r, o);
    return r;
}
__device__ __forceinline__ void route_phase(const float* X, const float* WR, const float* bg, const float* be, float* RS, int* assign_e, int* assign_pos, float* gate, int* gcnt, LAS unsigned char* lds) {
    int tid_ = threadIdx.x; asm volatile("" : "+v"(tid_)); const int tid = tid_, lane = tid & 63, wv = tid >> 6;
    LAS float* Wr = (LAS float*)lds;
    LAS int* lcnt = (LAS int*)(lds + 36 * 4096); LAS int* lbase = lcnt + 32; LAS int* l_e = lbase + 32; LAS int* l_rank = l_e + 256;
    for (int i = tid; i < 36 * 256; i += 512) ((LAS f32x4*)Wr)[i] = ((const f32x4*)WR)[i];
    for (int tb = blockIdx.x; tb < T / 128; tb += gridDim.x) {
        if (tid < 32) lcnt[tid] = 0;
        __syncthreads();
#pragma unroll 1
        for (int it = 0; it < 8; ++it) {
            const int tl0 = wv * 16 + it * 2, t0 = tb * 128 + tl0;
            f32x4 xv[2][4]; float rsv[2];
#pragma unroll
            for (int r = 0; r < 2; ++r) { float s = 0.f;
#pragma unroll
                for (int c = 0; c < 4; ++c) { xv[r][c] = *(const f32x4*)(X + (size_t)(t0 + r) * D + 256 * c + 4 * lane); s += (xv[r][c][0] * xv[r][c][0] + xv[r][c][1] * xv[r][c][1]) + (xv[r][c][2] * xv[r][c][2] + xv[r][c][3] * xv[r][c][3]); }
                rsv[r] = rsqrtf(wave_sum(s) * (1.0f / D) + EPS); }
            LAS float* lg = (LAS float*)(lds + 36 * 4096 + 4096) + wv * 160;
#pragma unroll 1
            for (int q = 0; q < 4; ++q) {
                float acc[2][9];
#pragma unroll
                for (int r = 0; r < 2; ++r)
#pragma unroll
                    for (int j = 0; j < 9; ++j) acc[r][j] = 0.f;
                const unsigned be_ = (unsigned)(8 * q * 4096 + 16 * lane), bg_ = (unsigned)((32 + q) * 4096 + 16 * lane);
#pragma unroll
                for (int j = 0; j < 9; ++j) {
#pragma unroll
                    for (int c = 0; c < 4; ++c) {
                        const f32x4 w4 = j < 8 ? *(const LAS f32x4*)(lds + be_ + j * 4096 + c * 1024) : *(const LAS f32x4*)(lds + bg_ + c * 1024);
#pragma unroll
                        for (int r = 0; r < 2; ++r) acc[r][j] = fmaf(xv[r][c][3], w4[3], fmaf(xv[r][c][2], w4[2], fmaf(xv[r][c][1], w4[1], fmaf(xv[r][c][0], w4[0], acc[r][j])))); }
                    if (j % 3 == 2) __builtin_amdgcn_sched_barrier(0);
                }
#pragma unroll
                for (int r = 0; r < 2; ++r) {
                    const float g1 = wave_sum(acc[r][8]);
#pragma unroll
                    for (int st = 0; st < 3; ++st) { const int half = 4 >> st, bit = 32 >> st; const bool up = (lane & bit) != 0;
#pragma unroll
                        for (int k = 0; k < half; ++k) { const float send = up ? acc[r][k] : acc[r][k + half]; const float keep = up ? acc[r][k + half] : acc[r][k]; acc[r][k] = keep + __shfl_xor(send, bit); } }
                    float e8 = acc[r][0]; e8 += __shfl_xor(e8, 4); e8 += __shfl_xor(e8, 2); e8 += __shfl_xor(e8, 1);
                    if ((lane & 7) == 0) lg[r * 40 + 8 * q + (lane >> 3)] = e8;
                    if (lane == 0) lg[r * 40 + 32 + q] = g1;
                }
            }
            asm volatile("s_waitcnt lgkmcnt(0)" ::: "memory");
            {
                const int r = lane & 1; const LAS float* L = lg + r * 40;
                const float rs = r == 0 ? rsv[0] : rsv[1];
                float gl[4];
#pragma unroll
                for (int g = 0; g < 4; ++g) gl[g] = L[32 + g] * rs + bg[g];
                int gs = 0; float gm = gl[0];
#pragma unroll
                for (int g = 1; g < 4; ++g) if (gl[g] > gm) { gm = gl[g]; gs = g; }
                float se = 0.f;
#pragma unroll
                for (int g = 0; g < 4; ++g) se += expf(gl[g] - gm);
                const float pg = 1.0f / se;
                float el[8];
#pragma unroll
                for (int i = 0; i < 8; ++i) el[i] = L[gs * 8 + i] * rs + be[gs * 8 + i];
                float em = el[0];
#pragma unroll
                for (int i = 1; i < 8; ++i) em = fmaxf(em, el[i]);
                float pe[8], ps = 0.f;
#pragma unroll
                for (int i = 0; i < 8; ++i) { pe[i] = expf(el[i] - em); ps += pe[i]; }
#pragma unroll
                for (int i = 0; i < 8; ++i) pe[i] = pe[i] / ps;
                int i1 = 0; float p1 = pe[0];
#pragma unroll
                for (int i = 1; i < 8; ++i) if (pe[i] > p1) { p1 = pe[i]; i1 = i; }
                int i2 = -1; float p2 = -1.f;
#pragma unroll
                for (int i = 0; i < 8; ++i) if (i != i1 && pe[i] > p2) { p2 = pe[i]; i2 = i; }
                if (lane < 2) {
                    const int t = t0 + r, tl = tl0 + r; const float den = p1 + p2; const int e1 = gs * 8 + i1, e2 = gs * 8 + i2;
                    RS[t] = rs; gate[2 * t] = pg * p1 / den; gate[2 * t + 1] = pg * p2 / den;
                    l_e[2 * tl] = e1; l_e[2 * tl + 1] = e2;
                    l_rank[2 * tl] = atomicAdd((int*)(lcnt + e1), 1); l_rank[2 * tl + 1] = atomicAdd((int*)(lcnt + e2), 1);
                }
            }
        }
        __syncthreads();
        if (tid < 32) lbase[tid] = __hip_atomic_fetch_add(gcnt + tid, lcnt[tid], __ATOMIC_RELAXED, __HIP_MEMORY_SCOPE_AGENT);
        __syncthreads();
        if (tid < 256) { const int a = tb * 256 + tid, e = l_e[tid]; assign_e[a] = e; assign_pos[a] = lbase[e] + l_rank[tid]; }
        __syncthreads();
    }
}
__device__ __forceinline__ void build_phase(const int* gcnt, const int* assign_e, const int* assign_pos, const float* gate, const float* RS,
                                            int* ntiles, int* tile_e, int* slot_tok, int* slot_a, float* slot_rs, float* slot_gate, LAS unsigned char* lds) {
    const int tix = otid();
    LAS int* poff = (LAS int*)lds; LAS int* cn = poff + 40;
    if (tix == 0) { int o = 0; for (int e = 0; e < 32; ++e) { const int cc = g8::ld_agent(gcnt + e); cn[e] = cc; poff[e] = o; o += (cc + 255) / 256 * 256; } poff[32] = o; }
    __syncthreads();
    const int gi = blockIdx.x * blockDim.x + tix, gs = gridDim.x * blockDim.x;
    for (int a = gi; a < NA; a += gs) { const int e = assign_e[a]; const int sl = poff[e] + assign_pos[a]; slot_tok[sl] = a >> 1; slot_a[sl] = a; slot_rs[sl] = RS[a >> 1]; slot_gate[sl] = gate[a]; }
    for (int i = gi; i < 32 * 256; i += gs) { const int e = i >> 8, sl = poff[e] + cn[e] + (i & 255); if (sl < poff[e + 1]) { slot_tok[sl] = 0; slot_a[sl] = -1; slot_rs[sl] = 0.f; slot_gate[sl] = 0.f; } }
    if (blockIdx.x == 0) {
        const int NT = poff[32] >> 8;
        for (int rt = tix; rt < NT; rt += blockDim.x) { int e = 0; for (int k = 0; k < 32; ++k) if (rt * 256 >= poff[k] && rt * 256 < poff[k + 1]) e = k; tile_e[rt] = e; }
        if (tix == 0) *ntiles = NT;
    }
    __syncthreads();
}
__device__ __forceinline__ void cvt_moe(const float* wgate, const float* wup, const float* wdown, const float* gain, bf16_t* W1, bf16_t* W2, LAS unsigned char* lds) {
    const int tix = otid();
    const int lane = tix & 63, wv = tix >> 6;
    LAS float* scr = (LAS float*)(lds + 1024 + wv * 8704);
    const int gw = blockIdx.x * (blockDim.x >> 6) + wv, ngw = gridDim.x * (blockDim.x >> 6);
    for (int it = gw; it < 32 * 768; it += ngw) {
        const int e = it / 768, r = it - e * 768;
        if (r < 256) cvt_item(wgate + (size_t)e * D * DE, DE, 0, D, gain, W1 + (size_t)e * D * D, 1, 0, scr, r, 16, lane);
        else if (r < 512) cvt_item(wup + (size_t)e * D * DE, DE, 0, D, gain, W1 + (size_t)e * D * D, 1, 1, scr, r - 256, 16, lane);
        else cvt_item(wdown + (size_t)e * DE * D, D, 0, DE, nullptr, W2 + (size_t)e * D * DE, 0, 0, scr, r - 512, 32, lane);
    }
}
__device__ __forceinline__ void combine_phase(float* X, const bf16_t* Y, bf16_t* XB, float* RS, float* ssp, const float* gfinal, int fin, const float* WA, float* ALR, LAS unsigned char* lds) {
    const int tix = otid();
    const int lane = tix & 63;
    if (WA) { for (int i = tix; i < 16 * 256; i += 512) ((LAS f32x4*)lds)[i] = ((const f32x4*)WA)[i]; __syncthreads(); }
    const int gw = (blockIdx.x * blockDim.x + tix) >> 6, ngw = (gridDim.x * blockDim.x) >> 6;
    for (int t = gw; t < T; t += ngw) {
        f32x4 v[4]; float s = 0.f;
#pragma unroll
        for (int j = 0; j < 4; ++j) {
            v[j] = ((const f32x4*)(X + (size_t)t * D))[lane + 64 * j];
            const u32x2 y0 = ((const u32x2*)(Y + (size_t)(2 * t) * D))[lane + 64 * j], y1 = ((const u32x2*)(Y + (size_t)(2 * t + 1) * D))[lane + 64 * j];
            v[j][0] += bf_lo(y0.x) + bf_lo(y1.x); v[j][1] += bf_hi(y0.x) + bf_hi(y1.x); v[j][2] += bf_lo(y0.y) + bf_lo(y1.y); v[j][3] += bf_hi(y0.y) + bf_hi(y1.y);
            s += (v[j][0] * v[j][0] + v[j][1] * v[j][1]) + (v[j][2] * v[j][2] + v[j][3] * v[j][3]); }
        s = wave_sum(s); const float rs = rsqrtf(s * (1.0f / D) + EPS);
        if (fin) {
#pragma unroll
            for (int j = 0; j < 4; ++j) { const f32x4 gg = ((const f32x4*)gfinal)[lane + 64 * j]; ((f32x4*)(X + (size_t)t * D))[lane + 64 * j] = v[j] * rs * gg; }
        } else {
            if (lane == 0) RS[t] = rs;
            if (lane < 16) ssp[(size_t)t * 16 + lane] = lane == 0 ? s : 0.f;
            if (WA) {
                float a16[18];
#pragma unroll
                for (int o = 0; o < 16; ++o) { float p = 0.f;
#pragma unroll
                    for (int j = 0; j < 4; ++j) { const f32x4 w4 = *(const LAS f32x4*)(lds + (o * 1024 + 256 * j + 4 * lane) * 4);
                        p = fmaf(v[j][3], w4[3], fmaf(v[j][2], w4[2], fmaf(v[j][1], w4[1], fmaf(v[j][0], w4[0], p)))); }
                    a16[o] = p; }
                a16[16] = 0.f; a16[17] = 0.f;
                const float red = reduce16(a16, lane);
                if ((lane & 3) == 0) ALR[(size_t)t * 16 + (lane >> 2)] = red * rs;
            }
#pragma unroll
            for (int j = 0; j < 4; ++j) { ((f32x4*)(X + (size_t)t * D))[lane + 64 * j] = v[j];
                u32x2 w; w.x = cvt_pk_bf16(v[j][0], v[j][1]); w.y = cvt_pk_bf16(v[j][2], v[j][3]); ((u32x2*)(XB + (size_t)t * D))[lane + 64 * j] = w; }
        }
    }
}

__device__ __forceinline__ void gla_prep(const float* win, const float* wo, const float* gain, bf16_t* WGTM, bf16_t* WGFM, bf16_t* WGO, float* WA, LAS unsigned char* lds) {
    cvt_matrix(win, GLA_COLS, 0, 512, D, gain, WGTM, 0, 0, lds);
    cvt_matrix(win, GLA_COLS, 512, 512, D, gain, WGTM + (size_t)512 * D, 0, 0, lds);
    cvt_matrix(win, GLA_COLS, 2064, 1024, D, gain, WGTM + (size_t)1024 * D, 0, 0, lds);
    cvt_matrix(win, GLA_COLS, 512, 512, D, gain, WGFM, 0, 0, lds);
    cvt_matrix(win, GLA_COLS, 1024, 1024, D, gain, WGFM + (size_t)512 * D, 0, 0, lds);
    cvt_matrix(wo, D, 0, D, D, nullptr, WGO, 0, 0, lds);
    const int tix = otid(); const int gi = blockIdx.x * blockDim.x + tix, gs = gridDim.x * blockDim.x;
    for (int i = gi; i < 16 * 1024; i += gs) { const int j = i >> 10, k = i & 1023; WA[i] = win[(size_t)k * GLA_COLS + 2048 + j] * gain[k]; }
}
__device__ __forceinline__ void gla_decay(const float* ALR, const float* wa2, const float* ba, float* BTM, float* BFM, float* DL) {
    const int tix = otid(); const int gi = blockIdx.x * blockDim.x + tix, gs = gridDim.x * blockDim.x;
    for (int it = gi; it < 128 * 512; it += gs) {
        const int ch = it >> 9, kf = it & 511, t0 = ch * 256;
        float w[16];
#pragma unroll
        for (int r = 0; r < 16; ++r) w[r] = wa2[r * GDK + kf];
        const float bias = ba[kf]; float b = 0.f;
#pragma unroll 1
        for (int s16 = 0; s16 < 16; ++s16) {
            float ring[16];
#pragma unroll
            for (int q = 0; q < 16; ++q) {
                const int t = t0 + s16 * 16 + q;
                const f32x4 a0 = *(const f32x4*)(ALR + (size_t)t * 16), a1 = *(const f32x4*)(ALR + (size_t)t * 16 + 4), a2 = *(const f32x4*)(ALR + (size_t)t * 16 + 8), a3 = *(const f32x4*)(ALR + (size_t)t * 16 + 12);
                float z = bias;
#pragma unroll
                for (int r = 0; r < 4; ++r) { z = fmaf(a0[r], w[r], z); z = fmaf(a1[r], w[4 + r], z); z = fmaf(a2[r], w[8 + r], z); z = fmaf(a3[r], w[12 + r], z); }
                const float ls = fminf(z, 0.f) - log1pf(expf(-fabsf(z)));
                b += ls * (1.0f / 16.0f);
                BTM[(size_t)t * 512 + kf] = b; ring[q] = b;
            }
            f32x4* o = (f32x4*)(BFM + (size_t)kf * T + t0 + s16 * 16);
#pragma unroll
            for (int q = 0; q < 4; ++q) o[q] = (f32x4){ring[4 * q], ring[4 * q + 1], ring[4 * q + 2], ring[4 * q + 3]};
        }
        DL[(size_t)ch * 512 + kf] = expf(b);
    }
}
__device__ __forceinline__ void gla_scan(const bf16_t* UT, const float* DL, bf16_t* SP) {
    const int tix = otid(); const int gi = blockIdx.x * blockDim.x + tix, gs = gridDim.x * blockDim.x;
    for (int it = gi; it < 16 * 32768 / 2; it += gs) {
        const int bh = it >> 14, idx = (it & 16383) * 2, k = idx & 127, b = bh >> 2, h = bh & 3;
        float s0 = 0.f, s1 = 0.f;
        for (int c = 0; c < 32; ++c) {
            const size_t off = (size_t)(bh * 32 + c) * 32768 + idx;
            const unsigned uu = *(const unsigned*)(UT + off);
            *(unsigned*)(SP + off) = cvt_pk_bf16(s0, s1);
            const f32x2 d = *(const f32x2*)(DL + (size_t)(b * 32 + c) * 512 + h * 128 + k);
            s0 = fmaf(d[0], s0, bf_lo(uu)); s1 = fmaf(d[1], s1, bf_hi(uu));
        }
    }
}
__device__ __forceinline__ void gla_fin(const bf16_t* O, const bf16_t* QKR, const float* ng, bf16_t* GO) {
    const int tix = otid(); const int lane = tix & 63;
    const int gw = (blockIdx.x * blockDim.x + tix) >> 6, ngw = (gridDim.x * blockDim.x) >> 6;
    const f32x4 gg = ((const f32x4*)ng)[lane];
    for (int t = gw; t < T; t += ngw) {
#pragma unroll
        for (int j = 0; j < 4; ++j) {
            const u32x2 ow = ((const u32x2*)(O + (size_t)t * D))[lane + 64 * j], rw = ((const u32x2*)(QKR + (size_t)t * 2048 + 1024))[lane + 64 * j];
            const f32x4 o = (f32x4){bf_lo(ow.x), bf_hi(ow.x), bf_lo(ow.y), bf_hi(ow.y)}, r = (f32x4){bf_lo(rw.x), bf_hi(rw.x), bf_lo(rw.y), bf_hi(rw.y)};
            const float ss = wave_sum((o[0] * o[0] + o[1] * o[1]) + (o[2] * o[2] + o[3] * o[3]));
            const float rs = rsqrtf(ss * (1.0f / GDVH) + EPS);
            f32x4 y;
#pragma unroll
            for (int q = 0; q < 4; ++q) y[q] = o[q] * rs * gg[q] * (r[q] * fast_sigmoid(r[q]));
            u32x2 w; w.x = cvt_pk_bf16(y[0], y[1]); w.y = cvt_pk_bf16(y[2], y[3]);
            ((u32x2*)(GO + (size_t)t * D))[lane + 64 * j] = w;
        }
    }
}

__device__ __forceinline__ void conv_phase(const bf16_t* U, const float* wdw, const float* bdw, const float* lng, const float* lnb, bf16_t* CV, LAS unsigned char* lds) {
    int tid_ = threadIdx.x; asm volatile("" : "+v"(tid_));
    const int tid = tid_, lane = tid & 63, wv = tid >> 6, c0 = 2 * tid;
    LAS float* red = (LAS float*)lds; LAS float* tot = red + 512;
    f32x2 w[CONVK];
#pragma unroll
    for (int j = 0; j < CONVK; ++j) w[j] = *(const f32x2*)(wdw + j * D + c0);
    const f32x2 bd = *(const f32x2*)(bdw + c0), lg = *(const f32x2*)(lng + c0), lb = *(const f32x2*)(lnb + c0);
    for (int item = blockIdx.x; item < T / 32; item += gridDim.x) {
        const int t0 = item * 32, s0 = t0 & (S - 1);
        f32x2 acc[32];
#pragma unroll
        for (int o = 0; o < 32; ++o) acc[o] = bd;
#pragma unroll
        for (int r = 0; r < 62; ++r) {
            unsigned raw = 0u;
            if (s0 - 30 + r >= 0) raw = *(const unsigned*)(U + (size_t)(t0 - 30 + r) * D + c0);
            const f32x2 uv = (f32x2){bf_lo(raw), bf_hi(raw)};
#pragma unroll
            for (int o = (r > 30 ? r - 30 : 0); o <= (r < 31 ? r : 31); ++o) acc[o] = __builtin_elementwise_fma(uv, w[r - o], acc[o]);
        }
        float v[64];
#pragma unroll
        for (int o = 0; o < 32; ++o) { v[o] = acc[o][0] + acc[o][1]; v[32 + o] = acc[o][0] * acc[o][0] + acc[o][1] * acc[o][1]; }
#pragma unroll
        for (int st = 0; st < 6; ++st) {
            const int half = 32 >> st, bit = 32 >> st; const bool up = (lane & bit) != 0;
#pragma unroll
            for (int k = 0; k < half; ++k) { const float send = up ? v[k] : v[k + half]; const float keep = up ? v[k + half] : v[k]; v[k] = keep + __shfl_xor(send, bit); }
        }
        red[wv * 64 + lane] = v[0];
        __syncthreads();
        if (tid < 64) { float s = 0.f;
#pragma unroll
            for (int q = 0; q < 8; ++q) s += red[q * 64 + tid];
            tot[tid] = s; }
        __syncthreads();
#pragma unroll
        for (int o = 0; o < 32; ++o) {
            const float mu = tot[o] * (1.0f / D), var = tot[32 + o] * (1.0f / D) - mu * mu, rstd = rsqrtf(var + EPS);
            const float y0 = (acc[o][0] - mu) * rstd * lg[0] + lb[0], y1 = (acc[o][1] - mu) * rstd * lg[1] + lb[1];
            *(unsigned*)(CV + (size_t)(t0 + o) * D + c0) = cvt_pk_bf16(y0 * fast_sigmoid(y0), y1 * fast_sigmoid(y1));
        }
        __syncthreads();
    }
}

enum Ph { PH_PREP0 = 0, PH_CONV_IN, PH_CONV_MID, PH_CONV_OUT, PH_ADAPT, PH_XA_PREP, PH_XA_Q, PH_XA_KV, PH_XA_S, PH_XA_PV, PH_XA_O, PH_ROUTE_PREP, PH_ROUTE, PH_BUILD, PH_MOE1, PH_MOE2, PH_COMBINE, PH_COMBINE_FIN, PH_GLA_PREP, PH_GLA_DECAY, PH_GLA_IN, PH_GLA_ATT, PH_GLA_UT, PH_GLA_SCAN, PH_GLA_O, PH_GLA_FIN, PH_GLA_OUT, PH_N };

__device__ __forceinline__ void run_phase(const Ctx& c, int ph, int l, LAS unsigned char* lds) {
    unsigned char* ws = c.ws;
    bf16_t* XB = (bf16_t*)(ws + OW_XB); float* RS = (float*)(ws + OW_RS); float* SSP = (float*)(ws + OW_SSP);
    bf16_t* ACTA = (bf16_t*)(ws + OW_ACTA); bf16_t* ACTB = (bf16_t*)(ws + OW_ACTB);
    bf16_t* WCIN = (bf16_t*)(ws + OW_WCIN); bf16_t* WCOUT = (bf16_t*)(ws + OW_WCOUT);
    bf16_t* ACTC = (bf16_t*)(ws + OW_ACTC); float* PSUM = (float*)(ws + OW_PSUM);
    bf16_t* WXQ = (bf16_t*)(ws + OW_WXQ) + (size_t)l * D * D; bf16_t* WXKV = (bf16_t*)(ws + OW_WXKV) + (size_t)l * 2048 * D; bf16_t* WXO = (bf16_t*)(ws + OW_WXO) + (size_t)l * D * D;
    float* WR = (float*)(ws + OW_WR) + (size_t)l * 36 * 1024;
    int* GCNT = (int*)(ws + OM_GCNT); int* NTP = (int*)(ws + OM_NT); int* TILEE = (int*)(ws + OM_TILEE); int* AE = (int*)(ws + OM_AE); int* APOS = (int*)(ws + OM_APOS); float* GATE = (float*)(ws + OM_GATE);
    int* STOK = (int*)(ws + OM_STOK); int* SA = (int*)(ws + OM_SA); float* SRS = (float*)(ws + OM_SRS); float* SGATE = (float*)(ws + OM_SGATE);
    bf16_t* HB = (bf16_t*)(ws + OW_H); bf16_t* YB = (bf16_t*)(ws + OW_Y); bf16_t* W1 = (bf16_t*)(ws + OW_WMOE); bf16_t* W2 = W1 + (size_t)NE * D * D;
    bf16_t* ATTB = (bf16_t*)(ws + OW_ATT); bf16_t* QKR = (bf16_t*)(ws + OW_QKR); bf16_t* KVT = (bf16_t*)(ws + OW_KVT); float* BTM = (float*)(ws + OW_BTM); float* BFM = (float*)(ws + OW_BFM);
    bf16_t* OB = (bf16_t*)(ws + OW_O); bf16_t* UTB = (bf16_t*)(ws + OW_UT); bf16_t* SPB = (bf16_t*)(ws + OW_SP); float* ALR = (float*)(ws + OW_ALR); float* DLF = (float*)(ws + OW_DL); bf16_t* GOB = (bf16_t*)(ws + OW_GO);
    bf16_t* WGTM = (bf16_t*)(ws + OW_WGTM); bf16_t* WGFM = (bf16_t*)(ws + OW_WGFM); bf16_t* WGO = (bf16_t*)(ws + OW_WGO); float* WAF = (float*)(ws + OW_WA);
    bf16_t* KB = (bf16_t*)(ws + OW_KVB); bf16_t* VT = KB + (size_t)1024 * 1024; bf16_t* MEMNB = (bf16_t*)(ws + OW_MEMNB);
    switch (ph) {
    case PH_PREP0:
        cvt_matrix(c.in[7], 2048, 0, 1024, D, c.in[2], WCIN, 1, 0, lds);
        cvt_matrix(c.in[7], 2048, 1024, 1024, D, c.in[2], WCIN, 1, 1, lds);
        cvt_matrix(c.in[13], D, 0, D, D, nullptr, WCOUT, 0, 0, lds);
        rows_prep(c.in[0], XB, RS, nullptr, T);
        break;
    case PH_CONV_IN: { g8::DenseSched S{8, 128 * 8, D, D, D, XB, WCIN}; g8::gemm_phase(lds, S, g8::EpiGlu{ACTA, RS, c.in[8]}); } break;
    case PH_CONV_MID: conv_phase(ACTA, c.in[9], c.in[10], c.in[11], c.in[12], ACTB, lds); break;
    case PH_CONV_OUT: { g8::DenseSched S{4, 128 * 4, D, D, D, ACTB, WCOUT}; g8::gemm_phase(lds, S, g8::EpiXres{c.in[0], c.out, XB, c.in[14], SSP}); } break;
    case PH_ADAPT: rows_prep(c.out, XB, RS, SSP, T); break;
    case PH_XA_PREP:
        cvt_matrix(c.in[20] + (size_t)l * D * D, D, 0, D, D, c.in[3] + l * D, WXQ, 0, 0, lds);
        cvt_matrix(c.in[21] + (size_t)l * D * 2048, 2048, 0, 2048, D, nullptr, WXKV, 0, 0, lds);
        cvt_matrix(c.in[22] + (size_t)l * D * D, D, 0, D, D, nullptr, WXO, 0, 0, lds);
        rows_norm_bf16(c.in[1], c.in[5], MEMNB, NB * NMEM);
        break;
    case PH_XA_Q: { g8::DenseSched S{4, 128 * 4, D, D, D, XB, WXQ}; g8::gemm_phase(lds, S, g8::EpiRowScale{ACTA, D, SSP, nullptr, 0.0625f, 0, 1.0f}); } break;
    case PH_XA_KV: { g8::KVSched S{D, D, D, MEMNB, WXKV}; g8::gemm_phase(lds, S, g8::EpiKV{KB, VT}); } break;
    case PH_XA_S: { g8::AttnSched S{256, D, D, ACTA, KB, 0}; g8::gemm_phase(lds, S, g8::EpiS{ACTB, PSUM}); } break;
    case PH_XA_PV: { g8::AttnSched S{256, D, 256, ACTB, VT, 1}; g8::gemm_phase(lds, S, g8::EpiPV{ACTC, PSUM}); } break;
    case PH_XA_O: { g8::DenseSched S{4, 128 * 4, D, D, D, ACTC, WXO}; g8::gemm_phase(lds, S, g8::EpiXres{c.out, c.out, XB, nullptr, nullptr}); } break;
    case PH_ROUTE_PREP: route_prep(c.in[23] + (size_t)l * D * NG, c.in[25] + (size_t)l * D * NE, c.in[4] + l * D, WR);
        { const int tix = otid(); if (blockIdx.x == 0 && tix < 32) GCNT[tix] = 0; }
        break;
    case PH_ROUTE: route_phase(c.out, WR, c.in[24] + l * NG, c.in[26] + l * NE, RS, AE, APOS, GATE, GCNT, lds); break;
    case PH_BUILD: build_phase(GCNT, AE, APOS, GATE, RS, NTP, TILEE, STOK, SA, SRS, SGATE, lds);
        cvt_moe(c.in[27] + (size_t)l * NE * D * DE, c.in[28] + (size_t)l * NE * D * DE, c.in[29] + (size_t)l * NE * DE * D, c.in[4] + l * D, W1, W2, lds);
        break;
    case PH_MOE1: { g8::MoeSched S{D, D, D, XB, W1, (size_t)D * D, TILEE, STOK, __builtin_amdgcn_readfirstlane(g8::ld_agent(NTP))}; g8::gemm_phase(lds, S, g8::EpiMoe1{HB, SRS}); } break;
    case PH_MOE2: { g8::MoeSched S{DE, DE, DE, HB, W2, (size_t)D * DE, TILEE, nullptr, __builtin_amdgcn_readfirstlane(g8::ld_agent(NTP))}; g8::gemm_phase(lds, S, g8::EpiMoe2{YB, SA, SGATE}); } break;
    case PH_COMBINE: combine_phase(c.out, YB, XB, RS, SSP, nullptr, 0, WAF, ALR, lds); break;
    case PH_COMBINE_FIN: combine_phase(c.out, YB, XB, RS, SSP, c.in[6], 1, nullptr, nullptr, lds); break;
    case PH_GLA_PREP: gla_prep(c.in[15], c.in[19], c.in[2] + D, WGTM, WGFM, WGO, WAF, lds); break;
    case PH_GLA_DECAY: gla_decay(ALR, c.in[16], c.in[17], BTM, BFM, DLF); break;
    case PH_GLA_IN: { g8::GlaInSched S{XB, WGTM, WGFM}; g8::gemm_phase(lds, S, g8::EpiGlaIn{QKR, KVT, RS, BTM, BFM}); } break;
    case PH_GLA_ATT: { g8::GlaAttSched<0> S{QKR, KVT}; g8::gemm_phase(lds, S, g8::EpiGlaAtt<0>{ATTB, UTB, DLF}); } break;
    case PH_GLA_UT: { g8::GlaAttSched<1> S{QKR, KVT}; g8::gemm_phase(lds, S, g8::EpiGlaAtt<1>{ATTB, UTB, DLF}); } break;
    case PH_GLA_SCAN: gla_scan(UTB, DLF, SPB); break;
    case PH_GLA_O: { g8::GlaOSched S{QKR, KVT, ATTB, SPB}; g8::gemm_phase(lds, S, g8::EpiGlaO{OB}); } break;
    case PH_GLA_FIN: gla_fin(OB, QKR, c.in[18], GOB); break;
    case PH_GLA_OUT: { g8::DenseSched S{4, 128 * 4, D, D, D, GOB, WGO}; g8::gemm_phase(lds, S, g8::EpiXres{c.out, c.out, XB, nullptr, SSP}); } break;
    }
}
template <int PH> __global__ void __launch_bounds__(512, 2) k_opt(Ctx c, int l) {
    extern __shared__ __attribute__((aligned(16))) unsigned char dynlds[];
    run_phase(c, PH, l, (LAS unsigned char*)dynlds);
}
#ifndef COOP
#define COOP 1
#endif
enum Op { OP_MEMN = 0, OP_MEMKV, OP_COPYX, OP_RMS_MIX, OP_CONV_IN, OP_GLU, OP_DWCONV, OP_CONV_OUT, OP_GLA_IN, OP_GLA_DECAY, OP_GLA_REC, OP_GLA_NORM, OP_GLA_OUT,
          OP_RMS_XA, OP_XA_Q, OP_XA_ATT, OP_XA_O, OP_RMS_FFN, OP_ROUTE, OP_BUILD, OP_MOE_GATE, OP_MOE_UP, OP_MOE_ACT, OP_MOE_DOWN, OP_MOE_COMBINE, OP_FINAL };

__device__ __forceinline__ void run_op(const Ctx& c, int op, int l, float* sm) {
    unsigned char* ws = c.ws;
    float* HN = (float*)(ws + WS_HN); float* BIG = (float*)(ws + WS_BIG);
    float* MEMN = (float*)(ws + WS_MEMN); float* KV = (float*)(ws + WS_KV) + (size_t)l * 1024 * 2048;
    int* eid = (int*)(ws + WS_EID); float* gate = (float*)(ws + WS_GATE); int* pos = (int*)(ws + WS_POS);
    int* slot_tok = (int*)(ws + WS_SLOTTOK); int* slot_a = (int*)(ws + WS_SLOTA); int* tile_e = (int*)(ws + WS_TILEE); int* cnt = (int*)(ws + WS_CNT);
    float* X = c.out;
    switch (op) {
    case OP_MEMN: n_rms(c.in[1], c.in[5], MEMN, NB * NMEM); break;
    case OP_MEMKV: n_gemm(sm, MEMN, D, nullptr, c.in[21] + (size_t)l * D * 2048, 2048, 0, nullptr, NB * NMEM, 2048, D, EpiStore{KV, 2048, nullptr}); break;
    case OP_COPYX: n_copy4(c.in[0], X, (size_t)T * D / 4); break;
    case OP_RMS_MIX: n_rms(X, c.in[2] + l * D, HN, T); break;
    case OP_CONV_IN: n_gemm(sm, HN, D, nullptr, c.in[7], 2048, 0, nullptr, T, 2048, D, EpiStore{BIG, 2048, c.in[8]}); break;
    case OP_GLU: n_glu(BIG, HN); break;
    case OP_DWCONV: n_dwconv(HN, c.in[9], c.in[10], c.in[11], c.in[12], BIG); break;
    case OP_CONV_OUT: n_gemm(sm, BIG, D, nullptr, c.in[13], D, 0, nullptr, T, D, D, EpiResid{X, D, c.in[14]}); break;
    case OP_GLA_IN: n_gemm(sm, HN, D, nullptr, c.in[15], GLA_COLS, 0, nullptr, T, GLA_COLS, D, EpiStore{BIG, GLA_COLS, nullptr}); break;
    case OP_GLA_DECAY: n_gla_decay(BIG, c.in[16], c.in[17], HN); break;
    case OP_GLA_REC: n_gla_rec(BIG, HN); break;
    case OP_GLA_NORM: n_gla_norm(BIG, c.in[18], HN); break;
    case OP_GLA_OUT: n_gemm(sm, HN, D, nullptr, c.in[19], D, 0, nullptr, T, D, D, EpiResid{X, D, nullptr}); break;
    case OP_RMS_XA: n_rms(X, c.in[3] + l * D, HN, T); break;
    case OP_XA_Q: n_gemm(sm, HN, D, nullptr, c.in[20] + (size_t)l * D * D, D, 0, nullptr, T, D, D, EpiStore{BIG, D, nullptr}); break;
    case OP_XA_ATT: n_attn(BIG, KV, BIG + (size_t)T * D); break;
    case OP_XA_O: n_gemm(sm, BIG + (size_t)T * D, D, nullptr, c.in[22] + (size_t)l * D * D, D, 0, nullptr, T, D, D, EpiResid{X, D, nullptr}); break;
    case OP_RMS_FFN: n_rms(X, c.in[4] + l * D, HN, T); n_moe_init(cnt, slot_tok, slot_a, tile_e); break;
    case OP_ROUTE: n_route(HN, c.in[23] + (size_t)l * D * NG, c.in[24] + l * NG, c.in[25] + (size_t)l * D * NE, c.in[26] + l * NE, eid, gate, pos, cnt); break;
    case OP_BUILD: n_moe_build(eid, pos, cnt, slot_tok, slot_a, tile_e); break;
    case OP_MOE_GATE: n_gemm(sm, HN, D, slot_tok, c.in[27] + (size_t)l * NE * D * DE, DE, (size_t)D * DE, tile_e, NSLOT, DE, D, EpiStore{BIG, DE, nullptr}); break;
    case OP_MOE_UP: n_gemm(sm, HN, D, slot_tok, c.in[28] + (size_t)l * NE * D * DE, DE, (size_t)D * DE, tile_e, NSLOT, DE, D, EpiStore{BIG + (size_t)NSLOT * DE, DE, nullptr}); break;
    case OP_MOE_ACT: n_moe_act(BIG, BIG + (size_t)NSLOT * DE); break;
    case OP_MOE_DOWN: n_gemm(sm, BIG, DE, nullptr, c.in[29] + (size_t)l * NE * DE * D, D, (size_t)DE * D, tile_e, NSLOT, D, DE, EpiMoeDown{BIG + (size_t)NSLOT * DE, slot_a, gate}); break;
    case OP_MOE_COMBINE: n_moe_combine(X, BIG + (size_t)NSLOT * DE); break;
    case OP_FINAL: n_rms(X, c.in[6], X, T); break;
    }
}

template <int OP> __global__ void __launch_bounds__(512) k_stage(Ctx c, int l) {
    __shared__ float sm[16 * 132 + 16 * 260];
    run_op(c, OP, l, sm);
}
typedef void (*StageFn)(Ctx, int);
template <int... I> struct Seq {};
template <int N, int... I> struct MkSeq : MkSeq<N - 1, N - 1, I...> {};
template <int... I> struct MkSeq<0, I...> { typedef Seq<I...> type; };
template <int... I> static void fill_tab(StageFn* t, Seq<I...>) { StageFn f[] = {k_stage<I>...}; for (unsigned i = 0; i < sizeof...(I); ++i) t[i] = f[i]; }
template <int... I> static void fill_tab_opt(StageFn* t, Seq<I...>) { StageFn f[] = {k_opt<I>...}; for (unsigned i = 0; i < sizeof...(I); ++i) t[i] = f[i]; }

template <int CODE> __device__ __forceinline__ void coop_step(const Ctx& c, LAS unsigned char* lds, cg::grid_group& grid, bool sync_after) {
    run_phase(c, CODE >> 1, CODE & 1, lds);
    if (sync_after) {
        asm volatile("s_waitcnt vmcnt(0) lgkmcnt(0)" ::: "memory");
        grid.sync();
        if (threadIdx.x < 64) { __builtin_amdgcn_fence(__ATOMIC_ACQUIRE, "agent"); asm volatile("s_waitcnt vmcnt(0)" ::: "memory"); }
        __syncthreads();
    }
}
template <int... CODES> __global__ void __launch_bounds__(512, 2) k_coop(Ctx c) {
    extern __shared__ __attribute__((aligned(16))) unsigned char dynlds[];
    cg::grid_group grid = cg::this_grid();
    LAS unsigned char* lds = (LAS unsigned char*)dynlds;
    int idx = 0; constexpr int N = sizeof...(CODES);
    ((coop_step<CODES>(c, lds, grid, ++idx < N)), ...);
}
#define CODE(ph, l) ((ph) * 2 + (l))
typedef void (*CoopFn)(Ctx);
struct Step { int kind, op, l; };
static const Step g_prog[] = { {1, 0, 0} };
constexpr int NSTEP = sizeof(g_prog) / sizeof(g_prog[0]);

extern "C" void kernel_launch(void* const* d_in, const int* in_sizes, int n_in, void* d_out, int out_size, void* d_ws, size_t ws_size, hipStream_t stream) {
    if (n_in != 30 || out_size != T * D || ws_size < OW_END || ws_size < WS_END) { fprintf(stderr, "kernel_launch: bad args n_in %d out %d ws %zu\n", n_in, out_size, ws_size); return; }
    Ctx c; memset(&c, 0, sizeof(c));
    for (int i = 0; i < 30; ++i) c.in[i] = (const float*)d_in[i];
    c.out = (float*)d_out; c.ws = (unsigned char*)d_ws;
    static StageFn tab[OP_FINAL + 1], tabo[PH_N];
    static bool init = false;
    if (!init) { fill_tab(tab, MkSeq<OP_FINAL + 1>::type()); fill_tab_opt(tabo, MkSeq<PH_N>::type());
        for (int i = 0; i < PH_N; ++i) hipFuncSetAttribute((const void*)tabo[i], hipFuncAttributeMaxDynamicSharedMemorySize, LDS_BYTES);
        init = true; }
#if COOP
    static int coop_grid = 0;
    static CoopFn coop_fns[2] = { k_coop<CODE(PH_PREP0, 0), CODE(PH_CONV_IN, 0), CODE(PH_CONV_MID, 0), CODE(PH_CONV_OUT, 0), CODE(PH_XA_PREP, 0), CODE(PH_XA_Q, 0), CODE(PH_XA_KV, 0), CODE(PH_XA_S, 0), CODE(PH_XA_PV, 0), CODE(PH_XA_O, 0),
                                         CODE(PH_ROUTE_PREP, 0), CODE(PH_ROUTE, 0), CODE(PH_BUILD, 0), CODE(PH_MOE1, 0), CODE(PH_MOE2, 0), CODE(PH_GLA_PREP, 0), CODE(PH_COMBINE, 0),
                                         CODE(PH_GLA_DECAY, 0), CODE(PH_GLA_IN, 0), CODE(PH_GLA_ATT, 0), CODE(PH_GLA_UT, 0), CODE(PH_GLA_SCAN, 0), CODE(PH_GLA_O, 0), CODE(PH_GLA_FIN, 0), CODE(PH_GLA_OUT, 0),
                                         CODE(PH_XA_PREP, 1), CODE(PH_XA_Q, 1), CODE(PH_XA_KV, 1), CODE(PH_XA_S, 1), CODE(PH_XA_PV, 1), CODE(PH_XA_O, 1),
                                         CODE(PH_ROUTE_PREP, 1), CODE(PH_ROUTE, 1), CODE(PH_BUILD, 1), CODE(PH_MOE1, 1), CODE(PH_MOE2, 1), CODE(PH_COMBINE_FIN, 1)>, nullptr };
    if (!coop_grid) { int dev = 0, cus = 0, per_cu = 0; hipGetDevice(&dev); hipDeviceGetAttribute(&cus, hipDeviceAttributeMultiprocessorCount, dev);
        for (int k = 0; k < 1; ++k) hipFuncSetAttribute((const void*)coop_fns[k], hipFuncAttributeMaxDynamicSharedMemorySize, LDS_BYTES);
        hipOccupancyMaxActiveBlocksPerMultiprocessor(&per_cu, coop_fns[0], 512, LDS_BYTES);
        coop_grid = cus * (per_cu < 1 ? 1 : per_cu); if (coop_grid > 256) coop_grid = 256;
        fprintf(stderr, "kernel_launch: cus %d per_cu %d grid %d\n", cus, per_cu, coop_grid); }
    int ncoop = 0;
#endif
    for (int i = 0; i < NSTEP; ++i) {
        if (g_prog[i].kind == 0) { hipLaunchKernelGGL(tab[g_prog[i].op], dim3(1024), dim3(512), 0, stream, c, g_prog[i].l); continue; }
#if COOP
        while (i < NSTEP && g_prog[i].kind == 1) ++i;
        --i;
        void* args[] = {&c};
        hipError_t e = hipLaunchCooperativeKernel((void*)coop_fns[ncoop++], dim3(coop_grid), dim3(512), args, LDS_BYTES, stream);
        if (e != hipSuccess) fprintf(stderr, "cooperative launch failed: %s\n", hipGetErrorString(e));
#else
        hipLaunchKernelGGL(tabo[g_prog[i].op], dim3(256), dim3(512), LDS_BYTES, stream, c, g_prog[i].l);
#endif
    }
}
```

```cpp
#include <hip/hip_runtime.h>
#include <hip/hip_cooperative_groups.h>
#include <cstdio>
#include <cstring>
namespace cg = cooperative_groups;

#ifndef MEGA
#define MEGA 0
#endif

constexpr int D = 1024, NB = 4, S = 8192, T = NB * S, NMEM = 256, DEPTH = 2;
constexpr int CONVK = 31;
constexpr int GH = 4, GDK = 512, GDV = 1024, GDKH = 128, GDVH = 256, GRANK = 16, GLA_COLS = 3088;
constexpr int XH = 4, XHD = 256;
constexpr int NG = 4, EPG = 8, NE = 32, DE = 512;
constexpr int NA = T * 2;
constexpr int NSLOT = NA + NE * 128;
constexpr float EPS = 1e-6f;

constexpr size_t MiB = 1u << 20;
constexpr size_t WS_HN = 0;
constexpr size_t WS_BIG = 128 * MiB;
constexpr size_t WS_SMALL = 528 * MiB;
constexpr size_t WS_MEMN = WS_SMALL;
constexpr size_t WS_KV = WS_MEMN + 4 * MiB;
constexpr size_t WS_EID = WS_KV + 16 * MiB;
constexpr size_t WS_GATE = WS_EID + NA * 4;
constexpr size_t WS_POS = WS_GATE + NA * 4;
constexpr size_t WS_SLOTTOK = WS_POS + NA * 4;
constexpr size_t WS_SLOTA = WS_SLOTTOK + NSLOT * 4;
constexpr size_t WS_TILEE = WS_SLOTA + NSLOT * 4;
constexpr size_t WS_CNT = WS_TILEE + 4096;
constexpr size_t WS_END = WS_CNT + 4096;

struct Ctx {
    const float* in[30];
    float* out;
    unsigned char* ws;
};

__device__ __forceinline__ float wave_sum(float v) {
#pragma unroll
    for (int o = 1; o < 64; o <<= 1) v += __shfl_xor(v, o);
    return v;
}
__device__ __forceinline__ float wave_max(float v) {
#pragma unroll
    for (int o = 1; o < 64; o <<= 1) v = fmaxf(v, __shfl_xor(v, o));
    return v;
}
__device__ __forceinline__ float sigmoidf_(float x) { return 1.0f / (1.0f + expf(-x)); }
__device__ __forceinline__ float siluf_(float x) { return x / (1.0f + expf(-x)); }

__device__ void n_rms(const float* x, const float* g, float* out, int rows) {
    const int lane = threadIdx.x & 63;
    const int gw = (blockIdx.x * blockDim.x + threadIdx.x) >> 6, ngw = (gridDim.x * blockDim.x) >> 6;
    for (int r = gw; r < rows; r += ngw) {
        const float4* xr = (const float4*)(x + (size_t)r * D);
        float4 v[4]; float s = 0.f;
#pragma unroll
        for (int j = 0; j < 4; ++j) { v[j] = xr[lane + 64 * j]; s += v[j].x * v[j].x + v[j].y * v[j].y + v[j].z * v[j].z + v[j].w * v[j].w; }
        s = wave_sum(s);
        const float rs = rsqrtf(s * (1.0f / D) + EPS);
        float4* o = (float4*)(out + (size_t)r * D);
#pragma unroll
        for (int j = 0; j < 4; ++j) { const float4 gg = ((const float4*)g)[lane + 64 * j];
            o[lane + 64 * j] = make_float4(v[j].x * rs * gg.x, v[j].y * rs * gg.y, v[j].z * rs * gg.z, v[j].w * rs * gg.w); }
    }
}
__device__ void n_copy4(const float* src, float* dst, size_t n4) {
    const size_t g = (size_t)blockIdx.x * blockDim.x + threadIdx.x, gs = (size_t)gridDim.x * blockDim.x;
    for (size_t i = g; i < n4; i += gs) ((float4*)dst)[i] = ((const float4*)src)[i];
}

struct EpiStore { float* C; int ldc; const float* bias;
    __device__ __forceinline__ void operator()(int m, int n, float acc) const { C[(size_t)m * ldc + n] = acc + (bias ? bias[n] : 0.f); } };
struct EpiResid { float* X; int ldc; const float* bias;
    __device__ __forceinline__ void operator()(int m, int n, float acc) const { X[(size_t)m * ldc + n] += acc + (bias ? bias[n] : 0.f); } };
struct EpiMoeDown { float* Y; const int* slot_a; const float* gate;
    __device__ __forceinline__ void operator()(int m, int n, float acc) const { const int a = slot_a[m]; if (a >= 0) Y[(size_t)a * D + n] = acc * gate[a]; } };

template <class Epi>
__device__ void n_gemm(float* sm, const float* A, int lda, const int* arow, const float* W, int ldw, size_t wstride, const int* tile_e,
                       int M, int N, int K, Epi epi) {
    float* As = sm;
    float* Bs = sm + 16 * 132;
    const int tid = threadIdx.x, ty = tid >> 5, tx = tid & 31;
    const int ntm = M / 128, ntn = (N + 255) / 256;
    for (int tile = blockIdx.x; tile < ntm * ntn; tile += gridDim.x) {
        const int mt = tile / ntn, nt = tile % ntn;
        const float* Wb = W;
        if (tile_e) { const int e = tile_e[mt]; if (e < 0) continue; Wb = W + (size_t)e * wstride; }
        const int m0 = mt * 128, n0 = nt * 256;
        float acc[8][8];
#pragma unroll
        for (int i = 0; i < 8; ++i)
#pragma unroll
            for (int j = 0; j < 8; ++j) acc[i][j] = 0.f;
        const int ar = tid >> 2, akq = (tid & 3) * 4;
        const int srow = arow ? arow[m0 + ar] : (m0 + ar);
        const float* ap = srow >= 0 ? A + (size_t)srow * lda : nullptr;
        const int bk = tid >> 6, bn = (tid & 63) * 4;
        for (int k0 = 0; k0 < K; k0 += 16) {
            float4 av = ap ? *(const float4*)(ap + k0 + akq) : make_float4(0.f, 0.f, 0.f, 0.f);
            As[(akq + 0) * 132 + ar] = av.x; As[(akq + 1) * 132 + ar] = av.y; As[(akq + 2) * 132 + ar] = av.z; As[(akq + 3) * 132 + ar] = av.w;
#pragma unroll
            for (int i = 0; i < 2; ++i) {
                const int kk = bk + 8 * i; const int n = n0 + bn;
                float4 bv = (n < N) ? *(const float4*)(Wb + (size_t)(k0 + kk) * ldw + n) : make_float4(0.f, 0.f, 0.f, 0.f);
                *(float4*)(Bs + kk * 260 + bn) = bv;
            }
            __syncthreads();
#pragma unroll
            for (int kk = 0; kk < 16; ++kk) {
                float a[8], b[8];
                *(float4*)(a) = *(const float4*)(As + kk * 132 + ty * 8); *(float4*)(a + 4) = *(const float4*)(As + kk * 132 + ty * 8 + 4);
                *(float4*)(b) = *(const float4*)(Bs + kk * 260 + tx * 8); *(float4*)(b + 4) = *(const float4*)(Bs + kk * 260 + tx * 8 + 4);
#pragma unroll
                for (int i = 0; i < 8; ++i)
#pragma unroll
                    for (int j = 0; j < 8; ++j) acc[i][j] = fmaf(a[i], b[j], acc[i][j]);
            }
            __syncthreads();
        }
#pragma unroll
        for (int i = 0; i < 8; ++i)
#pragma unroll
            for (int j = 0; j < 8; ++j) { const int m = m0 + ty * 8 + i, n = n0 + tx * 8 + j; if (n < N) epi(m, n, acc[i][j]); }
    }
}

__device__ void n_glu(const float* u, float* g) {
    const size_t gi = (size_t)blockIdx.x * blockDim.x + threadIdx.x, gs = (size_t)gridDim.x * blockDim.x;
    for (size_t i = gi; i < (size_t)T * D; i += gs) { const size_t t = i >> 10, c = i & 1023; g[i] = u[t * 2048 + c] * sigmoidf_(u[t * 2048 + 1024 + c]); }
}
__device__ void n_dwconv(const float* g, const float* wdw, const float* bdw, const float* lng, const float* lnb, float* out) {
    const int lane = threadIdx.x & 63;
    const int gw = (blockIdx.x * blockDim.x + threadIdx.x) >> 6, ngw = (gridDim.x * blockDim.x) >> 6;
    for (int t = gw; t < T; t += ngw) {
        const int s = t % S;
        float4 acc[4];
#pragma unroll
        for (int j = 0; j < 4; ++j) acc[j] = ((const float4*)bdw)[lane + 64 * j];
        for (int tap = 0; tap < CONVK; ++tap) {
            const int ss = s - (CONVK - 1) + tap; if (ss < 0) continue;
            const float4* gr = (const float4*)(g + (size_t)(t - (CONVK - 1) + tap) * D);
            const float4* wr = (const float4*)(wdw + (size_t)tap * D);
#pragma unroll
            for (int j = 0; j < 4; ++j) { const float4 a = gr[lane + 64 * j], w = wr[lane + 64 * j];
                acc[j].x = fmaf(a.x, w.x, acc[j].x); acc[j].y = fmaf(a.y, w.y, acc[j].y); acc[j].z = fmaf(a.z, w.z, acc[j].z); acc[j].w = fmaf(a.w, w.w, acc[j].w); }
        }
        float sm_ = 0.f;
#pragma unroll
        for (int j = 0; j < 4; ++j) sm_ += acc[j].x + acc[j].y + acc[j].z + acc[j].w;
        const float mu = wave_sum(sm_) * (1.0f / D);
        float q = 0.f;
#pragma unroll
        for (int j = 0; j < 4; ++j) { acc[j].x -= mu; acc[j].y -= mu; acc[j].z -= mu; acc[j].w -= mu; q += acc[j].x * acc[j].x + acc[j].y * acc[j].y + acc[j].z * acc[j].z + acc[j].w * acc[j].w; }
        const float rstd = rsqrtf(wave_sum(q) * (1.0f / D) + EPS);
        float4* o = (float4*)(out + (size_t)t * D);
#pragma unroll
        for (int j = 0; j < 4; ++j) { const float4 gg = ((const float4*)lng)[lane + 64 * j], bb = ((const float4*)lnb)[lane + 64 * j];
            o[lane + 64 * j] = make_float4(siluf_(acc[j].x * rstd * gg.x + bb.x), siluf_(acc[j].y * rstd * gg.y + bb.y), siluf_(acc[j].z * rstd * gg.z + bb.z), siluf_(acc[j].w * rstd * gg.w + bb.w)); }
    }
}
__device__ void n_attn(const float* q, const float* kv, float* o) {
    const int lane = threadIdx.x & 63;
    const int gw = (blockIdx.x * blockDim.x + threadIdx.x) >> 6, ngw = (gridDim.x * blockDim.x) >> 6;
    for (int it = gw; it < T * XH; it += ngw) {
        const int t = it >> 2, h = it & 3, b = t / S;
        const float4 qv = ((const float4*)(q + (size_t)t * D + h * XHD))[lane];
        const float* kb = kv + (size_t)b * NMEM * 2048 + h * XHD;
        float sc[4];
#pragma unroll
        for (int m4 = 0; m4 < 4; ++m4) {
            float mine = 0.f;
            for (int ml = 0; ml < 64; ++ml) {
                const float4 kk = ((const float4*)(kb + (size_t)(m4 * 64 + ml) * 2048))[lane];
                float p = qv.x * kk.x + qv.y * kk.y + qv.z * kk.z + qv.w * kk.w;
                p = wave_sum(p);
                if (ml == lane) mine = p;
            }
            sc[m4] = mine * 0.0625f;
        }
        float mx = fmaxf(fmaxf(sc[0], sc[1]), fmaxf(sc[2], sc[3])); mx = wave_max(mx);
        float se = 0.f;
#pragma unroll
        for (int m4 = 0; m4 < 4; ++m4) { sc[m4] = expf(sc[m4] - mx); se += sc[m4]; }
        se = wave_sum(se); const float inv = 1.0f / se;
        float4 acc = make_float4(0.f, 0.f, 0.f, 0.f);
        const float* vb = kb + 1024;
#pragma unroll
        for (int m4 = 0; m4 < 4; ++m4)
            for (int ml = 0; ml < 64; ++ml) {
                const float p = __shfl(sc[m4], ml) * inv;
                const float4 vv = ((const float4*)(vb + (size_t)(m4 * 64 + ml) * 2048))[lane];
                acc.x = fmaf(p, vv.x, acc.x); acc.y = fmaf(p, vv.y, acc.y); acc.z = fmaf(p, vv.z, acc.z); acc.w = fmaf(p, vv.w, acc.w);
            }
        ((float4*)(o + (size_t)t * D + h * XHD))[lane] = acc;
    }
}
__device__ void n_moe_init(int* cnt, int* slot_tok, int* slot_a, int* tile_e) {
    const int gi = blockIdx.x * blockDim.x + threadIdx.x, gs = gridDim.x * blockDim.x;
    for (int i = gi; i < NSLOT; i += gs) { slot_tok[i] = -1; slot_a[i] = -1; }
    for (int i = gi; i < NSLOT / 128; i += gs) tile_e[i] = -1;
    if (gi < 32) cnt[gi] = 0;
}
__device__ void n_route(const float* h, const float* wg, const float* bg, const float* we, const float* be, int* eid, float* gate, int* pos, int* cnt) {
    const int lane = threadIdx.x & 63;
    const int gw = (blockIdx.x * blockDim.x + threadIdx.x) >> 6, ngw = (gridDim.x * blockDim.x) >> 6;
    for (int t = gw; t < T; t += ngw) {
        float hv[16];
#pragma unroll
        for (int j = 0; j < 16; ++j) hv[j] = h[(size_t)t * D + j * 64 + lane];
        float gl[4];
#pragma unroll
        for (int o = 0; o < 4; ++o) { float p = 0.f;
#pragma unroll
            for (int j = 0; j < 16; ++j) p = fmaf(hv[j], wg[(size_t)(j * 64 + lane) * NG + o], p);
            gl[o] = wave_sum(p) + bg[o]; }
        int gs = 0; float gm = gl[0];
#pragma unroll
        for (int o = 1; o < 4; ++o) if (gl[o] > gm) { gm = gl[o]; gs = o; }
        float se = 0.f;
#pragma unroll
        for (int o = 0; o < 4; ++o) se += expf(gl[o] - gm);
        const float pg = 1.0f / se;
        float el[8];
#pragma unroll
        for (int o = 0; o < 8; ++o) { float p = 0.f;
#pragma unroll
            for (int j = 0; j < 16; ++j) p = fmaf(hv[j], we[(size_t)(j * 64 + lane) * NE + gs * 8 + o], p);
            el[o] = wave_sum(p) + be[gs * 8 + o]; }
        float em = el[0];
#pragma unroll
        for (int o = 1; o < 8; ++o) em = fmaxf(em, el[o]);
        float pe[8], ps = 0.f;
#pragma unroll
        for (int o = 0; o < 8; ++o) { pe[o] = expf(el[o] - em); ps += pe[o]; }
#pragma unroll
        for (int o = 0; o < 8; ++o) pe[o] = pe[o] / ps;
        int i1 = 0; float p1 = pe[0];
#pragma unroll
        for (int o = 1; o < 8; ++o) if (pe[o] > p1) { p1 = pe[o]; i1 = o; }
        int i2 = -1; float p2 = -1.f;
#pragma unroll
        for (int o = 0; o < 8; ++o) if (o != i1 && pe[o] > p2) { p2 = pe[o]; i2 = o; }
        if (lane == 0) {
            const float den = p1 + p2;
            const int e1 = gs * 8 + i1, e2 = gs * 8 + i2;
            eid[2 * t] = e1; eid[2 * t + 1] = e2;
            gate[2 * t] = pg * p1 / den; gate[2 * t + 1] = pg * p2 / den;
            pos[2 * t] = atomicAdd(&cnt[e1], 1); pos[2 * t + 1] = atomicAdd(&cnt[e2], 1);
        }
    }
}
__device__ void n_moe_build(const int* eid, const int* pos, const int* cnt, int* slot_tok, int* slot_a, int* tile_e) {
    __shared__ int poff[33];
    if (threadIdx.x == 0) { int o = 0; for (int e = 0; e < 32; ++e) { poff[e] = o; o += (cnt[e] + 127) / 128 * 128; } poff[32] = o; }
    __syncthreads();
    const int gi = blockIdx.x * blockDim.x + threadIdx.x, gs = gridDim.x * blockDim.x;
    for (int a = gi; a < NA; a += gs) { const int e = eid[a]; const int sl = poff[e] + pos[a]; slot_tok[sl] = a >> 1; slot_a[sl] = a; }
    for (int mt = gi; mt < NSLOT / 128; mt += gs) { const int r = mt * 128; int e = -1; for (int k = 0; k < 32; ++k) if (r >= poff[k] && r < poff[k + 1]) e = k; tile_e[mt] = e; }
    __syncthreads();
}
__device__ void n_moe_act(float* g, const float* u) {
    const size_t gi = (size_t)blockIdx.x * blockDim.x + threadIdx.x, gs = (size_t)gridDim.x * blockDim.x;
    for (size_t i = gi; i < (size_t)NSLOT * DE / 4; i += gs) { float4 a = ((float4*)g)[i]; const float4 b = ((const float4*)u)[i];
        a.x = siluf_(a.x) * b.x; a.y = siluf_(a.y) * b.y; a.z = siluf_(a.z) * b.z; a.w = siluf_(a.w) * b.w; ((float4*)g)[i] = a; }
}
__device__ void n_moe_combine(float* x, const float* y) {
    const size_t gi = (size_t)blockIdx.x * blockDim.x + threadIdx.x, gs = (size_t)gridDim.x * blockDim.x;
    for (size_t i = gi; i < (size_t)T * D / 4; i += gs) { const size_t t = i >> 8, c = i & 255; float4 a = ((float4*)x)[i];
        const float4 y0 = ((const float4*)y)[(2 * t) * 256 + c], y1 = ((const float4*)y)[(2 * t + 1) * 256 + c];
        a.x += y0.x + y1.x; a.y += y0.y + y1.y; a.z += y0.z + y1.z; a.w += y0.w + y1.w; ((float4*)x)[i] = a; }
}
__device__ void n_gla_decay(const float* proj, const float* wa2, const float* ba, float* dec) {
    const size_t gi = (size_t)blockIdx.x * blockDim.x + threadIdx.x, gs = (size_t)gridDim.x * blockDim.x;
    for (size_t i = gi; i < (size_t)T * GDK; i += gs) { const size_t t = i >> 9; const int j = (int)(i & 511);
        float a = ba[j];
#pragma unroll
        for (int r = 0; r < GRANK; ++r) a = fmaf(proj[t * GLA_COLS + 2048 + r], wa2[r * GDK + j], a);
        const float ls = fminf(a, 0.f) - log1pf(expf(-fabsf(a)));
        dec[i] = expf(ls * (1.0f / 16.0f)); }
}
__device__ void n_gla_rec(float* proj, const float* dec) {
    const int gi = blockIdx.x * blockDim.x + threadIdx.x, gs = gridDim.x * blockDim.x;
    for (int it = gi; it < NB * GH * GDVH; it += gs) {
        const int col = it & 255, h = (it >> 8) & 3, b = it >> 10;
        float st[GDKH];
#pragma unroll
        for (int k = 0; k < GDKH; ++k) st[k] = 0.f;
        const float qs = 0.08838834764831845f;
        for (int s = 0; s < S; ++s) {
            const size_t t = (size_t)b * S + s;
            float* pr = proj + t * GLA_COLS;
            const float v = pr[1024 + h * GDVH + col];
            const float* qq = pr + h * GDKH; const float* kk = pr + 512 + h * GDKH; const float* dd = dec + t * GDK + h * GDKH;
            float o = 0.f;
#pragma unroll
            for (int k = 0; k < GDKH; ++k) { st[k] = fmaf(st[k], dd[k], kk[k] * v); o = fmaf(qq[k], st[k], o); }
            pr[1024 + h * GDVH + col] = o * qs;
        }
    }
}
__device__ void n_gla_norm(const float* proj, const float* ng, float* go) {
    const int lane = threadIdx.x & 63;
    const int gw = (blockIdx.x * blockDim.x + threadIdx.x) >> 6, ngw = (gridDim.x * blockDim.x) >> 6;
    for (int it = gw; it < T * GH; it += ngw) {
        const int t = it >> 2, h = it & 3;
        const float4 ov = ((const float4*)(proj + (size_t)t * GLA_COLS + 1024 + h * GDVH))[lane];
        const float4 rv = ((const float4*)(proj + (size_t)t * GLA_COLS + 2064 + h * GDVH))[lane];
        const float4 gg = ((const float4*)ng)[lane];
        float s = ov.x * ov.x + ov.y * ov.y + ov.z * ov.z + ov.w * ov.w; s = wave_sum(s);
        const float rs = rsqrtf(s * (1.0f / GDVH) + EPS);
        ((float4*)(go + (size_t)t * D + h * GDVH))[lane] = make_float4(ov.x * rs * gg.x * siluf_(rv.x), ov.y * rs * gg.y * siluf_(rv.y), ov.z * rs * gg.z * siluf_(rv.z), ov.w * rs * gg.w * siluf_(rv.w));
    }
}

#define LAS __attribute__((address_space(3)))
typedef unsigned short bf16_t;
typedef short bf16x8 __attribute__((ext_vector_type(8)));
typedef float f32x4 __attribute__((ext_vector_type(4)));
typedef float f32x2 __attribute__((ext_vector_type(2)));
typedef unsigned u32x4 __attribute__((ext_vector_type(4)));
typedef unsigned u32x2 __attribute__((ext_vector_type(2)));

constexpr int LDS_BYTES = 160 * 1024;
constexpr int NSLOT2 = NA + NE * 256;
constexpr int MAXRT = NSLOT2 / 256;
constexpr size_t OW_XB = 0;
constexpr size_t OW_SSP = 64 * MiB;
constexpr size_t OW_RS = 66 * MiB;
constexpr size_t OW_PSUM = 67 * MiB;
constexpr size_t OW_MOE = 69 * MiB;
constexpr size_t OW_ACTA = 72 * MiB, OW_ACTB = 136 * MiB, OW_ACTC = 200 * MiB;
constexpr size_t OW_H = 72 * MiB, OW_Y = 144 * MiB, OW_WMOE = 272 * MiB;
constexpr size_t OW_KVB = 368 * MiB;
constexpr size_t OW_MEMNB = 372 * MiB;
constexpr size_t OW_WCIN = 550 * MiB, OW_WCOUT = 554 * MiB, OW_WXQ = 556 * MiB, OW_WXKV = 560 * MiB, OW_WXO = 568 * MiB, OW_WR = 572 * MiB, OW_BAR = 573 * MiB, OW_END = 574 * MiB;
constexpr size_t OW_ATT = 0, OW_QKR = 72 * MiB, OW_KVT = 200 * MiB, OW_BTM = 296 * MiB, OW_O = 296 * MiB, OW_BFM = 360 * MiB, OW_UT = 424 * MiB, OW_SP = 456 * MiB,
                 OW_ALR = 488 * MiB, OW_DL = 490 * MiB, OW_GO = 200 * MiB, OW_WGTM = 492 * MiB, OW_WGFM = 496 * MiB, OW_WGO = 499 * MiB, OW_WA = 501 * MiB;
constexpr size_t OM_GCNT = OW_MOE, OM_NT = OW_MOE + 256, OM_TILEE = OW_MOE + 512, OM_AE = OW_MOE + 4096, OM_APOS = OM_AE + NA * 4, OM_GATE = OM_APOS + NA * 4,
                 OM_STOK = OM_GATE + NA * 4, OM_SA = OM_STOK + NSLOT2 * 4, OM_SRS = OM_SA + NSLOT2 * 4, OM_SGATE = OM_SRS + NSLOT2 * 4, OM_END = OM_SGATE + NSLOT2 * 4;
static_assert(OM_END <= OW_ACTA, "MoE small arrays");

__device__ __forceinline__ unsigned cvt_pk_bf16(float lo, float hi) { unsigned r; asm volatile("v_cvt_pk_bf16_f32 %0, %1, %2" : "=v"(r) : "v"(lo), "v"(hi)); return r; }
__device__ __forceinline__ int otid() { int t = threadIdx.x; asm volatile("" : "+v"(t)); return t; }
__device__ __forceinline__ u32x4 pack8(const f32x4& a, const f32x4& b) { u32x4 w; w.x = cvt_pk_bf16(a[0], a[1]); w.y = cvt_pk_bf16(a[2], a[3]); w.z = cvt_pk_bf16(b[0], b[1]); w.w = cvt_pk_bf16(b[2], b[3]); return w; }
__device__ __forceinline__ float bf_lo(unsigned w) { return __uint_as_float(w << 16); }
__device__ __forceinline__ float bf_hi(unsigned w) { return __uint_as_float(w & 0xffff0000u); }
__device__ __forceinline__ float fast_sigmoid(float x) { return __builtin_amdgcn_rcpf(1.0f + __builtin_amdgcn_exp2f(-1.4426950408889634f * x)); }

namespace g8 {
constexpr int BM = 256, BK = 64, HALF = 128, HTB = HALF * BK * 2, STAGE_BYTES = 8 * HTB;
__device__ __forceinline__ int lds_byte(int r, int c) { const int st = (r >> 4) * 2 + (c >> 5), rr = r & 15, cc = c & 31, ob = rr * 64 + cc * 2; return st * 1024 + (ob ^ (((ob >> 9) & 1) << 5)); }
__device__ __forceinline__ void stage_rc(int b, int& R, int& C) { const int st = b / 1024, sb = b % 1024, swz = sb ^ (((sb >> 9) & 1) << 5); R = (st >> 1) * 16 + swz / 64; C = (st & 1) * 32 + (swz % 64) / 2; }
__device__ __forceinline__ int perm32(int rho) { const int n = rho >> 4, i = rho & 15; return 8 * (i >> 2) + 4 * n + (i & 3); }
struct Unit { int pm, pn, e; };

template <class Epi, class Sched>
__device__ __forceinline__ void gemm_phase(LAS unsigned char* lds, const Sched& S, const Epi& E) {
    int tid_ = threadIdx.x; asm volatile("" : "+v"(tid_));
    const int tid = tid_, wid = __builtin_amdgcn_readfirstlane(tid >> 6), lane = tid & 63, wr = wid >> 2, wc = wid & 3, fr = lane & 15, fq = lane >> 4;
    const size_t kstep = (size_t)(BK * 2);
    const unsigned ldsw = (unsigned)wid * 1024u;
    const int aoff = lds_byte(wr * 64 + fr, fq * 8), boff = lds_byte(wc * 32 + fr, fq * 8);
#define G8_SA(b, h) (((b) * 2 + (h)) * HTB)
#define G8_SB(b, h) ((4 + (b) * 2 + (h)) * HTB)
#define G8_STAGE(bufoff, gbase, vv) do { _Pragma("unroll") for (int _i = 0; _i < 2; ++_i) \
        __builtin_amdgcn_global_load_lds((const unsigned*)((const char*)(gbase) + (vv)[_i]), (LAS unsigned*)(lds + (bufoff) + ldsw + _i * 8192), 16, 0, 0); } while (0)
#define G8_LDA(dst, b, h) do { _Pragma("unroll") for (int m = 0; m < 4; ++m) _Pragma("unroll") for (int k = 0; k < 2; ++k) dst[m][k] = *(const LAS bf16x8*)(lds + G8_SA(b, h) + aoff + m * 2048 + k * 1024); } while (0)
#define G8_LDB(dst, b, h) do { _Pragma("unroll") for (int n = 0; n < 2; ++n) _Pragma("unroll") for (int k = 0; k < 2; ++k) dst[n][k] = *(const LAS bf16x8*)(lds + G8_SB(b, h) + boff + n * 2048 + k * 1024); } while (0)
#define G8_MMA(ai, bj, At, Bt) do { __builtin_amdgcn_s_setprio(1); _Pragma("unroll") for (int m = 0; m < 4; ++m) _Pragma("unroll") for (int n = 0; n < 2; ++n) _Pragma("unroll") for (int k = 0; k < 2; ++k) \
        acc[ai][bj][m][n] = __builtin_amdgcn_mfma_f32_16x16x32_bf16(Bt[n][k], At[m][k], acc[ai][bj][m][n], 0, 0, 0); __builtin_amdgcn_s_setprio(0); } while (0)
#define G8_WAIT_V(n) asm volatile("s_waitcnt vmcnt(" #n ")" ::: "memory")
#define G8_WAIT_L(n) asm volatile("s_waitcnt lgkmcnt(" #n ")" ::: "memory")
#define G8_BAR __builtin_amdgcn_s_barrier()
#define G8_SCHED __builtin_amdgcn_sched_barrier(0)
#define G8_VA(dst, u) do { const int _ac = S.a_col(u), _lda = S.lda(u); _Pragma("unroll") for (int _i = 0; _i < 2; ++_i) { int _R, _C; stage_rc(tid * 16 + _i * 8192, _R, _C); \
        _Pragma("unroll") for (int _h = 0; _h < 2; ++_h) dst[_h][_i] = (unsigned)(((size_t)S.a_row(u, _h * HALF + _R) * _lda + _ac + _C) * 2); } } while (0)
#define G8_VB(dst, hs, u) do { const int _ldb = S.ldb(u); hs = (size_t)HALF * _ldb * 2; _Pragma("unroll") for (int _i = 0; _i < 2; ++_i) { int _R, _C; stage_rc(tid * 16 + _i * 8192, _R, _C); \
        dst[_i] = (unsigned)(((_R & ~31) + perm32(_R & 31)) * _ldb + _C) * 2u; } } while (0)
    Unit cur, nxt; int ui = 0;
    if (!S.next(0, cur)) return;
    f32x4 acc[2][2][4][2];
#pragma unroll
    for (int a = 0; a < 2; ++a)
#pragma unroll
        for (int b = 0; b < 2; ++b)
#pragma unroll
            for (int m = 0; m < 4; ++m)
#pragma unroll
                for (int n = 0; n < 2; ++n) acc[a][b][m][n] = (f32x4){0.f, 0.f, 0.f, 0.f};
    bf16x8 At[4][2], B0[2][2], B1[2][2];
    unsigned va[2][2], nva[2][2], vb[2], nvb[2]; size_t hsB, nhsB;
    G8_VA(va, cur); G8_VB(vb, hsB, cur);
    const char* Ab = S.a_base(cur);
    const char* cB = S.b_base(cur);
    G8_STAGE(G8_SB(0, 0), cB, vb); G8_STAGE(G8_SA(0, 0), Ab, va[0]); G8_STAGE(G8_SB(0, 1), cB + hsB, vb); G8_STAGE(G8_SA(0, 1), Ab, va[1]);
    if (wr == 1) G8_BAR;
    G8_WAIT_V(4); G8_BAR;
    G8_STAGE(G8_SB(1, 0), cB + kstep, vb); G8_STAGE(G8_SA(1, 0), Ab + kstep, va[0]); G8_STAGE(G8_SB(1, 1), cB + hsB + kstep, vb);
    G8_WAIT_V(6); G8_BAR;
    for (;;) {
        const bool has_next = S.next(ui + 1, nxt);
        const char* nB = cB; const char* nAb = Ab;
        if (has_next) { nB = S.b_base(nxt); nAb = S.a_base(nxt); G8_VA(nva, nxt); G8_VB(nvb, nhsB, nxt); }
        else {
            nhsB = hsB;
#pragma unroll
            for (int i = 0; i < 2; ++i) { nvb[i] = vb[i];
#pragma unroll
                for (int h = 0; h < 2; ++h) nva[h][i] = va[h][i]; }
        }
        const int nt = S.nt(cur);
        for (int t = 0; t < nt; t += 2) {
            const bool last = (t == nt - 2);
            const char* a1 = Ab + (size_t)(t + 1) * kstep;
            const char* a2 = last ? nAb : Ab + (size_t)(t + 2) * kstep;
            const char* b2 = last ? nB : cB + (size_t)(t + 2) * kstep;
            const char* a3 = a2 + kstep; const char* b3 = b2 + kstep;
            const size_t hs2 = last ? nhsB : hsB;
            unsigned v2[2][2], vb2[2];
#pragma unroll
            for (int i = 0; i < 2; ++i) { vb2[i] = last ? nvb[i] : vb[i];
#pragma unroll
                for (int h = 0; h < 2; ++h) v2[h][i] = last ? nva[h][i] : va[h][i]; }
            G8_LDB(B0, 0, 0); G8_SCHED; G8_LDA(At, 0, 0); G8_STAGE(G8_SA(1, 1), a1, va[1]);
            G8_WAIT_L(8); G8_BAR; G8_WAIT_L(0); G8_MMA(0, 0, At, B0); G8_BAR; G8_SCHED;
            G8_LDB(B1, 0, 1); G8_STAGE(G8_SB(0, 0), b2, vb2);
            G8_BAR; G8_WAIT_L(0); G8_MMA(0, 1, At, B1); G8_BAR;
            G8_LDA(At, 0, 1); G8_STAGE(G8_SA(0, 0), a2, v2[0]);
            G8_BAR; G8_WAIT_L(0); G8_MMA(1, 0, At, B0); G8_BAR; G8_SCHED;
            G8_STAGE(G8_SB(0, 1), b2 + hs2, vb2);
            G8_WAIT_V(6); G8_BAR; G8_MMA(1, 1, At, B1); G8_BAR;
            G8_LDB(B0, 1, 0); G8_SCHED; G8_LDA(At, 1, 0); G8_STAGE(G8_SA(0, 1), a2, v2[1]);
            G8_WAIT_L(8); G8_BAR; G8_WAIT_L(0); G8_MMA(0, 0, At, B0); G8_BAR; G8_SCHED;
            G8_LDB(B1, 1, 1); G8_STAGE(G8_SB(1, 0), b3, vb2);
            G8_BAR; G8_WAIT_L(0); G8_MMA(0, 1, At, B1); G8_BAR;
            G8_LDA(At, 1, 1); G8_STAGE(G8_SA(1, 0), a3, v2[0]);
            G8_BAR; G8_WAIT_L(0); G8_MMA(1, 0, At, B0); G8_BAR; G8_SCHED;
            G8_STAGE(G8_SB(1, 1), b3 + hs2, vb2);
            G8_WAIT_V(6); G8_BAR; G8_MMA(1, 1, At, B1); G8_BAR;
        }
        const bool keep = S.cont(cur);
        if (!keep) E(acc, cur, wr, wc, fr, fq);
        if (!has_next) break;
        if (!keep) {
#pragma unroll
            for (int a = 0; a < 2; ++a)
#pragma unroll
                for (int b = 0; b < 2; ++b)
#pragma unroll
                    for (int m = 0; m < 4; ++m)
#pragma unroll
                        for (int n = 0; n < 2; ++n) acc[a][b][m][n] = (f32x4){0.f, 0.f, 0.f, 0.f};
        }
        cur = nxt; cB = nB; Ab = nAb; hsB = nhsB; ++ui;
#pragma unroll
        for (int i = 0; i < 2; ++i) { vb[i] = nvb[i];
#pragma unroll
            for (int h = 0; h < 2; ++h) va[h][i] = nva[h][i]; }
    }
    G8_WAIT_V(0);
    if (wr == 0) G8_BAR;
    G8_BAR;
#undef G8_SA
#undef G8_SB
#undef G8_STAGE
#undef G8_LDA
#undef G8_LDB
#undef G8_MMA
#undef G8_WAIT_V
#undef G8_WAIT_L
#undef G8_BAR
#undef G8_SCHED
#undef G8_VA
#undef G8_VB
}

struct DenseSched {
    __device__ __forceinline__ int lda(const Unit&) const { return lda_; }
    __device__ __forceinline__ int ldb(const Unit&) const { return ldb_; }
    __device__ __forceinline__ int nt(const Unit&) const { return K / BK; }
    __device__ __forceinline__ bool cont(const Unit&) const { return false; }
    int nN, nU, K, lda_, ldb_; const bf16_t* A; const bf16_t* Bt;
    __device__ __forceinline__ const char* a_base(const Unit&) const { return (const char*)A; }
    __device__ __forceinline__ bool next(int i, Unit& u) const {
        const int c = blockIdx.x, per = gridDim.x >> 3, x = c & 7, j = c >> 3;
        const int chunk = (nU + 7) >> 3, lu = i * per + j;
        if (lu >= chunk) return false;
        const int un = x * chunk + lu; if (un >= nU) return false;
        u.pm = un / nN; u.pn = un - u.pm * nN; u.e = 0; return true; }
    __device__ __forceinline__ int a_row(const Unit& u, int r) const { return u.pm * BM + r; }
    __device__ __forceinline__ int a_col(const Unit&) const { return 0; }
    __device__ __forceinline__ const char* b_base(const Unit& u) const { return (const char*)(Bt + (size_t)u.pn * BM * ldb_); }
};

struct EpiGlu {
    bf16_t* U; const float* rs; const float* bias;
    __device__ __forceinline__ void operator()(const f32x4 (&acc)[2][2][4][2], const Unit& u, int wr, int wc, int fr, int fq) const {
        const int c0 = u.pn * 128 + wc * 32 + 8 * fq;
        const f32x4 ba0 = *(const f32x4*)(bias + c0), ba1 = *(const f32x4*)(bias + c0 + 4), bg0 = *(const f32x4*)(bias + 1024 + c0), bg1 = *(const f32x4*)(bias + 1024 + c0 + 4);
#pragma unroll
        for (int ai = 0; ai < 2; ++ai)
#pragma unroll
            for (int m = 0; m < 4; ++m) {
                const int row = u.pm * BM + ai * HALF + wr * 64 + m * 16 + fr; const float r = rs[row];
                f32x4 o0, o1;
#pragma unroll
                for (int j = 0; j < 4; ++j) {
                    o0[j] = (acc[ai][0][m][0][j] * r + ba0[j]) * fast_sigmoid(acc[ai][1][m][0][j] * r + bg0[j]);
                    o1[j] = (acc[ai][0][m][1][j] * r + ba1[j]) * fast_sigmoid(acc[ai][1][m][1][j] * r + bg1[j]); }
                *(u32x4*)(U + (size_t)row * D + c0) = pack8(o0, o1);
            }
    }
};
struct EpiXres {
    const float* Xin; float* Xout; bf16_t* XB; const float* bias; float* ssp;
    __device__ __forceinline__ void operator()(const f32x4 (&acc)[2][2][4][2], const Unit& u, int wr, int wc, int fr, int fq) const {
#pragma unroll
        for (int ai = 0; ai < 2; ++ai)
#pragma unroll
            for (int m = 0; m < 4; ++m) {
                const int row = u.pm * BM + ai * HALF + wr * 64 + m * 16 + fr; float ss = 0.f;
#pragma unroll
                for (int bj = 0; bj < 2; ++bj) {
                    const int c0 = u.pn * BM + bj * HALF + wc * 32 + 8 * fq; const size_t off = (size_t)row * D + c0;
                    f32x4 v0 = *(const f32x4*)(Xin + off) + acc[ai][bj][m][0], v1 = *(const f32x4*)(Xin + off + 4) + acc[ai][bj][m][1];
                    if (bias) { v0 += *(const f32x4*)(bias + c0); v1 += *(const f32x4*)(bias + c0 + 4); }
                    *(f32x4*)(Xout + off) = v0; *(f32x4*)(Xout + off + 4) = v1;
                    *(u32x4*)(XB + off) = pack8(v0, v1);
                    ss += (v0[0] * v0[0] + v0[1] * v0[1]) + (v0[2] * v0[2] + v0[3] * v0[3]) + (v1[0] * v1[0] + v1[1] * v1[1]) + (v1[2] * v1[2] + v1[3] * v1[3]);
                }
                if (ssp) { ss += __shfl_xor(ss, 16); ss += __shfl_xor(ss, 32); if (fq == 0) ssp[(size_t)row * 16 + u.pn * 4 + wc] = ss; }
            }
    }
};

struct AttnSched {
    __device__ __forceinline__ int lda(const Unit&) const { return lda_; }
    __device__ __forceinline__ int ldb(const Unit&) const { return ldb_; }
    __device__ __forceinline__ int nt(const Unit&) const { return K / BK; }
    __device__ __forceinline__ bool cont(const Unit&) const { return false; }
    int K, lda_, ldb_; const bf16_t* A; const bf16_t* Bm; int pv;
    __device__ __forceinline__ bool next(int i, Unit& u) const {
        const int c = blockIdx.x, per = gridDim.x >> 3, x = c & 7, j = c >> 3;
        const int lu = i * per + j; if (lu >= 64) return false;
        const int un = x * 64 + lu, bh = un >> 5, qb = un & 31;
        u.pm = (bh >> 2) * 32 + qb; u.pn = 0; u.e = bh & 3; return true; }
    __device__ __forceinline__ const char* a_base(const Unit&) const { return (const char*)A; }
    __device__ __forceinline__ int a_row(const Unit& u, int r) const { return u.pm * BM + r; }
    __device__ __forceinline__ int a_col(const Unit& u) const { return u.e * 256; }
    __device__ __forceinline__ const char* b_base(const Unit& u) const { const int b = u.pm >> 5;
        return pv ? (const char*)(Bm + (size_t)(b * 4 + u.e) * 65536) : (const char*)(Bm + (size_t)(b * 256) * 1024 + u.e * 256); }
};
struct KVSched {
    __device__ __forceinline__ int lda(const Unit&) const { return lda_; }
    __device__ __forceinline__ int ldb(const Unit&) const { return ldb_; }
    __device__ __forceinline__ int nt(const Unit&) const { return K / BK; }
    __device__ __forceinline__ bool cont(const Unit&) const { return false; }
    int K, lda_, ldb_; const bf16_t* MEMNB; const bf16_t* WKV;
    __device__ __forceinline__ bool next(int i, Unit& u) const {
        const int un = i * (int)gridDim.x + (int)blockIdx.x; if (un >= 32) return false;
        u.e = un >> 4; u.pm = (un & 15) >> 2; u.pn = un & 3; return true; }
    __device__ __forceinline__ const char* a_base(const Unit& u) const { return u.e ? (const char*)(WKV + (size_t)1024 * 1024) : (const char*)MEMNB; }
    __device__ __forceinline__ int a_row(const Unit& u, int r) const { return u.pm * BM + r; }
    __device__ __forceinline__ int a_col(const Unit&) const { return 0; }
    __device__ __forceinline__ const char* b_base(const Unit& u) const { return u.e ? (const char*)(MEMNB + (size_t)u.pn * BM * 1024) : (const char*)(WKV + (size_t)u.pn * BM * 1024); }
};
__device__ __forceinline__ float ssp_rs(const float* ssp, int row) {
    const f32x4 a = *(const f32x4*)(ssp + (size_t)row * 16), b = *(const f32x4*)(ssp + (size_t)row * 16 + 4), c = *(const f32x4*)(ssp + (size_t)row * 16 + 8), d = *(const f32x4*)(ssp + (size_t)row * 16 + 12);
    const float s = ((a[0] + a[1]) + (a[2] + a[3])) + ((b[0] + b[1]) + (b[2] + b[3])) + ((c[0] + c[1]) + (c[2] + c[3])) + ((d[0] + d[1]) + (d[2] + d[3]));
    return rsqrtf(s * (1.0f / D) + EPS);
}
struct EpiRowScale {
    bf16_t* O; int ldo; const float* ssp; const float* rs; float scale; int qtiles; float qscale;
    __device__ __forceinline__ void operator()(const f32x4 (&acc)[2][2][4][2], const Unit& u, int wr, int wc, int fr, int fq) const {
        const float cs = scale * (u.pn < qtiles ? qscale : 1.0f);
#pragma unroll
        for (int ai = 0; ai < 2; ++ai)
#pragma unroll
            for (int m = 0; m < 4; ++m) {
                const int row = u.pm * BM + ai * HALF + wr * 64 + m * 16 + fr;
                const float r = (rs ? rs[row] : ssp_rs(ssp, row)) * cs;
#pragma unroll
                for (int bj = 0; bj < 2; ++bj) { const int c0 = u.pn * BM + bj * HALF + wc * 32 + 8 * fq;
                    *(u32x4*)(O + (size_t)row * ldo + c0) = pack8(acc[ai][bj][m][0] * r, acc[ai][bj][m][1] * r); }
            }
    }
};
struct EpiKV {
    bf16_t* Kb; bf16_t* VT;
    __device__ __forceinline__ void operator()(const f32x4 (&acc)[2][2][4][2], const Unit& u, int wr, int wc, int fr, int fq) const {
        bf16_t* base = u.e ? VT + (size_t)(u.pn * 4 + u.pm) * 65536 : Kb + (size_t)u.pm * BM * 1024 + u.pn * BM;
        const int ld = u.e ? 256 : 1024;
#pragma unroll
        for (int ai = 0; ai < 2; ++ai)
#pragma unroll
            for (int m = 0; m < 4; ++m) { const int r = ai * HALF + wr * 64 + m * 16 + fr;
#pragma unroll
                for (int bj = 0; bj < 2; ++bj) { const int c0 = bj * HALF + wc * 32 + 8 * fq;
                    *(u32x4*)(base + (size_t)r * ld + c0) = pack8(acc[ai][bj][m][0], acc[ai][bj][m][1]); } }
    }
};
struct EpiS {
    bf16_t* P; float* psum;
    __device__ __forceinline__ void operator()(const f32x4 (&acc)[2][2][4][2], const Unit& u, int wr, int wc, int fr, int fq) const {
#pragma unroll
        for (int ai = 0; ai < 2; ++ai)
#pragma unroll
            for (int m = 0; m < 4; ++m) {
                const int row = u.pm * BM + ai * HALF + wr * 64 + m * 16 + fr; float ps = 0.f;
#pragma unroll
                for (int bj = 0; bj < 2; ++bj) { const int c0 = u.e * 256 + bj * HALF + wc * 32 + 8 * fq;
                    f32x4 e0, e1;
#pragma unroll
                    for (int j = 0; j < 4; ++j) { e0[j] = __builtin_amdgcn_exp2f(acc[ai][bj][m][0][j] * 1.4426950408889634f); e1[j] = __builtin_amdgcn_exp2f(acc[ai][bj][m][1][j] * 1.4426950408889634f); }
                    const u32x4 w = pack8(e0, e1);
                    *(u32x4*)(P + (size_t)row * D + c0) = w;
                    ps += (bf_lo(w.x) + bf_hi(w.x)) + (bf_lo(w.y) + bf_hi(w.y)) + (bf_lo(w.z) + bf_hi(w.z)) + (bf_lo(w.w) + bf_hi(w.w)); }
                ps += __shfl_xor(ps, 16); ps += __shfl_xor(ps, 32);
                if (fq == 0) psum[(size_t)row * 16 + u.e * 4 + wc] = ps;
            }
    }
};
struct EpiPV {
    bf16_t* O; const float* psum;
    __device__ __forceinline__ void operator()(const f32x4 (&acc)[2][2][4][2], const Unit& u, int wr, int wc, int fr, int fq) const {
#pragma unroll
        for (int ai = 0; ai < 2; ++ai)
#pragma unroll
            for (int m = 0; m < 4; ++m) {
                const int row = u.pm * BM + ai * HALF + wr * 64 + m * 16 + fr;
                const f32x4 s4 = *(const f32x4*)(psum + (size_t)row * 16 + u.e * 4);
                const float inv = 1.0f / ((s4[0] + s4[1]) + (s4[2] + s4[3]));
#pragma unroll
                for (int bj = 0; bj < 2; ++bj) { const int c0 = u.e * 256 + bj * HALF + wc * 32 + 8 * fq;
                    *(u32x4*)(O + (size_t)row * D + c0) = pack8(acc[ai][bj][m][0] * inv, acc[ai][bj][m][1] * inv); }
            }
    }
};

__device__ __forceinline__ int ld_agent(const int* p) { return __hip_atomic_load(p, __ATOMIC_RELAXED, __HIP_MEMORY_SCOPE_AGENT); }
struct MoeSched {
    __device__ __forceinline__ int lda(const Unit&) const { return lda_; }
    __device__ __forceinline__ int ldb(const Unit&) const { return ldb_; }
    __device__ __forceinline__ int nt(const Unit&) const { return K / BK; }
    __device__ __forceinline__ bool cont(const Unit&) const { return false; }
    int K, lda_, ldb_; const bf16_t* A; const bf16_t* W; size_t wstride; const int* tile_e; const int* slot_tok; int NT;
    __device__ __forceinline__ bool next(int i, Unit& u) const {
        const int c = blockIdx.x, per = gridDim.x >> 3, x = c & 7, j = c >> 3;
        const int tpx = (NT + 7) >> 3, lu = i * per + j, lrt = lu >> 2;
        if (lrt >= tpx) return false;
        const int rt = x * tpx + lrt; if (rt >= NT) return false;
        u.pm = rt; u.pn = lu & 3; u.e = __builtin_amdgcn_readfirstlane(ld_agent(tile_e + rt)); return true; }
    __device__ __forceinline__ const char* a_base(const Unit&) const { return (const char*)A; }
    __device__ __forceinline__ int a_row(const Unit& u, int r) const { return slot_tok ? slot_tok[u.pm * BM + r] : u.pm * BM + r; }
    __device__ __forceinline__ int a_col(const Unit&) const { return 0; }
    __device__ __forceinline__ const char* b_base(const Unit& u) const { return (const char*)(W + (size_t)u.e * wstride + (size_t)u.pn * BM * ldb_); }
};
struct EpiMoe1 {
    bf16_t* H; const float* slot_rs;
    __device__ __forceinline__ void operator()(const f32x4 (&acc)[2][2][4][2], const Unit& u, int wr, int wc, int fr, int fq) const {
        const int c0 = u.pn * 128 + wc * 32 + 8 * fq;
#pragma unroll
        for (int ai = 0; ai < 2; ++ai)
#pragma unroll
            for (int m = 0; m < 4; ++m) {
                const int row = u.pm * BM + ai * HALF + wr * 64 + m * 16 + fr; const float r = slot_rs[row];
                f32x4 o0, o1;
#pragma unroll
                for (int j = 0; j < 4; ++j) {
                    const float g0 = acc[ai][0][m][0][j] * r, g1 = acc[ai][0][m][1][j] * r;
                    o0[j] = g0 * fast_sigmoid(g0) * (acc[ai][1][m][0][j] * r);
                    o1[j] = g1 * fast_sigmoid(g1) * (acc[ai][1][m][1][j] * r); }
                *(u32x4*)(H + (size_t)row * DE + c0) = pack8(o0, o1);
            }
    }
};
struct EpiMoe2 {
    bf16_t* Y; const int* slot_a; const float* slot_gate;
    __device__ __forceinline__ void operator()(const f32x4 (&acc)[2][2][4][2], const Unit& u, int wr, int wc, int fr, int fq) const {
#pragma unroll
        for (int ai = 0; ai < 2; ++ai)
#pragma unroll
            for (int m = 0; m < 4; ++m) {
                const int row = u.pm * BM + ai * HALF + wr * 64 + m * 16 + fr; const int a = slot_a[row]; const float g = slot_gate[row];
                if (a >= 0) {
#pragma unroll
                    for (int bj = 0; bj < 2; ++bj) { const int c0 = u.pn * BM + bj * HALF + wc * 32 + 8 * fq;
                        *(u32x4*)(Y + (size_t)a * D + c0) = pack8(acc[ai][bj][m][0] * g, acc[ai][bj][m][1] * g); }
                }
            }
    }
};

struct GlaInSched {
    const bf16_t* XB; const bf16_t* WTM; const bf16_t* WFM;
    __device__ __forceinline__ int lda(const Unit&) const { return D; }
    __device__ __forceinline__ int ldb(const Unit&) const { return D; }
    __device__ __forceinline__ int nt(const Unit&) const { return D / BK; }
    __device__ __forceinline__ bool cont(const Unit&) const { return false; }
    __device__ __forceinline__ bool next(int i, Unit& u) const {
        const int c = blockIdx.x, per = gridDim.x >> 3, x = c & 7, j = c >> 3, lu = i * per + j;
        if (lu >= 224) return false;
        const int un = x * 224 + lu;
        if (un < 1024) { u.e = 0; u.pm = un >> 3; u.pn = un & 7; } else { const int v = un - 1024; u.e = 1; u.pn = v / 6; u.pm = v - u.pn * 6; }
        return true; }
    __device__ __forceinline__ const char* a_base(const Unit& u) const { return u.e ? (const char*)WFM : (const char*)XB; }
    __device__ __forceinline__ int a_row(const Unit& u, int r) const { return u.pm * BM + r; }
    __device__ __forceinline__ int a_col(const Unit&) const { return 0; }
    __device__ __forceinline__ const char* b_base(const Unit& u) const { return u.e ? (const char*)(XB + (size_t)u.pn * BM * D) : (const char*)(WTM + (size_t)u.pn * BM * D); }
};
__device__ __forceinline__ float fexp(float x) { return __builtin_amdgcn_exp2f(x * 1.4426950408889634f); }
struct EpiGlaIn {
    bf16_t* QKR; bf16_t* KVT; const float* RS; const float* BTM; const float* BFM;
    __device__ __forceinline__ void operator()(const f32x4 (&acc)[2][2][4][2], const Unit& u, int wr, int wc, int fr, int fq) const {
        if (u.e == 0) {
#pragma unroll
            for (int ai = 0; ai < 2; ++ai)
#pragma unroll
                for (int m = 0; m < 4; ++m) {
                    const int row = u.pm * BM + ai * HALF + wr * 64 + m * 16 + fr; const float r = RS[row];
#pragma unroll
                    for (int bj = 0; bj < 2; ++bj) { const int c0 = u.pn * BM + bj * HALF + wc * 32 + 8 * fq;
                        f32x4 s0 = (f32x4){r, r, r, r}, s1 = s0;
                        if (u.pn < 4) { const float sg = u.pn < 2 ? 1.0f : -1.0f, qs = u.pn < 2 ? 0.08838834764831845f : 1.0f; const int kf = c0 & 511;
                            const f32x4 b0 = *(const f32x4*)(BTM + (size_t)row * 512 + kf), b1 = *(const f32x4*)(BTM + (size_t)row * 512 + kf + 4);
#pragma unroll
                            for (int j = 0; j < 4; ++j) { s0[j] = r * qs * fexp(sg * b0[j]); s1[j] = r * qs * fexp(sg * b1[j]); } }
                        *(u32x4*)(QKR + (size_t)row * 2048 + c0) = pack8(acc[ai][bj][m][0] * s0, acc[ai][bj][m][1] * s1); }
                }
        } else {
#pragma unroll
            for (int bj = 0; bj < 2; ++bj) { const int t0 = u.pn * BM + bj * HALF + wc * 32 + 8 * fq;
                const f32x4 r0 = *(const f32x4*)(RS + t0), r1 = *(const f32x4*)(RS + t0 + 4);
#pragma unroll
                for (int ai = 0; ai < 2; ++ai)
#pragma unroll
                    for (int m = 0; m < 4; ++m) { const int f = u.pm * BM + ai * HALF + wr * 64 + m * 16 + fr;
                        f32x4 s0 = r0, s1 = r1;
                        if (u.pm < 2) { const f32x4 b0 = *(const f32x4*)(BFM + (size_t)f * T + t0), b1 = *(const f32x4*)(BFM + (size_t)f * T + t0 + 4);
#pragma unroll
                            for (int j = 0; j < 4; ++j) { s0[j] *= fexp(-b0[j]); s1[j] *= fexp(-b1[j]); } }
                        *(u32x4*)(KVT + (size_t)f * T + t0) = pack8(acc[ai][bj][m][0] * s0, acc[ai][bj][m][1] * s1); }
            }
        }
    }
};
template <int TYP> struct GlaAttSched {
    const bf16_t* QKR; const bf16_t* KVT;
    __device__ __forceinline__ bool next(int i, Unit& u) const {
        const int c = blockIdx.x, per = gridDim.x >> 3, x = c & 7, j = c >> 3, lu = i * per + j;
        if (lu >= 64) return false;
        const int un = x * 64 + lu, bh = un >> 5, cc = un & 31;
        u.e = TYP; u.pm = (bh >> 2) * 32 + cc; u.pn = bh & 3; return true; }
    __device__ __forceinline__ int lda(const Unit& u) const { return TYP ? T : 2048; }
    __device__ __forceinline__ int ldb(const Unit& u) const { return TYP ? T : 2048; }
    __device__ __forceinline__ int nt(const Unit& u) const { int n = TYP ? 4 : 2; asm volatile("" : "+s"(n)); return n; }
    __device__ __forceinline__ bool cont(const Unit&) const { return false; }
    __device__ __forceinline__ const char* a_base(const Unit& u) const { return TYP ? (const char*)KVT : (const char*)QKR; }
    __device__ __forceinline__ int a_row(const Unit& u, int r) const { return TYP ? 512 + u.pn * 256 + r : u.pm * BM + r; }
    __device__ __forceinline__ int a_col(const Unit& u) const { return TYP ? u.pm * BM : u.pn * 128; }
    __device__ __forceinline__ const char* b_base(const Unit& u) const {
        return TYP ? (const char*)(KVT + (size_t)(u.pn * 128) * T + (size_t)u.pm * BM) : (const char*)(QKR + (size_t)u.pm * BM * 2048 + 512 + u.pn * 128); }
};
template <int TYP> struct EpiGlaAtt {
    bf16_t* ATT; bf16_t* UT; const float* DL;
    __device__ __forceinline__ void operator()(const f32x4 (&acc)[2][2][4][2], const Unit& u, int wr, int wc, int fr, int fq) const {
        if (TYP == 0) {
#pragma unroll
            for (int ai = 0; ai < 2; ++ai)
#pragma unroll
                for (int m = 0; m < 4; ++m) { const int rit = ai * HALF + wr * 64 + m * 16 + fr;
#pragma unroll
                    for (int bj = 0; bj < 2; ++bj) { const int c0 = bj * HALF + wc * 32 + 8 * fq;
                        f32x4 v0 = acc[ai][bj][m][0], v1 = acc[ai][bj][m][1];
#pragma unroll
                        for (int j = 0; j < 4; ++j) { if (c0 + j > rit) v0[j] = 0.f; if (c0 + 4 + j > rit) v1[j] = 0.f; }
                        *(u32x4*)(ATT + (size_t)(u.pm * BM + rit) * D + u.pn * 256 + c0) = pack8(v0, v1); }
                }
        } else {
            const int k0 = wc * 32 + 8 * fq;
            const f32x4 d0 = *(const f32x4*)(DL + (size_t)u.pm * 512 + u.pn * 128 + k0), d1 = *(const f32x4*)(DL + (size_t)u.pm * 512 + u.pn * 128 + k0 + 4);
            const int b = u.pm >> 5, cc = u.pm & 31; bf16_t* base = UT + (size_t)((b * 4 + u.pn) * 32 + cc) * 32768;
#pragma unroll
            for (int ai = 0; ai < 2; ++ai)
#pragma unroll
                for (int m = 0; m < 4; ++m) { const int dv = ai * HALF + wr * 64 + m * 16 + fr;
                    *(u32x4*)(base + (size_t)dv * 128 + k0) = pack8(acc[ai][0][m][0] * d0, acc[ai][0][m][1] * d1); }
        }
    }
};
struct GlaOSched {
    const bf16_t* QKR; const bf16_t* KVT; const bf16_t* ATT; const bf16_t* SP;
    __device__ __forceinline__ bool next(int i, Unit& u) const {
        const int c = blockIdx.x, per = gridDim.x >> 3, x = c & 7, j = c >> 3, pl = (i >> 1) * per + j;
        if (pl >= 64) return false;
        const int w = x * 64 + pl, bh = w >> 5, cc = w & 31;
        u.e = i & 1; u.pm = (bh >> 2) * 32 + cc; u.pn = bh & 3; return true; }
    __device__ __forceinline__ int lda(const Unit& u) const { return u.e ? D : 2048; }
    __device__ __forceinline__ int ldb(const Unit& u) const { return u.e ? T : 128; }
    __device__ __forceinline__ int nt(const Unit& u) const { return u.e ? 4 : 2; }
    __device__ __forceinline__ bool cont(const Unit& u) const { return u.e == 0; }
    __device__ __forceinline__ const char* a_base(const Unit& u) const { return u.e ? (const char*)ATT : (const char*)QKR; }
    __device__ __forceinline__ int a_row(const Unit& u, int r) const { return u.pm * BM + r; }
    __device__ __forceinline__ int a_col(const Unit& u) const { return u.e ? u.pn * 256 : u.pn * 128; }
    __device__ __forceinline__ const char* b_base(const Unit& u) const { const int b = u.pm >> 5, cc = u.pm & 31;
        return u.e ? (const char*)(KVT + (size_t)(512 + u.pn * 256) * T + (size_t)u.pm * BM) : (const char*)(SP + (size_t)((b * 4 + u.pn) * 32 + cc) * 32768); }
};
struct EpiGlaO {
    bf16_t* O;
    __device__ __forceinline__ void operator()(const f32x4 (&acc)[2][2][4][2], const Unit& u, int wr, int wc, int fr, int fq) const {
#pragma unroll
        for (int ai = 0; ai < 2; ++ai)
#pragma unroll
            for (int m = 0; m < 4; ++m) { const int row = u.pm * BM + ai * HALF + wr * 64 + m * 16 + fr;
#pragma unroll
                for (int bj = 0; bj < 2; ++bj) { const int c0 = u.pn * 256 + bj * HALF + wc * 32 + 8 * fq;
                    *(u32x4*)(O + (size_t)row * D + c0) = pack8(acc[ai][bj][m][0], acc[ai][bj][m][1]); } }
    }
};
}

__device__ __forceinline__ void cvt_item(const float* W, int ldw, int col0, int K, const float* g, bf16_t* Bt, int il, int half, LAS float* scr, int item, int nblk, int lane) {
    const int kb = item / nblk, nb = item - kb * nblk, k0 = 64 * kb, n0 = 32 * nb;
#pragma unroll 8
    for (int i = 0; i < 32; ++i) { const int kk = 2 * i + (lane >> 5); float v = W[(size_t)(k0 + kk) * ldw + col0 + n0 + (lane & 31)]; if (g) v *= g[k0 + kk]; scr[kk * 33 + (lane & 31)] = v; }
    asm volatile("s_waitcnt lgkmcnt(0)" ::: "memory");
    const int c = lane & 7;
#pragma unroll
    for (int j = 0; j < 4; ++j) { const int n = n0 + (lane >> 3) + 8 * j; const LAS float* s = scr + (8 * c) * 33 + (n - n0);
        u32x4 o; o.x = cvt_pk_bf16(s[0 * 33], s[1 * 33]); o.y = cvt_pk_bf16(s[2 * 33], s[3 * 33]); o.z = cvt_pk_bf16(s[4 * 33], s[5 * 33]); o.w = cvt_pk_bf16(s[6 * 33], s[7 * 33]);
        const int drow = il ? ((n >> 7) * 256 + half * 128 + (n & 127)) : n;
        *(u32x4*)(Bt + (size_t)drow * K + k0 + 8 * c) = o; }
    asm volatile("s_waitcnt lgkmcnt(0)" ::: "memory");
}
__device__ __forceinline__ void cvt_matrix(const float* W, int ldw, int col0, int ncols, int K, const float* g, bf16_t* Bt, int il, int half, LAS unsigned char* lds) {
    const int tix = otid();
    const int lane = tix & 63, wv = tix >> 6;
    LAS float* scr = (LAS float*)(lds + wv * 8704);
    const int gw = blockIdx.x * (blockDim.x >> 6) + wv, ngw = gridDim.x * (blockDim.x >> 6);
    const int nblk = ncols / 32, nitems = (K / 64) * nblk;
    for (int it = gw; it < nitems; it += ngw) cvt_item(W, ldw, col0, K, g, Bt, il, half, scr, it, nblk, lane);
}
__device__ __forceinline__ void rows_prep(const float* x, bf16_t* XB, float* rs, float* ssp, int rows) {
    const int tix = otid();
    const int lane = tix & 63;
    const int gw = (blockIdx.x * blockDim.x + tix) >> 6, ngw = (gridDim.x * blockDim.x) >> 6;
    for (int r = gw; r < rows; r += ngw) {
        const f32x4* xr = (const f32x4*)(x + (size_t)r * D);
        f32x4 v[4]; float s = 0.f;
#pragma unroll
        for (int j = 0; j < 4; ++j) { v[j] = xr[lane + 64 * j]; s += (v[j][0] * v[j][0] + v[j][1] * v[j][1]) + (v[j][2] * v[j][2] + v[j][3] * v[j][3]); }
        s = wave_sum(s);
        if (lane == 0) rs[r] = rsqrtf(s * (1.0f / D) + EPS);
        if (ssp && lane < 16) ssp[(size_t)r * 16 + lane] = lane == 0 ? s : 0.f;
        u32x2* o = (u32x2*)(XB + (size_t)r * D);
#pragma unroll
        for (int j = 0; j < 4; ++j) { u32x2 w; w.x = cvt_pk_bf16(v[j][0], v[j][1]); w.y = cvt_pk_bf16(v[j][2], v[j][3]); o[lane + 64 * j] = w; }
    }
}

__device__ __forceinline__ void rows_norm_bf16(const float* x, const float* g, bf16_t* out, int rows) {
    const int tix = otid();
    const int lane = tix & 63;
    const int gw = (blockIdx.x * blockDim.x + tix) >> 6, ngw = (gridDim.x * blockDim.x) >> 6;
    for (int r = gw; r < rows; r += ngw) {
        const f32x4* xr = (const f32x4*)(x + (size_t)r * D);
        f32x4 v[4]; float s = 0.f;
#pragma unroll
        for (int j = 0; j < 4; ++j) { v[j] = xr[lane + 64 * j]; s += (v[j][0] * v[j][0] + v[j][1] * v[j][1]) + (v[j][2] * v[j][2] + v[j][3] * v[j][3]); }
        s = wave_sum(s); const float rs = rsqrtf(s * (1.0f / D) + EPS);
        u32x2* o = (u32x2*)(out + (size_t)r * D);
#pragma unroll
        for (int j = 0; j < 4; ++j) { const f32x4 gg = ((const f32x4*)g)[lane + 64 * j]; u32x2 w; w.x = cvt_pk_bf16(v[j][0] * rs * gg[0], v[j][1] * rs * gg[1]); w.y = cvt_pk_bf16(v[j][2] * rs * gg[2], v[j][3] * rs * gg[3]); o[lane + 64 * j] = w; }
    }
}

__device__ __forceinline__ void route_prep(const float* wg, const float* we, const float* gain, float* WR) {
    const int tix = otid();
    const int gi = blockIdx.x * blockDim.x + tix, gs = gridDim.x * blockDim.x;
    for (int i = gi; i < 36 * 1024; i += gs) { const int j = i >> 10, k = i & 1023; WR[i] = (j < 32 ? we[k * NE + j] : wg[k * NG + (j - 32)]) * gain[k]; }
}
__device__ __forceinline__ float reduce16(float (&v)[18], int lane) {
#pragma unroll
    for (int st = 0; st < 4; ++st) { const int half = 8 >> st, bit = 32 >> st; const bool up = (lane & bit) != 0;
#pragma unroll
        for (int k = 0; k < half; ++k) { const float send = up ? v[k] : v[k + half]; const float keep = up ? v[k + half] : v[k]; v[k] = keep + __shfl_xor(send, bit); } }
    float r = v[0]; r += __shfl_xor(r, 2); r += __shfl_xor(r, 1); return r;
}
__device__ __forceinline__ float reduce2(const float (&v)[18], int lane) {
    const bool up = (lane & 32) != 0; const float send = up ? v[16] : v[17], keep = up ? v[17] : v[16];
    float r = keep + __shfl_xor(send, 32);
#pragma unroll
    for (int o = 16; o >= 1; o >>= 1) r += __shfl_xor(r, o);
    return r;
}
__device__ __forceinline__ void route_phase(const float* X, const float* WR, const float* bg, const float* be, float* RS, int* assign_e, int* assign_pos, float* gate, int* gcnt, LAS unsigned char* lds) {
    int tid_ = threadIdx.x; asm volatile("" : "+v"(tid_)); const int tid = tid_, lane = tid & 63, wv = tid >> 6;
    LAS float* Wr = (LAS float*)lds;
    LAS int* lcnt = (LAS int*)(lds + 36 * 4096); LAS int* lbase = lcnt + 32; LAS int* l_e = lbase + 32; LAS int* l_rank = l_e + 256;
    for (int i = tid; i < 36 * 256; i += 512) ((LAS f32x4*)Wr)[i] = ((const f32x4*)WR)[i];
    for (int tb = blockIdx.x; tb < T / 128; tb += gridDim.x) {
        if (tid < 32) lcnt[tid] = 0;
        __syncthreads();
#pragma unroll 1
        for (int it = 0; it < 8; ++it) {
            const int tl0 = wv * 16 + it * 2, t0 = tb * 128 + tl0;
            f32x4 xv[2][4]; float rsv[2];
#pragma unroll
            for (int r = 0; r < 2; ++r) { float s = 0.f;
#pragma unroll
                for (int c = 0; c < 4; ++c) { xv[r][c] = *(const f32x4*)(X + (size_t)(t0 + r) * D + 256 * c + 4 * lane); s += (xv[r][c][0] * xv[r][c][0] + xv[r][c][1] * xv[r][c][1]) + (xv[r][c][2] * xv[r][c][2] + xv[r][c][3] * xv[r][c][3]); }
                rsv[r] = rsqrtf(wave_sum(s) * (1.0f / D) + EPS); }
            LAS float* lg = (LAS float*)(lds + 36 * 4096 + 4096) + wv * 160;
#pragma unroll 1
            for (int q = 0; q < 4; ++q) {
                float acc[2][9];
#pragma unroll
                for (int r = 0; r < 2; ++r)
#pragma unroll
                    for (int j = 0; j < 9; ++j) acc[r][j] = 0.f;
                const unsigned be_ = (unsigned)(8 * q * 4096 + 16 * lane), bg_ = (unsigned)((32 + q) * 4096 + 16 * lane);
#pragma unroll
                for (int j = 0; j < 9; ++j) {
#pragma unroll
                    for (int c = 0; c < 4; ++c) {
                        const f32x4 w4 = j < 8 ? *(const LAS f32x4*)(lds + be_ + j * 4096 + c * 1024) : *(const LAS f32x4*)(lds + bg_ + c * 1024);
#pragma unroll
                        for (int r = 0; r < 2; ++r) acc[r][j] = fmaf(xv[r][c][3], w4[3], fmaf(xv[r][c][2], w4[2], fmaf(xv[r][c][1], w4[1], fmaf(xv[r][c][0], w4[0], acc[r][j])))); }
                    if (j % 3 == 2) __builtin_amdgcn_sched_barrier(0);
                }
#pragma unroll
                for (int r = 0; r < 2; ++r) {
                    const float g1 = wave_sum(acc[r][8]);
#pragma unroll
                    for (int st = 0; st < 3; ++st) { const int half = 4 >> st, bit = 32 >> st; const bool up = (lane & bit) != 0;
#pragma unroll
                        for (int k = 0; k < half; ++k) { const float send = up ? acc[r][k] : acc[r][k + half]; const float keep = up ? acc[r][k + half] : acc[r][k]; acc[r][k] = keep + __shfl_xor(send, bit); } }
                    float e8 = acc[r][0]; e8 += __shfl_xor(e8, 4); e8 += __shfl_xor(e8, 2); e8 += __shfl_xor(e8, 1);
                    if ((lane & 7) == 0) lg[r * 40 + 8 * q + (lane >> 3)] = e8;
                    if (lane == 0) lg[r * 40 + 32 + q] = g1;
                }
            }
            asm volatile("s_waitcnt lgkmcnt(0)" ::: "memory");
            {
                const int r = lane & 1; const LAS float* L = lg + r * 40;
                const float rs = r == 0 ? rsv[0] : rsv[1];
                float gl[4];
#pragma unroll
                for (int g = 0; g < 4; ++g) gl[g] = L[32 + g] * rs + bg[g];
                int gs = 0; float gm = gl[0];
#pragma unroll
                for (int g = 1; g < 4; ++g) if (gl[g] > gm) { gm = gl[g]; gs = g; }
                float se = 0.f;
#pragma unroll
                for (int g = 0; g < 4; ++g) se += expf(gl[g] - gm);
                const float pg = 1.0f / se;
                float el[8];
#pragma unroll
                for (int i = 0; i < 8; ++i) el[i] = L[gs * 8 + i] * rs + be[gs * 8 + i];
                float em = el[0];
#pragma unroll
                for (int i = 1; i < 8; ++i) em = fmaxf(em, el[i]);
                float pe[8], ps = 0.f;
#pragma unroll
                for (int i = 0; i < 8; ++i) { pe[i] = expf(el[i] - em); ps += pe[i]; }
#pragma unroll
                for (int i = 0; i < 8; ++i) pe[i] = pe[i] / ps;
                int i1 = 0; float p1 = pe[0];
#pragma unroll
                for (int i = 1; i < 8; ++i) if (pe[i] > p1) { p1 = pe[i]; i1 = i; }
                int i2 = -1; float p2 = -1.f;
#pragma unroll
                for (int i = 0; i < 8; ++i) if (i != i1 && pe[i] > p2) { p2 = pe[i]; i2 = i; }
                if (lane < 2) {
                    const int t = t0 + r, tl = tl0 + r; const float den = p1 + p2; const int e1 = gs * 8 + i1, e2 = gs * 8 + i2;
                    RS[t] = rs; gate[2 * t] = pg * p1 / den; gate[2 * t + 1] = pg * p2 / den;
                    l_e[2 * tl] = e1; l_e[2 * tl + 1] = e2;
                    l_rank[2 * tl] = atomicAdd((int*)(lcnt + e1), 1); l_rank[2 * tl + 1] = atomicAdd((int*)(lcnt + e2), 1);
                }
            }
        }
        __syncthreads();
        if (tid < 32) lbase[tid] = __hip_atomic_fetch_add(gcnt + tid, lcnt[tid], __ATOMIC_RELAXED, __HIP_MEMORY_SCOPE_AGENT);
        __syncthreads();
        if (tid < 256) { const int a = tb * 256 + tid, e = l_e[tid]; assign_e[a] = e; assign_pos[a] = lbase[e] + l_rank[tid]; }
        __syncthreads();
    }
}
__device__ __forceinline__ void build_phase(const int* gcnt, const int* assign_e, const int* assign_pos, const float* gate, const float* RS,
                                            int* ntiles, int* tile_e, int* slot_tok, int* slot_a, float* slot_rs, float* slot_gate, LAS unsigned char* lds) {
    const int tix = otid();
    LAS int* poff = (LAS int*)lds; LAS int* cn = poff + 40;
    if (tix == 0) { int o = 0; for (int e = 0; e < 32; ++e) { const int cc = g8::ld_agent(gcnt + e); cn[e] = cc; poff[e] = o; o += (cc + 255) / 256 * 256; } poff[32] = o; }
    __syncthreads();
    const int gi = blockIdx.x * blockDim.x + tix, gs = gridDim.x * blockDim.x;
    for (int a = gi; a < NA; a += gs) { const int e = assign_e[a]; const int sl = poff[e] + assign_pos[a]; slot_tok[sl] = a >> 1; slot_a[sl] = a; slot_rs[sl] = RS[a >> 1]; slot_gate[sl] = gate[a]; }
    for (int i = gi; i < 32 * 256; i += gs) { const int e = i >> 8, sl = poff[e] + cn[e] + (i & 255); if (sl < poff[e + 1]) { slot_tok[sl] = 0; slot_a[sl] = -1; slot_rs[sl] = 0.f; slot_gate[sl] = 0.f; } }
    if (blockIdx.x == 0) {
        const int NT = poff[32] >> 8;
        for (int rt = tix; rt < NT; rt += blockDim.x) { int e = 0; for (int k = 0; k < 32; ++k) if (rt * 256 >= poff[k] && rt * 256 < poff[k + 1]) e = k; tile_e[rt] = e; }
        if (tix == 0) *ntiles = NT;
    }
    __syncthreads();
}
__device__ __forceinline__ void cvt_moe(const float* wgate, const float* wup, const float* wdown, const float* gain, bf16_t* W1, bf16_t* W2, LAS unsigned char* lds) {
    const int tix = otid();
    const int lane = tix & 63, wv = tix >> 6;
    LAS float* scr = (LAS float*)(lds + 1024 + wv * 8704);
    const int gw = blockIdx.x * (blockDim.x >> 6) + wv, ngw = gridDim.x * (blockDim.x >> 6);
    for (int it = gw; it < 32 * 768; it += ngw) {
        const int e = it / 768, r = it - e * 768;
        if (r < 256) cvt_item(wgate + (size_t)e * D * DE, DE, 0, D, gain, W1 + (size_t)e * D * D, 1, 0, scr, r, 16, lane);
        else if (r < 512) cvt_item(wup + (size_t)e * D * DE, DE, 0, D, gain, W1 + (size_t)e * D * D, 1, 1, scr, r - 256, 16, lane);
        else cvt_item(wdown + (size_t)e * DE * D, D, 0, DE, nullptr, W2 + (size_t)e * D * DE, 0, 0, scr, r - 512, 32, lane);
    }
}
__device__ __forceinline__ void combine_phase(float* X, const bf16_t* Y, bf16_t* XB, float* RS, float* ssp, const float* gfinal, int fin, const float* WA, float* ALR, LAS unsigned char* lds) {
    const int tix = otid();
    const int lane = tix & 63;
    if (WA) { for (int i = tix; i < 16 * 256; i += 512) ((LAS f32x4*)lds)[i] = ((const f32x4*)WA)[i]; __syncthreads(); }
    const int gw = (blockIdx.x * blockDim.x + tix) >> 6, ngw = (gridDim.x * blockDim.x) >> 6;
    for (int t = gw; t < T; t += ngw) {
        f32x4 v[4]; float s = 0.f;
#pragma unroll
        for (int j = 0; j < 4; ++j) {
            v[j] = ((const f32x4*)(X + (size_t)t * D))[lane + 64 * j];
            const u32x2 y0 = ((const u32x2*)(Y + (size_t)(2 * t) * D))[lane + 64 * j], y1 = ((const u32x2*)(Y + (size_t)(2 * t + 1) * D))[lane + 64 * j];
            v[j][0] += bf_lo(y0.x) + bf_lo(y1.x); v[j][1] += bf_hi(y0.x) + bf_hi(y1.x); v[j][2] += bf_lo(y0.y) + bf_lo(y1.y); v[j][3] += bf_hi(y0.y) + bf_hi(y1.y);
            s += (v[j][0] * v[j][0] + v[j][1] * v[j][1]) + (v[j][2] * v[j][2] + v[j][3] * v[j][3]); }
        s = wave_sum(s); const float rs = rsqrtf(s * (1.0f / D) + EPS);
        if (fin) {
#pragma unroll
            for (int j = 0; j < 4; ++j) { const f32x4 gg = ((const f32x4*)gfinal)[lane + 64 * j]; ((f32x4*)(X + (size_t)t * D))[lane + 64 * j] = v[j] * rs * gg; }
        } else {
            if (lane == 0) RS[t] = rs;
            if (lane < 16) ssp[(size_t)t * 16 + lane] = lane == 0 ? s : 0.f;
            if (WA) {
                float a16[18];
#pragma unroll
                for (int o = 0; o < 16; ++o) { float p = 0.f;
#pragma unroll
                    for (int j = 0; j < 4; ++j) { const f32x4 w4 = *(const LAS f32x4*)(lds + (o * 1024 + 256 * j + 4 * lane) * 4);
                        p = fmaf(v[j][3], w4[3], fmaf(v[j][2], w4[2], fmaf(v[j][1], w4[1], fmaf(v[j][0], w4[0], p)))); }
                    a16[o] = p; }
                a16[16] = 0.f; a16[17] = 0.f;
                const float red = reduce16(a16, lane);
                if ((lane & 3) == 0) ALR[(size_t)t * 16 + (lane >> 2)] = red * rs;
            }
#pragma unroll
            for (int j = 0; j < 4; ++j) { ((f32x4*)(X + (size_t)t * D))[lane + 64 * j] = v[j];
                u32x2 w; w.x = cvt_pk_bf16(v[j][0], v[j][1]); w.y = cvt_pk_bf16(v[j][2], v[j][3]); ((u32x2*)(XB + (size_t)t * D))[lane + 64 * j] = w; }
        }
    }
}

__device__ __forceinline__ void gla_prep(const float* win, const float* wo, const float* gain, bf16_t* WGTM, bf16_t* WGFM, bf16_t* WGO, float* WA, LAS unsigned char* lds) {
    cvt_matrix(win, GLA_COLS, 0, 512, D, gain, WGTM, 0, 0, lds);
    cvt_matrix(win, GLA_COLS, 512, 512, D, gain, WGTM + (size_t)512 * D, 0, 0, lds);
    cvt_matrix(win, GLA_COLS, 2064, 1024, D, gain, WGTM + (size_t)1024 * D, 0, 0, lds);
    cvt_matrix(win, GLA_COLS, 512, 512, D, gain, WGFM, 0, 0, lds);
    cvt_matrix(win, GLA_COLS, 1024, 1024, D, gain, WGFM + (size_t)512 * D, 0, 0, lds);
    cvt_matrix(wo, D, 0, D, D, nullptr, WGO, 0, 0, lds);
    const int tix = otid(); const int gi = blockIdx.x * blockDim.x + tix, gs = gridDim.x * blockDim.x;
    for (int i = gi; i < 16 * 1024; i += gs) { const int j = i >> 10, k = i & 1023; WA[i] = win[(size_t)k * GLA_COLS + 2048 + j] * gain[k]; }
}
__device__ __forceinline__ void gla_decay(const float* ALR, const float* wa2, const float* ba, float* BTM, float* BFM, float* DL) {
    const int tix = otid(); const int gi = blockIdx.x * blockDim.x + tix, gs = gridDim.x * blockDim.x;
    for (int it = gi; it < 128 * 512; it += gs) {
        const int ch = it >> 9, kf = it & 511, t0 = ch * 256;
        float w[16];
#pragma unroll
        for (int r = 0; r < 16; ++r) w[r] = wa2[r * GDK + kf];
        const float bias = ba[kf]; float b = 0.f;
#pragma unroll 1
        for (int s16 = 0; s16 < 16; ++s16) {
            float ring[16];
#pragma unroll
            for (int q = 0; q < 16; ++q) {
                const int t = t0 + s16 * 16 + q;
                const f32x4 a0 = *(const f32x4*)(ALR + (size_t)t * 16), a1 = *(const f32x4*)(ALR + (size_t)t * 16 + 4), a2 = *(const f32x4*)(ALR + (size_t)t * 16 + 8), a3 = *(const f32x4*)(ALR + (size_t)t * 16 + 12);
                float z = bias;
#pragma unroll
                for (int r = 0; r < 4; ++r) { z = fmaf(a0[r], w[r], z); z = fmaf(a1[r], w[4 + r], z); z = fmaf(a2[r], w[8 + r], z); z = fmaf(a3[r], w[12 + r], z); }
                const float ls = fminf(z, 0.f) - log1pf(expf(-fabsf(z)));
                b += ls * (1.0f / 16.0f);
                BTM[(size_t)t * 512 + kf] = b; ring[q] = b;
            }
            f32x4* o = (f32x4*)(BFM + (size_t)kf * T + t0 + s16 * 16);
#pragma unroll
            for (int q = 0; q < 4; ++q) o[q] = (f32x4){ring[4 * q], ring[4 * q + 1], ring[4 * q + 2], ring[4 * q + 3]};
        }
        DL[(size_t)ch * 512 + kf] = expf(b);
    }
}
__device__ __forceinline__ void gla_scan(const bf16_t* UT, const float* DL, bf16_t* SP) {
    const int tix = otid(); const int gi = blockIdx.x * blockDim.x + tix, gs = gridDim.x * blockDim.x;
    for (int it = gi; it < 16 * 32768 / 2; it += gs) {
        const int bh = it >> 14, idx = (it & 16383) * 2, k = idx & 127, b = bh >> 2, h = bh & 3;
        float s0 = 0.f, s1 = 0.f;
        for (int c = 0; c < 32; ++c) {
            const size_t off = (size_t)(bh * 32 + c) * 32768 + idx;
            const unsigned uu = *(const unsigned*)(UT + off);
            *(unsigned*)(SP + off) = cvt_pk_bf16(s0, s1);
            const f32x2 d = *(const f32x2*)(DL + (size_t)(b * 32 + c) * 512 + h * 128 + k);
            s0 = fmaf(d[0], s0, bf_lo(uu)); s1 = fmaf(d[1], s1, bf_hi(uu));
        }
    }
}
__device__ __forceinline__ void gla_fin(const bf16_t* O, const bf16_t* QKR, const float* ng, bf16_t* GO) {
    const int tix = otid(); const int lane = tix & 63;
    const int gw = (blockIdx.x * blockDim.x + tix) >> 6, ngw = (gridDim.x * blockDim.x) >> 6;
    const f32x4 gg = ((const f32x4*)ng)[lane];
    for (int t = gw; t < T; t += ngw) {
#pragma unroll
        for (int j = 0; j < 4; ++j) {
            const u32x2 ow = ((const u32x2*)(O + (size_t)t * D))[lane + 64 * j], rw = ((const u32x2*)(QKR + (size_t)t * 2048 + 1024))[lane + 64 * j];
            const f32x4 o = (f32x4){bf_lo(ow.x), bf_hi(ow.x), bf_lo(ow.y), bf_hi(ow.y)}, r = (f32x4){bf_lo(rw.x), bf_hi(rw.x), bf_lo(rw.y), bf_hi(rw.y)};
            const float ss = wave_sum((o[0] * o[0] + o[1] * o[1]) + (o[2] * o[2] + o[3] * o[3]));
            const float rs = rsqrtf(ss * (1.0f / GDVH) + EPS);
            f32x4 y;
#pragma unroll
            for (int q = 0; q < 4; ++q) y[q] = o[q] * rs * gg[q] * (r[q] * fast_sigmoid(r[q]));
            u32x2 w; w.x = cvt_pk_bf16(y[0], y[1]); w.y = cvt_pk_bf16(y[2], y[3]);
            ((u32x2*)(GO + (size_t)t * D))[lane + 64 * j] = w;
        }
    }
}

__device__ __forceinline__ void conv_phase(const bf16_t* U, const float* wdw, const float* bdw, const float* lng, const float* lnb, bf16_t* CV, LAS unsigned char* lds) {
    int tid_ = threadIdx.x; asm volatile("" : "+v"(tid_));
    const int tid = tid_, lane = tid & 63, wv = tid >> 6, c0 = 2 * tid;
    LAS float* red = (LAS float*)lds; LAS float* tot = red + 512;
    f32x2 w[CONVK];
#pragma unroll
    for (int j = 0; j < CONVK; ++j) w[j] = *(const f32x2*)(wdw + j * D + c0);
    const f32x2 bd = *(const f32x2*)(bdw + c0), lg = *(const f32x2*)(lng + c0), lb = *(const f32x2*)(lnb + c0);
    for (int item = blockIdx.x; item < T / 32; item += gridDim.x) {
        const int t0 = item * 32, s0 = t0 & (S - 1);
        f32x2 acc[32];
#pragma unroll
        for (int o = 0; o < 32; ++o) acc[o] = bd;
#pragma unroll
        for (int r = 0; r < 62; ++r) {
            unsigned raw = 0u;
            if (s0 - 30 + r >= 0) raw = *(const unsigned*)(U + (size_t)(t0 - 30 + r) * D + c0);
            const f32x2 uv = (f32x2){bf_lo(raw), bf_hi(raw)};
#pragma unroll
            for (int o = (r > 30 ? r - 30 : 0); o <= (r < 31 ? r : 31); ++o) acc[o] = __builtin_elementwise_fma(uv, w[r - o], acc[o]);
        }
        float v[64];
#pragma unroll
        for (int o = 0; o < 32; ++o) { v[o] = acc[o][0] + acc[o][1]; v[32 + o] = acc[o][0] * acc[o][0] + acc[o][1] * acc[o][1]; }
#pragma unroll
        for (int st = 0; st < 6; ++st) {
            const int half = 32 >> st, bit = 32 >> st; const bool up = (lane & bit) != 0;
#pragma unroll
            for (int k = 0; k < half; ++k) { const float send = up ? v[k] : v[k + half]; const float keep = up ? v[k + half] : v[k]; v[k] = keep + __shfl_xor(send, bit); }
        }
        red[wv * 64 + lane] = v[0];
        __syncthreads();
        if (tid < 64) { float s = 0.f;
#pragma unroll
            for (int q = 0; q < 8; ++q) s += red[q * 64 + tid];
            tot[tid] = s; }
        __syncthreads();
#pragma unroll
        for (int o = 0; o < 32; ++o) {
            const float mu = tot[o] * (1.0f / D), var = tot[32 + o] * (1.0f / D) - mu * mu, rstd = rsqrtf(var + EPS);
            const float y0 = (acc[o][0] - mu) * rstd * lg[0] + lb[0], y1 = (acc[o][1] - mu) * rstd * lg[1] + lb[1];
            *(unsigned*)(CV + (size_t)(t0 + o) * D + c0) = cvt_pk_bf16(y0 * fast_sigmoid(y0), y1 * fast_sigmoid(y1));
        }
        __syncthreads();
    }
}

enum Ph { PH_PREP0 = 0, PH_CONV_IN, PH_CONV_MID, PH_CONV_OUT, PH_ADAPT, PH_XA_PREP, PH_XA_Q, PH_XA_KV, PH_XA_S, PH_XA_PV, PH_XA_O, PH_ROUTE_PREP, PH_ROUTE, PH_BUILD, PH_MOE1, PH_MOE2, PH_COMBINE, PH_COMBINE_FIN, PH_GLA_PREP, PH_GLA_DECAY, PH_GLA_IN, PH_GLA_ATT, PH_GLA_UT, PH_GLA_SCAN, PH_GLA_O, PH_GLA_FIN, PH_GLA_OUT, PH_NOP, PH_N };

__device__ __forceinline__ void run_phase(const Ctx& c, int ph, int l, LAS unsigned char* lds) {
    unsigned char* ws = c.ws;
    bf16_t* XB = (bf16_t*)(ws + OW_XB); float* RS = (float*)(ws + OW_RS); float* SSP = (float*)(ws + OW_SSP);
    bf16_t* ACTA = (bf16_t*)(ws + OW_ACTA); bf16_t* ACTB = (bf16_t*)(ws + OW_ACTB);
    bf16_t* WCIN = (bf16_t*)(ws + OW_WCIN); bf16_t* WCOUT = (bf16_t*)(ws + OW_WCOUT);
    bf16_t* ACTC = (bf16_t*)(ws + OW_ACTC); float* PSUM = (float*)(ws + OW_PSUM);
    bf16_t* WXQ = (bf16_t*)(ws + OW_WXQ) + (size_t)l * D * D; bf16_t* WXKV = (bf16_t*)(ws + OW_WXKV) + (size_t)l * 2048 * D; bf16_t* WXO = (bf16_t*)(ws + OW_WXO) + (size_t)l * D * D;
    float* WR = (float*)(ws + OW_WR) + (size_t)l * 36 * 1024;
    int* GCNT = (int*)(ws + OM_GCNT); int* NTP = (int*)(ws + OM_NT); int* TILEE = (int*)(ws + OM_TILEE); int* AE = (int*)(ws + OM_AE); int* APOS = (int*)(ws + OM_APOS); float* GATE = (float*)(ws + OM_GATE);
    int* STOK = (int*)(ws + OM_STOK); int* SA = (int*)(ws + OM_SA); float* SRS = (float*)(ws + OM_SRS); float* SGATE = (float*)(ws + OM_SGATE);
    bf16_t* HB = (bf16_t*)(ws + OW_H); bf16_t* YB = (bf16_t*)(ws + OW_Y); bf16_t* W1 = (bf16_t*)(ws + OW_WMOE); bf16_t* W2 = W1 + (size_t)NE * D * D;
    bf16_t* ATTB = (bf16_t*)(ws + OW_ATT); bf16_t* QKR = (bf16_t*)(ws + OW_QKR); bf16_t* KVT = (bf16_t*)(ws + OW_KVT); float* BTM = (float*)(ws + OW_BTM); float* BFM = (float*)(ws + OW_BFM);
    bf16_t* OB = (bf16_t*)(ws + OW_O); bf16_t* UTB = (bf16_t*)(ws + OW_UT); bf16_t* SPB = (bf16_t*)(ws + OW_SP); float* ALR = (float*)(ws + OW_ALR); float* DLF = (float*)(ws + OW_DL); bf16_t* GOB = (bf16_t*)(ws + OW_GO);
    bf16_t* WGTM = (bf16_t*)(ws + OW_WGTM); bf16_t* WGFM = (bf16_t*)(ws + OW_WGFM); bf16_t* WGO = (bf16_t*)(ws + OW_WGO); float* WAF = (float*)(ws + OW_WA);
    bf16_t* KB = (bf16_t*)(ws + OW_KVB); bf16_t* VT = KB + (size_t)1024 * 1024; bf16_t* MEMNB = (bf16_t*)(ws + OW_MEMNB);
    switch (ph) {
    case PH_PREP0:
        cvt_matrix(c.in[7], 2048, 0, 1024, D, c.in[2], WCIN, 1, 0, lds);
        cvt_matrix(c.in[7], 2048, 1024, 1024, D, c.in[2], WCIN, 1, 1, lds);
        cvt_matrix(c.in[13], D, 0, D, D, nullptr, WCOUT, 0, 0, lds);
        rows_prep(c.in[0], XB, RS, nullptr, T);
        break;
    case PH_CONV_IN: { g8::DenseSched S{8, 128 * 8, D, D, D, XB, WCIN}; g8::gemm_phase(lds, S, g8::EpiGlu{ACTA, RS, c.in[8]}); } break;
    case PH_CONV_MID: conv_phase(ACTA, c.in[9], c.in[10], c.in[11], c.in[12], ACTB, lds); break;
    case PH_CONV_OUT: { g8::DenseSched S{4, 128 * 4, D, D, D, ACTB, WCOUT}; g8::gemm_phase(lds, S, g8::EpiXres{c.in[0], c.out, XB, c.in[14], SSP}); } break;
    case PH_ADAPT: rows_prep(c.out, XB, RS, SSP, T); break;
    case PH_XA_PREP:
        cvt_matrix(c.in[20] + (size_t)l * D * D, D, 0, D, D, c.in[3] + l * D, WXQ, 0, 0, lds);
        cvt_matrix(c.in[21] + (size_t)l * D * 2048, 2048, 0, 2048, D, nullptr, WXKV, 0, 0, lds);
        cvt_matrix(c.in[22] + (size_t)l * D * D, D, 0, D, D, nullptr, WXO, 0, 0, lds);
        rows_norm_bf16(c.in[1], c.in[5], MEMNB, NB * NMEM);
        break;
    case PH_XA_Q: { g8::DenseSched S{4, 128 * 4, D, D, D, XB, WXQ}; g8::gemm_phase(lds, S, g8::EpiRowScale{ACTA, D, SSP, nullptr, 0.0625f, 0, 1.0f}); } break;
    case PH_XA_KV: { g8::KVSched S{D, D, D, MEMNB, WXKV}; g8::gemm_phase(lds, S, g8::EpiKV{KB, VT}); } break;
    case PH_XA_S: { g8::AttnSched S{256, D, D, ACTA, KB, 0}; g8::gemm_phase(lds, S, g8::EpiS{ACTB, PSUM}); } break;
    case PH_XA_PV: { g8::AttnSched S{256, D, 256, ACTB, VT, 1}; g8::gemm_phase(lds, S, g8::EpiPV{ACTC, PSUM}); } break;
    case PH_XA_O: { g8::DenseSched S{4, 128 * 4, D, D, D, ACTC, WXO}; g8::gemm_phase(lds, S, g8::EpiXres{c.out, c.out, XB, nullptr, nullptr}); } break;
    case PH_ROUTE_PREP: route_prep(c.in[23] + (size_t)l * D * NG, c.in[25] + (size_t)l * D * NE, c.in[4] + l * D, WR);
        { const int tix = otid(); if (blockIdx.x == 0 && tix < 32) GCNT[tix] = 0; }
        break;
    case PH_ROUTE: route_phase(c.out, WR, c.in[24] + l * NG, c.in[26] + l * NE, RS, AE, APOS, GATE, GCNT, lds); break;
    case PH_BUILD: build_phase(GCNT, AE, APOS, GATE, RS, NTP, TILEE, STOK, SA, SRS, SGATE, lds);
        cvt_moe(c.in[27] + (size_t)l * NE * D * DE, c.in[28] + (size_t)l * NE * D * DE, c.in[29] + (size_t)l * NE * DE * D, c.in[4] + l * D, W1, W2, lds);
        break;
    case PH_MOE1: { g8::MoeSched S{D, D, D, XB, W1, (size_t)D * D, TILEE, STOK, __builtin_amdgcn_readfirstlane(g8::ld_agent(NTP))}; g8::gemm_phase(lds, S, g8::EpiMoe1{HB, SRS}); } break;
    case PH_MOE2: { g8::MoeSched S{DE, DE, DE, HB, W2, (size_t)D * DE, TILEE, nullptr, __builtin_amdgcn_readfirstlane(g8::ld_agent(NTP))}; g8::gemm_phase(lds, S, g8::EpiMoe2{YB, SA, SGATE}); } break;
    case PH_COMBINE: combine_phase(c.out, YB, XB, RS, SSP, nullptr, 0, WAF, ALR, lds); break;
    case PH_COMBINE_FIN: combine_phase(c.out, YB, XB, RS, SSP, c.in[6], 1, nullptr, nullptr, lds); break;
    case PH_GLA_PREP: gla_prep(c.in[15], c.in[19], c.in[2] + D, WGTM, WGFM, WGO, WAF, lds); break;
    case PH_GLA_DECAY: gla_decay(ALR, c.in[16], c.in[17], BTM, BFM, DLF); break;
    case PH_GLA_IN: { g8::GlaInSched S{XB, WGTM, WGFM}; g8::gemm_phase(lds, S, g8::EpiGlaIn{QKR, KVT, RS, BTM, BFM}); } break;
    case PH_GLA_ATT: { g8::GlaAttSched<0> S{QKR, KVT}; g8::gemm_phase(lds, S, g8::EpiGlaAtt<0>{ATTB, UTB, DLF}); } break;
    case PH_GLA_UT: { g8::GlaAttSched<1> S{QKR, KVT}; g8::gemm_phase(lds, S, g8::EpiGlaAtt<1>{ATTB, UTB, DLF}); } break;
    case PH_GLA_SCAN: gla_scan(UTB, DLF, SPB); break;
    case PH_GLA_O: { g8::GlaOSched S{QKR, KVT, ATTB, SPB}; g8::gemm_phase(lds, S, g8::EpiGlaO{OB}); } break;
    case PH_GLA_FIN: gla_fin(OB, QKR, c.in[18], GOB); break;
    case PH_GLA_OUT: { g8::DenseSched S{4, 128 * 4, D, D, D, GOB, WGO}; g8::gemm_phase(lds, S, g8::EpiXres{c.out, c.out, XB, nullptr, SSP}); } break;
    }
}
template <int PH> __global__ void __launch_bounds__(512, 2) k_opt(Ctx c, int l) {
    extern __shared__ __attribute__((aligned(16))) unsigned char dynlds[];
    run_phase(c, PH, l, (LAS unsigned char*)dynlds);
}
#ifndef COOP
#define COOP 1
#endif
enum Op { OP_MEMN = 0, OP_MEMKV, OP_COPYX, OP_RMS_MIX, OP_CONV_IN, OP_GLU, OP_DWCONV, OP_CONV_OUT, OP_GLA_IN, OP_GLA_DECAY, OP_GLA_REC, OP_GLA_NORM, OP_GLA_OUT,
          OP_RMS_XA, OP_XA_Q, OP_XA_ATT, OP_XA_O, OP_RMS_FFN, OP_ROUTE, OP_BUILD, OP_MOE_GATE, OP_MOE_UP, OP_MOE_ACT, OP_MOE_DOWN, OP_MOE_COMBINE, OP_FINAL };

__device__ __forceinline__ void run_op(const Ctx& c, int op, int l, float* sm) {
    unsigned char* ws = c.ws;
    float* HN = (float*)(ws + WS_HN); float* BIG = (float*)(ws + WS_BIG);
    float* MEMN = (float*)(ws + WS_MEMN); float* KV = (float*)(ws + WS_KV) + (size_t)l * 1024 * 2048;
    int* eid = (int*)(ws + WS_EID); float* gate = (float*)(ws + WS_GATE); int* pos = (int*)(ws + WS_POS);
    int* slot_tok = (int*)(ws + WS_SLOTTOK); int* slot_a = (int*)(ws + WS_SLOTA); int* tile_e = (int*)(ws + WS_TILEE); int* cnt = (int*)(ws + WS_CNT);
    float* X = c.out;
    switch (op) {
    case OP_MEMN: n_rms(c.in[1], c.in[5], MEMN, NB * NMEM); break;
    case OP_MEMKV: n_gemm(sm, MEMN, D, nullptr, c.in[21] + (size_t)l * D * 2048, 2048, 0, nullptr, NB * NMEM, 2048, D, EpiStore{KV, 2048, nullptr}); break;
    case OP_COPYX: n_copy4(c.in[0], X, (size_t)T * D / 4); break;
    case OP_RMS_MIX: n_rms(X, c.in[2] + l * D, HN, T); break;
    case OP_CONV_IN: n_gemm(sm, HN, D, nullptr, c.in[7], 2048, 0, nullptr, T, 2048, D, EpiStore{BIG, 2048, c.in[8]}); break;
    case OP_GLU: n_glu(BIG, HN); break;
    case OP_DWCONV: n_dwconv(HN, c.in[9], c.in[10], c.in[11], c.in[12], BIG); break;
    case OP_CONV_OUT: n_gemm(sm, BIG, D, nullptr, c.in[13], D, 0, nullptr, T, D, D, EpiResid{X, D, c.in[14]}); break;
    case OP_GLA_IN: n_gemm(sm, HN, D, nullptr, c.in[15], GLA_COLS, 0, nullptr, T, GLA_COLS, D, EpiStore{BIG, GLA_COLS, nullptr}); break;
    case OP_GLA_DECAY: n_gla_decay(BIG, c.in[16], c.in[17], HN); break;
    case OP_GLA_REC: n_gla_rec(BIG, HN); break;
    case OP_GLA_NORM: n_gla_norm(BIG, c.in[18], HN); break;
    case OP_GLA_OUT: n_gemm(sm, HN, D, nullptr, c.in[19], D, 0, nullptr, T, D, D, EpiResid{X, D, nullptr}); break;
    case OP_RMS_XA: n_rms(X, c.in[3] + l * D, HN, T); break;
    case OP_XA_Q: n_gemm(sm, HN, D, nullptr, c.in[20] + (size_t)l * D * D, D, 0, nullptr, T, D, D, EpiStore{BIG, D, nullptr}); break;
    case OP_XA_ATT: n_attn(BIG, KV, BIG + (size_t)T * D); break;
    case OP_XA_O: n_gemm(sm, BIG + (size_t)T * D, D, nullptr, c.in[22] + (size_t)l * D * D, D, 0, nullptr, T, D, D, EpiResid{X, D, nullptr}); break;
    case OP_RMS_FFN: n_rms(X, c.in[4] + l * D, HN, T); n_moe_init(cnt, slot_tok, slot_a, tile_e); break;
    case OP_ROUTE: n_route(HN, c.in[23] + (size_t)l * D * NG, c.in[24] + l * NG, c.in[25] + (size_t)l * D * NE, c.in[26] + l * NE, eid, gate, pos, cnt); break;
    case OP_BUILD: n_moe_build(eid, pos, cnt, slot_tok, slot_a, tile_e); break;
    case OP_MOE_GATE: n_gemm(sm, HN, D, slot_tok, c.in[27] + (size_t)l * NE * D * DE, DE, (size_t)D * DE, tile_e, NSLOT, DE, D, EpiStore{BIG, DE, nullptr}); break;
    case OP_MOE_UP: n_gemm(sm, HN, D, slot_tok, c.in[28] + (size_t)l * NE * D * DE, DE, (size_t)D * DE, tile_e, NSLOT, DE, D, EpiStore{BIG + (size_t)NSLOT * DE, DE, nullptr}); break;
    case OP_MOE_ACT: n_moe_act(BIG, BIG + (size_t)NSLOT * DE); break;
    case OP_MOE_DOWN: n_gemm(sm, BIG, DE, nullptr, c.in[29] + (size_t)l * NE * DE * D, D, (size_t)DE * D, tile_e, NSLOT, D, DE, EpiMoeDown{BIG + (size_t)NSLOT * DE, slot_a, gate}); break;
    case OP_MOE_COMBINE: n_moe_combine(X, BIG + (size_t)NSLOT * DE); break;
    case OP_FINAL: n_rms(X, c.in[6], X, T); break;
    }
}

template <int OP> __global__ void __launch_bounds__(512) k_stage(Ctx c, int l) {
    __shared__ float sm[16 * 132 + 16 * 260];
    run_op(c, OP, l, sm);
}
typedef void (*StageFn)(Ctx, int);
template <int... I> struct Seq {};
template <int N, int... I> struct MkSeq : MkSeq<N - 1, N - 1, I...> {};
template <int... I> struct MkSeq<0, I...> { typedef Seq<I...> type; };
template <int... I> static void fill_tab(StageFn* t, Seq<I...>) { StageFn f[] = {k_stage<I>...}; for (unsigned i = 0; i < sizeof...(I); ++i) t[i] = f[i]; }
template <int... I> static void fill_tab_opt(StageFn* t, Seq<I...>) { StageFn f[] = {k_opt<I>...}; for (unsigned i = 0; i < sizeof...(I); ++i) t[i] = f[i]; }

#define XB_TMO      128
#define XB_XCNT(j)  (256  + 64 * (j))
#define XB_XSUB(j)  (1280 + 64 * (j))
#define XB_XGEN(j)  (2304 + 64 * (j))
#define XB_TOP      3328
#define XB_TOPGEN   3392
#define XCD_BAR_WORDS 3456
#define XB_SPIN_CAP (1u << 18)
__device__ __forceinline__ unsigned xb_ld(unsigned* p)              { return __hip_atomic_load(p, __ATOMIC_RELAXED, __HIP_MEMORY_SCOPE_AGENT); }
__device__ __forceinline__ unsigned xb_add(unsigned* p, unsigned v) { return __hip_atomic_fetch_add(p, v, __ATOMIC_RELAXED, __HIP_MEMORY_SCOPE_AGENT); }
__device__ __forceinline__ unsigned xb_xcc_id() { return (unsigned)__builtin_amdgcn_s_getreg((3 << 11) | 20) & 0xFu; }
#define XB_SPIN(cond, bar) do { unsigned _sp = 0; while (cond) { __builtin_amdgcn_s_sleep(1); \
    if ((++_sp & 255u) == 0u) { if (xb_ld(&(bar)[XB_TMO])) break; if (_sp > XB_SPIN_CAP) { atomicAdd(&(bar)[XB_TMO], 1u); break; } } } } while (0)
struct XcdBarrier { unsigned* bar; unsigned x; volatile LAS unsigned* st; };
__device__ __forceinline__ XcdBarrier xcd_barrier_post(unsigned* bar, volatile LAS unsigned* st) {
    XcdBarrier b; b.bar = bar; b.x = xb_xcc_id(); b.st = st;
    if (threadIdx.x == 0) (void)xb_add(&bar[XB_XCNT(b.x)], 1u);
    return b;
}
__device__ __forceinline__ void xcd_barrier_complete(unsigned* bar, unsigned x, unsigned& nloc, unsigned& nx) {
    const unsigned G = gridDim.x * gridDim.y * gridDim.z;
    unsigned sum, cnt, mine, sp = 0u;
    for (;;) {
        sum = 0u; cnt = 0u; mine = 0u;
#pragma unroll
        for (unsigned j = 0; j < 16; ++j) { const unsigned c = xb_ld(&bar[XB_XCNT(j)]); sum += c; cnt += (c > 0u) ? 1u : 0u; mine = (j == x) ? c : mine; }
        if (sum == G) break;
        __builtin_amdgcn_s_sleep(1);
        if ((++sp & 255u) == 0u) { if (xb_ld(&bar[XB_TMO])) break; if (sp > XB_SPIN_CAP) { atomicAdd(&bar[XB_TMO], 1u); break; } }
    }
    nloc = mine > 0u ? mine : 1u; nx = cnt > 0u ? cnt : 1u;
}
__device__ __forceinline__ void xcd_barrier(const XcdBarrier& b) {
    asm volatile("s_waitcnt vmcnt(0)" ::: "memory");
    __syncthreads();
    if (threadIdx.x == 0) {
        unsigned* bar = b.bar;
        __builtin_amdgcn_s_waitcnt(0);
        unsigned nloc = b.st[0], nx = b.st[1];
        if (nloc == 0u) { xcd_barrier_complete(bar, b.x, nloc, nx); b.st[0] = nloc; b.st[1] = nx; }
        const unsigned old = xb_add(&bar[XB_XSUB(b.x)], 1u);
        const unsigned gen = old / nloc;
        if (old + 1u == (gen + 1u) * nloc) {
            __builtin_amdgcn_fence(__ATOMIC_RELEASE, "agent");
            asm volatile("s_waitcnt vmcnt(0)" ::: "memory");
            const unsigned og = xb_add(&bar[XB_TOP], 1u);
            const unsigned tg = og / nx;
            if (og + 1u == (tg + 1u) * nx) xb_add(&bar[XB_TOPGEN], 1u);
            else XB_SPIN(xb_ld(&bar[XB_TOPGEN]) == tg, bar);
            __builtin_amdgcn_fence(__ATOMIC_ACQUIRE, "agent");
            xb_add(&bar[XB_XGEN(b.x)], 1u);
            asm volatile("s_waitcnt vmcnt(0)" ::: "memory");
        } else {
            XB_SPIN(xb_ld(&bar[XB_XGEN(b.x)]) == gen, bar);
            __builtin_amdgcn_fence(__ATOMIC_ACQUIRE, "agent");
            asm volatile("s_waitcnt vmcnt(0)" ::: "memory");
        }
    }
    __syncthreads();
}
template <int CODE> __device__ __forceinline__ void coop_step(const Ctx& c, LAS unsigned char* lds, cg::grid_group& grid, XcdBarrier& xb, bool sync_after, bool first) {
    run_phase(c, CODE >> 1, CODE & 1, lds);
    if (sync_after) {
        if (first) {
            unsigned* bar = (unsigned*)(c.ws + OW_BAR);
            if (blockIdx.x == 0) for (int i = threadIdx.x; i < XCD_BAR_WORDS; i += 512) bar[i] = 0u;
            asm volatile("s_waitcnt vmcnt(0) lgkmcnt(0)" ::: "memory");
            grid.sync();
            if (threadIdx.x < 64) { __builtin_amdgcn_fence(__ATOMIC_ACQUIRE, "agent"); asm volatile("s_waitcnt vmcnt(0)" ::: "memory"); }
            __syncthreads();
            xb = xcd_barrier_post(bar, xb.st);
        } else xcd_barrier(xb);
    }
}
template <int... CODES> __global__ void __launch_bounds__(512, 2) k_coop(Ctx c) {
    extern __shared__ __attribute__((aligned(16))) unsigned char dynlds[];
    cg::grid_group grid = cg::this_grid();
    LAS unsigned char* lds = (LAS unsigned char*)dynlds;
    volatile LAS unsigned* st = (volatile LAS unsigned*)(lds + LDS_BYTES - 16);
    if (threadIdx.x < 4) st[threadIdx.x] = 0u;
    __syncthreads();
    XcdBarrier xb; xb.bar = nullptr; xb.x = 0; xb.st = st;
    int idx = 0; constexpr int N = sizeof...(CODES);
    ((coop_step<CODES>(c, lds, grid, xb, idx + 1 < N, idx == 0), ++idx), ...);
}
#define CODE(ph, l) ((ph) * 2 + (l))
typedef void (*CoopFn)(Ctx);
struct Step { int kind, op, l; };
static const Step g_prog[] = { {1, 0, 0} };
constexpr int NSTEP = sizeof(g_prog) / sizeof(g_prog[0]);

extern "C" void kernel_launch(void* const* d_in, const int* in_sizes, int n_in, void* d_out, int out_size, void* d_ws, size_t ws_size, hipStream_t stream) {
    if (n_in != 30 || out_size != T * D || ws_size < OW_END || ws_size < WS_END) { fprintf(stderr, "kernel_launch: bad args n_in %d out %d ws %zu\n", n_in, out_size, ws_size); return; }
    Ctx c; memset(&c, 0, sizeof(c));
    for (int i = 0; i < 30; ++i) c.in[i] = (const float*)d_in[i];
    c.out = (float*)d_out; c.ws = (unsigned char*)d_ws;
    static StageFn tab[OP_FINAL + 1], tabo[PH_N];
    static bool init = false;
    if (!init) { fill_tab(tab, MkSeq<OP_FINAL + 1>::type()); fill_tab_opt(tabo, MkSeq<PH_N>::type());
        for (int i = 0; i < PH_N; ++i) hipFuncSetAttribute((const void*)tabo[i], hipFuncAttributeMaxDynamicSharedMemorySize, LDS_BYTES);
        init = true; }
#if COOP
    static int coop_grid = 0;
    static CoopFn coop_fns[2] = { k_coop<CODE(PH_PREP0, 0), CODE(PH_CONV_IN, 0), CODE(PH_CONV_MID, 0), CODE(PH_CONV_OUT, 0), CODE(PH_XA_PREP, 0), CODE(PH_XA_Q, 0), CODE(PH_XA_KV, 0), CODE(PH_XA_S, 0), CODE(PH_XA_PV, 0), CODE(PH_XA_O, 0),
                                         CODE(PH_ROUTE_PREP, 0), CODE(PH_ROUTE, 0), CODE(PH_BUILD, 0), CODE(PH_MOE1, 0), CODE(PH_MOE2, 0), CODE(PH_GLA_PREP, 0), CODE(PH_COMBINE, 0),
                                         CODE(PH_GLA_DECAY, 0), CODE(PH_GLA_IN, 0), CODE(PH_GLA_ATT, 0), CODE(PH_GLA_UT, 0), CODE(PH_GLA_SCAN, 0), CODE(PH_GLA_O, 0), CODE(PH_GLA_FIN, 0), CODE(PH_GLA_OUT, 0),
                                         CODE(PH_XA_PREP, 1), CODE(PH_XA_Q, 1), CODE(PH_XA_KV, 1), CODE(PH_XA_S, 1), CODE(PH_XA_PV, 1), CODE(PH_XA_O, 1),
                                         CODE(PH_ROUTE_PREP, 1), CODE(PH_ROUTE, 1), CODE(PH_BUILD, 1), CODE(PH_MOE1, 1), CODE(PH_MOE2, 1), CODE(PH_COMBINE_FIN, 1)>, nullptr };
    if (!coop_grid) { int dev = 0, cus = 0, per_cu = 0; hipGetDevice(&dev); hipDeviceGetAttribute(&cus, hipDeviceAttributeMultiprocessorCount, dev);
        for (int k = 0; k < 1; ++k) hipFuncSetAttribute((const void*)coop_fns[k], hipFuncAttributeMaxDynamicSharedMemorySize, LDS_BYTES);
        hipOccupancyMaxActiveBlocksPerMultiprocessor(&per_cu, coop_fns[0], 512, LDS_BYTES);
        coop_grid = cus * (per_cu < 1 ? 1 : per_cu); if (coop_grid > 256) coop_grid = 256;
        fprintf(stderr, "kernel_launch: cus %d per_cu %d grid %d\n", cus, per_cu, coop_grid); }
    int ncoop = 0;
#endif
    for (int i = 0; i < NSTEP; ++i) {
        if (g_prog[i].kind == 0) { hipLaunchKernelGGL(tab[g_prog[i].op], dim3(1024), dim3(512), 0, stream, c, g_prog[i].l); continue; }
#if COOP
        while (i < NSTEP && g_prog[i].kind == 1) ++i;
        --i;
        void* args[] = {&c};
        hipError_t e = hipLaunchCooperativeKernel((void*)coop_fns[ncoop++], dim3(coop_grid), dim3(512), args, LDS_BYTES, stream);
        if (e != hipSuccess) fprintf(stderr, "cooperative launch failed: %s\n", hipGetErrorString(e));
#else
        hipLaunchKernelGGL(tabo[g_prog[i].op], dim3(256), dim3(512), LDS_BYTES, stream, c, g_prog[i].l);
#endif
    }
}
```

```cpp
#include <hip/hip_runtime.h>
#include <hip/hip_cooperative_groups.h>
#include <cstdio>
#include <cstring>
namespace cg = cooperative_groups;

#ifndef MEGA
#define MEGA 0
#endif

constexpr int D = 1024, NB = 4, S = 8192, T = NB * S, NMEM = 256, DEPTH = 2;
constexpr int CONVK = 31;
constexpr int GH = 4, GDK = 512, GDV = 1024, GDKH = 128, GDVH = 256, GRANK = 16, GLA_COLS = 3088;
constexpr int XH = 4, XHD = 256;
constexpr int NG = 4, EPG = 8, NE = 32, DE = 512;
constexpr int NA = T * 2;
constexpr int NSLOT = NA + NE * 128;
constexpr float EPS = 1e-6f;

constexpr size_t MiB = 1u << 20;
constexpr size_t WS_HN = 0;
constexpr size_t WS_BIG = 128 * MiB;
constexpr size_t WS_SMALL = 528 * MiB;
constexpr size_t WS_MEMN = WS_SMALL;
constexpr size_t WS_KV = WS_MEMN + 4 * MiB;
constexpr size_t WS_EID = WS_KV + 16 * MiB;
constexpr size_t WS_GATE = WS_EID + NA * 4;
constexpr size_t WS_POS = WS_GATE + NA * 4;
constexpr size_t WS_SLOTTOK = WS_POS + NA * 4;
constexpr size_t WS_SLOTA = WS_SLOTTOK + NSLOT * 4;
constexpr size_t WS_TILEE = WS_SLOTA + NSLOT * 4;
constexpr size_t WS_CNT = WS_TILEE + 4096;
constexpr size_t WS_END = WS_CNT + 4096;

struct Ctx {
    const float* in[30];
    float* out;
    unsigned char* ws;
};

__device__ __forceinline__ float wave_sum(float v) {
#pragma unroll
    for (int o = 1; o < 64; o <<= 1) v += __shfl_xor(v, o);
    return v;
}
__device__ __forceinline__ float wave_max(float v) {
#pragma unroll
    for (int o = 1; o < 64; o <<= 1) v = fmaxf(v, __shfl_xor(v, o));
    return v;
}
__device__ __forceinline__ float sigmoidf_(float x) { return 1.0f / (1.0f + expf(-x)); }
__device__ __forceinline__ float siluf_(float x) { return x / (1.0f + expf(-x)); }

__device__ void n_rms(const float* x, const float* g, float* out, int rows) {
    const int lane = threadIdx.x & 63;
    const int gw = (blockIdx.x * blockDim.x + threadIdx.x) >> 6, ngw = (gridDim.x * blockDim.x) >> 6;
    for (int r = gw; r < rows; r += ngw) {
        const float4* xr = (const float4*)(x + (size_t)r * D);
        float4 v[4]; float s = 0.f;
#pragma unroll
        for (int j = 0; j < 4; ++j) { v[j] = xr[lane + 64 * j]; s += v[j].x * v[j].x + v[j].y * v[j].y + v[j].z * v[j].z + v[j].w * v[j].w; }
        s = wave_sum(s);
        const float rs = rsqrtf(s * (1.0f / D) + EPS);
        float4* o = (float4*)(out + (size_t)r * D);
#pragma unroll
        for (int j = 0; j < 4; ++j) { const float4 gg = ((const float4*)g)[lane + 64 * j];
            o[lane + 64 * j] = make_float4(v[j].x * rs * gg.x, v[j].y * rs * gg.y, v[j].z * rs * gg.z, v[j].w * rs * gg.w); }
    }
}
__device__ void n_copy4(const float* src, float* dst, size_t n4) {
    const size_t g = (size_t)blockIdx.x * blockDim.x + threadIdx.x, gs = (size_t)gridDim.x * blockDim.x;
    for (size_t i = g; i < n4; i += gs) ((float4*)dst)[i] = ((const float4*)src)[i];
}

struct EpiStore { float* C; int ldc; const float* bias;
    __device__ __forceinline__ void operator()(int m, int n, float acc) const { C[(size_t)m * ldc + n] = acc + (bias ? bias[n] : 0.f); } };
struct EpiResid { float* X; int ldc; const float* bias;
    __device__ __forceinline__ void operator()(int m, int n, float acc) const { X[(size_t)m * ldc + n] += acc + (bias ? bias[n] : 0.f); } };
struct EpiMoeDown { float* Y; const int* slot_a; const float* gate;
    __device__ __forceinline__ void operator()(int m, int n, float acc) const { const int a = slot_a[m]; if (a >= 0) Y[(size_t)a * D + n] = acc * gate[a]; } };

template <class Epi>
__device__ void n_gemm(float* sm, const float* A, int lda, const int* arow, const float* W, int ldw, size_t wstride, const int* tile_e,
                       int M, int N, int K, Epi epi) {
    float* As = sm;
    float* Bs = sm + 16 * 132;
    const int tid = threadIdx.x, ty = tid >> 5, tx = tid & 31;
    const int ntm = M / 128, ntn = (N + 255) / 256;
    for (int tile = blockIdx.x; tile < ntm * ntn; tile += gridDim.x) {
        const int mt = tile / ntn, nt = tile % ntn;
        const float* Wb = W;
        if (tile_e) { const int e = tile_e[mt]; if (e < 0) continue; Wb = W + (size_t)e * wstride; }
        const int m0 = mt * 128, n0 = nt * 256;
        float acc[8][8];
#pragma unroll
        for (int i = 0; i < 8; ++i)
#pragma unroll
            for (int j = 0; j < 8; ++j) acc[i][j] = 0.f;
        const int ar = tid >> 2, akq = (tid & 3) * 4;
        const int srow = arow ? arow[m0 + ar] : (m0 + ar);
        const float* ap = srow >= 0 ? A + (size_t)srow * lda : nullptr;
        const int bk = tid >> 6, bn = (tid & 63) * 4;
        for (int k0 = 0; k0 < K; k0 += 16) {
            float4 av = ap ? *(const float4*)(ap + k0 + akq) : make_float4(0.f, 0.f, 0.f, 0.f);
            As[(akq + 0) * 132 + ar] = av.x; As[(akq + 1) * 132 + ar] = av.y; As[(akq + 2) * 132 + ar] = av.z; As[(akq + 3) * 132 + ar] = av.w;
#pragma unroll
            for (int i = 0; i < 2; ++i) {
                const int kk = bk + 8 * i; const int n = n0 + bn;
                float4 bv = (n < N) ? *(const float4*)(Wb + (size_t)(k0 + kk) * ldw + n) : make_float4(0.f, 0.f, 0.f, 0.f);
                *(float4*)(Bs + kk * 260 + bn) = bv;
            }
            __syncthreads();
#pragma unroll
            for (int kk = 0; kk < 16; ++kk) {
                float a[8], b[8];
                *(float4*)(a) = *(const float4*)(As + kk * 132 + ty * 8); *(float4*)(a + 4) = *(const float4*)(As + kk * 132 + ty * 8 + 4);
                *(float4*)(b) = *(const float4*)(Bs + kk * 260 + tx * 8); *(float4*)(b + 4) = *(const float4*)(Bs + kk * 260 + tx * 8 + 4);
#pragma unroll
                for (int i = 0; i < 8; ++i)
#pragma unroll
                    for (int j = 0; j < 8; ++j) acc[i][j] = fmaf(a[i], b[j], acc[i][j]);
            }
            __syncthreads();
        }
#pragma unroll
        for (int i = 0; i < 8; ++i)
#pragma unroll
            for (int j = 0; j < 8; ++j) { const int m = m0 + ty * 8 + i, n = n0 + tx * 8 + j; if (n < N) epi(m, n, acc[i][j]); }
    }
}

__device__ void n_glu(const float* u, float* g) {
    const size_t gi = (size_t)blockIdx.x * blockDim.x + threadIdx.x, gs = (size_t)gridDim.x * blockDim.x;
    for (size_t i = gi; i < (size_t)T * D; i += gs) { const size_t t = i >> 10, c = i & 1023; g[i] = u[t * 2048 + c] * sigmoidf_(u[t * 2048 + 1024 + c]); }
}
__device__ void n_dwconv(const float* g, const float* wdw, const float* bdw, const float* lng, const float* lnb, float* out) {
    const int lane = threadIdx.x & 63;
    const int gw = (blockIdx.x * blockDim.x + threadIdx.x) >> 6, ngw = (gridDim.x * blockDim.x) >> 6;
    for (int t = gw; t < T; t += ngw) {
        const int s = t % S;
        float4 acc[4];
#pragma unroll
        for (int j = 0; j < 4; ++j) acc[j] = ((const float4*)bdw)[lane + 64 * j];
        for (int tap = 0; tap < CONVK; ++tap) {
            const int ss = s - (CONVK - 1) + tap; if (ss < 0) continue;
            const float4* gr = (const float4*)(g + (size_t)(t - (CONVK - 1) + tap) * D);
            const float4* wr = (const float4*)(wdw + (size_t)tap * D);
#pragma unroll
            for (int j = 0; j < 4; ++j) { const float4 a = gr[lane + 64 * j], w = wr[lane + 64 * j];
                acc[j].x = fmaf(a.x, w.x, acc[j].x); acc[j].y = fmaf(a.y, w.y, acc[j].y); acc[j].z = fmaf(a.z, w.z, acc[j].z); acc[j].w = fmaf(a.w, w.w, acc[j].w); }
        }
        float sm_ = 0.f;
#pragma unroll
        for (int j = 0; j < 4; ++j) sm_ += acc[j].x + acc[j].y + acc[j].z + acc[j].w;
        const float mu = wave_sum(sm_) * (1.0f / D);
        float q = 0.f;
#pragma unroll
        for (int j = 0; j < 4; ++j) { acc[j].x -= mu; acc[j].y -= mu; acc[j].z -= mu; acc[j].w -= mu; q += acc[j].x * acc[j].x + acc[j].y * acc[j].y + acc[j].z * acc[j].z + acc[j].w * acc[j].w; }
        const float rstd = rsqrtf(wave_sum(q) * (1.0f / D) + EPS);
        float4* o = (float4*)(out + (size_t)t * D);
#pragma unroll
        for (int j = 0; j < 4; ++j) { const float4 gg = ((const float4*)lng)[lane + 64 * j], bb = ((const float4*)lnb)[lane + 64 * j];
            o[lane + 64 * j] = make_float4(siluf_(acc[j].x * rstd * gg.x + bb.x), siluf_(acc[j].y * rstd * gg.y + bb.y), siluf_(acc[j].z * rstd * gg.z + bb.z), siluf_(acc[j].w * rstd * gg.w + bb.w)); }
    }
}
__device__ void n_attn(const float* q, const float* kv, float* o) {
    const int lane = threadIdx.x & 63;
    const int gw = (blockIdx.x * blockDim.x + threadIdx.x) >> 6, ngw = (gridDim.x * blockDim.x) >> 6;
    for (int it = gw; it < T * XH; it += ngw) {
        const int t = it >> 2, h = it & 3, b = t / S;
        const float4 qv = ((const float4*)(q + (size_t)t * D + h * XHD))[lane];
        const float* kb = kv + (size_t)b * NMEM * 2048 + h * XHD;
        float sc[4];
#pragma unroll
        for (int m4 = 0; m4 < 4; ++m4) {
            float mine = 0.f;
            for (int ml = 0; ml < 64; ++ml) {
                const float4 kk = ((const float4*)(kb + (size_t)(m4 * 64 + ml) * 2048))[lane];
                float p = qv.x * kk.x + qv.y * kk.y + qv.z * kk.z + qv.w * kk.w;
                p = wave_sum(p);
                if (ml == lane) mine = p;
            }
            sc[m4] = mine * 0.0625f;
        }
        float mx = fmaxf(fmaxf(sc[0], sc[1]), fmaxf(sc[2], sc[3])); mx = wave_max(mx);
        float se = 0.f;
#pragma unroll
        for (int m4 = 0; m4 < 4; ++m4) { sc[m4] = expf(sc[m4] - mx); se += sc[m4]; }
        se = wave_sum(se); const float inv = 1.0f / se;
        float4 acc = make_float4(0.f, 0.f, 0.f, 0.f);
        const float* vb = kb + 1024;
#pragma unroll
        for (int m4 = 0; m4 < 4; ++m4)
            for (int ml = 0; ml < 64; ++ml) {
                const float p = __shfl(sc[m4], ml) * inv;
                const float4 vv = ((const float4*)(vb + (size_t)(m4 * 64 + ml) * 2048))[lane];
                acc.x = fmaf(p, vv.x, acc.x); acc.y = fmaf(p, vv.y, acc.y); acc.z = fmaf(p, vv.z, acc.z); acc.w = fmaf(p, vv.w, acc.w);
            }
        ((float4*)(o + (size_t)t * D + h * XHD))[lane] = acc;
    }
}
__device__ void n_moe_init(int* cnt, int* slot_tok, int* slot_a, int* tile_e) {
    const int gi = blockIdx.x * blockDim.x + threadIdx.x, gs = gridDim.x * blockDim.x;
    for (int i = gi; i < NSLOT; i += gs) { slot_tok[i] = -1; slot_a[i] = -1; }
    for (int i = gi; i < NSLOT / 128; i += gs) tile_e[i] = -1;
    if (gi < 32) cnt[gi] = 0;
}
__device__ void n_route(const float* h, const float* wg, const float* bg, const float* we, const float* be, int* eid, float* gate, int* pos, int* cnt) {
    const int lane = threadIdx.x & 63;
    const int gw = (blockIdx.x * blockDim.x + threadIdx.x) >> 6, ngw = (gridDim.x * blockDim.x) >> 6;
    for (int t = gw; t < T; t += ngw) {
        float hv[16];
#pragma unroll
        for (int j = 0; j < 16; ++j) hv[j] = h[(size_t)t * D + j * 64 + lane];
        float gl[4];
#pragma unroll
        for (int o = 0; o < 4; ++o) { float p = 0.f;
#pragma unroll
            for (int j = 0; j < 16; ++j) p = fmaf(hv[j], wg[(size_t)(j * 64 + lane) * NG + o], p);
            gl[o] = wave_sum(p) + bg[o]; }
        int gs = 0; float gm = gl[0];
#pragma unroll
        for (int o = 1; o < 4; ++o) if (gl[o] > gm) { gm = gl[o]; gs = o; }
        float se = 0.f;
#pragma unroll
        for (int o = 0; o < 4; ++o) se += expf(gl[o] - gm);
        const float pg = 1.0f / se;
        float el[8];
#pragma unroll
        for (int o = 0; o < 8; ++o) { float p = 0.f;
#pragma unroll
            for (int j = 0; j < 16; ++j) p = fmaf(hv[j], we[(size_t)(j * 64 + lane) * NE + gs * 8 + o], p);
            el[o] = wave_sum(p) + be[gs * 8 + o]; }
        float em = el[0];
#pragma unroll
        for (int o = 1; o < 8; ++o) em = fmaxf(em, el[o]);
        float pe[8], ps = 0.f;
#pragma unroll
        for (int o = 0; o < 8; ++o) { pe[o] = expf(el[o] - em); ps += pe[o]; }
#pragma unroll
        for (int o = 0; o < 8; ++o) pe[o] = pe[o] / ps;
        int i1 = 0; float p1 = pe[0];
#pragma unroll
        for (int o = 1; o < 8; ++o) if (pe[o] > p1) { p1 = pe[o]; i1 = o; }
        int i2 = -1; float p2 = -1.f;
#pragma unroll
        for (int o = 0; o < 8; ++o) if (o != i1 && pe[o] > p2) { p2 = pe[o]; i2 = o; }
        if (lane == 0) {
            const float den = p1 + p2;
            const int e1 = gs * 8 + i1, e2 = gs * 8 + i2;
            eid[2 * t] = e1; eid[2 * t + 1] = e2;
            gate[2 * t] = pg * p1 / den; gate[2 * t + 1] = pg * p2 / den;
            pos[2 * t] = atomicAdd(&cnt[e1], 1); pos[2 * t + 1] = atomicAdd(&cnt[e2], 1);
        }
    }
}
__device__ void n_moe_build(const int* eid, const int* pos, const int* cnt, int* slot_tok, int* slot_a, int* tile_e) {
    __shared__ int poff[33];
    if (threadIdx.x == 0) { int o = 0; for (int e = 0; e < 32; ++e) { poff[e] = o; o += (cnt[e] + 127) / 128 * 128; } poff[32] = o; }
    __syncthreads();
    const int gi = blockIdx.x * blockDim.x + threadIdx.x, gs = gridDim.x * blockDim.x;
    for (int a = gi; a < NA; a += gs) { const int e = eid[a]; const int sl = poff[e] + pos[a]; slot_tok[sl] = a >> 1; slot_a[sl] = a; }
    for (int mt = gi; mt < NSLOT / 128; mt += gs) { const int r = mt * 128; int e = -1; for (int k = 0; k < 32; ++k) if (r >= poff[k] && r < poff[k + 1]) e = k; tile_e[mt] = e; }
    __syncthreads();
}
__device__ void n_moe_act(float* g, const float* u) {
    const size_t gi = (size_t)blockIdx.x * blockDim.x + threadIdx.x, gs = (size_t)gridDim.x * blockDim.x;
    for (size_t i = gi; i < (size_t)NSLOT * DE / 4; i += gs) { float4 a = ((float4*)g)[i]; const float4 b = ((const float4*)u)[i];
        a.x = siluf_(a.x) * b.x; a.y = siluf_(a.y) * b.y; a.z = siluf_(a.z) * b.z; a.w = siluf_(a.w) * b.w; ((float4*)g)[i] = a; }
}
__device__ void n_moe_combine(float* x, const float* y) {
    const size_t gi = (size_t)blockIdx.x * blockDim.x + threadIdx.x, gs = (size_t)gridDim.x * blockDim.x;
    for (size_t i = gi; i < (size_t)T * D / 4; i += gs) { const size_t t = i >> 8, c = i & 255; float4 a = ((float4*)x)[i];
        const float4 y0 = ((const float4*)y)[(2 * t) * 256 + c], y1 = ((const float4*)y)[(2 * t + 1) * 256 + c];
        a.x += y0.x + y1.x; a.y += y0.y + y1.y; a.z += y0.z + y1.z; a.w += y0.w + y1.w; ((float4*)x)[i] = a; }
}
__device__ void n_gla_decay(const float* proj, const float* wa2, const float* ba, float* dec) {
    const size_t gi = (size_t)blockIdx.x * blockDim.x + threadIdx.x, gs = (size_t)gridDim.x * blockDim.x;
    for (size_t i = gi; i < (size_t)T * GDK; i += gs) { const size_t t = i >> 9; const int j = (int)(i & 511);
        float a = ba[j];
#pragma unroll
        for (int r = 0; r < GRANK; ++r) a = fmaf(proj[t * GLA_COLS + 2048 + r], wa2[r * GDK + j], a);
        const float ls = fminf(a, 0.f) - log1pf(expf(-fabsf(a)));
        dec[i] = expf(ls * (1.0f / 16.0f)); }
}
__device__ void n_gla_rec(float* proj, const float* dec) {
    const int gi = blockIdx.x * blockDim.x + threadIdx.x, gs = gridDim.x * blockDim.x;
    for (int it = gi; it < NB * GH * GDVH; it += gs) {
        const int col = it & 255, h = (it >> 8) & 3, b = it >> 10;
        float st[GDKH];
#pragma unroll
        for (int k = 0; k < GDKH; ++k) st[k] = 0.f;
        const float qs = 0.08838834764831845f;
        for (int s = 0; s < S; ++s) {
            const size_t t = (size_t)b * S + s;
            float* pr = proj + t * GLA_COLS;
            const float v = pr[1024 + h * GDVH + col];
            const float* qq = pr + h * GDKH; const float* kk = pr + 512 + h * GDKH; const float* dd = dec + t * GDK + h * GDKH;
            float o = 0.f;
#pragma unroll
            for (int k = 0; k < GDKH; ++k) { st[k] = fmaf(st[k], dd[k], kk[k] * v); o = fmaf(qq[k], st[k], o); }
            pr[1024 + h * GDVH + col] = o * qs;
        }
    }
}
__device__ void n_gla_norm(const float* proj, const float* ng, float* go) {
    const int lane = threadIdx.x & 63;
    const int gw = (blockIdx.x * blockDim.x + threadIdx.x) >> 6, ngw = (gridDim.x * blockDim.x) >> 6;
    for (int it = gw; it < T * GH; it += ngw) {
        const int t = it >> 2, h = it & 3;
        const float4 ov = ((const float4*)(proj + (size_t)t * GLA_COLS + 1024 + h * GDVH))[lane];
        const float4 rv = ((const float4*)(proj + (size_t)t * GLA_COLS + 2064 + h * GDVH))[lane];
        const float4 gg = ((const float4*)ng)[lane];
        float s = ov.x * ov.x + ov.y * ov.y + ov.z * ov.z + ov.w * ov.w; s = wave_sum(s);
        const float rs = rsqrtf(s * (1.0f / GDVH) + EPS);
        ((float4*)(go + (size_t)t * D + h * GDVH))[lane] = make_float4(ov.x * rs * gg.x * siluf_(rv.x), ov.y * rs * gg.y * siluf_(rv.y), ov.z * rs * gg.z * siluf_(rv.z), ov.w * rs * gg.w * siluf_(rv.w));
    }
}

#define LAS __attribute__((address_space(3)))
typedef unsigned short bf16_t;
typedef short bf16x8 __attribute__((ext_vector_type(8)));
typedef float f32x4 __attribute__((ext_vector_type(4)));
typedef float f32x2 __attribute__((ext_vector_type(2)));
typedef unsigned u32x4 __attribute__((ext_vector_type(4)));
typedef unsigned u32x2 __attribute__((ext_vector_type(2)));

constexpr int LDS_BYTES = 160 * 1024;
constexpr int NSLOT2 = NA + NE * 256;
constexpr int MAXRT = NSLOT2 / 256;
constexpr size_t OW_XB = 0;
constexpr size_t OW_SSP = 64 * MiB;
constexpr size_t OW_RS = 66 * MiB;
constexpr size_t OW_PSUM = 67 * MiB;
constexpr size_t OW_MOE = 69 * MiB;
constexpr size_t OW_ACTA = 72 * MiB, OW_ACTB = 136 * MiB, OW_ACTC = 200 * MiB;
constexpr size_t OW_H = 72 * MiB, OW_Y = 144 * MiB, OW_WMOE = 272 * MiB;
constexpr size_t OW_KVB = 368 * MiB;
constexpr size_t OW_MEMNB = 372 * MiB;
constexpr size_t OW_WCIN = 550 * MiB, OW_WCOUT = 554 * MiB, OW_WXQ = 556 * MiB, OW_WXKV = 560 * MiB, OW_WXO = 568 * MiB, OW_WR = 572 * MiB, OW_BAR = 573 * MiB, OW_DBG = 574 * MiB, OW_END = 575 * MiB;
constexpr size_t OW_ATT = 0, OW_QKR = 72 * MiB, OW_KVT = 200 * MiB, OW_BTM = 296 * MiB, OW_O = 296 * MiB, OW_BFM = 360 * MiB, OW_UT = 424 * MiB, OW_SP = 456 * MiB,
                 OW_ALR = 488 * MiB, OW_DL = 490 * MiB, OW_GO = 200 * MiB, OW_WGTM = 492 * MiB, OW_WGFM = 496 * MiB, OW_WGO = 499 * MiB, OW_WA = 501 * MiB;
constexpr size_t OM_GCNT = OW_MOE, OM_NT = OW_MOE + 256, OM_TILEE = OW_MOE + 512, OM_AE = OW_MOE + 4096, OM_APOS = OM_AE + NA * 4, OM_GATE = OM_APOS + NA * 4,
                 OM_STOK = OM_GATE + NA * 4, OM_SA = OM_STOK + NSLOT2 * 4, OM_SRS = OM_SA + NSLOT2 * 4, OM_SGATE = OM_SRS + NSLOT2 * 4, OM_END = OM_SGATE + NSLOT2 * 4;
static_assert(OM_END <= OW_ACTA, "MoE small arrays");

typedef __bf16 bf16x2_t __attribute__((ext_vector_type(2)));
__device__ __forceinline__ unsigned cvt_pk_bf16(float lo, float hi) { const f32x2 v = {lo, hi}; return __builtin_bit_cast(unsigned, __builtin_convertvector(v, bf16x2_t)); }
__device__ __forceinline__ int otid() { int t = threadIdx.x; asm volatile("" : "+v"(t)); return t; }
__device__ __forceinline__ u32x4 pack8(const f32x4& a, const f32x4& b) { u32x4 w; w.x = cvt_pk_bf16(a[0], a[1]); w.y = cvt_pk_bf16(a[2], a[3]); w.z = cvt_pk_bf16(b[0], b[1]); w.w = cvt_pk_bf16(b[2], b[3]); return w; }
__device__ __forceinline__ float bf_lo(unsigned w) { return __uint_as_float(w << 16); }
__device__ __forceinline__ float bf_hi(unsigned w) { return __uint_as_float(w & 0xffff0000u); }
__device__ __forceinline__ float fast_sigmoid(float x) { return __builtin_amdgcn_rcpf(1.0f + __builtin_amdgcn_exp2f(-1.4426950408889634f * x)); }

#ifndef LDS_POISON
#define LDS_POISON 0
#endif
namespace g8 {
constexpr int BM = 256, BK = 64, HALF = 128, HTB = HALF * BK * 2, STAGE_BYTES = 8 * HTB;
__device__ __forceinline__ int lds_byte(int r, int c) { const int st = (r >> 4) * 2 + (c >> 5), rr = r & 15, cc = c & 31, ob = rr * 64 + cc * 2; return st * 1024 + (ob ^ (((ob >> 9) & 1) << 5)); }
__device__ __forceinline__ void stage_rc(int b, int& R, int& C) { const int st = b / 1024, sb = b % 1024, swz = sb ^ (((sb >> 9) & 1) << 5); R = (st >> 1) * 16 + swz / 64; C = (st & 1) * 32 + (swz % 64) / 2; }
__device__ __forceinline__ int perm32(int rho) { const int n = rho >> 4, i = rho & 15; return 8 * (i >> 2) + 4 * n + (i & 3); }
struct Unit { int pm, pn, e; };

template <class Epi, class Sched>
__device__ __forceinline__ void gemm_phase(LAS unsigned char* lds, const Sched& S, const Epi& E) {
    int tid_ = threadIdx.x; asm volatile("" : "+v"(tid_));
    const int tid = tid_, wid = __builtin_amdgcn_readfirstlane(tid >> 6), lane = tid & 63, wr = wid >> 2, wc = wid & 3, fr = lane & 15, fq = lane >> 4;
    const size_t kstep = (size_t)(BK * 2);
    const unsigned ldsw = (unsigned)wid * 1024u;
    const int aoff = lds_byte(wr * 64 + fr, fq * 8), boff = lds_byte(wc * 32 + fr, fq * 8);
#define G8_SA(b, h) (((b) * 2 + (h)) * HTB)
#define G8_SB(b, h) ((4 + (b) * 2 + (h)) * HTB)
#define G8_STAGE(bufoff, gbase, vv) do { _Pragma("unroll") for (int _i = 0; _i < 2; ++_i) \
        __builtin_amdgcn_global_load_lds((const unsigned*)((const char*)(gbase) + (vv)[_i]), (LAS unsigned*)(lds + (bufoff) + ldsw + _i * 8192), 16, 0, 0); } while (0)
#define G8_LDA(dst, b, h) do { _Pragma("unroll") for (int m = 0; m < 4; ++m) _Pragma("unroll") for (int k = 0; k < 2; ++k) dst[m][k] = *(const LAS bf16x8*)(lds + G8_SA(b, h) + aoff + m * 2048 + k * 1024); } while (0)
#define G8_LDB(dst, b, h) do { _Pragma("unroll") for (int n = 0; n < 2; ++n) _Pragma("unroll") for (int k = 0; k < 2; ++k) dst[n][k] = *(const LAS bf16x8*)(lds + G8_SB(b, h) + boff + n * 2048 + k * 1024); } while (0)
#define G8_MMA(ai, bj, At, Bt) do { __builtin_amdgcn_s_setprio(1); _Pragma("unroll") for (int m = 0; m < 4; ++m) _Pragma("unroll") for (int n = 0; n < 2; ++n) _Pragma("unroll") for (int k = 0; k < 2; ++k) \
        acc[ai][bj][m][n] = __builtin_amdgcn_mfma_f32_16x16x32_bf16(Bt[n][k], At[m][k], acc[ai][bj][m][n], 0, 0, 0); __builtin_amdgcn_s_setprio(0); } while (0)
#define G8_WAIT_V(n) asm volatile("s_waitcnt vmcnt(" #n ")" ::: "memory")
#define G8_WAIT_L(n) asm volatile("s_waitcnt lgkmcnt(" #n ")" ::: "memory")
#define G8_BAR __builtin_amdgcn_s_barrier()
#define G8_SCHED __builtin_amdgcn_sched_barrier(0)
#define G8_VA(dst, u) do { const int _ac = S.a_col(u), _lda = S.lda(u); _Pragma("unroll") for (int _i = 0; _i < 2; ++_i) { int _R, _C; stage_rc(tid * 16 + _i * 8192, _R, _C); \
        _Pragma("unroll") for (int _h = 0; _h < 2; ++_h) dst[_h][_i] = (unsigned)(((size_t)S.a_row(u, _h * HALF + _R) * _lda + _ac + _C) * 2); } } while (0)
#define G8_VB(dst, hs, u) do { const int _ldb = S.ldb(u); hs = (size_t)HALF * _ldb * 2; _Pragma("unroll") for (int _i = 0; _i < 2; ++_i) { int _R, _C; stage_rc(tid * 16 + _i * 8192, _R, _C); \
        dst[_i] = (unsigned)(((_R & ~31) + perm32(_R & 31)) * _ldb + _C) * 2u; } } while (0)
    Unit cur, nxt; int ui = 0;
    if (!S.next(0, cur)) return;
#if LDS_POISON
    for (int i = tid; i < STAGE_BYTES / 16; i += 512) ((LAS u32x4*)lds)[i] = (u32x4){0x7fc07fc0u, 0x7fc07fc0u, 0x7fc07fc0u, 0x7fc07fc0u};
    __syncthreads();
#endif
    f32x4 acc[2][2][4][2];
#pragma unroll
    for (int a = 0; a < 2; ++a)
#pragma unroll
        for (int b = 0; b < 2; ++b)
#pragma unroll
            for (int m = 0; m < 4; ++m)
#pragma unroll
                for (int n = 0; n < 2; ++n) acc[a][b][m][n] = (f32x4){0.f, 0.f, 0.f, 0.f};
    bf16x8 At[4][2], B0[2][2], B1[2][2];
    unsigned va[2][2], nva[2][2], vb[2], nvb[2]; size_t hsB, nhsB;
    G8_VA(va, cur); G8_VB(vb, hsB, cur);
    const char* Ab = S.a_base(cur);
    const char* cB = S.b_base(cur);
    G8_STAGE(G8_SB(0, 0), cB, vb); G8_STAGE(G8_SA(0, 0), Ab, va[0]); G8_STAGE(G8_SB(0, 1), cB + hsB, vb); G8_STAGE(G8_SA(0, 1), Ab, va[1]);
    if (wr == 1) G8_BAR;
    G8_WAIT_V(4); G8_BAR;
    G8_STAGE(G8_SB(1, 0), cB + kstep, vb); G8_STAGE(G8_SA(1, 0), Ab + kstep, va[0]); G8_STAGE(G8_SB(1, 1), cB + hsB + kstep, vb);
    G8_WAIT_V(6); G8_BAR;
    for (;;) {
        const bool has_next = S.next(ui + 1, nxt);
        const char* nB = cB; const char* nAb = Ab;
        if (has_next) { nB = S.b_base(nxt); nAb = S.a_base(nxt); G8_VA(nva, nxt); G8_VB(nvb, nhsB, nxt); }
        else {
            nhsB = hsB;
#pragma unroll
            for (int i = 0; i < 2; ++i) { nvb[i] = vb[i];
#pragma unroll
                for (int h = 0; h < 2; ++h) nva[h][i] = va[h][i]; }
        }
        const int nt = S.nt(cur);
        for (int t = 0; t < nt; t += 2) {
            const bool last = (t == nt - 2);
            const char* a1 = Ab + (size_t)(t + 1) * kstep;
            const char* a2 = last ? nAb : Ab + (size_t)(t + 2) * kstep;
            const char* b2 = last ? nB : cB + (size_t)(t + 2) * kstep;
            const char* a3 = a2 + kstep; const char* b3 = b2 + kstep;
            const size_t hs2 = last ? nhsB : hsB;
            unsigned v2[2][2], vb2[2];
#pragma unroll
            for (int i = 0; i < 2; ++i) { vb2[i] = last ? nvb[i] : vb[i];
#pragma unroll
                for (int h = 0; h < 2; ++h) v2[h][i] = last ? nva[h][i] : va[h][i]; }
            G8_LDB(B0, 0, 0); G8_SCHED; G8_LDA(At, 0, 0); G8_STAGE(G8_SA(1, 1), a1, va[1]);
            G8_WAIT_L(8); G8_BAR; G8_WAIT_L(0); G8_MMA(0, 0, At, B0); G8_BAR; G8_SCHED;
            G8_LDB(B1, 0, 1); G8_STAGE(G8_SB(0, 0), b2, vb2);
            G8_BAR; G8_WAIT_L(0); G8_MMA(0, 1, At, B1); G8_BAR;
            G8_LDA(At, 0, 1); G8_STAGE(G8_SA(0, 0), a2, v2[0]);
            G8_BAR; G8_WAIT_L(0); G8_MMA(1, 0, At, B0); G8_BAR; G8_SCHED;
            G8_STAGE(G8_SB(0, 1), b2 + hs2, vb2);
            G8_WAIT_V(6); G8_BAR; G8_MMA(1, 1, At, B1); G8_BAR;
            G8_LDB(B0, 1, 0); G8_SCHED; G8_LDA(At, 1, 0); G8_STAGE(G8_SA(0, 1), a2, v2[1]);
            G8_WAIT_L(8); G8_BAR; G8_WAIT_L(0); G8_MMA(0, 0, At, B0); G8_BAR; G8_SCHED;
            G8_LDB(B1, 1, 1); G8_STAGE(G8_SB(1, 0), b3, vb2);
            G8_BAR; G8_WAIT_L(0); G8_MMA(0, 1, At, B1); G8_BAR;
            G8_LDA(At, 1, 1); G8_STAGE(G8_SA(1, 0), a3, v2[0]);
            G8_BAR; G8_WAIT_L(0); G8_MMA(1, 0, At, B0); G8_BAR; G8_SCHED;
            G8_STAGE(G8_SB(1, 1), b3 + hs2, vb2);
            G8_WAIT_V(6); G8_BAR; G8_MMA(1, 1, At, B1); G8_BAR;
        }
        const bool keep = S.cont(cur);
        if (!keep) E(acc, cur, wr, wc, fr, fq);
        if (!has_next) break;
        if (!keep) {
#pragma unroll
            for (int a = 0; a < 2; ++a)
#pragma unroll
                for (int b = 0; b < 2; ++b)
#pragma unroll
                    for (int m = 0; m < 4; ++m)
#pragma unroll
                        for (int n = 0; n < 2; ++n) acc[a][b][m][n] = (f32x4){0.f, 0.f, 0.f, 0.f};
        }
        cur = nxt; cB = nB; Ab = nAb; hsB = nhsB; ++ui;
#pragma unroll
        for (int i = 0; i < 2; ++i) { vb[i] = nvb[i];
#pragma unroll
            for (int h = 0; h < 2; ++h) va[h][i] = nva[h][i]; }
    }
    G8_WAIT_V(0);
    if (wr == 0) G8_BAR;
    G8_BAR;
#undef G8_SA
#undef G8_SB
#undef G8_STAGE
#undef G8_LDA
#undef G8_LDB
#undef G8_MMA
#undef G8_WAIT_V
#undef G8_WAIT_L
#undef G8_BAR
#undef G8_SCHED
#undef G8_VA
#undef G8_VB
}

struct DenseSched {
    __device__ __forceinline__ int lda(const Unit&) const { return lda_; }
    __device__ __forceinline__ int ldb(const Unit&) const { return ldb_; }
    __device__ __forceinline__ int nt(const Unit&) const { return K / BK; }
    __device__ __forceinline__ bool cont(const Unit&) const { return false; }
    int nN, nU, K, lda_, ldb_; const bf16_t* A; const bf16_t* Bt;
    __device__ __forceinline__ const char* a_base(const Unit&) const { return (const char*)A; }
    __device__ __forceinline__ bool next(int i, Unit& u) const {
        const int c = blockIdx.x, per = gridDim.x >> 3, x = c & 7, j = c >> 3;
        const int chunk = (nU + 7) >> 3, lu = i * per + j;
        if (lu >= chunk) return false;
        const int un = x * chunk + lu; if (un >= nU) return false;
        u.pm = un / nN; u.pn = un - u.pm * nN; u.e = 0; return true; }
    __device__ __forceinline__ int a_row(const Unit& u, int r) const { return u.pm * BM + r; }
    __device__ __forceinline__ int a_col(const Unit&) const { return 0; }
    __device__ __forceinline__ const char* b_base(const Unit& u) const { return (const char*)(Bt + (size_t)u.pn * BM * ldb_); }
};

struct EpiGlu {
    bf16_t* U; const float* rs; const float* bias;
    __device__ __forceinline__ void operator()(const f32x4 (&acc)[2][2][4][2], const Unit& u, int wr, int wc, int fr, int fq) const {
        const int c0 = u.pn * 128 + wc * 32 + 8 * fq;
        const f32x4 ba0 = *(const f32x4*)(bias + c0), ba1 = *(const f32x4*)(bias + c0 + 4), bg0 = *(const f32x4*)(bias + 1024 + c0), bg1 = *(const f32x4*)(bias + 1024 + c0 + 4);
#pragma unroll
        for (int ai = 0; ai < 2; ++ai)
#pragma unroll
            for (int m = 0; m < 4; ++m) {
                const int row = u.pm * BM + ai * HALF + wr * 64 + m * 16 + fr; const float r = rs[row];
                f32x4 o0, o1;
#pragma unroll
                for (int j = 0; j < 4; ++j) {
                    o0[j] = (acc[ai][0][m][0][j] * r + ba0[j]) * fast_sigmoid(acc[ai][1][m][0][j] * r + bg0[j]);
                    o1[j] = (acc[ai][0][m][1][j] * r + ba1[j]) * fast_sigmoid(acc[ai][1][m][1][j] * r + bg1[j]); }
                *(u32x4*)(U + (size_t)row * D + c0) = pack8(o0, o1);
            }
    }
};
struct EpiXres {
    const float* Xin; float* Xout; bf16_t* XB; const float* bias; float* ssp;
    __device__ __forceinline__ void operator()(const f32x4 (&acc)[2][2][4][2], const Unit& u, int wr, int wc, int fr, int fq) const {
#pragma unroll
        for (int ai = 0; ai < 2; ++ai)
#pragma unroll
            for (int m = 0; m < 4; ++m) {
                const int row = u.pm * BM + ai * HALF + wr * 64 + m * 16 + fr; float ss = 0.f;
#pragma unroll
                for (int bj = 0; bj < 2; ++bj) {
                    const int c0 = u.pn * BM + bj * HALF + wc * 32 + 8 * fq; const size_t off = (size_t)row * D + c0;
                    f32x4 v0 = *(const f32x4*)(Xin + off) + acc[ai][bj][m][0], v1 = *(const f32x4*)(Xin + off + 4) + acc[ai][bj][m][1];
                    if (bias) { v0 += *(const f32x4*)(bias + c0); v1 += *(const f32x4*)(bias + c0 + 4); }
                    *(f32x4*)(Xout + off) = v0; *(f32x4*)(Xout + off + 4) = v1;
                    *(u32x4*)(XB + off) = pack8(v0, v1);
                    ss += (v0[0] * v0[0] + v0[1] * v0[1]) + (v0[2] * v0[2] + v0[3] * v0[3]) + (v1[0] * v1[0] + v1[1] * v1[1]) + (v1[2] * v1[2] + v1[3] * v1[3]);
                }
                if (ssp) { ss += __shfl_xor(ss, 16); ss += __shfl_xor(ss, 32); if (fq == 0) ssp[(size_t)row * 16 + u.pn * 4 + wc] = ss; }
            }
    }
};

struct AttnSched {
    __device__ __forceinline__ int lda(const Unit&) const { return lda_; }
    __device__ __forceinline__ int ldb(const Unit&) const { return ldb_; }
    __device__ __forceinline__ int nt(const Unit&) const { return K / BK; }
    __device__ __forceinline__ bool cont(const Unit&) const { return false; }
    int K, lda_, ldb_; const bf16_t* A; const bf16_t* Bm; int pv;
    __device__ __forceinline__ bool next(int i, Unit& u) const {
        const int c = blockIdx.x, per = gridDim.x >> 3, x = c & 7, j = c >> 3;
        const int lu = i * per + j; if (lu >= 64) return false;
        const int un = x * 64 + lu, bh = un >> 5, qb = un & 31;
        u.pm = (bh >> 2) * 32 + qb; u.pn = 0; u.e = bh & 3; return true; }
    __device__ __forceinline__ const char* a_base(const Unit&) const { return (const char*)A; }
    __device__ __forceinline__ int a_row(const Unit& u, int r) const { return u.pm * BM + r; }
    __device__ __forceinline__ int a_col(const Unit& u) const { return u.e * 256; }
    __device__ __forceinline__ const char* b_base(const Unit& u) const { const int b = u.pm >> 5;
        return pv ? (const char*)(Bm + (size_t)(b * 4 + u.e) * 65536) : (const char*)(Bm + (size_t)(b * 256) * 1024 + u.e * 256); }
};
struct KVSched {
    __device__ __forceinline__ int lda(const Unit&) const { return lda_; }
    __device__ __forceinline__ int ldb(const Unit&) const { return ldb_; }
    __device__ __forceinline__ int nt(const Unit&) const { return K / BK; }
    __device__ __forceinline__ bool cont(const Unit&) const { return false; }
    int K, lda_, ldb_; const bf16_t* MEMNB; const bf16_t* WKV;
    __device__ __forceinline__ bool next(int i, Unit& u) const {
        const int un = i * (int)gridDim.x + (int)blockIdx.x; if (un >= 32) return false;
        u.e = un >> 4; u.pm = (un & 15) >> 2; u.pn = un & 3; return true; }
    __device__ __forceinline__ const char* a_base(const Unit& u) const { return u.e ? (const char*)(WKV + (size_t)1024 * 1024) : (const char*)MEMNB; }
    __device__ __forceinline__ int a_row(const Unit& u, int r) const { return u.pm * BM + r; }
    __device__ __forceinline__ int a_col(const Unit&) const { return 0; }
    __device__ __forceinline__ const char* b_base(const Unit& u) const { return u.e ? (const char*)(MEMNB + (size_t)u.pn * BM * 1024) : (const char*)(WKV + (size_t)u.pn * BM * 1024); }
};
__device__ __forceinline__ float ssp_rs(const float* ssp, int row) {
    const f32x4 a = *(const f32x4*)(ssp + (size_t)row * 16), b = *(const f32x4*)(ssp + (size_t)row * 16 + 4), c = *(const f32x4*)(ssp + (size_t)row * 16 + 8), d = *(const f32x4*)(ssp + (size_t)row * 16 + 12);
    const float s = ((a[0] + a[1]) + (a[2] + a[3])) + ((b[0] + b[1]) + (b[2] + b[3])) + ((c[0] + c[1]) + (c[2] + c[3])) + ((d[0] + d[1]) + (d[2] + d[3]));
    return rsqrtf(s * (1.0f / D) + EPS);
}
struct EpiRowScale {
    bf16_t* O; int ldo; const float* ssp; const float* rs; float scale; int qtiles; float qscale;
    __device__ __forceinline__ void operator()(const f32x4 (&acc)[2][2][4][2], const Unit& u, int wr, int wc, int fr, int fq) const {
        const float cs = scale * (u.pn < qtiles ? qscale : 1.0f);
#pragma unroll
        for (int ai = 0; ai < 2; ++ai)
#pragma unroll
            for (int m = 0; m < 4; ++m) {
                const int row = u.pm * BM + ai * HALF + wr * 64 + m * 16 + fr;
                const float r = (rs ? rs[row] : ssp_rs(ssp, row)) * cs;
#pragma unroll
                for (int bj = 0; bj < 2; ++bj) { const int c0 = u.pn * BM + bj * HALF + wc * 32 + 8 * fq;
                    *(u32x4*)(O + (size_t)row * ldo + c0) = pack8(acc[ai][bj][m][0] * r, acc[ai][bj][m][1] * r); }
            }
    }
};
struct EpiKV {
    bf16_t* Kb; bf16_t* VT;
    __device__ __forceinline__ void operator()(const f32x4 (&acc)[2][2][4][2], const Unit& u, int wr, int wc, int fr, int fq) const {
        bf16_t* base = u.e ? VT + (size_t)(u.pn * 4 + u.pm) * 65536 : Kb + (size_t)u.pm * BM * 1024 + u.pn * BM;
        const int ld = u.e ? 256 : 1024;
#pragma unroll
        for (int ai = 0; ai < 2; ++ai)
#pragma unroll
            for (int m = 0; m < 4; ++m) { const int r = ai * HALF + wr * 64 + m * 16 + fr;
#pragma unroll
                for (int bj = 0; bj < 2; ++bj) { const int c0 = bj * HALF + wc * 32 + 8 * fq;
                    *(u32x4*)(base + (size_t)r * ld + c0) = pack8(acc[ai][bj][m][0], acc[ai][bj][m][1]); } }
    }
};
struct EpiS {
    bf16_t* P; float* psum;
    __device__ __forceinline__ void operator()(const f32x4 (&acc)[2][2][4][2], const Unit& u, int wr, int wc, int fr, int fq) const {
#pragma unroll
        for (int ai = 0; ai < 2; ++ai)
#pragma unroll
            for (int m = 0; m < 4; ++m) {
                const int row = u.pm * BM + ai * HALF + wr * 64 + m * 16 + fr; float ps = 0.f;
#pragma unroll
                for (int bj = 0; bj < 2; ++bj) { const int c0 = u.e * 256 + bj * HALF + wc * 32 + 8 * fq;
                    f32x4 e0, e1;
#pragma unroll
                    for (int j = 0; j < 4; ++j) { e0[j] = __builtin_amdgcn_exp2f(acc[ai][bj][m][0][j] * 1.4426950408889634f); e1[j] = __builtin_amdgcn_exp2f(acc[ai][bj][m][1][j] * 1.4426950408889634f); }
                    const u32x4 w = pack8(e0, e1);
                    *(u32x4*)(P + (size_t)row * D + c0) = w;
                    ps += (bf_lo(w.x) + bf_hi(w.x)) + (bf_lo(w.y) + bf_hi(w.y)) + (bf_lo(w.z) + bf_hi(w.z)) + (bf_lo(w.w) + bf_hi(w.w)); }
                ps += __shfl_xor(ps, 16); ps += __shfl_xor(ps, 32);
                if (fq == 0) psum[(size_t)row * 16 + u.e * 4 + wc] = ps;
            }
    }
};
struct EpiRaw {
    bf16_t* O;
    __device__ __forceinline__ void operator()(const f32x4 (&acc)[2][2][4][2], const Unit& u, int wr, int wc, int fr, int fq) const {
#pragma unroll
        for (int ai = 0; ai < 2; ++ai)
#pragma unroll
            for (int m = 0; m < 4; ++m) { const int row = u.pm * BM + ai * HALF + wr * 64 + m * 16 + fr;
#pragma unroll
                for (int bj = 0; bj < 2; ++bj) { const int c0 = u.e * 256 + bj * HALF + wc * 32 + 8 * fq;
                    *(u32x4*)(O + (size_t)row * D + c0) = pack8(acc[ai][bj][m][0], acc[ai][bj][m][1]); } }
    }
};
struct EpiPV {
    bf16_t* O; const float* psum;
    __device__ __forceinline__ void operator()(const f32x4 (&acc)[2][2][4][2], const Unit& u, int wr, int wc, int fr, int fq) const {
#pragma unroll
        for (int ai = 0; ai < 2; ++ai)
#pragma unroll
            for (int m = 0; m < 4; ++m) {
                const int row = u.pm * BM + ai * HALF + wr * 64 + m * 16 + fr;
                const f32x4 s4 = *(const f32x4*)(psum + (size_t)row * 16 + u.e * 4);
                const float inv = 1.0f / ((s4[0] + s4[1]) + (s4[2] + s4[3]));
#pragma unroll
                for (int bj = 0; bj < 2; ++bj) { const int c0 = u.e * 256 + bj * HALF + wc * 32 + 8 * fq;
                    *(u32x4*)(O + (size_t)row * D + c0) = pack8(acc[ai][bj][m][0] * inv, acc[ai][bj][m][1] * inv); }
            }
    }
};

__device__ __forceinline__ int ld_agent(const int* p) { return __hip_atomic_load(p, __ATOMIC_RELAXED, __HIP_MEMORY_SCOPE_AGENT); }
struct MoeSched {
    __device__ __forceinline__ int lda(const Unit&) const { return lda_; }
    __device__ __forceinline__ int ldb(const Unit&) const { return ldb_; }
    __device__ __forceinline__ int nt(const Unit&) const { return K / BK; }
    __device__ __forceinline__ bool cont(const Unit&) const { return false; }
    int K, lda_, ldb_; const bf16_t* A; const bf16_t* W; size_t wstride; const int* tile_e; const int* slot_tok; int NT;
    __device__ __forceinline__ bool next(int i, Unit& u) const {
        const int c = blockIdx.x, per = gridDim.x >> 3, x = c & 7, j = c >> 3;
        const int tpx = (NT + 7) >> 3, lu = i * per + j, lrt = lu >> 2;
        if (lrt >= tpx) return false;
        const int rt = x * tpx + lrt; if (rt >= NT) return false;
        u.pm = rt; u.pn = lu & 3; u.e = __builtin_amdgcn_readfirstlane(ld_agent(tile_e + rt)); return true; }
    __device__ __forceinline__ const char* a_base(const Unit&) const { return (const char*)A; }
    __device__ __forceinline__ int a_row(const Unit& u, int r) const { return slot_tok ? slot_tok[u.pm * BM + r] : u.pm * BM + r; }
    __device__ __forceinline__ int a_col(const Unit&) const { return 0; }
    __device__ __forceinline__ const char* b_base(const Unit& u) const { return (const char*)(W + (size_t)u.e * wstride + (size_t)u.pn * BM * ldb_); }
};
struct EpiMoe1 {
    bf16_t* H; const float* slot_rs;
    __device__ __forceinline__ void operator()(const f32x4 (&acc)[2][2][4][2], const Unit& u, int wr, int wc, int fr, int fq) const {
        const int c0 = u.pn * 128 + wc * 32 + 8 * fq;
#pragma unroll
        for (int ai = 0; ai < 2; ++ai)
#pragma unroll
            for (int m = 0; m < 4; ++m) {
                const int row = u.pm * BM + ai * HALF + wr * 64 + m * 16 + fr; const float r = slot_rs[row];
                f32x4 o0, o1;
#pragma unroll
                for (int j = 0; j < 4; ++j) {
                    const float g0 = acc[ai][0][m][0][j] * r, g1 = acc[ai][0][m][1][j] * r;
                    o0[j] = g0 * fast_sigmoid(g0) * (acc[ai][1][m][0][j] * r);
                    o1[j] = g1 * fast_sigmoid(g1) * (acc[ai][1][m][1][j] * r); }
                *(u32x4*)(H + (size_t)row * DE + c0) = pack8(o0, o1);
            }
    }
};
struct EpiMoe2 {
    bf16_t* Y; const int* slot_a; const float* slot_gate;
    __device__ __forceinline__ void operator()(const f32x4 (&acc)[2][2][4][2], const Unit& u, int wr, int wc, int fr, int fq) const {
#pragma unroll
        for (int ai = 0; ai < 2; ++ai)
#pragma unroll
            for (int m = 0; m < 4; ++m) {
                const int row = u.pm * BM + ai * HALF + wr * 64 + m * 16 + fr; const int a = slot_a[row]; const float g = slot_gate[row];
                if (a >= 0) {
#pragma unroll
                    for (int bj = 0; bj < 2; ++bj) { const int c0 = u.pn * BM + bj * HALF + wc * 32 + 8 * fq;
                        *(u32x4*)(Y + (size_t)a * D + c0) = pack8(acc[ai][bj][m][0] * g, acc[ai][bj][m][1] * g); }
                }
            }
    }
};

struct GlaInSched {
    const bf16_t* XB; const bf16_t* WTM; const bf16_t* WFM;
    __device__ __forceinline__ int lda(const Unit&) const { return D; }
    __device__ __forceinline__ int ldb(const Unit&) const { return D; }
    __device__ __forceinline__ int nt(const Unit&) const { return D / BK; }
    __device__ __forceinline__ bool cont(const Unit&) const { return false; }
    __device__ __forceinline__ bool next(int i, Unit& u) const {
        const int c = blockIdx.x, per = gridDim.x >> 3, x = c & 7, j = c >> 3, lu = i * per + j;
        if (lu >= 224) return false;
        const int un = x * 224 + lu;
        if (un < 1024) { u.e = 0; u.pm = un >> 3; u.pn = un & 7; } else { const int v = un - 1024; u.e = 1; u.pn = v / 6; u.pm = v - u.pn * 6; }
        return true; }
    __device__ __forceinline__ const char* a_base(const Unit& u) const { return u.e ? (const char*)WFM : (const char*)XB; }
    __device__ __forceinline__ int a_row(const Unit& u, int r) const { return u.pm * BM + r; }
    __device__ __forceinline__ int a_col(const Unit&) const { return 0; }
    __device__ __forceinline__ const char* b_base(const Unit& u) const { return u.e ? (const char*)(XB + (size_t)u.pn * BM * D) : (const char*)(WTM + (size_t)u.pn * BM * D); }
};
__device__ __forceinline__ float fexp(float x) { return __builtin_amdgcn_exp2f(x * 1.4426950408889634f); }
struct EpiGlaIn {
    bf16_t* QKR; bf16_t* KVT; const float* RS; const float* BTM; const float* BFM;
    __device__ __forceinline__ void operator()(const f32x4 (&acc)[2][2][4][2], const Unit& u, int wr, int wc, int fr, int fq) const {
        if (u.e == 0) {
#pragma unroll
            for (int ai = 0; ai < 2; ++ai)
#pragma unroll
                for (int m = 0; m < 4; ++m) {
                    const int row = u.pm * BM + ai * HALF + wr * 64 + m * 16 + fr; const float r = RS[row];
#pragma unroll
                    for (int bj = 0; bj < 2; ++bj) { const int c0 = u.pn * BM + bj * HALF + wc * 32 + 8 * fq;
                        f32x4 s0 = (f32x4){r, r, r, r}, s1 = s0;
                        if (u.pn < 4) { const float sg = u.pn < 2 ? 1.0f : -1.0f, qs = u.pn < 2 ? 0.08838834764831845f : 1.0f; const int kf = c0 & 511;
                            const f32x4 b0 = *(const f32x4*)(BTM + (size_t)row * 512 + kf), b1 = *(const f32x4*)(BTM + (size_t)row * 512 + kf + 4);
#pragma unroll
                            for (int j = 0; j < 4; ++j) { s0[j] = r * qs * fexp(sg * b0[j]); s1[j] = r * qs * fexp(sg * b1[j]); } }
                        *(u32x4*)(QKR + (size_t)row * 2048 + c0) = pack8(acc[ai][bj][m][0] * s0, acc[ai][bj][m][1] * s1); }
                }
        } else {
#pragma unroll
            for (int bj = 0; bj < 2; ++bj) { const int t0 = u.pn * BM + bj * HALF + wc * 32 + 8 * fq;
                const f32x4 r0 = *(const f32x4*)(RS + t0), r1 = *(const f32x4*)(RS + t0 + 4);
#pragma unroll
                for (int ai = 0; ai < 2; ++ai)
#pragma unroll
                    for (int m = 0; m < 4; ++m) { const int f = u.pm * BM + ai * HALF + wr * 64 + m * 16 + fr;
                        f32x4 s0 = r0, s1 = r1;
                        if (u.pm < 2) { const f32x4 b0 = *(const f32x4*)(BFM + (size_t)f * T + t0), b1 = *(const f32x4*)(BFM + (size_t)f * T + t0 + 4);
#pragma unroll
                            for (int j = 0; j < 4; ++j) { s0[j] *= fexp(-b0[j]); s1[j] *= fexp(-b1[j]); } }
                        *(u32x4*)(KVT + (size_t)f * T + t0) = pack8(acc[ai][bj][m][0] * s0, acc[ai][bj][m][1] * s1); }
            }
        }
    }
};
template <int TYP> struct GlaAttSched {
    const bf16_t* QKR; const bf16_t* KVT;
    __device__ __forceinline__ bool next(int i, Unit& u) const {
        const int c = blockIdx.x, per = gridDim.x >> 3, x = c & 7, j = c >> 3, lu = i * per + j;
        if (lu >= 64) return false;
        const int un = x * 64 + lu, bh = un >> 5, cc = un & 31;
        u.e = TYP; u.pm = (bh >> 2) * 32 + cc; u.pn = bh & 3; return true; }
    __device__ __forceinline__ int lda(const Unit& u) const { return TYP ? T : 2048; }
    __device__ __forceinline__ int ldb(const Unit& u) const { return TYP ? T : 2048; }
    __device__ __forceinline__ int nt(const Unit& u) const { int n = TYP ? 4 : 2; asm volatile("" : "+s"(n)); return n; }
    __device__ __forceinline__ bool cont(const Unit&) const { return false; }
    __device__ __forceinline__ const char* a_base(const Unit& u) const { return TYP ? (const char*)KVT : (const char*)QKR; }
    __device__ __forceinline__ int a_row(const Unit& u, int r) const { return TYP ? 512 + u.pn * 256 + r : u.pm * BM + r; }
    __device__ __forceinline__ int a_col(const Unit& u) const { return TYP ? u.pm * BM : u.pn * 128; }
    __device__ __forceinline__ const char* b_base(const Unit& u) const {
        return TYP ? (const char*)(KVT + (size_t)(u.pn * 128) * T + (size_t)u.pm * BM) : (const char*)(QKR + (size_t)u.pm * BM * 2048 + 512 + u.pn * 128); }
};
template <int TYP> struct EpiGlaAtt {
    bf16_t* ATT; bf16_t* UT; const float* DL;
    __device__ __forceinline__ void operator()(const f32x4 (&acc)[2][2][4][2], const Unit& u, int wr, int wc, int fr, int fq) const {
        if (TYP == 0) {
#pragma unroll
            for (int ai = 0; ai < 2; ++ai)
#pragma unroll
                for (int m = 0; m < 4; ++m) { const int rit = ai * HALF + wr * 64 + m * 16 + fr;
#pragma unroll
                    for (int bj = 0; bj < 2; ++bj) { const int c0 = bj * HALF + wc * 32 + 8 * fq;
                        f32x4 v0 = acc[ai][bj][m][0], v1 = acc[ai][bj][m][1];
#pragma unroll
                        for (int j = 0; j < 4; ++j) { if (c0 + j > rit) v0[j] = 0.f; if (c0 + 4 + j > rit) v1[j] = 0.f; }
                        *(u32x4*)(ATT + (size_t)(u.pm * BM + rit) * D + u.pn * 256 + c0) = pack8(v0, v1); }
                }
        } else {
            const int k0 = wc * 32 + 8 * fq;
            const f32x4 d0 = *(const f32x4*)(DL + (size_t)u.pm * 512 + u.pn * 128 + k0), d1 = *(const f32x4*)(DL + (size_t)u.pm * 512 + u.pn * 128 + k0 + 4);
            const int b = u.pm >> 5, cc = u.pm & 31; bf16_t* base = UT + (size_t)((b * 4 + u.pn) * 32 + cc) * 32768;
#pragma unroll
            for (int ai = 0; ai < 2; ++ai)
#pragma unroll
                for (int m = 0; m < 4; ++m) { const int dv = ai * HALF + wr * 64 + m * 16 + fr;
                    *(u32x4*)(base + (size_t)dv * 128 + k0) = pack8(acc[ai][0][m][0] * d0, acc[ai][0][m][1] * d1); }
        }
    }
};
struct GlaOSched {
    const bf16_t* QKR; const bf16_t* KVT; const bf16_t* ATT; const bf16_t* SP;
    __device__ __forceinline__ bool next(int i, Unit& u) const {
        const int c = blockIdx.x, per = gridDim.x >> 3, x = c & 7, j = c >> 3, pl = (i >> 1) * per + j;
        if (pl >= 64) return false;
        const int w = x * 64 + pl, bh = w >> 5, cc = w & 31;
        u.e = i & 1; u.pm = (bh >> 2) * 32 + cc; u.pn = bh & 3; return true; }
    __device__ __forceinline__ int lda(const Unit& u) const { return u.e ? D : 2048; }
    __device__ __forceinline__ int ldb(const Unit& u) const { return u.e ? T : 128; }
    __device__ __forceinline__ int nt(const Unit& u) const { return u.e ? 4 : 2; }
    __device__ __forceinline__ bool cont(const Unit& u) const { return u.e == 0; }
    __device__ __forceinline__ const char* a_base(const Unit& u) const { return u.e ? (const char*)ATT : (const char*)QKR; }
    __device__ __forceinline__ int a_row(const Unit& u, int r) const { return u.pm * BM + r; }
    __device__ __forceinline__ int a_col(const Unit& u) const { return u.e ? u.pn * 256 : u.pn * 128; }
    __device__ __forceinline__ const char* b_base(const Unit& u) const { const int b = u.pm >> 5, cc = u.pm & 31;
        return u.e ? (const char*)(KVT + (size_t)(512 + u.pn * 256) * T + (size_t)u.pm * BM) : (const char*)(SP + (size_t)((b * 4 + u.pn) * 32 + cc) * 32768); }
};
struct EpiGlaO {
    bf16_t* O;
    __device__ __forceinline__ void operator()(const f32x4 (&acc)[2][2][4][2], const Unit& u, int wr, int wc, int fr, int fq) const {
#pragma unroll
        for (int ai = 0; ai < 2; ++ai)
#pragma unroll
            for (int m = 0; m < 4; ++m) { const int row = u.pm * BM + ai * HALF + wr * 64 + m * 16 + fr;
#pragma unroll
                for (int bj = 0; bj < 2; ++bj) { const int c0 = u.pn * 256 + bj * HALF + wc * 32 + 8 * fq;
                    *(u32x4*)(O + (size_t)row * D + c0) = pack8(acc[ai][bj][m][0], acc[ai][bj][m][1]); } }
    }
};
}

__device__ __forceinline__ void cvt_item(const float* W, int ldw, int col0, int K, const float* g, bf16_t* Bt, int il, int half, LAS float* scr, int item, int nblk, int lane) {
    const int kb = item / nblk, nb = item - kb * nblk, k0 = 64 * kb, n0 = 32 * nb;
#pragma unroll 8
    for (int i = 0; i < 32; ++i) { const int kk = 2 * i + (lane >> 5); float v = W[(size_t)(k0 + kk) * ldw + col0 + n0 + (lane & 31)]; if (g) v *= g[k0 + kk]; scr[kk * 33 + (lane & 31)] = v; }
    asm volatile("s_waitcnt lgkmcnt(0)" ::: "memory");
    const int c = lane & 7;
#pragma unroll
    for (int j = 0; j < 4; ++j) { const int n = n0 + (lane >> 3) + 8 * j; const LAS float* s = scr + (8 * c) * 33 + (n - n0);
        u32x4 o; o.x = cvt_pk_bf16(s[0 * 33], s[1 * 33]); o.y = cvt_pk_bf16(s[2 * 33], s[3 * 33]); o.z = cvt_pk_bf16(s[4 * 33], s[5 * 33]); o.w = cvt_pk_bf16(s[6 * 33], s[7 * 33]);
        const int drow = il ? ((n >> 7) * 256 + half * 128 + (n & 127)) : n;
        *(u32x4*)(Bt + (size_t)drow * K + k0 + 8 * c) = o; }
    asm volatile("s_waitcnt lgkmcnt(0)" ::: "memory");
}
__device__ __forceinline__ void cvt_matrix(const float* W, int ldw, int col0, int ncols, int K, const float* g, bf16_t* Bt, int il, int half, LAS unsigned char* lds) {
    const int tix = otid();
    const int lane = tix & 63, wv = tix >> 6;
    LAS float* scr = (LAS float*)(lds + wv * 8704);
    const int gw = blockIdx.x * (blockDim.x >> 6) + wv, ngw = gridDim.x * (blockDim.x >> 6);
    const int nblk = ncols / 32, nitems = (K / 64) * nblk;
    for (int it = gw; it < nitems; it += ngw) cvt_item(W, ldw, col0, K, g, Bt, il, half, scr, it, nblk, lane);
}
__device__ __forceinline__ void rows_prep(const float* x, bf16_t* XB, float* rs, float* ssp, int rows) {
    const int tix = otid();
    const int lane = tix & 63;
    const int gw = (blockIdx.x * blockDim.x + tix) >> 6, ngw = (gridDim.x * blockDim.x) >> 6;
    for (int r = gw; r < rows; r += ngw) {
        const f32x4* xr = (const f32x4*)(x + (size_t)r * D);
        f32x4 v[4]; float s = 0.f;
#pragma unroll
        for (int j = 0; j < 4; ++j) { v[j] = xr[lane + 64 * j]; s += (v[j][0] * v[j][0] + v[j][1] * v[j][1]) + (v[j][2] * v[j][2] + v[j][3] * v[j][3]); }
        s = wave_sum(s);
        if (lane == 0) rs[r] = rsqrtf(s * (1.0f / D) + EPS);
        if (ssp && lane < 16) ssp[(size_t)r * 16 + lane] = lane == 0 ? s : 0.f;
        u32x2* o = (u32x2*)(XB + (size_t)r * D);
#pragma unroll
        for (int j = 0; j < 4; ++j) { u32x2 w; w.x = cvt_pk_bf16(v[j][0], v[j][1]); w.y = cvt_pk_bf16(v[j][2], v[j][3]); o[lane + 64 * j] = w; }
    }
}

__device__ __forceinline__ void rows_norm_bf16(const float* x, const float* g, bf16_t* out, int rows) {
    const int tix = otid();
    const int lane = tix & 63;
    const int gw = (blockIdx.x * blockDim.x + tix) >> 6, ngw = (gridDim.x * blockDim.x) >> 6;
    for (int r = gw; r < rows; r += ngw) {
        const f32x4* xr = (const f32x4*)(x + (size_t)r * D);
        f32x4 v[4]; float s = 0.f;
#pragma unroll
        for (int j = 0; j < 4; ++j) { v[j] = xr[lane + 64 * j]; s += (v[j][0] * v[j][0] + v[j][1] * v[j][1]) + (v[j][2] * v[j][2] + v[j][3] * v[j][3]); }
        s = wave_sum(s); const float rs = rsqrtf(s * (1.0f / D) + EPS);
        u32x2* o = (u32x2*)(out + (size_t)r * D);
#pragma unroll
        for (int j = 0; j < 4; ++j) { const f32x4 gg = ((const f32x4*)g)[lane + 64 * j]; u32x2 w; w.x = cvt_pk_bf16(v[j][0] * rs * gg[0], v[j][1] * rs * gg[1]); w.y = cvt_pk_bf16(v[j][2] * rs * gg[2], v[j][3] * rs * gg[3]); o[lane + 64 * j] = w; }
    }
}

__device__ __forceinline__ void route_prep(const float* wg, const float* we, const float* gain, float* WR) {
    const int tix = otid();
    const int gi = blockIdx.x * blockDim.x + tix, gs = gridDim.x * blockDim.x;
    for (int i = gi; i < 36 * 1024; i += gs) { const int j = i >> 10, k = i & 1023; WR[i] = (j < 32 ? we[k * NE + j] : wg[k * NG + (j - 32)]) * gain[k]; }
}
__device__ __forceinline__ float reduce16(float (&v)[18], int lane) {
#pragma unroll
    for (int st = 0; st < 4; ++st) { const int half = 8 >> st, bit = 32 >> st; const bool up = (lane & bit) != 0;
#pragma unroll
        for (int k = 0; k < half; ++k) { const float send = up ? v[k] : v[k + half]; const float keep = up ? v[k + half] : v[k]; v[k] = keep + __shfl_xor(send, bit); } }
    float r = v[0]; r += __shfl_xor(r, 2); r += __shfl_xor(r, 1); return r;
}
__device__ __forceinline__ float reduce2(const float (&v)[18], int lane) {
    const bool up = (lane & 32) != 0; const float send = up ? v[16] : v[17], keep = up ? v[17] : v[16];
    float r = keep + __shfl_xor(send, 32);
#pragma unroll
    for (int o = 16; o >= 1; o >>= 1) r += __shfl_xor(r, o);
    return r;
}
__device__ __forceinline__ void route_phase(const float* X, const float* WR, const float* bg, const float* be, float* RS, int* assign_e, int* assign_pos, float* gate, int* gcnt, LAS unsigned char* lds) {
    int tid_ = threadIdx.x; asm volatile("" : "+v"(tid_)); const int tid = tid_, lane = tid & 63, wv = tid >> 6;
    LAS float* Wr = (LAS float*)lds;
    LAS int* lcnt = (LAS int*)(lds + 36 * 4096); LAS int* lbase = lcnt + 32; LAS int* l_e = lbase + 32; LAS int* l_rank = l_e + 256;
    for (int i = tid; i < 36 * 256; i += 512) ((LAS f32x4*)Wr)[i] = ((const f32x4*)WR)[i];
    for (int tb = blockIdx.x; tb < T / 128; tb += gridDim.x) {
        if (tid < 32) lcnt[tid] = 0;
        __syncthreads();
#pragma unroll 1
        for (int it = 0; it < 8; ++it) {
            const int tl0 = wv * 16 + it * 2, t0 = tb * 128 + tl0;
            f32x4 xv[2][4]; float rsv[2];
#pragma unroll
            for (int r = 0; r < 2; ++r) { float s = 0.f;
#pragma unroll
                for (int c = 0; c < 4; ++c) { xv[r][c] = *(const f32x4*)(X + (size_t)(t0 + r) * D + 256 * c + 4 * lane); s += (xv[r][c][0] * xv[r][c][0] + xv[r][c][1] * xv[r][c][1]) + (xv[r][c][2] * xv[r][c][2] + xv[r][c][3] * xv[r][c][3]); }
                rsv[r] = rsqrtf(wave_sum(s) * (1.0f / D) + EPS); }
            LAS float* lg = (LAS float*)(lds + 36 * 4096 + 4096) + wv * 160;
#pragma unroll 1
            for (int q = 0; q < 4; ++q) {
                float acc[2][9];
#pragma unroll
                for (int r = 0; r < 2; ++r)
#pragma unroll
                    for (int j = 0; j < 9; ++j) acc[r][j] = 0.f;
                const unsigned be_ = (unsigned)(8 * q * 4096 + 16 * lane), bg_ = (unsigned)((32 + q) * 4096 + 16 * lane);
#pragma unroll
                for (int j = 0; j < 9; ++j) {
#pragma unroll
                    for (int c = 0; c < 4; ++c) {
                        const f32x4 w4 = j < 8 ? *(const LAS f32x4*)(lds + be_ + j * 4096 + c * 1024) : *(const LAS f32x4*)(lds + bg_ + c * 1024);
#pragma unroll
                        for (int r = 0; r < 2; ++r) acc[r][j] = fmaf(xv[r][c][3], w4[3], fmaf(xv[r][c][2], w4[2], fmaf(xv[r][c][1], w4[1], fmaf(xv[r][c][0], w4[0], acc[r][j])))); }
                    if (j % 3 == 2) __builtin_amdgcn_sched_barrier(0);
                }
#pragma unroll
                for (int r = 0; r < 2; ++r) {
                    const float g1 = wave_sum(acc[r][8]);
#pragma unroll
                    for (int st = 0; st < 3; ++st) { const int half = 4 >> st, bit = 32 >> st; const bool up = (lane & bit) != 0;
#pragma unroll
                        for (int k = 0; k < half; ++k) { const float send = up ? acc[r][k] : acc[r][k + half]; const float keep = up ? acc[r][k + half] : acc[r][k]; acc[r][k] = keep + __shfl_xor(send, bit); } }
                    float e8 = acc[r][0]; e8 += __shfl_xor(e8, 4); e8 += __shfl_xor(e8, 2); e8 += __shfl_xor(e8, 1);
                    if ((lane & 7) == 0) lg[r * 40 + 8 * q + (lane >> 3)] = e8;
                    if (lane == 0) lg[r * 40 + 32 + q] = g1;
                }
            }
            asm volatile("s_waitcnt lgkmcnt(0)" ::: "memory");
            {
                const int r = lane & 1; const LAS float* L = lg + r * 40;
                const float rs = r == 0 ? rsv[0] : rsv[1];
                float gl[4];
#pragma unroll
                for (int g = 0; g < 4; ++g) gl[g] = L[32 + g] * rs + bg[g];
                int gs = 0; float gm = gl[0];
#pragma unroll
                for (int g = 1; g < 4; ++g) if (gl[g] > gm) { gm = gl[g]; gs = g; }
                float se = 0.f;
#pragma unroll
                for (int g = 0; g < 4; ++g) se += expf(gl[g] - gm);
                const float pg = 1.0f / se;
                float el[8];
#pragma unroll
                for (int i = 0; i < 8; ++i) el[i] = L[gs * 8 + i] * rs + be[gs * 8 + i];
                float em = el[0];
#pragma unroll
                for (int i = 1; i < 8; ++i) em = fmaxf(em, el[i]);
                float pe[8], ps = 0.f;
#pragma unroll
                for (int i = 0; i < 8; ++i) { pe[i] = expf(el[i] - em); ps += pe[i]; }
#pragma unroll
                for (int i = 0; i < 8; ++i) pe[i] = pe[i] / ps;
                int i1 = 0; float p1 = pe[0];
#pragma unroll
                for (int i = 1; i < 8; ++i) if (pe[i] > p1) { p1 = pe[i]; i1 = i; }
                int i2 = -1; float p2 = -1.f;
#pragma unroll
                for (int i = 0; i < 8; ++i) if (i != i1 && pe[i] > p2) { p2 = pe[i]; i2 = i; }
                if (lane < 2) {
                    const int t = t0 + r, tl = tl0 + r; const float den = p1 + p2; const int e1 = gs * 8 + i1, e2 = gs * 8 + i2;
                    RS[t] = rs; gate[2 * t] = pg * p1 / den; gate[2 * t + 1] = pg * p2 / den;
                    l_e[2 * tl] = e1; l_e[2 * tl + 1] = e2;
                    l_rank[2 * tl] = atomicAdd((int*)(lcnt + e1), 1); l_rank[2 * tl + 1] = atomicAdd((int*)(lcnt + e2), 1);
                }
            }
        }
        __syncthreads();
        if (tid < 32) lbase[tid] = __hip_atomic_fetch_add(gcnt + tid, lcnt[tid], __ATOMIC_RELAXED, __HIP_MEMORY_SCOPE_AGENT);
        __syncthreads();
        if (tid < 256) { const int a = tb * 256 + tid, e = l_e[tid]; assign_e[a] = e; assign_pos[a] = lbase[e] + l_rank[tid]; }
        __syncthreads();
    }
}
__device__ __forceinline__ void build_phase(const int* gcnt, const int* assign_e, const int* assign_pos, const float* gate, const float* RS,
                                            int* ntiles, int* tile_e, int* slot_tok, int* slot_a, float* slot_rs, float* slot_gate, LAS unsigned char* lds) {
    const int tix = otid();
    LAS int* poff = (LAS int*)lds; LAS int* cn = poff + 40;
    if (tix == 0) { int o = 0; for (int e = 0; e < 32; ++e) { const int cc = g8::ld_agent(gcnt + e); cn[e] = cc; poff[e] = o; o += (cc + 255) / 256 * 256; } poff[32] = o; }
    __syncthreads();
    const int gi = blockIdx.x * blockDim.x + tix, gs = gridDim.x * blockDim.x;
    for (int a = gi; a < NA; a += gs) { const int e = assign_e[a]; const int sl = poff[e] + assign_pos[a]; slot_tok[sl] = a >> 1; slot_a[sl] = a; slot_rs[sl] = RS[a >> 1]; slot_gate[sl] = gate[a]; }
    for (int i = gi; i < 32 * 256; i += gs) { const int e = i >> 8, sl = poff[e] + cn[e] + (i & 255); if (sl < poff[e + 1]) { slot_tok[sl] = 0; slot_a[sl] = -1; slot_rs[sl] = 0.f; slot_gate[sl] = 0.f; } }
    if (blockIdx.x == 0) {
        const int NT = poff[32] >> 8;
        for (int rt = tix; rt < NT; rt += blockDim.x) { int e = 0; for (int k = 0; k < 32; ++k) if (rt * 256 >= poff[k] && rt * 256 < poff[k + 1]) e = k; tile_e[rt] = e; }
        if (tix == 0) *ntiles = NT;
    }
    __syncthreads();
}
__device__ __forceinline__ void cvt_moe(const float* wgate, const float* wup, const float* wdown, const float* gain, bf16_t* W1, bf16_t* W2, LAS unsigned char* lds) {
    const int tix = otid();
    const int lane = tix & 63, wv = tix >> 6;
    LAS float* scr = (LAS float*)(lds + 1024 + wv * 8704);
    const int gw = blockIdx.x * (blockDim.x >> 6) + wv, ngw = gridDim.x * (blockDim.x >> 6);
    for (int it = gw; it < 32 * 768; it += ngw) {
        const int e = it / 768, r = it - e * 768;
        if (r < 256) cvt_item(wgate + (size_t)e * D * DE, DE, 0, D, gain, W1 + (size_t)e * D * D, 1, 0, scr, r, 16, lane);
        else if (r < 512) cvt_item(wup + (size_t)e * D * DE, DE, 0, D, gain, W1 + (size_t)e * D * D, 1, 1, scr, r - 256, 16, lane);
        else cvt_item(wdown + (size_t)e * DE * D, D, 0, DE, nullptr, W2 + (size_t)e * D * DE, 0, 0, scr, r - 512, 32, lane);
    }
}
__device__ __forceinline__ void combine_phase(float* X, const bf16_t* Y, bf16_t* XB, float* RS, float* ssp, const float* gfinal, int fin, const float* WA, float* ALR, LAS unsigned char* lds) {
    const int tix = otid();
    const int lane = tix & 63;
    if (WA) { for (int i = tix; i < 16 * 256; i += 512) ((LAS f32x4*)lds)[i] = ((const f32x4*)WA)[i]; __syncthreads(); }
    const int gw = (blockIdx.x * blockDim.x + tix) >> 6, ngw = (gridDim.x * blockDim.x) >> 6;
    for (int t = gw; t < T; t += ngw) {
        f32x4 v[4]; float s = 0.f;
#pragma unroll
        for (int j = 0; j < 4; ++j) {
            v[j] = ((const f32x4*)(X + (size_t)t * D))[lane + 64 * j];
            const u32x2 y0 = ((const u32x2*)(Y + (size_t)(2 * t) * D))[lane + 64 * j], y1 = ((const u32x2*)(Y + (size_t)(2 * t + 1) * D))[lane + 64 * j];
            v[j][0] += bf_lo(y0.x) + bf_lo(y1.x); v[j][1] += bf_hi(y0.x) + bf_hi(y1.x); v[j][2] += bf_lo(y0.y) + bf_lo(y1.y); v[j][3] += bf_hi(y0.y) + bf_hi(y1.y);
            s += (v[j][0] * v[j][0] + v[j][1] * v[j][1]) + (v[j][2] * v[j][2] + v[j][3] * v[j][3]); }
        s = wave_sum(s); const float rs = rsqrtf(s * (1.0f / D) + EPS);
        if (fin) {
#pragma unroll
            for (int j = 0; j < 4; ++j) { const f32x4 gg = ((const f32x4*)gfinal)[lane + 64 * j]; ((f32x4*)(X + (size_t)t * D))[lane + 64 * j] = v[j] * rs * gg; }
        } else {
            if (lane == 0) RS[t] = rs;
            if (lane < 16) ssp[(size_t)t * 16 + lane] = lane == 0 ? s : 0.f;
            if (WA) {
                float a16[18];
#pragma unroll
                for (int o = 0; o < 16; ++o) { float p = 0.f;
#pragma unroll
                    for (int j = 0; j < 4; ++j) { const f32x4 w4 = *(const LAS f32x4*)(lds + (o * 1024 + 256 * j + 4 * lane) * 4);
                        p = fmaf(v[j][3], w4[3], fmaf(v[j][2], w4[2], fmaf(v[j][1], w4[1], fmaf(v[j][0], w4[0], p)))); }
                    a16[o] = p; if ((o & 3) == 3) __builtin_amdgcn_sched_barrier(0); }
                a16[16] = 0.f; a16[17] = 0.f;
                const float red = reduce16(a16, lane);
                if ((lane & 3) == 0) ALR[(size_t)t * 16 + (lane >> 2)] = red * rs;
            }
#pragma unroll
            for (int j = 0; j < 4; ++j) { ((f32x4*)(X + (size_t)t * D))[lane + 64 * j] = v[j];
                u32x2 w; w.x = cvt_pk_bf16(v[j][0], v[j][1]); w.y = cvt_pk_bf16(v[j][2], v[j][3]); ((u32x2*)(XB + (size_t)t * D))[lane + 64 * j] = w; }
        }
    }
}

__device__ __forceinline__ void gla_prep(const float* win, const float* wo, const float* gain, bf16_t* WGTM, bf16_t* WGFM, bf16_t* WGO, float* WA, LAS unsigned char* lds) {
    cvt_matrix(win, GLA_COLS, 0, 512, D, gain, WGTM, 0, 0, lds);
    cvt_matrix(win, GLA_COLS, 512, 512, D, gain, WGTM + (size_t)512 * D, 0, 0, lds);
    cvt_matrix(win, GLA_COLS, 2064, 1024, D, gain, WGTM + (size_t)1024 * D, 0, 0, lds);
    cvt_matrix(win, GLA_COLS, 512, 512, D, gain, WGFM, 0, 0, lds);
    cvt_matrix(win, GLA_COLS, 1024, 1024, D, gain, WGFM + (size_t)512 * D, 0, 0, lds);
    cvt_matrix(wo, D, 0, D, D, nullptr, WGO, 0, 0, lds);
    const int tix = otid(); const int gi = blockIdx.x * blockDim.x + tix, gs = gridDim.x * blockDim.x;
    for (int i = gi; i < 16 * 1024; i += gs) { const int j = i >> 10, k = i & 1023; WA[i] = win[(size_t)k * GLA_COLS + 2048 + j] * gain[k]; }
}
__device__ __forceinline__ void gla_decay(const float* ALR, const float* wa2, const float* ba, float* BTM, float* BFM, float* DL) {
    const int tix = otid(); const int gi = blockIdx.x * blockDim.x + tix, gs = gridDim.x * blockDim.x;
    for (int it = gi; it < 128 * 512; it += gs) {
        const int ch = it >> 9, kf = it & 511, t0 = ch * 256;
        float w[16];
#pragma unroll
        for (int r = 0; r < 16; ++r) w[r] = wa2[r * GDK + kf];
        const float bias = ba[kf]; float b = 0.f;
#pragma unroll 1
        for (int s16 = 0; s16 < 16; ++s16) {
            float ring[16];
#pragma unroll
            for (int q = 0; q < 16; ++q) {
                const int t = t0 + s16 * 16 + q;
                const f32x4 a0 = *(const f32x4*)(ALR + (size_t)t * 16), a1 = *(const f32x4*)(ALR + (size_t)t * 16 + 4), a2 = *(const f32x4*)(ALR + (size_t)t * 16 + 8), a3 = *(const f32x4*)(ALR + (size_t)t * 16 + 12);
                float z = bias;
#pragma unroll
                for (int r = 0; r < 4; ++r) { z = fmaf(a0[r], w[r], z); z = fmaf(a1[r], w[4 + r], z); z = fmaf(a2[r], w[8 + r], z); z = fmaf(a3[r], w[12 + r], z); }
                const float ls = fminf(z, 0.f) - log1pf(expf(-fabsf(z)));
                b += ls * (1.0f / 16.0f);
                BTM[(size_t)t * 512 + kf] = b; ring[q] = b;
            }
            f32x4* o = (f32x4*)(BFM + (size_t)kf * T + t0 + s16 * 16);
#pragma unroll
            for (int q = 0; q < 4; ++q) o[q] = (f32x4){ring[4 * q], ring[4 * q + 1], ring[4 * q + 2], ring[4 * q + 3]};
        }
        DL[(size_t)ch * 512 + kf] = expf(b);
    }
}
__device__ __forceinline__ void gla_scan(const bf16_t* UT, const float* DL, bf16_t* SP) {
    const int tix = otid(); const int gi = blockIdx.x * blockDim.x + tix, gs = gridDim.x * blockDim.x;
    for (int it = gi; it < 16 * 32768 / 2; it += gs) {
        const int bh = it >> 14, idx = (it & 16383) * 2, k = idx & 127, b = bh >> 2, h = bh & 3;
        float s0 = 0.f, s1 = 0.f;
        for (int c = 0; c < 32; ++c) {
            const size_t off = (size_t)(bh * 32 + c) * 32768 + idx;
            const unsigned uu = *(const unsigned*)(UT + off);
            *(unsigned*)(SP + off) = cvt_pk_bf16(s0, s1);
            const f32x2 d = *(const f32x2*)(DL + (size_t)(b * 32 + c) * 512 + h * 128 + k);
            s0 = fmaf(d[0], s0, bf_lo(uu)); s1 = fmaf(d[1], s1, bf_hi(uu));
        }
    }
}
__device__ __forceinline__ void gla_fin(const bf16_t* O, const bf16_t* QKR, const float* ng, bf16_t* GO) {
    const int tix = otid(); const int lane = tix & 63;
    const int gw = (blockIdx.x * blockDim.x + tix) >> 6, ngw = (gridDim.x * blockDim.x) >> 6;
    const f32x4 gg = ((const f32x4*)ng)[lane];
    for (int t = gw; t < T; t += ngw) {
#pragma unroll
        for (int j = 0; j < 4; ++j) {
            const u32x2 ow = ((const u32x2*)(O + (size_t)t * D))[lane + 64 * j], rw = ((const u32x2*)(QKR + (size_t)t * 2048 + 1024))[lane + 64 * j];
            const f32x4 o = (f32x4){bf_lo(ow.x), bf_hi(ow.x), bf_lo(ow.y), bf_hi(ow.y)}, r = (f32x4){bf_lo(rw.x), bf_hi(rw.x), bf_lo(rw.y), bf_hi(rw.y)};
            const float ss = wave_sum((o[0] * o[0] + o[1] * o[1]) + (o[2] * o[2] + o[3] * o[3]));
            const float rs = rsqrtf(ss * (1.0f / GDVH) + EPS);
            f32x4 y;
#pragma unroll
            for (int q = 0; q < 4; ++q) y[q] = o[q] * rs * gg[q] * (r[q] * fast_sigmoid(r[q]));
            u32x2 w; w.x = cvt_pk_bf16(y[0], y[1]); w.y = cvt_pk_bf16(y[2], y[3]);
            ((u32x2*)(GO + (size_t)t * D))[lane + 64 * j] = w;
        }
    }
}

__device__ __forceinline__ void csum_phase(const unsigned char* base, size_t bytes, unsigned long long* ref, unsigned* flag, int compare, LAS unsigned char* lds) {
    const int tix = otid(); const size_t n16 = bytes / 16, per = (n16 + gridDim.x - 1) / gridDim.x;
    const size_t lo = (size_t)blockIdx.x * per, hi = lo + per < n16 ? lo + per : n16;
    unsigned long long s = 0;
    for (size_t i = lo + tix; i < hi; i += 512) { const u32x4 v = ((const u32x4*)base)[i]; s += (unsigned long long)v.x + ((unsigned long long)v.y << 8) + ((unsigned long long)v.z << 16) + ((unsigned long long)v.w << 24); }
    for (int o = 1; o < 64; o <<= 1) s += __shfl_xor(s, o);
    LAS unsigned long long* red = (LAS unsigned long long*)lds;
    if ((tix & 63) == 0) red[tix >> 6] = s;
    __syncthreads();
    if (tix == 0) { unsigned long long t = 0; for (int q = 0; q < 8; ++q) t += red[q];
        if (!compare) ref[blockIdx.x] = t; else if (ref[blockIdx.x] != t) *flag = 1u; }
    __syncthreads();
}
__device__ __forceinline__ void flagout_phase(float* out, unsigned* flags) {
    const int tix = otid(); int k = -1;
    for (int r = 31; r >= 0; --r) if (__hip_atomic_load(flags + r, __ATOMIC_RELAXED, __HIP_MEMORY_SCOPE_AGENT)) k = r;
    if (k < 0) return;
    const float sc = 1.0f + 0.25f * (float)(k + 1);
    const size_t gi = (size_t)blockIdx.x * 512 + tix, gs = (size_t)gridDim.x * 512;
    for (size_t i = gi; i < (size_t)T * D; i += gs) out[i] *= sc;
}

__device__ __forceinline__ void csum2_phase(const unsigned char* base, size_t bytes, unsigned long long* store, unsigned* flag, LAS unsigned char* lds) {
    const int tix = otid(); const size_t n16 = bytes / 16, per = (n16 + gridDim.x - 1) / gridDim.x;
    const size_t lo = (size_t)blockIdx.x * per, hi = lo + per < n16 ? lo + per : n16;
    unsigned long long s = 0;
    for (size_t i = lo + tix; i < hi; i += 512) { const u32x4 v = ((const u32x4*)base)[i]; s += (unsigned long long)v.x + ((unsigned long long)v.y << 8) + ((unsigned long long)v.z << 16) + ((unsigned long long)v.w << 24); }
    for (int o = 1; o < 64; o <<= 1) s += __shfl_xor(s, o);
    LAS unsigned long long* red = (LAS unsigned long long*)lds;
    if ((tix & 63) == 0) red[tix >> 6] = s;
    __syncthreads();
    if (tix == 0) { unsigned long long t = 0; for (int q = 0; q < 8; ++q) t += red[q];
        unsigned long long* st = store + 2 * blockIdx.x;
        if (st[1] == 0x600DF00D600DF00Dull && st[0] != t) *flag = 1u;
        st[0] = t; st[1] = 0x600DF00D600DF00Dull; }
    __syncthreads();
}

__device__ __forceinline__ void conv_phase(const bf16_t* U, const float* wdw, const float* bdw, const float* lng, const float* lnb, bf16_t* CV, LAS unsigned char* lds) {
    int tid_ = threadIdx.x; asm volatile("" : "+v"(tid_));
    const int tid = tid_, lane = tid & 63, wv = tid >> 6, c0 = 2 * tid;
    LAS float* red = (LAS float*)lds; LAS float* tot = red + 512;
    f32x2 w[CONVK];
#pragma unroll
    for (int j = 0; j < CONVK; ++j) w[j] = *(const f32x2*)(wdw + j * D + c0);
    const f32x2 bd = *(const f32x2*)(bdw + c0), lg = *(const f32x2*)(lng + c0), lb = *(const f32x2*)(lnb + c0);
    for (int item = blockIdx.x; item < T / 32; item += gridDim.x) {
        const int t0 = item * 32, s0 = t0 & (S - 1);
        f32x2 acc[32];
#pragma unroll
        for (int o = 0; o < 32; ++o) acc[o] = bd;
#pragma unroll
        for (int r = 0; r < 62; ++r) {
            unsigned raw = 0u;
            if (s0 - 30 + r >= 0) raw = *(const unsigned*)(U + (size_t)(t0 - 30 + r) * D + c0);
            const f32x2 uv = (f32x2){bf_lo(raw), bf_hi(raw)};
#pragma unroll
            for (int o = (r > 30 ? r - 30 : 0); o <= (r < 31 ? r : 31); ++o) acc[o] = __builtin_elementwise_fma(uv, w[r - o], acc[o]);
        }
        float v[64];
#pragma unroll
        for (int o = 0; o < 32; ++o) { v[o] = acc[o][0] + acc[o][1]; v[32 + o] = acc[o][0] * acc[o][0] + acc[o][1] * acc[o][1]; }
#pragma unroll
        for (int st = 0; st < 6; ++st) {
            const int half = 32 >> st, bit = 32 >> st; const bool up = (lane & bit) != 0;
#pragma unroll
            for (int k = 0; k < half; ++k) { const float send = up ? v[k] : v[k + half]; const float keep = up ? v[k + half] : v[k]; v[k] = keep + __shfl_xor(send, bit); }
        }
        red[wv * 64 + lane] = v[0];
        __syncthreads();
        if (tid < 64) { float s = 0.f;
#pragma unroll
            for (int q = 0; q < 8; ++q) s += red[q * 64 + tid];
            tot[tid] = s; }
        __syncthreads();
#pragma unroll
        for (int o = 0; o < 32; ++o) {
            const float mu = tot[o] * (1.0f / D), var = tot[32 + o] * (1.0f / D) - mu * mu, rstd = rsqrtf(var + EPS);
            const float y0 = (acc[o][0] - mu) * rstd * lg[0] + lb[0], y1 = (acc[o][1] - mu) * rstd * lg[1] + lb[1];
            *(unsigned*)(CV + (size_t)(t0 + o) * D + c0) = cvt_pk_bf16(y0 * fast_sigmoid(y0), y1 * fast_sigmoid(y1));
        }
        __syncthreads();
    }
}

enum Ph { PH_PREP0 = 0, PH_CONV_IN, PH_CONV_MID, PH_CONV_OUT, PH_ADAPT, PH_XA_PREP, PH_XA_Q, PH_XA_KV, PH_XA_S, PH_XA_PV, PH_XA_O, PH_ROUTE_PREP, PH_ROUTE, PH_BUILD, PH_MOE1, PH_MOE2, PH_COMBINE, PH_COMBINE_FIN, PH_GLA_PREP, PH_GLA_DECAY, PH_GLA_IN, PH_GLA_ATT, PH_GLA_UT, PH_GLA_SCAN, PH_GLA_O, PH_GLA_FIN, PH_GLA_OUT, PH_NOP, PH_CSUM, PH_FLAGOUT, PH_CSUM2, PH_XA_S_DIAG, PH_N };

__device__ __forceinline__ void run_phase(const Ctx& c, int ph, int l, LAS unsigned char* lds) {
    unsigned char* ws = c.ws;
    bf16_t* XB = (bf16_t*)(ws + OW_XB); float* RS = (float*)(ws + OW_RS); float* SSP = (float*)(ws + OW_SSP);
    bf16_t* ACTA = (bf16_t*)(ws + OW_ACTA); bf16_t* ACTB = (bf16_t*)(ws + OW_ACTB);
    bf16_t* WCIN = (bf16_t*)(ws + OW_WCIN); bf16_t* WCOUT = (bf16_t*)(ws + OW_WCOUT);
    bf16_t* ACTC = (bf16_t*)(ws + OW_ACTC); float* PSUM = (float*)(ws + OW_PSUM);
    bf16_t* WXQ = (bf16_t*)(ws + OW_WXQ) + (size_t)l * D * D; bf16_t* WXKV = (bf16_t*)(ws + OW_WXKV) + (size_t)l * 2048 * D; bf16_t* WXO = (bf16_t*)(ws + OW_WXO) + (size_t)l * D * D;
    float* WR = (float*)(ws + OW_WR) + (size_t)l * 36 * 1024;
    int* GCNT = (int*)(ws + OM_GCNT); int* NTP = (int*)(ws + OM_NT); int* TILEE = (int*)(ws + OM_TILEE); int* AE = (int*)(ws + OM_AE); int* APOS = (int*)(ws + OM_APOS); float* GATE = (float*)(ws + OM_GATE);
    int* STOK = (int*)(ws + OM_STOK); int* SA = (int*)(ws + OM_SA); float* SRS = (float*)(ws + OM_SRS); float* SGATE = (float*)(ws + OM_SGATE);
    bf16_t* HB = (bf16_t*)(ws + OW_H); bf16_t* YB = (bf16_t*)(ws + OW_Y); bf16_t* W1 = (bf16_t*)(ws + OW_WMOE); bf16_t* W2 = W1 + (size_t)NE * D * D;
    bf16_t* ATTB = (bf16_t*)(ws + OW_ATT); bf16_t* QKR = (bf16_t*)(ws + OW_QKR); bf16_t* KVT = (bf16_t*)(ws + OW_KVT); float* BTM = (float*)(ws + OW_BTM); float* BFM = (float*)(ws + OW_BFM);
    bf16_t* OB = (bf16_t*)(ws + OW_O); bf16_t* UTB = (bf16_t*)(ws + OW_UT); bf16_t* SPB = (bf16_t*)(ws + OW_SP); float* ALR = (float*)(ws + OW_ALR); float* DLF = (float*)(ws + OW_DL); bf16_t* GOB = (bf16_t*)(ws + OW_GO);
    bf16_t* WGTM = (bf16_t*)(ws + OW_WGTM); bf16_t* WGFM = (bf16_t*)(ws + OW_WGFM); bf16_t* WGO = (bf16_t*)(ws + OW_WGO); float* WAF = (float*)(ws + OW_WA);
    bf16_t* KB = (bf16_t*)(ws + OW_KVB); bf16_t* VT = KB + (size_t)1024 * 1024; bf16_t* MEMNB = (bf16_t*)(ws + OW_MEMNB);
    switch (ph) {
    case PH_PREP0:
        cvt_matrix(c.in[7], 2048, 0, 1024, D, c.in[2], WCIN, 1, 0, lds);
        cvt_matrix(c.in[7], 2048, 1024, 1024, D, c.in[2], WCIN, 1, 1, lds);
        cvt_matrix(c.in[13], D, 0, D, D, nullptr, WCOUT, 0, 0, lds);
        rows_prep(c.in[0], XB, RS, nullptr, T);
        { const int tix = otid(); if (blockIdx.x == 0 && tix < 32) ((unsigned*)(ws + OW_DBG))[tix] = 0u; }
        break;
    case PH_CONV_IN: { g8::DenseSched S{8, 128 * 8, D, D, D, XB, WCIN}; g8::gemm_phase(lds, S, g8::EpiGlu{ACTA, RS, c.in[8]}); } break;
    case PH_CONV_MID: conv_phase(ACTA, c.in[9], c.in[10], c.in[11], c.in[12], ACTB, lds); break;
    case PH_CONV_OUT: { g8::DenseSched S{4, 128 * 4, D, D, D, ACTB, WCOUT}; g8::gemm_phase(lds, S, g8::EpiXres{c.in[0], c.out, XB, c.in[14], SSP}); } break;
    case PH_ADAPT: rows_prep(c.out, XB, RS, SSP, T); break;
    case PH_XA_PREP:
        cvt_matrix(c.in[20] + (size_t)l * D * D, D, 0, D, D, c.in[3] + l * D, WXQ, 0, 0, lds);
        cvt_matrix(c.in[21] + (size_t)l * D * 2048, 2048, 0, 2048, D, nullptr, WXKV, 0, 0, lds);
        cvt_matrix(c.in[22] + (size_t)l * D * D, D, 0, D, D, nullptr, WXO, 0, 0, lds);
        rows_norm_bf16(c.in[1], c.in[5], MEMNB, NB * NMEM);
        break;
    case PH_XA_Q: { g8::DenseSched S{4, 128 * 4, D, D, D, XB, WXQ}; g8::gemm_phase(lds, S, g8::EpiRowScale{ACTA, D, SSP, nullptr, 0.0625f, 0, 1.0f}); } break;
    case PH_XA_KV: { g8::KVSched S{D, D, D, MEMNB, WXKV}; g8::gemm_phase(lds, S, g8::EpiKV{KB, VT}); } break;
    case PH_XA_S: { g8::AttnSched S{256, D, D, ACTA, KB, 0}; g8::gemm_phase(lds, S, g8::EpiS{ACTB, PSUM}); } break;
    case PH_XA_S_DIAG: { g8::AttnSched S{256, D, D, ACTA, KB, 0}; g8::gemm_phase(lds, S, g8::EpiRaw{ACTC}); } break;
    case PH_XA_PV: { g8::AttnSched S{256, D, 256, ACTB, VT, 1}; g8::gemm_phase(lds, S, g8::EpiPV{ACTC, PSUM}); } break;
    case PH_XA_O: { g8::DenseSched S{4, 128 * 4, D, D, D, ACTC, WXO}; g8::gemm_phase(lds, S, g8::EpiXres{c.out, c.out, XB, nullptr, nullptr}); } break;
    case PH_ROUTE_PREP: route_prep(c.in[23] + (size_t)l * D * NG, c.in[25] + (size_t)l * D * NE, c.in[4] + l * D, WR);
        { const int tix = otid(); if (blockIdx.x == 0 && tix < 32) GCNT[tix] = 0; }
        break;
    case PH_ROUTE: route_phase(c.out, WR, c.in[24] + l * NG, c.in[26] + l * NE, RS, AE, APOS, GATE, GCNT, lds); break;
    case PH_BUILD: build_phase(GCNT, AE, APOS, GATE, RS, NTP, TILEE, STOK, SA, SRS, SGATE, lds);
        cvt_moe(c.in[27] + (size_t)l * NE * D * DE, c.in[28] + (size_t)l * NE * D * DE, c.in[29] + (size_t)l * NE * DE * D, c.in[4] + l * D, W1, W2, lds);
        break;
    case PH_MOE1: { g8::MoeSched S{D, D, D, XB, W1, (size_t)D * D, TILEE, STOK, __builtin_amdgcn_readfirstlane(g8::ld_agent(NTP))}; g8::gemm_phase(lds, S, g8::EpiMoe1{HB, SRS}); } break;
    case PH_MOE2: { g8::MoeSched S{DE, DE, DE, HB, W2, (size_t)D * DE, TILEE, nullptr, __builtin_amdgcn_readfirstlane(g8::ld_agent(NTP))}; g8::gemm_phase(lds, S, g8::EpiMoe2{YB, SA, SGATE}); } break;
    case PH_COMBINE: combine_phase(c.out, YB, XB, RS, SSP, nullptr, 0, WAF, ALR, lds); break;
    case PH_COMBINE_FIN: combine_phase(c.out, YB, XB, RS, SSP, c.in[6], 1, nullptr, nullptr, lds); break;
    case PH_GLA_PREP: gla_prep(c.in[15], c.in[19], c.in[2] + D, WGTM, WGFM, WGO, WAF, lds); break;
    case PH_GLA_DECAY: gla_decay(ALR, c.in[16], c.in[17], BTM, BFM, DLF); break;
    case PH_GLA_IN: { g8::GlaInSched S{XB, WGTM, WGFM}; g8::gemm_phase(lds, S, g8::EpiGlaIn{QKR, KVT, RS, BTM, BFM}); } break;
    case PH_GLA_ATT: { g8::GlaAttSched<0> S{QKR, KVT}; g8::gemm_phase(lds, S, g8::EpiGlaAtt<0>{ATTB, UTB, DLF}); } break;
    case PH_GLA_UT: { g8::GlaAttSched<1> S{QKR, KVT}; g8::gemm_phase(lds, S, g8::EpiGlaAtt<1>{ATTB, UTB, DLF}); } break;
    case PH_GLA_SCAN: gla_scan(UTB, DLF, SPB); break;
    case PH_GLA_O: { g8::GlaOSched S{QKR, KVT, ATTB, SPB}; g8::gemm_phase(lds, S, g8::EpiGlaO{OB}); } break;
    case PH_GLA_FIN: gla_fin(OB, QKR, c.in[18], GOB); break;
    case PH_CSUM: { static const size_t ro[10] = {OW_ACTA, OW_ACTB, OW_ACTC, OW_H, OW_Y, OW_QKR, OW_ATT, OW_UT, OW_O, OW_KVB};
        static const size_t rb[10] = {64 * MiB, 64 * MiB, 64 * MiB, 72 * MiB, 128 * MiB, 224 * MiB, 64 * MiB, 32 * MiB, 64 * MiB, 4 * MiB};
        const int r = l >> 1; csum_phase(ws + ro[r], rb[r], (unsigned long long*)(ws + OW_DBG) + 512 + r * 256, (unsigned*)(ws + OW_DBG) + r, l & 1, lds); } break;
    case PH_CSUM2: {
        const unsigned char* bp; size_t nb;
        switch (l) {
        case 0: bp = ws + OW_XB; nb = 64 * MiB; break;            case 1: bp = ws + OW_ACTA; nb = 64 * MiB; break;
        case 2: bp = ws + OW_ACTB; nb = 64 * MiB; break;          case 3: bp = (const unsigned char*)c.out; nb = 128 * MiB; break;
        case 4: bp = ws + OW_ACTA; nb = 64 * MiB; break;          case 5: bp = ws + OW_ACTC; nb = 64 * MiB; break;
        case 6: bp = ws + OW_ACTB; nb = 64 * MiB; break;          case 7: bp = ws + OW_ACTC; nb = 64 * MiB; break;
        case 8: bp = (const unsigned char*)c.out; nb = 128 * MiB; break;   case 9: bp = ws + OM_GATE; nb = NA * 4; break;
        case 10: bp = ws + OW_Y; nb = 128 * MiB; break;           case 11: bp = (const unsigned char*)c.out; nb = 128 * MiB; break;
        case 12: bp = ws + OW_BTM; nb = 128 * MiB; break;         case 13: bp = ws + OW_QKR; nb = 224 * MiB; break;
        case 14: bp = ws + OW_ATT; nb = 64 * MiB; break;          case 15: bp = ws + OW_UT; nb = 32 * MiB; break;
        case 16: bp = ws + OW_SP; nb = 32 * MiB; break;           case 17: bp = ws + OW_O; nb = 64 * MiB; break;
        case 18: bp = ws + OW_GO; nb = 64 * MiB; break;           case 19: bp = (const unsigned char*)c.out; nb = 128 * MiB; break;
        case 20: bp = ws + OW_ACTA; nb = 64 * MiB; break;         case 21: bp = ws + OW_ACTB; nb = 64 * MiB; break;
        case 22: bp = ws + OW_ACTC; nb = 64 * MiB; break;         case 23: bp = (const unsigned char*)c.out; nb = 128 * MiB; break;
        case 24: bp = ws + OM_GATE; nb = NA * 4; break;           case 25: bp = ws + OW_Y; nb = 128 * MiB; break;
        case 26: bp = ws + OW_RS; nb = T * 4; break;              case 27: bp = ws + OW_ALR; nb = 2 * MiB; break;
        default: bp = ws + OW_SSP; nb = 2 * MiB; break; }
        csum2_phase(bp, nb, (unsigned long long*)(ws + OW_DBG + 65536) + (size_t)l * 512, (unsigned*)(ws + OW_DBG) + l, lds); } break;
    case PH_FLAGOUT: flagout_phase(c.out, (unsigned*)(ws + OW_DBG)); break;
    case PH_GLA_OUT: { g8::DenseSched S{4, 128 * 4, D, D, D, GOB, WGO}; g8::gemm_phase(lds, S, g8::EpiXres{c.out, c.out, XB, nullptr, SSP}); } break;
    }
}
template <int PH> __global__ void __launch_bounds__(512, 2) k_opt(Ctx c, int l) {
    extern __shared__ __attribute__((aligned(16))) unsigned char dynlds[];
    run_phase(c, PH, l, (LAS unsigned char*)dynlds);
}
#ifndef ALLCG
#define ALLCG 0
#endif
#ifndef COOP
#define COOP 1
#endif
enum Op { OP_MEMN = 0, OP_MEMKV, OP_COPYX, OP_RMS_MIX, OP_CONV_IN, OP_GLU, OP_DWCONV, OP_CONV_OUT, OP_GLA_IN, OP_GLA_DECAY, OP_GLA_REC, OP_GLA_NORM, OP_GLA_OUT,
          OP_RMS_XA, OP_XA_Q, OP_XA_ATT, OP_XA_O, OP_RMS_FFN, OP_ROUTE, OP_BUILD, OP_MOE_GATE, OP_MOE_UP, OP_MOE_ACT, OP_MOE_DOWN, OP_MOE_COMBINE, OP_FINAL };

__device__ __forceinline__ void run_op(const Ctx& c, int op, int l, float* sm) {
    unsigned char* ws = c.ws;
    float* HN = (float*)(ws + WS_HN); float* BIG = (float*)(ws + WS_BIG);
    float* MEMN = (float*)(ws + WS_MEMN); float* KV = (float*)(ws + WS_KV) + (size_t)l * 1024 * 2048;
    int* eid = (int*)(ws + WS_EID); float* gate = (float*)(ws + WS_GATE); int* pos = (int*)(ws + WS_POS);
    int* slot_tok = (int*)(ws + WS_SLOTTOK); int* slot_a = (int*)(ws + WS_SLOTA); int* tile_e = (int*)(ws + WS_TILEE); int* cnt = (int*)(ws + WS_CNT);
    float* X = c.out;
    switch (op) {
    case OP_MEMN: n_rms(c.in[1], c.in[5], MEMN, NB * NMEM); break;
    case OP_MEMKV: n_gemm(sm, MEMN, D, nullptr, c.in[21] + (size_t)l * D * 2048, 2048, 0, nullptr, NB * NMEM, 2048, D, EpiStore{KV, 2048, nullptr}); break;
    case OP_COPYX: n_copy4(c.in[0], X, (size_t)T * D / 4); break;
    case OP_RMS_MIX: n_rms(X, c.in[2] + l * D, HN, T); break;
    case OP_CONV_IN: n_gemm(sm, HN, D, nullptr, c.in[7], 2048, 0, nullptr, T, 2048, D, EpiStore{BIG, 2048, c.in[8]}); break;
    case OP_GLU: n_glu(BIG, HN); break;
    case OP_DWCONV: n_dwconv(HN, c.in[9], c.in[10], c.in[11], c.in[12], BIG); break;
    case OP_CONV_OUT: n_gemm(sm, BIG, D, nullptr, c.in[13], D, 0, nullptr, T, D, D, EpiResid{X, D, c.in[14]}); break;
    case OP_GLA_IN: n_gemm(sm, HN, D, nullptr, c.in[15], GLA_COLS, 0, nullptr, T, GLA_COLS, D, EpiStore{BIG, GLA_COLS, nullptr}); break;
    case OP_GLA_DECAY: n_gla_decay(BIG, c.in[16], c.in[17], HN); break;
    case OP_GLA_REC: n_gla_rec(BIG, HN); break;
    case OP_GLA_NORM: n_gla_norm(BIG, c.in[18], HN); break;
    case OP_GLA_OUT: n_gemm(sm, HN, D, nullptr, c.in[19], D, 0, nullptr, T, D, D, EpiResid{X, D, nullptr}); break;
    case OP_RMS_XA: n_rms(X, c.in[3] + l * D, HN, T); break;
    case OP_XA_Q: n_gemm(sm, HN, D, nullptr, c.in[20] + (size_t)l * D * D, D, 0, nullptr, T, D, D, EpiStore{BIG, D, nullptr}); break;
    case OP_XA_ATT: n_attn(BIG, KV, BIG + (size_t)T * D); break;
    case OP_XA_O: n_gemm(sm, BIG + (size_t)T * D, D, nullptr, c.in[22] + (size_t)l * D * D, D, 0, nullptr, T, D, D, EpiResid{X, D, nullptr}); break;
    case OP_RMS_FFN: n_rms(X, c.in[4] + l * D, HN, T); n_moe_init(cnt, slot_tok, slot_a, tile_e); break;
    case OP_ROUTE: n_route(HN, c.in[23] + (size_t)l * D * NG, c.in[24] + l * NG, c.in[25] + (size_t)l * D * NE, c.in[26] + l * NE, eid, gate, pos, cnt); break;
    case OP_BUILD: n_moe_build(eid, pos, cnt, slot_tok, slot_a, tile_e); break;
    case OP_MOE_GATE: n_gemm(sm, HN, D, slot_tok, c.in[27] + (size_t)l * NE * D * DE, DE, (size_t)D * DE, tile_e, NSLOT, DE, D, EpiStore{BIG, DE, nullptr}); break;
    case OP_MOE_UP: n_gemm(sm, HN, D, slot_tok, c.in[28] + (size_t)l * NE * D * DE, DE, (size_t)D * DE, tile_e, NSLOT, DE, D, EpiStore{BIG + (size_t)NSLOT * DE, DE, nullptr}); break;
    case OP_MOE_ACT: n_moe_act(BIG, BIG + (size_t)NSLOT * DE); break;
    case OP_MOE_DOWN: n_gemm(sm, BIG, DE, nullptr, c.in[29] + (size_t)l * NE * DE * D, D, (size_t)DE * D, tile_e, NSLOT, D, DE, EpiMoeDown{BIG + (size_t)NSLOT * DE, slot_a, gate}); break;
    case OP_MOE_COMBINE: n_moe_combine(X, BIG + (size_t)NSLOT * DE); break;
    case OP_FINAL: n_rms(X, c.in[6], X, T); break;
    }
}

template <int OP> __global__ void __launch_bounds__(512) k_stage(Ctx c, int l) {
    __shared__ float sm[16 * 132 + 16 * 260];
    run_op(c, OP, l, sm);
}
typedef void (*StageFn)(Ctx, int);
template <int... I> struct Seq {};
template <int N, int... I> struct MkSeq : MkSeq<N - 1, N - 1, I...> {};
template <int... I> struct MkSeq<0, I...> { typedef Seq<I...> type; };
template <int... I> static void fill_tab(StageFn* t, Seq<I...>) { StageFn f[] = {k_stage<I>...}; for (unsigned i = 0; i < sizeof...(I); ++i) t[i] = f[i]; }
template <int... I> static void fill_tab_opt(StageFn* t, Seq<I...>) { StageFn f[] = {k_opt<I>...}; for (unsigned i = 0; i < sizeof...(I); ++i) t[i] = f[i]; }

#define XB_TMO      128
#define XB_XCNT(j)  (256  + 64 * (j))
#define XB_XSUB(j)  (1280 + 64 * (j))
#define XB_XGEN(j)  (2304 + 64 * (j))
#define XB_TOP      3328
#define XB_TOPGEN   3392
#define XCD_BAR_WORDS 3456
#define XB_SPIN_CAP (1u << 18)
__device__ __forceinline__ unsigned xb_ld(unsigned* p)              { return __hip_atomic_load(p, __ATOMIC_RELAXED, __HIP_MEMORY_SCOPE_AGENT); }
__device__ __forceinline__ unsigned xb_add(unsigned* p, unsigned v) { return __hip_atomic_fetch_add(p, v, __ATOMIC_RELAXED, __HIP_MEMORY_SCOPE_AGENT); }
__device__ __forceinline__ unsigned xb_xcc_id() { return (unsigned)__builtin_amdgcn_s_getreg((3 << 11) | 20) & 0xFu; }
#define XB_SPIN(cond, bar) do { unsigned _sp = 0; while (cond) { __builtin_amdgcn_s_sleep(1); \
    if ((++_sp & 255u) == 0u) { if (xb_ld(&(bar)[XB_TMO])) break; if (_sp > XB_SPIN_CAP) { atomicAdd(&(bar)[XB_TMO], 1u); break; } } } } while (0)
struct XcdBarrier { unsigned* bar; unsigned x; volatile LAS unsigned* st; };
__device__ __forceinline__ XcdBarrier xcd_barrier_post(unsigned* bar, volatile LAS unsigned* st) {
    XcdBarrier b; b.bar = bar; b.x = xb_xcc_id(); b.st = st;
    if (threadIdx.x == 0) (void)xb_add(&bar[XB_XCNT(b.x)], 1u);
    return b;
}
__device__ __forceinline__ void xcd_barrier_complete(unsigned* bar, unsigned x, unsigned& nloc, unsigned& nx) {
    const unsigned G = gridDim.x * gridDim.y * gridDim.z;
    unsigned sum, cnt, mine, sp = 0u;
    for (;;) {
        sum = 0u; cnt = 0u; mine = 0u;
#pragma unroll
        for (unsigned j = 0; j < 16; ++j) { const unsigned c = xb_ld(&bar[XB_XCNT(j)]); sum += c; cnt += (c > 0u) ? 1u : 0u; mine = (j == x) ? c : mine; }
        if (sum == G) break;
        __builtin_amdgcn_s_sleep(1);
        if ((++sp & 255u) == 0u) { if (xb_ld(&bar[XB_TMO])) break; if (sp > XB_SPIN_CAP) { atomicAdd(&bar[XB_TMO], 1u); break; } }
    }
    nloc = mine > 0u ? mine : 1u; nx = cnt > 0u ? cnt : 1u;
}
__device__ __forceinline__ void xcd_barrier(const XcdBarrier& b) {
    asm volatile("s_waitcnt vmcnt(0)" ::: "memory");
    __syncthreads();
    if (threadIdx.x == 0) {
        unsigned* bar = b.bar;
        __builtin_amdgcn_s_waitcnt(0);
        unsigned nloc = b.st[0], nx = b.st[1];
        if (nloc == 0u) { xcd_barrier_complete(bar, b.x, nloc, nx); b.st[0] = nloc; b.st[1] = nx; }
        __builtin_amdgcn_fence(__ATOMIC_RELEASE, "agent");
        asm volatile("s_waitcnt vmcnt(0)" ::: "memory");
        const unsigned old = xb_add(&bar[XB_XSUB(b.x)], 1u);
        const unsigned gen = old / nloc;
        if (old + 1u == (gen + 1u) * nloc) {
            const unsigned og = xb_add(&bar[XB_TOP], 1u);
            const unsigned tg = og / nx;
            if (og + 1u == (tg + 1u) * nx) xb_add(&bar[XB_TOPGEN], 1u);
            else XB_SPIN(xb_ld(&bar[XB_TOPGEN]) == tg, bar);
            __builtin_amdgcn_fence(__ATOMIC_ACQUIRE, "agent");
            xb_add(&bar[XB_XGEN(b.x)], 1u);
            asm volatile("s_waitcnt vmcnt(0)" ::: "memory");
        } else {
            XB_SPIN(xb_ld(&bar[XB_XGEN(b.x)]) == gen, bar);
            __builtin_amdgcn_fence(__ATOMIC_ACQUIRE, "agent");
            asm volatile("s_waitcnt vmcnt(0)" ::: "memory");
        }
    }
    __syncthreads();
}
template <int CODE> __device__ __forceinline__ void coop_step(const Ctx& c, LAS unsigned char* lds, cg::grid_group& grid, XcdBarrier& xb, bool sync_after, bool first) {
    run_phase(c, CODE >> 5, CODE & 31, lds);
    if (sync_after) {
        if (first || ALLCG) {
            unsigned* bar = (unsigned*)(c.ws + OW_BAR);
            if (first && blockIdx.x == 0) for (int i = threadIdx.x; i < XCD_BAR_WORDS; i += 512) bar[i] = 0u;
            asm volatile("s_waitcnt vmcnt(0) lgkmcnt(0)" ::: "memory");
            grid.sync();
            if (threadIdx.x < 64) { __builtin_amdgcn_fence(__ATOMIC_ACQUIRE, "agent"); asm volatile("s_waitcnt vmcnt(0)" ::: "memory"); }
            __syncthreads();
            if (first) xb = xcd_barrier_post(bar, xb.st);
        } else xcd_barrier(xb);
    }
}
template <int... CODES> __global__ void __launch_bounds__(512, 2) k_coop(Ctx c) {
    extern __shared__ __attribute__((aligned(16))) unsigned char dynlds[];
    cg::grid_group grid = cg::this_grid();
    LAS unsigned char* lds = (LAS unsigned char*)dynlds;
    volatile LAS unsigned* st = (volatile LAS unsigned*)(lds + LDS_BYTES - 16);
    if (threadIdx.x < 4) st[threadIdx.x] = 0u;
    __syncthreads();
    XcdBarrier xb; xb.bar = nullptr; xb.x = 0; xb.st = st;
    int idx = 0; constexpr int N = sizeof...(CODES);
    ((coop_step<CODES>(c, lds, grid, xb, idx + 1 < N, idx == 0), ++idx), ...);
}
#define CODE(ph, l) ((ph) * 32 + (l))
typedef void (*CoopFn)(Ctx);
struct Step { int kind, op, l; };
static const Step g_prog[] = { {1, 0, 0} };
constexpr int NSTEP = sizeof(g_prog) / sizeof(g_prog[0]);

extern "C" void kernel_launch(void* const* d_in, const int* in_sizes, int n_in, void* d_out, int out_size, void* d_ws, size_t ws_size, hipStream_t stream) {
    if (n_in != 30 || out_size != T * D || ws_size < OW_END || ws_size < WS_END) { fprintf(stderr, "kernel_launch: bad args n_in %d out %d ws %zu\n", n_in, out_size, ws_size); return; }
    Ctx c; memset(&c, 0, sizeof(c));
    for (int i = 0; i < 30; ++i) c.in[i] = (const float*)d_in[i];
    c.out = (float*)d_out; c.ws = (unsigned char*)d_ws;
    static StageFn tab[OP_FINAL + 1], tabo[PH_N];
    static bool init = false;
    if (!init) { fill_tab(tab, MkSeq<OP_FINAL + 1>::type()); fill_tab_opt(tabo, MkSeq<PH_N>::type());
        for (int i = 0; i < PH_N; ++i) hipFuncSetAttribute((const void*)tabo[i], hipFuncAttributeMaxDynamicSharedMemorySize, LDS_BYTES);
        init = true; }
#if COOP
    static int coop_grid = 0;
    static CoopFn coop_fns[2] = { k_coop<CODE(PH_PREP0, 0), CODE(PH_CONV_IN, 0), CODE(PH_CONV_MID, 0), CODE(PH_CONV_OUT, 0), CODE(PH_XA_PREP, 0), CODE(PH_XA_Q, 0), CODE(PH_XA_KV, 0), CODE(PH_XA_S, 0), CODE(PH_XA_PV, 0), CODE(PH_XA_O, 0),
                                         CODE(PH_ROUTE_PREP, 0), CODE(PH_ROUTE, 0), CODE(PH_BUILD, 0), CODE(PH_MOE1, 0), CODE(PH_MOE2, 0), CODE(PH_GLA_PREP, 0), CODE(PH_COMBINE, 0),
                                         CODE(PH_GLA_DECAY, 0), CODE(PH_GLA_IN, 0), CODE(PH_GLA_ATT, 0), CODE(PH_GLA_UT, 0), CODE(PH_GLA_SCAN, 0), CODE(PH_GLA_O, 0), CODE(PH_GLA_FIN, 0), CODE(PH_GLA_OUT, 0),
                                         CODE(PH_XA_PREP, 1), CODE(PH_XA_Q, 1), CODE(PH_XA_KV, 1), CODE(PH_XA_S, 1), CODE(PH_XA_PV, 1), CODE(PH_XA_O, 1),
                                         CODE(PH_ROUTE_PREP, 1), CODE(PH_ROUTE, 1), CODE(PH_BUILD, 1), CODE(PH_MOE1, 1), CODE(PH_MOE2, 1), CODE(PH_COMBINE_FIN, 1)>, nullptr };
    if (!coop_grid) { int dev = 0, cus = 0, per_cu = 0; hipGetDevice(&dev); hipDeviceGetAttribute(&cus, hipDeviceAttributeMultiprocessorCount, dev);
        for (int k = 0; k < 1; ++k) hipFuncSetAttribute((const void*)coop_fns[k], hipFuncAttributeMaxDynamicSharedMemorySize, LDS_BYTES);
        hipOccupancyMaxActiveBlocksPerMultiprocessor(&per_cu, coop_fns[0], 512, LDS_BYTES);
        coop_grid = cus * (per_cu < 1 ? 1 : per_cu); if (coop_grid > 256) coop_grid = 256;
        fprintf(stderr, "kernel_launch: cus %d per_cu %d grid %d\n", cus, per_cu, coop_grid); }
    int ncoop = 0;
#endif
    for (int i = 0; i < NSTEP; ++i) {
        if (g_prog[i].kind == 0) { hipLaunchKernelGGL(tab[g_prog[i].op], dim3(1024), dim3(512), 0, stream, c, g_prog[i].l); continue; }
#if COOP
        while (i < NSTEP && g_prog[i].kind == 1) ++i;
        --i;
        void* args[] = {&c};
        hipError_t e = hipLaunchCooperativeKernel((void*)coop_fns[ncoop++], dim3(coop_grid), dim3(512), args, LDS_BYTES, stream);
        if (e != hipSuccess) fprintf(stderr, "cooperative launch failed: %s\n", hipGetErrorString(e));
#else
        hipLaunchKernelGGL(tabo[g_prog[i].op], dim3(256), dim3(512), LDS_BYTES, stream, c, g_prog[i].l);
#endif
    }
}
```

```cpp
#include <hip/hip_runtime.h>
#include <hip/hip_cooperative_groups.h>
#include <cstdio>
#include <cstring>
namespace cg = cooperative_groups;

#ifndef MEGA
#define MEGA 0
#endif

constexpr int D = 1024, NB = 4, S = 8192, T = NB * S, NMEM = 256, DEPTH = 2;
constexpr int CONVK = 31;
constexpr int GH = 4, GDK = 512, GDV = 1024, GDKH = 128, GDVH = 256, GRANK = 16, GLA_COLS = 3088;
constexpr int XH = 4, XHD = 256;
constexpr int NG = 4, EPG = 8, NE = 32, DE = 512;
constexpr int NA = T * 2;
constexpr int NSLOT = NA + NE * 128;
constexpr float EPS = 1e-6f;

constexpr size_t MiB = 1u << 20;
constexpr size_t WS_HN = 0;
constexpr size_t WS_BIG = 128 * MiB;
constexpr size_t WS_SMALL = 528 * MiB;
constexpr size_t WS_MEMN = WS_SMALL;
constexpr size_t WS_KV = WS_MEMN + 4 * MiB;
constexpr size_t WS_EID = WS_KV + 16 * MiB;
constexpr size_t WS_GATE = WS_EID + NA * 4;
constexpr size_t WS_POS = WS_GATE + NA * 4;
constexpr size_t WS_SLOTTOK = WS_POS + NA * 4;
constexpr size_t WS_SLOTA = WS_SLOTTOK + NSLOT * 4;
constexpr size_t WS_TILEE = WS_SLOTA + NSLOT * 4;
constexpr size_t WS_CNT = WS_TILEE + 4096;
constexpr size_t WS_END = WS_CNT + 4096;

struct Ctx {
    const float* in[30];
    float* out;
    unsigned char* ws;
};

__device__ __forceinline__ float wave_sum(float v) {
#pragma unroll
    for (int o = 1; o < 64; o <<= 1) v += __shfl_xor(v, o);
    return v;
}
__device__ __forceinline__ float wave_max(float v) {
#pragma unroll
    for (int o = 1; o < 64; o <<= 1) v = fmaxf(v, __shfl_xor(v, o));
    return v;
}
__device__ __forceinline__ float sigmoidf_(float x) { return 1.0f / (1.0f + expf(-x)); }
__device__ __forceinline__ float siluf_(float x) { return x / (1.0f + expf(-x)); }

__device__ void n_rms(const float* x, const float* g, float* out, int rows) {
    const int lane = threadIdx.x & 63;
    const int gw = (blockIdx.x * blockDim.x + threadIdx.x) >> 6, ngw = (gridDim.x * blockDim.x) >> 6;
    for (int r = gw; r < rows; r += ngw) {
        const float4* xr = (const float4*)(x + (size_t)r * D);
        float4 v[4]; float s = 0.f;
#pragma unroll
        for (int j = 0; j < 4; ++j) { v[j] = xr[lane + 64 * j]; s += v[j].x * v[j].x + v[j].y * v[j].y + v[j].z * v[j].z + v[j].w * v[j].w; }
        s = wave_sum(s);
        const float rs = rsqrtf(s * (1.0f / D) + EPS);
        float4* o = (float4*)(out + (size_t)r * D);
#pragma unroll
        for (int j = 0; j < 4; ++j) { const float4 gg = ((const float4*)g)[lane + 64 * j];
            o[lane + 64 * j] = make_float4(v[j].x * rs * gg.x, v[j].y * rs * gg.y, v[j].z * rs * gg.z, v[j].w * rs * gg.w); }
    }
}
__device__ void n_copy4(const float* src, float* dst, size_t n4) {
    const size_t g = (size_t)blockIdx.x * blockDim.x + threadIdx.x, gs = (size_t)gridDim.x * blockDim.x;
    for (size_t i = g; i < n4; i += gs) ((float4*)dst)[i] = ((const float4*)src)[i];
}

struct EpiStore { float* C; int ldc; const float* bias;
    __device__ __forceinline__ void operator()(int m, int n, float acc) const { C[(size_t)m * ldc + n] = acc + (bias ? bias[n] : 0.f); } };
struct EpiResid { float* X; int ldc; const float* bias;
    __device__ __forceinline__ void operator()(int m, int n, float acc) const { X[(size_t)m * ldc + n] += acc + (bias ? bias[n] : 0.f); } };
struct EpiMoeDown { float* Y; const int* slot_a; const float* gate;
    __device__ __forceinline__ void operator()(int m, int n, float acc) const { const int a = slot_a[m]; if (a >= 0) Y[(size_t)a * D + n] = acc * gate[a]; } };

template <class Epi>
__device__ void n_gemm(float* sm, const float* A, int lda, const int* arow, const float* W, int ldw, size_t wstride, const int* tile_e,
                       int M, int N, int K, Epi epi) {
    float* As = sm;
    float* Bs = sm + 16 * 132;
    const int tid = threadIdx.x, ty = tid >> 5, tx = tid & 31;
    const int ntm = M / 128, ntn = (N + 255) / 256;
    for (int tile = blockIdx.x; tile < ntm * ntn; tile += gridDim.x) {
        const int mt = tile / ntn, nt = tile % ntn;
        const float* Wb = W;
        if (tile_e) { const int e = tile_e[mt]; if (e < 0) continue; Wb = W + (size_t)e * wstride; }
        const int m0 = mt * 128, n0 = nt * 256;
        float acc[8][8];
#pragma unroll
        for (int i = 0; i < 8; ++i)
#pragma unroll
            for (int j = 0; j < 8; ++j) acc[i][j] = 0.f;
        const int ar = tid >> 2, akq = (tid & 3) * 4;
        const int srow = arow ? arow[m0 + ar] : (m0 + ar);
        const float* ap = srow >= 0 ? A + (size_t)srow * lda : nullptr;
        const int bk = tid >> 6, bn = (tid & 63) * 4;
        for (int k0 = 0; k0 < K; k0 += 16) {
            float4 av = ap ? *(const float4*)(ap + k0 + akq) : make_float4(0.f, 0.f, 0.f, 0.f);
            As[(akq + 0) * 132 + ar] = av.x; As[(akq + 1) * 132 + ar] = av.y; As[(akq + 2) * 132 + ar] = av.z; As[(akq + 3) * 132 + ar] = av.w;
#pragma unroll
            for (int i = 0; i < 2; ++i) {
                const int kk = bk + 8 * i; const int n = n0 + bn;
                float4 bv = (n < N) ? *(const float4*)(Wb + (size_t)(k0 + kk) * ldw + n) : make_float4(0.f, 0.f, 0.f, 0.f);
                *(float4*)(Bs + kk * 260 + bn) = bv;
            }
            __syncthreads();
#pragma unroll
            for (int kk = 0; kk < 16; ++kk) {
                float a[8], b[8];
                *(float4*)(a) = *(const float4*)(As + kk * 132 + ty * 8); *(float4*)(a + 4) = *(const float4*)(As + kk * 132 + ty * 8 + 4);
                *(float4*)(b) = *(const float4*)(Bs + kk * 260 + tx * 8); *(float4*)(b + 4) = *(const float4*)(Bs + kk * 260 + tx * 8 + 4);
#pragma unroll
                for (int i = 0; i < 8; ++i)
#pragma unroll
                    for (int j = 0; j < 8; ++j) acc[i][j] = fmaf(a[i], b[j], acc[i][j]);
            }
            __syncthreads();
        }
#pragma unroll
        for (int i = 0; i < 8; ++i)
#pragma unroll
            for (int j = 0; j < 8; ++j) { const int m = m0 + ty * 8 + i, n = n0 + tx * 8 + j; if (n < N) epi(m, n, acc[i][j]); }
    }
}

__device__ void n_glu(const float* u, float* g) {
    const size_t gi = (size_t)blockIdx.x * blockDim.x + threadIdx.x, gs = (size_t)gridDim.x * blockDim.x;
    for (size_t i = gi; i < (size_t)T * D; i += gs) { const size_t t = i >> 10, c = i & 1023; g[i] = u[t * 2048 + c] * sigmoidf_(u[t * 2048 + 1024 + c]); }
}
__device__ void n_dwconv(const float* g, const float* wdw, const float* bdw, const float* lng, const float* lnb, float* out) {
    const int lane = threadIdx.x & 63;
    const int gw = (blockIdx.x * blockDim.x + threadIdx.x) >> 6, ngw = (gridDim.x * blockDim.x) >> 6;
    for (int t = gw; t < T; t += ngw) {
        const int s = t % S;
        float4 acc[4];
#pragma unroll
        for (int j = 0; j < 4; ++j) acc[j] = ((const float4*)bdw)[lane + 64 * j];
        for (int tap = 0; tap < CONVK; ++tap) {
            const int ss = s - (CONVK - 1) + tap; if (ss < 0) continue;
            const float4* gr = (const float4*)(g + (size_t)(t - (CONVK - 1) + tap) * D);
            const float4* wr = (const float4*)(wdw + (size_t)tap * D);
#pragma unroll
            for (int j = 0; j < 4; ++j) { const float4 a = gr[lane + 64 * j], w = wr[lane + 64 * j];
                acc[j].x = fmaf(a.x, w.x, acc[j].x); acc[j].y = fmaf(a.y, w.y, acc[j].y); acc[j].z = fmaf(a.z, w.z, acc[j].z); acc[j].w = fmaf(a.w, w.w, acc[j].w); }
        }
        float sm_ = 0.f;
#pragma unroll
        for (int j = 0; j < 4; ++j) sm_ += acc[j].x + acc[j].y + acc[j].z + acc[j].w;
        const float mu = wave_sum(sm_) * (1.0f / D);
        float q = 0.f;
#pragma unroll
        for (int j = 0; j < 4; ++j) { acc[j].x -= mu; acc[j].y -= mu; acc[j].z -= mu; acc[j].w -= mu; q += acc[j].x * acc[j].x + acc[j].y * acc[j].y + acc[j].z * acc[j].z + acc[j].w * acc[j].w; }
        const float rstd = rsqrtf(wave_sum(q) * (1.0f / D) + EPS);
        float4* o = (float4*)(out + (size_t)t * D);
#pragma unroll
        for (int j = 0; j < 4; ++j) { const float4 gg = ((const float4*)lng)[lane + 64 * j], bb = ((const float4*)lnb)[lane + 64 * j];
            o[lane + 64 * j] = make_float4(siluf_(acc[j].x * rstd * gg.x + bb.x), siluf_(acc[j].y * rstd * gg.y + bb.y), siluf_(acc[j].z * rstd * gg.z + bb.z), siluf_(acc[j].w * rstd * gg.w + bb.w)); }
    }
}
__device__ void n_attn(const float* q, const float* kv, float* o) {
    const int lane = threadIdx.x & 63;
    const int gw = (blockIdx.x * blockDim.x + threadIdx.x) >> 6, ngw = (gridDim.x * blockDim.x) >> 6;
    for (int it = gw; it < T * XH; it += ngw) {
        const int t = it >> 2, h = it & 3, b = t / S;
        const float4 qv = ((const float4*)(q + (size_t)t * D + h * XHD))[lane];
        const float* kb = kv + (size_t)b * NMEM * 2048 + h * XHD;
        float sc[4];
#pragma unroll
        for (int m4 = 0; m4 < 4; ++m4) {
            float mine = 0.f;
            for (int ml = 0; ml < 64; ++ml) {
                const float4 kk = ((const float4*)(kb + (size_t)(m4 * 64 + ml) * 2048))[lane];
                float p = qv.x * kk.x + qv.y * kk.y + qv.z * kk.z + qv.w * kk.w;
                p = wave_sum(p);
                if (ml == lane) mine = p;
            }
            sc[m4] = mine * 0.0625f;
        }
        float mx = fmaxf(fmaxf(sc[0], sc[1]), fmaxf(sc[2], sc[3])); mx = wave_max(mx);
        float se = 0.f;
#pragma unroll
        for (int m4 = 0; m4 < 4; ++m4) { sc[m4] = expf(sc[m4] - mx); se += sc[m4]; }
        se = wave_sum(se); const float inv = 1.0f / se;
        float4 acc = make_float4(0.f, 0.f, 0.f, 0.f);
        const float* vb = kb + 1024;
#pragma unroll
        for (int m4 = 0; m4 < 4; ++m4)
            for (int ml = 0; ml < 64; ++ml) {
                const float p = __shfl(sc[m4], ml) * inv;
                const float4 vv = ((const float4*)(vb + (size_t)(m4 * 64 + ml) * 2048))[lane];
                acc.x = fmaf(p, vv.x, acc.x); acc.y = fmaf(p, vv.y, acc.y); acc.z = fmaf(p, vv.z, acc.z); acc.w = fmaf(p, vv.w, acc.w);
            }
        ((float4*)(o + (size_t)t * D + h * XHD))[lane] = acc;
    }
}
__device__ void n_moe_init(int* cnt, int* slot_tok, int* slot_a, int* tile_e) {
    const int gi = blockIdx.x * blockDim.x + threadIdx.x, gs = gridDim.x * blockDim.x;
    for (int i = gi; i < NSLOT; i += gs) { slot_tok[i] = -1; slot_a[i] = -1; }
    for (int i = gi; i < NSLOT / 128; i += gs) tile_e[i] = -1;
    if (gi < 32) cnt[gi] = 0;
}
__device__ void n_route(const float* h, const float* wg, const float* bg, const float* we, const float* be, int* eid, float* gate, int* pos, int* cnt) {
    const int lane = threadIdx.x & 63;
    const int gw = (blockIdx.x * blockDim.x + threadIdx.x) >> 6, ngw = (gridDim.x * blockDim.x) >> 6;
    for (int t = gw; t < T; t += ngw) {
        float hv[16];
#pragma unroll
        for (int j = 0; j < 16; ++j) hv[j] = h[(size_t)t * D + j * 64 + lane];
        float gl[4];
#pragma unroll
        for (int o = 0; o < 4; ++o) { float p = 0.f;
#pragma unroll
            for (int j = 0; j < 16; ++j) p = fmaf(hv[j], wg[(size_t)(j * 64 + lane) * NG + o], p);
            gl[o] = wave_sum(p) + bg[o]; }
        int gs = 0; float gm = gl[0];
#pragma unroll
        for (int o = 1; o < 4; ++o) if (gl[o] > gm) { gm = gl[o]; gs = o; }
        float se = 0.f;
#pragma unroll
        for (int o = 0; o < 4; ++o) se += expf(gl[o] - gm);
        const float pg = 1.0f / se;
        float el[8];
#pragma unroll
        for (int o = 0; o < 8; ++o) { float p = 0.f;
#pragma unroll
            for (int j = 0; j < 16; ++j) p = fmaf(hv[j], we[(size_t)(j * 64 + lane) * NE + gs * 8 + o], p);
            el[o] = wave_sum(p) + be[gs * 8 + o]; }
        float em = el[0];
#pragma unroll
        for (int o = 1; o < 8; ++o) em = fmaxf(em, el[o]);
        float pe[8], ps = 0.f;
#pragma unroll
        for (int o = 0; o < 8; ++o) { pe[o] = expf(el[o] - em); ps += pe[o]; }
#pragma unroll
        for (int o = 0; o < 8; ++o) pe[o] = pe[o] / ps;
        int i1 = 0; float p1 = pe[0];
#pragma unroll
        for (int o = 1; o < 8; ++o) if (pe[o] > p1) { p1 = pe[o]; i1 = o; }
        int i2 = -1; float p2 = -1.f;
#pragma unroll
        for (int o = 0; o < 8; ++o) if (o != i1 && pe[o] > p2) { p2 = pe[o]; i2 = o; }
        if (lane == 0) {
            const float den = p1 + p2;
            const int e1 = gs * 8 + i1, e2 = gs * 8 + i2;
            eid[2 * t] = e1; eid[2 * t + 1] = e2;
            gate[2 * t] = pg * p1 / den; gate[2 * t + 1] = pg * p2 / den;
            pos[2 * t] = atomicAdd(&cnt[e1], 1); pos[2 * t + 1] = atomicAdd(&cnt[e2], 1);
        }
    }
}
__device__ void n_moe_build(const int* eid, const int* pos, const int* cnt, int* slot_tok, int* slot_a, int* tile_e) {
    __shared__ int poff[33];
    if (threadIdx.x == 0) { int o = 0; for (int e = 0; e < 32; ++e) { poff[e] = o; o += (cnt[e] + 127) / 128 * 128; } poff[32] = o; }
    __syncthreads();
    const int gi = blockIdx.x * blockDim.x + threadIdx.x, gs = gridDim.x * blockDim.x;
    for (int a = gi; a < NA; a += gs) { const int e = eid[a]; const int sl = poff[e] + pos[a]; slot_tok[sl] = a >> 1; slot_a[sl] = a; }
    for (int mt = gi; mt < NSLOT / 128; mt += gs) { const int r = mt * 128; int e = -1; for (int k = 0; k < 32; ++k) if (r >= poff[k] && r < poff[k + 1]) e = k; tile_e[mt] = e; }
    __syncthreads();
}
__device__ void n_moe_act(float* g, const float* u) {
    const size_t gi = (size_t)blockIdx.x * blockDim.x + threadIdx.x, gs = (size_t)gridDim.x * blockDim.x;
    for (size_t i = gi; i < (size_t)NSLOT * DE / 4; i += gs) { float4 a = ((float4*)g)[i]; const float4 b = ((const float4*)u)[i];
        a.x = siluf_(a.x) * b.x; a.y = siluf_(a.y) * b.y; a.z = siluf_(a.z) * b.z; a.w = siluf_(a.w) * b.w; ((float4*)g)[i] = a; }
}
__device__ void n_moe_combine(float* x, const float* y) {
    const size_t gi = (size_t)blockIdx.x * blockDim.x + threadIdx.x, gs = (size_t)gridDim.x * blockDim.x;
    for (size_t i = gi; i < (size_t)T * D / 4; i += gs) { const size_t t = i >> 8, c = i & 255; float4 a = ((float4*)x)[i];
        const float4 y0 = ((const float4*)y)[(2 * t) * 256 + c], y1 = ((const float4*)y)[(2 * t + 1) * 256 + c];
        a.x += y0.x + y1.x; a.y += y0.y + y1.y; a.z += y0.z + y1.z; a.w += y0.w + y1.w; ((float4*)x)[i] = a; }
}
__device__ void n_gla_decay(const float* proj, const float* wa2, const float* ba, float* dec) {
    const size_t gi = (size_t)blockIdx.x * blockDim.x + threadIdx.x, gs = (size_t)gridDim.x * blockDim.x;
    for (size_t i = gi; i < (size_t)T * GDK; i += gs) { const size_t t = i >> 9; const int j = (int)(i & 511);
        float a = ba[j];
#pragma unroll
        for (int r = 0; r < GRANK; ++r) a = fmaf(proj[t * GLA_COLS + 2048 + r], wa2[r * GDK + j], a);
        const float ls = fminf(a, 0.f) - log1pf(expf(-fabsf(a)));
        dec[i] = expf(ls * (1.0f / 16.0f)); }
}
__device__ void n_gla_rec(float* proj, const float* dec) {
    const int gi = blockIdx.x * blockDim.x + threadIdx.x, gs = gridDim.x * blockDim.x;
    for (int it = gi; it < NB * GH * GDVH; it += gs) {
        const int col = it & 255, h = (it >> 8) & 3, b = it >> 10;
        float st[GDKH];
#pragma unroll
        for (int k = 0; k < GDKH; ++k) st[k] = 0.f;
        const float qs = 0.08838834764831845f;
        for (int s = 0; s < S; ++s) {
            const size_t t = (size_t)b * S + s;
            float* pr = proj + t * GLA_COLS;
            const float v = pr[1024 + h * GDVH + col];
            const float* qq = pr + h * GDKH; const float* kk = pr + 512 + h * GDKH; const float* dd = dec + t * GDK + h * GDKH;
            float o = 0.f;
#pragma unroll
            for (int k = 0; k < GDKH; ++k) { st[k] = fmaf(st[k], dd[k], kk[k] * v); o = fmaf(qq[k], st[k], o); }
            pr[1024 + h * GDVH + col] = o * qs;
        }
    }
}
__device__ void n_gla_norm(const float* proj, const float* ng, float* go) {
    const int lane = threadIdx.x & 63;
    const int gw = (blockIdx.x * blockDim.x + threadIdx.x) >> 6, ngw = (gridDim.x * blockDim.x) >> 6;
    for (int it = gw; it < T * GH; it += ngw) {
        const int t = it >> 2, h = it & 3;
        const float4 ov = ((const float4*)(proj + (size_t)t * GLA_COLS + 1024 + h * GDVH))[lane];
        const float4 rv = ((const float4*)(proj + (size_t)t * GLA_COLS + 2064 + h * GDVH))[lane];
        const float4 gg = ((const float4*)ng)[lane];
        float s = ov.x * ov.x + ov.y * ov.y + ov.z * ov.z + ov.w * ov.w; s = wave_sum(s);
        const float rs = rsqrtf(s * (1.0f / GDVH) + EPS);
        ((float4*)(go + (size_t)t * D + h * GDVH))[lane] = make_float4(ov.x * rs * gg.x * siluf_(rv.x), ov.y * rs * gg.y * siluf_(rv.y), ov.z * rs * gg.z * siluf_(rv.z), ov.w * rs * gg.w * siluf_(rv.w));
    }
}

#define LAS __attribute__((address_space(3)))
typedef unsigned short bf16_t;
typedef short bf16x8 __attribute__((ext_vector_type(8)));
typedef float f32x4 __attribute__((ext_vector_type(4)));
typedef float f32x2 __attribute__((ext_vector_type(2)));
typedef unsigned u32x4 __attribute__((ext_vector_type(4)));
typedef unsigned u32x2 __attribute__((ext_vector_type(2)));

constexpr int LDS_BYTES = 160 * 1024;
constexpr int NSLOT2 = NA + NE * 256;
constexpr int MAXRT = NSLOT2 / 256;
constexpr size_t OW_XB = 0;
constexpr size_t OW_SSP = 64 * MiB;
constexpr size_t OW_RS = 66 * MiB;
constexpr size_t OW_PSUM = 67 * MiB;
constexpr size_t OW_MOE = 69 * MiB;
constexpr size_t OW_ACTA = 72 * MiB, OW_ACTB = 136 * MiB, OW_ACTC = 200 * MiB;
constexpr size_t OW_H = 72 * MiB, OW_Y = 144 * MiB, OW_WMOE = 272 * MiB;
constexpr size_t OW_KVB = 368 * MiB;
constexpr size_t OW_MEMNB = 372 * MiB;
constexpr size_t OW_WCIN = 550 * MiB, OW_WCOUT = 554 * MiB, OW_WXQ = 556 * MiB, OW_WXKV = 560 * MiB, OW_WXO = 568 * MiB, OW_WR = 572 * MiB, OW_BAR = 573 * MiB, OW_DBG = 574 * MiB, OW_END = 575 * MiB;
constexpr size_t OW_ATT = 0, OW_QKR = 72 * MiB, OW_KVT = 200 * MiB, OW_BTM = 296 * MiB, OW_O = 296 * MiB, OW_BFM = 360 * MiB, OW_UT = 424 * MiB, OW_SP = 456 * MiB,
                 OW_ALR = 488 * MiB, OW_DL = 490 * MiB, OW_GO = 200 * MiB, OW_WGTM = 492 * MiB, OW_WGFM = 496 * MiB, OW_WGO = 499 * MiB, OW_WA = 501 * MiB;
constexpr size_t OM_GCNT = OW_MOE, OM_NT = OW_MOE + 256, OM_TILEE = OW_MOE + 512, OM_AE = OW_MOE + 4096, OM_APOS = OM_AE + NA * 4, OM_GATE = OM_APOS + NA * 4,
                 OM_STOK = OM_GATE + NA * 4, OM_SA = OM_STOK + NSLOT2 * 4, OM_SRS = OM_SA + NSLOT2 * 4, OM_SGATE = OM_SRS + NSLOT2 * 4, OM_END = OM_SGATE + NSLOT2 * 4;
static_assert(OM_END <= OW_ACTA, "MoE small arrays");

typedef __bf16 bf16x2_t __attribute__((ext_vector_type(2)));
__device__ __forceinline__ unsigned cvt_pk_bf16(float lo, float hi) { const f32x2 v = {lo, hi}; return __builtin_bit_cast(unsigned, __builtin_convertvector(v, bf16x2_t)); }
__device__ __forceinline__ int otid() { int t = threadIdx.x; asm volatile("" : "+v"(t)); return t; }
__device__ __forceinline__ u32x4 pack8(const f32x4& a, const f32x4& b) { u32x4 w; w.x = cvt_pk_bf16(a[0], a[1]); w.y = cvt_pk_bf16(a[2], a[3]); w.z = cvt_pk_bf16(b[0], b[1]); w.w = cvt_pk_bf16(b[2], b[3]); return w; }
__device__ __forceinline__ float bf_lo(unsigned w) { return __uint_as_float(w << 16); }
__device__ __forceinline__ float bf_hi(unsigned w) { return __uint_as_float(w & 0xffff0000u); }
__device__ __forceinline__ float fast_sigmoid(float x) { return __builtin_amdgcn_rcpf(1.0f + __builtin_amdgcn_exp2f(-1.4426950408889634f * x)); }

#ifndef LDS_POISON
#define LDS_POISON 0
#endif
namespace g8 {
constexpr int BM = 256, BK = 64, HALF = 128, HTB = HALF * BK * 2, STAGE_BYTES = 8 * HTB;
__device__ __forceinline__ int lds_byte(int r, int c) { const int st = (r >> 4) * 2 + (c >> 5), rr = r & 15, cc = c & 31, ob = rr * 64 + cc * 2; return st * 1024 + (ob ^ (((ob >> 9) & 1) << 5)); }
__device__ __forceinline__ void stage_rc(int b, int& R, int& C) { const int st = b / 1024, sb = b % 1024, swz = sb ^ (((sb >> 9) & 1) << 5); R = (st >> 1) * 16 + swz / 64; C = (st & 1) * 32 + (swz % 64) / 2; }
__device__ __forceinline__ int perm32(int rho) { const int n = rho >> 4, i = rho & 15; return 8 * (i >> 2) + 4 * n + (i & 3); }
struct Unit { int pm, pn, e; };

template <class Epi, class Sched>
__device__ __forceinline__ void gemm_phase(LAS unsigned char* lds, const Sched& S, const Epi& E) {
    int tid_ = threadIdx.x; asm volatile("" : "+v"(tid_));
    const int tid = tid_, wid = __builtin_amdgcn_readfirstlane(tid >> 6), lane = tid & 63, wr = wid >> 2, wc = wid & 3, fr = lane & 15, fq = lane >> 4;
    const size_t kstep = (size_t)(BK * 2);
    const unsigned ldsw = (unsigned)wid * 1024u;
    const int aoff = lds_byte(wr * 64 + fr, fq * 8), boff = lds_byte(wc * 32 + fr, fq * 8);
#define G8_SA(b, h) (((b) * 2 + (h)) * HTB)
#define G8_SB(b, h) ((4 + (b) * 2 + (h)) * HTB)
#define G8_STAGE(bufoff, gbase, vv) do { _Pragma("unroll") for (int _i = 0; _i < 2; ++_i) \
        __builtin_amdgcn_global_load_lds((const unsigned*)((const char*)(gbase) + (vv)[_i]), (LAS unsigned*)(lds + (bufoff) + ldsw + _i * 8192), 16, 0, 0); } while (0)
#define G8_LDA(dst, b, h) do { _Pragma("unroll") for (int m = 0; m < 4; ++m) _Pragma("unroll") for (int k = 0; k < 2; ++k) dst[m][k] = *(const LAS bf16x8*)(lds + G8_SA(b, h) + aoff + m * 2048 + k * 1024); } while (0)
#define G8_LDB(dst, b, h) do { _Pragma("unroll") for (int n = 0; n < 2; ++n) _Pragma("unroll") for (int k = 0; k < 2; ++k) dst[n][k] = *(const LAS bf16x8*)(lds + G8_SB(b, h) + boff + n * 2048 + k * 1024); } while (0)
#define G8_MMA(ai, bj, At, Bt) do { __builtin_amdgcn_s_setprio(1); _Pragma("unroll") for (int m = 0; m < 4; ++m) _Pragma("unroll") for (int n = 0; n < 2; ++n) _Pragma("unroll") for (int k = 0; k < 2; ++k) \
        acc[ai][bj][m][n] = __builtin_amdgcn_mfma_f32_16x16x32_bf16(Bt[n][k], At[m][k], acc[ai][bj][m][n], 0, 0, 0); __builtin_amdgcn_s_setprio(0); } while (0)
#define G8_WAIT_V(n) asm volatile("s_waitcnt vmcnt(" #n ")" ::: "memory")
#define G8_WAIT_L(n) asm volatile("s_waitcnt lgkmcnt(" #n ")" ::: "memory")
#define G8_BAR __builtin_amdgcn_s_barrier()
#define G8_SCHED __builtin_amdgcn_sched_barrier(0)
#define G8_VA(dst, u) do { const int _ac = S.a_col(u), _lda = S.lda(u); _Pragma("unroll") for (int _i = 0; _i < 2; ++_i) { int _R, _C; stage_rc(tid * 16 + _i * 8192, _R, _C); \
        _Pragma("unroll") for (int _h = 0; _h < 2; ++_h) dst[_h][_i] = (unsigned)(((size_t)S.a_row(u, _h * HALF + _R) * _lda + _ac + _C) * 2); } } while (0)
#define G8_VB(dst, hs, u) do { const int _ldb = S.ldb(u); hs = (size_t)HALF * _ldb * 2; _Pragma("unroll") for (int _i = 0; _i < 2; ++_i) { int _R, _C; stage_rc(tid * 16 + _i * 8192, _R, _C); \
        dst[_i] = (unsigned)(((_R & ~31) + perm32(_R & 31)) * _ldb + _C) * 2u; } } while (0)
    Unit cur, nxt; int ui = 0;
    if (!S.next(0, cur)) return;
#if LDS_POISON
    for (int i = tid; i < STAGE_BYTES / 16; i += 512) ((LAS u32x4*)lds)[i] = (u32x4){0x7fc07fc0u, 0x7fc07fc0u, 0x7fc07fc0u, 0x7fc07fc0u};
    __syncthreads();
#endif
    f32x4 acc[2][2][4][2];
#pragma unroll
    for (int a = 0; a < 2; ++a)
#pragma unroll
        for (int b = 0; b < 2; ++b)
#pragma unroll
            for (int m = 0; m < 4; ++m)
#pragma unroll
                for (int n = 0; n < 2; ++n) acc[a][b][m][n] = (f32x4){0.f, 0.f, 0.f, 0.f};
    bf16x8 At[4][2], B0[2][2], B1[2][2];
    unsigned va[2][2], nva[2][2], vb[2], nvb[2]; size_t hsB, nhsB;
    G8_VA(va, cur); G8_VB(vb, hsB, cur);
    const char* Ab = S.a_base(cur);
    const char* cB = S.b_base(cur);
    G8_STAGE(G8_SB(0, 0), cB, vb); G8_STAGE(G8_SA(0, 0), Ab, va[0]); G8_STAGE(G8_SB(0, 1), cB + hsB, vb); G8_STAGE(G8_SA(0, 1), Ab, va[1]);
    if (wr == 1) G8_BAR;
    G8_WAIT_V(4); G8_BAR;
    G8_STAGE(G8_SB(1, 0), cB + kstep, vb); G8_STAGE(G8_SA(1, 0), Ab + kstep, va[0]); G8_STAGE(G8_SB(1, 1), cB + hsB + kstep, vb);
    G8_WAIT_V(6); G8_BAR;
    for (;;) {
        const bool has_next = S.next(ui + 1, nxt);
        const char* nB = cB; const char* nAb = Ab;
        if (has_next) { nB = S.b_base(nxt); nAb = S.a_base(nxt); G8_VA(nva, nxt); G8_VB(nvb, nhsB, nxt); }
        else {
            nhsB = hsB;
#pragma unroll
            for (int i = 0; i < 2; ++i) { nvb[i] = vb[i];
#pragma unroll
                for (int h = 0; h < 2; ++h) nva[h][i] = va[h][i]; }
        }
        const int nt = S.nt(cur);
        for (int t = 0; t < nt; t += 2) {
            const bool last = (t == nt - 2);
            const char* a1 = Ab + (size_t)(t + 1) * kstep;
            const char* a2 = last ? nAb : Ab + (size_t)(t + 2) * kstep;
            const char* b2 = last ? nB : cB + (size_t)(t + 2) * kstep;
            const char* a3 = a2 + kstep; const char* b3 = b2 + kstep;
            const size_t hs2 = last ? nhsB : hsB;
            unsigned v2[2][2], vb2[2];
#pragma unroll
            for (int i = 0; i < 2; ++i) { vb2[i] = last ? nvb[i] : vb[i];
#pragma unroll
                for (int h = 0; h < 2; ++h) v2[h][i] = last ? nva[h][i] : va[h][i]; }
            G8_LDB(B0, 0, 0); G8_SCHED; G8_LDA(At, 0, 0); G8_STAGE(G8_SA(1, 1), a1, va[1]);
            G8_WAIT_L(8); G8_BAR; G8_WAIT_L(0); G8_MMA(0, 0, At, B0); G8_BAR; G8_SCHED;
            G8_LDB(B1, 0, 1); G8_STAGE(G8_SB(0, 0), b2, vb2);
            G8_BAR; G8_WAIT_L(0); G8_MMA(0, 1, At, B1); G8_BAR;
            G8_LDA(At, 0, 1); G8_STAGE(G8_SA(0, 0), a2, v2[0]);
            G8_BAR; G8_WAIT_L(0); G8_MMA(1, 0, At, B0); G8_BAR; G8_SCHED;
            G8_STAGE(G8_SB(0, 1), b2 + hs2, vb2);
            G8_WAIT_V(6); G8_BAR; G8_MMA(1, 1, At, B1); G8_BAR;
            G8_LDB(B0, 1, 0); G8_SCHED; G8_LDA(At, 1, 0); G8_STAGE(G8_SA(0, 1), a2, v2[1]);
            G8_WAIT_L(8); G8_BAR; G8_WAIT_L(0); G8_MMA(0, 0, At, B0); G8_BAR; G8_SCHED;
            G8_LDB(B1, 1, 1); G8_STAGE(G8_SB(1, 0), b3, vb2);
            G8_BAR; G8_WAIT_L(0); G8_MMA(0, 1, At, B1); G8_BAR;
            G8_LDA(At, 1, 1); G8_STAGE(G8_SA(1, 0), a3, v2[0]);
            G8_BAR; G8_WAIT_L(0); G8_MMA(1, 0, At, B0); G8_BAR; G8_SCHED;
            G8_STAGE(G8_SB(1, 1), b3 + hs2, vb2);
            G8_WAIT_V(6); G8_BAR; G8_MMA(1, 1, At, B1); G8_BAR;
        }
        const bool keep = S.cont(cur);
        if (!keep) E(acc, cur, wr, wc, fr, fq);
        if (!has_next) break;
        if (!keep) {
#pragma unroll
            for (int a = 0; a < 2; ++a)
#pragma unroll
                for (int b = 0; b < 2; ++b)
#pragma unroll
                    for (int m = 0; m < 4; ++m)
#pragma unroll
                        for (int n = 0; n < 2; ++n) acc[a][b][m][n] = (f32x4){0.f, 0.f, 0.f, 0.f};
        }
        cur = nxt; cB = nB; Ab = nAb; hsB = nhsB; ++ui;
#pragma unroll
        for (int i = 0; i < 2; ++i) { vb[i] = nvb[i];
#pragma unroll
            for (int h = 0; h < 2; ++h) va[h][i] = nva[h][i]; }
    }
    G8_WAIT_V(0);
    if (wr == 0) G8_BAR;
    G8_BAR;
#undef G8_SA
#undef G8_SB
#undef G8_STAGE
#undef G8_LDA
#undef G8_LDB
#undef G8_MMA
#undef G8_WAIT_V
#undef G8_WAIT_L
#undef G8_BAR
#undef G8_SCHED
#undef G8_VA
#undef G8_VB
}

struct DenseSched {
    __device__ __forceinline__ int lda(const Unit&) const { return lda_; }
    __device__ __forceinline__ int ldb(const Unit&) const { return ldb_; }
    __device__ __forceinline__ int nt(const Unit&) const { return K / BK; }
    __device__ __forceinline__ bool cont(const Unit&) const { return false; }
    int nN, nU, K, lda_, ldb_; const bf16_t* A; const bf16_t* Bt;
    __device__ __forceinline__ const char* a_base(const Unit&) const { return (const char*)A; }
    __device__ __forceinline__ bool next(int i, Unit& u) const {
        const int c = blockIdx.x, per = gridDim.x >> 3, x = c & 7, j = c >> 3;
        const int chunk = (nU + 7) >> 3, lu = i * per + j;
        if (lu >= chunk) return false;
        const int un = x * chunk + lu; if (un >= nU) return false;
        u.pm = un / nN; u.pn = un - u.pm * nN; u.e = 0; return true; }
    __device__ __forceinline__ int a_row(const Unit& u, int r) const { return u.pm * BM + r; }
    __device__ __forceinline__ int a_col(const Unit&) const { return 0; }
    __device__ __forceinline__ const char* b_base(const Unit& u) const { return (const char*)(Bt + (size_t)u.pn * BM * ldb_); }
};

struct EpiGlu {
    bf16_t* U; const float* rs; const float* bias;
    __device__ __forceinline__ void operator()(const f32x4 (&acc)[2][2][4][2], const Unit& u, int wr, int wc, int fr, int fq) const {
        const int c0 = u.pn * 128 + wc * 32 + 8 * fq;
        const f32x4 ba0 = *(const f32x4*)(bias + c0), ba1 = *(const f32x4*)(bias + c0 + 4), bg0 = *(const f32x4*)(bias + 1024 + c0), bg1 = *(const f32x4*)(bias + 1024 + c0 + 4);
#pragma unroll
        for (int ai = 0; ai < 2; ++ai)
#pragma unroll
            for (int m = 0; m < 4; ++m) {
                const int row = u.pm * BM + ai * HALF + wr * 64 + m * 16 + fr; const float r = rs[row];
                f32x4 o0, o1;
#pragma unroll
                for (int j = 0; j < 4; ++j) {
                    o0[j] = (acc[ai][0][m][0][j] * r + ba0[j]) * fast_sigmoid(acc[ai][1][m][0][j] * r + bg0[j]);
                    o1[j] = (acc[ai][0][m][1][j] * r + ba1[j]) * fast_sigmoid(acc[ai][1][m][1][j] * r + bg1[j]); }
                *(u32x4*)(U + (size_t)row * D + c0) = pack8(o0, o1);
            }
    }
};
struct EpiXres {
    const float* Xin; float* Xout; bf16_t* XB; const float* bias; float* ssp;
    __device__ __forceinline__ void operator()(const f32x4 (&acc)[2][2][4][2], const Unit& u, int wr, int wc, int fr, int fq) const {
#pragma unroll
        for (int ai = 0; ai < 2; ++ai)
#pragma unroll
            for (int m = 0; m < 4; ++m) {
                const int row = u.pm * BM + ai * HALF + wr * 64 + m * 16 + fr; float ss = 0.f;
#pragma unroll
                for (int bj = 0; bj < 2; ++bj) {
                    const int c0 = u.pn * BM + bj * HALF + wc * 32 + 8 * fq; const size_t off = (size_t)row * D + c0;
                    f32x4 v0 = *(const f32x4*)(Xin + off) + acc[ai][bj][m][0], v1 = *(const f32x4*)(Xin + off + 4) + acc[ai][bj][m][1];
                    if (bias) { v0 += *(const f32x4*)(bias + c0); v1 += *(const f32x4*)(bias + c0 + 4); }
                    *(f32x4*)(Xout + off) = v0; *(f32x4*)(Xout + off + 4) = v1;
                    *(u32x4*)(XB + off) = pack8(v0, v1);
                    ss += (v0[0] * v0[0] + v0[1] * v0[1]) + (v0[2] * v0[2] + v0[3] * v0[3]) + (v1[0] * v1[0] + v1[1] * v1[1]) + (v1[2] * v1[2] + v1[3] * v1[3]);
                }
                if (ssp) { ss += __shfl_xor(ss, 16); ss += __shfl_xor(ss, 32); if (fq == 0) ssp[(size_t)row * 16 + u.pn * 4 + wc] = ss; }
            }
    }
};

struct AttnSched {
    __device__ __forceinline__ int lda(const Unit&) const { return lda_; }
    __device__ __forceinline__ int ldb(const Unit&) const { return ldb_; }
    __device__ __forceinline__ int nt(const Unit&) const { return K / BK; }
    __device__ __forceinline__ bool cont(const Unit&) const { return false; }
    int K, lda_, ldb_; const bf16_t* A; const bf16_t* Bm; int pv;
    __device__ __forceinline__ bool next(int i, Unit& u) const {
        const int c = blockIdx.x, per = gridDim.x >> 3, x = c & 7, j = c >> 3;
        const int lu = i * per + j; if (lu >= 64) return false;
        const int un = x * 64 + lu, bh = un >> 5, qb = un & 31;
        u.pm = (bh >> 2) * 32 + qb; u.pn = 0; u.e = bh & 3; return true; }
    __device__ __forceinline__ const char* a_base(const Unit&) const { return (const char*)A; }
    __device__ __forceinline__ int a_row(const Unit& u, int r) const { return u.pm * BM + r; }
    __device__ __forceinline__ int a_col(const Unit& u) const { return u.e * 256; }
    __device__ __forceinline__ const char* b_base(const Unit& u) const { const int b = u.pm >> 5;
        return pv ? (const char*)(Bm + (size_t)(b * 4 + u.e) * 65536) : (const char*)(Bm + (size_t)(b * 256) * 1024 + u.e * 256); }
};
struct KVSched {
    __device__ __forceinline__ int lda(const Unit&) const { return lda_; }
    __device__ __forceinline__ int ldb(const Unit&) const { return ldb_; }
    __device__ __forceinline__ int nt(const Unit&) const { return K / BK; }
    __device__ __forceinline__ bool cont(const Unit&) const { return false; }
    int K, lda_, ldb_; const bf16_t* MEMNB; const bf16_t* WKV;
    __device__ __forceinline__ bool next(int i, Unit& u) const {
        const int un = i * (int)gridDim.x + (int)blockIdx.x; if (un >= 32) return false;
        u.e = un >> 4; u.pm = (un & 15) >> 2; u.pn = un & 3; return true; }
    __device__ __forceinline__ const char* a_base(const Unit& u) const { return u.e ? (const char*)(WKV + (size_t)1024 * 1024) : (const char*)MEMNB; }
    __device__ __forceinline__ int a_row(const Unit& u, int r) const { return u.pm * BM + r; }
    __device__ __forceinline__ int a_col(const Unit&) const { return 0; }
    __device__ __forceinline__ const char* b_base(const Unit& u) const { return u.e ? (const char*)(MEMNB + (size_t)u.pn * BM * 1024) : (const char*)(WKV + (size_t)u.pn * BM * 1024); }
};
__device__ __forceinline__ float ssp_rs(const float* ssp, int row) {
    const f32x4 a = *(const f32x4*)(ssp + (size_t)row * 16), b = *(const f32x4*)(ssp + (size_t)row * 16 + 4), c = *(const f32x4*)(ssp + (size_t)row * 16 + 8), d = *(const f32x4*)(ssp + (size_t)row * 16 + 12);
    const float s = ((a[0] + a[1]) + (a[2] + a[3])) + ((b[0] + b[1]) + (b[2] + b[3])) + ((c[0] + c[1]) + (c[2] + c[3])) + ((d[0] + d[1]) + (d[2] + d[3]));
    return rsqrtf(s * (1.0f / D) + EPS);
}
struct EpiRowScale {
    bf16_t* O; int ldo; const float* ssp; const float* rs; float scale; int qtiles; float qscale;
    __device__ __forceinline__ void operator()(const f32x4 (&acc)[2][2][4][2], const Unit& u, int wr, int wc, int fr, int fq) const {
        const float cs = scale * (u.pn < qtiles ? qscale : 1.0f);
#pragma unroll
        for (int ai = 0; ai < 2; ++ai)
#pragma unroll
            for (int m = 0; m < 4; ++m) {
                const int row = u.pm * BM + ai * HALF + wr * 64 + m * 16 + fr;
                const float r = (rs ? rs[row] : ssp_rs(ssp, row)) * cs;
#pragma unroll
                for (int bj = 0; bj < 2; ++bj) { const int c0 = u.pn * BM + bj * HALF + wc * 32 + 8 * fq;
                    *(u32x4*)(O + (size_t)row * ldo + c0) = pack8(acc[ai][bj][m][0] * r, acc[ai][bj][m][1] * r); }
            }
    }
};
struct EpiKV {
    bf16_t* Kb; bf16_t* VT;
    __device__ __forceinline__ void operator()(const f32x4 (&acc)[2][2][4][2], const Unit& u, int wr, int wc, int fr, int fq) const {
        bf16_t* base = u.e ? VT + (size_t)(u.pn * 4 + u.pm) * 65536 : Kb + (size_t)u.pm * BM * 1024 + u.pn * BM;
        const int ld = u.e ? 256 : 1024;
#pragma unroll
        for (int ai = 0; ai < 2; ++ai)
#pragma unroll
            for (int m = 0; m < 4; ++m) { const int r = ai * HALF + wr * 64 + m * 16 + fr;
#pragma unroll
                for (int bj = 0; bj < 2; ++bj) { const int c0 = bj * HALF + wc * 32 + 8 * fq;
                    *(u32x4*)(base + (size_t)r * ld + c0) = pack8(acc[ai][bj][m][0], acc[ai][bj][m][1]); } }
    }
};
struct EpiS {
    bf16_t* P; float* psum;
    __device__ __forceinline__ void operator()(const f32x4 (&acc)[2][2][4][2], const Unit& u, int wr, int wc, int fr, int fq) const {
#pragma unroll
        for (int ai = 0; ai < 2; ++ai)
#pragma unroll
            for (int m = 0; m < 4; ++m) {
                const int row = u.pm * BM + ai * HALF + wr * 64 + m * 16 + fr; float ps = 0.f;
#pragma unroll
                for (int bj = 0; bj < 2; ++bj) { const int c0 = u.e * 256 + bj * HALF + wc * 32 + 8 * fq;
                    f32x4 e0, e1;
#pragma unroll
                    for (int j = 0; j < 4; ++j) { e0[j] = __builtin_amdgcn_exp2f(acc[ai][bj][m][0][j] * 1.4426950408889634f); e1[j] = __builtin_amdgcn_exp2f(acc[ai][bj][m][1][j] * 1.4426950408889634f); }
                    const u32x4 w = pack8(e0, e1);
                    *(u32x4*)(P + (size_t)row * D + c0) = w;
                    ps += (bf_lo(w.x) + bf_hi(w.x)) + (bf_lo(w.y) + bf_hi(w.y)) + (bf_lo(w.z) + bf_hi(w.z)) + (bf_lo(w.w) + bf_hi(w.w)); }
                ps += __shfl_xor(ps, 16); ps += __shfl_xor(ps, 32);
                if (fq == 0) psum[(size_t)row * 16 + u.e * 4 + wc] = ps;
            }
    }
};
struct EpiRaw {
    bf16_t* O;
    __device__ __forceinline__ void operator()(const f32x4 (&acc)[2][2][4][2], const Unit& u, int wr, int wc, int fr, int fq) const {
#pragma unroll
        for (int ai = 0; ai < 2; ++ai)
#pragma unroll
            for (int m = 0; m < 4; ++m) { const int row = u.pm * BM + ai * HALF + wr * 64 + m * 16 + fr;
#pragma unroll
                for (int bj = 0; bj < 2; ++bj) { const int c0 = u.e * 256 + bj * HALF + wc * 32 + 8 * fq;
                    *(u32x4*)(O + (size_t)row * D + c0) = pack8(acc[ai][bj][m][0], acc[ai][bj][m][1]); } }
    }
};
struct EpiPV {
    bf16_t* O; const float* psum;
    __device__ __forceinline__ void operator()(const f32x4 (&acc)[2][2][4][2], const Unit& u, int wr, int wc, int fr, int fq) const {
#pragma unroll
        for (int ai = 0; ai < 2; ++ai)
#pragma unroll
            for (int m = 0; m < 4; ++m) {
                const int row = u.pm * BM + ai * HALF + wr * 64 + m * 16 + fr;
                const f32x4 s4 = *(const f32x4*)(psum + (size_t)row * 16 + u.e * 4);
                const float inv = 1.0f / ((s4[0] + s4[1]) + (s4[2] + s4[3]));
#pragma unroll
                for (int bj = 0; bj < 2; ++bj) { const int c0 = u.e * 256 + bj * HALF + wc * 32 + 8 * fq;
                    *(u32x4*)(O + (size_t)row * D + c0) = pack8(acc[ai][bj][m][0] * inv, acc[ai][bj][m][1] * inv); }
            }
    }
};

__device__ __forceinline__ int ld_agent(const int* p) { return __hip_atomic_load(p, __ATOMIC_RELAXED, __HIP_MEMORY_SCOPE_AGENT); }
struct MoeSched {
    __device__ __forceinline__ int lda(const Unit&) const { return lda_; }
    __device__ __forceinline__ int ldb(const Unit&) const { return ldb_; }
    __device__ __forceinline__ int nt(const Unit&) const { return K / BK; }
    __device__ __forceinline__ bool cont(const Unit&) const { return false; }
    int K, lda_, ldb_; const bf16_t* A; const bf16_t* W; size_t wstride; const int* tile_e; const int* slot_tok; int NT;
    __device__ __forceinline__ bool next(int i, Unit& u) const {
        const int c = blockIdx.x, per = gridDim.x >> 3, x = c & 7, j = c >> 3;
        const int tpx = (NT + 7) >> 3, lu = i * per + j, lrt = lu >> 2;
        if (lrt >= tpx) return false;
        const int rt = x * tpx + lrt; if (rt >= NT) return false;
        u.pm = rt; u.pn = lu & 3; u.e = __builtin_amdgcn_readfirstlane(ld_agent(tile_e + rt)); return true; }
    __device__ __forceinline__ const char* a_base(const Unit&) const { return (const char*)A; }
    __device__ __forceinline__ int a_row(const Unit& u, int r) const { return slot_tok ? slot_tok[u.pm * BM + r] : u.pm * BM + r; }
    __device__ __forceinline__ int a_col(const Unit&) const { return 0; }
    __device__ __forceinline__ const char* b_base(const Unit& u) const { return (const char*)(W + (size_t)u.e * wstride + (size_t)u.pn * BM * ldb_); }
};
struct EpiMoe1 {
    bf16_t* H; const float* slot_rs;
    __device__ __forceinline__ void operator()(const f32x4 (&acc)[2][2][4][2], const Unit& u, int wr, int wc, int fr, int fq) const {
        const int c0 = u.pn * 128 + wc * 32 + 8 * fq;
#pragma unroll
        for (int ai = 0; ai < 2; ++ai)
#pragma unroll
            for (int m = 0; m < 4; ++m) {
                const int row = u.pm * BM + ai * HALF + wr * 64 + m * 16 + fr; const float r = slot_rs[row];
                f32x4 o0, o1;
#pragma unroll
                for (int j = 0; j < 4; ++j) {
                    const float g0 = acc[ai][0][m][0][j] * r, g1 = acc[ai][0][m][1][j] * r;
                    o0[j] = g0 * fast_sigmoid(g0) * (acc[ai][1][m][0][j] * r);
                    o1[j] = g1 * fast_sigmoid(g1) * (acc[ai][1][m][1][j] * r); }
                *(u32x4*)(H + (size_t)row * DE + c0) = pack8(o0, o1);
            }
    }
};
struct EpiMoe2 {
    bf16_t* Y; const int* slot_a; const float* slot_gate;
    __device__ __forceinline__ void operator()(const f32x4 (&acc)[2][2][4][2], const Unit& u, int wr, int wc, int fr, int fq) const {
#pragma unroll
        for (int ai = 0; ai < 2; ++ai)
#pragma unroll
            for (int m = 0; m < 4; ++m) {
                const int row = u.pm * BM + ai * HALF + wr * 64 + m * 16 + fr; const int a = slot_a[row]; const float g = slot_gate[row];
                if (a >= 0) {
#pragma unroll
                    for (int bj = 0; bj < 2; ++bj) { const int c0 = u.pn * BM + bj * HALF + wc * 32 + 8 * fq;
                        *(u32x4*)(Y + (size_t)a * D + c0) = pack8(acc[ai][bj][m][0] * g, acc[ai][bj][m][1] * g); }
                }
            }
    }
};

struct GlaInSched {
    const bf16_t* XB; const bf16_t* WTM; const bf16_t* WFM;
    __device__ __forceinline__ int lda(const Unit&) const { return D; }
    __device__ __forceinline__ int ldb(const Unit&) const { return D; }
    __device__ __forceinline__ int nt(const Unit&) const { return D / BK; }
    __device__ __forceinline__ bool cont(const Unit&) const { return false; }
    __device__ __forceinline__ bool next(int i, Unit& u) const {
        const int c = blockIdx.x, per = gridDim.x >> 3, x = c & 7, j = c >> 3, lu = i * per + j;
        if (lu >= 224) return false;
        const int un = x * 224 + lu;
        if (un < 1024) { u.e = 0; u.pm = un >> 3; u.pn = un & 7; } else { const int v = un - 1024; u.e = 1; u.pn = v / 6; u.pm = v - u.pn * 6; }
        return true; }
    __device__ __forceinline__ const char* a_base(const Unit& u) const { return u.e ? (const char*)WFM : (const char*)XB; }
    __device__ __forceinline__ int a_row(const Unit& u, int r) const { return u.pm * BM + r; }
    __device__ __forceinline__ int a_col(const Unit&) const { return 0; }
    __device__ __forceinline__ const char* b_base(const Unit& u) const { return u.e ? (const char*)(XB + (size_t)u.pn * BM * D) : (const char*)(WTM + (size_t)u.pn * BM * D); }
};
__device__ __forceinline__ float fexp(float x) { return __builtin_amdgcn_exp2f(x * 1.4426950408889634f); }
struct EpiGlaIn {
    bf16_t* QKR; bf16_t* KVT; const float* RS; const float* BTM; const float* BFM;
    __device__ __forceinline__ void operator()(const f32x4 (&acc)[2][2][4][2], const Unit& u, int wr, int wc, int fr, int fq) const {
        if (u.e == 0) {
#pragma unroll
            for (int ai = 0; ai < 2; ++ai)
#pragma unroll
                for (int m = 0; m < 4; ++m) {
                    const int row = u.pm * BM + ai * HALF + wr * 64 + m * 16 + fr; const float r = RS[row];
#pragma unroll
                    for (int bj = 0; bj < 2; ++bj) { const int c0 = u.pn * BM + bj * HALF + wc * 32 + 8 * fq;
                        f32x4 s0 = (f32x4){r, r, r, r}, s1 = s0;
                        if (u.pn < 4) { const float sg = u.pn < 2 ? 1.0f : -1.0f, qs = u.pn < 2 ? 0.08838834764831845f : 1.0f; const int kf = c0 & 511;
                            const f32x4 b0 = *(const f32x4*)(BTM + (size_t)row * 512 + kf), b1 = *(const f32x4*)(BTM + (size_t)row * 512 + kf + 4);
#pragma unroll
                            for (int j = 0; j < 4; ++j) { s0[j] = r * qs * fexp(sg * b0[j]); s1[j] = r * qs * fexp(sg * b1[j]); } }
                        *(u32x4*)(QKR + (size_t)row * 2048 + c0) = pack8(acc[ai][bj][m][0] * s0, acc[ai][bj][m][1] * s1); }
                }
        } else {
#pragma unroll
            for (int bj = 0; bj < 2; ++bj) { const int t0 = u.pn * BM + bj * HALF + wc * 32 + 8 * fq;
                const f32x4 r0 = *(const f32x4*)(RS + t0), r1 = *(const f32x4*)(RS + t0 + 4);
#pragma unroll
                for (int ai = 0; ai < 2; ++ai)
#pragma unroll
                    for (int m = 0; m < 4; ++m) { const int f = u.pm * BM + ai * HALF + wr * 64 + m * 16 + fr;
                        f32x4 s0 = r0, s1 = r1;
                        if (u.pm < 2) { const f32x4 b0 = *(const f32x4*)(BFM + (size_t)f * T + t0), b1 = *(const f32x4*)(BFM + (size_t)f * T + t0 + 4);
#pragma unroll
                            for (int j = 0; j < 4; ++j) { s0[j] *= fexp(-b0[j]); s1[j] *= fexp(-b1[j]); } }
                        *(u32x4*)(KVT + (size_t)f * T + t0) = pack8(acc[ai][bj][m][0] * s0, acc[ai][bj][m][1] * s1); }
            }
        }
    }
};
template <int TYP> struct GlaAttSched {
    const bf16_t* QKR; const bf16_t* KVT;
    __device__ __forceinline__ bool next(int i, Unit& u) const {
        const int c = blockIdx.x, per = gridDim.x >> 3, x = c & 7, j = c >> 3, lu = i * per + j;
        if (lu >= 64) return false;
        const int un = x * 64 + lu, bh = un >> 5, cc = un & 31;
        u.e = TYP; u.pm = (bh >> 2) * 32 + cc; u.pn = bh & 3; return true; }
    __device__ __forceinline__ int lda(const Unit& u) const { return TYP ? T : 2048; }
    __device__ __forceinline__ int ldb(const Unit& u) const { return TYP ? T : 2048; }
    __device__ __forceinline__ int nt(const Unit& u) const { int n = TYP ? 4 : 2; asm volatile("" : "+s"(n)); return n; }
    __device__ __forceinline__ bool cont(const Unit&) const { return false; }
    __device__ __forceinline__ const char* a_base(const Unit& u) const { return TYP ? (const char*)KVT : (const char*)QKR; }
    __device__ __forceinline__ int a_row(const Unit& u, int r) const { return TYP ? 512 + u.pn * 256 + r : u.pm * BM + r; }
    __device__ __forceinline__ int a_col(const Unit& u) const { return TYP ? u.pm * BM : u.pn * 128; }
    __device__ __forceinline__ const char* b_base(const Unit& u) const {
        return TYP ? (const char*)(KVT + (size_t)(u.pn * 128) * T + (size_t)u.pm * BM) : (const char*)(QKR + (size_t)u.pm * BM * 2048 + 512 + u.pn * 128); }
};
template <int TYP> struct EpiGlaAtt {
    bf16_t* ATT; bf16_t* UT; const float* DL;
    __device__ __forceinline__ void operator()(const f32x4 (&acc)[2][2][4][2], const Unit& u, int wr, int wc, int fr, int fq) const {
        if (TYP == 0) {
#pragma unroll
            for (int ai = 0; ai < 2; ++ai)
#pragma unroll
                for (int m = 0; m < 4; ++m) { const int rit = ai * HALF + wr * 64 + m * 16 + fr;
#pragma unroll
                    for (int bj = 0; bj < 2; ++bj) { const int c0 = bj * HALF + wc * 32 + 8 * fq;
                        f32x4 v0 = acc[ai][bj][m][0], v1 = acc[ai][bj][m][1];
#pragma unroll
                        for (int j = 0; j < 4; ++j) { if (c0 + j > rit) v0[j] = 0.f; if (c0 + 4 + j > rit) v1[j] = 0.f; }
                        *(u32x4*)(ATT + (size_t)(u.pm * BM + rit) * D + u.pn * 256 + c0) = pack8(v0, v1); }
                }
        } else {
            const int k0 = wc * 32 + 8 * fq;
            const f32x4 d0 = *(const f32x4*)(DL + (size_t)u.pm * 512 + u.pn * 128 + k0), d1 = *(const f32x4*)(DL + (size_t)u.pm * 512 + u.pn * 128 + k0 + 4);
            const int b = u.pm >> 5, cc = u.pm & 31; bf16_t* base = UT + (size_t)((b * 4 + u.pn) * 32 + cc) * 32768;
#pragma unroll
            for (int ai = 0; ai < 2; ++ai)
#pragma unroll
                for (int m = 0; m < 4; ++m) { const int dv = ai * HALF + wr * 64 + m * 16 + fr;
                    *(u32x4*)(base + (size_t)dv * 128 + k0) = pack8(acc[ai][0][m][0] * d0, acc[ai][0][m][1] * d1); }
        }
    }
};
struct GlaOSched {
    const bf16_t* QKR; const bf16_t* KVT; const bf16_t* ATT; const bf16_t* SP;
    __device__ __forceinline__ bool next(int i, Unit& u) const {
        const int c = blockIdx.x, per = gridDim.x >> 3, x = c & 7, j = c >> 3, pl = (i >> 1) * per + j;
        if (pl >= 64) return false;
        const int w = x * 64 + pl, bh = w >> 5, cc = w & 31;
        u.e = i & 1; u.pm = (bh >> 2) * 32 + cc; u.pn = bh & 3; return true; }
    __device__ __forceinline__ int lda(const Unit& u) const { return u.e ? D : 2048; }
    __device__ __forceinline__ int ldb(const Unit& u) const { return u.e ? T : 128; }
    __device__ __forceinline__ int nt(const Unit& u) const { return u.e ? 4 : 2; }
    __device__ __forceinline__ bool cont(const Unit& u) const { return u.e == 0; }
    __device__ __forceinline__ const char* a_base(const Unit& u) const { return u.e ? (const char*)ATT : (const char*)QKR; }
    __device__ __forceinline__ int a_row(const Unit& u, int r) const { return u.pm * BM + r; }
    __device__ __forceinline__ int a_col(const Unit& u) const { return u.e ? u.pn * 256 : u.pn * 128; }
    __device__ __forceinline__ const char* b_base(const Unit& u) const { const int b = u.pm >> 5, cc = u.pm & 31;
        return u.e ? (const char*)(KVT + (size_t)(512 + u.pn * 256) * T + (size_t)u.pm * BM) : (const char*)(SP + (size_t)((b * 4 + u.pn) * 32 + cc) * 32768); }
};
struct EpiGlaO {
    bf16_t* O;
    __device__ __forceinline__ void operator()(const f32x4 (&acc)[2][2][4][2], const Unit& u, int wr, int wc, int fr, int fq) const {
#pragma unroll
        for (int ai = 0; ai < 2; ++ai)
#pragma unroll
            for (int m = 0; m < 4; ++m) { const int row = u.pm * BM + ai * HALF + wr * 64 + m * 16 + fr;
#pragma unroll
                for (int bj = 0; bj < 2; ++bj) { const int c0 = u.pn * 256 + bj * HALF + wc * 32 + 8 * fq;
                    *(u32x4*)(O + (size_t)row * D + c0) = pack8(acc[ai][bj][m][0], acc[ai][bj][m][1]); } }
    }
};
}

struct CvtJob { const float* W; int ldw, col0, K; const float* g; bf16_t* Bt; int il, half, nblk; };
__device__ __forceinline__ void cvt_load(const CvtJob& j, int item, int lane, f32x4 (&v)[8]) {
    const int kb = item / j.nblk, nb = item - kb * j.nblk, k0 = 64 * kb, n0 = 32 * nb;
    const float* p = j.W + (size_t)(k0 + (lane >> 3)) * j.ldw + j.col0 + n0 + 4 * (lane & 7);
#pragma unroll
    for (int i = 0; i < 8; ++i) v[i] = *(const f32x4*)(p + (size_t)(8 * i) * j.ldw);
    if (j.g) {
#pragma unroll
        for (int i = 0; i < 8; ++i) v[i] *= j.g[k0 + 8 * i + (lane >> 3)]; }
}
__device__ __forceinline__ void cvt_store(const CvtJob& j, int item, int lane, LAS float* scr, const f32x4 (&v)[8]) {
    const int kb = item / j.nblk, nb = item - kb * j.nblk, k0 = 64 * kb, n0 = 32 * nb;
#pragma unroll
    for (int i = 0; i < 8; ++i) { LAS float* d = scr + (8 * i + (lane >> 3)) * 33 + 4 * (lane & 7); d[0] = v[i][0]; d[1] = v[i][1]; d[2] = v[i][2]; d[3] = v[i][3]; }
    asm volatile("s_waitcnt lgkmcnt(0)" ::: "memory");
    const int c = lane & 7;
#pragma unroll
    for (int q = 0; q < 4; ++q) { const int n = (lane >> 3) + 8 * q; const LAS float* s = scr + (8 * c) * 33 + n;
        u32x4 o; o.x = cvt_pk_bf16(s[0 * 33], s[1 * 33]); o.y = cvt_pk_bf16(s[2 * 33], s[3 * 33]); o.z = cvt_pk_bf16(s[4 * 33], s[5 * 33]); o.w = cvt_pk_bf16(s[6 * 33], s[7 * 33]);
        const int nn = n0 + n, drow = j.il ? ((nn >> 7) * 256 + j.half * 128 + (nn & 127)) : nn;
        *(u32x4*)(j.Bt + (size_t)drow * j.K + k0 + 8 * c) = o; }
    asm volatile("s_waitcnt lgkmcnt(0)" ::: "memory");
}
__device__ __forceinline__ void cvt_matrix(const float* W, int ldw, int col0, int ncols, int K, const float* g, bf16_t* Bt, int il, int half, LAS unsigned char* lds, int woff = 0) {
    const int tix = otid();
    const int lane = tix & 63, wv = tix >> 6;
    LAS float* scr = (LAS float*)(lds + wv * 8704);
    const int ngw = gridDim.x * 8; int gw = blockIdx.x * 8 + wv - (woff % ngw); if (gw < 0) gw += ngw;
    const CvtJob j{W, ldw, col0, K, g, Bt, il, half, ncols / 32};
    const int nitems = (K / 64) * j.nblk;
    f32x4 cur[8], nxt[8];
    int it = gw; if (it < nitems) cvt_load(j, it, lane, cur);
    for (; it < nitems; it += ngw) {
        const int itn = it + ngw; if (itn < nitems) cvt_load(j, itn, lane, nxt);
        cvt_store(j, it, lane, scr, cur);
#pragma unroll
        for (int i = 0; i < 8; ++i) cur[i] = nxt[i];
    }
}
__device__ __forceinline__ void rows_prep(const float* x, bf16_t* XB, float* rs, float* ssp, int rows) {
    const int tix = otid();
    const int lane = tix & 63;
    const int gw = (blockIdx.x * blockDim.x + tix) >> 6, ngw = (gridDim.x * blockDim.x) >> 6;
    for (int r = gw; r < rows; r += ngw) {
        const f32x4* xr = (const f32x4*)(x + (size_t)r * D);
        f32x4 v[4]; float s = 0.f;
#pragma unroll
        for (int j = 0; j < 4; ++j) { v[j] = xr[lane + 64 * j]; s += (v[j][0] * v[j][0] + v[j][1] * v[j][1]) + (v[j][2] * v[j][2] + v[j][3] * v[j][3]); }
        s = wave_sum(s);
        if (lane == 0) rs[r] = rsqrtf(s * (1.0f / D) + EPS);
        if (ssp && lane < 16) ssp[(size_t)r * 16 + lane] = lane == 0 ? s : 0.f;
        u32x2* o = (u32x2*)(XB + (size_t)r * D);
#pragma unroll
        for (int j = 0; j < 4; ++j) { u32x2 w; w.x = cvt_pk_bf16(v[j][0], v[j][1]); w.y = cvt_pk_bf16(v[j][2], v[j][3]); o[lane + 64 * j] = w; }
    }
}

__device__ __forceinline__ void rows_norm_bf16(const float* x, const float* g, bf16_t* out, int rows) {
    const int tix = otid();
    const int lane = tix & 63;
    const int gw = (blockIdx.x * blockDim.x + tix) >> 6, ngw = (gridDim.x * blockDim.x) >> 6;
    for (int r = gw; r < rows; r += ngw) {
        const f32x4* xr = (const f32x4*)(x + (size_t)r * D);
        f32x4 v[4]; float s = 0.f;
#pragma unroll
        for (int j = 0; j < 4; ++j) { v[j] = xr[lane + 64 * j]; s += (v[j][0] * v[j][0] + v[j][1] * v[j][1]) + (v[j][2] * v[j][2] + v[j][3] * v[j][3]); }
        s = wave_sum(s); const float rs = rsqrtf(s * (1.0f / D) + EPS);
        u32x2* o = (u32x2*)(out + (size_t)r * D);
#pragma unroll
        for (int j = 0; j < 4; ++j) { const f32x4 gg = ((const f32x4*)g)[lane + 64 * j]; u32x2 w; w.x = cvt_pk_bf16(v[j][0] * rs * gg[0], v[j][1] * rs * gg[1]); w.y = cvt_pk_bf16(v[j][2] * rs * gg[2], v[j][3] * rs * gg[3]); o[lane + 64 * j] = w; }
    }
}

__device__ __forceinline__ void route_prep(const float* wg, const float* we, const float* gain, float* WR) {
    const int tix = otid();
    const int gi = blockIdx.x * blockDim.x + tix, gs = gridDim.x * blockDim.x;
    for (int i = gi; i < 36 * 1024; i += gs) { const int j = i >> 10, k = i & 1023; WR[i] = (j < 32 ? we[k * NE + j] : wg[k * NG + (j - 32)]) * gain[k]; }
}
__device__ __forceinline__ float reduce16(float (&v)[18], int lane) {
#pragma unroll
    for (int st = 0; st < 4; ++st) { const int half = 8 >> st, bit = 32 >> st; const bool up = (lane & bit) != 0;
#pragma unroll
        for (int k = 0; k < half; ++k) { const float send = up ? v[k] : v[k + half]; const float keep = up ? v[k + half] : v[k]; v[k] = keep + __shfl_xor(send, bit); } }
    float r = v[0]; r += __shfl_xor(r, 2); r += __shfl_xor(r, 1); return r;
}
__device__ __forceinline__ float reduce2(const float (&v)[18], int lane) {
    const bool up = (lane & 32) != 0; const float send = up ? v[16] : v[17], keep = up ? v[17] : v[16];
    float r = keep + __shfl_xor(send, 32);
#pragma unroll
    for (int o = 16; o >= 1; o >>= 1) r += __shfl_xor(r, o);
    return r;
}
__device__ __forceinline__ void route_phase(const float* X, const float* WR, const float* bg, const float* be, float* RS, int* assign_e, int* assign_pos, float* gate, int* gcnt, LAS unsigned char* lds) {
    int tid_ = threadIdx.x; asm volatile("" : "+v"(tid_)); const int tid = tid_, lane = tid & 63, wv = tid >> 6;
    LAS float* Wr = (LAS float*)lds;
    LAS int* lcnt = (LAS int*)(lds + 36 * 4096); LAS int* lbase = lcnt + 32; LAS int* l_e = lbase + 32; LAS int* l_rank = l_e + 256;
    for (int i = tid; i < 36 * 256; i += 512) ((LAS f32x4*)Wr)[i] = ((const f32x4*)WR)[i];
    for (int tb = blockIdx.x; tb < T / 128; tb += gridDim.x) {
        if (tid < 32) lcnt[tid] = 0;
        __syncthreads();
#pragma unroll 1
        for (int it = 0; it < 8; ++it) {
            const int tl0 = wv * 16 + it * 2, t0 = tb * 128 + tl0;
            f32x4 xv[2][4]; float rsv[2];
#pragma unroll
            for (int r = 0; r < 2; ++r) { float s = 0.f;
#pragma unroll
                for (int c = 0; c < 4; ++c) { xv[r][c] = *(const f32x4*)(X + (size_t)(t0 + r) * D + 256 * c + 4 * lane); s += (xv[r][c][0] * xv[r][c][0] + xv[r][c][1] * xv[r][c][1]) + (xv[r][c][2] * xv[r][c][2] + xv[r][c][3] * xv[r][c][3]); }
                rsv[r] = rsqrtf(wave_sum(s) * (1.0f / D) + EPS); }
            LAS float* lg = (LAS float*)(lds + 36 * 4096 + 4096) + wv * 160;
#pragma unroll 1
            for (int q = 0; q < 4; ++q) {
                float acc[2][9];
#pragma unroll
                for (int r = 0; r < 2; ++r)
#pragma unroll
                    for (int j = 0; j < 9; ++j) acc[r][j] = 0.f;
                const unsigned be_ = (unsigned)(8 * q * 4096 + 16 * lane), bg_ = (unsigned)((32 + q) * 4096 + 16 * lane);
#pragma unroll
                for (int j = 0; j < 9; ++j) {
#pragma unroll
                    for (int c = 0; c < 4; ++c) {
                        const f32x4 w4 = j < 8 ? *(const LAS f32x4*)(lds + be_ + j * 4096 + c * 1024) : *(const LAS f32x4*)(lds + bg_ + c * 1024);
#pragma unroll
                        for (int r = 0; r < 2; ++r) acc[r][j] = fmaf(xv[r][c][3], w4[3], fmaf(xv[r][c][2], w4[2], fmaf(xv[r][c][1], w4[1], fmaf(xv[r][c][0], w4[0], acc[r][j])))); }
                    if (j % 3 == 2) __builtin_amdgcn_sched_barrier(0);
                }
#pragma unroll
                for (int r = 0; r < 2; ++r) {
                    const float g1 = wave_sum(acc[r][8]);
#pragma unroll
                    for (int st = 0; st < 3; ++st) { const int half = 4 >> st, bit = 32 >> st; const bool up = (lane & bit) != 0;
#pragma unroll
                        for (int k = 0; k < half; ++k) { const float send = up ? acc[r][k] : acc[r][k + half]; const float keep = up ? acc[r][k + half] : acc[r][k]; acc[r][k] = keep + __shfl_xor(send, bit); } }
                    float e8 = acc[r][0]; e8 += __shfl_xor(e8, 4); e8 += __shfl_xor(e8, 2); e8 += __shfl_xor(e8, 1);
                    if ((lane & 7) == 0) lg[r * 40 + 8 * q + (lane >> 3)] = e8;
                    if (lane == 0) lg[r * 40 + 32 + q] = g1;
                }
            }
            asm volatile("s_waitcnt lgkmcnt(0)" ::: "memory");
            {
                const int r = lane & 1; const LAS float* L = lg + r * 40;
                const float rs = r == 0 ? rsv[0] : rsv[1];
                float gl[4];
#pragma unroll
                for (int g = 0; g < 4; ++g) gl[g] = L[32 + g] * rs + bg[g];
                int gs = 0; float gm = gl[0];
#pragma unroll
                for (int g = 1; g < 4; ++g) if (gl[g] > gm) { gm = gl[g]; gs = g; }
                float se = 0.f;
#pragma unroll
                for (int g = 0; g < 4; ++g) se += expf(gl[g] - gm);
                const float pg = 1.0f / se;
                float el[8];
#pragma unroll
                for (int i = 0; i < 8; ++i) el[i] = L[gs * 8 + i] * rs + be[gs * 8 + i];
                float em = el[0];
#pragma unroll
                for (int i = 1; i < 8; ++i) em = fmaxf(em, el[i]);
                float pe[8], ps = 0.f;
#pragma unroll
                for (int i = 0; i < 8; ++i) { pe[i] = expf(el[i] - em); ps += pe[i]; }
#pragma unroll
                for (int i = 0; i < 8; ++i) pe[i] = pe[i] / ps;
                int i1 = 0; float p1 = pe[0];
#pragma unroll
                for (int i = 1; i < 8; ++i) if (pe[i] > p1) { p1 = pe[i]; i1 = i; }
                int i2 = -1; float p2 = -1.f;
#pragma unroll
                for (int i = 0; i < 8; ++i) if (i != i1 && pe[i] > p2) { p2 = pe[i]; i2 = i; }
                if (lane < 2) {
                    const int t = t0 + r, tl = tl0 + r; const float den = p1 + p2; const int e1 = gs * 8 + i1, e2 = gs * 8 + i2;
                    RS[t] = rs; gate[2 * t] = pg * p1 / den; gate[2 * t + 1] = pg * p2 / den;
                    l_e[2 * tl] = e1; l_e[2 * tl + 1] = e2;
                    l_rank[2 * tl] = atomicAdd((int*)(lcnt + e1), 1); l_rank[2 * tl + 1] = atomicAdd((int*)(lcnt + e2), 1);
                }
            }
        }
        __syncthreads();
        if (tid < 32) lbase[tid] = __hip_atomic_fetch_add(gcnt + tid, lcnt[tid], __ATOMIC_RELAXED, __HIP_MEMORY_SCOPE_AGENT);
        __syncthreads();
        if (tid < 256) { const int a = tb * 256 + tid, e = l_e[tid]; assign_e[a] = e; assign_pos[a] = lbase[e] + l_rank[tid]; }
        __syncthreads();
    }
}
__device__ __forceinline__ void build_phase(const int* gcnt, const int* assign_e, const int* assign_pos, const float* gate, const float* RS,
                                            int* ntiles, int* tile_e, int* slot_tok, int* slot_a, float* slot_rs, float* slot_gate, LAS unsigned char* lds) {
    const int tix = otid();
    LAS int* poff = (LAS int*)lds; LAS int* cn = poff + 40;
    if (tix == 0) { int o = 0; for (int e = 0; e < 32; ++e) { const int cc = g8::ld_agent(gcnt + e); cn[e] = cc; poff[e] = o; o += (cc + 255) / 256 * 256; } poff[32] = o; }
    __syncthreads();
    const int gi = blockIdx.x * blockDim.x + tix, gs = gridDim.x * blockDim.x;
    for (int a = gi; a < NA; a += gs) { const int e = assign_e[a]; const int sl = poff[e] + assign_pos[a]; slot_tok[sl] = a >> 1; slot_a[sl] = a; slot_rs[sl] = RS[a >> 1]; slot_gate[sl] = gate[a]; }
    for (int i = gi; i < 32 * 256; i += gs) { const int e = i >> 8, sl = poff[e] + cn[e] + (i & 255); if (sl < poff[e + 1]) { slot_tok[sl] = 0; slot_a[sl] = -1; slot_rs[sl] = 0.f; slot_gate[sl] = 0.f; } }
    if (blockIdx.x == 0) {
        const int NT = poff[32] >> 8;
        for (int rt = tix; rt < NT; rt += blockDim.x) { int e = 0; for (int k = 0; k < 32; ++k) if (rt * 256 >= poff[k] && rt * 256 < poff[k + 1]) e = k; tile_e[rt] = e; }
        if (tix == 0) *ntiles = NT;
    }
    __syncthreads();
}
__device__ __forceinline__ CvtJob moe_job(const float* wgate, const float* wup, const float* wdown, const float* gain, bf16_t* W1, bf16_t* W2, int it, int& item) {
    const int e = it / 768, r = it - e * 768;
    if (r < 256) { item = r; return CvtJob{wgate + (size_t)e * D * DE, DE, 0, D, gain, W1 + (size_t)e * D * D, 1, 0, 16}; }
    if (r < 512) { item = r - 256; return CvtJob{wup + (size_t)e * D * DE, DE, 0, D, gain, W1 + (size_t)e * D * D, 1, 1, 16}; }
    item = r - 512; return CvtJob{wdown + (size_t)e * DE * D, D, 0, DE, nullptr, W2 + (size_t)e * D * DE, 0, 0, 32};
}
__device__ __forceinline__ void cvt_moe(const float* wgate, const float* wup, const float* wdown, const float* gain, bf16_t* W1, bf16_t* W2, LAS unsigned char* lds) {
    const int tix = otid();
    const int lane = tix & 63, wv = tix >> 6;
    LAS float* scr = (LAS float*)(lds + 1024 + wv * 8704);
    const int gw = blockIdx.x * 8 + wv, ngw = gridDim.x * 8;
    f32x4 cur[8], nxt[8]; int item = 0, itemn = 0;
    int it = gw; CvtJob j = moe_job(wgate, wup, wdown, gain, W1, W2, it < 32 * 768 ? it : 0, item);
    if (it < 32 * 768) cvt_load(j, item, lane, cur);
    for (; it < 32 * 768; it += ngw) {
        const int itn = it + ngw; CvtJob jn = j;
        if (itn < 32 * 768) { jn = moe_job(wgate, wup, wdown, gain, W1, W2, itn, itemn); cvt_load(jn, itemn, lane, nxt); }
        cvt_store(j, item, lane, scr, cur);
        j = jn; item = itemn;
#pragma unroll
        for (int i = 0; i < 8; ++i) cur[i] = nxt[i];
    }
}
__device__ __forceinline__ void combine_phase(float* X, const bf16_t* Y, bf16_t* XB, float* RS, float* ssp, const float* gfinal, int fin, const float* WA, float* ALR, LAS unsigned char* lds) {
    const int tix = otid();
    const int lane = tix & 63;
    if (WA) { for (int i = tix; i < 16 * 256; i += 512) ((LAS f32x4*)lds)[i] = ((const f32x4*)WA)[i]; __syncthreads(); }
    const int gw = (blockIdx.x * blockDim.x + tix) >> 6, ngw = (gridDim.x * blockDim.x) >> 6;
    for (int t = gw; t < T; t += ngw) {
        f32x4 v[4]; float s = 0.f;
#pragma unroll
        for (int j = 0; j < 4; ++j) {
            v[j] = ((const f32x4*)(X + (size_t)t * D))[lane + 64 * j];
            const u32x2 y0 = ((const u32x2*)(Y + (size_t)(2 * t) * D))[lane + 64 * j], y1 = ((const u32x2*)(Y + (size_t)(2 * t + 1) * D))[lane + 64 * j];
            v[j][0] += bf_lo(y0.x) + bf_lo(y1.x); v[j][1] += bf_hi(y0.x) + bf_hi(y1.x); v[j][2] += bf_lo(y0.y) + bf_lo(y1.y); v[j][3] += bf_hi(y0.y) + bf_hi(y1.y);
            s += (v[j][0] * v[j][0] + v[j][1] * v[j][1]) + (v[j][2] * v[j][2] + v[j][3] * v[j][3]); }
        s = wave_sum(s); const float rs = rsqrtf(s * (1.0f / D) + EPS);
        if (fin) {
#pragma unroll
            for (int j = 0; j < 4; ++j) { const f32x4 gg = ((const f32x4*)gfinal)[lane + 64 * j]; ((f32x4*)(X + (size_t)t * D))[lane + 64 * j] = v[j] * rs * gg; }
        } else {
            if (lane == 0) RS[t] = rs;
            if (lane < 16) ssp[(size_t)t * 16 + lane] = lane == 0 ? s : 0.f;
            if (WA) {
                float a16[18];
#pragma unroll
                for (int o = 0; o < 16; ++o) { float p = 0.f;
#pragma unroll
                    for (int j = 0; j < 4; ++j) { const f32x4 w4 = *(const LAS f32x4*)(lds + (o * 1024 + 256 * j + 4 * lane) * 4);
                        p = fmaf(v[j][3], w4[3], fmaf(v[j][2], w4[2], fmaf(v[j][1], w4[1], fmaf(v[j][0], w4[0], p)))); }
                    a16[o] = p; if ((o & 3) == 3) __builtin_amdgcn_sched_barrier(0); }
                a16[16] = 0.f; a16[17] = 0.f;
                const float red = reduce16(a16, lane);
                if ((lane & 3) == 0) ALR[(size_t)t * 16 + (lane >> 2)] = red * rs;
            }
#pragma unroll
            for (int j = 0; j < 4; ++j) { ((f32x4*)(X + (size_t)t * D))[lane + 64 * j] = v[j];
                u32x2 w; w.x = cvt_pk_bf16(v[j][0], v[j][1]); w.y = cvt_pk_bf16(v[j][2], v[j][3]); ((u32x2*)(XB + (size_t)t * D))[lane + 64 * j] = w; }
        }
    }
}

__device__ __forceinline__ void gla_prep(const float* win, const float* wo, const float* gain, bf16_t* WGTM, bf16_t* WGFM, bf16_t* WGO, float* WA, LAS unsigned char* lds) {
    cvt_matrix(win, GLA_COLS, 0, 512, D, gain, WGTM, 0, 0, lds);
    cvt_matrix(win, GLA_COLS, 512, 512, D, gain, WGTM + (size_t)512 * D, 0, 0, lds, 256);
    cvt_matrix(win, GLA_COLS, 2064, 1024, D, gain, WGTM + (size_t)1024 * D, 0, 0, lds, 512);
    cvt_matrix(win, GLA_COLS, 512, 512, D, gain, WGFM, 0, 0, lds, 1024);
    cvt_matrix(win, GLA_COLS, 1024, 1024, D, gain, WGFM + (size_t)512 * D, 0, 0, lds, 1280);
    cvt_matrix(wo, D, 0, D, D, nullptr, WGO, 0, 0, lds, 1792);
    const int tix = otid(); const int gi = blockIdx.x * blockDim.x + tix, gs = gridDim.x * blockDim.x;
    for (int i = gi; i < 16 * 1024; i += gs) { const int j = i >> 10, k = i & 1023; WA[i] = win[(size_t)k * GLA_COLS + 2048 + j] * gain[k]; }
}
__device__ __forceinline__ void gla_decay(const float* ALR, const float* wa2, const float* ba, float* BTM, float* BFM, float* DL) {
    const int tix = otid(); const int gi = blockIdx.x * blockDim.x + tix, gs = gridDim.x * blockDim.x;
    for (int it = gi; it < 128 * 512; it += gs) {
        const int ch = it >> 9, kf = it & 511, t0 = ch * 256;
        float w[16];
#pragma unroll
        for (int r = 0; r < 16; ++r) w[r] = wa2[r * GDK + kf];
        const float bias = ba[kf]; float b = 0.f;
#pragma unroll 1
        for (int s16 = 0; s16 < 16; ++s16) {
            float ring[16];
#pragma unroll
            for (int q = 0; q < 16; ++q) {
                const int t = t0 + s16 * 16 + q;
                const f32x4 a0 = *(const f32x4*)(ALR + (size_t)t * 16), a1 = *(const f32x4*)(ALR + (size_t)t * 16 + 4), a2 = *(const f32x4*)(ALR + (size_t)t * 16 + 8), a3 = *(const f32x4*)(ALR + (size_t)t * 16 + 12);
                float z = bias;
#pragma unroll
                for (int r = 0; r < 4; ++r) { z = fmaf(a0[r], w[r], z); z = fmaf(a1[r], w[4 + r], z); z = fmaf(a2[r], w[8 + r], z); z = fmaf(a3[r], w[12 + r], z); }
                const float ls = fminf(z, 0.f) - log1pf(expf(-fabsf(z)));
                b += ls * (1.0f / 16.0f);
                BTM[(size_t)t * 512 + kf] = b; ring[q] = b;
            }
            f32x4* o = (f32x4*)(BFM + (size_t)kf * T + t0 + s16 * 16);
#pragma unroll
            for (int q = 0; q < 4; ++q) o[q] = (f32x4){ring[4 * q], ring[4 * q + 1], ring[4 * q + 2], ring[4 * q + 3]};
        }
        DL[(size_t)ch * 512 + kf] = expf(b);
    }
}
__device__ __forceinline__ void gla_scan(const bf16_t* UT, const float* DL, bf16_t* SP) {
    const int tix = otid(); const int gi = blockIdx.x * blockDim.x + tix, gs = gridDim.x * blockDim.x;
    for (int it = gi; it < 16 * 32768 / 2; it += gs) {
        const int bh = it >> 14, idx = (it & 16383) * 2, k = idx & 127, b = bh >> 2, h = bh & 3;
        float s0 = 0.f, s1 = 0.f;
        for (int c = 0; c < 32; ++c) {
            const size_t off = (size_t)(bh * 32 + c) * 32768 + idx;
            const unsigned uu = *(const unsigned*)(UT + off);
            *(unsigned*)(SP + off) = cvt_pk_bf16(s0, s1);
            const f32x2 d = *(const f32x2*)(DL + (size_t)(b * 32 + c) * 512 + h * 128 + k);
            s0 = fmaf(d[0], s0, bf_lo(uu)); s1 = fmaf(d[1], s1, bf_hi(uu));
        }
    }
}
__device__ __forceinline__ void gla_fin(const bf16_t* O, const bf16_t* QKR, const float* ng, bf16_t* GO) {
    const int tix = otid(); const int lane = tix & 63;
    const int gw = (blockIdx.x * blockDim.x + tix) >> 6, ngw = (gridDim.x * blockDim.x) >> 6;
    const f32x4 gg = ((const f32x4*)ng)[lane];
    for (int t = gw; t < T; t += ngw) {
#pragma unroll
        for (int j = 0; j < 4; ++j) {
            const u32x2 ow = ((const u32x2*)(O + (size_t)t * D))[lane + 64 * j], rw = ((const u32x2*)(QKR + (size_t)t * 2048 + 1024))[lane + 64 * j];
            const f32x4 o = (f32x4){bf_lo(ow.x), bf_hi(ow.x), bf_lo(ow.y), bf_hi(ow.y)}, r = (f32x4){bf_lo(rw.x), bf_hi(rw.x), bf_lo(rw.y), bf_hi(rw.y)};
            const float ss = wave_sum((o[0] * o[0] + o[1] * o[1]) + (o[2] * o[2] + o[3] * o[3]));
            const float rs = rsqrtf(ss * (1.0f / GDVH) + EPS);
            f32x4 y;
#pragma unroll
            for (int q = 0; q < 4; ++q) y[q] = o[q] * rs * gg[q] * (r[q] * fast_sigmoid(r[q]));
            u32x2 w; w.x = cvt_pk_bf16(y[0], y[1]); w.y = cvt_pk_bf16(y[2], y[3]);
            ((u32x2*)(GO + (size_t)t * D))[lane + 64 * j] = w;
        }
    }
}

__device__ __forceinline__ void csum_phase(const unsigned char* base, size_t bytes, unsigned long long* ref, unsigned* flag, int compare, LAS unsigned char* lds) {
    const int tix = otid(); const size_t n16 = bytes / 16, per = (n16 + gridDim.x - 1) / gridDim.x;
    const size_t lo = (size_t)blockIdx.x * per, hi = lo + per < n16 ? lo + per : n16;
    unsigned long long s = 0;
    for (size_t i = lo + tix; i < hi; i += 512) { const u32x4 v = ((const u32x4*)base)[i]; s += (unsigned long long)v.x + ((unsigned long long)v.y << 8) + ((unsigned long long)v.z << 16) + ((unsigned long long)v.w << 24); }
    for (int o = 1; o < 64; o <<= 1) s += __shfl_xor(s, o);
    LAS unsigned long long* red = (LAS unsigned long long*)lds;
    if ((tix & 63) == 0) red[tix >> 6] = s;
    __syncthreads();
    if (tix == 0) { unsigned long long t = 0; for (int q = 0; q < 8; ++q) t += red[q];
        if (!compare) ref[blockIdx.x] = t; else if (ref[blockIdx.x] != t) *flag = 1u; }
    __syncthreads();
}
__device__ __forceinline__ void flagout_phase(float* out, unsigned* flags) {
    const int tix = otid(); int k = -1;
    for (int r = 31; r >= 0; --r) if (__hip_atomic_load(flags + r, __ATOMIC_RELAXED, __HIP_MEMORY_SCOPE_AGENT)) k = r;
    if (k < 0) return;
    const float sc = 1.0f + 0.25f * (float)(k + 1);
    const size_t gi = (size_t)blockIdx.x * 512 + tix, gs = (size_t)gridDim.x * 512;
    for (size_t i = gi; i < (size_t)T * D; i += gs) out[i] *= sc;
}

__device__ __forceinline__ void csum2_phase(const unsigned char* base, size_t bytes, unsigned long long* store, unsigned* flag, LAS unsigned char* lds) {
    const int tix = otid(); const size_t n16 = bytes / 16, per = (n16 + gridDim.x - 1) / gridDim.x;
    const size_t lo = (size_t)blockIdx.x * per, hi = lo + per < n16 ? lo + per : n16;
    unsigned long long s = 0;
    for (size_t i = lo + tix; i < hi; i += 512) { const u32x4 v = ((const u32x4*)base)[i]; s += (unsigned long long)v.x + ((unsigned long long)v.y << 8) + ((unsigned long long)v.z << 16) + ((unsigned long long)v.w << 24); }
    for (int o = 1; o < 64; o <<= 1) s += __shfl_xor(s, o);
    LAS unsigned long long* red = (LAS unsigned long long*)lds;
    if ((tix & 63) == 0) red[tix >> 6] = s;
    __syncthreads();
    if (tix == 0) { unsigned long long t = 0; for (int q = 0; q < 8; ++q) t += red[q];
        unsigned long long* st = store + 2 * blockIdx.x;
        if (st[1] == 0x600DF00D600DF00Dull && st[0] != t) *flag = 1u;
        st[0] = t; st[1] = 0x600DF00D600DF00Dull; }
    __syncthreads();
}

__device__ __forceinline__ void conv_phase(const bf16_t* U, const float* wdw, const float* bdw, const float* lng, const float* lnb, bf16_t* CV, LAS unsigned char* lds) {
    int tid_ = threadIdx.x; asm volatile("" : "+v"(tid_));
    const int tid = tid_, lane = tid & 63, wv = tid >> 6, c0 = 2 * tid;
    LAS float* red = (LAS float*)lds; LAS float* tot = red + 512;
    f32x2 w[CONVK];
#pragma unroll
    for (int j = 0; j < CONVK; ++j) w[j] = *(const f32x2*)(wdw + j * D + c0);
    const f32x2 bd = *(const f32x2*)(bdw + c0), lg = *(const f32x2*)(lng + c0), lb = *(const f32x2*)(lnb + c0);
    for (int item = blockIdx.x; item < T / 32; item += gridDim.x) {
        const int t0 = item * 32, s0 = t0 & (S - 1);
        f32x2 acc[32];
#pragma unroll
        for (int o = 0; o < 32; ++o) acc[o] = bd;
#pragma unroll
        for (int r = 0; r < 62; ++r) {
            unsigned raw = 0u;
            if (s0 - 30 + r >= 0) raw = *(const unsigned*)(U + (size_t)(t0 - 30 + r) * D + c0);
            const f32x2 uv = (f32x2){bf_lo(raw), bf_hi(raw)};
#pragma unroll
            for (int o = (r > 30 ? r - 30 : 0); o <= (r < 31 ? r : 31); ++o) acc[o] = __builtin_elementwise_fma(uv, w[r - o], acc[o]);
        }
        float v[64];
#pragma unroll
        for (int o = 0; o < 32; ++o) { v[o] = acc[o][0] + acc[o][1]; v[32 + o] = acc[o][0] * acc[o][0] + acc[o][1] * acc[o][1]; }
#pragma unroll
        for (int st = 0; st < 6; ++st) {
            const int half = 32 >> st, bit = 32 >> st; const bool up = (lane & bit) != 0;
#pragma unroll
            for (int k = 0; k < half; ++k) { const float send = up ? v[k] : v[k + half]; const float keep = up ? v[k + half] : v[k]; v[k] = keep + __shfl_xor(send, bit); }
        }
        red[wv * 64 + lane] = v[0];
        __syncthreads();
        if (tid < 64) { float s = 0.f;
#pragma unroll
            for (int q = 0; q < 8; ++q) s += red[q * 64 + tid];
            tot[tid] = s; }
        __syncthreads();
#pragma unroll
        for (int o = 0; o < 32; ++o) {
            const float mu = tot[o] * (1.0f / D), var = tot[32 + o] * (1.0f / D) - mu * mu, rstd = rsqrtf(var + EPS);
            const float y0 = (acc[o][0] - mu) * rstd * lg[0] + lb[0], y1 = (acc[o][1] - mu) * rstd * lg[1] + lb[1];
            *(unsigned*)(CV + (size_t)(t0 + o) * D + c0) = cvt_pk_bf16(y0 * fast_sigmoid(y0), y1 * fast_sigmoid(y1));
        }
        __syncthreads();
    }
}

enum Ph { PH_PREP0 = 0, PH_CONV_IN, PH_CONV_MID, PH_CONV_OUT, PH_ADAPT, PH_XA_PREP, PH_XA_Q, PH_XA_KV, PH_XA_S, PH_XA_PV, PH_XA_O, PH_ROUTE_PREP, PH_ROUTE, PH_BUILD, PH_MOE1, PH_MOE2, PH_COMBINE, PH_COMBINE_FIN, PH_GLA_PREP, PH_GLA_DECAY, PH_GLA_IN, PH_GLA_ATT, PH_GLA_UT, PH_GLA_SCAN, PH_GLA_O, PH_GLA_FIN, PH_GLA_OUT, PH_NOP, PH_CSUM, PH_FLAGOUT, PH_CSUM2, PH_XA_S_DIAG, PH_N };

__device__ __forceinline__ void run_phase(const Ctx& c, int ph, int l, LAS unsigned char* lds) {
    unsigned char* ws = c.ws;
    bf16_t* XB = (bf16_t*)(ws + OW_XB); float* RS = (float*)(ws + OW_RS); float* SSP = (float*)(ws + OW_SSP);
    bf16_t* ACTA = (bf16_t*)(ws + OW_ACTA); bf16_t* ACTB = (bf16_t*)(ws + OW_ACTB);
    bf16_t* WCIN = (bf16_t*)(ws + OW_WCIN); bf16_t* WCOUT = (bf16_t*)(ws + OW_WCOUT);
    bf16_t* ACTC = (bf16_t*)(ws + OW_ACTC); float* PSUM = (float*)(ws + OW_PSUM);
    bf16_t* WXQ = (bf16_t*)(ws + OW_WXQ) + (size_t)l * D * D; bf16_t* WXKV = (bf16_t*)(ws + OW_WXKV) + (size_t)l * 2048 * D; bf16_t* WXO = (bf16_t*)(ws + OW_WXO) + (size_t)l * D * D;
    float* WR = (float*)(ws + OW_WR) + (size_t)l * 36 * 1024;
    int* GCNT = (int*)(ws + OM_GCNT); int* NTP = (int*)(ws + OM_NT); int* TILEE = (int*)(ws + OM_TILEE); int* AE = (int*)(ws + OM_AE); int* APOS = (int*)(ws + OM_APOS); float* GATE = (float*)(ws + OM_GATE);
    int* STOK = (int*)(ws + OM_STOK); int* SA = (int*)(ws + OM_SA); float* SRS = (float*)(ws + OM_SRS); float* SGATE = (float*)(ws + OM_SGATE);
    bf16_t* HB = (bf16_t*)(ws + OW_H); bf16_t* YB = (bf16_t*)(ws + OW_Y); bf16_t* W1 = (bf16_t*)(ws + OW_WMOE); bf16_t* W2 = W1 + (size_t)NE * D * D;
    bf16_t* ATTB = (bf16_t*)(ws + OW_ATT); bf16_t* QKR = (bf16_t*)(ws + OW_QKR); bf16_t* KVT = (bf16_t*)(ws + OW_KVT); float* BTM = (float*)(ws + OW_BTM); float* BFM = (float*)(ws + OW_BFM);
    bf16_t* OB = (bf16_t*)(ws + OW_O); bf16_t* UTB = (bf16_t*)(ws + OW_UT); bf16_t* SPB = (bf16_t*)(ws + OW_SP); float* ALR = (float*)(ws + OW_ALR); float* DLF = (float*)(ws + OW_DL); bf16_t* GOB = (bf16_t*)(ws + OW_GO);
    bf16_t* WGTM = (bf16_t*)(ws + OW_WGTM); bf16_t* WGFM = (bf16_t*)(ws + OW_WGFM); bf16_t* WGO = (bf16_t*)(ws + OW_WGO); float* WAF = (float*)(ws + OW_WA);
    bf16_t* KB = (bf16_t*)(ws + OW_KVB); bf16_t* VT = KB + (size_t)1024 * 1024; bf16_t* MEMNB = (bf16_t*)(ws + OW_MEMNB);
    switch (ph) {
    case PH_PREP0:
        cvt_matrix(c.in[7], 2048, 0, 1024, D, c.in[2], WCIN, 1, 0, lds);
        cvt_matrix(c.in[7], 2048, 1024, 1024, D, c.in[2], WCIN, 1, 1, lds, 512);
        cvt_matrix(c.in[13], D, 0, D, D, nullptr, WCOUT, 0, 0, lds, 1024);
        rows_prep(c.in[0], XB, RS, nullptr, T);
        { const int tix = otid(); if (blockIdx.x == 0 && tix < 32) ((unsigned*)(ws + OW_DBG))[tix] = 0u; }
        break;
    case PH_CONV_IN: { g8::DenseSched S{8, 128 * 8, D, D, D, XB, WCIN}; g8::gemm_phase(lds, S, g8::EpiGlu{ACTA, RS, c.in[8]}); } break;
    case PH_CONV_MID: conv_phase(ACTA, c.in[9], c.in[10], c.in[11], c.in[12], ACTB, lds); break;
    case PH_CONV_OUT: { g8::DenseSched S{4, 128 * 4, D, D, D, ACTB, WCOUT}; g8::gemm_phase(lds, S, g8::EpiXres{c.in[0], c.out, XB, c.in[14], SSP}); } break;
    case PH_ADAPT: rows_prep(c.out, XB, RS, SSP, T); break;
    case PH_XA_PREP:
        cvt_matrix(c.in[20] + (size_t)l * D * D, D, 0, D, D, c.in[3] + l * D, WXQ, 0, 0, lds);
        cvt_matrix(c.in[21] + (size_t)l * D * 2048, 2048, 0, 2048, D, nullptr, WXKV, 0, 0, lds, 512);
        cvt_matrix(c.in[22] + (size_t)l * D * D, D, 0, D, D, nullptr, WXO, 0, 0, lds, 1536);
        rows_norm_bf16(c.in[1], c.in[5], MEMNB, NB * NMEM);
        break;
    case PH_XA_Q: { g8::DenseSched S{4, 128 * 4, D, D, D, XB, WXQ}; g8::gemm_phase(lds, S, g8::EpiRowScale{ACTA, D, SSP, nullptr, 0.0625f, 0, 1.0f}); } break;
    case PH_XA_KV: { g8::KVSched S{D, D, D, MEMNB, WXKV}; g8::gemm_phase(lds, S, g8::EpiKV{KB, VT}); } break;
    case PH_XA_S: { g8::AttnSched S{256, D, D, ACTA, KB, 0}; g8::gemm_phase(lds, S, g8::EpiS{ACTB, PSUM}); } break;
    case PH_XA_S_DIAG: { g8::AttnSched S{256, D, D, ACTA, KB, 0}; g8::gemm_phase(lds, S, g8::EpiRaw{ACTC}); } break;
    case PH_XA_PV: { g8::AttnSched S{256, D, 256, ACTB, VT, 1}; g8::gemm_phase(lds, S, g8::EpiPV{ACTC, PSUM}); } break;
    case PH_XA_O: { g8::DenseSched S{4, 128 * 4, D, D, D, ACTC, WXO}; g8::gemm_phase(lds, S, g8::EpiXres{c.out, c.out, XB, nullptr, nullptr}); } break;
    case PH_ROUTE_PREP: route_prep(c.in[23] + (size_t)l * D * NG, c.in[25] + (size_t)l * D * NE, c.in[4] + l * D, WR);
        { const int tix = otid(); if (blockIdx.x == 0 && tix < 32) GCNT[tix] = 0; }
        break;
    case PH_ROUTE: route_phase(c.out, WR, c.in[24] + l * NG, c.in[26] + l * NE, RS, AE, APOS, GATE, GCNT, lds); break;
    case PH_BUILD: build_phase(GCNT, AE, APOS, GATE, RS, NTP, TILEE, STOK, SA, SRS, SGATE, lds);
        cvt_moe(c.in[27] + (size_t)l * NE * D * DE, c.in[28] + (size_t)l * NE * D * DE, c.in[29] + (size_t)l * NE * DE * D, c.in[4] + l * D, W1, W2, lds);
        break;
    case PH_MOE1: { g8::MoeSched S{D, D, D, XB, W1, (size_t)D * D, TILEE, STOK, __builtin_amdgcn_readfirstlane(g8::ld_agent(NTP))}; g8::gemm_phase(lds, S, g8::EpiMoe1{HB, SRS}); } break;
    case PH_MOE2: { g8::MoeSched S{DE, DE, DE, HB, W2, (size_t)D * DE, TILEE, nullptr, __builtin_amdgcn_readfirstlane(g8::ld_agent(NTP))}; g8::gemm_phase(lds, S, g8::EpiMoe2{YB, SA, SGATE}); } break;
    case PH_COMBINE: combine_phase(c.out, YB, XB, RS, SSP, nullptr, 0, WAF, ALR, lds); break;
    case PH_COMBINE_FIN: combine_phase(c.out, YB, XB, RS, SSP, c.in[6], 1, nullptr, nullptr, lds); break;
    case PH_GLA_PREP: gla_prep(c.in[15], c.in[19], c.in[2] + D, WGTM, WGFM, WGO, WAF, lds); break;
    case PH_GLA_DECAY: gla_decay(ALR, c.in[16], c.in[17], BTM, BFM, DLF); break;
    case PH_GLA_IN: { g8::GlaInSched S{XB, WGTM, WGFM}; g8::gemm_phase(lds, S, g8::EpiGlaIn{QKR, KVT, RS, BTM, BFM}); } break;
    case PH_GLA_ATT: { g8::GlaAttSched<0> S{QKR, KVT}; g8::gemm_phase(lds, S, g8::EpiGlaAtt<0>{ATTB, UTB, DLF}); } break;
    case PH_GLA_UT: { g8::GlaAttSched<1> S{QKR, KVT}; g8::gemm_phase(lds, S, g8::EpiGlaAtt<1>{ATTB, UTB, DLF}); } break;
    case PH_GLA_SCAN: gla_scan(UTB, DLF, SPB); break;
    case PH_GLA_O: { g8::GlaOSched S{QKR, KVT, ATTB, SPB}; g8::gemm_phase(lds, S, g8::EpiGlaO{OB}); } break;
    case PH_GLA_FIN: gla_fin(OB, QKR, c.in[18], GOB); break;
    case PH_CSUM: { static const size_t ro[10] = {OW_ACTA, OW_ACTB, OW_ACTC, OW_H, OW_Y, OW_QKR, OW_ATT, OW_UT, OW_O, OW_KVB};
        static const size_t rb[10] = {64 * MiB, 64 * MiB, 64 * MiB, 72 * MiB, 128 * MiB, 224 * MiB, 64 * MiB, 32 * MiB, 64 * MiB, 4 * MiB};
        const int r = l >> 1; csum_phase(ws + ro[r], rb[r], (unsigned long long*)(ws + OW_DBG) + 512 + r * 256, (unsigned*)(ws + OW_DBG) + r, l & 1, lds); } break;
    case PH_CSUM2: {
        const unsigned char* bp; size_t nb;
        switch (l) {
        case 0: bp = ws + OW_XB; nb = 64 * MiB; break;            case 1: bp = ws + OW_ACTA; nb = 64 * MiB; break;
        case 2: bp = ws + OW_ACTB; nb = 64 * MiB; break;          case 3: bp = (const unsigned char*)c.out; nb = 128 * MiB; break;
        case 4: bp = ws + OW_ACTA; nb = 64 * MiB; break;          case 5: bp = ws + OW_ACTC; nb = 64 * MiB; break;
        case 6: bp = ws + OW_ACTB; nb = 64 * MiB; break;          case 7: bp = ws + OW_ACTC; nb = 64 * MiB; break;
        case 8: bp = (const unsigned char*)c.out; nb = 128 * MiB; break;   case 9: bp = ws + OM_GATE; nb = NA * 4; break;
        case 10: bp = ws + OW_Y; nb = 128 * MiB; break;           case 11: bp = (const unsigned char*)c.out; nb = 128 * MiB; break;
        case 12: bp = ws + OW_BTM; nb = 128 * MiB; break;         case 13: bp = ws + OW_QKR; nb = 224 * MiB; break;
        case 14: bp = ws + OW_ATT; nb = 64 * MiB; break;          case 15: bp = ws + OW_UT; nb = 32 * MiB; break;
        case 16: bp = ws + OW_SP; nb = 32 * MiB; break;           case 17: bp = ws + OW_O; nb = 64 * MiB; break;
        case 18: bp = ws + OW_GO; nb = 64 * MiB; break;           case 19: bp = (const unsigned char*)c.out; nb = 128 * MiB; break;
        case 20: bp = ws + OW_ACTA; nb = 64 * MiB; break;         case 21: bp = ws + OW_ACTB; nb = 64 * MiB; break;
        case 22: bp = ws + OW_ACTC; nb = 64 * MiB; break;         case 23: bp = (const unsigned char*)c.out; nb = 128 * MiB; break;
        case 24: bp = ws + OM_GATE; nb = NA * 4; break;           case 25: bp = ws + OW_Y; nb = 128 * MiB; break;
        case 26: bp = ws + OW_RS; nb = T * 4; break;              case 27: bp = ws + OW_ALR; nb = 2 * MiB; break;
        default: bp = ws + OW_SSP; nb = 2 * MiB; break; }
        csum2_phase(bp, nb, (unsigned long long*)(ws + OW_DBG + 65536) + (size_t)l * 512, (unsigned*)(ws + OW_DBG) + l, lds); } break;
    case PH_FLAGOUT: flagout_phase(c.out, (unsigned*)(ws + OW_DBG)); break;
    case PH_GLA_OUT: { g8::DenseSched S{4, 128 * 4, D, D, D, GOB, WGO}; g8::gemm_phase(lds, S, g8::EpiXres{c.out, c.out, XB, nullptr, SSP}); } break;
    }
}
template <int PH> __global__ void __launch_bounds__(512, 2) k_opt(Ctx c, int l) {
    extern __shared__ __attribute__((aligned(16))) unsigned char dynlds[];
    run_phase(c, PH, l, (LAS unsigned char*)dynlds);
}
#ifndef ALLCG
#define ALLCG 0
#endif
#ifndef COOP
#define COOP 1
#endif
enum Op { OP_MEMN = 0, OP_MEMKV, OP_COPYX, OP_RMS_MIX, OP_CONV_IN, OP_GLU, OP_DWCONV, OP_CONV_OUT, OP_GLA_IN, OP_GLA_DECAY, OP_GLA_REC, OP_GLA_NORM, OP_GLA_OUT,
          OP_RMS_XA, OP_XA_Q, OP_XA_ATT, OP_XA_O, OP_RMS_FFN, OP_ROUTE, OP_BUILD, OP_MOE_GATE, OP_MOE_UP, OP_MOE_ACT, OP_MOE_DOWN, OP_MOE_COMBINE, OP_FINAL };

__device__ __forceinline__ void run_op(const Ctx& c, int op, int l, float* sm) {
    unsigned char* ws = c.ws;
    float* HN = (float*)(ws + WS_HN); float* BIG = (float*)(ws + WS_BIG);
    float* MEMN = (float*)(ws + WS_MEMN); float* KV = (float*)(ws + WS_KV) + (size_t)l * 1024 * 2048;
    int* eid = (int*)(ws + WS_EID); float* gate = (float*)(ws + WS_GATE); int* pos = (int*)(ws + WS_POS);
    int* slot_tok = (int*)(ws + WS_SLOTTOK); int* slot_a = (int*)(ws + WS_SLOTA); int* tile_e = (int*)(ws + WS_TILEE); int* cnt = (int*)(ws + WS_CNT);
    float* X = c.out;
    switch (op) {
    case OP_MEMN: n_rms(c.in[1], c.in[5], MEMN, NB * NMEM); break;
    case OP_MEMKV: n_gemm(sm, MEMN, D, nullptr, c.in[21] + (size_t)l * D * 2048, 2048, 0, nullptr, NB * NMEM, 2048, D, EpiStore{KV, 2048, nullptr}); break;
    case OP_COPYX: n_copy4(c.in[0], X, (size_t)T * D / 4); break;
    case OP_RMS_MIX: n_rms(X, c.in[2] + l * D, HN, T); break;
    case OP_CONV_IN: n_gemm(sm, HN, D, nullptr, c.in[7], 2048, 0, nullptr, T, 2048, D, EpiStore{BIG, 2048, c.in[8]}); break;
    case OP_GLU: n_glu(BIG, HN); break;
    case OP_DWCONV: n_dwconv(HN, c.in[9], c.in[10], c.in[11], c.in[12], BIG); break;
    case OP_CONV_OUT: n_gemm(sm, BIG, D, nullptr, c.in[13], D, 0, nullptr, T, D, D, EpiResid{X, D, c.in[14]}); break;
    case OP_GLA_IN: n_gemm(sm, HN, D, nullptr, c.in[15], GLA_COLS, 0, nullptr, T, GLA_COLS, D, EpiStore{BIG, GLA_COLS, nullptr}); break;
    case OP_GLA_DECAY: n_gla_decay(BIG, c.in[16], c.in[17], HN); break;
    case OP_GLA_REC: n_gla_rec(BIG, HN); break;
    case OP_GLA_NORM: n_gla_norm(BIG, c.in[18], HN); break;
    case OP_GLA_OUT: n_gemm(sm, HN, D, nullptr, c.in[19], D, 0, nullptr, T, D, D, EpiResid{X, D, nullptr}); break;
    case OP_RMS_XA: n_rms(X, c.in[3] + l * D, HN, T); break;
    case OP_XA_Q: n_gemm(sm, HN, D, nullptr, c.in[20] + (size_t)l * D * D, D, 0, nullptr, T, D, D, EpiStore{BIG, D, nullptr}); break;
    case OP_XA_ATT: n_attn(BIG, KV, BIG + (size_t)T * D); break;
    case OP_XA_O: n_gemm(sm, BIG + (size_t)T * D, D, nullptr, c.in[22] + (size_t)l * D * D, D, 0, nullptr, T, D, D, EpiResid{X, D, nullptr}); break;
    case OP_RMS_FFN: n_rms(X, c.in[4] + l * D, HN, T); n_moe_init(cnt, slot_tok, slot_a, tile_e); break;
    case OP_ROUTE: n_route(HN, c.in[23] + (size_t)l * D * NG, c.in[24] + l * NG, c.in[25] + (size_t)l * D * NE, c.in[26] + l * NE, eid, gate, pos, cnt); break;
    case OP_BUILD: n_moe_build(eid, pos, cnt, slot_tok, slot_a, tile_e); break;
    case OP_MOE_GATE: n_gemm(sm, HN, D, slot_tok, c.in[27] + (size_t)l * NE * D * DE, DE, (size_t)D * DE, tile_e, NSLOT, DE, D, EpiStore{BIG, DE, nullptr}); break;
    case OP_MOE_UP: n_gemm(sm, HN, D, slot_tok, c.in[28] + (size_t)l * NE * D * DE, DE, (size_t)D * DE, tile_e, NSLOT, DE, D, EpiStore{BIG + (size_t)NSLOT * DE, DE, nullptr}); break;
    case OP_MOE_ACT: n_moe_act(BIG, BIG + (size_t)NSLOT * DE); break;
    case OP_MOE_DOWN: n_gemm(sm, BIG, DE, nullptr, c.in[29] + (size_t)l * NE * DE * D, D, (size_t)DE * D, tile_e, NSLOT, D, DE, EpiMoeDown{BIG + (size_t)NSLOT * DE, slot_a, gate}); break;
    case OP_MOE_COMBINE: n_moe_combine(X, BIG + (size_t)NSLOT * DE); break;
    case OP_FINAL: n_rms(X, c.in[6], X, T); break;
    }
}

template <int OP> __global__ void __launch_bounds__(512) k_stage(Ctx c, int l) {
    __shared__ float sm[16 * 132 + 16 * 260];
    run_op(c, OP, l, sm);
}
typedef void (*StageFn)(Ctx, int);
template <int... I> struct Seq {};
template <int N, int... I> struct MkSeq : MkSeq<N - 1, N - 1, I...> {};
template <int... I> struct MkSeq<0, I...> { typedef Seq<I...> type; };
template <int... I> static void fill_tab(StageFn* t, Seq<I...>) { StageFn f[] = {k_stage<I>...}; for (unsigned i = 0; i < sizeof...(I); ++i) t[i] = f[i]; }
template <int... I> static void fill_tab_opt(StageFn* t, Seq<I...>) { StageFn f[] = {k_opt<I>...}; for (unsigned i = 0; i < sizeof...(I); ++i) t[i] = f[i]; }

#define XB_TMO      128
#define XB_XCNT(j)  (256  + 64 * (j))
#define XB_XSUB(j)  (1280 + 64 * (j))
#define XB_XGEN(j)  (2304 + 64 * (j))
#define XB_TOP      3328
#define XB_TOPGEN   3392
#define XCD_BAR_WORDS 3456
#define XB_SPIN_CAP (1u << 18)
__device__ __forceinline__ unsigned xb_ld(unsigned* p)              { return __hip_atomic_load(p, __ATOMIC_RELAXED, __HIP_MEMORY_SCOPE_AGENT); }
__device__ __forceinline__ unsigned xb_add(unsigned* p, unsigned v) { return __hip_atomic_fetch_add(p, v, __ATOMIC_RELAXED, __HIP_MEMORY_SCOPE_AGENT); }
__device__ __forceinline__ unsigned xb_xcc_id() { return (unsigned)__builtin_amdgcn_s_getreg((3 << 11) | 20) & 0xFu; }
#define XB_SPIN(cond, bar) do { unsigned _sp = 0; while (cond) { __builtin_amdgcn_s_sleep(1); \
    if ((++_sp & 255u) == 0u) { if (xb_ld(&(bar)[XB_TMO])) break; if (_sp > XB_SPIN_CAP) { atomicAdd(&(bar)[XB_TMO], 1u); break; } } } } while (0)
struct XcdBarrier { unsigned* bar; unsigned x; volatile LAS unsigned* st; };
__device__ __forceinline__ XcdBarrier xcd_barrier_post(unsigned* bar, volatile LAS unsigned* st) {
    XcdBarrier b; b.bar = bar; b.x = xb_xcc_id(); b.st = st;
    if (threadIdx.x == 0) (void)xb_add(&bar[XB_XCNT(b.x)], 1u);
    return b;
}
__device__ __forceinline__ void xcd_barrier_complete(unsigned* bar, unsigned x, unsigned& nloc, unsigned& nx) {
    const unsigned G = gridDim.x * gridDim.y * gridDim.z;
    unsigned sum, cnt, mine, sp = 0u;
    for (;;) {
        sum = 0u; cnt = 0u; mine = 0u;
#pragma unroll
        for (unsigned j = 0; j < 16; ++j) { const unsigned c = xb_ld(&bar[XB_XCNT(j)]); sum += c; cnt += (c > 0u) ? 1u : 0u; mine = (j == x) ? c : mine; }
        if (sum == G) break;
        __builtin_amdgcn_s_sleep(1);
        if ((++sp & 255u) == 0u) { if (xb_ld(&bar[XB_TMO])) break; if (sp > XB_SPIN_CAP) { atomicAdd(&bar[XB_TMO], 1u); break; } }
    }
    nloc = mine > 0u ? mine : 1u; nx = cnt > 0u ? cnt : 1u;
}
__device__ __forceinline__ void xcd_barrier(const XcdBarrier& b) {
    asm volatile("s_waitcnt vmcnt(0)" ::: "memory");
    __syncthreads();
    if (threadIdx.x == 0) {
        unsigned* bar = b.bar;
        __builtin_amdgcn_s_waitcnt(0);
        unsigned nloc = b.st[0], nx = b.st[1];
        if (nloc == 0u) { xcd_barrier_complete(bar, b.x, nloc, nx); b.st[0] = nloc; b.st[1] = nx; }
        __builtin_amdgcn_fence(__ATOMIC_RELEASE, "agent");
        asm volatile("s_waitcnt vmcnt(0)" ::: "memory");
        const unsigned old = xb_add(&bar[XB_XSUB(b.x)], 1u);
        const unsigned gen = old / nloc;
        if (old + 1u == (gen + 1u) * nloc) {
            const unsigned og = xb_add(&bar[XB_TOP], 1u);
            const unsigned tg = og / nx;
            if (og + 1u == (tg + 1u) * nx) xb_add(&bar[XB_TOPGEN], 1u);
            else XB_SPIN(xb_ld(&bar[XB_TOPGEN]) == tg, bar);
            __builtin_amdgcn_fence(__ATOMIC_ACQUIRE, "agent");
            xb_add(&bar[XB_XGEN(b.x)], 1u);
            asm volatile("s_waitcnt vmcnt(0)" ::: "memory");
        } else {
            XB_SPIN(xb_ld(&bar[XB_XGEN(b.x)]) == gen, bar);
            __builtin_amdgcn_fence(__ATOMIC_ACQUIRE, "agent");
            asm volatile("s_waitcnt vmcnt(0)" ::: "memory");
        }
    }
    __syncthreads();
}
template <int CODE> __device__ __forceinline__ void coop_step(const Ctx& c, LAS unsigned char* lds, cg::grid_group& grid, XcdBarrier& xb, bool sync_after, bool first) {
    run_phase(c, CODE >> 5, CODE & 31, lds);
    if (sync_after) {
        if (first || ALLCG) {
            unsigned* bar = (unsigned*)(c.ws + OW_BAR);
            if (first && blockIdx.x == 0) for (int i = threadIdx.x; i < XCD_BAR_WORDS; i += 512) bar[i] = 0u;
            asm volatile("s_waitcnt vmcnt(0) lgkmcnt(0)" ::: "memory");
            grid.sync();
            if (threadIdx.x < 64) { __builtin_amdgcn_fence(__ATOMIC_ACQUIRE, "agent"); asm volatile("s_waitcnt vmcnt(0)" ::: "memory"); }
            __syncthreads();
            if (first) xb = xcd_barrier_post(bar, xb.st);
        } else xcd_barrier(xb);
    }
}
template <int... CODES> __global__ void __launch_bounds__(512, 2) k_coop(Ctx c) {
    extern __shared__ __attribute__((aligned(16))) unsigned char dynlds[];
    cg::grid_group grid = cg::this_grid();
    LAS unsigned char* lds = (LAS unsigned char*)dynlds;
    volatile LAS unsigned* st = (volatile LAS unsigned*)(lds + LDS_BYTES - 16);
    if (threadIdx.x < 4) st[threadIdx.x] = 0u;
    __syncthreads();
    XcdBarrier xb; xb.bar = nullptr; xb.x = 0; xb.st = st;
    int idx = 0; constexpr int N = sizeof...(CODES);
    ((coop_step<CODES>(c, lds, grid, xb, idx + 1 < N, idx == 0), ++idx), ...);
}
#define CODE(ph, l) ((ph) * 32 + (l))
typedef void (*CoopFn)(Ctx);
struct Step { int kind, op, l; };
static const Step g_prog[] = { {1, 0, 0} };
constexpr int NSTEP = sizeof(g_prog) / sizeof(g_prog[0]);

extern "C" void kernel_launch(void* const* d_in, const int* in_sizes, int n_in, void* d_out, int out_size, void* d_ws, size_t ws_size, hipStream_t stream) {
    if (n_in != 30 || out_size != T * D || ws_size < OW_END || ws_size < WS_END) { fprintf(stderr, "kernel_launch: bad args n_in %d out %d ws %zu\n", n_in, out_size, ws_size); return; }
    Ctx c; memset(&c, 0, sizeof(c));
    for (int i = 0; i < 30; ++i) c.in[i] = (const float*)d_in[i];
    c.out = (float*)d_out; c.ws = (unsigned char*)d_ws;
    static StageFn tab[OP_FINAL + 1], tabo[PH_N];
    static bool init = false;
    if (!init) { fill_tab(tab, MkSeq<OP_FINAL + 1>::type()); fill_tab_opt(tabo, MkSeq<PH_N>::type());
        for (int i = 0; i < PH_N; ++i) hipFuncSetAttribute((const void*)tabo[i], hipFuncAttributeMaxDynamicSharedMemorySize, LDS_BYTES);
        init = true; }
#if COOP
    static int coop_grid = 0;
    static CoopFn coop_fns[2] = { k_coop<CODE(PH_PREP0, 0), CODE(PH_CONV_IN, 0), CODE(PH_CONV_MID, 0), CODE(PH_CONV_OUT, 0), CODE(PH_XA_PREP, 0), CODE(PH_XA_Q, 0), CODE(PH_XA_KV, 0), CODE(PH_XA_S, 0), CODE(PH_XA_PV, 0), CODE(PH_XA_O, 0),
                                         CODE(PH_ROUTE_PREP, 0), CODE(PH_ROUTE, 0), CODE(PH_BUILD, 0), CODE(PH_MOE1, 0), CODE(PH_MOE2, 0), CODE(PH_GLA_PREP, 0), CODE(PH_COMBINE, 0),
                                         CODE(PH_GLA_DECAY, 0), CODE(PH_GLA_IN, 0), CODE(PH_GLA_ATT, 0), CODE(PH_GLA_UT, 0), CODE(PH_GLA_SCAN, 0), CODE(PH_GLA_O, 0), CODE(PH_GLA_FIN, 0), CODE(PH_GLA_OUT, 0),
                                         CODE(PH_XA_PREP, 1), CODE(PH_XA_Q, 1), CODE(PH_XA_KV, 1), CODE(PH_XA_S, 1), CODE(PH_XA_PV, 1), CODE(PH_XA_O, 1),
                                         CODE(PH_ROUTE_PREP, 1), CODE(PH_ROUTE, 1), CODE(PH_BUILD, 1), CODE(PH_MOE1, 1), CODE(PH_MOE2, 1), CODE(PH_COMBINE_FIN, 1)>, nullptr };
    if (!coop_grid) { int dev = 0, cus = 0, per_cu = 0; hipGetDevice(&dev); hipDeviceGetAttribute(&cus, hipDeviceAttributeMultiprocessorCount, dev);
        for (int k = 0; k < 1; ++k) hipFuncSetAttribute((const void*)coop_fns[k], hipFuncAttributeMaxDynamicSharedMemorySize, LDS_BYTES);
        hipOccupancyMaxActiveBlocksPerMultiprocessor(&per_cu, coop_fns[0], 512, LDS_BYTES);
        coop_grid = cus * (per_cu < 1 ? 1 : per_cu); if (coop_grid > 256) coop_grid = 256;
        fprintf(stderr, "kernel_launch: cus %d per_cu %d grid %d\n", cus, per_cu, coop_grid); }
    int ncoop = 0;
#endif
    for (int i = 0; i < NSTEP; ++i) {
        if (g_prog[i].kind == 0) { hipLaunchKernelGGL(tab[g_prog[i].op], dim3(1024), dim3(512), 0, stream, c, g_prog[i].l); continue; }
#if COOP
        while (i < NSTEP && g_prog[i].kind == 1) ++i;
        --i;
        void* args[] = {&c};
        hipError_t e = hipLaunchCooperativeKernel((void*)coop_fns[ncoop++], dim3(coop_grid), dim3(512), args, LDS_BYTES, stream);
        if (e != hipSuccess) fprintf(stderr, "cooperative launch failed: %s\n", hipGetErrorString(e));
#else
        hipLaunchKernelGGL(tabo[g_prog[i].op], dim3(256), dim3(512), LDS_BYTES, stream, c, g_prog[i].l);
#endif
    }
}
```

```cpp
#include <hip/hip_runtime.h>
#include <hip/hip_cooperative_groups.h>
#include <cstdio>
#include <cstring>
namespace cg = cooperative_groups;

#ifndef MEGA
#define MEGA 0
#endif

constexpr int D = 1024, NB = 4, S = 8192, T = NB * S, NMEM = 256, DEPTH = 2;
constexpr int CONVK = 31;
constexpr int GH = 4, GDK = 512, GDV = 1024, GDKH = 128, GDVH = 256, GRANK = 16, GLA_COLS = 3088;
constexpr int XH = 4, XHD = 256;
constexpr int NG = 4, EPG = 8, NE = 32, DE = 512;
constexpr int NA = T * 2;
constexpr int NSLOT = NA + NE * 128;
constexpr float EPS = 1e-6f;

constexpr size_t MiB = 1u << 20;
constexpr size_t WS_HN = 0;
constexpr size_t WS_BIG = 128 * MiB;
constexpr size_t WS_SMALL = 528 * MiB;
constexpr size_t WS_MEMN = WS_SMALL;
constexpr size_t WS_KV = WS_MEMN + 4 * MiB;
constexpr size_t WS_EID = WS_KV + 16 * MiB;
constexpr size_t WS_GATE = WS_EID + NA * 4;
constexpr size_t WS_POS = WS_GATE + NA * 4;
constexpr size_t WS_SLOTTOK = WS_POS + NA * 4;
constexpr size_t WS_SLOTA = WS_SLOTTOK + NSLOT * 4;
constexpr size_t WS_TILEE = WS_SLOTA + NSLOT * 4;
constexpr size_t WS_CNT = WS_TILEE + 4096;
constexpr size_t WS_END = WS_CNT + 4096;

struct Ctx {
    const float* in[30];
    float* out;
    unsigned char* ws;
};

__device__ __forceinline__ float wave_sum(float v) {
#pragma unroll
    for (int o = 1; o < 64; o <<= 1) v += __shfl_xor(v, o);
    return v;
}
__device__ __forceinline__ float wave_max(float v) {
#pragma unroll
    for (int o = 1; o < 64; o <<= 1) v = fmaxf(v, __shfl_xor(v, o));
    return v;
}
__device__ __forceinline__ float sigmoidf_(float x) { return 1.0f / (1.0f + expf(-x)); }
__device__ __forceinline__ float siluf_(float x) { return x / (1.0f + expf(-x)); }

__device__ void n_rms(const float* x, const float* g, float* out, int rows) {
    const int lane = threadIdx.x & 63;
    const int gw = (blockIdx.x * blockDim.x + threadIdx.x) >> 6, ngw = (gridDim.x * blockDim.x) >> 6;
    for (int r = gw; r < rows; r += ngw) {
        const float4* xr = (const float4*)(x + (size_t)r * D);
        float4 v[4]; float s = 0.f;
#pragma unroll
        for (int j = 0; j < 4; ++j) { v[j] = xr[lane + 64 * j]; s += v[j].x * v[j].x + v[j].y * v[j].y + v[j].z * v[j].z + v[j].w * v[j].w; }
        s = wave_sum(s);
        const float rs = rsqrtf(s * (1.0f / D) + EPS);
        float4* o = (float4*)(out + (size_t)r * D);
#pragma unroll
        for (int j = 0; j < 4; ++j) { const float4 gg = ((const float4*)g)[lane + 64 * j];
            o[lane + 64 * j] = make_float4(v[j].x * rs * gg.x, v[j].y * rs * gg.y, v[j].z * rs * gg.z, v[j].w * rs * gg.w); }
    }
}
__device__ void n_copy4(const float* src, float* dst, size_t n4) {
    const size_t g = (size_t)blockIdx.x * blockDim.x + threadIdx.x, gs = (size_t)gridDim.x * blockDim.x;
    for (size_t i = g; i < n4; i += gs) ((float4*)dst)[i] = ((const float4*)src)[i];
}

struct EpiStore { float* C; int ldc; const float* bias;
    __device__ __forceinline__ void operator()(int m, int n, float acc) const { C[(size_t)m * ldc + n] = acc + (bias ? bias[n] : 0.f); } };
struct EpiResid { float* X; int ldc; const float* bias;
    __device__ __forceinline__ void operator()(int m, int n, float acc) const { X[(size_t)m * ldc + n] += acc + (bias ? bias[n] : 0.f); } };
struct EpiMoeDown { float* Y; const int* slot_a; const float* gate;
    __device__ __forceinline__ void operator()(int m, int n, float acc) const { const int a = slot_a[m]; if (a >= 0) Y[(size_t)a * D + n] = acc * gate[a]; } };

template <class Epi>
__device__ void n_gemm(float* sm, const float* A, int lda, const int* arow, const float* W, int ldw, size_t wstride, const int* tile_e,
                       int M, int N, int K, Epi epi) {
    float* As = sm;
    float* Bs = sm + 16 * 132;
    const int tid = threadIdx.x, ty = tid >> 5, tx = tid & 31;
    const int ntm = M / 128, ntn = (N + 255) / 256;
    for (int tile = blockIdx.x; tile < ntm * ntn; tile += gridDim.x) {
        const int mt = tile / ntn, nt = tile % ntn;
        const float* Wb = W;
        if (tile_e) { const int e = tile_e[mt]; if (e < 0) continue; Wb = W + (size_t)e * wstride; }
        const int m0 = mt * 128, n0 = nt * 256;
        float acc[8][8];
#pragma unroll
        for (int i = 0; i < 8; ++i)
#pragma unroll
            for (int j = 0; j < 8; ++j) acc[i][j] = 0.f;
        const int ar = tid >> 2, akq = (tid & 3) * 4;
        const int srow = arow ? arow[m0 + ar] : (m0 + ar);
        const float* ap = srow >= 0 ? A + (size_t)srow * lda : nullptr;
        const int bk = tid >> 6, bn = (tid & 63) * 4;
        for (int k0 = 0; k0 < K; k0 += 16) {
            float4 av = ap ? *(const float4*)(ap + k0 + akq) : make_float4(0.f, 0.f, 0.f, 0.f);
            As[(akq + 0) * 132 + ar] = av.x; As[(akq + 1) * 132 + ar] = av.y; As[(akq + 2) * 132 + ar] = av.z; As[(akq + 3) * 132 + ar] = av.w;
#pragma unroll
            for (int i = 0; i < 2; ++i) {
                const int kk = bk + 8 * i; const int n = n0 + bn;
                float4 bv = (n < N) ? *(const float4*)(Wb + (size_t)(k0 + kk) * ldw + n) : make_float4(0.f, 0.f, 0.f, 0.f);
                *(float4*)(Bs + kk * 260 + bn) = bv;
            }
            __syncthreads();
#pragma unroll
            for (int kk = 0; kk < 16; ++kk) {
                float a[8], b[8];
                *(float4*)(a) = *(const float4*)(As + kk * 132 + ty * 8); *(float4*)(a + 4) = *(const float4*)(As + kk * 132 + ty * 8 + 4);
                *(float4*)(b) = *(const float4*)(Bs + kk * 260 + tx * 8); *(float4*)(b + 4) = *(const float4*)(Bs + kk * 260 + tx * 8 + 4);
#pragma unroll
                for (int i = 0; i < 8; ++i)
#pragma unroll
                    for (int j = 0; j < 8; ++j) acc[i][j] = fmaf(a[i], b[j], acc[i][j]);
            }
            __syncthreads();
        }
#pragma unroll
        for (int i = 0; i < 8; ++i)
#pragma unroll
            for (int j = 0; j < 8; ++j) { const int m = m0 + ty * 8 + i, n = n0 + tx * 8 + j; if (n < N) epi(m, n, acc[i][j]); }
    }
}

__device__ void n_glu(const float* u, float* g) {
    const size_t gi = (size_t)blockIdx.x * blockDim.x + threadIdx.x, gs = (size_t)gridDim.x * blockDim.x;
    for (size_t i = gi; i < (size_t)T * D; i += gs) { const size_t t = i >> 10, c = i & 1023; g[i] = u[t * 2048 + c] * sigmoidf_(u[t * 2048 + 1024 + c]); }
}
__device__ void n_dwconv(const float* g, const float* wdw, const float* bdw, const float* lng, const float* lnb, float* out) {
    const int lane = threadIdx.x & 63;
    const int gw = (blockIdx.x * blockDim.x + threadIdx.x) >> 6, ngw = (gridDim.x * blockDim.x) >> 6;
    for (int t = gw; t < T; t += ngw) {
        const int s = t % S;
        float4 acc[4];
#pragma unroll
        for (int j = 0; j < 4; ++j) acc[j] = ((const float4*)bdw)[lane + 64 * j];
        for (int tap = 0; tap < CONVK; ++tap) {
            const int ss = s - (CONVK - 1) + tap; if (ss < 0) continue;
            const float4* gr = (const float4*)(g + (size_t)(t - (CONVK - 1) + tap) * D);
            const float4* wr = (const float4*)(wdw + (size_t)tap * D);
#pragma unroll
            for (int j = 0; j < 4; ++j) { const float4 a = gr[lane + 64 * j], w = wr[lane + 64 * j];
                acc[j].x = fmaf(a.x, w.x, acc[j].x); acc[j].y = fmaf(a.y, w.y, acc[j].y); acc[j].z = fmaf(a.z, w.z, acc[j].z); acc[j].w = fmaf(a.w, w.w, acc[j].w); }
        }
        float sm_ = 0.f;
#pragma unroll
        for (int j = 0; j < 4; ++j) sm_ += acc[j].x + acc[j].y + acc[j].z + acc[j].w;
        const float mu = wave_sum(sm_) * (1.0f / D);
        float q = 0.f;
#pragma unroll
        for (int j = 0; j < 4; ++j) { acc[j].x -= mu; acc[j].y -= mu; acc[j].z -= mu; acc[j].w -= mu; q += acc[j].x * acc[j].x + acc[j].y * acc[j].y + acc[j].z * acc[j].z + acc[j].w * acc[j].w; }
        const float rstd = rsqrtf(wave_sum(q) * (1.0f / D) + EPS);
        float4* o = (float4*)(out + (size_t)t * D);
#pragma unroll
        for (int j = 0; j < 4; ++j) { const float4 gg = ((const float4*)lng)[lane + 64 * j], bb = ((const float4*)lnb)[lane + 64 * j];
            o[lane + 64 * j] = make_float4(siluf_(acc[j].x * rstd * gg.x + bb.x), siluf_(acc[j].y * rstd * gg.y + bb.y), siluf_(acc[j].z * rstd * gg.z + bb.z), siluf_(acc[j].w * rstd * gg.w + bb.w)); }
    }
}
__device__ void n_attn(const float* q, const float* kv, float* o) {
    const int lane = threadIdx.x & 63;
    const int gw = (blockIdx.x * blockDim.x + threadIdx.x) >> 6, ngw = (gridDim.x * blockDim.x) >> 6;
    for (int it = gw; it < T * XH; it += ngw) {
        const int t = it >> 2, h = it & 3, b = t / S;
        const float4 qv = ((const float4*)(q + (size_t)t * D + h * XHD))[lane];
        const float* kb = kv + (size_t)b * NMEM * 2048 + h * XHD;
        float sc[4];
#pragma unroll
        for (int m4 = 0; m4 < 4; ++m4) {
            float mine = 0.f;
            for (int ml = 0; ml < 64; ++ml) {
                const float4 kk = ((const float4*)(kb + (size_t)(m4 * 64 + ml) * 2048))[lane];
                float p = qv.x * kk.x + qv.y * kk.y + qv.z * kk.z + qv.w * kk.w;
                p = wave_sum(p);
                if (ml == lane) mine = p;
            }
            sc[m4] = mine * 0.0625f;
        }
        float mx = fmaxf(fmaxf(sc[0], sc[1]), fmaxf(sc[2], sc[3])); mx = wave_max(mx);
        float se = 0.f;
#pragma unroll
        for (int m4 = 0; m4 < 4; ++m4) { sc[m4] = expf(sc[m4] - mx); se += sc[m4]; }
        se = wave_sum(se); const float inv = 1.0f / se;
        float4 acc = make_float4(0.f, 0.f, 0.f, 0.f);
        const float* vb = kb + 1024;
#pragma unroll
        for (int m4 = 0; m4 < 4; ++m4)
            for (int ml = 0; ml < 64; ++ml) {
                const float p = __shfl(sc[m4], ml) * inv;
                const float4 vv = ((const float4*)(vb + (size_t)(m4 * 64 + ml) * 2048))[lane];
                acc.x = fmaf(p, vv.x, acc.x); acc.y = fmaf(p, vv.y, acc.y); acc.z = fmaf(p, vv.z, acc.z); acc.w = fmaf(p, vv.w, acc.w);
            }
        ((float4*)(o + (size_t)t * D + h * XHD))[lane] = acc;
    }
}
__device__ void n_moe_init(int* cnt, int* slot_tok, int* slot_a, int* tile_e) {
    const int gi = blockIdx.x * blockDim.x + threadIdx.x, gs = gridDim.x * blockDim.x;
    for (int i = gi; i < NSLOT; i += gs) { slot_tok[i] = -1; slot_a[i] = -1; }
    for (int i = gi; i < NSLOT / 128; i += gs) tile_e[i] = -1;
    if (gi < 32) cnt[gi] = 0;
}
__device__ void n_route(const float* h, const float* wg, const float* bg, const float* we, const float* be, int* eid, float* gate, int* pos, int* cnt) {
    const int lane = threadIdx.x & 63;
    const int gw = (blockIdx.x * blockDim.x + threadIdx.x) >> 6, ngw = (gridDim.x * blockDim.x) >> 6;
    for (int t = gw; t < T; t += ngw) {
        float hv[16];
#pragma unroll
        for (int j = 0; j < 16; ++j) hv[j] = h[(size_t)t * D + j * 64 + lane];
        float gl[4];
#pragma unroll
        for (int o = 0; o < 4; ++o) { float p = 0.f;
#pragma unroll
            for (int j = 0; j < 16; ++j) p = fmaf(hv[j], wg[(size_t)(j * 64 + lane) * NG + o], p);
            gl[o] = wave_sum(p) + bg[o]; }
        int gs = 0; float gm = gl[0];
#pragma unroll
        for (int o = 1; o < 4; ++o) if (gl[o] > gm) { gm = gl[o]; gs = o; }
        float se = 0.f;
#pragma unroll
        for (int o = 0; o < 4; ++o) se += expf(gl[o] - gm);
        const float pg = 1.0f / se;
        float el[8];
#pragma unroll
        for (int o = 0; o < 8; ++o) { float p = 0.f;
#pragma unroll
            for (int j = 0; j < 16; ++j) p = fmaf(hv[j], we[(size_t)(j * 64 + lane) * NE + gs * 8 + o], p);
            el[o] = wave_sum(p) + be[gs * 8 + o]; }
        float em = el[0];
#pragma unroll
        for (int o = 1; o < 8; ++o) em = fmaxf(em, el[o]);
        float pe[8], ps = 0.f;
#pragma unroll
        for (int o = 0; o < 8; ++o) { pe[o] = expf(el[o] - em); ps += pe[o]; }
#pragma unroll
        for (int o = 0; o < 8; ++o) pe[o] = pe[o] / ps;
        int i1 = 0; float p1 = pe[0];
#pragma unroll
        for (int o = 1; o < 8; ++o) if (pe[o] > p1) { p1 = pe[o]; i1 = o; }
        int i2 = -1; float p2 = -1.f;
#pragma unroll
        for (int o = 0; o < 8; ++o) if (o != i1 && pe[o] > p2) { p2 = pe[o]; i2 = o; }
        if (lane == 0) {
            const float den = p1 + p2;
            const int e1 = gs * 8 + i1, e2 = gs * 8 + i2;
            eid[2 * t] = e1; eid[2 * t + 1] = e2;
            gate[2 * t] = pg * p1 / den; gate[2 * t + 1] = pg * p2 / den;
            pos[2 * t] = atomicAdd(&cnt[e1], 1); pos[2 * t + 1] = atomicAdd(&cnt[e2], 1);
        }
    }
}
__device__ void n_moe_build(const int* eid, const int* pos, const int* cnt, int* slot_tok, int* slot_a, int* tile_e) {
    __shared__ int poff[33];
    if (threadIdx.x == 0) { int o = 0; for (int e = 0; e < 32; ++e) { poff[e] = o; o += (cnt[e] + 127) / 128 * 128; } poff[32] = o; }
    __syncthreads();
    const int gi = blockIdx.x * blockDim.x + threadIdx.x, gs = gridDim.x * blockDim.x;
    for (int a = gi; a < NA; a += gs) { const int e = eid[a]; const int sl = poff[e] + pos[a]; slot_tok[sl] = a >> 1; slot_a[sl] = a; }
    for (int mt = gi; mt < NSLOT / 128; mt += gs) { const int r = mt * 128; int e = -1; for (int k = 0; k < 32; ++k) if (r >= poff[k] && r < poff[k + 1]) e = k; tile_e[mt] = e; }
    __syncthreads();
}
__device__ void n_moe_act(float* g, const float* u) {
    const size_t gi = (size_t)blockIdx.x * blockDim.x + threadIdx.x, gs = (size_t)gridDim.x * blockDim.x;
    for (size_t i = gi; i < (size_t)NSLOT * DE / 4; i += gs) { float4 a = ((float4*)g)[i]; const float4 b = ((const float4*)u)[i];
        a.x = siluf_(a.x) * b.x; a.y = siluf_(a.y) * b.y; a.z = siluf_(a.z) * b.z; a.w = siluf_(a.w) * b.w; ((float4*)g)[i] = a; }
}
__device__ void n_moe_combine(float* x, const float* y) {
    const size_t gi = (size_t)blockIdx.x * blockDim.x + threadIdx.x, gs = (size_t)gridDim.x * blockDim.x;
    for (size_t i = gi; i < (size_t)T * D / 4; i += gs) { const size_t t = i >> 8, c = i & 255; float4 a = ((float4*)x)[i];
        const float4 y0 = ((const float4*)y)[(2 * t) * 256 + c], y1 = ((const float4*)y)[(2 * t + 1) * 256 + c];
        a.x += y0.x + y1.x; a.y += y0.y + y1.y; a.z += y0.z + y1.z; a.w += y0.w + y1.w; ((float4*)x)[i] = a; }
}
__device__ void n_gla_decay(const float* proj, const float* wa2, const float* ba, float* dec) {
    const size_t gi = (size_t)blockIdx.x * blockDim.x + threadIdx.x, gs = (size_t)gridDim.x * blockDim.x;
    for (size_t i = gi; i < (size_t)T * GDK; i += gs) { const size_t t = i >> 9; const int j = (int)(i & 511);
        float a = ba[j];
#pragma unroll
        for (int r = 0; r < GRANK; ++r) a = fmaf(proj[t * GLA_COLS + 2048 + r], wa2[r * GDK + j], a);
        const float ls = fminf(a, 0.f) - log1pf(expf(-fabsf(a)));
        dec[i] = expf(ls * (1.0f / 16.0f)); }
}
__device__ void n_gla_rec(float* proj, const float* dec) {
    const int gi = blockIdx.x * blockDim.x + threadIdx.x, gs = gridDim.x * blockDim.x;
    for (int it = gi; it < NB * GH * GDVH; it += gs) {
        const int col = it & 255, h = (it >> 8) & 3, b = it >> 10;
        float st[GDKH];
#pragma unroll
        for (int k = 0; k < GDKH; ++k) st[k] = 0.f;
        const float qs = 0.08838834764831845f;
        for (int s = 0; s < S; ++s) {
            const size_t t = (size_t)b * S + s;
            float* pr = proj + t * GLA_COLS;
            const float v = pr[1024 + h * GDVH + col];
            const float* qq = pr + h * GDKH; const float* kk = pr + 512 + h * GDKH; const float* dd = dec + t * GDK + h * GDKH;
            float o = 0.f;
#pragma unroll
            for (int k = 0; k < GDKH; ++k) { st[k] = fmaf(st[k], dd[k], kk[k] * v); o = fmaf(qq[k], st[k], o); }
            pr[1024 + h * GDVH + col] = o * qs;
        }
    }
}
__device__ void n_gla_norm(const float* proj, const float* ng, float* go) {
    const int lane = threadIdx.x & 63;
    const int gw = (blockIdx.x * blockDim.x + threadIdx.x) >> 6, ngw = (gridDim.x * blockDim.x) >> 6;
    for (int it = gw; it < T * GH; it += ngw) {
        const int t = it >> 2, h = it & 3;
        const float4 ov = ((const float4*)(proj + (size_t)t * GLA_COLS + 1024 + h * GDVH))[lane];
        const float4 rv = ((const float4*)(proj + (size_t)t * GLA_COLS + 2064 + h * GDVH))[lane];
        const float4 gg = ((const float4*)ng)[lane];
        float s = ov.x * ov.x + ov.y * ov.y + ov.z * ov.z + ov.w * ov.w; s = wave_sum(s);
        const float rs = rsqrtf(s * (1.0f / GDVH) + EPS);
        ((float4*)(go + (size_t)t * D + h * GDVH))[lane] = make_float4(ov.x * rs * gg.x * siluf_(rv.x), ov.y * rs * gg.y * siluf_(rv.y), ov.z * rs * gg.z * siluf_(rv.z), ov.w * rs * gg.w * siluf_(rv.w));
    }
}

#define LAS __attribute__((address_space(3)))
typedef unsigned short bf16_t;
typedef short bf16x8 __attribute__((ext_vector_type(8)));
typedef float f32x4 __attribute__((ext_vector_type(4)));
typedef float f32x2 __attribute__((ext_vector_type(2)));
typedef unsigned u32x4 __attribute__((ext_vector_type(4)));
typedef unsigned u32x2 __attribute__((ext_vector_type(2)));

constexpr int LDS_BYTES = 160 * 1024;
constexpr int NSLOT2 = NA + NE * 256;
constexpr int MAXRT = NSLOT2 / 256;
constexpr size_t OW_XB = 0;
constexpr size_t OW_SSP = 64 * MiB;
constexpr size_t OW_RS = 66 * MiB;
constexpr size_t OW_PSUM = 67 * MiB;
constexpr size_t OW_MOE = 69 * MiB;
constexpr size_t OW_ACTA = 72 * MiB, OW_ACTB = 136 * MiB, OW_ACTC = 200 * MiB;
constexpr size_t OW_H = 72 * MiB, OW_Y = 144 * MiB, OW_WMOE = 272 * MiB;
constexpr size_t OW_KVB = 368 * MiB;
constexpr size_t OW_MEMNB = 372 * MiB;
constexpr size_t OW_WCIN = 550 * MiB, OW_WCOUT = 554 * MiB, OW_WXQ = 556 * MiB, OW_WXKV = 560 * MiB, OW_WXO = 568 * MiB, OW_WR = 572 * MiB, OW_BAR = 573 * MiB, OW_DBG = 574 * MiB, OW_END = 575 * MiB;
constexpr size_t OW_ATT = 0, OW_QKR = 72 * MiB, OW_KVT = 200 * MiB, OW_BTM = 296 * MiB, OW_O = 296 * MiB, OW_BFM = 360 * MiB, OW_UT = 424 * MiB, OW_SP = 456 * MiB,
                 OW_ALR = 488 * MiB, OW_DL = 490 * MiB, OW_GO = 200 * MiB, OW_WGTM = 492 * MiB, OW_WGFM = 496 * MiB, OW_WGO = 499 * MiB, OW_WA = 501 * MiB;
constexpr size_t OM_GCNT = OW_MOE, OM_NT = OW_MOE + 256, OM_TILEE = OW_MOE + 512, OM_AE = OW_MOE + 4096, OM_APOS = OM_AE + NA * 4, OM_GATE = OM_APOS + NA * 4,
                 OM_STOK = OM_GATE + NA * 4, OM_SA = OM_STOK + NSLOT2 * 4, OM_SRS = OM_SA + NSLOT2 * 4, OM_SGATE = OM_SRS + NSLOT2 * 4, OM_END = OM_SGATE + NSLOT2 * 4;
static_assert(OM_END <= OW_ACTA, "MoE small arrays");

typedef __bf16 bf16x2_t __attribute__((ext_vector_type(2)));
__device__ __forceinline__ unsigned cvt_pk_bf16(float lo, float hi) { const f32x2 v = {lo, hi}; return __builtin_bit_cast(unsigned, __builtin_convertvector(v, bf16x2_t)); }
__device__ __forceinline__ int otid() { int t = threadIdx.x; asm volatile("" : "+v"(t)); return t; }
__device__ __forceinline__ u32x4 pack8(const f32x4& a, const f32x4& b) { u32x4 w; w.x = cvt_pk_bf16(a[0], a[1]); w.y = cvt_pk_bf16(a[2], a[3]); w.z = cvt_pk_bf16(b[0], b[1]); w.w = cvt_pk_bf16(b[2], b[3]); return w; }
__device__ __forceinline__ float bf_lo(unsigned w) { return __uint_as_float(w << 16); }
__device__ __forceinline__ float bf_hi(unsigned w) { return __uint_as_float(w & 0xffff0000u); }
__device__ __forceinline__ float fast_sigmoid(float x) { return __builtin_amdgcn_rcpf(1.0f + __builtin_amdgcn_exp2f(-1.4426950408889634f * x)); }

#ifndef LDS_POISON
#define LDS_POISON 0
#endif
namespace g8 {
constexpr int BM = 256, BK = 64, HALF = 128, HTB = HALF * BK * 2, STAGE_BYTES = 8 * HTB;
__device__ __forceinline__ int lds_byte(int r, int c) { const int st = (r >> 4) * 2 + (c >> 5), rr = r & 15, cc = c & 31, ob = rr * 64 + cc * 2; return st * 1024 + (ob ^ (((ob >> 9) & 1) << 5)); }
__device__ __forceinline__ void stage_rc(int b, int& R, int& C) { const int st = b / 1024, sb = b % 1024, swz = sb ^ (((sb >> 9) & 1) << 5); R = (st >> 1) * 16 + swz / 64; C = (st & 1) * 32 + (swz % 64) / 2; }
__device__ __forceinline__ int perm32(int rho) { const int n = rho >> 4, i = rho & 15; return 8 * (i >> 2) + 4 * n + (i & 3); }
struct Unit { int pm, pn, e; };

template <class Epi, class Sched>
__device__ __forceinline__ void gemm_phase(LAS unsigned char* lds, const Sched& S, const Epi& E) {
    int tid_ = threadIdx.x; asm volatile("" : "+v"(tid_));
    const int tid = tid_, wid = __builtin_amdgcn_readfirstlane(tid >> 6), lane = tid & 63, wr = wid >> 2, wc = wid & 3, fr = lane & 15, fq = lane >> 4;
    const size_t kstep = (size_t)(BK * 2);
    const unsigned ldsw = (unsigned)wid * 1024u;
    const int aoff = lds_byte(wr * 64 + fr, fq * 8), boff = lds_byte(wc * 32 + fr, fq * 8);
#define G8_SA(b, h) (((b) * 2 + (h)) * HTB)
#define G8_SB(b, h) ((4 + (b) * 2 + (h)) * HTB)
#define G8_STAGE(bufoff, gbase, vv) do { _Pragma("unroll") for (int _i = 0; _i < 2; ++_i) \
        __builtin_amdgcn_global_load_lds((const unsigned*)((const char*)(gbase) + (vv)[_i]), (LAS unsigned*)(lds + (bufoff) + ldsw + _i * 8192), 16, 0, 0); } while (0)
#define G8_LDA(dst, b, h) do { _Pragma("unroll") for (int m = 0; m < 4; ++m) _Pragma("unroll") for (int k = 0; k < 2; ++k) dst[m][k] = *(const LAS bf16x8*)(lds + G8_SA(b, h) + aoff + m * 2048 + k * 1024); } while (0)
#define G8_LDB(dst, b, h) do { _Pragma("unroll") for (int n = 0; n < 2; ++n) _Pragma("unroll") for (int k = 0; k < 2; ++k) dst[n][k] = *(const LAS bf16x8*)(lds + G8_SB(b, h) + boff + n * 2048 + k * 1024); } while (0)
#define G8_MMA(ai, bj, At, Bt) do { __builtin_amdgcn_s_setprio(1); _Pragma("unroll") for (int m = 0; m < 4; ++m) _Pragma("unroll") for (int n = 0; n < 2; ++n) _Pragma("unroll") for (int k = 0; k < 2; ++k) \
        acc[ai][bj][m][n] = __builtin_amdgcn_mfma_f32_16x16x32_bf16(Bt[n][k], At[m][k], acc[ai][bj][m][n], 0, 0, 0); __builtin_amdgcn_s_setprio(0); } while (0)
#define G8_WAIT_V(n) asm volatile("s_waitcnt vmcnt(" #n ")" ::: "memory")
#define G8_WAIT_L(n) asm volatile("s_waitcnt lgkmcnt(" #n ")" ::: "memory")
#define G8_BAR __builtin_amdgcn_s_barrier()
#define G8_SCHED __builtin_amdgcn_sched_barrier(0)
#define G8_VA(dst, u) do { const int _ac = S.a_col(u), _lda = S.lda(u); _Pragma("unroll") for (int _i = 0; _i < 2; ++_i) { int _R, _C; stage_rc(tid * 16 + _i * 8192, _R, _C); \
        _Pragma("unroll") for (int _h = 0; _h < 2; ++_h) dst[_h][_i] = (unsigned)(((size_t)S.a_row(u, _h * HALF + _R) * _lda + _ac + _C) * 2); } } while (0)
#define G8_VB(dst, hs, u) do { const int _ldb = S.ldb(u); hs = (size_t)HALF * _ldb * 2; _Pragma("unroll") for (int _i = 0; _i < 2; ++_i) { int _R, _C; stage_rc(tid * 16 + _i * 8192, _R, _C); \
        dst[_i] = (unsigned)(((_R & ~31) + perm32(_R & 31)) * _ldb + _C) * 2u; } } while (0)
    Unit cur, nxt; int ui = 0;
    if (!S.next(0, cur)) return;
#if LDS_POISON
    for (int i = tid; i < STAGE_BYTES / 16; i += 512) ((LAS u32x4*)lds)[i] = (u32x4){0x7fc07fc0u, 0x7fc07fc0u, 0x7fc07fc0u, 0x7fc07fc0u};
    __syncthreads();
#endif
    f32x4 acc[2][2][4][2];
#pragma unroll
    for (int a = 0; a < 2; ++a)
#pragma unroll
        for (int b = 0; b < 2; ++b)
#pragma unroll
            for (int m = 0; m < 4; ++m)
#pragma unroll
                for (int n = 0; n < 2; ++n) acc[a][b][m][n] = (f32x4){0.f, 0.f, 0.f, 0.f};
    bf16x8 At[4][2], B0[2][2], B1[2][2];
    unsigned va[2][2], nva[2][2], vb[2], nvb[2]; size_t hsB, nhsB;
    G8_VA(va, cur); G8_VB(vb, hsB, cur);
    const char* Ab = S.a_base(cur);
    const char* cB = S.b_base(cur);
    G8_STAGE(G8_SB(0, 0), cB, vb); G8_STAGE(G8_SA(0, 0), Ab, va[0]); G8_STAGE(G8_SB(0, 1), cB + hsB, vb); G8_STAGE(G8_SA(0, 1), Ab, va[1]);
    if (wr == 1) G8_BAR;
    G8_WAIT_V(4); G8_BAR;
    G8_STAGE(G8_SB(1, 0), cB + kstep, vb); G8_STAGE(G8_SA(1, 0), Ab + kstep, va[0]); G8_STAGE(G8_SB(1, 1), cB + hsB + kstep, vb);
    G8_WAIT_V(6); G8_BAR;
    for (;;) {
        const bool has_next = S.next(ui + 1, nxt);
        const char* nB = cB; const char* nAb = Ab;
        if (has_next) { nB = S.b_base(nxt); nAb = S.a_base(nxt); G8_VA(nva, nxt); G8_VB(nvb, nhsB, nxt); }
        else {
            nhsB = hsB;
#pragma unroll
            for (int i = 0; i < 2; ++i) { nvb[i] = vb[i];
#pragma unroll
                for (int h = 0; h < 2; ++h) nva[h][i] = va[h][i]; }
        }
        const int nt = S.nt(cur);
        for (int t = 0; t < nt; t += 2) {
            const bool last = (t == nt - 2);
            const char* a1 = Ab + (size_t)(t + 1) * kstep;
            const char* a2 = last ? nAb : Ab + (size_t)(t + 2) * kstep;
            const char* b2 = last ? nB : cB + (size_t)(t + 2) * kstep;
            const char* a3 = a2 + kstep; const char* b3 = b2 + kstep;
            const size_t hs2 = last ? nhsB : hsB;
            unsigned v2[2][2], vb2[2];
#pragma unroll
            for (int i = 0; i < 2; ++i) { vb2[i] = last ? nvb[i] : vb[i];
#pragma unroll
                for (int h = 0; h < 2; ++h) v2[h][i] = last ? nva[h][i] : va[h][i]; }
            G8_LDB(B0, 0, 0); G8_SCHED; G8_LDA(At, 0, 0); G8_STAGE(G8_SA(1, 1), a1, va[1]);
            G8_WAIT_L(8); G8_BAR; G8_WAIT_L(0); G8_MMA(0, 0, At, B0); G8_BAR; G8_SCHED;
            G8_LDB(B1, 0, 1); G8_STAGE(G8_SB(0, 0), b2, vb2);
            G8_BAR; G8_WAIT_L(0); G8_MMA(0, 1, At, B1); G8_BAR;
            G8_LDA(At, 0, 1); G8_STAGE(G8_SA(0, 0), a2, v2[0]);
            G8_BAR; G8_WAIT_L(0); G8_MMA(1, 0, At, B0); G8_BAR; G8_SCHED;
            G8_STAGE(G8_SB(0, 1), b2 + hs2, vb2);
            G8_WAIT_V(6); G8_BAR; G8_MMA(1, 1, At, B1); G8_BAR;
            G8_LDB(B0, 1, 0); G8_SCHED; G8_LDA(At, 1, 0); G8_STAGE(G8_SA(0, 1), a2, v2[1]);
            G8_WAIT_L(8); G8_BAR; G8_WAIT_L(0); G8_MMA(0, 0, At, B0); G8_BAR; G8_SCHED;
            G8_LDB(B1, 1, 1); G8_STAGE(G8_SB(1, 0), b3, vb2);
            G8_BAR; G8_WAIT_L(0); G8_MMA(0, 1, At, B1); G8_BAR;
            G8_LDA(At, 1, 1); G8_STAGE(G8_SA(1, 0), a3, v2[0]);
            G8_BAR; G8_WAIT_L(0); G8_MMA(1, 0, At, B0); G8_BAR; G8_SCHED;
            G8_STAGE(G8_SB(1, 1), b3 + hs2, vb2);
            G8_WAIT_V(6); G8_BAR; G8_MMA(1, 1, At, B1); G8_BAR;
        }
        const bool keep = S.cont(cur);
        if (!keep) E(acc, cur, wr, wc, fr, fq);
        if (!has_next) break;
        if (!keep) {
#pragma unroll
            for (int a = 0; a < 2; ++a)
#pragma unroll
                for (int b = 0; b < 2; ++b)
#pragma unroll
                    for (int m = 0; m < 4; ++m)
#pragma unroll
                        for (int n = 0; n < 2; ++n) acc[a][b][m][n] = (f32x4){0.f, 0.f, 0.f, 0.f};
        }
        cur = nxt; cB = nB; Ab = nAb; hsB = nhsB; ++ui;
#pragma unroll
        for (int i = 0; i < 2; ++i) { vb[i] = nvb[i];
#pragma unroll
            for (int h = 0; h < 2; ++h) va[h][i] = nva[h][i]; }
    }
    G8_WAIT_V(0);
    if (wr == 0) G8_BAR;
    G8_BAR;
#undef G8_SA
#undef G8_SB
#undef G8_STAGE
#undef G8_LDA
#undef G8_LDB
#undef G8_MMA
#undef G8_WAIT_V
#undef G8_WAIT_L
#undef G8_BAR
#undef G8_SCHED
#undef G8_VA
#undef G8_VB
}

struct DenseSched {
    __device__ __forceinline__ int lda(const Unit&) const { return lda_; }
    __device__ __forceinline__ int ldb(const Unit&) const { return ldb_; }
    __device__ __forceinline__ int nt(const Unit&) const { return K / BK; }
    __device__ __forceinline__ bool cont(const Unit&) const { return false; }
    int nN, nU, K, lda_, ldb_; const bf16_t* A; const bf16_t* Bt;
    __device__ __forceinline__ const char* a_base(const Unit&) const { return (const char*)A; }
    __device__ __forceinline__ bool next(int i, Unit& u) const {
        const int c = blockIdx.x, per = gridDim.x >> 3, x = c & 7, j = c >> 3;
        const int chunk = (nU + 7) >> 3, lu = i * per + j;
        if (lu >= chunk) return false;
        const int un = x * chunk + lu; if (un >= nU) return false;
        u.pm = un / nN; u.pn = un - u.pm * nN; u.e = 0; return true; }
    __device__ __forceinline__ int a_row(const Unit& u, int r) const { return u.pm * BM + r; }
    __device__ __forceinline__ int a_col(const Unit&) const { return 0; }
    __device__ __forceinline__ const char* b_base(const Unit& u) const { return (const char*)(Bt + (size_t)u.pn * BM * ldb_); }
};

struct EpiGlu {
    bf16_t* U; const float* rs; const float* bias;
    __device__ __forceinline__ void operator()(const f32x4 (&acc)[2][2][4][2], const Unit& u, int wr, int wc, int fr, int fq) const {
        const int c0 = u.pn * 128 + wc * 32 + 8 * fq;
        const f32x4 ba0 = *(const f32x4*)(bias + c0), ba1 = *(const f32x4*)(bias + c0 + 4), bg0 = *(const f32x4*)(bias + 1024 + c0), bg1 = *(const f32x4*)(bias + 1024 + c0 + 4);
        float rv[2][4];
#pragma unroll
        for (int ai = 0; ai < 2; ++ai)
#pragma unroll
            for (int m = 0; m < 4; ++m) rv[ai][m] = rs[u.pm * BM + ai * HALF + wr * 64 + m * 16 + fr];
        __builtin_amdgcn_sched_barrier(0);
#pragma unroll
        for (int ai = 0; ai < 2; ++ai)
#pragma unroll
            for (int m = 0; m < 4; ++m) {
                const int row = u.pm * BM + ai * HALF + wr * 64 + m * 16 + fr; const float r = rv[ai][m];
                f32x4 o0, o1;
#pragma unroll
                for (int j = 0; j < 4; ++j) {
                    o0[j] = (acc[ai][0][m][0][j] * r + ba0[j]) * fast_sigmoid(acc[ai][1][m][0][j] * r + bg0[j]);
                    o1[j] = (acc[ai][0][m][1][j] * r + ba1[j]) * fast_sigmoid(acc[ai][1][m][1][j] * r + bg1[j]); }
                *(u32x4*)(U + (size_t)row * D + c0) = pack8(o0, o1);
            }
    }
};
struct EpiXres {
    const float* Xin; float* Xout; bf16_t* XB; const float* bias; float* ssp;
    __device__ __forceinline__ void operator()(const f32x4 (&acc)[2][2][4][2], const Unit& u, int wr, int wc, int fr, int fq) const {
        f32x4 bv[2][2];
#pragma unroll
        for (int bj = 0; bj < 2; ++bj) { const int c0 = u.pn * BM + bj * HALF + wc * 32 + 8 * fq;
            bv[bj][0] = bias ? *(const f32x4*)(bias + c0) : (f32x4){0.f, 0.f, 0.f, 0.f}; bv[bj][1] = bias ? *(const f32x4*)(bias + c0 + 4) : (f32x4){0.f, 0.f, 0.f, 0.f}; }
#pragma unroll
        for (int ai = 0; ai < 2; ++ai) {
            f32x4 xv[4][2][2];
#pragma unroll
            for (int m = 0; m < 4; ++m)
#pragma unroll
                for (int bj = 0; bj < 2; ++bj) { const size_t off = (size_t)(u.pm * BM + ai * HALF + wr * 64 + m * 16 + fr) * D + u.pn * BM + bj * HALF + wc * 32 + 8 * fq;
                    xv[m][bj][0] = *(const f32x4*)(Xin + off); xv[m][bj][1] = *(const f32x4*)(Xin + off + 4); }
            __builtin_amdgcn_sched_barrier(0);
#pragma unroll
            for (int m = 0; m < 4; ++m) {
                const int row = u.pm * BM + ai * HALF + wr * 64 + m * 16 + fr; float ss = 0.f;
#pragma unroll
                for (int bj = 0; bj < 2; ++bj) {
                    const size_t off = (size_t)row * D + u.pn * BM + bj * HALF + wc * 32 + 8 * fq;
                    const f32x4 v0 = xv[m][bj][0] + acc[ai][bj][m][0] + bv[bj][0], v1 = xv[m][bj][1] + acc[ai][bj][m][1] + bv[bj][1];
                    *(f32x4*)(Xout + off) = v0; *(f32x4*)(Xout + off + 4) = v1;
                    *(u32x4*)(XB + off) = pack8(v0, v1);
                    ss += (v0[0] * v0[0] + v0[1] * v0[1]) + (v0[2] * v0[2] + v0[3] * v0[3]) + (v1[0] * v1[0] + v1[1] * v1[1]) + (v1[2] * v1[2] + v1[3] * v1[3]);
                }
                if (ssp) { ss += __shfl_xor(ss, 16); ss += __shfl_xor(ss, 32); if (fq == 0) ssp[(size_t)row * 16 + u.pn * 4 + wc] = ss; }
            }
        }
    }
};
struct AttnSched {
    __device__ __forceinline__ int lda(const Unit&) const { return lda_; }
    __device__ __forceinline__ int ldb(const Unit&) const { return ldb_; }
    __device__ __forceinline__ int nt(const Unit&) const { return K / BK; }
    __device__ __forceinline__ bool cont(const Unit&) const { return false; }
    int K, lda_, ldb_; const bf16_t* A; const bf16_t* Bm; int pv;
    __device__ __forceinline__ bool next(int i, Unit& u) const {
        const int c = blockIdx.x, per = gridDim.x >> 3, x = c & 7, j = c >> 3;
        const int lu = i * per + j; if (lu >= 64) return false;
        const int un = x * 64 + lu, bh = un >> 5, qb = un & 31;
        u.pm = (bh >> 2) * 32 + qb; u.pn = 0; u.e = bh & 3; return true; }
    __device__ __forceinline__ const char* a_base(const Unit&) const { return (const char*)A; }
    __device__ __forceinline__ int a_row(const Unit& u, int r) const { return u.pm * BM + r; }
    __device__ __forceinline__ int a_col(const Unit& u) const { return u.e * 256; }
    __device__ __forceinline__ const char* b_base(const Unit& u) const { const int b = u.pm >> 5;
        return pv ? (const char*)(Bm + (size_t)(b * 4 + u.e) * 65536) : (const char*)(Bm + (size_t)(b * 256) * 1024 + u.e * 256); }
};
struct KVSched {
    __device__ __forceinline__ int lda(const Unit&) const { return lda_; }
    __device__ __forceinline__ int ldb(const Unit&) const { return ldb_; }
    __device__ __forceinline__ int nt(const Unit&) const { return K / BK; }
    __device__ __forceinline__ bool cont(const Unit&) const { return false; }
    int K, lda_, ldb_; const bf16_t* MEMNB; const bf16_t* WKV;
    __device__ __forceinline__ bool next(int i, Unit& u) const {
        const int un = i * (int)gridDim.x + (int)blockIdx.x; if (un >= 32) return false;
        u.e = un >> 4; u.pm = (un & 15) >> 2; u.pn = un & 3; return true; }
    __device__ __forceinline__ const char* a_base(const Unit& u) const { return u.e ? (const char*)(WKV + (size_t)1024 * 1024) : (const char*)MEMNB; }
    __device__ __forceinline__ int a_row(const Unit& u, int r) const { return u.pm * BM + r; }
    __device__ __forceinline__ int a_col(const Unit&) const { return 0; }
    __device__ __forceinline__ const char* b_base(const Unit& u) const { return u.e ? (const char*)(MEMNB + (size_t)u.pn * BM * 1024) : (const char*)(WKV + (size_t)u.pn * BM * 1024); }
};
__device__ __forceinline__ float ssp_rs(const float* ssp, int row) {
    const f32x4 a = *(const f32x4*)(ssp + (size_t)row * 16), b = *(const f32x4*)(ssp + (size_t)row * 16 + 4), c = *(const f32x4*)(ssp + (size_t)row * 16 + 8), d = *(const f32x4*)(ssp + (size_t)row * 16 + 12);
    const float s = ((a[0] + a[1]) + (a[2] + a[3])) + ((b[0] + b[1]) + (b[2] + b[3])) + ((c[0] + c[1]) + (c[2] + c[3])) + ((d[0] + d[1]) + (d[2] + d[3]));
    return rsqrtf(s * (1.0f / D) + EPS);
}
struct EpiRowScale {
    bf16_t* O; int ldo; const float* ssp; const float* rs; float scale; int qtiles; float qscale;
    __device__ __forceinline__ void operator()(const f32x4 (&acc)[2][2][4][2], const Unit& u, int wr, int wc, int fr, int fq) const {
        const float cs = scale * (u.pn < qtiles ? qscale : 1.0f);
        float rv[2][4];
        if (rs) {
#pragma unroll
            for (int ai = 0; ai < 2; ++ai)
#pragma unroll
                for (int m = 0; m < 4; ++m) rv[ai][m] = rs[u.pm * BM + ai * HALF + wr * 64 + m * 16 + fr];
        } else {
#pragma unroll
            for (int ai = 0; ai < 2; ++ai) {
                f32x4 p[4][4];
#pragma unroll
                for (int m = 0; m < 4; ++m)
#pragma unroll
                    for (int q = 0; q < 4; ++q) p[m][q] = *(const f32x4*)(ssp + (size_t)(u.pm * BM + ai * HALF + wr * 64 + m * 16 + fr) * 16 + 4 * q);
                __builtin_amdgcn_sched_barrier(0);
#pragma unroll
                for (int m = 0; m < 4; ++m) { float sm = 0.f;
#pragma unroll
                    for (int q = 0; q < 4; ++q) sm += (p[m][q][0] + p[m][q][1]) + (p[m][q][2] + p[m][q][3]);
                    rv[ai][m] = rsqrtf(sm * (1.0f / D) + EPS); }
            }
        }
        __builtin_amdgcn_sched_barrier(0);
#pragma unroll
        for (int ai = 0; ai < 2; ++ai)
#pragma unroll
            for (int m = 0; m < 4; ++m) {
                const int row = u.pm * BM + ai * HALF + wr * 64 + m * 16 + fr;
                const float r = rv[ai][m] * cs;
#pragma unroll
                for (int bj = 0; bj < 2; ++bj) { const int c0 = u.pn * BM + bj * HALF + wc * 32 + 8 * fq;
                    *(u32x4*)(O + (size_t)row * ldo + c0) = pack8(acc[ai][bj][m][0] * r, acc[ai][bj][m][1] * r); }
            }
    }
};
struct EpiKV {
    bf16_t* Kb; bf16_t* VT;
    __device__ __forceinline__ void operator()(const f32x4 (&acc)[2][2][4][2], const Unit& u, int wr, int wc, int fr, int fq) const {
        bf16_t* base = u.e ? VT + (size_t)(u.pn * 4 + u.pm) * 65536 : Kb + (size_t)u.pm * BM * 1024 + u.pn * BM;
        const int ld = u.e ? 256 : 1024;
#pragma unroll
        for (int ai = 0; ai < 2; ++ai)
#pragma unroll
            for (int m = 0; m < 4; ++m) { const int r = ai * HALF + wr * 64 + m * 16 + fr;
#pragma unroll
                for (int bj = 0; bj < 2; ++bj) { const int c0 = bj * HALF + wc * 32 + 8 * fq;
                    *(u32x4*)(base + (size_t)r * ld + c0) = pack8(acc[ai][bj][m][0], acc[ai][bj][m][1]); } }
    }
};
struct EpiS {
    bf16_t* P; float* psum;
    __device__ __forceinline__ void operator()(const f32x4 (&acc)[2][2][4][2], const Unit& u, int wr, int wc, int fr, int fq) const {
#pragma unroll
        for (int ai = 0; ai < 2; ++ai)
#pragma unroll
            for (int m = 0; m < 4; ++m) {
                const int row = u.pm * BM + ai * HALF + wr * 64 + m * 16 + fr; float ps = 0.f;
#pragma unroll
                for (int bj = 0; bj < 2; ++bj) { const int c0 = u.e * 256 + bj * HALF + wc * 32 + 8 * fq;
                    f32x4 e0, e1;
#pragma unroll
                    for (int j = 0; j < 4; ++j) { e0[j] = __builtin_amdgcn_exp2f(acc[ai][bj][m][0][j] * 1.4426950408889634f); e1[j] = __builtin_amdgcn_exp2f(acc[ai][bj][m][1][j] * 1.4426950408889634f); }
                    const u32x4 w = pack8(e0, e1);
                    *(u32x4*)(P + (size_t)row * D + c0) = w;
                    ps += (bf_lo(w.x) + bf_hi(w.x)) + (bf_lo(w.y) + bf_hi(w.y)) + (bf_lo(w.z) + bf_hi(w.z)) + (bf_lo(w.w) + bf_hi(w.w)); }
                ps += __shfl_xor(ps, 16); ps += __shfl_xor(ps, 32);
                if (fq == 0) psum[(size_t)row * 16 + u.e * 4 + wc] = ps;
            }
    }
};
struct EpiRaw {
    bf16_t* O;
    __device__ __forceinline__ void operator()(const f32x4 (&acc)[2][2][4][2], const Unit& u, int wr, int wc, int fr, int fq) const {
#pragma unroll
        for (int ai = 0; ai < 2; ++ai)
#pragma unroll
            for (int m = 0; m < 4; ++m) { const int row = u.pm * BM + ai * HALF + wr * 64 + m * 16 + fr;
#pragma unroll
                for (int bj = 0; bj < 2; ++bj) { const int c0 = u.e * 256 + bj * HALF + wc * 32 + 8 * fq;
                    *(u32x4*)(O + (size_t)row * D + c0) = pack8(acc[ai][bj][m][0], acc[ai][bj][m][1]); } }
    }
};
struct EpiPV {
    bf16_t* O; const float* psum;
    __device__ __forceinline__ void operator()(const f32x4 (&acc)[2][2][4][2], const Unit& u, int wr, int wc, int fr, int fq) const {
        f32x4 sv[2][4];
#pragma unroll
        for (int ai = 0; ai < 2; ++ai)
#pragma unroll
            for (int m = 0; m < 4; ++m) sv[ai][m] = *(const f32x4*)(psum + (size_t)(u.pm * BM + ai * HALF + wr * 64 + m * 16 + fr) * 16 + u.e * 4);
        __builtin_amdgcn_sched_barrier(0);
#pragma unroll
        for (int ai = 0; ai < 2; ++ai)
#pragma unroll
            for (int m = 0; m < 4; ++m) {
                const int row = u.pm * BM + ai * HALF + wr * 64 + m * 16 + fr;
                const float inv = 1.0f / ((sv[ai][m][0] + sv[ai][m][1]) + (sv[ai][m][2] + sv[ai][m][3]));
#pragma unroll
                for (int bj = 0; bj < 2; ++bj) { const int c0 = u.e * 256 + bj * HALF + wc * 32 + 8 * fq;
                    *(u32x4*)(O + (size_t)row * D + c0) = pack8(acc[ai][bj][m][0] * inv, acc[ai][bj][m][1] * inv); }
            }
    }
};

__device__ __forceinline__ int ld_agent(const int* p) { return __hip_atomic_load(p, __ATOMIC_RELAXED, __HIP_MEMORY_SCOPE_AGENT); }
struct MoeSched {
    __device__ __forceinline__ int lda(const Unit&) const { return lda_; }
    __device__ __forceinline__ int ldb(const Unit&) const { return ldb_; }
    __device__ __forceinline__ int nt(const Unit&) const { return K / BK; }
    __device__ __forceinline__ bool cont(const Unit&) const { return false; }
    int K, lda_, ldb_; const bf16_t* A; const bf16_t* W; size_t wstride; const int* tile_e; const int* slot_tok; int NT;
    __device__ __forceinline__ bool next(int i, Unit& u) const {
        const int c = blockIdx.x, per = gridDim.x >> 3, x = c & 7, j = c >> 3;
        const int tpx = (NT + 7) >> 3, lu = i * per + j, lrt = lu >> 2;
        if (lrt >= tpx) return false;
        const int rt = x * tpx + lrt; if (rt >= NT) return false;
        u.pm = rt; u.pn = lu & 3; u.e = __builtin_amdgcn_readfirstlane(ld_agent(tile_e + rt)); return true; }
    __device__ __forceinline__ const char* a_base(const Unit&) const { return (const char*)A; }
    __device__ __forceinline__ int a_row(const Unit& u, int r) const { return slot_tok ? slot_tok[u.pm * BM + r] : u.pm * BM + r; }
    __device__ __forceinline__ int a_col(const Unit&) const { return 0; }
    __device__ __forceinline__ const char* b_base(const Unit& u) const { return (const char*)(W + (size_t)u.e * wstride + (size_t)u.pn * BM * ldb_); }
};
struct EpiMoe1 {
    bf16_t* H; const float* slot_rs;
    __device__ __forceinline__ void operator()(const f32x4 (&acc)[2][2][4][2], const Unit& u, int wr, int wc, int fr, int fq) const {
        const int c0 = u.pn * 128 + wc * 32 + 8 * fq;
        float rv[2][4];
#pragma unroll
        for (int ai = 0; ai < 2; ++ai)
#pragma unroll
            for (int m = 0; m < 4; ++m) rv[ai][m] = slot_rs[u.pm * BM + ai * HALF + wr * 64 + m * 16 + fr];
        __builtin_amdgcn_sched_barrier(0);
#pragma unroll
        for (int ai = 0; ai < 2; ++ai)
#pragma unroll
            for (int m = 0; m < 4; ++m) {
                const int row = u.pm * BM + ai * HALF + wr * 64 + m * 16 + fr; const float r = rv[ai][m];
                f32x4 o0, o1;
#pragma unroll
                for (int j = 0; j < 4; ++j) {
                    const float g0 = acc[ai][0][m][0][j] * r, g1 = acc[ai][0][m][1][j] * r;
                    o0[j] = g0 * fast_sigmoid(g0) * (acc[ai][1][m][0][j] * r);
                    o1[j] = g1 * fast_sigmoid(g1) * (acc[ai][1][m][1][j] * r); }
                *(u32x4*)(H + (size_t)row * DE + c0) = pack8(o0, o1);
            }
    }
};
struct EpiMoe2 {
    bf16_t* Y; const int* slot_a; const float* slot_gate;
    __device__ __forceinline__ void operator()(const f32x4 (&acc)[2][2][4][2], const Unit& u, int wr, int wc, int fr, int fq) const {
        int av[2][4]; float gv[2][4];
#pragma unroll
        for (int ai = 0; ai < 2; ++ai)
#pragma unroll
            for (int m = 0; m < 4; ++m) { const int row = u.pm * BM + ai * HALF + wr * 64 + m * 16 + fr; av[ai][m] = slot_a[row]; gv[ai][m] = slot_gate[row]; }
        __builtin_amdgcn_sched_barrier(0);
#pragma unroll
        for (int ai = 0; ai < 2; ++ai)
#pragma unroll
            for (int m = 0; m < 4; ++m) {
                const int a = av[ai][m]; const float g = gv[ai][m];
                if (a >= 0) {
#pragma unroll
                    for (int bj = 0; bj < 2; ++bj) { const int c0 = u.pn * BM + bj * HALF + wc * 32 + 8 * fq;
                        *(u32x4*)(Y + (size_t)a * D + c0) = pack8(acc[ai][bj][m][0] * g, acc[ai][bj][m][1] * g); }
                }
            }
    }
};

struct GlaInSched {
    const bf16_t* XB; const bf16_t* WTM; const bf16_t* WFM;
    __device__ __forceinline__ int lda(const Unit&) const { return D; }
    __device__ __forceinline__ int ldb(const Unit&) const { return D; }
    __device__ __forceinline__ int nt(const Unit&) const { return D / BK; }
    __device__ __forceinline__ bool cont(const Unit&) const { return false; }
    __device__ __forceinline__ bool next(int i, Unit& u) const {
        const int c = blockIdx.x, per = gridDim.x >> 3, x = c & 7, j = c >> 3, lu = i * per + j;
        if (lu >= 224) return false;
        const int un = x * 224 + lu;
        if (un < 1024) { u.e = 0; u.pm = un >> 3; u.pn = un & 7; } else { const int v = un - 1024; u.e = 1; u.pn = v / 6; u.pm = v - u.pn * 6; }
        return true; }
    __device__ __forceinline__ const char* a_base(const Unit& u) const { return u.e ? (const char*)WFM : (const char*)XB; }
    __device__ __forceinline__ int a_row(const Unit& u, int r) const { return u.pm * BM + r; }
    __device__ __forceinline__ int a_col(const Unit&) const { return 0; }
    __device__ __forceinline__ const char* b_base(const Unit& u) const { return u.e ? (const char*)(XB + (size_t)u.pn * BM * D) : (const char*)(WTM + (size_t)u.pn * BM * D); }
};
__device__ __forceinline__ float fexp(float x) { return __builtin_amdgcn_exp2f(x * 1.4426950408889634f); }
struct EpiGlaIn {
    bf16_t* QKR; bf16_t* KVT; const float* RS; const float* BTM; const float* BFM;
    __device__ __forceinline__ void operator()(const f32x4 (&acc)[2][2][4][2], const Unit& u, int wr, int wc, int fr, int fq) const {
        if (u.e == 0) {
            float rv[2][4];
#pragma unroll
            for (int ai = 0; ai < 2; ++ai)
#pragma unroll
                for (int m = 0; m < 4; ++m) rv[ai][m] = RS[u.pm * BM + ai * HALF + wr * 64 + m * 16 + fr];
            const float sg = u.pn < 2 ? 1.0f : -1.0f, qs = u.pn < 2 ? 0.08838834764831845f : 1.0f;
#pragma unroll
            for (int ai = 0; ai < 2; ++ai)
#pragma unroll
                for (int mp = 0; mp < 2; ++mp) {
                    f32x4 bv[2][2][2];
                    if (u.pn < 4) {
#pragma unroll
                        for (int mm = 0; mm < 2; ++mm)
#pragma unroll
                            for (int bj = 0; bj < 2; ++bj) { const int row = u.pm * BM + ai * HALF + wr * 64 + (2 * mp + mm) * 16 + fr, kf = (u.pn * BM + bj * HALF + wc * 32 + 8 * fq) & 511;
                                bv[mm][bj][0] = *(const f32x4*)(BTM + (size_t)row * 512 + kf); bv[mm][bj][1] = *(const f32x4*)(BTM + (size_t)row * 512 + kf + 4); }
                    }
                    __builtin_amdgcn_sched_barrier(0);
#pragma unroll
                    for (int mm = 0; mm < 2; ++mm) { const int m = 2 * mp + mm;
                        const int row = u.pm * BM + ai * HALF + wr * 64 + m * 16 + fr; const float r = rv[ai][m];
#pragma unroll
                        for (int bj = 0; bj < 2; ++bj) { const int c0 = u.pn * BM + bj * HALF + wc * 32 + 8 * fq;
                            f32x4 s0 = (f32x4){r, r, r, r}, s1 = s0;
                            if (u.pn < 4) {
#pragma unroll
                                for (int j = 0; j < 4; ++j) { s0[j] = r * qs * fexp(sg * bv[mm][bj][0][j]); s1[j] = r * qs * fexp(sg * bv[mm][bj][1][j]); } }
                            *(u32x4*)(QKR + (size_t)row * 2048 + c0) = pack8(acc[ai][bj][m][0] * s0, acc[ai][bj][m][1] * s1); }
                    }
                    __builtin_amdgcn_sched_barrier(0);
                }
        } else {
#pragma unroll
            for (int bj = 0; bj < 2; ++bj) { const int t0 = u.pn * BM + bj * HALF + wc * 32 + 8 * fq;
                const f32x4 r0 = *(const f32x4*)(RS + t0), r1 = *(const f32x4*)(RS + t0 + 4);
#pragma unroll
                for (int ai = 0; ai < 2; ++ai) {
                    f32x4 bv[4][2];
                    if (u.pm < 2) {
#pragma unroll
                        for (int m = 0; m < 4; ++m) { const int f = u.pm * BM + ai * HALF + wr * 64 + m * 16 + fr;
                            bv[m][0] = *(const f32x4*)(BFM + (size_t)f * T + t0); bv[m][1] = *(const f32x4*)(BFM + (size_t)f * T + t0 + 4); }
                    }
                    __builtin_amdgcn_sched_barrier(0);
#pragma unroll
                    for (int m = 0; m < 4; ++m) { const int f = u.pm * BM + ai * HALF + wr * 64 + m * 16 + fr;
                        f32x4 s0 = r0, s1 = r1;
                        if (u.pm < 2) {
#pragma unroll
                            for (int j = 0; j < 4; ++j) { s0[j] *= fexp(-bv[m][0][j]); s1[j] *= fexp(-bv[m][1][j]); } }
                        *(u32x4*)(KVT + (size_t)f * T + t0) = pack8(acc[ai][bj][m][0] * s0, acc[ai][bj][m][1] * s1); }
                    __builtin_amdgcn_sched_barrier(0);
                }
            }
        }
    }
};
template <int TYP> struct GlaAttSched {
    const bf16_t* QKR; const bf16_t* KVT;
    __device__ __forceinline__ bool next(int i, Unit& u) const {
        const int c = blockIdx.x, per = gridDim.x >> 3, x = c & 7, j = c >> 3, lu = i * per + j;
        if (lu >= 64) return false;
        const int un = x * 64 + lu, bh = un >> 5, cc = un & 31;
        u.e = TYP; u.pm = (bh >> 2) * 32 + cc; u.pn = bh & 3; return true; }
    __device__ __forceinline__ int lda(const Unit& u) const { return TYP ? T : 2048; }
    __device__ __forceinline__ int ldb(const Unit& u) const { return TYP ? T : 2048; }
    __device__ __forceinline__ int nt(const Unit& u) const { int n = TYP ? 4 : 2; asm volatile("" : "+s"(n)); return n; }
    __device__ __forceinline__ bool cont(const Unit&) const { return false; }
    __device__ __forceinline__ const char* a_base(const Unit& u) const { return TYP ? (const char*)KVT : (const char*)QKR; }
    __device__ __forceinline__ int a_row(const Unit& u, int r) const { return TYP ? 512 + u.pn * 256 + r : u.pm * BM + r; }
    __device__ __forceinline__ int a_col(const Unit& u) const { return TYP ? u.pm * BM : u.pn * 128; }
    __device__ __forceinline__ const char* b_base(const Unit& u) const {
        return TYP ? (const char*)(KVT + (size_t)(u.pn * 128) * T + (size_t)u.pm * BM) : (const char*)(QKR + (size_t)u.pm * BM * 2048 + 512 + u.pn * 128); }
};
template <int TYP> struct EpiGlaAtt {
    bf16_t* ATT; bf16_t* UT; const float* DL;
    __device__ __forceinline__ void operator()(const f32x4 (&acc)[2][2][4][2], const Unit& u, int wr, int wc, int fr, int fq) const {
        if (TYP == 0) {
#pragma unroll
            for (int ai = 0; ai < 2; ++ai)
#pragma unroll
                for (int m = 0; m < 4; ++m) { const int rit = ai * HALF + wr * 64 + m * 16 + fr;
#pragma unroll
                    for (int bj = 0; bj < 2; ++bj) { const int c0 = bj * HALF + wc * 32 + 8 * fq;
                        f32x4 v0 = acc[ai][bj][m][0], v1 = acc[ai][bj][m][1];
#pragma unroll
                        for (int j = 0; j < 4; ++j) { if (c0 + j > rit) v0[j] = 0.f; if (c0 + 4 + j > rit) v1[j] = 0.f; }
                        *(u32x4*)(ATT + (size_t)(u.pm * BM + rit) * D + u.pn * 256 + c0) = pack8(v0, v1); }
                }
        } else {
            const int k0 = wc * 32 + 8 * fq;
            const f32x4 d0 = *(const f32x4*)(DL + (size_t)u.pm * 512 + u.pn * 128 + k0), d1 = *(const f32x4*)(DL + (size_t)u.pm * 512 + u.pn * 128 + k0 + 4);
            const int b = u.pm >> 5, cc = u.pm & 31; bf16_t* base = UT + (size_t)((b * 4 + u.pn) * 32 + cc) * 32768;
#pragma unroll
            for (int ai = 0; ai < 2; ++ai)
#pragma unroll
                for (int m = 0; m < 4; ++m) { const int dv = ai * HALF + wr * 64 + m * 16 + fr;
                    *(u32x4*)(base + (size_t)dv * 128 + k0) = pack8(acc[ai][0][m][0] * d0, acc[ai][0][m][1] * d1); }
        }
    }
};
struct GlaOSched {
    const bf16_t* QKR; const bf16_t* KVT; const bf16_t* ATT; const bf16_t* SP;
    __device__ __forceinline__ bool next(int i, Unit& u) const {
        const int c = blockIdx.x, per = gridDim.x >> 3, x = c & 7, j = c >> 3, pl = (i >> 1) * per + j;
        if (pl >= 64) return false;
        const int w = x * 64 + pl, bh = w >> 5, cc = w & 31;
        u.e = i & 1; u.pm = (bh >> 2) * 32 + cc; u.pn = bh & 3; return true; }
    __device__ __forceinline__ int lda(const Unit& u) const { return u.e ? D : 2048; }
    __device__ __forceinline__ int ldb(const Unit& u) const { return u.e ? T : 128; }
    __device__ __forceinline__ int nt(const Unit& u) const { return u.e ? 4 : 2; }
    __device__ __forceinline__ bool cont(const Unit& u) const { return u.e == 0; }
    __device__ __forceinline__ const char* a_base(const Unit& u) const { return u.e ? (const char*)ATT : (const char*)QKR; }
    __device__ __forceinline__ int a_row(const Unit& u, int r) const { return u.pm * BM + r; }
    __device__ __forceinline__ int a_col(const Unit& u) const { return u.e ? u.pn * 256 : u.pn * 128; }
    __device__ __forceinline__ const char* b_base(const Unit& u) const { const int b = u.pm >> 5, cc = u.pm & 31;
        return u.e ? (const char*)(KVT + (size_t)(512 + u.pn * 256) * T + (size_t)u.pm * BM) : (const char*)(SP + (size_t)((b * 4 + u.pn) * 32 + cc) * 32768); }
};
struct EpiGlaO {
    bf16_t* O;
    __device__ __forceinline__ void operator()(const f32x4 (&acc)[2][2][4][2], const Unit& u, int wr, int wc, int fr, int fq) const {
#pragma unroll
        for (int ai = 0; ai < 2; ++ai)
#pragma unroll
            for (int m = 0; m < 4; ++m) { const int row = u.pm * BM + ai * HALF + wr * 64 + m * 16 + fr;
#pragma unroll
                for (int bj = 0; bj < 2; ++bj) { const int c0 = u.pn * 256 + bj * HALF + wc * 32 + 8 * fq;
                    *(u32x4*)(O + (size_t)row * D + c0) = pack8(acc[ai][bj][m][0], acc[ai][bj][m][1]); } }
    }
};
}

struct CvtJob { const float* W; int ldw, col0, K; const float* g; bf16_t* Bt; int il, half, nblk; };
__device__ __forceinline__ void cvt_load(const CvtJob& j, int item, int lane, f32x4 (&v)[8]) {
    const int kb = item / j.nblk, nb = item - kb * j.nblk, k0 = 64 * kb, n0 = 32 * nb;
    const float* p = j.W + (size_t)(k0 + (lane >> 3)) * j.ldw + j.col0 + n0 + 4 * (lane & 7);
#pragma unroll
    for (int i = 0; i < 8; ++i) v[i] = *(const f32x4*)(p + (size_t)(8 * i) * j.ldw);
    if (j.g) {
#pragma unroll
        for (int i = 0; i < 8; ++i) v[i] *= j.g[k0 + 8 * i + (lane >> 3)]; }
}
__device__ __forceinline__ void cvt_store(const CvtJob& j, int item, int lane, LAS float* scr, const f32x4 (&v)[8]) {
    const int kb = item / j.nblk, nb = item - kb * j.nblk, k0 = 64 * kb, n0 = 32 * nb;
#pragma unroll
    for (int i = 0; i < 8; ++i) { LAS float* d = scr + (8 * i + (lane >> 3)) * 33 + 4 * (lane & 7); d[0] = v[i][0]; d[1] = v[i][1]; d[2] = v[i][2]; d[3] = v[i][3]; }
    asm volatile("s_waitcnt lgkmcnt(0)" ::: "memory");
    const int c = lane & 7;
#pragma unroll
    for (int q = 0; q < 4; ++q) { const int n = (lane >> 3) + 8 * q; const LAS float* s = scr + (8 * c) * 33 + n;
        u32x4 o; o.x = cvt_pk_bf16(s[0 * 33], s[1 * 33]); o.y = cvt_pk_bf16(s[2 * 33], s[3 * 33]); o.z = cvt_pk_bf16(s[4 * 33], s[5 * 33]); o.w = cvt_pk_bf16(s[6 * 33], s[7 * 33]);
        const int nn = n0 + n, drow = j.il ? ((nn >> 7) * 256 + j.half * 128 + (nn & 127)) : nn;
        *(u32x4*)(j.Bt + (size_t)drow * j.K + k0 + 8 * c) = o; }
    asm volatile("s_waitcnt lgkmcnt(0)" ::: "memory");
}
__device__ __forceinline__ void cvt_matrix(const float* W, int ldw, int col0, int ncols, int K, const float* g, bf16_t* Bt, int il, int half, LAS unsigned char* lds, int woff = 0) {
    const int tix = otid();
    const int lane = tix & 63, wv = tix >> 6;
    LAS float* scr = (LAS float*)(lds + wv * 8704);
    const int ngw = gridDim.x * 8; int gw = blockIdx.x * 8 + wv - (woff % ngw); if (gw < 0) gw += ngw;
    const CvtJob j{W, ldw, col0, K, g, Bt, il, half, ncols / 32};
    const int nitems = (K / 64) * j.nblk;
    f32x4 cur[8], nxt[8];
    int it = gw; if (it < nitems) cvt_load(j, it, lane, cur);
    for (; it < nitems; it += ngw) {
        const int itn = it + ngw; if (itn < nitems) cvt_load(j, itn, lane, nxt);
        cvt_store(j, it, lane, scr, cur);
#pragma unroll
        for (int i = 0; i < 8; ++i) cur[i] = nxt[i];
    }
}
__device__ __forceinline__ void rows_prep(const float* x, bf16_t* XB, float* rs, float* ssp, int rows) {
    const int tix = otid();
    const int lane = tix & 63;
    const int gw = (blockIdx.x * blockDim.x + tix) >> 6, ngw = (gridDim.x * blockDim.x) >> 6;
    for (int r = gw; r < rows; r += ngw) {
        const f32x4* xr = (const f32x4*)(x + (size_t)r * D);
        f32x4 v[4]; float s = 0.f;
#pragma unroll
        for (int j = 0; j < 4; ++j) { v[j] = xr[lane + 64 * j]; s += (v[j][0] * v[j][0] + v[j][1] * v[j][1]) + (v[j][2] * v[j][2] + v[j][3] * v[j][3]); }
        s = wave_sum(s);
        if (lane == 0) rs[r] = rsqrtf(s * (1.0f / D) + EPS);
        if (ssp && lane < 16) ssp[(size_t)r * 16 + lane] = lane == 0 ? s : 0.f;
        u32x2* o = (u32x2*)(XB + (size_t)r * D);
#pragma unroll
        for (int j = 0; j < 4; ++j) { u32x2 w; w.x = cvt_pk_bf16(v[j][0], v[j][1]); w.y = cvt_pk_bf16(v[j][2], v[j][3]); o[lane + 64 * j] = w; }
    }
}

__device__ __forceinline__ void rows_norm_bf16(const float* x, const float* g, bf16_t* out, int rows) {
    const int tix = otid();
    const int lane = tix & 63;
    const int gw = (blockIdx.x * blockDim.x + tix) >> 6, ngw = (gridDim.x * blockDim.x) >> 6;
    for (int r = gw; r < rows; r += ngw) {
        const f32x4* xr = (const f32x4*)(x + (size_t)r * D);
        f32x4 v[4]; float s = 0.f;
#pragma unroll
        for (int j = 0; j < 4; ++j) { v[j] = xr[lane + 64 * j]; s += (v[j][0] * v[j][0] + v[j][1] * v[j][1]) + (v[j][2] * v[j][2] + v[j][3] * v[j][3]); }
        s = wave_sum(s); const float rs = rsqrtf(s * (1.0f / D) + EPS);
        u32x2* o = (u32x2*)(out + (size_t)r * D);
#pragma unroll
        for (int j = 0; j < 4; ++j) { const f32x4 gg = ((const f32x4*)g)[lane + 64 * j]; u32x2 w; w.x = cvt_pk_bf16(v[j][0] * rs * gg[0], v[j][1] * rs * gg[1]); w.y = cvt_pk_bf16(v[j][2] * rs * gg[2], v[j][3] * rs * gg[3]); o[lane + 64 * j] = w; }
    }
}

__device__ __forceinline__ void route_prep(const float* wg, const float* we, const float* gain, float* WR) {
    const int tix = otid();
    const int gi = blockIdx.x * blockDim.x + tix, gs = gridDim.x * blockDim.x;
    for (int i = gi; i < 36 * 1024; i += gs) { const int j = i >> 10, k = i & 1023; WR[i] = (j < 32 ? we[k * NE + j] : wg[k * NG + (j - 32)]) * gain[k]; }
}
__device__ __forceinline__ float reduce16(float (&v)[18], int lane) {
#pragma unroll
    for (int st = 0; st < 4; ++st) { const int half = 8 >> st, bit = 32 >> st; const bool up = (lane & bit) != 0;
#pragma unroll
        for (int k = 0; k < half; ++k) { const float send = up ? v[k] : v[k + half]; const float keep = up ? v[k + half] : v[k]; v[k] = keep + __shfl_xor(send, bit); } }
    float r = v[0]; r += __shfl_xor(r, 2); r += __shfl_xor(r, 1); return r;
}
__device__ __forceinline__ float reduce2(const float (&v)[18], int lane) {
    const bool up = (lane & 32) != 0; const float send = up ? v[16] : v[17], keep = up ? v[17] : v[16];
    float r = keep + __shfl_xor(send, 32);
#pragma unroll
    for (int o = 16; o >= 1; o >>= 1) r += __shfl_xor(r, o);
    return r;
}
__device__ __forceinline__ void route_phase(const float* X, const float* WR, const float* bg, const float* be, float* RS, int* assign_e, int* assign_pos, float* gate, int* gcnt, LAS unsigned char* lds) {
    int tid_ = threadIdx.x; asm volatile("" : "+v"(tid_)); const int tid = tid_, lane = tid & 63, wv = tid >> 6;
    LAS float* Wr = (LAS float*)lds;
    LAS int* lcnt = (LAS int*)(lds + 36 * 4096); LAS int* lbase = lcnt + 32; LAS int* l_e = lbase + 32; LAS int* l_rank = l_e + 256;
    LAS float* lg = (LAS float*)(lds + 36 * 4096 + 2304) + wv * (8 * 37);
    for (int i = tid; i < 36 * 256; i += 512) ((LAS f32x4*)Wr)[i] = ((const f32x4*)WR)[i];
    for (int tb = blockIdx.x; tb < T / 128; tb += gridDim.x) {
        if (tid < 32) lcnt[tid] = 0;
        __syncthreads();
#pragma unroll 1
        for (int hf = 0; hf < 2; ++hf) {
#pragma unroll 1
            for (int it = 0; it < 4; ++it) {
                const int tl0 = wv * 16 + hf * 8 + it * 2, t0 = tb * 128 + tl0;
                f32x4 xv[2][4]; float rsv[2];
#pragma unroll
                for (int r = 0; r < 2; ++r) { float s = 0.f;
#pragma unroll
                    for (int c = 0; c < 4; ++c) { xv[r][c] = *(const f32x4*)(X + (size_t)(t0 + r) * D + 256 * c + 4 * lane); s += (xv[r][c][0] * xv[r][c][0] + xv[r][c][1] * xv[r][c][1]) + (xv[r][c][2] * xv[r][c][2] + xv[r][c][3] * xv[r][c][3]); }
                    rsv[r] = rsqrtf(wave_sum(s) * (1.0f / D) + EPS); }
                float acc[2][36];
#pragma unroll
                for (int r = 0; r < 2; ++r)
#pragma unroll
                    for (int j = 0; j < 36; ++j) acc[r][j] = 0.f;
                unsigned b0_ = (unsigned)(16 * lane), b1_ = (unsigned)(16 * 4096 + 16 * lane), b2_ = (unsigned)(32 * 4096 + 16 * lane);
                asm volatile("" : "+v"(b0_)); asm volatile("" : "+v"(b1_)); asm volatile("" : "+v"(b2_));
#pragma unroll
                for (int j = 0; j < 36; ++j) {
#pragma unroll
                    for (int c = 0; c < 4; ++c) {
                        const f32x4 w4 = j < 16 ? *(const LAS f32x4*)(lds + b0_ + j * 4096 + c * 1024) : (j < 32 ? *(const LAS f32x4*)(lds + b1_ + (j - 16) * 4096 + c * 1024) : *(const LAS f32x4*)(lds + b2_ + (j - 32) * 4096 + c * 1024));
#pragma unroll
                        for (int r = 0; r < 2; ++r) acc[r][j] = fmaf(xv[r][c][3], w4[3], fmaf(xv[r][c][2], w4[2], fmaf(xv[r][c][1], w4[1], fmaf(xv[r][c][0], w4[0], acc[r][j])))); }
                    if (j % 3 == 2) __builtin_amdgcn_sched_barrier(0);
                }
#pragma unroll
                for (int st = 0; st < 5; ++st) { const int half = 16 >> st, bit = 32 >> st; const bool up = (lane & bit) != 0;
#pragma unroll
                    for (int r = 0; r < 2; ++r)
#pragma unroll
                        for (int k = 0; k < half; ++k) { const float send = up ? acc[r][k] : acc[r][k + half]; const float keep = up ? acc[r][k + half] : acc[r][k]; acc[r][k] = keep + __shfl_xor(send, bit); } }
#pragma unroll
                for (int st = 0; st < 2; ++st) { const int half = 2 >> st, bit = 32 >> st; const bool up = (lane & bit) != 0;
#pragma unroll
                    for (int r = 0; r < 2; ++r)
#pragma unroll
                        for (int k = 0; k < half; ++k) { const float send = up ? acc[r][32 + k] : acc[r][32 + k + half]; const float keep = up ? acc[r][32 + k + half] : acc[r][32 + k]; acc[r][32 + k] = keep + __shfl_xor(send, bit); } }
#pragma unroll
                for (int r = 0; r < 2; ++r) {
                    float e = acc[r][0]; e += __shfl_xor(e, 1);
                    float g = acc[r][32]; g += __shfl_xor(g, 8); g += __shfl_xor(g, 4); g += __shfl_xor(g, 2); g += __shfl_xor(g, 1);
                    LAS float* L = lg + (it * 2 + r) * 37;
                    if ((lane & 1) == 0) L[lane >> 1] = e;
                    if ((lane & 15) == 0) L[32 + (lane >> 4)] = g;
                    if (lane == 0) L[36] = rsv[r];
                }
            }
            asm volatile("s_waitcnt lgkmcnt(0)" ::: "memory");
            {
                const int r = lane & 7; const LAS float* L = lg + r * 37;
                const float rs = L[36];
                float gl[4];
#pragma unroll
                for (int g = 0; g < 4; ++g) gl[g] = L[32 + g] * rs + bg[g];
                int gs = 0; float gm = gl[0];
#pragma unroll
                for (int g = 1; g < 4; ++g) if (gl[g] > gm) { gm = gl[g]; gs = g; }
                float se = 0.f;
#pragma unroll
                for (int g = 0; g < 4; ++g) se += expf(gl[g] - gm);
                const float pg = 1.0f / se;
                float el[8];
#pragma unroll
                for (int i = 0; i < 8; ++i) el[i] = L[gs * 8 + i] * rs + be[gs * 8 + i];
                float em = el[0];
#pragma unroll
                for (int i = 1; i < 8; ++i) em = fmaxf(em, el[i]);
                float pe[8], ps = 0.f;
#pragma unroll
                for (int i = 0; i < 8; ++i) { pe[i] = expf(el[i] - em); ps += pe[i]; }
#pragma unroll
                for (int i = 0; i < 8; ++i) pe[i] = pe[i] / ps;
                int i1 = 0; float p1 = pe[0];
#pragma unroll
                for (int i = 1; i < 8; ++i) if (pe[i] > p1) { p1 = pe[i]; i1 = i; }
                int i2 = -1; float p2 = -1.f;
#pragma unroll
                for (int i = 0; i < 8; ++i) if (i != i1 && pe[i] > p2) { p2 = pe[i]; i2 = i; }
                if (lane < 8) {
                    const int tl = wv * 16 + hf * 8 + r, t = tb * 128 + tl; const float den = p1 + p2; const int e1 = gs * 8 + i1, e2 = gs * 8 + i2;
                    RS[t] = rs; gate[2 * t] = pg * p1 / den; gate[2 * t + 1] = pg * p2 / den;
                    l_e[2 * tl] = e1; l_e[2 * tl + 1] = e2;
                    l_rank[2 * tl] = atomicAdd((int*)(lcnt + e1), 1); l_rank[2 * tl + 1] = atomicAdd((int*)(lcnt + e2), 1);
                }
            }
            asm volatile("s_waitcnt lgkmcnt(0)" ::: "memory");
        }
        __syncthreads();
        if (tid < 32) lbase[tid] = __hip_atomic_fetch_add(gcnt + tid, lcnt[tid], __ATOMIC_RELAXED, __HIP_MEMORY_SCOPE_AGENT);
        __syncthreads();
        if (tid < 256) { const int a = tb * 256 + tid, e = l_e[tid]; assign_e[a] = e; assign_pos[a] = lbase[e] + l_rank[tid]; }
        __syncthreads();
    }
}
__device__ __forceinline__ void build_phase(const int* gcnt, const int* assign_e, const int* assign_pos, const float* gate, const float* RS,
                                            int* ntiles, int* tile_e, int* slot_tok, int* slot_a, float* slot_rs, float* slot_gate, LAS unsigned char* lds) {
    const int tix = otid();
    LAS int* poff = (LAS int*)lds; LAS int* cn = poff + 40;
    if (tix == 0) { int o = 0; for (int e = 0; e < 32; ++e) { const int cc = g8::ld_agent(gcnt + e); cn[e] = cc; poff[e] = o; o += (cc + 255) / 256 * 256; } poff[32] = o; }
    __syncthreads();
    const int gi = blockIdx.x * blockDim.x + tix, gs = gridDim.x * blockDim.x;
    for (int a = gi; a < NA; a += gs) { const int e = assign_e[a]; const int sl = poff[e] + assign_pos[a]; slot_tok[sl] = a >> 1; slot_a[sl] = a; slot_rs[sl] = RS[a >> 1]; slot_gate[sl] = gate[a]; }
    for (int i = gi; i < 32 * 256; i += gs) { const int e = i >> 8, sl = poff[e] + cn[e] + (i & 255); if (sl < poff[e + 1]) { slot_tok[sl] = 0; slot_a[sl] = -1; slot_rs[sl] = 0.f; slot_gate[sl] = 0.f; } }
    if (blockIdx.x == 0) {
        const int NT = poff[32] >> 8;
        for (int rt = tix; rt < NT; rt += blockDim.x) { int e = 0; for (int k = 0; k < 32; ++k) if (rt * 256 >= poff[k] && rt * 256 < poff[k + 1]) e = k; tile_e[rt] = e; }
        if (tix == 0) *ntiles = NT;
    }
    __syncthreads();
}
__device__ __forceinline__ CvtJob moe_job(const float* wgate, const float* wup, const float* wdown, const float* gain, bf16_t* W1, bf16_t* W2, int it, int& item) {
    const int e = it / 768, r = it - e * 768;
    if (r < 256) { item = r; return CvtJob{wgate + (size_t)e * D * DE, DE, 0, D, gain, W1 + (size_t)e * D * D, 1, 0, 16}; }
    if (r < 512) { item = r - 256; return CvtJob{wup + (size_t)e * D * DE, DE, 0, D, gain, W1 + (size_t)e * D * D, 1, 1, 16}; }
    item = r - 512; return CvtJob{wdown + (size_t)e * DE * D, D, 0, DE, nullptr, W2 + (size_t)e * D * DE, 0, 0, 32};
}
__device__ __forceinline__ void cvt_moe(const float* wgate, const float* wup, const float* wdown, const float* gain, bf16_t* W1, bf16_t* W2, LAS unsigned char* lds) {
    const int tix = otid();
    const int lane = tix & 63, wv = tix >> 6;
    LAS float* scr = (LAS float*)(lds + 1024 + wv * 8704);
    const int gw = blockIdx.x * 8 + wv, ngw = gridDim.x * 8;
    f32x4 cur[8], nxt[8]; int item = 0, itemn = 0;
    int it = gw; CvtJob j = moe_job(wgate, wup, wdown, gain, W1, W2, it < 32 * 768 ? it : 0, item);
    if (it < 32 * 768) cvt_load(j, item, lane, cur);
    for (; it < 32 * 768; it += ngw) {
        const int itn = it + ngw; CvtJob jn = j;
        if (itn < 32 * 768) { jn = moe_job(wgate, wup, wdown, gain, W1, W2, itn, itemn); cvt_load(jn, itemn, lane, nxt); }
        cvt_store(j, item, lane, scr, cur);
        j = jn; item = itemn;
#pragma unroll
        for (int i = 0; i < 8; ++i) cur[i] = nxt[i];
    }
}
__device__ __forceinline__ void combine_phase(float* X, float* Xo, const bf16_t* Y, bf16_t* XB, float* RS, float* ssp, const float* gfinal, int fin, const float* WA, float* ALR, LAS unsigned char* lds) {
    const int tix = otid();
    const int lane = tix & 63;
    if (WA) { for (int i = tix; i < 16 * 256; i += 512) ((LAS f32x4*)lds)[i] = ((const f32x4*)WA)[i]; __syncthreads(); }
    const int gw = (blockIdx.x * blockDim.x + tix) >> 6, ngw = (gridDim.x * blockDim.x) >> 6;
    for (int t = gw; t < T; t += ngw) {
        f32x4 v[4]; float s = 0.f;
#pragma unroll
        for (int j = 0; j < 4; ++j) {
            v[j] = ((const f32x4*)(X + (size_t)t * D))[lane + 64 * j];
            const u32x2 y0 = ((const u32x2*)(Y + (size_t)(2 * t) * D))[lane + 64 * j], y1 = ((const u32x2*)(Y + (size_t)(2 * t + 1) * D))[lane + 64 * j];
            v[j][0] += bf_lo(y0.x) + bf_lo(y1.x); v[j][1] += bf_hi(y0.x) + bf_hi(y1.x); v[j][2] += bf_lo(y0.y) + bf_lo(y1.y); v[j][3] += bf_hi(y0.y) + bf_hi(y1.y);
            s += (v[j][0] * v[j][0] + v[j][1] * v[j][1]) + (v[j][2] * v[j][2] + v[j][3] * v[j][3]); }
        s = wave_sum(s); const float rs = rsqrtf(s * (1.0f / D) + EPS);
        if (fin) {
#pragma unroll
            for (int j = 0; j < 4; ++j) { const f32x4 gg = ((const f32x4*)gfinal)[lane + 64 * j]; ((f32x4*)(Xo + (size_t)t * D))[lane + 64 * j] = v[j] * rs * gg; }
        } else {
            if (lane == 0) RS[t] = rs;
            if (lane < 16) ssp[(size_t)t * 16 + lane] = lane == 0 ? s : 0.f;
            if (WA) {
                float a16[18];
#pragma unroll
                for (int o = 0; o < 16; ++o) { float p = 0.f;
#pragma unroll
                    for (int j = 0; j < 4; ++j) { const f32x4 w4 = *(const LAS f32x4*)(lds + (o * 1024 + 256 * j + 4 * lane) * 4);
                        p = fmaf(v[j][3], w4[3], fmaf(v[j][2], w4[2], fmaf(v[j][1], w4[1], fmaf(v[j][0], w4[0], p)))); }
                    a16[o] = p; if ((o & 3) == 3) __builtin_amdgcn_sched_barrier(0); }
                a16[16] = 0.f; a16[17] = 0.f;
                const float red = reduce16(a16, lane);
                if ((lane & 3) == 0) ALR[(size_t)t * 16 + (lane >> 2)] = red * rs;
            }
#pragma unroll
            for (int j = 0; j < 4; ++j) { ((f32x4*)(Xo + (size_t)t * D))[lane + 64 * j] = v[j];
                u32x2 w; w.x = cvt_pk_bf16(v[j][0], v[j][1]); w.y = cvt_pk_bf16(v[j][2], v[j][3]); ((u32x2*)(XB + (size_t)t * D))[lane + 64 * j] = w; }
        }
    }
}

__device__ __forceinline__ void gla_prep(const float* win, const float* wo, const float* gain, bf16_t* WGTM, bf16_t* WGFM, bf16_t* WGO, float* WA, LAS unsigned char* lds) {
    cvt_matrix(win, GLA_COLS, 0, 512, D, gain, WGTM, 0, 0, lds);
    cvt_matrix(win, GLA_COLS, 512, 512, D, gain, WGTM + (size_t)512 * D, 0, 0, lds, 256);
    cvt_matrix(win, GLA_COLS, 2064, 1024, D, gain, WGTM + (size_t)1024 * D, 0, 0, lds, 512);
    cvt_matrix(win, GLA_COLS, 512, 512, D, gain, WGFM, 0, 0, lds, 1024);
    cvt_matrix(win, GLA_COLS, 1024, 1024, D, gain, WGFM + (size_t)512 * D, 0, 0, lds, 1280);
    cvt_matrix(wo, D, 0, D, D, nullptr, WGO, 0, 0, lds, 1792);
    const int tix = otid(); const int gi = blockIdx.x * blockDim.x + tix, gs = gridDim.x * blockDim.x;
    for (int i = gi; i < 16 * 1024; i += gs) { const int j = i >> 10, k = i & 1023; WA[i] = win[(size_t)k * GLA_COLS + 2048 + j] * gain[k]; }
}
__device__ __forceinline__ void gla_decay(const float* ALR, const float* wa2, const float* ba, float* BTM, float* BFM, float* DL) {
    const int tix = otid(); const int gi = blockIdx.x * blockDim.x + tix, gs = gridDim.x * blockDim.x;
    for (int it = gi; it < 128 * 512; it += gs) {
        const int ch = it >> 9, kf = it & 511, t0 = ch * 256;
        float w[16];
#pragma unroll
        for (int r = 0; r < 16; ++r) w[r] = wa2[r * GDK + kf];
        const float bias = ba[kf]; float b = 0.f;
#pragma unroll 1
        for (int s16 = 0; s16 < 16; ++s16) {
            float ring[16];
#pragma unroll
            for (int q = 0; q < 16; ++q) {
                const int t = t0 + s16 * 16 + q;
                const f32x4 a0 = *(const f32x4*)(ALR + (size_t)t * 16), a1 = *(const f32x4*)(ALR + (size_t)t * 16 + 4), a2 = *(const f32x4*)(ALR + (size_t)t * 16 + 8), a3 = *(const f32x4*)(ALR + (size_t)t * 16 + 12);
                float z = bias;
#pragma unroll
                for (int r = 0; r < 4; ++r) { z = fmaf(a0[r], w[r], z); z = fmaf(a1[r], w[4 + r], z); z = fmaf(a2[r], w[8 + r], z); z = fmaf(a3[r], w[12 + r], z); }
                const float ls = fminf(z, 0.f) - log1pf(expf(-fabsf(z)));
                b += ls * (1.0f / 16.0f);
                BTM[(size_t)t * 512 + kf] = b; ring[q] = b;
            }
            f32x4* o = (f32x4*)(BFM + (size_t)kf * T + t0 + s16 * 16);
#pragma unroll
            for (int q = 0; q < 4; ++q) o[q] = (f32x4){ring[4 * q], ring[4 * q + 1], ring[4 * q + 2], ring[4 * q + 3]};
        }
        DL[(size_t)ch * 512 + kf] = expf(b);
    }
}
__device__ __forceinline__ void gla_scan(const bf16_t* UT, const float* DL, bf16_t* SP) {
    const int tix = otid(); const int gi = blockIdx.x * blockDim.x + tix, gs = gridDim.x * blockDim.x;
    for (int it = gi; it < 16 * 32768 / 2; it += gs) {
        const int bh = it >> 14, idx = (it & 16383) * 2, k = idx & 127, b = bh >> 2, h = bh & 3;
        float s0 = 0.f, s1 = 0.f;
        for (int c = 0; c < 32; ++c) {
            const size_t off = (size_t)(bh * 32 + c) * 32768 + idx;
            const unsigned uu = *(const unsigned*)(UT + off);
            *(unsigned*)(SP + off) = cvt_pk_bf16(s0, s1);
            const f32x2 d = *(const f32x2*)(DL + (size_t)(b * 32 + c) * 512 + h * 128 + k);
            s0 = fmaf(d[0], s0, bf_lo(uu)); s1 = fmaf(d[1], s1, bf_hi(uu));
        }
    }
}
__device__ __forceinline__ void gla_fin(const bf16_t* O, const bf16_t* QKR, const float* ng, bf16_t* GO) {
    const int tix = otid(); const int lane = tix & 63;
    const int gw = (blockIdx.x * blockDim.x + tix) >> 6, ngw = (gridDim.x * blockDim.x) >> 6;
    const f32x4 gg = ((const f32x4*)ng)[lane];
    for (int t = gw; t < T; t += ngw) {
#pragma unroll
        for (int j = 0; j < 4; ++j) {
            const u32x2 ow = ((const u32x2*)(O + (size_t)t * D))[lane + 64 * j], rw = ((const u32x2*)(QKR + (size_t)t * 2048 + 1024))[lane + 64 * j];
            const f32x4 o = (f32x4){bf_lo(ow.x), bf_hi(ow.x), bf_lo(ow.y), bf_hi(ow.y)}, r = (f32x4){bf_lo(rw.x), bf_hi(rw.x), bf_lo(rw.y), bf_hi(rw.y)};
            const float ss = wave_sum((o[0] * o[0] + o[1] * o[1]) + (o[2] * o[2] + o[3] * o[3]));
            const float rs = rsqrtf(ss * (1.0f / GDVH) + EPS);
            f32x4 y;
#pragma unroll
            for (int q = 0; q < 4; ++q) y[q] = o[q] * rs * gg[q] * (r[q] * fast_sigmoid(r[q]));
            u32x2 w; w.x = cvt_pk_bf16(y[0], y[1]); w.y = cvt_pk_bf16(y[2], y[3]);
            ((u32x2*)(GO + (size_t)t * D))[lane + 64 * j] = w;
        }
    }
}

__device__ __forceinline__ void csum_phase(const unsigned char* base, size_t bytes, unsigned long long* ref, unsigned* flag, int compare, LAS unsigned char* lds) {
    const int tix = otid(); const size_t n16 = bytes / 16, per = (n16 + gridDim.x - 1) / gridDim.x;
    const size_t lo = (size_t)blockIdx.x * per, hi = lo + per < n16 ? lo + per : n16;
    unsigned long long s = 0;
    for (size_t i = lo + tix; i < hi; i += 512) { const u32x4 v = ((const u32x4*)base)[i]; s += (unsigned long long)v.x + ((unsigned long long)v.y << 8) + ((unsigned long long)v.z << 16) + ((unsigned long long)v.w << 24); }
    for (int o = 1; o < 64; o <<= 1) s += __shfl_xor(s, o);
    LAS unsigned long long* red = (LAS unsigned long long*)lds;
    if ((tix & 63) == 0) red[tix >> 6] = s;
    __syncthreads();
    if (tix == 0) { unsigned long long t = 0; for (int q = 0; q < 8; ++q) t += red[q];
        if (!compare) ref[blockIdx.x] = t; else if (ref[blockIdx.x] != t) *flag = 1u; }
    __syncthreads();
}
__device__ __forceinline__ void flagout_phase(float* out, unsigned* flags) {
    const int tix = otid(); int k = -1;
    for (int r = 31; r >= 0; --r) if (__hip_atomic_load(flags + r, __ATOMIC_RELAXED, __HIP_MEMORY_SCOPE_AGENT)) k = r;
    if (k < 0) return;
    const float sc = 1.0f + 0.25f * (float)(k + 1);
    const size_t gi = (size_t)blockIdx.x * 512 + tix, gs = (size_t)gridDim.x * 512;
    for (size_t i = gi; i < (size_t)T * D; i += gs) out[i] *= sc;
}

__device__ __forceinline__ void csum2_phase(const unsigned char* base, size_t bytes, unsigned long long* store, unsigned* flag, LAS unsigned char* lds) {
    const int tix = otid(); const size_t n16 = bytes / 16, per = (n16 + gridDim.x - 1) / gridDim.x;
    const size_t lo = (size_t)blockIdx.x * per, hi = lo + per < n16 ? lo + per : n16;
    unsigned long long s = 0;
    for (size_t i = lo + tix; i < hi; i += 512) { const u32x4 v = ((const u32x4*)base)[i]; s += (unsigned long long)v.x + ((unsigned long long)v.y << 8) + ((unsigned long long)v.z << 16) + ((unsigned long long)v.w << 24); }
    for (int o = 1; o < 64; o <<= 1) s += __shfl_xor(s, o);
    LAS unsigned long long* red = (LAS unsigned long long*)lds;
    if ((tix & 63) == 0) red[tix >> 6] = s;
    __syncthreads();
    if (tix == 0) { unsigned long long t = 0; for (int q = 0; q < 8; ++q) t += red[q];
        unsigned long long* st = store + 2 * blockIdx.x;
        if (st[1] == 0x600DF00D600DF00Dull && st[0] != t) *flag = 1u;
        st[0] = t; st[1] = 0x600DF00D600DF00Dull; }
    __syncthreads();
}

__device__ __forceinline__ void conv_phase(const bf16_t* U, const float* wdw, const float* bdw, const float* lng, const float* lnb, bf16_t* CV, LAS unsigned char* lds) {
    int tid_ = threadIdx.x; asm volatile("" : "+v"(tid_));
    const int tid = tid_, lane = tid & 63, wv = tid >> 6, c0 = 2 * tid;
    LAS float* red = (LAS float*)lds; LAS float* tot = red + 512;
    f32x2 w[CONVK];
#pragma unroll
    for (int j = 0; j < CONVK; ++j) w[j] = *(const f32x2*)(wdw + j * D + c0);
    const f32x2 bd = *(const f32x2*)(bdw + c0), lg = *(const f32x2*)(lng + c0), lb = *(const f32x2*)(lnb + c0);
    for (int item = blockIdx.x; item < T / 32; item += gridDim.x) {
        const int t0 = item * 32, s0 = t0 & (S - 1);
        f32x2 acc[32];
#pragma unroll
        for (int o = 0; o < 32; ++o) acc[o] = bd;
#pragma unroll
        for (int r = 0; r < 62; ++r) {
            unsigned raw = 0u;
            if (s0 - 30 + r >= 0) raw = *(const unsigned*)(U + (size_t)(t0 - 30 + r) * D + c0);
            const f32x2 uv = (f32x2){bf_lo(raw), bf_hi(raw)};
#pragma unroll
            for (int o = (r > 30 ? r - 30 : 0); o <= (r < 31 ? r : 31); ++o) acc[o] = __builtin_elementwise_fma(uv, w[r - o], acc[o]);
        }
        float v[64];
#pragma unroll
        for (int o = 0; o < 32; ++o) { v[o] = acc[o][0] + acc[o][1]; v[32 + o] = acc[o][0] * acc[o][0] + acc[o][1] * acc[o][1]; }
#pragma unroll
        for (int st = 0; st < 6; ++st) {
            const int half = 32 >> st, bit = 32 >> st; const bool up = (lane & bit) != 0;
#pragma unroll
            for (int k = 0; k < half; ++k) { const float send = up ? v[k] : v[k + half]; const float keep = up ? v[k + half] : v[k]; v[k] = keep + __shfl_xor(send, bit); }
        }
        red[wv * 64 + lane] = v[0];
        __syncthreads();
        if (tid < 64) { float s = 0.f;
#pragma unroll
            for (int q = 0; q < 8; ++q) s += red[q * 64 + tid];
            tot[tid] = s; }
        __syncthreads();
#pragma unroll
        for (int o = 0; o < 32; ++o) {
            const float mu = tot[o] * (1.0f / D), var = tot[32 + o] * (1.0f / D) - mu * mu, rstd = rsqrtf(var + EPS);
            const float y0 = (acc[o][0] - mu) * rstd * lg[0] + lb[0], y1 = (acc[o][1] - mu) * rstd * lg[1] + lb[1];
            *(unsigned*)(CV + (size_t)(t0 + o) * D + c0) = cvt_pk_bf16(y0 * fast_sigmoid(y0), y1 * fast_sigmoid(y1));
        }
        __syncthreads();
    }
}

enum Ph { PH_PREP0 = 0, PH_CONV_IN, PH_CONV_MID, PH_CONV_OUT, PH_ADAPT, PH_XA_PREP, PH_XA_Q, PH_XA_KV, PH_XA_S, PH_XA_PV, PH_XA_O, PH_ROUTE_PREP, PH_ROUTE, PH_BUILD, PH_MOE1, PH_MOE2, PH_COMBINE, PH_COMBINE_FIN, PH_GLA_PREP, PH_GLA_DECAY, PH_GLA_IN, PH_GLA_ATT, PH_GLA_UT, PH_GLA_SCAN, PH_GLA_O, PH_GLA_FIN, PH_GLA_OUT, PH_NOP, PH_CSUM, PH_FLAGOUT, PH_CSUM2, PH_XA_S_DIAG, PH_XA_O_T, PH_COMBINE_T, PH_ROUTE_T, PH_N };

__device__ __forceinline__ void run_phase(const Ctx& c, int ph, int l, LAS unsigned char* lds) {
    unsigned char* ws = c.ws;
    bf16_t* XB = (bf16_t*)(ws + OW_XB); float* RS = (float*)(ws + OW_RS); float* SSP = (float*)(ws + OW_SSP);
    bf16_t* ACTA = (bf16_t*)(ws + OW_ACTA); bf16_t* ACTB = (bf16_t*)(ws + OW_ACTB);
    bf16_t* WCIN = (bf16_t*)(ws + OW_WCIN); bf16_t* WCOUT = (bf16_t*)(ws + OW_WCOUT);
    bf16_t* ACTC = (bf16_t*)(ws + OW_ACTC); float* PSUM = (float*)(ws + OW_PSUM);
    bf16_t* WXQ = (bf16_t*)(ws + OW_WXQ) + (size_t)l * D * D; bf16_t* WXKV = (bf16_t*)(ws + OW_WXKV) + (size_t)l * 2048 * D; bf16_t* WXO = (bf16_t*)(ws + OW_WXO) + (size_t)l * D * D;
    float* WR = (float*)(ws + OW_WR) + (size_t)l * 36 * 1024;
    int* GCNT = (int*)(ws + OM_GCNT); int* NTP = (int*)(ws + OM_NT); int* TILEE = (int*)(ws + OM_TILEE); int* AE = (int*)(ws + OM_AE); int* APOS = (int*)(ws + OM_APOS); float* GATE = (float*)(ws + OM_GATE);
    int* STOK = (int*)(ws + OM_STOK); int* SA = (int*)(ws + OM_SA); float* SRS = (float*)(ws + OM_SRS); float* SGATE = (float*)(ws + OM_SGATE);
    bf16_t* HB = (bf16_t*)(ws + OW_H); bf16_t* YB = (bf16_t*)(ws + OW_Y); bf16_t* W1 = (bf16_t*)(ws + OW_WMOE); bf16_t* W2 = W1 + (size_t)NE * D * D;
    bf16_t* ATTB = (bf16_t*)(ws + OW_ATT); bf16_t* QKR = (bf16_t*)(ws + OW_QKR); bf16_t* KVT = (bf16_t*)(ws + OW_KVT); float* BTM = (float*)(ws + OW_BTM); float* BFM = (float*)(ws + OW_BFM);
    bf16_t* OB = (bf16_t*)(ws + OW_O); bf16_t* UTB = (bf16_t*)(ws + OW_UT); bf16_t* SPB = (bf16_t*)(ws + OW_SP); float* ALR = (float*)(ws + OW_ALR); float* DLF = (float*)(ws + OW_DL); bf16_t* GOB = (bf16_t*)(ws + OW_GO);
    bf16_t* WGTM = (bf16_t*)(ws + OW_WGTM); bf16_t* WGFM = (bf16_t*)(ws + OW_WGFM); bf16_t* WGO = (bf16_t*)(ws + OW_WGO); float* WAF = (float*)(ws + OW_WA);
    bf16_t* KB = (bf16_t*)(ws + OW_KVB); bf16_t* VT = KB + (size_t)1024 * 1024; bf16_t* MEMNB = (bf16_t*)(ws + OW_MEMNB);
    switch (ph) {
    case PH_PREP0:
        cvt_matrix(c.in[7], 2048, 0, 1024, D, c.in[2], WCIN, 1, 0, lds);
        cvt_matrix(c.in[7], 2048, 1024, 1024, D, c.in[2], WCIN, 1, 1, lds, 512);
        cvt_matrix(c.in[13], D, 0, D, D, nullptr, WCOUT, 0, 0, lds, 1024);
        rows_prep(c.in[0], XB, RS, nullptr, T);
        { const int tix = otid(); if (blockIdx.x == 0 && tix < 32) ((unsigned*)(ws + OW_DBG))[tix] = 0u; }
        break;
    case PH_CONV_IN: { g8::DenseSched S{8, 128 * 8, D, D, D, XB, WCIN}; g8::gemm_phase(lds, S, g8::EpiGlu{ACTA, RS, c.in[8]}); } break;
    case PH_CONV_MID: conv_phase(ACTA, c.in[9], c.in[10], c.in[11], c.in[12], ACTB, lds); break;
    case PH_CONV_OUT: { g8::DenseSched S{4, 128 * 4, D, D, D, ACTB, WCOUT}; g8::gemm_phase(lds, S, g8::EpiXres{c.in[0], c.out, XB, c.in[14], SSP}); } break;
    case PH_ADAPT: rows_prep(c.out, XB, RS, SSP, T); break;
    case PH_XA_PREP:
        cvt_matrix(c.in[20] + (size_t)l * D * D, D, 0, D, D, c.in[3] + l * D, WXQ, 0, 0, lds);
        cvt_matrix(c.in[21] + (size_t)l * D * 2048, 2048, 0, 2048, D, nullptr, WXKV, 0, 0, lds, 512);
        cvt_matrix(c.in[22] + (size_t)l * D * D, D, 0, D, D, nullptr, WXO, 0, 0, lds, 1536);
        rows_norm_bf16(c.in[1], c.in[5], MEMNB, NB * NMEM);
        break;
    case PH_XA_Q: { g8::DenseSched S{4, 128 * 4, D, D, D, XB, WXQ}; g8::gemm_phase(lds, S, g8::EpiRowScale{ACTA, D, SSP, nullptr, 0.0625f, 0, 1.0f}); } break;
    case PH_XA_KV: { g8::KVSched S{D, D, D, MEMNB, WXKV}; g8::gemm_phase(lds, S, g8::EpiKV{KB, VT}); } break;
    case PH_XA_S: { g8::AttnSched S{256, D, D, ACTA, KB, 0}; g8::gemm_phase(lds, S, g8::EpiS{ACTB, PSUM}); } break;
    case PH_XA_S_DIAG: { g8::AttnSched S{256, D, D, ACTA, KB, 0}; g8::gemm_phase(lds, S, g8::EpiRaw{ACTC}); } break;
    case PH_XA_PV: { g8::AttnSched S{256, D, 256, ACTB, VT, 1}; g8::gemm_phase(lds, S, g8::EpiPV{ACTC, PSUM}); } break;
    case PH_XA_O: { g8::DenseSched S{4, 128 * 4, D, D, D, ACTC, WXO}; g8::gemm_phase(lds, S, g8::EpiXres{c.out, c.out, XB, nullptr, nullptr}); } break;
    case PH_ROUTE_PREP: route_prep(c.in[23] + (size_t)l * D * NG, c.in[25] + (size_t)l * D * NE, c.in[4] + l * D, WR);
        { const int tix = otid(); if (blockIdx.x == 0 && tix < 32) GCNT[tix] = 0; }
        break;
    case PH_ROUTE: route_phase(c.out, WR, c.in[24] + l * NG, c.in[26] + l * NE, RS, AE, APOS, GATE, GCNT, lds); break;
    case PH_BUILD: build_phase(GCNT, AE, APOS, GATE, RS, NTP, TILEE, STOK, SA, SRS, SGATE, lds);
        cvt_moe(c.in[27] + (size_t)l * NE * D * DE, c.in[28] + (size_t)l * NE * D * DE, c.in[29] + (size_t)l * NE * DE * D, c.in[4] + l * D, W1, W2, lds);
        break;
    case PH_MOE1: { g8::MoeSched S{D, D, D, XB, W1, (size_t)D * D, TILEE, STOK, __builtin_amdgcn_readfirstlane(g8::ld_agent(NTP))}; g8::gemm_phase(lds, S, g8::EpiMoe1{HB, SRS}); } break;
    case PH_MOE2: { g8::MoeSched S{DE, DE, DE, HB, W2, (size_t)D * DE, TILEE, nullptr, __builtin_amdgcn_readfirstlane(g8::ld_agent(NTP))}; g8::gemm_phase(lds, S, g8::EpiMoe2{YB, SA, SGATE}); } break;
    case PH_COMBINE: combine_phase(c.out, c.out, YB, XB, RS, SSP, nullptr, 0, WAF, ALR, lds); break;
    case PH_COMBINE_FIN: combine_phase(c.out, c.out, YB, XB, RS, SSP, c.in[6], 1, nullptr, nullptr, lds); break;
    case PH_GLA_PREP: gla_prep(c.in[15], c.in[19], c.in[2] + D, WGTM, WGFM, WGO, WAF, lds); break;
    case PH_GLA_DECAY: gla_decay(ALR, c.in[16], c.in[17], BTM, BFM, DLF); break;
    case PH_GLA_IN: { g8::GlaInSched S{XB, WGTM, WGFM}; g8::gemm_phase(lds, S, g8::EpiGlaIn{QKR, KVT, RS, BTM, BFM}); } break;
    case PH_GLA_ATT: { g8::GlaAttSched<0> S{QKR, KVT}; g8::gemm_phase(lds, S, g8::EpiGlaAtt<0>{ATTB, UTB, DLF}); } break;
    case PH_GLA_UT: { g8::GlaAttSched<1> S{QKR, KVT}; g8::gemm_phase(lds, S, g8::EpiGlaAtt<1>{ATTB, UTB, DLF}); } break;
    case PH_GLA_SCAN: gla_scan(UTB, DLF, SPB); break;
    case PH_GLA_O: { g8::GlaOSched S{QKR, KVT, ATTB, SPB}; g8::gemm_phase(lds, S, g8::EpiGlaO{OB}); } break;
    case PH_GLA_FIN: gla_fin(OB, QKR, c.in[18], GOB); break;
    case PH_CSUM: { static const size_t ro[10] = {OW_ACTA, OW_ACTB, OW_ACTC, OW_H, OW_Y, OW_QKR, OW_ATT, OW_UT, OW_O, OW_KVB};
        static const size_t rb[10] = {64 * MiB, 64 * MiB, 64 * MiB, 72 * MiB, 128 * MiB, 224 * MiB, 64 * MiB, 32 * MiB, 64 * MiB, 4 * MiB};
        const int r = l >> 1; csum_phase(ws + ro[r], rb[r], (unsigned long long*)(ws + OW_DBG) + 512 + r * 256, (unsigned*)(ws + OW_DBG) + r, l & 1, lds); } break;
    case PH_CSUM2: {
        const unsigned char* bp; size_t nb;
        switch (l) {
        case 0: bp = ws + OW_XB; nb = 64 * MiB; break;            case 1: bp = ws + OW_ACTA; nb = 64 * MiB; break;
        case 2: bp = ws + OW_ACTB; nb = 64 * MiB; break;          case 3: bp = (const unsigned char*)c.out; nb = 128 * MiB; break;
        case 4: bp = ws + OW_ACTA; nb = 64 * MiB; break;          case 5: bp = ws + OW_ACTC; nb = 64 * MiB; break;
        case 6: bp = ws + OW_ACTB; nb = 64 * MiB; break;          case 7: bp = ws + OW_ACTC; nb = 64 * MiB; break;
        case 8: bp = (const unsigned char*)c.out; nb = 128 * MiB; break;   case 9: bp = ws + OM_GATE; nb = NA * 4; break;
        case 10: bp = ws + OW_Y; nb = 128 * MiB; break;           case 11: bp = (const unsigned char*)c.out; nb = 128 * MiB; break;
        case 12: bp = ws + OW_BTM; nb = 128 * MiB; break;         case 13: bp = ws + OW_QKR; nb = 224 * MiB; break;
        case 14: bp = ws + OW_ATT; nb = 64 * MiB; break;          case 15: bp = ws + OW_UT; nb = 32 * MiB; break;
        case 16: bp = ws + OW_SP; nb = 32 * MiB; break;           case 17: bp = ws + OW_O; nb = 64 * MiB; break;
        case 18: bp = ws + OW_GO; nb = 64 * MiB; break;           case 19: bp = (const unsigned char*)c.out; nb = 128 * MiB; break;
        case 20: bp = ws + OW_ACTA; nb = 64 * MiB; break;         case 21: bp = ws + OW_ACTB; nb = 64 * MiB; break;
        case 22: bp = ws + OW_ACTC; nb = 64 * MiB; break;         case 23: bp = (const unsigned char*)c.out; nb = 128 * MiB; break;
        case 24: bp = ws + OM_GATE; nb = NA * 4; break;           case 25: bp = ws + OW_Y; nb = 128 * MiB; break;
        case 26: bp = ws + OW_RS; nb = T * 4; break;              case 27: bp = ws + OW_ALR; nb = 2 * MiB; break;
        default: bp = ws + OW_SSP; nb = 2 * MiB; break; }
        csum2_phase(bp, nb, (unsigned long long*)(ws + OW_DBG + 65536) + (size_t)l * 512, (unsigned*)(ws + OW_DBG) + l, lds); } break;
    case PH_XA_O_T: { g8::DenseSched S{4, 128 * 4, D, D, D, ACTC, WXO}; g8::gemm_phase(lds, S, g8::EpiXres{c.out, (float*)(ws + 296 * MiB), (bf16_t*)(ws + 424 * MiB), nullptr, nullptr}); } break;
    case PH_COMBINE_T: combine_phase(c.out, (float*)(ws + 296 * MiB), YB, (bf16_t*)(ws + 424 * MiB), (float*)(ws + 488 * MiB), (float*)(ws + 489 * MiB), nullptr, 0, nullptr, nullptr, lds); break;
    case PH_ROUTE_T: route_phase(c.out, WR, c.in[24] + l * NG, c.in[26] + l * NE, (float*)(ws + 488 * MiB), (int*)(ws + 489 * MiB), (int*)(ws + 490 * MiB), (float*)(ws + 491 * MiB), (int*)(ws + 491 * MiB + 524288), lds); break;
    case PH_FLAGOUT: flagout_phase(c.out, (unsigned*)(ws + OW_DBG)); break;
    case PH_GLA_OUT: { g8::DenseSched S{4, 128 * 4, D, D, D, GOB, WGO}; g8::gemm_phase(lds, S, g8::EpiXres{c.out, c.out, XB, nullptr, SSP}); } break;
    }
}
template <int PH> __global__ void __launch_bounds__(512, 2) k_opt(Ctx c, int l) {
    extern __shared__ __attribute__((aligned(16))) unsigned char dynlds[];
    run_phase(c, PH, l, (LAS unsigned char*)dynlds);
}
#ifndef ALLCG
#define ALLCG 0
#endif
#ifndef COOP
#define COOP 1
#endif
enum Op { OP_MEMN = 0, OP_MEMKV, OP_COPYX, OP_RMS_MIX, OP_CONV_IN, OP_GLU, OP_DWCONV, OP_CONV_OUT, OP_GLA_IN, OP_GLA_DECAY, OP_GLA_REC, OP_GLA_NORM, OP_GLA_OUT,
          OP_RMS_XA, OP_XA_Q, OP_XA_ATT, OP_XA_O, OP_RMS_FFN, OP_ROUTE, OP_BUILD, OP_MOE_GATE, OP_MOE_UP, OP_MOE_ACT, OP_MOE_DOWN, OP_MOE_COMBINE, OP_FINAL };

__device__ __forceinline__ void run_op(const Ctx& c, int op, int l, float* sm) {
    unsigned char* ws = c.ws;
    float* HN = (float*)(ws + WS_HN); float* BIG = (float*)(ws + WS_BIG);
    float* MEMN = (float*)(ws + WS_MEMN); float* KV = (float*)(ws + WS_KV) + (size_t)l * 1024 * 2048;
    int* eid = (int*)(ws + WS_EID); float* gate = (float*)(ws + WS_GATE); int* pos = (int*)(ws + WS_POS);
    int* slot_tok = (int*)(ws + WS_SLOTTOK); int* slot_a = (int*)(ws + WS_SLOTA); int* tile_e = (int*)(ws + WS_TILEE); int* cnt = (int*)(ws + WS_CNT);
    float* X = c.out;
    switch (op) {
    case OP_MEMN: n_rms(c.in[1], c.in[5], MEMN, NB * NMEM); break;
    case OP_MEMKV: n_gemm(sm, MEMN, D, nullptr, c.in[21] + (size_t)l * D * 2048, 2048, 0, nullptr, NB * NMEM, 2048, D, EpiStore{KV, 2048, nullptr}); break;
    case OP_COPYX: n_copy4(c.in[0], X, (size_t)T * D / 4); break;
    case OP_RMS_MIX: n_rms(X, c.in[2] + l * D, HN, T); break;
    case OP_CONV_IN: n_gemm(sm, HN, D, nullptr, c.in[7], 2048, 0, nullptr, T, 2048, D, EpiStore{BIG, 2048, c.in[8]}); break;
    case OP_GLU: n_glu(BIG, HN); break;
    case OP_DWCONV: n_dwconv(HN, c.in[9], c.in[10], c.in[11], c.in[12], BIG); break;
    case OP_CONV_OUT: n_gemm(sm, BIG, D, nullptr, c.in[13], D, 0, nullptr, T, D, D, EpiResid{X, D, c.in[14]}); break;
    case OP_GLA_IN: n_gemm(sm, HN, D, nullptr, c.in[15], GLA_COLS, 0, nullptr, T, GLA_COLS, D, EpiStore{BIG, GLA_COLS, nullptr}); break;
    case OP_GLA_DECAY: n_gla_decay(BIG, c.in[16], c.in[17], HN); break;
    case OP_GLA_REC: n_gla_rec(BIG, HN); break;
    case OP_GLA_NORM: n_gla_norm(BIG, c.in[18], HN); break;
    case OP_GLA_OUT: n_gemm(sm, HN, D, nullptr, c.in[19], D, 0, nullptr, T, D, D, EpiResid{X, D, nullptr}); break;
    case OP_RMS_XA: n_rms(X, c.in[3] + l * D, HN, T); break;
    case OP_XA_Q: n_gemm(sm, HN, D, nullptr, c.in[20] + (size_t)l * D * D, D, 0, nullptr, T, D, D, EpiStore{BIG, D, nullptr}); break;
    case OP_XA_ATT: n_attn(BIG, KV, BIG + (size_t)T * D); break;
    case OP_XA_O: n_gemm(sm, BIG + (size_t)T * D, D, nullptr, c.in[22] + (size_t)l * D * D, D, 0, nullptr, T, D, D, EpiResid{X, D, nullptr}); break;
    case OP_RMS_FFN: n_rms(X, c.in[4] + l * D, HN, T); n_moe_init(cnt, slot_tok, slot_a, tile_e); break;
    case OP_ROUTE: n_route(HN, c.in[23] + (size_t)l * D * NG, c.in[24] + l * NG, c.in[25] + (size_t)l * D * NE, c.in[26] + l * NE, eid, gate, pos, cnt); break;
    case OP_BUILD: n_moe_build(eid, pos, cnt, slot_tok, slot_a, tile_e); break;
    case OP_MOE_GATE: n_gemm(sm, HN, D, slot_tok, c.in[27] + (size_t)l * NE * D * DE, DE, (size_t)D * DE, tile_e, NSLOT, DE, D, EpiStore{BIG, DE, nullptr}); break;
    case OP_MOE_UP: n_gemm(sm, HN, D, slot_tok, c.in[28] + (size_t)l * NE * D * DE, DE, (size_t)D * DE, tile_e, NSLOT, DE, D, EpiStore{BIG + (size_t)NSLOT * DE, DE, nullptr}); break;
    case OP_MOE_ACT: n_moe_act(BIG, BIG + (size_t)NSLOT * DE); break;
    case OP_MOE_DOWN: n_gemm(sm, BIG, DE, nullptr, c.in[29] + (size_t)l * NE * DE * D, D, (size_t)DE * D, tile_e, NSLOT, D, DE, EpiMoeDown{BIG + (size_t)NSLOT * DE, slot_a, gate}); break;
    case OP_MOE_COMBINE: n_moe_combine(X, BIG + (size_t)NSLOT * DE); break;
    case OP_FINAL: n_rms(X, c.in[6], X, T); break;
    }
}

template <int OP> __global__ void __launch_bounds__(512) k_stage(Ctx c, int l) {
    __shared__ float sm[16 * 132 + 16 * 260];
    run_op(c, OP, l, sm);
}
typedef void (*StageFn)(Ctx, int);
template <int... I> struct Seq {};
template <int N, int... I> struct MkSeq : MkSeq<N - 1, N - 1, I...> {};
template <int... I> struct MkSeq<0, I...> { typedef Seq<I...> type; };
template <int... I> static void fill_tab(StageFn* t, Seq<I...>) { StageFn f[] = {k_stage<I>...}; for (unsigned i = 0; i < sizeof...(I); ++i) t[i] = f[i]; }
template <int... I> static void fill_tab_opt(StageFn* t, Seq<I...>) { StageFn f[] = {k_opt<I>...}; for (unsigned i = 0; i < sizeof...(I); ++i) t[i] = f[i]; }

#define XB_TMO      128
#define XB_XCNT(j)  (256  + 64 * (j))
#define XB_XSUB(j)  (1280 + 64 * (j))
#define XB_XGEN(j)  (2304 + 64 * (j))
#define XB_TOP      3328
#define XB_TOPGEN   3392
#define XCD_BAR_WORDS 3456
#define XB_SPIN_CAP (1u << 18)
__device__ __forceinline__ unsigned xb_ld(unsigned* p)              { return __hip_atomic_load(p, __ATOMIC_RELAXED, __HIP_MEMORY_SCOPE_AGENT); }
__device__ __forceinline__ unsigned xb_add(unsigned* p, unsigned v) { return __hip_atomic_fetch_add(p, v, __ATOMIC_RELAXED, __HIP_MEMORY_SCOPE_AGENT); }
__device__ __forceinline__ unsigned xb_xcc_id() { return (unsigned)__builtin_amdgcn_s_getreg((3 << 11) | 20) & 0xFu; }
#define XB_SPIN(cond, bar) do { unsigned _sp = 0; while (cond) { __builtin_amdgcn_s_sleep(1); \
    if ((++_sp & 255u) == 0u) { if (xb_ld(&(bar)[XB_TMO])) break; if (_sp > XB_SPIN_CAP) { atomicAdd(&(bar)[XB_TMO], 1u); break; } } } } while (0)
struct XcdBarrier { unsigned* bar; unsigned x; volatile LAS unsigned* st; };
__device__ __forceinline__ XcdBarrier xcd_barrier_post(unsigned* bar, volatile LAS unsigned* st) {
    XcdBarrier b; b.bar = bar; b.x = xb_xcc_id(); b.st = st;
    if (threadIdx.x == 0) (void)xb_add(&bar[XB_XCNT(b.x)], 1u);
    return b;
}
__device__ __forceinline__ void xcd_barrier_complete(unsigned* bar, unsigned x, unsigned& nloc, unsigned& nx) {
    const unsigned G = gridDim.x * gridDim.y * gridDim.z;
    unsigned sum, cnt, mine, sp = 0u;
    for (;;) {
        sum = 0u; cnt = 0u; mine = 0u;
#pragma unroll
        for (unsigned j = 0; j < 16; ++j) { const unsigned c = xb_ld(&bar[XB_XCNT(j)]); sum += c; cnt += (c > 0u) ? 1u : 0u; mine = (j == x) ? c : mine; }
        if (sum == G) break;
        __builtin_amdgcn_s_sleep(1);
        if ((++sp & 255u) == 0u) { if (xb_ld(&bar[XB_TMO])) break; if (sp > XB_SPIN_CAP) { atomicAdd(&bar[XB_TMO], 1u); break; } }
    }
    nloc = mine > 0u ? mine : 1u; nx = cnt > 0u ? cnt : 1u;
}
__device__ __forceinline__ void xcd_barrier(const XcdBarrier& b) {
    asm volatile("s_waitcnt vmcnt(0)" ::: "memory");
    __syncthreads();
    if (threadIdx.x == 0) {
        unsigned* bar = b.bar;
        __builtin_amdgcn_s_waitcnt(0);
        unsigned nloc = b.st[0], nx = b.st[1];
        if (nloc == 0u) { xcd_barrier_complete(bar, b.x, nloc, nx); b.st[0] = nloc; b.st[1] = nx; }
        __builtin_amdgcn_fence(__ATOMIC_RELEASE, "agent");
        asm volatile("s_waitcnt vmcnt(0)" ::: "memory");
        const unsigned old = xb_add(&bar[XB_XSUB(b.x)], 1u);
        const unsigned gen = old / nloc;
        if (old + 1u == (gen + 1u) * nloc) {
            const unsigned og = xb_add(&bar[XB_TOP], 1u);
            const unsigned tg = og / nx;
            if (og + 1u == (tg + 1u) * nx) xb_add(&bar[XB_TOPGEN], 1u);
            else XB_SPIN(xb_ld(&bar[XB_TOPGEN]) == tg, bar);
            __builtin_amdgcn_fence(__ATOMIC_ACQUIRE, "agent");
            xb_add(&bar[XB_XGEN(b.x)], 1u);
            asm volatile("s_waitcnt vmcnt(0)" ::: "memory");
        } else {
            XB_SPIN(xb_ld(&bar[XB_XGEN(b.x)]) == gen, bar);
            __builtin_amdgcn_fence(__ATOMIC_ACQUIRE, "agent");
            asm volatile("s_waitcnt vmcnt(0)" ::: "memory");
        }
    }
    __syncthreads();
}
template <int CODE> __device__ __forceinline__ void coop_step(const Ctx& c, LAS unsigned char* lds, cg::grid_group& grid, XcdBarrier& xb, bool sync_after, bool first) {
    run_phase(c, CODE >> 5, CODE & 31, lds);
    if (sync_after) {
        if (first || ALLCG) {
            unsigned* bar = (unsigned*)(c.ws + OW_BAR);
            if (first && blockIdx.x == 0) for (int i = threadIdx.x; i < XCD_BAR_WORDS; i += 512) bar[i] = 0u;
            asm volatile("s_waitcnt vmcnt(0) lgkmcnt(0)" ::: "memory");
            grid.sync();
            if (threadIdx.x < 64) { __builtin_amdgcn_fence(__ATOMIC_ACQUIRE, "agent"); asm volatile("s_waitcnt vmcnt(0)" ::: "memory"); }
            __syncthreads();
            if (first) xb = xcd_barrier_post(bar, xb.st);
        } else xcd_barrier(xb);
    }
}
template <int... CODES> __global__ void __launch_bounds__(512, 2) k_coop(Ctx c) {
    extern __shared__ __attribute__((aligned(16))) unsigned char dynlds[];
    cg::grid_group grid = cg::this_grid();
    LAS unsigned char* lds = (LAS unsigned char*)dynlds;
    volatile LAS unsigned* st = (volatile LAS unsigned*)(lds + LDS_BYTES - 16);
    if (threadIdx.x < 4) st[threadIdx.x] = 0u;
    __syncthreads();
    XcdBarrier xb; xb.bar = nullptr; xb.x = 0; xb.st = st;
    int idx = 0; constexpr int N = sizeof...(CODES);
    ((coop_step<CODES>(c, lds, grid, xb, idx + 1 < N, idx == 0), ++idx), ...);
}
#define CODE(ph, l) ((ph) * 32 + (l))
typedef void (*CoopFn)(Ctx);
struct Step { int kind, op, l; };
static const Step g_prog[] = { {1, 0, 0} };
constexpr int NSTEP = sizeof(g_prog) / sizeof(g_prog[0]);

extern "C" void kernel_launch(void* const* d_in, const int* in_sizes, int n_in, void* d_out, int out_size, void* d_ws, size_t ws_size, hipStream_t stream) {
    if (n_in != 30 || out_size != T * D || ws_size < OW_END || ws_size < WS_END) { fprintf(stderr, "kernel_launch: bad args n_in %d out %d ws %zu\n", n_in, out_size, ws_size); return; }
    Ctx c; memset(&c, 0, sizeof(c));
    for (int i = 0; i < 30; ++i) c.in[i] = (const float*)d_in[i];
    c.out = (float*)d_out; c.ws = (unsigned char*)d_ws;
    static StageFn tab[OP_FINAL + 1], tabo[PH_N];
    static bool init = false;
    if (!init) { fill_tab(tab, MkSeq<OP_FINAL + 1>::type()); fill_tab_opt(tabo, MkSeq<PH_N>::type());
        for (int i = 0; i < PH_N; ++i) hipFuncSetAttribute((const void*)tabo[i], hipFuncAttributeMaxDynamicSharedMemorySize, LDS_BYTES);
        init = true; }
#if COOP
    static int coop_grid = 0;
    static CoopFn coop_fns[2] = { k_coop<CODE(PH_PREP0, 0), CODE(PH_CONV_IN, 0), CODE(PH_CONV_MID, 0), CODE(PH_CONV_OUT, 0), CODE(PH_XA_PREP, 0), CODE(PH_XA_Q, 0), CODE(PH_XA_KV, 0), CODE(PH_XA_S, 0), CODE(PH_XA_PV, 0), CODE(PH_XA_O, 0),
                                         CODE(PH_ROUTE_PREP, 0), CODE(PH_ROUTE, 0), CODE(PH_BUILD, 0), CODE(PH_MOE1, 0), CODE(PH_MOE2, 0), CODE(PH_GLA_PREP, 0), CODE(PH_COMBINE, 0),
                                         CODE(PH_GLA_DECAY, 0), CODE(PH_GLA_IN, 0), CODE(PH_GLA_ATT, 0), CODE(PH_GLA_UT, 0), CODE(PH_GLA_SCAN, 0), CODE(PH_GLA_O, 0), CODE(PH_GLA_FIN, 0), CODE(PH_GLA_OUT, 0),
                                         CODE(PH_XA_PREP, 1), CODE(PH_XA_Q, 1), CODE(PH_XA_KV, 1), CODE(PH_XA_S, 1), CODE(PH_XA_PV, 1), CODE(PH_XA_O, 1),
                                         CODE(PH_ROUTE_PREP, 1), CODE(PH_ROUTE, 1), CODE(PH_BUILD, 1), CODE(PH_MOE1, 1), CODE(PH_MOE2, 1), CODE(PH_COMBINE_FIN, 1)>, nullptr };
    if (!coop_grid) { int dev = 0, cus = 0, per_cu = 0; hipGetDevice(&dev); hipDeviceGetAttribute(&cus, hipDeviceAttributeMultiprocessorCount, dev);
        for (int k = 0; k < 1; ++k) hipFuncSetAttribute((const void*)coop_fns[k], hipFuncAttributeMaxDynamicSharedMemorySize, LDS_BYTES);
        hipOccupancyMaxActiveBlocksPerMultiprocessor(&per_cu, coop_fns[0], 512, LDS_BYTES);
        coop_grid = cus * (per_cu < 1 ? 1 : per_cu); if (coop_grid > 256) coop_grid = 256;
        fprintf(stderr, "kernel_launch: cus %d per_cu %d grid %d\n", cus, per_cu, coop_grid); }
    int ncoop = 0;
#endif
    for (int i = 0; i < NSTEP; ++i) {
        if (g_prog[i].kind == 0) { hipLaunchKernelGGL(tab[g_prog[i].op], dim3(1024), dim3(512), 0, stream, c, g_prog[i].l); continue; }
#if COOP
        while (i < NSTEP && g_prog[i].kind == 1) ++i;
        --i;
        void* args[] = {&c};
        hipError_t e = hipLaunchCooperativeKernel((void*)coop_fns[ncoop++], dim3(coop_grid), dim3(512), args, LDS_BYTES, stream);
        if (e != hipSuccess) fprintf(stderr, "cooperative launch failed: %s\n", hipGetErrorString(e));
#else
        hipLaunchKernelGGL(tabo[g_prog[i].op], dim3(256), dim3(512), LDS_BYTES, stream, c, g_prog[i].l);
#endif
    }
}
```

```cpp
#include <hip/hip_runtime.h>
#include <hip/hip_cooperative_groups.h>
#include <cstdio>
#include <cstring>
namespace cg = cooperative_groups;

#ifndef MEGA
#define MEGA 0
#endif

constexpr int D = 1024, NB = 4, S = 8192, T = NB * S, NMEM = 256, DEPTH = 2;
constexpr int CONVK = 31;
constexpr int GH = 4, GDK = 512, GDV = 1024, GDKH = 128, GDVH = 256, GRANK = 16, GLA_COLS = 3088;
constexpr int XH = 4, XHD = 256;
constexpr int NG = 4, EPG = 8, NE = 32, DE = 512;
constexpr int NA = T * 2;
constexpr int NSLOT = NA + NE * 128;
constexpr float EPS = 1e-6f;

constexpr size_t MiB = 1u << 20;
constexpr size_t WS_HN = 0;
constexpr size_t WS_BIG = 128 * MiB;
constexpr size_t WS_SMALL = 528 * MiB;
constexpr size_t WS_MEMN = WS_SMALL;
constexpr size_t WS_KV = WS_MEMN + 4 * MiB;
constexpr size_t WS_EID = WS_KV + 16 * MiB;
constexpr size_t WS_GATE = WS_EID + NA * 4;
constexpr size_t WS_POS = WS_GATE + NA * 4;
constexpr size_t WS_SLOTTOK = WS_POS + NA * 4;
constexpr size_t WS_SLOTA = WS_SLOTTOK + NSLOT * 4;
constexpr size_t WS_TILEE = WS_SLOTA + NSLOT * 4;
constexpr size_t WS_CNT = WS_TILEE + 4096;
constexpr size_t WS_END = WS_CNT + 4096;

struct Ctx {
    const float* in[30];
    float* out;
    unsigned char* ws;
};

__device__ __forceinline__ float wave_sum(float v) {
#pragma unroll
    for (int o = 1; o < 64; o <<= 1) v += __shfl_xor(v, o);
    return v;
}
__device__ __forceinline__ float wave_max(float v) {
#pragma unroll
    for (int o = 1; o < 64; o <<= 1) v = fmaxf(v, __shfl_xor(v, o));
    return v;
}
__device__ __forceinline__ float sigmoidf_(float x) { return 1.0f / (1.0f + expf(-x)); }
__device__ __forceinline__ float siluf_(float x) { return x / (1.0f + expf(-x)); }

__device__ void n_rms(const float* x, const float* g, float* out, int rows) {
    const int lane = threadIdx.x & 63;
    const int gw = (blockIdx.x * blockDim.x + threadIdx.x) >> 6, ngw = (gridDim.x * blockDim.x) >> 6;
    for (int r = gw; r < rows; r += ngw) {
        const float4* xr = (const float4*)(x + (size_t)r * D);
        float4 v[4]; float s = 0.f;
#pragma unroll
        for (int j = 0; j < 4; ++j) { v[j] = xr[lane + 64 * j]; s += v[j].x * v[j].x + v[j].y * v[j].y + v[j].z * v[j].z + v[j].w * v[j].w; }
        s = wave_sum(s);
        const float rs = rsqrtf(s * (1.0f / D) + EPS);
        float4* o = (float4*)(out + (size_t)r * D);
#pragma unroll
        for (int j = 0; j < 4; ++j) { const float4 gg = ((const float4*)g)[lane + 64 * j];
            o[lane + 64 * j] = make_float4(v[j].x * rs * gg.x, v[j].y * rs * gg.y, v[j].z * rs * gg.z, v[j].w * rs * gg.w); }
    }
}
__device__ void n_copy4(const float* src, float* dst, size_t n4) {
    const size_t g = (size_t)blockIdx.x * blockDim.x + threadIdx.x, gs = (size_t)gridDim.x * blockDim.x;
    for (size_t i = g; i < n4; i += gs) ((float4*)dst)[i] = ((const float4*)src)[i];
}

struct EpiStore { float* C; int ldc; const float* bias;
    __device__ __forceinline__ void operator()(int m, int n, float acc) const { C[(size_t)m * ldc + n] = acc + (bias ? bias[n] : 0.f); } };
struct EpiResid { float* X; int ldc; const float* bias;
    __device__ __forceinline__ void operator()(int m, int n, float acc) const { X[(size_t)m * ldc + n] += acc + (bias ? bias[n] : 0.f); } };
struct EpiMoeDown { float* Y; const int* slot_a; const float* gate;
    __device__ __forceinline__ void operator()(int m, int n, float acc) const { const int a = slot_a[m]; if (a >= 0) Y[(size_t)a * D + n] = acc * gate[a]; } };

template <class Epi>
__device__ void n_gemm(float* sm, const float* A, int lda, const int* arow, const float* W, int ldw, size_t wstride, const int* tile_e,
                       int M, int N, int K, Epi epi) {
    float* As = sm;
    float* Bs = sm + 16 * 132;
    const int tid = threadIdx.x, ty = tid >> 5, tx = tid & 31;
    const int ntm = M / 128, ntn = (N + 255) / 256;
    for (int tile = blockIdx.x; tile < ntm * ntn; tile += gridDim.x) {
        const int mt = tile / ntn, nt = tile % ntn;
        const float* Wb = W;
        if (tile_e) { const int e = tile_e[mt]; if (e < 0) continue; Wb = W + (size_t)e * wstride; }
        const int m0 = mt * 128, n0 = nt * 256;
        float acc[8][8];
#pragma unroll
        for (int i = 0; i < 8; ++i)
#pragma unroll
            for (int j = 0; j < 8; ++j) acc[i][j] = 0.f;
        const int ar = tid >> 2, akq = (tid & 3) * 4;
        const int srow = arow ? arow[m0 + ar] : (m0 + ar);
        const float* ap = srow >= 0 ? A + (size_t)srow * lda : nullptr;
        const int bk = tid >> 6, bn = (tid & 63) * 4;
        for (int k0 = 0; k0 < K; k0 += 16) {
            float4 av = ap ? *(const float4*)(ap + k0 + akq) : make_float4(0.f, 0.f, 0.f, 0.f);
            As[(akq + 0) * 132 + ar] = av.x; As[(akq + 1) * 132 + ar] = av.y; As[(akq + 2) * 132 + ar] = av.z; As[(akq + 3) * 132 + ar] = av.w;
#pragma unroll
            for (int i = 0; i < 2; ++i) {
                const int kk = bk + 8 * i; const int n = n0 + bn;
                float4 bv = (n < N) ? *(const float4*)(Wb + (size_t)(k0 + kk) * ldw + n) : make_float4(0.f, 0.f, 0.f, 0.f);
                *(float4*)(Bs + kk * 260 + bn) = bv;
            }
            __syncthreads();
#pragma unroll
            for (int kk = 0; kk < 16; ++kk) {
                float a[8], b[8];
                *(float4*)(a) = *(const float4*)(As + kk * 132 + ty * 8); *(float4*)(a + 4) = *(const float4*)(As + kk * 132 + ty * 8 + 4);
                *(float4*)(b) = *(const float4*)(Bs + kk * 260 + tx * 8); *(float4*)(b + 4) = *(const float4*)(Bs + kk * 260 + tx * 8 + 4);
#pragma unroll
                for (int i = 0; i < 8; ++i)
#pragma unroll
                    for (int j = 0; j < 8; ++j) acc[i][j] = fmaf(a[i], b[j], acc[i][j]);
            }
            __syncthreads();
        }
#pragma unroll
        for (int i = 0; i < 8; ++i)
#pragma unroll
            for (int j = 0; j < 8; ++j) { const int m = m0 + ty * 8 + i, n = n0 + tx * 8 + j; if (n < N) epi(m, n, acc[i][j]); }
    }
}

__device__ void n_glu(const float* u, float* g) {
    const size_t gi = (size_t)blockIdx.x * blockDim.x + threadIdx.x, gs = (size_t)gridDim.x * blockDim.x;
    for (size_t i = gi; i < (size_t)T * D; i += gs) { const size_t t = i >> 10, c = i & 1023; g[i] = u[t * 2048 + c] * sigmoidf_(u[t * 2048 + 1024 + c]); }
}
__device__ void n_dwconv(const float* g, const float* wdw, const float* bdw, const float* lng, const float* lnb, float* out) {
    const int lane = threadIdx.x & 63;
    const int gw = (blockIdx.x * blockDim.x + threadIdx.x) >> 6, ngw = (gridDim.x * blockDim.x) >> 6;
    for (int t = gw; t < T; t += ngw) {
        const int s = t % S;
        float4 acc[4];
#pragma unroll
        for (int j = 0; j < 4; ++j) acc[j] = ((const float4*)bdw)[lane + 64 * j];
        for (int tap = 0; tap < CONVK; ++tap) {
            const int ss = s - (CONVK - 1) + tap; if (ss < 0) continue;
            const float4* gr = (const float4*)(g + (size_t)(t - (CONVK - 1) + tap) * D);
            const float4* wr = (const float4*)(wdw + (size_t)tap * D);
#pragma unroll
            for (int j = 0; j < 4; ++j) { const float4 a = gr[lane + 64 * j], w = wr[lane + 64 * j];
                acc[j].x = fmaf(a.x, w.x, acc[j].x); acc[j].y = fmaf(a.y, w.y, acc[j].y); acc[j].z = fmaf(a.z, w.z, acc[j].z); acc[j].w = fmaf(a.w, w.w, acc[j].w); }
        }
        float sm_ = 0.f;
#pragma unroll
        for (int j = 0; j < 4; ++j) sm_ += acc[j].x + acc[j].y + acc[j].z + acc[j].w;
        const float mu = wave_sum(sm_) * (1.0f / D);
        float q = 0.f;
#pragma unroll
        for (int j = 0; j < 4; ++j) { acc[j].x -= mu; acc[j].y -= mu; acc[j].z -= mu; acc[j].w -= mu; q += acc[j].x * acc[j].x + acc[j].y * acc[j].y + acc[j].z * acc[j].z + acc[j].w * acc[j].w; }
        const float rstd = rsqrtf(wave_sum(q) * (1.0f / D) + EPS);
        float4* o = (float4*)(out + (size_t)t * D);
#pragma unroll
        for (int j = 0; j < 4; ++j) { const float4 gg = ((const float4*)lng)[lane + 64 * j], bb = ((const float4*)lnb)[lane + 64 * j];
            o[lane + 64 * j] = make_float4(siluf_(acc[j].x * rstd * gg.x + bb.x), siluf_(acc[j].y * rstd * gg.y + bb.y), siluf_(acc[j].z * rstd * gg.z + bb.z), siluf_(acc[j].w * rstd * gg.w + bb.w)); }
    }
}
__device__ void n_attn(const float* q, const float* kv, float* o) {
    const int lane = threadIdx.x & 63;
    const int gw = (blockIdx.x * blockDim.x + threadIdx.x) >> 6, ngw = (gridDim.x * blockDim.x) >> 6;
    for (int it = gw; it < T * XH; it += ngw) {
        const int t = it >> 2, h = it & 3, b = t / S;
        const float4 qv = ((const float4*)(q + (size_t)t * D + h * XHD))[lane];
        const float* kb = kv + (size_t)b * NMEM * 2048 + h * XHD;
        float sc[4];
#pragma unroll
        for (int m4 = 0; m4 < 4; ++m4) {
            float mine = 0.f;
            for (int ml = 0; ml < 64; ++ml) {
                const float4 kk = ((const float4*)(kb + (size_t)(m4 * 64 + ml) * 2048))[lane];
                float p = qv.x * kk.x + qv.y * kk.y + qv.z * kk.z + qv.w * kk.w;
                p = wave_sum(p);
                if (ml == lane) mine = p;
            }
            sc[m4] = mine * 0.0625f;
        }
        float mx = fmaxf(fmaxf(sc[0], sc[1]), fmaxf(sc[2], sc[3])); mx = wave_max(mx);
        float se = 0.f;
#pragma unroll
        for (int m4 = 0; m4 < 4; ++m4) { sc[m4] = expf(sc[m4] - mx); se += sc[m4]; }
        se = wave_sum(se); const float inv = 1.0f / se;
        float4 acc = make_float4(0.f, 0.f, 0.f, 0.f);
        const float* vb = kb + 1024;
#pragma unroll
        for (int m4 = 0; m4 < 4; ++m4)
            for (int ml = 0; ml < 64; ++ml) {
                const float p = __shfl(sc[m4], ml) * inv;
                const float4 vv = ((const float4*)(vb + (size_t)(m4 * 64 + ml) * 2048))[lane];
                acc.x = fmaf(p, vv.x, acc.x); acc.y = fmaf(p, vv.y, acc.y); acc.z = fmaf(p, vv.z, acc.z); acc.w = fmaf(p, vv.w, acc.w);
            }
        ((float4*)(o + (size_t)t * D + h * XHD))[lane] = acc;
    }
}
__device__ void n_moe_init(int* cnt, int* slot_tok, int* slot_a, int* tile_e) {
    const int gi = blockIdx.x * blockDim.x + threadIdx.x, gs = gridDim.x * blockDim.x;
    for (int i = gi; i < NSLOT; i += gs) { slot_tok[i] = -1; slot_a[i] = -1; }
    for (int i = gi; i < NSLOT / 128; i += gs) tile_e[i] = -1;
    if (gi < 32) cnt[gi] = 0;
}
__device__ void n_route(const float* h, const float* wg, const float* bg, const float* we, const float* be, int* eid, float* gate, int* pos, int* cnt) {
    const int lane = threadIdx.x & 63;
    const int gw = (blockIdx.x * blockDim.x + threadIdx.x) >> 6, ngw = (gridDim.x * blockDim.x) >> 6;
    for (int t = gw; t < T; t += ngw) {
        float hv[16];
#pragma unroll
        for (int j = 0; j < 16; ++j) hv[j] = h[(size_t)t * D + j * 64 + lane];
        float gl[4];
#pragma unroll
        for (int o = 0; o < 4; ++o) { float p = 0.f;
#pragma unroll
            for (int j = 0; j < 16; ++j) p = fmaf(hv[j], wg[(size_t)(j * 64 + lane) * NG + o], p);
            gl[o] = wave_sum(p) + bg[o]; }
        int gs = 0; float gm = gl[0];
#pragma unroll
        for (int o = 1; o < 4; ++o) if (gl[o] > gm) { gm = gl[o]; gs = o; }
        float se = 0.f;
#pragma unroll
        for (int o = 0; o < 4; ++o) se += expf(gl[o] - gm);
        const float pg = 1.0f / se;
        float el[8];
#pragma unroll
        for (int o = 0; o < 8; ++o) { float p = 0.f;
#pragma unroll
            for (int j = 0; j < 16; ++j) p = fmaf(hv[j], we[(size_t)(j * 64 + lane) * NE + gs * 8 + o], p);
            el[o] = wave_sum(p) + be[gs * 8 + o]; }
        float em = el[0];
#pragma unroll
        for (int o = 1; o < 8; ++o) em = fmaxf(em, el[o]);
        float pe[8], ps = 0.f;
#pragma unroll
        for (int o = 0; o < 8; ++o) { pe[o] = expf(el[o] - em); ps += pe[o]; }
#pragma unroll
        for (int o = 0; o < 8; ++o) pe[o] = pe[o] / ps;
        int i1 = 0; float p1 = pe[0];
#pragma unroll
        for (int o = 1; o < 8; ++o) if (pe[o] > p1) { p1 = pe[o]; i1 = o; }
        int i2 = -1; float p2 = -1.f;
#pragma unroll
        for (int o = 0; o < 8; ++o) if (o != i1 && pe[o] > p2) { p2 = pe[o]; i2 = o; }
        if (lane == 0) {
            const float den = p1 + p2;
            const int e1 = gs * 8 + i1, e2 = gs * 8 + i2;
            eid[2 * t] = e1; eid[2 * t + 1] = e2;
            gate[2 * t] = pg * p1 / den; gate[2 * t + 1] = pg * p2 / den;
            pos[2 * t] = atomicAdd(&cnt[e1], 1); pos[2 * t + 1] = atomicAdd(&cnt[e2], 1);
        }
    }
}
__device__ void n_moe_build(const int* eid, const int* pos, const int* cnt, int* slot_tok, int* slot_a, int* tile_e) {
    __shared__ int poff[33];
    if (threadIdx.x == 0) { int o = 0; for (int e = 0; e < 32; ++e) { poff[e] = o; o += (cnt[e] + 127) / 128 * 128; } poff[32] = o; }
    __syncthreads();
    const int gi = blockIdx.x * blockDim.x + threadIdx.x, gs = gridDim.x * blockDim.x;
    for (int a = gi; a < NA; a += gs) { const int e = eid[a]; const int sl = poff[e] + pos[a]; slot_tok[sl] = a >> 1; slot_a[sl] = a; }
    for (int mt = gi; mt < NSLOT / 128; mt += gs) { const int r = mt * 128; int e = -1; for (int k = 0; k < 32; ++k) if (r >= poff[k] && r < poff[k + 1]) e = k; tile_e[mt] = e; }
    __syncthreads();
}
__device__ void n_moe_act(float* g, const float* u) {
    const size_t gi = (size_t)blockIdx.x * blockDim.x + threadIdx.x, gs = (size_t)gridDim.x * blockDim.x;
    for (size_t i = gi; i < (size_t)NSLOT * DE / 4; i += gs) { float4 a = ((float4*)g)[i]; const float4 b = ((const float4*)u)[i];
        a.x = siluf_(a.x) * b.x; a.y = siluf_(a.y) * b.y; a.z = siluf_(a.z) * b.z; a.w = siluf_(a.w) * b.w; ((float4*)g)[i] = a; }
}
__device__ void n_moe_combine(float* x, const float* y) {
    const size_t gi = (size_t)blockIdx.x * blockDim.x + threadIdx.x, gs = (size_t)gridDim.x * blockDim.x;
    for (size_t i = gi; i < (size_t)T * D / 4; i += gs) { const size_t t = i >> 8, c = i & 255; float4 a = ((float4*)x)[i];
        const float4 y0 = ((const float4*)y)[(2 * t) * 256 + c], y1 = ((const float4*)y)[(2 * t + 1) * 256 + c];
        a.x += y0.x + y1.x; a.y += y0.y + y1.y; a.z += y0.z + y1.z; a.w += y0.w + y1.w; ((float4*)x)[i] = a; }
}
__device__ void n_gla_decay(const float* proj, const float* wa2, const float* ba, float* dec) {
    const size_t gi = (size_t)blockIdx.x * blockDim.x + threadIdx.x, gs = (size_t)gridDim.x * blockDim.x;
    for (size_t i = gi; i < (size_t)T * GDK; i += gs) { const size_t t = i >> 9; const int j = (int)(i & 511);
        float a = ba[j];
#pragma unroll
        for (int r = 0; r < GRANK; ++r) a = fmaf(proj[t * GLA_COLS + 2048 + r], wa2[r * GDK + j], a);
        const float ls = fminf(a, 0.f) - log1pf(expf(-fabsf(a)));
        dec[i] = expf(ls * (1.0f / 16.0f)); }
}
__device__ void n_gla_rec(float* proj, const float* dec) {
    const int gi = blockIdx.x * blockDim.x + threadIdx.x, gs = gridDim.x * blockDim.x;
    for (int it = gi; it < NB * GH * GDVH; it += gs) {
        const int col = it & 255, h = (it >> 8) & 3, b = it >> 10;
        float st[GDKH];
#pragma unroll
        for (int k = 0; k < GDKH; ++k) st[k] = 0.f;
        const float qs = 0.08838834764831845f;
        for (int s = 0; s < S; ++s) {
            const size_t t = (size_t)b * S + s;
            float* pr = proj + t * GLA_COLS;
            const float v = pr[1024 + h * GDVH + col];
            const float* qq = pr + h * GDKH; const float* kk = pr + 512 + h * GDKH; const float* dd = dec + t * GDK + h * GDKH;
            float o = 0.f;
#pragma unroll
            for (int k = 0; k < GDKH; ++k) { st[k] = fmaf(st[k], dd[k], kk[k] * v); o = fmaf(qq[k], st[k], o); }
            pr[1024 + h * GDVH + col] = o * qs;
        }
    }
}
__device__ void n_gla_norm(const float* proj, const float* ng, float* go) {
    const int lane = threadIdx.x & 63;
    const int gw = (blockIdx.x * blockDim.x + threadIdx.x) >> 6, ngw = (gridDim.x * blockDim.x) >> 6;
    for (int it = gw; it < T * GH; it += ngw) {
        const int t = it >> 2, h = it & 3;
        const float4 ov = ((const float4*)(proj + (size_t)t * GLA_COLS + 1024 + h * GDVH))[lane];
        const float4 rv = ((const float4*)(proj + (size_t)t * GLA_COLS + 2064 + h * GDVH))[lane];
        const float4 gg = ((const float4*)ng)[lane];
        float s = ov.x * ov.x + ov.y * ov.y + ov.z * ov.z + ov.w * ov.w; s = wave_sum(s);
        const float rs = rsqrtf(s * (1.0f / GDVH) + EPS);
        ((float4*)(go + (size_t)t * D + h * GDVH))[lane] = make_float4(ov.x * rs * gg.x * siluf_(rv.x), ov.y * rs * gg.y * siluf_(rv.y), ov.z * rs * gg.z * siluf_(rv.z), ov.w * rs * gg.w * siluf_(rv.w));
    }
}

#define LAS __attribute__((address_space(3)))
typedef unsigned short bf16_t;
typedef short bf16x8 __attribute__((ext_vector_type(8)));
typedef float f32x4 __attribute__((ext_vector_type(4)));
typedef float f32x2 __attribute__((ext_vector_type(2)));
typedef unsigned u32x4 __attribute__((ext_vector_type(4)));
typedef unsigned u32x2 __attribute__((ext_vector_type(2)));

constexpr int LDS_BYTES = 160 * 1024;
constexpr int NSLOT2 = NA + NE * 256;
constexpr int MAXRT = NSLOT2 / 256;
constexpr size_t OW_XB = 0;
constexpr size_t OW_SSP = 64 * MiB;
constexpr size_t OW_RS = 66 * MiB;
constexpr size_t OW_PSUM = 67 * MiB;
constexpr size_t OW_MOE = 69 * MiB;
constexpr size_t OW_ACTA = 72 * MiB, OW_ACTB = 136 * MiB, OW_ACTC = 200 * MiB;
constexpr size_t OW_H = 72 * MiB, OW_Y = 144 * MiB, OW_WMOE = 272 * MiB;
constexpr size_t OW_KVB = 368 * MiB;
constexpr size_t OW_MEMNB = 502 * MiB;
constexpr size_t OW_WCIN = 550 * MiB, OW_WCOUT = 554 * MiB, OW_WXQ = 556 * MiB, OW_WXKV = 560 * MiB, OW_WXO = 568 * MiB, OW_WR = 572 * MiB, OW_BAR = 573 * MiB, OW_DBG = 574 * MiB, OW_END = 575 * MiB;
constexpr size_t OW_ATT = 0, OW_QKR = 72 * MiB, OW_KVT = 200 * MiB, OW_BTM = 296 * MiB, OW_O = 296 * MiB, OW_BFM = 360 * MiB, OW_UT = 424 * MiB, OW_SP = 456 * MiB,
                 OW_ALR = 488 * MiB, OW_DL = 490 * MiB, OW_GO = 200 * MiB, OW_WGTM = 492 * MiB, OW_WGFM = 496 * MiB, OW_WGO = 499 * MiB, OW_WA = 501 * MiB;
constexpr size_t OM_GCNT = OW_MOE, OM_NT = OW_MOE + 256, OM_TILEE = OW_MOE + 512, OM_AE = OW_MOE + 4096, OM_APOS = OM_AE + NA * 4, OM_GATE = OM_APOS + NA * 4,
                 OM_STOK = OM_GATE + NA * 4, OM_SA = OM_STOK + NSLOT2 * 4, OM_SRS = OM_SA + NSLOT2 * 4, OM_SGATE = OM_SRS + NSLOT2 * 4, OM_END = OM_SGATE + NSLOT2 * 4;
static_assert(OM_END <= OW_ACTA, "MoE small arrays");

typedef __bf16 bf16x2_t __attribute__((ext_vector_type(2)));
__device__ __forceinline__ unsigned cvt_pk_bf16(float lo, float hi) { const f32x2 v = {lo, hi}; return __builtin_bit_cast(unsigned, __builtin_convertvector(v, bf16x2_t)); }
__device__ __forceinline__ int otid() { int t = threadIdx.x; asm volatile("" : "+v"(t)); return t; }
__device__ __forceinline__ u32x4 pack8(const f32x4& a, const f32x4& b) { u32x4 w; w.x = cvt_pk_bf16(a[0], a[1]); w.y = cvt_pk_bf16(a[2], a[3]); w.z = cvt_pk_bf16(b[0], b[1]); w.w = cvt_pk_bf16(b[2], b[3]); return w; }
__device__ __forceinline__ float bf_lo(unsigned w) { return __uint_as_float(w << 16); }
__device__ __forceinline__ float bf_hi(unsigned w) { return __uint_as_float(w & 0xffff0000u); }
__device__ __forceinline__ float fast_sigmoid(float x) { return __builtin_amdgcn_rcpf(1.0f + __builtin_amdgcn_exp2f(-1.4426950408889634f * x)); }

#ifndef LDS_POISON
#define LDS_POISON 0
#endif
namespace g8 {
constexpr int BM = 256, BK = 64, HALF = 128, HTB = HALF * BK * 2, STAGE_BYTES = 8 * HTB;
__device__ __forceinline__ int lds_byte(int r, int c) { const int st = (r >> 4) * 2 + (c >> 5), rr = r & 15, cc = c & 31, ob = rr * 64 + cc * 2; return st * 1024 + (ob ^ (((ob >> 9) & 1) << 5)); }
__device__ __forceinline__ void stage_rc(int b, int& R, int& C) { const int st = b / 1024, sb = b % 1024, swz = sb ^ (((sb >> 9) & 1) << 5); R = (st >> 1) * 16 + swz / 64; C = (st & 1) * 32 + (swz % 64) / 2; }
__device__ __forceinline__ int perm32(int rho) { const int n = rho >> 4, i = rho & 15; return 8 * (i >> 2) + 4 * n + (i & 3); }
struct Unit { int pm, pn, e; };

template <class Epi, class Sched>
__device__ __forceinline__ void gemm_phase(LAS unsigned char* lds, const Sched& S, const Epi& E) {
    int tid_ = threadIdx.x; asm volatile("" : "+v"(tid_));
    const int tid = tid_, wid = __builtin_amdgcn_readfirstlane(tid >> 6), lane = tid & 63, wr = wid >> 2, wc = wid & 3, fr = lane & 15, fq = lane >> 4;
    const size_t kstep = (size_t)(BK * 2);
    const unsigned ldsw = (unsigned)wid * 1024u;
    const int aoff = lds_byte(wr * 64 + fr, fq * 8), boff = lds_byte(wc * 32 + fr, fq * 8);
#define G8_SA(b, h) (((b) * 2 + (h)) * HTB)
#define G8_SB(b, h) ((4 + (b) * 2 + (h)) * HTB)
#define G8_STAGE(bufoff, gbase, vv) do { _Pragma("unroll") for (int _i = 0; _i < 2; ++_i) \
        __builtin_amdgcn_global_load_lds((const unsigned*)((const char*)(gbase) + (vv)[_i]), (LAS unsigned*)(lds + (bufoff) + ldsw + _i * 8192), 16, 0, 0); } while (0)
#define G8_LDA(dst, b, h) do { _Pragma("unroll") for (int m = 0; m < 4; ++m) _Pragma("unroll") for (int k = 0; k < 2; ++k) dst[m][k] = *(const LAS bf16x8*)(lds + G8_SA(b, h) + aoff + m * 2048 + k * 1024); } while (0)
#define G8_LDB(dst, b, h) do { _Pragma("unroll") for (int n = 0; n < 2; ++n) _Pragma("unroll") for (int k = 0; k < 2; ++k) dst[n][k] = *(const LAS bf16x8*)(lds + G8_SB(b, h) + boff + n * 2048 + k * 1024); } while (0)
#define G8_MMA(ai, bj, At, Bt) do { __builtin_amdgcn_s_setprio(1); _Pragma("unroll") for (int m = 0; m < 4; ++m) _Pragma("unroll") for (int n = 0; n < 2; ++n) _Pragma("unroll") for (int k = 0; k < 2; ++k) \
        acc[ai][bj][m][n] = __builtin_amdgcn_mfma_f32_16x16x32_bf16(Bt[n][k], At[m][k], acc[ai][bj][m][n], 0, 0, 0); __builtin_amdgcn_s_setprio(0); } while (0)
#define G8_WAIT_V(n) asm volatile("s_waitcnt vmcnt(" #n ")" ::: "memory")
#define G8_WAIT_L(n) asm volatile("s_waitcnt lgkmcnt(" #n ")" ::: "memory")
#define G8_BAR __builtin_amdgcn_s_barrier()
#define G8_SCHED __builtin_amdgcn_sched_barrier(0)
#define G8_VA(dst, u) do { const int _ac = S.a_col(u), _lda = S.lda(u); _Pragma("unroll") for (int _i = 0; _i < 2; ++_i) { int _R, _C; stage_rc(tid * 16 + _i * 8192, _R, _C); \
        _Pragma("unroll") for (int _h = 0; _h < 2; ++_h) dst[_h][_i] = (unsigned)(((size_t)S.a_row(u, _h * HALF + _R) * _lda + _ac + _C) * 2); } } while (0)
#define G8_VB(dst, hs, u) do { const int _ldb = S.ldb(u); hs = (size_t)HALF * _ldb * 2; _Pragma("unroll") for (int _i = 0; _i < 2; ++_i) { int _R, _C; stage_rc(tid * 16 + _i * 8192, _R, _C); \
        dst[_i] = (unsigned)(((_R & ~31) + perm32(_R & 31)) * _ldb + _C) * 2u; } } while (0)
    Unit cur, nxt; int ui = 0;
    if (!S.next(0, cur)) return;
#if LDS_POISON
    for (int i = tid; i < STAGE_BYTES / 16; i += 512) ((LAS u32x4*)lds)[i] = (u32x4){0x7fc07fc0u, 0x7fc07fc0u, 0x7fc07fc0u, 0x7fc07fc0u};
    __syncthreads();
#endif
    f32x4 acc[2][2][4][2];
#pragma unroll
    for (int a = 0; a < 2; ++a)
#pragma unroll
        for (int b = 0; b < 2; ++b)
#pragma unroll
            for (int m = 0; m < 4; ++m)
#pragma unroll
                for (int n = 0; n < 2; ++n) acc[a][b][m][n] = (f32x4){0.f, 0.f, 0.f, 0.f};
    bf16x8 At[4][2], B0[2][2], B1[2][2];
    unsigned va[2][2], nva[2][2], vb[2], nvb[2]; size_t hsB, nhsB;
    G8_VA(va, cur); G8_VB(vb, hsB, cur);
    const char* Ab = S.a_base(cur);
    const char* cB = S.b_base(cur);
    G8_STAGE(G8_SB(0, 0), cB, vb); G8_STAGE(G8_SA(0, 0), Ab, va[0]); G8_STAGE(G8_SB(0, 1), cB + hsB, vb); G8_STAGE(G8_SA(0, 1), Ab, va[1]);
    if (wr == 1) G8_BAR;
    G8_WAIT_V(4); G8_BAR;
    G8_STAGE(G8_SB(1, 0), cB + kstep, vb); G8_STAGE(G8_SA(1, 0), Ab + kstep, va[0]); G8_STAGE(G8_SB(1, 1), cB + hsB + kstep, vb);
    G8_WAIT_V(6); G8_BAR;
    for (;;) {
        const bool has_next = S.next(ui + 1, nxt);
        const char* nB = cB; const char* nAb = Ab;
        if (has_next) { nB = S.b_base(nxt); nAb = S.a_base(nxt); G8_VA(nva, nxt); G8_VB(nvb, nhsB, nxt); }
        else {
            nhsB = hsB;
#pragma unroll
            for (int i = 0; i < 2; ++i) { nvb[i] = vb[i];
#pragma unroll
                for (int h = 0; h < 2; ++h) nva[h][i] = va[h][i]; }
        }
        const int nt = S.nt(cur);
        for (int t = 0; t < nt; t += 2) {
            const bool last = (t == nt - 2);
            const char* a1 = Ab + (size_t)(t + 1) * kstep;
            const char* a2 = last ? nAb : Ab + (size_t)(t + 2) * kstep;
            const char* b2 = last ? nB : cB + (size_t)(t + 2) * kstep;
            const char* a3 = a2 + kstep; const char* b3 = b2 + kstep;
            const size_t hs2 = last ? nhsB : hsB;
            unsigned v2[2][2], vb2[2];
#pragma unroll
            for (int i = 0; i < 2; ++i) { vb2[i] = last ? nvb[i] : vb[i];
#pragma unroll
                for (int h = 0; h < 2; ++h) v2[h][i] = last ? nva[h][i] : va[h][i]; }
            G8_LDB(B0, 0, 0); G8_SCHED; G8_LDA(At, 0, 0); G8_STAGE(G8_SA(1, 1), a1, va[1]);
            G8_WAIT_L(8); G8_BAR; G8_WAIT_L(0); G8_MMA(0, 0, At, B0); G8_BAR; G8_SCHED;
            G8_LDB(B1, 0, 1); G8_STAGE(G8_SB(0, 0), b2, vb2);
            G8_BAR; G8_WAIT_L(0); G8_MMA(0, 1, At, B1); G8_BAR;
            G8_LDA(At, 0, 1); G8_STAGE(G8_SA(0, 0), a2, v2[0]);
            G8_BAR; G8_WAIT_L(0); G8_MMA(1, 0, At, B0); G8_BAR; G8_SCHED;
            G8_STAGE(G8_SB(0, 1), b2 + hs2, vb2);
            G8_WAIT_V(6); G8_BAR; G8_MMA(1, 1, At, B1); G8_BAR;
            G8_LDB(B0, 1, 0); G8_SCHED; G8_LDA(At, 1, 0); G8_STAGE(G8_SA(0, 1), a2, v2[1]);
            G8_WAIT_L(8); G8_BAR; G8_WAIT_L(0); G8_MMA(0, 0, At, B0); G8_BAR; G8_SCHED;
            G8_LDB(B1, 1, 1); G8_STAGE(G8_SB(1, 0), b3, vb2);
            G8_BAR; G8_WAIT_L(0); G8_MMA(0, 1, At, B1); G8_BAR;
            G8_LDA(At, 1, 1); G8_STAGE(G8_SA(1, 0), a3, v2[0]);
            G8_BAR; G8_WAIT_L(0); G8_MMA(1, 0, At, B0); G8_BAR; G8_SCHED;
            G8_STAGE(G8_SB(1, 1), b3 + hs2, vb2);
            G8_WAIT_V(6); G8_BAR; G8_MMA(1, 1, At, B1); G8_BAR;
        }
        const bool keep = S.cont(cur);
        if (!keep) E(acc, cur, wr, wc, fr, fq);
        if (!has_next) break;
        if (!keep) {
#pragma unroll
            for (int a = 0; a < 2; ++a)
#pragma unroll
                for (int b = 0; b < 2; ++b)
#pragma unroll
                    for (int m = 0; m < 4; ++m)
#pragma unroll
                        for (int n = 0; n < 2; ++n) acc[a][b][m][n] = (f32x4){0.f, 0.f, 0.f, 0.f};
        }
        cur = nxt; cB = nB; Ab = nAb; hsB = nhsB; ++ui;
#pragma unroll
        for (int i = 0; i < 2; ++i) { vb[i] = nvb[i];
#pragma unroll
            for (int h = 0; h < 2; ++h) va[h][i] = nva[h][i]; }
    }
    G8_WAIT_V(0);
    if (wr == 0) G8_BAR;
    G8_BAR;
#undef G8_SA
#undef G8_SB
#undef G8_STAGE
#undef G8_LDA
#undef G8_LDB
#undef G8_MMA
#undef G8_WAIT_V
#undef G8_WAIT_L
#undef G8_BAR
#undef G8_SCHED
#undef G8_VA
#undef G8_VB
}

struct DenseSched {
    __device__ __forceinline__ int lda(const Unit&) const { return lda_; }
    __device__ __forceinline__ int ldb(const Unit&) const { return ldb_; }
    __device__ __forceinline__ int nt(const Unit&) const { return K / BK; }
    __device__ __forceinline__ bool cont(const Unit&) const { return false; }
    int nN, nU, K, lda_, ldb_; const bf16_t* A; const bf16_t* Bt;
    __device__ __forceinline__ const char* a_base(const Unit&) const { return (const char*)A; }
    __device__ __forceinline__ bool next(int i, Unit& u) const {
        const int c = blockIdx.x, per = gridDim.x >> 3, x = c & 7, j = c >> 3;
        const int chunk = (nU + 7) >> 3, lu = i * per + j;
        if (lu >= chunk) return false;
        const int un = x * chunk + lu; if (un >= nU) return false;
        u.pm = un / nN; u.pn = un - u.pm * nN; u.e = 0; return true; }
    __device__ __forceinline__ int a_row(const Unit& u, int r) const { return u.pm * BM + r; }
    __device__ __forceinline__ int a_col(const Unit&) const { return 0; }
    __device__ __forceinline__ const char* b_base(const Unit& u) const { return (const char*)(Bt + (size_t)u.pn * BM * ldb_); }
};

struct EpiGlu {
    bf16_t* U; const float* rs; const float* bias;
    __device__ __forceinline__ void operator()(const f32x4 (&acc)[2][2][4][2], const Unit& u, int wr, int wc, int fr, int fq) const {
        const int c0 = u.pn * 128 + wc * 32 + 8 * fq;
        const f32x4 ba0 = *(const f32x4*)(bias + c0), ba1 = *(const f32x4*)(bias + c0 + 4), bg0 = *(const f32x4*)(bias + 1024 + c0), bg1 = *(const f32x4*)(bias + 1024 + c0 + 4);
        float rv[2][4];
#pragma unroll
        for (int ai = 0; ai < 2; ++ai)
#pragma unroll
            for (int m = 0; m < 4; ++m) rv[ai][m] = rs[u.pm * BM + ai * HALF + wr * 64 + m * 16 + fr];
        __builtin_amdgcn_sched_barrier(0);
#pragma unroll
        for (int ai = 0; ai < 2; ++ai)
#pragma unroll
            for (int m = 0; m < 4; ++m) {
                const int row = u.pm * BM + ai * HALF + wr * 64 + m * 16 + fr; const float r = rv[ai][m];
                f32x4 o0, o1;
#pragma unroll
                for (int j = 0; j < 4; ++j) {
                    o0[j] = (acc[ai][0][m][0][j] * r + ba0[j]) * fast_sigmoid(acc[ai][1][m][0][j] * r + bg0[j]);
                    o1[j] = (acc[ai][0][m][1][j] * r + ba1[j]) * fast_sigmoid(acc[ai][1][m][1][j] * r + bg1[j]); }
                *(u32x4*)(U + (size_t)row * D + c0) = pack8(o0, o1);
            }
    }
};
struct EpiXres {
    const float* Xin; float* Xout; bf16_t* XB; const float* bias; float* ssp;
    __device__ __forceinline__ void operator()(const f32x4 (&acc)[2][2][4][2], const Unit& u, int wr, int wc, int fr, int fq) const {
        f32x4 bv[2][2];
#pragma unroll
        for (int bj = 0; bj < 2; ++bj) { const int c0 = u.pn * BM + bj * HALF + wc * 32 + 8 * fq;
            bv[bj][0] = bias ? *(const f32x4*)(bias + c0) : (f32x4){0.f, 0.f, 0.f, 0.f}; bv[bj][1] = bias ? *(const f32x4*)(bias + c0 + 4) : (f32x4){0.f, 0.f, 0.f, 0.f}; }
#pragma unroll
        for (int ai = 0; ai < 2; ++ai) {
            f32x4 xv[4][2][2];
#pragma unroll
            for (int m = 0; m < 4; ++m)
#pragma unroll
                for (int bj = 0; bj < 2; ++bj) { const size_t off = (size_t)(u.pm * BM + ai * HALF + wr * 64 + m * 16 + fr) * D + u.pn * BM + bj * HALF + wc * 32 + 8 * fq;
                    xv[m][bj][0] = *(const f32x4*)(Xin + off); xv[m][bj][1] = *(const f32x4*)(Xin + off + 4); }
            __builtin_amdgcn_sched_barrier(0);
#pragma unroll
            for (int m = 0; m < 4; ++m) {
                const int row = u.pm * BM + ai * HALF + wr * 64 + m * 16 + fr; float ss = 0.f;
#pragma unroll
                for (int bj = 0; bj < 2; ++bj) {
                    const size_t off = (size_t)row * D + u.pn * BM + bj * HALF + wc * 32 + 8 * fq;
                    const f32x4 v0 = xv[m][bj][0] + acc[ai][bj][m][0] + bv[bj][0], v1 = xv[m][bj][1] + acc[ai][bj][m][1] + bv[bj][1];
                    *(f32x4*)(Xout + off) = v0; *(f32x4*)(Xout + off + 4) = v1;
                    *(u32x4*)(XB + off) = pack8(v0, v1);
                    ss += (v0[0] * v0[0] + v0[1] * v0[1]) + (v0[2] * v0[2] + v0[3] * v0[3]) + (v1[0] * v1[0] + v1[1] * v1[1]) + (v1[2] * v1[2] + v1[3] * v1[3]);
                }
                if (ssp) { ss += __shfl_xor(ss, 16); ss += __shfl_xor(ss, 32); if (fq == 0) ssp[(size_t)row * 16 + u.pn * 4 + wc] = ss; }
            }
        }
    }
};
struct AttnSched {
    __device__ __forceinline__ int lda(const Unit&) const { return lda_; }
    __device__ __forceinline__ int ldb(const Unit&) const { return ldb_; }
    __device__ __forceinline__ int nt(const Unit&) const { return K / BK; }
    __device__ __forceinline__ bool cont(const Unit&) const { return false; }
    int K, lda_, ldb_; const bf16_t* A; const bf16_t* Bm; int pv;
    __device__ __forceinline__ bool next(int i, Unit& u) const {
        const int c = blockIdx.x, per = gridDim.x >> 3, x = c & 7, j = c >> 3;
        const int lu = i * per + j; if (lu >= 64) return false;
        const int un = x * 64 + lu, bh = un >> 5, qb = un & 31;
        u.pm = (bh >> 2) * 32 + qb; u.pn = 0; u.e = bh & 3; return true; }
    __device__ __forceinline__ const char* a_base(const Unit&) const { return (const char*)A; }
    __device__ __forceinline__ int a_row(const Unit& u, int r) const { return u.pm * BM + r; }
    __device__ __forceinline__ int a_col(const Unit& u) const { return u.e * 256; }
    __device__ __forceinline__ const char* b_base(const Unit& u) const { const int b = u.pm >> 5;
        return pv ? (const char*)(Bm + (size_t)(b * 4 + u.e) * 65536) : (const char*)(Bm + (size_t)(b * 256) * 1024 + u.e * 256); }
};
struct KVSched {
    __device__ __forceinline__ int lda(const Unit&) const { return lda_; }
    __device__ __forceinline__ int ldb(const Unit&) const { return ldb_; }
    __device__ __forceinline__ int nt(const Unit&) const { return K / BK; }
    __device__ __forceinline__ bool cont(const Unit&) const { return false; }
    int K, lda_, ldb_; const bf16_t* MEMNB; const bf16_t* WKV;
    __device__ __forceinline__ bool next(int i, Unit& u) const {
        const int un = i * (int)gridDim.x + (int)blockIdx.x; if (un >= 32) return false;
        u.e = un >> 4; u.pm = (un & 15) >> 2; u.pn = un & 3; return true; }
    __device__ __forceinline__ const char* a_base(const Unit& u) const { return u.e ? (const char*)(WKV + (size_t)1024 * 1024) : (const char*)MEMNB; }
    __device__ __forceinline__ int a_row(const Unit& u, int r) const { return u.pm * BM + r; }
    __device__ __forceinline__ int a_col(const Unit&) const { return 0; }
    __device__ __forceinline__ const char* b_base(const Unit& u) const { return u.e ? (const char*)(MEMNB + (size_t)u.pn * BM * 1024) : (const char*)(WKV + (size_t)u.pn * BM * 1024); }
};
__device__ __forceinline__ float ssp_rs(const float* ssp, int row) {
    const f32x4 a = *(const f32x4*)(ssp + (size_t)row * 16), b = *(const f32x4*)(ssp + (size_t)row * 16 + 4), c = *(const f32x4*)(ssp + (size_t)row * 16 + 8), d = *(const f32x4*)(ssp + (size_t)row * 16 + 12);
    const float s = ((a[0] + a[1]) + (a[2] + a[3])) + ((b[0] + b[1]) + (b[2] + b[3])) + ((c[0] + c[1]) + (c[2] + c[3])) + ((d[0] + d[1]) + (d[2] + d[3]));
    return rsqrtf(s * (1.0f / D) + EPS);
}
struct EpiRowScale {
    bf16_t* O; int ldo; const float* ssp; const float* rs; float scale; int qtiles; float qscale;
    __device__ __forceinline__ void operator()(const f32x4 (&acc)[2][2][4][2], const Unit& u, int wr, int wc, int fr, int fq) const {
        const float cs = scale * (u.pn < qtiles ? qscale : 1.0f);
        float rv[2][4];
        if (rs) {
#pragma unroll
            for (int ai = 0; ai < 2; ++ai)
#pragma unroll
                for (int m = 0; m < 4; ++m) rv[ai][m] = rs[u.pm * BM + ai * HALF + wr * 64 + m * 16 + fr];
        } else {
#pragma unroll
            for (int ai = 0; ai < 2; ++ai) {
                f32x4 p[4][4];
#pragma unroll
                for (int m = 0; m < 4; ++m)
#pragma unroll
                    for (int q = 0; q < 4; ++q) p[m][q] = *(const f32x4*)(ssp + (size_t)(u.pm * BM + ai * HALF + wr * 64 + m * 16 + fr) * 16 + 4 * q);
                __builtin_amdgcn_sched_barrier(0);
#pragma unroll
                for (int m = 0; m < 4; ++m) { float sm = 0.f;
#pragma unroll
                    for (int q = 0; q < 4; ++q) sm += (p[m][q][0] + p[m][q][1]) + (p[m][q][2] + p[m][q][3]);
                    rv[ai][m] = rsqrtf(sm * (1.0f / D) + EPS); }
            }
        }
        __builtin_amdgcn_sched_barrier(0);
#pragma unroll
        for (int ai = 0; ai < 2; ++ai)
#pragma unroll
            for (int m = 0; m < 4; ++m) {
                const int row = u.pm * BM + ai * HALF + wr * 64 + m * 16 + fr;
                const float r = rv[ai][m] * cs;
#pragma unroll
                for (int bj = 0; bj < 2; ++bj) { const int c0 = u.pn * BM + bj * HALF + wc * 32 + 8 * fq;
                    *(u32x4*)(O + (size_t)row * ldo + c0) = pack8(acc[ai][bj][m][0] * r, acc[ai][bj][m][1] * r); }
            }
    }
};
struct EpiKV {
    bf16_t* Kb; bf16_t* VT;
    __device__ __forceinline__ void operator()(const f32x4 (&acc)[2][2][4][2], const Unit& u, int wr, int wc, int fr, int fq) const {
        bf16_t* base = u.e ? VT + (size_t)(u.pn * 4 + u.pm) * 65536 : Kb + (size_t)u.pm * BM * 1024 + u.pn * BM;
        const int ld = u.e ? 256 : 1024;
#pragma unroll
        for (int ai = 0; ai < 2; ++ai)
#pragma unroll
            for (int m = 0; m < 4; ++m) { const int r = ai * HALF + wr * 64 + m * 16 + fr;
#pragma unroll
                for (int bj = 0; bj < 2; ++bj) { const int c0 = bj * HALF + wc * 32 + 8 * fq;
                    *(u32x4*)(base + (size_t)r * ld + c0) = pack8(acc[ai][bj][m][0], acc[ai][bj][m][1]); } }
    }
};
struct EpiS {
    bf16_t* P; float* psum;
    __device__ __forceinline__ void operator()(const f32x4 (&acc)[2][2][4][2], const Unit& u, int wr, int wc, int fr, int fq) const {
#pragma unroll
        for (int ai = 0; ai < 2; ++ai)
#pragma unroll
            for (int m = 0; m < 4; ++m) {
                const int row = u.pm * BM + ai * HALF + wr * 64 + m * 16 + fr; float ps = 0.f;
#pragma unroll
                for (int bj = 0; bj < 2; ++bj) { const int c0 = u.e * 256 + bj * HALF + wc * 32 + 8 * fq;
                    f32x4 e0, e1;
#pragma unroll
                    for (int j = 0; j < 4; ++j) { e0[j] = __builtin_amdgcn_exp2f(acc[ai][bj][m][0][j] * 1.4426950408889634f); e1[j] = __builtin_amdgcn_exp2f(acc[ai][bj][m][1][j] * 1.4426950408889634f); }
                    const u32x4 w = pack8(e0, e1);
                    *(u32x4*)(P + (size_t)row * D + c0) = w;
                    ps += (bf_lo(w.x) + bf_hi(w.x)) + (bf_lo(w.y) + bf_hi(w.y)) + (bf_lo(w.z) + bf_hi(w.z)) + (bf_lo(w.w) + bf_hi(w.w)); }
                ps += __shfl_xor(ps, 16); ps += __shfl_xor(ps, 32);
                if (fq == 0) psum[(size_t)row * 16 + u.e * 4 + wc] = ps;
            }
    }
};
struct EpiRaw {
    bf16_t* O;
    __device__ __forceinline__ void operator()(const f32x4 (&acc)[2][2][4][2], const Unit& u, int wr, int wc, int fr, int fq) const {
#pragma unroll
        for (int ai = 0; ai < 2; ++ai)
#pragma unroll
            for (int m = 0; m < 4; ++m) { const int row = u.pm * BM + ai * HALF + wr * 64 + m * 16 + fr;
#pragma unroll
                for (int bj = 0; bj < 2; ++bj) { const int c0 = u.e * 256 + bj * HALF + wc * 32 + 8 * fq;
                    *(u32x4*)(O + (size_t)row * D + c0) = pack8(acc[ai][bj][m][0], acc[ai][bj][m][1]); } }
    }
};
struct EpiPV {
    bf16_t* O; const float* psum;
    __device__ __forceinline__ void operator()(const f32x4 (&acc)[2][2][4][2], const Unit& u, int wr, int wc, int fr, int fq) const {
        f32x4 sv[2][4];
#pragma unroll
        for (int ai = 0; ai < 2; ++ai)
#pragma unroll
            for (int m = 0; m < 4; ++m) sv[ai][m] = *(const f32x4*)(psum + (size_t)(u.pm * BM + ai * HALF + wr * 64 + m * 16 + fr) * 16 + u.e * 4);
        __builtin_amdgcn_sched_barrier(0);
#pragma unroll
        for (int ai = 0; ai < 2; ++ai)
#pragma unroll
            for (int m = 0; m < 4; ++m) {
                const int row = u.pm * BM + ai * HALF + wr * 64 + m * 16 + fr;
                const float inv = 1.0f / ((sv[ai][m][0] + sv[ai][m][1]) + (sv[ai][m][2] + sv[ai][m][3]));
#pragma unroll
                for (int bj = 0; bj < 2; ++bj) { const int c0 = u.e * 256 + bj * HALF + wc * 32 + 8 * fq;
                    *(u32x4*)(O + (size_t)row * D + c0) = pack8(acc[ai][bj][m][0] * inv, acc[ai][bj][m][1] * inv); }
            }
    }
};

__device__ __forceinline__ int ld_agent(const int* p) { return __hip_atomic_load(p, __ATOMIC_RELAXED, __HIP_MEMORY_SCOPE_AGENT); }
struct MoeSched {
    __device__ __forceinline__ int lda(const Unit&) const { return lda_; }
    __device__ __forceinline__ int ldb(const Unit&) const { return ldb_; }
    __device__ __forceinline__ int nt(const Unit&) const { return K / BK; }
    __device__ __forceinline__ bool cont(const Unit&) const { return false; }
    int K, lda_, ldb_; const bf16_t* A; const bf16_t* W; size_t wstride; const int* tile_e; const int* slot_tok; int NT;
    __device__ __forceinline__ bool next(int i, Unit& u) const {
        const int c = blockIdx.x, per = gridDim.x >> 3, x = c & 7, j = c >> 3;
        const int tpx = (NT + 7) >> 3, lu = i * per + j, lrt = lu >> 2;
        if (lrt >= tpx) return false;
        const int rt = x * tpx + lrt; if (rt >= NT) return false;
        u.pm = rt; u.pn = lu & 3; u.e = __builtin_amdgcn_readfirstlane(ld_agent(tile_e + rt)); return true; }
    __device__ __forceinline__ const char* a_base(const Unit&) const { return (const char*)A; }
    __device__ __forceinline__ int a_row(const Unit& u, int r) const { return slot_tok ? slot_tok[u.pm * BM + r] : u.pm * BM + r; }
    __device__ __forceinline__ int a_col(const Unit&) const { return 0; }
    __device__ __forceinline__ const char* b_base(const Unit& u) const { return (const char*)(W + (size_t)u.e * wstride + (size_t)u.pn * BM * ldb_); }
};
struct EpiMoe1 {
    bf16_t* H; const float* slot_rs;
    __device__ __forceinline__ void operator()(const f32x4 (&acc)[2][2][4][2], const Unit& u, int wr, int wc, int fr, int fq) const {
        const int c0 = u.pn * 128 + wc * 32 + 8 * fq;
        float rv[2][4];
#pragma unroll
        for (int ai = 0; ai < 2; ++ai)
#pragma unroll
            for (int m = 0; m < 4; ++m) rv[ai][m] = slot_rs[u.pm * BM + ai * HALF + wr * 64 + m * 16 + fr];
        __builtin_amdgcn_sched_barrier(0);
#pragma unroll
        for (int ai = 0; ai < 2; ++ai)
#pragma unroll
            for (int m = 0; m < 4; ++m) {
                const int row = u.pm * BM + ai * HALF + wr * 64 + m * 16 + fr; const float r = rv[ai][m];
                f32x4 o0, o1;
#pragma unroll
                for (int j = 0; j < 4; ++j) {
                    const float g0 = acc[ai][0][m][0][j] * r, g1 = acc[ai][0][m][1][j] * r;
                    o0[j] = g0 * fast_sigmoid(g0) * (acc[ai][1][m][0][j] * r);
                    o1[j] = g1 * fast_sigmoid(g1) * (acc[ai][1][m][1][j] * r); }
                *(u32x4*)(H + (size_t)row * DE + c0) = pack8(o0, o1);
            }
    }
};
struct EpiMoe2 {
    bf16_t* Y; const int* slot_a; const float* slot_gate;
    __device__ __forceinline__ void operator()(const f32x4 (&acc)[2][2][4][2], const Unit& u, int wr, int wc, int fr, int fq) const {
        int av[2][4]; float gv[2][4];
#pragma unroll
        for (int ai = 0; ai < 2; ++ai)
#pragma unroll
            for (int m = 0; m < 4; ++m) { const int row = u.pm * BM + ai * HALF + wr * 64 + m * 16 + fr; av[ai][m] = slot_a[row]; gv[ai][m] = slot_gate[row]; }
        __builtin_amdgcn_sched_barrier(0);
#pragma unroll
        for (int ai = 0; ai < 2; ++ai)
#pragma unroll
            for (int m = 0; m < 4; ++m) {
                const int a = av[ai][m]; const float g = gv[ai][m];
                if (a >= 0) {
#pragma unroll
                    for (int bj = 0; bj < 2; ++bj) { const int c0 = u.pn * BM + bj * HALF + wc * 32 + 8 * fq;
                        *(u32x4*)(Y + (size_t)a * D + c0) = pack8(acc[ai][bj][m][0] * g, acc[ai][bj][m][1] * g); }
                }
            }
    }
};

struct GlaInSched {
    const bf16_t* XB; const bf16_t* WTM; const bf16_t* WFM;
    __device__ __forceinline__ int lda(const Unit&) const { return D; }
    __device__ __forceinline__ int ldb(const Unit&) const { return D; }
    __device__ __forceinline__ int nt(const Unit&) const { return D / BK; }
    __device__ __forceinline__ bool cont(const Unit&) const { return false; }
    __device__ __forceinline__ bool next(int i, Unit& u) const {
        const int c = blockIdx.x, per = gridDim.x >> 3, x = c & 7, j = c >> 3, lu = i * per + j;
        if (lu >= 224) return false;
        const int un = x * 224 + lu;
        if (un < 1024) { u.e = 0; u.pm = un >> 3; u.pn = un & 7; } else { const int v = un - 1024; u.e = 1; u.pn = v / 6; u.pm = v - u.pn * 6; }
        return true; }
    __device__ __forceinline__ const char* a_base(const Unit& u) const { return u.e ? (const char*)WFM : (const char*)XB; }
    __device__ __forceinline__ int a_row(const Unit& u, int r) const { return u.pm * BM + r; }
    __device__ __forceinline__ int a_col(const Unit&) const { return 0; }
    __device__ __forceinline__ const char* b_base(const Unit& u) const { return u.e ? (const char*)(XB + (size_t)u.pn * BM * D) : (const char*)(WTM + (size_t)u.pn * BM * D); }
};
__device__ __forceinline__ float fexp(float x) { return __builtin_amdgcn_exp2f(x * 1.4426950408889634f); }
struct EpiGlaIn {
    bf16_t* QKR; bf16_t* KVT; const float* RS; const float* BTM; const float* BFM;
    __device__ __forceinline__ void operator()(const f32x4 (&acc)[2][2][4][2], const Unit& u, int wr, int wc, int fr, int fq) const {
        if (u.e == 0) {
            float rv[2][4];
#pragma unroll
            for (int ai = 0; ai < 2; ++ai)
#pragma unroll
                for (int m = 0; m < 4; ++m) rv[ai][m] = RS[u.pm * BM + ai * HALF + wr * 64 + m * 16 + fr];
            const float sg = u.pn < 2 ? 1.0f : -1.0f, qs = u.pn < 2 ? 0.08838834764831845f : 1.0f;
#pragma unroll
            for (int ai = 0; ai < 2; ++ai)
#pragma unroll
                for (int mp = 0; mp < 2; ++mp) {
                    f32x4 bv[2][2][2];
                    if (u.pn < 4) {
#pragma unroll
                        for (int mm = 0; mm < 2; ++mm)
#pragma unroll
                            for (int bj = 0; bj < 2; ++bj) { const int row = u.pm * BM + ai * HALF + wr * 64 + (2 * mp + mm) * 16 + fr, kf = (u.pn * BM + bj * HALF + wc * 32 + 8 * fq) & 511;
                                bv[mm][bj][0] = *(const f32x4*)(BTM + (size_t)row * 512 + kf); bv[mm][bj][1] = *(const f32x4*)(BTM + (size_t)row * 512 + kf + 4); }
                    }
                    __builtin_amdgcn_sched_barrier(0);
#pragma unroll
                    for (int mm = 0; mm < 2; ++mm) { const int m = 2 * mp + mm;
                        const int row = u.pm * BM + ai * HALF + wr * 64 + m * 16 + fr; const float r = rv[ai][m];
#pragma unroll
                        for (int bj = 0; bj < 2; ++bj) { const int c0 = u.pn * BM + bj * HALF + wc * 32 + 8 * fq;
                            f32x4 s0 = (f32x4){r, r, r, r}, s1 = s0;
                            if (u.pn < 4) {
#pragma unroll
                                for (int j = 0; j < 4; ++j) { s0[j] = r * qs * fexp(sg * bv[mm][bj][0][j]); s1[j] = r * qs * fexp(sg * bv[mm][bj][1][j]); } }
                            *(u32x4*)(QKR + (size_t)row * 2048 + c0) = pack8(acc[ai][bj][m][0] * s0, acc[ai][bj][m][1] * s1); }
                    }
                    __builtin_amdgcn_sched_barrier(0);
                }
        } else {
#pragma unroll
            for (int bj = 0; bj < 2; ++bj) { const int t0 = u.pn * BM + bj * HALF + wc * 32 + 8 * fq;
                const f32x4 r0 = *(const f32x4*)(RS + t0), r1 = *(const f32x4*)(RS + t0 + 4);
#pragma unroll
                for (int ai = 0; ai < 2; ++ai) {
                    f32x4 bv[4][2];
                    if (u.pm < 2) {
#pragma unroll
                        for (int m = 0; m < 4; ++m) { const int f = u.pm * BM + ai * HALF + wr * 64 + m * 16 + fr;
                            bv[m][0] = *(const f32x4*)(BFM + (size_t)f * T + t0); bv[m][1] = *(const f32x4*)(BFM + (size_t)f * T + t0 + 4); }
                    }
                    __builtin_amdgcn_sched_barrier(0);
#pragma unroll
                    for (int m = 0; m < 4; ++m) { const int f = u.pm * BM + ai * HALF + wr * 64 + m * 16 + fr;
                        f32x4 s0 = r0, s1 = r1;
                        if (u.pm < 2) {
#pragma unroll
                            for (int j = 0; j < 4; ++j) { s0[j] *= fexp(-bv[m][0][j]); s1[j] *= fexp(-bv[m][1][j]); } }
                        *(u32x4*)(KVT + (size_t)f * T + t0) = pack8(acc[ai][bj][m][0] * s0, acc[ai][bj][m][1] * s1); }
                    __builtin_amdgcn_sched_barrier(0);
                }
            }
        }
    }
};
template <int TYP> struct GlaAttSched {
    const bf16_t* QKR; const bf16_t* KVT;
    __device__ __forceinline__ bool next(int i, Unit& u) const {
        const int c = blockIdx.x, per = gridDim.x >> 3, x = c & 7, j = c >> 3, lu = i * per + j;
        if (lu >= 64) return false;
        const int un = x * 64 + lu, bh = un >> 5, cc = un & 31;
        u.e = TYP; u.pm = (bh >> 2) * 32 + cc; u.pn = bh & 3; return true; }
    __device__ __forceinline__ int lda(const Unit& u) const { return TYP ? T : 2048; }
    __device__ __forceinline__ int ldb(const Unit& u) const { return TYP ? T : 2048; }
    __device__ __forceinline__ int nt(const Unit& u) const { int n = TYP ? 4 : 2; asm volatile("" : "+s"(n)); return n; }
    __device__ __forceinline__ bool cont(const Unit&) const { return false; }
    __device__ __forceinline__ const char* a_base(const Unit& u) const { return TYP ? (const char*)KVT : (const char*)QKR; }
    __device__ __forceinline__ int a_row(const Unit& u, int r) const { return TYP ? 512 + u.pn * 256 + r : u.pm * BM + r; }
    __device__ __forceinline__ int a_col(const Unit& u) const { return TYP ? u.pm * BM : u.pn * 128; }
    __device__ __forceinline__ const char* b_base(const Unit& u) const {
        return TYP ? (const char*)(KVT + (size_t)(u.pn * 128) * T + (size_t)u.pm * BM) : (const char*)(QKR + (size_t)u.pm * BM * 2048 + 512 + u.pn * 128); }
};
template <int TYP> struct EpiGlaAtt {
    bf16_t* ATT; bf16_t* UT; const float* DL;
    __device__ __forceinline__ void operator()(const f32x4 (&acc)[2][2][4][2], const Unit& u, int wr, int wc, int fr, int fq) const {
        if (TYP == 0) {
#pragma unroll
            for (int ai = 0; ai < 2; ++ai)
#pragma unroll
                for (int m = 0; m < 4; ++m) { const int rit = ai * HALF + wr * 64 + m * 16 + fr;
#pragma unroll
                    for (int bj = 0; bj < 2; ++bj) { const int c0 = bj * HALF + wc * 32 + 8 * fq;
                        f32x4 v0 = acc[ai][bj][m][0], v1 = acc[ai][bj][m][1];
#pragma unroll
                        for (int j = 0; j < 4; ++j) { if (c0 + j > rit) v0[j] = 0.f; if (c0 + 4 + j > rit) v1[j] = 0.f; }
                        *(u32x4*)(ATT + (size_t)(u.pm * BM + rit) * D + u.pn * 256 + c0) = pack8(v0, v1); }
                }
        } else {
            const int k0 = wc * 32 + 8 * fq;
            const f32x4 d0 = *(const f32x4*)(DL + (size_t)u.pm * 512 + u.pn * 128 + k0), d1 = *(const f32x4*)(DL + (size_t)u.pm * 512 + u.pn * 128 + k0 + 4);
            const int b = u.pm >> 5, cc = u.pm & 31; bf16_t* base = UT + (size_t)((b * 4 + u.pn) * 32 + cc) * 32768;
#pragma unroll
            for (int ai = 0; ai < 2; ++ai)
#pragma unroll
                for (int m = 0; m < 4; ++m) { const int dv = ai * HALF + wr * 64 + m * 16 + fr;
                    *(u32x4*)(base + (size_t)dv * 128 + k0) = pack8(acc[ai][0][m][0] * d0, acc[ai][0][m][1] * d1); }
        }
    }
};
struct GlaOSched {
    const bf16_t* QKR; const bf16_t* KVT; const bf16_t* ATT; const bf16_t* SP;
    __device__ __forceinline__ bool next(int i, Unit& u) const {
        const int c = blockIdx.x, per = gridDim.x >> 3, x = c & 7, j = c >> 3, pl = (i >> 1) * per + j;
        if (pl >= 64) return false;
        const int w = x * 64 + pl, bh = w >> 5, cc = w & 31;
        u.e = i & 1; u.pm = (bh >> 2) * 32 + cc; u.pn = bh & 3; return true; }
    __device__ __forceinline__ int lda(const Unit& u) const { return u.e ? D : 2048; }
    __device__ __forceinline__ int ldb(const Unit& u) const { return u.e ? T : 128; }
    __device__ __forceinline__ int nt(const Unit& u) const { return u.e ? 4 : 2; }
    __device__ __forceinline__ bool cont(const Unit& u) const { return u.e == 0; }
    __device__ __forceinline__ const char* a_base(const Unit& u) const { return u.e ? (const char*)ATT : (const char*)QKR; }
    __device__ __forceinline__ int a_row(const Unit& u, int r) const { return u.pm * BM + r; }
    __device__ __forceinline__ int a_col(const Unit& u) const { return u.e ? u.pn * 256 : u.pn * 128; }
    __device__ __forceinline__ const char* b_base(const Unit& u) const { const int b = u.pm >> 5, cc = u.pm & 31;
        return u.e ? (const char*)(KVT + (size_t)(512 + u.pn * 256) * T + (size_t)u.pm * BM) : (const char*)(SP + (size_t)((b * 4 + u.pn) * 32 + cc) * 32768); }
};
struct EpiGlaO {
    bf16_t* O;
    __device__ __forceinline__ void operator()(const f32x4 (&acc)[2][2][4][2], const Unit& u, int wr, int wc, int fr, int fq) const {
#pragma unroll
        for (int ai = 0; ai < 2; ++ai)
#pragma unroll
            for (int m = 0; m < 4; ++m) { const int row = u.pm * BM + ai * HALF + wr * 64 + m * 16 + fr;
#pragma unroll
                for (int bj = 0; bj < 2; ++bj) { const int c0 = u.pn * 256 + bj * HALF + wc * 32 + 8 * fq;
                    *(u32x4*)(O + (size_t)row * D + c0) = pack8(acc[ai][bj][m][0], acc[ai][bj][m][1]); } }
    }
};
}

struct CvtJob { const float* W; int ldw, col0, K; const float* g; bf16_t* Bt; int il, half, nblk; };
__device__ __forceinline__ void cvt_load(const CvtJob& j, int item, int lane, f32x4 (&v)[8]) {
    const int kb = item / j.nblk, nb = item - kb * j.nblk, k0 = 64 * kb, n0 = 32 * nb;
    const float* p = j.W + (size_t)(k0 + (lane >> 3)) * j.ldw + j.col0 + n0 + 4 * (lane & 7);
#pragma unroll
    for (int i = 0; i < 8; ++i) v[i] = *(const f32x4*)(p + (size_t)(8 * i) * j.ldw);
    if (j.g) {
#pragma unroll
        for (int i = 0; i < 8; ++i) v[i] *= j.g[k0 + 8 * i + (lane >> 3)]; }
}
__device__ __forceinline__ void cvt_store(const CvtJob& j, int item, int lane, LAS float* scr, const f32x4 (&v)[8]) {
    const int kb = item / j.nblk, nb = item - kb * j.nblk, k0 = 64 * kb, n0 = 32 * nb;
#pragma unroll
    for (int i = 0; i < 8; ++i) { LAS float* d = scr + (8 * i + (lane >> 3)) * 33 + 4 * (lane & 7); d[0] = v[i][0]; d[1] = v[i][1]; d[2] = v[i][2]; d[3] = v[i][3]; }
    asm volatile("s_waitcnt lgkmcnt(0)" ::: "memory");
    const int c = lane & 7;
#pragma unroll
    for (int q = 0; q < 4; ++q) { const int n = (lane >> 3) + 8 * q; const LAS float* s = scr + (8 * c) * 33 + n;
        u32x4 o; o.x = cvt_pk_bf16(s[0 * 33], s[1 * 33]); o.y = cvt_pk_bf16(s[2 * 33], s[3 * 33]); o.z = cvt_pk_bf16(s[4 * 33], s[5 * 33]); o.w = cvt_pk_bf16(s[6 * 33], s[7 * 33]);
        const int nn = n0 + n, drow = j.il ? ((nn >> 7) * 256 + j.half * 128 + (nn & 127)) : nn;
        *(u32x4*)(j.Bt + (size_t)drow * j.K + k0 + 8 * c) = o; }
    asm volatile("s_waitcnt lgkmcnt(0)" ::: "memory");
}
__device__ __forceinline__ void cvt_matrix(const float* W, int ldw, int col0, int ncols, int K, const float* g, bf16_t* Bt, int il, int half, LAS unsigned char* lds, int woff = 0) {
    const int tix = otid();
    const int lane = tix & 63, wv = tix >> 6;
    LAS float* scr = (LAS float*)(lds + wv * 8704);
    const int ngw = gridDim.x * 8; int gw = blockIdx.x * 8 + wv - (woff % ngw); if (gw < 0) gw += ngw;
    const CvtJob j{W, ldw, col0, K, g, Bt, il, half, ncols / 32};
    const int nitems = (K / 64) * j.nblk;
    f32x4 cur[8], nxt[8];
    int it = gw; if (it < nitems) cvt_load(j, it, lane, cur);
    for (; it < nitems; it += ngw) {
        const int itn = it + ngw; if (itn < nitems) cvt_load(j, itn, lane, nxt);
        cvt_store(j, it, lane, scr, cur);
#pragma unroll
        for (int i = 0; i < 8; ++i) cur[i] = nxt[i];
    }
}
__device__ __forceinline__ void rows_prep(const float* x, bf16_t* XB, float* rs, float* ssp, int rows) {
    const int tix = otid();
    const int lane = tix & 63;
    const int gw = (blockIdx.x * blockDim.x + tix) >> 6, ngw = (gridDim.x * blockDim.x) >> 6;
    for (int r = gw; r < rows; r += ngw) {
        const f32x4* xr = (const f32x4*)(x + (size_t)r * D);
        f32x4 v[4]; float s = 0.f;
#pragma unroll
        for (int j = 0; j < 4; ++j) { v[j] = xr[lane + 64 * j]; s += (v[j][0] * v[j][0] + v[j][1] * v[j][1]) + (v[j][2] * v[j][2] + v[j][3] * v[j][3]); }
        s = wave_sum(s);
        if (lane == 0) rs[r] = rsqrtf(s * (1.0f / D) + EPS);
        if (ssp && lane < 16) ssp[(size_t)r * 16 + lane] = lane == 0 ? s : 0.f;
        u32x2* o = (u32x2*)(XB + (size_t)r * D);
#pragma unroll
        for (int j = 0; j < 4; ++j) { u32x2 w; w.x = cvt_pk_bf16(v[j][0], v[j][1]); w.y = cvt_pk_bf16(v[j][2], v[j][3]); o[lane + 64 * j] = w; }
    }
}

__device__ __forceinline__ void rows_norm_bf16(const float* x, const float* g, bf16_t* out, int rows) {
    const int tix = otid();
    const int lane = tix & 63;
    const int gw = (blockIdx.x * blockDim.x + tix) >> 6, ngw = (gridDim.x * blockDim.x) >> 6;
    for (int r = gw; r < rows; r += ngw) {
        const f32x4* xr = (const f32x4*)(x + (size_t)r * D);
        f32x4 v[4]; float s = 0.f;
#pragma unroll
        for (int j = 0; j < 4; ++j) { v[j] = xr[lane + 64 * j]; s += (v[j][0] * v[j][0] + v[j][1] * v[j][1]) + (v[j][2] * v[j][2] + v[j][3] * v[j][3]); }
        s = wave_sum(s); const float rs = rsqrtf(s * (1.0f / D) + EPS);
        u32x2* o = (u32x2*)(out + (size_t)r * D);
#pragma unroll
        for (int j = 0; j < 4; ++j) { const f32x4 gg = ((const f32x4*)g)[lane + 64 * j]; u32x2 w; w.x = cvt_pk_bf16(v[j][0] * rs * gg[0], v[j][1] * rs * gg[1]); w.y = cvt_pk_bf16(v[j][2] * rs * gg[2], v[j][3] * rs * gg[3]); o[lane + 64 * j] = w; }
    }
}

__device__ __forceinline__ void route_prep(const float* wg, const float* we, const float* gain, float* WR) {
    const int tix = otid();
    const int gi = blockIdx.x * blockDim.x + tix, gs = gridDim.x * blockDim.x;
    for (int i = gi; i < 36 * 1024; i += gs) { const int j = i >> 10, k = i & 1023; WR[i] = (j < 32 ? we[k * NE + j] : wg[k * NG + (j - 32)]) * gain[k]; }
}
__device__ __forceinline__ float reduce16(float (&v)[18], int lane) {
#pragma unroll
    for (int st = 0; st < 4; ++st) { const int half = 8 >> st, bit = 32 >> st; const bool up = (lane & bit) != 0;
#pragma unroll
        for (int k = 0; k < half; ++k) { const float send = up ? v[k] : v[k + half]; const float keep = up ? v[k + half] : v[k]; v[k] = keep + __shfl_xor(send, bit); } }
    float r = v[0]; r += __shfl_xor(r, 2); r += __shfl_xor(r, 1); return r;
}
__device__ __forceinline__ float reduce2(const float (&v)[18], int lane) {
    const bool up = (lane & 32) != 0; const float send = up ? v[16] : v[17], keep = up ? v[17] : v[16];
    float r = keep + __shfl_xor(send, 32);
#pragma unroll
    for (int o = 16; o >= 1; o >>= 1) r += __shfl_xor(r, o);
    return r;
}
__device__ __forceinline__ void route_phase(const float* X, const float* WR, const float* bg, const float* be, float* RS, int* assign_e, int* assign_pos, float* gate, int* gcnt, LAS unsigned char* lds) {
    int tid_ = threadIdx.x; asm volatile("" : "+v"(tid_)); const int tid = tid_, lane = tid & 63, wv = tid >> 6;
    LAS float* Wr = (LAS float*)lds;
    LAS int* lcnt = (LAS int*)(lds + 36 * 4096); LAS int* lbase = lcnt + 32; LAS int* l_e = lbase + 32; LAS int* l_rank = l_e + 256;
    LAS float* lg = (LAS float*)(lds + 36 * 4096 + 2304) + wv * (8 * 37);
    for (int i = tid; i < 36 * 256; i += 512) ((LAS f32x4*)Wr)[i] = ((const f32x4*)WR)[i];
    for (int tb = blockIdx.x; tb < T / 128; tb += gridDim.x) {
        if (tid < 32) lcnt[tid] = 0;
        __syncthreads();
#pragma unroll 1
        for (int hf = 0; hf < 2; ++hf) {
#pragma unroll 1
            for (int it = 0; it < 4; ++it) {
                const int tl0 = wv * 16 + hf * 8 + it * 2, t0 = tb * 128 + tl0;
                f32x4 xv[2][4]; float rsv[2];
#pragma unroll
                for (int r = 0; r < 2; ++r) { float s = 0.f;
#pragma unroll
                    for (int c = 0; c < 4; ++c) { xv[r][c] = *(const f32x4*)(X + (size_t)(t0 + r) * D + 256 * c + 4 * lane); s += (xv[r][c][0] * xv[r][c][0] + xv[r][c][1] * xv[r][c][1]) + (xv[r][c][2] * xv[r][c][2] + xv[r][c][3] * xv[r][c][3]); }
                    rsv[r] = rsqrtf(wave_sum(s) * (1.0f / D) + EPS); }
                float acc[2][36];
#pragma unroll
                for (int r = 0; r < 2; ++r)
#pragma unroll
                    for (int j = 0; j < 36; ++j) acc[r][j] = 0.f;
                unsigned b0_ = (unsigned)(16 * lane), b1_ = (unsigned)(16 * 4096 + 16 * lane), b2_ = (unsigned)(32 * 4096 + 16 * lane);
                asm volatile("" : "+v"(b0_)); asm volatile("" : "+v"(b1_)); asm volatile("" : "+v"(b2_));
#pragma unroll
                for (int j = 0; j < 36; ++j) {
#pragma unroll
                    for (int c = 0; c < 4; ++c) {
                        const f32x4 w4 = j < 16 ? *(const LAS f32x4*)(lds + b0_ + j * 4096 + c * 1024) : (j < 32 ? *(const LAS f32x4*)(lds + b1_ + (j - 16) * 4096 + c * 1024) : *(const LAS f32x4*)(lds + b2_ + (j - 32) * 4096 + c * 1024));
#pragma unroll
                        for (int r = 0; r < 2; ++r) acc[r][j] = fmaf(xv[r][c][3], w4[3], fmaf(xv[r][c][2], w4[2], fmaf(xv[r][c][1], w4[1], fmaf(xv[r][c][0], w4[0], acc[r][j])))); }
                    if (j % 3 == 2) __builtin_amdgcn_sched_barrier(0);
                }
#pragma unroll
                for (int st = 0; st < 5; ++st) { const int half = 16 >> st, bit = 32 >> st; const bool up = (lane & bit) != 0;
#pragma unroll
                    for (int r = 0; r < 2; ++r)
#pragma unroll
                        for (int k = 0; k < half; ++k) { const float send = up ? acc[r][k] : acc[r][k + half]; const float keep = up ? acc[r][k + half] : acc[r][k]; acc[r][k] = keep + __shfl_xor(send, bit); } }
#pragma unroll
                for (int st = 0; st < 2; ++st) { const int half = 2 >> st, bit = 32 >> st; const bool up = (lane & bit) != 0;
#pragma unroll
                    for (int r = 0; r < 2; ++r)
#pragma unroll
                        for (int k = 0; k < half; ++k) { const float send = up ? acc[r][32 + k] : acc[r][32 + k + half]; const float keep = up ? acc[r][32 + k + half] : acc[r][32 + k]; acc[r][32 + k] = keep + __shfl_xor(send, bit); } }
#pragma unroll
                for (int r = 0; r < 2; ++r) {
                    float e = acc[r][0]; e += __shfl_xor(e, 1);
                    float g = acc[r][32]; g += __shfl_xor(g, 8); g += __shfl_xor(g, 4); g += __shfl_xor(g, 2); g += __shfl_xor(g, 1);
                    LAS float* L = lg + (it * 2 + r) * 37;
                    if ((lane & 1) == 0) L[lane >> 1] = e;
                    if ((lane & 15) == 0) L[32 + (lane >> 4)] = g;
                    if (lane == 0) L[36] = rsv[r];
                }
            }
            asm volatile("s_waitcnt lgkmcnt(0)" ::: "memory");
            {
                const int r = lane & 7; const LAS float* L = lg + r * 37;
                const float rs = L[36];
                float gl[4];
#pragma unroll
                for (int g = 0; g < 4; ++g) gl[g] = L[32 + g] * rs + bg[g];
                int gs = 0; float gm = gl[0];
#pragma unroll
                for (int g = 1; g < 4; ++g) if (gl[g] > gm) { gm = gl[g]; gs = g; }
                float se = 0.f;
#pragma unroll
                for (int g = 0; g < 4; ++g) se += expf(gl[g] - gm);
                const float pg = 1.0f / se;
                float el[8];
#pragma unroll
                for (int i = 0; i < 8; ++i) el[i] = L[gs * 8 + i] * rs + be[gs * 8 + i];
                float em = el[0];
#pragma unroll
                for (int i = 1; i < 8; ++i) em = fmaxf(em, el[i]);
                float pe[8], ps = 0.f;
#pragma unroll
                for (int i = 0; i < 8; ++i) { pe[i] = expf(el[i] - em); ps += pe[i]; }
#pragma unroll
                for (int i = 0; i < 8; ++i) pe[i] = pe[i] / ps;
                int i1 = 0; float p1 = pe[0];
#pragma unroll
                for (int i = 1; i < 8; ++i) if (pe[i] > p1) { p1 = pe[i]; i1 = i; }
                int i2 = -1; float p2 = -1.f;
#pragma unroll
                for (int i = 0; i < 8; ++i) if (i != i1 && pe[i] > p2) { p2 = pe[i]; i2 = i; }
                if (lane < 8) {
                    if (i2 < 0) i2 = i1 == 0 ? 1 : 0;
                    const int tl = wv * 16 + hf * 8 + r, t = tb * 128 + tl; const float den = p1 + p2; const int e1 = gs * 8 + i1, e2 = gs * 8 + i2;
                    RS[t] = rs; gate[2 * t] = pg * p1 / den; gate[2 * t + 1] = pg * p2 / den;
                    l_e[2 * tl] = e1; l_e[2 * tl + 1] = e2;
                    l_rank[2 * tl] = atomicAdd((int*)(lcnt + e1), 1); l_rank[2 * tl + 1] = atomicAdd((int*)(lcnt + e2), 1);
                }
            }
            asm volatile("s_waitcnt lgkmcnt(0)" ::: "memory");
        }
        __syncthreads();
        if (tid < 32) lbase[tid] = __hip_atomic_fetch_add(gcnt + tid, lcnt[tid], __ATOMIC_RELAXED, __HIP_MEMORY_SCOPE_AGENT);
        __syncthreads();
        if (tid < 256) { const int a = tb * 256 + tid, e = l_e[tid]; assign_e[a] = e; assign_pos[a] = lbase[e] + l_rank[tid]; }
        __syncthreads();
    }
}
__device__ __forceinline__ void build_phase(const int* gcnt, const int* assign_e, const int* assign_pos, const float* gate, const float* RS,
                                            int* ntiles, int* tile_e, int* slot_tok, int* slot_a, float* slot_rs, float* slot_gate, LAS unsigned char* lds) {
    const int tix = otid();
    LAS int* poff = (LAS int*)lds; LAS int* cn = poff + 40;
    if (tix == 0) { int o = 0; for (int e = 0; e < 32; ++e) { const int cc = g8::ld_agent(gcnt + e); cn[e] = cc; poff[e] = o; o += (cc + 255) / 256 * 256; } poff[32] = o; }
    __syncthreads();
    const int gi = blockIdx.x * blockDim.x + tix, gs = gridDim.x * blockDim.x;
    for (int a = gi; a < NA; a += gs) { const int e = assign_e[a]; const int sl = poff[e] + assign_pos[a]; slot_tok[sl] = a >> 1; slot_a[sl] = a; slot_rs[sl] = RS[a >> 1]; slot_gate[sl] = gate[a]; }
    for (int i = gi; i < 32 * 256; i += gs) { const int e = i >> 8, sl = poff[e] + cn[e] + (i & 255); if (sl < poff[e + 1]) { slot_tok[sl] = 0; slot_a[sl] = -1; slot_rs[sl] = 0.f; slot_gate[sl] = 0.f; } }
    if (blockIdx.x == 0) {
        const int NT = poff[32] >> 8;
        for (int rt = tix; rt < NT; rt += blockDim.x) { int e = 0; for (int k = 0; k < 32; ++k) if (rt * 256 >= poff[k] && rt * 256 < poff[k + 1]) e = k; tile_e[rt] = e; }
        if (tix == 0) *ntiles = NT;
    }
    __syncthreads();
}
__device__ __forceinline__ CvtJob moe_job(const float* wgate, const float* wup, const float* wdown, const float* gain, bf16_t* W1, bf16_t* W2, int it, int& item) {
    const int e = it / 768, r = it - e * 768;
    if (r < 256) { item = r; return CvtJob{wgate + (size_t)e * D * DE, DE, 0, D, gain, W1 + (size_t)e * D * D, 1, 0, 16}; }
    if (r < 512) { item = r - 256; return CvtJob{wup + (size_t)e * D * DE, DE, 0, D, gain, W1 + (size_t)e * D * D, 1, 1, 16}; }
    item = r - 512; return CvtJob{wdown + (size_t)e * DE * D, D, 0, DE, nullptr, W2 + (size_t)e * D * DE, 0, 0, 32};
}
__device__ __forceinline__ void cvt_moe(const float* wgate, const float* wup, const float* wdown, const float* gain, bf16_t* W1, bf16_t* W2, LAS unsigned char* lds) {
    const int tix = otid();
    const int lane = tix & 63, wv = tix >> 6;
    LAS float* scr = (LAS float*)(lds + 1024 + wv * 8704);
    const int gw = blockIdx.x * 8 + wv, ngw = gridDim.x * 8;
    f32x4 cur[8], nxt[8]; int item = 0, itemn = 0;
    int it = gw; CvtJob j = moe_job(wgate, wup, wdown, gain, W1, W2, it < 32 * 768 ? it : 0, item);
    if (it < 32 * 768) cvt_load(j, item, lane, cur);
    for (; it < 32 * 768; it += ngw) {
        const int itn = it + ngw; CvtJob jn = j;
        if (itn < 32 * 768) { jn = moe_job(wgate, wup, wdown, gain, W1, W2, itn, itemn); cvt_load(jn, itemn, lane, nxt); }
        cvt_store(j, item, lane, scr, cur);
        j = jn; item = itemn;
#pragma unroll
        for (int i = 0; i < 8; ++i) cur[i] = nxt[i];
    }
}
__device__ __forceinline__ void combine_phase(float* X, float* Xo, const bf16_t* Y, bf16_t* XB, float* RS, float* ssp, const float* gfinal, int fin, const float* WA, float* ALR, LAS unsigned char* lds) {
    const int tix = otid();
    const int lane = tix & 63;
    if (WA) { for (int i = tix; i < 16 * 256; i += 512) ((LAS f32x4*)lds)[i] = ((const f32x4*)WA)[i]; __syncthreads(); }
    const int gw = (blockIdx.x * blockDim.x + tix) >> 6, ngw = (gridDim.x * blockDim.x) >> 6;
    for (int t = gw; t < T; t += ngw) {
        f32x4 v[4]; float s = 0.f;
#pragma unroll
        for (int j = 0; j < 4; ++j) {
            v[j] = ((const f32x4*)(X + (size_t)t * D))[lane + 64 * j];
            const u32x2 y0 = ((const u32x2*)(Y + (size_t)(2 * t) * D))[lane + 64 * j], y1 = ((const u32x2*)(Y + (size_t)(2 * t + 1) * D))[lane + 64 * j];
            v[j][0] += bf_lo(y0.x) + bf_lo(y1.x); v[j][1] += bf_hi(y0.x) + bf_hi(y1.x); v[j][2] += bf_lo(y0.y) + bf_lo(y1.y); v[j][3] += bf_hi(y0.y) + bf_hi(y1.y);
            s += (v[j][0] * v[j][0] + v[j][1] * v[j][1]) + (v[j][2] * v[j][2] + v[j][3] * v[j][3]); }
        s = wave_sum(s); const float rs = rsqrtf(s * (1.0f / D) + EPS);
        if (fin) {
#pragma unroll
            for (int j = 0; j < 4; ++j) { const f32x4 gg = ((const f32x4*)gfinal)[lane + 64 * j]; ((f32x4*)(Xo + (size_t)t * D))[lane + 64 * j] = v[j] * rs * gg; }
        } else {
            if (lane == 0) RS[t] = rs;
            if (lane < 16) ssp[(size_t)t * 16 + lane] = lane == 0 ? s : 0.f;
            if (WA) {
                float a16[18];
#pragma unroll
                for (int o = 0; o < 16; ++o) { float p = 0.f;
#pragma unroll
                    for (int j = 0; j < 4; ++j) { const f32x4 w4 = *(const LAS f32x4*)(lds + (o * 1024 + 256 * j + 4 * lane) * 4);
                        p = fmaf(v[j][3], w4[3], fmaf(v[j][2], w4[2], fmaf(v[j][1], w4[1], fmaf(v[j][0], w4[0], p)))); }
                    a16[o] = p; if ((o & 3) == 3) __builtin_amdgcn_sched_barrier(0); }
                a16[16] = 0.f; a16[17] = 0.f;
                const float red = reduce16(a16, lane);
                if ((lane & 3) == 0) ALR[(size_t)t * 16 + (lane >> 2)] = red * rs;
            }
#pragma unroll
            for (int j = 0; j < 4; ++j) { ((f32x4*)(Xo + (size_t)t * D))[lane + 64 * j] = v[j];
                u32x2 w; w.x = cvt_pk_bf16(v[j][0], v[j][1]); w.y = cvt_pk_bf16(v[j][2], v[j][3]); ((u32x2*)(XB + (size_t)t * D))[lane + 64 * j] = w; }
        }
    }
}

__device__ __forceinline__ void gla_prep(const float* win, const float* wo, const float* gain, bf16_t* WGTM, bf16_t* WGFM, bf16_t* WGO, float* WA, LAS unsigned char* lds) {
    cvt_matrix(win, GLA_COLS, 0, 512, D, gain, WGTM, 0, 0, lds);
    cvt_matrix(win, GLA_COLS, 512, 512, D, gain, WGTM + (size_t)512 * D, 0, 0, lds, 256);
    cvt_matrix(win, GLA_COLS, 2064, 1024, D, gain, WGTM + (size_t)1024 * D, 0, 0, lds, 512);
    cvt_matrix(win, GLA_COLS, 512, 512, D, gain, WGFM, 0, 0, lds, 1024);
    cvt_matrix(win, GLA_COLS, 1024, 1024, D, gain, WGFM + (size_t)512 * D, 0, 0, lds, 1280);
    cvt_matrix(wo, D, 0, D, D, nullptr, WGO, 0, 0, lds, 1792);
    const int tix = otid(); const int gi = blockIdx.x * blockDim.x + tix, gs = gridDim.x * blockDim.x;
    for (int i = gi; i < 16 * 1024; i += gs) { const int j = i >> 10, k = i & 1023; WA[i] = win[(size_t)k * GLA_COLS + 2048 + j] * gain[k]; }
}
__device__ __forceinline__ void gla_decay(const float* ALR, const float* wa2, const float* ba, float* BTM, float* BFM, float* DL) {
    const int tix = otid(); const int gi = blockIdx.x * blockDim.x + tix, gs = gridDim.x * blockDim.x;
    for (int it = gi; it < 128 * 512; it += gs) {
        const int ch = it >> 9, kf = it & 511, t0 = ch * 256;
        float w[16];
#pragma unroll
        for (int r = 0; r < 16; ++r) w[r] = wa2[r * GDK + kf];
        const float bias = ba[kf]; float b = 0.f;
#pragma unroll 1
        for (int s16 = 0; s16 < 16; ++s16) {
            float ring[16];
#pragma unroll
            for (int q = 0; q < 16; ++q) {
                const int t = t0 + s16 * 16 + q;
                const f32x4 a0 = *(const f32x4*)(ALR + (size_t)t * 16), a1 = *(const f32x4*)(ALR + (size_t)t * 16 + 4), a2 = *(const f32x4*)(ALR + (size_t)t * 16 + 8), a3 = *(const f32x4*)(ALR + (size_t)t * 16 + 12);
                float z = bias;
#pragma unroll
                for (int r = 0; r < 4; ++r) { z = fmaf(a0[r], w[r], z); z = fmaf(a1[r], w[4 + r], z); z = fmaf(a2[r], w[8 + r], z); z = fmaf(a3[r], w[12 + r], z); }
                const float ls = fminf(z, 0.f) - log1pf(expf(-fabsf(z)));
                b += ls * (1.0f / 16.0f);
                BTM[(size_t)t * 512 + kf] = b; ring[q] = b;
            }
            f32x4* o = (f32x4*)(BFM + (size_t)kf * T + t0 + s16 * 16);
#pragma unroll
            for (int q = 0; q < 4; ++q) o[q] = (f32x4){ring[4 * q], ring[4 * q + 1], ring[4 * q + 2], ring[4 * q + 3]};
        }
        DL[(size_t)ch * 512 + kf] = expf(b);
    }
}
__device__ __forceinline__ void gla_scan(const bf16_t* UT, const float* DL, bf16_t* SP) {
    const int tix = otid(); const int gi = blockIdx.x * blockDim.x + tix, gs = gridDim.x * blockDim.x;
    for (int it = gi; it < 16 * 32768 / 2; it += gs) {
        const int bh = it >> 14, idx = (it & 16383) * 2, k = idx & 127, b = bh >> 2, h = bh & 3;
        float s0 = 0.f, s1 = 0.f;
        for (int c = 0; c < 32; ++c) {
            const size_t off = (size_t)(bh * 32 + c) * 32768 + idx;
            const unsigned uu = *(const unsigned*)(UT + off);
            *(unsigned*)(SP + off) = cvt_pk_bf16(s0, s1);
            const f32x2 d = *(const f32x2*)(DL + (size_t)(b * 32 + c) * 512 + h * 128 + k);
            s0 = fmaf(d[0], s0, bf_lo(uu)); s1 = fmaf(d[1], s1, bf_hi(uu));
        }
    }
}
__device__ __forceinline__ void gla_fin(const bf16_t* O, const bf16_t* QKR, const float* ng, bf16_t* GO) {
    const int tix = otid(); const int lane = tix & 63;
    const int gw = (blockIdx.x * blockDim.x + tix) >> 6, ngw = (gridDim.x * blockDim.x) >> 6;
    const f32x4 gg = ((const f32x4*)ng)[lane];
    for (int t = gw; t < T; t += ngw) {
#pragma unroll
        for (int j = 0; j < 4; ++j) {
            const u32x2 ow = ((const u32x2*)(O + (size_t)t * D))[lane + 64 * j], rw = ((const u32x2*)(QKR + (size_t)t * 2048 + 1024))[lane + 64 * j];
            const f32x4 o = (f32x4){bf_lo(ow.x), bf_hi(ow.x), bf_lo(ow.y), bf_hi(ow.y)}, r = (f32x4){bf_lo(rw.x), bf_hi(rw.x), bf_lo(rw.y), bf_hi(rw.y)};
            const float ss = wave_sum((o[0] * o[0] + o[1] * o[1]) + (o[2] * o[2] + o[3] * o[3]));
            const float rs = rsqrtf(ss * (1.0f / GDVH) + EPS);
            f32x4 y;
#pragma unroll
            for (int q = 0; q < 4; ++q) y[q] = o[q] * rs * gg[q] * (r[q] * fast_sigmoid(r[q]));
            u32x2 w; w.x = cvt_pk_bf16(y[0], y[1]); w.y = cvt_pk_bf16(y[2], y[3]);
            ((u32x2*)(GO + (size_t)t * D))[lane + 64 * j] = w;
        }
    }
}

__device__ __forceinline__ void csum_phase(const unsigned char* base, size_t bytes, unsigned long long* ref, unsigned* flag, int compare, LAS unsigned char* lds) {
    const int tix = otid(); const size_t n16 = bytes / 16, per = (n16 + gridDim.x - 1) / gridDim.x;
    const size_t lo = (size_t)blockIdx.x * per, hi = lo + per < n16 ? lo + per : n16;
    unsigned long long s = 0;
    for (size_t i = lo + tix; i < hi; i += 512) { const u32x4 v = ((const u32x4*)base)[i]; s += (unsigned long long)v.x + ((unsigned long long)v.y << 8) + ((unsigned long long)v.z << 16) + ((unsigned long long)v.w << 24); }
    for (int o = 1; o < 64; o <<= 1) s += __shfl_xor(s, o);
    LAS unsigned long long* red = (LAS unsigned long long*)lds;
    if ((tix & 63) == 0) red[tix >> 6] = s;
    __syncthreads();
    if (tix == 0) { unsigned long long t = 0; for (int q = 0; q < 8; ++q) t += red[q];
        if (!compare) ref[blockIdx.x] = t; else if (ref[blockIdx.x] != t) *flag = 1u; }
    __syncthreads();
}
__device__ __forceinline__ void flagout_phase(float* out, unsigned* flags) {
    const int tix = otid(); int k = -1;
    for (int r = 31; r >= 0; --r) if (__hip_atomic_load(flags + r, __ATOMIC_RELAXED, __HIP_MEMORY_SCOPE_AGENT)) k = r;
    if (k < 0) return;
    const float sc = 1.0f + 0.25f * (float)(k + 1);
    const size_t gi = (size_t)blockIdx.x * 512 + tix, gs = (size_t)gridDim.x * 512;
    for (size_t i = gi; i < (size_t)T * D; i += gs) out[i] *= sc;
}

__device__ __forceinline__ void csum2_phase(const unsigned char* base, size_t bytes, unsigned long long* store, unsigned* flag, LAS unsigned char* lds) {
    const int tix = otid(); const size_t n16 = bytes / 16, per = (n16 + gridDim.x - 1) / gridDim.x;
    const size_t lo = (size_t)blockIdx.x * per, hi = lo + per < n16 ? lo + per : n16;
    unsigned long long s = 0;
    for (size_t i = lo + tix; i < hi; i += 512) { const u32x4 v = ((const u32x4*)base)[i]; s += (unsigned long long)v.x + ((unsigned long long)v.y << 8) + ((unsigned long long)v.z << 16) + ((unsigned long long)v.w << 24); }
    for (int o = 1; o < 64; o <<= 1) s += __shfl_xor(s, o);
    LAS unsigned long long* red = (LAS unsigned long long*)lds;
    if ((tix & 63) == 0) red[tix >> 6] = s;
    __syncthreads();
    if (tix == 0) { unsigned long long t = 0; for (int q = 0; q < 8; ++q) t += red[q];
        unsigned long long* st = store + 2 * blockIdx.x;
        if (st[1] == 0x600DF00D600DF00Dull && st[0] != t) *flag = 1u;
        st[0] = t; st[1] = 0x600DF00D600DF00Dull; }
    __syncthreads();
}

__device__ __forceinline__ void conv_phase(const bf16_t* U, const float* wdw, const float* bdw, const float* lng, const float* lnb, bf16_t* CV, LAS unsigned char* lds) {
    int tid_ = threadIdx.x; asm volatile("" : "+v"(tid_));
    const int tid = tid_, lane = tid & 63, wv = tid >> 6, c0 = 2 * tid;
    LAS float* red = (LAS float*)lds; LAS float* tot = red + 512;
    f32x2 w[CONVK];
#pragma unroll
    for (int j = 0; j < CONVK; ++j) w[j] = *(const f32x2*)(wdw + j * D + c0);
    const f32x2 bd = *(const f32x2*)(bdw + c0), lg = *(const f32x2*)(lng + c0), lb = *(const f32x2*)(lnb + c0);
    for (int item = blockIdx.x; item < T / 32; item += gridDim.x) {
        const int t0 = item * 32, s0 = t0 & (S - 1);
        f32x2 acc[32];
#pragma unroll
        for (int o = 0; o < 32; ++o) acc[o] = bd;
#pragma unroll
        for (int r = 0; r < 62; ++r) {
            unsigned raw = 0u;
            if (s0 - 30 + r >= 0) raw = *(const unsigned*)(U + (size_t)(t0 - 30 + r) * D + c0);
            const f32x2 uv = (f32x2){bf_lo(raw), bf_hi(raw)};
#pragma unroll
            for (int o = (r > 30 ? r - 30 : 0); o <= (r < 31 ? r : 31); ++o) acc[o] = __builtin_elementwise_fma(uv, w[r - o], acc[o]);
        }
        float v[64];
#pragma unroll
        for (int o = 0; o < 32; ++o) { v[o] = acc[o][0] + acc[o][1]; v[32 + o] = acc[o][0] * acc[o][0] + acc[o][1] * acc[o][1]; }
#pragma unroll
        for (int st = 0; st < 6; ++st) {
            const int half = 32 >> st, bit = 32 >> st; const bool up = (lane & bit) != 0;
#pragma unroll
            for (int k = 0; k < half; ++k) { const float send = up ? v[k] : v[k + half]; const float keep = up ? v[k + half] : v[k]; v[k] = keep + __shfl_xor(send, bit); }
        }
        red[wv * 64 + lane] = v[0];
        __syncthreads();
        if (tid < 64) { float s = 0.f;
#pragma unroll
            for (int q = 0; q < 8; ++q) s += red[q * 64 + tid];
            tot[tid] = s; }
        __syncthreads();
#pragma unroll
        for (int o = 0; o < 32; ++o) {
            const float mu = tot[o] * (1.0f / D), var = tot[32 + o] * (1.0f / D) - mu * mu, rstd = rsqrtf(var + EPS);
            const float y0 = (acc[o][0] - mu) * rstd * lg[0] + lb[0], y1 = (acc[o][1] - mu) * rstd * lg[1] + lb[1];
            *(unsigned*)(CV + (size_t)(t0 + o) * D + c0) = cvt_pk_bf16(y0 * fast_sigmoid(y0), y1 * fast_sigmoid(y1));
        }
        __syncthreads();
    }
}

enum Ph { PH_PREP0 = 0, PH_CONV_IN, PH_CONV_MID, PH_CONV_OUT, PH_ADAPT, PH_XA_PREP, PH_XA_Q, PH_XA_KV, PH_XA_S, PH_XA_PV, PH_XA_O, PH_ROUTE_PREP, PH_ROUTE, PH_BUILD, PH_MOE1, PH_MOE2, PH_COMBINE, PH_COMBINE_FIN, PH_GLA_PREP, PH_GLA_DECAY, PH_GLA_IN, PH_GLA_ATT, PH_GLA_UT, PH_GLA_SCAN, PH_GLA_O, PH_GLA_FIN, PH_GLA_OUT, PH_NOP, PH_CSUM, PH_FLAGOUT, PH_CSUM2, PH_XA_S_DIAG, PH_XA_O_T, PH_COMBINE_T, PH_ROUTE_T, PH_PREP_ALL, PH_N };

__device__ __forceinline__ void run_phase(const Ctx& c, int ph, int l, LAS unsigned char* lds) {
    unsigned char* ws = c.ws;
    bf16_t* XB = (bf16_t*)(ws + OW_XB); float* RS = (float*)(ws + OW_RS); float* SSP = (float*)(ws + OW_SSP);
    bf16_t* ACTA = (bf16_t*)(ws + OW_ACTA); bf16_t* ACTB = (bf16_t*)(ws + OW_ACTB);
    bf16_t* WCIN = (bf16_t*)(ws + OW_WCIN); bf16_t* WCOUT = (bf16_t*)(ws + OW_WCOUT);
    bf16_t* ACTC = (bf16_t*)(ws + OW_ACTC); float* PSUM = (float*)(ws + OW_PSUM);
    bf16_t* WXQ = (bf16_t*)(ws + OW_WXQ) + (size_t)l * D * D; bf16_t* WXKV = (bf16_t*)(ws + OW_WXKV) + (size_t)l * 2048 * D; bf16_t* WXO = (bf16_t*)(ws + OW_WXO) + (size_t)l * D * D;
    float* WR = (float*)(ws + OW_WR) + (size_t)l * 36 * 1024;
    int* GCNT = (int*)(ws + OM_GCNT) + l * 32; int* NTP = (int*)(ws + OM_NT); int* TILEE = (int*)(ws + OM_TILEE); int* AE = (int*)(ws + OM_AE); int* APOS = (int*)(ws + OM_APOS); float* GATE = (float*)(ws + OM_GATE);
    int* STOK = (int*)(ws + OM_STOK); int* SA = (int*)(ws + OM_SA); float* SRS = (float*)(ws + OM_SRS); float* SGATE = (float*)(ws + OM_SGATE);
    bf16_t* HB = (bf16_t*)(ws + OW_H); bf16_t* YB = (bf16_t*)(ws + OW_Y); bf16_t* W1 = (bf16_t*)(ws + OW_WMOE); bf16_t* W2 = W1 + (size_t)NE * D * D;
    bf16_t* ATTB = (bf16_t*)(ws + OW_ATT); bf16_t* QKR = (bf16_t*)(ws + OW_QKR); bf16_t* KVT = (bf16_t*)(ws + OW_KVT); float* BTM = (float*)(ws + OW_BTM); float* BFM = (float*)(ws + OW_BFM);
    bf16_t* OB = (bf16_t*)(ws + OW_O); bf16_t* UTB = (bf16_t*)(ws + OW_UT); bf16_t* SPB = (bf16_t*)(ws + OW_SP); float* ALR = (float*)(ws + OW_ALR); float* DLF = (float*)(ws + OW_DL); bf16_t* GOB = (bf16_t*)(ws + OW_GO);
    bf16_t* WGTM = (bf16_t*)(ws + OW_WGTM); bf16_t* WGFM = (bf16_t*)(ws + OW_WGFM); bf16_t* WGO = (bf16_t*)(ws + OW_WGO); float* WAF = (float*)(ws + OW_WA);
    bf16_t* KB = (bf16_t*)(ws + OW_KVB); bf16_t* VT = KB + (size_t)1024 * 1024; bf16_t* MEMNB = (bf16_t*)(ws + OW_MEMNB);
    switch (ph) {
    case PH_PREP0:
        cvt_matrix(c.in[7], 2048, 0, 1024, D, c.in[2], WCIN, 1, 0, lds);
        cvt_matrix(c.in[7], 2048, 1024, 1024, D, c.in[2], WCIN, 1, 1, lds, 512);
        cvt_matrix(c.in[13], D, 0, D, D, nullptr, WCOUT, 0, 0, lds, 1024);
        rows_prep(c.in[0], XB, RS, nullptr, T);
        { const int tix = otid(); if (blockIdx.x == 0 && tix < 32) ((unsigned*)(ws + OW_DBG))[tix] = 0u; }
        break;
    case PH_PREP_ALL: {
        cvt_matrix(c.in[7], 2048, 0, 1024, D, c.in[2], WCIN, 1, 0, lds);
        cvt_matrix(c.in[7], 2048, 1024, 1024, D, c.in[2], WCIN, 1, 1, lds, 512);
        cvt_matrix(c.in[13], D, 0, D, D, nullptr, WCOUT, 0, 0, lds, 1024);
        for (int ll = 0; ll < 2; ++ll) {
            cvt_matrix(c.in[20] + (size_t)ll * D * D, D, 0, D, D, c.in[3] + ll * D, (bf16_t*)(ws + OW_WXQ) + (size_t)ll * D * D, 0, 0, lds, 1536 + 1024 * ll);
            cvt_matrix(c.in[21] + (size_t)ll * D * 2048, 2048, 0, 2048, D, nullptr, (bf16_t*)(ws + OW_WXKV) + (size_t)ll * 2048 * D, 0, 0, lds, 0 + 1024 * ll);
            cvt_matrix(c.in[22] + (size_t)ll * D * D, D, 0, D, D, nullptr, (bf16_t*)(ws + OW_WXO) + (size_t)ll * D * D, 0, 0, lds, 1024 + 512 * ll);
            route_prep(c.in[23] + (size_t)ll * D * NG, c.in[25] + (size_t)ll * D * NE, c.in[4] + ll * D, (float*)(ws + OW_WR) + (size_t)ll * 36 * 1024);
        }
        gla_prep(c.in[15], c.in[19], c.in[2] + D, WGTM, WGFM, WGO, WAF, lds);
        rows_norm_bf16(c.in[1], c.in[5], MEMNB, NB * NMEM);
        rows_prep(c.in[0], XB, RS, nullptr, T);
        { const int tix = otid(); if (blockIdx.x == 0 && tix < 64) ((int*)(ws + OM_GCNT))[tix] = 0; }
        } break;
    case PH_CONV_IN: { g8::DenseSched S{8, 128 * 8, D, D, D, XB, WCIN}; g8::gemm_phase(lds, S, g8::EpiGlu{ACTA, RS, c.in[8]}); } break;
    case PH_CONV_MID: conv_phase(ACTA, c.in[9], c.in[10], c.in[11], c.in[12], ACTB, lds); break;
    case PH_CONV_OUT: { g8::DenseSched S{4, 128 * 4, D, D, D, ACTB, WCOUT}; g8::gemm_phase(lds, S, g8::EpiXres{c.in[0], c.out, XB, c.in[14], SSP}); } break;
    case PH_ADAPT: rows_prep(c.out, XB, RS, SSP, T); break;
    case PH_XA_PREP:
        cvt_matrix(c.in[20] + (size_t)l * D * D, D, 0, D, D, c.in[3] + l * D, WXQ, 0, 0, lds);
        cvt_matrix(c.in[21] + (size_t)l * D * 2048, 2048, 0, 2048, D, nullptr, WXKV, 0, 0, lds, 512);
        cvt_matrix(c.in[22] + (size_t)l * D * D, D, 0, D, D, nullptr, WXO, 0, 0, lds, 1536);
        rows_norm_bf16(c.in[1], c.in[5], MEMNB, NB * NMEM);
        break;
    case PH_XA_Q: { g8::DenseSched S{4, 128 * 4, D, D, D, XB, WXQ}; g8::gemm_phase(lds, S, g8::EpiRowScale{ACTA, D, SSP, nullptr, 0.0625f, 0, 1.0f}); } break;
    case PH_XA_KV: { g8::KVSched S{D, D, D, MEMNB, WXKV}; g8::gemm_phase(lds, S, g8::EpiKV{KB, VT}); }
        cvt_moe(c.in[27] + (size_t)l * NE * D * DE, c.in[28] + (size_t)l * NE * D * DE, c.in[29] + (size_t)l * NE * DE * D, c.in[4] + l * D, W1, W2, lds);
        break;
    case PH_XA_S: { g8::AttnSched S{256, D, D, ACTA, KB, 0}; g8::gemm_phase(lds, S, g8::EpiS{ACTB, PSUM}); } break;
    case PH_XA_S_DIAG: { g8::AttnSched S{256, D, D, ACTA, KB, 0}; g8::gemm_phase(lds, S, g8::EpiRaw{ACTC}); } break;
    case PH_XA_PV: { g8::AttnSched S{256, D, 256, ACTB, VT, 1}; g8::gemm_phase(lds, S, g8::EpiPV{ACTC, PSUM}); } break;
    case PH_XA_O: { g8::DenseSched S{4, 128 * 4, D, D, D, ACTC, WXO}; g8::gemm_phase(lds, S, g8::EpiXres{c.out, c.out, XB, nullptr, nullptr}); } break;
    case PH_ROUTE_PREP: route_prep(c.in[23] + (size_t)l * D * NG, c.in[25] + (size_t)l * D * NE, c.in[4] + l * D, WR);
        { const int tix = otid(); if (blockIdx.x == 0 && tix < 32) GCNT[tix] = 0; }
        break;
    case PH_ROUTE: route_phase(c.out, WR, c.in[24] + l * NG, c.in[26] + l * NE, RS, AE, APOS, GATE, GCNT, lds); break;
    case PH_BUILD: build_phase(GCNT, AE, APOS, GATE, RS, NTP, TILEE, STOK, SA, SRS, SGATE, lds); break;
    case PH_MOE1: { g8::MoeSched S{D, D, D, XB, W1, (size_t)D * D, TILEE, STOK, __builtin_amdgcn_readfirstlane(g8::ld_agent(NTP))}; g8::gemm_phase(lds, S, g8::EpiMoe1{HB, SRS}); } break;
    case PH_MOE2: { g8::MoeSched S{DE, DE, DE, HB, W2, (size_t)D * DE, TILEE, nullptr, __builtin_amdgcn_readfirstlane(g8::ld_agent(NTP))}; g8::gemm_phase(lds, S, g8::EpiMoe2{YB, SA, SGATE}); } break;
    case PH_COMBINE: combine_phase(c.out, c.out, YB, XB, RS, SSP, nullptr, 0, WAF, ALR, lds); break;
    case PH_COMBINE_FIN: combine_phase(c.out, c.out, YB, XB, RS, SSP, c.in[6], 1, nullptr, nullptr, lds); break;
    case PH_GLA_PREP: gla_prep(c.in[15], c.in[19], c.in[2] + D, WGTM, WGFM, WGO, WAF, lds); break;
    case PH_GLA_DECAY: gla_decay(ALR, c.in[16], c.in[17], BTM, BFM, DLF); break;
    case PH_GLA_IN: { g8::GlaInSched S{XB, WGTM, WGFM}; g8::gemm_phase(lds, S, g8::EpiGlaIn{QKR, KVT, RS, BTM, BFM}); } break;
    case PH_GLA_ATT: { g8::GlaAttSched<0> S{QKR, KVT}; g8::gemm_phase(lds, S, g8::EpiGlaAtt<0>{ATTB, UTB, DLF}); }
        { g8::GlaAttSched<1> S{QKR, KVT}; g8::gemm_phase(lds, S, g8::EpiGlaAtt<1>{ATTB, UTB, DLF}); } break;
    case PH_GLA_UT: { g8::GlaAttSched<1> S{QKR, KVT}; g8::gemm_phase(lds, S, g8::EpiGlaAtt<1>{ATTB, UTB, DLF}); } break;
    case PH_GLA_SCAN: gla_scan(UTB, DLF, SPB); break;
    case PH_GLA_O: { g8::GlaOSched S{QKR, KVT, ATTB, SPB}; g8::gemm_phase(lds, S, g8::EpiGlaO{OB}); } break;
    case PH_GLA_FIN: gla_fin(OB, QKR, c.in[18], GOB); break;
    case PH_CSUM: { static const size_t ro[10] = {OW_ACTA, OW_ACTB, OW_ACTC, OW_H, OW_Y, OW_QKR, OW_ATT, OW_UT, OW_O, OW_KVB};
        static const size_t rb[10] = {64 * MiB, 64 * MiB, 64 * MiB, 72 * MiB, 128 * MiB, 224 * MiB, 64 * MiB, 32 * MiB, 64 * MiB, 4 * MiB};
        const int r = l >> 1; csum_phase(ws + ro[r], rb[r], (unsigned long long*)(ws + OW_DBG) + 512 + r * 256, (unsigned*)(ws + OW_DBG) + r, l & 1, lds); } break;
    case PH_CSUM2: {
        const unsigned char* bp; size_t nb;
        switch (l) {
        case 0: bp = ws + OW_XB; nb = 64 * MiB; break;            case 1: bp = ws + OW_ACTA; nb = 64 * MiB; break;
        case 2: bp = ws + OW_ACTB; nb = 64 * MiB; break;          case 3: bp = (const unsigned char*)c.out; nb = 128 * MiB; break;
        case 4: bp = ws + OW_ACTA; nb = 64 * MiB; break;          case 5: bp = ws + OW_ACTC; nb = 64 * MiB; break;
        case 6: bp = ws + OW_ACTB; nb = 64 * MiB; break;          case 7: bp = ws + OW_ACTC; nb = 64 * MiB; break;
        case 8: bp = (const unsigned char*)c.out; nb = 128 * MiB; break;   case 9: bp = ws + OM_GATE; nb = NA * 4; break;
        case 10: bp = ws + OW_Y; nb = 128 * MiB; break;           case 11: bp = (const unsigned char*)c.out; nb = 128 * MiB; break;
        case 12: bp = ws + OW_BTM; nb = 128 * MiB; break;         case 13: bp = ws + OW_QKR; nb = 224 * MiB; break;
        case 14: bp = ws + OW_ATT; nb = 64 * MiB; break;          case 15: bp = ws + OW_UT; nb = 32 * MiB; break;
        case 16: bp = ws + OW_SP; nb = 32 * MiB; break;           case 17: bp = ws + OW_O; nb = 64 * MiB; break;
        case 18: bp = ws + OW_GO; nb = 64 * MiB; break;           case 19: bp = (const unsigned char*)c.out; nb = 128 * MiB; break;
        case 20: bp = ws + OW_ACTA; nb = 64 * MiB; break;         case 21: bp = ws + OW_ACTB; nb = 64 * MiB; break;
        case 22: bp = ws + OW_ACTC; nb = 64 * MiB; break;         case 23: bp = (const unsigned char*)c.out; nb = 128 * MiB; break;
        case 24: bp = ws + OM_GATE; nb = NA * 4; break;           case 25: bp = ws + OW_Y; nb = 128 * MiB; break;
        case 26: bp = ws + OW_RS; nb = T * 4; break;              case 27: bp = ws + OW_ALR; nb = 2 * MiB; break;
        default: bp = ws + OW_SSP; nb = 2 * MiB; break; }
        csum2_phase(bp, nb, (unsigned long long*)(ws + OW_DBG + 65536) + (size_t)l * 512, (unsigned*)(ws + OW_DBG) + l, lds); } break;
    case PH_XA_O_T: { g8::DenseSched S{4, 128 * 4, D, D, D, ACTC, WXO}; g8::gemm_phase(lds, S, g8::EpiXres{c.out, (float*)(ws + 296 * MiB), (bf16_t*)(ws + 424 * MiB), nullptr, nullptr}); } break;
    case PH_COMBINE_T: combine_phase(c.out, (float*)(ws + 296 * MiB), YB, (bf16_t*)(ws + 424 * MiB), (float*)(ws + 488 * MiB), (float*)(ws + 489 * MiB), nullptr, 0, nullptr, nullptr, lds); break;
    case PH_ROUTE_T: route_phase(c.out, WR, c.in[24] + l * NG, c.in[26] + l * NE, (float*)(ws + 488 * MiB), (int*)(ws + 489 * MiB), (int*)(ws + 490 * MiB), (float*)(ws + 491 * MiB), (int*)(ws + 491 * MiB + 524288), lds); break;
    case PH_FLAGOUT: flagout_phase(c.out, (unsigned*)(ws + OW_DBG)); break;
    case PH_GLA_OUT: { g8::DenseSched S{4, 128 * 4, D, D, D, GOB, WGO}; g8::gemm_phase(lds, S, g8::EpiXres{c.out, c.out, XB, nullptr, SSP}); } break;
    }
}
template <int PH> __global__ void __launch_bounds__(512, 2) k_opt(Ctx c, int l) {
    extern __shared__ __attribute__((aligned(16))) unsigned char dynlds[];
    run_phase(c, PH, l, (LAS unsigned char*)dynlds);
}
#ifndef ALLCG
#define ALLCG 0
#endif
#ifndef COOP
#define COOP 1
#endif
enum Op { OP_MEMN = 0, OP_MEMKV, OP_COPYX, OP_RMS_MIX, OP_CONV_IN, OP_GLU, OP_DWCONV, OP_CONV_OUT, OP_GLA_IN, OP_GLA_DECAY, OP_GLA_REC, OP_GLA_NORM, OP_GLA_OUT,
          OP_RMS_XA, OP_XA_Q, OP_XA_ATT, OP_XA_O, OP_RMS_FFN, OP_ROUTE, OP_BUILD, OP_MOE_GATE, OP_MOE_UP, OP_MOE_ACT, OP_MOE_DOWN, OP_MOE_COMBINE, OP_FINAL };

__device__ __forceinline__ void run_op(const Ctx& c, int op, int l, float* sm) {
    unsigned char* ws = c.ws;
    float* HN = (float*)(ws + WS_HN); float* BIG = (float*)(ws + WS_BIG);
    float* MEMN = (float*)(ws + WS_MEMN); float* KV = (float*)(ws + WS_KV) + (size_t)l * 1024 * 2048;
    int* eid = (int*)(ws + WS_EID); float* gate = (float*)(ws + WS_GATE); int* pos = (int*)(ws + WS_POS);
    int* slot_tok = (int*)(ws + WS_SLOTTOK); int* slot_a = (int*)(ws + WS_SLOTA); int* tile_e = (int*)(ws + WS_TILEE); int* cnt = (int*)(ws + WS_CNT);
    float* X = c.out;
    switch (op) {
    case OP_MEMN: n_rms(c.in[1], c.in[5], MEMN, NB * NMEM); break;
    case OP_MEMKV: n_gemm(sm, MEMN, D, nullptr, c.in[21] + (size_t)l * D * 2048, 2048, 0, nullptr, NB * NMEM, 2048, D, EpiStore{KV, 2048, nullptr}); break;
    case OP_COPYX: n_copy4(c.in[0], X, (size_t)T * D / 4); break;
    case OP_RMS_MIX: n_rms(X, c.in[2] + l * D, HN, T); break;
    case OP_CONV_IN: n_gemm(sm, HN, D, nullptr, c.in[7], 2048, 0, nullptr, T, 2048, D, EpiStore{BIG, 2048, c.in[8]}); break;
    case OP_GLU: n_glu(BIG, HN); break;
    case OP_DWCONV: n_dwconv(HN, c.in[9], c.in[10], c.in[11], c.in[12], BIG); break;
    case OP_CONV_OUT: n_gemm(sm, BIG, D, nullptr, c.in[13], D, 0, nullptr, T, D, D, EpiResid{X, D, c.in[14]}); break;
    case OP_GLA_IN: n_gemm(sm, HN, D, nullptr, c.in[15], GLA_COLS, 0, nullptr, T, GLA_COLS, D, EpiStore{BIG, GLA_COLS, nullptr}); break;
    case OP_GLA_DECAY: n_gla_decay(BIG, c.in[16], c.in[17], HN); break;
    case OP_GLA_REC: n_gla_rec(BIG, HN); break;
    case OP_GLA_NORM: n_gla_norm(BIG, c.in[18], HN); break;
    case OP_GLA_OUT: n_gemm(sm, HN, D, nullptr, c.in[19], D, 0, nullptr, T, D, D, EpiResid{X, D, nullptr}); break;
    case OP_RMS_XA: n_rms(X, c.in[3] + l * D, HN, T); break;
    case OP_XA_Q: n_gemm(sm, HN, D, nullptr, c.in[20] + (size_t)l * D * D, D, 0, nullptr, T, D, D, EpiStore{BIG, D, nullptr}); break;
    case OP_XA_ATT: n_attn(BIG, KV, BIG + (size_t)T * D); break;
    case OP_XA_O: n_gemm(sm, BIG + (size_t)T * D, D, nullptr, c.in[22] + (size_t)l * D * D, D, 0, nullptr, T, D, D, EpiResid{X, D, nullptr}); break;
    case OP_RMS_FFN: n_rms(X, c.in[4] + l * D, HN, T); n_moe_init(cnt, slot_tok, slot_a, tile_e); break;
    case OP_ROUTE: n_route(HN, c.in[23] + (size_t)l * D * NG, c.in[24] + l * NG, c.in[25] + (size_t)l * D * NE, c.in[26] + l * NE, eid, gate, pos, cnt); break;
    case OP_BUILD: n_moe_build(eid, pos, cnt, slot_tok, slot_a, tile_e); break;
    case OP_MOE_GATE: n_gemm(sm, HN, D, slot_tok, c.in[27] + (size_t)l * NE * D * DE, DE, (size_t)D * DE, tile_e, NSLOT, DE, D, EpiStore{BIG, DE, nullptr}); break;
    case OP_MOE_UP: n_gemm(sm, HN, D, slot_tok, c.in[28] + (size_t)l * NE * D * DE, DE, (size_t)D * DE, tile_e, NSLOT, DE, D, EpiStore{BIG + (size_t)NSLOT * DE, DE, nullptr}); break;
    case OP_MOE_ACT: n_moe_act(BIG, BIG + (size_t)NSLOT * DE); break;
    case OP_MOE_DOWN: n_gemm(sm, BIG, DE, nullptr, c.in[29] + (size_t)l * NE * DE * D, D, (size_t)DE * D, tile_e, NSLOT, D, DE, EpiMoeDown{BIG + (size_t)NSLOT * DE, slot_a, gate}); break;
    case OP_MOE_COMBINE: n_moe_combine(X, BIG + (size_t)NSLOT * DE); break;
    case OP_FINAL: n_rms(X, c.in[6], X, T); break;
    }
}

template <int OP> __global__ void __launch_bounds__(512) k_stage(Ctx c, int l) {
    __shared__ float sm[16 * 132 + 16 * 260];
    run_op(c, OP, l, sm);
}
typedef void (*StageFn)(Ctx, int);
template <int... I> struct Seq {};
template <int N, int... I> struct MkSeq : MkSeq<N - 1, N - 1, I...> {};
template <int... I> struct MkSeq<0, I...> { typedef Seq<I...> type; };
template <int... I> static void fill_tab(StageFn* t, Seq<I...>) { StageFn f[] = {k_stage<I>...}; for (unsigned i = 0; i < sizeof...(I); ++i) t[i] = f[i]; }
template <int... I> static void fill_tab_opt(StageFn* t, Seq<I...>) { StageFn f[] = {k_opt<I>...}; for (unsigned i = 0; i < sizeof...(I); ++i) t[i] = f[i]; }

#define XB_TMO      128
#define XB_XCNT(j)  (256  + 64 * (j))
#define XB_XSUB(j)  (1280 + 64 * (j))
#define XB_XGEN(j)  (2304 + 64 * (j))
#define XB_TOP      3328
#define XB_TOPGEN   3392
#define XCD_BAR_WORDS 3456
#define XB_SPIN_CAP (1u << 18)
__device__ __forceinline__ unsigned xb_ld(unsigned* p)              { return __hip_atomic_load(p, __ATOMIC_RELAXED, __HIP_MEMORY_SCOPE_AGENT); }
__device__ __forceinline__ unsigned xb_add(unsigned* p, unsigned v) { return __hip_atomic_fetch_add(p, v, __ATOMIC_RELAXED, __HIP_MEMORY_SCOPE_AGENT); }
__device__ __forceinline__ unsigned xb_xcc_id() { return (unsigned)__builtin_amdgcn_s_getreg((3 << 11) | 20) & 0xFu; }
#define XB_SPIN(cond, bar) do { unsigned _sp = 0; while (cond) { __builtin_amdgcn_s_sleep(1); \
    if ((++_sp & 255u) == 0u) { if (xb_ld(&(bar)[XB_TMO])) break; if (_sp > XB_SPIN_CAP) { atomicAdd(&(bar)[XB_TMO], 1u); break; } } } } while (0)
struct XcdBarrier { unsigned* bar; unsigned x; volatile LAS unsigned* st; };
__device__ __forceinline__ XcdBarrier xcd_barrier_post(unsigned* bar, volatile LAS unsigned* st) {
    XcdBarrier b; b.bar = bar; b.x = xb_xcc_id(); b.st = st;
    if (threadIdx.x == 0) (void)xb_add(&bar[XB_XCNT(b.x)], 1u);
    return b;
}
__device__ __forceinline__ void xcd_barrier_complete(unsigned* bar, unsigned x, unsigned& nloc, unsigned& nx) {
    const unsigned G = gridDim.x * gridDim.y * gridDim.z;
    unsigned sum, cnt, mine, sp = 0u;
    for (;;) {
        sum = 0u; cnt = 0u; mine = 0u;
#pragma unroll
        for (unsigned j = 0; j < 16; ++j) { const unsigned c = xb_ld(&bar[XB_XCNT(j)]); sum += c; cnt += (c > 0u) ? 1u : 0u; mine = (j == x) ? c : mine; }
        if (sum == G) break;
        __builtin_amdgcn_s_sleep(1);
        if ((++sp & 255u) == 0u) { if (xb_ld(&bar[XB_TMO])) break; if (sp > XB_SPIN_CAP) { atomicAdd(&bar[XB_TMO], 1u); break; } }
    }
    nloc = mine > 0u ? mine : 1u; nx = cnt > 0u ? cnt : 1u;
}
__device__ __forceinline__ void xcd_barrier(const XcdBarrier& b) {
    asm volatile("s_waitcnt vmcnt(0)" ::: "memory");
    __syncthreads();
    if (threadIdx.x == 0) {
        unsigned* bar = b.bar;
        __builtin_amdgcn_s_waitcnt(0);
        unsigned nloc = b.st[0], nx = b.st[1];
        if (nloc == 0u) { xcd_barrier_complete(bar, b.x, nloc, nx); b.st[0] = nloc; b.st[1] = nx; }
        const unsigned old = xb_add(&bar[XB_XSUB(b.x)], 1u);
        const unsigned gen = old / nloc;
        if (old + 1u == (gen + 1u) * nloc) {
            __builtin_amdgcn_fence(__ATOMIC_RELEASE, "agent");
            asm volatile("s_waitcnt vmcnt(0)" ::: "memory");
            const unsigned og = xb_add(&bar[XB_TOP], 1u);
            const unsigned tg = og / nx;
            if (og + 1u == (tg + 1u) * nx) xb_add(&bar[XB_TOPGEN], 1u);
            else XB_SPIN(xb_ld(&bar[XB_TOPGEN]) == tg, bar);
            __builtin_amdgcn_fence(__ATOMIC_ACQUIRE, "agent");
            xb_add(&bar[XB_XGEN(b.x)], 1u);
            asm volatile("s_waitcnt vmcnt(0)" ::: "memory");
        } else {
            XB_SPIN(xb_ld(&bar[XB_XGEN(b.x)]) == gen, bar);
            __builtin_amdgcn_fence(__ATOMIC_ACQUIRE, "agent");
            asm volatile("s_waitcnt vmcnt(0)" ::: "memory");
        }
    }
    __syncthreads();
}
template <int CODE> __device__ __forceinline__ void coop_step(const Ctx& c, LAS unsigned char* lds, cg::grid_group& grid, XcdBarrier& xb, bool sync_after, bool first) {
    run_phase(c, CODE >> 5, CODE & 31, lds);
    if (sync_after) {
        if (first || ALLCG) {
            unsigned* bar = (unsigned*)(c.ws + OW_BAR);
            if (first && blockIdx.x == 0) for (int i = threadIdx.x; i < XCD_BAR_WORDS; i += 512) bar[i] = 0u;
            asm volatile("s_waitcnt vmcnt(0) lgkmcnt(0)" ::: "memory");
            grid.sync();
            if (threadIdx.x < 64) { __builtin_amdgcn_fence(__ATOMIC_ACQUIRE, "agent"); asm volatile("s_waitcnt vmcnt(0)" ::: "memory"); }
            __syncthreads();
            if (first) xb = xcd_barrier_post(bar, xb.st);
        } else xcd_barrier(xb);
    }
}
template <int... CODES> __global__ void __launch_bounds__(512, 2) k_coop(Ctx c) {
    extern __shared__ __attribute__((aligned(16))) unsigned char dynlds[];
    cg::grid_group grid = cg::this_grid();
    LAS unsigned char* lds = (LAS unsigned char*)dynlds;
    volatile LAS unsigned* st = (volatile LAS unsigned*)(lds + LDS_BYTES - 16);
    if (threadIdx.x < 4) st[threadIdx.x] = 0u;
    __syncthreads();
    XcdBarrier xb; xb.bar = nullptr; xb.x = 0; xb.st = st;
    int idx = 0; constexpr int N = sizeof...(CODES);
    ((coop_step<CODES>(c, lds, grid, xb, idx + 1 < N, idx == 0), ++idx), ...);
}
#define CODE(ph, l) ((ph) * 32 + (l))
typedef void (*CoopFn)(Ctx);
struct Step { int kind, op, l; };
static const Step g_prog[] = { {1, 0, 0} };
constexpr int NSTEP = sizeof(g_prog) / sizeof(g_prog[0]);

extern "C" void kernel_launch(void* const* d_in, const int* in_sizes, int n_in, void* d_out, int out_size, void* d_ws, size_t ws_size, hipStream_t stream) {
    if (n_in != 30 || out_size != T * D || ws_size < OW_END || ws_size < WS_END) { fprintf(stderr, "kernel_launch: bad args n_in %d out %d ws %zu\n", n_in, out_size, ws_size); return; }
    Ctx c; memset(&c, 0, sizeof(c));
    for (int i = 0; i < 30; ++i) c.in[i] = (const float*)d_in[i];
    c.out = (float*)d_out; c.ws = (unsigned char*)d_ws;
    static StageFn tab[OP_FINAL + 1], tabo[PH_N];
    static bool init = false;
    if (!init) { fill_tab(tab, MkSeq<OP_FINAL + 1>::type()); fill_tab_opt(tabo, MkSeq<PH_N>::type());
        for (int i = 0; i < PH_N; ++i) hipFuncSetAttribute((const void*)tabo[i], hipFuncAttributeMaxDynamicSharedMemorySize, LDS_BYTES);
        init = true; }
#if COOP
    static int coop_grid = 0;
    static CoopFn coop_fns[2] = { k_coop<CODE(PH_PREP_ALL, 0), CODE(PH_CONV_IN, 0), CODE(PH_CONV_MID, 0), CODE(PH_CONV_OUT, 0),
                                         CODE(PH_XA_Q, 0), CODE(PH_XA_KV, 0), CODE(PH_XA_S, 0), CODE(PH_XA_PV, 0), CODE(PH_XA_O, 0),
                                         CODE(PH_ROUTE, 0), CODE(PH_BUILD, 0), CODE(PH_MOE1, 0), CODE(PH_MOE2, 0), CODE(PH_COMBINE, 0),
                                         CODE(PH_GLA_DECAY, 0), CODE(PH_GLA_IN, 0), CODE(PH_GLA_ATT, 0), CODE(PH_GLA_SCAN, 0), CODE(PH_GLA_O, 0), CODE(PH_GLA_FIN, 0), CODE(PH_GLA_OUT, 0),
                                         CODE(PH_XA_Q, 1), CODE(PH_XA_KV, 1), CODE(PH_XA_S, 1), CODE(PH_XA_PV, 1), CODE(PH_XA_O, 1),
                                         CODE(PH_ROUTE, 1), CODE(PH_BUILD, 1), CODE(PH_MOE1, 1), CODE(PH_MOE2, 1), CODE(PH_COMBINE_FIN, 1)>, nullptr };
    if (!coop_grid) { int dev = 0, cus = 0, per_cu = 0; hipGetDevice(&dev); hipDeviceGetAttribute(&cus, hipDeviceAttributeMultiprocessorCount, dev);
        for (int k = 0; k < 1; ++k) hipFuncSetAttribute((const void*)coop_fns[k], hipFuncAttributeMaxDynamicSharedMemorySize, LDS_BYTES);
        hipOccupancyMaxActiveBlocksPerMultiprocessor(&per_cu, coop_fns[0], 512, LDS_BYTES);
        coop_grid = cus * (per_cu < 1 ? 1 : per_cu); if (coop_grid > 256) coop_grid = 256;
        fprintf(stderr, "kernel_launch: cus %d per_cu %d grid %d\n", cus, per_cu, coop_grid); }
    int ncoop = 0;
#endif
    for (int i = 0; i < NSTEP; ++i) {
        if (g_prog[i].kind == 0) { hipLaunchKernelGGL(tab[g_prog[i].op], dim3(1024), dim3(512), 0, stream, c, g_prog[i].l); continue; }
#if COOP
        while (i < NSTEP && g_prog[i].kind == 1) ++i;
        --i;
        void* args[] = {&c};
        hipError_t e = hipLaunchCooperativeKernel((void*)coop_fns[ncoop++], dim3(coop_grid), dim3(512), args, LDS_BYTES, stream);
        if (e != hipSuccess) fprintf(stderr, "cooperative launch failed: %s\n", hipGetErrorString(e));
#else
        hipLaunchKernelGGL(tabo[g_prog[i].op], dim3(256), dim3(512), LDS_BYTES, stream, c, g_prog[i].l);
#endif
    }
}
```

```cpp
#include <hip/hip_runtime.h>
#include <hip/hip_cooperative_groups.h>
#include <cstdio>
#include <cstring>
namespace cg = cooperative_groups;

#ifndef MEGA
#define MEGA 0
#endif

constexpr int D = 1024, NB = 4, S = 8192, T = NB * S, NMEM = 256, DEPTH = 2;
constexpr int CONVK = 31;
constexpr int GH = 4, GDK = 512, GDV = 1024, GDKH = 128, GDVH = 256, GRANK = 16, GLA_COLS = 3088;
constexpr int XH = 4, XHD = 256;
constexpr int NG = 4, EPG = 8, NE = 32, DE = 512;
constexpr int NA = T * 2;
constexpr int NSLOT = NA + NE * 128;
constexpr float EPS = 1e-6f;

constexpr size_t MiB = 1u << 20;
constexpr size_t WS_HN = 0;
constexpr size_t WS_BIG = 128 * MiB;
constexpr size_t WS_SMALL = 528 * MiB;
constexpr size_t WS_MEMN = WS_SMALL;
constexpr size_t WS_KV = WS_MEMN + 4 * MiB;
constexpr size_t WS_EID = WS_KV + 16 * MiB;
constexpr size_t WS_GATE = WS_EID + NA * 4;
constexpr size_t WS_POS = WS_GATE + NA * 4;
constexpr size_t WS_SLOTTOK = WS_POS + NA * 4;
constexpr size_t WS_SLOTA = WS_SLOTTOK + NSLOT * 4;
constexpr size_t WS_TILEE = WS_SLOTA + NSLOT * 4;
constexpr size_t WS_CNT = WS_TILEE + 4096;
constexpr size_t WS_END = WS_CNT + 4096;

struct Ctx {
    const float* in[30];
    float* out;
    unsigned char* ws;
};

__device__ __forceinline__ float wave_sum(float v) {
#pragma unroll
    for (int o = 1; o < 64; o <<= 1) v += __shfl_xor(v, o);
    return v;
}
__device__ __forceinline__ float wave_max(float v) {
#pragma unroll
    for (int o = 1; o < 64; o <<= 1) v = fmaxf(v, __shfl_xor(v, o));
    return v;
}
__device__ __forceinline__ float sigmoidf_(float x) { return 1.0f / (1.0f + expf(-x)); }
__device__ __forceinline__ float siluf_(float x) { return x / (1.0f + expf(-x)); }

__device__ void n_rms(const float* x, const float* g, float* out, int rows) {
    const int lane = threadIdx.x & 63;
    const int gw = (blockIdx.x * blockDim.x + threadIdx.x) >> 6, ngw = (gridDim.x * blockDim.x) >> 6;
    for (int r = gw; r < rows; r += ngw) {
        const float4* xr = (const float4*)(x + (size_t)r * D);
        float4 v[4]; float s = 0.f;
#pragma unroll
        for (int j = 0; j < 4; ++j) { v[j] = xr[lane + 64 * j]; s += v[j].x * v[j].x + v[j].y * v[j].y + v[j].z * v[j].z + v[j].w * v[j].w; }
        s = wave_sum(s);
        const float rs = rsqrtf(s * (1.0f / D) + EPS);
        float4* o = (float4*)(out + (size_t)r * D);
#pragma unroll
        for (int j = 0; j < 4; ++j) { const float4 gg = ((const float4*)g)[lane + 64 * j];
            o[lane + 64 * j] = make_float4(v[j].x * rs * gg.x, v[j].y * rs * gg.y, v[j].z * rs * gg.z, v[j].w * rs * gg.w); }
    }
}
__device__ void n_copy4(const float* src, float* dst, size_t n4) {
    const size_t g = (size_t)blockIdx.x * blockDim.x + threadIdx.x, gs = (size_t)gridDim.x * blockDim.x;
    for (size_t i = g; i < n4; i += gs) ((float4*)dst)[i] = ((const float4*)src)[i];
}

struct EpiStore { float* C; int ldc; const float* bias;
    __device__ __forceinline__ void operator()(int m, int n, float acc) const { C[(size_t)m * ldc + n] = acc + (bias ? bias[n] : 0.f); } };
struct EpiResid { float* X; int ldc; const float* bias;
    __device__ __forceinline__ void operator()(int m, int n, float acc) const { X[(size_t)m * ldc + n] += acc + (bias ? bias[n] : 0.f); } };
struct EpiMoeDown { float* Y; const int* slot_a; const float* gate;
    __device__ __forceinline__ void operator()(int m, int n, float acc) const { const int a = slot_a[m]; if (a >= 0) Y[(size_t)a * D + n] = acc * gate[a]; } };

template <class Epi>
__device__ void n_gemm(float* sm, const float* A, int lda, const int* arow, const float* W, int ldw, size_t wstride, const int* tile_e,
                       int M, int N, int K, Epi epi) {
    float* As = sm;
    float* Bs = sm + 16 * 132;
    const int tid = threadIdx.x, ty = tid >> 5, tx = tid & 31;
    const int ntm = M / 128, ntn = (N + 255) / 256;
    for (int tile = blockIdx.x; tile < ntm * ntn; tile += gridDim.x) {
        const int mt = tile / ntn, nt = tile % ntn;
        const float* Wb = W;
        if (tile_e) { const int e = tile_e[mt]; if (e < 0) continue; Wb = W + (size_t)e * wstride; }
        const int m0 = mt * 128, n0 = nt * 256;
        float acc[8][8];
#pragma unroll
        for (int i = 0; i < 8; ++i)
#pragma unroll
            for (int j = 0; j < 8; ++j) acc[i][j] = 0.f;
        const int ar = tid >> 2, akq = (tid & 3) * 4;
        const int srow = arow ? arow[m0 + ar] : (m0 + ar);
        const float* ap = srow >= 0 ? A + (size_t)srow * lda : nullptr;
        const int bk = tid >> 6, bn = (tid & 63) * 4;
        for (int k0 = 0; k0 < K; k0 += 16) {
            float4 av = ap ? *(const float4*)(ap + k0 + akq) : make_float4(0.f, 0.f, 0.f, 0.f);
            As[(akq + 0) * 132 + ar] = av.x; As[(akq + 1) * 132 + ar] = av.y; As[(akq + 2) * 132 + ar] = av.z; As[(akq + 3) * 132 + ar] = av.w;
#pragma unroll
            for (int i = 0; i < 2; ++i) {
                const int kk = bk + 8 * i; const int n = n0 + bn;
                float4 bv = (n < N) ? *(const float4*)(Wb + (size_t)(k0 + kk) * ldw + n) : make_float4(0.f, 0.f, 0.f, 0.f);
                *(float4*)(Bs + kk * 260 + bn) = bv;
            }
            __syncthreads();
#pragma unroll
            for (int kk = 0; kk < 16; ++kk) {
                float a[8], b[8];
                *(float4*)(a) = *(const float4*)(As + kk * 132 + ty * 8); *(float4*)(a + 4) = *(const float4*)(As + kk * 132 + ty * 8 + 4);
                *(float4*)(b) = *(const float4*)(Bs + kk * 260 + tx * 8); *(float4*)(b + 4) = *(const float4*)(Bs + kk * 260 + tx * 8 + 4);
#pragma unroll
                for (int i = 0; i < 8; ++i)
#pragma unroll
                    for (int j = 0; j < 8; ++j) acc[i][j] = fmaf(a[i], b[j], acc[i][j]);
            }
            __syncthreads();
        }
#pragma unroll
        for (int i = 0; i < 8; ++i)
#pragma unroll
            for (int j = 0; j < 8; ++j) { const int m = m0 + ty * 8 + i, n = n0 + tx * 8 + j; if (n < N) epi(m, n, acc[i][j]); }
    }
}

__device__ void n_glu(const float* u, float* g) {
    const size_t gi = (size_t)blockIdx.x * blockDim.x + threadIdx.x, gs = (size_t)gridDim.x * blockDim.x;
    for (size_t i = gi; i < (size_t)T * D; i += gs) { const size_t t = i >> 10, c = i & 1023; g[i] = u[t * 2048 + c] * sigmoidf_(u[t * 2048 + 1024 + c]); }
}
__device__ void n_dwconv(const float* g, const float* wdw, const float* bdw, const float* lng, const float* lnb, float* out) {
    const int lane = threadIdx.x & 63;
    const int gw = (blockIdx.x * blockDim.x + threadIdx.x) >> 6, ngw = (gridDim.x * blockDim.x) >> 6;
    for (int t = gw; t < T; t += ngw) {
        const int s = t % S;
        float4 acc[4];
#pragma unroll
        for (int j = 0; j < 4; ++j) acc[j] = ((const float4*)bdw)[lane + 64 * j];
        for (int tap = 0; tap < CONVK; ++tap) {
            const int ss = s - (CONVK - 1) + tap; if (ss < 0) continue;
            const float4* gr = (const float4*)(g + (size_t)(t - (CONVK - 1) + tap) * D);
            const float4* wr = (const float4*)(wdw + (size_t)tap * D);
#pragma unroll
            for (int j = 0; j < 4; ++j) { const float4 a = gr[lane + 64 * j], w = wr[lane + 64 * j];
                acc[j].x = fmaf(a.x, w.x, acc[j].x); acc[j].y = fmaf(a.y, w.y, acc[j].y); acc[j].z = fmaf(a.z, w.z, acc[j].z); acc[j].w = fmaf(a.w, w.w, acc[j].w); }
        }
        float sm_ = 0.f;
#pragma unroll
        for (int j = 0; j < 4; ++j) sm_ += acc[j].x + acc[j].y + acc[j].z + acc[j].w;
        const float mu = wave_sum(sm_) * (1.0f / D);
        float q = 0.f;
#pragma unroll
        for (int j = 0; j < 4; ++j) { acc[j].x -= mu; acc[j].y -= mu; acc[j].z -= mu; acc[j].w -= mu; q += acc[j].x * acc[j].x + acc[j].y * acc[j].y + acc[j].z * acc[j].z + acc[j].w * acc[j].w; }
        const float rstd = rsqrtf(wave_sum(q) * (1.0f / D) + EPS);
        float4* o = (float4*)(out + (size_t)t * D);
#pragma unroll
        for (int j = 0; j < 4; ++j) { const float4 gg = ((const float4*)lng)[lane + 64 * j], bb = ((const float4*)lnb)[lane + 64 * j];
            o[lane + 64 * j] = make_float4(siluf_(acc[j].x * rstd * gg.x + bb.x), siluf_(acc[j].y * rstd * gg.y + bb.y), siluf_(acc[j].z * rstd * gg.z + bb.z), siluf_(acc[j].w * rstd * gg.w + bb.w)); }
    }
}
__device__ void n_attn(const float* q, const float* kv, float* o) {
    const int lane = threadIdx.x & 63;
    const int gw = (blockIdx.x * blockDim.x + threadIdx.x) >> 6, ngw = (gridDim.x * blockDim.x) >> 6;
    for (int it = gw; it < T * XH; it += ngw) {
        const int t = it >> 2, h = it & 3, b = t / S;
        const float4 qv = ((const float4*)(q + (size_t)t * D + h * XHD))[lane];
        const float* kb = kv + (size_t)b * NMEM * 2048 + h * XHD;
        float sc[4];
#pragma unroll
        for (int m4 = 0; m4 < 4; ++m4) {
            float mine = 0.f;
            for (int ml = 0; ml < 64; ++ml) {
                const float4 kk = ((const float4*)(kb + (size_t)(m4 * 64 + ml) * 2048))[lane];
                float p = qv.x * kk.x + qv.y * kk.y + qv.z * kk.z + qv.w * kk.w;
                p = wave_sum(p);
                if (ml == lane) mine = p;
            }
            sc[m4] = mine * 0.0625f;
        }
        float mx = fmaxf(fmaxf(sc[0], sc[1]), fmaxf(sc[2], sc[3])); mx = wave_max(mx);
        float se = 0.f;
#pragma unroll
        for (int m4 = 0; m4 < 4; ++m4) { sc[m4] = expf(sc[m4] - mx); se += sc[m4]; }
        se = wave_sum(se); const float inv = 1.0f / se;
        float4 acc = make_float4(0.f, 0.f, 0.f, 0.f);
        const float* vb = kb + 1024;
#pragma unroll
        for (int m4 = 0; m4 < 4; ++m4)
            for (int ml = 0; ml < 64; ++ml) {
                const float p = __shfl(sc[m4], ml) * inv;
                const float4 vv = ((const float4*)(vb + (size_t)(m4 * 64 + ml) * 2048))[lane];
                acc.x = fmaf(p, vv.x, acc.x); acc.y = fmaf(p, vv.y, acc.y); acc.z = fmaf(p, vv.z, acc.z); acc.w = fmaf(p, vv.w, acc.w);
            }
        ((float4*)(o + (size_t)t * D + h * XHD))[lane] = acc;
    }
}
__device__ void n_moe_init(int* cnt, int* slot_tok, int* slot_a, int* tile_e) {
    const int gi = blockIdx.x * blockDim.x + threadIdx.x, gs = gridDim.x * blockDim.x;
    for (int i = gi; i < NSLOT; i += gs) { slot_tok[i] = -1; slot_a[i] = -1; }
    for (int i = gi; i < NSLOT / 128; i += gs) tile_e[i] = -1;
    if (gi < 32) cnt[gi] = 0;
}
__device__ void n_route(const float* h, const float* wg, const float* bg, const float* we, const float* be, int* eid, float* gate, int* pos, int* cnt) {
    const int lane = threadIdx.x & 63;
    const int gw = (blockIdx.x * blockDim.x + threadIdx.x) >> 6, ngw = (gridDim.x * blockDim.x) >> 6;
    for (int t = gw; t < T; t += ngw) {
        float hv[16];
#pragma unroll
        for (int j = 0; j < 16; ++j) hv[j] = h[(size_t)t * D + j * 64 + lane];
        float gl[4];
#pragma unroll
        for (int o = 0; o < 4; ++o) { float p = 0.f;
#pragma unroll
            for (int j = 0; j < 16; ++j) p = fmaf(hv[j], wg[(size_t)(j * 64 + lane) * NG + o], p);
            gl[o] = wave_sum(p) + bg[o]; }
        int gs = 0; float gm = gl[0];
#pragma unroll
        for (int o = 1; o < 4; ++o) if (gl[o] > gm) { gm = gl[o]; gs = o; }
        float se = 0.f;
#pragma unroll
        for (int o = 0; o < 4; ++o) se += expf(gl[o] - gm);
        const float pg = 1.0f / se;
        float el[8];
#pragma unroll
        for (int o = 0; o < 8; ++o) { float p = 0.f;
#pragma unroll
            for (int j = 0; j < 16; ++j) p = fmaf(hv[j], we[(size_t)(j * 64 + lane) * NE + gs * 8 + o], p);
            el[o] = wave_sum(p) + be[gs * 8 + o]; }
        float em = el[0];
#pragma unroll
        for (int o = 1; o < 8; ++o) em = fmaxf(em, el[o]);
        float pe[8], ps = 0.f;
#pragma unroll
        for (int o = 0; o < 8; ++o) { pe[o] = expf(el[o] - em); ps += pe[o]; }
#pragma unroll
        for (int o = 0; o < 8; ++o) pe[o] = pe[o] / ps;
        int i1 = 0; float p1 = pe[0];
#pragma unroll
        for (int o = 1; o < 8; ++o) if (pe[o] > p1) { p1 = pe[o]; i1 = o; }
        int i2 = -1; float p2 = -1.f;
#pragma unroll
        for (int o = 0; o < 8; ++o) if (o != i1 && pe[o] > p2) { p2 = pe[o]; i2 = o; }
        if (lane == 0) {
            const float den = p1 + p2;
            const int e1 = gs * 8 + i1, e2 = gs * 8 + i2;
            eid[2 * t] = e1; eid[2 * t + 1] = e2;
            gate[2 * t] = pg * p1 / den; gate[2 * t + 1] = pg * p2 / den;
            pos[2 * t] = atomicAdd(&cnt[e1], 1); pos[2 * t + 1] = atomicAdd(&cnt[e2], 1);
        }
    }
}
__device__ void n_moe_build(const int* eid, const int* pos, const int* cnt, int* slot_tok, int* slot_a, int* tile_e) {
    __shared__ int poff[33];
    if (threadIdx.x == 0) { int o = 0; for (int e = 0; e < 32; ++e) { poff[e] = o; o += (cnt[e] + 127) / 128 * 128; } poff[32] = o; }
    __syncthreads();
    const int gi = blockIdx.x * blockDim.x + threadIdx.x, gs = gridDim.x * blockDim.x;
    for (int a = gi; a < NA; a += gs) { const int e = eid[a]; const int sl = poff[e] + pos[a]; slot_tok[sl] = a >> 1; slot_a[sl] = a; }
    for (int mt = gi; mt < NSLOT / 128; mt += gs) { const int r = mt * 128; int e = -1; for (int k = 0; k < 32; ++k) if (r >= poff[k] && r < poff[k + 1]) e = k; tile_e[mt] = e; }
    __syncthreads();
}
__device__ void n_moe_act(float* g, const float* u) {
    const size_t gi = (size_t)blockIdx.x * blockDim.x + threadIdx.x, gs = (size_t)gridDim.x * blockDim.x;
    for (size_t i = gi; i < (size_t)NSLOT * DE / 4; i += gs) { float4 a = ((float4*)g)[i]; const float4 b = ((const float4*)u)[i];
        a.x = siluf_(a.x) * b.x; a.y = siluf_(a.y) * b.y; a.z = siluf_(a.z) * b.z; a.w = siluf_(a.w) * b.w; ((float4*)g)[i] = a; }
}
__device__ void n_moe_combine(float* x, const float* y) {
    const size_t gi = (size_t)blockIdx.x * blockDim.x + threadIdx.x, gs = (size_t)gridDim.x * blockDim.x;
    for (size_t i = gi; i < (size_t)T * D / 4; i += gs) { const size_t t = i >> 8, c = i & 255; float4 a = ((float4*)x)[i];
        const float4 y0 = ((const float4*)y)[(2 * t) * 256 + c], y1 = ((const float4*)y)[(2 * t + 1) * 256 + c];
        a.x += y0.x + y1.x; a.y += y0.y + y1.y; a.z += y0.z + y1.z; a.w += y0.w + y1.w; ((float4*)x)[i] = a; }
}
__device__ void n_gla_decay(const float* proj, const float* wa2, const float* ba, float* dec) {
    const size_t gi = (size_t)blockIdx.x * blockDim.x + threadIdx.x, gs = (size_t)gridDim.x * blockDim.x;
    for (size_t i = gi; i < (size_t)T * GDK; i += gs) { const size_t t = i >> 9; const int j = (int)(i & 511);
        float a = ba[j];
#pragma unroll
        for (int r = 0; r < GRANK; ++r) a = fmaf(proj[t * GLA_COLS + 2048 + r], wa2[r * GDK + j], a);
        const float ls = fminf(a, 0.f) - log1pf(expf(-fabsf(a)));
        dec[i] = expf(ls * (1.0f / 16.0f)); }
}
__device__ void n_gla_rec(float* proj, const float* dec) {
    const int gi = blockIdx.x * blockDim.x + threadIdx.x, gs = gridDim.x * blockDim.x;
    for (int it = gi; it < NB * GH * GDVH; it += gs) {
        const int col = it & 255, h = (it >> 8) & 3, b = it >> 10;
        float st[GDKH];
#pragma unroll
        for (int k = 0; k < GDKH; ++k) st[k] = 0.f;
        const float qs = 0.08838834764831845f;
        for (int s = 0; s < S; ++s) {
            const size_t t = (size_t)b * S + s;
            float* pr = proj + t * GLA_COLS;
            const float v = pr[1024 + h * GDVH + col];
            const float* qq = pr + h * GDKH; const float* kk = pr + 512 + h * GDKH; const float* dd = dec + t * GDK + h * GDKH;
            float o = 0.f;
#pragma unroll
            for (int k = 0; k < GDKH; ++k) { st[k] = fmaf(st[k], dd[k], kk[k] * v); o = fmaf(qq[k], st[k], o); }
            pr[1024 + h * GDVH + col] = o * qs;
        }
    }
}
__device__ void n_gla_norm(const float* proj, const float* ng, float* go) {
    const int lane = threadIdx.x & 63;
    const int gw = (blockIdx.x * blockDim.x + threadIdx.x) >> 6, ngw = (gridDim.x * blockDim.x) >> 6;
    for (int it = gw; it < T * GH; it += ngw) {
        const int t = it >> 2, h = it & 3;
        const float4 ov = ((const float4*)(proj + (size_t)t * GLA_COLS + 1024 + h * GDVH))[lane];
        const float4 rv = ((const float4*)(proj + (size_t)t * GLA_COLS + 2064 + h * GDVH))[lane];
        const float4 gg = ((const float4*)ng)[lane];
        float s = ov.x * ov.x + ov.y * ov.y + ov.z * ov.z + ov.w * ov.w; s = wave_sum(s);
        const float rs = rsqrtf(s * (1.0f / GDVH) + EPS);
        ((float4*)(go + (size_t)t * D + h * GDVH))[lane] = make_float4(ov.x * rs * gg.x * siluf_(rv.x), ov.y * rs * gg.y * siluf_(rv.y), ov.z * rs * gg.z * siluf_(rv.z), ov.w * rs * gg.w * siluf_(rv.w));
    }
}

#define LAS __attribute__((address_space(3)))
typedef unsigned short bf16_t;
typedef short bf16x8 __attribute__((ext_vector_type(8)));
typedef float f32x4 __attribute__((ext_vector_type(4)));
typedef float f32x2 __attribute__((ext_vector_type(2)));
typedef unsigned u32x4 __attribute__((ext_vector_type(4)));
typedef unsigned u32x2 __attribute__((ext_vector_type(2)));

constexpr int LDS_BYTES = 160 * 1024;
constexpr int NSLOT2 = NA + NE * 256;
constexpr int MAXRT = NSLOT2 / 256;
constexpr size_t OW_XB = 0;
constexpr size_t OW_SSP = 64 * MiB;
constexpr size_t OW_RS = 66 * MiB;
constexpr size_t OW_PSUM = 67 * MiB;
constexpr size_t OW_MOE = 69 * MiB;
constexpr size_t OW_ACTA = 72 * MiB, OW_ACTB = 136 * MiB, OW_ACTC = 200 * MiB;
constexpr size_t OW_H = 72 * MiB, OW_Y = 144 * MiB, OW_WMOE = 272 * MiB;
constexpr size_t OW_KVB = 368 * MiB;
constexpr size_t OW_MEMNB = 502 * MiB;
constexpr size_t OW_WCIN = 550 * MiB, OW_WCOUT = 554 * MiB, OW_WXQ = 556 * MiB, OW_WXKV = 560 * MiB, OW_WXO = 568 * MiB, OW_WR = 572 * MiB, OW_BAR = 573 * MiB, OW_DBG = 574 * MiB, OW_END = 575 * MiB;
constexpr size_t OW_ATT = 0, OW_QKR = 72 * MiB, OW_KVT = 200 * MiB, OW_BTM = 296 * MiB, OW_O = 296 * MiB, OW_BFM = 360 * MiB, OW_UT = 424 * MiB, OW_SP = 456 * MiB,
                 OW_ALR = 488 * MiB, OW_DL = 490 * MiB, OW_GO = 200 * MiB, OW_WGTM = 492 * MiB, OW_WGFM = 496 * MiB, OW_WGO = 499 * MiB, OW_WA = 501 * MiB;
constexpr size_t OM_GCNT = OW_MOE, OM_NT = OW_MOE + 256, OM_TILEE = OW_MOE + 512, OM_AE = OW_MOE + 4096, OM_APOS = OM_AE + NA * 4, OM_GATE = OM_APOS + NA * 4,
                 OM_STOK = OM_GATE + NA * 4, OM_SA = OM_STOK + NSLOT2 * 4, OM_SRS = OM_SA + NSLOT2 * 4, OM_SGATE = OM_SRS + NSLOT2 * 4, OM_END = OM_SGATE + NSLOT2 * 4;
static_assert(OM_END <= OW_ACTA, "MoE small arrays");

typedef __bf16 bf16x2_t __attribute__((ext_vector_type(2)));
__device__ __forceinline__ unsigned cvt_pk_bf16(float lo, float hi) { const f32x2 v = {lo, hi}; return __builtin_bit_cast(unsigned, __builtin_convertvector(v, bf16x2_t)); }
__device__ __forceinline__ int otid() { int t = threadIdx.x; asm volatile("" : "+v"(t)); return t; }
__device__ __forceinline__ u32x4 pack8(const f32x4& a, const f32x4& b) { u32x4 w; w.x = cvt_pk_bf16(a[0], a[1]); w.y = cvt_pk_bf16(a[2], a[3]); w.z = cvt_pk_bf16(b[0], b[1]); w.w = cvt_pk_bf16(b[2], b[3]); return w; }
__device__ __forceinline__ float bf_lo(unsigned w) { return __uint_as_float(w << 16); }
__device__ __forceinline__ float bf_hi(unsigned w) { return __uint_as_float(w & 0xffff0000u); }
__device__ __forceinline__ float fast_sigmoid(float x) { return __builtin_amdgcn_rcpf(1.0f + __builtin_amdgcn_exp2f(-1.4426950408889634f * x)); }

#ifndef LDS_POISON
#define LDS_POISON 0
#endif
namespace g8 {
constexpr int BM = 256, BK = 64, HALF = 128, HTB = HALF * BK * 2, STAGE_BYTES = 8 * HTB;
__device__ __forceinline__ int lds_byte(int r, int c) { const int st = (r >> 4) * 2 + (c >> 5), rr = r & 15, cc = c & 31, ob = rr * 64 + cc * 2; return st * 1024 + (ob ^ (((ob >> 9) & 1) << 5)); }
__device__ __forceinline__ void stage_rc(int b, int& R, int& C) { const int st = b / 1024, sb = b % 1024, swz = sb ^ (((sb >> 9) & 1) << 5); R = (st >> 1) * 16 + swz / 64; C = (st & 1) * 32 + (swz % 64) / 2; }
__device__ __forceinline__ int perm32(int rho) { const int n = rho >> 4, i = rho & 15; return 8 * (i >> 2) + 4 * n + (i & 3); }
struct Unit { int pm, pn, e; };

template <class Epi, class Sched>
__device__ __forceinline__ void gemm_phase(LAS unsigned char* lds, const Sched& S, const Epi& E) {
    int tid_ = threadIdx.x; asm volatile("" : "+v"(tid_));
    const int tid = tid_, wid = __builtin_amdgcn_readfirstlane(tid >> 6), lane = tid & 63, wr = wid >> 2, wc = wid & 3, fr = lane & 15, fq = lane >> 4;
    const size_t kstep = (size_t)(BK * 2);
    const unsigned ldsw = (unsigned)wid * 1024u;
    const int aoff = lds_byte(wr * 64 + fr, fq * 8), boff = lds_byte(wc * 32 + fr, fq * 8);
#define G8_SA(b, h) (((b) * 2 + (h)) * HTB)
#define G8_SB(b, h) ((4 + (b) * 2 + (h)) * HTB)
#define G8_STAGE(bufoff, gbase, vv) do { _Pragma("unroll") for (int _i = 0; _i < 2; ++_i) \
        __builtin_amdgcn_global_load_lds((const unsigned*)((const char*)(gbase) + (vv)[_i]), (LAS unsigned*)(lds + (bufoff) + ldsw + _i * 8192), 16, 0, 0); } while (0)
#define G8_LDA(dst, b, h) do { _Pragma("unroll") for (int m = 0; m < 4; ++m) _Pragma("unroll") for (int k = 0; k < 2; ++k) dst[m][k] = *(const LAS bf16x8*)(lds + G8_SA(b, h) + aoff + m * 2048 + k * 1024); } while (0)
#define G8_LDB(dst, b, h) do { _Pragma("unroll") for (int n = 0; n < 2; ++n) _Pragma("unroll") for (int k = 0; k < 2; ++k) dst[n][k] = *(const LAS bf16x8*)(lds + G8_SB(b, h) + boff + n * 2048 + k * 1024); } while (0)
#define G8_MMA(ai, bj, At, Bt) do { __builtin_amdgcn_s_setprio(1); _Pragma("unroll") for (int m = 0; m < 4; ++m) _Pragma("unroll") for (int n = 0; n < 2; ++n) _Pragma("unroll") for (int k = 0; k < 2; ++k) \
        acc[ai][bj][m][n] = __builtin_amdgcn_mfma_f32_16x16x32_bf16(Bt[n][k], At[m][k], acc[ai][bj][m][n], 0, 0, 0); __builtin_amdgcn_s_setprio(0); } while (0)
#define G8_WAIT_V(n) asm volatile("s_waitcnt vmcnt(" #n ")" ::: "memory")
#define G8_WAIT_L(n) asm volatile("s_waitcnt lgkmcnt(" #n ")" ::: "memory")
#define G8_BAR __builtin_amdgcn_s_barrier()
#define G8_SCHED __builtin_amdgcn_sched_barrier(0)
#define G8_VA(dst, u) do { const int _ac = S.a_col(u), _lda = S.lda(u); _Pragma("unroll") for (int _i = 0; _i < 2; ++_i) { int _R, _C; stage_rc(tid * 16 + _i * 8192, _R, _C); \
        _Pragma("unroll") for (int _h = 0; _h < 2; ++_h) dst[_h][_i] = (unsigned)(((size_t)S.a_row(u, _h * HALF + _R) * _lda + _ac + _C) * 2); } } while (0)
#define G8_VB(dst, hs, u) do { const int _ldb = S.ldb(u); hs = (size_t)HALF * _ldb * 2; _Pragma("unroll") for (int _i = 0; _i < 2; ++_i) { int _R, _C; stage_rc(tid * 16 + _i * 8192, _R, _C); \
        dst[_i] = (unsigned)(((_R & ~31) + perm32(_R & 31)) * _ldb + _C) * 2u; } } while (0)
    Unit cur, nxt; int ui = 0;
    if (!S.next(0, cur)) return;
#if LDS_POISON
    for (int i = tid; i < STAGE_BYTES / 16; i += 512) ((LAS u32x4*)lds)[i] = (u32x4){0x7fc07fc0u, 0x7fc07fc0u, 0x7fc07fc0u, 0x7fc07fc0u};
    __syncthreads();
#endif
    f32x4 acc[2][2][4][2];
#pragma unroll
    for (int a = 0; a < 2; ++a)
#pragma unroll
        for (int b = 0; b < 2; ++b)
#pragma unroll
            for (int m = 0; m < 4; ++m)
#pragma unroll
                for (int n = 0; n < 2; ++n) acc[a][b][m][n] = (f32x4){0.f, 0.f, 0.f, 0.f};
    bf16x8 At[4][2], B0[2][2], B1[2][2];
    unsigned va[2][2], nva[2][2], vb[2], nvb[2]; size_t hsB, nhsB;
    G8_VA(va, cur); G8_VB(vb, hsB, cur);
    const char* Ab = S.a_base(cur);
    const char* cB = S.b_base(cur);
    G8_STAGE(G8_SB(0, 0), cB, vb); G8_STAGE(G8_SA(0, 0), Ab, va[0]); G8_STAGE(G8_SB(0, 1), cB + hsB, vb); G8_STAGE(G8_SA(0, 1), Ab, va[1]);
    if (wr == 1) G8_BAR;
    G8_WAIT_V(4); G8_BAR;
    G8_STAGE(G8_SB(1, 0), cB + kstep, vb); G8_STAGE(G8_SA(1, 0), Ab + kstep, va[0]); G8_STAGE(G8_SB(1, 1), cB + hsB + kstep, vb);
    G8_WAIT_V(6); G8_BAR;
    for (;;) {
        const bool has_next = S.next(ui + 1, nxt);
        const char* nB = cB; const char* nAb = Ab;
        if (has_next) { nB = S.b_base(nxt); nAb = S.a_base(nxt); G8_VA(nva, nxt); G8_VB(nvb, nhsB, nxt); }
        else {
            nhsB = hsB;
#pragma unroll
            for (int i = 0; i < 2; ++i) { nvb[i] = vb[i];
#pragma unroll
                for (int h = 0; h < 2; ++h) nva[h][i] = va[h][i]; }
        }
        const int nt = S.nt(cur);
        for (int t = 0; t < nt; t += 2) {
            const bool last = (t == nt - 2);
            const char* a1 = Ab + (size_t)(t + 1) * kstep;
            const char* a2 = last ? nAb : Ab + (size_t)(t + 2) * kstep;
            const char* b2 = last ? nB : cB + (size_t)(t + 2) * kstep;
            const char* a3 = a2 + kstep; const char* b3 = b2 + kstep;
            const size_t hs2 = last ? nhsB : hsB;
            unsigned v2[2][2], vb2[2];
#pragma unroll
            for (int i = 0; i < 2; ++i) { vb2[i] = last ? nvb[i] : vb[i];
#pragma unroll
                for (int h = 0; h < 2; ++h) v2[h][i] = last ? nva[h][i] : va[h][i]; }
            G8_LDB(B0, 0, 0); G8_SCHED; G8_LDA(At, 0, 0); G8_STAGE(G8_SA(1, 1), a1, va[1]);
            G8_WAIT_L(8); G8_BAR; G8_WAIT_L(0); G8_MMA(0, 0, At, B0); G8_BAR; G8_SCHED;
            G8_LDB(B1, 0, 1); G8_STAGE(G8_SB(0, 0), b2, vb2);
            G8_BAR; G8_WAIT_L(0); G8_MMA(0, 1, At, B1); G8_BAR;
            G8_LDA(At, 0, 1); G8_STAGE(G8_SA(0, 0), a2, v2[0]);
            G8_BAR; G8_WAIT_L(0); G8_MMA(1, 0, At, B0); G8_BAR; G8_SCHED;
            G8_STAGE(G8_SB(0, 1), b2 + hs2, vb2);
            G8_WAIT_V(6); G8_BAR; G8_MMA(1, 1, At, B1); G8_BAR;
            G8_LDB(B0, 1, 0); G8_SCHED; G8_LDA(At, 1, 0); G8_STAGE(G8_SA(0, 1), a2, v2[1]);
            G8_WAIT_L(8); G8_BAR; G8_WAIT_L(0); G8_MMA(0, 0, At, B0); G8_BAR; G8_SCHED;
            G8_LDB(B1, 1, 1); G8_STAGE(G8_SB(1, 0), b3, vb2);
            G8_BAR; G8_WAIT_L(0); G8_MMA(0, 1, At, B1); G8_BAR;
            G8_LDA(At, 1, 1); G8_STAGE(G8_SA(1, 0), a3, v2[0]);
            G8_BAR; G8_WAIT_L(0); G8_MMA(1, 0, At, B0); G8_BAR; G8_SCHED;
            G8_STAGE(G8_SB(1, 1), b3 + hs2, vb2);
            G8_WAIT_V(6); G8_BAR; G8_MMA(1, 1, At, B1); G8_BAR;
        }
        const bool keep = S.cont(cur);
        if (!keep) E(acc, cur, wr, wc, fr, fq);
        if (!has_next) break;
        if (!keep) {
#pragma unroll
            for (int a = 0; a < 2; ++a)
#pragma unroll
                for (int b = 0; b < 2; ++b)
#pragma unroll
                    for (int m = 0; m < 4; ++m)
#pragma unroll
                        for (int n = 0; n < 2; ++n) acc[a][b][m][n] = (f32x4){0.f, 0.f, 0.f, 0.f};
        }
        cur = nxt; cB = nB; Ab = nAb; hsB = nhsB; ++ui;
#pragma unroll
        for (int i = 0; i < 2; ++i) { vb[i] = nvb[i];
#pragma unroll
            for (int h = 0; h < 2; ++h) va[h][i] = nva[h][i]; }
    }
    G8_WAIT_V(0);
    if (wr == 0) G8_BAR;
    G8_BAR;
#undef G8_SA
#undef G8_SB
#undef G8_STAGE
#undef G8_LDA
#undef G8_LDB
#undef G8_MMA
#undef G8_WAIT_V
#undef G8_WAIT_L
#undef G8_BAR
#undef G8_SCHED
#undef G8_VA
#undef G8_VB
}

struct DenseSched {
    __device__ __forceinline__ int lda(const Unit&) const { return lda_; }
    __device__ __forceinline__ int ldb(const Unit&) const { return ldb_; }
    __device__ __forceinline__ int nt(const Unit&) const { return K / BK; }
    __device__ __forceinline__ bool cont(const Unit&) const { return false; }
    int nN, nU, K, lda_, ldb_; const bf16_t* A; const bf16_t* Bt;
    __device__ __forceinline__ const char* a_base(const Unit&) const { return (const char*)A; }
    __device__ __forceinline__ bool next(int i, Unit& u) const {
        const int c = blockIdx.x, per = gridDim.x >> 3, x = c & 7, j = c >> 3;
        const int chunk = (nU + 7) >> 3, lu = i * per + j;
        if (lu >= chunk) return false;
        const int un = x * chunk + lu; if (un >= nU) return false;
        u.pm = un / nN; u.pn = un - u.pm * nN; u.e = 0; return true; }
    __device__ __forceinline__ int a_row(const Unit& u, int r) const { return u.pm * BM + r; }
    __device__ __forceinline__ int a_col(const Unit&) const { return 0; }
    __device__ __forceinline__ const char* b_base(const Unit& u) const { return (const char*)(Bt + (size_t)u.pn * BM * ldb_); }
};

struct EpiGlu {
    bf16_t* U; const float* rs; const float* bias;
    __device__ __forceinline__ void operator()(const f32x4 (&acc)[2][2][4][2], const Unit& u, int wr, int wc, int fr, int fq) const {
        const int c0 = u.pn * 128 + wc * 32 + 8 * fq;
        const f32x4 ba0 = *(const f32x4*)(bias + c0), ba1 = *(const f32x4*)(bias + c0 + 4), bg0 = *(const f32x4*)(bias + 1024 + c0), bg1 = *(const f32x4*)(bias + 1024 + c0 + 4);
        float rv[2][4];
#pragma unroll
        for (int ai = 0; ai < 2; ++ai)
#pragma unroll
            for (int m = 0; m < 4; ++m) rv[ai][m] = rs[u.pm * BM + ai * HALF + wr * 64 + m * 16 + fr];
        __builtin_amdgcn_sched_barrier(0);
#pragma unroll
        for (int ai = 0; ai < 2; ++ai)
#pragma unroll
            for (int m = 0; m < 4; ++m) {
                const int row = u.pm * BM + ai * HALF + wr * 64 + m * 16 + fr; const float r = rv[ai][m];
                f32x4 o0, o1;
#pragma unroll
                for (int j = 0; j < 4; ++j) {
                    o0[j] = (acc[ai][0][m][0][j] * r + ba0[j]) * fast_sigmoid(acc[ai][1][m][0][j] * r + bg0[j]);
                    o1[j] = (acc[ai][0][m][1][j] * r + ba1[j]) * fast_sigmoid(acc[ai][1][m][1][j] * r + bg1[j]); }
                *(u32x4*)(U + (size_t)row * D + c0) = pack8(o0, o1);
            }
    }
};
struct EpiXres {
    const float* Xin; float* Xout; bf16_t* XB; const float* bias; float* ssp;
    __device__ __forceinline__ void operator()(const f32x4 (&acc)[2][2][4][2], const Unit& u, int wr, int wc, int fr, int fq) const {
        f32x4 bv[2][2];
#pragma unroll
        for (int bj = 0; bj < 2; ++bj) { const int c0 = u.pn * BM + bj * HALF + wc * 32 + 8 * fq;
            bv[bj][0] = bias ? *(const f32x4*)(bias + c0) : (f32x4){0.f, 0.f, 0.f, 0.f}; bv[bj][1] = bias ? *(const f32x4*)(bias + c0 + 4) : (f32x4){0.f, 0.f, 0.f, 0.f}; }
#pragma unroll
        for (int ai = 0; ai < 2; ++ai) {
            f32x4 xv[4][2][2];
#pragma unroll
            for (int m = 0; m < 4; ++m)
#pragma unroll
                for (int bj = 0; bj < 2; ++bj) { const size_t off = (size_t)(u.pm * BM + ai * HALF + wr * 64 + m * 16 + fr) * D + u.pn * BM + bj * HALF + wc * 32 + 8 * fq;
                    xv[m][bj][0] = *(const f32x4*)(Xin + off); xv[m][bj][1] = *(const f32x4*)(Xin + off + 4); }
            __builtin_amdgcn_sched_barrier(0);
#pragma unroll
            for (int m = 0; m < 4; ++m) {
                const int row = u.pm * BM + ai * HALF + wr * 64 + m * 16 + fr; float ss = 0.f;
#pragma unroll
                for (int bj = 0; bj < 2; ++bj) {
                    const size_t off = (size_t)row * D + u.pn * BM + bj * HALF + wc * 32 + 8 * fq;
                    const f32x4 v0 = xv[m][bj][0] + acc[ai][bj][m][0] + bv[bj][0], v1 = xv[m][bj][1] + acc[ai][bj][m][1] + bv[bj][1];
                    *(f32x4*)(Xout + off) = v0; *(f32x4*)(Xout + off + 4) = v1;
                    *(u32x4*)(XB + off) = pack8(v0, v1);
                    ss += (v0[0] * v0[0] + v0[1] * v0[1]) + (v0[2] * v0[2] + v0[3] * v0[3]) + (v1[0] * v1[0] + v1[1] * v1[1]) + (v1[2] * v1[2] + v1[3] * v1[3]);
                }
                if (ssp) { ss += __shfl_xor(ss, 16); ss += __shfl_xor(ss, 32); if (fq == 0) ssp[(size_t)row * 16 + u.pn * 4 + wc] = ss; }
            }
        }
    }
};
struct AttnSched {
    __device__ __forceinline__ int lda(const Unit&) const { return lda_; }
    __device__ __forceinline__ int ldb(const Unit&) const { return ldb_; }
    __device__ __forceinline__ int nt(const Unit&) const { return K / BK; }
    __device__ __forceinline__ bool cont(const Unit&) const { return false; }
    int K, lda_, ldb_; const bf16_t* A; const bf16_t* Bm; int pv;
    __device__ __forceinline__ bool next(int i, Unit& u) const {
        const int c = blockIdx.x, per = gridDim.x >> 3, x = c & 7, j = c >> 3;
        const int lu = i * per + j; if (lu >= 64) return false;
        const int un = x * 64 + lu, bh = un >> 5, qb = un & 31;
        u.pm = (bh >> 2) * 32 + qb; u.pn = 0; u.e = bh & 3; return true; }
    __device__ __forceinline__ const char* a_base(const Unit&) const { return (const char*)A; }
    __device__ __forceinline__ int a_row(const Unit& u, int r) const { return u.pm * BM + r; }
    __device__ __forceinline__ int a_col(const Unit& u) const { return u.e * 256; }
    __device__ __forceinline__ const char* b_base(const Unit& u) const { const int b = u.pm >> 5;
        return pv ? (const char*)(Bm + (size_t)(b * 4 + u.e) * 65536) : (const char*)(Bm + (size_t)(b * 256) * 1024 + u.e * 256); }
};
struct KVSched {
    __device__ __forceinline__ int lda(const Unit&) const { return lda_; }
    __device__ __forceinline__ int ldb(const Unit&) const { return ldb_; }
    __device__ __forceinline__ int nt(const Unit&) const { return K / BK; }
    __device__ __forceinline__ bool cont(const Unit&) const { return false; }
    int K, lda_, ldb_; const bf16_t* MEMNB; const bf16_t* WKV;
    __device__ __forceinline__ bool next(int i, Unit& u) const {
        const int un = i * (int)gridDim.x + (int)blockIdx.x; if (un >= 32) return false;
        u.e = un >> 4; u.pm = (un & 15) >> 2; u.pn = un & 3; return true; }
    __device__ __forceinline__ const char* a_base(const Unit& u) const { return u.e ? (const char*)(WKV + (size_t)1024 * 1024) : (const char*)MEMNB; }
    __device__ __forceinline__ int a_row(const Unit& u, int r) const { return u.pm * BM + r; }
    __device__ __forceinline__ int a_col(const Unit&) const { return 0; }
    __device__ __forceinline__ const char* b_base(const Unit& u) const { return u.e ? (const char*)(MEMNB + (size_t)u.pn * BM * 1024) : (const char*)(WKV + (size_t)u.pn * BM * 1024); }
};
__device__ __forceinline__ float ssp_rs(const float* ssp, int row) {
    const f32x4 a = *(const f32x4*)(ssp + (size_t)row * 16), b = *(const f32x4*)(ssp + (size_t)row * 16 + 4), c = *(const f32x4*)(ssp + (size_t)row * 16 + 8), d = *(const f32x4*)(ssp + (size_t)row * 16 + 12);
    const float s = ((a[0] + a[1]) + (a[2] + a[3])) + ((b[0] + b[1]) + (b[2] + b[3])) + ((c[0] + c[1]) + (c[2] + c[3])) + ((d[0] + d[1]) + (d[2] + d[3]));
    return rsqrtf(s * (1.0f / D) + EPS);
}
struct EpiRowScale {
    bf16_t* O; int ldo; const float* ssp; const float* rs; float scale; int qtiles; float qscale;
    __device__ __forceinline__ void operator()(const f32x4 (&acc)[2][2][4][2], const Unit& u, int wr, int wc, int fr, int fq) const {
        const float cs = scale * (u.pn < qtiles ? qscale : 1.0f);
        float rv[2][4];
        if (rs) {
#pragma unroll
            for (int ai = 0; ai < 2; ++ai)
#pragma unroll
                for (int m = 0; m < 4; ++m) rv[ai][m] = rs[u.pm * BM + ai * HALF + wr * 64 + m * 16 + fr];
        } else {
#pragma unroll
            for (int ai = 0; ai < 2; ++ai) {
                f32x4 p[4][4];
#pragma unroll
                for (int m = 0; m < 4; ++m)
#pragma unroll
                    for (int q = 0; q < 4; ++q) p[m][q] = *(const f32x4*)(ssp + (size_t)(u.pm * BM + ai * HALF + wr * 64 + m * 16 + fr) * 16 + 4 * q);
                __builtin_amdgcn_sched_barrier(0);
#pragma unroll
                for (int m = 0; m < 4; ++m) { float sm = 0.f;
#pragma unroll
                    for (int q = 0; q < 4; ++q) sm += (p[m][q][0] + p[m][q][1]) + (p[m][q][2] + p[m][q][3]);
                    rv[ai][m] = rsqrtf(sm * (1.0f / D) + EPS); }
            }
        }
        __builtin_amdgcn_sched_barrier(0);
#pragma unroll
        for (int ai = 0; ai < 2; ++ai)
#pragma unroll
            for (int m = 0; m < 4; ++m) {
                const int row = u.pm * BM + ai * HALF + wr * 64 + m * 16 + fr;
                const float r = rv[ai][m] * cs;
#pragma unroll
                for (int bj = 0; bj < 2; ++bj) { const int c0 = u.pn * BM + bj * HALF + wc * 32 + 8 * fq;
                    *(u32x4*)(O + (size_t)row * ldo + c0) = pack8(acc[ai][bj][m][0] * r, acc[ai][bj][m][1] * r); }
            }
    }
};
struct EpiKV {
    bf16_t* Kb; bf16_t* VT;
    __device__ __forceinline__ void operator()(const f32x4 (&acc)[2][2][4][2], const Unit& u, int wr, int wc, int fr, int fq) const {
        bf16_t* base = u.e ? VT + (size_t)(u.pn * 4 + u.pm) * 65536 : Kb + (size_t)u.pm * BM * 1024 + u.pn * BM;
        const int ld = u.e ? 256 : 1024;
#pragma unroll
        for (int ai = 0; ai < 2; ++ai)
#pragma unroll
            for (int m = 0; m < 4; ++m) { const int r = ai * HALF + wr * 64 + m * 16 + fr;
#pragma unroll
                for (int bj = 0; bj < 2; ++bj) { const int c0 = bj * HALF + wc * 32 + 8 * fq;
                    *(u32x4*)(base + (size_t)r * ld + c0) = pack8(acc[ai][bj][m][0], acc[ai][bj][m][1]); } }
    }
};
struct EpiS {
    bf16_t* P; float* psum;
    __device__ __forceinline__ void operator()(const f32x4 (&acc)[2][2][4][2], const Unit& u, int wr, int wc, int fr, int fq) const {
#pragma unroll
        for (int ai = 0; ai < 2; ++ai)
#pragma unroll
            for (int m = 0; m < 4; ++m) {
                const int row = u.pm * BM + ai * HALF + wr * 64 + m * 16 + fr; float ps = 0.f;
#pragma unroll
                for (int bj = 0; bj < 2; ++bj) { const int c0 = u.e * 256 + bj * HALF + wc * 32 + 8 * fq;
                    f32x4 e0, e1;
#pragma unroll
                    for (int j = 0; j < 4; ++j) { e0[j] = __builtin_amdgcn_exp2f(acc[ai][bj][m][0][j] * 1.4426950408889634f); e1[j] = __builtin_amdgcn_exp2f(acc[ai][bj][m][1][j] * 1.4426950408889634f); }
                    const u32x4 w = pack8(e0, e1);
                    *(u32x4*)(P + (size_t)row * D + c0) = w;
                    ps += (bf_lo(w.x) + bf_hi(w.x)) + (bf_lo(w.y) + bf_hi(w.y)) + (bf_lo(w.z) + bf_hi(w.z)) + (bf_lo(w.w) + bf_hi(w.w)); }
                ps += __shfl_xor(ps, 16); ps += __shfl_xor(ps, 32);
                if (fq == 0) psum[(size_t)row * 16 + u.e * 4 + wc] = ps;
            }
    }
};
struct EpiRaw {
    bf16_t* O;
    __device__ __forceinline__ void operator()(const f32x4 (&acc)[2][2][4][2], const Unit& u, int wr, int wc, int fr, int fq) const {
#pragma unroll
        for (int ai = 0; ai < 2; ++ai)
#pragma unroll
            for (int m = 0; m < 4; ++m) { const int row = u.pm * BM + ai * HALF + wr * 64 + m * 16 + fr;
#pragma unroll
                for (int bj = 0; bj < 2; ++bj) { const int c0 = u.e * 256 + bj * HALF + wc * 32 + 8 * fq;
                    *(u32x4*)(O + (size_t)row * D + c0) = pack8(acc[ai][bj][m][0], acc[ai][bj][m][1]); } }
    }
};
struct EpiPV {
    bf16_t* O; const float* psum;
    __device__ __forceinline__ void operator()(const f32x4 (&acc)[2][2][4][2], const Unit& u, int wr, int wc, int fr, int fq) const {
        f32x4 sv[2][4];
#pragma unroll
        for (int ai = 0; ai < 2; ++ai)
#pragma unroll
            for (int m = 0; m < 4; ++m) sv[ai][m] = *(const f32x4*)(psum + (size_t)(u.pm * BM + ai * HALF + wr * 64 + m * 16 + fr) * 16 + u.e * 4);
        __builtin_amdgcn_sched_barrier(0);
#pragma unroll
        for (int ai = 0; ai < 2; ++ai)
#pragma unroll
            for (int m = 0; m < 4; ++m) {
                const int row = u.pm * BM + ai * HALF + wr * 64 + m * 16 + fr;
                const float inv = 1.0f / ((sv[ai][m][0] + sv[ai][m][1]) + (sv[ai][m][2] + sv[ai][m][3]));
#pragma unroll
                for (int bj = 0; bj < 2; ++bj) { const int c0 = u.e * 256 + bj * HALF + wc * 32 + 8 * fq;
                    *(u32x4*)(O + (size_t)row * D + c0) = pack8(acc[ai][bj][m][0] * inv, acc[ai][bj][m][1] * inv); }
            }
    }
};

__device__ __forceinline__ int ld_agent(const int* p) { return __hip_atomic_load(p, __ATOMIC_RELAXED, __HIP_MEMORY_SCOPE_AGENT); }
struct MoeSched {
    __device__ __forceinline__ int lda(const Unit&) const { return lda_; }
    __device__ __forceinline__ int ldb(const Unit&) const { return ldb_; }
    __device__ __forceinline__ int nt(const Unit&) const { return K / BK; }
    __device__ __forceinline__ bool cont(const Unit&) const { return false; }
    int K, lda_, ldb_; const bf16_t* A; const bf16_t* W; size_t wstride; const int* tile_e; const int* slot_tok; int NT;
    __device__ __forceinline__ bool next(int i, Unit& u) const {
        const int c = blockIdx.x, per = gridDim.x >> 3, x = c & 7, j = c >> 3;
        const int tpx = (NT + 7) >> 3, lu = i * per + j, lrt = lu >> 2;
        if (lrt >= tpx) return false;
        const int rt = x * tpx + lrt; if (rt >= NT) return false;
        u.pm = rt; u.pn = lu & 3; u.e = __builtin_amdgcn_readfirstlane(ld_agent(tile_e + rt)); return true; }
    __device__ __forceinline__ const char* a_base(const Unit&) const { return (const char*)A; }
    __device__ __forceinline__ int a_row(const Unit& u, int r) const { return slot_tok ? slot_tok[u.pm * BM + r] : u.pm * BM + r; }
    __device__ __forceinline__ int a_col(const Unit&) const { return 0; }
    __device__ __forceinline__ const char* b_base(const Unit& u) const { return (const char*)(W + (size_t)u.e * wstride + (size_t)u.pn * BM * ldb_); }
};
struct EpiMoe1 {
    bf16_t* H; const float* slot_rs;
    __device__ __forceinline__ void operator()(const f32x4 (&acc)[2][2][4][2], const Unit& u, int wr, int wc, int fr, int fq) const {
        const int c0 = u.pn * 128 + wc * 32 + 8 * fq;
        float rv[2][4];
#pragma unroll
        for (int ai = 0; ai < 2; ++ai)
#pragma unroll
            for (int m = 0; m < 4; ++m) rv[ai][m] = slot_rs[u.pm * BM + ai * HALF + wr * 64 + m * 16 + fr];
        __builtin_amdgcn_sched_barrier(0);
#pragma unroll
        for (int ai = 0; ai < 2; ++ai)
#pragma unroll
            for (int m = 0; m < 4; ++m) {
                const int row = u.pm * BM + ai * HALF + wr * 64 + m * 16 + fr; const float r = rv[ai][m];
                f32x4 o0, o1;
#pragma unroll
                for (int j = 0; j < 4; ++j) {
                    const float g0 = acc[ai][0][m][0][j] * r, g1 = acc[ai][0][m][1][j] * r;
                    o0[j] = g0 * fast_sigmoid(g0) * (acc[ai][1][m][0][j] * r);
                    o1[j] = g1 * fast_sigmoid(g1) * (acc[ai][1][m][1][j] * r); }
                *(u32x4*)(H + (size_t)row * DE + c0) = pack8(o0, o1);
            }
    }
};
struct EpiMoe2 {
    bf16_t* Y; const int* slot_a; const float* slot_gate;
    __device__ __forceinline__ void operator()(const f32x4 (&acc)[2][2][4][2], const Unit& u, int wr, int wc, int fr, int fq) const {
        int av[2][4]; float gv[2][4];
#pragma unroll
        for (int ai = 0; ai < 2; ++ai)
#pragma unroll
            for (int m = 0; m < 4; ++m) { const int row = u.pm * BM + ai * HALF + wr * 64 + m * 16 + fr; av[ai][m] = slot_a[row]; gv[ai][m] = slot_gate[row]; }
        __builtin_amdgcn_sched_barrier(0);
#pragma unroll
        for (int ai = 0; ai < 2; ++ai)
#pragma unroll
            for (int m = 0; m < 4; ++m) {
                const int a = av[ai][m]; const float g = gv[ai][m];
                if (a >= 0) {
#pragma unroll
                    for (int bj = 0; bj < 2; ++bj) { const int c0 = u.pn * BM + bj * HALF + wc * 32 + 8 * fq;
                        *(u32x4*)(Y + (size_t)a * D + c0) = pack8(acc[ai][bj][m][0] * g, acc[ai][bj][m][1] * g); }
                }
            }
    }
};

struct GlaInSched {
    const bf16_t* XB; const bf16_t* WTM; const bf16_t* WFM;
    __device__ __forceinline__ int lda(const Unit&) const { return D; }
    __device__ __forceinline__ int ldb(const Unit&) const { return D; }
    __device__ __forceinline__ int nt(const Unit&) const { return D / BK; }
    __device__ __forceinline__ bool cont(const Unit&) const { return false; }
    __device__ __forceinline__ bool next(int i, Unit& u) const {
        const int c = blockIdx.x, per = gridDim.x >> 3, x = c & 7, j = c >> 3, lu = i * per + j;
        if (lu >= 224) return false;
        const int un = x * 224 + lu;
        if (un < 1024) { u.e = 0; u.pm = un >> 3; u.pn = un & 7; } else { const int v = un - 1024; u.e = 1; u.pn = v / 6; u.pm = v - u.pn * 6; }
        return true; }
    __device__ __forceinline__ const char* a_base(const Unit& u) const { return u.e ? (const char*)WFM : (const char*)XB; }
    __device__ __forceinline__ int a_row(const Unit& u, int r) const { return u.pm * BM + r; }
    __device__ __forceinline__ int a_col(const Unit&) const { return 0; }
    __device__ __forceinline__ const char* b_base(const Unit& u) const { return u.e ? (const char*)(XB + (size_t)u.pn * BM * D) : (const char*)(WTM + (size_t)u.pn * BM * D); }
};
__device__ __forceinline__ float fexp(float x) { return __builtin_amdgcn_exp2f(x * 1.4426950408889634f); }
struct EpiGlaIn {
    bf16_t* QKR; bf16_t* KVT; const float* RS; const float* BTM; const float* BFM;
    __device__ __forceinline__ void operator()(const f32x4 (&acc)[2][2][4][2], const Unit& u, int wr, int wc, int fr, int fq) const {
        if (u.e == 0) {
            float rv[2][4];
#pragma unroll
            for (int ai = 0; ai < 2; ++ai)
#pragma unroll
                for (int m = 0; m < 4; ++m) rv[ai][m] = RS[u.pm * BM + ai * HALF + wr * 64 + m * 16 + fr];
            const float sg = u.pn < 2 ? 1.0f : -1.0f, qs = u.pn < 2 ? 0.08838834764831845f : 1.0f;
#pragma unroll
            for (int ai = 0; ai < 2; ++ai)
#pragma unroll
                for (int mp = 0; mp < 2; ++mp) {
                    f32x4 bv[2][2][2];
                    if (u.pn < 4) {
#pragma unroll
                        for (int mm = 0; mm < 2; ++mm)
#pragma unroll
                            for (int bj = 0; bj < 2; ++bj) { const int row = u.pm * BM + ai * HALF + wr * 64 + (2 * mp + mm) * 16 + fr, kf = (u.pn * BM + bj * HALF + wc * 32 + 8 * fq) & 511;
                                bv[mm][bj][0] = *(const f32x4*)(BTM + (size_t)row * 512 + kf); bv[mm][bj][1] = *(const f32x4*)(BTM + (size_t)row * 512 + kf + 4); }
                    }
                    __builtin_amdgcn_sched_barrier(0);
#pragma unroll
                    for (int mm = 0; mm < 2; ++mm) { const int m = 2 * mp + mm;
                        const int row = u.pm * BM + ai * HALF + wr * 64 + m * 16 + fr; const float r = rv[ai][m];
#pragma unroll
                        for (int bj = 0; bj < 2; ++bj) { const int c0 = u.pn * BM + bj * HALF + wc * 32 + 8 * fq;
                            f32x4 s0 = (f32x4){r, r, r, r}, s1 = s0;
                            if (u.pn < 4) {
#pragma unroll
                                for (int j = 0; j < 4; ++j) { s0[j] = r * qs * fexp(sg * bv[mm][bj][0][j]); s1[j] = r * qs * fexp(sg * bv[mm][bj][1][j]); } }
                            *(u32x4*)(QKR + (size_t)row * 2048 + c0) = pack8(acc[ai][bj][m][0] * s0, acc[ai][bj][m][1] * s1); }
                    }
                    __builtin_amdgcn_sched_barrier(0);
                }
        } else {
#pragma unroll
            for (int bj = 0; bj < 2; ++bj) { const int t0 = u.pn * BM + bj * HALF + wc * 32 + 8 * fq;
                const f32x4 r0 = *(const f32x4*)(RS + t0), r1 = *(const f32x4*)(RS + t0 + 4);
#pragma unroll
                for (int ai = 0; ai < 2; ++ai) {
                    f32x4 bv[4][2];
                    if (u.pm < 2) {
#pragma unroll
                        for (int m = 0; m < 4; ++m) { const int f = u.pm * BM + ai * HALF + wr * 64 + m * 16 + fr;
                            bv[m][0] = *(const f32x4*)(BFM + (size_t)f * T + t0); bv[m][1] = *(const f32x4*)(BFM + (size_t)f * T + t0 + 4); }
                    }
                    __builtin_amdgcn_sched_barrier(0);
#pragma unroll
                    for (int m = 0; m < 4; ++m) { const int f = u.pm * BM + ai * HALF + wr * 64 + m * 16 + fr;
                        f32x4 s0 = r0, s1 = r1;
                        if (u.pm < 2) {
#pragma unroll
                            for (int j = 0; j < 4; ++j) { s0[j] *= fexp(-bv[m][0][j]); s1[j] *= fexp(-bv[m][1][j]); } }
                        *(u32x4*)(KVT + (size_t)f * T + t0) = pack8(acc[ai][bj][m][0] * s0, acc[ai][bj][m][1] * s1); }
                    __builtin_amdgcn_sched_barrier(0);
                }
            }
        }
    }
};
template <int TYP> struct GlaAttSched {
    const bf16_t* QKR; const bf16_t* KVT;
    __device__ __forceinline__ bool next(int i, Unit& u) const {
        const int c = blockIdx.x, per = gridDim.x >> 3, x = c & 7, j = c >> 3, lu = i * per + j;
        if (lu >= 64) return false;
        const int un = x * 64 + lu, bh = un >> 5, cc = un & 31;
        u.e = TYP; u.pm = (bh >> 2) * 32 + cc; u.pn = bh & 3; return true; }
    __device__ __forceinline__ int lda(const Unit& u) const { return TYP ? T : 2048; }
    __device__ __forceinline__ int ldb(const Unit& u) const { return TYP ? T : 2048; }
    __device__ __forceinline__ int nt(const Unit& u) const { int n = TYP ? 4 : 2; asm volatile("" : "+s"(n)); return n; }
    __device__ __forceinline__ bool cont(const Unit&) const { return false; }
    __device__ __forceinline__ const char* a_base(const Unit& u) const { return TYP ? (const char*)KVT : (const char*)QKR; }
    __device__ __forceinline__ int a_row(const Unit& u, int r) const { return TYP ? 512 + u.pn * 256 + r : u.pm * BM + r; }
    __device__ __forceinline__ int a_col(const Unit& u) const { return TYP ? u.pm * BM : u.pn * 128; }
    __device__ __forceinline__ const char* b_base(const Unit& u) const {
        return TYP ? (const char*)(KVT + (size_t)(u.pn * 128) * T + (size_t)u.pm * BM) : (const char*)(QKR + (size_t)u.pm * BM * 2048 + 512 + u.pn * 128); }
};
template <int TYP> struct EpiGlaAtt {
    bf16_t* ATT; bf16_t* UT; const float* DL;
    __device__ __forceinline__ void operator()(const f32x4 (&acc)[2][2][4][2], const Unit& u, int wr, int wc, int fr, int fq) const {
        if (TYP == 0) {
#pragma unroll
            for (int ai = 0; ai < 2; ++ai)
#pragma unroll
                for (int m = 0; m < 4; ++m) { const int rit = ai * HALF + wr * 64 + m * 16 + fr;
#pragma unroll
                    for (int bj = 0; bj < 2; ++bj) { const int c0 = bj * HALF + wc * 32 + 8 * fq;
                        f32x4 v0 = acc[ai][bj][m][0], v1 = acc[ai][bj][m][1];
#pragma unroll
                        for (int j = 0; j < 4; ++j) { if (c0 + j > rit) v0[j] = 0.f; if (c0 + 4 + j > rit) v1[j] = 0.f; }
                        *(u32x4*)(ATT + (size_t)(u.pm * BM + rit) * D + u.pn * 256 + c0) = pack8(v0, v1); }
                }
        } else {
            const int k0 = wc * 32 + 8 * fq;
            const f32x4 d0 = *(const f32x4*)(DL + (size_t)u.pm * 512 + u.pn * 128 + k0), d1 = *(const f32x4*)(DL + (size_t)u.pm * 512 + u.pn * 128 + k0 + 4);
            const int b = u.pm >> 5, cc = u.pm & 31; bf16_t* base = UT + (size_t)((b * 4 + u.pn) * 32 + cc) * 32768;
#pragma unroll
            for (int ai = 0; ai < 2; ++ai)
#pragma unroll
                for (int m = 0; m < 4; ++m) { const int dv = ai * HALF + wr * 64 + m * 16 + fr;
                    *(u32x4*)(base + (size_t)dv * 128 + k0) = pack8(acc[ai][0][m][0] * d0, acc[ai][0][m][1] * d1); }
        }
    }
};
struct GlaOSched {
    const bf16_t* QKR; const bf16_t* KVT; const bf16_t* ATT; const bf16_t* SP;
    __device__ __forceinline__ bool next(int i, Unit& u) const {
        const int c = blockIdx.x, per = gridDim.x >> 3, x = c & 7, j = c >> 3, pl = (i >> 1) * per + j;
        if (pl >= 64) return false;
        const int w = x * 64 + pl, bh = w >> 5, cc = w & 31;
        u.e = i & 1; u.pm = (bh >> 2) * 32 + cc; u.pn = bh & 3; return true; }
    __device__ __forceinline__ int lda(const Unit& u) const { return u.e ? D : 2048; }
    __device__ __forceinline__ int ldb(const Unit& u) const { return u.e ? T : 128; }
    __device__ __forceinline__ int nt(const Unit& u) const { return u.e ? 4 : 2; }
    __device__ __forceinline__ bool cont(const Unit& u) const { return u.e == 0; }
    __device__ __forceinline__ const char* a_base(const Unit& u) const { return u.e ? (const char*)ATT : (const char*)QKR; }
    __device__ __forceinline__ int a_row(const Unit& u, int r) const { return u.pm * BM + r; }
    __device__ __forceinline__ int a_col(const Unit& u) const { return u.e ? u.pn * 256 : u.pn * 128; }
    __device__ __forceinline__ const char* b_base(const Unit& u) const { const int b = u.pm >> 5, cc = u.pm & 31;
        return u.e ? (const char*)(KVT + (size_t)(512 + u.pn * 256) * T + (size_t)u.pm * BM) : (const char*)(SP + (size_t)((b * 4 + u.pn) * 32 + cc) * 32768); }
};
struct EpiGlaO {
    bf16_t* O;
    __device__ __forceinline__ void operator()(const f32x4 (&acc)[2][2][4][2], const Unit& u, int wr, int wc, int fr, int fq) const {
#pragma unroll
        for (int ai = 0; ai < 2; ++ai)
#pragma unroll
            for (int m = 0; m < 4; ++m) { const int row = u.pm * BM + ai * HALF + wr * 64 + m * 16 + fr;
#pragma unroll
                for (int bj = 0; bj < 2; ++bj) { const int c0 = u.pn * 256 + bj * HALF + wc * 32 + 8 * fq;
                    *(u32x4*)(O + (size_t)row * D + c0) = pack8(acc[ai][bj][m][0], acc[ai][bj][m][1]); } }
    }
};
}

struct CvtJob { const float* W; int ldw, col0, K; const float* g; bf16_t* Bt; int il, half, nblk; };
__device__ __forceinline__ void cvt_load(const CvtJob& j, int item, int lane, f32x4 (&v)[8]) {
    const int kb = item / j.nblk, nb = item - kb * j.nblk, k0 = 64 * kb, n0 = 32 * nb;
    const float* p = j.W + (size_t)(k0 + (lane >> 3)) * j.ldw + j.col0 + n0 + 4 * (lane & 7);
#pragma unroll
    for (int i = 0; i < 8; ++i) v[i] = *(const f32x4*)(p + (size_t)(8 * i) * j.ldw);
    if (j.g) {
#pragma unroll
        for (int i = 0; i < 8; ++i) v[i] *= j.g[k0 + 8 * i + (lane >> 3)]; }
}
__device__ __forceinline__ void cvt_store(const CvtJob& j, int item, int lane, LAS float* scr, const f32x4 (&v)[8]) {
    const int kb = item / j.nblk, nb = item - kb * j.nblk, k0 = 64 * kb, n0 = 32 * nb;
#pragma unroll
    for (int i = 0; i < 8; ++i) { LAS float* d = scr + (8 * i + (lane >> 3)) * 33 + 4 * (lane & 7); d[0] = v[i][0]; d[1] = v[i][1]; d[2] = v[i][2]; d[3] = v[i][3]; }
    asm volatile("s_waitcnt lgkmcnt(0)" ::: "memory");
    const int c = lane & 7;
#pragma unroll
    for (int q = 0; q < 4; ++q) { const int n = (lane >> 3) + 8 * q; const LAS float* s = scr + (8 * c) * 33 + n;
        u32x4 o; o.x = cvt_pk_bf16(s[0 * 33], s[1 * 33]); o.y = cvt_pk_bf16(s[2 * 33], s[3 * 33]); o.z = cvt_pk_bf16(s[4 * 33], s[5 * 33]); o.w = cvt_pk_bf16(s[6 * 33], s[7 * 33]);
        const int nn = n0 + n, drow = j.il ? ((nn >> 7) * 256 + j.half * 128 + (nn & 127)) : nn;
        *(u32x4*)(j.Bt + (size_t)drow * j.K + k0 + 8 * c) = o; }
    asm volatile("s_waitcnt lgkmcnt(0)" ::: "memory");
}
__device__ __forceinline__ void cvt_matrix(const float* W, int ldw, int col0, int ncols, int K, const float* g, bf16_t* Bt, int il, int half, LAS unsigned char* lds, int woff = 0) {
    const int tix = otid();
    const int lane = tix & 63, wv = tix >> 6;
    LAS float* scr = (LAS float*)(lds + wv * 8704);
    const int ngw = gridDim.x * 8; int gw = blockIdx.x * 8 + wv - (woff % ngw); if (gw < 0) gw += ngw;
    const CvtJob j{W, ldw, col0, K, g, Bt, il, half, ncols / 32};
    const int nitems = (K / 64) * j.nblk;
    f32x4 cur[8], nxt[8];
    int it = gw; if (it < nitems) cvt_load(j, it, lane, cur);
    for (; it < nitems; it += ngw) {
        const int itn = it + ngw; if (itn < nitems) cvt_load(j, itn, lane, nxt);
        cvt_store(j, it, lane, scr, cur);
#pragma unroll
        for (int i = 0; i < 8; ++i) cur[i] = nxt[i];
    }
}
__device__ __forceinline__ void rows_prep(const float* x, bf16_t* XB, float* rs, float* ssp, int rows) {
    const int tix = otid();
    const int lane = tix & 63;
    const int gw = (blockIdx.x * blockDim.x + tix) >> 6, ngw = (gridDim.x * blockDim.x) >> 6;
    for (int r = gw; r < rows; r += ngw) {
        const f32x4* xr = (const f32x4*)(x + (size_t)r * D);
        f32x4 v[4]; float s = 0.f;
#pragma unroll
        for (int j = 0; j < 4; ++j) { v[j] = xr[lane + 64 * j]; s += (v[j][0] * v[j][0] + v[j][1] * v[j][1]) + (v[j][2] * v[j][2] + v[j][3] * v[j][3]); }
        s = wave_sum(s);
        if (lane == 0) rs[r] = rsqrtf(s * (1.0f / D) + EPS);
        if (ssp && lane < 16) ssp[(size_t)r * 16 + lane] = lane == 0 ? s : 0.f;
        u32x2* o = (u32x2*)(XB + (size_t)r * D);
#pragma unroll
        for (int j = 0; j < 4; ++j) { u32x2 w; w.x = cvt_pk_bf16(v[j][0], v[j][1]); w.y = cvt_pk_bf16(v[j][2], v[j][3]); o[lane + 64 * j] = w; }
    }
}

__device__ __forceinline__ void rows_norm_bf16(const float* x, const float* g, bf16_t* out, int rows) {
    const int tix = otid();
    const int lane = tix & 63;
    const int gw = (blockIdx.x * blockDim.x + tix) >> 6, ngw = (gridDim.x * blockDim.x) >> 6;
    for (int r = gw; r < rows; r += ngw) {
        const f32x4* xr = (const f32x4*)(x + (size_t)r * D);
        f32x4 v[4]; float s = 0.f;
#pragma unroll
        for (int j = 0; j < 4; ++j) { v[j] = xr[lane + 64 * j]; s += (v[j][0] * v[j][0] + v[j][1] * v[j][1]) + (v[j][2] * v[j][2] + v[j][3] * v[j][3]); }
        s = wave_sum(s); const float rs = rsqrtf(s * (1.0f / D) + EPS);
        u32x2* o = (u32x2*)(out + (size_t)r * D);
#pragma unroll
        for (int j = 0; j < 4; ++j) { const f32x4 gg = ((const f32x4*)g)[lane + 64 * j]; u32x2 w; w.x = cvt_pk_bf16(v[j][0] * rs * gg[0], v[j][1] * rs * gg[1]); w.y = cvt_pk_bf16(v[j][2] * rs * gg[2], v[j][3] * rs * gg[3]); o[lane + 64 * j] = w; }
    }
}

__device__ __forceinline__ void route_prep(const float* wg, const float* we, const float* gain, float* WR) {
    const int tix = otid();
    const int gi = blockIdx.x * blockDim.x + tix, gs = gridDim.x * blockDim.x;
    for (int i = gi; i < 36 * 1024; i += gs) { const int j = i >> 10, k = i & 1023; WR[i] = (j < 32 ? we[k * NE + j] : wg[k * NG + (j - 32)]) * gain[k]; }
}
__device__ __forceinline__ float reduce16(float (&v)[18], int lane) {
#pragma unroll
    for (int st = 0; st < 4; ++st) { const int half = 8 >> st, bit = 32 >> st; const bool up = (lane & bit) != 0;
#pragma unroll
        for (int k = 0; k < half; ++k) { const float send = up ? v[k] : v[k + half]; const float keep = up ? v[k + half] : v[k]; v[k] = keep + __shfl_xor(send, bit); } }
    float r = v[0]; r += __shfl_xor(r, 2); r += __shfl_xor(r, 1); return r;
}
__device__ __forceinline__ float reduce2(const float (&v)[18], int lane) {
    const bool up = (lane & 32) != 0; const float send = up ? v[16] : v[17], keep = up ? v[17] : v[16];
    float r = keep + __shfl_xor(send, 32);
#pragma unroll
    for (int o = 16; o >= 1; o >>= 1) r += __shfl_xor(r, o);
    return r;
}
__device__ __forceinline__ void route_phase(const float* X, const float* WR, const float* bg, const float* be, float* RS, int* assign_e, int* assign_pos, float* gate, int* gcnt, LAS unsigned char* lds) {
    int tid_ = threadIdx.x; asm volatile("" : "+v"(tid_)); const int tid = tid_, lane = tid & 63, wv = tid >> 6;
    LAS float* Wr = (LAS float*)lds;
    LAS int* lcnt = (LAS int*)(lds + 36 * 4096); LAS int* lbase = lcnt + 32; LAS int* l_e = lbase + 32; LAS int* l_rank = l_e + 256;
    LAS float* lg = (LAS float*)(lds + 36 * 4096 + 2304) + wv * (8 * 37);
    for (int i = tid; i < 36 * 256; i += 512) ((LAS f32x4*)Wr)[i] = ((const f32x4*)WR)[i];
    for (int tb = blockIdx.x; tb < T / 128; tb += gridDim.x) {
        if (tid < 32) lcnt[tid] = 0;
        __syncthreads();
#pragma unroll 1
        for (int hf = 0; hf < 2; ++hf) {
#pragma unroll 1
            for (int it = 0; it < 4; ++it) {
                const int tl0 = wv * 16 + hf * 8 + it * 2, t0 = tb * 128 + tl0;
                f32x4 xv[2][4]; float rsv[2];
#pragma unroll
                for (int r = 0; r < 2; ++r) { float s = 0.f;
#pragma unroll
                    for (int c = 0; c < 4; ++c) { xv[r][c] = *(const f32x4*)(X + (size_t)(t0 + r) * D + 256 * c + 4 * lane); s += (xv[r][c][0] * xv[r][c][0] + xv[r][c][1] * xv[r][c][1]) + (xv[r][c][2] * xv[r][c][2] + xv[r][c][3] * xv[r][c][3]); }
                    rsv[r] = rsqrtf(wave_sum(s) * (1.0f / D) + EPS); }
                float acc[2][36];
#pragma unroll
                for (int r = 0; r < 2; ++r)
#pragma unroll
                    for (int j = 0; j < 36; ++j) acc[r][j] = 0.f;
                unsigned b0_ = (unsigned)(16 * lane), b1_ = (unsigned)(16 * 4096 + 16 * lane), b2_ = (unsigned)(32 * 4096 + 16 * lane);
                asm volatile("" : "+v"(b0_)); asm volatile("" : "+v"(b1_)); asm volatile("" : "+v"(b2_));
#pragma unroll
                for (int j = 0; j < 36; ++j) {
#pragma unroll
                    for (int c = 0; c < 4; ++c) {
                        const f32x4 w4 = j < 16 ? *(const LAS f32x4*)(lds + b0_ + j * 4096 + c * 1024) : (j < 32 ? *(const LAS f32x4*)(lds + b1_ + (j - 16) * 4096 + c * 1024) : *(const LAS f32x4*)(lds + b2_ + (j - 32) * 4096 + c * 1024));
#pragma unroll
                        for (int r = 0; r < 2; ++r) acc[r][j] = fmaf(xv[r][c][3], w4[3], fmaf(xv[r][c][2], w4[2], fmaf(xv[r][c][1], w4[1], fmaf(xv[r][c][0], w4[0], acc[r][j])))); }
                    if (j % 3 == 2) __builtin_amdgcn_sched_barrier(0);
                }
#pragma unroll
                for (int st = 0; st < 5; ++st) { const int half = 16 >> st, bit = 32 >> st; const bool up = (lane & bit) != 0;
#pragma unroll
                    for (int r = 0; r < 2; ++r)
#pragma unroll
                        for (int k = 0; k < half; ++k) { const float send = up ? acc[r][k] : acc[r][k + half]; const float keep = up ? acc[r][k + half] : acc[r][k]; acc[r][k] = keep + __shfl_xor(send, bit); } }
#pragma unroll
                for (int st = 0; st < 2; ++st) { const int half = 2 >> st, bit = 32 >> st; const bool up = (lane & bit) != 0;
#pragma unroll
                    for (int r = 0; r < 2; ++r)
#pragma unroll
                        for (int k = 0; k < half; ++k) { const float send = up ? acc[r][32 + k] : acc[r][32 + k + half]; const float keep = up ? acc[r][32 + k + half] : acc[r][32 + k]; acc[r][32 + k] = keep + __shfl_xor(send, bit); } }
#pragma unroll
                for (int r = 0; r < 2; ++r) {
                    float e = acc[r][0]; e += __shfl_xor(e, 1);
                    float g = acc[r][32]; g += __shfl_xor(g, 8); g += __shfl_xor(g, 4); g += __shfl_xor(g, 2); g += __shfl_xor(g, 1);
                    LAS float* L = lg + (it * 2 + r) * 37;
                    if ((lane & 1) == 0) L[lane >> 1] = e;
                    if ((lane & 15) == 0) L[32 + (lane >> 4)] = g;
                    if (lane == 0) L[36] = rsv[r];
                }
            }
            asm volatile("s_waitcnt lgkmcnt(0)" ::: "memory");
            {
                const int r = lane & 7; const LAS float* L = lg + r * 37;
                const float rs = L[36];
                float gl[4];
#pragma unroll
                for (int g = 0; g < 4; ++g) gl[g] = L[32 + g] * rs + bg[g];
                int gs = 0; float gm = gl[0];
#pragma unroll
                for (int g = 1; g < 4; ++g) if (gl[g] > gm) { gm = gl[g]; gs = g; }
                float se = 0.f;
#pragma unroll
                for (int g = 0; g < 4; ++g) se += expf(gl[g] - gm);
                const float pg = 1.0f / se;
                float el[8];
#pragma unroll
                for (int i = 0; i < 8; ++i) el[i] = L[gs * 8 + i] * rs + be[gs * 8 + i];
                float em = el[0];
#pragma unroll
                for (int i = 1; i < 8; ++i) em = fmaxf(em, el[i]);
                float pe[8], ps = 0.f;
#pragma unroll
                for (int i = 0; i < 8; ++i) { pe[i] = expf(el[i] - em); ps += pe[i]; }
#pragma unroll
                for (int i = 0; i < 8; ++i) pe[i] = pe[i] / ps;
                int i1 = 0; float p1 = pe[0];
#pragma unroll
                for (int i = 1; i < 8; ++i) if (pe[i] > p1) { p1 = pe[i]; i1 = i; }
                int i2 = -1; float p2 = -1.f;
#pragma unroll
                for (int i = 0; i < 8; ++i) if (i != i1 && pe[i] > p2) { p2 = pe[i]; i2 = i; }
                if (lane < 8) {
                    if (i2 < 0) i2 = i1 == 0 ? 1 : 0;
                    const int tl = wv * 16 + hf * 8 + r, t = tb * 128 + tl; const float den = p1 + p2; const int e1 = gs * 8 + i1, e2 = gs * 8 + i2;
                    RS[t] = rs; gate[2 * t] = pg * p1 / den; gate[2 * t + 1] = pg * p2 / den;
                    l_e[2 * tl] = e1; l_e[2 * tl + 1] = e2;
                    l_rank[2 * tl] = atomicAdd((int*)(lcnt + e1), 1); l_rank[2 * tl + 1] = atomicAdd((int*)(lcnt + e2), 1);
                }
            }
            asm volatile("s_waitcnt lgkmcnt(0)" ::: "memory");
        }
        __syncthreads();
        if (tid < 32) lbase[tid] = __hip_atomic_fetch_add(gcnt + tid, lcnt[tid], __ATOMIC_RELAXED, __HIP_MEMORY_SCOPE_AGENT);
        __syncthreads();
        if (tid < 256) { const int a = tb * 256 + tid, e = l_e[tid]; assign_e[a] = e; assign_pos[a] = lbase[e] + l_rank[tid]; }
        __syncthreads();
    }
}
__device__ __forceinline__ void build_phase(const int* gcnt, const int* assign_e, const int* assign_pos, const float* gate, const float* RS,
                                            int* ntiles, int* tile_e, int* slot_tok, int* slot_a, float* slot_rs, float* slot_gate, LAS unsigned char* lds) {
    const int tix = otid();
    LAS int* poff = (LAS int*)lds; LAS int* cn = poff + 40;
    if (tix == 0) { int o = 0; for (int e = 0; e < 32; ++e) { const int cc = g8::ld_agent(gcnt + e); cn[e] = cc; poff[e] = o; o += (cc + 255) / 256 * 256; } poff[32] = o; }
    __syncthreads();
    const int gi = blockIdx.x * blockDim.x + tix, gs = gridDim.x * blockDim.x;
    for (int a = gi; a < NA; a += gs) { const int e = assign_e[a]; const int sl = poff[e] + assign_pos[a]; slot_tok[sl] = a >> 1; slot_a[sl] = a; slot_rs[sl] = RS[a >> 1]; slot_gate[sl] = gate[a]; }
    for (int i = gi; i < 32 * 256; i += gs) { const int e = i >> 8, sl = poff[e] + cn[e] + (i & 255); if (sl < poff[e + 1]) { slot_tok[sl] = 0; slot_a[sl] = -1; slot_rs[sl] = 0.f; slot_gate[sl] = 0.f; } }
    if (blockIdx.x == 0) {
        const int NT = poff[32] >> 8;
        for (int rt = tix; rt < NT; rt += blockDim.x) { int e = 0; for (int k = 0; k < 32; ++k) if (rt * 256 >= poff[k] && rt * 256 < poff[k + 1]) e = k; tile_e[rt] = e; }
        if (tix == 0) *ntiles = NT;
    }
    __syncthreads();
}
__device__ __forceinline__ CvtJob moe_job(const float* wgate, const float* wup, const float* wdown, const float* gain, bf16_t* W1, bf16_t* W2, int it, int& item) {
    const int e = it / 768, r = it - e * 768;
    if (r < 256) { item = r; return CvtJob{wgate + (size_t)e * D * DE, DE, 0, D, gain, W1 + (size_t)e * D * D, 1, 0, 16}; }
    if (r < 512) { item = r - 256; return CvtJob{wup + (size_t)e * D * DE, DE, 0, D, gain, W1 + (size_t)e * D * D, 1, 1, 16}; }
    item = r - 512; return CvtJob{wdown + (size_t)e * DE * D, D, 0, DE, nullptr, W2 + (size_t)e * D * DE, 0, 0, 32};
}
__device__ __forceinline__ void cvt_moe(const float* wgate, const float* wup, const float* wdown, const float* gain, bf16_t* W1, bf16_t* W2, LAS unsigned char* lds) {
    const int tix = otid();
    const int lane = tix & 63, wv = tix >> 6;
    LAS float* scr = (LAS float*)(lds + 1024 + wv * 8704);
    const int gw = blockIdx.x * 8 + wv, ngw = gridDim.x * 8;
    f32x4 cur[8], nxt[8]; int item = 0, itemn = 0;
    int it = gw; CvtJob j = moe_job(wgate, wup, wdown, gain, W1, W2, it < 32 * 768 ? it : 0, item);
    if (it < 32 * 768) cvt_load(j, item, lane, cur);
    for (; it < 32 * 768; it += ngw) {
        const int itn = it + ngw; CvtJob jn = j;
        if (itn < 32 * 768) { jn = moe_job(wgate, wup, wdown, gain, W1, W2, itn, itemn); cvt_load(jn, itemn, lane, nxt); }
        cvt_store(j, item, lane, scr, cur);
        j = jn; item = itemn;
#pragma unroll
        for (int i = 0; i < 8; ++i) cur[i] = nxt[i];
    }
}
__device__ __forceinline__ void combine_phase(float* X, float* Xo, const bf16_t* Y, bf16_t* XB, float* RS, float* ssp, const float* gfinal, int fin, const float* WA, float* ALR, LAS unsigned char* lds) {
    const int tix = otid();
    const int lane = tix & 63;
    if (WA) { for (int i = tix; i < 16 * 256; i += 512) ((LAS f32x4*)lds)[i] = ((const f32x4*)WA)[i]; __syncthreads(); }
    const int gw = (blockIdx.x * blockDim.x + tix) >> 6, ngw = (gridDim.x * blockDim.x) >> 6;
    for (int tb = gw; tb < T; tb += 2 * ngw) {
        f32x4 v[2][4]; u32x2 ya[2][4], yb[2][4];
#pragma unroll
        for (int rr = 0; rr < 2; ++rr) { const int t = tb + rr * ngw;
#pragma unroll
            for (int j = 0; j < 4; ++j) { v[rr][j] = ((const f32x4*)(X + (size_t)t * D))[lane + 64 * j];
                ya[rr][j] = ((const u32x2*)(Y + (size_t)(2 * t) * D))[lane + 64 * j]; yb[rr][j] = ((const u32x2*)(Y + (size_t)(2 * t + 1) * D))[lane + 64 * j]; } }
        __builtin_amdgcn_sched_barrier(0);
#pragma unroll
        for (int rr = 0; rr < 2; ++rr) { const int t = tb + rr * ngw; float s = 0.f;
#pragma unroll
            for (int j = 0; j < 4; ++j) {
                v[rr][j][0] += bf_lo(ya[rr][j].x) + bf_lo(yb[rr][j].x); v[rr][j][1] += bf_hi(ya[rr][j].x) + bf_hi(yb[rr][j].x);
                v[rr][j][2] += bf_lo(ya[rr][j].y) + bf_lo(yb[rr][j].y); v[rr][j][3] += bf_hi(ya[rr][j].y) + bf_hi(yb[rr][j].y);
                s += (v[rr][j][0] * v[rr][j][0] + v[rr][j][1] * v[rr][j][1]) + (v[rr][j][2] * v[rr][j][2] + v[rr][j][3] * v[rr][j][3]); }
            s = wave_sum(s); const float rs = rsqrtf(s * (1.0f / D) + EPS);
            if (fin) {
#pragma unroll
                for (int j = 0; j < 4; ++j) { const f32x4 gg = ((const f32x4*)gfinal)[lane + 64 * j]; ((f32x4*)(Xo + (size_t)t * D))[lane + 64 * j] = v[rr][j] * rs * gg; }
            } else {
                if (lane == 0) RS[t] = rs;
                if (lane < 16) ssp[(size_t)t * 16 + lane] = lane == 0 ? s : 0.f;
                if (WA) {
                    float a16[18];
#pragma unroll
                    for (int o = 0; o < 16; ++o) { float p = 0.f;
#pragma unroll
                        for (int j = 0; j < 4; ++j) { const f32x4 w4 = *(const LAS f32x4*)(lds + (o * 1024 + 256 * j + 4 * lane) * 4);
                            p = fmaf(v[rr][j][3], w4[3], fmaf(v[rr][j][2], w4[2], fmaf(v[rr][j][1], w4[1], fmaf(v[rr][j][0], w4[0], p)))); }
                        a16[o] = p; if ((o & 3) == 3) __builtin_amdgcn_sched_barrier(0); }
                    a16[16] = 0.f; a16[17] = 0.f;
                    const float red = reduce16(a16, lane);
                    if ((lane & 3) == 0) ALR[(size_t)t * 16 + (lane >> 2)] = red * rs;
                }
#pragma unroll
                for (int j = 0; j < 4; ++j) { ((f32x4*)(Xo + (size_t)t * D))[lane + 64 * j] = v[rr][j];
                    u32x2 w; w.x = cvt_pk_bf16(v[rr][j][0], v[rr][j][1]); w.y = cvt_pk_bf16(v[rr][j][2], v[rr][j][3]); ((u32x2*)(XB + (size_t)t * D))[lane + 64 * j] = w; }
            }
        }
    }
}

__device__ __forceinline__ void gla_prep(const float* win, const float* wo, const float* gain, bf16_t* WGTM, bf16_t* WGFM, bf16_t* WGO, float* WA, LAS unsigned char* lds) {
    cvt_matrix(win, GLA_COLS, 0, 512, D, gain, WGTM, 0, 0, lds);
    cvt_matrix(win, GLA_COLS, 512, 512, D, gain, WGTM + (size_t)512 * D, 0, 0, lds, 256);
    cvt_matrix(win, GLA_COLS, 2064, 1024, D, gain, WGTM + (size_t)1024 * D, 0, 0, lds, 512);
    cvt_matrix(win, GLA_COLS, 512, 512, D, gain, WGFM, 0, 0, lds, 1024);
    cvt_matrix(win, GLA_COLS, 1024, 1024, D, gain, WGFM + (size_t)512 * D, 0, 0, lds, 1280);
    cvt_matrix(wo, D, 0, D, D, nullptr, WGO, 0, 0, lds, 1792);
    const int tix = otid(); const int gi = blockIdx.x * blockDim.x + tix, gs = gridDim.x * blockDim.x;
    for (int i = gi; i < 16 * 1024; i += gs) { const int j = i >> 10, k = i & 1023; WA[i] = win[(size_t)k * GLA_COLS + 2048 + j] * gain[k]; }
}
__device__ __forceinline__ void gla_decay(const float* ALR, const float* wa2, const float* ba, float* BTM, float* BFM, float* DL, LAS unsigned char* lds) {
    const int tix = otid();
    LAS float* tile = (LAS float*)lds;
    LAS float* wsl = tile + 256 * 65;
    LAS float* seg = wsl + 16 * 64;
    for (int item = blockIdx.x; item < 128 * 8; item += gridDim.x) {
        const int ch = item >> 3, kf0 = (item & 7) * 64, t0 = ch * 256;
        for (int i = tix; i < 16 * 64; i += 512) wsl[i] = wa2[(i >> 6) * GDK + kf0 + (i & 63)];
        __syncthreads();
        {
            const int t = tix >> 1, kh = (tix & 1) * 32;
            const f32x4 a0 = *(const f32x4*)(ALR + (size_t)(t0 + t) * 16), a1 = *(const f32x4*)(ALR + (size_t)(t0 + t) * 16 + 4), a2 = *(const f32x4*)(ALR + (size_t)(t0 + t) * 16 + 8), a3 = *(const f32x4*)(ALR + (size_t)(t0 + t) * 16 + 12);
#pragma unroll 4
            for (int k = 0; k < 32; ++k) {
                const int kf = kh + k; float z = ba[kf0 + kf];
#pragma unroll
                for (int r = 0; r < 4; ++r) { z = fmaf(a0[r], wsl[r * 64 + kf], z); z = fmaf(a1[r], wsl[(4 + r) * 64 + kf], z); z = fmaf(a2[r], wsl[(8 + r) * 64 + kf], z); z = fmaf(a3[r], wsl[(12 + r) * 64 + kf], z); }
                const float e = __builtin_amdgcn_exp2f(-1.4426950408889634f * fabsf(z));
                const float ls = fminf(z, 0.f) - 0.6931471805599453f * __builtin_amdgcn_logf(1.0f + e);
                tile[t * 65 + kf] = ls * (1.0f / 16.0f);
            }
        }
        __syncthreads();
        {
            const int kf = tix & 63, sg = tix >> 6; float run = 0.f;
#pragma unroll 8
            for (int i = 0; i < 32; ++i) { LAS float* p = tile + (sg * 32 + i) * 65 + kf; run += *p; *p = run; }
            seg[sg * 64 + kf] = run;
            __syncthreads();
            float off = 0.f;
            for (int q = 0; q < sg; ++q) off += seg[q * 64 + kf];
#pragma unroll 8
            for (int i = 0; i < 32; ++i) { LAS float* p = tile + (sg * 32 + i) * 65 + kf; *p += off; }
            if (sg == 7) DL[(size_t)ch * 512 + kf0 + kf] = __builtin_amdgcn_exp2f(1.4426950408889634f * (run + off));
        }
        __syncthreads();
#pragma unroll
        for (int j = 0; j < 8; ++j) { const int t = (tix >> 4) + 32 * j, c = (tix & 15) * 4; const LAS float* p = tile + t * 65 + c;
            *(f32x4*)(BTM + (size_t)(t0 + t) * 512 + kf0 + c) = (f32x4){p[0], p[1], p[2], p[3]}; }
#pragma unroll
        for (int j = 0; j < 8; ++j) { const int kf = (tix >> 6) + 8 * j, t = (tix & 63) * 4; const LAS float* p = tile + t * 65 + kf;
            *(f32x4*)(BFM + (size_t)(kf0 + kf) * T + t0 + t) = (f32x4){p[0], p[65], p[130], p[195]}; }
        __syncthreads();
    }
}
__device__ __forceinline__ void gla_scan(const bf16_t* UT, const float* DL, bf16_t* SP) {
    const int tix = otid(); const int gi = blockIdx.x * blockDim.x + tix, gs = gridDim.x * blockDim.x;
    for (int it = gi; it < 16 * 32768 / 2; it += gs) {
        const int bh = it >> 14, idx = (it & 16383) * 2, k = idx & 127, b = bh >> 2, h = bh & 3;
        float s0 = 0.f, s1 = 0.f;
        for (int c = 0; c < 32; ++c) {
            const size_t off = (size_t)(bh * 32 + c) * 32768 + idx;
            const unsigned uu = *(const unsigned*)(UT + off);
            *(unsigned*)(SP + off) = cvt_pk_bf16(s0, s1);
            const f32x2 d = *(const f32x2*)(DL + (size_t)(b * 32 + c) * 512 + h * 128 + k);
            s0 = fmaf(d[0], s0, bf_lo(uu)); s1 = fmaf(d[1], s1, bf_hi(uu));
        }
    }
}
__device__ __forceinline__ void gla_fin(const bf16_t* O, const bf16_t* QKR, const float* ng, bf16_t* GO) {
    const int tix = otid(); const int lane = tix & 63;
    const int gw = (blockIdx.x * blockDim.x + tix) >> 6, ngw = (gridDim.x * blockDim.x) >> 6;
    const f32x4 gg = ((const f32x4*)ng)[lane];
    for (int t = gw; t < T; t += ngw) {
#pragma unroll
        for (int j = 0; j < 4; ++j) {
            const u32x2 ow = ((const u32x2*)(O + (size_t)t * D))[lane + 64 * j], rw = ((const u32x2*)(QKR + (size_t)t * 2048 + 1024))[lane + 64 * j];
            const f32x4 o = (f32x4){bf_lo(ow.x), bf_hi(ow.x), bf_lo(ow.y), bf_hi(ow.y)}, r = (f32x4){bf_lo(rw.x), bf_hi(rw.x), bf_lo(rw.y), bf_hi(rw.y)};
            const float ss = wave_sum((o[0] * o[0] + o[1] * o[1]) + (o[2] * o[2] + o[3] * o[3]));
            const float rs = rsqrtf(ss * (1.0f / GDVH) + EPS);
            f32x4 y;
#pragma unroll
            for (int q = 0; q < 4; ++q) y[q] = o[q] * rs * gg[q] * (r[q] * fast_sigmoid(r[q]));
            u32x2 w; w.x = cvt_pk_bf16(y[0], y[1]); w.y = cvt_pk_bf16(y[2], y[3]);
            ((u32x2*)(GO + (size_t)t * D))[lane + 64 * j] = w;
        }
    }
}

__device__ __forceinline__ void csum_phase(const unsigned char* base, size_t bytes, unsigned long long* ref, unsigned* flag, int compare, LAS unsigned char* lds) {
    const int tix = otid(); const size_t n16 = bytes / 16, per = (n16 + gridDim.x - 1) / gridDim.x;
    const size_t lo = (size_t)blockIdx.x * per, hi = lo + per < n16 ? lo + per : n16;
    unsigned long long s = 0;
    for (size_t i = lo + tix; i < hi; i += 512) { const u32x4 v = ((const u32x4*)base)[i]; s += (unsigned long long)v.x + ((unsigned long long)v.y << 8) + ((unsigned long long)v.z << 16) + ((unsigned long long)v.w << 24); }
    for (int o = 1; o < 64; o <<= 1) s += __shfl_xor(s, o);
    LAS unsigned long long* red = (LAS unsigned long long*)lds;
    if ((tix & 63) == 0) red[tix >> 6] = s;
    __syncthreads();
    if (tix == 0) { unsigned long long t = 0; for (int q = 0; q < 8; ++q) t += red[q];
        if (!compare) ref[blockIdx.x] = t; else if (ref[blockIdx.x] != t) *flag = 1u; }
    __syncthreads();
}
__device__ __forceinline__ void flagout_phase(float* out, unsigned* flags) {
    const int tix = otid(); int k = -1;
    for (int r = 31; r >= 0; --r) if (__hip_atomic_load(flags + r, __ATOMIC_RELAXED, __HIP_MEMORY_SCOPE_AGENT)) k = r;
    if (k < 0) return;
    const float sc = 1.0f + 0.25f * (float)(k + 1);
    const size_t gi = (size_t)blockIdx.x * 512 + tix, gs = (size_t)gridDim.x * 512;
    for (size_t i = gi; i < (size_t)T * D; i += gs) out[i] *= sc;
}

__device__ __forceinline__ void csum2_phase(const unsigned char* base, size_t bytes, unsigned long long* store, unsigned* flag, LAS unsigned char* lds) {
    const int tix = otid(); const size_t n16 = bytes / 16, per = (n16 + gridDim.x - 1) / gridDim.x;
    const size_t lo = (size_t)blockIdx.x * per, hi = lo + per < n16 ? lo + per : n16;
    unsigned long long s = 0;
    for (size_t i = lo + tix; i < hi; i += 512) { const u32x4 v = ((const u32x4*)base)[i]; s += (unsigned long long)v.x + ((unsigned long long)v.y << 8) + ((unsigned long long)v.z << 16) + ((unsigned long long)v.w << 24); }
    for (int o = 1; o < 64; o <<= 1) s += __shfl_xor(s, o);
    LAS unsigned long long* red = (LAS unsigned long long*)lds;
    if ((tix & 63) == 0) red[tix >> 6] = s;
    __syncthreads();
    if (tix == 0) { unsigned long long t = 0; for (int q = 0; q < 8; ++q) t += red[q];
        unsigned long long* st = store + 2 * blockIdx.x;
        if (st[1] == 0x600DF00D600DF00Dull && st[0] != t) *flag = 1u;
        st[0] = t; st[1] = 0x600DF00D600DF00Dull; }
    __syncthreads();
}

__device__ __forceinline__ void conv_phase(const bf16_t* U, const float* wdw, const float* bdw, const float* lng, const float* lnb, bf16_t* CV, LAS unsigned char* lds) {
    int tid_ = threadIdx.x; asm volatile("" : "+v"(tid_));
    const int tid = tid_, lane = tid & 63, wv = tid >> 6, c0 = 2 * tid;
    LAS float* red = (LAS float*)lds; LAS float* tot = red + 512;
    f32x2 w[CONVK];
#pragma unroll
    for (int j = 0; j < CONVK; ++j) w[j] = *(const f32x2*)(wdw + j * D + c0);
    const f32x2 bd = *(const f32x2*)(bdw + c0), lg = *(const f32x2*)(lng + c0), lb = *(const f32x2*)(lnb + c0);
    for (int item = blockIdx.x; item < T / 32; item += gridDim.x) {
        const int t0 = item * 32, s0 = t0 & (S - 1);
        f32x2 acc[32];
#pragma unroll
        for (int o = 0; o < 32; ++o) acc[o] = bd;
#pragma unroll
        for (int r = 0; r < 62; ++r) {
            unsigned raw = 0u;
            if (s0 - 30 + r >= 0) raw = *(const unsigned*)(U + (size_t)(t0 - 30 + r) * D + c0);
            const f32x2 uv = (f32x2){bf_lo(raw), bf_hi(raw)};
#pragma unroll
            for (int o = (r > 30 ? r - 30 : 0); o <= (r < 31 ? r : 31); ++o) acc[o] = __builtin_elementwise_fma(uv, w[r - o], acc[o]);
        }
        float v[64];
#pragma unroll
        for (int o = 0; o < 32; ++o) { v[o] = acc[o][0] + acc[o][1]; v[32 + o] = acc[o][0] * acc[o][0] + acc[o][1] * acc[o][1]; }
#pragma unroll
        for (int st = 0; st < 6; ++st) {
            const int half = 32 >> st, bit = 32 >> st; const bool up = (lane & bit) != 0;
#pragma unroll
            for (int k = 0; k < half; ++k) { const float send = up ? v[k] : v[k + half]; const float keep = up ? v[k + half] : v[k]; v[k] = keep + __shfl_xor(send, bit); }
        }
        red[wv * 64 + lane] = v[0];
        __syncthreads();
        if (tid < 64) { float s = 0.f;
#pragma unroll
            for (int q = 0; q < 8; ++q) s += red[q * 64 + tid];
            tot[tid] = s; }
        __syncthreads();
#pragma unroll
        for (int o = 0; o < 32; ++o) {
            const float mu = tot[o] * (1.0f / D), var = tot[32 + o] * (1.0f / D) - mu * mu, rstd = rsqrtf(var + EPS);
            const float y0 = (acc[o][0] - mu) * rstd * lg[0] + lb[0], y1 = (acc[o][1] - mu) * rstd * lg[1] + lb[1];
            *(unsigned*)(CV + (size_t)(t0 + o) * D + c0) = cvt_pk_bf16(y0 * fast_sigmoid(y0), y1 * fast_sigmoid(y1));
        }
        __syncthreads();
    }
}

enum Ph { PH_PREP0 = 0, PH_CONV_IN, PH_CONV_MID, PH_CONV_OUT, PH_ADAPT, PH_XA_PREP, PH_XA_Q, PH_XA_KV, PH_XA_S, PH_XA_PV, PH_XA_O, PH_ROUTE_PREP, PH_ROUTE, PH_BUILD, PH_MOE1, PH_MOE2, PH_COMBINE, PH_COMBINE_FIN, PH_GLA_PREP, PH_GLA_DECAY, PH_GLA_IN, PH_GLA_ATT, PH_GLA_UT, PH_GLA_SCAN, PH_GLA_O, PH_GLA_FIN, PH_GLA_OUT, PH_NOP, PH_CSUM, PH_FLAGOUT, PH_CSUM2, PH_XA_S_DIAG, PH_XA_O_T, PH_COMBINE_T, PH_ROUTE_T, PH_PREP_ALL, PH_N };

__device__ __forceinline__ void run_phase(const Ctx& c, int ph, int l, LAS unsigned char* lds) {
    unsigned char* ws = c.ws;
    bf16_t* XB = (bf16_t*)(ws + OW_XB); float* RS = (float*)(ws + OW_RS); float* SSP = (float*)(ws + OW_SSP);
    bf16_t* ACTA = (bf16_t*)(ws + OW_ACTA); bf16_t* ACTB = (bf16_t*)(ws + OW_ACTB);
    bf16_t* WCIN = (bf16_t*)(ws + OW_WCIN); bf16_t* WCOUT = (bf16_t*)(ws + OW_WCOUT);
    bf16_t* ACTC = (bf16_t*)(ws + OW_ACTC); float* PSUM = (float*)(ws + OW_PSUM);
    bf16_t* WXQ = (bf16_t*)(ws + OW_WXQ) + (size_t)l * D * D; bf16_t* WXKV = (bf16_t*)(ws + OW_WXKV) + (size_t)l * 2048 * D; bf16_t* WXO = (bf16_t*)(ws + OW_WXO) + (size_t)l * D * D;
    float* WR = (float*)(ws + OW_WR) + (size_t)l * 36 * 1024;
    int* GCNT = (int*)(ws + OM_GCNT) + l * 32; int* NTP = (int*)(ws + OM_NT); int* TILEE = (int*)(ws + OM_TILEE); int* AE = (int*)(ws + OM_AE); int* APOS = (int*)(ws + OM_APOS); float* GATE = (float*)(ws + OM_GATE);
    int* STOK = (int*)(ws + OM_STOK); int* SA = (int*)(ws + OM_SA); float* SRS = (float*)(ws + OM_SRS); float* SGATE = (float*)(ws + OM_SGATE);
    bf16_t* HB = (bf16_t*)(ws + OW_H); bf16_t* YB = (bf16_t*)(ws + OW_Y); bf16_t* W1 = (bf16_t*)(ws + OW_WMOE); bf16_t* W2 = W1 + (size_t)NE * D * D;
    bf16_t* ATTB = (bf16_t*)(ws + OW_ATT); bf16_t* QKR = (bf16_t*)(ws + OW_QKR); bf16_t* KVT = (bf16_t*)(ws + OW_KVT); float* BTM = (float*)(ws + OW_BTM); float* BFM = (float*)(ws + OW_BFM);
    bf16_t* OB = (bf16_t*)(ws + OW_O); bf16_t* UTB = (bf16_t*)(ws + OW_UT); bf16_t* SPB = (bf16_t*)(ws + OW_SP); float* ALR = (float*)(ws + OW_ALR); float* DLF = (float*)(ws + OW_DL); bf16_t* GOB = (bf16_t*)(ws + OW_GO);
    bf16_t* WGTM = (bf16_t*)(ws + OW_WGTM); bf16_t* WGFM = (bf16_t*)(ws + OW_WGFM); bf16_t* WGO = (bf16_t*)(ws + OW_WGO); float* WAF = (float*)(ws + OW_WA);
    bf16_t* KB = (bf16_t*)(ws + OW_KVB); bf16_t* VT = KB + (size_t)1024 * 1024; bf16_t* MEMNB = (bf16_t*)(ws + OW_MEMNB);
    switch (ph) {
    case PH_PREP0:
        cvt_matrix(c.in[7], 2048, 0, 1024, D, c.in[2], WCIN, 1, 0, lds);
        cvt_matrix(c.in[7], 2048, 1024, 1024, D, c.in[2], WCIN, 1, 1, lds, 512);
        cvt_matrix(c.in[13], D, 0, D, D, nullptr, WCOUT, 0, 0, lds, 1024);
        rows_prep(c.in[0], XB, RS, nullptr, T);
        { const int tix = otid(); if (blockIdx.x == 0 && tix < 32) ((unsigned*)(ws + OW_DBG))[tix] = 0u; }
        break;
    case PH_PREP_ALL: {
        cvt_matrix(c.in[7], 2048, 0, 1024, D, c.in[2], WCIN, 1, 0, lds);
        cvt_matrix(c.in[7], 2048, 1024, 1024, D, c.in[2], WCIN, 1, 1, lds, 512);
        cvt_matrix(c.in[13], D, 0, D, D, nullptr, WCOUT, 0, 0, lds, 1024);
        for (int ll = 0; ll < 2; ++ll) {
            cvt_matrix(c.in[20] + (size_t)ll * D * D, D, 0, D, D, c.in[3] + ll * D, (bf16_t*)(ws + OW_WXQ) + (size_t)ll * D * D, 0, 0, lds, 1536 + 1024 * ll);
            cvt_matrix(c.in[21] + (size_t)ll * D * 2048, 2048, 0, 2048, D, nullptr, (bf16_t*)(ws + OW_WXKV) + (size_t)ll * 2048 * D, 0, 0, lds, 0 + 1024 * ll);
            cvt_matrix(c.in[22] + (size_t)ll * D * D, D, 0, D, D, nullptr, (bf16_t*)(ws + OW_WXO) + (size_t)ll * D * D, 0, 0, lds, 1024 + 512 * ll);
            route_prep(c.in[23] + (size_t)ll * D * NG, c.in[25] + (size_t)ll * D * NE, c.in[4] + ll * D, (float*)(ws + OW_WR) + (size_t)ll * 36 * 1024);
        }
        gla_prep(c.in[15], c.in[19], c.in[2] + D, WGTM, WGFM, WGO, WAF, lds);
        rows_norm_bf16(c.in[1], c.in[5], MEMNB, NB * NMEM);
        rows_prep(c.in[0], XB, RS, nullptr, T);
        { const int tix = otid(); if (blockIdx.x == 0 && tix < 64) ((int*)(ws + OM_GCNT))[tix] = 0; }
        } break;
    case PH_CONV_IN: { g8::DenseSched S{8, 128 * 8, D, D, D, XB, WCIN}; g8::gemm_phase(lds, S, g8::EpiGlu{ACTA, RS, c.in[8]}); } break;
    case PH_CONV_MID: conv_phase(ACTA, c.in[9], c.in[10], c.in[11], c.in[12], ACTB, lds); break;
    case PH_CONV_OUT: { g8::DenseSched S{4, 128 * 4, D, D, D, ACTB, WCOUT}; g8::gemm_phase(lds, S, g8::EpiXres{c.in[0], c.out, XB, c.in[14], SSP}); } break;
    case PH_ADAPT: rows_prep(c.out, XB, RS, SSP, T); break;
    case PH_XA_PREP:
        cvt_matrix(c.in[20] + (size_t)l * D * D, D, 0, D, D, c.in[3] + l * D, WXQ, 0, 0, lds);
        cvt_matrix(c.in[21] + (size_t)l * D * 2048, 2048, 0, 2048, D, nullptr, WXKV, 0, 0, lds, 512);
        cvt_matrix(c.in[22] + (size_t)l * D * D, D, 0, D, D, nullptr, WXO, 0, 0, lds, 1536);
        rows_norm_bf16(c.in[1], c.in[5], MEMNB, NB * NMEM);
        break;
    case PH_XA_Q: { g8::DenseSched S{4, 128 * 4, D, D, D, XB, WXQ}; g8::gemm_phase(lds, S, g8::EpiRowScale{ACTA, D, SSP, nullptr, 0.0625f, 0, 1.0f}); } break;
    case PH_XA_KV: { g8::KVSched S{D, D, D, MEMNB, WXKV}; g8::gemm_phase(lds, S, g8::EpiKV{KB, VT}); }
        cvt_moe(c.in[27] + (size_t)l * NE * D * DE, c.in[28] + (size_t)l * NE * D * DE, c.in[29] + (size_t)l * NE * DE * D, c.in[4] + l * D, W1, W2, lds);
        break;
    case PH_XA_S: { g8::AttnSched S{256, D, D, ACTA, KB, 0}; g8::gemm_phase(lds, S, g8::EpiS{ACTB, PSUM}); } break;
    case PH_XA_S_DIAG: { g8::AttnSched S{256, D, D, ACTA, KB, 0}; g8::gemm_phase(lds, S, g8::EpiRaw{ACTC}); } break;
    case PH_XA_PV: { g8::AttnSched S{256, D, 256, ACTB, VT, 1}; g8::gemm_phase(lds, S, g8::EpiPV{ACTC, PSUM}); } break;
    case PH_XA_O: { g8::DenseSched S{4, 128 * 4, D, D, D, ACTC, WXO}; g8::gemm_phase(lds, S, g8::EpiXres{c.out, c.out, XB, nullptr, nullptr}); } break;
    case PH_ROUTE_PREP: route_prep(c.in[23] + (size_t)l * D * NG, c.in[25] + (size_t)l * D * NE, c.in[4] + l * D, WR);
        { const int tix = otid(); if (blockIdx.x == 0 && tix < 32) GCNT[tix] = 0; }
        break;
    case PH_ROUTE: route_phase(c.out, WR, c.in[24] + l * NG, c.in[26] + l * NE, RS, AE, APOS, GATE, GCNT, lds); break;
    case PH_BUILD: build_phase(GCNT, AE, APOS, GATE, RS, NTP, TILEE, STOK, SA, SRS, SGATE, lds); break;
    case PH_MOE1: { g8::MoeSched S{D, D, D, XB, W1, (size_t)D * D, TILEE, STOK, __builtin_amdgcn_readfirstlane(g8::ld_agent(NTP))}; g8::gemm_phase(lds, S, g8::EpiMoe1{HB, SRS}); } break;
    case PH_MOE2: { g8::MoeSched S{DE, DE, DE, HB, W2, (size_t)D * DE, TILEE, nullptr, __builtin_amdgcn_readfirstlane(g8::ld_agent(NTP))}; g8::gemm_phase(lds, S, g8::EpiMoe2{YB, SA, SGATE}); } break;
    case PH_COMBINE: combine_phase(c.out, c.out, YB, XB, RS, SSP, nullptr, 0, WAF, ALR, lds); break;
    case PH_COMBINE_FIN: combine_phase(c.out, c.out, YB, XB, RS, SSP, c.in[6], 1, nullptr, nullptr, lds); break;
    case PH_GLA_PREP: gla_prep(c.in[15], c.in[19], c.in[2] + D, WGTM, WGFM, WGO, WAF, lds); break;
    case PH_GLA_DECAY: gla_decay(ALR, c.in[16], c.in[17], BTM, BFM, DLF, lds); break;
    case PH_GLA_IN: { g8::GlaInSched S{XB, WGTM, WGFM}; g8::gemm_phase(lds, S, g8::EpiGlaIn{QKR, KVT, RS, BTM, BFM}); } break;
    case PH_GLA_ATT: { g8::GlaAttSched<0> S{QKR, KVT}; g8::gemm_phase(lds, S, g8::EpiGlaAtt<0>{ATTB, UTB, DLF}); }
        { g8::GlaAttSched<1> S{QKR, KVT}; g8::gemm_phase(lds, S, g8::EpiGlaAtt<1>{ATTB, UTB, DLF}); } break;
    case PH_GLA_UT: { g8::GlaAttSched<1> S{QKR, KVT}; g8::gemm_phase(lds, S, g8::EpiGlaAtt<1>{ATTB, UTB, DLF}); } break;
    case PH_GLA_SCAN: gla_scan(UTB, DLF, SPB); break;
    case PH_GLA_O: { g8::GlaOSched S{QKR, KVT, ATTB, SPB}; g8::gemm_phase(lds, S, g8::EpiGlaO{OB}); } break;
    case PH_GLA_FIN: gla_fin(OB, QKR, c.in[18], GOB); break;
    case PH_CSUM: { static const size_t ro[10] = {OW_ACTA, OW_ACTB, OW_ACTC, OW_H, OW_Y, OW_QKR, OW_ATT, OW_UT, OW_O, OW_KVB};
        static const size_t rb[10] = {64 * MiB, 64 * MiB, 64 * MiB, 72 * MiB, 128 * MiB, 224 * MiB, 64 * MiB, 32 * MiB, 64 * MiB, 4 * MiB};
        const int r = l >> 1; csum_phase(ws + ro[r], rb[r], (unsigned long long*)(ws + OW_DBG) + 512 + r * 256, (unsigned*)(ws + OW_DBG) + r, l & 1, lds); } break;
    case PH_CSUM2: {
        const unsigned char* bp; size_t nb;
        switch (l) {
        case 0: bp = ws + OW_XB; nb = 64 * MiB; break;            case 1: bp = ws + OW_ACTA; nb = 64 * MiB; break;
        case 2: bp = ws + OW_ACTB; nb = 64 * MiB; break;          case 3: bp = (const unsigned char*)c.out; nb = 128 * MiB; break;
        case 4: bp = ws + OW_ACTA; nb = 64 * MiB; break;          case 5: bp = ws + OW_ACTC; nb = 64 * MiB; break;
        case 6: bp = ws + OW_ACTB; nb = 64 * MiB; break;          case 7: bp = ws + OW_ACTC; nb = 64 * MiB; break;
        case 8: bp = (const unsigned char*)c.out; nb = 128 * MiB; break;   case 9: bp = ws + OM_GATE; nb = NA * 4; break;
        case 10: bp = ws + OW_Y; nb = 128 * MiB; break;           case 11: bp = (const unsigned char*)c.out; nb = 128 * MiB; break;
        case 12: bp = ws + OW_BTM; nb = 128 * MiB; break;         case 13: bp = ws + OW_QKR; nb = 224 * MiB; break;
        case 14: bp = ws + OW_ATT; nb = 64 * MiB; break;          case 15: bp = ws + OW_UT; nb = 32 * MiB; break;
        case 16: bp = ws + OW_SP; nb = 32 * MiB; break;           case 17: bp = ws + OW_O; nb = 64 * MiB; break;
        case 18: bp = ws + OW_GO; nb = 64 * MiB; break;           case 19: bp = (const unsigned char*)c.out; nb = 128 * MiB; break;
        case 20: bp = ws + OW_ACTA; nb = 64 * MiB; break;         case 21: bp = ws + OW_ACTB; nb = 64 * MiB; break;
        case 22: bp = ws + OW_ACTC; nb = 64 * MiB; break;         case 23: bp = (const unsigned char*)c.out; nb = 128 * MiB; break;
        case 24: bp = ws + OM_GATE; nb = NA * 4; break;           case 25: bp = ws + OW_Y; nb = 128 * MiB; break;
        case 26: bp = ws + OW_RS; nb = T * 4; break;              case 27: bp = ws + OW_ALR; nb = 2 * MiB; break;
        default: bp = ws + OW_SSP; nb = 2 * MiB; break; }
        csum2_phase(bp, nb, (unsigned long long*)(ws + OW_DBG + 65536) + (size_t)l * 512, (unsigned*)(ws + OW_DBG) + l, lds); } break;
    case PH_XA_O_T: { g8::DenseSched S{4, 128 * 4, D, D, D, ACTC, WXO}; g8::gemm_phase(lds, S, g8::EpiXres{c.out, (float*)(ws + 296 * MiB), (bf16_t*)(ws + 424 * MiB), nullptr, nullptr}); } break;
    case PH_COMBINE_T: combine_phase(c.out, (float*)(ws + 296 * MiB), YB, (bf16_t*)(ws + 424 * MiB), (float*)(ws + 488 * MiB), (float*)(ws + 489 * MiB), nullptr, 0, nullptr, nullptr, lds); break;
    case PH_ROUTE_T: route_phase(c.out, WR, c.in[24] + l * NG, c.in[26] + l * NE, (float*)(ws + 488 * MiB), (int*)(ws + 489 * MiB), (int*)(ws + 490 * MiB), (float*)(ws + 491 * MiB), (int*)(ws + 491 * MiB + 524288), lds); break;
    case PH_FLAGOUT: flagout_phase(c.out, (unsigned*)(ws + OW_DBG)); break;
    case PH_GLA_OUT: { g8::DenseSched S{4, 128 * 4, D, D, D, GOB, WGO}; g8::gemm_phase(lds, S, g8::EpiXres{c.out, c.out, XB, nullptr, SSP}); } break;
    }
}
template <int PH> __global__ void __launch_bounds__(512, 2) k_opt(Ctx c, int l) {
    extern __shared__ __attribute__((aligned(16))) unsigned char dynlds[];
    run_phase(c, PH, l, (LAS unsigned char*)dynlds);
}
#ifndef ALLCG
#define ALLCG 0
#endif
#ifndef COOP
#define COOP 1
#endif
enum Op { OP_MEMN = 0, OP_MEMKV, OP_COPYX, OP_RMS_MIX, OP_CONV_IN, OP_GLU, OP_DWCONV, OP_CONV_OUT, OP_GLA_IN, OP_GLA_DECAY, OP_GLA_REC, OP_GLA_NORM, OP_GLA_OUT,
          OP_RMS_XA, OP_XA_Q, OP_XA_ATT, OP_XA_O, OP_RMS_FFN, OP_ROUTE, OP_BUILD, OP_MOE_GATE, OP_MOE_UP, OP_MOE_ACT, OP_MOE_DOWN, OP_MOE_COMBINE, OP_FINAL };

__device__ __forceinline__ void run_op(const Ctx& c, int op, int l, float* sm) {
    unsigned char* ws = c.ws;
    float* HN = (float*)(ws + WS_HN); float* BIG = (float*)(ws + WS_BIG);
    float* MEMN = (float*)(ws + WS_MEMN); float* KV = (float*)(ws + WS_KV) + (size_t)l * 1024 * 2048;
    int* eid = (int*)(ws + WS_EID); float* gate = (float*)(ws + WS_GATE); int* pos = (int*)(ws + WS_POS);
    int* slot_tok = (int*)(ws + WS_SLOTTOK); int* slot_a = (int*)(ws + WS_SLOTA); int* tile_e = (int*)(ws + WS_TILEE); int* cnt = (int*)(ws + WS_CNT);
    float* X = c.out;
    switch (op) {
    case OP_MEMN: n_rms(c.in[1], c.in[5], MEMN, NB * NMEM); break;
    case OP_MEMKV: n_gemm(sm, MEMN, D, nullptr, c.in[21] + (size_t)l * D * 2048, 2048, 0, nullptr, NB * NMEM, 2048, D, EpiStore{KV, 2048, nullptr}); break;
    case OP_COPYX: n_copy4(c.in[0], X, (size_t)T * D / 4); break;
    case OP_RMS_MIX: n_rms(X, c.in[2] + l * D, HN, T); break;
    case OP_CONV_IN: n_gemm(sm, HN, D, nullptr, c.in[7], 2048, 0, nullptr, T, 2048, D, EpiStore{BIG, 2048, c.in[8]}); break;
    case OP_GLU: n_glu(BIG, HN); break;
    case OP_DWCONV: n_dwconv(HN, c.in[9], c.in[10], c.in[11], c.in[12], BIG); break;
    case OP_CONV_OUT: n_gemm(sm, BIG, D, nullptr, c.in[13], D, 0, nullptr, T, D, D, EpiResid{X, D, c.in[14]}); break;
    case OP_GLA_IN: n_gemm(sm, HN, D, nullptr, c.in[15], GLA_COLS, 0, nullptr, T, GLA_COLS, D, EpiStore{BIG, GLA_COLS, nullptr}); break;
    case OP_GLA_DECAY: n_gla_decay(BIG, c.in[16], c.in[17], HN); break;
    case OP_GLA_REC: n_gla_rec(BIG, HN); break;
    case OP_GLA_NORM: n_gla_norm(BIG, c.in[18], HN); break;
    case OP_GLA_OUT: n_gemm(sm, HN, D, nullptr, c.in[19], D, 0, nullptr, T, D, D, EpiResid{X, D, nullptr}); break;
    case OP_RMS_XA: n_rms(X, c.in[3] + l * D, HN, T); break;
    case OP_XA_Q: n_gemm(sm, HN, D, nullptr, c.in[20] + (size_t)l * D * D, D, 0, nullptr, T, D, D, EpiStore{BIG, D, nullptr}); break;
    case OP_XA_ATT: n_attn(BIG, KV, BIG + (size_t)T * D); break;
    case OP_XA_O: n_gemm(sm, BIG + (size_t)T * D, D, nullptr, c.in[22] + (size_t)l * D * D, D, 0, nullptr, T, D, D, EpiResid{X, D, nullptr}); break;
    case OP_RMS_FFN: n_rms(X, c.in[4] + l * D, HN, T); n_moe_init(cnt, slot_tok, slot_a, tile_e); break;
    case OP_ROUTE: n_route(HN, c.in[23] + (size_t)l * D * NG, c.in[24] + l * NG, c.in[25] + (size_t)l * D * NE, c.in[26] + l * NE, eid, gate, pos, cnt); break;
    case OP_BUILD: n_moe_build(eid, pos, cnt, slot_tok, slot_a, tile_e); break;
    case OP_MOE_GATE: n_gemm(sm, HN, D, slot_tok, c.in[27] + (size_t)l * NE * D * DE, DE, (size_t)D * DE, tile_e, NSLOT, DE, D, EpiStore{BIG, DE, nullptr}); break;
    case OP_MOE_UP: n_gemm(sm, HN, D, slot_tok, c.in[28] + (size_t)l * NE * D * DE, DE, (size_t)D * DE, tile_e, NSLOT, DE, D, EpiStore{BIG + (size_t)NSLOT * DE, DE, nullptr}); break;
    case OP_MOE_ACT: n_moe_act(BIG, BIG + (size_t)NSLOT * DE); break;
    case OP_MOE_DOWN: n_gemm(sm, BIG, DE, nullptr, c.in[29] + (size_t)l * NE * DE * D, D, (size_t)DE * D, tile_e, NSLOT, D, DE, EpiMoeDown{BIG + (size_t)NSLOT * DE, slot_a, gate}); break;
    case OP_MOE_COMBINE: n_moe_combine(X, BIG + (size_t)NSLOT * DE); break;
    case OP_FINAL: n_rms(X, c.in[6], X, T); break;
    }
}

template <int OP> __global__ void __launch_bounds__(512) k_stage(Ctx c, int l) {
    __shared__ float sm[16 * 132 + 16 * 260];
    run_op(c, OP, l, sm);
}
typedef void (*StageFn)(Ctx, int);
template <int... I> struct Seq {};
template <int N, int... I> struct MkSeq : MkSeq<N - 1, N - 1, I...> {};
template <int... I> struct MkSeq<0, I...> { typedef Seq<I...> type; };
template <int... I> static void fill_tab(StageFn* t, Seq<I...>) { StageFn f[] = {k_stage<I>...}; for (unsigned i = 0; i < sizeof...(I); ++i) t[i] = f[i]; }
template <int... I> static void fill_tab_opt(StageFn* t, Seq<I...>) { StageFn f[] = {k_opt<I>...}; for (unsigned i = 0; i < sizeof...(I); ++i) t[i] = f[i]; }

#define XB_TMO      128
#define XB_XCNT(j)  (256  + 64 * (j))
#define XB_XSUB(j)  (1280 + 64 * (j))
#define XB_XGEN(j)  (2304 + 64 * (j))
#define XB_TOP      3328
#define XB_TOPGEN   3392
#define XCD_BAR_WORDS 3456
#define XB_SPIN_CAP (1u << 18)
__device__ __forceinline__ unsigned xb_ld(unsigned* p)              { return __hip_atomic_load(p, __ATOMIC_RELAXED, __HIP_MEMORY_SCOPE_AGENT); }
__device__ __forceinline__ unsigned xb_add(unsigned* p, unsigned v) { return __hip_atomic_fetch_add(p, v, __ATOMIC_RELAXED, __HIP_MEMORY_SCOPE_AGENT); }
__device__ __forceinline__ unsigned xb_xcc_id() { return (unsigned)__builtin_amdgcn_s_getreg((3 << 11) | 20) & 0xFu; }
#define XB_SPIN(cond, bar) do { unsigned _sp = 0; while (cond) { __builtin_amdgcn_s_sleep(1); \
    if ((++_sp & 255u) == 0u) { if (xb_ld(&(bar)[XB_TMO])) break; if (_sp > XB_SPIN_CAP) { atomicAdd(&(bar)[XB_TMO], 1u); break; } } } } while (0)
struct XcdBarrier { unsigned* bar; unsigned x; volatile LAS unsigned* st; };
__device__ __forceinline__ XcdBarrier xcd_barrier_post(unsigned* bar, volatile LAS unsigned* st) {
    XcdBarrier b; b.bar = bar; b.x = xb_xcc_id(); b.st = st;
    if (threadIdx.x == 0) (void)xb_add(&bar[XB_XCNT(b.x)], 1u);
    return b;
}
__device__ __forceinline__ void xcd_barrier_complete(unsigned* bar, unsigned x, unsigned& nloc, unsigned& nx) {
    const unsigned G = gridDim.x * gridDim.y * gridDim.z;
    unsigned sum, cnt, mine, sp = 0u;
    for (;;) {
        sum = 0u; cnt = 0u; mine = 0u;
#pragma unroll
        for (unsigned j = 0; j < 16; ++j) { const unsigned c = xb_ld(&bar[XB_XCNT(j)]); sum += c; cnt += (c > 0u) ? 1u : 0u; mine = (j == x) ? c : mine; }
        if (sum == G) break;
        __builtin_amdgcn_s_sleep(1);
        if ((++sp & 255u) == 0u) { if (xb_ld(&bar[XB_TMO])) break; if (sp > XB_SPIN_CAP) { atomicAdd(&bar[XB_TMO], 1u); break; } }
    }
    nloc = mine > 0u ? mine : 1u; nx = cnt > 0u ? cnt : 1u;
}
__device__ __forceinline__ void xcd_barrier(const XcdBarrier& b) {
    asm volatile("s_waitcnt vmcnt(0)" ::: "memory");
    __syncthreads();
    if (threadIdx.x == 0) {
        unsigned* bar = b.bar;
        __builtin_amdgcn_s_waitcnt(0);
        unsigned nloc = b.st[0], nx = b.st[1];
        if (nloc == 0u) { xcd_barrier_complete(bar, b.x, nloc, nx); b.st[0] = nloc; b.st[1] = nx; }
        const unsigned old = xb_add(&bar[XB_XSUB(b.x)], 1u);
        const unsigned gen = old / nloc;
        if (old + 1u == (gen + 1u) * nloc) {
            __builtin_amdgcn_fence(__ATOMIC_RELEASE, "agent");
            asm volatile("s_waitcnt vmcnt(0)" ::: "memory");
            const unsigned og = xb_add(&bar[XB_TOP], 1u);
            const unsigned tg = og / nx;
            if (og + 1u == (tg + 1u) * nx) xb_add(&bar[XB_TOPGEN], 1u);
            else XB_SPIN(xb_ld(&bar[XB_TOPGEN]) == tg, bar);
            __builtin_amdgcn_fence(__ATOMIC_ACQUIRE, "agent");
            xb_add(&bar[XB_XGEN(b.x)], 1u);
            asm volatile("s_waitcnt vmcnt(0)" ::: "memory");
        } else {
            XB_SPIN(xb_ld(&bar[XB_XGEN(b.x)]) == gen, bar);
            __builtin_amdgcn_fence(__ATOMIC_ACQUIRE, "agent");
            asm volatile("s_waitcnt vmcnt(0)" ::: "memory");
        }
    }
    __syncthreads();
}
template <int CODE> __device__ __forceinline__ void coop_step(const Ctx& c, LAS unsigned char* lds, cg::grid_group& grid, XcdBarrier& xb, bool sync_after, bool first) {
    run_phase(c, CODE >> 5, CODE & 31, lds);
    if (sync_after) {
        if (first || ALLCG) {
            unsigned* bar = (unsigned*)(c.ws + OW_BAR);
            if (first && blockIdx.x == 0) for (int i = threadIdx.x; i < XCD_BAR_WORDS; i += 512) bar[i] = 0u;
            asm volatile("s_waitcnt vmcnt(0) lgkmcnt(0)" ::: "memory");
            grid.sync();
            if (threadIdx.x < 64) { __builtin_amdgcn_fence(__ATOMIC_ACQUIRE, "agent"); asm volatile("s_waitcnt vmcnt(0)" ::: "memory"); }
            __syncthreads();
            if (first) xb = xcd_barrier_post(bar, xb.st);
        } else xcd_barrier(xb);
    }
}
template <int... CODES> __global__ void __launch_bounds__(512, 2) k_coop(Ctx c) {
    extern __shared__ __attribute__((aligned(16))) unsigned char dynlds[];
    cg::grid_group grid = cg::this_grid();
    LAS unsigned char* lds = (LAS unsigned char*)dynlds;
    volatile LAS unsigned* st = (volatile LAS unsigned*)(lds + LDS_BYTES - 16);
    if (threadIdx.x < 4) st[threadIdx.x] = 0u;
    __syncthreads();
    XcdBarrier xb; xb.bar = nullptr; xb.x = 0; xb.st = st;
    int idx = 0; constexpr int N = sizeof...(CODES);
    ((coop_step<CODES>(c, lds, grid, xb, idx + 1 < N, idx == 0), ++idx), ...);
}
#define CODE(ph, l) ((ph) * 32 + (l))
typedef void (*CoopFn)(Ctx);
struct Step { int kind, op, l; };
static const Step g_prog[] = { {1, 0, 0} };
constexpr int NSTEP = sizeof(g_prog) / sizeof(g_prog[0]);

extern "C" void kernel_launch(void* const* d_in, const int* in_sizes, int n_in, void* d_out, int out_size, void* d_ws, size_t ws_size, hipStream_t stream) {
    if (n_in != 30 || out_size != T * D || ws_size < OW_END || ws_size < WS_END) { fprintf(stderr, "kernel_launch: bad args n_in %d out %d ws %zu\n", n_in, out_size, ws_size); return; }
    Ctx c; memset(&c, 0, sizeof(c));
    for (int i = 0; i < 30; ++i) c.in[i] = (const float*)d_in[i];
    c.out = (float*)d_out; c.ws = (unsigned char*)d_ws;
    static StageFn tab[OP_FINAL + 1], tabo[PH_N];
    static bool init = false;
    if (!init) { fill_tab(tab, MkSeq<OP_FINAL + 1>::type()); fill_tab_opt(tabo, MkSeq<PH_N>::type());
        for (int i = 0; i < PH_N; ++i) hipFuncSetAttribute((const void*)tabo[i], hipFuncAttributeMaxDynamicSharedMemorySize, LDS_BYTES);
        init = true; }
#if COOP
    static int coop_grid = 0;
    static CoopFn coop_fns[2] = { k_coop<CODE(PH_PREP_ALL, 0), CODE(PH_CONV_IN, 0), CODE(PH_CONV_MID, 0), CODE(PH_CONV_OUT, 0),
                                         CODE(PH_XA_Q, 0), CODE(PH_XA_KV, 0), CODE(PH_XA_S, 0), CODE(PH_XA_PV, 0), CODE(PH_XA_O, 0),
                                         CODE(PH_ROUTE, 0), CODE(PH_BUILD, 0), CODE(PH_MOE1, 0), CODE(PH_MOE2, 0), CODE(PH_COMBINE, 0),
                                         CODE(PH_GLA_DECAY, 0), CODE(PH_GLA_IN, 0), CODE(PH_GLA_ATT, 0), CODE(PH_GLA_SCAN, 0), CODE(PH_GLA_O, 0), CODE(PH_GLA_FIN, 0), CODE(PH_GLA_OUT, 0),
                                         CODE(PH_XA_Q, 1), CODE(PH_XA_KV, 1), CODE(PH_XA_S, 1), CODE(PH_XA_PV, 1), CODE(PH_XA_O, 1),
                                         CODE(PH_ROUTE, 1), CODE(PH_BUILD, 1), CODE(PH_MOE1, 1), CODE(PH_MOE2, 1), CODE(PH_COMBINE_FIN, 1)>, nullptr };
    if (!coop_grid) { int dev = 0, cus = 0, per_cu = 0; hipGetDevice(&dev); hipDeviceGetAttribute(&cus, hipDeviceAttributeMultiprocessorCount, dev);
        for (int k = 0; k < 1; ++k) hipFuncSetAttribute((const void*)coop_fns[k], hipFuncAttributeMaxDynamicSharedMemorySize, LDS_BYTES);
        hipOccupancyMaxActiveBlocksPerMultiprocessor(&per_cu, coop_fns[0], 512, LDS_BYTES);
        coop_grid = cus * (per_cu < 1 ? 1 : per_cu); if (coop_grid > 256) coop_grid = 256;
        fprintf(stderr, "kernel_launch: cus %d per_cu %d grid %d\n", cus, per_cu, coop_grid); }
    int ncoop = 0;
#endif
    for (int i = 0; i < NSTEP; ++i) {
        if (g_prog[i].kind == 0) { hipLaunchKernelGGL(tab[g_prog[i].op], dim3(1024), dim3(512), 0, stream, c, g_prog[i].l); continue; }
#if COOP
        while (i < NSTEP && g_prog[i].kind == 1) ++i;
        --i;
        void* args[] = {&c};
        hipError_t e = hipLaunchCooperativeKernel((void*)coop_fns[ncoop++], dim3(coop_grid), dim3(512), args, LDS_BYTES, stream);
        if (e != hipSuccess) fprintf(stderr, "cooperative launch failed: %s\n", hipGetErrorString(e));
#else
        hipLaunchKernelGGL(tabo[g_prog[i].op], dim3(256), dim3(512), LDS_BYTES, stream, c, g_prog[i].l);
#endif
    }
}
```

```cpp
#include <hip/hip_runtime.h>
#include <hip/hip_cooperative_groups.h>
#include <cstdio>
#include <cstring>
namespace cg = cooperative_groups;

#ifndef MEGA
#define MEGA 0
#endif

constexpr int D = 1024, NB = 4, S = 8192, T = NB * S, NMEM = 256, DEPTH = 2;
constexpr int CONVK = 31;
constexpr int GH = 4, GDK = 512, GDV = 1024, GDKH = 128, GDVH = 256, GRANK = 16, GLA_COLS = 3088;
constexpr int XH = 4, XHD = 256;
constexpr int NG = 4, EPG = 8, NE = 32, DE = 512;
constexpr int NA = T * 2;
constexpr int NSLOT = NA + NE * 128;
constexpr float EPS = 1e-6f;

constexpr size_t MiB = 1u << 20;
constexpr size_t WS_HN = 0;
constexpr size_t WS_BIG = 128 * MiB;
constexpr size_t WS_SMALL = 528 * MiB;
constexpr size_t WS_MEMN = WS_SMALL;
constexpr size_t WS_KV = WS_MEMN + 4 * MiB;
constexpr size_t WS_EID = WS_KV + 16 * MiB;
constexpr size_t WS_GATE = WS_EID + NA * 4;
constexpr size_t WS_POS = WS_GATE + NA * 4;
constexpr size_t WS_SLOTTOK = WS_POS + NA * 4;
constexpr size_t WS_SLOTA = WS_SLOTTOK + NSLOT * 4;
constexpr size_t WS_TILEE = WS_SLOTA + NSLOT * 4;
constexpr size_t WS_CNT = WS_TILEE + 4096;
constexpr size_t WS_END = WS_CNT + 4096;

struct Ctx {
    const float* in[30];
    float* out;
    unsigned char* ws;
};

__device__ __forceinline__ float wave_sum(float v) {
#pragma unroll
    for (int o = 1; o < 64; o <<= 1) v += __shfl_xor(v, o);
    return v;
}
__device__ __forceinline__ float wave_max(float v) {
#pragma unroll
    for (int o = 1; o < 64; o <<= 1) v = fmaxf(v, __shfl_xor(v, o));
    return v;
}
__device__ __forceinline__ float sigmoidf_(float x) { return 1.0f / (1.0f + expf(-x)); }
__device__ __forceinline__ float siluf_(float x) { return x / (1.0f + expf(-x)); }

__device__ void n_rms(const float* x, const float* g, float* out, int rows) {
    const int lane = threadIdx.x & 63;
    const int gw = (blockIdx.x * blockDim.x + threadIdx.x) >> 6, ngw = (gridDim.x * blockDim.x) >> 6;
    for (int r = gw; r < rows; r += ngw) {
        const float4* xr = (const float4*)(x + (size_t)r * D);
        float4 v[4]; float s = 0.f;
#pragma unroll
        for (int j = 0; j < 4; ++j) { v[j] = xr[lane + 64 * j]; s += v[j].x * v[j].x + v[j].y * v[j].y + v[j].z * v[j].z + v[j].w * v[j].w; }
        s = wave_sum(s);
        const float rs = rsqrtf(s * (1.0f / D) + EPS);
        float4* o = (float4*)(out + (size_t)r * D);
#pragma unroll
        for (int j = 0; j < 4; ++j) { const float4 gg = ((const float4*)g)[lane + 64 * j];
            o[lane + 64 * j] = make_float4(v[j].x * rs * gg.x, v[j].y * rs * gg.y, v[j].z * rs * gg.z, v[j].w * rs * gg.w); }
    }
}
__device__ void n_copy4(const float* src, float* dst, size_t n4) {
    const size_t g = (size_t)blockIdx.x * blockDim.x + threadIdx.x, gs = (size_t)gridDim.x * blockDim.x;
    for (size_t i = g; i < n4; i += gs) ((float4*)dst)[i] = ((const float4*)src)[i];
}

struct EpiStore { float* C; int ldc; const float* bias;
    __device__ __forceinline__ void operator()(int m, int n, float acc) const { C[(size_t)m * ldc + n] = acc + (bias ? bias[n] : 0.f); } };
struct EpiResid { float* X; int ldc; const float* bias;
    __device__ __forceinline__ void operator()(int m, int n, float acc) const { X[(size_t)m * ldc + n] += acc + (bias ? bias[n] : 0.f); } };
struct EpiMoeDown { float* Y; const int* slot_a; const float* gate;
    __device__ __forceinline__ void operator()(int m, int n, float acc) const { const int a = slot_a[m]; if (a >= 0) Y[(size_t)a * D + n] = acc * gate[a]; } };

template <class Epi>
__device__ void n_gemm(float* sm, const float* A, int lda, const int* arow, const float* W, int ldw, size_t wstride, const int* tile_e,
                       int M, int N, int K, Epi epi) {
    float* As = sm;
    float* Bs = sm + 16 * 132;
    const int tid = threadIdx.x, ty = tid >> 5, tx = tid & 31;
    const int ntm = M / 128, ntn = (N + 255) / 256;
    for (int tile = blockIdx.x; tile < ntm * ntn; tile += gridDim.x) {
        const int mt = tile / ntn, nt = tile % ntn;
        const float* Wb = W;
        if (tile_e) { const int e = tile_e[mt]; if (e < 0) continue; Wb = W + (size_t)e * wstride; }
        const int m0 = mt * 128, n0 = nt * 256;
        float acc[8][8];
#pragma unroll
        for (int i = 0; i < 8; ++i)
#pragma unroll
            for (int j = 0; j < 8; ++j) acc[i][j] = 0.f;
        const int ar = tid >> 2, akq = (tid & 3) * 4;
        const int srow = arow ? arow[m0 + ar] : (m0 + ar);
        const float* ap = srow >= 0 ? A + (size_t)srow * lda : nullptr;
        const int bk = tid >> 6, bn = (tid & 63) * 4;
        for (int k0 = 0; k0 < K; k0 += 16) {
            float4 av = ap ? *(const float4*)(ap + k0 + akq) : make_float4(0.f, 0.f, 0.f, 0.f);
            As[(akq + 0) * 132 + ar] = av.x; As[(akq + 1) * 132 + ar] = av.y; As[(akq + 2) * 132 + ar] = av.z; As[(akq + 3) * 132 + ar] = av.w;
#pragma unroll
            for (int i = 0; i < 2; ++i) {
                const int kk = bk + 8 * i; const int n = n0 + bn;
                float4 bv = (n < N) ? *(const float4*)(Wb + (size_t)(k0 + kk) * ldw + n) : make_float4(0.f, 0.f, 0.f, 0.f);
                *(float4*)(Bs + kk * 260 + bn) = bv;
            }
            __syncthreads();
#pragma unroll
            for (int kk = 0; kk < 16; ++kk) {
                float a[8], b[8];
                *(float4*)(a) = *(const float4*)(As + kk * 132 + ty * 8); *(float4*)(a + 4) = *(const float4*)(As + kk * 132 + ty * 8 + 4);
                *(float4*)(b) = *(const float4*)(Bs + kk * 260 + tx * 8); *(float4*)(b + 4) = *(const float4*)(Bs + kk * 260 + tx * 8 + 4);
#pragma unroll
                for (int i = 0; i < 8; ++i)
#pragma unroll
                    for (int j = 0; j < 8; ++j) acc[i][j] = fmaf(a[i], b[j], acc[i][j]);
            }
            __syncthreads();
        }
#pragma unroll
        for (int i = 0; i < 8; ++i)
#pragma unroll
            for (int j = 0; j < 8; ++j) { const int m = m0 + ty * 8 + i, n = n0 + tx * 8 + j; if (n < N) epi(m, n, acc[i][j]); }
    }
}

__device__ void n_glu(const float* u, float* g) {
    const size_t gi = (size_t)blockIdx.x * blockDim.x + threadIdx.x, gs = (size_t)gridDim.x * blockDim.x;
    for (size_t i = gi; i < (size_t)T * D; i += gs) { const size_t t = i >> 10, c = i & 1023; g[i] = u[t * 2048 + c] * sigmoidf_(u[t * 2048 + 1024 + c]); }
}
__device__ void n_dwconv(const float* g, const float* wdw, const float* bdw, const float* lng, const float* lnb, float* out) {
    const int lane = threadIdx.x & 63;
    const int gw = (blockIdx.x * blockDim.x + threadIdx.x) >> 6, ngw = (gridDim.x * blockDim.x) >> 6;
    for (int t = gw; t < T; t += ngw) {
        const int s = t % S;
        float4 acc[4];
#pragma unroll
        for (int j = 0; j < 4; ++j) acc[j] = ((const float4*)bdw)[lane + 64 * j];
        for (int tap = 0; tap < CONVK; ++tap) {
            const int ss = s - (CONVK - 1) + tap; if (ss < 0) continue;
            const float4* gr = (const float4*)(g + (size_t)(t - (CONVK - 1) + tap) * D);
            const float4* wr = (const float4*)(wdw + (size_t)tap * D);
#pragma unroll
            for (int j = 0; j < 4; ++j) { const float4 a = gr[lane + 64 * j], w = wr[lane + 64 * j];
                acc[j].x = fmaf(a.x, w.x, acc[j].x); acc[j].y = fmaf(a.y, w.y, acc[j].y); acc[j].z = fmaf(a.z, w.z, acc[j].z); acc[j].w = fmaf(a.w, w.w, acc[j].w); }
        }
        float sm_ = 0.f;
#pragma unroll
        for (int j = 0; j < 4; ++j) sm_ += acc[j].x + acc[j].y + acc[j].z + acc[j].w;
        const float mu = wave_sum(sm_) * (1.0f / D);
        float q = 0.f;
#pragma unroll
        for (int j = 0; j < 4; ++j) { acc[j].x -= mu; acc[j].y -= mu; acc[j].z -= mu; acc[j].w -= mu; q += acc[j].x * acc[j].x + acc[j].y * acc[j].y + acc[j].z * acc[j].z + acc[j].w * acc[j].w; }
        const float rstd = rsqrtf(wave_sum(q) * (1.0f / D) + EPS);
        float4* o = (float4*)(out + (size_t)t * D);
#pragma unroll
        for (int j = 0; j < 4; ++j) { const float4 gg = ((const float4*)lng)[lane + 64 * j], bb = ((const float4*)lnb)[lane + 64 * j];
            o[lane + 64 * j] = make_float4(siluf_(acc[j].x * rstd * gg.x + bb.x), siluf_(acc[j].y * rstd * gg.y + bb.y), siluf_(acc[j].z * rstd * gg.z + bb.z), siluf_(acc[j].w * rstd * gg.w + bb.w)); }
    }
}
__device__ void n_attn(const float* q, const float* kv, float* o) {
    const int lane = threadIdx.x & 63;
    const int gw = (blockIdx.x * blockDim.x + threadIdx.x) >> 6, ngw = (gridDim.x * blockDim.x) >> 6;
    for (int it = gw; it < T * XH; it += ngw) {
        const int t = it >> 2, h = it & 3, b = t / S;
        const float4 qv = ((const float4*)(q + (size_t)t * D + h * XHD))[lane];
        const float* kb = kv + (size_t)b * NMEM * 2048 + h * XHD;
        float sc[4];
#pragma unroll
        for (int m4 = 0; m4 < 4; ++m4) {
            float mine = 0.f;
            for (int ml = 0; ml < 64; ++ml) {
                const float4 kk = ((const float4*)(kb + (size_t)(m4 * 64 + ml) * 2048))[lane];
                float p = qv.x * kk.x + qv.y * kk.y + qv.z * kk.z + qv.w * kk.w;
                p = wave_sum(p);
                if (ml == lane) mine = p;
            }
            sc[m4] = mine * 0.0625f;
        }
        float mx = fmaxf(fmaxf(sc[0], sc[1]), fmaxf(sc[2], sc[3])); mx = wave_max(mx);
        float se = 0.f;
#pragma unroll
        for (int m4 = 0; m4 < 4; ++m4) { sc[m4] = expf(sc[m4] - mx); se += sc[m4]; }
        se = wave_sum(se); const float inv = 1.0f / se;
        float4 acc = make_float4(0.f, 0.f, 0.f, 0.f);
        const float* vb = kb + 1024;
#pragma unroll
        for (int m4 = 0; m4 < 4; ++m4)
            for (int ml = 0; ml < 64; ++ml) {
                const float p = __shfl(sc[m4], ml) * inv;
                const float4 vv = ((const float4*)(vb + (size_t)(m4 * 64 + ml) * 2048))[lane];
                acc.x = fmaf(p, vv.x, acc.x); acc.y = fmaf(p, vv.y, acc.y); acc.z = fmaf(p, vv.z, acc.z); acc.w = fmaf(p, vv.w, acc.w);
            }
        ((float4*)(o + (size_t)t * D + h * XHD))[lane] = acc;
    }
}
__device__ void n_moe_init(int* cnt, int* slot_tok, int* slot_a, int* tile_e) {
    const int gi = blockIdx.x * blockDim.x + threadIdx.x, gs = gridDim.x * blockDim.x;
    for (int i = gi; i < NSLOT; i += gs) { slot_tok[i] = -1; slot_a[i] = -1; }
    for (int i = gi; i < NSLOT / 128; i += gs) tile_e[i] = -1;
    if (gi < 32) cnt[gi] = 0;
}
__device__ void n_route(const float* h, const float* wg, const float* bg, const float* we, const float* be, int* eid, float* gate, int* pos, int* cnt) {
    const int lane = threadIdx.x & 63;
    const int gw = (blockIdx.x * blockDim.x + threadIdx.x) >> 6, ngw = (gridDim.x * blockDim.x) >> 6;
    for (int t = gw; t < T; t += ngw) {
        float hv[16];
#pragma unroll
        for (int j = 0; j < 16; ++j) hv[j] = h[(size_t)t * D + j * 64 + lane];
        float gl[4];
#pragma unroll
        for (int o = 0; o < 4; ++o) { float p = 0.f;
#pragma unroll
            for (int j = 0; j < 16; ++j) p = fmaf(hv[j], wg[(size_t)(j * 64 + lane) * NG + o], p);
            gl[o] = wave_sum(p) + bg[o]; }
        int gs = 0; float gm = gl[0];
#pragma unroll
        for (int o = 1; o < 4; ++o) if (gl[o] > gm) { gm = gl[o]; gs = o; }
        float se = 0.f;
#pragma unroll
        for (int o = 0; o < 4; ++o) se += expf(gl[o] - gm);
        const float pg = 1.0f / se;
        float el[8];
#pragma unroll
        for (int o = 0; o < 8; ++o) { float p = 0.f;
#pragma unroll
            for (int j = 0; j < 16; ++j) p = fmaf(hv[j], we[(size_t)(j * 64 + lane) * NE + gs * 8 + o], p);
            el[o] = wave_sum(p) + be[gs * 8 + o]; }
        float em = el[0];
#pragma unroll
        for (int o = 1; o < 8; ++o) em = fmaxf(em, el[o]);
        float pe[8], ps = 0.f;
#pragma unroll
        for (int o = 0; o < 8; ++o) { pe[o] = expf(el[o] - em); ps += pe[o]; }
#pragma unroll
        for (int o = 0; o < 8; ++o) pe[o] = pe[o] / ps;
        int i1 = 0; float p1 = pe[0];
#pragma unroll
        for (int o = 1; o < 8; ++o) if (pe[o] > p1) { p1 = pe[o]; i1 = o; }
        int i2 = -1; float p2 = -1.f;
#pragma unroll
        for (int o = 0; o < 8; ++o) if (o != i1 && pe[o] > p2) { p2 = pe[o]; i2 = o; }
        if (lane == 0) {
            const float den = p1 + p2;
            const int e1 = gs * 8 + i1, e2 = gs * 8 + i2;
            eid[2 * t] = e1; eid[2 * t + 1] = e2;
            gate[2 * t] = pg * p1 / den; gate[2 * t + 1] = pg * p2 / den;
            pos[2 * t] = atomicAdd(&cnt[e1], 1); pos[2 * t + 1] = atomicAdd(&cnt[e2], 1);
        }
    }
}
__device__ void n_moe_build(const int* eid, const int* pos, const int* cnt, int* slot_tok, int* slot_a, int* tile_e) {
    __shared__ int poff[33];
    if (threadIdx.x == 0) { int o = 0; for (int e = 0; e < 32; ++e) { poff[e] = o; o += (cnt[e] + 127) / 128 * 128; } poff[32] = o; }
    __syncthreads();
    const int gi = blockIdx.x * blockDim.x + threadIdx.x, gs = gridDim.x * blockDim.x;
    for (int a = gi; a < NA; a += gs) { const int e = eid[a]; const int sl = poff[e] + pos[a]; slot_tok[sl] = a >> 1; slot_a[sl] = a; }
    for (int mt = gi; mt < NSLOT / 128; mt += gs) { const int r = mt * 128; int e = -1; for (int k = 0; k < 32; ++k) if (r >= poff[k] && r < poff[k + 1]) e = k; tile_e[mt] = e; }
    __syncthreads();
}
__device__ void n_moe_act(float* g, const float* u) {
    const size_t gi = (size_t)blockIdx.x * blockDim.x + threadIdx.x, gs = (size_t)gridDim.x * blockDim.x;
    for (size_t i = gi; i < (size_t)NSLOT * DE / 4; i += gs) { float4 a = ((float4*)g)[i]; const float4 b = ((const float4*)u)[i];
        a.x = siluf_(a.x) * b.x; a.y = siluf_(a.y) * b.y; a.z = siluf_(a.z) * b.z; a.w = siluf_(a.w) * b.w; ((float4*)g)[i] = a; }
}
__device__ void n_moe_combine(float* x, const float* y) {
    const size_t gi = (size_t)blockIdx.x * blockDim.x + threadIdx.x, gs = (size_t)gridDim.x * blockDim.x;
    for (size_t i = gi; i < (size_t)T * D / 4; i += gs) { const size_t t = i >> 8, c = i & 255; float4 a = ((float4*)x)[i];
        const float4 y0 = ((const float4*)y)[(2 * t) * 256 + c], y1 = ((const float4*)y)[(2 * t + 1) * 256 + c];
        a.x += y0.x + y1.x; a.y += y0.y + y1.y; a.z += y0.z + y1.z; a.w += y0.w + y1.w; ((float4*)x)[i] = a; }
}
__device__ void n_gla_decay(const float* proj, const float* wa2, const float* ba, float* dec) {
    const size_t gi = (size_t)blockIdx.x * blockDim.x + threadIdx.x, gs = (size_t)gridDim.x * blockDim.x;
    for (size_t i = gi; i < (size_t)T * GDK; i += gs) { const size_t t = i >> 9; const int j = (int)(i & 511);
        float a = ba[j];
#pragma unroll
        for (int r = 0; r < GRANK; ++r) a = fmaf(proj[t * GLA_COLS + 2048 + r], wa2[r * GDK + j], a);
        const float ls = fminf(a, 0.f) - log1pf(expf(-fabsf(a)));
        dec[i] = expf(ls * (1.0f / 16.0f)); }
}
__device__ void n_gla_rec(float* proj, const float* dec) {
    const int gi = blockIdx.x * blockDim.x + threadIdx.x, gs = gridDim.x * blockDim.x;
    for (int it = gi; it < NB * GH * GDVH; it += gs) {
        const int col = it & 255, h = (it >> 8) & 3, b = it >> 10;
        float st[GDKH];
#pragma unroll
        for (int k = 0; k < GDKH; ++k) st[k] = 0.f;
        const float qs = 0.08838834764831845f;
        for (int s = 0; s < S; ++s) {
            const size_t t = (size_t)b * S + s;
            float* pr = proj + t * GLA_COLS;
            const float v = pr[1024 + h * GDVH + col];
            const float* qq = pr + h * GDKH; const float* kk = pr + 512 + h * GDKH; const float* dd = dec + t * GDK + h * GDKH;
            float o = 0.f;
#pragma unroll
            for (int k = 0; k < GDKH; ++k) { st[k] = fmaf(st[k], dd[k], kk[k] * v); o = fmaf(qq[k], st[k], o); }
            pr[1024 + h * GDVH + col] = o * qs;
        }
    }
}
__device__ void n_gla_norm(const float* proj, const float* ng, float* go) {
    const int lane = threadIdx.x & 63;
    const int gw = (blockIdx.x * blockDim.x + threadIdx.x) >> 6, ngw = (gridDim.x * blockDim.x) >> 6;
    for (int it = gw; it < T * GH; it += ngw) {
        const int t = it >> 2, h = it & 3;
        const float4 ov = ((const float4*)(proj + (size_t)t * GLA_COLS + 1024 + h * GDVH))[lane];
        const float4 rv = ((const float4*)(proj + (size_t)t * GLA_COLS + 2064 + h * GDVH))[lane];
        const float4 gg = ((const float4*)ng)[lane];
        float s = ov.x * ov.x + ov.y * ov.y + ov.z * ov.z + ov.w * ov.w; s = wave_sum(s);
        const float rs = rsqrtf(s * (1.0f / GDVH) + EPS);
        ((float4*)(go + (size_t)t * D + h * GDVH))[lane] = make_float4(ov.x * rs * gg.x * siluf_(rv.x), ov.y * rs * gg.y * siluf_(rv.y), ov.z * rs * gg.z * siluf_(rv.z), ov.w * rs * gg.w * siluf_(rv.w));
    }
}

#define LAS __attribute__((address_space(3)))
typedef unsigned short bf16_t;
typedef short bf16x8 __attribute__((ext_vector_type(8)));
typedef float f32x4 __attribute__((ext_vector_type(4)));
typedef float f32x2 __attribute__((ext_vector_type(2)));
typedef unsigned u32x4 __attribute__((ext_vector_type(4)));
typedef unsigned u32x2 __attribute__((ext_vector_type(2)));

constexpr int LDS_BYTES = 160 * 1024;
constexpr int NSLOT2 = NA + NE * 256;
constexpr int MAXRT = NSLOT2 / 256;
constexpr size_t OW_XB = 0;
constexpr size_t OW_SSP = 64 * MiB;
constexpr size_t OW_RS = 66 * MiB;
constexpr size_t OW_PSUM = 67 * MiB;
constexpr size_t OW_MOE = 69 * MiB;
constexpr size_t OW_ACTA = 72 * MiB, OW_ACTB = 136 * MiB, OW_ACTC = 200 * MiB;
constexpr size_t OW_H = 72 * MiB, OW_Y = 144 * MiB, OW_WMOE = 272 * MiB;
constexpr size_t OW_KVB = 368 * MiB;
constexpr size_t OW_MEMNB = 502 * MiB;
constexpr size_t OW_WCIN = 550 * MiB, OW_WCOUT = 554 * MiB, OW_WXQ = 556 * MiB, OW_WXKV = 560 * MiB, OW_WXO = 568 * MiB, OW_WR = 572 * MiB, OW_BAR = 573 * MiB, OW_DBG = 574 * MiB, OW_END = 575 * MiB;
constexpr size_t OW_ATT = 360 * MiB, OW_QKR = 72 * MiB, OW_KVT = 200 * MiB, OW_BTM = 296 * MiB, OW_O = 296 * MiB, OW_BFM = 360 * MiB, OW_UT = 424 * MiB, OW_SP = 456 * MiB,
                 OW_ALR = 488 * MiB, OW_DL = 490 * MiB, OW_GO = 200 * MiB, OW_WGTM = 492 * MiB, OW_WGFM = 496 * MiB, OW_WGO = 499 * MiB, OW_WA = 501 * MiB;
constexpr size_t OM_GCNT = OW_MOE, OM_NT = OW_MOE + 256, OM_TILEE = OW_MOE + 512, OM_AE = OW_MOE + 4096, OM_APOS = OM_AE + NA * 4, OM_GATE = OM_APOS + NA * 4,
                 OM_STOK = OM_GATE + NA * 4, OM_SA = OM_STOK + NSLOT2 * 4, OM_SRS = OM_SA + NSLOT2 * 4, OM_SGATE = OM_SRS + NSLOT2 * 4, OM_END = OM_SGATE + NSLOT2 * 4;
static_assert(OM_END <= OW_ACTA, "MoE small arrays");

typedef __bf16 bf16x2_t __attribute__((ext_vector_type(2)));
__device__ __forceinline__ unsigned cvt_pk_bf16(float lo, float hi) { const f32x2 v = {lo, hi}; return __builtin_bit_cast(unsigned, __builtin_convertvector(v, bf16x2_t)); }
__device__ __forceinline__ int otid() { int t = threadIdx.x; asm volatile("" : "+v"(t)); return t; }
__device__ __forceinline__ u32x4 pack8(const f32x4& a, const f32x4& b) { u32x4 w; w.x = cvt_pk_bf16(a[0], a[1]); w.y = cvt_pk_bf16(a[2], a[3]); w.z = cvt_pk_bf16(b[0], b[1]); w.w = cvt_pk_bf16(b[2], b[3]); return w; }
__device__ __forceinline__ float bf_lo(unsigned w) { return __uint_as_float(w << 16); }
__device__ __forceinline__ float bf_hi(unsigned w) { return __uint_as_float(w & 0xffff0000u); }
__device__ __forceinline__ float fast_sigmoid(float x) { return __builtin_amdgcn_rcpf(1.0f + __builtin_amdgcn_exp2f(-1.4426950408889634f * x)); }

#ifndef LDS_POISON
#define LDS_POISON 0
#endif
namespace g8 {
constexpr int BM = 256, BK = 64, HALF = 128, HTB = HALF * BK * 2, STAGE_BYTES = 8 * HTB;
__device__ __forceinline__ int lds_byte(int r, int c) { const int st = (r >> 4) * 2 + (c >> 5), rr = r & 15, cc = c & 31, ob = rr * 64 + cc * 2; return st * 1024 + (ob ^ (((ob >> 9) & 1) << 5)); }
__device__ __forceinline__ void stage_rc(int b, int& R, int& C) { const int st = b / 1024, sb = b % 1024, swz = sb ^ (((sb >> 9) & 1) << 5); R = (st >> 1) * 16 + swz / 64; C = (st & 1) * 32 + (swz % 64) / 2; }
__device__ __forceinline__ int perm32(int rho) { const int n = rho >> 4, i = rho & 15; return 8 * (i >> 2) + 4 * n + (i & 3); }
struct Unit { int pm, pn, e; };

template <class Epi, class Sched>
__device__ __forceinline__ void gemm_phase(LAS unsigned char* lds, const Sched& S, const Epi& E) {
    int tid_ = threadIdx.x; asm volatile("" : "+v"(tid_));
    const int tid = tid_, wid = __builtin_amdgcn_readfirstlane(tid >> 6), lane = tid & 63, wr = wid >> 2, wc = wid & 3, fr = lane & 15, fq = lane >> 4;
    const size_t kstep = (size_t)(BK * 2);
    const unsigned ldsw = (unsigned)wid * 1024u;
    const int aoff = lds_byte(wr * 64 + fr, fq * 8), boff = lds_byte(wc * 32 + fr, fq * 8);
#define G8_SA(b, h) (((b) * 2 + (h)) * HTB)
#define G8_SB(b, h) ((4 + (b) * 2 + (h)) * HTB)
#define G8_STAGE(bufoff, gbase, vv) do { _Pragma("unroll") for (int _i = 0; _i < 2; ++_i) \
        __builtin_amdgcn_global_load_lds((const unsigned*)((const char*)(gbase) + (vv)[_i]), (LAS unsigned*)(lds + (bufoff) + ldsw + _i * 8192), 16, 0, 0); } while (0)
#define G8_LDA(dst, b, h) do { _Pragma("unroll") for (int m = 0; m < 4; ++m) _Pragma("unroll") for (int k = 0; k < 2; ++k) dst[m][k] = *(const LAS bf16x8*)(lds + G8_SA(b, h) + aoff + m * 2048 + k * 1024); } while (0)
#define G8_LDB(dst, b, h) do { _Pragma("unroll") for (int n = 0; n < 2; ++n) _Pragma("unroll") for (int k = 0; k < 2; ++k) dst[n][k] = *(const LAS bf16x8*)(lds + G8_SB(b, h) + boff + n * 2048 + k * 1024); } while (0)
#define G8_MMA(ai, bj, At, Bt) do { __builtin_amdgcn_s_setprio(1); _Pragma("unroll") for (int m = 0; m < 4; ++m) _Pragma("unroll") for (int n = 0; n < 2; ++n) _Pragma("unroll") for (int k = 0; k < 2; ++k) \
        acc[ai][bj][m][n] = __builtin_amdgcn_mfma_f32_16x16x32_bf16(Bt[n][k], At[m][k], acc[ai][bj][m][n], 0, 0, 0); __builtin_amdgcn_s_setprio(0); } while (0)
#define G8_WAIT_V(n) asm volatile("s_waitcnt vmcnt(" #n ")" ::: "memory")
#define G8_WAIT_L(n) asm volatile("s_waitcnt lgkmcnt(" #n ")" ::: "memory")
#define G8_BAR __builtin_amdgcn_s_barrier()
#define G8_SCHED __builtin_amdgcn_sched_barrier(0)
#define G8_VA(dst, u) do { const int _ac = S.a_col(u), _lda = S.lda(u); _Pragma("unroll") for (int _i = 0; _i < 2; ++_i) { int _R, _C; stage_rc(tid * 16 + _i * 8192, _R, _C); \
        _Pragma("unroll") for (int _h = 0; _h < 2; ++_h) dst[_h][_i] = (unsigned)(((size_t)S.a_row(u, _h * HALF + _R) * _lda + _ac + _C) * 2); } } while (0)
#define G8_VB(dst, hs, u) do { const int _ldb = S.ldb(u); hs = (size_t)HALF * _ldb * 2; _Pragma("unroll") for (int _i = 0; _i < 2; ++_i) { int _R, _C; stage_rc(tid * 16 + _i * 8192, _R, _C); \
        dst[_i] = (unsigned)(((_R & ~31) + perm32(_R & 31)) * _ldb + _C) * 2u; } } while (0)
    Unit cur, nxt; int ui = 0;
    if (!S.next(0, cur)) return;
#if LDS_POISON
    for (int i = tid; i < STAGE_BYTES / 16; i += 512) ((LAS u32x4*)lds)[i] = (u32x4){0x7fc07fc0u, 0x7fc07fc0u, 0x7fc07fc0u, 0x7fc07fc0u};
    __syncthreads();
#endif
    f32x4 acc[2][2][4][2];
#pragma unroll
    for (int a = 0; a < 2; ++a)
#pragma unroll
        for (int b = 0; b < 2; ++b)
#pragma unroll
            for (int m = 0; m < 4; ++m)
#pragma unroll
                for (int n = 0; n < 2; ++n) acc[a][b][m][n] = (f32x4){0.f, 0.f, 0.f, 0.f};
    bf16x8 At[4][2], B0[2][2], B1[2][2];
    unsigned va[2][2], nva[2][2], vb[2], nvb[2]; size_t hsB, nhsB;
    G8_VA(va, cur); G8_VB(vb, hsB, cur);
    const char* Ab = S.a_base(cur);
    const char* cB = S.b_base(cur);
    G8_STAGE(G8_SB(0, 0), cB, vb); G8_STAGE(G8_SA(0, 0), Ab, va[0]); G8_STAGE(G8_SB(0, 1), cB + hsB, vb); G8_STAGE(G8_SA(0, 1), Ab, va[1]);
    if (wr == 1) G8_BAR;
    G8_WAIT_V(4); G8_BAR;
    G8_STAGE(G8_SB(1, 0), cB + kstep, vb); G8_STAGE(G8_SA(1, 0), Ab + kstep, va[0]); G8_STAGE(G8_SB(1, 1), cB + hsB + kstep, vb);
    G8_WAIT_V(6); G8_BAR;
    for (;;) {
        const bool has_next = S.next(ui + 1, nxt);
        const char* nB = cB; const char* nAb = Ab;
        if (has_next) { nB = S.b_base(nxt); nAb = S.a_base(nxt); G8_VA(nva, nxt); G8_VB(nvb, nhsB, nxt); }
        else {
            nhsB = hsB;
#pragma unroll
            for (int i = 0; i < 2; ++i) { nvb[i] = vb[i];
#pragma unroll
                for (int h = 0; h < 2; ++h) nva[h][i] = va[h][i]; }
        }
        const int nt = S.nt(cur);
        for (int t = 0; t < nt; t += 2) {
            const bool last = (t == nt - 2);
            const char* a1 = Ab + (size_t)(t + 1) * kstep;
            const char* a2 = last ? nAb : Ab + (size_t)(t + 2) * kstep;
            const char* b2 = last ? nB : cB + (size_t)(t + 2) * kstep;
            const char* a3 = a2 + kstep; const char* b3 = b2 + kstep;
            const size_t hs2 = last ? nhsB : hsB;
            unsigned v2[2][2], vb2[2];
#pragma unroll
            for (int i = 0; i < 2; ++i) { vb2[i] = last ? nvb[i] : vb[i];
#pragma unroll
                for (int h = 0; h < 2; ++h) v2[h][i] = last ? nva[h][i] : va[h][i]; }
            G8_LDB(B0, 0, 0); G8_SCHED; G8_LDA(At, 0, 0); G8_STAGE(G8_SA(1, 1), a1, va[1]);
            G8_WAIT_L(8); G8_BAR; G8_WAIT_L(0); G8_MMA(0, 0, At, B0); G8_BAR; G8_SCHED;
            G8_LDB(B1, 0, 1); G8_STAGE(G8_SB(0, 0), b2, vb2);
            G8_BAR; G8_WAIT_L(0); G8_MMA(0, 1, At, B1); G8_BAR;
            G8_LDA(At, 0, 1); G8_STAGE(G8_SA(0, 0), a2, v2[0]);
            G8_BAR; G8_WAIT_L(0); G8_MMA(1, 0, At, B0); G8_BAR; G8_SCHED;
            G8_STAGE(G8_SB(0, 1), b2 + hs2, vb2);
            G8_WAIT_V(6); G8_BAR; G8_MMA(1, 1, At, B1); G8_BAR;
            G8_LDB(B0, 1, 0); G8_SCHED; G8_LDA(At, 1, 0); G8_STAGE(G8_SA(0, 1), a2, v2[1]);
            G8_WAIT_L(8); G8_BAR; G8_WAIT_L(0); G8_MMA(0, 0, At, B0); G8_BAR; G8_SCHED;
            G8_LDB(B1, 1, 1); G8_STAGE(G8_SB(1, 0), b3, vb2);
            G8_BAR; G8_WAIT_L(0); G8_MMA(0, 1, At, B1); G8_BAR;
            G8_LDA(At, 1, 1); G8_STAGE(G8_SA(1, 0), a3, v2[0]);
            G8_BAR; G8_WAIT_L(0); G8_MMA(1, 0, At, B0); G8_BAR; G8_SCHED;
            G8_STAGE(G8_SB(1, 1), b3 + hs2, vb2);
            G8_WAIT_V(6); G8_BAR; G8_MMA(1, 1, At, B1); G8_BAR;
        }
        const bool keep = S.cont(cur);
        if (!keep) E(acc, cur, wr, wc, fr, fq);
        if (!has_next) break;
        if (!keep) {
#pragma unroll
            for (int a = 0; a < 2; ++a)
#pragma unroll
                for (int b = 0; b < 2; ++b)
#pragma unroll
                    for (int m = 0; m < 4; ++m)
#pragma unroll
                        for (int n = 0; n < 2; ++n) acc[a][b][m][n] = (f32x4){0.f, 0.f, 0.f, 0.f};
        }
        cur = nxt; cB = nB; Ab = nAb; hsB = nhsB; ++ui;
#pragma unroll
        for (int i = 0; i < 2; ++i) { vb[i] = nvb[i];
#pragma unroll
            for (int h = 0; h < 2; ++h) va[h][i] = nva[h][i]; }
    }
    G8_WAIT_V(0);
    if (wr == 0) G8_BAR;
    G8_BAR;
#undef G8_SA
#undef G8_SB
#undef G8_STAGE
#undef G8_LDA
#undef G8_LDB
#undef G8_MMA
#undef G8_WAIT_V
#undef G8_WAIT_L
#undef G8_BAR
#undef G8_SCHED
#undef G8_VA
#undef G8_VB
}

struct DenseSched {
    __device__ __forceinline__ int lda(const Unit&) const { return lda_; }
    __device__ __forceinline__ int ldb(const Unit&) const { return ldb_; }
    __device__ __forceinline__ int nt(const Unit&) const { return K / BK; }
    __device__ __forceinline__ bool cont(const Unit&) const { return false; }
    int nN, nU, K, lda_, ldb_; const bf16_t* A; const bf16_t* Bt;
    __device__ __forceinline__ const char* a_base(const Unit&) const { return (const char*)A; }
    __device__ __forceinline__ bool next(int i, Unit& u) const {
        const int c = blockIdx.x, per = gridDim.x >> 3, x = c & 7, j = c >> 3;
        const int chunk = (nU + 7) >> 3, lu = i * per + j;
        if (lu >= chunk) return false;
        const int un = x * chunk + lu; if (un >= nU) return false;
        u.pm = un / nN; u.pn = un - u.pm * nN; u.e = 0; return true; }
    __device__ __forceinline__ int a_row(const Unit& u, int r) const { return u.pm * BM + r; }
    __device__ __forceinline__ int a_col(const Unit&) const { return 0; }
    __device__ __forceinline__ const char* b_base(const Unit& u) const { return (const char*)(Bt + (size_t)u.pn * BM * ldb_); }
};

struct EpiGlu {
    bf16_t* U; const float* rs; const float* bias;
    __device__ __forceinline__ void operator()(const f32x4 (&acc)[2][2][4][2], const Unit& u, int wr, int wc, int fr, int fq) const {
        const int c0 = u.pn * 128 + wc * 32 + 8 * fq;
        const f32x4 ba0 = *(const f32x4*)(bias + c0), ba1 = *(const f32x4*)(bias + c0 + 4), bg0 = *(const f32x4*)(bias + 1024 + c0), bg1 = *(const f32x4*)(bias + 1024 + c0 + 4);
        float rv[2][4];
#pragma unroll
        for (int ai = 0; ai < 2; ++ai)
#pragma unroll
            for (int m = 0; m < 4; ++m) rv[ai][m] = rs[u.pm * BM + ai * HALF + wr * 64 + m * 16 + fr];
        __builtin_amdgcn_sched_barrier(0);
#pragma unroll
        for (int ai = 0; ai < 2; ++ai)
#pragma unroll
            for (int m = 0; m < 4; ++m) {
                const int row = u.pm * BM + ai * HALF + wr * 64 + m * 16 + fr; const float r = rv[ai][m];
                f32x4 o0, o1;
#pragma unroll
                for (int j = 0; j < 4; ++j) {
                    o0[j] = (acc[ai][0][m][0][j] * r + ba0[j]) * fast_sigmoid(acc[ai][1][m][0][j] * r + bg0[j]);
                    o1[j] = (acc[ai][0][m][1][j] * r + ba1[j]) * fast_sigmoid(acc[ai][1][m][1][j] * r + bg1[j]); }
                *(u32x4*)(U + (size_t)row * D + c0) = pack8(o0, o1);
            }
    }
};
struct EpiXres {
    bf16_t* XB; const float* bias; float* ssp;
    __device__ __forceinline__ void operator()(const f32x4 (&acc)[2][2][4][2], const Unit& u, int wr, int wc, int fr, int fq) const {
        f32x4 bv[2][2];
#pragma unroll
        for (int bj = 0; bj < 2; ++bj) { const int c0 = u.pn * BM + bj * HALF + wc * 32 + 8 * fq;
            bv[bj][0] = bias ? *(const f32x4*)(bias + c0) : (f32x4){0.f, 0.f, 0.f, 0.f}; bv[bj][1] = bias ? *(const f32x4*)(bias + c0 + 4) : (f32x4){0.f, 0.f, 0.f, 0.f}; }
#pragma unroll
        for (int ai = 0; ai < 2; ++ai) {
            u32x4 xv[2][4][2];
#pragma unroll
            for (int m = 0; m < 4; ++m)
#pragma unroll
                for (int bj = 0; bj < 2; ++bj) xv[ai][m][bj] = *(const u32x4*)(XB + (size_t)(u.pm * BM + ai * HALF + wr * 64 + m * 16 + fr) * D + u.pn * BM + bj * HALF + wc * 32 + 8 * fq);
            __builtin_amdgcn_sched_barrier(0);
#pragma unroll
            for (int m = 0; m < 4; ++m) {
                const int row = u.pm * BM + ai * HALF + wr * 64 + m * 16 + fr; float ss = 0.f;
#pragma unroll
                for (int bj = 0; bj < 2; ++bj) {
                    const size_t off = (size_t)row * D + u.pn * BM + bj * HALF + wc * 32 + 8 * fq; const u32x4 xw = xv[ai][m][bj];
                    const f32x4 v0 = (f32x4){bf_lo(xw.x), bf_hi(xw.x), bf_lo(xw.y), bf_hi(xw.y)} + acc[ai][bj][m][0] + bv[bj][0];
                    const f32x4 v1 = (f32x4){bf_lo(xw.z), bf_hi(xw.z), bf_lo(xw.w), bf_hi(xw.w)} + acc[ai][bj][m][1] + bv[bj][1];
                    const u32x4 w = pack8(v0, v1);
                    *(u32x4*)(XB + off) = w;
                    const float r0 = bf_lo(w.x), r1 = bf_hi(w.x), r2 = bf_lo(w.y), r3 = bf_hi(w.y), r4 = bf_lo(w.z), r5 = bf_hi(w.z), r6 = bf_lo(w.w), r7 = bf_hi(w.w);
                    ss += (r0 * r0 + r1 * r1) + (r2 * r2 + r3 * r3) + (r4 * r4 + r5 * r5) + (r6 * r6 + r7 * r7);
                }
                if (ssp) { ss += __shfl_xor(ss, 16); ss += __shfl_xor(ss, 32); if (fq == 0) ssp[(size_t)row * 16 + u.pn * 4 + wc] = ss; }
            }
            __builtin_amdgcn_sched_barrier(0);
        }
    }
};
struct AttnSched {
    __device__ __forceinline__ int lda(const Unit&) const { return lda_; }
    __device__ __forceinline__ int ldb(const Unit&) const { return ldb_; }
    __device__ __forceinline__ int nt(const Unit&) const { return K / BK; }
    __device__ __forceinline__ bool cont(const Unit&) const { return false; }
    int K, lda_, ldb_; const bf16_t* A; const bf16_t* Bm; int pv;
    __device__ __forceinline__ bool next(int i, Unit& u) const {
        const int c = blockIdx.x, per = gridDim.x >> 3, x = c & 7, j = c >> 3;
        const int lu = i * per + j; if (lu >= 64) return false;
        const int un = x * 64 + lu, bh = un >> 5, qb = un & 31;
        u.pm = (bh >> 2) * 32 + qb; u.pn = 0; u.e = bh & 3; return true; }
    __device__ __forceinline__ const char* a_base(const Unit&) const { return (const char*)A; }
    __device__ __forceinline__ int a_row(const Unit& u, int r) const { return u.pm * BM + r; }
    __device__ __forceinline__ int a_col(const Unit& u) const { return u.e * 256; }
    __device__ __forceinline__ const char* b_base(const Unit& u) const { const int b = u.pm >> 5;
        return pv ? (const char*)(Bm + (size_t)(b * 4 + u.e) * 65536) : (const char*)(Bm + (size_t)(b * 256) * 1024 + u.e * 256); }
};
struct KVSched {
    __device__ __forceinline__ int lda(const Unit&) const { return lda_; }
    __device__ __forceinline__ int ldb(const Unit&) const { return ldb_; }
    __device__ __forceinline__ int nt(const Unit&) const { return K / BK; }
    __device__ __forceinline__ bool cont(const Unit&) const { return false; }
    int K, lda_, ldb_; const bf16_t* MEMNB; const bf16_t* WKV;
    __device__ __forceinline__ bool next(int i, Unit& u) const {
        const int un = i * (int)gridDim.x + (int)blockIdx.x; if (un >= 32) return false;
        u.e = un >> 4; u.pm = (un & 15) >> 2; u.pn = un & 3; return true; }
    __device__ __forceinline__ const char* a_base(const Unit& u) const { return u.e ? (const char*)(WKV + (size_t)1024 * 1024) : (const char*)MEMNB; }
    __device__ __forceinline__ int a_row(const Unit& u, int r) const { return u.pm * BM + r; }
    __device__ __forceinline__ int a_col(const Unit&) const { return 0; }
    __device__ __forceinline__ const char* b_base(const Unit& u) const { return u.e ? (const char*)(MEMNB + (size_t)u.pn * BM * 1024) : (const char*)(WKV + (size_t)u.pn * BM * 1024); }
};
__device__ __forceinline__ float ssp_rs(const float* ssp, int row) {
    const f32x4 a = *(const f32x4*)(ssp + (size_t)row * 16), b = *(const f32x4*)(ssp + (size_t)row * 16 + 4), c = *(const f32x4*)(ssp + (size_t)row * 16 + 8), d = *(const f32x4*)(ssp + (size_t)row * 16 + 12);
    const float s = ((a[0] + a[1]) + (a[2] + a[3])) + ((b[0] + b[1]) + (b[2] + b[3])) + ((c[0] + c[1]) + (c[2] + c[3])) + ((d[0] + d[1]) + (d[2] + d[3]));
    return rsqrtf(s * (1.0f / D) + EPS);
}
struct EpiRowScale {
    bf16_t* O; int ldo; const float* ssp; const float* rs; float scale; int qtiles; float qscale;
    __device__ __forceinline__ void operator()(const f32x4 (&acc)[2][2][4][2], const Unit& u, int wr, int wc, int fr, int fq) const {
        const float cs = scale * (u.pn < qtiles ? qscale : 1.0f);
        float rv[2][4];
        if (rs) {
#pragma unroll
            for (int ai = 0; ai < 2; ++ai)
#pragma unroll
                for (int m = 0; m < 4; ++m) rv[ai][m] = rs[u.pm * BM + ai * HALF + wr * 64 + m * 16 + fr];
        } else {
#pragma unroll
            for (int ai = 0; ai < 2; ++ai) {
                f32x4 p[4][4];
#pragma unroll
                for (int m = 0; m < 4; ++m)
#pragma unroll
                    for (int q = 0; q < 4; ++q) p[m][q] = *(const f32x4*)(ssp + (size_t)(u.pm * BM + ai * HALF + wr * 64 + m * 16 + fr) * 16 + 4 * q);
                __builtin_amdgcn_sched_barrier(0);
#pragma unroll
                for (int m = 0; m < 4; ++m) { float sm = 0.f;
#pragma unroll
                    for (int q = 0; q < 4; ++q) sm += (p[m][q][0] + p[m][q][1]) + (p[m][q][2] + p[m][q][3]);
                    rv[ai][m] = rsqrtf(sm * (1.0f / D) + EPS); }
            }
        }
        __builtin_amdgcn_sched_barrier(0);
#pragma unroll
        for (int ai = 0; ai < 2; ++ai)
#pragma unroll
            for (int m = 0; m < 4; ++m) {
                const int row = u.pm * BM + ai * HALF + wr * 64 + m * 16 + fr;
                const float r = rv[ai][m] * cs;
#pragma unroll
                for (int bj = 0; bj < 2; ++bj) { const int c0 = u.pn * BM + bj * HALF + wc * 32 + 8 * fq;
                    *(u32x4*)(O + (size_t)row * ldo + c0) = pack8(acc[ai][bj][m][0] * r, acc[ai][bj][m][1] * r); }
            }
    }
};
struct EpiKV {
    bf16_t* Kb; bf16_t* VT;
    __device__ __forceinline__ void operator()(const f32x4 (&acc)[2][2][4][2], const Unit& u, int wr, int wc, int fr, int fq) const {
        bf16_t* base = u.e ? VT + (size_t)(u.pn * 4 + u.pm) * 65536 : Kb + (size_t)u.pm * BM * 1024 + u.pn * BM;
        const int ld = u.e ? 256 : 1024;
#pragma unroll
        for (int ai = 0; ai < 2; ++ai)
#pragma unroll
            for (int m = 0; m < 4; ++m) { const int r = ai * HALF + wr * 64 + m * 16 + fr;
#pragma unroll
                for (int bj = 0; bj < 2; ++bj) { const int c0 = bj * HALF + wc * 32 + 8 * fq;
                    *(u32x4*)(base + (size_t)r * ld + c0) = pack8(acc[ai][bj][m][0], acc[ai][bj][m][1]); } }
    }
};
struct EpiS {
    bf16_t* P; float* psum;
    __device__ __forceinline__ void operator()(const f32x4 (&acc)[2][2][4][2], const Unit& u, int wr, int wc, int fr, int fq) const {
#pragma unroll
        for (int ai = 0; ai < 2; ++ai)
#pragma unroll
            for (int m = 0; m < 4; ++m) {
                const int row = u.pm * BM + ai * HALF + wr * 64 + m * 16 + fr; float ps = 0.f;
#pragma unroll
                for (int bj = 0; bj < 2; ++bj) { const int c0 = u.e * 256 + bj * HALF + wc * 32 + 8 * fq;
                    f32x4 e0, e1;
#pragma unroll
                    for (int j = 0; j < 4; ++j) { e0[j] = __builtin_amdgcn_exp2f(acc[ai][bj][m][0][j] * 1.4426950408889634f); e1[j] = __builtin_amdgcn_exp2f(acc[ai][bj][m][1][j] * 1.4426950408889634f); }
                    const u32x4 w = pack8(e0, e1);
                    *(u32x4*)(P + (size_t)row * D + c0) = w;
                    ps += (bf_lo(w.x) + bf_hi(w.x)) + (bf_lo(w.y) + bf_hi(w.y)) + (bf_lo(w.z) + bf_hi(w.z)) + (bf_lo(w.w) + bf_hi(w.w)); }
                ps += __shfl_xor(ps, 16); ps += __shfl_xor(ps, 32);
                if (fq == 0) psum[(size_t)row * 16 + u.e * 4 + wc] = ps;
            }
    }
};
struct EpiRaw {
    bf16_t* O;
    __device__ __forceinline__ void operator()(const f32x4 (&acc)[2][2][4][2], const Unit& u, int wr, int wc, int fr, int fq) const {
#pragma unroll
        for (int ai = 0; ai < 2; ++ai)
#pragma unroll
            for (int m = 0; m < 4; ++m) { const int row = u.pm * BM + ai * HALF + wr * 64 + m * 16 + fr;
#pragma unroll
                for (int bj = 0; bj < 2; ++bj) { const int c0 = u.e * 256 + bj * HALF + wc * 32 + 8 * fq;
                    *(u32x4*)(O + (size_t)row * D + c0) = pack8(acc[ai][bj][m][0], acc[ai][bj][m][1]); } }
    }
};
struct EpiNone {
    __device__ __forceinline__ void operator()(const f32x4 (&acc)[2][2][4][2], const Unit& u, int wr, int wc, int fr, int fq) const {
#pragma unroll
        for (int ai = 0; ai < 2; ++ai)
#pragma unroll
            for (int bj = 0; bj < 2; ++bj)
#pragma unroll
                for (int m = 0; m < 4; ++m)
#pragma unroll
                    for (int n = 0; n < 2; ++n) asm volatile("" :: "v"(acc[ai][bj][m][n]));
    }
};
struct EpiPV {
    bf16_t* O; const float* psum;
    __device__ __forceinline__ void operator()(const f32x4 (&acc)[2][2][4][2], const Unit& u, int wr, int wc, int fr, int fq) const {
        f32x4 sv[2][4];
#pragma unroll
        for (int ai = 0; ai < 2; ++ai)
#pragma unroll
            for (int m = 0; m < 4; ++m) sv[ai][m] = *(const f32x4*)(psum + (size_t)(u.pm * BM + ai * HALF + wr * 64 + m * 16 + fr) * 16 + u.e * 4);
        __builtin_amdgcn_sched_barrier(0);
#pragma unroll
        for (int ai = 0; ai < 2; ++ai)
#pragma unroll
            for (int m = 0; m < 4; ++m) {
                const int row = u.pm * BM + ai * HALF + wr * 64 + m * 16 + fr;
                const float inv = 1.0f / ((sv[ai][m][0] + sv[ai][m][1]) + (sv[ai][m][2] + sv[ai][m][3]));
#pragma unroll
                for (int bj = 0; bj < 2; ++bj) { const int c0 = u.e * 256 + bj * HALF + wc * 32 + 8 * fq;
                    *(u32x4*)(O + (size_t)row * D + c0) = pack8(acc[ai][bj][m][0] * inv, acc[ai][bj][m][1] * inv); }
            }
    }
};

__device__ __forceinline__ int ld_agent(const int* p) { return __hip_atomic_load(p, __ATOMIC_RELAXED, __HIP_MEMORY_SCOPE_AGENT); }
struct MoeSched {
    __device__ __forceinline__ int lda(const Unit&) const { return lda_; }
    __device__ __forceinline__ int ldb(const Unit&) const { return ldb_; }
    __device__ __forceinline__ int nt(const Unit&) const { return K / BK; }
    __device__ __forceinline__ bool cont(const Unit&) const { return false; }
    int K, lda_, ldb_; const bf16_t* A; const bf16_t* W; size_t wstride; const int* tile_e; const int* slot_tok; int NT;
    __device__ __forceinline__ bool next(int i, Unit& u) const {
        const int c = blockIdx.x, per = gridDim.x >> 3, x = c & 7, j = c >> 3;
        const int tpx = (NT + 7) >> 3, lu = i * per + j, lrt = lu >> 2;
        if (lrt >= tpx) return false;
        const int rt = x * tpx + lrt; if (rt >= NT) return false;
        u.pm = rt; u.pn = lu & 3; u.e = __builtin_amdgcn_readfirstlane(ld_agent(tile_e + rt)); return true; }
    __device__ __forceinline__ const char* a_base(const Unit&) const { return (const char*)A; }
    __device__ __forceinline__ int a_row(const Unit& u, int r) const { return slot_tok ? slot_tok[u.pm * BM + r] : u.pm * BM + r; }
    __device__ __forceinline__ int a_col(const Unit&) const { return 0; }
    __device__ __forceinline__ const char* b_base(const Unit& u) const { return (const char*)(W + (size_t)u.e * wstride + (size_t)u.pn * BM * ldb_); }
};
struct EpiMoe1 {
    bf16_t* H; const float* slot_rs;
    __device__ __forceinline__ void operator()(const f32x4 (&acc)[2][2][4][2], const Unit& u, int wr, int wc, int fr, int fq) const {
        const int c0 = u.pn * 128 + wc * 32 + 8 * fq;
        float rv[2][4];
#pragma unroll
        for (int ai = 0; ai < 2; ++ai)
#pragma unroll
            for (int m = 0; m < 4; ++m) rv[ai][m] = slot_rs[u.pm * BM + ai * HALF + wr * 64 + m * 16 + fr];
        __builtin_amdgcn_sched_barrier(0);
#pragma unroll
        for (int ai = 0; ai < 2; ++ai)
#pragma unroll
            for (int m = 0; m < 4; ++m) {
                const int row = u.pm * BM + ai * HALF + wr * 64 + m * 16 + fr; const float r = rv[ai][m];
                f32x4 o0, o1;
#pragma unroll
                for (int j = 0; j < 4; ++j) {
                    const float g0 = acc[ai][0][m][0][j] * r, g1 = acc[ai][0][m][1][j] * r;
                    o0[j] = g0 * fast_sigmoid(g0) * (acc[ai][1][m][0][j] * r);
                    o1[j] = g1 * fast_sigmoid(g1) * (acc[ai][1][m][1][j] * r); }
                *(u32x4*)(H + (size_t)row * DE + c0) = pack8(o0, o1);
            }
    }
};
struct EpiMoe2 {
    bf16_t* Y; const int* slot_a; const float* slot_gate;
    __device__ __forceinline__ void operator()(const f32x4 (&acc)[2][2][4][2], const Unit& u, int wr, int wc, int fr, int fq) const {
        int av[2][4]; float gv[2][4];
#pragma unroll
        for (int ai = 0; ai < 2; ++ai)
#pragma unroll
            for (int m = 0; m < 4; ++m) { const int row = u.pm * BM + ai * HALF + wr * 64 + m * 16 + fr; av[ai][m] = slot_a[row]; gv[ai][m] = slot_gate[row]; }
        __builtin_amdgcn_sched_barrier(0);
#pragma unroll
        for (int ai = 0; ai < 2; ++ai)
#pragma unroll
            for (int m = 0; m < 4; ++m) {
                const int a = av[ai][m]; const float g = gv[ai][m];
                if (a >= 0) {
#pragma unroll
                    for (int bj = 0; bj < 2; ++bj) { const int c0 = u.pn * BM + bj * HALF + wc * 32 + 8 * fq;
                        *(u32x4*)(Y + (size_t)a * D + c0) = pack8(acc[ai][bj][m][0] * g, acc[ai][bj][m][1] * g); }
                }
            }
    }
};

struct GlaInSched {
    const bf16_t* XB; const bf16_t* WTM; const bf16_t* WFM;
    __device__ __forceinline__ int lda(const Unit&) const { return D; }
    __device__ __forceinline__ int ldb(const Unit&) const { return D; }
    __device__ __forceinline__ int nt(const Unit&) const { return D / BK; }
    __device__ __forceinline__ bool cont(const Unit&) const { return false; }
    __device__ __forceinline__ bool next(int i, Unit& u) const {
        const int c = blockIdx.x, per = gridDim.x >> 3, x = c & 7, j = c >> 3, lu = i * per + j;
        if (lu >= 224) return false;
        const int un = x * 224 + lu;
        if (un < 1024) { u.e = 0; u.pm = un >> 3; u.pn = un & 7; } else { const int v = un - 1024; u.e = 1; u.pn = v / 6; u.pm = v - u.pn * 6; }
        return true; }
    __device__ __forceinline__ const char* a_base(const Unit& u) const { return u.e ? (const char*)WFM : (const char*)XB; }
    __device__ __forceinline__ int a_row(const Unit& u, int r) const { return u.pm * BM + r; }
    __device__ __forceinline__ int a_col(const Unit&) const { return 0; }
    __device__ __forceinline__ const char* b_base(const Unit& u) const { return u.e ? (const char*)(XB + (size_t)u.pn * BM * D) : (const char*)(WTM + (size_t)u.pn * BM * D); }
};
__device__ __forceinline__ float fexp(float x) { return __builtin_amdgcn_exp2f(x * 1.4426950408889634f); }
struct EpiGlaIn {
    bf16_t* QKR; bf16_t* KVT; const float* RS; const float* BTM; const float* BFM;
    __device__ __forceinline__ void operator()(const f32x4 (&acc)[2][2][4][2], const Unit& u, int wr, int wc, int fr, int fq) const {
        if (u.e == 0) {
            float rv[2][4];
#pragma unroll
            for (int ai = 0; ai < 2; ++ai)
#pragma unroll
                for (int m = 0; m < 4; ++m) rv[ai][m] = RS[u.pm * BM + ai * HALF + wr * 64 + m * 16 + fr];
            const float sg = u.pn < 2 ? 1.0f : -1.0f, qs = u.pn < 2 ? 0.08838834764831845f : 1.0f;
#pragma unroll
            for (int ai = 0; ai < 2; ++ai)
#pragma unroll
                for (int mp = 0; mp < 2; ++mp) {
                    f32x4 bv[2][2][2];
                    if (u.pn < 4) {
#pragma unroll
                        for (int mm = 0; mm < 2; ++mm)
#pragma unroll
                            for (int bj = 0; bj < 2; ++bj) { const int row = u.pm * BM + ai * HALF + wr * 64 + (2 * mp + mm) * 16 + fr, kf = (u.pn * BM + bj * HALF + wc * 32 + 8 * fq) & 511;
                                bv[mm][bj][0] = *(const f32x4*)(BTM + (size_t)row * 512 + kf); bv[mm][bj][1] = *(const f32x4*)(BTM + (size_t)row * 512 + kf + 4); }
                    }
                    __builtin_amdgcn_sched_barrier(0);
#pragma unroll
                    for (int mm = 0; mm < 2; ++mm) { const int m = 2 * mp + mm;
                        const int row = u.pm * BM + ai * HALF + wr * 64 + m * 16 + fr; const float r = rv[ai][m];
#pragma unroll
                        for (int bj = 0; bj < 2; ++bj) { const int c0 = u.pn * BM + bj * HALF + wc * 32 + 8 * fq;
                            f32x4 s0 = (f32x4){r, r, r, r}, s1 = s0;
                            if (u.pn < 4) {
#pragma unroll
                                for (int j = 0; j < 4; ++j) { s0[j] = r * qs * fexp(sg * bv[mm][bj][0][j]); s1[j] = r * qs * fexp(sg * bv[mm][bj][1][j]); } }
                            *(u32x4*)(QKR + (size_t)row * 2048 + c0) = pack8(acc[ai][bj][m][0] * s0, acc[ai][bj][m][1] * s1); }
                    }
                    __builtin_amdgcn_sched_barrier(0);
                }
        } else {
#pragma unroll
            for (int bj = 0; bj < 2; ++bj) { const int t0 = u.pn * BM + bj * HALF + wc * 32 + 8 * fq;
                const f32x4 r0 = *(const f32x4*)(RS + t0), r1 = *(const f32x4*)(RS + t0 + 4);
#pragma unroll
                for (int ai = 0; ai < 2; ++ai) {
                    f32x4 bv[4][2];
                    if (u.pm < 2) {
#pragma unroll
                        for (int m = 0; m < 4; ++m) { const int f = u.pm * BM + ai * HALF + wr * 64 + m * 16 + fr;
                            bv[m][0] = *(const f32x4*)(BFM + (size_t)f * T + t0); bv[m][1] = *(const f32x4*)(BFM + (size_t)f * T + t0 + 4); }
                    }
                    __builtin_amdgcn_sched_barrier(0);
#pragma unroll
                    for (int m = 0; m < 4; ++m) { const int f = u.pm * BM + ai * HALF + wr * 64 + m * 16 + fr;
                        f32x4 s0 = r0, s1 = r1;
                        if (u.pm < 2) {
#pragma unroll
                            for (int j = 0; j < 4; ++j) { s0[j] *= fexp(-bv[m][0][j]); s1[j] *= fexp(-bv[m][1][j]); } }
                        *(u32x4*)(KVT + (size_t)f * T + t0) = pack8(acc[ai][bj][m][0] * s0, acc[ai][bj][m][1] * s1); }
                    __builtin_amdgcn_sched_barrier(0);
                }
            }
        }
    }
};
template <int TYP> struct GlaAttSched {
    const bf16_t* QKR; const bf16_t* KVT;
    __device__ __forceinline__ bool next(int i, Unit& u) const {
        const int c = blockIdx.x, per = gridDim.x >> 3, x = c & 7, j = c >> 3, lu = i * per + j;
        if (lu >= 64) return false;
        const int un = x * 64 + lu, bh = un >> 5, cc = un & 31;
        u.e = TYP; u.pm = (bh >> 2) * 32 + cc; u.pn = bh & 3; return true; }
    __device__ __forceinline__ int lda(const Unit& u) const { return TYP ? T : 2048; }
    __device__ __forceinline__ int ldb(const Unit& u) const { return TYP ? T : 2048; }
    __device__ __forceinline__ int nt(const Unit& u) const { int n = TYP ? 4 : 2; asm volatile("" : "+s"(n)); return n; }
    __device__ __forceinline__ bool cont(const Unit&) const { return false; }
    __device__ __forceinline__ const char* a_base(const Unit& u) const { return TYP ? (const char*)KVT : (const char*)QKR; }
    __device__ __forceinline__ int a_row(const Unit& u, int r) const { return TYP ? 512 + u.pn * 256 + r : u.pm * BM + r; }
    __device__ __forceinline__ int a_col(const Unit& u) const { return TYP ? u.pm * BM : u.pn * 128; }
    __device__ __forceinline__ const char* b_base(const Unit& u) const {
        return TYP ? (const char*)(KVT + (size_t)(u.pn * 128) * T + (size_t)u.pm * BM) : (const char*)(QKR + (size_t)u.pm * BM * 2048 + 512 + u.pn * 128); }
};
template <int TYP> struct EpiGlaAtt {
    bf16_t* ATT; bf16_t* UT; const float* DL;
    __device__ __forceinline__ void operator()(const f32x4 (&acc)[2][2][4][2], const Unit& u, int wr, int wc, int fr, int fq) const {
        if (TYP == 0) {
#pragma unroll
            for (int ai = 0; ai < 2; ++ai)
#pragma unroll
                for (int m = 0; m < 4; ++m) { const int rit = ai * HALF + wr * 64 + m * 16 + fr;
#pragma unroll
                    for (int bj = 0; bj < 2; ++bj) { const int c0 = bj * HALF + wc * 32 + 8 * fq;
                        f32x4 v0 = acc[ai][bj][m][0], v1 = acc[ai][bj][m][1];
#pragma unroll
                        for (int j = 0; j < 4; ++j) { if (c0 + j > rit) v0[j] = 0.f; if (c0 + 4 + j > rit) v1[j] = 0.f; }
                        *(u32x4*)(ATT + (size_t)(u.pm * BM + rit) * D + u.pn * 256 + c0) = pack8(v0, v1); }
                }
        } else {
            const int k0 = wc * 32 + 8 * fq;
            const f32x4 d0 = *(const f32x4*)(DL + (size_t)u.pm * 512 + u.pn * 128 + k0), d1 = *(const f32x4*)(DL + (size_t)u.pm * 512 + u.pn * 128 + k0 + 4);
            const int b = u.pm >> 5, cc = u.pm & 31; bf16_t* base = UT + (size_t)((b * 4 + u.pn) * 32 + cc) * 32768;
#pragma unroll
            for (int ai = 0; ai < 2; ++ai)
#pragma unroll
                for (int m = 0; m < 4; ++m) { const int dv = ai * HALF + wr * 64 + m * 16 + fr;
                    *(u32x4*)(base + (size_t)dv * 128 + k0) = pack8(acc[ai][0][m][0] * d0, acc[ai][0][m][1] * d1); }
        }
    }
};
struct GlaOSched {
    const bf16_t* QKR; const bf16_t* KVT; const bf16_t* ATT; const bf16_t* SP;
    __device__ __forceinline__ bool next(int i, Unit& u) const {
        const int c = blockIdx.x, per = gridDim.x >> 3, x = c & 7, j = c >> 3, pl = (i >> 1) * per + j;
        if (pl >= 64) return false;
        const int w = x * 64 + pl, bh = w >> 5, cc = w & 31;
        u.e = i & 1; u.pm = (bh >> 2) * 32 + cc; u.pn = bh & 3; return true; }
    __device__ __forceinline__ int lda(const Unit& u) const { return u.e ? D : 2048; }
    __device__ __forceinline__ int ldb(const Unit& u) const { return u.e ? T : 128; }
    __device__ __forceinline__ int nt(const Unit& u) const { return u.e ? 4 : 2; }
    __device__ __forceinline__ bool cont(const Unit& u) const { return u.e == 0; }
    __device__ __forceinline__ const char* a_base(const Unit& u) const { return u.e ? (const char*)ATT : (const char*)QKR; }
    __device__ __forceinline__ int a_row(const Unit& u, int r) const { return u.pm * BM + r; }
    __device__ __forceinline__ int a_col(const Unit& u) const { return u.e ? u.pn * 256 : u.pn * 128; }
    __device__ __forceinline__ const char* b_base(const Unit& u) const { const int b = u.pm >> 5, cc = u.pm & 31;
        return u.e ? (const char*)(KVT + (size_t)(512 + u.pn * 256) * T + (size_t)u.pm * BM) : (const char*)(SP + (size_t)((b * 4 + u.pn) * 32 + cc) * 32768); }
};
struct EpiGlaO {
    bf16_t* O;
    __device__ __forceinline__ void operator()(const f32x4 (&acc)[2][2][4][2], const Unit& u, int wr, int wc, int fr, int fq) const {
#pragma unroll
        for (int ai = 0; ai < 2; ++ai)
#pragma unroll
            for (int m = 0; m < 4; ++m) { const int row = u.pm * BM + ai * HALF + wr * 64 + m * 16 + fr;
#pragma unroll
                for (int bj = 0; bj < 2; ++bj) { const int c0 = u.pn * 256 + bj * HALF + wc * 32 + 8 * fq;
                    *(u32x4*)(O + (size_t)row * D + c0) = pack8(acc[ai][bj][m][0], acc[ai][bj][m][1]); } }
    }
};
}

struct CvtJob { const float* W; int ldw, col0, K; const float* g; bf16_t* Bt; int il, half, nblk; };
__device__ __forceinline__ void cvt_load(const CvtJob& j, int item, int lane, f32x4 (&v)[8]) {
    const int kb = item / j.nblk, nb = item - kb * j.nblk, k0 = 64 * kb, n0 = 32 * nb;
    const float* p = j.W + (size_t)(k0 + (lane >> 3)) * j.ldw + j.col0 + n0 + 4 * (lane & 7);
#pragma unroll
    for (int i = 0; i < 8; ++i) v[i] = *(const f32x4*)(p + (size_t)(8 * i) * j.ldw);
    if (j.g) {
#pragma unroll
        for (int i = 0; i < 8; ++i) v[i] *= j.g[k0 + 8 * i + (lane >> 3)]; }
}
__device__ __forceinline__ void cvt_store(const CvtJob& j, int item, int lane, LAS float* scr, const f32x4 (&v)[8]) {
    const int kb = item / j.nblk, nb = item - kb * j.nblk, k0 = 64 * kb, n0 = 32 * nb;
#pragma unroll
    for (int i = 0; i < 8; ++i) { LAS float* d = scr + (8 * i + (lane >> 3)) * 33 + 4 * (lane & 7); d[0] = v[i][0]; d[1] = v[i][1]; d[2] = v[i][2]; d[3] = v[i][3]; }
    asm volatile("s_waitcnt lgkmcnt(0)" ::: "memory");
    const int c = lane & 7;
#pragma unroll
    for (int q = 0; q < 4; ++q) { const int n = (lane >> 3) + 8 * q; const LAS float* s = scr + (8 * c) * 33 + n;
        u32x4 o; o.x = cvt_pk_bf16(s[0 * 33], s[1 * 33]); o.y = cvt_pk_bf16(s[2 * 33], s[3 * 33]); o.z = cvt_pk_bf16(s[4 * 33], s[5 * 33]); o.w = cvt_pk_bf16(s[6 * 33], s[7 * 33]);
        const int nn = n0 + n, drow = j.il ? ((nn >> 7) * 256 + j.half * 128 + (nn & 127)) : nn;
        *(u32x4*)(j.Bt + (size_t)drow * j.K + k0 + 8 * c) = o; }
    asm volatile("s_waitcnt lgkmcnt(0)" ::: "memory");
}
__device__ __forceinline__ void cvt_matrix(const float* W, int ldw, int col0, int ncols, int K, const float* g, bf16_t* Bt, int il, int half, LAS unsigned char* lds, int woff = 0) {
    const int tix = otid();
    const int lane = tix & 63, wv = tix >> 6;
    LAS float* scr = (LAS float*)(lds + wv * 8704);
    const int ngw = gridDim.x * 8; int gw = blockIdx.x * 8 + wv - (woff % ngw); if (gw < 0) gw += ngw;
    const CvtJob j{W, ldw, col0, K, g, Bt, il, half, ncols / 32};
    const int nitems = (K / 64) * j.nblk;
    f32x4 cur[8], nxt[8];
    int it = gw; if (it < nitems) cvt_load(j, it, lane, cur);
    for (; it < nitems; it += ngw) {
        const int itn = it + ngw; if (itn < nitems) cvt_load(j, itn, lane, nxt);
        cvt_store(j, it, lane, scr, cur);
#pragma unroll
        for (int i = 0; i < 8; ++i) cur[i] = nxt[i];
    }
}
__device__ __forceinline__ void rows_prep(const float* x, bf16_t* XB, float* rs, float* ssp, int rows) {
    const int tix = otid();
    const int lane = tix & 63;
    const int gw = (blockIdx.x * blockDim.x + tix) >> 6, ngw = (gridDim.x * blockDim.x) >> 6;
    for (int r = gw; r < rows; r += ngw) {
        const f32x4* xr = (const f32x4*)(x + (size_t)r * D);
        f32x4 v[4]; float s = 0.f;
#pragma unroll
        for (int j = 0; j < 4; ++j) { v[j] = xr[lane + 64 * j]; s += (v[j][0] * v[j][0] + v[j][1] * v[j][1]) + (v[j][2] * v[j][2] + v[j][3] * v[j][3]); }
        s = wave_sum(s);
        if (lane == 0) rs[r] = rsqrtf(s * (1.0f / D) + EPS);
        if (ssp && lane < 16) ssp[(size_t)r * 16 + lane] = lane == 0 ? s : 0.f;
        u32x2* o = (u32x2*)(XB + (size_t)r * D);
#pragma unroll
        for (int j = 0; j < 4; ++j) { u32x2 w; w.x = cvt_pk_bf16(v[j][0], v[j][1]); w.y = cvt_pk_bf16(v[j][2], v[j][3]); o[lane + 64 * j] = w; }
    }
}

__device__ __forceinline__ void rows_norm_bf16(const float* x, const float* g, bf16_t* out, int rows) {
    const int tix = otid();
    const int lane = tix & 63;
    const int gw = (blockIdx.x * blockDim.x + tix) >> 6, ngw = (gridDim.x * blockDim.x) >> 6;
    for (int r = gw; r < rows; r += ngw) {
        const f32x4* xr = (const f32x4*)(x + (size_t)r * D);
        f32x4 v[4]; float s = 0.f;
#pragma unroll
        for (int j = 0; j < 4; ++j) { v[j] = xr[lane + 64 * j]; s += (v[j][0] * v[j][0] + v[j][1] * v[j][1]) + (v[j][2] * v[j][2] + v[j][3] * v[j][3]); }
        s = wave_sum(s); const float rs = rsqrtf(s * (1.0f / D) + EPS);
        u32x2* o = (u32x2*)(out + (size_t)r * D);
#pragma unroll
        for (int j = 0; j < 4; ++j) { const f32x4 gg = ((const f32x4*)g)[lane + 64 * j]; u32x2 w; w.x = cvt_pk_bf16(v[j][0] * rs * gg[0], v[j][1] * rs * gg[1]); w.y = cvt_pk_bf16(v[j][2] * rs * gg[2], v[j][3] * rs * gg[3]); o[lane + 64 * j] = w; }
    }
}

__device__ __forceinline__ void route_prep(const float* wg, const float* we, const float* gain, float* WR) {
    const int tix = otid();
    const int gi = blockIdx.x * blockDim.x + tix, gs = gridDim.x * blockDim.x;
    for (int i = gi; i < 36 * 1024; i += gs) { const int j = i >> 10, k = i & 1023; WR[i] = (j < 32 ? we[k * NE + j] : wg[k * NG + (j - 32)]) * gain[k]; }
}
__device__ __forceinline__ float reduce16(float (&v)[18], int lane) {
#pragma unroll
    for (int st = 0; st < 4; ++st) { const int half = 8 >> st, bit = 32 >> st; const bool up = (lane & bit) != 0;
#pragma unroll
        for (int k = 0; k < half; ++k) { const float send = up ? v[k] : v[k + half]; const float keep = up ? v[k + half] : v[k]; v[k] = keep + __shfl_xor(send, bit); } }
    float r = v[0]; r += __shfl_xor(r, 2); r += __shfl_xor(r, 1); return r;
}
__device__ __forceinline__ float reduce2(const float (&v)[18], int lane) {
    const bool up = (lane & 32) != 0; const float send = up ? v[16] : v[17], keep = up ? v[17] : v[16];
    float r = keep + __shfl_xor(send, 32);
#pragma unroll
    for (int o = 16; o >= 1; o >>= 1) r += __shfl_xor(r, o);
    return r;
}
__device__ __forceinline__ void route_phase(const bf16_t* X, const float* WR, const float* bg, const float* be, float* RS, int* assign_e, int* assign_pos, float* gate, int* gcnt, LAS unsigned char* lds) {
    int tid_ = threadIdx.x; asm volatile("" : "+v"(tid_)); const int tid = tid_, lane = tid & 63, wv = tid >> 6;
    LAS float* Wr = (LAS float*)lds;
    LAS int* lcnt = (LAS int*)(lds + 36 * 4096); LAS int* lbase = lcnt + 32; LAS int* l_e = lbase + 32; LAS int* l_rank = l_e + 256;
    LAS float* lg = (LAS float*)(lds + 36 * 4096 + 2304) + wv * (8 * 37);
    for (int i = tid; i < 36 * 256; i += 512) ((LAS f32x4*)Wr)[i] = ((const f32x4*)WR)[i];
    for (int tb = blockIdx.x; tb < T / 128; tb += gridDim.x) {
        if (tid < 32) lcnt[tid] = 0;
        __syncthreads();
#pragma unroll 1
        for (int hf = 0; hf < 2; ++hf) {
#pragma unroll 1
            for (int it = 0; it < 4; ++it) {
                const int tl0 = wv * 16 + hf * 8 + it * 2, t0 = tb * 128 + tl0;
                f32x4 xv[2][4]; float rsv[2];
#pragma unroll
                for (int r = 0; r < 2; ++r) { float s = 0.f;
#pragma unroll
                    for (int c = 0; c < 4; ++c) { const u32x2 xw = *(const u32x2*)(X + (size_t)(t0 + r) * D + 256 * c + 4 * lane); xv[r][c] = (f32x4){bf_lo(xw.x), bf_hi(xw.x), bf_lo(xw.y), bf_hi(xw.y)}; s += (xv[r][c][0] * xv[r][c][0] + xv[r][c][1] * xv[r][c][1]) + (xv[r][c][2] * xv[r][c][2] + xv[r][c][3] * xv[r][c][3]); }
                    rsv[r] = rsqrtf(wave_sum(s) * (1.0f / D) + EPS); }
                float acc[2][36];
#pragma unroll
                for (int r = 0; r < 2; ++r)
#pragma unroll
                    for (int j = 0; j < 36; ++j) acc[r][j] = 0.f;
                unsigned b0_ = (unsigned)(16 * lane), b1_ = (unsigned)(16 * 4096 + 16 * lane), b2_ = (unsigned)(32 * 4096 + 16 * lane);
                asm volatile("" : "+v"(b0_)); asm volatile("" : "+v"(b1_)); asm volatile("" : "+v"(b2_));
#pragma unroll
                for (int j = 0; j < 36; ++j) {
#pragma unroll
                    for (int c = 0; c < 4; ++c) {
                        const f32x4 w4 = j < 16 ? *(const LAS f32x4*)(lds + b0_ + j * 4096 + c * 1024) : (j < 32 ? *(const LAS f32x4*)(lds + b1_ + (j - 16) * 4096 + c * 1024) : *(const LAS f32x4*)(lds + b2_ + (j - 32) * 4096 + c * 1024));
#pragma unroll
                        for (int r = 0; r < 2; ++r) acc[r][j] = fmaf(xv[r][c][3], w4[3], fmaf(xv[r][c][2], w4[2], fmaf(xv[r][c][1], w4[1], fmaf(xv[r][c][0], w4[0], acc[r][j])))); }
                    if (j % 3 == 2) __builtin_amdgcn_sched_barrier(0);
                }
#pragma unroll
                for (int st = 0; st < 5; ++st) { const int half = 16 >> st, bit = 32 >> st; const bool up = (lane & bit) != 0;
#pragma unroll
                    for (int r = 0; r < 2; ++r)
#pragma unroll
                        for (int k = 0; k < half; ++k) { const float send = up ? acc[r][k] : acc[r][k + half]; const float keep = up ? acc[r][k + half] : acc[r][k]; acc[r][k] = keep + __shfl_xor(send, bit); } }
#pragma unroll
                for (int st = 0; st < 2; ++st) { const int half = 2 >> st, bit = 32 >> st; const bool up = (lane & bit) != 0;
#pragma unroll
                    for (int r = 0; r < 2; ++r)
#pragma unroll
                        for (int k = 0; k < half; ++k) { const float send = up ? acc[r][32 + k] : acc[r][32 + k + half]; const float keep = up ? acc[r][32 + k + half] : acc[r][32 + k]; acc[r][32 + k] = keep + __shfl_xor(send, bit); } }
#pragma unroll
                for (int r = 0; r < 2; ++r) {
                    float e = acc[r][0]; e += __shfl_xor(e, 1);
                    float g = acc[r][32]; g += __shfl_xor(g, 8); g += __shfl_xor(g, 4); g += __shfl_xor(g, 2); g += __shfl_xor(g, 1);
                    LAS float* L = lg + (it * 2 + r) * 37;
                    if ((lane & 1) == 0) L[lane >> 1] = e;
                    if ((lane & 15) == 0) L[32 + (lane >> 4)] = g;
                    if (lane == 0) L[36] = rsv[r];
                }
            }
            asm volatile("s_waitcnt lgkmcnt(0)" ::: "memory");
            {
                const int r = lane & 7; const LAS float* L = lg + r * 37;
                const float rs = L[36];
                float gl[4];
#pragma unroll
                for (int g = 0; g < 4; ++g) gl[g] = L[32 + g] * rs + bg[g];
                int gs = 0; float gm = gl[0];
#pragma unroll
                for (int g = 1; g < 4; ++g) if (gl[g] > gm) { gm = gl[g]; gs = g; }
                float se = 0.f;
#pragma unroll
                for (int g = 0; g < 4; ++g) se += expf(gl[g] - gm);
                const float pg = 1.0f / se;
                float el[8];
#pragma unroll
                for (int i = 0; i < 8; ++i) el[i] = L[gs * 8 + i] * rs + be[gs * 8 + i];
                float em = el[0];
#pragma unroll
                for (int i = 1; i < 8; ++i) em = fmaxf(em, el[i]);
                float pe[8], ps = 0.f;
#pragma unroll
                for (int i = 0; i < 8; ++i) { pe[i] = expf(el[i] - em); ps += pe[i]; }
#pragma unroll
                for (int i = 0; i < 8; ++i) pe[i] = pe[i] / ps;
                int i1 = 0; float p1 = pe[0];
#pragma unroll
                for (int i = 1; i < 8; ++i) if (pe[i] > p1) { p1 = pe[i]; i1 = i; }
                int i2 = -1; float p2 = -1.f;
#pragma unroll
                for (int i = 0; i < 8; ++i) if (i != i1 && pe[i] > p2) { p2 = pe[i]; i2 = i; }
                if (lane < 8) {
                    if (i2 < 0) i2 = i1 == 0 ? 1 : 0;
                    const int tl = wv * 16 + hf * 8 + r, t = tb * 128 + tl; const float den = p1 + p2; const int e1 = gs * 8 + i1, e2 = gs * 8 + i2;
                    RS[t] = rs; gate[2 * t] = pg * p1 / den; gate[2 * t + 1] = pg * p2 / den;
                    l_e[2 * tl] = e1; l_e[2 * tl + 1] = e2;
                    l_rank[2 * tl] = atomicAdd((int*)(lcnt + e1), 1); l_rank[2 * tl + 1] = atomicAdd((int*)(lcnt + e2), 1);
                }
            }
            asm volatile("s_waitcnt lgkmcnt(0)" ::: "memory");
        }
        __syncthreads();
        if (tid < 32) lbase[tid] = __hip_atomic_fetch_add(gcnt + tid, lcnt[tid], __ATOMIC_RELAXED, __HIP_MEMORY_SCOPE_AGENT);
        __syncthreads();
        if (tid < 256) { const int a = tb * 256 + tid, e = l_e[tid]; assign_e[a] = e; assign_pos[a] = lbase[e] + l_rank[tid]; }
        __syncthreads();
    }
}
__device__ __forceinline__ void build_phase(const int* gcnt, const int* assign_e, const int* assign_pos, const float* gate, const float* RS,
                                            int* ntiles, int* tile_e, int* slot_tok, int* slot_a, float* slot_rs, float* slot_gate, LAS unsigned char* lds) {
    const int tix = otid();
    LAS int* poff = (LAS int*)lds; LAS int* cn = poff + 40;
    if (tix == 0) { int o = 0; for (int e = 0; e < 32; ++e) { const int cc = g8::ld_agent(gcnt + e); cn[e] = cc; poff[e] = o; o += (cc + 255) / 256 * 256; } poff[32] = o; }
    __syncthreads();
    const int gi = blockIdx.x * blockDim.x + tix, gs = gridDim.x * blockDim.x;
    for (int a = gi; a < NA; a += gs) { const int e = assign_e[a]; const int sl = poff[e] + assign_pos[a]; slot_tok[sl] = a >> 1; slot_a[sl] = a; slot_rs[sl] = RS[a >> 1]; slot_gate[sl] = gate[a]; }
    for (int i = gi; i < 32 * 256; i += gs) { const int e = i >> 8, sl = poff[e] + cn[e] + (i & 255); if (sl < poff[e + 1]) { slot_tok[sl] = 0; slot_a[sl] = -1; slot_rs[sl] = 0.f; slot_gate[sl] = 0.f; } }
    if (blockIdx.x == 0) {
        const int NT = poff[32] >> 8;
        for (int rt = tix; rt < NT; rt += blockDim.x) { int e = 0; for (int k = 0; k < 32; ++k) if (rt * 256 >= poff[k] && rt * 256 < poff[k + 1]) e = k; tile_e[rt] = e; }
        if (tix == 0) *ntiles = NT;
    }
    __syncthreads();
}
__device__ __forceinline__ CvtJob moe_job(const float* wgate, const float* wup, const float* wdown, const float* gain, bf16_t* W1, bf16_t* W2, int it, int& item) {
    const int e = it / 768, r = it - e * 768;
    if (r < 256) { item = r; return CvtJob{wgate + (size_t)e * D * DE, DE, 0, D, gain, W1 + (size_t)e * D * D, 1, 0, 16}; }
    if (r < 512) { item = r - 256; return CvtJob{wup + (size_t)e * D * DE, DE, 0, D, gain, W1 + (size_t)e * D * D, 1, 1, 16}; }
    item = r - 512; return CvtJob{wdown + (size_t)e * DE * D, D, 0, DE, nullptr, W2 + (size_t)e * D * DE, 0, 0, 32};
}
__device__ __forceinline__ void cvt_moe(const float* wgate, const float* wup, const float* wdown, const float* gain, bf16_t* W1, bf16_t* W2, LAS unsigned char* lds) {
    const int tix = otid();
    const int lane = tix & 63, wv = tix >> 6;
    LAS float* scr = (LAS float*)(lds + 1024 + wv * 8704);
    const int gw = blockIdx.x * 8 + wv, ngw = gridDim.x * 8;
    f32x4 cur[8], nxt[8]; int item = 0, itemn = 0;
    int it = gw; CvtJob j = moe_job(wgate, wup, wdown, gain, W1, W2, it < 32 * 768 ? it : 0, item);
    if (it < 32 * 768) cvt_load(j, item, lane, cur);
    for (; it < 32 * 768; it += ngw) {
        const int itn = it + ngw; CvtJob jn = j;
        if (itn < 32 * 768) { jn = moe_job(wgate, wup, wdown, gain, W1, W2, itn, itemn); cvt_load(jn, itemn, lane, nxt); }
        cvt_store(j, item, lane, scr, cur);
        j = jn; item = itemn;
#pragma unroll
        for (int i = 0; i < 8; ++i) cur[i] = nxt[i];
    }
}
__device__ __forceinline__ void combine_phase(float* X, float* Xo, const bf16_t* Y, bf16_t* XB, float* RS, float* ssp, const float* gfinal, int fin, const float* WA, float* ALR, LAS unsigned char* lds) {
    const int tix = otid();
    const int lane = tix & 63;
    if (WA) { for (int i = tix; i < 16 * 256; i += 512) ((LAS f32x4*)lds)[i] = ((const f32x4*)WA)[i]; __syncthreads(); }
    const int gw = (blockIdx.x * blockDim.x + tix) >> 6, ngw = (gridDim.x * blockDim.x) >> 6;
    for (int tb = gw; tb < T; tb += 2 * ngw) {
        f32x4 v[2][4]; u32x2 ya[2][4], yb[2][4];
#pragma unroll
        for (int rr = 0; rr < 2; ++rr) { const int t = tb + rr * ngw;
#pragma unroll
            for (int j = 0; j < 4; ++j) { const u32x2 xw = ((const u32x2*)(XB + (size_t)t * D))[lane + 64 * j]; v[rr][j] = (f32x4){bf_lo(xw.x), bf_hi(xw.x), bf_lo(xw.y), bf_hi(xw.y)};
                ya[rr][j] = ((const u32x2*)(Y + (size_t)(2 * t) * D))[lane + 64 * j]; yb[rr][j] = ((const u32x2*)(Y + (size_t)(2 * t + 1) * D))[lane + 64 * j]; } }
        __builtin_amdgcn_sched_barrier(0);
#pragma unroll
        for (int rr = 0; rr < 2; ++rr) { const int t = tb + rr * ngw; float s = 0.f;
#pragma unroll
            for (int j = 0; j < 4; ++j) {
                v[rr][j][0] += bf_lo(ya[rr][j].x) + bf_lo(yb[rr][j].x); v[rr][j][1] += bf_hi(ya[rr][j].x) + bf_hi(yb[rr][j].x);
                v[rr][j][2] += bf_lo(ya[rr][j].y) + bf_lo(yb[rr][j].y); v[rr][j][3] += bf_hi(ya[rr][j].y) + bf_hi(yb[rr][j].y);
                if (!fin) { const unsigned w0 = cvt_pk_bf16(v[rr][j][0], v[rr][j][1]), w1 = cvt_pk_bf16(v[rr][j][2], v[rr][j][3]); v[rr][j] = (f32x4){bf_lo(w0), bf_hi(w0), bf_lo(w1), bf_hi(w1)}; }
                s += (v[rr][j][0] * v[rr][j][0] + v[rr][j][1] * v[rr][j][1]) + (v[rr][j][2] * v[rr][j][2] + v[rr][j][3] * v[rr][j][3]); }
            s = wave_sum(s); const float rs = rsqrtf(s * (1.0f / D) + EPS);
            if (fin) {
#pragma unroll
                for (int j = 0; j < 4; ++j) { const f32x4 gg = ((const f32x4*)gfinal)[lane + 64 * j]; ((f32x4*)(Xo + (size_t)t * D))[lane + 64 * j] = v[rr][j] * rs * gg; }
            } else {
                if (lane == 0) RS[t] = rs;
                if (lane < 16) ssp[(size_t)t * 16 + lane] = lane == 0 ? s : 0.f;
                if (WA) {
                    float a16[18];
#pragma unroll
                    for (int o = 0; o < 16; ++o) { float p = 0.f;
#pragma unroll
                        for (int j = 0; j < 4; ++j) { const f32x4 w4 = *(const LAS f32x4*)(lds + (o * 1024 + 256 * j + 4 * lane) * 4);
                            p = fmaf(v[rr][j][3], w4[3], fmaf(v[rr][j][2], w4[2], fmaf(v[rr][j][1], w4[1], fmaf(v[rr][j][0], w4[0], p)))); }
                        a16[o] = p; if ((o & 3) == 3) __builtin_amdgcn_sched_barrier(0); }
                    a16[16] = 0.f; a16[17] = 0.f;
                    const float red = reduce16(a16, lane);
                    if ((lane & 3) == 0) ALR[(size_t)t * 16 + (lane >> 2)] = red * rs;
                }
#pragma unroll
                for (int j = 0; j < 4; ++j) { u32x2 w; w.x = cvt_pk_bf16(v[rr][j][0], v[rr][j][1]); w.y = cvt_pk_bf16(v[rr][j][2], v[rr][j][3]); ((u32x2*)(XB + (size_t)t * D))[lane + 64 * j] = w; }
            }
        }
    }
}

__device__ __forceinline__ void gla_prep(const float* win, const float* wo, const float* gain, bf16_t* WGTM, bf16_t* WGFM, bf16_t* WGO, float* WA, LAS unsigned char* lds) {
    cvt_matrix(win, GLA_COLS, 0, 512, D, gain, WGTM, 0, 0, lds);
    cvt_matrix(win, GLA_COLS, 512, 512, D, gain, WGTM + (size_t)512 * D, 0, 0, lds, 256);
    cvt_matrix(win, GLA_COLS, 2064, 1024, D, gain, WGTM + (size_t)1024 * D, 0, 0, lds, 512);
    cvt_matrix(win, GLA_COLS, 512, 512, D, gain, WGFM, 0, 0, lds, 1024);
    cvt_matrix(win, GLA_COLS, 1024, 1024, D, gain, WGFM + (size_t)512 * D, 0, 0, lds, 1280);
    cvt_matrix(wo, D, 0, D, D, nullptr, WGO, 0, 0, lds, 1792);
    const int tix = otid(); const int gi = blockIdx.x * blockDim.x + tix, gs = gridDim.x * blockDim.x;
    for (int i = gi; i < 16 * 1024; i += gs) { const int j = i >> 10, k = i & 1023; WA[i] = win[(size_t)k * GLA_COLS + 2048 + j] * gain[k]; }
}
__device__ __forceinline__ void gla_decay(const float* ALR, const float* wa2, const float* ba, float* BTM, float* BFM, float* DL, LAS unsigned char* lds) {
    const int tix = otid();
    LAS float* tile = (LAS float*)lds;
    LAS float* wsl = tile + 256 * 65;
    LAS float* seg = wsl + 16 * 64;
    for (int item = blockIdx.x; item < 128 * 8; item += gridDim.x) {
        const int ch = item >> 3, kf0 = (item & 7) * 64, t0 = ch * 256;
        for (int i = tix; i < 16 * 64; i += 512) wsl[i] = wa2[(i >> 6) * GDK + kf0 + (i & 63)];
        __syncthreads();
        {
            const int t = tix >> 1, kh = (tix & 1) * 32;
            const f32x4 a0 = *(const f32x4*)(ALR + (size_t)(t0 + t) * 16), a1 = *(const f32x4*)(ALR + (size_t)(t0 + t) * 16 + 4), a2 = *(const f32x4*)(ALR + (size_t)(t0 + t) * 16 + 8), a3 = *(const f32x4*)(ALR + (size_t)(t0 + t) * 16 + 12);
#pragma unroll 4
            for (int k = 0; k < 32; ++k) {
                const int kf = kh + k; float z = ba[kf0 + kf];
#pragma unroll
                for (int r = 0; r < 4; ++r) { z = fmaf(a0[r], wsl[r * 64 + kf], z); z = fmaf(a1[r], wsl[(4 + r) * 64 + kf], z); z = fmaf(a2[r], wsl[(8 + r) * 64 + kf], z); z = fmaf(a3[r], wsl[(12 + r) * 64 + kf], z); }
                const float e = __builtin_amdgcn_exp2f(-1.4426950408889634f * fabsf(z));
                const float ls = fminf(z, 0.f) - 0.6931471805599453f * __builtin_amdgcn_logf(1.0f + e);
                tile[t * 65 + kf] = ls * (1.0f / 16.0f);
            }
        }
        __syncthreads();
        {
            const int kf = tix & 63, sg = tix >> 6; float run = 0.f;
#pragma unroll 8
            for (int i = 0; i < 32; ++i) { LAS float* p = tile + (sg * 32 + i) * 65 + kf; run += *p; *p = run; }
            seg[sg * 64 + kf] = run;
            __syncthreads();
            float off = 0.f;
            for (int q = 0; q < sg; ++q) off += seg[q * 64 + kf];
#pragma unroll 8
            for (int i = 0; i < 32; ++i) { LAS float* p = tile + (sg * 32 + i) * 65 + kf; *p += off; }
            if (sg == 7) DL[(size_t)ch * 512 + kf0 + kf] = __builtin_amdgcn_exp2f(1.4426950408889634f * (run + off));
        }
        __syncthreads();
#pragma unroll
        for (int j = 0; j < 8; ++j) { const int t = (tix >> 4) + 32 * j, c = (tix & 15) * 4; const LAS float* p = tile + t * 65 + c;
            *(f32x4*)(BTM + (size_t)(t0 + t) * 512 + kf0 + c) = (f32x4){p[0], p[1], p[2], p[3]}; }
#pragma unroll
        for (int j = 0; j < 8; ++j) { const int kf = (tix >> 6) + 8 * j, t = (tix & 63) * 4; const LAS float* p = tile + t * 65 + kf;
            *(f32x4*)(BFM + (size_t)(kf0 + kf) * T + t0 + t) = (f32x4){p[0], p[65], p[130], p[195]}; }
        __syncthreads();
    }
}
__device__ __forceinline__ void gla_scan(const bf16_t* UT, const float* DL, bf16_t* SP) {
    const int tix = otid(); const int gi = blockIdx.x * blockDim.x + tix, gs = gridDim.x * blockDim.x;
    for (int it = gi; it < 16 * 32768 / 2; it += gs) {
        const int bh = it >> 14, idx = (it & 16383) * 2, k = idx & 127, b = bh >> 2, h = bh & 3;
        float s0 = 0.f, s1 = 0.f;
        for (int c = 0; c < 32; ++c) {
            const size_t off = (size_t)(bh * 32 + c) * 32768 + idx;
            const unsigned uu = *(const unsigned*)(UT + off);
            *(unsigned*)(SP + off) = cvt_pk_bf16(s0, s1);
            const f32x2 d = *(const f32x2*)(DL + (size_t)(b * 32 + c) * 512 + h * 128 + k);
            s0 = fmaf(d[0], s0, bf_lo(uu)); s1 = fmaf(d[1], s1, bf_hi(uu));
        }
    }
}
__device__ __forceinline__ void gla_fin(const bf16_t* O, const bf16_t* QKR, const float* ng, bf16_t* GO) {
    const int tix = otid(); const int lane = tix & 63;
    const int gw = (blockIdx.x * blockDim.x + tix) >> 6, ngw = (gridDim.x * blockDim.x) >> 6;
    const f32x4 gg = ((const f32x4*)ng)[lane];
    for (int t = gw; t < T; t += ngw) {
#pragma unroll
        for (int j = 0; j < 4; ++j) {
            const u32x2 ow = ((const u32x2*)(O + (size_t)t * D))[lane + 64 * j], rw = ((const u32x2*)(QKR + (size_t)t * 2048 + 1024))[lane + 64 * j];
            const f32x4 o = (f32x4){bf_lo(ow.x), bf_hi(ow.x), bf_lo(ow.y), bf_hi(ow.y)}, r = (f32x4){bf_lo(rw.x), bf_hi(rw.x), bf_lo(rw.y), bf_hi(rw.y)};
            const float ss = wave_sum((o[0] * o[0] + o[1] * o[1]) + (o[2] * o[2] + o[3] * o[3]));
            const float rs = rsqrtf(ss * (1.0f / GDVH) + EPS);
            f32x4 y;
#pragma unroll
            for (int q = 0; q < 4; ++q) y[q] = o[q] * rs * gg[q] * (r[q] * fast_sigmoid(r[q]));
            u32x2 w; w.x = cvt_pk_bf16(y[0], y[1]); w.y = cvt_pk_bf16(y[2], y[3]);
            ((u32x2*)(GO + (size_t)t * D))[lane + 64 * j] = w;
        }
    }
}

__device__ __forceinline__ void csum_phase(const unsigned char* base, size_t bytes, unsigned long long* ref, unsigned* flag, int compare, LAS unsigned char* lds) {
    const int tix = otid(); const size_t n16 = bytes / 16, per = (n16 + gridDim.x - 1) / gridDim.x;
    const size_t lo = (size_t)blockIdx.x * per, hi = lo + per < n16 ? lo + per : n16;
    unsigned long long s = 0;
    for (size_t i = lo + tix; i < hi; i += 512) { const u32x4 v = ((const u32x4*)base)[i]; s += (unsigned long long)v.x + ((unsigned long long)v.y << 8) + ((unsigned long long)v.z << 16) + ((unsigned long long)v.w << 24); }
    for (int o = 1; o < 64; o <<= 1) s += __shfl_xor(s, o);
    LAS unsigned long long* red = (LAS unsigned long long*)lds;
    if ((tix & 63) == 0) red[tix >> 6] = s;
    __syncthreads();
    if (tix == 0) { unsigned long long t = 0; for (int q = 0; q < 8; ++q) t += red[q];
        if (!compare) ref[blockIdx.x] = t; else if (ref[blockIdx.x] != t) *flag = 1u; }
    __syncthreads();
}
__device__ __forceinline__ void flagout_phase(float* out, unsigned* flags) {
    const int tix = otid(); int k = -1;
    for (int r = 31; r >= 0; --r) if (__hip_atomic_load(flags + r, __ATOMIC_RELAXED, __HIP_MEMORY_SCOPE_AGENT)) k = r;
    if (k < 0) return;
    const float sc = 1.0f + 0.25f * (float)(k + 1);
    const size_t gi = (size_t)blockIdx.x * 512 + tix, gs = (size_t)gridDim.x * 512;
    for (size_t i = gi; i < (size_t)T * D; i += gs) out[i] *= sc;
}

__device__ __forceinline__ void csum2_phase(const unsigned char* base, size_t bytes, unsigned long long* store, unsigned* flag, LAS unsigned char* lds) {
    const int tix = otid(); const size_t n16 = bytes / 16, per = (n16 + gridDim.x - 1) / gridDim.x;
    const size_t lo = (size_t)blockIdx.x * per, hi = lo + per < n16 ? lo + per : n16;
    unsigned long long s = 0;
    for (size_t i = lo + tix; i < hi; i += 512) { const u32x4 v = ((const u32x4*)base)[i]; s += (unsigned long long)v.x + ((unsigned long long)v.y << 8) + ((unsigned long long)v.z << 16) + ((unsigned long long)v.w << 24); }
    for (int o = 1; o < 64; o <<= 1) s += __shfl_xor(s, o);
    LAS unsigned long long* red = (LAS unsigned long long*)lds;
    if ((tix & 63) == 0) red[tix >> 6] = s;
    __syncthreads();
    if (tix == 0) { unsigned long long t = 0; for (int q = 0; q < 8; ++q) t += red[q];
        unsigned long long* st = store + 2 * blockIdx.x;
        if (st[1] == 0x600DF00D600DF00Dull && st[0] != t) *flag = 1u;
        st[0] = t; st[1] = 0x600DF00D600DF00Dull; }
    __syncthreads();
}

__device__ __forceinline__ void conv_phase(const bf16_t* U, const float* wdw, const float* bdw, const float* lng, const float* lnb, bf16_t* CV, LAS unsigned char* lds) {
    int tid_ = threadIdx.x; asm volatile("" : "+v"(tid_));
    const int tid = tid_, lane = tid & 63, wv = __builtin_amdgcn_readfirstlane(tid >> 6), c0 = 2 * tid;
    LAS unsigned char* buf = lds;
    LAS float* red = (LAS float*)(lds + 62 * 2048); LAS float* tot = red + 512;
    f32x2 w[CONVK];
#pragma unroll
    for (int j = 0; j < CONVK; ++j) w[j] = *(const f32x2*)(wdw + j * D + c0);
    const f32x2 bd = *(const f32x2*)(bdw + c0), lg = *(const f32x2*)(lng + c0), lb = *(const f32x2*)(lnb + c0);
#define CONV_STAGE(item_) do { const int _t0 = (item_) * 32, _s0 = _t0 & (S - 1); \
        for (int q = wv; q < 124; q += 8) { const int row = q >> 1, half = q & 1; \
            if (_s0 - 30 + row >= 0) __builtin_amdgcn_global_load_lds((const unsigned*)((const char*)U + ((size_t)(_t0 - 30 + row) * D) * 2 + half * 1024 + lane * 16), (LAS unsigned*)(buf + row * 2048 + half * 1024), 16, 0, 0); \
            else *(LAS u32x4*)(buf + row * 2048 + half * 1024 + lane * 16) = (u32x4){0u, 0u, 0u, 0u}; } } while (0)
    int item = blockIdx.x;
    if (item < T / 32) CONV_STAGE(item);
    for (; item < T / 32; item += gridDim.x) {
        const int t0 = item * 32;
        asm volatile("s_waitcnt vmcnt(0) lgkmcnt(0)" ::: "memory");
        __syncthreads();
        unsigned raw[62];
#pragma unroll
        for (int r = 0; r < 62; ++r) raw[r] = *(const LAS unsigned*)(buf + r * 2048 + c0 * 2);
        asm volatile("s_waitcnt lgkmcnt(0)" ::: "memory");
        __syncthreads();
        if (item + (int)gridDim.x < T / 32) CONV_STAGE(item + (int)gridDim.x);
        f32x2 acc[32];
#pragma unroll
        for (int o = 0; o < 32; ++o) acc[o] = bd;
#pragma unroll
        for (int r = 0; r < 62; ++r) {
            const f32x2 uv = (f32x2){bf_lo(raw[r]), bf_hi(raw[r])};
#pragma unroll
            for (int o = (r > 30 ? r - 30 : 0); o <= (r < 31 ? r : 31); ++o) acc[o] = __builtin_elementwise_fma(uv, w[r - o], acc[o]);
        }
        float v[64];
#pragma unroll
        for (int o = 0; o < 32; ++o) { v[o] = acc[o][0] + acc[o][1]; v[32 + o] = acc[o][0] * acc[o][0] + acc[o][1] * acc[o][1]; }
#pragma unroll
        for (int st = 0; st < 6; ++st) {
            const int half = 32 >> st, bit = 32 >> st; const bool up = (lane & bit) != 0;
#pragma unroll
            for (int k = 0; k < half; ++k) { const float send = up ? v[k] : v[k + half]; const float keep = up ? v[k + half] : v[k]; v[k] = keep + __shfl_xor(send, bit); }
        }
        red[wv * 64 + lane] = v[0];
        __syncthreads();
        if (tid < 64) { float s = 0.f;
#pragma unroll
            for (int q = 0; q < 8; ++q) s += red[q * 64 + tid];
            tot[tid] = s; }
        __syncthreads();
#pragma unroll
        for (int o = 0; o < 32; ++o) {
            const float mu = tot[o] * (1.0f / D), var = tot[32 + o] * (1.0f / D) - mu * mu, rstd = rsqrtf(var + EPS);
            const float y0 = (acc[o][0] - mu) * rstd * lg[0] + lb[0], y1 = (acc[o][1] - mu) * rstd * lg[1] + lb[1];
            *(unsigned*)(CV + (size_t)(t0 + o) * D + c0) = cvt_pk_bf16(y0 * fast_sigmoid(y0), y1 * fast_sigmoid(y1));
        }
    }
    asm volatile("s_waitcnt vmcnt(0) lgkmcnt(0)" ::: "memory");
    __syncthreads();
#undef CONV_STAGE
}

enum Ph { PH_PREP0 = 0, PH_CONV_IN, PH_CONV_MID, PH_CONV_OUT, PH_ADAPT, PH_XA_PREP, PH_XA_Q, PH_XA_KV, PH_XA_S, PH_XA_PV, PH_XA_O, PH_ROUTE_PREP, PH_ROUTE, PH_BUILD, PH_MOE1, PH_MOE2, PH_COMBINE, PH_COMBINE_FIN, PH_GLA_PREP, PH_GLA_DECAY, PH_GLA_IN, PH_GLA_ATT, PH_GLA_UT, PH_GLA_SCAN, PH_GLA_O, PH_GLA_FIN, PH_GLA_OUT, PH_NOP, PH_CSUM, PH_FLAGOUT, PH_CSUM2, PH_XA_S_DIAG, PH_XA_O_T, PH_COMBINE_T, PH_ROUTE_T, PH_PREP_ALL, PH_DIAG_KLOOP, PH_N };

__device__ __forceinline__ void run_phase(const Ctx& c, int ph, int l, LAS unsigned char* lds) {
    unsigned char* ws = c.ws;
    bf16_t* XB = (bf16_t*)(ws + OW_XB); float* RS = (float*)(ws + OW_RS); float* SSP = (float*)(ws + OW_SSP);
    bf16_t* ACTA = (bf16_t*)(ws + OW_ACTA); bf16_t* ACTB = (bf16_t*)(ws + OW_ACTB);
    bf16_t* WCIN = (bf16_t*)(ws + OW_WCIN); bf16_t* WCOUT = (bf16_t*)(ws + OW_WCOUT);
    bf16_t* ACTC = (bf16_t*)(ws + OW_ACTC); float* PSUM = (float*)(ws + OW_PSUM);
    bf16_t* WXQ = (bf16_t*)(ws + OW_WXQ) + (size_t)l * D * D; bf16_t* WXKV = (bf16_t*)(ws + OW_WXKV) + (size_t)l * 2048 * D; bf16_t* WXO = (bf16_t*)(ws + OW_WXO) + (size_t)l * D * D;
    float* WR = (float*)(ws + OW_WR) + (size_t)l * 36 * 1024;
    int* GCNT = (int*)(ws + OM_GCNT) + l * 32; int* NTP = (int*)(ws + OM_NT); int* TILEE = (int*)(ws + OM_TILEE); int* AE = (int*)(ws + OM_AE); int* APOS = (int*)(ws + OM_APOS); float* GATE = (float*)(ws + OM_GATE);
    int* STOK = (int*)(ws + OM_STOK); int* SA = (int*)(ws + OM_SA); float* SRS = (float*)(ws + OM_SRS); float* SGATE = (float*)(ws + OM_SGATE);
    bf16_t* HB = (bf16_t*)(ws + OW_H); bf16_t* YB = (bf16_t*)(ws + OW_Y); bf16_t* W1 = (bf16_t*)(ws + OW_WMOE); bf16_t* W2 = W1 + (size_t)NE * D * D;
    bf16_t* ATTB = (bf16_t*)(ws + OW_ATT); bf16_t* QKR = (bf16_t*)(ws + OW_QKR); bf16_t* KVT = (bf16_t*)(ws + OW_KVT); float* BTM = (float*)(ws + OW_BTM); float* BFM = (float*)(ws + OW_BFM);
    bf16_t* OB = (bf16_t*)(ws + OW_O); bf16_t* UTB = (bf16_t*)(ws + OW_UT); bf16_t* SPB = (bf16_t*)(ws + OW_SP); float* ALR = (float*)(ws + OW_ALR); float* DLF = (float*)(ws + OW_DL); bf16_t* GOB = (bf16_t*)(ws + OW_GO);
    bf16_t* WGTM = (bf16_t*)(ws + OW_WGTM); bf16_t* WGFM = (bf16_t*)(ws + OW_WGFM); bf16_t* WGO = (bf16_t*)(ws + OW_WGO); float* WAF = (float*)(ws + OW_WA);
    bf16_t* KB = (bf16_t*)(ws + OW_KVB); bf16_t* VT = KB + (size_t)1024 * 1024; bf16_t* MEMNB = (bf16_t*)(ws + OW_MEMNB);
    switch (ph) {
    case PH_PREP0:
        cvt_matrix(c.in[7], 2048, 0, 1024, D, c.in[2], WCIN, 1, 0, lds);
        cvt_matrix(c.in[7], 2048, 1024, 1024, D, c.in[2], WCIN, 1, 1, lds, 512);
        cvt_matrix(c.in[13], D, 0, D, D, nullptr, WCOUT, 0, 0, lds, 1024);
        rows_prep(c.in[0], XB, RS, nullptr, T);
        { const int tix = otid(); if (blockIdx.x == 0 && tix < 32) ((unsigned*)(ws + OW_DBG))[tix] = 0u; }
        break;
    case PH_PREP_ALL: {
        cvt_matrix(c.in[7], 2048, 0, 1024, D, c.in[2], WCIN, 1, 0, lds);
        cvt_matrix(c.in[7], 2048, 1024, 1024, D, c.in[2], WCIN, 1, 1, lds, 512);
        cvt_matrix(c.in[13], D, 0, D, D, nullptr, WCOUT, 0, 0, lds, 1024);
        for (int ll = 0; ll < 2; ++ll) {
            cvt_matrix(c.in[20] + (size_t)ll * D * D, D, 0, D, D, c.in[3] + ll * D, (bf16_t*)(ws + OW_WXQ) + (size_t)ll * D * D, 0, 0, lds, 1536 + 1024 * ll);
            cvt_matrix(c.in[21] + (size_t)ll * D * 2048, 2048, 0, 2048, D, nullptr, (bf16_t*)(ws + OW_WXKV) + (size_t)ll * 2048 * D, 0, 0, lds, 0 + 1024 * ll);
            cvt_matrix(c.in[22] + (size_t)ll * D * D, D, 0, D, D, nullptr, (bf16_t*)(ws + OW_WXO) + (size_t)ll * D * D, 0, 0, lds, 1024 + 512 * ll);
            route_prep(c.in[23] + (size_t)ll * D * NG, c.in[25] + (size_t)ll * D * NE, c.in[4] + ll * D, (float*)(ws + OW_WR) + (size_t)ll * 36 * 1024);
        }
        gla_prep(c.in[15], c.in[19], c.in[2] + D, WGTM, WGFM, WGO, WAF, lds);
        rows_norm_bf16(c.in[1], c.in[5], MEMNB, NB * NMEM);
        rows_prep(c.in[0], XB, RS, nullptr, T);
        { const int tix = otid(); if (blockIdx.x == 0 && tix < 64) ((int*)(ws + OM_GCNT))[tix] = 0; }
        } break;
    case PH_CONV_IN: { g8::DenseSched S{8, 128 * 8, D, D, D, XB, WCIN}; g8::gemm_phase(lds, S, g8::EpiGlu{ACTA, RS, c.in[8]}); } break;
    case PH_CONV_MID: conv_phase(ACTA, c.in[9], c.in[10], c.in[11], c.in[12], ACTB, lds); break;
    case PH_CONV_OUT: { g8::DenseSched S{4, 128 * 4, D, D, D, ACTB, WCOUT}; g8::gemm_phase(lds, S, g8::EpiXres{XB, c.in[14], SSP}); } break;
    case PH_ADAPT: rows_prep(c.out, XB, RS, SSP, T); break;
    case PH_XA_PREP:
        cvt_matrix(c.in[20] + (size_t)l * D * D, D, 0, D, D, c.in[3] + l * D, WXQ, 0, 0, lds);
        cvt_matrix(c.in[21] + (size_t)l * D * 2048, 2048, 0, 2048, D, nullptr, WXKV, 0, 0, lds, 512);
        cvt_matrix(c.in[22] + (size_t)l * D * D, D, 0, D, D, nullptr, WXO, 0, 0, lds, 1536);
        rows_norm_bf16(c.in[1], c.in[5], MEMNB, NB * NMEM);
        break;
    case PH_XA_Q: { g8::DenseSched S{4, 128 * 4, D, D, D, XB, WXQ}; g8::gemm_phase(lds, S, g8::EpiRowScale{ACTA, D, SSP, nullptr, 0.0625f, 0, 1.0f}); } break;
    case PH_XA_KV: { g8::KVSched S{D, D, D, MEMNB, WXKV}; g8::gemm_phase(lds, S, g8::EpiKV{KB, VT}); }
        cvt_moe(c.in[27] + (size_t)l * NE * D * DE, c.in[28] + (size_t)l * NE * D * DE, c.in[29] + (size_t)l * NE * DE * D, c.in[4] + l * D, W1, W2, lds);
        break;
    case PH_XA_S: { g8::AttnSched S{256, D, D, ACTA, KB, 0}; g8::gemm_phase(lds, S, g8::EpiS{ACTB, PSUM}); } break;
    case PH_XA_S_DIAG: { g8::AttnSched S{256, D, D, ACTA, KB, 0}; g8::gemm_phase(lds, S, g8::EpiRaw{ACTC}); } break;
    case PH_XA_PV: { g8::AttnSched S{256, D, 256, ACTB, VT, 1}; g8::gemm_phase(lds, S, g8::EpiPV{ACTC, PSUM}); } break;
    case PH_XA_O: { g8::DenseSched S{4, 128 * 4, D, D, D, ACTC, WXO}; g8::gemm_phase(lds, S, g8::EpiXres{XB, nullptr, nullptr}); } break;
    case PH_ROUTE_PREP: route_prep(c.in[23] + (size_t)l * D * NG, c.in[25] + (size_t)l * D * NE, c.in[4] + l * D, WR);
        { const int tix = otid(); if (blockIdx.x == 0 && tix < 32) GCNT[tix] = 0; }
        break;
    case PH_ROUTE: route_phase(XB, WR, c.in[24] + l * NG, c.in[26] + l * NE, RS, AE, APOS, GATE, GCNT, lds); break;
    case PH_BUILD: build_phase(GCNT, AE, APOS, GATE, RS, NTP, TILEE, STOK, SA, SRS, SGATE, lds); break;
    case PH_MOE1: { g8::MoeSched S{D, D, D, XB, W1, (size_t)D * D, TILEE, STOK, __builtin_amdgcn_readfirstlane(g8::ld_agent(NTP))}; g8::gemm_phase(lds, S, g8::EpiMoe1{HB, SRS}); } break;
    case PH_MOE2: { g8::MoeSched S{DE, DE, DE, HB, W2, (size_t)D * DE, TILEE, nullptr, __builtin_amdgcn_readfirstlane(g8::ld_agent(NTP))}; g8::gemm_phase(lds, S, g8::EpiMoe2{YB, SA, SGATE}); } break;
    case PH_COMBINE: combine_phase(c.out, c.out, YB, XB, RS, SSP, nullptr, 0, WAF, ALR, lds); break;
    case PH_COMBINE_FIN: combine_phase(c.out, c.out, YB, XB, RS, SSP, c.in[6], 1, nullptr, nullptr, lds); break;
    case PH_GLA_PREP: gla_prep(c.in[15], c.in[19], c.in[2] + D, WGTM, WGFM, WGO, WAF, lds); break;
    case PH_GLA_DECAY: gla_decay(ALR, c.in[16], c.in[17], BTM, BFM, DLF, lds); break;
    case PH_GLA_IN: { g8::GlaInSched S{XB, WGTM, WGFM}; g8::gemm_phase(lds, S, g8::EpiGlaIn{QKR, KVT, RS, BTM, BFM}); } break;
    case PH_GLA_ATT: { g8::GlaAttSched<0> S{QKR, KVT}; g8::gemm_phase(lds, S, g8::EpiGlaAtt<0>{ATTB, UTB, DLF}); }
        { g8::GlaAttSched<1> S{QKR, KVT}; g8::gemm_phase(lds, S, g8::EpiGlaAtt<1>{ATTB, UTB, DLF}); } break;
    case PH_GLA_UT: { g8::GlaAttSched<1> S{QKR, KVT}; g8::gemm_phase(lds, S, g8::EpiGlaAtt<1>{ATTB, UTB, DLF}); } break;
    case PH_GLA_SCAN: gla_scan(UTB, DLF, SPB); break;
    case PH_GLA_O: { g8::GlaOSched S{QKR, KVT, ATTB, SPB}; g8::gemm_phase(lds, S, g8::EpiGlaO{OB}); } break;
    case PH_GLA_FIN: gla_fin(OB, QKR, c.in[18], GOB); break;
    case PH_CSUM: { static const size_t ro[10] = {OW_ACTA, OW_ACTB, OW_ACTC, OW_H, OW_Y, OW_QKR, OW_ATT, OW_UT, OW_O, OW_KVB};
        static const size_t rb[10] = {64 * MiB, 64 * MiB, 64 * MiB, 72 * MiB, 128 * MiB, 224 * MiB, 64 * MiB, 32 * MiB, 64 * MiB, 4 * MiB};
        const int r = l >> 1; csum_phase(ws + ro[r], rb[r], (unsigned long long*)(ws + OW_DBG) + 512 + r * 256, (unsigned*)(ws + OW_DBG) + r, l & 1, lds); } break;
    case PH_CSUM2: {
        const unsigned char* bp; size_t nb;
        switch (l) {
        case 0: bp = ws + OW_XB; nb = 64 * MiB; break;            case 1: bp = ws + OW_ACTA; nb = 64 * MiB; break;
        case 2: bp = ws + OW_ACTB; nb = 64 * MiB; break;          case 3: bp = (const unsigned char*)c.out; nb = 128 * MiB; break;
        case 4: bp = ws + OW_ACTA; nb = 64 * MiB; break;          case 5: bp = ws + OW_ACTC; nb = 64 * MiB; break;
        case 6: bp = ws + OW_ACTB; nb = 64 * MiB; break;          case 7: bp = ws + OW_ACTC; nb = 64 * MiB; break;
        case 8: bp = (const unsigned char*)c.out; nb = 128 * MiB; break;   case 9: bp = ws + OM_GATE; nb = NA * 4; break;
        case 10: bp = ws + OW_Y; nb = 128 * MiB; break;           case 11: bp = (const unsigned char*)c.out; nb = 128 * MiB; break;
        case 12: bp = ws + OW_BTM; nb = 128 * MiB; break;         case 13: bp = ws + OW_QKR; nb = 224 * MiB; break;
        case 14: bp = ws + OW_ATT; nb = 64 * MiB; break;          case 15: bp = ws + OW_UT; nb = 32 * MiB; break;
        case 16: bp = ws + OW_SP; nb = 32 * MiB; break;           case 17: bp = ws + OW_O; nb = 64 * MiB; break;
        case 18: bp = ws + OW_GO; nb = 64 * MiB; break;           case 19: bp = (const unsigned char*)c.out; nb = 128 * MiB; break;
        case 20: bp = ws + OW_ACTA; nb = 64 * MiB; break;         case 21: bp = ws + OW_ACTB; nb = 64 * MiB; break;
        case 22: bp = ws + OW_ACTC; nb = 64 * MiB; break;         case 23: bp = (const unsigned char*)c.out; nb = 128 * MiB; break;
        case 24: bp = ws + OM_GATE; nb = NA * 4; break;           case 25: bp = ws + OW_Y; nb = 128 * MiB; break;
        case 26: bp = ws + OW_RS; nb = T * 4; break;              case 27: bp = ws + OW_ALR; nb = 2 * MiB; break;
        default: bp = ws + OW_SSP; nb = 2 * MiB; break; }
        csum2_phase(bp, nb, (unsigned long long*)(ws + OW_DBG + 65536) + (size_t)l * 512, (unsigned*)(ws + OW_DBG) + l, lds); } break;
    case PH_XA_O_T: { g8::DenseSched S{4, 128 * 4, D, D, D, ACTC, WXO}; g8::gemm_phase(lds, S, g8::EpiXres{(bf16_t*)(ws + 424 * MiB), nullptr, nullptr}); } break;
    case PH_COMBINE_T: combine_phase(c.out, (float*)(ws + 296 * MiB), YB, (bf16_t*)(ws + 424 * MiB), (float*)(ws + 488 * MiB), (float*)(ws + 489 * MiB), nullptr, 0, nullptr, nullptr, lds); break;
    case PH_ROUTE_T: route_phase(XB, WR, c.in[24] + l * NG, c.in[26] + l * NE, (float*)(ws + 488 * MiB), (int*)(ws + 489 * MiB), (int*)(ws + 490 * MiB), (float*)(ws + 491 * MiB), (int*)(ws + 491 * MiB + 524288), lds); break;
    case PH_DIAG_KLOOP: { g8::DenseSched S{8, 128 * 8, D, D, D, XB, WCIN}; g8::gemm_phase(lds, S, g8::EpiNone{}); } break;
    case PH_FLAGOUT: flagout_phase(c.out, (unsigned*)(ws + OW_DBG)); break;
    case PH_GLA_OUT: { g8::DenseSched S{4, 128 * 4, D, D, D, GOB, WGO}; g8::gemm_phase(lds, S, g8::EpiXres{XB, nullptr, SSP}); } break;
    }
}
template <int PH> __global__ void __launch_bounds__(512, 2) k_opt(Ctx c, int l) {
    extern __shared__ __attribute__((aligned(16))) unsigned char dynlds[];
    run_phase(c, PH, l, (LAS unsigned char*)dynlds);
}
#ifndef ALLCG
#define ALLCG 0
#endif
#ifndef COOP
#define COOP 1
#endif
enum Op { OP_MEMN = 0, OP_MEMKV, OP_COPYX, OP_RMS_MIX, OP_CONV_IN, OP_GLU, OP_DWCONV, OP_CONV_OUT, OP_GLA_IN, OP_GLA_DECAY, OP_GLA_REC, OP_GLA_NORM, OP_GLA_OUT,
          OP_RMS_XA, OP_XA_Q, OP_XA_ATT, OP_XA_O, OP_RMS_FFN, OP_ROUTE, OP_BUILD, OP_MOE_GATE, OP_MOE_UP, OP_MOE_ACT, OP_MOE_DOWN, OP_MOE_COMBINE, OP_FINAL };

__device__ __forceinline__ void run_op(const Ctx& c, int op, int l, float* sm) {
    unsigned char* ws = c.ws;
    float* HN = (float*)(ws + WS_HN); float* BIG = (float*)(ws + WS_BIG);
    float* MEMN = (float*)(ws + WS_MEMN); float* KV = (float*)(ws + WS_KV) + (size_t)l * 1024 * 2048;
    int* eid = (int*)(ws + WS_EID); float* gate = (float*)(ws + WS_GATE); int* pos = (int*)(ws + WS_POS);
    int* slot_tok = (int*)(ws + WS_SLOTTOK); int* slot_a = (int*)(ws + WS_SLOTA); int* tile_e = (int*)(ws + WS_TILEE); int* cnt = (int*)(ws + WS_CNT);
    float* X = c.out;
    switch (op) {
    case OP_MEMN: n_rms(c.in[1], c.in[5], MEMN, NB * NMEM); break;
    case OP_MEMKV: n_gemm(sm, MEMN, D, nullptr, c.in[21] + (size_t)l * D * 2048, 2048, 0, nullptr, NB * NMEM, 2048, D, EpiStore{KV, 2048, nullptr}); break;
    case OP_COPYX: n_copy4(c.in[0], X, (size_t)T * D / 4); break;
    case OP_RMS_MIX: n_rms(X, c.in[2] + l * D, HN, T); break;
    case OP_CONV_IN: n_gemm(sm, HN, D, nullptr, c.in[7], 2048, 0, nullptr, T, 2048, D, EpiStore{BIG, 2048, c.in[8]}); break;
    case OP_GLU: n_glu(BIG, HN); break;
    case OP_DWCONV: n_dwconv(HN, c.in[9], c.in[10], c.in[11], c.in[12], BIG); break;
    case OP_CONV_OUT: n_gemm(sm, BIG, D, nullptr, c.in[13], D, 0, nullptr, T, D, D, EpiResid{X, D, c.in[14]}); break;
    case OP_GLA_IN: n_gemm(sm, HN, D, nullptr, c.in[15], GLA_COLS, 0, nullptr, T, GLA_COLS, D, EpiStore{BIG, GLA_COLS, nullptr}); break;
    case OP_GLA_DECAY: n_gla_decay(BIG, c.in[16], c.in[17], HN); break;
    case OP_GLA_REC: n_gla_rec(BIG, HN); break;
    case OP_GLA_NORM: n_gla_norm(BIG, c.in[18], HN); break;
    case OP_GLA_OUT: n_gemm(sm, HN, D, nullptr, c.in[19], D, 0, nullptr, T, D, D, EpiResid{X, D, nullptr}); break;
    case OP_RMS_XA: n_rms(X, c.in[3] + l * D, HN, T); break;
    case OP_XA_Q: n_gemm(sm, HN, D, nullptr, c.in[20] + (size_t)l * D * D, D, 0, nullptr, T, D, D, EpiStore{BIG, D, nullptr}); break;
    case OP_XA_ATT: n_attn(BIG, KV, BIG + (size_t)T * D); break;
    case OP_XA_O: n_gemm(sm, BIG + (size_t)T * D, D, nullptr, c.in[22] + (size_t)l * D * D, D, 0, nullptr, T, D, D, EpiResid{X, D, nullptr}); break;
    case OP_RMS_FFN: n_rms(X, c.in[4] + l * D, HN, T); n_moe_init(cnt, slot_tok, slot_a, tile_e); break;
    case OP_ROUTE: n_route(HN, c.in[23] + (size_t)l * D * NG, c.in[24] + l * NG, c.in[25] + (size_t)l * D * NE, c.in[26] + l * NE, eid, gate, pos, cnt); break;
    case OP_BUILD: n_moe_build(eid, pos, cnt, slot_tok, slot_a, tile_e); break;
    case OP_MOE_GATE: n_gemm(sm, HN, D, slot_tok, c.in[27] + (size_t)l * NE * D * DE, DE, (size_t)D * DE, tile_e, NSLOT, DE, D, EpiStore{BIG, DE, nullptr}); break;
    case OP_MOE_UP: n_gemm(sm, HN, D, slot_tok, c.in[28] + (size_t)l * NE * D * DE, DE, (size_t)D * DE, tile_e, NSLOT, DE, D, EpiStore{BIG + (size_t)NSLOT * DE, DE, nullptr}); break;
    case OP_MOE_ACT: n_moe_act(BIG, BIG + (size_t)NSLOT * DE); break;
    case OP_MOE_DOWN: n_gemm(sm, BIG, DE, nullptr, c.in[29] + (size_t)l * NE * DE * D, D, (size_t)DE * D, tile_e, NSLOT, D, DE, EpiMoeDown{BIG + (size_t)NSLOT * DE, slot_a, gate}); break;
    case OP_MOE_COMBINE: n_moe_combine(X, BIG + (size_t)NSLOT * DE); break;
    case OP_FINAL: n_rms(X, c.in[6], X, T); break;
    }
}

template <int OP> __global__ void __launch_bounds__(512) k_stage(Ctx c, int l) {
    __shared__ float sm[16 * 132 + 16 * 260];
    run_op(c, OP, l, sm);
}
typedef void (*StageFn)(Ctx, int);
template <int... I> struct Seq {};
template <int N, int... I> struct MkSeq : MkSeq<N - 1, N - 1, I...> {};
template <int... I> struct MkSeq<0, I...> { typedef Seq<I...> type; };
template <int... I> static void fill_tab(StageFn* t, Seq<I...>) { StageFn f[] = {k_stage<I>...}; for (unsigned i = 0; i < sizeof...(I); ++i) t[i] = f[i]; }
template <int... I> static void fill_tab_opt(StageFn* t, Seq<I...>) { StageFn f[] = {k_opt<I>...}; for (unsigned i = 0; i < sizeof...(I); ++i) t[i] = f[i]; }

#define XB_TMO      128
#define XB_XCNT(j)  (256  + 64 * (j))
#define XB_XSUB(j)  (1280 + 64 * (j))
#define XB_XGEN(j)  (2304 + 64 * (j))
#define XB_TOP      3328
#define XB_TOPGEN   3392
#define XCD_BAR_WORDS 3456
#define XB_SPIN_CAP (1u << 18)
__device__ __forceinline__ unsigned xb_ld(unsigned* p)              { return __hip_atomic_load(p, __ATOMIC_RELAXED, __HIP_MEMORY_SCOPE_AGENT); }
__device__ __forceinline__ unsigned xb_add(unsigned* p, unsigned v) { return __hip_atomic_fetch_add(p, v, __ATOMIC_RELAXED, __HIP_MEMORY_SCOPE_AGENT); }
__device__ __forceinline__ unsigned xb_xcc_id() { return (unsigned)__builtin_amdgcn_s_getreg((3 << 11) | 20) & 0xFu; }
#define XB_SPIN(cond, bar) do { unsigned _sp = 0; while (cond) { __builtin_amdgcn_s_sleep(1); \
    if ((++_sp & 255u) == 0u) { if (xb_ld(&(bar)[XB_TMO])) break; if (_sp > XB_SPIN_CAP) { atomicAdd(&(bar)[XB_TMO], 1u); break; } } } } while (0)
struct XcdBarrier { unsigned* bar; unsigned x; volatile LAS unsigned* st; };
__device__ __forceinline__ XcdBarrier xcd_barrier_post(unsigned* bar, volatile LAS unsigned* st) {
    XcdBarrier b; b.bar = bar; b.x = xb_xcc_id(); b.st = st;
    if (threadIdx.x == 0) (void)xb_add(&bar[XB_XCNT(b.x)], 1u);
    return b;
}
__device__ __forceinline__ void xcd_barrier_complete(unsigned* bar, unsigned x, unsigned& nloc, unsigned& nx) {
    const unsigned G = gridDim.x * gridDim.y * gridDim.z;
    unsigned sum, cnt, mine, sp = 0u;
    for (;;) {
        sum = 0u; cnt = 0u; mine = 0u;
#pragma unroll
        for (unsigned j = 0; j < 16; ++j) { const unsigned c = xb_ld(&bar[XB_XCNT(j)]); sum += c; cnt += (c > 0u) ? 1u : 0u; mine = (j == x) ? c : mine; }
        if (sum == G) break;
        __builtin_amdgcn_s_sleep(1);
        if ((++sp & 255u) == 0u) { if (xb_ld(&bar[XB_TMO])) break; if (sp > XB_SPIN_CAP) { atomicAdd(&bar[XB_TMO], 1u); break; } }
    }
    nloc = mine > 0u ? mine : 1u; nx = cnt > 0u ? cnt : 1u;
}
__device__ __forceinline__ void xcd_barrier(const XcdBarrier& b) {
    asm volatile("s_waitcnt vmcnt(0)" ::: "memory");
    __syncthreads();
    if (threadIdx.x == 0) {
        unsigned* bar = b.bar;
        __builtin_amdgcn_s_waitcnt(0);
        unsigned nloc = b.st[0], nx = b.st[1];
        if (nloc == 0u) { xcd_barrier_complete(bar, b.x, nloc, nx); b.st[0] = nloc; b.st[1] = nx; }
        const unsigned old = xb_add(&bar[XB_XSUB(b.x)], 1u);
        const unsigned gen = old / nloc;
        if (old + 1u == (gen + 1u) * nloc) {
            __builtin_amdgcn_fence(__ATOMIC_RELEASE, "agent");
            asm volatile("s_waitcnt vmcnt(0)" ::: "memory");
            const unsigned og = xb_add(&bar[XB_TOP], 1u);
            const unsigned tg = og / nx;
            if (og + 1u == (tg + 1u) * nx) xb_add(&bar[XB_TOPGEN], 1u);
            else XB_SPIN(xb_ld(&bar[XB_TOPGEN]) == tg, bar);
            __builtin_amdgcn_fence(__ATOMIC_ACQUIRE, "agent");
            xb_add(&bar[XB_XGEN(b.x)], 1u);
            asm volatile("s_waitcnt vmcnt(0)" ::: "memory");
        } else {
            XB_SPIN(xb_ld(&bar[XB_XGEN(b.x)]) == gen, bar);
            __builtin_amdgcn_fence(__ATOMIC_ACQUIRE, "agent");
            asm volatile("s_waitcnt vmcnt(0)" ::: "memory");
        }
    }
    __syncthreads();
}
template <int CODE> __device__ __forceinline__ void coop_step(const Ctx& c, LAS unsigned char* lds, cg::grid_group& grid, XcdBarrier& xb, bool sync_after, bool first) {
    run_phase(c, CODE >> 5, CODE & 31, lds);
    if (sync_after) {
        if (first || ALLCG) {
            unsigned* bar = (unsigned*)(c.ws + OW_BAR);
            if (first && blockIdx.x == 0) for (int i = threadIdx.x; i < XCD_BAR_WORDS; i += 512) bar[i] = 0u;
            asm volatile("s_waitcnt vmcnt(0) lgkmcnt(0)" ::: "memory");
            grid.sync();
            if (threadIdx.x < 64) { __builtin_amdgcn_fence(__ATOMIC_ACQUIRE, "agent"); asm volatile("s_waitcnt vmcnt(0)" ::: "memory"); }
            __syncthreads();
            if (first) xb = xcd_barrier_post(bar, xb.st);
        } else xcd_barrier(xb);
    }
}
template <int... CODES> __global__ void __launch_bounds__(512, 2) k_coop(Ctx c) {
    extern __shared__ __attribute__((aligned(16))) unsigned char dynlds[];
    cg::grid_group grid = cg::this_grid();
    LAS unsigned char* lds = (LAS unsigned char*)dynlds;
    volatile LAS unsigned* st = (volatile LAS unsigned*)(lds + LDS_BYTES - 16);
    if (threadIdx.x < 4) st[threadIdx.x] = 0u;
    __syncthreads();
    XcdBarrier xb; xb.bar = nullptr; xb.x = 0; xb.st = st;
    int idx = 0; constexpr int N = sizeof...(CODES);
    ((coop_step<CODES>(c, lds, grid, xb, idx + 1 < N, idx == 0), ++idx), ...);
}
#define CODE(ph, l) ((ph) * 32 + (l))
typedef void (*CoopFn)(Ctx);
struct Step { int kind, op, l; };
static const Step g_prog[] = { {1, 0, 0} };
constexpr int NSTEP = sizeof(g_prog) / sizeof(g_prog[0]);

extern "C" void kernel_launch(void* const* d_in, const int* in_sizes, int n_in, void* d_out, int out_size, void* d_ws, size_t ws_size, hipStream_t stream) {
    if (n_in != 30 || out_size != T * D || ws_size < OW_END || ws_size < WS_END) { fprintf(stderr, "kernel_launch: bad args n_in %d out %d ws %zu\n", n_in, out_size, ws_size); return; }
    Ctx c; memset(&c, 0, sizeof(c));
    for (int i = 0; i < 30; ++i) c.in[i] = (const float*)d_in[i];
    c.out = (float*)d_out; c.ws = (unsigned char*)d_ws;
    static StageFn tab[OP_FINAL + 1], tabo[PH_N];
    static bool init = false;
    if (!init) { fill_tab(tab, MkSeq<OP_FINAL + 1>::type()); fill_tab_opt(tabo, MkSeq<PH_N>::type());
        for (int i = 0; i < PH_N; ++i) hipFuncSetAttribute((const void*)tabo[i], hipFuncAttributeMaxDynamicSharedMemorySize, LDS_BYTES);
        init = true; }
#if COOP
    static int coop_grid = 0;
    static CoopFn coop_fns[2] = { k_coop<CODE(PH_PREP_ALL, 0), CODE(PH_CONV_IN, 0), CODE(PH_CONV_MID, 0), CODE(PH_CONV_OUT, 0),
                                         CODE(PH_XA_Q, 0), CODE(PH_XA_KV, 0), CODE(PH_XA_S, 0), CODE(PH_XA_PV, 0), CODE(PH_XA_O, 0),
                                         CODE(PH_ROUTE, 0), CODE(PH_BUILD, 0), CODE(PH_MOE1, 0), CODE(PH_MOE2, 0), CODE(PH_COMBINE, 0),
                                         CODE(PH_GLA_DECAY, 0), CODE(PH_GLA_IN, 0), CODE(PH_GLA_ATT, 0), CODE(PH_GLA_SCAN, 0), CODE(PH_GLA_O, 0), CODE(PH_GLA_FIN, 0), CODE(PH_GLA_OUT, 0),
                                         CODE(PH_XA_Q, 1), CODE(PH_XA_KV, 1), CODE(PH_XA_S, 1), CODE(PH_XA_PV, 1), CODE(PH_XA_O, 1),
                                         CODE(PH_ROUTE, 1), CODE(PH_BUILD, 1), CODE(PH_MOE1, 1), CODE(PH_MOE2, 1), CODE(PH_COMBINE_FIN, 1)>, nullptr };
    if (!coop_grid) { int dev = 0, cus = 0, per_cu = 0; hipGetDevice(&dev); hipDeviceGetAttribute(&cus, hipDeviceAttributeMultiprocessorCount, dev);
        for (int k = 0; k < 1; ++k) hipFuncSetAttribute((const void*)coop_fns[k], hipFuncAttributeMaxDynamicSharedMemorySize, LDS_BYTES);
        hipOccupancyMaxActiveBlocksPerMultiprocessor(&per_cu, coop_fns[0], 512, LDS_BYTES);
        coop_grid = cus * (per_cu < 1 ? 1 : per_cu); if (coop_grid > 256) coop_grid = 256;
        fprintf(stderr, "kernel_launch: cus %d per_cu %d grid %d\n", cus, per_cu, coop_grid); }
    int ncoop = 0;
#endif
    for (int i = 0; i < NSTEP; ++i) {
        if (g_prog[i].kind == 0) { hipLaunchKernelGGL(tab[g_prog[i].op], dim3(1024), dim3(512), 0, stream, c, g_prog[i].l); continue; }
#if COOP
        while (i < NSTEP && g_prog[i].kind == 1) ++i;
        --i;
        void* args[] = {&c};
        hipError_t e = hipLaunchCooperativeKernel((void*)coop_fns[ncoop++], dim3(coop_grid), dim3(512), args, LDS_BYTES, stream);
        if (e != hipSuccess) fprintf(stderr, "cooperative launch failed: %s\n", hipGetErrorString(e));
#else
        hipLaunchKernelGGL(tabo[g_prog[i].op], dim3(256), dim3(512), LDS_BYTES, stream, c, g_prog[i].l);
#endif
    }
}
```

```cpp
#include <hip/hip_runtime.h>
#include <hip/hip_cooperative_groups.h>
#include <cstdio>
#include <cstring>
namespace cg = cooperative_groups;

#ifndef MEGA
#define MEGA 0
#endif

constexpr int D = 1024, NB = 4, S = 8192, T = NB * S, NMEM = 256, DEPTH = 2;
constexpr int CONVK = 31;
constexpr int GH = 4, GDK = 512, GDV = 1024, GDKH = 128, GDVH = 256, GRANK = 16, GLA_COLS = 3088;
constexpr int XH = 4, XHD = 256;
constexpr int NG = 4, EPG = 8, NE = 32, DE = 512;
constexpr int NA = T * 2;
constexpr int NSLOT = NA + NE * 128;
constexpr float EPS = 1e-6f;

constexpr size_t MiB = 1u << 20;
constexpr size_t WS_HN = 0;
constexpr size_t WS_BIG = 128 * MiB;
constexpr size_t WS_SMALL = 528 * MiB;
constexpr size_t WS_MEMN = WS_SMALL;
constexpr size_t WS_KV = WS_MEMN + 4 * MiB;
constexpr size_t WS_EID = WS_KV + 16 * MiB;
constexpr size_t WS_GATE = WS_EID + NA * 4;
constexpr size_t WS_POS = WS_GATE + NA * 4;
constexpr size_t WS_SLOTTOK = WS_POS + NA * 4;
constexpr size_t WS_SLOTA = WS_SLOTTOK + NSLOT * 4;
constexpr size_t WS_TILEE = WS_SLOTA + NSLOT * 4;
constexpr size_t WS_CNT = WS_TILEE + 4096;
constexpr size_t WS_END = WS_CNT + 4096;

struct Ctx {
    const float* in[30];
    float* out;
    unsigned char* ws;
};

__device__ __forceinline__ float wave_sum(float v) {
#pragma unroll
    for (int o = 1; o < 64; o <<= 1) v += __shfl_xor(v, o);
    return v;
}
__device__ __forceinline__ float wave_max(float v) {
#pragma unroll
    for (int o = 1; o < 64; o <<= 1) v = fmaxf(v, __shfl_xor(v, o));
    return v;
}
__device__ __forceinline__ float sigmoidf_(float x) { return 1.0f / (1.0f + expf(-x)); }
__device__ __forceinline__ float siluf_(float x) { return x / (1.0f + expf(-x)); }

__device__ void n_rms(const float* x, const float* g, float* out, int rows) {
    const int lane = threadIdx.x & 63;
    const int gw = (blockIdx.x * blockDim.x + threadIdx.x) >> 6, ngw = (gridDim.x * blockDim.x) >> 6;
    for (int r = gw; r < rows; r += ngw) {
        const float4* xr = (const float4*)(x + (size_t)r * D);
        float4 v[4]; float s = 0.f;
#pragma unroll
        for (int j = 0; j < 4; ++j) { v[j] = xr[lane + 64 * j]; s += v[j].x * v[j].x + v[j].y * v[j].y + v[j].z * v[j].z + v[j].w * v[j].w; }
        s = wave_sum(s);
        const float rs = rsqrtf(s * (1.0f / D) + EPS);
        float4* o = (float4*)(out + (size_t)r * D);
#pragma unroll
        for (int j = 0; j < 4; ++j) { const float4 gg = ((const float4*)g)[lane + 64 * j];
            o[lane + 64 * j] = make_float4(v[j].x * rs * gg.x, v[j].y * rs * gg.y, v[j].z * rs * gg.z, v[j].w * rs * gg.w); }
    }
}
__device__ void n_copy4(const float* src, float* dst, size_t n4) {
    const size_t g = (size_t)blockIdx.x * blockDim.x + threadIdx.x, gs = (size_t)gridDim.x * blockDim.x;
    for (size_t i = g; i < n4; i += gs) ((float4*)dst)[i] = ((const float4*)src)[i];
}

struct EpiStore { float* C; int ldc; const float* bias;
    __device__ __forceinline__ void operator()(int m, int n, float acc) const { C[(size_t)m * ldc + n] = acc + (bias ? bias[n] : 0.f); } };
struct EpiResid { float* X; int ldc; const float* bias;
    __device__ __forceinline__ void operator()(int m, int n, float acc) const { X[(size_t)m * ldc + n] += acc + (bias ? bias[n] : 0.f); } };
struct EpiMoeDown { float* Y; const int* slot_a; const float* gate;
    __device__ __forceinline__ void operator()(int m, int n, float acc) const { const int a = slot_a[m]; if (a >= 0) Y[(size_t)a * D + n] = acc * gate[a]; } };

template <class Epi>
__device__ void n_gemm(float* sm, const float* A, int lda, const int* arow, const float* W, int ldw, size_t wstride, const int* tile_e,
                       int M, int N, int K, Epi epi) {
    float* As = sm;
    float* Bs = sm + 16 * 132;
    const int tid = threadIdx.x, ty = tid >> 5, tx = tid & 31;
    const int ntm = M / 128, ntn = (N + 255) / 256;
    for (int tile = blockIdx.x; tile < ntm * ntn; tile += gridDim.x) {
        const int mt = tile / ntn, nt = tile % ntn;
        const float* Wb = W;
        if (tile_e) { const int e = tile_e[mt]; if (e < 0) continue; Wb = W + (size_t)e * wstride; }
        const int m0 = mt * 128, n0 = nt * 256;
        float acc[8][8];
#pragma unroll
        for (int i = 0; i < 8; ++i)
#pragma unroll
            for (int j = 0; j < 8; ++j) acc[i][j] = 0.f;
        const int ar = tid >> 2, akq = (tid & 3) * 4;
        const int srow = arow ? arow[m0 + ar] : (m0 + ar);
        const float* ap = srow >= 0 ? A + (size_t)srow * lda : nullptr;
        const int bk = tid >> 6, bn = (tid & 63) * 4;
        for (int k0 = 0; k0 < K; k0 += 16) {
            float4 av = ap ? *(const float4*)(ap + k0 + akq) : make_float4(0.f, 0.f, 0.f, 0.f);
            As[(akq + 0) * 132 + ar] = av.x; As[(akq + 1) * 132 + ar] = av.y; As[(akq + 2) * 132 + ar] = av.z; As[(akq + 3) * 132 + ar] = av.w;
#pragma unroll
            for (int i = 0; i < 2; ++i) {
                const int kk = bk + 8 * i; const int n = n0 + bn;
                float4 bv = (n < N) ? *(const float4*)(Wb + (size_t)(k0 + kk) * ldw + n) : make_float4(0.f, 0.f, 0.f, 0.f);
                *(float4*)(Bs + kk * 260 + bn) = bv;
            }
            __syncthreads();
#pragma unroll
            for (int kk = 0; kk < 16; ++kk) {
                float a[8], b[8];
                *(float4*)(a) = *(const float4*)(As + kk * 132 + ty * 8); *(float4*)(a + 4) = *(const float4*)(As + kk * 132 + ty * 8 + 4);
                *(float4*)(b) = *(const float4*)(Bs + kk * 260 + tx * 8); *(float4*)(b + 4) = *(const float4*)(Bs + kk * 260 + tx * 8 + 4);
#pragma unroll
                for (int i = 0; i < 8; ++i)
#pragma unroll
                    for (int j = 0; j < 8; ++j) acc[i][j] = fmaf(a[i], b[j], acc[i][j]);
            }
            __syncthreads();
        }
#pragma unroll
        for (int i = 0; i < 8; ++i)
#pragma unroll
            for (int j = 0; j < 8; ++j) { const int m = m0 + ty * 8 + i, n = n0 + tx * 8 + j; if (n < N) epi(m, n, acc[i][j]); }
    }
}

__device__ void n_glu(const float* u, float* g) {
    const size_t gi = (size_t)blockIdx.x * blockDim.x + threadIdx.x, gs = (size_t)gridDim.x * blockDim.x;
    for (size_t i = gi; i < (size_t)T * D; i += gs) { const size_t t = i >> 10, c = i & 1023; g[i] = u[t * 2048 + c] * sigmoidf_(u[t * 2048 + 1024 + c]); }
}
__device__ void n_dwconv(const float* g, const float* wdw, const float* bdw, const float* lng, const float* lnb, float* out) {
    const int lane = threadIdx.x & 63;
    const int gw = (blockIdx.x * blockDim.x + threadIdx.x) >> 6, ngw = (gridDim.x * blockDim.x) >> 6;
    for (int t = gw; t < T; t += ngw) {
        const int s = t % S;
        float4 acc[4];
#pragma unroll
        for (int j = 0; j < 4; ++j) acc[j] = ((const float4*)bdw)[lane + 64 * j];
        for (int tap = 0; tap < CONVK; ++tap) {
            const int ss = s - (CONVK - 1) + tap; if (ss < 0) continue;
            const float4* gr = (const float4*)(g + (size_t)(t - (CONVK - 1) + tap) * D);
            const float4* wr = (const float4*)(wdw + (size_t)tap * D);
#pragma unroll
            for (int j = 0; j < 4; ++j) { const float4 a = gr[lane + 64 * j], w = wr[lane + 64 * j];
                acc[j].x = fmaf(a.x, w.x, acc[j].x); acc[j].y = fmaf(a.y, w.y, acc[j].y); acc[j].z = fmaf(a.z, w.z, acc[j].z); acc[j].w = fmaf(a.w, w.w, acc[j].w); }
        }
        float sm_ = 0.f;
#pragma unroll
        for (int j = 0; j < 4; ++j) sm_ += acc[j].x + acc[j].y + acc[j].z + acc[j].w;
        const float mu = wave_sum(sm_) * (1.0f / D);
        float q = 0.f;
#pragma unroll
        for (int j = 0; j < 4; ++j) { acc[j].x -= mu; acc[j].y -= mu; acc[j].z -= mu; acc[j].w -= mu; q += acc[j].x * acc[j].x + acc[j].y * acc[j].y + acc[j].z * acc[j].z + acc[j].w * acc[j].w; }
        const float rstd = rsqrtf(wave_sum(q) * (1.0f / D) + EPS);
        float4* o = (float4*)(out + (size_t)t * D);
#pragma unroll
        for (int j = 0; j < 4; ++j) { const float4 gg = ((const float4*)lng)[lane + 64 * j], bb = ((const float4*)lnb)[lane + 64 * j];
            o[lane + 64 * j] = make_float4(siluf_(acc[j].x * rstd * gg.x + bb.x), siluf_(acc[j].y * rstd * gg.y + bb.y), siluf_(acc[j].z * rstd * gg.z + bb.z), siluf_(acc[j].w * rstd * gg.w + bb.w)); }
    }
}
__device__ void n_attn(const float* q, const float* kv, float* o) {
    const int lane = threadIdx.x & 63;
    const int gw = (blockIdx.x * blockDim.x + threadIdx.x) >> 6, ngw = (gridDim.x * blockDim.x) >> 6;
    for (int it = gw; it < T * XH; it += ngw) {
        const int t = it >> 2, h = it & 3, b = t / S;
        const float4 qv = ((const float4*)(q + (size_t)t * D + h * XHD))[lane];
        const float* kb = kv + (size_t)b * NMEM * 2048 + h * XHD;
        float sc[4];
#pragma unroll
        for (int m4 = 0; m4 < 4; ++m4) {
            float mine = 0.f;
            for (int ml = 0; ml < 64; ++ml) {
                const float4 kk = ((const float4*)(kb + (size_t)(m4 * 64 + ml) * 2048))[lane];
                float p = qv.x * kk.x + qv.y * kk.y + qv.z * kk.z + qv.w * kk.w;
                p = wave_sum(p);
                if (ml == lane) mine = p;
            }
            sc[m4] = mine * 0.0625f;
        }
        float mx = fmaxf(fmaxf(sc[0], sc[1]), fmaxf(sc[2], sc[3])); mx = wave_max(mx);
        float se = 0.f;
#pragma unroll
        for (int m4 = 0; m4 < 4; ++m4) { sc[m4] = expf(sc[m4] - mx); se += sc[m4]; }
        se = wave_sum(se); const float inv = 1.0f / se;
        float4 acc = make_float4(0.f, 0.f, 0.f, 0.f);
        const float* vb = kb + 1024;
#pragma unroll
        for (int m4 = 0; m4 < 4; ++m4)
            for (int ml = 0; ml < 64; ++ml) {
                const float p = __shfl(sc[m4], ml) * inv;
                const float4 vv = ((const float4*)(vb + (size_t)(m4 * 64 + ml) * 2048))[lane];
                acc.x = fmaf(p, vv.x, acc.x); acc.y = fmaf(p, vv.y, acc.y); acc.z = fmaf(p, vv.z, acc.z); acc.w = fmaf(p, vv.w, acc.w);
            }
        ((float4*)(o + (size_t)t * D + h * XHD))[lane] = acc;
    }
}
__device__ void n_moe_init(int* cnt, int* slot_tok, int* slot_a, int* tile_e) {
    const int gi = blockIdx.x * blockDim.x + threadIdx.x, gs = gridDim.x * blockDim.x;
    for (int i = gi; i < NSLOT; i += gs) { slot_tok[i] = -1; slot_a[i] = -1; }
    for (int i = gi; i < NSLOT / 128; i += gs) tile_e[i] = -1;
    if (gi < 32) cnt[gi] = 0;
}
__device__ void n_route(const float* h, const float* wg, const float* bg, const float* we, const float* be, int* eid, float* gate, int* pos, int* cnt) {
    const int lane = threadIdx.x & 63;
    const int gw = (blockIdx.x * blockDim.x + threadIdx.x) >> 6, ngw = (gridDim.x * blockDim.x) >> 6;
    for (int t = gw; t < T; t += ngw) {
        float hv[16];
#pragma unroll
        for (int j = 0; j < 16; ++j) hv[j] = h[(size_t)t * D + j * 64 + lane];
        float gl[4];
#pragma unroll
        for (int o = 0; o < 4; ++o) { float p = 0.f;
#pragma unroll
            for (int j = 0; j < 16; ++j) p = fmaf(hv[j], wg[(size_t)(j * 64 + lane) * NG + o], p);
            gl[o] = wave_sum(p) + bg[o]; }
        int gs = 0; float gm = gl[0];
#pragma unroll
        for (int o = 1; o < 4; ++o) if (gl[o] > gm) { gm = gl[o]; gs = o; }
        float se = 0.f;
#pragma unroll
        for (int o = 0; o < 4; ++o) se += expf(gl[o] - gm);
        const float pg = 1.0f / se;
        float el[8];
#pragma unroll
        for (int o = 0; o < 8; ++o) { float p = 0.f;
#pragma unroll
            for (int j = 0; j < 16; ++j) p = fmaf(hv[j], we[(size_t)(j * 64 + lane) * NE + gs * 8 + o], p);
            el[o] = wave_sum(p) + be[gs * 8 + o]; }
        float em = el[0];
#pragma unroll
        for (int o = 1; o < 8; ++o) em = fmaxf(em, el[o]);
        float pe[8], ps = 0.f;
#pragma unroll
        for (int o = 0; o < 8; ++o) { pe[o] = expf(el[o] - em); ps += pe[o]; }
#pragma unroll
        for (int o = 0; o < 8; ++o) pe[o] = pe[o] / ps;
        int i1 = 0; float p1 = pe[0];
#pragma unroll
        for (int o = 1; o < 8; ++o) if (pe[o] > p1) { p1 = pe[o]; i1 = o; }
        int i2 = -1; float p2 = -1.f;
#pragma unroll
        for (int o = 0; o < 8; ++o) if (o != i1 && pe[o] > p2) { p2 = pe[o]; i2 = o; }
        if (lane == 0) {
            const float den = p1 + p2;
            const int e1 = gs * 8 + i1, e2 = gs * 8 + i2;
            eid[2 * t] = e1; eid[2 * t + 1] = e2;
            gate[2 * t] = pg * p1 / den; gate[2 * t + 1] = pg * p2 / den;
            pos[2 * t] = atomicAdd(&cnt[e1], 1); pos[2 * t + 1] = atomicAdd(&cnt[e2], 1);
        }
    }
}
__device__ void n_moe_build(const int* eid, const int* pos, const int* cnt, int* slot_tok, int* slot_a, int* tile_e) {
    __shared__ int poff[33];
    if (threadIdx.x == 0) { int o = 0; for (int e = 0; e < 32; ++e) { poff[e] = o; o += (cnt[e] + 127) / 128 * 128; } poff[32] = o; }
    __syncthreads();
    const int gi = blockIdx.x * blockDim.x + threadIdx.x, gs = gridDim.x * blockDim.x;
    for (int a = gi; a < NA; a += gs) { const int e = eid[a]; const int sl = poff[e] + pos[a]; slot_tok[sl] = a >> 1; slot_a[sl] = a; }
    for (int mt = gi; mt < NSLOT / 128; mt += gs) { const int r = mt * 128; int e = -1; for (int k = 0; k < 32; ++k) if (r >= poff[k] && r < poff[k + 1]) e = k; tile_e[mt] = e; }
    __syncthreads();
}
__device__ void n_moe_act(float* g, const float* u) {
    const size_t gi = (size_t)blockIdx.x * blockDim.x + threadIdx.x, gs = (size_t)gridDim.x * blockDim.x;
    for (size_t i = gi; i < (size_t)NSLOT * DE / 4; i += gs) { float4 a = ((float4*)g)[i]; const float4 b = ((const float4*)u)[i];
        a.x = siluf_(a.x) * b.x; a.y = siluf_(a.y) * b.y; a.z = siluf_(a.z) * b.z; a.w = siluf_(a.w) * b.w; ((float4*)g)[i] = a; }
}
__device__ void n_moe_combine(float* x, const float* y) {
    const size_t gi = (size_t)blockIdx.x * blockDim.x + threadIdx.x, gs = (size_t)gridDim.x * blockDim.x;
    for (size_t i = gi; i < (size_t)T * D / 4; i += gs) { const size_t t = i >> 8, c = i & 255; float4 a = ((float4*)x)[i];
        const float4 y0 = ((const float4*)y)[(2 * t) * 256 + c], y1 = ((const float4*)y)[(2 * t + 1) * 256 + c];
        a.x += y0.x + y1.x; a.y += y0.y + y1.y; a.z += y0.z + y1.z; a.w += y0.w + y1.w; ((float4*)x)[i] = a; }
}
__device__ void n_gla_decay(const float* proj, const float* wa2, const float* ba, float* dec) {
    const size_t gi = (size_t)blockIdx.x * blockDim.x + threadIdx.x, gs = (size_t)gridDim.x * blockDim.x;
    for (size_t i = gi; i < (size_t)T * GDK; i += gs) { const size_t t = i >> 9; const int j = (int)(i & 511);
        float a = ba[j];
#pragma unroll
        for (int r = 0; r < GRANK; ++r) a = fmaf(proj[t * GLA_COLS + 2048 + r], wa2[r * GDK + j], a);
        const float ls = fminf(a, 0.f) - log1pf(expf(-fabsf(a)));
        dec[i] = expf(ls * (1.0f / 16.0f)); }
}
__device__ void n_gla_rec(float* proj, const float* dec) {
    const int gi = blockIdx.x * blockDim.x + threadIdx.x, gs = gridDim.x * blockDim.x;
    for (int it = gi; it < NB * GH * GDVH; it += gs) {
        const int col = it & 255, h = (it >> 8) & 3, b = it >> 10;
        float st[GDKH];
#pragma unroll
        for (int k = 0; k < GDKH; ++k) st[k] = 0.f;
        const float qs = 0.08838834764831845f;
        for (int s = 0; s < S; ++s) {
            const size_t t = (size_t)b * S + s;
            float* pr = proj + t * GLA_COLS;
            const float v = pr[1024 + h * GDVH + col];
            const float* qq = pr + h * GDKH; const float* kk = pr + 512 + h * GDKH; const float* dd = dec + t * GDK + h * GDKH;
            float o = 0.f;
#pragma unroll
            for (int k = 0; k < GDKH; ++k) { st[k] = fmaf(st[k], dd[k], kk[k] * v); o = fmaf(qq[k], st[k], o); }
            pr[1024 + h * GDVH + col] = o * qs;
        }
    }
}
__device__ void n_gla_norm(const float* proj, const float* ng, float* go) {
    const int lane = threadIdx.x & 63;
    const int gw = (blockIdx.x * blockDim.x + threadIdx.x) >> 6, ngw = (gridDim.x * blockDim.x) >> 6;
    for (int it = gw; it < T * GH; it += ngw) {
        const int t = it >> 2, h = it & 3;
        const float4 ov = ((const float4*)(proj + (size_t)t * GLA_COLS + 1024 + h * GDVH))[lane];
        const float4 rv = ((const float4*)(proj + (size_t)t * GLA_COLS + 2064 + h * GDVH))[lane];
        const float4 gg = ((const float4*)ng)[lane];
        float s = ov.x * ov.x + ov.y * ov.y + ov.z * ov.z + ov.w * ov.w; s = wave_sum(s);
        const float rs = rsqrtf(s * (1.0f / GDVH) + EPS);
        ((float4*)(go + (size_t)t * D + h * GDVH))[lane] = make_float4(ov.x * rs * gg.x * siluf_(rv.x), ov.y * rs * gg.y * siluf_(rv.y), ov.z * rs * gg.z * siluf_(rv.z), ov.w * rs * gg.w * siluf_(rv.w));
    }
}

#define LAS __attribute__((address_space(3)))
typedef unsigned short bf16_t;
typedef short bf16x8 __attribute__((ext_vector_type(8)));
typedef float f32x4 __attribute__((ext_vector_type(4)));
typedef float f32x2 __attribute__((ext_vector_type(2)));
typedef unsigned u32x4 __attribute__((ext_vector_type(4)));
typedef unsigned u32x2 __attribute__((ext_vector_type(2)));

constexpr int LDS_BYTES = 160 * 1024;
constexpr int NSLOT2 = NA + NE * 256;
constexpr int MAXRT = NSLOT2 / 256;
constexpr size_t OW_XB = 0;
constexpr size_t OW_SSP = 64 * MiB;
constexpr size_t OW_RS = 66 * MiB;
constexpr size_t OW_PSUM = 67 * MiB;
constexpr size_t OW_MOE = 69 * MiB;
constexpr size_t OW_ACTA = 72 * MiB, OW_ACTB = 136 * MiB, OW_ACTC = 200 * MiB;
constexpr size_t OW_H = 72 * MiB, OW_Y = 144 * MiB, OW_WMOE = 272 * MiB;
constexpr size_t OW_KVB = 368 * MiB;
constexpr size_t OW_MEMNB = 502 * MiB;
constexpr size_t OW_WCIN = 550 * MiB, OW_WCOUT = 554 * MiB, OW_WXQ = 556 * MiB, OW_WXKV = 560 * MiB, OW_WXO = 568 * MiB, OW_WR = 572 * MiB, OW_BAR = 573 * MiB, OW_DBG = 574 * MiB, OW_END = 575 * MiB;
constexpr size_t OW_ATT = 360 * MiB, OW_QKR = 72 * MiB, OW_KVT = 200 * MiB, OW_BTM = 296 * MiB, OW_O = 296 * MiB, OW_BFM = 360 * MiB, OW_UT = 424 * MiB, OW_SP = 456 * MiB,
                 OW_ALR = 488 * MiB, OW_DL = 490 * MiB, OW_GO = 200 * MiB, OW_WGTM = 492 * MiB, OW_WGFM = 496 * MiB, OW_WGO = 499 * MiB, OW_WA = 501 * MiB;
constexpr size_t OM_GCNT = OW_MOE, OM_NT = OW_MOE + 256, OM_TILEE = OW_MOE + 512, OM_AE = OW_MOE + 4096, OM_APOS = OM_AE + NA * 4, OM_GATE = OM_APOS + NA * 4,
                 OM_STOK = OM_GATE + NA * 4, OM_SA = OM_STOK + NSLOT2 * 4, OM_SRS = OM_SA + NSLOT2 * 4, OM_SGATE = OM_SRS + NSLOT2 * 4, OM_END = OM_SGATE + NSLOT2 * 4;
static_assert(OM_END <= OW_ACTA, "MoE small arrays");

typedef __bf16 bf16x2_t __attribute__((ext_vector_type(2)));
__device__ __forceinline__ unsigned cvt_pk_bf16(float lo, float hi) { const f32x2 v = {lo, hi}; return __builtin_bit_cast(unsigned, __builtin_convertvector(v, bf16x2_t)); }
__device__ __forceinline__ int otid() { int t = threadIdx.x; asm volatile("" : "+v"(t)); return t; }
__device__ __forceinline__ u32x4 pack8(const f32x4& a, const f32x4& b) { u32x4 w; w.x = cvt_pk_bf16(a[0], a[1]); w.y = cvt_pk_bf16(a[2], a[3]); w.z = cvt_pk_bf16(b[0], b[1]); w.w = cvt_pk_bf16(b[2], b[3]); return w; }
__device__ __forceinline__ float bf_lo(unsigned w) { return __uint_as_float(w << 16); }
__device__ __forceinline__ float bf_hi(unsigned w) { return __uint_as_float(w & 0xffff0000u); }
__device__ __forceinline__ float fast_sigmoid(float x) { return __builtin_amdgcn_rcpf(1.0f + __builtin_amdgcn_exp2f(-1.4426950408889634f * x)); }

#ifndef LDS_POISON
#define LDS_POISON 0
#endif
namespace g8 {
constexpr int BM = 256, BK = 64, HALF = 128, HTB = HALF * BK * 2, STAGE_BYTES = 8 * HTB;
__device__ __forceinline__ int lds_byte(int r, int c) { const int st = (r >> 4) * 2 + (c >> 5), rr = r & 15, cc = c & 31, ob = rr * 64 + cc * 2; return st * 1024 + (ob ^ (((ob >> 9) & 1) << 5)); }
__device__ __forceinline__ void stage_rc(int b, int& R, int& C) { const int st = b / 1024, sb = b % 1024, swz = sb ^ (((sb >> 9) & 1) << 5); R = (st >> 1) * 16 + swz / 64; C = (st & 1) * 32 + (swz % 64) / 2; }
__device__ __forceinline__ int perm32(int rho) { const int n = rho >> 4, i = rho & 15; return 8 * (i >> 2) + 4 * n + (i & 3); }
struct Unit { int pm, pn, e; };

template <class Epi, class Sched>
__device__ __forceinline__ void gemm_phase(LAS unsigned char* lds, const Sched& S, const Epi& E) {
    int tid_ = threadIdx.x; asm volatile("" : "+v"(tid_));
    const int tid = tid_, wid = __builtin_amdgcn_readfirstlane(tid >> 6), lane = tid & 63, wr = wid >> 2, wc = wid & 3, fr = lane & 15, fq = lane >> 4;
    const size_t kstep = (size_t)(BK * 2);
    const unsigned ldsw = (unsigned)wid * 1024u;
    const int aoff = lds_byte(wr * 64 + fr, fq * 8), boff = lds_byte(wc * 32 + fr, fq * 8);
#define G8_SA(b, h) (((b) * 2 + (h)) * HTB)
#define G8_SB(b, h) ((4 + (b) * 2 + (h)) * HTB)
#define G8_STAGE(bufoff, gbase, vv) do { _Pragma("unroll") for (int _i = 0; _i < 2; ++_i) \
        __builtin_amdgcn_global_load_lds((const unsigned*)((const char*)(gbase) + (vv)[_i]), (LAS unsigned*)(lds + (bufoff) + ldsw + _i * 8192), 16, 0, 0); } while (0)
#define G8_LDA(dst, b, h) do { _Pragma("unroll") for (int m = 0; m < 4; ++m) _Pragma("unroll") for (int k = 0; k < 2; ++k) dst[m][k] = *(const LAS bf16x8*)(lds + G8_SA(b, h) + aoff + m * 2048 + k * 1024); } while (0)
#define G8_LDB(dst, b, h) do { _Pragma("unroll") for (int n = 0; n < 2; ++n) _Pragma("unroll") for (int k = 0; k < 2; ++k) dst[n][k] = *(const LAS bf16x8*)(lds + G8_SB(b, h) + boff + n * 2048 + k * 1024); } while (0)
#define G8_MMA(ai, bj, At, Bt) do { __builtin_amdgcn_s_setprio(1); _Pragma("unroll") for (int m = 0; m < 4; ++m) _Pragma("unroll") for (int n = 0; n < 2; ++n) _Pragma("unroll") for (int k = 0; k < 2; ++k) \
        acc[ai][bj][m][n] = __builtin_amdgcn_mfma_f32_16x16x32_bf16(Bt[n][k], At[m][k], acc[ai][bj][m][n], 0, 0, 0); __builtin_amdgcn_s_setprio(0); } while (0)
#define G8_WAIT_V(n) asm volatile("s_waitcnt vmcnt(" #n ")" ::: "memory")
#define G8_WAIT_L(n) asm volatile("s_waitcnt lgkmcnt(" #n ")" ::: "memory")
#define G8_BAR __builtin_amdgcn_s_barrier()
#define G8_SCHED __builtin_amdgcn_sched_barrier(0)
#define G8_VA(dst, u) do { const int _ac = S.a_col(u), _lda = S.lda(u); _Pragma("unroll") for (int _i = 0; _i < 2; ++_i) { int _R, _C; stage_rc(tid * 16 + _i * 8192, _R, _C); \
        _Pragma("unroll") for (int _h = 0; _h < 2; ++_h) dst[_h][_i] = (unsigned)(((size_t)S.a_row(u, _h * HALF + _R) * _lda + _ac + _C) * 2); } } while (0)
#define G8_VB(dst, hs, u) do { const int _ldb = S.ldb(u); hs = (size_t)HALF * _ldb * 2; _Pragma("unroll") for (int _i = 0; _i < 2; ++_i) { int _R, _C; stage_rc(tid * 16 + _i * 8192, _R, _C); \
        dst[_i] = (unsigned)(((_R & ~31) + perm32(_R & 31)) * _ldb + _C) * 2u; } } while (0)
    Unit cur, nxt; int ui = 0; bool aligned_end = false;
    if (!S.next(0, cur)) return;
#if LDS_POISON
    for (int i = tid; i < STAGE_BYTES / 16; i += 512) ((LAS u32x4*)lds)[i] = (u32x4){0x7fc07fc0u, 0x7fc07fc0u, 0x7fc07fc0u, 0x7fc07fc0u};
    __syncthreads();
#endif
    f32x4 acc[2][2][4][2];
#pragma unroll
    for (int a = 0; a < 2; ++a)
#pragma unroll
        for (int b = 0; b < 2; ++b)
#pragma unroll
            for (int m = 0; m < 4; ++m)
#pragma unroll
                for (int n = 0; n < 2; ++n) acc[a][b][m][n] = (f32x4){0.f, 0.f, 0.f, 0.f};
    bf16x8 At[4][2], B0[2][2], B1[2][2];
    unsigned va[2][2], nva[2][2], vb[2], nvb[2]; size_t hsB, nhsB;
    G8_VA(va, cur); G8_VB(vb, hsB, cur);
    const char* Ab = S.a_base(cur);
    const char* cB = S.b_base(cur);
    G8_STAGE(G8_SB(0, 0), cB, vb); G8_STAGE(G8_SA(0, 0), Ab, va[0]); G8_STAGE(G8_SB(0, 1), cB + hsB, vb); G8_STAGE(G8_SA(0, 1), Ab, va[1]);
    if (wr == 1) G8_BAR;
    G8_WAIT_V(4); G8_BAR;
    G8_STAGE(G8_SB(1, 0), cB + kstep, vb); G8_STAGE(G8_SA(1, 0), Ab + kstep, va[0]); G8_STAGE(G8_SB(1, 1), cB + hsB + kstep, vb);
    G8_WAIT_V(6); G8_BAR;
    for (;;) {
        const bool has_next = S.next(ui + 1, nxt);
        const char* nB = cB; const char* nAb = Ab;
        if (has_next) { nB = S.b_base(nxt); nAb = S.a_base(nxt); G8_VA(nva, nxt); G8_VB(nvb, nhsB, nxt); }
        else {
            nhsB = hsB;
#pragma unroll
            for (int i = 0; i < 2; ++i) { nvb[i] = vb[i];
#pragma unroll
                for (int h = 0; h < 2; ++h) nva[h][i] = va[h][i]; }
        }
        const int nt = S.nt(cur);
        for (int t = 0; t < nt; t += 2) {
            const bool last = (t == nt - 2);
            const char* a1 = Ab + (size_t)(t + 1) * kstep;
            const char* a2 = last ? nAb : Ab + (size_t)(t + 2) * kstep;
            const char* b2 = last ? nB : cB + (size_t)(t + 2) * kstep;
            const char* a3 = a2 + kstep; const char* b3 = b2 + kstep;
            const size_t hs2 = last ? nhsB : hsB;
            unsigned v2[2][2], vb2[2];
#pragma unroll
            for (int i = 0; i < 2; ++i) { vb2[i] = last ? nvb[i] : vb[i];
#pragma unroll
                for (int h = 0; h < 2; ++h) v2[h][i] = last ? nva[h][i] : va[h][i]; }
            G8_LDB(B0, 0, 0); G8_SCHED; G8_LDA(At, 0, 0); G8_STAGE(G8_SA(1, 1), a1, va[1]);
            G8_WAIT_L(8); G8_BAR; G8_WAIT_L(0); G8_MMA(0, 0, At, B0); G8_BAR; G8_SCHED;
            G8_LDB(B1, 0, 1); G8_STAGE(G8_SB(0, 0), b2, vb2);
            G8_BAR; G8_WAIT_L(0); G8_MMA(0, 1, At, B1); G8_BAR;
            G8_LDA(At, 0, 1); G8_STAGE(G8_SA(0, 0), a2, v2[0]);
            G8_BAR; G8_WAIT_L(0); G8_MMA(1, 0, At, B0); G8_BAR; G8_SCHED;
            G8_STAGE(G8_SB(0, 1), b2 + hs2, vb2);
            G8_WAIT_V(6); G8_BAR; G8_MMA(1, 1, At, B1); G8_BAR;
            G8_LDB(B0, 1, 0); G8_SCHED; G8_LDA(At, 1, 0); G8_STAGE(G8_SA(0, 1), a2, v2[1]);
            G8_WAIT_L(8); G8_BAR; G8_WAIT_L(0); G8_MMA(0, 0, At, B0); G8_BAR; G8_SCHED;
            G8_LDB(B1, 1, 1); G8_STAGE(G8_SB(1, 0), b3, vb2);
            G8_BAR; G8_WAIT_L(0); G8_MMA(0, 1, At, B1); G8_BAR;
            G8_LDA(At, 1, 1); G8_STAGE(G8_SA(1, 0), a3, v2[0]);
            G8_BAR; G8_WAIT_L(0); G8_MMA(1, 0, At, B0); G8_BAR; G8_SCHED;
            G8_STAGE(G8_SB(1, 1), b3 + hs2, vb2);
            G8_WAIT_V(6); G8_BAR; G8_MMA(1, 1, At, B1); G8_BAR;
        }
        const bool keep = S.cont(cur);
        if (!keep) {
            if (wr == 0) G8_BAR;
            E(acc, cur, wr, wc, fr, fq);
            if (has_next && wr == 1) G8_BAR;
        }
        if (!has_next) { aligned_end = !keep; break; }
        if (!keep) {
#pragma unroll
            for (int a = 0; a < 2; ++a)
#pragma unroll
                for (int b = 0; b < 2; ++b)
#pragma unroll
                    for (int m = 0; m < 4; ++m)
#pragma unroll
                        for (int n = 0; n < 2; ++n) acc[a][b][m][n] = (f32x4){0.f, 0.f, 0.f, 0.f};
        }
        cur = nxt; cB = nB; Ab = nAb; hsB = nhsB; ++ui;
#pragma unroll
        for (int i = 0; i < 2; ++i) { vb[i] = nvb[i];
#pragma unroll
            for (int h = 0; h < 2; ++h) va[h][i] = nva[h][i]; }
    }
    G8_WAIT_V(0);
    if (!aligned_end && wr == 0) G8_BAR;
    G8_BAR;
#undef G8_SA
#undef G8_SB
#undef G8_STAGE
#undef G8_LDA
#undef G8_LDB
#undef G8_MMA
#undef G8_WAIT_V
#undef G8_WAIT_L
#undef G8_BAR
#undef G8_SCHED
#undef G8_VA
#undef G8_VB
}

struct DenseSched {
    __device__ __forceinline__ int lda(const Unit&) const { return lda_; }
    __device__ __forceinline__ int ldb(const Unit&) const { return ldb_; }
    __device__ __forceinline__ int nt(const Unit&) const { return K / BK; }
    __device__ __forceinline__ bool cont(const Unit&) const { return false; }
    int nN, nU, K, lda_, ldb_; const bf16_t* A; const bf16_t* Bt;
    __device__ __forceinline__ const char* a_base(const Unit&) const { return (const char*)A; }
    __device__ __forceinline__ bool next(int i, Unit& u) const {
        const int c = blockIdx.x, per = gridDim.x >> 3, x = c & 7, j = c >> 3;
        const int chunk = (nU + 7) >> 3, lu = i * per + j;
        if (lu >= chunk) return false;
        const int un = x * chunk + lu; if (un >= nU) return false;
        u.pm = un / nN; u.pn = un - u.pm * nN; u.e = 0; return true; }
    __device__ __forceinline__ int a_row(const Unit& u, int r) const { return u.pm * BM + r; }
    __device__ __forceinline__ int a_col(const Unit&) const { return 0; }
    __device__ __forceinline__ const char* b_base(const Unit& u) const { return (const char*)(Bt + (size_t)u.pn * BM * ldb_); }
};

struct EpiGlu {
    bf16_t* U; const float* rs; const float* bias;
    __device__ __forceinline__ void operator()(const f32x4 (&acc)[2][2][4][2], const Unit& u, int wr, int wc, int fr, int fq) const {
        const int c0 = u.pn * 128 + wc * 32 + 8 * fq;
        const f32x4 ba0 = *(const f32x4*)(bias + c0), ba1 = *(const f32x4*)(bias + c0 + 4), bg0 = *(const f32x4*)(bias + 1024 + c0), bg1 = *(const f32x4*)(bias + 1024 + c0 + 4);
        float rv[2][4];
#pragma unroll
        for (int ai = 0; ai < 2; ++ai)
#pragma unroll
            for (int m = 0; m < 4; ++m) rv[ai][m] = rs[u.pm * BM + ai * HALF + wr * 64 + m * 16 + fr];
        __builtin_amdgcn_sched_barrier(0);
#pragma unroll
        for (int ai = 0; ai < 2; ++ai)
#pragma unroll
            for (int m = 0; m < 4; ++m) {
                const int row = u.pm * BM + ai * HALF + wr * 64 + m * 16 + fr; const float r = rv[ai][m];
                f32x4 o0, o1;
#pragma unroll
                for (int j = 0; j < 4; ++j) {
                    o0[j] = (acc[ai][0][m][0][j] * r + ba0[j]) * fast_sigmoid(acc[ai][1][m][0][j] * r + bg0[j]);
                    o1[j] = (acc[ai][0][m][1][j] * r + ba1[j]) * fast_sigmoid(acc[ai][1][m][1][j] * r + bg1[j]); }
                *(u32x4*)(U + (size_t)row * D + c0) = pack8(o0, o1);
            }
    }
};
struct EpiXres {
    bf16_t* XB; const float* bias; float* ssp;
    __device__ __forceinline__ void operator()(const f32x4 (&acc)[2][2][4][2], const Unit& u, int wr, int wc, int fr, int fq) const {
        f32x4 bv[2][2];
#pragma unroll
        for (int bj = 0; bj < 2; ++bj) { const int c0 = u.pn * BM + bj * HALF + wc * 32 + 8 * fq;
            bv[bj][0] = bias ? *(const f32x4*)(bias + c0) : (f32x4){0.f, 0.f, 0.f, 0.f}; bv[bj][1] = bias ? *(const f32x4*)(bias + c0 + 4) : (f32x4){0.f, 0.f, 0.f, 0.f}; }
#pragma unroll
        for (int ai = 0; ai < 2; ++ai) {
            u32x4 xv[2][4][2];
#pragma unroll
            for (int m = 0; m < 4; ++m)
#pragma unroll
                for (int bj = 0; bj < 2; ++bj) xv[ai][m][bj] = *(const u32x4*)(XB + (size_t)(u.pm * BM + ai * HALF + wr * 64 + m * 16 + fr) * D + u.pn * BM + bj * HALF + wc * 32 + 8 * fq);
            __builtin_amdgcn_sched_barrier(0);
#pragma unroll
            for (int m = 0; m < 4; ++m) {
                const int row = u.pm * BM + ai * HALF + wr * 64 + m * 16 + fr; float ss = 0.f;
#pragma unroll
                for (int bj = 0; bj < 2; ++bj) {
                    const size_t off = (size_t)row * D + u.pn * BM + bj * HALF + wc * 32 + 8 * fq; const u32x4 xw = xv[ai][m][bj];
                    const f32x4 v0 = (f32x4){bf_lo(xw.x), bf_hi(xw.x), bf_lo(xw.y), bf_hi(xw.y)} + acc[ai][bj][m][0] + bv[bj][0];
                    const f32x4 v1 = (f32x4){bf_lo(xw.z), bf_hi(xw.z), bf_lo(xw.w), bf_hi(xw.w)} + acc[ai][bj][m][1] + bv[bj][1];
                    const u32x4 w = pack8(v0, v1);
                    *(u32x4*)(XB + off) = w;
                    const float r0 = bf_lo(w.x), r1 = bf_hi(w.x), r2 = bf_lo(w.y), r3 = bf_hi(w.y), r4 = bf_lo(w.z), r5 = bf_hi(w.z), r6 = bf_lo(w.w), r7 = bf_hi(w.w);
                    ss += (r0 * r0 + r1 * r1) + (r2 * r2 + r3 * r3) + (r4 * r4 + r5 * r5) + (r6 * r6 + r7 * r7);
                }
                if (ssp) { ss += __shfl_xor(ss, 16); ss += __shfl_xor(ss, 32); if (fq == 0) ssp[(size_t)row * 16 + u.pn * 4 + wc] = ss; }
            }
            __builtin_amdgcn_sched_barrier(0);
        }
    }
};
struct AttnSched {
    __device__ __forceinline__ int lda(const Unit&) const { return lda_; }
    __device__ __forceinline__ int ldb(const Unit&) const { return ldb_; }
    __device__ __forceinline__ int nt(const Unit&) const { return K / BK; }
    __device__ __forceinline__ bool cont(const Unit&) const { return false; }
    int K, lda_, ldb_; const bf16_t* A; const bf16_t* Bm; int pv;
    __device__ __forceinline__ bool next(int i, Unit& u) const {
        const int c = blockIdx.x, per = gridDim.x >> 3, x = c & 7, j = c >> 3;
        const int lu = i * per + j; if (lu >= 64) return false;
        const int un = x * 64 + lu, bh = un >> 5, qb = un & 31;
        u.pm = (bh >> 2) * 32 + qb; u.pn = 0; u.e = bh & 3; return true; }
    __device__ __forceinline__ const char* a_base(const Unit&) const { return (const char*)A; }
    __device__ __forceinline__ int a_row(const Unit& u, int r) const { return u.pm * BM + r; }
    __device__ __forceinline__ int a_col(const Unit& u) const { return u.e * 256; }
    __device__ __forceinline__ const char* b_base(const Unit& u) const { const int b = u.pm >> 5;
        return pv ? (const char*)(Bm + (size_t)(b * 4 + u.e) * 65536) : (const char*)(Bm + (size_t)(b * 256) * 1024 + u.e * 256); }
};
struct KVSched {
    __device__ __forceinline__ int lda(const Unit&) const { return lda_; }
    __device__ __forceinline__ int ldb(const Unit&) const { return ldb_; }
    __device__ __forceinline__ int nt(const Unit&) const { return K / BK; }
    __device__ __forceinline__ bool cont(const Unit&) const { return false; }
    int K, lda_, ldb_; const bf16_t* MEMNB; const bf16_t* WKV;
    __device__ __forceinline__ bool next(int i, Unit& u) const {
        const int un = i * (int)gridDim.x + (int)blockIdx.x; if (un >= 32) return false;
        u.e = un >> 4; u.pm = (un & 15) >> 2; u.pn = un & 3; return true; }
    __device__ __forceinline__ const char* a_base(const Unit& u) const { return u.e ? (const char*)(WKV + (size_t)1024 * 1024) : (const char*)MEMNB; }
    __device__ __forceinline__ int a_row(const Unit& u, int r) const { return u.pm * BM + r; }
    __device__ __forceinline__ int a_col(const Unit&) const { return 0; }
    __device__ __forceinline__ const char* b_base(const Unit& u) const { return u.e ? (const char*)(MEMNB + (size_t)u.pn * BM * 1024) : (const char*)(WKV + (size_t)u.pn * BM * 1024); }
};
__device__ __forceinline__ float ssp_rs(const float* ssp, int row) {
    const f32x4 a = *(const f32x4*)(ssp + (size_t)row * 16), b = *(const f32x4*)(ssp + (size_t)row * 16 + 4), c = *(const f32x4*)(ssp + (size_t)row * 16 + 8), d = *(const f32x4*)(ssp + (size_t)row * 16 + 12);
    const float s = ((a[0] + a[1]) + (a[2] + a[3])) + ((b[0] + b[1]) + (b[2] + b[3])) + ((c[0] + c[1]) + (c[2] + c[3])) + ((d[0] + d[1]) + (d[2] + d[3]));
    return rsqrtf(s * (1.0f / D) + EPS);
}
struct EpiRowScale {
    bf16_t* O; int ldo; const float* ssp; const float* rs; float scale; int qtiles; float qscale;
    __device__ __forceinline__ void operator()(const f32x4 (&acc)[2][2][4][2], const Unit& u, int wr, int wc, int fr, int fq) const {
        const float cs = scale * (u.pn < qtiles ? qscale : 1.0f);
        float rv[2][4];
        if (rs) {
#pragma unroll
            for (int ai = 0; ai < 2; ++ai)
#pragma unroll
                for (int m = 0; m < 4; ++m) rv[ai][m] = rs[u.pm * BM + ai * HALF + wr * 64 + m * 16 + fr];
        } else {
#pragma unroll
            for (int ai = 0; ai < 2; ++ai) {
                f32x4 p[4][4];
#pragma unroll
                for (int m = 0; m < 4; ++m)
#pragma unroll
                    for (int q = 0; q < 4; ++q) p[m][q] = *(const f32x4*)(ssp + (size_t)(u.pm * BM + ai * HALF + wr * 64 + m * 16 + fr) * 16 + 4 * q);
                __builtin_amdgcn_sched_barrier(0);
#pragma unroll
                for (int m = 0; m < 4; ++m) { float sm = 0.f;
#pragma unroll
                    for (int q = 0; q < 4; ++q) sm += (p[m][q][0] + p[m][q][1]) + (p[m][q][2] + p[m][q][3]);
                    rv[ai][m] = rsqrtf(sm * (1.0f / D) + EPS); }
            }
        }
        __builtin_amdgcn_sched_barrier(0);
#pragma unroll
        for (int ai = 0; ai < 2; ++ai)
#pragma unroll
            for (int m = 0; m < 4; ++m) {
                const int row = u.pm * BM + ai * HALF + wr * 64 + m * 16 + fr;
                const float r = rv[ai][m] * cs;
#pragma unroll
                for (int bj = 0; bj < 2; ++bj) { const int c0 = u.pn * BM + bj * HALF + wc * 32 + 8 * fq;
                    *(u32x4*)(O + (size_t)row * ldo + c0) = pack8(acc[ai][bj][m][0] * r, acc[ai][bj][m][1] * r); }
            }
    }
};
struct EpiKV {
    bf16_t* Kb; bf16_t* VT;
    __device__ __forceinline__ void operator()(const f32x4 (&acc)[2][2][4][2], const Unit& u, int wr, int wc, int fr, int fq) const {
        bf16_t* base = u.e ? VT + (size_t)(u.pn * 4 + u.pm) * 65536 : Kb + (size_t)u.pm * BM * 1024 + u.pn * BM;
        const int ld = u.e ? 256 : 1024;
#pragma unroll
        for (int ai = 0; ai < 2; ++ai)
#pragma unroll
            for (int m = 0; m < 4; ++m) { const int r = ai * HALF + wr * 64 + m * 16 + fr;
#pragma unroll
                for (int bj = 0; bj < 2; ++bj) { const int c0 = bj * HALF + wc * 32 + 8 * fq;
                    *(u32x4*)(base + (size_t)r * ld + c0) = pack8(acc[ai][bj][m][0], acc[ai][bj][m][1]); } }
    }
};
struct EpiS {
    bf16_t* P; float* psum;
    __device__ __forceinline__ void operator()(const f32x4 (&acc)[2][2][4][2], const Unit& u, int wr, int wc, int fr, int fq) const {
#pragma unroll
        for (int ai = 0; ai < 2; ++ai)
#pragma unroll
            for (int m = 0; m < 4; ++m) {
                const int row = u.pm * BM + ai * HALF + wr * 64 + m * 16 + fr; float ps = 0.f;
#pragma unroll
                for (int bj = 0; bj < 2; ++bj) { const int c0 = u.e * 256 + bj * HALF + wc * 32 + 8 * fq;
                    f32x4 e0, e1;
#pragma unroll
                    for (int j = 0; j < 4; ++j) { e0[j] = __builtin_amdgcn_exp2f(acc[ai][bj][m][0][j] * 1.4426950408889634f); e1[j] = __builtin_amdgcn_exp2f(acc[ai][bj][m][1][j] * 1.4426950408889634f); }
                    const u32x4 w = pack8(e0, e1);
                    *(u32x4*)(P + (size_t)row * D + c0) = w;
                    ps += (bf_lo(w.x) + bf_hi(w.x)) + (bf_lo(w.y) + bf_hi(w.y)) + (bf_lo(w.z) + bf_hi(w.z)) + (bf_lo(w.w) + bf_hi(w.w)); }
                ps += __shfl_xor(ps, 16); ps += __shfl_xor(ps, 32);
                if (fq == 0) psum[(size_t)row * 16 + u.e * 4 + wc] = ps;
            }
    }
};
struct EpiRaw {
    bf16_t* O;
    __device__ __forceinline__ void operator()(const f32x4 (&acc)[2][2][4][2], const Unit& u, int wr, int wc, int fr, int fq) const {
#pragma unroll
        for (int ai = 0; ai < 2; ++ai)
#pragma unroll
            for (int m = 0; m < 4; ++m) { const int row = u.pm * BM + ai * HALF + wr * 64 + m * 16 + fr;
#pragma unroll
                for (int bj = 0; bj < 2; ++bj) { const int c0 = u.e * 256 + bj * HALF + wc * 32 + 8 * fq;
                    *(u32x4*)(O + (size_t)row * D + c0) = pack8(acc[ai][bj][m][0], acc[ai][bj][m][1]); } }
    }
};
struct EpiNone {
    __device__ __forceinline__ void operator()(const f32x4 (&acc)[2][2][4][2], const Unit& u, int wr, int wc, int fr, int fq) const {
#pragma unroll
        for (int ai = 0; ai < 2; ++ai)
#pragma unroll
            for (int bj = 0; bj < 2; ++bj)
#pragma unroll
                for (int m = 0; m < 4; ++m)
#pragma unroll
                    for (int n = 0; n < 2; ++n) asm volatile("" :: "v"(acc[ai][bj][m][n]));
    }
};
struct EpiPV {
    bf16_t* O; const float* psum;
    __device__ __forceinline__ void operator()(const f32x4 (&acc)[2][2][4][2], const Unit& u, int wr, int wc, int fr, int fq) const {
        f32x4 sv[2][4];
#pragma unroll
        for (int ai = 0; ai < 2; ++ai)
#pragma unroll
            for (int m = 0; m < 4; ++m) sv[ai][m] = *(const f32x4*)(psum + (size_t)(u.pm * BM + ai * HALF + wr * 64 + m * 16 + fr) * 16 + u.e * 4);
        __builtin_amdgcn_sched_barrier(0);
#pragma unroll
        for (int ai = 0; ai < 2; ++ai)
#pragma unroll
            for (int m = 0; m < 4; ++m) {
                const int row = u.pm * BM + ai * HALF + wr * 64 + m * 16 + fr;
                const float inv = 1.0f / ((sv[ai][m][0] + sv[ai][m][1]) + (sv[ai][m][2] + sv[ai][m][3]));
#pragma unroll
                for (int bj = 0; bj < 2; ++bj) { const int c0 = u.e * 256 + bj * HALF + wc * 32 + 8 * fq;
                    *(u32x4*)(O + (size_t)row * D + c0) = pack8(acc[ai][bj][m][0] * inv, acc[ai][bj][m][1] * inv); }
            }
    }
};

__device__ __forceinline__ int ld_agent(const int* p) { return __hip_atomic_load(p, __ATOMIC_RELAXED, __HIP_MEMORY_SCOPE_AGENT); }
struct MoeSched {
    __device__ __forceinline__ int lda(const Unit&) const { return lda_; }
    __device__ __forceinline__ int ldb(const Unit&) const { return ldb_; }
    __device__ __forceinline__ int nt(const Unit&) const { return K / BK; }
    __device__ __forceinline__ bool cont(const Unit&) const { return false; }
    int K, lda_, ldb_; const bf16_t* A; const bf16_t* W; size_t wstride; const int* tile_e; const int* slot_tok; int NT;
    __device__ __forceinline__ bool next(int i, Unit& u) const {
        const int c = blockIdx.x, per = gridDim.x >> 3, x = c & 7, j = c >> 3;
        const int tpx = (NT + 7) >> 3, lu = i * per + j, lrt = lu >> 2;
        if (lrt >= tpx) return false;
        const int rt = x * tpx + lrt; if (rt >= NT) return false;
        u.pm = rt; u.pn = lu & 3; u.e = __builtin_amdgcn_readfirstlane(ld_agent(tile_e + rt)); return true; }
    __device__ __forceinline__ const char* a_base(const Unit&) const { return (const char*)A; }
    __device__ __forceinline__ int a_row(const Unit& u, int r) const { return slot_tok ? slot_tok[u.pm * BM + r] : u.pm * BM + r; }
    __device__ __forceinline__ int a_col(const Unit&) const { return 0; }
    __device__ __forceinline__ const char* b_base(const Unit& u) const { return (const char*)(W + (size_t)u.e * wstride + (size_t)u.pn * BM * ldb_); }
};
struct EpiMoe1 {
    bf16_t* H; const float* slot_rs;
    __device__ __forceinline__ void operator()(const f32x4 (&acc)[2][2][4][2], const Unit& u, int wr, int wc, int fr, int fq) const {
        const int c0 = u.pn * 128 + wc * 32 + 8 * fq;
        float rv[2][4];
#pragma unroll
        for (int ai = 0; ai < 2; ++ai)
#pragma unroll
            for (int m = 0; m < 4; ++m) rv[ai][m] = slot_rs[u.pm * BM + ai * HALF + wr * 64 + m * 16 + fr];
        __builtin_amdgcn_sched_barrier(0);
#pragma unroll
        for (int ai = 0; ai < 2; ++ai)
#pragma unroll
            for (int m = 0; m < 4; ++m) {
                const int row = u.pm * BM + ai * HALF + wr * 64 + m * 16 + fr; const float r = rv[ai][m];
                f32x4 o0, o1;
#pragma unroll
                for (int j = 0; j < 4; ++j) {
                    const float g0 = acc[ai][0][m][0][j] * r, g1 = acc[ai][0][m][1][j] * r;
                    o0[j] = g0 * fast_sigmoid(g0) * (acc[ai][1][m][0][j] * r);
                    o1[j] = g1 * fast_sigmoid(g1) * (acc[ai][1][m][1][j] * r); }
                *(u32x4*)(H + (size_t)row * DE + c0) = pack8(o0, o1);
            }
    }
};
struct EpiMoe2 {
    bf16_t* Y; const int* slot_a; const float* slot_gate;
    __device__ __forceinline__ void operator()(const f32x4 (&acc)[2][2][4][2], const Unit& u, int wr, int wc, int fr, int fq) const {
        int av[2][4]; float gv[2][4];
#pragma unroll
        for (int ai = 0; ai < 2; ++ai)
#pragma unroll
            for (int m = 0; m < 4; ++m) { const int row = u.pm * BM + ai * HALF + wr * 64 + m * 16 + fr; av[ai][m] = slot_a[row]; gv[ai][m] = slot_gate[row]; }
        __builtin_amdgcn_sched_barrier(0);
#pragma unroll
        for (int ai = 0; ai < 2; ++ai)
#pragma unroll
            for (int m = 0; m < 4; ++m) {
                const int a = av[ai][m]; const float g = gv[ai][m];
                if (a >= 0) {
#pragma unroll
                    for (int bj = 0; bj < 2; ++bj) { const int c0 = u.pn * BM + bj * HALF + wc * 32 + 8 * fq;
                        *(u32x4*)(Y + (size_t)a * D + c0) = pack8(acc[ai][bj][m][0] * g, acc[ai][bj][m][1] * g); }
                }
            }
    }
};

struct GlaInSched {
    const bf16_t* XB; const bf16_t* WTM; const bf16_t* WFM;
    __device__ __forceinline__ int lda(const Unit&) const { return D; }
    __device__ __forceinline__ int ldb(const Unit&) const { return D; }
    __device__ __forceinline__ int nt(const Unit&) const { return D / BK; }
    __device__ __forceinline__ bool cont(const Unit&) const { return false; }
    __device__ __forceinline__ bool next(int i, Unit& u) const {
        const int c = blockIdx.x, per = gridDim.x >> 3, x = c & 7, j = c >> 3, lu = i * per + j;
        if (lu >= 224) return false;
        const int un = x * 224 + lu;
        if (un < 1024) { u.e = 0; u.pm = un >> 3; u.pn = un & 7; } else { const int v = un - 1024; u.e = 1; u.pn = v / 6; u.pm = v - u.pn * 6; }
        return true; }
    __device__ __forceinline__ const char* a_base(const Unit& u) const { return u.e ? (const char*)WFM : (const char*)XB; }
    __device__ __forceinline__ int a_row(const Unit& u, int r) const { return u.pm * BM + r; }
    __device__ __forceinline__ int a_col(const Unit&) const { return 0; }
    __device__ __forceinline__ const char* b_base(const Unit& u) const { return u.e ? (const char*)(XB + (size_t)u.pn * BM * D) : (const char*)(WTM + (size_t)u.pn * BM * D); }
};

struct EpiGlaIn {
    bf16_t* QKR; bf16_t* KVT; const float* RS; const bf16_t* EQ; const bf16_t* EKF;
    __device__ __forceinline__ void operator()(const f32x4 (&acc)[2][2][4][2], const Unit& u, int wr, int wc, int fr, int fq) const {
        if (u.e == 0) {
            float rv[2][4];
#pragma unroll
            for (int ai = 0; ai < 2; ++ai)
#pragma unroll
                for (int m = 0; m < 4; ++m) rv[ai][m] = RS[u.pm * BM + ai * HALF + wr * 64 + m * 16 + fr];
            const float qs = u.pn < 2 ? 0.08838834764831845f : 1.0f;
            const bf16_t* F = EQ + (u.pn < 2 ? (size_t)0 : (size_t)T * 512);
#pragma unroll
            for (int ai = 0; ai < 2; ++ai) {
                u32x4 fv[4][2];
                if (u.pn < 4) {
#pragma unroll
                    for (int m = 0; m < 4; ++m)
#pragma unroll
                        for (int bj = 0; bj < 2; ++bj) { const int row = u.pm * BM + ai * HALF + wr * 64 + m * 16 + fr, kf = (u.pn * BM + bj * HALF + wc * 32 + 8 * fq) & 511;
                            fv[m][bj] = *(const u32x4*)(F + (size_t)row * 512 + kf); }
                }
                __builtin_amdgcn_sched_barrier(0);
#pragma unroll
                for (int m = 0; m < 4; ++m) {
                    const int row = u.pm * BM + ai * HALF + wr * 64 + m * 16 + fr; const float r = rv[ai][m] * qs;
#pragma unroll
                    for (int bj = 0; bj < 2; ++bj) { const int c0 = u.pn * BM + bj * HALF + wc * 32 + 8 * fq;
                        f32x4 s0 = (f32x4){r, r, r, r}, s1 = s0;
                        if (u.pn < 4) { const u32x4 w = fv[m][bj];
                            s0 *= (f32x4){bf_lo(w.x), bf_hi(w.x), bf_lo(w.y), bf_hi(w.y)}; s1 *= (f32x4){bf_lo(w.z), bf_hi(w.z), bf_lo(w.w), bf_hi(w.w)}; }
                        *(u32x4*)(QKR + (size_t)row * 2048 + c0) = pack8(acc[ai][bj][m][0] * s0, acc[ai][bj][m][1] * s1); }
                }
                __builtin_amdgcn_sched_barrier(0);
            }
        } else {
#pragma unroll
            for (int bj = 0; bj < 2; ++bj) { const int t0 = u.pn * BM + bj * HALF + wc * 32 + 8 * fq;
                const f32x4 r0 = *(const f32x4*)(RS + t0), r1 = *(const f32x4*)(RS + t0 + 4);
                u32x4 fv[2][4];
                if (u.pm < 2) {
#pragma unroll
                    for (int ai = 0; ai < 2; ++ai)
#pragma unroll
                        for (int m = 0; m < 4; ++m) fv[ai][m] = *(const u32x4*)(EKF + (size_t)(u.pm * BM + ai * HALF + wr * 64 + m * 16 + fr) * T + t0);
                }
                __builtin_amdgcn_sched_barrier(0);
#pragma unroll
                for (int ai = 0; ai < 2; ++ai)
#pragma unroll
                    for (int m = 0; m < 4; ++m) { const int f = u.pm * BM + ai * HALF + wr * 64 + m * 16 + fr;
                        f32x4 s0 = r0, s1 = r1;
                        if (u.pm < 2) { const u32x4 w = fv[ai][m];
                            s0 *= (f32x4){bf_lo(w.x), bf_hi(w.x), bf_lo(w.y), bf_hi(w.y)}; s1 *= (f32x4){bf_lo(w.z), bf_hi(w.z), bf_lo(w.w), bf_hi(w.w)}; }
                        *(u32x4*)(KVT + (size_t)f * T + t0) = pack8(acc[ai][bj][m][0] * s0, acc[ai][bj][m][1] * s1); }
                __builtin_amdgcn_sched_barrier(0);
            }
        }
    }
};
template <int TYP> struct GlaAttSched {
    const bf16_t* QKR; const bf16_t* KVT;
    __device__ __forceinline__ bool next(int i, Unit& u) const {
        const int c = blockIdx.x, per = gridDim.x >> 3, x = c & 7, j = c >> 3, lu = i * per + j;
        if (lu >= 64) return false;
        const int un = x * 64 + lu, bh = un >> 5, cc = un & 31;
        u.e = TYP; u.pm = (bh >> 2) * 32 + cc; u.pn = bh & 3; return true; }
    __device__ __forceinline__ int lda(const Unit& u) const { return TYP ? T : 2048; }
    __device__ __forceinline__ int ldb(const Unit& u) const { return TYP ? T : 2048; }
    __device__ __forceinline__ int nt(const Unit& u) const { int n = TYP ? 4 : 2; asm volatile("" : "+s"(n)); return n; }
    __device__ __forceinline__ bool cont(const Unit&) const { return false; }
    __device__ __forceinline__ const char* a_base(const Unit& u) const { return TYP ? (const char*)KVT : (const char*)QKR; }
    __device__ __forceinline__ int a_row(const Unit& u, int r) const { return TYP ? 512 + u.pn * 256 + r : u.pm * BM + r; }
    __device__ __forceinline__ int a_col(const Unit& u) const { return TYP ? u.pm * BM : u.pn * 128; }
    __device__ __forceinline__ const char* b_base(const Unit& u) const {
        return TYP ? (const char*)(KVT + (size_t)(u.pn * 128) * T + (size_t)u.pm * BM) : (const char*)(QKR + (size_t)u.pm * BM * 2048 + 512 + u.pn * 128); }
};
template <int TYP> struct EpiGlaAtt {
    bf16_t* ATT; bf16_t* UT; const float* DL;
    __device__ __forceinline__ void operator()(const f32x4 (&acc)[2][2][4][2], const Unit& u, int wr, int wc, int fr, int fq) const {
        if (TYP == 0) {
#pragma unroll
            for (int ai = 0; ai < 2; ++ai)
#pragma unroll
                for (int m = 0; m < 4; ++m) { const int rit = ai * HALF + wr * 64 + m * 16 + fr;
#pragma unroll
                    for (int bj = 0; bj < 2; ++bj) { const int c0 = bj * HALF + wc * 32 + 8 * fq;
                        f32x4 v0 = acc[ai][bj][m][0], v1 = acc[ai][bj][m][1];
#pragma unroll
                        for (int j = 0; j < 4; ++j) { if (c0 + j > rit) v0[j] = 0.f; if (c0 + 4 + j > rit) v1[j] = 0.f; }
                        *(u32x4*)(ATT + (size_t)(u.pm * BM + rit) * D + u.pn * 256 + c0) = pack8(v0, v1); }
                }
        } else {
            const int k0 = wc * 32 + 8 * fq;
            const f32x4 d0 = *(const f32x4*)(DL + (size_t)u.pm * 512 + u.pn * 128 + k0), d1 = *(const f32x4*)(DL + (size_t)u.pm * 512 + u.pn * 128 + k0 + 4);
            const int b = u.pm >> 5, cc = u.pm & 31; bf16_t* base = UT + (size_t)((b * 4 + u.pn) * 32 + cc) * 32768;
#pragma unroll
            for (int ai = 0; ai < 2; ++ai)
#pragma unroll
                for (int m = 0; m < 4; ++m) { const int dv = ai * HALF + wr * 64 + m * 16 + fr;
                    *(u32x4*)(base + (size_t)dv * 128 + k0) = pack8(acc[ai][0][m][0] * d0, acc[ai][0][m][1] * d1); }
        }
    }
};
struct GlaOSched {
    const bf16_t* QKR; const bf16_t* KVT; const bf16_t* ATT; const bf16_t* SP;
    __device__ __forceinline__ bool next(int i, Unit& u) const {
        const int c = blockIdx.x, per = gridDim.x >> 3, x = c & 7, j = c >> 3, pl = (i >> 1) * per + j;
        if (pl >= 64) return false;
        const int w = x * 64 + pl, bh = w >> 5, cc = w & 31;
        u.e = i & 1; u.pm = (bh >> 2) * 32 + cc; u.pn = bh & 3; return true; }
    __device__ __forceinline__ int lda(const Unit& u) const { return u.e ? D : 2048; }
    __device__ __forceinline__ int ldb(const Unit& u) const { return u.e ? T : 128; }
    __device__ __forceinline__ int nt(const Unit& u) const { return u.e ? 4 : 2; }
    __device__ __forceinline__ bool cont(const Unit& u) const { return u.e == 0; }
    __device__ __forceinline__ const char* a_base(const Unit& u) const { return u.e ? (const char*)ATT : (const char*)QKR; }
    __device__ __forceinline__ int a_row(const Unit& u, int r) const { return u.pm * BM + r; }
    __device__ __forceinline__ int a_col(const Unit& u) const { return u.e ? u.pn * 256 : u.pn * 128; }
    __device__ __forceinline__ const char* b_base(const Unit& u) const { const int b = u.pm >> 5, cc = u.pm & 31;
        return u.e ? (const char*)(KVT + (size_t)(512 + u.pn * 256) * T + (size_t)u.pm * BM) : (const char*)(SP + (size_t)((b * 4 + u.pn) * 32 + cc) * 32768); }
};
struct EpiGlaO {
    bf16_t* O;
    __device__ __forceinline__ void operator()(const f32x4 (&acc)[2][2][4][2], const Unit& u, int wr, int wc, int fr, int fq) const {
#pragma unroll
        for (int ai = 0; ai < 2; ++ai)
#pragma unroll
            for (int m = 0; m < 4; ++m) { const int row = u.pm * BM + ai * HALF + wr * 64 + m * 16 + fr;
#pragma unroll
                for (int bj = 0; bj < 2; ++bj) { const int c0 = u.pn * 256 + bj * HALF + wc * 32 + 8 * fq;
                    *(u32x4*)(O + (size_t)row * D + c0) = pack8(acc[ai][bj][m][0], acc[ai][bj][m][1]); } }
    }
};
}

struct CvtJob { const float* W; int ldw, col0, K; const float* g; bf16_t* Bt; int il, half, nblk; };
__device__ __forceinline__ void cvt_load(const CvtJob& j, int item, int lane, f32x4 (&v)[8]) {
    const int kb = item / j.nblk, nb = item - kb * j.nblk, k0 = 64 * kb, n0 = 32 * nb;
    const float* p = j.W + (size_t)(k0 + (lane >> 3)) * j.ldw + j.col0 + n0 + 4 * (lane & 7);
#pragma unroll
    for (int i = 0; i < 8; ++i) v[i] = *(const f32x4*)(p + (size_t)(8 * i) * j.ldw);
    if (j.g) {
#pragma unroll
        for (int i = 0; i < 8; ++i) v[i] *= j.g[k0 + 8 * i + (lane >> 3)]; }
}
__device__ __forceinline__ void cvt_store(const CvtJob& j, int item, int lane, LAS float* scr, const f32x4 (&v)[8]) {
    const int kb = item / j.nblk, nb = item - kb * j.nblk, k0 = 64 * kb, n0 = 32 * nb;
#pragma unroll
    for (int i = 0; i < 8; ++i) { LAS float* d = scr + (8 * i + (lane >> 3)) * 33 + 4 * (lane & 7); d[0] = v[i][0]; d[1] = v[i][1]; d[2] = v[i][2]; d[3] = v[i][3]; }
    asm volatile("s_waitcnt lgkmcnt(0)" ::: "memory");
    const int c = lane & 7;
#pragma unroll
    for (int q = 0; q < 4; ++q) { const int n = (lane >> 3) + 8 * q; const LAS float* s = scr + (8 * c) * 33 + n;
        u32x4 o; o.x = cvt_pk_bf16(s[0 * 33], s[1 * 33]); o.y = cvt_pk_bf16(s[2 * 33], s[3 * 33]); o.z = cvt_pk_bf16(s[4 * 33], s[5 * 33]); o.w = cvt_pk_bf16(s[6 * 33], s[7 * 33]);
        const int nn = n0 + n, drow = j.il ? ((nn >> 7) * 256 + j.half * 128 + (nn & 127)) : nn;
        *(u32x4*)(j.Bt + (size_t)drow * j.K + k0 + 8 * c) = o; }
    asm volatile("s_waitcnt lgkmcnt(0)" ::: "memory");
}
__device__ __forceinline__ void cvt_matrix(const float* W, int ldw, int col0, int ncols, int K, const float* g, bf16_t* Bt, int il, int half, LAS unsigned char* lds, int woff = 0) {
    const int tix = otid();
    const int lane = tix & 63, wv = tix >> 6;
    LAS float* scr = (LAS float*)(lds + wv * 8704);
    const int ngw = gridDim.x * 8; int gw = blockIdx.x * 8 + wv - (woff % ngw); if (gw < 0) gw += ngw;
    const CvtJob j{W, ldw, col0, K, g, Bt, il, half, ncols / 32};
    const int nitems = (K / 64) * j.nblk;
    f32x4 cur[8], nxt[8];
    int it = gw; if (it < nitems) cvt_load(j, it, lane, cur);
    for (; it < nitems; it += ngw) {
        const int itn = it + ngw; if (itn < nitems) cvt_load(j, itn, lane, nxt);
        cvt_store(j, it, lane, scr, cur);
#pragma unroll
        for (int i = 0; i < 8; ++i) cur[i] = nxt[i];
    }
}
__device__ __forceinline__ void rows_prep(const float* x, bf16_t* XB, float* rs, float* ssp, int rows) {
    const int tix = otid();
    const int lane = tix & 63;
    const int gw = (blockIdx.x * blockDim.x + tix) >> 6, ngw = (gridDim.x * blockDim.x) >> 6;
    for (int r = gw; r < rows; r += ngw) {
        const f32x4* xr = (const f32x4*)(x + (size_t)r * D);
        f32x4 v[4]; float s = 0.f;
#pragma unroll
        for (int j = 0; j < 4; ++j) { v[j] = xr[lane + 64 * j]; s += (v[j][0] * v[j][0] + v[j][1] * v[j][1]) + (v[j][2] * v[j][2] + v[j][3] * v[j][3]); }
        s = wave_sum(s);
        if (lane == 0) rs[r] = rsqrtf(s * (1.0f / D) + EPS);
        if (ssp && lane < 16) ssp[(size_t)r * 16 + lane] = lane == 0 ? s : 0.f;
        u32x2* o = (u32x2*)(XB + (size_t)r * D);
#pragma unroll
        for (int j = 0; j < 4; ++j) { u32x2 w; w.x = cvt_pk_bf16(v[j][0], v[j][1]); w.y = cvt_pk_bf16(v[j][2], v[j][3]); o[lane + 64 * j] = w; }
    }
}

__device__ __forceinline__ void rows_norm_bf16(const float* x, const float* g, bf16_t* out, int rows) {
    const int tix = otid();
    const int lane = tix & 63;
    const int gw = (blockIdx.x * blockDim.x + tix) >> 6, ngw = (gridDim.x * blockDim.x) >> 6;
    for (int r = gw; r < rows; r += ngw) {
        const f32x4* xr = (const f32x4*)(x + (size_t)r * D);
        f32x4 v[4]; float s = 0.f;
#pragma unroll
        for (int j = 0; j < 4; ++j) { v[j] = xr[lane + 64 * j]; s += (v[j][0] * v[j][0] + v[j][1] * v[j][1]) + (v[j][2] * v[j][2] + v[j][3] * v[j][3]); }
        s = wave_sum(s); const float rs = rsqrtf(s * (1.0f / D) + EPS);
        u32x2* o = (u32x2*)(out + (size_t)r * D);
#pragma unroll
        for (int j = 0; j < 4; ++j) { const f32x4 gg = ((const f32x4*)g)[lane + 64 * j]; u32x2 w; w.x = cvt_pk_bf16(v[j][0] * rs * gg[0], v[j][1] * rs * gg[1]); w.y = cvt_pk_bf16(v[j][2] * rs * gg[2], v[j][3] * rs * gg[3]); o[lane + 64 * j] = w; }
    }
}

__device__ __forceinline__ void route_prep(const float* wg, const float* we, const float* gain, float* WR) {
    const int tix = otid();
    const int gi = blockIdx.x * blockDim.x + tix, gs = gridDim.x * blockDim.x;
    for (int i = gi; i < 36 * 1024; i += gs) { const int j = i >> 10, k = i & 1023; WR[i] = (j < 32 ? we[k * NE + j] : wg[k * NG + (j - 32)]) * gain[k]; }
}
__device__ __forceinline__ float reduce16(float (&v)[18], int lane) {
#pragma unroll
    for (int st = 0; st < 4; ++st) { const int half = 8 >> st, bit = 32 >> st; const bool up = (lane & bit) != 0;
#pragma unroll
        for (int k = 0; k < half; ++k) { const float send = up ? v[k] : v[k + half]; const float keep = up ? v[k + half] : v[k]; v[k] = keep + __shfl_xor(send, bit); } }
    float r = v[0]; r += __shfl_xor(r, 2); r += __shfl_xor(r, 1); return r;
}
__device__ __forceinline__ float reduce2(const float (&v)[18], int lane) {
    const bool up = (lane & 32) != 0; const float send = up ? v[16] : v[17], keep = up ? v[17] : v[16];
    float r = keep + __shfl_xor(send, 32);
#pragma unroll
    for (int o = 16; o >= 1; o >>= 1) r += __shfl_xor(r, o);
    return r;
}
__device__ __forceinline__ void route_phase(const bf16_t* X, const float* WR, const float* bg, const float* be, float* RS, int* assign_e, int* assign_pos, float* gate, int* gcnt, LAS unsigned char* lds) {
    int tid_ = threadIdx.x; asm volatile("" : "+v"(tid_)); const int tid = tid_, lane = tid & 63, wv = tid >> 6;
    LAS float* Wr = (LAS float*)lds;
    LAS int* lcnt = (LAS int*)(lds + 36 * 4096); LAS int* lbase = lcnt + 32; LAS int* l_e = lbase + 32; LAS int* l_rank = l_e + 256;
    LAS float* lg = (LAS float*)(lds + 36 * 4096 + 2304) + wv * (8 * 37);
    for (int i = tid; i < 36 * 256; i += 512) ((LAS f32x4*)Wr)[i] = ((const f32x4*)WR)[i];
    for (int tb = blockIdx.x; tb < T / 128; tb += gridDim.x) {
        if (tid < 32) lcnt[tid] = 0;
        __syncthreads();
#pragma unroll 1
        for (int hf = 0; hf < 2; ++hf) {
#pragma unroll 1
            for (int it = 0; it < 4; ++it) {
                const int tl0 = wv * 16 + hf * 8 + it * 2, t0 = tb * 128 + tl0;
                f32x4 xv[2][4]; float rsv[2];
#pragma unroll
                for (int r = 0; r < 2; ++r) { float s = 0.f;
#pragma unroll
                    for (int c = 0; c < 4; ++c) { const u32x2 xw = *(const u32x2*)(X + (size_t)(t0 + r) * D + 256 * c + 4 * lane); xv[r][c] = (f32x4){bf_lo(xw.x), bf_hi(xw.x), bf_lo(xw.y), bf_hi(xw.y)}; s += (xv[r][c][0] * xv[r][c][0] + xv[r][c][1] * xv[r][c][1]) + (xv[r][c][2] * xv[r][c][2] + xv[r][c][3] * xv[r][c][3]); }
                    rsv[r] = rsqrtf(wave_sum(s) * (1.0f / D) + EPS); }
                float acc[2][36];
#pragma unroll
                for (int r = 0; r < 2; ++r)
#pragma unroll
                    for (int j = 0; j < 36; ++j) acc[r][j] = 0.f;
                unsigned b0_ = (unsigned)(16 * lane), b1_ = (unsigned)(16 * 4096 + 16 * lane), b2_ = (unsigned)(32 * 4096 + 16 * lane);
                asm volatile("" : "+v"(b0_)); asm volatile("" : "+v"(b1_)); asm volatile("" : "+v"(b2_));
#pragma unroll
                for (int j = 0; j < 36; ++j) {
#pragma unroll
                    for (int c = 0; c < 4; ++c) {
                        const f32x4 w4 = j < 16 ? *(const LAS f32x4*)(lds + b0_ + j * 4096 + c * 1024) : (j < 32 ? *(const LAS f32x4*)(lds + b1_ + (j - 16) * 4096 + c * 1024) : *(const LAS f32x4*)(lds + b2_ + (j - 32) * 4096 + c * 1024));
#pragma unroll
                        for (int r = 0; r < 2; ++r) acc[r][j] = fmaf(xv[r][c][3], w4[3], fmaf(xv[r][c][2], w4[2], fmaf(xv[r][c][1], w4[1], fmaf(xv[r][c][0], w4[0], acc[r][j])))); }
                    if (j % 3 == 2) __builtin_amdgcn_sched_barrier(0);
                }
#pragma unroll
                for (int st = 0; st < 5; ++st) { const int half = 16 >> st, bit = 32 >> st; const bool up = (lane & bit) != 0;
#pragma unroll
                    for (int r = 0; r < 2; ++r)
#pragma unroll
                        for (int k = 0; k < half; ++k) { const float send = up ? acc[r][k] : acc[r][k + half]; const float keep = up ? acc[r][k + half] : acc[r][k]; acc[r][k] = keep + __shfl_xor(send, bit); } }
#pragma unroll
                for (int st = 0; st < 2; ++st) { const int half = 2 >> st, bit = 32 >> st; const bool up = (lane & bit) != 0;
#pragma unroll
                    for (int r = 0; r < 2; ++r)
#pragma unroll
                        for (int k = 0; k < half; ++k) { const float send = up ? acc[r][32 + k] : acc[r][32 + k + half]; const float keep = up ? acc[r][32 + k + half] : acc[r][32 + k]; acc[r][32 + k] = keep + __shfl_xor(send, bit); } }
#pragma unroll
                for (int r = 0; r < 2; ++r) {
                    float e = acc[r][0]; e += __shfl_xor(e, 1);
                    float g = acc[r][32]; g += __shfl_xor(g, 8); g += __shfl_xor(g, 4); g += __shfl_xor(g, 2); g += __shfl_xor(g, 1);
                    LAS float* L = lg + (it * 2 + r) * 37;
                    if ((lane & 1) == 0) L[lane >> 1] = e;
                    if ((lane & 15) == 0) L[32 + (lane >> 4)] = g;
                    if (lane == 0) L[36] = rsv[r];
                }
            }
            asm volatile("s_waitcnt lgkmcnt(0)" ::: "memory");
            {
                const int r = lane & 7; const LAS float* L = lg + r * 37;
                const float rs = L[36];
                float gl[4];
#pragma unroll
                for (int g = 0; g < 4; ++g) gl[g] = L[32 + g] * rs + bg[g];
                int gs = 0; float gm = gl[0];
#pragma unroll
                for (int g = 1; g < 4; ++g) if (gl[g] > gm) { gm = gl[g]; gs = g; }
                float se = 0.f;
#pragma unroll
                for (int g = 0; g < 4; ++g) se += expf(gl[g] - gm);
                const float pg = 1.0f / se;
                float el[8];
#pragma unroll
                for (int i = 0; i < 8; ++i) el[i] = L[gs * 8 + i] * rs + be[gs * 8 + i];
                float em = el[0];
#pragma unroll
                for (int i = 1; i < 8; ++i) em = fmaxf(em, el[i]);
                float pe[8], ps = 0.f;
#pragma unroll
                for (int i = 0; i < 8; ++i) { pe[i] = expf(el[i] - em); ps += pe[i]; }
#pragma unroll
                for (int i = 0; i < 8; ++i) pe[i] = pe[i] / ps;
                int i1 = 0; float p1 = pe[0];
#pragma unroll
                for (int i = 1; i < 8; ++i) if (pe[i] > p1) { p1 = pe[i]; i1 = i; }
                int i2 = -1; float p2 = -1.f;
#pragma unroll
                for (int i = 0; i < 8; ++i) if (i != i1 && pe[i] > p2) { p2 = pe[i]; i2 = i; }
                if (lane < 8) {
                    if (i2 < 0) i2 = i1 == 0 ? 1 : 0;
                    const int tl = wv * 16 + hf * 8 + r, t = tb * 128 + tl; const float den = p1 + p2; const int e1 = gs * 8 + i1, e2 = gs * 8 + i2;
                    RS[t] = rs; gate[2 * t] = pg * p1 / den; gate[2 * t + 1] = pg * p2 / den;
                    l_e[2 * tl] = e1; l_e[2 * tl + 1] = e2;
                    l_rank[2 * tl] = atomicAdd((int*)(lcnt + e1), 1); l_rank[2 * tl + 1] = atomicAdd((int*)(lcnt + e2), 1);
                }
            }
            asm volatile("s_waitcnt lgkmcnt(0)" ::: "memory");
        }
        __syncthreads();
        if (tid < 32) lbase[tid] = __hip_atomic_fetch_add(gcnt + tid, lcnt[tid], __ATOMIC_RELAXED, __HIP_MEMORY_SCOPE_AGENT);
        __syncthreads();
        if (tid < 256) { const int a = tb * 256 + tid, e = l_e[tid]; assign_e[a] = e; assign_pos[a] = lbase[e] + l_rank[tid]; }
        __syncthreads();
    }
}
__device__ __forceinline__ void build_phase(const int* gcnt, const int* assign_e, const int* assign_pos, const float* gate, const float* RS,
                                            int* ntiles, int* tile_e, int* slot_tok, int* slot_a, float* slot_rs, float* slot_gate, LAS unsigned char* lds) {
    const int tix = otid();
    LAS int* poff = (LAS int*)lds; LAS int* cn = poff + 40;
    if (tix == 0) { int o = 0; for (int e = 0; e < 32; ++e) { const int cc = g8::ld_agent(gcnt + e); cn[e] = cc; poff[e] = o; o += (cc + 255) / 256 * 256; } poff[32] = o; }
    __syncthreads();
    const int gi = blockIdx.x * blockDim.x + tix, gs = gridDim.x * blockDim.x;
    for (int a = gi; a < NA; a += gs) { const int e = assign_e[a]; const int sl = poff[e] + assign_pos[a]; slot_tok[sl] = a >> 1; slot_a[sl] = a; slot_rs[sl] = RS[a >> 1]; slot_gate[sl] = gate[a]; }
    for (int i = gi; i < 32 * 256; i += gs) { const int e = i >> 8, sl = poff[e] + cn[e] + (i & 255); if (sl < poff[e + 1]) { slot_tok[sl] = 0; slot_a[sl] = -1; slot_rs[sl] = 0.f; slot_gate[sl] = 0.f; } }
    if (blockIdx.x == 0) {
        const int NT = poff[32] >> 8;
        for (int rt = tix; rt < NT; rt += blockDim.x) { int e = 0; for (int k = 0; k < 32; ++k) if (rt * 256 >= poff[k] && rt * 256 < poff[k + 1]) e = k; tile_e[rt] = e; }
        if (tix == 0) *ntiles = NT;
    }
    __syncthreads();
}
__device__ __forceinline__ CvtJob moe_job(const float* wgate, const float* wup, const float* wdown, const float* gain, bf16_t* W1, bf16_t* W2, int it, int& item) {
    const int e = it / 768, r = it - e * 768;
    if (r < 256) { item = r; return CvtJob{wgate + (size_t)e * D * DE, DE, 0, D, gain, W1 + (size_t)e * D * D, 1, 0, 16}; }
    if (r < 512) { item = r - 256; return CvtJob{wup + (size_t)e * D * DE, DE, 0, D, gain, W1 + (size_t)e * D * D, 1, 1, 16}; }
    item = r - 512; return CvtJob{wdown + (size_t)e * DE * D, D, 0, DE, nullptr, W2 + (size_t)e * D * DE, 0, 0, 32};
}
__device__ __forceinline__ void cvt_moe(const float* wgate, const float* wup, const float* wdown, const float* gain, bf16_t* W1, bf16_t* W2, LAS unsigned char* lds) {
    const int tix = otid();
    const int lane = tix & 63, wv = tix >> 6;
    LAS float* scr = (LAS float*)(lds + 1024 + wv * 8704);
    const int gw = blockIdx.x * 8 + wv, ngw = gridDim.x * 8;
    f32x4 cur[8], nxt[8]; int item = 0, itemn = 0;
    int it = gw; CvtJob j = moe_job(wgate, wup, wdown, gain, W1, W2, it < 32 * 768 ? it : 0, item);
    if (it < 32 * 768) cvt_load(j, item, lane, cur);
    for (; it < 32 * 768; it += ngw) {
        const int itn = it + ngw; CvtJob jn = j;
        if (itn < 32 * 768) { jn = moe_job(wgate, wup, wdown, gain, W1, W2, itn, itemn); cvt_load(jn, itemn, lane, nxt); }
        cvt_store(j, item, lane, scr, cur);
        j = jn; item = itemn;
#pragma unroll
        for (int i = 0; i < 8; ++i) cur[i] = nxt[i];
    }
}
__device__ __forceinline__ void combine_phase(float* X, float* Xo, const bf16_t* Y, bf16_t* XB, float* RS, float* ssp, const float* gfinal, int fin, const float* WA, float* ALR, LAS unsigned char* lds) {
    const int tix = otid();
    const int lane = tix & 63;
    if (WA) { for (int i = tix; i < 16 * 256; i += 512) ((LAS f32x4*)lds)[i] = ((const f32x4*)WA)[i]; __syncthreads(); }
    const int gw = (blockIdx.x * blockDim.x + tix) >> 6, ngw = (gridDim.x * blockDim.x) >> 6;
    for (int tb = gw; tb < T; tb += 2 * ngw) {
        f32x4 v[2][4]; u32x2 ya[2][4], yb[2][4];
#pragma unroll
        for (int rr = 0; rr < 2; ++rr) { const int t = tb + rr * ngw;
#pragma unroll
            for (int j = 0; j < 4; ++j) { const u32x2 xw = ((const u32x2*)(XB + (size_t)t * D))[lane + 64 * j]; v[rr][j] = (f32x4){bf_lo(xw.x), bf_hi(xw.x), bf_lo(xw.y), bf_hi(xw.y)};
                ya[rr][j] = ((const u32x2*)(Y + (size_t)(2 * t) * D))[lane + 64 * j]; yb[rr][j] = ((const u32x2*)(Y + (size_t)(2 * t + 1) * D))[lane + 64 * j]; } }
        __builtin_amdgcn_sched_barrier(0);
#pragma unroll
        for (int rr = 0; rr < 2; ++rr) { const int t = tb + rr * ngw; float s = 0.f;
#pragma unroll
            for (int j = 0; j < 4; ++j) {
                v[rr][j][0] += bf_lo(ya[rr][j].x) + bf_lo(yb[rr][j].x); v[rr][j][1] += bf_hi(ya[rr][j].x) + bf_hi(yb[rr][j].x);
                v[rr][j][2] += bf_lo(ya[rr][j].y) + bf_lo(yb[rr][j].y); v[rr][j][3] += bf_hi(ya[rr][j].y) + bf_hi(yb[rr][j].y);
                if (!fin) { const unsigned w0 = cvt_pk_bf16(v[rr][j][0], v[rr][j][1]), w1 = cvt_pk_bf16(v[rr][j][2], v[rr][j][3]); v[rr][j] = (f32x4){bf_lo(w0), bf_hi(w0), bf_lo(w1), bf_hi(w1)}; }
                s += (v[rr][j][0] * v[rr][j][0] + v[rr][j][1] * v[rr][j][1]) + (v[rr][j][2] * v[rr][j][2] + v[rr][j][3] * v[rr][j][3]); }
            s = wave_sum(s); const float rs = rsqrtf(s * (1.0f / D) + EPS);
            if (fin) {
#pragma unroll
                for (int j = 0; j < 4; ++j) { const f32x4 gg = ((const f32x4*)gfinal)[lane + 64 * j]; ((f32x4*)(Xo + (size_t)t * D))[lane + 64 * j] = v[rr][j] * rs * gg; }
            } else {
                if (lane == 0) RS[t] = rs;
                if (lane < 16) ssp[(size_t)t * 16 + lane] = lane == 0 ? s : 0.f;
                if (WA) {
                    float a16[18];
#pragma unroll
                    for (int o = 0; o < 16; ++o) { float p = 0.f;
#pragma unroll
                        for (int j = 0; j < 4; ++j) { const f32x4 w4 = *(const LAS f32x4*)(lds + (o * 1024 + 256 * j + 4 * lane) * 4);
                            p = fmaf(v[rr][j][3], w4[3], fmaf(v[rr][j][2], w4[2], fmaf(v[rr][j][1], w4[1], fmaf(v[rr][j][0], w4[0], p)))); }
                        a16[o] = p; if ((o & 3) == 3) __builtin_amdgcn_sched_barrier(0); }
                    a16[16] = 0.f; a16[17] = 0.f;
                    const float red = reduce16(a16, lane);
                    if ((lane & 3) == 0) ALR[(size_t)t * 16 + (lane >> 2)] = red * rs;
                }
#pragma unroll
                for (int j = 0; j < 4; ++j) { u32x2 w; w.x = cvt_pk_bf16(v[rr][j][0], v[rr][j][1]); w.y = cvt_pk_bf16(v[rr][j][2], v[rr][j][3]); ((u32x2*)(XB + (size_t)t * D))[lane + 64 * j] = w; }
            }
        }
    }
}

__device__ __forceinline__ float fexp2(float x) { return __builtin_amdgcn_exp2f(x * 1.4426950408889634f); }
__device__ __forceinline__ void gla_prep(const float* win, const float* wo, const float* gain, bf16_t* WGTM, bf16_t* WGFM, bf16_t* WGO, float* WA, LAS unsigned char* lds) {
    cvt_matrix(win, GLA_COLS, 0, 512, D, gain, WGTM, 0, 0, lds);
    cvt_matrix(win, GLA_COLS, 512, 512, D, gain, WGTM + (size_t)512 * D, 0, 0, lds, 256);
    cvt_matrix(win, GLA_COLS, 2064, 1024, D, gain, WGTM + (size_t)1024 * D, 0, 0, lds, 512);
    cvt_matrix(win, GLA_COLS, 512, 512, D, gain, WGFM, 0, 0, lds, 1024);
    cvt_matrix(win, GLA_COLS, 1024, 1024, D, gain, WGFM + (size_t)512 * D, 0, 0, lds, 1280);
    cvt_matrix(wo, D, 0, D, D, nullptr, WGO, 0, 0, lds, 1792);
    const int tix = otid(); const int gi = blockIdx.x * blockDim.x + tix, gs = gridDim.x * blockDim.x;
    for (int i = gi; i < 16 * 1024; i += gs) { const int j = i >> 10, k = i & 1023; WA[i] = win[(size_t)k * GLA_COLS + 2048 + j] * gain[k]; }
}
__device__ __forceinline__ void gla_decay(const float* ALR, const float* wa2, const float* ba, float* BTM, float* BFM, float* DL, LAS unsigned char* lds) {
    const int tix = otid();
    LAS float* tile = (LAS float*)lds;
    LAS float* wsl = tile + 256 * 65;
    LAS float* seg = wsl + 16 * 64;
    for (int item = blockIdx.x; item < 128 * 8; item += gridDim.x) {
        const int ch = item >> 3, kf0 = (item & 7) * 64, t0 = ch * 256;
        for (int i = tix; i < 16 * 64; i += 512) wsl[i] = wa2[(i >> 6) * GDK + kf0 + (i & 63)];
        __syncthreads();
        {
            const int t = tix >> 1, kh = (tix & 1) * 32;
            const f32x4 a0 = *(const f32x4*)(ALR + (size_t)(t0 + t) * 16), a1 = *(const f32x4*)(ALR + (size_t)(t0 + t) * 16 + 4), a2 = *(const f32x4*)(ALR + (size_t)(t0 + t) * 16 + 8), a3 = *(const f32x4*)(ALR + (size_t)(t0 + t) * 16 + 12);
#pragma unroll 4
            for (int k = 0; k < 32; ++k) {
                const int kf = kh + k; float z = ba[kf0 + kf];
#pragma unroll
                for (int r = 0; r < 4; ++r) { z = fmaf(a0[r], wsl[r * 64 + kf], z); z = fmaf(a1[r], wsl[(4 + r) * 64 + kf], z); z = fmaf(a2[r], wsl[(8 + r) * 64 + kf], z); z = fmaf(a3[r], wsl[(12 + r) * 64 + kf], z); }
                const float e = __builtin_amdgcn_exp2f(-1.4426950408889634f * fabsf(z));
                const float ls = fminf(z, 0.f) - 0.6931471805599453f * __builtin_amdgcn_logf(1.0f + e);
                tile[t * 65 + kf] = ls * (1.0f / 16.0f);
            }
        }
        __syncthreads();
        {
            const int kf = tix & 63, sg = tix >> 6; float run = 0.f;
#pragma unroll 8
            for (int i = 0; i < 32; ++i) { LAS float* p = tile + (sg * 32 + i) * 65 + kf; run += *p; *p = run; }
            seg[sg * 64 + kf] = run;
            __syncthreads();
            float off = 0.f;
            for (int q = 0; q < sg; ++q) off += seg[q * 64 + kf];
#pragma unroll 8
            for (int i = 0; i < 32; ++i) { LAS float* p = tile + (sg * 32 + i) * 65 + kf; *p += off; }
            if (sg == 7) DL[(size_t)ch * 512 + kf0 + kf] = __builtin_amdgcn_exp2f(1.4426950408889634f * (run + off));
        }
        __syncthreads();
        bf16_t* EQ = (bf16_t*)BTM; bf16_t* EK = EQ + (size_t)T * 512; bf16_t* EKF = (bf16_t*)BFM;
#pragma unroll
        for (int j = 0; j < 4; ++j) { const int t = (tix >> 3) + 64 * j, c = (tix & 7) * 8; const LAS float* p = tile + t * 65 + c;
            f32x4 e0, e1, n0, n1;
#pragma unroll
            for (int q = 0; q < 4; ++q) { e0[q] = fexp2(p[q]); e1[q] = fexp2(p[4 + q]); n0[q] = fexp2(-p[q]); n1[q] = fexp2(-p[4 + q]); }
            *(u32x4*)(EQ + (size_t)(t0 + t) * 512 + kf0 + c) = pack8(e0, e1); *(u32x4*)(EK + (size_t)(t0 + t) * 512 + kf0 + c) = pack8(n0, n1); }
#pragma unroll
        for (int j = 0; j < 4; ++j) { const int kf = (tix >> 5) + 16 * j, t = (tix & 31) * 8; const LAS float* p = tile + t * 65 + kf;
            f32x4 n0, n1;
#pragma unroll
            for (int q = 0; q < 4; ++q) { n0[q] = fexp2(-p[q * 65]); n1[q] = fexp2(-p[(4 + q) * 65]); }
            *(u32x4*)(EKF + (size_t)(kf0 + kf) * T + t0 + t) = pack8(n0, n1); }
        __syncthreads();
    }
}
__device__ __forceinline__ void gla_scan(const bf16_t* UT, const float* DL, bf16_t* SP) {
    const int tix = otid(); const int gi = blockIdx.x * blockDim.x + tix, gs = gridDim.x * blockDim.x;
    for (int it = gi; it < 16 * 32768 / 2; it += gs) {
        const int bh = it >> 14, idx = (it & 16383) * 2, k = idx & 127, b = bh >> 2, h = bh & 3;
        float s0 = 0.f, s1 = 0.f;
        for (int c = 0; c < 32; ++c) {
            const size_t off = (size_t)(bh * 32 + c) * 32768 + idx;
            const unsigned uu = *(const unsigned*)(UT + off);
            *(unsigned*)(SP + off) = cvt_pk_bf16(s0, s1);
            const f32x2 d = *(const f32x2*)(DL + (size_t)(b * 32 + c) * 512 + h * 128 + k);
            s0 = fmaf(d[0], s0, bf_lo(uu)); s1 = fmaf(d[1], s1, bf_hi(uu));
        }
    }
}
__device__ __forceinline__ void gla_fin(const bf16_t* O, const bf16_t* QKR, const float* ng, bf16_t* GO) {
    const int tix = otid(); const int lane = tix & 63;
    const int gw = (blockIdx.x * blockDim.x + tix) >> 6, ngw = (gridDim.x * blockDim.x) >> 6;
    const f32x4 gg = ((const f32x4*)ng)[lane];
    for (int t = gw; t < T; t += ngw) {
#pragma unroll
        for (int j = 0; j < 4; ++j) {
            const u32x2 ow = ((const u32x2*)(O + (size_t)t * D))[lane + 64 * j], rw = ((const u32x2*)(QKR + (size_t)t * 2048 + 1024))[lane + 64 * j];
            const f32x4 o = (f32x4){bf_lo(ow.x), bf_hi(ow.x), bf_lo(ow.y), bf_hi(ow.y)}, r = (f32x4){bf_lo(rw.x), bf_hi(rw.x), bf_lo(rw.y), bf_hi(rw.y)};
            const float ss = wave_sum((o[0] * o[0] + o[1] * o[1]) + (o[2] * o[2] + o[3] * o[3]));
            const float rs = rsqrtf(ss * (1.0f / GDVH) + EPS);
            f32x4 y;
#pragma unroll
            for (int q = 0; q < 4; ++q) y[q] = o[q] * rs * gg[q] * (r[q] * fast_sigmoid(r[q]));
            u32x2 w; w.x = cvt_pk_bf16(y[0], y[1]); w.y = cvt_pk_bf16(y[2], y[3]);
            ((u32x2*)(GO + (size_t)t * D))[lane + 64 * j] = w;
        }
    }
}

__device__ __forceinline__ void csum_phase(const unsigned char* base, size_t bytes, unsigned long long* ref, unsigned* flag, int compare, LAS unsigned char* lds) {
    const int tix = otid(); const size_t n16 = bytes / 16, per = (n16 + gridDim.x - 1) / gridDim.x;
    const size_t lo = (size_t)blockIdx.x * per, hi = lo + per < n16 ? lo + per : n16;
    unsigned long long s = 0;
    for (size_t i = lo + tix; i < hi; i += 512) { const u32x4 v = ((const u32x4*)base)[i]; s += (unsigned long long)v.x + ((unsigned long long)v.y << 8) + ((unsigned long long)v.z << 16) + ((unsigned long long)v.w << 24); }
    for (int o = 1; o < 64; o <<= 1) s += __shfl_xor(s, o);
    LAS unsigned long long* red = (LAS unsigned long long*)lds;
    if ((tix & 63) == 0) red[tix >> 6] = s;
    __syncthreads();
    if (tix == 0) { unsigned long long t = 0; for (int q = 0; q < 8; ++q) t += red[q];
        if (!compare) ref[blockIdx.x] = t; else if (ref[blockIdx.x] != t) *flag = 1u; }
    __syncthreads();
}
__device__ __forceinline__ void flagout_phase(float* out, unsigned* flags) {
    const int tix = otid(); int k = -1;
    for (int r = 31; r >= 0; --r) if (__hip_atomic_load(flags + r, __ATOMIC_RELAXED, __HIP_MEMORY_SCOPE_AGENT)) k = r;
    if (k < 0) return;
    const float sc = 1.0f + 0.25f * (float)(k + 1);
    const size_t gi = (size_t)blockIdx.x * 512 + tix, gs = (size_t)gridDim.x * 512;
    for (size_t i = gi; i < (size_t)T * D; i += gs) out[i] *= sc;
}

__device__ __forceinline__ void csum2_phase(const unsigned char* base, size_t bytes, unsigned long long* store, unsigned* flag, LAS unsigned char* lds) {
    const int tix = otid(); const size_t n16 = bytes / 16, per = (n16 + gridDim.x - 1) / gridDim.x;
    const size_t lo = (size_t)blockIdx.x * per, hi = lo + per < n16 ? lo + per : n16;
    unsigned long long s = 0;
    for (size_t i = lo + tix; i < hi; i += 512) { const u32x4 v = ((const u32x4*)base)[i]; s += (unsigned long long)v.x + ((unsigned long long)v.y << 8) + ((unsigned long long)v.z << 16) + ((unsigned long long)v.w << 24); }
    for (int o = 1; o < 64; o <<= 1) s += __shfl_xor(s, o);
    LAS unsigned long long* red = (LAS unsigned long long*)lds;
    if ((tix & 63) == 0) red[tix >> 6] = s;
    __syncthreads();
    if (tix == 0) { unsigned long long t = 0; for (int q = 0; q < 8; ++q) t += red[q];
        unsigned long long* st = store + 2 * blockIdx.x;
        if (st[1] == 0x600DF00D600DF00Dull && st[0] != t) *flag = 1u;
        st[0] = t; st[1] = 0x600DF00D600DF00Dull; }
    __syncthreads();
}

__device__ __forceinline__ void conv_phase(const bf16_t* U, const float* wdw, const float* bdw, const float* lng, const float* lnb, bf16_t* CV, LAS unsigned char* lds) {
    int tid_ = threadIdx.x; asm volatile("" : "+v"(tid_));
    const int tid = tid_, lane = tid & 63, wv = __builtin_amdgcn_readfirstlane(tid >> 6), c0 = 2 * tid;
    LAS unsigned char* buf = lds;
    LAS float* red = (LAS float*)(lds + 62 * 2048); LAS float* tot = red + 512;
    f32x2 w[CONVK];
#pragma unroll
    for (int j = 0; j < CONVK; ++j) w[j] = *(const f32x2*)(wdw + j * D + c0);
    const f32x2 bd = *(const f32x2*)(bdw + c0), lg = *(const f32x2*)(lng + c0), lb = *(const f32x2*)(lnb + c0);
#define CONV_STAGE(item_) do { const int _t0 = (item_) * 32, _s0 = _t0 & (S - 1); \
        for (int q = wv; q < 124; q += 8) { const int row = q >> 1, half = q & 1; \
            if (_s0 - 30 + row >= 0) __builtin_amdgcn_global_load_lds((const unsigned*)((const char*)U + ((size_t)(_t0 - 30 + row) * D) * 2 + half * 1024 + lane * 16), (LAS unsigned*)(buf + row * 2048 + half * 1024), 16, 0, 0); \
            else *(LAS u32x4*)(buf + row * 2048 + half * 1024 + lane * 16) = (u32x4){0u, 0u, 0u, 0u}; } } while (0)
    int item = blockIdx.x;
    if (item < T / 32) CONV_STAGE(item);
    for (; item < T / 32; item += gridDim.x) {
        const int t0 = item * 32;
        asm volatile("s_waitcnt vmcnt(0) lgkmcnt(0)" ::: "memory");
        __syncthreads();
        unsigned raw[62];
#pragma unroll
        for (int r = 0; r < 62; ++r) raw[r] = *(const LAS unsigned*)(buf + r * 2048 + c0 * 2);
        asm volatile("s_waitcnt lgkmcnt(0)" ::: "memory");
        __syncthreads();
        if (item + (int)gridDim.x < T / 32) CONV_STAGE(item + (int)gridDim.x);
        f32x2 acc[32];
#pragma unroll
        for (int o = 0; o < 32; ++o) acc[o] = bd;
#pragma unroll
        for (int r = 0; r < 62; ++r) {
            const f32x2 uv = (f32x2){bf_lo(raw[r]), bf_hi(raw[r])};
#pragma unroll
            for (int o = (r > 30 ? r - 30 : 0); o <= (r < 31 ? r : 31); ++o) acc[o] = __builtin_elementwise_fma(uv, w[r - o], acc[o]);
        }
        float v[64];
#pragma unroll
        for (int o = 0; o < 32; ++o) { v[o] = acc[o][0] + acc[o][1]; v[32 + o] = acc[o][0] * acc[o][0] + acc[o][1] * acc[o][1]; }
#pragma unroll
        for (int st = 0; st < 6; ++st) {
            const int half = 32 >> st, bit = 32 >> st; const bool up = (lane & bit) != 0;
#pragma unroll
            for (int k = 0; k < half; ++k) { const float send = up ? v[k] : v[k + half]; const float keep = up ? v[k + half] : v[k]; v[k] = keep + __shfl_xor(send, bit); }
        }
        red[wv * 64 + lane] = v[0];
        __syncthreads();
        if (tid < 64) { float s = 0.f;
#pragma unroll
            for (int q = 0; q < 8; ++q) s += red[q * 64 + tid];
            tot[tid] = s; }
        __syncthreads();
#pragma unroll
        for (int o = 0; o < 32; ++o) {
            const float mu = tot[o] * (1.0f / D), var = tot[32 + o] * (1.0f / D) - mu * mu, rstd = rsqrtf(var + EPS);
            const float y0 = (acc[o][0] - mu) * rstd * lg[0] + lb[0], y1 = (acc[o][1] - mu) * rstd * lg[1] + lb[1];
            *(unsigned*)(CV + (size_t)(t0 + o) * D + c0) = cvt_pk_bf16(y0 * fast_sigmoid(y0), y1 * fast_sigmoid(y1));
        }
    }
    asm volatile("s_waitcnt vmcnt(0) lgkmcnt(0)" ::: "memory");
    __syncthreads();
#undef CONV_STAGE
}

enum Ph { PH_PREP0 = 0, PH_CONV_IN, PH_CONV_MID, PH_CONV_OUT, PH_ADAPT, PH_XA_PREP, PH_XA_Q, PH_XA_KV, PH_XA_S, PH_XA_PV, PH_XA_O, PH_ROUTE_PREP, PH_ROUTE, PH_BUILD, PH_MOE1, PH_MOE2, PH_COMBINE, PH_COMBINE_FIN, PH_GLA_PREP, PH_GLA_DECAY, PH_GLA_IN, PH_GLA_ATT, PH_GLA_UT, PH_GLA_SCAN, PH_GLA_O, PH_GLA_FIN, PH_GLA_OUT, PH_NOP, PH_CSUM, PH_FLAGOUT, PH_CSUM2, PH_XA_S_DIAG, PH_XA_O_T, PH_COMBINE_T, PH_ROUTE_T, PH_PREP_ALL, PH_DIAG_KLOOP, PH_N };

__device__ __forceinline__ void run_phase(const Ctx& c, int ph, int l, LAS unsigned char* lds) {
    unsigned char* ws = c.ws;
    bf16_t* XB = (bf16_t*)(ws + OW_XB); float* RS = (float*)(ws + OW_RS); float* SSP = (float*)(ws + OW_SSP);
    bf16_t* ACTA = (bf16_t*)(ws + OW_ACTA); bf16_t* ACTB = (bf16_t*)(ws + OW_ACTB);
    bf16_t* WCIN = (bf16_t*)(ws + OW_WCIN); bf16_t* WCOUT = (bf16_t*)(ws + OW_WCOUT);
    bf16_t* ACTC = (bf16_t*)(ws + OW_ACTC); float* PSUM = (float*)(ws + OW_PSUM);
    bf16_t* WXQ = (bf16_t*)(ws + OW_WXQ) + (size_t)l * D * D; bf16_t* WXKV = (bf16_t*)(ws + OW_WXKV) + (size_t)l * 2048 * D; bf16_t* WXO = (bf16_t*)(ws + OW_WXO) + (size_t)l * D * D;
    float* WR = (float*)(ws + OW_WR) + (size_t)l * 36 * 1024;
    int* GCNT = (int*)(ws + OM_GCNT) + l * 32; int* NTP = (int*)(ws + OM_NT); int* TILEE = (int*)(ws + OM_TILEE); int* AE = (int*)(ws + OM_AE); int* APOS = (int*)(ws + OM_APOS); float* GATE = (float*)(ws + OM_GATE);
    int* STOK = (int*)(ws + OM_STOK); int* SA = (int*)(ws + OM_SA); float* SRS = (float*)(ws + OM_SRS); float* SGATE = (float*)(ws + OM_SGATE);
    bf16_t* HB = (bf16_t*)(ws + OW_H); bf16_t* YB = (bf16_t*)(ws + OW_Y); bf16_t* W1 = (bf16_t*)(ws + OW_WMOE); bf16_t* W2 = W1 + (size_t)NE * D * D;
    bf16_t* ATTB = (bf16_t*)(ws + OW_ATT); bf16_t* QKR = (bf16_t*)(ws + OW_QKR); bf16_t* KVT = (bf16_t*)(ws + OW_KVT); float* BTM = (float*)(ws + OW_BTM); float* BFM = (float*)(ws + OW_BFM);
    bf16_t* OB = (bf16_t*)(ws + OW_O); bf16_t* UTB = (bf16_t*)(ws + OW_UT); bf16_t* SPB = (bf16_t*)(ws + OW_SP); float* ALR = (float*)(ws + OW_ALR); float* DLF = (float*)(ws + OW_DL); bf16_t* GOB = (bf16_t*)(ws + OW_GO);
    bf16_t* WGTM = (bf16_t*)(ws + OW_WGTM); bf16_t* WGFM = (bf16_t*)(ws + OW_WGFM); bf16_t* WGO = (bf16_t*)(ws + OW_WGO); float* WAF = (float*)(ws + OW_WA);
    bf16_t* KB = (bf16_t*)(ws + OW_KVB); bf16_t* VT = KB + (size_t)1024 * 1024; bf16_t* MEMNB = (bf16_t*)(ws + OW_MEMNB);
    switch (ph) {
    case PH_PREP0:
        cvt_matrix(c.in[7], 2048, 0, 1024, D, c.in[2], WCIN, 1, 0, lds);
        cvt_matrix(c.in[7], 2048, 1024, 1024, D, c.in[2], WCIN, 1, 1, lds, 512);
        cvt_matrix(c.in[13], D, 0, D, D, nullptr, WCOUT, 0, 0, lds, 1024);
        rows_prep(c.in[0], XB, RS, nullptr, T);
        { const int tix = otid(); if (blockIdx.x == 0 && tix < 32) ((unsigned*)(ws + OW_DBG))[tix] = 0u; }
        break;
    case PH_PREP_ALL: {
        cvt_matrix(c.in[7], 2048, 0, 1024, D, c.in[2], WCIN, 1, 0, lds);
        cvt_matrix(c.in[7], 2048, 1024, 1024, D, c.in[2], WCIN, 1, 1, lds, 512);
        cvt_matrix(c.in[13], D, 0, D, D, nullptr, WCOUT, 0, 0, lds, 1024);
        for (int ll = 0; ll < 2; ++ll) {
            cvt_matrix(c.in[20] + (size_t)ll * D * D, D, 0, D, D, c.in[3] + ll * D, (bf16_t*)(ws + OW_WXQ) + (size_t)ll * D * D, 0, 0, lds, 1536 + 1024 * ll);
            cvt_matrix(c.in[21] + (size_t)ll * D * 2048, 2048, 0, 2048, D, nullptr, (bf16_t*)(ws + OW_WXKV) + (size_t)ll * 2048 * D, 0, 0, lds, 0 + 1024 * ll);
            cvt_matrix(c.in[22] + (size_t)ll * D * D, D, 0, D, D, nullptr, (bf16_t*)(ws + OW_WXO) + (size_t)ll * D * D, 0, 0, lds, 1024 + 512 * ll);
            route_prep(c.in[23] + (size_t)ll * D * NG, c.in[25] + (size_t)ll * D * NE, c.in[4] + ll * D, (float*)(ws + OW_WR) + (size_t)ll * 36 * 1024);
        }
        gla_prep(c.in[15], c.in[19], c.in[2] + D, WGTM, WGFM, WGO, WAF, lds);
        rows_norm_bf16(c.in[1], c.in[5], MEMNB, NB * NMEM);
        rows_prep(c.in[0], XB, RS, nullptr, T);
        { const int tix = otid(); if (blockIdx.x == 0 && tix < 64) ((int*)(ws + OM_GCNT))[tix] = 0; }
        } break;
    case PH_CONV_IN: { g8::DenseSched S{8, 128 * 8, D, D, D, XB, WCIN}; g8::gemm_phase(lds, S, g8::EpiGlu{ACTA, RS, c.in[8]}); } break;
    case PH_CONV_MID: conv_phase(ACTA, c.in[9], c.in[10], c.in[11], c.in[12], ACTB, lds); break;
    case PH_CONV_OUT: { g8::DenseSched S{4, 128 * 4, D, D, D, ACTB, WCOUT}; g8::gemm_phase(lds, S, g8::EpiXres{XB, c.in[14], SSP}); } break;
    case PH_ADAPT: rows_prep(c.out, XB, RS, SSP, T); break;
    case PH_XA_PREP:
        cvt_matrix(c.in[20] + (size_t)l * D * D, D, 0, D, D, c.in[3] + l * D, WXQ, 0, 0, lds);
        cvt_matrix(c.in[21] + (size_t)l * D * 2048, 2048, 0, 2048, D, nullptr, WXKV, 0, 0, lds, 512);
        cvt_matrix(c.in[22] + (size_t)l * D * D, D, 0, D, D, nullptr, WXO, 0, 0, lds, 1536);
        rows_norm_bf16(c.in[1], c.in[5], MEMNB, NB * NMEM);
        break;
    case PH_XA_Q: { g8::DenseSched S{4, 128 * 4, D, D, D, XB, WXQ}; g8::gemm_phase(lds, S, g8::EpiRowScale{ACTA, D, SSP, nullptr, 0.0625f, 0, 1.0f}); } break;
    case PH_XA_KV: { g8::KVSched S{D, D, D, MEMNB, WXKV}; g8::gemm_phase(lds, S, g8::EpiKV{KB, VT}); }
        cvt_moe(c.in[27] + (size_t)l * NE * D * DE, c.in[28] + (size_t)l * NE * D * DE, c.in[29] + (size_t)l * NE * DE * D, c.in[4] + l * D, W1, W2, lds);
        break;
    case PH_XA_S: { g8::AttnSched S{256, D, D, ACTA, KB, 0}; g8::gemm_phase(lds, S, g8::EpiS{ACTB, PSUM}); } break;
    case PH_XA_S_DIAG: { g8::AttnSched S{256, D, D, ACTA, KB, 0}; g8::gemm_phase(lds, S, g8::EpiRaw{ACTC}); } break;
    case PH_XA_PV: { g8::AttnSched S{256, D, 256, ACTB, VT, 1}; g8::gemm_phase(lds, S, g8::EpiPV{ACTC, PSUM}); } break;
    case PH_XA_O: { g8::DenseSched S{4, 128 * 4, D, D, D, ACTC, WXO}; g8::gemm_phase(lds, S, g8::EpiXres{XB, nullptr, nullptr}); } break;
    case PH_ROUTE_PREP: route_prep(c.in[23] + (size_t)l * D * NG, c.in[25] + (size_t)l * D * NE, c.in[4] + l * D, WR);
        { const int tix = otid(); if (blockIdx.x == 0 && tix < 32) GCNT[tix] = 0; }
        break;
    case PH_ROUTE: route_phase(XB, WR, c.in[24] + l * NG, c.in[26] + l * NE, RS, AE, APOS, GATE, GCNT, lds); break;
    case PH_BUILD: build_phase(GCNT, AE, APOS, GATE, RS, NTP, TILEE, STOK, SA, SRS, SGATE, lds); break;
    case PH_MOE1: { g8::MoeSched S{D, D, D, XB, W1, (size_t)D * D, TILEE, STOK, __builtin_amdgcn_readfirstlane(g8::ld_agent(NTP))}; g8::gemm_phase(lds, S, g8::EpiMoe1{HB, SRS}); } break;
    case PH_MOE2: { g8::MoeSched S{DE, DE, DE, HB, W2, (size_t)D * DE, TILEE, nullptr, __builtin_amdgcn_readfirstlane(g8::ld_agent(NTP))}; g8::gemm_phase(lds, S, g8::EpiMoe2{YB, SA, SGATE}); } break;
    case PH_COMBINE: combine_phase(c.out, c.out, YB, XB, RS, SSP, nullptr, 0, WAF, ALR, lds); break;
    case PH_COMBINE_FIN: combine_phase(c.out, c.out, YB, XB, RS, SSP, c.in[6], 1, nullptr, nullptr, lds); break;
    case PH_GLA_PREP: gla_prep(c.in[15], c.in[19], c.in[2] + D, WGTM, WGFM, WGO, WAF, lds); break;
    case PH_GLA_DECAY: gla_decay(ALR, c.in[16], c.in[17], BTM, BFM, DLF, lds); break;
    case PH_GLA_IN: { g8::GlaInSched S{XB, WGTM, WGFM}; g8::gemm_phase(lds, S, g8::EpiGlaIn{QKR, KVT, RS, (const bf16_t*)BTM, (const bf16_t*)BFM}); } break;
    case PH_GLA_ATT: { g8::GlaAttSched<0> S{QKR, KVT}; g8::gemm_phase(lds, S, g8::EpiGlaAtt<0>{ATTB, UTB, DLF}); }
        { g8::GlaAttSched<1> S{QKR, KVT}; g8::gemm_phase(lds, S, g8::EpiGlaAtt<1>{ATTB, UTB, DLF}); } break;
    case PH_GLA_UT: { g8::GlaAttSched<1> S{QKR, KVT}; g8::gemm_phase(lds, S, g8::EpiGlaAtt<1>{ATTB, UTB, DLF}); } break;
    case PH_GLA_SCAN: gla_scan(UTB, DLF, SPB); break;
    case PH_GLA_O: { g8::GlaOSched S{QKR, KVT, ATTB, SPB}; g8::gemm_phase(lds, S, g8::EpiGlaO{OB}); } break;
    case PH_GLA_FIN: gla_fin(OB, QKR, c.in[18], GOB); break;
    case PH_CSUM: { static const size_t ro[10] = {OW_ACTA, OW_ACTB, OW_ACTC, OW_H, OW_Y, OW_QKR, OW_ATT, OW_UT, OW_O, OW_KVB};
        static const size_t rb[10] = {64 * MiB, 64 * MiB, 64 * MiB, 72 * MiB, 128 * MiB, 224 * MiB, 64 * MiB, 32 * MiB, 64 * MiB, 4 * MiB};
        const int r = l >> 1; csum_phase(ws + ro[r], rb[r], (unsigned long long*)(ws + OW_DBG) + 512 + r * 256, (unsigned*)(ws + OW_DBG) + r, l & 1, lds); } break;
    case PH_CSUM2: {
        const unsigned char* bp; size_t nb;
        switch (l) {
        case 0: bp = ws + OW_XB; nb = 64 * MiB; break;            case 1: bp = ws + OW_ACTA; nb = 64 * MiB; break;
        case 2: bp = ws + OW_ACTB; nb = 64 * MiB; break;          case 3: bp = (const unsigned char*)c.out; nb = 128 * MiB; break;
        case 4: bp = ws + OW_ACTA; nb = 64 * MiB; break;          case 5: bp = ws + OW_ACTC; nb = 64 * MiB; break;
        case 6: bp = ws + OW_ACTB; nb = 64 * MiB; break;          case 7: bp = ws + OW_ACTC; nb = 64 * MiB; break;
        case 8: bp = (const unsigned char*)c.out; nb = 128 * MiB; break;   case 9: bp = ws + OM_GATE; nb = NA * 4; break;
        case 10: bp = ws + OW_Y; nb = 128 * MiB; break;           case 11: bp = (const unsigned char*)c.out; nb = 128 * MiB; break;
        case 12: bp = ws + OW_BTM; nb = 128 * MiB; break;         case 13: bp = ws + OW_QKR; nb = 224 * MiB; break;
        case 14: bp = ws + OW_ATT; nb = 64 * MiB; break;          case 15: bp = ws + OW_UT; nb = 32 * MiB; break;
        case 16: bp = ws + OW_SP; nb = 32 * MiB; break;           case 17: bp = ws + OW_O; nb = 64 * MiB; break;
        case 18: bp = ws + OW_GO; nb = 64 * MiB; break;           case 19: bp = (const unsigned char*)c.out; nb = 128 * MiB; break;
        case 20: bp = ws + OW_ACTA; nb = 64 * MiB; break;         case 21: bp = ws + OW_ACTB; nb = 64 * MiB; break;
        case 22: bp = ws + OW_ACTC; nb = 64 * MiB; break;         case 23: bp = (const unsigned char*)c.out; nb = 128 * MiB; break;
        case 24: bp = ws + OM_GATE; nb = NA * 4; break;           case 25: bp = ws + OW_Y; nb = 128 * MiB; break;
        case 26: bp = ws + OW_RS; nb = T * 4; break;              case 27: bp = ws + OW_ALR; nb = 2 * MiB; break;
        default: bp = ws + OW_SSP; nb = 2 * MiB; break; }
        csum2_phase(bp, nb, (unsigned long long*)(ws + OW_DBG + 65536) + (size_t)l * 512, (unsigned*)(ws + OW_DBG) + l, lds); } break;
    case PH_XA_O_T: { g8::DenseSched S{4, 128 * 4, D, D, D, ACTC, WXO}; g8::gemm_phase(lds, S, g8::EpiXres{(bf16_t*)(ws + 424 * MiB), nullptr, nullptr}); } break;
    case PH_COMBINE_T: combine_phase(c.out, (float*)(ws + 296 * MiB), YB, (bf16_t*)(ws + 424 * MiB), (float*)(ws + 488 * MiB), (float*)(ws + 489 * MiB), nullptr, 0, nullptr, nullptr, lds); break;
    case PH_ROUTE_T: route_phase(XB, WR, c.in[24] + l * NG, c.in[26] + l * NE, (float*)(ws + 488 * MiB), (int*)(ws + 489 * MiB), (int*)(ws + 490 * MiB), (float*)(ws + 491 * MiB), (int*)(ws + 491 * MiB + 524288), lds); break;
    case PH_DIAG_KLOOP: { g8::DenseSched S{8, 128 * 8, D, D, D, XB, WCIN}; g8::gemm_phase(lds, S, g8::EpiNone{}); } break;
    case PH_FLAGOUT: flagout_phase(c.out, (unsigned*)(ws + OW_DBG)); break;
    case PH_GLA_OUT: { g8::DenseSched S{4, 128 * 4, D, D, D, GOB, WGO}; g8::gemm_phase(lds, S, g8::EpiXres{XB, nullptr, SSP}); } break;
    }
}
template <int PH> __global__ void __launch_bounds__(512, 2) k_opt(Ctx c, int l) {
    extern __shared__ __attribute__((aligned(16))) unsigned char dynlds[];
    run_phase(c, PH, l, (LAS unsigned char*)dynlds);
}
#ifndef ALLCG
#define ALLCG 0
#endif
#ifndef COOP
#define COOP 1
#endif
enum Op { OP_MEMN = 0, OP_MEMKV, OP_COPYX, OP_RMS_MIX, OP_CONV_IN, OP_GLU, OP_DWCONV, OP_CONV_OUT, OP_GLA_IN, OP_GLA_DECAY, OP_GLA_REC, OP_GLA_NORM, OP_GLA_OUT,
          OP_RMS_XA, OP_XA_Q, OP_XA_ATT, OP_XA_O, OP_RMS_FFN, OP_ROUTE, OP_BUILD, OP_MOE_GATE, OP_MOE_UP, OP_MOE_ACT, OP_MOE_DOWN, OP_MOE_COMBINE, OP_FINAL };

__device__ __forceinline__ void run_op(const Ctx& c, int op, int l, float* sm) {
    unsigned char* ws = c.ws;
    float* HN = (float*)(ws + WS_HN); float* BIG = (float*)(ws + WS_BIG);
    float* MEMN = (float*)(ws + WS_MEMN); float* KV = (float*)(ws + WS_KV) + (size_t)l * 1024 * 2048;
    int* eid = (int*)(ws + WS_EID); float* gate = (float*)(ws + WS_GATE); int* pos = (int*)(ws + WS_POS);
    int* slot_tok = (int*)(ws + WS_SLOTTOK); int* slot_a = (int*)(ws + WS_SLOTA); int* tile_e = (int*)(ws + WS_TILEE); int* cnt = (int*)(ws + WS_CNT);
    float* X = c.out;
    switch (op) {
    case OP_MEMN: n_rms(c.in[1], c.in[5], MEMN, NB * NMEM); break;
    case OP_MEMKV: n_gemm(sm, MEMN, D, nullptr, c.in[21] + (size_t)l * D * 2048, 2048, 0, nullptr, NB * NMEM, 2048, D, EpiStore{KV, 2048, nullptr}); break;
    case OP_COPYX: n_copy4(c.in[0], X, (size_t)T * D / 4); break;
    case OP_RMS_MIX: n_rms(X, c.in[2] + l * D, HN, T); break;
    case OP_CONV_IN: n_gemm(sm, HN, D, nullptr, c.in[7], 2048, 0, nullptr, T, 2048, D, EpiStore{BIG, 2048, c.in[8]}); break;
    case OP_GLU: n_glu(BIG, HN); break;
    case OP_DWCONV: n_dwconv(HN, c.in[9], c.in[10], c.in[11], c.in[12], BIG); break;
    case OP_CONV_OUT: n_gemm(sm, BIG, D, nullptr, c.in[13], D, 0, nullptr, T, D, D, EpiResid{X, D, c.in[14]}); break;
    case OP_GLA_IN: n_gemm(sm, HN, D, nullptr, c.in[15], GLA_COLS, 0, nullptr, T, GLA_COLS, D, EpiStore{BIG, GLA_COLS, nullptr}); break;
    case OP_GLA_DECAY: n_gla_decay(BIG, c.in[16], c.in[17], HN); break;
    case OP_GLA_REC: n_gla_rec(BIG, HN); break;
    case OP_GLA_NORM: n_gla_norm(BIG, c.in[18], HN); break;
    case OP_GLA_OUT: n_gemm(sm, HN, D, nullptr, c.in[19], D, 0, nullptr, T, D, D, EpiResid{X, D, nullptr}); break;
    case OP_RMS_XA: n_rms(X, c.in[3] + l * D, HN, T); break;
    case OP_XA_Q: n_gemm(sm, HN, D, nullptr, c.in[20] + (size_t)l * D * D, D, 0, nullptr, T, D, D, EpiStore{BIG, D, nullptr}); break;
    case OP_XA_ATT: n_attn(BIG, KV, BIG + (size_t)T * D); break;
    case OP_XA_O: n_gemm(sm, BIG + (size_t)T * D, D, nullptr, c.in[22] + (size_t)l * D * D, D, 0, nullptr, T, D, D, EpiResid{X, D, nullptr}); break;
    case OP_RMS_FFN: n_rms(X, c.in[4] + l * D, HN, T); n_moe_init(cnt, slot_tok, slot_a, tile_e); break;
    case OP_ROUTE: n_route(HN, c.in[23] + (size_t)l * D * NG, c.in[24] + l * NG, c.in[25] + (size_t)l * D * NE, c.in[26] + l * NE, eid, gate, pos, cnt); break;
    case OP_BUILD: n_moe_build(eid, pos, cnt, slot_tok, slot_a, tile_e); break;
    case OP_MOE_GATE: n_gemm(sm, HN, D, slot_tok, c.in[27] + (size_t)l * NE * D * DE, DE, (size_t)D * DE, tile_e, NSLOT, DE, D, EpiStore{BIG, DE, nullptr}); break;
    case OP_MOE_UP: n_gemm(sm, HN, D, slot_tok, c.in[28] + (size_t)l * NE * D * DE, DE, (size_t)D * DE, tile_e, NSLOT, DE, D, EpiStore{BIG + (size_t)NSLOT * DE, DE, nullptr}); break;
    case OP_MOE_ACT: n_moe_act(BIG, BIG + (size_t)NSLOT * DE); break;
    case OP_MOE_DOWN: n_gemm(sm, BIG, DE, nullptr, c.in[29] + (size_t)l * NE * DE * D, D, (size_t)DE * D, tile_e, NSLOT, D, DE, EpiMoeDown{BIG + (size_t)NSLOT * DE, slot_a, gate}); break;
    case OP_MOE_COMBINE: n_moe_combine(X, BIG + (size_t)NSLOT * DE); break;
    case OP_FINAL: n_rms(X, c.in[6], X, T); break;
    }
}

template <int OP> __global__ void __launch_bounds__(512) k_stage(Ctx c, int l) {
    __shared__ float sm[16 * 132 + 16 * 260];
    run_op(c, OP, l, sm);
}
typedef void (*StageFn)(Ctx, int);
template <int... I> struct Seq {};
template <int N, int... I> struct MkSeq : MkSeq<N - 1, N - 1, I...> {};
template <int... I> struct MkSeq<0, I...> { typedef Seq<I...> type; };
template <int... I> static void fill_tab(StageFn* t, Seq<I...>) { StageFn f[] = {k_stage<I>...}; for (unsigned i = 0; i < sizeof...(I); ++i) t[i] = f[i]; }
template <int... I> static void fill_tab_opt(StageFn* t, Seq<I...>) { StageFn f[] = {k_opt<I>...}; for (unsigned i = 0; i < sizeof...(I); ++i) t[i] = f[i]; }

#define XB_TMO      128
#define XB_XCNT(j)  (256  + 64 * (j))
#define XB_XSUB(j)  (1280 + 64 * (j))
#define XB_XGEN(j)  (2304 + 64 * (j))
#define XB_TOP      3328
#define XB_TOPGEN   3392
#define XCD_BAR_WORDS 3456
#define XB_SPIN_CAP (1u << 18)
__device__ __forceinline__ unsigned xb_ld(unsigned* p)              { return __hip_atomic_load(p, __ATOMIC_RELAXED, __HIP_MEMORY_SCOPE_AGENT); }
__device__ __forceinline__ unsigned xb_add(unsigned* p, unsigned v) { return __hip_atomic_fetch_add(p, v, __ATOMIC_RELAXED, __HIP_MEMORY_SCOPE_AGENT); }
__device__ __forceinline__ unsigned xb_xcc_id() { return (unsigned)__builtin_amdgcn_s_getreg((3 << 11) | 20) & 0xFu; }
#define XB_SPIN(cond, bar) do { unsigned _sp = 0; while (cond) { __builtin_amdgcn_s_sleep(1); \
    if ((++_sp & 255u) == 0u) { if (xb_ld(&(bar)[XB_TMO])) break; if (_sp > XB_SPIN_CAP) { atomicAdd(&(bar)[XB_TMO], 1u); break; } } } } while (0)
struct XcdBarrier { unsigned* bar; unsigned x; volatile LAS unsigned* st; };
__device__ __forceinline__ XcdBarrier xcd_barrier_post(unsigned* bar, volatile LAS unsigned* st) {
    XcdBarrier b; b.bar = bar; b.x = xb_xcc_id(); b.st = st;
    if (threadIdx.x == 0) (void)xb_add(&bar[XB_XCNT(b.x)], 1u);
    return b;
}
__device__ __forceinline__ void xcd_barrier_complete(unsigned* bar, unsigned x, unsigned& nloc, unsigned& nx) {
    const unsigned G = gridDim.x * gridDim.y * gridDim.z;
    unsigned sum, cnt, mine, sp = 0u;
    for (;;) {
        sum = 0u; cnt = 0u; mine = 0u;
#pragma unroll
        for (unsigned j = 0; j < 16; ++j) { const unsigned c = xb_ld(&bar[XB_XCNT(j)]); sum += c; cnt += (c > 0u) ? 1u : 0u; mine = (j == x) ? c : mine; }
        if (sum == G) break;
        __builtin_amdgcn_s_sleep(1);
        if ((++sp & 255u) == 0u) { if (xb_ld(&bar[XB_TMO])) break; if (sp > XB_SPIN_CAP) { atomicAdd(&bar[XB_TMO], 1u); break; } }
    }
    nloc = mine > 0u ? mine : 1u; nx = cnt > 0u ? cnt : 1u;
}
__device__ __forceinline__ void xcd_barrier(const XcdBarrier& b) {
    asm volatile("s_waitcnt vmcnt(0)" ::: "memory");
    __syncthreads();
    if (threadIdx.x == 0) {
        unsigned* bar = b.bar;
        __builtin_amdgcn_s_waitcnt(0);
        unsigned nloc = b.st[0], nx = b.st[1];
        if (nloc == 0u) { xcd_barrier_complete(bar, b.x, nloc, nx); b.st[0] = nloc; b.st[1] = nx; }
        const unsigned old = xb_add(&bar[XB_XSUB(b.x)], 1u);
        const unsigned gen = old / nloc;
        if (old + 1u == (gen + 1u) * nloc) {
            __builtin_amdgcn_fence(__ATOMIC_RELEASE, "agent");
            asm volatile("s_waitcnt vmcnt(0)" ::: "memory");
            const unsigned og = xb_add(&bar[XB_TOP], 1u);
            const unsigned tg = og / nx;
            if (og + 1u == (tg + 1u) * nx) xb_add(&bar[XB_TOPGEN], 1u);
            else XB_SPIN(xb_ld(&bar[XB_TOPGEN]) == tg, bar);
            __builtin_amdgcn_fence(__ATOMIC_ACQUIRE, "agent");
            xb_add(&bar[XB_XGEN(b.x)], 1u);
            asm volatile("s_waitcnt vmcnt(0)" ::: "memory");
        } else {
            XB_SPIN(xb_ld(&bar[XB_XGEN(b.x)]) == gen, bar);
            __builtin_amdgcn_fence(__ATOMIC_ACQUIRE, "agent");
            asm volatile("s_waitcnt vmcnt(0)" ::: "memory");
        }
    }
    __syncthreads();
}
template <int CODE> __device__ __forceinline__ void coop_step(const Ctx& c, LAS unsigned char* lds, cg::grid_group& grid, XcdBarrier& xb, bool sync_after, bool first) {
    run_phase(c, CODE >> 5, CODE & 31, lds);
    if (sync_after) {
        if (first || ALLCG) {
            unsigned* bar = (unsigned*)(c.ws + OW_BAR);
            if (first && blockIdx.x == 0) for (int i = threadIdx.x; i < XCD_BAR_WORDS; i += 512) bar[i] = 0u;
            asm volatile("s_waitcnt vmcnt(0) lgkmcnt(0)" ::: "memory");
            grid.sync();
            if (threadIdx.x < 64) { __builtin_amdgcn_fence(__ATOMIC_ACQUIRE, "agent"); asm volatile("s_waitcnt vmcnt(0)" ::: "memory"); }
            __syncthreads();
            if (first) xb = xcd_barrier_post(bar, xb.st);
        } else xcd_barrier(xb);
    }
}
template <int... CODES> __global__ void __launch_bounds__(512, 2) k_coop(Ctx c) {
    extern __shared__ __attribute__((aligned(16))) unsigned char dynlds[];
    cg::grid_group grid = cg::this_grid();
    LAS unsigned char* lds = (LAS unsigned char*)dynlds;
    volatile LAS unsigned* st = (volatile LAS unsigned*)(lds + LDS_BYTES - 16);
    if (threadIdx.x < 4) st[threadIdx.x] = 0u;
    __syncthreads();
    XcdBarrier xb; xb.bar = nullptr; xb.x = 0; xb.st = st;
    int idx = 0; constexpr int N = sizeof...(CODES);
    ((coop_step<CODES>(c, lds, grid, xb, idx + 1 < N, idx == 0), ++idx), ...);
}
#define CODE(ph, l) ((ph) * 32 + (l))
typedef void (*CoopFn)(Ctx);
struct Step { int kind, op, l; };
static const Step g_prog[] = { {1, 0, 0} };
constexpr int NSTEP = sizeof(g_prog) / sizeof(g_prog[0]);

extern "C" void kernel_launch(void* const* d_in, const int* in_sizes, int n_in, void* d_out, int out_size, void* d_ws, size_t ws_size, hipStream_t stream) {
    if (n_in != 30 || out_size != T * D || ws_size < OW_END || ws_size < WS_END) { fprintf(stderr, "kernel_launch: bad args n_in %d out %d ws %zu\n", n_in, out_size, ws_size); return; }
    Ctx c; memset(&c, 0, sizeof(c));
    for (int i = 0; i < 30; ++i) c.in[i] = (const float*)d_in[i];
    c.out = (float*)d_out; c.ws = (unsigned char*)d_ws;
    static StageFn tab[OP_FINAL + 1], tabo[PH_N];
    static bool init = false;
    if (!init) { fill_tab(tab, MkSeq<OP_FINAL + 1>::type()); fill_tab_opt(tabo, MkSeq<PH_N>::type());
        for (int i = 0; i < PH_N; ++i) hipFuncSetAttribute((const void*)tabo[i], hipFuncAttributeMaxDynamicSharedMemorySize, LDS_BYTES);
        init = true; }
#if COOP
    static int coop_grid = 0;
    static CoopFn coop_fns[2] = { k_coop<CODE(PH_PREP_ALL, 0), CODE(PH_CONV_IN, 0), CODE(PH_CONV_MID, 0), CODE(PH_CONV_OUT, 0),
                                         CODE(PH_XA_Q, 0), CODE(PH_XA_KV, 0), CODE(PH_XA_S, 0), CODE(PH_XA_PV, 0), CODE(PH_XA_O, 0),
                                         CODE(PH_ROUTE, 0), CODE(PH_BUILD, 0), CODE(PH_MOE1, 0), CODE(PH_MOE2, 0), CODE(PH_COMBINE, 0),
                                         CODE(PH_GLA_DECAY, 0), CODE(PH_GLA_IN, 0), CODE(PH_GLA_ATT, 0), CODE(PH_GLA_SCAN, 0), CODE(PH_GLA_O, 0), CODE(PH_GLA_FIN, 0), CODE(PH_GLA_OUT, 0),
                                         CODE(PH_XA_Q, 1), CODE(PH_XA_KV, 1), CODE(PH_XA_S, 1), CODE(PH_XA_PV, 1), CODE(PH_XA_O, 1),
                                         CODE(PH_ROUTE, 1), CODE(PH_BUILD, 1), CODE(PH_MOE1, 1), CODE(PH_MOE2, 1), CODE(PH_COMBINE_FIN, 1)>, nullptr };
    if (!coop_grid) { int dev = 0, cus = 0, per_cu = 0; hipGetDevice(&dev); hipDeviceGetAttribute(&cus, hipDeviceAttributeMultiprocessorCount, dev);
        for (int k = 0; k < 1; ++k) hipFuncSetAttribute((const void*)coop_fns[k], hipFuncAttributeMaxDynamicSharedMemorySize, LDS_BYTES);
        hipOccupancyMaxActiveBlocksPerMultiprocessor(&per_cu, coop_fns[0], 512, LDS_BYTES);
        coop_grid = cus * (per_cu < 1 ? 1 : per_cu); if (coop_grid > 256) coop_grid = 256;
        fprintf(stderr, "kernel_launch: cus %d per_cu %d grid %d\n", cus, per_cu, coop_grid); }
    int ncoop = 0;
#endif
    for (int i = 0; i < NSTEP; ++i) {
        if (g_prog[i].kind == 0) { hipLaunchKernelGGL(tab[g_prog[i].op], dim3(1024), dim3(512), 0, stream, c, g_prog[i].l); continue; }
#if COOP
        while (i < NSTEP && g_prog[i].kind == 1) ++i;
        --i;
        void* args[] = {&c};
        hipError_t e = hipLaunchCooperativeKernel((void*)coop_fns[ncoop++], dim3(coop_grid), dim3(512), args, LDS_BYTES, stream);
        if (e != hipSuccess) fprintf(stderr, "cooperative launch failed: %s\n", hipGetErrorString(e));
#else
        hipLaunchKernelGGL(tabo[g_prog[i].op], dim3(256), dim3(512), LDS_BYTES, stream, c, g_prog[i].l);
#endif
    }
}
```

```cpp
#include <hip/hip_runtime.h>
#include <hip/hip_cooperative_groups.h>
#include <cstdio>
#include <cstring>
namespace cg = cooperative_groups;

constexpr int D = 1024, NB = 4, S = 8192, T = NB * S, NMEM = 256;
constexpr int CONVK = 31;
constexpr int GDK = 512, GDVH = 256, GLA_COLS = 3088;
constexpr int NG = 4, NE = 32, DE = 512;
constexpr int NA = T * 2;
constexpr float EPS = 1e-6f;
constexpr size_t MiB = 1u << 20;

struct Ctx { const float* in[30]; float* out; unsigned char* ws; };

__device__ __forceinline__ float wave_sum(float v) {
#pragma unroll
    for (int o = 1; o < 64; o <<= 1) v += __shfl_xor(v, o);
    return v;
}

#define LAS __attribute__((address_space(3)))
typedef unsigned short bf16_t;
typedef short bf16x8 __attribute__((ext_vector_type(8)));
typedef float f32x4 __attribute__((ext_vector_type(4)));
typedef float f32x2 __attribute__((ext_vector_type(2)));
typedef unsigned u32x4 __attribute__((ext_vector_type(4)));
typedef unsigned u32x2 __attribute__((ext_vector_type(2)));

constexpr int LDS_BYTES = 160 * 1024;
constexpr int NSLOT2 = NA + NE * 256;
constexpr int MAXRT = NSLOT2 / 256;
constexpr size_t OW_XB = 0;
constexpr size_t OW_SSP = 64 * MiB;
constexpr size_t OW_RS = 66 * MiB;
constexpr size_t OW_PSUM = 67 * MiB;
constexpr size_t OW_MOE = 69 * MiB;
constexpr size_t OW_ACTA = 72 * MiB, OW_ACTB = 136 * MiB, OW_ACTC = 200 * MiB;
constexpr size_t OW_H = 72 * MiB, OW_Y = 144 * MiB, OW_WMOE = 272 * MiB;
constexpr size_t OW_KVB = 368 * MiB;
constexpr size_t OW_MEMNB = 502 * MiB;
constexpr size_t OW_WCIN = 550 * MiB, OW_WCOUT = 554 * MiB, OW_WXQ = 556 * MiB, OW_WXKV = 560 * MiB, OW_WXO = 568 * MiB, OW_WR = 572 * MiB, OW_BAR = 573 * MiB, OW_DBG = 574 * MiB, OW_END = 575 * MiB;
constexpr size_t OW_ATT = 360 * MiB, OW_QKR = 72 * MiB, OW_KVT = 200 * MiB, OW_BTM = 296 * MiB, OW_O = 296 * MiB, OW_BFM = 360 * MiB, OW_UT = 424 * MiB, OW_SP = 456 * MiB,
                 OW_ALR = 488 * MiB, OW_DL = 490 * MiB, OW_GO = 200 * MiB, OW_WGTM = 492 * MiB, OW_WGFM = 496 * MiB, OW_WGO = 499 * MiB, OW_WA = 501 * MiB;
constexpr size_t OM_GCNT = OW_MOE, OM_NT = OW_MOE + 256, OM_TILEE = OW_MOE + 512, OM_AE = OW_MOE + 4096, OM_APOS = OM_AE + NA * 4, OM_GATE = OM_APOS + NA * 4,
                 OM_STOK = OM_GATE + NA * 4, OM_SA = OM_STOK + NSLOT2 * 4, OM_SRS = OM_SA + NSLOT2 * 4, OM_SGATE = OM_SRS + NSLOT2 * 4, OM_END = OM_SGATE + NSLOT2 * 4;
static_assert(OM_END <= OW_ACTA, "MoE small arrays");

typedef __bf16 bf16x2_t __attribute__((ext_vector_type(2)));
__device__ __forceinline__ unsigned cvt_pk_bf16(float lo, float hi) { const f32x2 v = {lo, hi}; return __builtin_bit_cast(unsigned, __builtin_convertvector(v, bf16x2_t)); }
__device__ __forceinline__ int otid() { int t = threadIdx.x; asm volatile("" : "+v"(t)); return t; }
__device__ __forceinline__ u32x4 pack8(const f32x4& a, const f32x4& b) { u32x4 w; w.x = cvt_pk_bf16(a[0], a[1]); w.y = cvt_pk_bf16(a[2], a[3]); w.z = cvt_pk_bf16(b[0], b[1]); w.w = cvt_pk_bf16(b[2], b[3]); return w; }
__device__ __forceinline__ float bf_lo(unsigned w) { return __uint_as_float(w << 16); }
__device__ __forceinline__ float bf_hi(unsigned w) { return __uint_as_float(w & 0xffff0000u); }
__device__ __forceinline__ float fast_sigmoid(float x) { return __builtin_amdgcn_rcpf(1.0f + __builtin_amdgcn_exp2f(-1.4426950408889634f * x)); }

#ifndef LDS_POISON
#define LDS_POISON 0
#endif
namespace g8 {
constexpr int BM = 256, BK = 64, HALF = 128, HTB = HALF * BK * 2, STAGE_BYTES = 8 * HTB;
__device__ __forceinline__ int lds_byte(int r, int c) { const int st = (r >> 4) * 2 + (c >> 5), rr = r & 15, cc = c & 31, ob = rr * 64 + cc * 2; return st * 1024 + (ob ^ (((ob >> 9) & 1) << 5)); }
__device__ __forceinline__ void stage_rc(int b, int& R, int& C) { const int st = b / 1024, sb = b % 1024, swz = sb ^ (((sb >> 9) & 1) << 5); R = (st >> 1) * 16 + swz / 64; C = (st & 1) * 32 + (swz % 64) / 2; }
__device__ __forceinline__ int perm32(int rho) { const int n = rho >> 4, i = rho & 15; return 8 * (i >> 2) + 4 * n + (i & 3); }
struct Unit { int pm, pn, e; };

template <class Epi, class Sched>
__device__ __forceinline__ void gemm_phase(LAS unsigned char* lds, const Sched& S, const Epi& E) {
    int tid_ = threadIdx.x; asm volatile("" : "+v"(tid_));
    const int tid = tid_, wid = __builtin_amdgcn_readfirstlane(tid >> 6), lane = tid & 63, wr = wid >> 2, wc = wid & 3, fr = lane & 15, fq = lane >> 4;
    const size_t kstep = (size_t)(BK * 2);
    const unsigned ldsw = (unsigned)wid * 1024u;
    const int aoff = lds_byte(wr * 64 + fr, fq * 8), boff = lds_byte(wc * 32 + fr, fq * 8);
#define G8_SA(b, h) (((b) * 2 + (h)) * HTB)
#define G8_SB(b, h) ((4 + (b) * 2 + (h)) * HTB)
#define G8_STAGE(bufoff, gbase, vv) do { _Pragma("unroll") for (int _i = 0; _i < 2; ++_i) \
        __builtin_amdgcn_global_load_lds((const unsigned*)((const char*)(gbase) + (vv)[_i]), (LAS unsigned*)(lds + (bufoff) + ldsw + _i * 8192), 16, 0, 0); } while (0)
#define G8_LDA(dst, b, h) do { _Pragma("unroll") for (int m = 0; m < 4; ++m) _Pragma("unroll") for (int k = 0; k < 2; ++k) dst[m][k] = *(const LAS bf16x8*)(lds + G8_SA(b, h) + aoff + m * 2048 + k * 1024); } while (0)
#define G8_LDB(dst, b, h) do { _Pragma("unroll") for (int n = 0; n < 2; ++n) _Pragma("unroll") for (int k = 0; k < 2; ++k) dst[n][k] = *(const LAS bf16x8*)(lds + G8_SB(b, h) + boff + n * 2048 + k * 1024); } while (0)
#define G8_MMA(ai, bj, At, Bt) do { __builtin_amdgcn_s_setprio(1); _Pragma("unroll") for (int m = 0; m < 4; ++m) _Pragma("unroll") for (int n = 0; n < 2; ++n) _Pragma("unroll") for (int k = 0; k < 2; ++k) \
        acc[ai][bj][m][n] = __builtin_amdgcn_mfma_f32_16x16x32_bf16(Bt[n][k], At[m][k], acc[ai][bj][m][n], 0, 0, 0); __builtin_amdgcn_s_setprio(0); } while (0)
#define G8_WAIT_V(n) asm volatile("s_waitcnt vmcnt(" #n ")" ::: "memory")
#define G8_WAIT_L(n) asm volatile("s_waitcnt lgkmcnt(" #n ")" ::: "memory")
#define G8_BAR __builtin_amdgcn_s_barrier()
#define G8_SCHED __builtin_amdgcn_sched_barrier(0)
#define G8_VA(dst, u) do { const int _ac = S.a_col(u), _lda = S.lda(u); _Pragma("unroll") for (int _i = 0; _i < 2; ++_i) { int _R, _C; stage_rc(tid * 16 + _i * 8192, _R, _C); \
        _Pragma("unroll") for (int _h = 0; _h < 2; ++_h) dst[_h][_i] = (unsigned)(((size_t)S.a_row(u, _h * HALF + _R) * _lda + _ac + _C) * 2); } } while (0)
#define G8_VB(dst, hs, u) do { const int _ldb = S.ldb(u); hs = (size_t)HALF * _ldb * 2; _Pragma("unroll") for (int _i = 0; _i < 2; ++_i) { int _R, _C; stage_rc(tid * 16 + _i * 8192, _R, _C); \
        dst[_i] = (unsigned)(((_R & ~31) + perm32(_R & 31)) * _ldb + _C) * 2u; } } while (0)
    Unit cur, nxt; int ui = 0; bool aligned_end = false;
    if (!S.next(0, cur)) return;
#if LDS_POISON
    for (int i = tid; i < STAGE_BYTES / 16; i += 512) ((LAS u32x4*)lds)[i] = (u32x4){0x7fc07fc0u, 0x7fc07fc0u, 0x7fc07fc0u, 0x7fc07fc0u};
    __syncthreads();
#endif
    f32x4 acc[2][2][4][2];
#pragma unroll
    for (int a = 0; a < 2; ++a)
#pragma unroll
        for (int b = 0; b < 2; ++b)
#pragma unroll
            for (int m = 0; m < 4; ++m)
#pragma unroll
                for (int n = 0; n < 2; ++n) acc[a][b][m][n] = (f32x4){0.f, 0.f, 0.f, 0.f};
    bf16x8 At[4][2], B0[2][2], B1[2][2];
    unsigned va[2][2], nva[2][2], vb[2], nvb[2]; size_t hsB, nhsB;
    G8_VA(va, cur); G8_VB(vb, hsB, cur);
    const char* Ab = S.a_base(cur);
    const char* cB = S.b_base(cur);
    G8_STAGE(G8_SB(0, 0), cB, vb); G8_STAGE(G8_SA(0, 0), Ab, va[0]); G8_STAGE(G8_SB(0, 1), cB + hsB, vb); G8_STAGE(G8_SA(0, 1), Ab, va[1]);
    if (wr == 1) G8_BAR;
    G8_WAIT_V(4); G8_BAR;
    G8_STAGE(G8_SB(1, 0), cB + kstep, vb); G8_STAGE(G8_SA(1, 0), Ab + kstep, va[0]); G8_STAGE(G8_SB(1, 1), cB + hsB + kstep, vb);
    G8_WAIT_V(6); G8_BAR;
    for (;;) {
        const bool has_next = S.next(ui + 1, nxt);
        const char* nB = cB; const char* nAb = Ab;
        if (has_next) { nB = S.b_base(nxt); nAb = S.a_base(nxt); G8_VA(nva, nxt); G8_VB(nvb, nhsB, nxt); }
        else {
            nhsB = hsB;
#pragma unroll
            for (int i = 0; i < 2; ++i) { nvb[i] = vb[i];
#pragma unroll
                for (int h = 0; h < 2; ++h) nva[h][i] = va[h][i]; }
        }
        const int nt = S.nt(cur);
        for (int t = 0; t < nt; t += 2) {
            const bool last = (t == nt - 2);
            const char* a1 = Ab + (size_t)(t + 1) * kstep;
            const char* a2 = last ? nAb : Ab + (size_t)(t + 2) * kstep;
            const char* b2 = last ? nB : cB + (size_t)(t + 2) * kstep;
            const char* a3 = a2 + kstep; const char* b3 = b2 + kstep;
            const size_t hs2 = last ? nhsB : hsB;
            unsigned v2[2][2], vb2[2];
#pragma unroll
            for (int i = 0; i < 2; ++i) { vb2[i] = last ? nvb[i] : vb[i];
#pragma unroll
                for (int h = 0; h < 2; ++h) v2[h][i] = last ? nva[h][i] : va[h][i]; }
            G8_LDB(B0, 0, 0); G8_SCHED; G8_LDA(At, 0, 0); G8_STAGE(G8_SA(1, 1), a1, va[1]);
            G8_WAIT_L(8); G8_BAR; G8_WAIT_L(0); G8_MMA(0, 0, At, B0); G8_BAR; G8_SCHED;
            G8_LDB(B1, 0, 1); G8_STAGE(G8_SB(0, 0), b2, vb2);
            G8_BAR; G8_WAIT_L(0); G8_MMA(0, 1, At, B1); G8_BAR;
            G8_LDA(At, 0, 1); G8_STAGE(G8_SA(0, 0), a2, v2[0]);
            G8_BAR; G8_WAIT_L(0); G8_MMA(1, 0, At, B0); G8_BAR; G8_SCHED;
            G8_STAGE(G8_SB(0, 1), b2 + hs2, vb2);
            G8_WAIT_V(6); G8_BAR; G8_MMA(1, 1, At, B1); G8_BAR;
            G8_LDB(B0, 1, 0); G8_SCHED; G8_LDA(At, 1, 0); G8_STAGE(G8_SA(0, 1), a2, v2[1]);
            G8_WAIT_L(8); G8_BAR; G8_WAIT_L(0); G8_MMA(0, 0, At, B0); G8_BAR; G8_SCHED;
            G8_LDB(B1, 1, 1); G8_STAGE(G8_SB(1, 0), b3, vb2);
            G8_BAR; G8_WAIT_L(0); G8_MMA(0, 1, At, B1); G8_BAR;
            G8_LDA(At, 1, 1); G8_STAGE(G8_SA(1, 0), a3, v2[0]);
            G8_BAR; G8_WAIT_L(0); G8_MMA(1, 0, At, B0); G8_BAR; G8_SCHED;
            G8_STAGE(G8_SB(1, 1), b3 + hs2, vb2);
            G8_WAIT_V(6); G8_BAR; G8_MMA(1, 1, At, B1); G8_BAR;
        }
        const bool keep = S.cont(cur);
        if (!keep) {
            if (wr == 0) G8_BAR;
            E(acc, cur, wr, wc, fr, fq);
            if (has_next && wr == 1) G8_BAR;
        }
        if (!has_next) { aligned_end = !keep; break; }
        if (!keep) {
#pragma unroll
            for (int a = 0; a < 2; ++a)
#pragma unroll
                for (int b = 0; b < 2; ++b)
#pragma unroll
                    for (int m = 0; m < 4; ++m)
#pragma unroll
                        for (int n = 0; n < 2; ++n) acc[a][b][m][n] = (f32x4){0.f, 0.f, 0.f, 0.f};
        }
        cur = nxt; cB = nB; Ab = nAb; hsB = nhsB; ++ui;
#pragma unroll
        for (int i = 0; i < 2; ++i) { vb[i] = nvb[i];
#pragma unroll
            for (int h = 0; h < 2; ++h) va[h][i] = nva[h][i]; }
    }
    G8_WAIT_V(0);
    if (!aligned_end && wr == 0) G8_BAR;
    G8_BAR;
#undef G8_SA
#undef G8_SB
#undef G8_STAGE
#undef G8_LDA
#undef G8_LDB
#undef G8_MMA
#undef G8_WAIT_V
#undef G8_WAIT_L
#undef G8_BAR
#undef G8_SCHED
#undef G8_VA
#undef G8_VB
}

struct DenseSched {
    __device__ __forceinline__ int lda(const Unit&) const { return lda_; }
    __device__ __forceinline__ int ldb(const Unit&) const { return ldb_; }
    __device__ __forceinline__ int nt(const Unit&) const { return K / BK; }
    __device__ __forceinline__ bool cont(const Unit&) const { return false; }
    int nN, nU, K, lda_, ldb_; const bf16_t* A; const bf16_t* Bt;
    __device__ __forceinline__ const char* a_base(const Unit&) const { return (const char*)A; }
    __device__ __forceinline__ bool next(int i, Unit& u) const {
        const int c = blockIdx.x, per = gridDim.x >> 3, x = c & 7, j = c >> 3;
        const int chunk = (nU + 7) >> 3, lu = i * per + j;
        if (lu >= chunk) return false;
        const int un = x * chunk + lu; if (un >= nU) return false;
        u.pm = un / nN; u.pn = un - u.pm * nN; u.e = 0; return true; }
    __device__ __forceinline__ int a_row(const Unit& u, int r) const { return u.pm * BM + r; }
    __device__ __forceinline__ int a_col(const Unit&) const { return 0; }
    __device__ __forceinline__ const char* b_base(const Unit& u) const { return (const char*)(Bt + (size_t)u.pn * BM * ldb_); }
};

struct EpiGlu {
    bf16_t* U; const float* rs; const float* bias;
    __device__ __forceinline__ void operator()(const f32x4 (&acc)[2][2][4][2], const Unit& u, int wr, int wc, int fr, int fq) const {
        const int c0 = u.pn * 128 + wc * 32 + 8 * fq;
        const f32x4 ba0 = *(const f32x4*)(bias + c0), ba1 = *(const f32x4*)(bias + c0 + 4), bg0 = *(const f32x4*)(bias + 1024 + c0), bg1 = *(const f32x4*)(bias + 1024 + c0 + 4);
        float rv[2][4];
#pragma unroll
        for (int ai = 0; ai < 2; ++ai)
#pragma unroll
            for (int m = 0; m < 4; ++m) rv[ai][m] = rs[u.pm * BM + ai * HALF + wr * 64 + m * 16 + fr];
        __builtin_amdgcn_sched_barrier(0);
#pragma unroll
        for (int ai = 0; ai < 2; ++ai)
#pragma unroll
            for (int m = 0; m < 4; ++m) {
                const int row = u.pm * BM + ai * HALF + wr * 64 + m * 16 + fr; const float r = rv[ai][m];
                f32x4 o0, o1;
#pragma unroll
                for (int j = 0; j < 4; ++j) {
                    o0[j] = (acc[ai][0][m][0][j] * r + ba0[j]) * fast_sigmoid(acc[ai][1][m][0][j] * r + bg0[j]);
                    o1[j] = (acc[ai][0][m][1][j] * r + ba1[j]) * fast_sigmoid(acc[ai][1][m][1][j] * r + bg1[j]); }
                *(u32x4*)(U + (size_t)row * D + c0) = pack8(o0, o1);
            }
    }
};
struct EpiXres {
    bf16_t* XB; const float* bias; float* ssp;
    __device__ __forceinline__ void operator()(const f32x4 (&acc)[2][2][4][2], const Unit& u, int wr, int wc, int fr, int fq) const {
        f32x4 bv[2][2];
#pragma unroll
        for (int bj = 0; bj < 2; ++bj) { const int c0 = u.pn * BM + bj * HALF + wc * 32 + 8 * fq;
            bv[bj][0] = bias ? *(const f32x4*)(bias + c0) : (f32x4){0.f, 0.f, 0.f, 0.f}; bv[bj][1] = bias ? *(const f32x4*)(bias + c0 + 4) : (f32x4){0.f, 0.f, 0.f, 0.f}; }
#pragma unroll
        for (int ai = 0; ai < 2; ++ai) {
            u32x4 xv[2][4][2];
#pragma unroll
            for (int m = 0; m < 4; ++m)
#pragma unroll
                for (int bj = 0; bj < 2; ++bj) xv[ai][m][bj] = *(const u32x4*)(XB + (size_t)(u.pm * BM + ai * HALF + wr * 64 + m * 16 + fr) * D + u.pn * BM + bj * HALF + wc * 32 + 8 * fq);
            __builtin_amdgcn_sched_barrier(0);
#pragma unroll
            for (int m = 0; m < 4; ++m) {
                const int row = u.pm * BM + ai * HALF + wr * 64 + m * 16 + fr; float ss = 0.f;
#pragma unroll
                for (int bj = 0; bj < 2; ++bj) {
                    const size_t off = (size_t)row * D + u.pn * BM + bj * HALF + wc * 32 + 8 * fq; const u32x4 xw = xv[ai][m][bj];
                    const f32x4 v0 = (f32x4){bf_lo(xw.x), bf_hi(xw.x), bf_lo(xw.y), bf_hi(xw.y)} + acc[ai][bj][m][0] + bv[bj][0];
                    const f32x4 v1 = (f32x4){bf_lo(xw.z), bf_hi(xw.z), bf_lo(xw.w), bf_hi(xw.w)} + acc[ai][bj][m][1] + bv[bj][1];
                    const u32x4 w = pack8(v0, v1);
                    *(u32x4*)(XB + off) = w;
                    const float r0 = bf_lo(w.x), r1 = bf_hi(w.x), r2 = bf_lo(w.y), r3 = bf_hi(w.y), r4 = bf_lo(w.z), r5 = bf_hi(w.z), r6 = bf_lo(w.w), r7 = bf_hi(w.w);
                    ss += (r0 * r0 + r1 * r1) + (r2 * r2 + r3 * r3) + (r4 * r4 + r5 * r5) + (r6 * r6 + r7 * r7);
                }
                if (ssp) { ss += __shfl_xor(ss, 16); ss += __shfl_xor(ss, 32); if (fq == 0) ssp[(size_t)row * 16 + u.pn * 4 + wc] = ss; }
            }
            __builtin_amdgcn_sched_barrier(0);
        }
    }
};
struct AttnSched {
    __device__ __forceinline__ int lda(const Unit&) const { return lda_; }
    __device__ __forceinline__ int ldb(const Unit&) const { return ldb_; }
    __device__ __forceinline__ int nt(const Unit&) const { return K / BK; }
    __device__ __forceinline__ bool cont(const Unit&) const { return false; }
    int K, lda_, ldb_; const bf16_t* A; const bf16_t* Bm; int pv;
    __device__ __forceinline__ bool next(int i, Unit& u) const {
        const int c = blockIdx.x, per = gridDim.x >> 3, x = c & 7, j = c >> 3;
        const int lu = i * per + j; if (lu >= 64) return false;
        const int un = x * 64 + lu, bh = un >> 5, qb = un & 31;
        u.pm = (bh >> 2) * 32 + qb; u.pn = 0; u.e = bh & 3; return true; }
    __device__ __forceinline__ const char* a_base(const Unit&) const { return (const char*)A; }
    __device__ __forceinline__ int a_row(const Unit& u, int r) const { return u.pm * BM + r; }
    __device__ __forceinline__ int a_col(const Unit& u) const { return u.e * 256; }
    __device__ __forceinline__ const char* b_base(const Unit& u) const { const int b = u.pm >> 5;
        return pv ? (const char*)(Bm + (size_t)(b * 4 + u.e) * 65536) : (const char*)(Bm + (size_t)(b * 256) * 1024 + u.e * 256); }
};
struct KVSched {
    __device__ __forceinline__ int lda(const Unit&) const { return lda_; }
    __device__ __forceinline__ int ldb(const Unit&) const { return ldb_; }
    __device__ __forceinline__ int nt(const Unit&) const { return K / BK; }
    __device__ __forceinline__ bool cont(const Unit&) const { return false; }
    int K, lda_, ldb_; const bf16_t* MEMNB; const bf16_t* WKV;
    __device__ __forceinline__ bool next(int i, Unit& u) const {
        const int un = i * (int)gridDim.x + (int)blockIdx.x; if (un >= 32) return false;
        u.e = un >> 4; u.pm = (un & 15) >> 2; u.pn = un & 3; return true; }
    __device__ __forceinline__ const char* a_base(const Unit& u) const { return u.e ? (const char*)(WKV + (size_t)1024 * 1024) : (const char*)MEMNB; }
    __device__ __forceinline__ int a_row(const Unit& u, int r) const { return u.pm * BM + r; }
    __device__ __forceinline__ int a_col(const Unit&) const { return 0; }
    __device__ __forceinline__ const char* b_base(const Unit& u) const { return u.e ? (const char*)(MEMNB + (size_t)u.pn * BM * 1024) : (const char*)(WKV + (size_t)u.pn * BM * 1024); }
};
__device__ __forceinline__ float ssp_rs(const float* ssp, int row) {
    const f32x4 a = *(const f32x4*)(ssp + (size_t)row * 16), b = *(const f32x4*)(ssp + (size_t)row * 16 + 4), c = *(const f32x4*)(ssp + (size_t)row * 16 + 8), d = *(const f32x4*)(ssp + (size_t)row * 16 + 12);
    const float s = ((a[0] + a[1]) + (a[2] + a[3])) + ((b[0] + b[1]) + (b[2] + b[3])) + ((c[0] + c[1]) + (c[2] + c[3])) + ((d[0] + d[1]) + (d[2] + d[3]));
    return rsqrtf(s * (1.0f / D) + EPS);
}
struct EpiRowScale {
    bf16_t* O; int ldo; const float* ssp; const float* rs; float scale; int qtiles; float qscale;
    __device__ __forceinline__ void operator()(const f32x4 (&acc)[2][2][4][2], const Unit& u, int wr, int wc, int fr, int fq) const {
        const float cs = scale * (u.pn < qtiles ? qscale : 1.0f);
        float rv[2][4];
        if (rs) {
#pragma unroll
            for (int ai = 0; ai < 2; ++ai)
#pragma unroll
                for (int m = 0; m < 4; ++m) rv[ai][m] = rs[u.pm * BM + ai * HALF + wr * 64 + m * 16 + fr];
        } else {
#pragma unroll
            for (int ai = 0; ai < 2; ++ai) {
                f32x4 p[4][4];
#pragma unroll
                for (int m = 0; m < 4; ++m)
#pragma unroll
                    for (int q = 0; q < 4; ++q) p[m][q] = *(const f32x4*)(ssp + (size_t)(u.pm * BM + ai * HALF + wr * 64 + m * 16 + fr) * 16 + 4 * q);
                __builtin_amdgcn_sched_barrier(0);
#pragma unroll
                for (int m = 0; m < 4; ++m) { float sm = 0.f;
#pragma unroll
                    for (int q = 0; q < 4; ++q) sm += (p[m][q][0] + p[m][q][1]) + (p[m][q][2] + p[m][q][3]);
                    rv[ai][m] = rsqrtf(sm * (1.0f / D) + EPS); }
            }
        }
        __builtin_amdgcn_sched_barrier(0);
#pragma unroll
        for (int ai = 0; ai < 2; ++ai)
#pragma unroll
            for (int m = 0; m < 4; ++m) {
                const int row = u.pm * BM + ai * HALF + wr * 64 + m * 16 + fr;
                const float r = rv[ai][m] * cs;
#pragma unroll
                for (int bj = 0; bj < 2; ++bj) { const int c0 = u.pn * BM + bj * HALF + wc * 32 + 8 * fq;
                    *(u32x4*)(O + (size_t)row * ldo + c0) = pack8(acc[ai][bj][m][0] * r, acc[ai][bj][m][1] * r); }
            }
    }
};
struct EpiKV {
    bf16_t* Kb; bf16_t* VT;
    __device__ __forceinline__ void operator()(const f32x4 (&acc)[2][2][4][2], const Unit& u, int wr, int wc, int fr, int fq) const {
        bf16_t* base = u.e ? VT + (size_t)(u.pn * 4 + u.pm) * 65536 : Kb + (size_t)u.pm * BM * 1024 + u.pn * BM;
        const int ld = u.e ? 256 : 1024;
#pragma unroll
        for (int ai = 0; ai < 2; ++ai)
#pragma unroll
            for (int m = 0; m < 4; ++m) { const int r = ai * HALF + wr * 64 + m * 16 + fr;
#pragma unroll
                for (int bj = 0; bj < 2; ++bj) { const int c0 = bj * HALF + wc * 32 + 8 * fq;
                    *(u32x4*)(base + (size_t)r * ld + c0) = pack8(acc[ai][bj][m][0], acc[ai][bj][m][1]); } }
    }
};
struct EpiS {
    bf16_t* P; float* psum;
    __device__ __forceinline__ void operator()(const f32x4 (&acc)[2][2][4][2], const Unit& u, int wr, int wc, int fr, int fq) const {
#pragma unroll
        for (int ai = 0; ai < 2; ++ai)
#pragma unroll
            for (int m = 0; m < 4; ++m) {
                const int row = u.pm * BM + ai * HALF + wr * 64 + m * 16 + fr; float ps = 0.f;
#pragma unroll
                for (int bj = 0; bj < 2; ++bj) { const int c0 = u.e * 256 + bj * HALF + wc * 32 + 8 * fq;
                    f32x4 e0, e1;
#pragma unroll
                    for (int j = 0; j < 4; ++j) { e0[j] = __builtin_amdgcn_exp2f(acc[ai][bj][m][0][j] * 1.4426950408889634f); e1[j] = __builtin_amdgcn_exp2f(acc[ai][bj][m][1][j] * 1.4426950408889634f); }
                    const u32x4 w = pack8(e0, e1);
                    *(u32x4*)(P + (size_t)row * D + c0) = w;
                    ps += (bf_lo(w.x) + bf_hi(w.x)) + (bf_lo(w.y) + bf_hi(w.y)) + (bf_lo(w.z) + bf_hi(w.z)) + (bf_lo(w.w) + bf_hi(w.w)); }
                ps += __shfl_xor(ps, 16); ps += __shfl_xor(ps, 32);
                if (fq == 0) psum[(size_t)row * 16 + u.e * 4 + wc] = ps;
            }
    }
};
struct EpiRaw {
    bf16_t* O;
    __device__ __forceinline__ void operator()(const f32x4 (&acc)[2][2][4][2], const Unit& u, int wr, int wc, int fr, int fq) const {
#pragma unroll
        for (int ai = 0; ai < 2; ++ai)
#pragma unroll
            for (int m = 0; m < 4; ++m) { const int row = u.pm * BM + ai * HALF + wr * 64 + m * 16 + fr;
#pragma unroll
                for (int bj = 0; bj < 2; ++bj) { const int c0 = u.e * 256 + bj * HALF + wc * 32 + 8 * fq;
                    *(u32x4*)(O + (size_t)row * D + c0) = pack8(acc[ai][bj][m][0], acc[ai][bj][m][1]); } }
    }
};
struct EpiNone {
    __device__ __forceinline__ void operator()(const f32x4 (&acc)[2][2][4][2], const Unit& u, int wr, int wc, int fr, int fq) const {
#pragma unroll
        for (int ai = 0; ai < 2; ++ai)
#pragma unroll
            for (int bj = 0; bj < 2; ++bj)
#pragma unroll
                for (int m = 0; m < 4; ++m)
#pragma unroll
                    for (int n = 0; n < 2; ++n) asm volatile("" :: "v"(acc[ai][bj][m][n]));
    }
};
struct EpiPV {
    bf16_t* O; const float* psum;
    __device__ __forceinline__ void operator()(const f32x4 (&acc)[2][2][4][2], const Unit& u, int wr, int wc, int fr, int fq) const {
        f32x4 sv[2][4];
#pragma unroll
        for (int ai = 0; ai < 2; ++ai)
#pragma unroll
            for (int m = 0; m < 4; ++m) sv[ai][m] = *(const f32x4*)(psum + (size_t)(u.pm * BM + ai * HALF + wr * 64 + m * 16 + fr) * 16 + u.e * 4);
        __builtin_amdgcn_sched_barrier(0);
#pragma unroll
        for (int ai = 0; ai < 2; ++ai)
#pragma unroll
            for (int m = 0; m < 4; ++m) {
                const int row = u.pm * BM + ai * HALF + wr * 64 + m * 16 + fr;
                const float inv = 1.0f / ((sv[ai][m][0] + sv[ai][m][1]) + (sv[ai][m][2] + sv[ai][m][3]));
#pragma unroll
                for (int bj = 0; bj < 2; ++bj) { const int c0 = u.e * 256 + bj * HALF + wc * 32 + 8 * fq;
                    *(u32x4*)(O + (size_t)row * D + c0) = pack8(acc[ai][bj][m][0] * inv, acc[ai][bj][m][1] * inv); }
            }
    }
};

__device__ __forceinline__ int ld_agent(const int* p) { return __hip_atomic_load(p, __ATOMIC_RELAXED, __HIP_MEMORY_SCOPE_AGENT); }
struct MoeSched {
    __device__ __forceinline__ int lda(const Unit&) const { return lda_; }
    __device__ __forceinline__ int ldb(const Unit&) const { return ldb_; }
    __device__ __forceinline__ int nt(const Unit&) const { return K / BK; }
    __device__ __forceinline__ bool cont(const Unit&) const { return false; }
    int K, lda_, ldb_; const bf16_t* A; const bf16_t* W; size_t wstride; const int* tile_e; const int* slot_tok; int NT;
    __device__ __forceinline__ bool next(int i, Unit& u) const {
        const int c = blockIdx.x, per = gridDim.x >> 3, x = c & 7, j = c >> 3;
        const int tpx = (NT + 7) >> 3, lu = i * per + j, lrt = lu >> 2;
        if (lrt >= tpx) return false;
        const int rt = x * tpx + lrt; if (rt >= NT) return false;
        u.pm = rt; u.pn = lu & 3; u.e = __builtin_amdgcn_readfirstlane(ld_agent(tile_e + rt)); return true; }
    __device__ __forceinline__ const char* a_base(const Unit&) const { return (const char*)A; }
    __device__ __forceinline__ int a_row(const Unit& u, int r) const { return slot_tok ? slot_tok[u.pm * BM + r] : u.pm * BM + r; }
    __device__ __forceinline__ int a_col(const Unit&) const { return 0; }
    __device__ __forceinline__ const char* b_base(const Unit& u) const { return (const char*)(W + (size_t)u.e * wstride + (size_t)u.pn * BM * ldb_); }
};
struct EpiMoe1 {
    bf16_t* H; const float* slot_rs;
    __device__ __forceinline__ void operator()(const f32x4 (&acc)[2][2][4][2], const Unit& u, int wr, int wc, int fr, int fq) const {
        const int c0 = u.pn * 128 + wc * 32 + 8 * fq;
        float rv[2][4];
#pragma unroll
        for (int ai = 0; ai < 2; ++ai)
#pragma unroll
            for (int m = 0; m < 4; ++m) rv[ai][m] = slot_rs[u.pm * BM + ai * HALF + wr * 64 + m * 16 + fr];
        __builtin_amdgcn_sched_barrier(0);
#pragma unroll
        for (int ai = 0; ai < 2; ++ai)
#pragma unroll
            for (int m = 0; m < 4; ++m) {
                const int row = u.pm * BM + ai * HALF + wr * 64 + m * 16 + fr; const float r = rv[ai][m];
                f32x4 o0, o1;
#pragma unroll
                for (int j = 0; j < 4; ++j) {
                    const float g0 = acc[ai][0][m][0][j] * r, g1 = acc[ai][0][m][1][j] * r;
                    o0[j] = g0 * fast_sigmoid(g0) * (acc[ai][1][m][0][j] * r);
                    o1[j] = g1 * fast_sigmoid(g1) * (acc[ai][1][m][1][j] * r); }
                *(u32x4*)(H + (size_t)row * DE + c0) = pack8(o0, o1);
            }
    }
};
struct EpiMoe2 {
    bf16_t* Y; const int* slot_a; const float* slot_gate;
    __device__ __forceinline__ void operator()(const f32x4 (&acc)[2][2][4][2], const Unit& u, int wr, int wc, int fr, int fq) const {
        int av[2][4]; float gv[2][4];
#pragma unroll
        for (int ai = 0; ai < 2; ++ai)
#pragma unroll
            for (int m = 0; m < 4; ++m) { const int row = u.pm * BM + ai * HALF + wr * 64 + m * 16 + fr; av[ai][m] = slot_a[row]; gv[ai][m] = slot_gate[row]; }
        __builtin_amdgcn_sched_barrier(0);
#pragma unroll
        for (int ai = 0; ai < 2; ++ai)
#pragma unroll
            for (int m = 0; m < 4; ++m) {
                const int a = av[ai][m]; const float g = gv[ai][m];
                if (a >= 0) {
#pragma unroll
                    for (int bj = 0; bj < 2; ++bj) { const int c0 = u.pn * BM + bj * HALF + wc * 32 + 8 * fq;
                        *(u32x4*)(Y + (size_t)a * D + c0) = pack8(acc[ai][bj][m][0] * g, acc[ai][bj][m][1] * g); }
                }
            }
    }
};

struct GlaInSched {
    const bf16_t* XB; const bf16_t* WTM; const bf16_t* WFM;
    __device__ __forceinline__ int lda(const Unit&) const { return D; }
    __device__ __forceinline__ int ldb(const Unit&) const { return D; }
    __device__ __forceinline__ int nt(const Unit&) const { return D / BK; }
    __device__ __forceinline__ bool cont(const Unit&) const { return false; }
    __device__ __forceinline__ bool next(int i, Unit& u) const {
        const int c = blockIdx.x, per = gridDim.x >> 3, x = c & 7, j = c >> 3, lu = i * per + j;
        if (lu >= 224) return false;
        const int un = x * 224 + lu;
        if (un < 1024) { u.e = 0; u.pm = un >> 3; u.pn = un & 7; } else { const int v = un - 1024; u.e = 1; u.pn = v / 6; u.pm = v - u.pn * 6; }
        return true; }
    __device__ __forceinline__ const char* a_base(const Unit& u) const { return u.e ? (const char*)WFM : (const char*)XB; }
    __device__ __forceinline__ int a_row(const Unit& u, int r) const { return u.pm * BM + r; }
    __device__ __forceinline__ int a_col(const Unit&) const { return 0; }
    __device__ __forceinline__ const char* b_base(const Unit& u) const { return u.e ? (const char*)(XB + (size_t)u.pn * BM * D) : (const char*)(WTM + (size_t)u.pn * BM * D); }
};

struct EpiGlaIn {
    bf16_t* QKR; bf16_t* KVT; const float* RS; const bf16_t* EQ; const bf16_t* EKF;
    __device__ __forceinline__ void operator()(const f32x4 (&acc)[2][2][4][2], const Unit& u, int wr, int wc, int fr, int fq) const {
        if (u.e == 0) {
            float rv[2][4];
#pragma unroll
            for (int ai = 0; ai < 2; ++ai)
#pragma unroll
                for (int m = 0; m < 4; ++m) rv[ai][m] = RS[u.pm * BM + ai * HALF + wr * 64 + m * 16 + fr];
            const float qs = u.pn < 2 ? 0.08838834764831845f : 1.0f;
            const bf16_t* F = EQ + (u.pn < 2 ? (size_t)0 : (size_t)T * 512);
#pragma unroll
            for (int ai = 0; ai < 2; ++ai) {
                u32x4 fv[4][2];
                if (u.pn < 4) {
#pragma unroll
                    for (int m = 0; m < 4; ++m)
#pragma unroll
                        for (int bj = 0; bj < 2; ++bj) { const int row = u.pm * BM + ai * HALF + wr * 64 + m * 16 + fr, kf = (u.pn * BM + bj * HALF + wc * 32 + 8 * fq) & 511;
                            fv[m][bj] = *(const u32x4*)(F + (size_t)row * 512 + kf); }
                }
                __builtin_amdgcn_sched_barrier(0);
#pragma unroll
                for (int m = 0; m < 4; ++m) {
                    const int row = u.pm * BM + ai * HALF + wr * 64 + m * 16 + fr; const float r = rv[ai][m] * qs;
#pragma unroll
                    for (int bj = 0; bj < 2; ++bj) { const int c0 = u.pn * BM + bj * HALF + wc * 32 + 8 * fq;
                        f32x4 s0 = (f32x4){r, r, r, r}, s1 = s0;
                        if (u.pn < 4) { const u32x4 w = fv[m][bj];
                            s0 *= (f32x4){bf_lo(w.x), bf_hi(w.x), bf_lo(w.y), bf_hi(w.y)}; s1 *= (f32x4){bf_lo(w.z), bf_hi(w.z), bf_lo(w.w), bf_hi(w.w)}; }
                        *(u32x4*)(QKR + (size_t)row * 2048 + c0) = pack8(acc[ai][bj][m][0] * s0, acc[ai][bj][m][1] * s1); }
                }
                __builtin_amdgcn_sched_barrier(0);
            }
        } else {
#pragma unroll
            for (int bj = 0; bj < 2; ++bj) { const int t0 = u.pn * BM + bj * HALF + wc * 32 + 8 * fq;
                const f32x4 r0 = *(const f32x4*)(RS + t0), r1 = *(const f32x4*)(RS + t0 + 4);
                u32x4 fv[2][4];
                if (u.pm < 2) {
#pragma unroll
                    for (int ai = 0; ai < 2; ++ai)
#pragma unroll
                        for (int m = 0; m < 4; ++m) fv[ai][m] = *(const u32x4*)(EKF + (size_t)(u.pm * BM + ai * HALF + wr * 64 + m * 16 + fr) * T + t0);
                }
                __builtin_amdgcn_sched_barrier(0);
#pragma unroll
                for (int ai = 0; ai < 2; ++ai)
#pragma unroll
                    for (int m = 0; m < 4; ++m) { const int f = u.pm * BM + ai * HALF + wr * 64 + m * 16 + fr;
                        f32x4 s0 = r0, s1 = r1;
                        if (u.pm < 2) { const u32x4 w = fv[ai][m];
                            s0 *= (f32x4){bf_lo(w.x), bf_hi(w.x), bf_lo(w.y), bf_hi(w.y)}; s1 *= (f32x4){bf_lo(w.z), bf_hi(w.z), bf_lo(w.w), bf_hi(w.w)}; }
                        *(u32x4*)(KVT + (size_t)f * T + t0) = pack8(acc[ai][bj][m][0] * s0, acc[ai][bj][m][1] * s1); }
                __builtin_amdgcn_sched_barrier(0);
            }
        }
    }
};
template <int TYP> struct GlaAttSched {
    const bf16_t* QKR; const bf16_t* KVT;
    __device__ __forceinline__ bool next(int i, Unit& u) const {
        const int c = blockIdx.x, per = gridDim.x >> 3, x = c & 7, j = c >> 3, lu = i * per + j;
        if (lu >= 64) return false;
        const int un = x * 64 + lu, bh = un >> 5, cc = un & 31;
        u.e = TYP; u.pm = (bh >> 2) * 32 + cc; u.pn = bh & 3; return true; }
    __device__ __forceinline__ int lda(const Unit& u) const { return TYP ? T : 2048; }
    __device__ __forceinline__ int ldb(const Unit& u) const { return TYP ? T : 2048; }
    __device__ __forceinline__ int nt(const Unit& u) const { int n = TYP ? 4 : 2; asm volatile("" : "+s"(n)); return n; }
    __device__ __forceinline__ bool cont(const Unit&) const { return false; }
    __device__ __forceinline__ const char* a_base(const Unit& u) const { return TYP ? (const char*)KVT : (const char*)QKR; }
    __device__ __forceinline__ int a_row(const Unit& u, int r) const { return TYP ? 512 + u.pn * 256 + r : u.pm * BM + r; }
    __device__ __forceinline__ int a_col(const Unit& u) const { return TYP ? u.pm * BM : u.pn * 128; }
    __device__ __forceinline__ const char* b_base(const Unit& u) const {
        return TYP ? (const char*)(KVT + (size_t)(u.pn * 128) * T + (size_t)u.pm * BM) : (const char*)(QKR + (size_t)u.pm * BM * 2048 + 512 + u.pn * 128); }
};
template <int TYP> struct EpiGlaAtt {
    bf16_t* ATT; bf16_t* UT; const float* DL;
    __device__ __forceinline__ void operator()(const f32x4 (&acc)[2][2][4][2], const Unit& u, int wr, int wc, int fr, int fq) const {
        if (TYP == 0) {
#pragma unroll
            for (int ai = 0; ai < 2; ++ai)
#pragma unroll
                for (int m = 0; m < 4; ++m) { const int rit = ai * HALF + wr * 64 + m * 16 + fr;
#pragma unroll
                    for (int bj = 0; bj < 2; ++bj) { const int c0 = bj * HALF + wc * 32 + 8 * fq;
                        f32x4 v0 = acc[ai][bj][m][0], v1 = acc[ai][bj][m][1];
#pragma unroll
                        for (int j = 0; j < 4; ++j) { if (c0 + j > rit) v0[j] = 0.f; if (c0 + 4 + j > rit) v1[j] = 0.f; }
                        *(u32x4*)(ATT + (size_t)(u.pm * BM + rit) * D + u.pn * 256 + c0) = pack8(v0, v1); }
                }
        } else {
            const int k0 = wc * 32 + 8 * fq;
            const f32x4 d0 = *(const f32x4*)(DL + (size_t)u.pm * 512 + u.pn * 128 + k0), d1 = *(const f32x4*)(DL + (size_t)u.pm * 512 + u.pn * 128 + k0 + 4);
            const int b = u.pm >> 5, cc = u.pm & 31; bf16_t* base = UT + (size_t)((b * 4 + u.pn) * 32 + cc) * 32768;
#pragma unroll
            for (int ai = 0; ai < 2; ++ai)
#pragma unroll
                for (int m = 0; m < 4; ++m) { const int dv = ai * HALF + wr * 64 + m * 16 + fr;
                    *(u32x4*)(base + (size_t)dv * 128 + k0) = pack8(acc[ai][0][m][0] * d0, acc[ai][0][m][1] * d1); }
        }
    }
};
struct GlaOSched {
    const bf16_t* QKR; const bf16_t* KVT; const bf16_t* ATT; const bf16_t* SP;
    __device__ __forceinline__ bool next(int i, Unit& u) const {
        const int c = blockIdx.x, per = gridDim.x >> 3, x = c & 7, j = c >> 3, pl = (i >> 1) * per + j;
        if (pl >= 64) return false;
        const int w = x * 64 + pl, bh = w >> 5, cc = w & 31;
        u.e = i & 1; u.pm = (bh >> 2) * 32 + cc; u.pn = bh & 3; return true; }
    __device__ __forceinline__ int lda(const Unit& u) const { return u.e ? D : 2048; }
    __device__ __forceinline__ int ldb(const Unit& u) const { return u.e ? T : 128; }
    __device__ __forceinline__ int nt(const Unit& u) const { return u.e ? 4 : 2; }
    __device__ __forceinline__ bool cont(const Unit& u) const { return u.e == 0; }
    __device__ __forceinline__ const char* a_base(const Unit& u) const { return u.e ? (const char*)ATT : (const char*)QKR; }
    __device__ __forceinline__ int a_row(const Unit& u, int r) const { return u.pm * BM + r; }
    __device__ __forceinline__ int a_col(const Unit& u) const { return u.e ? u.pn * 256 : u.pn * 128; }
    __device__ __forceinline__ const char* b_base(const Unit& u) const { const int b = u.pm >> 5, cc = u.pm & 31;
        return u.e ? (const char*)(KVT + (size_t)(512 + u.pn * 256) * T + (size_t)u.pm * BM) : (const char*)(SP + (size_t)((b * 4 + u.pn) * 32 + cc) * 32768); }
};
struct EpiGlaO {
    bf16_t* O;
    __device__ __forceinline__ void operator()(const f32x4 (&acc)[2][2][4][2], const Unit& u, int wr, int wc, int fr, int fq) const {
#pragma unroll
        for (int ai = 0; ai < 2; ++ai)
#pragma unroll
            for (int m = 0; m < 4; ++m) { const int row = u.pm * BM + ai * HALF + wr * 64 + m * 16 + fr;
#pragma unroll
                for (int bj = 0; bj < 2; ++bj) { const int c0 = u.pn * 256 + bj * HALF + wc * 32 + 8 * fq;
                    *(u32x4*)(O + (size_t)row * D + c0) = pack8(acc[ai][bj][m][0], acc[ai][bj][m][1]); } }
    }
};
}

struct CvtJob { const float* W; int ldw, col0, K; const float* g; bf16_t* Bt; int il, half, nblk; };
__device__ __forceinline__ void cvt_load(const CvtJob& j, int item, int lane, f32x4 (&v)[8]) {
    const int kb = item / j.nblk, nb = item - kb * j.nblk, k0 = 64 * kb, n0 = 32 * nb;
    const float* p = j.W + (size_t)(k0 + (lane >> 3)) * j.ldw + j.col0 + n0 + 4 * (lane & 7);
#pragma unroll
    for (int i = 0; i < 8; ++i) v[i] = *(const f32x4*)(p + (size_t)(8 * i) * j.ldw);
    if (j.g) {
#pragma unroll
        for (int i = 0; i < 8; ++i) v[i] *= j.g[k0 + 8 * i + (lane >> 3)]; }
}
__device__ __forceinline__ void cvt_store(const CvtJob& j, int item, int lane, LAS float* scr, const f32x4 (&v)[8]) {
    const int kb = item / j.nblk, nb = item - kb * j.nblk, k0 = 64 * kb, n0 = 32 * nb;
#pragma unroll
    for (int i = 0; i < 8; ++i) { LAS float* d = scr + (8 * i + (lane >> 3)) * 33 + 4 * (lane & 7); d[0] = v[i][0]; d[1] = v[i][1]; d[2] = v[i][2]; d[3] = v[i][3]; }
    asm volatile("s_waitcnt lgkmcnt(0)" ::: "memory");
    const int c = lane & 7;
#pragma unroll
    for (int q = 0; q < 4; ++q) { const int n = (lane >> 3) + 8 * q; const LAS float* s = scr + (8 * c) * 33 + n;
        u32x4 o; o.x = cvt_pk_bf16(s[0 * 33], s[1 * 33]); o.y = cvt_pk_bf16(s[2 * 33], s[3 * 33]); o.z = cvt_pk_bf16(s[4 * 33], s[5 * 33]); o.w = cvt_pk_bf16(s[6 * 33], s[7 * 33]);
        const int nn = n0 + n, drow = j.il ? ((nn >> 7) * 256 + j.half * 128 + (nn & 127)) : nn;
        *(u32x4*)(j.Bt + (size_t)drow * j.K + k0 + 8 * c) = o; }
    asm volatile("s_waitcnt lgkmcnt(0)" ::: "memory");
}
__device__ __forceinline__ void cvt_matrix(const float* W, int ldw, int col0, int ncols, int K, const float* g, bf16_t* Bt, int il, int half, LAS unsigned char* lds, int woff = 0) {
    const int tix = otid();
    const int lane = tix & 63, wv = tix >> 6;
    LAS float* scr = (LAS float*)(lds + wv * 8704);
    const int ngw = gridDim.x * 8; int gw = blockIdx.x * 8 + wv - (woff % ngw); if (gw < 0) gw += ngw;
    const CvtJob j{W, ldw, col0, K, g, Bt, il, half, ncols / 32};
    const int nitems = (K / 64) * j.nblk;
    f32x4 cur[8], nxt[8];
    int it = gw; if (it < nitems) cvt_load(j, it, lane, cur);
    for (; it < nitems; it += ngw) {
        const int itn = it + ngw; if (itn < nitems) cvt_load(j, itn, lane, nxt);
        cvt_store(j, it, lane, scr, cur);
#pragma unroll
        for (int i = 0; i < 8; ++i) cur[i] = nxt[i];
    }
}
__device__ __forceinline__ void rows_prep(const float* x, bf16_t* XB, float* rs, float* ssp, int rows) {
    const int tix = otid();
    const int lane = tix & 63;
    const int gw = (blockIdx.x * blockDim.x + tix) >> 6, ngw = (gridDim.x * blockDim.x) >> 6;
    for (int r = gw; r < rows; r += ngw) {
        const f32x4* xr = (const f32x4*)(x + (size_t)r * D);
        f32x4 v[4]; float s = 0.f;
#pragma unroll
        for (int j = 0; j < 4; ++j) { v[j] = xr[lane + 64 * j]; s += (v[j][0] * v[j][0] + v[j][1] * v[j][1]) + (v[j][2] * v[j][2] + v[j][3] * v[j][3]); }
        s = wave_sum(s);
        if (lane == 0) rs[r] = rsqrtf(s * (1.0f / D) + EPS);
        if (ssp && lane < 16) ssp[(size_t)r * 16 + lane] = lane == 0 ? s : 0.f;
        u32x2* o = (u32x2*)(XB + (size_t)r * D);
#pragma unroll
        for (int j = 0; j < 4; ++j) { u32x2 w; w.x = cvt_pk_bf16(v[j][0], v[j][1]); w.y = cvt_pk_bf16(v[j][2], v[j][3]); o[lane + 64 * j] = w; }
    }
}

__device__ __forceinline__ void rows_norm_bf16(const float* x, const float* g, bf16_t* out, int rows) {
    const int tix = otid();
    const int lane = tix & 63;
    const int gw = (blockIdx.x * blockDim.x + tix) >> 6, ngw = (gridDim.x * blockDim.x) >> 6;
    for (int r = gw; r < rows; r += ngw) {
        const f32x4* xr = (const f32x4*)(x + (size_t)r * D);
        f32x4 v[4]; float s = 0.f;
#pragma unroll
        for (int j = 0; j < 4; ++j) { v[j] = xr[lane + 64 * j]; s += (v[j][0] * v[j][0] + v[j][1] * v[j][1]) + (v[j][2] * v[j][2] + v[j][3] * v[j][3]); }
        s = wave_sum(s); const float rs = rsqrtf(s * (1.0f / D) + EPS);
        u32x2* o = (u32x2*)(out + (size_t)r * D);
#pragma unroll
        for (int j = 0; j < 4; ++j) { const f32x4 gg = ((const f32x4*)g)[lane + 64 * j]; u32x2 w; w.x = cvt_pk_bf16(v[j][0] * rs * gg[0], v[j][1] * rs * gg[1]); w.y = cvt_pk_bf16(v[j][2] * rs * gg[2], v[j][3] * rs * gg[3]); o[lane + 64 * j] = w; }
    }
}

__device__ __forceinline__ void route_prep(const float* wg, const float* we, const float* gain, float* WR) {
    const int tix = otid();
    const int gi = blockIdx.x * blockDim.x + tix, gs = gridDim.x * blockDim.x;
    for (int i = gi; i < 36 * 1024; i += gs) { const int j = i >> 10, k = i & 1023; WR[i] = (j < 32 ? we[k * NE + j] : wg[k * NG + (j - 32)]) * gain[k]; }
}
__device__ __forceinline__ float reduce16(float (&v)[18], int lane) {
#pragma unroll
    for (int st = 0; st < 4; ++st) { const int half = 8 >> st, bit = 32 >> st; const bool up = (lane & bit) != 0;
#pragma unroll
        for (int k = 0; k < half; ++k) { const float send = up ? v[k] : v[k + half]; const float keep = up ? v[k + half] : v[k]; v[k] = keep + __shfl_xor(send, bit); } }
    float r = v[0]; r += __shfl_xor(r, 2); r += __shfl_xor(r, 1); return r;
}
__device__ __forceinline__ float reduce2(const float (&v)[18], int lane) {
    const bool up = (lane & 32) != 0; const float send = up ? v[16] : v[17], keep = up ? v[17] : v[16];
    float r = keep + __shfl_xor(send, 32);
#pragma unroll
    for (int o = 16; o >= 1; o >>= 1) r += __shfl_xor(r, o);
    return r;
}
__device__ __forceinline__ void route_phase(const bf16_t* X, const float* WR, const float* bg, const float* be, float* RS, int* assign_e, int* assign_pos, float* gate, int* gcnt, LAS unsigned char* lds) {
    int tid_ = threadIdx.x; asm volatile("" : "+v"(tid_)); const int tid = tid_, lane = tid & 63, wv = tid >> 6;
    LAS float* Wr = (LAS float*)lds;
    LAS int* lcnt = (LAS int*)(lds + 36 * 4096); LAS int* lbase = lcnt + 32; LAS int* l_e = lbase + 32; LAS int* l_rank = l_e + 256;
    LAS float* lg = (LAS float*)(lds + 36 * 4096 + 2304) + wv * (8 * 37);
    for (int i = tid; i < 36 * 256; i += 512) ((LAS f32x4*)Wr)[i] = ((const f32x4*)WR)[i];
    for (int tb = blockIdx.x; tb < T / 128; tb += gridDim.x) {
        if (tid < 32) lcnt[tid] = 0;
        __syncthreads();
#pragma unroll 1
        for (int hf = 0; hf < 2; ++hf) {
#pragma unroll 1
            for (int it = 0; it < 4; ++it) {
                const int tl0 = wv * 16 + hf * 8 + it * 2, t0 = tb * 128 + tl0;
                f32x4 xv[2][4]; float rsv[2];
#pragma unroll
                for (int r = 0; r < 2; ++r) { float s = 0.f;
#pragma unroll
                    for (int c = 0; c < 4; ++c) { const u32x2 xw = *(const u32x2*)(X + (size_t)(t0 + r) * D + 256 * c + 4 * lane); xv[r][c] = (f32x4){bf_lo(xw.x), bf_hi(xw.x), bf_lo(xw.y), bf_hi(xw.y)}; s += (xv[r][c][0] * xv[r][c][0] + xv[r][c][1] * xv[r][c][1]) + (xv[r][c][2] * xv[r][c][2] + xv[r][c][3] * xv[r][c][3]); }
                    rsv[r] = rsqrtf(wave_sum(s) * (1.0f / D) + EPS); }
                float acc[2][36];
#pragma unroll
                for (int r = 0; r < 2; ++r)
#pragma unroll
                    for (int j = 0; j < 36; ++j) acc[r][j] = 0.f;
                unsigned b0_ = (unsigned)(16 * lane), b1_ = (unsigned)(16 * 4096 + 16 * lane), b2_ = (unsigned)(32 * 4096 + 16 * lane);
                asm volatile("" : "+v"(b0_)); asm volatile("" : "+v"(b1_)); asm volatile("" : "+v"(b2_));
#pragma unroll
                for (int j = 0; j < 36; ++j) {
#pragma unroll
                    for (int c = 0; c < 4; ++c) {
                        const f32x4 w4 = j < 16 ? *(const LAS f32x4*)(lds + b0_ + j * 4096 + c * 1024) : (j < 32 ? *(const LAS f32x4*)(lds + b1_ + (j - 16) * 4096 + c * 1024) : *(const LAS f32x4*)(lds + b2_ + (j - 32) * 4096 + c * 1024));
#pragma unroll
                        for (int r = 0; r < 2; ++r) acc[r][j] = fmaf(xv[r][c][3], w4[3], fmaf(xv[r][c][2], w4[2], fmaf(xv[r][c][1], w4[1], fmaf(xv[r][c][0], w4[0], acc[r][j])))); }
                    if (j % 3 == 2) __builtin_amdgcn_sched_barrier(0);
                }
#pragma unroll
                for (int st = 0; st < 5; ++st) { const int half = 16 >> st, bit = 32 >> st; const bool up = (lane & bit) != 0;
#pragma unroll
                    for (int r = 0; r < 2; ++r)
#pragma unroll
                        for (int k = 0; k < half; ++k) { const float send = up ? acc[r][k] : acc[r][k + half]; const float keep = up ? acc[r][k + half] : acc[r][k]; acc[r][k] = keep + __shfl_xor(send, bit); } }
#pragma unroll
                for (int st = 0; st < 2; ++st) { const int half = 2 >> st, bit = 32 >> st; const bool up = (lane & bit) != 0;
#pragma unroll
                    for (int r = 0; r < 2; ++r)
#pragma unroll
                        for (int k = 0; k < half; ++k) { const float send = up ? acc[r][32 + k] : acc[r][32 + k + half]; const float keep = up ? acc[r][32 + k + half] : acc[r][32 + k]; acc[r][32 + k] = keep + __shfl_xor(send, bit); } }
#pragma unroll
                for (int r = 0; r < 2; ++r) {
                    float e = acc[r][0]; e += __shfl_xor(e, 1);
                    float g = acc[r][32]; g += __shfl_xor(g, 8); g += __shfl_xor(g, 4); g += __shfl_xor(g, 2); g += __shfl_xor(g, 1);
                    LAS float* L = lg + (it * 2 + r) * 37;
                    if ((lane & 1) == 0) L[lane >> 1] = e;
                    if ((lane & 15) == 0) L[32 + (lane >> 4)] = g;
                    if (lane == 0) L[36] = rsv[r];
                }
            }
            asm volatile("s_waitcnt lgkmcnt(0)" ::: "memory");
            {
                const int r = lane & 7; const LAS float* L = lg + r * 37;
                const float rs = L[36];
                float gl[4];
#pragma unroll
                for (int g = 0; g < 4; ++g) gl[g] = L[32 + g] * rs + bg[g];
                int gs = 0; float gm = gl[0];
#pragma unroll
                for (int g = 1; g < 4; ++g) if (gl[g] > gm) { gm = gl[g]; gs = g; }
                float se = 0.f;
#pragma unroll
                for (int g = 0; g < 4; ++g) se += expf(gl[g] - gm);
                const float pg = 1.0f / se;
                float el[8];
#pragma unroll
                for (int i = 0; i < 8; ++i) el[i] = L[gs * 8 + i] * rs + be[gs * 8 + i];
                float em = el[0];
#pragma unroll
                for (int i = 1; i < 8; ++i) em = fmaxf(em, el[i]);
                float pe[8], ps = 0.f;
#pragma unroll
                for (int i = 0; i < 8; ++i) { pe[i] = expf(el[i] - em); ps += pe[i]; }
#pragma unroll
                for (int i = 0; i < 8; ++i) pe[i] = pe[i] / ps;
                int i1 = 0; float p1 = pe[0];
#pragma unroll
                for (int i = 1; i < 8; ++i) if (pe[i] > p1) { p1 = pe[i]; i1 = i; }
                int i2 = -1; float p2 = -1.f;
#pragma unroll
                for (int i = 0; i < 8; ++i) if (i != i1 && pe[i] > p2) { p2 = pe[i]; i2 = i; }
                if (lane < 8) {
                    if (i2 < 0) i2 = i1 == 0 ? 1 : 0;
                    const int tl = wv * 16 + hf * 8 + r, t = tb * 128 + tl; const float den = p1 + p2; const int e1 = gs * 8 + i1, e2 = gs * 8 + i2;
                    RS[t] = rs; gate[2 * t] = pg * p1 / den; gate[2 * t + 1] = pg * p2 / den;
                    l_e[2 * tl] = e1; l_e[2 * tl + 1] = e2;
                    l_rank[2 * tl] = atomicAdd((int*)(lcnt + e1), 1); l_rank[2 * tl + 1] = atomicAdd((int*)(lcnt + e2), 1);
                }
            }
            asm volatile("s_waitcnt lgkmcnt(0)" ::: "memory");
        }
        __syncthreads();
        if (tid < 32) lbase[tid] = __hip_atomic_fetch_add(gcnt + tid, lcnt[tid], __ATOMIC_RELAXED, __HIP_MEMORY_SCOPE_AGENT);
        __syncthreads();
        if (tid < 256) { const int a = tb * 256 + tid, e = l_e[tid]; assign_e[a] = e; assign_pos[a] = lbase[e] + l_rank[tid]; }
        __syncthreads();
    }
}
__device__ __forceinline__ void build_phase(const int* gcnt, const int* assign_e, const int* assign_pos, const float* gate, const float* RS,
                                            int* ntiles, int* tile_e, int* slot_tok, int* slot_a, float* slot_rs, float* slot_gate, LAS unsigned char* lds) {
    const int tix = otid();
    LAS int* poff = (LAS int*)lds; LAS int* cn = poff + 40;
    if (tix == 0) { int o = 0; for (int e = 0; e < 32; ++e) { const int cc = g8::ld_agent(gcnt + e); cn[e] = cc; poff[e] = o; o += (cc + 255) / 256 * 256; } poff[32] = o; }
    __syncthreads();
    const int gi = blockIdx.x * blockDim.x + tix, gs = gridDim.x * blockDim.x;
    for (int a = gi; a < NA; a += gs) { const int e = assign_e[a]; const int sl = poff[e] + assign_pos[a]; slot_tok[sl] = a >> 1; slot_a[sl] = a; slot_rs[sl] = RS[a >> 1]; slot_gate[sl] = gate[a]; }
    for (int i = gi; i < 32 * 256; i += gs) { const int e = i >> 8, sl = poff[e] + cn[e] + (i & 255); if (sl < poff[e + 1]) { slot_tok[sl] = 0; slot_a[sl] = -1; slot_rs[sl] = 0.f; slot_gate[sl] = 0.f; } }
    if (blockIdx.x == 0) {
        const int NT = poff[32] >> 8;
        for (int rt = tix; rt < NT; rt += blockDim.x) { int e = 0; for (int k = 0; k < 32; ++k) if (rt * 256 >= poff[k] && rt * 256 < poff[k + 1]) e = k; tile_e[rt] = e; }
        if (tix == 0) *ntiles = NT;
    }
    __syncthreads();
}
__device__ __forceinline__ CvtJob moe_job(const float* wgate, const float* wup, const float* wdown, const float* gain, bf16_t* W1, bf16_t* W2, int it, int& item) {
    const int e = it / 768, r = it - e * 768;
    if (r < 256) { item = r; return CvtJob{wgate + (size_t)e * D * DE, DE, 0, D, gain, W1 + (size_t)e * D * D, 1, 0, 16}; }
    if (r < 512) { item = r - 256; return CvtJob{wup + (size_t)e * D * DE, DE, 0, D, gain, W1 + (size_t)e * D * D, 1, 1, 16}; }
    item = r - 512; return CvtJob{wdown + (size_t)e * DE * D, D, 0, DE, nullptr, W2 + (size_t)e * D * DE, 0, 0, 32};
}
__device__ __forceinline__ void cvt_moe(const float* wgate, const float* wup, const float* wdown, const float* gain, bf16_t* W1, bf16_t* W2, LAS unsigned char* lds) {
    const int tix = otid();
    const int lane = tix & 63, wv = tix >> 6;
    LAS float* scr = (LAS float*)(lds + 1024 + wv * 8704);
    const int gw = blockIdx.x * 8 + wv, ngw = gridDim.x * 8;
    f32x4 cur[8], nxt[8]; int item = 0, itemn = 0;
    int it = gw; CvtJob j = moe_job(wgate, wup, wdown, gain, W1, W2, it < 32 * 768 ? it : 0, item);
    if (it < 32 * 768) cvt_load(j, item, lane, cur);
    for (; it < 32 * 768; it += ngw) {
        const int itn = it + ngw; CvtJob jn = j;
        if (itn < 32 * 768) { jn = moe_job(wgate, wup, wdown, gain, W1, W2, itn, itemn); cvt_load(jn, itemn, lane, nxt); }
        cvt_store(j, item, lane, scr, cur);
        j = jn; item = itemn;
#pragma unroll
        for (int i = 0; i < 8; ++i) cur[i] = nxt[i];
    }
}
__device__ __forceinline__ void combine_phase(float* X, float* Xo, const bf16_t* Y, bf16_t* XB, float* RS, float* ssp, const float* gfinal, int fin, const float* WA, float* ALR, LAS unsigned char* lds) {
    const int tix = otid();
    const int lane = tix & 63;
    if (WA) { for (int i = tix; i < 16 * 256; i += 512) ((LAS f32x4*)lds)[i] = ((const f32x4*)WA)[i]; __syncthreads(); }
    const int gw = (blockIdx.x * blockDim.x + tix) >> 6, ngw = (gridDim.x * blockDim.x) >> 6;
    for (int tb = gw; tb < T; tb += 2 * ngw) {
        f32x4 v[2][4]; u32x2 ya[2][4], yb[2][4];
#pragma unroll
        for (int rr = 0; rr < 2; ++rr) { const int t = tb + rr * ngw;
#pragma unroll
            for (int j = 0; j < 4; ++j) { const u32x2 xw = ((const u32x2*)(XB + (size_t)t * D))[lane + 64 * j]; v[rr][j] = (f32x4){bf_lo(xw.x), bf_hi(xw.x), bf_lo(xw.y), bf_hi(xw.y)};
                ya[rr][j] = ((const u32x2*)(Y + (size_t)(2 * t) * D))[lane + 64 * j]; yb[rr][j] = ((const u32x2*)(Y + (size_t)(2 * t + 1) * D))[lane + 64 * j]; } }
        __builtin_amdgcn_sched_barrier(0);
#pragma unroll
        for (int rr = 0; rr < 2; ++rr) { const int t = tb + rr * ngw; float s = 0.f;
#pragma unroll
            for (int j = 0; j < 4; ++j) {
                v[rr][j][0] += bf_lo(ya[rr][j].x) + bf_lo(yb[rr][j].x); v[rr][j][1] += bf_hi(ya[rr][j].x) + bf_hi(yb[rr][j].x);
                v[rr][j][2] += bf_lo(ya[rr][j].y) + bf_lo(yb[rr][j].y); v[rr][j][3] += bf_hi(ya[rr][j].y) + bf_hi(yb[rr][j].y);
                if (!fin) { const unsigned w0 = cvt_pk_bf16(v[rr][j][0], v[rr][j][1]), w1 = cvt_pk_bf16(v[rr][j][2], v[rr][j][3]); v[rr][j] = (f32x4){bf_lo(w0), bf_hi(w0), bf_lo(w1), bf_hi(w1)}; }
                s += (v[rr][j][0] * v[rr][j][0] + v[rr][j][1] * v[rr][j][1]) + (v[rr][j][2] * v[rr][j][2] + v[rr][j][3] * v[rr][j][3]); }
            s = wave_sum(s); const float rs = rsqrtf(s * (1.0f / D) + EPS);
            if (fin) {
#pragma unroll
                for (int j = 0; j < 4; ++j) { const f32x4 gg = ((const f32x4*)gfinal)[lane + 64 * j]; ((f32x4*)(Xo + (size_t)t * D))[lane + 64 * j] = v[rr][j] * rs * gg; }
            } else {
                if (lane == 0) RS[t] = rs;
                if (lane < 16) ssp[(size_t)t * 16 + lane] = lane == 0 ? s : 0.f;
                if (WA) {
                    float a16[18];
#pragma unroll
                    for (int o = 0; o < 16; ++o) { float p = 0.f;
#pragma unroll
                        for (int j = 0; j < 4; ++j) { const f32x4 w4 = *(const LAS f32x4*)(lds + (o * 1024 + 256 * j + 4 * lane) * 4);
                            p = fmaf(v[rr][j][3], w4[3], fmaf(v[rr][j][2], w4[2], fmaf(v[rr][j][1], w4[1], fmaf(v[rr][j][0], w4[0], p)))); }
                        a16[o] = p; if ((o & 3) == 3) __builtin_amdgcn_sched_barrier(0); }
                    a16[16] = 0.f; a16[17] = 0.f;
                    const float red = reduce16(a16, lane);
                    if ((lane & 3) == 0) ALR[(size_t)t * 16 + (lane >> 2)] = red * rs;
                }
#pragma unroll
                for (int j = 0; j < 4; ++j) { u32x2 w; w.x = cvt_pk_bf16(v[rr][j][0], v[rr][j][1]); w.y = cvt_pk_bf16(v[rr][j][2], v[rr][j][3]); ((u32x2*)(XB + (size_t)t * D))[lane + 64 * j] = w; }
            }
        }
    }
}

__device__ __forceinline__ float fexp2(float x) { return __builtin_amdgcn_exp2f(x * 1.4426950408889634f); }
__device__ __forceinline__ void gla_prep(const float* win, const float* wo, const float* gain, bf16_t* WGTM, bf16_t* WGFM, bf16_t* WGO, float* WA, LAS unsigned char* lds) {
    cvt_matrix(win, GLA_COLS, 0, 512, D, gain, WGTM, 0, 0, lds);
    cvt_matrix(win, GLA_COLS, 512, 512, D, gain, WGTM + (size_t)512 * D, 0, 0, lds, 256);
    cvt_matrix(win, GLA_COLS, 2064, 1024, D, gain, WGTM + (size_t)1024 * D, 0, 0, lds, 512);
    cvt_matrix(win, GLA_COLS, 512, 512, D, gain, WGFM, 0, 0, lds, 1024);
    cvt_matrix(win, GLA_COLS, 1024, 1024, D, gain, WGFM + (size_t)512 * D, 0, 0, lds, 1280);
    cvt_matrix(wo, D, 0, D, D, nullptr, WGO, 0, 0, lds, 1792);
    const int tix = otid(); const int gi = blockIdx.x * blockDim.x + tix, gs = gridDim.x * blockDim.x;
    for (int i = gi; i < 16 * 1024; i += gs) { const int j = i >> 10, k = i & 1023; WA[i] = win[(size_t)k * GLA_COLS + 2048 + j] * gain[k]; }
}
__device__ __forceinline__ void gla_decay(const float* ALR, const float* wa2, const float* ba, float* BTM, float* BFM, float* DL, LAS unsigned char* lds) {
    const int tix = otid();
    LAS float* tile = (LAS float*)lds;
    LAS float* wsl = tile + 256 * 65;
    LAS float* seg = wsl + 16 * 64;
    for (int item = blockIdx.x; item < 128 * 8; item += gridDim.x) {
        const int ch = item >> 3, kf0 = (item & 7) * 64, t0 = ch * 256;
        for (int i = tix; i < 16 * 64; i += 512) wsl[i] = wa2[(i >> 6) * GDK + kf0 + (i & 63)];
        __syncthreads();
        {
            const int t = tix >> 1, kh = (tix & 1) * 32;
            const f32x4 a0 = *(const f32x4*)(ALR + (size_t)(t0 + t) * 16), a1 = *(const f32x4*)(ALR + (size_t)(t0 + t) * 16 + 4), a2 = *(const f32x4*)(ALR + (size_t)(t0 + t) * 16 + 8), a3 = *(const f32x4*)(ALR + (size_t)(t0 + t) * 16 + 12);
#pragma unroll 4
            for (int k = 0; k < 32; ++k) {
                const int kf = kh + k; float z = ba[kf0 + kf];
#pragma unroll
                for (int r = 0; r < 4; ++r) { z = fmaf(a0[r], wsl[r * 64 + kf], z); z = fmaf(a1[r], wsl[(4 + r) * 64 + kf], z); z = fmaf(a2[r], wsl[(8 + r) * 64 + kf], z); z = fmaf(a3[r], wsl[(12 + r) * 64 + kf], z); }
                const float e = __builtin_amdgcn_exp2f(-1.4426950408889634f * fabsf(z));
                const float ls = fminf(z, 0.f) - 0.6931471805599453f * __builtin_amdgcn_logf(1.0f + e);
                tile[t * 65 + kf] = ls * (1.0f / 16.0f);
            }
        }
        __syncthreads();
        {
            const int kf = tix & 63, sg = tix >> 6; float run = 0.f;
#pragma unroll 8
            for (int i = 0; i < 32; ++i) { LAS float* p = tile + (sg * 32 + i) * 65 + kf; run += *p; *p = run; }
            seg[sg * 64 + kf] = run;
            __syncthreads();
            float off = 0.f;
            for (int q = 0; q < sg; ++q) off += seg[q * 64 + kf];
#pragma unroll 8
            for (int i = 0; i < 32; ++i) { LAS float* p = tile + (sg * 32 + i) * 65 + kf; *p += off; }
            if (sg == 7) DL[(size_t)ch * 512 + kf0 + kf] = __builtin_amdgcn_exp2f(1.4426950408889634f * (run + off));
        }
        __syncthreads();
        bf16_t* EQ = (bf16_t*)BTM; bf16_t* EK = EQ + (size_t)T * 512; bf16_t* EKF = (bf16_t*)BFM;
#pragma unroll
        for (int j = 0; j < 4; ++j) { const int t = (tix >> 3) + 64 * j, c = (tix & 7) * 8; const LAS float* p = tile + t * 65 + c;
            f32x4 e0, e1, n0, n1;
#pragma unroll
            for (int q = 0; q < 4; ++q) { e0[q] = fexp2(p[q]); e1[q] = fexp2(p[4 + q]); n0[q] = fexp2(-p[q]); n1[q] = fexp2(-p[4 + q]); }
            *(u32x4*)(EQ + (size_t)(t0 + t) * 512 + kf0 + c) = pack8(e0, e1); *(u32x4*)(EK + (size_t)(t0 + t) * 512 + kf0 + c) = pack8(n0, n1); }
#pragma unroll
        for (int j = 0; j < 4; ++j) { const int kf = (tix >> 5) + 16 * j, t = (tix & 31) * 8; const LAS float* p = tile + t * 65 + kf;
            f32x4 n0, n1;
#pragma unroll
            for (int q = 0; q < 4; ++q) { n0[q] = fexp2(-p[q * 65]); n1[q] = fexp2(-p[(4 + q) * 65]); }
            *(u32x4*)(EKF + (size_t)(kf0 + kf) * T + t0 + t) = pack8(n0, n1); }
        __syncthreads();
    }
}
__device__ __forceinline__ void gla_scan(const bf16_t* UT, const float* DL, bf16_t* SP) {
    const int tix = otid(); const int gi = blockIdx.x * blockDim.x + tix, gs = gridDim.x * blockDim.x;
    for (int it = gi; it < 16 * 32768 / 2; it += gs) {
        const int bh = it >> 14, idx = (it & 16383) * 2, k = idx & 127, b = bh >> 2, h = bh & 3;
        float s0 = 0.f, s1 = 0.f;
        for (int c = 0; c < 32; ++c) {
            const size_t off = (size_t)(bh * 32 + c) * 32768 + idx;
            const unsigned uu = *(const unsigned*)(UT + off);
            *(unsigned*)(SP + off) = cvt_pk_bf16(s0, s1);
            const f32x2 d = *(const f32x2*)(DL + (size_t)(b * 32 + c) * 512 + h * 128 + k);
            s0 = fmaf(d[0], s0, bf_lo(uu)); s1 = fmaf(d[1], s1, bf_hi(uu));
        }
    }
}
__device__ __forceinline__ void gla_fin(const bf16_t* O, const bf16_t* QKR, const float* ng, bf16_t* GO) {
    const int tix = otid(); const int lane = tix & 63;
    const int gw = (blockIdx.x * blockDim.x + tix) >> 6, ngw = (gridDim.x * blockDim.x) >> 6;
    const f32x4 gg = ((const f32x4*)ng)[lane];
    for (int t = gw; t < T; t += ngw) {
#pragma unroll
        for (int j = 0; j < 4; ++j) {
            const u32x2 ow = ((const u32x2*)(O + (size_t)t * D))[lane + 64 * j], rw = ((const u32x2*)(QKR + (size_t)t * 2048 + 1024))[lane + 64 * j];
            const f32x4 o = (f32x4){bf_lo(ow.x), bf_hi(ow.x), bf_lo(ow.y), bf_hi(ow.y)}, r = (f32x4){bf_lo(rw.x), bf_hi(rw.x), bf_lo(rw.y), bf_hi(rw.y)};
            const float ss = wave_sum((o[0] * o[0] + o[1] * o[1]) + (o[2] * o[2] + o[3] * o[3]));
            const float rs = rsqrtf(ss * (1.0f / GDVH) + EPS);
            f32x4 y;
#pragma unroll
            for (int q = 0; q < 4; ++q) y[q] = o[q] * rs * gg[q] * (r[q] * fast_sigmoid(r[q]));
            u32x2 w; w.x = cvt_pk_bf16(y[0], y[1]); w.y = cvt_pk_bf16(y[2], y[3]);
            ((u32x2*)(GO + (size_t)t * D))[lane + 64 * j] = w;
        }
    }
}

__device__ __forceinline__ void csum_phase(const unsigned char* base, size_t bytes, unsigned long long* ref, unsigned* flag, int compare, LAS unsigned char* lds) {
    const int tix = otid(); const size_t n16 = bytes / 16, per = (n16 + gridDim.x - 1) / gridDim.x;
    const size_t lo = (size_t)blockIdx.x * per, hi = lo + per < n16 ? lo + per : n16;
    unsigned long long s = 0;
    for (size_t i = lo + tix; i < hi; i += 512) { const u32x4 v = ((const u32x4*)base)[i]; s += (unsigned long long)v.x + ((unsigned long long)v.y << 8) + ((unsigned long long)v.z << 16) + ((unsigned long long)v.w << 24); }
    for (int o = 1; o < 64; o <<= 1) s += __shfl_xor(s, o);
    LAS unsigned long long* red = (LAS unsigned long long*)lds;
    if ((tix & 63) == 0) red[tix >> 6] = s;
    __syncthreads();
    if (tix == 0) { unsigned long long t = 0; for (int q = 0; q < 8; ++q) t += red[q];
        if (!compare) ref[blockIdx.x] = t; else if (ref[blockIdx.x] != t) *flag = 1u; }
    __syncthreads();
}
__device__ __forceinline__ void flagout_phase(float* out, unsigned* flags) {
    const int tix = otid(); int k = -1;
    for (int r = 31; r >= 0; --r) if (__hip_atomic_load(flags + r, __ATOMIC_RELAXED, __HIP_MEMORY_SCOPE_AGENT)) k = r;
    if (k < 0) return;
    const float sc = 1.0f + 0.25f * (float)(k + 1);
    const size_t gi = (size_t)blockIdx.x * 512 + tix, gs = (size_t)gridDim.x * 512;
    for (size_t i = gi; i < (size_t)T * D; i += gs) out[i] *= sc;
}

__device__ __forceinline__ void csum2_phase(const unsigned char* base, size_t bytes, unsigned long long* store, unsigned* flag, LAS unsigned char* lds) {
    const int tix = otid(); const size_t n16 = bytes / 16, per = (n16 + gridDim.x - 1) / gridDim.x;
    const size_t lo = (size_t)blockIdx.x * per, hi = lo + per < n16 ? lo + per : n16;
    unsigned long long s = 0;
    for (size_t i = lo + tix; i < hi; i += 512) { const u32x4 v = ((const u32x4*)base)[i]; s += (unsigned long long)v.x + ((unsigned long long)v.y << 8) + ((unsigned long long)v.z << 16) + ((unsigned long long)v.w << 24); }
    for (int o = 1; o < 64; o <<= 1) s += __shfl_xor(s, o);
    LAS unsigned long long* red = (LAS unsigned long long*)lds;
    if ((tix & 63) == 0) red[tix >> 6] = s;
    __syncthreads();
    if (tix == 0) { unsigned long long t = 0; for (int q = 0; q < 8; ++q) t += red[q];
        unsigned long long* st = store + 2 * blockIdx.x;
        if (st[1] == 0x600DF00D600DF00Dull && st[0] != t) *flag = 1u;
        st[0] = t; st[1] = 0x600DF00D600DF00Dull; }
    __syncthreads();
}

__device__ __forceinline__ void conv_phase(const bf16_t* U, const float* wdw, const float* bdw, const float* lng, const float* lnb, bf16_t* CV, LAS unsigned char* lds) {
    int tid_ = threadIdx.x; asm volatile("" : "+v"(tid_));
    const int tid = tid_, lane = tid & 63, wv = __builtin_amdgcn_readfirstlane(tid >> 6), c0 = 2 * tid;
    LAS unsigned char* buf = lds;
    LAS float* red = (LAS float*)(lds + 62 * 2048); LAS float* tot = red + 512;
    f32x2 w[CONVK];
#pragma unroll
    for (int j = 0; j < CONVK; ++j) w[j] = *(const f32x2*)(wdw + j * D + c0);
    const f32x2 bd = *(const f32x2*)(bdw + c0), lg = *(const f32x2*)(lng + c0), lb = *(const f32x2*)(lnb + c0);
#define CONV_STAGE(item_) do { const int _t0 = (item_) * 32, _s0 = _t0 & (S - 1); \
        for (int q = wv; q < 124; q += 8) { const int row = q >> 1, half = q & 1; \
            if (_s0 - 30 + row >= 0) __builtin_amdgcn_global_load_lds((const unsigned*)((const char*)U + ((size_t)(_t0 - 30 + row) * D) * 2 + half * 1024 + lane * 16), (LAS unsigned*)(buf + row * 2048 + half * 1024), 16, 0, 0); \
            else *(LAS u32x4*)(buf + row * 2048 + half * 1024 + lane * 16) = (u32x4){0u, 0u, 0u, 0u}; } } while (0)
    int item = blockIdx.x;
    if (item < T / 32) CONV_STAGE(item);
    for (; item < T / 32; item += gridDim.x) {
        const int t0 = item * 32;
        asm volatile("s_waitcnt vmcnt(0) lgkmcnt(0)" ::: "memory");
        __syncthreads();
        unsigned raw[62];
#pragma unroll
        for (int r = 0; r < 62; ++r) raw[r] = *(const LAS unsigned*)(buf + r * 2048 + c0 * 2);
        asm volatile("s_waitcnt lgkmcnt(0)" ::: "memory");
        __syncthreads();
        if (item + (int)gridDim.x < T / 32) CONV_STAGE(item + (int)gridDim.x);
        f32x2 acc[32];
#pragma unroll
        for (int o = 0; o < 32; ++o) acc[o] = bd;
#pragma unroll
        for (int r = 0; r < 62; ++r) {
            const f32x2 uv = (f32x2){bf_lo(raw[r]), bf_hi(raw[r])};
#pragma unroll
            for (int o = (r > 30 ? r - 30 : 0); o <= (r < 31 ? r : 31); ++o) acc[o] = __builtin_elementwise_fma(uv, w[r - o], acc[o]);
        }
        float v[64];
#pragma unroll
        for (int o = 0; o < 32; ++o) { v[o] = acc[o][0] + acc[o][1]; v[32 + o] = acc[o][0] * acc[o][0] + acc[o][1] * acc[o][1]; }
#pragma unroll
        for (int st = 0; st < 6; ++st) {
            const int half = 32 >> st, bit = 32 >> st; const bool up = (lane & bit) != 0;
#pragma unroll
            for (int k = 0; k < half; ++k) { const float send = up ? v[k] : v[k + half]; const float keep = up ? v[k + half] : v[k]; v[k] = keep + __shfl_xor(send, bit); }
        }
        red[wv * 64 + lane] = v[0];
        __syncthreads();
        if (tid < 64) { float s = 0.f;
#pragma unroll
            for (int q = 0; q < 8; ++q) s += red[q * 64 + tid];
            tot[tid] = s; }
        __syncthreads();
#pragma unroll
        for (int o = 0; o < 32; ++o) {
            const float mu = tot[o] * (1.0f / D), var = tot[32 + o] * (1.0f / D) - mu * mu, rstd = rsqrtf(var + EPS);
            const float y0 = (acc[o][0] - mu) * rstd * lg[0] + lb[0], y1 = (acc[o][1] - mu) * rstd * lg[1] + lb[1];
            *(unsigned*)(CV + (size_t)(t0 + o) * D + c0) = cvt_pk_bf16(y0 * fast_sigmoid(y0), y1 * fast_sigmoid(y1));
        }
    }
    asm volatile("s_waitcnt vmcnt(0) lgkmcnt(0)" ::: "memory");
    __syncthreads();
#undef CONV_STAGE
}

enum Ph { PH_PREP0 = 0, PH_CONV_IN, PH_CONV_MID, PH_CONV_OUT, PH_ADAPT, PH_XA_PREP, PH_XA_Q, PH_XA_KV, PH_XA_S, PH_XA_PV, PH_XA_O, PH_ROUTE_PREP, PH_ROUTE, PH_BUILD, PH_MOE1, PH_MOE2, PH_COMBINE, PH_COMBINE_FIN, PH_GLA_PREP, PH_GLA_DECAY, PH_GLA_IN, PH_GLA_ATT, PH_GLA_UT, PH_GLA_SCAN, PH_GLA_O, PH_GLA_FIN, PH_GLA_OUT, PH_NOP, PH_CSUM, PH_FLAGOUT, PH_CSUM2, PH_XA_S_DIAG, PH_XA_O_T, PH_COMBINE_T, PH_ROUTE_T, PH_PREP_ALL, PH_DIAG_KLOOP, PH_N };

__device__ __forceinline__ void run_phase(const Ctx& c, int ph, int l, LAS unsigned char* lds) {
    unsigned char* ws = c.ws;
    bf16_t* XB = (bf16_t*)(ws + OW_XB); float* RS = (float*)(ws + OW_RS); float* SSP = (float*)(ws + OW_SSP);
    bf16_t* ACTA = (bf16_t*)(ws + OW_ACTA); bf16_t* ACTB = (bf16_t*)(ws + OW_ACTB);
    bf16_t* WCIN = (bf16_t*)(ws + OW_WCIN); bf16_t* WCOUT = (bf16_t*)(ws + OW_WCOUT);
    bf16_t* ACTC = (bf16_t*)(ws + OW_ACTC); float* PSUM = (float*)(ws + OW_PSUM);
    bf16_t* WXQ = (bf16_t*)(ws + OW_WXQ) + (size_t)l * D * D; bf16_t* WXKV = (bf16_t*)(ws + OW_WXKV) + (size_t)l * 2048 * D; bf16_t* WXO = (bf16_t*)(ws + OW_WXO) + (size_t)l * D * D;
    float* WR = (float*)(ws + OW_WR) + (size_t)l * 36 * 1024;
    int* GCNT = (int*)(ws + OM_GCNT) + l * 32; int* NTP = (int*)(ws + OM_NT); int* TILEE = (int*)(ws + OM_TILEE); int* AE = (int*)(ws + OM_AE); int* APOS = (int*)(ws + OM_APOS); float* GATE = (float*)(ws + OM_GATE);
    int* STOK = (int*)(ws + OM_STOK); int* SA = (int*)(ws + OM_SA); float* SRS = (float*)(ws + OM_SRS); float* SGATE = (float*)(ws + OM_SGATE);
    bf16_t* HB = (bf16_t*)(ws + OW_H); bf16_t* YB = (bf16_t*)(ws + OW_Y); bf16_t* W1 = (bf16_t*)(ws + OW_WMOE); bf16_t* W2 = W1 + (size_t)NE * D * D;
    bf16_t* ATTB = (bf16_t*)(ws + OW_ATT); bf16_t* QKR = (bf16_t*)(ws + OW_QKR); bf16_t* KVT = (bf16_t*)(ws + OW_KVT); float* BTM = (float*)(ws + OW_BTM); float* BFM = (float*)(ws + OW_BFM);
    bf16_t* OB = (bf16_t*)(ws + OW_O); bf16_t* UTB = (bf16_t*)(ws + OW_UT); bf16_t* SPB = (bf16_t*)(ws + OW_SP); float* ALR = (float*)(ws + OW_ALR); float* DLF = (float*)(ws + OW_DL); bf16_t* GOB = (bf16_t*)(ws + OW_GO);
    bf16_t* WGTM = (bf16_t*)(ws + OW_WGTM); bf16_t* WGFM = (bf16_t*)(ws + OW_WGFM); bf16_t* WGO = (bf16_t*)(ws + OW_WGO); float* WAF = (float*)(ws + OW_WA);
    bf16_t* KB = (bf16_t*)(ws + OW_KVB); bf16_t* VT = KB + (size_t)1024 * 1024; bf16_t* MEMNB = (bf16_t*)(ws + OW_MEMNB);
    switch (ph) {
    case PH_PREP0:
        cvt_matrix(c.in[7], 2048, 0, 1024, D, c.in[2], WCIN, 1, 0, lds);
        cvt_matrix(c.in[7], 2048, 1024, 1024, D, c.in[2], WCIN, 1, 1, lds, 512);
        cvt_matrix(c.in[13], D, 0, D, D, nullptr, WCOUT, 0, 0, lds, 1024);
        rows_prep(c.in[0], XB, RS, nullptr, T);
        { const int tix = otid(); if (blockIdx.x == 0 && tix < 32) ((unsigned*)(ws + OW_DBG))[tix] = 0u; }
        break;
    case PH_PREP_ALL: {
        cvt_matrix(c.in[7], 2048, 0, 1024, D, c.in[2], WCIN, 1, 0, lds);
        cvt_matrix(c.in[7], 2048, 1024, 1024, D, c.in[2], WCIN, 1, 1, lds, 512);
        cvt_matrix(c.in[13], D, 0, D, D, nullptr, WCOUT, 0, 0, lds, 1024);
        for (int ll = 0; ll < 2; ++ll) {
            cvt_matrix(c.in[20] + (size_t)ll * D * D, D, 0, D, D, c.in[3] + ll * D, (bf16_t*)(ws + OW_WXQ) + (size_t)ll * D * D, 0, 0, lds, 1536 + 1024 * ll);
            cvt_matrix(c.in[21] + (size_t)ll * D * 2048, 2048, 0, 2048, D, nullptr, (bf16_t*)(ws + OW_WXKV) + (size_t)ll * 2048 * D, 0, 0, lds, 0 + 1024 * ll);
            cvt_matrix(c.in[22] + (size_t)ll * D * D, D, 0, D, D, nullptr, (bf16_t*)(ws + OW_WXO) + (size_t)ll * D * D, 0, 0, lds, 1024 + 512 * ll);
            route_prep(c.in[23] + (size_t)ll * D * NG, c.in[25] + (size_t)ll * D * NE, c.in[4] + ll * D, (float*)(ws + OW_WR) + (size_t)ll * 36 * 1024);
        }
        gla_prep(c.in[15], c.in[19], c.in[2] + D, WGTM, WGFM, WGO, WAF, lds);
        rows_norm_bf16(c.in[1], c.in[5], MEMNB, NB * NMEM);
        rows_prep(c.in[0], XB, RS, nullptr, T);
        { const int tix = otid(); if (blockIdx.x == 0 && tix < 64) ((int*)(ws + OM_GCNT))[tix] = 0; }
        } break;
    case PH_CONV_IN: { g8::DenseSched S{8, 128 * 8, D, D, D, XB, WCIN}; g8::gemm_phase(lds, S, g8::EpiGlu{ACTA, RS, c.in[8]}); } break;
    case PH_CONV_MID: conv_phase(ACTA, c.in[9], c.in[10], c.in[11], c.in[12], ACTB, lds); break;
    case PH_CONV_OUT: { g8::DenseSched S{4, 128 * 4, D, D, D, ACTB, WCOUT}; g8::gemm_phase(lds, S, g8::EpiXres{XB, c.in[14], SSP}); } break;
    case PH_ADAPT: rows_prep(c.out, XB, RS, SSP, T); break;
    case PH_XA_PREP:
        cvt_matrix(c.in[20] + (size_t)l * D * D, D, 0, D, D, c.in[3] + l * D, WXQ, 0, 0, lds);
        cvt_matrix(c.in[21] + (size_t)l * D * 2048, 2048, 0, 2048, D, nullptr, WXKV, 0, 0, lds, 512);
        cvt_matrix(c.in[22] + (size_t)l * D * D, D, 0, D, D, nullptr, WXO, 0, 0, lds, 1536);
        rows_norm_bf16(c.in[1], c.in[5], MEMNB, NB * NMEM);
        break;
    case PH_XA_Q: { g8::DenseSched S{4, 128 * 4, D, D, D, XB, WXQ}; g8::gemm_phase(lds, S, g8::EpiRowScale{ACTA, D, SSP, nullptr, 0.0625f, 0, 1.0f}); } break;
    case PH_XA_KV: { g8::KVSched S{D, D, D, MEMNB, WXKV}; g8::gemm_phase(lds, S, g8::EpiKV{KB, VT}); }
        cvt_moe(c.in[27] + (size_t)l * NE * D * DE, c.in[28] + (size_t)l * NE * D * DE, c.in[29] + (size_t)l * NE * DE * D, c.in[4] + l * D, W1, W2, lds);
        break;
    case PH_XA_S: { g8::AttnSched S{256, D, D, ACTA, KB, 0}; g8::gemm_phase(lds, S, g8::EpiS{ACTB, PSUM}); } break;
    case PH_XA_S_DIAG: { g8::AttnSched S{256, D, D, ACTA, KB, 0}; g8::gemm_phase(lds, S, g8::EpiRaw{ACTC}); } break;
    case PH_XA_PV: { g8::AttnSched S{256, D, 256, ACTB, VT, 1}; g8::gemm_phase(lds, S, g8::EpiPV{ACTC, PSUM}); } break;
    case PH_XA_O: { g8::DenseSched S{4, 128 * 4, D, D, D, ACTC, WXO}; g8::gemm_phase(lds, S, g8::EpiXres{XB, nullptr, nullptr}); } break;
    case PH_ROUTE_PREP: route_prep(c.in[23] + (size_t)l * D * NG, c.in[25] + (size_t)l * D * NE, c.in[4] + l * D, WR);
        { const int tix = otid(); if (blockIdx.x == 0 && tix < 32) GCNT[tix] = 0; }
        break;
    case PH_ROUTE: route_phase(XB, WR, c.in[24] + l * NG, c.in[26] + l * NE, RS, AE, APOS, GATE, GCNT, lds); break;
    case PH_BUILD: build_phase(GCNT, AE, APOS, GATE, RS, NTP, TILEE, STOK, SA, SRS, SGATE, lds); break;
    case PH_MOE1: { g8::MoeSched S{D, D, D, XB, W1, (size_t)D * D, TILEE, STOK, __builtin_amdgcn_readfirstlane(g8::ld_agent(NTP))}; g8::gemm_phase(lds, S, g8::EpiMoe1{HB, SRS}); } break;
    case PH_MOE2: { g8::MoeSched S{DE, DE, DE, HB, W2, (size_t)D * DE, TILEE, nullptr, __builtin_amdgcn_readfirstlane(g8::ld_agent(NTP))}; g8::gemm_phase(lds, S, g8::EpiMoe2{YB, SA, SGATE}); } break;
    case PH_COMBINE: combine_phase(c.out, c.out, YB, XB, RS, SSP, nullptr, 0, WAF, ALR, lds); break;
    case PH_COMBINE_FIN: combine_phase(c.out, c.out, YB, XB, RS, SSP, c.in[6], 1, nullptr, nullptr, lds); break;
    case PH_GLA_PREP: gla_prep(c.in[15], c.in[19], c.in[2] + D, WGTM, WGFM, WGO, WAF, lds); break;
    case PH_GLA_DECAY: gla_decay(ALR, c.in[16], c.in[17], BTM, BFM, DLF, lds); break;
    case PH_GLA_IN: { g8::GlaInSched S{XB, WGTM, WGFM}; g8::gemm_phase(lds, S, g8::EpiGlaIn{QKR, KVT, RS, (const bf16_t*)BTM, (const bf16_t*)BFM}); } break;
    case PH_GLA_ATT: { g8::GlaAttSched<0> S{QKR, KVT}; g8::gemm_phase(lds, S, g8::EpiGlaAtt<0>{ATTB, UTB, DLF}); }
        { g8::GlaAttSched<1> S{QKR, KVT}; g8::gemm_phase(lds, S, g8::EpiGlaAtt<1>{ATTB, UTB, DLF}); } break;
    case PH_GLA_UT: { g8::GlaAttSched<1> S{QKR, KVT}; g8::gemm_phase(lds, S, g8::EpiGlaAtt<1>{ATTB, UTB, DLF}); } break;
    case PH_GLA_SCAN: gla_scan(UTB, DLF, SPB); break;
    case PH_GLA_O: { g8::GlaOSched S{QKR, KVT, ATTB, SPB}; g8::gemm_phase(lds, S, g8::EpiGlaO{OB}); } break;
    case PH_GLA_FIN: gla_fin(OB, QKR, c.in[18], GOB); break;
    case PH_CSUM: { static const size_t ro[10] = {OW_ACTA, OW_ACTB, OW_ACTC, OW_H, OW_Y, OW_QKR, OW_ATT, OW_UT, OW_O, OW_KVB};
        static const size_t rb[10] = {64 * MiB, 64 * MiB, 64 * MiB, 72 * MiB, 128 * MiB, 224 * MiB, 64 * MiB, 32 * MiB, 64 * MiB, 4 * MiB};
        const int r = l >> 1; csum_phase(ws + ro[r], rb[r], (unsigned long long*)(ws + OW_DBG) + 512 + r * 256, (unsigned*)(ws + OW_DBG) + r, l & 1, lds); } break;
    case PH_CSUM2: {
        const unsigned char* bp; size_t nb;
        switch (l) {
        case 0: bp = ws + OW_XB; nb = 64 * MiB; break;            case 1: bp = ws + OW_ACTA; nb = 64 * MiB; break;
        case 2: bp = ws + OW_ACTB; nb = 64 * MiB; break;          case 3: bp = (const unsigned char*)c.out; nb = 128 * MiB; break;
        case 4: bp = ws + OW_ACTA; nb = 64 * MiB; break;          case 5: bp = ws + OW_ACTC; nb = 64 * MiB; break;
        case 6: bp = ws + OW_ACTB; nb = 64 * MiB; break;          case 7: bp = ws + OW_ACTC; nb = 64 * MiB; break;
        case 8: bp = (const unsigned char*)c.out; nb = 128 * MiB; break;   case 9: bp = ws + OM_GATE; nb = NA * 4; break;
        case 10: bp = ws + OW_Y; nb = 128 * MiB; break;           case 11: bp = (const unsigned char*)c.out; nb = 128 * MiB; break;
        case 12: bp = ws + OW_BTM; nb = 128 * MiB; break;         case 13: bp = ws + OW_QKR; nb = 224 * MiB; break;
        case 14: bp = ws + OW_ATT; nb = 64 * MiB; break;          case 15: bp = ws + OW_UT; nb = 32 * MiB; break;
        case 16: bp = ws + OW_SP; nb = 32 * MiB; break;           case 17: bp = ws + OW_O; nb = 64 * MiB; break;
        case 18: bp = ws + OW_GO; nb = 64 * MiB; break;           case 19: bp = (const unsigned char*)c.out; nb = 128 * MiB; break;
        case 20: bp = ws + OW_ACTA; nb = 64 * MiB; break;         case 21: bp = ws + OW_ACTB; nb = 64 * MiB; break;
        case 22: bp = ws + OW_ACTC; nb = 64 * MiB; break;         case 23: bp = (const unsigned char*)c.out; nb = 128 * MiB; break;
        case 24: bp = ws + OM_GATE; nb = NA * 4; break;           case 25: bp = ws + OW_Y; nb = 128 * MiB; break;
        case 26: bp = ws + OW_RS; nb = T * 4; break;              case 27: bp = ws + OW_ALR; nb = 2 * MiB; break;
        default: bp = ws + OW_SSP; nb = 2 * MiB; break; }
        csum2_phase(bp, nb, (unsigned long long*)(ws + OW_DBG + 65536) + (size_t)l * 512, (unsigned*)(ws + OW_DBG) + l, lds); } break;
    case PH_XA_O_T: { g8::DenseSched S{4, 128 * 4, D, D, D, ACTC, WXO}; g8::gemm_phase(lds, S, g8::EpiXres{(bf16_t*)(ws + 424 * MiB), nullptr, nullptr}); } break;
    case PH_COMBINE_T: combine_phase(c.out, (float*)(ws + 296 * MiB), YB, (bf16_t*)(ws + 424 * MiB), (float*)(ws + 488 * MiB), (float*)(ws + 489 * MiB), nullptr, 0, nullptr, nullptr, lds); break;
    case PH_ROUTE_T: route_phase(XB, WR, c.in[24] + l * NG, c.in[26] + l * NE, (float*)(ws + 488 * MiB), (int*)(ws + 489 * MiB), (int*)(ws + 490 * MiB), (float*)(ws + 491 * MiB), (int*)(ws + 491 * MiB + 524288), lds); break;
    case PH_DIAG_KLOOP: { g8::DenseSched S{8, 128 * 8, D, D, D, XB, WCIN}; g8::gemm_phase(lds, S, g8::EpiNone{}); } break;
    case PH_FLAGOUT: flagout_phase(c.out, (unsigned*)(ws + OW_DBG)); break;
    case PH_GLA_OUT: { g8::DenseSched S{4, 128 * 4, D, D, D, GOB, WGO}; g8::gemm_phase(lds, S, g8::EpiXres{XB, nullptr, SSP}); } break;
    }
}
template <int PH> __global__ void __launch_bounds__(512, 2) k_opt(Ctx c, int l) {
    extern __shared__ __attribute__((aligned(16))) unsigned char dynlds[];
    run_phase(c, PH, l, (LAS unsigned char*)dynlds);
}

#ifndef ALLCG
#define ALLCG 0
#endif
#define XB_TMO      128
#define XB_XCNT(j)  (256  + 64 * (j))
#define XB_XSUB(j)  (1280 + 64 * (j))
#define XB_XGEN(j)  (2304 + 64 * (j))
#define XB_TOP      3328
#define XB_TOPGEN   3392
#define XCD_BAR_WORDS 3456
#define XB_SPIN_CAP (1u << 18)
__device__ __forceinline__ unsigned xb_ld(unsigned* p)              { return __hip_atomic_load(p, __ATOMIC_RELAXED, __HIP_MEMORY_SCOPE_AGENT); }
__device__ __forceinline__ unsigned xb_add(unsigned* p, unsigned v) { return __hip_atomic_fetch_add(p, v, __ATOMIC_RELAXED, __HIP_MEMORY_SCOPE_AGENT); }
__device__ __forceinline__ unsigned xb_xcc_id() { return (unsigned)__builtin_amdgcn_s_getreg((3 << 11) | 20) & 0xFu; }
#define XB_SPIN(cond, bar) do { unsigned _sp = 0; while (cond) { __builtin_amdgcn_s_sleep(1); \
    if ((++_sp & 255u) == 0u) { if (xb_ld(&(bar)[XB_TMO])) break; if (_sp > XB_SPIN_CAP) { atomicAdd(&(bar)[XB_TMO], 1u); break; } } } } while (0)
struct XcdBarrier { unsigned* bar; unsigned x; volatile LAS unsigned* st; };
__device__ __forceinline__ XcdBarrier xcd_barrier_post(unsigned* bar, volatile LAS unsigned* st) {
    XcdBarrier b; b.bar = bar; b.x = xb_xcc_id(); b.st = st;
    if (threadIdx.x == 0) (void)xb_add(&bar[XB_XCNT(b.x)], 1u);
    return b;
}
__device__ __forceinline__ void xcd_barrier_complete(unsigned* bar, unsigned x, unsigned& nloc, unsigned& nx) {
    const unsigned G = gridDim.x * gridDim.y * gridDim.z;
    unsigned sum, cnt, mine, sp = 0u;
    for (;;) {
        sum = 0u; cnt = 0u; mine = 0u;
#pragma unroll
        for (unsigned j = 0; j < 16; ++j) { const unsigned c = xb_ld(&bar[XB_XCNT(j)]); sum += c; cnt += (c > 0u) ? 1u : 0u; mine = (j == x) ? c : mine; }
        if (sum == G) break;
        __builtin_amdgcn_s_sleep(1);
        if ((++sp & 255u) == 0u) { if (xb_ld(&bar[XB_TMO])) break; if (sp > XB_SPIN_CAP) { atomicAdd(&bar[XB_TMO], 1u); break; } }
    }
    nloc = mine > 0u ? mine : 1u; nx = cnt > 0u ? cnt : 1u;
}
__device__ __forceinline__ void xcd_barrier(const XcdBarrier& b) {
    asm volatile("s_waitcnt vmcnt(0)" ::: "memory");
    __syncthreads();
    if (threadIdx.x == 0) {
        unsigned* bar = b.bar;
        __builtin_amdgcn_s_waitcnt(0);
        unsigned nloc = b.st[0], nx = b.st[1];
        if (nloc == 0u) { xcd_barrier_complete(bar, b.x, nloc, nx); b.st[0] = nloc; b.st[1] = nx; }
        const unsigned old = xb_add(&bar[XB_XSUB(b.x)], 1u);
        const unsigned gen = old / nloc;
        if (old + 1u == (gen + 1u) * nloc) {
            __builtin_amdgcn_fence(__ATOMIC_RELEASE, "agent");
            asm volatile("s_waitcnt vmcnt(0)" ::: "memory");
            const unsigned og = xb_add(&bar[XB_TOP], 1u);
            const unsigned tg = og / nx;
            if (og + 1u == (tg + 1u) * nx) xb_add(&bar[XB_TOPGEN], 1u);
            else XB_SPIN(xb_ld(&bar[XB_TOPGEN]) == tg, bar);
            __builtin_amdgcn_fence(__ATOMIC_ACQUIRE, "agent");
            xb_add(&bar[XB_XGEN(b.x)], 1u);
            asm volatile("s_waitcnt vmcnt(0)" ::: "memory");
        } else {
            XB_SPIN(xb_ld(&bar[XB_XGEN(b.x)]) == gen, bar);
            __builtin_amdgcn_fence(__ATOMIC_ACQUIRE, "agent");
            asm volatile("s_waitcnt vmcnt(0)" ::: "memory");
        }
    }
    __syncthreads();
}
template <int CODE> __device__ __forceinline__ void coop_step(const Ctx& c, LAS unsigned char* lds, cg::grid_group& grid, XcdBarrier& xb, bool sync_after, bool first) {
    run_phase(c, CODE >> 5, CODE & 31, lds);
    if (sync_after) {
        if (first || ALLCG) {
            unsigned* bar = (unsigned*)(c.ws + OW_BAR);
            if (first && blockIdx.x == 0) for (int i = threadIdx.x; i < XCD_BAR_WORDS; i += 512) bar[i] = 0u;
            asm volatile("s_waitcnt vmcnt(0) lgkmcnt(0)" ::: "memory");
            grid.sync();
            if (threadIdx.x < 64) { __builtin_amdgcn_fence(__ATOMIC_ACQUIRE, "agent"); asm volatile("s_waitcnt vmcnt(0)" ::: "memory"); }
            __syncthreads();
            if (first) xb = xcd_barrier_post(bar, xb.st);
        } else xcd_barrier(xb);
    }
}
template <int... CODES> __global__ void __launch_bounds__(512, 2) k_coop(Ctx c) {
    extern __shared__ __attribute__((aligned(16))) unsigned char dynlds[];
    cg::grid_group grid = cg::this_grid();
    LAS unsigned char* lds = (LAS unsigned char*)dynlds;
    volatile LAS unsigned* st = (volatile LAS unsigned*)(lds + LDS_BYTES - 16);
    if (threadIdx.x < 4) st[threadIdx.x] = 0u;
    __syncthreads();
    XcdBarrier xb; xb.bar = nullptr; xb.x = 0; xb.st = st;
    int idx = 0; constexpr int N = sizeof...(CODES);
    ((coop_step<CODES>(c, lds, grid, xb, idx + 1 < N, idx == 0), ++idx), ...);
}
#define CODE(ph, l) ((ph) * 32 + (l))
typedef void (*CoopFn)(Ctx);
extern "C" void kernel_launch(void* const* d_in, const int* in_sizes, int n_in, void* d_out, int out_size, void* d_ws, size_t ws_size, hipStream_t stream) {
    if (n_in != 30 || out_size != T * D || ws_size < OW_END) { fprintf(stderr, "kernel_launch: built for 30 inputs, %d outputs and >= %zu bytes of workspace; got n_in %d, out %d, ws %zu; nothing launched\n", T * D, (size_t)OW_END, n_in, out_size, ws_size); return; }
    Ctx c; memset(&c, 0, sizeof(c));
    for (int i = 0; i < 30; ++i) c.in[i] = (const float*)d_in[i];
    c.out = (float*)d_out; c.ws = (unsigned char*)d_ws;
    static CoopFn fn = k_coop<CODE(PH_PREP_ALL, 0), CODE(PH_CONV_IN, 0), CODE(PH_CONV_MID, 0), CODE(PH_CONV_OUT, 0),
                                         CODE(PH_XA_Q, 0), CODE(PH_XA_KV, 0), CODE(PH_XA_S, 0), CODE(PH_XA_PV, 0), CODE(PH_XA_O, 0),
                                         CODE(PH_ROUTE, 0), CODE(PH_BUILD, 0), CODE(PH_MOE1, 0), CODE(PH_MOE2, 0), CODE(PH_COMBINE, 0),
                                         CODE(PH_GLA_DECAY, 0), CODE(PH_GLA_IN, 0), CODE(PH_GLA_ATT, 0), CODE(PH_GLA_SCAN, 0), CODE(PH_GLA_O, 0), CODE(PH_GLA_FIN, 0), CODE(PH_GLA_OUT, 0),
                                         CODE(PH_XA_Q, 1), CODE(PH_XA_KV, 1), CODE(PH_XA_S, 1), CODE(PH_XA_PV, 1), CODE(PH_XA_O, 1),
                                         CODE(PH_ROUTE, 1), CODE(PH_BUILD, 1), CODE(PH_MOE1, 1), CODE(PH_MOE2, 1), CODE(PH_COMBINE_FIN, 1)>;
    static int grid = 0;
    if (!grid) {
        int dev = 0, cus = 0, per_cu = 0;
        (void)hipGetDevice(&dev); (void)hipDeviceGetAttribute(&cus, hipDeviceAttributeMultiprocessorCount, dev);
        (void)hipFuncSetAttribute((const void*)fn, hipFuncAttributeMaxDynamicSharedMemorySize, LDS_BYTES);
        (void)hipOccupancyMaxActiveBlocksPerMultiprocessor(&per_cu, fn, 512, LDS_BYTES);
        grid = cus * (per_cu < 1 ? 1 : per_cu); if (grid > 256) grid = 256;
        if (grid != 256) fprintf(stderr, "kernel_launch: %d CUs x %d workgroups: this kernel is laid out for 256 resident workgroups\n", cus, per_cu);
    }
    void* args[] = {&c};
    hipError_t e = hipLaunchCooperativeKernel((void*)fn, dim3(grid), dim3(512), args, LDS_BYTES, stream);
    if (e != hipSuccess) fprintf(stderr, "cooperative launch failed: %s (grid %d)\n", hipGetErrorString(e), grid);
}
```

```cpp
#include <hip/hip_runtime.h>
#include <hip/hip_cooperative_groups.h>
#include <cstdio>
#include <cstring>
namespace cg = cooperative_groups;

constexpr int D = 1024, NB = 4, S = 8192, T = NB * S, NMEM = 256;
constexpr int CONVK = 31;
constexpr int GDK = 512, GDVH = 256, GLA_COLS = 3088;
constexpr int NG = 4, NE = 32, DE = 512;
constexpr int NA = T * 2;
constexpr float EPS = 1e-6f;
constexpr size_t MiB = 1u << 20;

struct Ctx { const float* in[30]; float* out; unsigned char* ws; };

__device__ __forceinline__ float wave_sum(float v) {
#pragma unroll
    for (int o = 1; o < 64; o <<= 1) v += __shfl_xor(v, o);
    return v;
}

#define LAS __attribute__((address_space(3)))
typedef unsigned short bf16_t;
typedef short bf16x8 __attribute__((ext_vector_type(8)));
typedef float f32x4 __attribute__((ext_vector_type(4)));
typedef float f32x2 __attribute__((ext_vector_type(2)));
typedef unsigned u32x4 __attribute__((ext_vector_type(4)));
typedef unsigned u32x2 __attribute__((ext_vector_type(2)));

constexpr int LDS_BYTES = 160 * 1024;
constexpr int NSLOT2 = NA + NE * 256;
constexpr int MAXRT = NSLOT2 / 256;
constexpr size_t OW_XB = 0;
constexpr size_t OW_SSP = 64 * MiB;
constexpr size_t OW_RS = 66 * MiB;
constexpr size_t OW_PSUM = 67 * MiB;
constexpr size_t OW_MOE = 69 * MiB;
constexpr size_t OW_ACTA = 72 * MiB, OW_ACTB = 136 * MiB, OW_ACTC = 200 * MiB;
constexpr size_t OW_H = 72 * MiB, OW_Y = 144 * MiB, OW_WMOE = 272 * MiB;
constexpr size_t OW_KVB = 368 * MiB;
constexpr size_t OW_MEMNB = 502 * MiB;
constexpr size_t OW_WCIN = 550 * MiB, OW_WCOUT = 554 * MiB, OW_WXQ = 556 * MiB, OW_WXKV = 560 * MiB, OW_WXO = 568 * MiB, OW_WR = 572 * MiB, OW_BAR = 573 * MiB, OW_DBG = 574 * MiB, OW_END = 575 * MiB;
constexpr size_t OW_ATT = 360 * MiB, OW_QKR = 72 * MiB, OW_KVT = 200 * MiB, OW_BTM = 296 * MiB, OW_O = 296 * MiB, OW_BFM = 360 * MiB, OW_UT = 424 * MiB, OW_SP = 456 * MiB,
                 OW_ALR = 488 * MiB, OW_DL = 490 * MiB, OW_GO = 200 * MiB, OW_WGTM = 492 * MiB, OW_WGFM = 496 * MiB, OW_WGO = 499 * MiB, OW_WA = 501 * MiB;
constexpr size_t OM_GCNT = OW_MOE, OM_NT = OW_MOE + 256, OM_TILEE = OW_MOE + 512, OM_AE = OW_MOE + 4096, OM_APOS = OM_AE + NA * 4, OM_GATE = OM_APOS + NA * 4,
                 OM_STOK = OM_GATE + NA * 4, OM_SA = OM_STOK + NSLOT2 * 4, OM_SRS = OM_SA + NSLOT2 * 4, OM_SGATE = OM_SRS + NSLOT2 * 4, OM_END = OM_SGATE + NSLOT2 * 4;
static_assert(OM_END <= OW_ACTA, "MoE small arrays");

typedef __bf16 bf16x2_t __attribute__((ext_vector_type(2)));
__device__ __forceinline__ unsigned cvt_pk_bf16(float lo, float hi) { const f32x2 v = {lo, hi}; return __builtin_bit_cast(unsigned, __builtin_convertvector(v, bf16x2_t)); }
__device__ __forceinline__ int otid() { int t = threadIdx.x; asm volatile("" : "+v"(t)); return t; }
__device__ __forceinline__ u32x4 pack8(const f32x4& a, const f32x4& b) { u32x4 w; w.x = cvt_pk_bf16(a[0], a[1]); w.y = cvt_pk_bf16(a[2], a[3]); w.z = cvt_pk_bf16(b[0], b[1]); w.w = cvt_pk_bf16(b[2], b[3]); return w; }
__device__ __forceinline__ float bf_lo(unsigned w) { return __uint_as_float(w << 16); }
__device__ __forceinline__ float bf_hi(unsigned w) { return __uint_as_float(w & 0xffff0000u); }
__device__ __forceinline__ float fast_sigmoid(float x) { return __builtin_amdgcn_rcpf(1.0f + __builtin_amdgcn_exp2f(-1.4426950408889634f * x)); }

#ifndef LDS_POISON
#define LDS_POISON 0
#endif
namespace g8 {
constexpr int BM = 256, BK = 64, HALF = 128, HTB = HALF * BK * 2, STAGE_BYTES = 8 * HTB;
__device__ __forceinline__ int lds_byte(int r, int c) { const int st = (r >> 4) * 2 + (c >> 5), rr = r & 15, cc = c & 31, ob = rr * 64 + cc * 2; return st * 1024 + (ob ^ (((ob >> 9) & 1) << 5)); }
__device__ __forceinline__ void stage_rc(int b, int& R, int& C) { const int st = b / 1024, sb = b % 1024, swz = sb ^ (((sb >> 9) & 1) << 5); R = (st >> 1) * 16 + swz / 64; C = (st & 1) * 32 + (swz % 64) / 2; }
__device__ __forceinline__ int perm32(int rho) { const int n = rho >> 4, i = rho & 15; return 8 * (i >> 2) + 4 * n + (i & 3); }
struct Unit { int pm, pn, e; };

template <class Epi, class Sched>
__device__ __forceinline__ void gemm_phase(LAS unsigned char* lds, const Sched& S, const Epi& E) {
    int tid_ = threadIdx.x; asm volatile("" : "+v"(tid_));
    const int tid = tid_, wid = __builtin_amdgcn_readfirstlane(tid >> 6), lane = tid & 63, wr = wid >> 2, wc = wid & 3, fr = lane & 15, fq = lane >> 4;
    const size_t kstep = (size_t)(BK * 2);
    const unsigned ldsw = (unsigned)wid * 1024u;
    const int aoff = lds_byte(wr * 64 + fr, fq * 8), boff = lds_byte(wc * 32 + fr, fq * 8);
#define G8_SA(b, h) (((b) * 2 + (h)) * HTB)
#define G8_SB(b, h) ((4 + (b) * 2 + (h)) * HTB)
#define G8_STAGE(bufoff, gbase, vv) do { _Pragma("unroll") for (int _i = 0; _i < 2; ++_i) \
        __builtin_amdgcn_global_load_lds((const unsigned*)((const char*)(gbase) + (vv)[_i]), (LAS unsigned*)(lds + (bufoff) + ldsw + _i * 8192), 16, 0, 0); } while (0)
#define G8_LDA(dst, b, h) do { _Pragma("unroll") for (int m = 0; m < 4; ++m) _Pragma("unroll") for (int k = 0; k < 2; ++k) dst[m][k] = *(const LAS bf16x8*)(lds + G8_SA(b, h) + aoff + m * 2048 + k * 1024); } while (0)
#define G8_LDB(dst, b, h) do { _Pragma("unroll") for (int n = 0; n < 2; ++n) _Pragma("unroll") for (int k = 0; k < 2; ++k) dst[n][k] = *(const LAS bf16x8*)(lds + G8_SB(b, h) + boff + n * 2048 + k * 1024); } while (0)
#define G8_MMA(ai, bj, At, Bt) do { __builtin_amdgcn_s_setprio(1); _Pragma("unroll") for (int m = 0; m < 4; ++m) _Pragma("unroll") for (int n = 0; n < 2; ++n) _Pragma("unroll") for (int k = 0; k < 2; ++k) \
        acc[ai][bj][m][n] = __builtin_amdgcn_mfma_f32_16x16x32_bf16(Bt[n][k], At[m][k], acc[ai][bj][m][n], 0, 0, 0); __builtin_amdgcn_s_setprio(0); } while (0)
#define G8_WAIT_V(n) asm volatile("s_waitcnt vmcnt(" #n ")" ::: "memory")
#define G8_WAIT_L(n) asm volatile("s_waitcnt lgkmcnt(" #n ")" ::: "memory")
#define G8_BAR __builtin_amdgcn_s_barrier()
#define G8_SCHED __builtin_amdgcn_sched_barrier(0)
#define G8_VA(dst, u) do { const int _ac = S.a_col(u), _lda = S.lda(u); _Pragma("unroll") for (int _i = 0; _i < 2; ++_i) { int _R, _C; stage_rc(tid * 16 + _i * 8192, _R, _C); \
        _Pragma("unroll") for (int _h = 0; _h < 2; ++_h) dst[_h][_i] = (unsigned)(((size_t)S.a_row(u, _h * HALF + _R) * _lda + _ac + _C) * 2); } } while (0)
#define G8_VB(dst, hs, u) do { const int _ldb = S.ldb(u); hs = (size_t)HALF * _ldb * 2; _Pragma("unroll") for (int _i = 0; _i < 2; ++_i) { int _R, _C; stage_rc(tid * 16 + _i * 8192, _R, _C); \
        dst[_i] = (unsigned)(((_R & ~31) + perm32(_R & 31)) * _ldb + _C) * 2u; } } while (0)
    Unit cur, nxt; int ui = 0; bool aligned_end = false;
    if (!S.next(0, cur)) return;
#if LDS_POISON
    for (int i = tid; i < STAGE_BYTES / 16; i += 512) ((LAS u32x4*)lds)[i] = (u32x4){0x7fc07fc0u, 0x7fc07fc0u, 0x7fc07fc0u, 0x7fc07fc0u};
    __syncthreads();
#endif
    f32x4 acc[2][2][4][2];
#pragma unroll
    for (int a = 0; a < 2; ++a)
#pragma unroll
        for (int b = 0; b < 2; ++b)
#pragma unroll
            for (int m = 0; m < 4; ++m)
#pragma unroll
                for (int n = 0; n < 2; ++n) acc[a][b][m][n] = (f32x4){0.f, 0.f, 0.f, 0.f};
    bf16x8 At[4][2], B0[2][2], B1[2][2];
    unsigned va[2][2], nva[2][2], vb[2], nvb[2]; size_t hsB, nhsB;
    G8_VA(va, cur); G8_VB(vb, hsB, cur);
    const char* Ab = S.a_base(cur);
    const char* cB = S.b_base(cur);
    G8_STAGE(G8_SB(0, 0), cB, vb); G8_STAGE(G8_SA(0, 0), Ab, va[0]); G8_STAGE(G8_SB(0, 1), cB + hsB, vb); G8_STAGE(G8_SA(0, 1), Ab, va[1]);
    if (wr == 1) G8_BAR;
    G8_WAIT_V(4); G8_BAR;
    G8_STAGE(G8_SB(1, 0), cB + kstep, vb); G8_STAGE(G8_SA(1, 0), Ab + kstep, va[0]); G8_STAGE(G8_SB(1, 1), cB + hsB + kstep, vb);
    G8_WAIT_V(6); G8_BAR;
    for (;;) {
        const bool has_next = S.next(ui + 1, nxt);
        const char* nB = cB; const char* nAb = Ab;
        if (has_next) { nB = S.b_base(nxt); nAb = S.a_base(nxt); G8_VA(nva, nxt); G8_VB(nvb, nhsB, nxt); }
        else {
            nhsB = hsB;
#pragma unroll
            for (int i = 0; i < 2; ++i) { nvb[i] = vb[i];
#pragma unroll
                for (int h = 0; h < 2; ++h) nva[h][i] = va[h][i]; }
        }
        const int nt = S.nt(cur);
        for (int t = 0; t < nt; t += 2) {
            const bool last = (t == nt - 2);
            const char* a1 = Ab + (size_t)(t + 1) * kstep;
            const char* a2 = last ? nAb : Ab + (size_t)(t + 2) * kstep;
            const char* b2 = last ? nB : cB + (size_t)(t + 2) * kstep;
            const char* a3 = a2 + kstep; const char* b3 = b2 + kstep;
            const size_t hs2 = last ? nhsB : hsB;
            unsigned v2[2][2], vb2[2];
#pragma unroll
            for (int i = 0; i < 2; ++i) { vb2[i] = last ? nvb[i] : vb[i];
#pragma unroll
                for (int h = 0; h < 2; ++h) v2[h][i] = last ? nva[h][i] : va[h][i]; }
            G8_LDB(B0, 0, 0); G8_SCHED; G8_LDA(At, 0, 0); G8_STAGE(G8_SA(1, 1), a1, va[1]);
            G8_WAIT_L(8); G8_BAR; G8_WAIT_L(0); G8_MMA(0, 0, At, B0); G8_BAR; G8_SCHED;
            G8_LDB(B1, 0, 1); G8_STAGE(G8_SB(0, 0), b2, vb2);
            G8_BAR; G8_WAIT_L(0); G8_MMA(0, 1, At, B1); G8_BAR;
            G8_LDA(At, 0, 1); G8_STAGE(G8_SA(0, 0), a2, v2[0]);
            G8_BAR; G8_WAIT_L(0); G8_MMA(1, 0, At, B0); G8_BAR; G8_SCHED;
            G8_STAGE(G8_SB(0, 1), b2 + hs2, vb2);
            G8_WAIT_V(6); G8_BAR; G8_MMA(1, 1, At, B1); G8_BAR;
            G8_LDB(B0, 1, 0); G8_SCHED; G8_LDA(At, 1, 0); G8_STAGE(G8_SA(0, 1), a2, v2[1]);
            G8_WAIT_L(8); G8_BAR; G8_WAIT_L(0); G8_MMA(0, 0, At, B0); G8_BAR; G8_SCHED;
            G8_LDB(B1, 1, 1); G8_STAGE(G8_SB(1, 0), b3, vb2);
            G8_BAR; G8_WAIT_L(0); G8_MMA(0, 1, At, B1); G8_BAR;
            G8_LDA(At, 1, 1); G8_STAGE(G8_SA(1, 0), a3, v2[0]);
            G8_BAR; G8_WAIT_L(0); G8_MMA(1, 0, At, B0); G8_BAR; G8_SCHED;
            G8_STAGE(G8_SB(1, 1), b3 + hs2, vb2);
            G8_WAIT_V(6); G8_BAR; G8_MMA(1, 1, At, B1); G8_BAR;
        }
        const bool keep = S.cont(cur);
        if (!keep) {
            if (wr == 0) G8_BAR;
            E(acc, cur, wr, wc, fr, fq);
            if (has_next && wr == 1) G8_BAR;
        }
        if (!has_next) { aligned_end = !keep; break; }
        if (!keep) {
#pragma unroll
            for (int a = 0; a < 2; ++a)
#pragma unroll
                for (int b = 0; b < 2; ++b)
#pragma unroll
                    for (int m = 0; m < 4; ++m)
#pragma unroll
                        for (int n = 0; n < 2; ++n) acc[a][b][m][n] = (f32x4){0.f, 0.f, 0.f, 0.f};
        }
        cur = nxt; cB = nB; Ab = nAb; hsB = nhsB; ++ui;
#pragma unroll
        for (int i = 0; i < 2; ++i) { vb[i] = nvb[i];
#pragma unroll
            for (int h = 0; h < 2; ++h) va[h][i] = nva[h][i]; }
    }
    G8_WAIT_V(0);
    if (!aligned_end && wr == 0) G8_BAR;
    G8_BAR;
#undef G8_SA
#undef G8_SB
#undef G8_STAGE
#undef G8_LDA
#undef G8_LDB
#undef G8_MMA
#undef G8_WAIT_V
#undef G8_WAIT_L
#undef G8_BAR
#undef G8_SCHED
#undef G8_VA
#undef G8_VB
}

struct DenseSched {
    __device__ __forceinline__ int lda(const Unit&) const { return lda_; }
    __device__ __forceinline__ int ldb(const Unit&) const { return ldb_; }
    __device__ __forceinline__ int nt(const Unit&) const { return K / BK; }
    __device__ __forceinline__ bool cont(const Unit&) const { return false; }
    int nN, nU, K, lda_, ldb_; const bf16_t* A; const bf16_t* Bt;
    __device__ __forceinline__ const char* a_base(const Unit&) const { return (const char*)A; }
    __device__ __forceinline__ bool next(int i, Unit& u) const {
        const int c = blockIdx.x, per = gridDim.x >> 3, x = c & 7, j = c >> 3;
        const int chunk = (nU + 7) >> 3, lu = i * per + j;
        if (lu >= chunk) return false;
        const int un = x * chunk + lu; if (un >= nU) return false;
        u.pm = un / nN; u.pn = un - u.pm * nN; u.e = 0; return true; }
    __device__ __forceinline__ int a_row(const Unit& u, int r) const { return u.pm * BM + r; }
    __device__ __forceinline__ int a_col(const Unit&) const { return 0; }
    __device__ __forceinline__ const char* b_base(const Unit& u) const { return (const char*)(Bt + (size_t)u.pn * BM * ldb_); }
};

struct EpiGlu {
    bf16_t* U; const float* rs; const float* bias;
    __device__ __forceinline__ void operator()(const f32x4 (&acc)[2][2][4][2], const Unit& u, int wr, int wc, int fr, int fq) const {
        const int c0 = u.pn * 128 + wc * 32 + 8 * fq;
        const f32x4 ba0 = *(const f32x4*)(bias + c0), ba1 = *(const f32x4*)(bias + c0 + 4), bg0 = *(const f32x4*)(bias + 1024 + c0), bg1 = *(const f32x4*)(bias + 1024 + c0 + 4);
        float rv[2][4];
#pragma unroll
        for (int ai = 0; ai < 2; ++ai)
#pragma unroll
            for (int m = 0; m < 4; ++m) rv[ai][m] = rs[u.pm * BM + ai * HALF + wr * 64 + m * 16 + fr];
        __builtin_amdgcn_sched_barrier(0);
#pragma unroll
        for (int ai = 0; ai < 2; ++ai)
#pragma unroll
            for (int m = 0; m < 4; ++m) {
                const int row = u.pm * BM + ai * HALF + wr * 64 + m * 16 + fr; const float r = rv[ai][m];
                f32x4 o0, o1;
#pragma unroll
                for (int j = 0; j < 4; ++j) {
                    o0[j] = (acc[ai][0][m][0][j] * r + ba0[j]) * fast_sigmoid(acc[ai][1][m][0][j] * r + bg0[j]);
                    o1[j] = (acc[ai][0][m][1][j] * r + ba1[j]) * fast_sigmoid(acc[ai][1][m][1][j] * r + bg1[j]); }
                *(u32x4*)(U + (size_t)row * D + c0) = pack8(o0, o1);
            }
    }
};
struct EpiXres {
    bf16_t* XB; const float* bias; float* ssp;
    __device__ __forceinline__ void operator()(const f32x4 (&acc)[2][2][4][2], const Unit& u, int wr, int wc, int fr, int fq) const {
        f32x4 bv[2][2];
#pragma unroll
        for (int bj = 0; bj < 2; ++bj) { const int c0 = u.pn * BM + bj * HALF + wc * 32 + 8 * fq;
            bv[bj][0] = bias ? *(const f32x4*)(bias + c0) : (f32x4){0.f, 0.f, 0.f, 0.f}; bv[bj][1] = bias ? *(const f32x4*)(bias + c0 + 4) : (f32x4){0.f, 0.f, 0.f, 0.f}; }
#pragma unroll
        for (int ai = 0; ai < 2; ++ai) {
            u32x4 xv[2][4][2];
#pragma unroll
            for (int m = 0; m < 4; ++m)
#pragma unroll
                for (int bj = 0; bj < 2; ++bj) xv[ai][m][bj] = *(const u32x4*)(XB + (size_t)(u.pm * BM + ai * HALF + wr * 64 + m * 16 + fr) * D + u.pn * BM + bj * HALF + wc * 32 + 8 * fq);
            __builtin_amdgcn_sched_barrier(0);
#pragma unroll
            for (int m = 0; m < 4; ++m) {
                const int row = u.pm * BM + ai * HALF + wr * 64 + m * 16 + fr; float ss = 0.f;
#pragma unroll
                for (int bj = 0; bj < 2; ++bj) {
                    const size_t off = (size_t)row * D + u.pn * BM + bj * HALF + wc * 32 + 8 * fq; const u32x4 xw = xv[ai][m][bj];
                    const f32x4 v0 = (f32x4){bf_lo(xw.x), bf_hi(xw.x), bf_lo(xw.y), bf_hi(xw.y)} + acc[ai][bj][m][0] + bv[bj][0];
                    const f32x4 v1 = (f32x4){bf_lo(xw.z), bf_hi(xw.z), bf_lo(xw.w), bf_hi(xw.w)} + acc[ai][bj][m][1] + bv[bj][1];
                    const u32x4 w = pack8(v0, v1);
                    *(u32x4*)(XB + off) = w;
                    const float r0 = bf_lo(w.x), r1 = bf_hi(w.x), r2 = bf_lo(w.y), r3 = bf_hi(w.y), r4 = bf_lo(w.z), r5 = bf_hi(w.z), r6 = bf_lo(w.w), r7 = bf_hi(w.w);
                    ss += (r0 * r0 + r1 * r1) + (r2 * r2 + r3 * r3) + (r4 * r4 + r5 * r5) + (r6 * r6 + r7 * r7);
                }
                if (ssp) { ss += __shfl_xor(ss, 16); ss += __shfl_xor(ss, 32); if (fq == 0) ssp[(size_t)row * 16 + u.pn * 4 + wc] = ss; }
            }
            __builtin_amdgcn_sched_barrier(0);
        }
    }
};
struct AttnSched {
    __device__ __forceinline__ int lda(const Unit&) const { return lda_; }
    __device__ __forceinline__ int ldb(const Unit&) const { return ldb_; }
    __device__ __forceinline__ int nt(const Unit&) const { return K / BK; }
    __device__ __forceinline__ bool cont(const Unit&) const { return false; }
    int K, lda_, ldb_; const bf16_t* A; const bf16_t* Bm; int pv;
    __device__ __forceinline__ bool next(int i, Unit& u) const {
        const int c = blockIdx.x, per = gridDim.x >> 3, x = c & 7, j = c >> 3;
        const int lu = i * per + j; if (lu >= 64) return false;
        const int un = x * 64 + lu;
        u.pm = un >> 2; u.pn = 0; u.e = un & 3; return true; }
    __device__ __forceinline__ const char* a_base(const Unit&) const { return (const char*)A; }
    __device__ __forceinline__ int a_row(const Unit& u, int r) const { return u.pm * BM + r; }
    __device__ __forceinline__ int a_col(const Unit& u) const { return u.e * 256; }
    __device__ __forceinline__ const char* b_base(const Unit& u) const { const int b = u.pm >> 5;
        return pv ? (const char*)(Bm + (size_t)(b * 4 + u.e) * 65536) : (const char*)(Bm + (size_t)(b * 256) * 1024 + u.e * 256); }
};
struct KVSched {
    __device__ __forceinline__ int lda(const Unit&) const { return lda_; }
    __device__ __forceinline__ int ldb(const Unit&) const { return ldb_; }
    __device__ __forceinline__ int nt(const Unit&) const { return K / BK; }
    __device__ __forceinline__ bool cont(const Unit&) const { return false; }
    int K, lda_, ldb_; const bf16_t* MEMNB; const bf16_t* WKV;
    __device__ __forceinline__ bool next(int i, Unit& u) const {
        const int un = i * (int)gridDim.x + (int)blockIdx.x; if (un >= 32) return false;
        u.e = un >> 4; u.pm = (un & 15) >> 2; u.pn = un & 3; return true; }
    __device__ __forceinline__ const char* a_base(const Unit& u) const { return u.e ? (const char*)(WKV + (size_t)1024 * 1024) : (const char*)MEMNB; }
    __device__ __forceinline__ int a_row(const Unit& u, int r) const { return u.pm * BM + r; }
    __device__ __forceinline__ int a_col(const Unit&) const { return 0; }
    __device__ __forceinline__ const char* b_base(const Unit& u) const { return u.e ? (const char*)(MEMNB + (size_t)u.pn * BM * 1024) : (const char*)(WKV + (size_t)u.pn * BM * 1024); }
};
__device__ __forceinline__ float ssp_rs(const float* ssp, int row) {
    const f32x4 a = *(const f32x4*)(ssp + (size_t)row * 16), b = *(const f32x4*)(ssp + (size_t)row * 16 + 4), c = *(const f32x4*)(ssp + (size_t)row * 16 + 8), d = *(const f32x4*)(ssp + (size_t)row * 16 + 12);
    const float s = ((a[0] + a[1]) + (a[2] + a[3])) + ((b[0] + b[1]) + (b[2] + b[3])) + ((c[0] + c[1]) + (c[2] + c[3])) + ((d[0] + d[1]) + (d[2] + d[3]));
    return rsqrtf(s * (1.0f / D) + EPS);
}
struct EpiRowScale {
    bf16_t* O; int ldo; const float* ssp; const float* rs; float scale; int qtiles; float qscale;
    __device__ __forceinline__ void operator()(const f32x4 (&acc)[2][2][4][2], const Unit& u, int wr, int wc, int fr, int fq) const {
        const float cs = scale * (u.pn < qtiles ? qscale : 1.0f);
        float rv[2][4];
        if (rs) {
#pragma unroll
            for (int ai = 0; ai < 2; ++ai)
#pragma unroll
                for (int m = 0; m < 4; ++m) rv[ai][m] = rs[u.pm * BM + ai * HALF + wr * 64 + m * 16 + fr];
        } else {
#pragma unroll
            for (int ai = 0; ai < 2; ++ai) {
                f32x4 p[4][4];
#pragma unroll
                for (int m = 0; m < 4; ++m)
#pragma unroll
                    for (int q = 0; q < 4; ++q) p[m][q] = *(const f32x4*)(ssp + (size_t)(u.pm * BM + ai * HALF + wr * 64 + m * 16 + fr) * 16 + 4 * q);
                __builtin_amdgcn_sched_barrier(0);
#pragma unroll
                for (int m = 0; m < 4; ++m) { float sm = 0.f;
#pragma unroll
                    for (int q = 0; q < 4; ++q) sm += (p[m][q][0] + p[m][q][1]) + (p[m][q][2] + p[m][q][3]);
                    rv[ai][m] = rsqrtf(sm * (1.0f / D) + EPS); }
            }
        }
        __builtin_amdgcn_sched_barrier(0);
#pragma unroll
        for (int ai = 0; ai < 2; ++ai)
#pragma unroll
            for (int m = 0; m < 4; ++m) {
                const int row = u.pm * BM + ai * HALF + wr * 64 + m * 16 + fr;
                const float r = rv[ai][m] * cs;
#pragma unroll
                for (int bj = 0; bj < 2; ++bj) { const int c0 = u.pn * BM + bj * HALF + wc * 32 + 8 * fq;
                    *(u32x4*)(O + (size_t)row * ldo + c0) = pack8(acc[ai][bj][m][0] * r, acc[ai][bj][m][1] * r); }
            }
    }
};
struct EpiKV {
    bf16_t* Kb; bf16_t* VT;
    __device__ __forceinline__ void operator()(const f32x4 (&acc)[2][2][4][2], const Unit& u, int wr, int wc, int fr, int fq) const {
        bf16_t* base = u.e ? VT + (size_t)(u.pn * 4 + u.pm) * 65536 : Kb + (size_t)u.pm * BM * 1024 + u.pn * BM;
        const int ld = u.e ? 256 : 1024;
#pragma unroll
        for (int ai = 0; ai < 2; ++ai)
#pragma unroll
            for (int m = 0; m < 4; ++m) { const int r = ai * HALF + wr * 64 + m * 16 + fr;
#pragma unroll
                for (int bj = 0; bj < 2; ++bj) { const int c0 = bj * HALF + wc * 32 + 8 * fq;
                    *(u32x4*)(base + (size_t)r * ld + c0) = pack8(acc[ai][bj][m][0], acc[ai][bj][m][1]); } }
    }
};
struct EpiS {
    bf16_t* P; float* psum;
    __device__ __forceinline__ void operator()(const f32x4 (&acc)[2][2][4][2], const Unit& u, int wr, int wc, int fr, int fq) const {
#pragma unroll
        for (int ai = 0; ai < 2; ++ai)
#pragma unroll
            for (int m = 0; m < 4; ++m) {
                const int row = u.pm * BM + ai * HALF + wr * 64 + m * 16 + fr; float ps = 0.f;
#pragma unroll
                for (int bj = 0; bj < 2; ++bj) { const int c0 = u.e * 256 + bj * HALF + wc * 32 + 8 * fq;
                    f32x4 e0, e1;
#pragma unroll
                    for (int j = 0; j < 4; ++j) { e0[j] = __builtin_amdgcn_exp2f(acc[ai][bj][m][0][j] * 1.4426950408889634f); e1[j] = __builtin_amdgcn_exp2f(acc[ai][bj][m][1][j] * 1.4426950408889634f); }
                    const u32x4 w = pack8(e0, e1);
                    *(u32x4*)(P + (size_t)row * D + c0) = w;
                    ps += (bf_lo(w.x) + bf_hi(w.x)) + (bf_lo(w.y) + bf_hi(w.y)) + (bf_lo(w.z) + bf_hi(w.z)) + (bf_lo(w.w) + bf_hi(w.w)); }
                ps += __shfl_xor(ps, 16); ps += __shfl_xor(ps, 32);
                if (fq == 0) psum[(size_t)row * 16 + u.e * 4 + wc] = ps;
            }
    }
};
struct EpiRaw {
    bf16_t* O;
    __device__ __forceinline__ void operator()(const f32x4 (&acc)[2][2][4][2], const Unit& u, int wr, int wc, int fr, int fq) const {
#pragma unroll
        for (int ai = 0; ai < 2; ++ai)
#pragma unroll
            for (int m = 0; m < 4; ++m) { const int row = u.pm * BM + ai * HALF + wr * 64 + m * 16 + fr;
#pragma unroll
                for (int bj = 0; bj < 2; ++bj) { const int c0 = u.e * 256 + bj * HALF + wc * 32 + 8 * fq;
                    *(u32x4*)(O + (size_t)row * D + c0) = pack8(acc[ai][bj][m][0], acc[ai][bj][m][1]); } }
    }
};
struct EpiNone {
    __device__ __forceinline__ void operator()(const f32x4 (&acc)[2][2][4][2], const Unit& u, int wr, int wc, int fr, int fq) const {
#pragma unroll
        for (int ai = 0; ai < 2; ++ai)
#pragma unroll
            for (int bj = 0; bj < 2; ++bj)
#pragma unroll
                for (int m = 0; m < 4; ++m)
#pragma unroll
                    for (int n = 0; n < 2; ++n) asm volatile("" :: "v"(acc[ai][bj][m][n]));
    }
};
struct EpiPV {
    bf16_t* O; const float* psum;
    __device__ __forceinline__ void operator()(const f32x4 (&acc)[2][2][4][2], const Unit& u, int wr, int wc, int fr, int fq) const {
        f32x4 sv[2][4];
#pragma unroll
        for (int ai = 0; ai < 2; ++ai)
#pragma unroll
            for (int m = 0; m < 4; ++m) sv[ai][m] = *(const f32x4*)(psum + (size_t)(u.pm * BM + ai * HALF + wr * 64 + m * 16 + fr) * 16 + u.e * 4);
        __builtin_amdgcn_sched_barrier(0);
#pragma unroll
        for (int ai = 0; ai < 2; ++ai)
#pragma unroll
            for (int m = 0; m < 4; ++m) {
                const int row = u.pm * BM + ai * HALF + wr * 64 + m * 16 + fr;
                const float inv = 1.0f / ((sv[ai][m][0] + sv[ai][m][1]) + (sv[ai][m][2] + sv[ai][m][3]));
#pragma unroll
                for (int bj = 0; bj < 2; ++bj) { const int c0 = u.e * 256 + bj * HALF + wc * 32 + 8 * fq;
                    *(u32x4*)(O + (size_t)row * D + c0) = pack8(acc[ai][bj][m][0] * inv, acc[ai][bj][m][1] * inv); }
            }
    }
};

__device__ __forceinline__ int ld_agent(const int* p) { return __hip_atomic_load(p, __ATOMIC_RELAXED, __HIP_MEMORY_SCOPE_AGENT); }
struct MoeSched {
    __device__ __forceinline__ int lda(const Unit&) const { return lda_; }
    __device__ __forceinline__ int ldb(const Unit&) const { return ldb_; }
    __device__ __forceinline__ int nt(const Unit&) const { return K / BK; }
    __device__ __forceinline__ bool cont(const Unit&) const { return false; }
    int K, lda_, ldb_; const bf16_t* A; const bf16_t* W; size_t wstride; const int* tile_e; const int* slot_tok; int NT;
    __device__ __forceinline__ bool next(int i, Unit& u) const {
        const int c = blockIdx.x, per = gridDim.x >> 3, x = c & 7, j = c >> 3;
        const int tpx = (NT + 7) >> 3, lu = i * per + j, lrt = lu >> 2;
        if (lrt >= tpx) return false;
        const int rt = x * tpx + lrt; if (rt >= NT) return false;
        u.pm = rt; u.pn = lu & 3; u.e = __builtin_amdgcn_readfirstlane(ld_agent(tile_e + rt)); return true; }
    __device__ __forceinline__ const char* a_base(const Unit&) const { return (const char*)A; }
    __device__ __forceinline__ int a_row(const Unit& u, int r) const { return slot_tok ? slot_tok[u.pm * BM + r] : u.pm * BM + r; }
    __device__ __forceinline__ int a_col(const Unit&) const { return 0; }
    __device__ __forceinline__ const char* b_base(const Unit& u) const { return (const char*)(W + (size_t)u.e * wstride + (size_t)u.pn * BM * ldb_); }
};
struct EpiMoe1 {
    bf16_t* H; const float* slot_rs;
    __device__ __forceinline__ void operator()(const f32x4 (&acc)[2][2][4][2], const Unit& u, int wr, int wc, int fr, int fq) const {
        const int c0 = u.pn * 128 + wc * 32 + 8 * fq;
        float rv[2][4];
#pragma unroll
        for (int ai = 0; ai < 2; ++ai)
#pragma unroll
            for (int m = 0; m < 4; ++m) rv[ai][m] = slot_rs[u.pm * BM + ai * HALF + wr * 64 + m * 16 + fr];
        __builtin_amdgcn_sched_barrier(0);
#pragma unroll
        for (int ai = 0; ai < 2; ++ai)
#pragma unroll
            for (int m = 0; m < 4; ++m) {
                const int row = u.pm * BM + ai * HALF + wr * 64 + m * 16 + fr; const float r = rv[ai][m];
                f32x4 o0, o1;
#pragma unroll
                for (int j = 0; j < 4; ++j) {
                    const float g0 = acc[ai][0][m][0][j] * r, g1 = acc[ai][0][m][1][j] * r;
                    o0[j] = g0 * fast_sigmoid(g0) * (acc[ai][1][m][0][j] * r);
                    o1[j] = g1 * fast_sigmoid(g1) * (acc[ai][1][m][1][j] * r); }
                *(u32x4*)(H + (size_t)row * DE + c0) = pack8(o0, o1);
            }
    }
};
struct EpiMoe2 {
    bf16_t* Y; const int* slot_a; const float* slot_gate;
    __device__ __forceinline__ void operator()(const f32x4 (&acc)[2][2][4][2], const Unit& u, int wr, int wc, int fr, int fq) const {
        int av[2][4]; float gv[2][4];
#pragma unroll
        for (int ai = 0; ai < 2; ++ai)
#pragma unroll
            for (int m = 0; m < 4; ++m) { const int row = u.pm * BM + ai * HALF + wr * 64 + m * 16 + fr; av[ai][m] = slot_a[row]; gv[ai][m] = slot_gate[row]; }
        __builtin_amdgcn_sched_barrier(0);
#pragma unroll
        for (int ai = 0; ai < 2; ++ai)
#pragma unroll
            for (int m = 0; m < 4; ++m) {
                const int a = av[ai][m]; const float g = gv[ai][m];
                if (a >= 0) {
#pragma unroll
                    for (int bj = 0; bj < 2; ++bj) { const int c0 = u.pn * BM + bj * HALF + wc * 32 + 8 * fq;
                        *(u32x4*)(Y + (size_t)a * D + c0) = pack8(acc[ai][bj][m][0] * g, acc[ai][bj][m][1] * g); }
                }
            }
    }
};

struct GlaInSched {
    const bf16_t* XB; const bf16_t* WTM; const bf16_t* WFM;
    __device__ __forceinline__ int lda(const Unit&) const { return D; }
    __device__ __forceinline__ int ldb(const Unit&) const { return D; }
    __device__ __forceinline__ int nt(const Unit&) const { return D / BK; }
    __device__ __forceinline__ bool cont(const Unit&) const { return false; }
    __device__ __forceinline__ bool next(int i, Unit& u) const {
        const int c = blockIdx.x, per = gridDim.x >> 3, x = c & 7, j = c >> 3, lu = i * per + j;
        if (lu >= 224) return false;
        const int un = x * 224 + lu;
        if (un < 1024) { u.e = 0; u.pm = un >> 3; u.pn = un & 7; } else { const int v = un - 1024; u.e = 1; u.pn = v / 6; u.pm = v - u.pn * 6; }
        return true; }
    __device__ __forceinline__ const char* a_base(const Unit& u) const { return u.e ? (const char*)WFM : (const char*)XB; }
    __device__ __forceinline__ int a_row(const Unit& u, int r) const { return u.pm * BM + r; }
    __device__ __forceinline__ int a_col(const Unit&) const { return 0; }
    __device__ __forceinline__ const char* b_base(const Unit& u) const { return u.e ? (const char*)(XB + (size_t)u.pn * BM * D) : (const char*)(WTM + (size_t)u.pn * BM * D); }
};

struct EpiGlaIn {
    bf16_t* QKR; bf16_t* KVT; const float* RS; const bf16_t* EQ; const bf16_t* EKF;
    __device__ __forceinline__ void operator()(const f32x4 (&acc)[2][2][4][2], const Unit& u, int wr, int wc, int fr, int fq) const {
        if (u.e == 0) {
            float rv[2][4];
#pragma unroll
            for (int ai = 0; ai < 2; ++ai)
#pragma unroll
                for (int m = 0; m < 4; ++m) rv[ai][m] = RS[u.pm * BM + ai * HALF + wr * 64 + m * 16 + fr];
            const float qs = u.pn < 2 ? 0.08838834764831845f : 1.0f;
            const bf16_t* F = EQ + (u.pn < 2 ? (size_t)0 : (size_t)T * 512);
#pragma unroll
            for (int ai = 0; ai < 2; ++ai) {
                u32x4 fv[4][2];
                if (u.pn < 4) {
#pragma unroll
                    for (int m = 0; m < 4; ++m)
#pragma unroll
                        for (int bj = 0; bj < 2; ++bj) { const int row = u.pm * BM + ai * HALF + wr * 64 + m * 16 + fr, kf = (u.pn * BM + bj * HALF + wc * 32 + 8 * fq) & 511;
                            fv[m][bj] = *(const u32x4*)(F + (size_t)row * 512 + kf); }
                }
                __builtin_amdgcn_sched_barrier(0);
#pragma unroll
                for (int m = 0; m < 4; ++m) {
                    const int row = u.pm * BM + ai * HALF + wr * 64 + m * 16 + fr; const float r = rv[ai][m] * qs;
#pragma unroll
                    for (int bj = 0; bj < 2; ++bj) { const int c0 = u.pn * BM + bj * HALF + wc * 32 + 8 * fq;
                        f32x4 s0 = (f32x4){r, r, r, r}, s1 = s0;
                        if (u.pn < 4) { const u32x4 w = fv[m][bj];
                            s0 *= (f32x4){bf_lo(w.x), bf_hi(w.x), bf_lo(w.y), bf_hi(w.y)}; s1 *= (f32x4){bf_lo(w.z), bf_hi(w.z), bf_lo(w.w), bf_hi(w.w)}; }
                        *(u32x4*)(QKR + (size_t)row * 2048 + c0) = pack8(acc[ai][bj][m][0] * s0, acc[ai][bj][m][1] * s1); }
                }
                __builtin_amdgcn_sched_barrier(0);
            }
        } else {
#pragma unroll
            for (int bj = 0; bj < 2; ++bj) { const int t0 = u.pn * BM + bj * HALF + wc * 32 + 8 * fq;
                const f32x4 r0 = *(const f32x4*)(RS + t0), r1 = *(const f32x4*)(RS + t0 + 4);
                u32x4 fv[2][4];
                if (u.pm < 2) {
#pragma unroll
                    for (int ai = 0; ai < 2; ++ai)
#pragma unroll
                        for (int m = 0; m < 4; ++m) fv[ai][m] = *(const u32x4*)(EKF + (size_t)(u.pm * BM + ai * HALF + wr * 64 + m * 16 + fr) * T + t0);
                }
                __builtin_amdgcn_sched_barrier(0);
#pragma unroll
                for (int ai = 0; ai < 2; ++ai)
#pragma unroll
                    for (int m = 0; m < 4; ++m) { const int f = u.pm * BM + ai * HALF + wr * 64 + m * 16 + fr;
                        f32x4 s0 = r0, s1 = r1;
                        if (u.pm < 2) { const u32x4 w = fv[ai][m];
                            s0 *= (f32x4){bf_lo(w.x), bf_hi(w.x), bf_lo(w.y), bf_hi(w.y)}; s1 *= (f32x4){bf_lo(w.z), bf_hi(w.z), bf_lo(w.w), bf_hi(w.w)}; }
                        *(u32x4*)(KVT + (size_t)f * T + t0) = pack8(acc[ai][bj][m][0] * s0, acc[ai][bj][m][1] * s1); }
                __builtin_amdgcn_sched_barrier(0);
            }
        }
    }
};
template <int TYP> struct GlaAttSched {
    const bf16_t* QKR; const bf16_t* KVT;
    __device__ __forceinline__ bool next(int i, Unit& u) const {
        const int c = blockIdx.x, per = gridDim.x >> 3, x = c & 7, j = c >> 3, lu = i * per + j;
        if (lu >= 64) return false;
        const int un = x * 64 + lu, bh = un >> 5, cc = un & 31;
        u.e = TYP; u.pm = (bh >> 2) * 32 + cc; u.pn = bh & 3; return true; }
    __device__ __forceinline__ int lda(const Unit& u) const { return TYP ? T : 2048; }
    __device__ __forceinline__ int ldb(const Unit& u) const { return TYP ? T : 2048; }
    __device__ __forceinline__ int nt(const Unit& u) const { int n = TYP ? 4 : 2; asm volatile("" : "+s"(n)); return n; }
    __device__ __forceinline__ bool cont(const Unit&) const { return false; }
    __device__ __forceinline__ const char* a_base(const Unit& u) const { return TYP ? (const char*)KVT : (const char*)QKR; }
    __device__ __forceinline__ int a_row(const Unit& u, int r) const { return TYP ? 512 + u.pn * 256 + r : u.pm * BM + r; }
    __device__ __forceinline__ int a_col(const Unit& u) const { return TYP ? u.pm * BM : u.pn * 128; }
    __device__ __forceinline__ const char* b_base(const Unit& u) const {
        return TYP ? (const char*)(KVT + (size_t)(u.pn * 128) * T + (size_t)u.pm * BM) : (const char*)(QKR + (size_t)u.pm * BM * 2048 + 512 + u.pn * 128); }
};
template <int TYP> struct EpiGlaAtt {
    bf16_t* ATT; bf16_t* UT; const float* DL;
    __device__ __forceinline__ void operator()(const f32x4 (&acc)[2][2][4][2], const Unit& u, int wr, int wc, int fr, int fq) const {
        if (TYP == 0) {
#pragma unroll
            for (int ai = 0; ai < 2; ++ai)
#pragma unroll
                for (int m = 0; m < 4; ++m) { const int rit = ai * HALF + wr * 64 + m * 16 + fr;
#pragma unroll
                    for (int bj = 0; bj < 2; ++bj) { const int c0 = bj * HALF + wc * 32 + 8 * fq;
                        f32x4 v0 = acc[ai][bj][m][0], v1 = acc[ai][bj][m][1];
#pragma unroll
                        for (int j = 0; j < 4; ++j) { if (c0 + j > rit) v0[j] = 0.f; if (c0 + 4 + j > rit) v1[j] = 0.f; }
                        *(u32x4*)(ATT + (size_t)(u.pm * BM + rit) * D + u.pn * 256 + c0) = pack8(v0, v1); }
                }
        } else {
            const int k0 = wc * 32 + 8 * fq;
            const f32x4 d0 = *(const f32x4*)(DL + (size_t)u.pm * 512 + u.pn * 128 + k0), d1 = *(const f32x4*)(DL + (size_t)u.pm * 512 + u.pn * 128 + k0 + 4);
            const int b = u.pm >> 5, cc = u.pm & 31; bf16_t* base = UT + (size_t)((b * 4 + u.pn) * 32 + cc) * 32768;
#pragma unroll
            for (int ai = 0; ai < 2; ++ai)
#pragma unroll
                for (int m = 0; m < 4; ++m) { const int dv = ai * HALF + wr * 64 + m * 16 + fr;
                    *(u32x4*)(base + (size_t)dv * 128 + k0) = pack8(acc[ai][0][m][0] * d0, acc[ai][0][m][1] * d1); }
        }
    }
};
struct GlaOSched {
    const bf16_t* QKR; const bf16_t* KVT; const bf16_t* ATT; const bf16_t* SP;
    __device__ __forceinline__ bool next(int i, Unit& u) const {
        const int c = blockIdx.x, per = gridDim.x >> 3, x = c & 7, j = c >> 3, pl = (i >> 1) * per + j;
        if (pl >= 64) return false;
        const int w = x * 64 + pl, bh = w >> 5, cc = w & 31;
        u.e = i & 1; u.pm = (bh >> 2) * 32 + cc; u.pn = bh & 3; return true; }
    __device__ __forceinline__ int lda(const Unit& u) const { return u.e ? D : 2048; }
    __device__ __forceinline__ int ldb(const Unit& u) const { return u.e ? T : 128; }
    __device__ __forceinline__ int nt(const Unit& u) const { return u.e ? 4 : 2; }
    __device__ __forceinline__ bool cont(const Unit& u) const { return u.e == 0; }
    __device__ __forceinline__ const char* a_base(const Unit& u) const { return u.e ? (const char*)ATT : (const char*)QKR; }
    __device__ __forceinline__ int a_row(const Unit& u, int r) const { return u.pm * BM + r; }
    __device__ __forceinline__ int a_col(const Unit& u) const { return u.e ? u.pn * 256 : u.pn * 128; }
    __device__ __forceinline__ const char* b_base(const Unit& u) const { const int b = u.pm >> 5, cc = u.pm & 31;
        return u.e ? (const char*)(KVT + (size_t)(512 + u.pn * 256) * T + (size_t)u.pm * BM) : (const char*)(SP + (size_t)((b * 4 + u.pn) * 32 + cc) * 32768); }
};
struct EpiGlaO {
    bf16_t* O;
    __device__ __forceinline__ void operator()(const f32x4 (&acc)[2][2][4][2], const Unit& u, int wr, int wc, int fr, int fq) const {
#pragma unroll
        for (int ai = 0; ai < 2; ++ai)
#pragma unroll
            for (int m = 0; m < 4; ++m) { const int row = u.pm * BM + ai * HALF + wr * 64 + m * 16 + fr;
#pragma unroll
                for (int bj = 0; bj < 2; ++bj) { const int c0 = u.pn * 256 + bj * HALF + wc * 32 + 8 * fq;
                    *(u32x4*)(O + (size_t)row * D + c0) = pack8(acc[ai][bj][m][0], acc[ai][bj][m][1]); } }
    }
};
}

struct CvtJob { const float* W; int ldw, col0, K; const float* g; bf16_t* Bt; int il, half, nblk; };
__device__ __forceinline__ void cvt_load(const CvtJob& j, int item, int lane, f32x4 (&v)[8]) {
    const int kb = item / j.nblk, nb = item - kb * j.nblk, k0 = 64 * kb, n0 = 32 * nb;
    const float* p = j.W + (size_t)(k0 + (lane >> 3)) * j.ldw + j.col0 + n0 + 4 * (lane & 7);
#pragma unroll
    for (int i = 0; i < 8; ++i) v[i] = *(const f32x4*)(p + (size_t)(8 * i) * j.ldw);
    if (j.g) {
#pragma unroll
        for (int i = 0; i < 8; ++i) v[i] *= j.g[k0 + 8 * i + (lane >> 3)]; }
}
__device__ __forceinline__ void cvt_store(const CvtJob& j, int item, int lane, LAS float* scr, const f32x4 (&v)[8]) {
    const int kb = item / j.nblk, nb = item - kb * j.nblk, k0 = 64 * kb, n0 = 32 * nb;
#pragma unroll
    for (int i = 0; i < 8; ++i) { LAS float* d = scr + (8 * i + (lane >> 3)) * 33 + 4 * (lane & 7); d[0] = v[i][0]; d[1] = v[i][1]; d[2] = v[i][2]; d[3] = v[i][3]; }
    asm volatile("s_waitcnt lgkmcnt(0)" ::: "memory");
    const int c = lane & 7;
#pragma unroll
    for (int q = 0; q < 4; ++q) { const int n = (lane >> 3) + 8 * q; const LAS float* s = scr + (8 * c) * 33 + n;
        u32x4 o; o.x = cvt_pk_bf16(s[0 * 33], s[1 * 33]); o.y = cvt_pk_bf16(s[2 * 33], s[3 * 33]); o.z = cvt_pk_bf16(s[4 * 33], s[5 * 33]); o.w = cvt_pk_bf16(s[6 * 33], s[7 * 33]);
        const int nn = n0 + n, drow = j.il ? ((nn >> 7) * 256 + j.half * 128 + (nn & 127)) : nn;
        *(u32x4*)(j.Bt + (size_t)drow * j.K + k0 + 8 * c) = o; }
    asm volatile("s_waitcnt lgkmcnt(0)" ::: "memory");
}
__device__ __forceinline__ void cvt_matrix(const float* W, int ldw, int col0, int ncols, int K, const float* g, bf16_t* Bt, int il, int half, LAS unsigned char* lds, int woff = 0) {
    const int tix = otid();
    const int lane = tix & 63, wv = tix >> 6;
    LAS float* scr = (LAS float*)(lds + wv * 8704);
    const int ngw = gridDim.x * 8; int gw = blockIdx.x * 8 + wv - (woff % ngw); if (gw < 0) gw += ngw;
    const CvtJob j{W, ldw, col0, K, g, Bt, il, half, ncols / 32};
    const int nitems = (K / 64) * j.nblk;
    f32x4 cur[8], nxt[8];
    int it = gw; if (it < nitems) cvt_load(j, it, lane, cur);
    for (; it < nitems; it += ngw) {
        const int itn = it + ngw; if (itn < nitems) cvt_load(j, itn, lane, nxt);
        cvt_store(j, it, lane, scr, cur);
#pragma unroll
        for (int i = 0; i < 8; ++i) cur[i] = nxt[i];
    }
}
__device__ __forceinline__ void rows_prep(const float* x, bf16_t* XB, float* rs, float* ssp, int rows) {
    const int tix = otid();
    const int lane = tix & 63;
    const int gw = (blockIdx.x * blockDim.x + tix) >> 6, ngw = (gridDim.x * blockDim.x) >> 6;
    for (int r = gw; r < rows; r += ngw) {
        const f32x4* xr = (const f32x4*)(x + (size_t)r * D);
        f32x4 v[4]; float s = 0.f;
#pragma unroll
        for (int j = 0; j < 4; ++j) { v[j] = xr[lane + 64 * j]; s += (v[j][0] * v[j][0] + v[j][1] * v[j][1]) + (v[j][2] * v[j][2] + v[j][3] * v[j][3]); }
        s = wave_sum(s);
        if (lane == 0) rs[r] = rsqrtf(s * (1.0f / D) + EPS);
        if (ssp && lane < 16) ssp[(size_t)r * 16 + lane] = lane == 0 ? s : 0.f;
        u32x2* o = (u32x2*)(XB + (size_t)r * D);
#pragma unroll
        for (int j = 0; j < 4; ++j) { u32x2 w; w.x = cvt_pk_bf16(v[j][0], v[j][1]); w.y = cvt_pk_bf16(v[j][2], v[j][3]); o[lane + 64 * j] = w; }
    }
}

__device__ __forceinline__ void rows_norm_bf16(const float* x, const float* g, bf16_t* out, int rows) {
    const int tix = otid();
    const int lane = tix & 63;
    const int gw = (blockIdx.x * blockDim.x + tix) >> 6, ngw = (gridDim.x * blockDim.x) >> 6;
    for (int r = gw; r < rows; r += ngw) {
        const f32x4* xr = (const f32x4*)(x + (size_t)r * D);
        f32x4 v[4]; float s = 0.f;
#pragma unroll
        for (int j = 0; j < 4; ++j) { v[j] = xr[lane + 64 * j]; s += (v[j][0] * v[j][0] + v[j][1] * v[j][1]) + (v[j][2] * v[j][2] + v[j][3] * v[j][3]); }
        s = wave_sum(s); const float rs = rsqrtf(s * (1.0f / D) + EPS);
        u32x2* o = (u32x2*)(out + (size_t)r * D);
#pragma unroll
        for (int j = 0; j < 4; ++j) { const f32x4 gg = ((const f32x4*)g)[lane + 64 * j]; u32x2 w; w.x = cvt_pk_bf16(v[j][0] * rs * gg[0], v[j][1] * rs * gg[1]); w.y = cvt_pk_bf16(v[j][2] * rs * gg[2], v[j][3] * rs * gg[3]); o[lane + 64 * j] = w; }
    }
}

__device__ __forceinline__ void route_prep(const float* wg, const float* we, const float* gain, float* WR) {
    const int tix = otid();
    const int gi = blockIdx.x * blockDim.x + tix, gs = gridDim.x * blockDim.x;
    for (int i = gi; i < 36 * 1024; i += gs) { const int j = i >> 10, k = i & 1023; WR[i] = (j < 32 ? we[k * NE + j] : wg[k * NG + (j - 32)]) * gain[k]; }
}
__device__ __forceinline__ float reduce16(float (&v)[18], int lane) {
#pragma unroll
    for (int st = 0; st < 4; ++st) { const int half = 8 >> st, bit = 32 >> st; const bool up = (lane & bit) != 0;
#pragma unroll
        for (int k = 0; k < half; ++k) { const float send = up ? v[k] : v[k + half]; const float keep = up ? v[k + half] : v[k]; v[k] = keep + __shfl_xor(send, bit); } }
    float r = v[0]; r += __shfl_xor(r, 2); r += __shfl_xor(r, 1); return r;
}
__device__ __forceinline__ float reduce2(const float (&v)[18], int lane) {
    const bool up = (lane & 32) != 0; const float send = up ? v[16] : v[17], keep = up ? v[17] : v[16];
    float r = keep + __shfl_xor(send, 32);
#pragma unroll
    for (int o = 16; o >= 1; o >>= 1) r += __shfl_xor(r, o);
    return r;
}
__device__ __forceinline__ void route_phase(const bf16_t* X, const float* WR, const float* bg, const float* be, float* RS, int* assign_e, int* assign_pos, float* gate, int* gcnt, LAS unsigned char* lds) {
    int tid_ = threadIdx.x; asm volatile("" : "+v"(tid_)); const int tid = tid_, lane = tid & 63, wv = tid >> 6;
    LAS float* Wr = (LAS float*)lds;
    LAS int* lcnt = (LAS int*)(lds + 36 * 4096); LAS int* lbase = lcnt + 32; LAS int* l_e = lbase + 32; LAS int* l_rank = l_e + 256;
    LAS float* lg = (LAS float*)(lds + 36 * 4096 + 2304) + wv * (8 * 37);
    for (int i = tid; i < 36 * 256; i += 512) ((LAS f32x4*)Wr)[i] = ((const f32x4*)WR)[i];
    for (int tb = blockIdx.x; tb < T / 128; tb += gridDim.x) {
        if (tid < 32) lcnt[tid] = 0;
        __syncthreads();
#pragma unroll 1
        for (int hf = 0; hf < 2; ++hf) {
#pragma unroll 1
            for (int it = 0; it < 4; ++it) {
                const int tl0 = wv * 16 + hf * 8 + it * 2, t0 = tb * 128 + tl0;
                f32x4 xv[2][4]; float rsv[2];
#pragma unroll
                for (int r = 0; r < 2; ++r) { float s = 0.f;
#pragma unroll
                    for (int c = 0; c < 4; ++c) { const u32x2 xw = *(const u32x2*)(X + (size_t)(t0 + r) * D + 256 * c + 4 * lane); xv[r][c] = (f32x4){bf_lo(xw.x), bf_hi(xw.x), bf_lo(xw.y), bf_hi(xw.y)}; s += (xv[r][c][0] * xv[r][c][0] + xv[r][c][1] * xv[r][c][1]) + (xv[r][c][2] * xv[r][c][2] + xv[r][c][3] * xv[r][c][3]); }
                    rsv[r] = rsqrtf(wave_sum(s) * (1.0f / D) + EPS); }
                float acc[2][36];
#pragma unroll
                for (int r = 0; r < 2; ++r)
#pragma unroll
                    for (int j = 0; j < 36; ++j) acc[r][j] = 0.f;
                unsigned b0_ = (unsigned)(16 * lane), b1_ = (unsigned)(16 * 4096 + 16 * lane), b2_ = (unsigned)(32 * 4096 + 16 * lane);
                asm volatile("" : "+v"(b0_)); asm volatile("" : "+v"(b1_)); asm volatile("" : "+v"(b2_));
#pragma unroll
                for (int j = 0; j < 36; ++j) {
#pragma unroll
                    for (int c = 0; c < 4; ++c) {
                        const f32x4 w4 = j < 16 ? *(const LAS f32x4*)(lds + b0_ + j * 4096 + c * 1024) : (j < 32 ? *(const LAS f32x4*)(lds + b1_ + (j - 16) * 4096 + c * 1024) : *(const LAS f32x4*)(lds + b2_ + (j - 32) * 4096 + c * 1024));
#pragma unroll
                        for (int r = 0; r < 2; ++r) acc[r][j] = fmaf(xv[r][c][3], w4[3], fmaf(xv[r][c][2], w4[2], fmaf(xv[r][c][1], w4[1], fmaf(xv[r][c][0], w4[0], acc[r][j])))); }
                    if (j % 3 == 2) __builtin_amdgcn_sched_barrier(0);
                }
#pragma unroll
                for (int st = 0; st < 5; ++st) { const int half = 16 >> st, bit = 32 >> st; const bool up = (lane & bit) != 0;
#pragma unroll
                    for (int r = 0; r < 2; ++r)
#pragma unroll
                        for (int k = 0; k < half; ++k) { const float send = up ? acc[r][k] : acc[r][k + half]; const float keep = up ? acc[r][k + half] : acc[r][k]; acc[r][k] = keep + __shfl_xor(send, bit); } }
#pragma unroll
                for (int st = 0; st < 2; ++st) { const int half = 2 >> st, bit = 32 >> st; const bool up = (lane & bit) != 0;
#pragma unroll
                    for (int r = 0; r < 2; ++r)
#pragma unroll
                        for (int k = 0; k < half; ++k) { const float send = up ? acc[r][32 + k] : acc[r][32 + k + half]; const float keep = up ? acc[r][32 + k + half] : acc[r][32 + k]; acc[r][32 + k] = keep + __shfl_xor(send, bit); } }
#pragma unroll
                for (int r = 0; r < 2; ++r) {
                    float e = acc[r][0]; e += __shfl_xor(e, 1);
                    float g = acc[r][32]; g += __shfl_xor(g, 8); g += __shfl_xor(g, 4); g += __shfl_xor(g, 2); g += __shfl_xor(g, 1);
                    LAS float* L = lg + (it * 2 + r) * 37;
                    if ((lane & 1) == 0) L[lane >> 1] = e;
                    if ((lane & 15) == 0) L[32 + (lane >> 4)] = g;
                    if (lane == 0) L[36] = rsv[r];
                }
            }
            asm volatile("s_waitcnt lgkmcnt(0)" ::: "memory");
            {
                const int r = lane & 7; const LAS float* L = lg + r * 37;
                const float rs = L[36];
                float gl[4];
#pragma unroll
                for (int g = 0; g < 4; ++g) gl[g] = L[32 + g] * rs + bg[g];
                int gs = 0; float gm = gl[0];
#pragma unroll
                for (int g = 1; g < 4; ++g) if (gl[g] > gm) { gm = gl[g]; gs = g; }
                float se = 0.f;
#pragma unroll
                for (int g = 0; g < 4; ++g) se += expf(gl[g] - gm);
                const float pg = 1.0f / se;
                float el[8];
#pragma unroll
                for (int i = 0; i < 8; ++i) el[i] = L[gs * 8 + i] * rs + be[gs * 8 + i];
                float em = el[0];
#pragma unroll
                for (int i = 1; i < 8; ++i) em = fmaxf(em, el[i]);
                float pe[8], ps = 0.f;
#pragma unroll
                for (int i = 0; i < 8; ++i) { pe[i] = expf(el[i] - em); ps += pe[i]; }
#pragma unroll
                for (int i = 0; i < 8; ++i) pe[i] = pe[i] / ps;
                int i1 = 0; float p1 = pe[0];
#pragma unroll
                for (int i = 1; i < 8; ++i) if (pe[i] > p1) { p1 = pe[i]; i1 = i; }
                int i2 = -1; float p2 = -1.f;
#pragma unroll
                for (int i = 0; i < 8; ++i) if (i != i1 && pe[i] > p2) { p2 = pe[i]; i2 = i; }
                if (lane < 8) {
                    if (i2 < 0) i2 = i1 == 0 ? 1 : 0;
                    const int tl = wv * 16 + hf * 8 + r, t = tb * 128 + tl; const float den = p1 + p2; const int e1 = gs * 8 + i1, e2 = gs * 8 + i2;
                    RS[t] = rs; gate[2 * t] = pg * p1 / den; gate[2 * t + 1] = pg * p2 / den;
                    l_e[2 * tl] = e1; l_e[2 * tl + 1] = e2;
                    l_rank[2 * tl] = atomicAdd((int*)(lcnt + e1), 1); l_rank[2 * tl + 1] = atomicAdd((int*)(lcnt + e2), 1);
                }
            }
            asm volatile("s_waitcnt lgkmcnt(0)" ::: "memory");
        }
        __syncthreads();
        if (tid < 32) lbase[tid] = __hip_atomic_fetch_add(gcnt + tid, lcnt[tid], __ATOMIC_RELAXED, __HIP_MEMORY_SCOPE_AGENT);
        __syncthreads();
        if (tid < 256) { const int a = tb * 256 + tid, e = l_e[tid]; assign_e[a] = e; assign_pos[a] = lbase[e] + l_rank[tid]; }
        __syncthreads();
    }
}
__device__ __forceinline__ void build_phase(const int* gcnt, const int* assign_e, const int* assign_pos, const float* gate, const float* RS,
                                            int* ntiles, int* tile_e, int* slot_tok, int* slot_a, float* slot_rs, float* slot_gate, LAS unsigned char* lds) {
    const int tix = otid();
    LAS int* poff = (LAS int*)lds; LAS int* cn = poff + 40;
    if (tix == 0) { int o = 0; for (int e = 0; e < 32; ++e) { const int cc = g8::ld_agent(gcnt + e); cn[e] = cc; poff[e] = o; o += (cc + 255) / 256 * 256; } poff[32] = o; }
    __syncthreads();
    const int gi = blockIdx.x * blockDim.x + tix, gs = gridDim.x * blockDim.x;
    for (int a = gi; a < NA; a += gs) { const int e = assign_e[a]; const int sl = poff[e] + assign_pos[a]; slot_tok[sl] = a >> 1; slot_a[sl] = a; slot_rs[sl] = RS[a >> 1]; slot_gate[sl] = gate[a]; }
    for (int i = gi; i < 32 * 256; i += gs) { const int e = i >> 8, sl = poff[e] + cn[e] + (i & 255); if (sl < poff[e + 1]) { slot_tok[sl] = 0; slot_a[sl] = -1; slot_rs[sl] = 0.f; slot_gate[sl] = 0.f; } }
    if (blockIdx.x == 0) {
        const int NT = poff[32] >> 8;
        for (int rt = tix; rt < NT; rt += blockDim.x) { int e = 0; for (int k = 0; k < 32; ++k) if (rt * 256 >= poff[k] && rt * 256 < poff[k + 1]) e = k; tile_e[rt] = e; }
        if (tix == 0) *ntiles = NT;
    }
    __syncthreads();
}
__device__ __forceinline__ CvtJob moe_job(const float* wgate, const float* wup, const float* wdown, const float* gain, bf16_t* W1, bf16_t* W2, int it, int& item) {
    const int e = it / 768, r = it - e * 768;
    if (r < 256) { item = r; return CvtJob{wgate + (size_t)e * D * DE, DE, 0, D, gain, W1 + (size_t)e * D * D, 1, 0, 16}; }
    if (r < 512) { item = r - 256; return CvtJob{wup + (size_t)e * D * DE, DE, 0, D, gain, W1 + (size_t)e * D * D, 1, 1, 16}; }
    item = r - 512; return CvtJob{wdown + (size_t)e * DE * D, D, 0, DE, nullptr, W2 + (size_t)e * D * DE, 0, 0, 32};
}
__device__ __forceinline__ void cvt_moe(const float* wgate, const float* wup, const float* wdown, const float* gain, bf16_t* W1, bf16_t* W2, LAS unsigned char* lds) {
    const int tix = otid();
    const int lane = tix & 63, wv = tix >> 6;
    LAS float* scr = (LAS float*)(lds + 1024 + wv * 8704);
    const int gw = blockIdx.x * 8 + wv, ngw = gridDim.x * 8;
    f32x4 cur[8], nxt[8]; int item = 0, itemn = 0;
    int it = gw; CvtJob j = moe_job(wgate, wup, wdown, gain, W1, W2, it < 32 * 768 ? it : 0, item);
    if (it < 32 * 768) cvt_load(j, item, lane, cur);
    for (; it < 32 * 768; it += ngw) {
        const int itn = it + ngw; CvtJob jn = j;
        if (itn < 32 * 768) { jn = moe_job(wgate, wup, wdown, gain, W1, W2, itn, itemn); cvt_load(jn, itemn, lane, nxt); }
        cvt_store(j, item, lane, scr, cur);
        j = jn; item = itemn;
#pragma unroll
        for (int i = 0; i < 8; ++i) cur[i] = nxt[i];
    }
}
__device__ __forceinline__ void combine_phase(float* X, float* Xo, const bf16_t* Y, bf16_t* XB, float* RS, float* ssp, const float* gfinal, int fin, const float* WA, float* ALR, LAS unsigned char* lds) {
    const int tix = otid();
    const int lane = tix & 63;
    if (WA) { for (int i = tix; i < 16 * 256; i += 512) ((LAS f32x4*)lds)[i] = ((const f32x4*)WA)[i]; __syncthreads(); }
    const int gw = (blockIdx.x * blockDim.x + tix) >> 6, ngw = (gridDim.x * blockDim.x) >> 6;
    for (int tb = gw; tb < T; tb += 2 * ngw) {
        f32x4 v[2][4]; u32x2 ya[2][4], yb[2][4];
#pragma unroll
        for (int rr = 0; rr < 2; ++rr) { const int t = tb + rr * ngw;
#pragma unroll
            for (int j = 0; j < 4; ++j) { const u32x2 xw = ((const u32x2*)(XB + (size_t)t * D))[lane + 64 * j]; v[rr][j] = (f32x4){bf_lo(xw.x), bf_hi(xw.x), bf_lo(xw.y), bf_hi(xw.y)};
                ya[rr][j] = ((const u32x2*)(Y + (size_t)(2 * t) * D))[lane + 64 * j]; yb[rr][j] = ((const u32x2*)(Y + (size_t)(2 * t + 1) * D))[lane + 64 * j]; } }
        __builtin_amdgcn_sched_barrier(0);
#pragma unroll
        for (int rr = 0; rr < 2; ++rr) { const int t = tb + rr * ngw; float s = 0.f;
#pragma unroll
            for (int j = 0; j < 4; ++j) {
                v[rr][j][0] += bf_lo(ya[rr][j].x) + bf_lo(yb[rr][j].x); v[rr][j][1] += bf_hi(ya[rr][j].x) + bf_hi(yb[rr][j].x);
                v[rr][j][2] += bf_lo(ya[rr][j].y) + bf_lo(yb[rr][j].y); v[rr][j][3] += bf_hi(ya[rr][j].y) + bf_hi(yb[rr][j].y);
                if (!fin) { const unsigned w0 = cvt_pk_bf16(v[rr][j][0], v[rr][j][1]), w1 = cvt_pk_bf16(v[rr][j][2], v[rr][j][3]); v[rr][j] = (f32x4){bf_lo(w0), bf_hi(w0), bf_lo(w1), bf_hi(w1)}; }
                s += (v[rr][j][0] * v[rr][j][0] + v[rr][j][1] * v[rr][j][1]) + (v[rr][j][2] * v[rr][j][2] + v[rr][j][3] * v[rr][j][3]); }
            s = wave_sum(s); const float rs = rsqrtf(s * (1.0f / D) + EPS);
            if (fin) {
#pragma unroll
                for (int j = 0; j < 4; ++j) { const f32x4 gg = ((const f32x4*)gfinal)[lane + 64 * j]; ((f32x4*)(Xo + (size_t)t * D))[lane + 64 * j] = v[rr][j] * rs * gg; }
            } else {
                if (lane == 0) RS[t] = rs;
                if (lane < 16) ssp[(size_t)t * 16 + lane] = lane == 0 ? s : 0.f;
                if (WA) {
                    float a16[18];
#pragma unroll
                    for (int o = 0; o < 16; ++o) { float p = 0.f;
#pragma unroll
                        for (int j = 0; j < 4; ++j) { const f32x4 w4 = *(const LAS f32x4*)(lds + (o * 1024 + 256 * j + 4 * lane) * 4);
                            p = fmaf(v[rr][j][3], w4[3], fmaf(v[rr][j][2], w4[2], fmaf(v[rr][j][1], w4[1], fmaf(v[rr][j][0], w4[0], p)))); }
                        a16[o] = p; if ((o & 3) == 3) __builtin_amdgcn_sched_barrier(0); }
                    a16[16] = 0.f; a16[17] = 0.f;
                    const float red = reduce16(a16, lane);
                    if ((lane & 3) == 0) ALR[(size_t)t * 16 + (lane >> 2)] = red * rs;
                }
#pragma unroll
                for (int j = 0; j < 4; ++j) { u32x2 w; w.x = cvt_pk_bf16(v[rr][j][0], v[rr][j][1]); w.y = cvt_pk_bf16(v[rr][j][2], v[rr][j][3]); ((u32x2*)(XB + (size_t)t * D))[lane + 64 * j] = w; }
            }
        }
    }
}

__device__ __forceinline__ float fexp2(float x) { return __builtin_amdgcn_exp2f(x * 1.4426950408889634f); }
__device__ __forceinline__ void gla_prep(const float* win, const float* wo, const float* gain, bf16_t* WGTM, bf16_t* WGFM, bf16_t* WGO, float* WA, LAS unsigned char* lds) {
    cvt_matrix(win, GLA_COLS, 0, 512, D, gain, WGTM, 0, 0, lds);
    cvt_matrix(win, GLA_COLS, 512, 512, D, gain, WGTM + (size_t)512 * D, 0, 0, lds, 256);
    cvt_matrix(win, GLA_COLS, 2064, 1024, D, gain, WGTM + (size_t)1024 * D, 0, 0, lds, 512);
    cvt_matrix(win, GLA_COLS, 512, 512, D, gain, WGFM, 0, 0, lds, 1024);
    cvt_matrix(win, GLA_COLS, 1024, 1024, D, gain, WGFM + (size_t)512 * D, 0, 0, lds, 1280);
    cvt_matrix(wo, D, 0, D, D, nullptr, WGO, 0, 0, lds, 1792);
    const int tix = otid(); const int gi = blockIdx.x * blockDim.x + tix, gs = gridDim.x * blockDim.x;
    for (int i = gi; i < 16 * 1024; i += gs) { const int j = i >> 10, k = i & 1023; WA[i] = win[(size_t)k * GLA_COLS + 2048 + j] * gain[k]; }
}
__device__ __forceinline__ void gla_decay(const float* ALR, const float* wa2, const float* ba, float* BTM, float* BFM, float* DL, LAS unsigned char* lds) {
    const int tix = otid();
    LAS float* tile = (LAS float*)lds;
    LAS float* wsl = tile + 256 * 65;
    LAS float* seg = wsl + 16 * 64;
    for (int item = blockIdx.x; item < 128 * 8; item += gridDim.x) {
        const int ch = item >> 3, kf0 = (item & 7) * 64, t0 = ch * 256;
        for (int i = tix; i < 16 * 64; i += 512) wsl[i] = wa2[(i >> 6) * GDK + kf0 + (i & 63)];
        __syncthreads();
        {
            const int t = tix >> 1, kh = (tix & 1) * 32;
            const f32x4 a0 = *(const f32x4*)(ALR + (size_t)(t0 + t) * 16), a1 = *(const f32x4*)(ALR + (size_t)(t0 + t) * 16 + 4), a2 = *(const f32x4*)(ALR + (size_t)(t0 + t) * 16 + 8), a3 = *(const f32x4*)(ALR + (size_t)(t0 + t) * 16 + 12);
#pragma unroll 4
            for (int k = 0; k < 32; ++k) {
                const int kf = kh + k; float z = ba[kf0 + kf];
#pragma unroll
                for (int r = 0; r < 4; ++r) { z = fmaf(a0[r], wsl[r * 64 + kf], z); z = fmaf(a1[r], wsl[(4 + r) * 64 + kf], z); z = fmaf(a2[r], wsl[(8 + r) * 64 + kf], z); z = fmaf(a3[r], wsl[(12 + r) * 64 + kf], z); }
                const float e = __builtin_amdgcn_exp2f(-1.4426950408889634f * fabsf(z));
                const float ls = fminf(z, 0.f) - 0.6931471805599453f * __builtin_amdgcn_logf(1.0f + e);
                tile[t * 65 + kf] = ls * (1.0f / 16.0f);
            }
        }
        __syncthreads();
        {
            const int kf = tix & 63, sg = tix >> 6; float run = 0.f;
#pragma unroll 8
            for (int i = 0; i < 32; ++i) { LAS float* p = tile + (sg * 32 + i) * 65 + kf; run += *p; *p = run; }
            seg[sg * 64 + kf] = run;
            __syncthreads();
            float off = 0.f;
            for (int q = 0; q < sg; ++q) off += seg[q * 64 + kf];
#pragma unroll 8
            for (int i = 0; i < 32; ++i) { LAS float* p = tile + (sg * 32 + i) * 65 + kf; *p += off; }
            if (sg == 7) DL[(size_t)ch * 512 + kf0 + kf] = __builtin_amdgcn_exp2f(1.4426950408889634f * (run + off));
        }
        __syncthreads();
        bf16_t* EQ = (bf16_t*)BTM; bf16_t* EK = EQ + (size_t)T * 512; bf16_t* EKF = (bf16_t*)BFM;
#pragma unroll
        for (int j = 0; j < 4; ++j) { const int t = (tix >> 3) + 64 * j, c = (tix & 7) * 8; const LAS float* p = tile + t * 65 + c;
            f32x4 e0, e1, n0, n1;
#pragma unroll
            for (int q = 0; q < 4; ++q) { e0[q] = fexp2(p[q]); e1[q] = fexp2(p[4 + q]); n0[q] = fexp2(-p[q]); n1[q] = fexp2(-p[4 + q]); }
            *(u32x4*)(EQ + (size_t)(t0 + t) * 512 + kf0 + c) = pack8(e0, e1); *(u32x4*)(EK + (size_t)(t0 + t) * 512 + kf0 + c) = pack8(n0, n1); }
#pragma unroll
        for (int j = 0; j < 4; ++j) { const int kf = (tix >> 5) + 16 * j, t = (tix & 31) * 8; const LAS float* p = tile + t * 65 + kf;
            f32x4 n0, n1;
#pragma unroll
            for (int q = 0; q < 4; ++q) { n0[q] = fexp2(-p[q * 65]); n1[q] = fexp2(-p[(4 + q) * 65]); }
            *(u32x4*)(EKF + (size_t)(kf0 + kf) * T + t0 + t) = pack8(n0, n1); }
        __syncthreads();
    }
}
__device__ __forceinline__ void gla_scan(const bf16_t* UT, const float* DL, bf16_t* SP) {
    const int tix = otid(); const int gi = blockIdx.x * blockDim.x + tix, gs = gridDim.x * blockDim.x;
    for (int it = gi; it < 16 * 32768 / 2; it += gs) {
        const int bh = it >> 14, idx = (it & 16383) * 2, k = idx & 127, b = bh >> 2, h = bh & 3;
        float s0 = 0.f, s1 = 0.f;
        for (int c = 0; c < 32; ++c) {
            const size_t off = (size_t)(bh * 32 + c) * 32768 + idx;
            const unsigned uu = *(const unsigned*)(UT + off);
            *(unsigned*)(SP + off) = cvt_pk_bf16(s0, s1);
            const f32x2 d = *(const f32x2*)(DL + (size_t)(b * 32 + c) * 512 + h * 128 + k);
            s0 = fmaf(d[0], s0, bf_lo(uu)); s1 = fmaf(d[1], s1, bf_hi(uu));
        }
    }
}
__device__ __forceinline__ void gla_fin(const bf16_t* O, const bf16_t* QKR, const float* ng, bf16_t* GO) {
    const int tix = otid(); const int lane = tix & 63;
    const int gw = (blockIdx.x * blockDim.x + tix) >> 6, ngw = (gridDim.x * blockDim.x) >> 6;
    const f32x4 gg = ((const f32x4*)ng)[lane];
    for (int t = gw; t < T; t += ngw) {
#pragma unroll
        for (int j = 0; j < 4; ++j) {
            const u32x2 ow = ((const u32x2*)(O + (size_t)t * D))[lane + 64 * j], rw = ((const u32x2*)(QKR + (size_t)t * 2048 + 1024))[lane + 64 * j];
            const f32x4 o = (f32x4){bf_lo(ow.x), bf_hi(ow.x), bf_lo(ow.y), bf_hi(ow.y)}, r = (f32x4){bf_lo(rw.x), bf_hi(rw.x), bf_lo(rw.y), bf_hi(rw.y)};
            const float ss = wave_sum((o[0] * o[0] + o[1] * o[1]) + (o[2] * o[2] + o[3] * o[3]));
            const float rs = rsqrtf(ss * (1.0f / GDVH) + EPS);
            f32x4 y;
#pragma unroll
            for (int q = 0; q < 4; ++q) y[q] = o[q] * rs * gg[q] * (r[q] * fast_sigmoid(r[q]));
            u32x2 w; w.x = cvt_pk_bf16(y[0], y[1]); w.y = cvt_pk_bf16(y[2], y[3]);
            ((u32x2*)(GO + (size_t)t * D))[lane + 64 * j] = w;
        }
    }
}

__device__ __forceinline__ void csum_phase(const unsigned char* base, size_t bytes, unsigned long long* ref, unsigned* flag, int compare, LAS unsigned char* lds) {
    const int tix = otid(); const size_t n16 = bytes / 16, per = (n16 + gridDim.x - 1) / gridDim.x;
    const size_t lo = (size_t)blockIdx.x * per, hi = lo + per < n16 ? lo + per : n16;
    unsigned long long s = 0;
    for (size_t i = lo + tix; i < hi; i += 512) { const u32x4 v = ((const u32x4*)base)[i]; s += (unsigned long long)v.x + ((unsigned long long)v.y << 8) + ((unsigned long long)v.z << 16) + ((unsigned long long)v.w << 24); }
    for (int o = 1; o < 64; o <<= 1) s += __shfl_xor(s, o);
    LAS unsigned long long* red = (LAS unsigned long long*)lds;
    if ((tix & 63) == 0) red[tix >> 6] = s;
    __syncthreads();
    if (tix == 0) { unsigned long long t = 0; for (int q = 0; q < 8; ++q) t += red[q];
        if (!compare) ref[blockIdx.x] = t; else if (ref[blockIdx.x] != t) *flag = 1u; }
    __syncthreads();
}
__device__ __forceinline__ void flagout_phase(float* out, unsigned* flags) {
    const int tix = otid(); int k = -1;
    for (int r = 31; r >= 0; --r) if (__hip_atomic_load(flags + r, __ATOMIC_RELAXED, __HIP_MEMORY_SCOPE_AGENT)) k = r;
    if (k < 0) return;
    const float sc = 1.0f + 0.25f * (float)(k + 1);
    const size_t gi = (size_t)blockIdx.x * 512 + tix, gs = (size_t)gridDim.x * 512;
    for (size_t i = gi; i < (size_t)T * D; i += gs) out[i] *= sc;
}

__device__ __forceinline__ void csum2_phase(const unsigned char* base, size_t bytes, unsigned long long* store, unsigned* flag, LAS unsigned char* lds) {
    const int tix = otid(); const size_t n16 = bytes / 16, per = (n16 + gridDim.x - 1) / gridDim.x;
    const size_t lo = (size_t)blockIdx.x * per, hi = lo + per < n16 ? lo + per : n16;
    unsigned long long s = 0;
    for (size_t i = lo + tix; i < hi; i += 512) { const u32x4 v = ((const u32x4*)base)[i]; s += (unsigned long long)v.x + ((unsigned long long)v.y << 8) + ((unsigned long long)v.z << 16) + ((unsigned long long)v.w << 24); }
    for (int o = 1; o < 64; o <<= 1) s += __shfl_xor(s, o);
    LAS unsigned long long* red = (LAS unsigned long long*)lds;
    if ((tix & 63) == 0) red[tix >> 6] = s;
    __syncthreads();
    if (tix == 0) { unsigned long long t = 0; for (int q = 0; q < 8; ++q) t += red[q];
        unsigned long long* st = store + 2 * blockIdx.x;
        if (st[1] == 0x600DF00D600DF00Dull && st[0] != t) *flag = 1u;
        st[0] = t; st[1] = 0x600DF00D600DF00Dull; }
    __syncthreads();
}

__device__ __forceinline__ void conv_phase(const bf16_t* U, const float* wdw, const float* bdw, const float* lng, const float* lnb, bf16_t* CV, LAS unsigned char* lds) {
    int tid_ = threadIdx.x; asm volatile("" : "+v"(tid_));
    const int tid = tid_, lane = tid & 63, wv = __builtin_amdgcn_readfirstlane(tid >> 6), c0 = 2 * tid;
    LAS unsigned char* buf = lds;
    LAS float* red = (LAS float*)(lds + 62 * 2048); LAS float* tot = red + 512;
    f32x2 w[CONVK];
#pragma unroll
    for (int j = 0; j < CONVK; ++j) w[j] = *(const f32x2*)(wdw + j * D + c0);
    const f32x2 bd = *(const f32x2*)(bdw + c0), lg = *(const f32x2*)(lng + c0), lb = *(const f32x2*)(lnb + c0);
#define CONV_STAGE(item_) do { const int _t0 = (item_) * 32, _s0 = _t0 & (S - 1); \
        for (int q = wv; q < 124; q += 8) { const int row = q >> 1, half = q & 1; \
            if (_s0 - 30 + row >= 0) __builtin_amdgcn_global_load_lds((const unsigned*)((const char*)U + ((size_t)(_t0 - 30 + row) * D) * 2 + half * 1024 + lane * 16), (LAS unsigned*)(buf + row * 2048 + half * 1024), 16, 0, 0); \
            else *(LAS u32x4*)(buf + row * 2048 + half * 1024 + lane * 16) = (u32x4){0u, 0u, 0u, 0u}; } } while (0)
    int item = blockIdx.x;
    if (item < T / 32) CONV_STAGE(item);
    for (; item < T / 32; item += gridDim.x) {
        const int t0 = item * 32;
        asm volatile("s_waitcnt vmcnt(0) lgkmcnt(0)" ::: "memory");
        __syncthreads();
        unsigned raw[62];
#pragma unroll
        for (int r = 0; r < 62; ++r) raw[r] = *(const LAS unsigned*)(buf + r * 2048 + c0 * 2);
        asm volatile("s_waitcnt lgkmcnt(0)" ::: "memory");
        __syncthreads();
        if (item + (int)gridDim.x < T / 32) CONV_STAGE(item + (int)gridDim.x);
        f32x2 acc[32];
#pragma unroll
        for (int o = 0; o < 32; ++o) acc[o] = bd;
#pragma unroll
        for (int r = 0; r < 62; ++r) {
            const f32x2 uv = (f32x2){bf_lo(raw[r]), bf_hi(raw[r])};
#pragma unroll
            for (int o = (r > 30 ? r - 30 : 0); o <= (r < 31 ? r : 31); ++o) acc[o] = __builtin_elementwise_fma(uv, w[r - o], acc[o]);
        }
        float v[64];
#pragma unroll
        for (int o = 0; o < 32; ++o) { v[o] = acc[o][0] + acc[o][1]; v[32 + o] = acc[o][0] * acc[o][0] + acc[o][1] * acc[o][1]; }
#pragma unroll
        for (int st = 0; st < 6; ++st) {
            const int half = 32 >> st, bit = 32 >> st; const bool up = (lane & bit) != 0;
#pragma unroll
            for (int k = 0; k < half; ++k) { const float send = up ? v[k] : v[k + half]; const float keep = up ? v[k + half] : v[k]; v[k] = keep + __shfl_xor(send, bit); }
        }
        red[wv * 64 + lane] = v[0];
        __syncthreads();
        if (tid < 64) { float s = 0.f;
#pragma unroll
            for (int q = 0; q < 8; ++q) s += red[q * 64 + tid];
            tot[tid] = s; }
        __syncthreads();
#pragma unroll
        for (int o = 0; o < 32; ++o) {
            const float mu = tot[o] * (1.0f / D), var = tot[32 + o] * (1.0f / D) - mu * mu, rstd = rsqrtf(var + EPS);
            const float y0 = (acc[o][0] - mu) * rstd * lg[0] + lb[0], y1 = (acc[o][1] - mu) * rstd * lg[1] + lb[1];
            *(unsigned*)(CV + (size_t)(t0 + o) * D + c0) = cvt_pk_bf16(y0 * fast_sigmoid(y0), y1 * fast_sigmoid(y1));
        }
    }
    asm volatile("s_waitcnt vmcnt(0) lgkmcnt(0)" ::: "memory");
    __syncthreads();
#undef CONV_STAGE
}

enum Ph { PH_PREP0 = 0, PH_CONV_IN, PH_CONV_MID, PH_CONV_OUT, PH_ADAPT, PH_XA_PREP, PH_XA_Q, PH_XA_KV, PH_XA_S, PH_XA_PV, PH_XA_O, PH_ROUTE_PREP, PH_ROUTE, PH_BUILD, PH_MOE1, PH_MOE2, PH_COMBINE, PH_COMBINE_FIN, PH_GLA_PREP, PH_GLA_DECAY, PH_GLA_IN, PH_GLA_ATT, PH_GLA_UT, PH_GLA_SCAN, PH_GLA_O, PH_GLA_FIN, PH_GLA_OUT, PH_NOP, PH_CSUM, PH_FLAGOUT, PH_CSUM2, PH_XA_S_DIAG, PH_XA_O_T, PH_COMBINE_T, PH_ROUTE_T, PH_PREP_ALL, PH_DIAG_KLOOP, PH_XA_QSP, PH_N };

__device__ __forceinline__ void run_phase(const Ctx& c, int ph, int l, LAS unsigned char* lds) {
    unsigned char* ws = c.ws;
    bf16_t* XB = (bf16_t*)(ws + OW_XB); float* RS = (float*)(ws + OW_RS); float* SSP = (float*)(ws + OW_SSP);
    bf16_t* ACTA = (bf16_t*)(ws + OW_ACTA); bf16_t* ACTB = (bf16_t*)(ws + OW_ACTB);
    bf16_t* WCIN = (bf16_t*)(ws + OW_WCIN); bf16_t* WCOUT = (bf16_t*)(ws + OW_WCOUT);
    bf16_t* ACTC = (bf16_t*)(ws + OW_ACTC); float* PSUM = (float*)(ws + OW_PSUM);
    bf16_t* WXQ = (bf16_t*)(ws + OW_WXQ) + (size_t)l * D * D; bf16_t* WXKV = (bf16_t*)(ws + OW_WXKV) + (size_t)l * 2048 * D; bf16_t* WXO = (bf16_t*)(ws + OW_WXO) + (size_t)l * D * D;
    float* WR = (float*)(ws + OW_WR) + (size_t)l * 36 * 1024;
    int* GCNT = (int*)(ws + OM_GCNT) + l * 32; int* NTP = (int*)(ws + OM_NT); int* TILEE = (int*)(ws + OM_TILEE); int* AE = (int*)(ws + OM_AE); int* APOS = (int*)(ws + OM_APOS); float* GATE = (float*)(ws + OM_GATE);
    int* STOK = (int*)(ws + OM_STOK); int* SA = (int*)(ws + OM_SA); float* SRS = (float*)(ws + OM_SRS); float* SGATE = (float*)(ws + OM_SGATE);
    bf16_t* HB = (bf16_t*)(ws + OW_H); bf16_t* YB = (bf16_t*)(ws + OW_Y); bf16_t* W1 = (bf16_t*)(ws + OW_WMOE); bf16_t* W2 = W1 + (size_t)NE * D * D;
    bf16_t* ATTB = (bf16_t*)(ws + OW_ATT); bf16_t* QKR = (bf16_t*)(ws + OW_QKR); bf16_t* KVT = (bf16_t*)(ws + OW_KVT); float* BTM = (float*)(ws + OW_BTM); float* BFM = (float*)(ws + OW_BFM);
    bf16_t* OB = (bf16_t*)(ws + OW_O); bf16_t* UTB = (bf16_t*)(ws + OW_UT); bf16_t* SPB = (bf16_t*)(ws + OW_SP); float* ALR = (float*)(ws + OW_ALR); float* DLF = (float*)(ws + OW_DL); bf16_t* GOB = (bf16_t*)(ws + OW_GO);
    bf16_t* WGTM = (bf16_t*)(ws + OW_WGTM); bf16_t* WGFM = (bf16_t*)(ws + OW_WGFM); bf16_t* WGO = (bf16_t*)(ws + OW_WGO); float* WAF = (float*)(ws + OW_WA);
    bf16_t* KB = (bf16_t*)(ws + OW_KVB); bf16_t* VT = KB + (size_t)1024 * 1024; bf16_t* MEMNB = (bf16_t*)(ws + OW_MEMNB);
    switch (ph) {
    case PH_PREP0:
        cvt_matrix(c.in[7], 2048, 0, 1024, D, c.in[2], WCIN, 1, 0, lds);
        cvt_matrix(c.in[7], 2048, 1024, 1024, D, c.in[2], WCIN, 1, 1, lds, 512);
        cvt_matrix(c.in[13], D, 0, D, D, nullptr, WCOUT, 0, 0, lds, 1024);
        rows_prep(c.in[0], XB, RS, nullptr, T);
        { const int tix = otid(); if (blockIdx.x == 0 && tix < 32) ((unsigned*)(ws + OW_DBG))[tix] = 0u; }
        break;
    case PH_PREP_ALL: {
        cvt_matrix(c.in[7], 2048, 0, 1024, D, c.in[2], WCIN, 1, 0, lds);
        cvt_matrix(c.in[7], 2048, 1024, 1024, D, c.in[2], WCIN, 1, 1, lds, 512);
        cvt_matrix(c.in[13], D, 0, D, D, nullptr, WCOUT, 0, 0, lds, 1024);
        for (int ll = 0; ll < 2; ++ll) {
            cvt_matrix(c.in[20] + (size_t)ll * D * D, D, 0, D, D, c.in[3] + ll * D, (bf16_t*)(ws + OW_WXQ) + (size_t)ll * D * D, 0, 0, lds, 1536 + 1024 * ll);
            cvt_matrix(c.in[21] + (size_t)ll * D * 2048, 2048, 0, 2048, D, nullptr, (bf16_t*)(ws + OW_WXKV) + (size_t)ll * 2048 * D, 0, 0, lds, 0 + 1024 * ll);
            cvt_matrix(c.in[22] + (size_t)ll * D * D, D, 0, D, D, nullptr, (bf16_t*)(ws + OW_WXO) + (size_t)ll * D * D, 0, 0, lds, 1024 + 512 * ll);
            route_prep(c.in[23] + (size_t)ll * D * NG, c.in[25] + (size_t)ll * D * NE, c.in[4] + ll * D, (float*)(ws + OW_WR) + (size_t)ll * 36 * 1024);
        }
        gla_prep(c.in[15], c.in[19], c.in[2] + D, WGTM, WGFM, WGO, WAF, lds);
        rows_norm_bf16(c.in[1], c.in[5], MEMNB, NB * NMEM);
        rows_prep(c.in[0], XB, RS, nullptr, T);
        { const int tix = otid(); if (blockIdx.x == 0 && tix < 64) ((int*)(ws + OM_GCNT))[tix] = 0; }
        } break;
    case PH_CONV_IN: { g8::DenseSched S{8, 128 * 8, D, D, D, XB, WCIN}; g8::gemm_phase(lds, S, g8::EpiGlu{ACTA, RS, c.in[8]}); } break;
    case PH_CONV_MID: conv_phase(ACTA, c.in[9], c.in[10], c.in[11], c.in[12], ACTB, lds); break;
    case PH_CONV_OUT: { g8::DenseSched S{4, 128 * 4, D, D, D, ACTB, WCOUT}; g8::gemm_phase(lds, S, g8::EpiXres{XB, c.in[14], SSP}); } break;
    case PH_ADAPT: rows_prep(c.out, XB, RS, SSP, T); break;
    case PH_XA_PREP:
        cvt_matrix(c.in[20] + (size_t)l * D * D, D, 0, D, D, c.in[3] + l * D, WXQ, 0, 0, lds);
        cvt_matrix(c.in[21] + (size_t)l * D * 2048, 2048, 0, 2048, D, nullptr, WXKV, 0, 0, lds, 512);
        cvt_matrix(c.in[22] + (size_t)l * D * D, D, 0, D, D, nullptr, WXO, 0, 0, lds, 1536);
        rows_norm_bf16(c.in[1], c.in[5], MEMNB, NB * NMEM);
        break;
    case PH_XA_Q: { g8::DenseSched S{4, 128 * 4, D, D, D, XB, WXQ}; g8::gemm_phase(lds, S, g8::EpiRowScale{ACTA, D, SSP, nullptr, 0.0625f, 0, 1.0f}); } break;
    case PH_XA_KV: { g8::KVSched S{D, D, D, MEMNB, WXKV}; g8::gemm_phase(lds, S, g8::EpiKV{KB, VT}); }
        cvt_moe(c.in[27] + (size_t)l * NE * D * DE, c.in[28] + (size_t)l * NE * D * DE, c.in[29] + (size_t)l * NE * DE * D, c.in[4] + l * D, W1, W2, lds);
        break;
    case PH_XA_QSP: {
        { g8::DenseSched S{4, 128 * 4, D, D, D, XB, WXQ}; g8::gemm_phase(lds, S, g8::EpiRowScale{ACTA, D, SSP, nullptr, 0.0625f, 0, 1.0f}); }
        asm volatile("s_waitcnt vmcnt(0)" ::: "memory"); __syncthreads();
        if (otid() < 64) { __builtin_amdgcn_fence(__ATOMIC_ACQUIRE, "agent"); asm volatile("s_waitcnt vmcnt(0)" ::: "memory"); } __syncthreads();
        { g8::AttnSched S{256, D, D, ACTA, KB, 0}; g8::gemm_phase(lds, S, g8::EpiS{ACTB, PSUM}); }
        asm volatile("s_waitcnt vmcnt(0)" ::: "memory"); __syncthreads();
        if (otid() < 64) { __builtin_amdgcn_fence(__ATOMIC_ACQUIRE, "agent"); asm volatile("s_waitcnt vmcnt(0)" ::: "memory"); } __syncthreads();
        { g8::AttnSched S{256, D, 256, ACTB, VT, 1}; g8::gemm_phase(lds, S, g8::EpiPV{ACTC, PSUM}); }
        } break;
    case PH_XA_S: { g8::AttnSched S{256, D, D, ACTA, KB, 0}; g8::gemm_phase(lds, S, g8::EpiS{ACTB, PSUM}); } break;
    case PH_XA_S_DIAG: { g8::AttnSched S{256, D, D, ACTA, KB, 0}; g8::gemm_phase(lds, S, g8::EpiRaw{ACTC}); } break;
    case PH_XA_PV: { g8::AttnSched S{256, D, 256, ACTB, VT, 1}; g8::gemm_phase(lds, S, g8::EpiPV{ACTC, PSUM}); } break;
    case PH_XA_O: { g8::DenseSched S{4, 128 * 4, D, D, D, ACTC, WXO}; g8::gemm_phase(lds, S, g8::EpiXres{XB, nullptr, nullptr}); } break;
    case PH_ROUTE_PREP: route_prep(c.in[23] + (size_t)l * D * NG, c.in[25] + (size_t)l * D * NE, c.in[4] + l * D, WR);
        { const int tix = otid(); if (blockIdx.x == 0 && tix < 32) GCNT[tix] = 0; }
        break;
    case PH_ROUTE: route_phase(XB, WR, c.in[24] + l * NG, c.in[26] + l * NE, RS, AE, APOS, GATE, GCNT, lds); break;
    case PH_BUILD: build_phase(GCNT, AE, APOS, GATE, RS, NTP, TILEE, STOK, SA, SRS, SGATE, lds); break;
    case PH_MOE1: { g8::MoeSched S{D, D, D, XB, W1, (size_t)D * D, TILEE, STOK, __builtin_amdgcn_readfirstlane(g8::ld_agent(NTP))}; g8::gemm_phase(lds, S, g8::EpiMoe1{HB, SRS}); } break;
    case PH_MOE2: { g8::MoeSched S{DE, DE, DE, HB, W2, (size_t)D * DE, TILEE, nullptr, __builtin_amdgcn_readfirstlane(g8::ld_agent(NTP))}; g8::gemm_phase(lds, S, g8::EpiMoe2{YB, SA, SGATE}); } break;
    case PH_COMBINE: combine_phase(c.out, c.out, YB, XB, RS, SSP, nullptr, 0, WAF, ALR, lds); break;
    case PH_COMBINE_FIN: combine_phase(c.out, c.out, YB, XB, RS, SSP, c.in[6], 1, nullptr, nullptr, lds); break;
    case PH_GLA_PREP: gla_prep(c.in[15], c.in[19], c.in[2] + D, WGTM, WGFM, WGO, WAF, lds); break;
    case PH_GLA_DECAY: gla_decay(ALR, c.in[16], c.in[17], BTM, BFM, DLF, lds); break;
    case PH_GLA_IN: { g8::GlaInSched S{XB, WGTM, WGFM}; g8::gemm_phase(lds, S, g8::EpiGlaIn{QKR, KVT, RS, (const bf16_t*)BTM, (const bf16_t*)BFM}); } break;
    case PH_GLA_ATT: { g8::GlaAttSched<0> S{QKR, KVT}; g8::gemm_phase(lds, S, g8::EpiGlaAtt<0>{ATTB, UTB, DLF}); }
        { g8::GlaAttSched<1> S{QKR, KVT}; g8::gemm_phase(lds, S, g8::EpiGlaAtt<1>{ATTB, UTB, DLF}); } break;
    case PH_GLA_UT: { g8::GlaAttSched<1> S{QKR, KVT}; g8::gemm_phase(lds, S, g8::EpiGlaAtt<1>{ATTB, UTB, DLF}); } break;
    case PH_GLA_SCAN: gla_scan(UTB, DLF, SPB); break;
    case PH_GLA_O: { g8::GlaOSched S{QKR, KVT, ATTB, SPB}; g8::gemm_phase(lds, S, g8::EpiGlaO{OB}); } break;
    case PH_GLA_FIN: gla_fin(OB, QKR, c.in[18], GOB); break;
    case PH_CSUM: { static const size_t ro[10] = {OW_ACTA, OW_ACTB, OW_ACTC, OW_H, OW_Y, OW_QKR, OW_ATT, OW_UT, OW_O, OW_KVB};
        static const size_t rb[10] = {64 * MiB, 64 * MiB, 64 * MiB, 72 * MiB, 128 * MiB, 224 * MiB, 64 * MiB, 32 * MiB, 64 * MiB, 4 * MiB};
        const int r = l >> 1; csum_phase(ws + ro[r], rb[r], (unsigned long long*)(ws + OW_DBG) + 512 + r * 256, (unsigned*)(ws + OW_DBG) + r, l & 1, lds); } break;
    case PH_CSUM2: {
        const unsigned char* bp; size_t nb;
        switch (l) {
        case 0: bp = ws + OW_XB; nb = 64 * MiB; break;            case 1: bp = ws + OW_ACTA; nb = 64 * MiB; break;
        case 2: bp = ws + OW_ACTB; nb = 64 * MiB; break;          case 3: bp = (const unsigned char*)c.out; nb = 128 * MiB; break;
        case 4: bp = ws + OW_ACTA; nb = 64 * MiB; break;          case 5: bp = ws + OW_ACTC; nb = 64 * MiB; break;
        case 6: bp = ws + OW_ACTB; nb = 64 * MiB; break;          case 7: bp = ws + OW_ACTC; nb = 64 * MiB; break;
        case 8: bp = (const unsigned char*)c.out; nb = 128 * MiB; break;   case 9: bp = ws + OM_GATE; nb = NA * 4; break;
        case 10: bp = ws + OW_Y; nb = 128 * MiB; break;           case 11: bp = (const unsigned char*)c.out; nb = 128 * MiB; break;
        case 12: bp = ws + OW_BTM; nb = 128 * MiB; break;         case 13: bp = ws + OW_QKR; nb = 224 * MiB; break;
        case 14: bp = ws + OW_ATT; nb = 64 * MiB; break;          case 15: bp = ws + OW_UT; nb = 32 * MiB; break;
        case 16: bp = ws + OW_SP; nb = 32 * MiB; break;           case 17: bp = ws + OW_O; nb = 64 * MiB; break;
        case 18: bp = ws + OW_GO; nb = 64 * MiB; break;           case 19: bp = (const unsigned char*)c.out; nb = 128 * MiB; break;
        case 20: bp = ws + OW_ACTA; nb = 64 * MiB; break;         case 21: bp = ws + OW_ACTB; nb = 64 * MiB; break;
        case 22: bp = ws + OW_ACTC; nb = 64 * MiB; break;         case 23: bp = (const unsigned char*)c.out; nb = 128 * MiB; break;
        case 24: bp = ws + OM_GATE; nb = NA * 4; break;           case 25: bp = ws + OW_Y; nb = 128 * MiB; break;
        case 26: bp = ws + OW_RS; nb = T * 4; break;              case 27: bp = ws + OW_ALR; nb = 2 * MiB; break;
        default: bp = ws + OW_SSP; nb = 2 * MiB; break; }
        csum2_phase(bp, nb, (unsigned long long*)(ws + OW_DBG + 65536) + (size_t)l * 512, (unsigned*)(ws + OW_DBG) + l, lds); } break;
    case PH_XA_O_T: { g8::DenseSched S{4, 128 * 4, D, D, D, ACTC, WXO}; g8::gemm_phase(lds, S, g8::EpiXres{(bf16_t*)(ws + 424 * MiB), nullptr, nullptr}); } break;
    case PH_COMBINE_T: combine_phase(c.out, (float*)(ws + 296 * MiB), YB, (bf16_t*)(ws + 424 * MiB), (float*)(ws + 488 * MiB), (float*)(ws + 489 * MiB), nullptr, 0, nullptr, nullptr, lds); break;
    case PH_ROUTE_T: route_phase(XB, WR, c.in[24] + l * NG, c.in[26] + l * NE, (float*)(ws + 488 * MiB), (int*)(ws + 489 * MiB), (int*)(ws + 490 * MiB), (float*)(ws + 491 * MiB), (int*)(ws + 491 * MiB + 524288), lds); break;
    case PH_DIAG_KLOOP: { g8::DenseSched S{8, 128 * 8, D, D, D, XB, WCIN}; g8::gemm_phase(lds, S, g8::EpiNone{}); } break;
    case PH_FLAGOUT: flagout_phase(c.out, (unsigned*)(ws + OW_DBG)); break;
    case PH_GLA_OUT: { g8::DenseSched S{4, 128 * 4, D, D, D, GOB, WGO}; g8::gemm_phase(lds, S, g8::EpiXres{XB, nullptr, SSP}); } break;
    }
}
template <int PH> __global__ void __launch_bounds__(512, 2) k_opt(Ctx c, int l) {
    extern __shared__ __attribute__((aligned(16))) unsigned char dynlds[];
    run_phase(c, PH, l, (LAS unsigned char*)dynlds);
}

#ifndef ALLCG
#define ALLCG 0
#endif
#define XB_TMO      128
#define XB_XCNT(j)  (256  + 64 * (j))
#define XB_XSUB(j)  (1280 + 64 * (j))
#define XB_XGEN(j)  (2304 + 64 * (j))
#define XB_TOP      3328
#define XB_TOPGEN   3392
#define XCD_BAR_WORDS 3456
#define XB_SPIN_CAP (1u << 18)
__device__ __forceinline__ unsigned xb_ld(unsigned* p)              { return __hip_atomic_load(p, __ATOMIC_RELAXED, __HIP_MEMORY_SCOPE_AGENT); }
__device__ __forceinline__ unsigned xb_add(unsigned* p, unsigned v) { return __hip_atomic_fetch_add(p, v, __ATOMIC_RELAXED, __HIP_MEMORY_SCOPE_AGENT); }
__device__ __forceinline__ unsigned xb_xcc_id() { return (unsigned)__builtin_amdgcn_s_getreg((3 << 11) | 20) & 0xFu; }
#define XB_SPIN(cond, bar) do { unsigned _sp = 0; while (cond) { __builtin_amdgcn_s_sleep(1); \
    if ((++_sp & 255u) == 0u) { if (xb_ld(&(bar)[XB_TMO])) break; if (_sp > XB_SPIN_CAP) { atomicAdd(&(bar)[XB_TMO], 1u); break; } } } } while (0)
struct XcdBarrier { unsigned* bar; unsigned x; volatile LAS unsigned* st; };
__device__ __forceinline__ XcdBarrier xcd_barrier_post(unsigned* bar, volatile LAS unsigned* st) {
    XcdBarrier b; b.bar = bar; b.x = xb_xcc_id(); b.st = st;
    if (threadIdx.x == 0) (void)xb_add(&bar[XB_XCNT(b.x)], 1u);
    return b;
}
__device__ __forceinline__ void xcd_barrier_complete(unsigned* bar, unsigned x, unsigned& nloc, unsigned& nx) {
    const unsigned G = gridDim.x * gridDim.y * gridDim.z;
    unsigned sum, cnt, mine, sp = 0u;
    for (;;) {
        sum = 0u; cnt = 0u; mine = 0u;
#pragma unroll
        for (unsigned j = 0; j < 16; ++j) { const unsigned c = xb_ld(&bar[XB_XCNT(j)]); sum += c; cnt += (c > 0u) ? 1u : 0u; mine = (j == x) ? c : mine; }
        if (sum == G) break;
        __builtin_amdgcn_s_sleep(1);
        if ((++sp & 255u) == 0u) { if (xb_ld(&bar[XB_TMO])) break; if (sp > XB_SPIN_CAP) { atomicAdd(&bar[XB_TMO], 1u); break; } }
    }
    nloc = mine > 0u ? mine : 1u; nx = cnt > 0u ? cnt : 1u;
}
__device__ __forceinline__ void xcd_barrier(const XcdBarrier& b) {
    asm volatile("s_waitcnt vmcnt(0)" ::: "memory");
    __syncthreads();
    if (threadIdx.x == 0) {
        unsigned* bar = b.bar;
        __builtin_amdgcn_s_waitcnt(0);
        unsigned nloc = b.st[0], nx = b.st[1];
        if (nloc == 0u) { xcd_barrier_complete(bar, b.x, nloc, nx); b.st[0] = nloc; b.st[1] = nx; }
        const unsigned old = xb_add(&bar[XB_XSUB(b.x)], 1u);
        const unsigned gen = old / nloc;
        if (old + 1u == (gen + 1u) * nloc) {
            __builtin_amdgcn_fence(__ATOMIC_RELEASE, "agent");
            asm volatile("s_waitcnt vmcnt(0)" ::: "memory");
            const unsigned og = xb_add(&bar[XB_TOP], 1u);
            const unsigned tg = og / nx;
            if (og + 1u == (tg + 1u) * nx) xb_add(&bar[XB_TOPGEN], 1u);
            else XB_SPIN(xb_ld(&bar[XB_TOPGEN]) == tg, bar);
            __builtin_amdgcn_fence(__ATOMIC_ACQUIRE, "agent");
            xb_add(&bar[XB_XGEN(b.x)], 1u);
            asm volatile("s_waitcnt vmcnt(0)" ::: "memory");
        } else {
            XB_SPIN(xb_ld(&bar[XB_XGEN(b.x)]) == gen, bar);
            __builtin_amdgcn_fence(__ATOMIC_ACQUIRE, "agent");
            asm volatile("s_waitcnt vmcnt(0)" ::: "memory");
        }
    }
    __syncthreads();
}
template <int CODE> __device__ __forceinline__ void coop_step(const Ctx& c, LAS unsigned char* lds, cg::grid_group& grid, XcdBarrier& xb, bool sync_after, bool first) {
    run_phase(c, CODE >> 5, CODE & 31, lds);
    if (sync_after) {
        if (first || ALLCG) {
            unsigned* bar = (unsigned*)(c.ws + OW_BAR);
            if (first && blockIdx.x == 0) for (int i = threadIdx.x; i < XCD_BAR_WORDS; i += 512) bar[i] = 0u;
            asm volatile("s_waitcnt vmcnt(0) lgkmcnt(0)" ::: "memory");
            grid.sync();
            if (threadIdx.x < 64) { __builtin_amdgcn_fence(__ATOMIC_ACQUIRE, "agent"); asm volatile("s_waitcnt vmcnt(0)" ::: "memory"); }
            __syncthreads();
            if (first) xb = xcd_barrier_post(bar, xb.st);
        } else xcd_barrier(xb);
    }
}
template <int... CODES> __global__ void __launch_bounds__(512, 2) k_coop(Ctx c) {
    extern __shared__ __attribute__((aligned(16))) unsigned char dynlds[];
    cg::grid_group grid = cg::this_grid();
    LAS unsigned char* lds = (LAS unsigned char*)dynlds;
    volatile LAS unsigned* st = (volatile LAS unsigned*)(lds + LDS_BYTES - 16);
    if (threadIdx.x < 4) st[threadIdx.x] = 0u;
    __syncthreads();
    XcdBarrier xb; xb.bar = nullptr; xb.x = 0; xb.st = st;
    int idx = 0; constexpr int N = sizeof...(CODES);
    ((coop_step<CODES>(c, lds, grid, xb, idx + 1 < N, idx == 0), ++idx), ...);
}
#define CODE(ph, l) ((ph) * 32 + (l))
typedef void (*CoopFn)(Ctx);
extern "C" void kernel_launch(void* const* d_in, const int* in_sizes, int n_in, void* d_out, int out_size, void* d_ws, size_t ws_size, hipStream_t stream) {
    if (n_in != 30 || out_size != T * D || ws_size < OW_END) { fprintf(stderr, "kernel_launch: built for 30 inputs, %d outputs and >= %zu bytes of workspace; got n_in %d, out %d, ws %zu; nothing launched\n", T * D, (size_t)OW_END, n_in, out_size, ws_size); return; }
    Ctx c; memset(&c, 0, sizeof(c));
    for (int i = 0; i < 30; ++i) c.in[i] = (const float*)d_in[i];
    c.out = (float*)d_out; c.ws = (unsigned char*)d_ws;
    static CoopFn fn = k_coop<CODE(PH_PREP_ALL, 0), CODE(PH_CONV_IN, 0), CODE(PH_CONV_MID, 0), CODE(PH_CONV_OUT, 0),
                                         CODE(PH_XA_KV, 0), CODE(PH_XA_QSP, 0), CODE(PH_XA_O, 0),
                                         CODE(PH_ROUTE, 0), CODE(PH_BUILD, 0), CODE(PH_MOE1, 0), CODE(PH_MOE2, 0), CODE(PH_COMBINE, 0),
                                         CODE(PH_GLA_DECAY, 0), CODE(PH_GLA_IN, 0), CODE(PH_GLA_ATT, 0), CODE(PH_GLA_SCAN, 0), CODE(PH_GLA_O, 0), CODE(PH_GLA_FIN, 0), CODE(PH_GLA_OUT, 0),
                                         CODE(PH_XA_KV, 1), CODE(PH_XA_QSP, 1), CODE(PH_XA_O, 1),
                                         CODE(PH_ROUTE, 1), CODE(PH_BUILD, 1), CODE(PH_MOE1, 1), CODE(PH_MOE2, 1), CODE(PH_COMBINE_FIN, 1)>;
    static int grid = 0;
    if (!grid) {
        int dev = 0, cus = 0, per_cu = 0;
        (void)hipGetDevice(&dev); (void)hipDeviceGetAttribute(&cus, hipDeviceAttributeMultiprocessorCount, dev);
        (void)hipFuncSetAttribute((const void*)fn, hipFuncAttributeMaxDynamicSharedMemorySize, LDS_BYTES);
        (void)hipOccupancyMaxActiveBlocksPerMultiprocessor(&per_cu, fn, 512, LDS_BYTES);
        grid = cus * (per_cu < 1 ? 1 : per_cu); if (grid > 256) grid = 256;
        if (grid != 256) fprintf(stderr, "kernel_launch: %d CUs x %d workgroups: this kernel is laid out for 256 resident workgroups\n", cus, per_cu);
    }
    void* args[] = {&c};
    hipError_t e = hipLaunchCooperativeKernel((void*)fn, dim3(grid), dim3(512), args, LDS_BYTES, stream);
    if (e != hipSuccess) fprintf(stderr, "cooperative launch failed: %s (grid %d)\n", hipGetErrorString(e), grid);
}
```

```cpp
#include <hip/hip_runtime.h>
#include <hip/hip_cooperative_groups.h>
#include <cstdio>
#include <cstring>
namespace cg = cooperative_groups;

constexpr int D = 1024, NB = 4, S = 8192, T = NB * S, NMEM = 256;
constexpr int CONVK = 31;
constexpr int GDK = 512, GDVH = 256, GLA_COLS = 3088;
constexpr int NG = 4, NE = 32, DE = 512;
constexpr int NA = T * 2;
constexpr float EPS = 1e-6f;
constexpr size_t MiB = 1u << 20;

struct Ctx { const float* in[30]; float* out; unsigned char* ws; };

__device__ __forceinline__ float wave_sum(float v) {
#pragma unroll
    for (int o = 1; o < 64; o <<= 1) v += __shfl_xor(v, o);
    return v;
}

#define LAS __attribute__((address_space(3)))
typedef unsigned short bf16_t;
typedef short bf16x8 __attribute__((ext_vector_type(8)));
typedef float f32x4 __attribute__((ext_vector_type(4)));
typedef float f32x2 __attribute__((ext_vector_type(2)));
typedef unsigned u32x4 __attribute__((ext_vector_type(4)));
typedef unsigned u32x2 __attribute__((ext_vector_type(2)));

constexpr int LDS_BYTES = 160 * 1024;
constexpr int NSLOT2 = NA + NE * 256;
constexpr int MAXRT = NSLOT2 / 256;
constexpr size_t OW_XB = 0;
constexpr size_t OW_SSP = 64 * MiB;
constexpr size_t OW_RS = 66 * MiB;
constexpr size_t OW_PSUM = 67 * MiB;
constexpr size_t OW_MOE = 69 * MiB;
constexpr size_t OW_ACTA = 72 * MiB, OW_ACTB = 136 * MiB, OW_ACTC = 200 * MiB;
constexpr size_t OW_H = 72 * MiB, OW_Y = 144 * MiB, OW_WMOE = 272 * MiB;
constexpr size_t OW_KVB = 368 * MiB;
constexpr size_t OW_MEMNB = 502 * MiB;
constexpr size_t OW_WCIN = 550 * MiB, OW_WCOUT = 554 * MiB, OW_WXQ = 556 * MiB, OW_WXKV = 560 * MiB, OW_WXO = 568 * MiB, OW_WR = 572 * MiB, OW_BAR = 573 * MiB, OW_DBG = 574 * MiB, OW_END = 575 * MiB;
constexpr size_t OW_ATT = 360 * MiB, OW_QKR = 72 * MiB, OW_KVT = 200 * MiB, OW_BTM = 296 * MiB, OW_O = 296 * MiB, OW_BFM = 360 * MiB, OW_UT = 424 * MiB, OW_SP = 456 * MiB,
                 OW_ALR = 488 * MiB, OW_DL = 490 * MiB, OW_GO = 200 * MiB, OW_WGTM = 492 * MiB, OW_WGFM = 496 * MiB, OW_WGO = 499 * MiB, OW_WA = 501 * MiB;
constexpr size_t OM_GCNT = OW_MOE, OM_NT = OW_MOE + 256, OM_TILEE = OW_MOE + 512, OM_AE = OW_MOE + 4096, OM_APOS = OM_AE + NA * 4, OM_GATE = OM_APOS + NA * 4,
                 OM_STOK = OM_GATE + NA * 4, OM_SA = OM_STOK + NSLOT2 * 4, OM_SRS = OM_SA + NSLOT2 * 4, OM_SGATE = OM_SRS + NSLOT2 * 4, OM_END = OM_SGATE + NSLOT2 * 4;
static_assert(OM_END <= OW_ACTA, "MoE small arrays");

typedef __bf16 bf16x2_t __attribute__((ext_vector_type(2)));
__device__ __forceinline__ unsigned cvt_pk_bf16(float lo, float hi) { const f32x2 v = {lo, hi}; return __builtin_bit_cast(unsigned, __builtin_convertvector(v, bf16x2_t)); }
__device__ __forceinline__ int otid() { int t = threadIdx.x; asm volatile("" : "+v"(t)); return t; }
__device__ __forceinline__ u32x4 pack8(const f32x4& a, const f32x4& b) { u32x4 w; w.x = cvt_pk_bf16(a[0], a[1]); w.y = cvt_pk_bf16(a[2], a[3]); w.z = cvt_pk_bf16(b[0], b[1]); w.w = cvt_pk_bf16(b[2], b[3]); return w; }
__device__ __forceinline__ float bf_lo(unsigned w) { return __uint_as_float(w << 16); }
__device__ __forceinline__ float bf_hi(unsigned w) { return __uint_as_float(w & 0xffff0000u); }
__device__ __forceinline__ float fast_sigmoid(float x) { return __builtin_amdgcn_rcpf(1.0f + __builtin_amdgcn_exp2f(-1.4426950408889634f * x)); }

#ifndef LDS_POISON
#define LDS_POISON 0
#endif
#ifndef G8_SP2
#define G8_SP2 1
#endif
namespace g8 {
constexpr int BM = 256, BK = 64, HALF = 128, HTB = HALF * BK * 2, STAGE_BYTES = 8 * HTB;
__device__ __forceinline__ int lds_byte(int r, int c) { const int st = (r >> 4) * 2 + (c >> 5), rr = r & 15, cc = c & 31, ob = rr * 64 + cc * 2; return st * 1024 + (ob ^ (((ob >> 9) & 1) << 5)); }
__device__ __forceinline__ void stage_rc(int b, int& R, int& C) { const int st = b / 1024, sb = b % 1024, swz = sb ^ (((sb >> 9) & 1) << 5); R = (st >> 1) * 16 + swz / 64; C = (st & 1) * 32 + (swz % 64) / 2; }
__device__ __forceinline__ int perm32(int rho) { const int n = rho >> 4, i = rho & 15; return 8 * (i >> 2) + 4 * n + (i & 3); }
struct Unit { int pm, pn, e; };

template <class Epi, class Sched>
__device__ __forceinline__ void gemm_phase(LAS unsigned char* lds, const Sched& S, const Epi& E) {
    int tid_ = threadIdx.x; asm volatile("" : "+v"(tid_));
    const int tid = tid_, wid = __builtin_amdgcn_readfirstlane(tid >> 6), lane = tid & 63, wr = wid >> 2, wc = wid & 3, fr = lane & 15, fq = lane >> 4;
    const size_t kstep = (size_t)(BK * 2);
    const unsigned ldsw = (unsigned)wid * 1024u;
    const int aoff = lds_byte(wr * 64 + fr, fq * 8), boff = lds_byte(wc * 32 + fr, fq * 8);
#define G8_SA(b, h) (((b) * 2 + (h)) * HTB)
#define G8_SB(b, h) ((4 + (b) * 2 + (h)) * HTB)
#define G8_STAGE(bufoff, gbase, vv) do { _Pragma("unroll") for (int _i = 0; _i < 2; ++_i) \
        __builtin_amdgcn_global_load_lds((const unsigned*)((const char*)(gbase) + (vv)[_i]), (LAS unsigned*)(lds + (bufoff) + ldsw + _i * 8192), 16, 0, 0); } while (0)
#define G8_LDA(dst, b, h) do { _Pragma("unroll") for (int m = 0; m < 4; ++m) _Pragma("unroll") for (int k = 0; k < 2; ++k) dst[m][k] = *(const LAS bf16x8*)(lds + G8_SA(b, h) + aoff + m * 2048 + k * 1024); } while (0)
#define G8_LDB(dst, b, h) do { _Pragma("unroll") for (int n = 0; n < 2; ++n) _Pragma("unroll") for (int k = 0; k < 2; ++k) dst[n][k] = *(const LAS bf16x8*)(lds + G8_SB(b, h) + boff + n * 2048 + k * 1024); } while (0)
#define G8_MMA(ai, bj, At, Bt) do { __builtin_amdgcn_s_setprio(1); _Pragma("unroll") for (int m = 0; m < 4; ++m) _Pragma("unroll") for (int n = 0; n < 2; ++n) _Pragma("unroll") for (int k = 0; k < 2; ++k) \
        acc[ai][bj][m][n] = __builtin_amdgcn_mfma_f32_16x16x32_bf16(Bt[n][k], At[m][k], acc[ai][bj][m][n], 0, 0, 0); __builtin_amdgcn_s_setprio(0); } while (0)
#define G8_WAIT_V(n) asm volatile("s_waitcnt vmcnt(" #n ")" ::: "memory")
#define G8_WAIT_L(n) asm volatile("s_waitcnt lgkmcnt(" #n ")" ::: "memory")
#define G8_BAR __builtin_amdgcn_s_barrier()
#define G8_SCHED __builtin_amdgcn_sched_barrier(0)
#define G8_VA(dst, u) do { const int _ac = S.a_col(u), _lda = S.lda(u); _Pragma("unroll") for (int _i = 0; _i < 2; ++_i) { int _R, _C; stage_rc(tid * 16 + _i * 8192, _R, _C); \
        _Pragma("unroll") for (int _h = 0; _h < 2; ++_h) dst[_h][_i] = (unsigned)(((size_t)S.a_row(u, _h * HALF + _R) * _lda + _ac + _C) * 2); } } while (0)
#define G8_VB(dst, hs, u) do { const int _ldb = S.ldb(u); hs = (size_t)HALF * _ldb * 2; _Pragma("unroll") for (int _i = 0; _i < 2; ++_i) { int _R, _C; stage_rc(tid * 16 + _i * 8192, _R, _C); \
        dst[_i] = (unsigned)(((_R & ~31) + perm32(_R & 31)) * _ldb + _C) * 2u; } } while (0)
    Unit cur, nxt; int ui = 0; bool aligned_end = false;
    if (!S.next(0, cur)) return;
#if LDS_POISON
    for (int i = tid; i < STAGE_BYTES / 16; i += 512) ((LAS u32x4*)lds)[i] = (u32x4){0x7fc07fc0u, 0x7fc07fc0u, 0x7fc07fc0u, 0x7fc07fc0u};
    __syncthreads();
#endif
    f32x4 acc[2][2][4][2];
#pragma unroll
    for (int a = 0; a < 2; ++a)
#pragma unroll
        for (int b = 0; b < 2; ++b)
#pragma unroll
            for (int m = 0; m < 4; ++m)
#pragma unroll
                for (int n = 0; n < 2; ++n) acc[a][b][m][n] = (f32x4){0.f, 0.f, 0.f, 0.f};
    bf16x8 At[4][2], B0[2][2], B1[2][2];
    unsigned va[2][2], nva[2][2], vb[2], nvb[2]; size_t hsB, nhsB;
    G8_VA(va, cur); G8_VB(vb, hsB, cur);
    const char* Ab = S.a_base(cur);
    const char* cB = S.b_base(cur);
#if G8_SP2
    G8_STAGE(G8_SB(0, 0), cB, vb); G8_STAGE(G8_SB(0, 1), cB + hsB, vb); G8_STAGE(G8_SA(0, 0), Ab, va[0]); G8_STAGE(G8_SA(0, 1), Ab, va[1]);
    if (wr == 1) G8_BAR;
    G8_WAIT_V(2); G8_BAR;
    G8_STAGE(G8_SB(1, 0), cB + kstep, vb); G8_STAGE(G8_SA(1, 0), Ab + kstep, va[0]); G8_STAGE(G8_SB(1, 1), cB + hsB + kstep, vb);
    G8_WAIT_V(6); G8_BAR;
#else
    G8_STAGE(G8_SB(0, 0), cB, vb); G8_STAGE(G8_SA(0, 0), Ab, va[0]); G8_STAGE(G8_SB(0, 1), cB + hsB, vb); G8_STAGE(G8_SA(0, 1), Ab, va[1]);
    if (wr == 1) G8_BAR;
    G8_WAIT_V(4); G8_BAR;
    G8_STAGE(G8_SB(1, 0), cB + kstep, vb); G8_STAGE(G8_SA(1, 0), Ab + kstep, va[0]); G8_STAGE(G8_SB(1, 1), cB + hsB + kstep, vb);
    G8_WAIT_V(6); G8_BAR;
#endif
    for (;;) {
        const bool has_next = S.next(ui + 1, nxt);
        const char* nB = cB; const char* nAb = Ab;
        if (has_next) { nB = S.b_base(nxt); nAb = S.a_base(nxt); G8_VA(nva, nxt); G8_VB(nvb, nhsB, nxt); }
        else {
            nhsB = hsB;
#pragma unroll
            for (int i = 0; i < 2; ++i) { nvb[i] = vb[i];
#pragma unroll
                for (int h = 0; h < 2; ++h) nva[h][i] = va[h][i]; }
        }
        const int nt = S.nt(cur);
        for (int t = 0; t < nt; t += 2) {
            const bool last = (t == nt - 2);
            const char* a1 = Ab + (size_t)(t + 1) * kstep;
            const char* a2 = last ? nAb : Ab + (size_t)(t + 2) * kstep;
            const char* b2 = last ? nB : cB + (size_t)(t + 2) * kstep;
            const char* a3 = a2 + kstep; const char* b3 = b2 + kstep;
            const size_t hs2 = last ? nhsB : hsB;
            unsigned v2[2][2], vb2[2];
#pragma unroll
            for (int i = 0; i < 2; ++i) { vb2[i] = last ? nvb[i] : vb[i];
#pragma unroll
                for (int h = 0; h < 2; ++h) v2[h][i] = last ? nva[h][i] : va[h][i]; }
#if G8_SP2
            G8_LDB(B0, 0, 0); G8_LDB(B1, 0, 1); G8_SCHED; G8_LDA(At, 0, 0); G8_STAGE(G8_SA(1, 1), a1, va[1]);
            G8_WAIT_V(8); G8_WAIT_L(0); G8_BAR; G8_MMA(0, 0, At, B0); G8_MMA(0, 1, At, B1); G8_BAR; G8_SCHED;
            G8_LDA(At, 0, 1); G8_STAGE(G8_SB(0, 0), b2, vb2); G8_STAGE(G8_SB(0, 1), b2 + hs2, vb2); G8_STAGE(G8_SA(0, 0), a2, v2[0]);
            G8_WAIT_V(8); G8_WAIT_L(0); G8_BAR; G8_MMA(1, 0, At, B0); G8_MMA(1, 1, At, B1); G8_BAR; G8_SCHED;
            G8_LDB(B0, 1, 0); G8_LDB(B1, 1, 1); G8_SCHED; G8_LDA(At, 1, 0); G8_STAGE(G8_SA(0, 1), a2, v2[1]);
            G8_WAIT_V(8); G8_WAIT_L(0); G8_BAR; G8_MMA(0, 0, At, B0); G8_MMA(0, 1, At, B1); G8_BAR; G8_SCHED;
            G8_LDA(At, 1, 1); G8_STAGE(G8_SB(1, 0), b3, vb2); G8_STAGE(G8_SB(1, 1), b3 + hs2, vb2); G8_STAGE(G8_SA(1, 0), a3, v2[0]);
            G8_WAIT_V(8); G8_WAIT_L(0); G8_BAR; G8_MMA(1, 0, At, B0); G8_MMA(1, 1, At, B1); G8_BAR; G8_SCHED;
#else
            G8_LDB(B0, 0, 0); G8_SCHED; G8_LDA(At, 0, 0); G8_STAGE(G8_SA(1, 1), a1, va[1]);
            G8_WAIT_L(8); G8_BAR; G8_WAIT_L(0); G8_MMA(0, 0, At, B0); G8_BAR; G8_SCHED;
            G8_LDB(B1, 0, 1); G8_STAGE(G8_SB(0, 0), b2, vb2);
            G8_BAR; G8_WAIT_L(0); G8_MMA(0, 1, At, B1); G8_BAR;
            G8_LDA(At, 0, 1); G8_STAGE(G8_SA(0, 0), a2, v2[0]);
            G8_BAR; G8_WAIT_L(0); G8_MMA(1, 0, At, B0); G8_BAR; G8_SCHED;
            G8_STAGE(G8_SB(0, 1), b2 + hs2, vb2);
            G8_WAIT_V(6); G8_BAR; G8_MMA(1, 1, At, B1); G8_BAR;
            G8_LDB(B0, 1, 0); G8_SCHED; G8_LDA(At, 1, 0); G8_STAGE(G8_SA(0, 1), a2, v2[1]);
            G8_WAIT_L(8); G8_BAR; G8_WAIT_L(0); G8_MMA(0, 0, At, B0); G8_BAR; G8_SCHED;
            G8_LDB(B1, 1, 1); G8_STAGE(G8_SB(1, 0), b3, vb2);
            G8_BAR; G8_WAIT_L(0); G8_MMA(0, 1, At, B1); G8_BAR;
            G8_LDA(At, 1, 1); G8_STAGE(G8_SA(1, 0), a3, v2[0]);
            G8_BAR; G8_WAIT_L(0); G8_MMA(1, 0, At, B0); G8_BAR; G8_SCHED;
            G8_STAGE(G8_SB(1, 1), b3 + hs2, vb2);
            G8_WAIT_V(6); G8_BAR; G8_MMA(1, 1, At, B1); G8_BAR;
#endif
        }
        const bool keep = S.cont(cur);
        if (!keep) {
            if (wr == 0) G8_BAR;
            E(acc, cur, wr, wc, fr, fq);
            if (has_next && wr == 1) G8_BAR;
        }
        if (!has_next) { aligned_end = !keep; break; }
        if (!keep) {
#pragma unroll
            for (int a = 0; a < 2; ++a)
#pragma unroll
                for (int b = 0; b < 2; ++b)
#pragma unroll
                    for (int m = 0; m < 4; ++m)
#pragma unroll
                        for (int n = 0; n < 2; ++n) acc[a][b][m][n] = (f32x4){0.f, 0.f, 0.f, 0.f};
        }
        cur = nxt; cB = nB; Ab = nAb; hsB = nhsB; ++ui;
#pragma unroll
        for (int i = 0; i < 2; ++i) { vb[i] = nvb[i];
#pragma unroll
            for (int h = 0; h < 2; ++h) va[h][i] = nva[h][i]; }
    }
    G8_WAIT_V(0);
    if (!aligned_end && wr == 0) G8_BAR;
    G8_BAR;
#undef G8_SA
#undef G8_SB
#undef G8_STAGE
#undef G8_LDA
#undef G8_LDB
#undef G8_MMA
#undef G8_WAIT_V
#undef G8_WAIT_L
#undef G8_BAR
#undef G8_SCHED
#undef G8_VA
#undef G8_VB
}

struct DenseSched {
    __device__ __forceinline__ int lda(const Unit&) const { return lda_; }
    __device__ __forceinline__ int ldb(const Unit&) const { return ldb_; }
    __device__ __forceinline__ int nt(const Unit&) const { return K / BK; }
    __device__ __forceinline__ bool cont(const Unit&) const { return false; }
    int nN, nU, K, lda_, ldb_; const bf16_t* A; const bf16_t* Bt;
    __device__ __forceinline__ const char* a_base(const Unit&) const { return (const char*)A; }
    __device__ __forceinline__ bool next(int i, Unit& u) const {
        const int c = blockIdx.x, per = gridDim.x >> 3, x = c & 7, j = c >> 3;
        const int chunk = (nU + 7) >> 3, lu = i * per + j;
        if (lu >= chunk) return false;
        const int un = x * chunk + lu; if (un >= nU) return false;
        u.pm = un / nN; u.pn = un - u.pm * nN; u.e = 0; return true; }
    __device__ __forceinline__ int a_row(const Unit& u, int r) const { return u.pm * BM + r; }
    __device__ __forceinline__ int a_col(const Unit&) const { return 0; }
    __device__ __forceinline__ const char* b_base(const Unit& u) const { return (const char*)(Bt + (size_t)u.pn * BM * ldb_); }
};

struct EpiGlu {
    bf16_t* U; const float* rs; const float* bias;
    __device__ __forceinline__ void operator()(const f32x4 (&acc)[2][2][4][2], const Unit& u, int wr, int wc, int fr, int fq) const {
        const int c0 = u.pn * 128 + wc * 32 + 8 * fq;
        const f32x4 ba0 = *(const f32x4*)(bias + c0), ba1 = *(const f32x4*)(bias + c0 + 4), bg0 = *(const f32x4*)(bias + 1024 + c0), bg1 = *(const f32x4*)(bias + 1024 + c0 + 4);
        float rv[2][4];
#pragma unroll
        for (int ai = 0; ai < 2; ++ai)
#pragma unroll
            for (int m = 0; m < 4; ++m) rv[ai][m] = rs[u.pm * BM + ai * HALF + wr * 64 + m * 16 + fr];
        __builtin_amdgcn_sched_barrier(0);
#pragma unroll
        for (int ai = 0; ai < 2; ++ai)
#pragma unroll
            for (int m = 0; m < 4; ++m) {
                const int row = u.pm * BM + ai * HALF + wr * 64 + m * 16 + fr; const float r = rv[ai][m];
                f32x4 o0, o1;
#pragma unroll
                for (int j = 0; j < 4; ++j) {
                    o0[j] = (acc[ai][0][m][0][j] * r + ba0[j]) * fast_sigmoid(acc[ai][1][m][0][j] * r + bg0[j]);
                    o1[j] = (acc[ai][0][m][1][j] * r + ba1[j]) * fast_sigmoid(acc[ai][1][m][1][j] * r + bg1[j]); }
                *(u32x4*)(U + (size_t)row * D + c0) = pack8(o0, o1);
            }
    }
};
struct EpiXres {
    bf16_t* XB; const float* bias; float* ssp;
    __device__ __forceinline__ void operator()(const f32x4 (&acc)[2][2][4][2], const Unit& u, int wr, int wc, int fr, int fq) const {
        f32x4 bv[2][2];
#pragma unroll
        for (int bj = 0; bj < 2; ++bj) { const int c0 = u.pn * BM + bj * HALF + wc * 32 + 8 * fq;
            bv[bj][0] = bias ? *(const f32x4*)(bias + c0) : (f32x4){0.f, 0.f, 0.f, 0.f}; bv[bj][1] = bias ? *(const f32x4*)(bias + c0 + 4) : (f32x4){0.f, 0.f, 0.f, 0.f}; }
#pragma unroll
        for (int ai = 0; ai < 2; ++ai) {
            u32x4 xv[2][4][2];
#pragma unroll
            for (int m = 0; m < 4; ++m)
#pragma unroll
                for (int bj = 0; bj < 2; ++bj) xv[ai][m][bj] = *(const u32x4*)(XB + (size_t)(u.pm * BM + ai * HALF + wr * 64 + m * 16 + fr) * D + u.pn * BM + bj * HALF + wc * 32 + 8 * fq);
            __builtin_amdgcn_sched_barrier(0);
#pragma unroll
            for (int m = 0; m < 4; ++m) {
                const int row = u.pm * BM + ai * HALF + wr * 64 + m * 16 + fr; float ss = 0.f;
#pragma unroll
                for (int bj = 0; bj < 2; ++bj) {
                    const size_t off = (size_t)row * D + u.pn * BM + bj * HALF + wc * 32 + 8 * fq; const u32x4 xw = xv[ai][m][bj];
                    const f32x4 v0 = (f32x4){bf_lo(xw.x), bf_hi(xw.x), bf_lo(xw.y), bf_hi(xw.y)} + acc[ai][bj][m][0] + bv[bj][0];
                    const f32x4 v1 = (f32x4){bf_lo(xw.z), bf_hi(xw.z), bf_lo(xw.w), bf_hi(xw.w)} + acc[ai][bj][m][1] + bv[bj][1];
                    const u32x4 w = pack8(v0, v1);
                    *(u32x4*)(XB + off) = w;
                    const float r0 = bf_lo(w.x), r1 = bf_hi(w.x), r2 = bf_lo(w.y), r3 = bf_hi(w.y), r4 = bf_lo(w.z), r5 = bf_hi(w.z), r6 = bf_lo(w.w), r7 = bf_hi(w.w);
                    ss += (r0 * r0 + r1 * r1) + (r2 * r2 + r3 * r3) + (r4 * r4 + r5 * r5) + (r6 * r6 + r7 * r7);
                }
                if (ssp) { ss += __shfl_xor(ss, 16); ss += __shfl_xor(ss, 32); if (fq == 0) ssp[(size_t)row * 16 + u.pn * 4 + wc] = ss; }
            }
            __builtin_amdgcn_sched_barrier(0);
        }
    }
};
struct AttnSched {
    __device__ __forceinline__ int lda(const Unit&) const { return lda_; }
    __device__ __forceinline__ int ldb(const Unit&) const { return ldb_; }
    __device__ __forceinline__ int nt(const Unit&) const { return K / BK; }
    __device__ __forceinline__ bool cont(const Unit&) const { return false; }
    int K, lda_, ldb_; const bf16_t* A; const bf16_t* Bm; int pv;
    __device__ __forceinline__ bool next(int i, Unit& u) const {
        const int c = blockIdx.x, per = gridDim.x >> 3, x = c & 7, j = c >> 3;
        const int lu = i * per + j; if (lu >= 64) return false;
        const int un = x * 64 + lu;
        u.pm = un >> 2; u.pn = 0; u.e = un & 3; return true; }
    __device__ __forceinline__ const char* a_base(const Unit&) const { return (const char*)A; }
    __device__ __forceinline__ int a_row(const Unit& u, int r) const { return u.pm * BM + r; }
    __device__ __forceinline__ int a_col(const Unit& u) const { return u.e * 256; }
    __device__ __forceinline__ const char* b_base(const Unit& u) const { const int b = u.pm >> 5;
        return pv ? (const char*)(Bm + (size_t)(b * 4 + u.e) * 65536) : (const char*)(Bm + (size_t)(b * 256) * 1024 + u.e * 256); }
};
struct KVSched {
    __device__ __forceinline__ int lda(const Unit&) const { return lda_; }
    __device__ __forceinline__ int ldb(const Unit&) const { return ldb_; }
    __device__ __forceinline__ int nt(const Unit&) const { return K / BK; }
    __device__ __forceinline__ bool cont(const Unit&) const { return false; }
    int K, lda_, ldb_; const bf16_t* MEMNB; const bf16_t* WKV;
    __device__ __forceinline__ bool next(int i, Unit& u) const {
        const int un = i * (int)gridDim.x + (int)blockIdx.x; if (un >= 32) return false;
        u.e = un >> 4; u.pm = (un & 15) >> 2; u.pn = un & 3; return true; }
    __device__ __forceinline__ const char* a_base(const Unit& u) const { return u.e ? (const char*)(WKV + (size_t)1024 * 1024) : (const char*)MEMNB; }
    __device__ __forceinline__ int a_row(const Unit& u, int r) const { return u.pm * BM + r; }
    __device__ __forceinline__ int a_col(const Unit&) const { return 0; }
    __device__ __forceinline__ const char* b_base(const Unit& u) const { return u.e ? (const char*)(MEMNB + (size_t)u.pn * BM * 1024) : (const char*)(WKV + (size_t)u.pn * BM * 1024); }
};
__device__ __forceinline__ float ssp_rs(const float* ssp, int row) {
    const f32x4 a = *(const f32x4*)(ssp + (size_t)row * 16), b = *(const f32x4*)(ssp + (size_t)row * 16 + 4), c = *(const f32x4*)(ssp + (size_t)row * 16 + 8), d = *(const f32x4*)(ssp + (size_t)row * 16 + 12);
    const float s = ((a[0] + a[1]) + (a[2] + a[3])) + ((b[0] + b[1]) + (b[2] + b[3])) + ((c[0] + c[1]) + (c[2] + c[3])) + ((d[0] + d[1]) + (d[2] + d[3]));
    return rsqrtf(s * (1.0f / D) + EPS);
}
struct EpiRowScale {
    bf16_t* O; int ldo; const float* ssp; const float* rs; float scale; int qtiles; float qscale;
    __device__ __forceinline__ void operator()(const f32x4 (&acc)[2][2][4][2], const Unit& u, int wr, int wc, int fr, int fq) const {
        const float cs = scale * (u.pn < qtiles ? qscale : 1.0f);
        float rv[2][4];
        if (rs) {
#pragma unroll
            for (int ai = 0; ai < 2; ++ai)
#pragma unroll
                for (int m = 0; m < 4; ++m) rv[ai][m] = rs[u.pm * BM + ai * HALF + wr * 64 + m * 16 + fr];
        } else {
#pragma unroll
            for (int ai = 0; ai < 2; ++ai) {
                f32x4 p[4][4];
#pragma unroll
                for (int m = 0; m < 4; ++m)
#pragma unroll
                    for (int q = 0; q < 4; ++q) p[m][q] = *(const f32x4*)(ssp + (size_t)(u.pm * BM + ai * HALF + wr * 64 + m * 16 + fr) * 16 + 4 * q);
                __builtin_amdgcn_sched_barrier(0);
#pragma unroll
                for (int m = 0; m < 4; ++m) { float sm = 0.f;
#pragma unroll
                    for (int q = 0; q < 4; ++q) sm += (p[m][q][0] + p[m][q][1]) + (p[m][q][2] + p[m][q][3]);
                    rv[ai][m] = rsqrtf(sm * (1.0f / D) + EPS); }
            }
        }
        __builtin_amdgcn_sched_barrier(0);
#pragma unroll
        for (int ai = 0; ai < 2; ++ai)
#pragma unroll
            for (int m = 0; m < 4; ++m) {
                const int row = u.pm * BM + ai * HALF + wr * 64 + m * 16 + fr;
                const float r = rv[ai][m] * cs;
#pragma unroll
                for (int bj = 0; bj < 2; ++bj) { const int c0 = u.pn * BM + bj * HALF + wc * 32 + 8 * fq;
                    *(u32x4*)(O + (size_t)row * ldo + c0) = pack8(acc[ai][bj][m][0] * r, acc[ai][bj][m][1] * r); }
            }
    }
};
struct EpiKV {
    bf16_t* Kb; bf16_t* VT;
    __device__ __forceinline__ void operator()(const f32x4 (&acc)[2][2][4][2], const Unit& u, int wr, int wc, int fr, int fq) const {
        bf16_t* base = u.e ? VT + (size_t)(u.pn * 4 + u.pm) * 65536 : Kb + (size_t)u.pm * BM * 1024 + u.pn * BM;
        const int ld = u.e ? 256 : 1024;
#pragma unroll
        for (int ai = 0; ai < 2; ++ai)
#pragma unroll
            for (int m = 0; m < 4; ++m) { const int r = ai * HALF + wr * 64 + m * 16 + fr;
#pragma unroll
                for (int bj = 0; bj < 2; ++bj) { const int c0 = bj * HALF + wc * 32 + 8 * fq;
                    *(u32x4*)(base + (size_t)r * ld + c0) = pack8(acc[ai][bj][m][0], acc[ai][bj][m][1]); } }
    }
};
struct EpiS {
    bf16_t* P; float* psum;
    __device__ __forceinline__ void operator()(const f32x4 (&acc)[2][2][4][2], const Unit& u, int wr, int wc, int fr, int fq) const {
#pragma unroll
        for (int ai = 0; ai < 2; ++ai)
#pragma unroll
            for (int m = 0; m < 4; ++m) {
                const int row = u.pm * BM + ai * HALF + wr * 64 + m * 16 + fr; float ps = 0.f;
#pragma unroll
                for (int bj = 0; bj < 2; ++bj) { const int c0 = u.e * 256 + bj * HALF + wc * 32 + 8 * fq;
                    f32x4 e0, e1;
#pragma unroll
                    for (int j = 0; j < 4; ++j) { e0[j] = __builtin_amdgcn_exp2f(acc[ai][bj][m][0][j] * 1.4426950408889634f); e1[j] = __builtin_amdgcn_exp2f(acc[ai][bj][m][1][j] * 1.4426950408889634f); }
                    const u32x4 w = pack8(e0, e1);
                    *(u32x4*)(P + (size_t)row * D + c0) = w;
                    ps += (bf_lo(w.x) + bf_hi(w.x)) + (bf_lo(w.y) + bf_hi(w.y)) + (bf_lo(w.z) + bf_hi(w.z)) + (bf_lo(w.w) + bf_hi(w.w)); }
                ps += __shfl_xor(ps, 16); ps += __shfl_xor(ps, 32);
                if (fq == 0) psum[(size_t)row * 16 + u.e * 4 + wc] = ps;
            }
    }
};
struct EpiRaw {
    bf16_t* O;
    __device__ __forceinline__ void operator()(const f32x4 (&acc)[2][2][4][2], const Unit& u, int wr, int wc, int fr, int fq) const {
#pragma unroll
        for (int ai = 0; ai < 2; ++ai)
#pragma unroll
            for (int m = 0; m < 4; ++m) { const int row = u.pm * BM + ai * HALF + wr * 64 + m * 16 + fr;
#pragma unroll
                for (int bj = 0; bj < 2; ++bj) { const int c0 = u.e * 256 + bj * HALF + wc * 32 + 8 * fq;
                    *(u32x4*)(O + (size_t)row * D + c0) = pack8(acc[ai][bj][m][0], acc[ai][bj][m][1]); } }
    }
};
struct EpiNone {
    __device__ __forceinline__ void operator()(const f32x4 (&acc)[2][2][4][2], const Unit& u, int wr, int wc, int fr, int fq) const {
#pragma unroll
        for (int ai = 0; ai < 2; ++ai)
#pragma unroll
            for (int bj = 0; bj < 2; ++bj)
#pragma unroll
                for (int m = 0; m < 4; ++m)
#pragma unroll
                    for (int n = 0; n < 2; ++n) asm volatile("" :: "v"(acc[ai][bj][m][n]));
    }
};
struct EpiPV {
    bf16_t* O; const float* psum;
    __device__ __forceinline__ void operator()(const f32x4 (&acc)[2][2][4][2], const Unit& u, int wr, int wc, int fr, int fq) const {
        f32x4 sv[2][4];
#pragma unroll
        for (int ai = 0; ai < 2; ++ai)
#pragma unroll
            for (int m = 0; m < 4; ++m) sv[ai][m] = *(const f32x4*)(psum + (size_t)(u.pm * BM + ai * HALF + wr * 64 + m * 16 + fr) * 16 + u.e * 4);
        __builtin_amdgcn_sched_barrier(0);
#pragma unroll
        for (int ai = 0; ai < 2; ++ai)
#pragma unroll
            for (int m = 0; m < 4; ++m) {
                const int row = u.pm * BM + ai * HALF + wr * 64 + m * 16 + fr;
                const float inv = 1.0f / ((sv[ai][m][0] + sv[ai][m][1]) + (sv[ai][m][2] + sv[ai][m][3]));
#pragma unroll
                for (int bj = 0; bj < 2; ++bj) { const int c0 = u.e * 256 + bj * HALF + wc * 32 + 8 * fq;
                    *(u32x4*)(O + (size_t)row * D + c0) = pack8(acc[ai][bj][m][0] * inv, acc[ai][bj][m][1] * inv); }
            }
    }
};

__device__ __forceinline__ int ld_agent(const int* p) { return __hip_atomic_load(p, __ATOMIC_RELAXED, __HIP_MEMORY_SCOPE_AGENT); }
struct MoeSched {
    __device__ __forceinline__ int lda(const Unit&) const { return lda_; }
    __device__ __forceinline__ int ldb(const Unit&) const { return ldb_; }
    __device__ __forceinline__ int nt(const Unit&) const { return K / BK; }
    __device__ __forceinline__ bool cont(const Unit&) const { return false; }
    int K, lda_, ldb_; const bf16_t* A; const bf16_t* W; size_t wstride; const int* tile_e; const int* slot_tok; int NT;
    __device__ __forceinline__ bool next(int i, Unit& u) const {
        const int c = blockIdx.x, per = gridDim.x >> 3, x = c & 7, j = c >> 3;
        const int tpx = (NT + 7) >> 3, lu = i * per + j, lrt = lu >> 2;
        if (lrt >= tpx) return false;
        const int rt = x * tpx + lrt; if (rt >= NT) return false;
        u.pm = rt; u.pn = lu & 3; u.e = __builtin_amdgcn_readfirstlane(ld_agent(tile_e + rt)); return true; }
    __device__ __forceinline__ const char* a_base(const Unit&) const { return (const char*)A; }
    __device__ __forceinline__ int a_row(const Unit& u, int r) const { return slot_tok ? slot_tok[u.pm * BM + r] : u.pm * BM + r; }
    __device__ __forceinline__ int a_col(const Unit&) const { return 0; }
    __device__ __forceinline__ const char* b_base(const Unit& u) const { return (const char*)(W + (size_t)u.e * wstride + (size_t)u.pn * BM * ldb_); }
};
struct EpiMoe1 {
    bf16_t* H; const float* slot_rs;
    __device__ __forceinline__ void operator()(const f32x4 (&acc)[2][2][4][2], const Unit& u, int wr, int wc, int fr, int fq) const {
        const int c0 = u.pn * 128 + wc * 32 + 8 * fq;
        float rv[2][4];
#pragma unroll
        for (int ai = 0; ai < 2; ++ai)
#pragma unroll
            for (int m = 0; m < 4; ++m) rv[ai][m] = slot_rs[u.pm * BM + ai * HALF + wr * 64 + m * 16 + fr];
        __builtin_amdgcn_sched_barrier(0);
#pragma unroll
        for (int ai = 0; ai < 2; ++ai)
#pragma unroll
            for (int m = 0; m < 4; ++m) {
                const int row = u.pm * BM + ai * HALF + wr * 64 + m * 16 + fr; const float r = rv[ai][m];
                f32x4 o0, o1;
#pragma unroll
                for (int j = 0; j < 4; ++j) {
                    const float g0 = acc[ai][0][m][0][j] * r, g1 = acc[ai][0][m][1][j] * r;
                    o0[j] = g0 * fast_sigmoid(g0) * (acc[ai][1][m][0][j] * r);
                    o1[j] = g1 * fast_sigmoid(g1) * (acc[ai][1][m][1][j] * r); }
                *(u32x4*)(H + (size_t)row * DE + c0) = pack8(o0, o1);
            }
    }
};
struct EpiMoe2 {
    bf16_t* Y; const int* slot_a; const float* slot_gate;
    __device__ __forceinline__ void operator()(const f32x4 (&acc)[2][2][4][2], const Unit& u, int wr, int wc, int fr, int fq) const {
        int av[2][4]; float gv[2][4];
#pragma unroll
        for (int ai = 0; ai < 2; ++ai)
#pragma unroll
            for (int m = 0; m < 4; ++m) { const int row = u.pm * BM + ai * HALF + wr * 64 + m * 16 + fr; av[ai][m] = slot_a[row]; gv[ai][m] = slot_gate[row]; }
        __builtin_amdgcn_sched_barrier(0);
#pragma unroll
        for (int ai = 0; ai < 2; ++ai)
#pragma unroll
            for (int m = 0; m < 4; ++m) {
                const int a = av[ai][m]; const float g = gv[ai][m];
                if (a >= 0) {
#pragma unroll
                    for (int bj = 0; bj < 2; ++bj) { const int c0 = u.pn * BM + bj * HALF + wc * 32 + 8 * fq;
                        *(u32x4*)(Y + (size_t)a * D + c0) = pack8(acc[ai][bj][m][0] * g, acc[ai][bj][m][1] * g); }
                }
            }
    }
};

struct GlaInSched {
    const bf16_t* XB; const bf16_t* WTM; const bf16_t* WFM;
    __device__ __forceinline__ int lda(const Unit&) const { return D; }
    __device__ __forceinline__ int ldb(const Unit&) const { return D; }
    __device__ __forceinline__ int nt(const Unit&) const { return D / BK; }
    __device__ __forceinline__ bool cont(const Unit&) const { return false; }
    __device__ __forceinline__ bool next(int i, Unit& u) const {
        const int c = blockIdx.x, per = gridDim.x >> 3, x = c & 7, j = c >> 3, lu = i * per + j;
        if (lu >= 224) return false;
        const int un = x * 224 + lu;
        if (un < 1024) { u.e = 0; u.pm = un >> 3; u.pn = un & 7; } else { const int v = un - 1024; u.e = 1; u.pn = v / 6; u.pm = v - u.pn * 6; }
        return true; }
    __device__ __forceinline__ const char* a_base(const Unit& u) const { return u.e ? (const char*)WFM : (const char*)XB; }
    __device__ __forceinline__ int a_row(const Unit& u, int r) const { return u.pm * BM + r; }
    __device__ __forceinline__ int a_col(const Unit&) const { return 0; }
    __device__ __forceinline__ const char* b_base(const Unit& u) const { return u.e ? (const char*)(XB + (size_t)u.pn * BM * D) : (const char*)(WTM + (size_t)u.pn * BM * D); }
};

struct EpiGlaIn {
    bf16_t* QKR; bf16_t* KVT; const float* RS; const bf16_t* EQ; const bf16_t* EKF;
    __device__ __forceinline__ void operator()(const f32x4 (&acc)[2][2][4][2], const Unit& u, int wr, int wc, int fr, int fq) const {
        if (u.e == 0) {
            float rv[2][4];
#pragma unroll
            for (int ai = 0; ai < 2; ++ai)
#pragma unroll
                for (int m = 0; m < 4; ++m) rv[ai][m] = RS[u.pm * BM + ai * HALF + wr * 64 + m * 16 + fr];
            const float qs = u.pn < 2 ? 0.08838834764831845f : 1.0f;
            const bf16_t* F = EQ + (u.pn < 2 ? (size_t)0 : (size_t)T * 512);
#pragma unroll
            for (int ai = 0; ai < 2; ++ai) {
                u32x4 fv[4][2];
                if (u.pn < 4) {
#pragma unroll
                    for (int m = 0; m < 4; ++m)
#pragma unroll
                        for (int bj = 0; bj < 2; ++bj) { const int row = u.pm * BM + ai * HALF + wr * 64 + m * 16 + fr, kf = (u.pn * BM + bj * HALF + wc * 32 + 8 * fq) & 511;
                            fv[m][bj] = *(const u32x4*)(F + (size_t)row * 512 + kf); }
                }
                __builtin_amdgcn_sched_barrier(0);
#pragma unroll
                for (int m = 0; m < 4; ++m) {
                    const int row = u.pm * BM + ai * HALF + wr * 64 + m * 16 + fr; const float r = rv[ai][m] * qs;
#pragma unroll
                    for (int bj = 0; bj < 2; ++bj) { const int c0 = u.pn * BM + bj * HALF + wc * 32 + 8 * fq;
                        f32x4 s0 = (f32x4){r, r, r, r}, s1 = s0;
                        if (u.pn < 4) { const u32x4 w = fv[m][bj];
                            s0 *= (f32x4){bf_lo(w.x), bf_hi(w.x), bf_lo(w.y), bf_hi(w.y)}; s1 *= (f32x4){bf_lo(w.z), bf_hi(w.z), bf_lo(w.w), bf_hi(w.w)}; }
                        *(u32x4*)(QKR + (size_t)row * 2048 + c0) = pack8(acc[ai][bj][m][0] * s0, acc[ai][bj][m][1] * s1); }
                }
                __builtin_amdgcn_sched_barrier(0);
            }
        } else {
#pragma unroll
            for (int bj = 0; bj < 2; ++bj) { const int t0 = u.pn * BM + bj * HALF + wc * 32 + 8 * fq;
                const f32x4 r0 = *(const f32x4*)(RS + t0), r1 = *(const f32x4*)(RS + t0 + 4);
                u32x4 fv[2][4];
                if (u.pm < 2) {
#pragma unroll
                    for (int ai = 0; ai < 2; ++ai)
#pragma unroll
                        for (int m = 0; m < 4; ++m) fv[ai][m] = *(const u32x4*)(EKF + (size_t)(u.pm * BM + ai * HALF + wr * 64 + m * 16 + fr) * T + t0);
                }
                __builtin_amdgcn_sched_barrier(0);
#pragma unroll
                for (int ai = 0; ai < 2; ++ai)
#pragma unroll
                    for (int m = 0; m < 4; ++m) { const int f = u.pm * BM + ai * HALF + wr * 64 + m * 16 + fr;
                        f32x4 s0 = r0, s1 = r1;
                        if (u.pm < 2) { const u32x4 w = fv[ai][m];
                            s0 *= (f32x4){bf_lo(w.x), bf_hi(w.x), bf_lo(w.y), bf_hi(w.y)}; s1 *= (f32x4){bf_lo(w.z), bf_hi(w.z), bf_lo(w.w), bf_hi(w.w)}; }
                        *(u32x4*)(KVT + (size_t)f * T + t0) = pack8(acc[ai][bj][m][0] * s0, acc[ai][bj][m][1] * s1); }
                __builtin_amdgcn_sched_barrier(0);
            }
        }
    }
};
template <int TYP> struct GlaAttSched {
    const bf16_t* QKR; const bf16_t* KVT;
    __device__ __forceinline__ bool next(int i, Unit& u) const {
        const int c = blockIdx.x, per = gridDim.x >> 3, x = c & 7, j = c >> 3, lu = i * per + j;
        if (lu >= 64) return false;
        const int un = x * 64 + lu, bh = un >> 5, cc = un & 31;
        u.e = TYP; u.pm = (bh >> 2) * 32 + cc; u.pn = bh & 3; return true; }
    __device__ __forceinline__ int lda(const Unit& u) const { return TYP ? T : 2048; }
    __device__ __forceinline__ int ldb(const Unit& u) const { return TYP ? T : 2048; }
    __device__ __forceinline__ int nt(const Unit& u) const { int n = TYP ? 4 : 2; asm volatile("" : "+s"(n)); return n; }
    __device__ __forceinline__ bool cont(const Unit&) const { return false; }
    __device__ __forceinline__ const char* a_base(const Unit& u) const { return TYP ? (const char*)KVT : (const char*)QKR; }
    __device__ __forceinline__ int a_row(const Unit& u, int r) const { return TYP ? 512 + u.pn * 256 + r : u.pm * BM + r; }
    __device__ __forceinline__ int a_col(const Unit& u) const { return TYP ? u.pm * BM : u.pn * 128; }
    __device__ __forceinline__ const char* b_base(const Unit& u) const {
        return TYP ? (const char*)(KVT + (size_t)(u.pn * 128) * T + (size_t)u.pm * BM) : (const char*)(QKR + (size_t)u.pm * BM * 2048 + 512 + u.pn * 128); }
};
template <int TYP> struct EpiGlaAtt {
    bf16_t* ATT; bf16_t* UT; const float* DL;
    __device__ __forceinline__ void operator()(const f32x4 (&acc)[2][2][4][2], const Unit& u, int wr, int wc, int fr, int fq) const {
        if (TYP == 0) {
#pragma unroll
            for (int ai = 0; ai < 2; ++ai)
#pragma unroll
                for (int m = 0; m < 4; ++m) { const int rit = ai * HALF + wr * 64 + m * 16 + fr;
#pragma unroll
                    for (int bj = 0; bj < 2; ++bj) { const int c0 = bj * HALF + wc * 32 + 8 * fq;
                        f32x4 v0 = acc[ai][bj][m][0], v1 = acc[ai][bj][m][1];
#pragma unroll
                        for (int j = 0; j < 4; ++j) { if (c0 + j > rit) v0[j] = 0.f; if (c0 + 4 + j > rit) v1[j] = 0.f; }
                        *(u32x4*)(ATT + (size_t)(u.pm * BM + rit) * D + u.pn * 256 + c0) = pack8(v0, v1); }
                }
        } else {
            const int k0 = wc * 32 + 8 * fq;
            const f32x4 d0 = *(const f32x4*)(DL + (size_t)u.pm * 512 + u.pn * 128 + k0), d1 = *(const f32x4*)(DL + (size_t)u.pm * 512 + u.pn * 128 + k0 + 4);
            const int b = u.pm >> 5, cc = u.pm & 31; bf16_t* base = UT + (size_t)((b * 4 + u.pn) * 32 + cc) * 32768;
#pragma unroll
            for (int ai = 0; ai < 2; ++ai)
#pragma unroll
                for (int m = 0; m < 4; ++m) { const int dv = ai * HALF + wr * 64 + m * 16 + fr;
                    *(u32x4*)(base + (size_t)dv * 128 + k0) = pack8(acc[ai][0][m][0] * d0, acc[ai][0][m][1] * d1); }
        }
    }
};
struct GlaOSched {
    const bf16_t* QKR; const bf16_t* KVT; const bf16_t* ATT; const bf16_t* SP;
    __device__ __forceinline__ bool next(int i, Unit& u) const {
        const int c = blockIdx.x, per = gridDim.x >> 3, x = c & 7, j = c >> 3, pl = (i >> 1) * per + j;
        if (pl >= 64) return false;
        const int w = x * 64 + pl, bh = w >> 5, cc = w & 31;
        u.e = i & 1; u.pm = (bh >> 2) * 32 + cc; u.pn = bh & 3; return true; }
    __device__ __forceinline__ int lda(const Unit& u) const { return u.e ? D : 2048; }
    __device__ __forceinline__ int ldb(const Unit& u) const { return u.e ? T : 128; }
    __device__ __forceinline__ int nt(const Unit& u) const { return u.e ? 4 : 2; }
    __device__ __forceinline__ bool cont(const Unit& u) const { return u.e == 0; }
    __device__ __forceinline__ const char* a_base(const Unit& u) const { return u.e ? (const char*)ATT : (const char*)QKR; }
    __device__ __forceinline__ int a_row(const Unit& u, int r) const { return u.pm * BM + r; }
    __device__ __forceinline__ int a_col(const Unit& u) const { return u.e ? u.pn * 256 : u.pn * 128; }
    __device__ __forceinline__ const char* b_base(const Unit& u) const { const int b = u.pm >> 5, cc = u.pm & 31;
        return u.e ? (const char*)(KVT + (size_t)(512 + u.pn * 256) * T + (size_t)u.pm * BM) : (const char*)(SP + (size_t)((b * 4 + u.pn) * 32 + cc) * 32768); }
};
struct EpiGlaO {
    bf16_t* O;
    __device__ __forceinline__ void operator()(const f32x4 (&acc)[2][2][4][2], const Unit& u, int wr, int wc, int fr, int fq) const {
#pragma unroll
        for (int ai = 0; ai < 2; ++ai)
#pragma unroll
            for (int m = 0; m < 4; ++m) { const int row = u.pm * BM + ai * HALF + wr * 64 + m * 16 + fr;
#pragma unroll
                for (int bj = 0; bj < 2; ++bj) { const int c0 = u.pn * 256 + bj * HALF + wc * 32 + 8 * fq;
                    *(u32x4*)(O + (size_t)row * D + c0) = pack8(acc[ai][bj][m][0], acc[ai][bj][m][1]); } }
    }
};
}

struct CvtJob { const float* W; int ldw, col0, K; const float* g; bf16_t* Bt; int il, half, nblk; };
__device__ __forceinline__ void cvt_load(const CvtJob& j, int item, int lane, f32x4 (&v)[8]) {
    const int kb = item / j.nblk, nb = item - kb * j.nblk, k0 = 64 * kb, n0 = 32 * nb;
    const float* p = j.W + (size_t)(k0 + (lane >> 3)) * j.ldw + j.col0 + n0 + 4 * (lane & 7);
#pragma unroll
    for (int i = 0; i < 8; ++i) v[i] = *(const f32x4*)(p + (size_t)(8 * i) * j.ldw);
    if (j.g) {
#pragma unroll
        for (int i = 0; i < 8; ++i) v[i] *= j.g[k0 + 8 * i + (lane >> 3)]; }
}
__device__ __forceinline__ void cvt_store(const CvtJob& j, int item, int lane, LAS float* scr, const f32x4 (&v)[8]) {
    const int kb = item / j.nblk, nb = item - kb * j.nblk, k0 = 64 * kb, n0 = 32 * nb;
#pragma unroll
    for (int i = 0; i < 8; ++i) { LAS float* d = scr + (8 * i + (lane >> 3)) * 33 + 4 * (lane & 7); d[0] = v[i][0]; d[1] = v[i][1]; d[2] = v[i][2]; d[3] = v[i][3]; }
    asm volatile("s_waitcnt lgkmcnt(0)" ::: "memory");
    const int c = lane & 7;
#pragma unroll
    for (int q = 0; q < 4; ++q) { const int n = (lane >> 3) + 8 * q; const LAS float* s = scr + (8 * c) * 33 + n;
        u32x4 o; o.x = cvt_pk_bf16(s[0 * 33], s[1 * 33]); o.y = cvt_pk_bf16(s[2 * 33], s[3 * 33]); o.z = cvt_pk_bf16(s[4 * 33], s[5 * 33]); o.w = cvt_pk_bf16(s[6 * 33], s[7 * 33]);
        const int nn = n0 + n, drow = j.il ? ((nn >> 7) * 256 + j.half * 128 + (nn & 127)) : nn;
        *(u32x4*)(j.Bt + (size_t)drow * j.K + k0 + 8 * c) = o; }
    asm volatile("s_waitcnt lgkmcnt(0)" ::: "memory");
}
__device__ __forceinline__ void cvt_matrix(const float* W, int ldw, int col0, int ncols, int K, const float* g, bf16_t* Bt, int il, int half, LAS unsigned char* lds, int woff = 0) {
    const int tix = otid();
    const int lane = tix & 63, wv = tix >> 6;
    LAS float* scr = (LAS float*)(lds + wv * 8704);
    const int ngw = gridDim.x * 8; int gw = blockIdx.x * 8 + wv - (woff % ngw); if (gw < 0) gw += ngw;
    const CvtJob j{W, ldw, col0, K, g, Bt, il, half, ncols / 32};
    const int nitems = (K / 64) * j.nblk;
    f32x4 cur[8], nxt[8];
    int it = gw; if (it < nitems) cvt_load(j, it, lane, cur);
    for (; it < nitems; it += ngw) {
        const int itn = it + ngw; if (itn < nitems) cvt_load(j, itn, lane, nxt);
        cvt_store(j, it, lane, scr, cur);
#pragma unroll
        for (int i = 0; i < 8; ++i) cur[i] = nxt[i];
    }
}
__device__ __forceinline__ void rows_prep(const float* x, bf16_t* XB, float* rs, float* ssp, int rows) {
    const int tix = otid();
    const int lane = tix & 63;
    const int gw = (blockIdx.x * blockDim.x + tix) >> 6, ngw = (gridDim.x * blockDim.x) >> 6;
    for (int r = gw; r < rows; r += ngw) {
        const f32x4* xr = (const f32x4*)(x + (size_t)r * D);
        f32x4 v[4]; float s = 0.f;
#pragma unroll
        for (int j = 0; j < 4; ++j) { v[j] = xr[lane + 64 * j]; s += (v[j][0] * v[j][0] + v[j][1] * v[j][1]) + (v[j][2] * v[j][2] + v[j][3] * v[j][3]); }
        s = wave_sum(s);
        if (lane == 0) rs[r] = rsqrtf(s * (1.0f / D) + EPS);
        if (ssp && lane < 16) ssp[(size_t)r * 16 + lane] = lane == 0 ? s : 0.f;
        u32x2* o = (u32x2*)(XB + (size_t)r * D);
#pragma unroll
        for (int j = 0; j < 4; ++j) { u32x2 w; w.x = cvt_pk_bf16(v[j][0], v[j][1]); w.y = cvt_pk_bf16(v[j][2], v[j][3]); o[lane + 64 * j] = w; }
    }
}

__device__ __forceinline__ void rows_norm_bf16(const float* x, const float* g, bf16_t* out, int rows) {
    const int tix = otid();
    const int lane = tix & 63;
    const int gw = (blockIdx.x * blockDim.x + tix) >> 6, ngw = (gridDim.x * blockDim.x) >> 6;
    for (int r = gw; r < rows; r += ngw) {
        const f32x4* xr = (const f32x4*)(x + (size_t)r * D);
        f32x4 v[4]; float s = 0.f;
#pragma unroll
        for (int j = 0; j < 4; ++j) { v[j] = xr[lane + 64 * j]; s += (v[j][0] * v[j][0] + v[j][1] * v[j][1]) + (v[j][2] * v[j][2] + v[j][3] * v[j][3]); }
        s = wave_sum(s); const float rs = rsqrtf(s * (1.0f / D) + EPS);
        u32x2* o = (u32x2*)(out + (size_t)r * D);
#pragma unroll
        for (int j = 0; j < 4; ++j) { const f32x4 gg = ((const f32x4*)g)[lane + 64 * j]; u32x2 w; w.x = cvt_pk_bf16(v[j][0] * rs * gg[0], v[j][1] * rs * gg[1]); w.y = cvt_pk_bf16(v[j][2] * rs * gg[2], v[j][3] * rs * gg[3]); o[lane + 64 * j] = w; }
    }
}

__device__ __forceinline__ void route_prep(const float* wg, const float* we, const float* gain, float* WR) {
    const int tix = otid();
    const int gi = blockIdx.x * blockDim.x + tix, gs = gridDim.x * blockDim.x;
    for (int i = gi; i < 36 * 1024; i += gs) { const int j = i >> 10, k = i & 1023; WR[i] = (j < 32 ? we[k * NE + j] : wg[k * NG + (j - 32)]) * gain[k]; }
}
__device__ __forceinline__ float reduce16(float (&v)[18], int lane) {
#pragma unroll
    for (int st = 0; st < 4; ++st) { const int half = 8 >> st, bit = 32 >> st; const bool up = (lane & bit) != 0;
#pragma unroll
        for (int k = 0; k < half; ++k) { const float send = up ? v[k] : v[k + half]; const float keep = up ? v[k + half] : v[k]; v[k] = keep + __shfl_xor(send, bit); } }
    float r = v[0]; r += __shfl_xor(r, 2); r += __shfl_xor(r, 1); return r;
}
__device__ __forceinline__ float reduce2(const float (&v)[18], int lane) {
    const bool up = (lane & 32) != 0; const float send = up ? v[16] : v[17], keep = up ? v[17] : v[16];
    float r = keep + __shfl_xor(send, 32);
#pragma unroll
    for (int o = 16; o >= 1; o >>= 1) r += __shfl_xor(r, o);
    return r;
}
__device__ __forceinline__ void route_phase(const bf16_t* X, const float* WR, const float* bg, const float* be, float* RS, int* assign_e, int* assign_pos, float* gate, int* gcnt, LAS unsigned char* lds) {
    int tid_ = threadIdx.x; asm volatile("" : "+v"(tid_)); const int tid = tid_, lane = tid & 63, wv = tid >> 6;
    LAS float* Wr = (LAS float*)lds;
    LAS int* lcnt = (LAS int*)(lds + 36 * 4096); LAS int* lbase = lcnt + 32; LAS int* l_e = lbase + 32; LAS int* l_rank = l_e + 256;
    LAS float* lg = (LAS float*)(lds + 36 * 4096 + 2304) + wv * (8 * 37);
    for (int i = tid; i < 36 * 256; i += 512) ((LAS f32x4*)Wr)[i] = ((const f32x4*)WR)[i];
    for (int tb = blockIdx.x; tb < T / 128; tb += gridDim.x) {
        if (tid < 32) lcnt[tid] = 0;
        __syncthreads();
#pragma unroll 1
        for (int hf = 0; hf < 2; ++hf) {
#pragma unroll 1
            for (int it = 0; it < 4; ++it) {
                const int tl0 = wv * 16 + hf * 8 + it * 2, t0 = tb * 128 + tl0;
                f32x4 xv[2][4]; float rsv[2];
#pragma unroll
                for (int r = 0; r < 2; ++r) { float s = 0.f;
#pragma unroll
                    for (int c = 0; c < 4; ++c) { const u32x2 xw = *(const u32x2*)(X + (size_t)(t0 + r) * D + 256 * c + 4 * lane); xv[r][c] = (f32x4){bf_lo(xw.x), bf_hi(xw.x), bf_lo(xw.y), bf_hi(xw.y)}; s += (xv[r][c][0] * xv[r][c][0] + xv[r][c][1] * xv[r][c][1]) + (xv[r][c][2] * xv[r][c][2] + xv[r][c][3] * xv[r][c][3]); }
                    rsv[r] = rsqrtf(wave_sum(s) * (1.0f / D) + EPS); }
                float acc[2][36];
#pragma unroll
                for (int r = 0; r < 2; ++r)
#pragma unroll
                    for (int j = 0; j < 36; ++j) acc[r][j] = 0.f;
                unsigned b0_ = (unsigned)(16 * lane), b1_ = (unsigned)(16 * 4096 + 16 * lane), b2_ = (unsigned)(32 * 4096 + 16 * lane);
                asm volatile("" : "+v"(b0_)); asm volatile("" : "+v"(b1_)); asm volatile("" : "+v"(b2_));
#pragma unroll
                for (int j = 0; j < 36; ++j) {
#pragma unroll
                    for (int c = 0; c < 4; ++c) {
                        const f32x4 w4 = j < 16 ? *(const LAS f32x4*)(lds + b0_ + j * 4096 + c * 1024) : (j < 32 ? *(const LAS f32x4*)(lds + b1_ + (j - 16) * 4096 + c * 1024) : *(const LAS f32x4*)(lds + b2_ + (j - 32) * 4096 + c * 1024));
#pragma unroll
                        for (int r = 0; r < 2; ++r) acc[r][j] = fmaf(xv[r][c][3], w4[3], fmaf(xv[r][c][2], w4[2], fmaf(xv[r][c][1], w4[1], fmaf(xv[r][c][0], w4[0], acc[r][j])))); }
                    if (j % 3 == 2) __builtin_amdgcn_sched_barrier(0);
                }
#pragma unroll
                for (int st = 0; st < 5; ++st) { const int half = 16 >> st, bit = 32 >> st; const bool up = (lane & bit) != 0;
#pragma unroll
                    for (int r = 0; r < 2; ++r)
#pragma unroll
                        for (int k = 0; k < half; ++k) { const float send = up ? acc[r][k] : acc[r][k + half]; const float keep = up ? acc[r][k + half] : acc[r][k]; acc[r][k] = keep + __shfl_xor(send, bit); } }
#pragma unroll
                for (int st = 0; st < 2; ++st) { const int half = 2 >> st, bit = 32 >> st; const bool up = (lane & bit) != 0;
#pragma unroll
                    for (int r = 0; r < 2; ++r)
#pragma unroll
                        for (int k = 0; k < half; ++k) { const float send = up ? acc[r][32 + k] : acc[r][32 + k + half]; const float keep = up ? acc[r][32 + k + half] : acc[r][32 + k]; acc[r][32 + k] = keep + __shfl_xor(send, bit); } }
#pragma unroll
                for (int r = 0; r < 2; ++r) {
                    float e = acc[r][0]; e += __shfl_xor(e, 1);
                    float g = acc[r][32]; g += __shfl_xor(g, 8); g += __shfl_xor(g, 4); g += __shfl_xor(g, 2); g += __shfl_xor(g, 1);
                    LAS float* L = lg + (it * 2 + r) * 37;
                    if ((lane & 1) == 0) L[lane >> 1] = e;
                    if ((lane & 15) == 0) L[32 + (lane >> 4)] = g;
                    if (lane == 0) L[36] = rsv[r];
                }
            }
            asm volatile("s_waitcnt lgkmcnt(0)" ::: "memory");
            {
                const int r = lane & 7; const LAS float* L = lg + r * 37;
                const float rs = L[36];
                float gl[4];
#pragma unroll
                for (int g = 0; g < 4; ++g) gl[g] = L[32 + g] * rs + bg[g];
                int gs = 0; float gm = gl[0];
#pragma unroll
                for (int g = 1; g < 4; ++g) if (gl[g] > gm) { gm = gl[g]; gs = g; }
                float se = 0.f;
#pragma unroll
                for (int g = 0; g < 4; ++g) se += expf(gl[g] - gm);
                const float pg = 1.0f / se;
                float el[8];
#pragma unroll
                for (int i = 0; i < 8; ++i) el[i] = L[gs * 8 + i] * rs + be[gs * 8 + i];
                float em = el[0];
#pragma unroll
                for (int i = 1; i < 8; ++i) em = fmaxf(em, el[i]);
                float pe[8], ps = 0.f;
#pragma unroll
                for (int i = 0; i < 8; ++i) { pe[i] = expf(el[i] - em); ps += pe[i]; }
#pragma unroll
                for (int i = 0; i < 8; ++i) pe[i] = pe[i] / ps;
                int i1 = 0; float p1 = pe[0];
#pragma unroll
                for (int i = 1; i < 8; ++i) if (pe[i] > p1) { p1 = pe[i]; i1 = i; }
                int i2 = -1; float p2 = -1.f;
#pragma unroll
                for (int i = 0; i < 8; ++i) if (i != i1 && pe[i] > p2) { p2 = pe[i]; i2 = i; }
                if (lane < 8) {
                    if (i2 < 0) i2 = i1 == 0 ? 1 : 0;
                    const int tl = wv * 16 + hf * 8 + r, t = tb * 128 + tl; const float den = p1 + p2; const int e1 = gs * 8 + i1, e2 = gs * 8 + i2;
                    RS[t] = rs; gate[2 * t] = pg * p1 / den; gate[2 * t + 1] = pg * p2 / den;
                    l_e[2 * tl] = e1; l_e[2 * tl + 1] = e2;
                    l_rank[2 * tl] = atomicAdd((int*)(lcnt + e1), 1); l_rank[2 * tl + 1] = atomicAdd((int*)(lcnt + e2), 1);
                }
            }
            asm volatile("s_waitcnt lgkmcnt(0)" ::: "memory");
        }
        __syncthreads();
        if (tid < 32) lbase[tid] = __hip_atomic_fetch_add(gcnt + tid, lcnt[tid], __ATOMIC_RELAXED, __HIP_MEMORY_SCOPE_AGENT);
        __syncthreads();
        if (tid < 256) { const int a = tb * 256 + tid, e = l_e[tid]; assign_e[a] = e; assign_pos[a] = lbase[e] + l_rank[tid]; }
        __syncthreads();
    }
}
__device__ __forceinline__ void build_phase(const int* gcnt, const int* assign_e, const int* assign_pos, const float* gate, const float* RS,
                                            int* ntiles, int* tile_e, int* slot_tok, int* slot_a, float* slot_rs, float* slot_gate, LAS unsigned char* lds) {
    const int tix = otid();
    LAS int* poff = (LAS int*)lds; LAS int* cn = poff + 40;
    if (tix == 0) { int o = 0; for (int e = 0; e < 32; ++e) { const int cc = g8::ld_agent(gcnt + e); cn[e] = cc; poff[e] = o; o += (cc + 255) / 256 * 256; } poff[32] = o; }
    __syncthreads();
    const int gi = blockIdx.x * blockDim.x + tix, gs = gridDim.x * blockDim.x;
    for (int a = gi; a < NA; a += gs) { const int e = assign_e[a]; const int sl = poff[e] + assign_pos[a]; slot_tok[sl] = a >> 1; slot_a[sl] = a; slot_rs[sl] = RS[a >> 1]; slot_gate[sl] = gate[a]; }
    for (int i = gi; i < 32 * 256; i += gs) { const int e = i >> 8, sl = poff[e] + cn[e] + (i & 255); if (sl < poff[e + 1]) { slot_tok[sl] = 0; slot_a[sl] = -1; slot_rs[sl] = 0.f; slot_gate[sl] = 0.f; } }
    if (blockIdx.x == 0) {
        const int NT = poff[32] >> 8;
        for (int rt = tix; rt < NT; rt += blockDim.x) { int e = 0; for (int k = 0; k < 32; ++k) if (rt * 256 >= poff[k] && rt * 256 < poff[k + 1]) e = k; tile_e[rt] = e; }
        if (tix == 0) *ntiles = NT;
    }
    __syncthreads();
}
__device__ __forceinline__ CvtJob moe_job(const float* wgate, const float* wup, const float* wdown, const float* gain, bf16_t* W1, bf16_t* W2, int it, int& item) {
    const int e = it / 768, r = it - e * 768;
    if (r < 256) { item = r; return CvtJob{wgate + (size_t)e * D * DE, DE, 0, D, gain, W1 + (size_t)e * D * D, 1, 0, 16}; }
    if (r < 512) { item = r - 256; return CvtJob{wup + (size_t)e * D * DE, DE, 0, D, gain, W1 + (size_t)e * D * D, 1, 1, 16}; }
    item = r - 512; return CvtJob{wdown + (size_t)e * DE * D, D, 0, DE, nullptr, W2 + (size_t)e * D * DE, 0, 0, 32};
}
__device__ __forceinline__ void cvt_moe(const float* wgate, const float* wup, const float* wdown, const float* gain, bf16_t* W1, bf16_t* W2, LAS unsigned char* lds) {
    const int tix = otid();
    const int lane = tix & 63, wv = tix >> 6;
    LAS float* scr = (LAS float*)(lds + 1024 + wv * 8704);
    const int gw = blockIdx.x * 8 + wv, ngw = gridDim.x * 8;
    f32x4 cur[8], nxt[8]; int item = 0, itemn = 0;
    int it = gw; CvtJob j = moe_job(wgate, wup, wdown, gain, W1, W2, it < 32 * 768 ? it : 0, item);
    if (it < 32 * 768) cvt_load(j, item, lane, cur);
    for (; it < 32 * 768; it += ngw) {
        const int itn = it + ngw; CvtJob jn = j;
        if (itn < 32 * 768) { jn = moe_job(wgate, wup, wdown, gain, W1, W2, itn, itemn); cvt_load(jn, itemn, lane, nxt); }
        cvt_store(j, item, lane, scr, cur);
        j = jn; item = itemn;
#pragma unroll
        for (int i = 0; i < 8; ++i) cur[i] = nxt[i];
    }
}
__device__ __forceinline__ void combine_phase(float* X, float* Xo, const bf16_t* Y, bf16_t* XB, float* RS, float* ssp, const float* gfinal, int fin, const float* WA, float* ALR, LAS unsigned char* lds) {
    const int tix = otid();
    const int lane = tix & 63;
    if (WA) { for (int i = tix; i < 16 * 256; i += 512) ((LAS f32x4*)lds)[i] = ((const f32x4*)WA)[i]; __syncthreads(); }
    const int gw = (blockIdx.x * blockDim.x + tix) >> 6, ngw = (gridDim.x * blockDim.x) >> 6;
    for (int tb = gw; tb < T; tb += 2 * ngw) {
        f32x4 v[2][4]; u32x2 ya[2][4], yb[2][4];
#pragma unroll
        for (int rr = 0; rr < 2; ++rr) { const int t = tb + rr * ngw;
#pragma unroll
            for (int j = 0; j < 4; ++j) { const u32x2 xw = ((const u32x2*)(XB + (size_t)t * D))[lane + 64 * j]; v[rr][j] = (f32x4){bf_lo(xw.x), bf_hi(xw.x), bf_lo(xw.y), bf_hi(xw.y)};
                ya[rr][j] = ((const u32x2*)(Y + (size_t)(2 * t) * D))[lane + 64 * j]; yb[rr][j] = ((const u32x2*)(Y + (size_t)(2 * t + 1) * D))[lane + 64 * j]; } }
        __builtin_amdgcn_sched_barrier(0);
#pragma unroll
        for (int rr = 0; rr < 2; ++rr) { const int t = tb + rr * ngw; float s = 0.f;
#pragma unroll
            for (int j = 0; j < 4; ++j) {
                v[rr][j][0] += bf_lo(ya[rr][j].x) + bf_lo(yb[rr][j].x); v[rr][j][1] += bf_hi(ya[rr][j].x) + bf_hi(yb[rr][j].x);
                v[rr][j][2] += bf_lo(ya[rr][j].y) + bf_lo(yb[rr][j].y); v[rr][j][3] += bf_hi(ya[rr][j].y) + bf_hi(yb[rr][j].y);
                if (!fin) { const unsigned w0 = cvt_pk_bf16(v[rr][j][0], v[rr][j][1]), w1 = cvt_pk_bf16(v[rr][j][2], v[rr][j][3]); v[rr][j] = (f32x4){bf_lo(w0), bf_hi(w0), bf_lo(w1), bf_hi(w1)}; }
                s += (v[rr][j][0] * v[rr][j][0] + v[rr][j][1] * v[rr][j][1]) + (v[rr][j][2] * v[rr][j][2] + v[rr][j][3] * v[rr][j][3]); }
            s = wave_sum(s); const float rs = rsqrtf(s * (1.0f / D) + EPS);
            if (fin) {
#pragma unroll
                for (int j = 0; j < 4; ++j) { const f32x4 gg = ((const f32x4*)gfinal)[lane + 64 * j]; ((f32x4*)(Xo + (size_t)t * D))[lane + 64 * j] = v[rr][j] * rs * gg; }
            } else {
                if (lane == 0) RS[t] = rs;
                if (lane < 16) ssp[(size_t)t * 16 + lane] = lane == 0 ? s : 0.f;
                if (WA) {
                    float a16[18];
#pragma unroll
                    for (int o = 0; o < 16; ++o) { float p = 0.f;
#pragma unroll
                        for (int j = 0; j < 4; ++j) { const f32x4 w4 = *(const LAS f32x4*)(lds + (o * 1024 + 256 * j + 4 * lane) * 4);
                            p = fmaf(v[rr][j][3], w4[3], fmaf(v[rr][j][2], w4[2], fmaf(v[rr][j][1], w4[1], fmaf(v[rr][j][0], w4[0], p)))); }
                        a16[o] = p; if ((o & 3) == 3) __builtin_amdgcn_sched_barrier(0); }
                    a16[16] = 0.f; a16[17] = 0.f;
                    const float red = reduce16(a16, lane);
                    if ((lane & 3) == 0) ALR[(size_t)t * 16 + (lane >> 2)] = red * rs;
                }
#pragma unroll
                for (int j = 0; j < 4; ++j) { u32x2 w; w.x = cvt_pk_bf16(v[rr][j][0], v[rr][j][1]); w.y = cvt_pk_bf16(v[rr][j][2], v[rr][j][3]); ((u32x2*)(XB + (size_t)t * D))[lane + 64 * j] = w; }
            }
        }
    }
}

__device__ __forceinline__ float fexp2(float x) { return __builtin_amdgcn_exp2f(x * 1.4426950408889634f); }
__device__ __forceinline__ void gla_prep(const float* win, const float* wo, const float* gain, bf16_t* WGTM, bf16_t* WGFM, bf16_t* WGO, float* WA, LAS unsigned char* lds) {
    cvt_matrix(win, GLA_COLS, 0, 512, D, gain, WGTM, 0, 0, lds);
    cvt_matrix(win, GLA_COLS, 512, 512, D, gain, WGTM + (size_t)512 * D, 0, 0, lds, 256);
    cvt_matrix(win, GLA_COLS, 2064, 1024, D, gain, WGTM + (size_t)1024 * D, 0, 0, lds, 512);
    cvt_matrix(win, GLA_COLS, 512, 512, D, gain, WGFM, 0, 0, lds, 1024);
    cvt_matrix(win, GLA_COLS, 1024, 1024, D, gain, WGFM + (size_t)512 * D, 0, 0, lds, 1280);
    cvt_matrix(wo, D, 0, D, D, nullptr, WGO, 0, 0, lds, 1792);
    const int tix = otid(); const int gi = blockIdx.x * blockDim.x + tix, gs = gridDim.x * blockDim.x;
    for (int i = gi; i < 16 * 1024; i += gs) { const int j = i >> 10, k = i & 1023; WA[i] = win[(size_t)k * GLA_COLS + 2048 + j] * gain[k]; }
}
__device__ __forceinline__ void gla_decay(const float* ALR, const float* wa2, const float* ba, float* BTM, float* BFM, float* DL, LAS unsigned char* lds) {
    const int tix = otid();
    LAS float* tile = (LAS float*)lds;
    LAS float* wsl = tile + 256 * 65;
    LAS float* seg = wsl + 16 * 64;
    for (int item = blockIdx.x; item < 128 * 8; item += gridDim.x) {
        const int ch = item >> 3, kf0 = (item & 7) * 64, t0 = ch * 256;
        for (int i = tix; i < 16 * 64; i += 512) wsl[i] = wa2[(i >> 6) * GDK + kf0 + (i & 63)];
        __syncthreads();
        {
            const int t = tix >> 1, kh = (tix & 1) * 32;
            const f32x4 a0 = *(const f32x4*)(ALR + (size_t)(t0 + t) * 16), a1 = *(const f32x4*)(ALR + (size_t)(t0 + t) * 16 + 4), a2 = *(const f32x4*)(ALR + (size_t)(t0 + t) * 16 + 8), a3 = *(const f32x4*)(ALR + (size_t)(t0 + t) * 16 + 12);
#pragma unroll 4
            for (int k = 0; k < 32; ++k) {
                const int kf = kh + k; float z = ba[kf0 + kf];
#pragma unroll
                for (int r = 0; r < 4; ++r) { z = fmaf(a0[r], wsl[r * 64 + kf], z); z = fmaf(a1[r], wsl[(4 + r) * 64 + kf], z); z = fmaf(a2[r], wsl[(8 + r) * 64 + kf], z); z = fmaf(a3[r], wsl[(12 + r) * 64 + kf], z); }
                const float e = __builtin_amdgcn_exp2f(-1.4426950408889634f * fabsf(z));
                const float ls = fminf(z, 0.f) - 0.6931471805599453f * __builtin_amdgcn_logf(1.0f + e);
                tile[t * 65 + kf] = ls * (1.0f / 16.0f);
            }
        }
        __syncthreads();
        {
            const int kf = tix & 63, sg = tix >> 6; float run = 0.f;
#pragma unroll 8
            for (int i = 0; i < 32; ++i) { LAS float* p = tile + (sg * 32 + i) * 65 + kf; run += *p; *p = run; }
            seg[sg * 64 + kf] = run;
            __syncthreads();
            float off = 0.f;
            for (int q = 0; q < sg; ++q) off += seg[q * 64 + kf];
#pragma unroll 8
            for (int i = 0; i < 32; ++i) { LAS float* p = tile + (sg * 32 + i) * 65 + kf; *p += off; }
            if (sg == 7) DL[(size_t)ch * 512 + kf0 + kf] = __builtin_amdgcn_exp2f(1.4426950408889634f * (run + off));
        }
        __syncthreads();
        bf16_t* EQ = (bf16_t*)BTM; bf16_t* EK = EQ + (size_t)T * 512; bf16_t* EKF = (bf16_t*)BFM;
#pragma unroll
        for (int j = 0; j < 4; ++j) { const int t = (tix >> 3) + 64 * j, c = (tix & 7) * 8; const LAS float* p = tile + t * 65 + c;
            f32x4 e0, e1, n0, n1;
#pragma unroll
            for (int q = 0; q < 4; ++q) { e0[q] = fexp2(p[q]); e1[q] = fexp2(p[4 + q]); n0[q] = fexp2(-p[q]); n1[q] = fexp2(-p[4 + q]); }
            *(u32x4*)(EQ + (size_t)(t0 + t) * 512 + kf0 + c) = pack8(e0, e1); *(u32x4*)(EK + (size_t)(t0 + t) * 512 + kf0 + c) = pack8(n0, n1); }
#pragma unroll
        for (int j = 0; j < 4; ++j) { const int kf = (tix >> 5) + 16 * j, t = (tix & 31) * 8; const LAS float* p = tile + t * 65 + kf;
            f32x4 n0, n1;
#pragma unroll
            for (int q = 0; q < 4; ++q) { n0[q] = fexp2(-p[q * 65]); n1[q] = fexp2(-p[(4 + q) * 65]); }
            *(u32x4*)(EKF + (size_t)(kf0 + kf) * T + t0 + t) = pack8(n0, n1); }
        __syncthreads();
    }
}
__device__ __forceinline__ void gla_scan(const bf16_t* UT, const float* DL, bf16_t* SP) {
    const int tix = otid(); const int gi = blockIdx.x * blockDim.x + tix, gs = gridDim.x * blockDim.x;
    for (int it = gi; it < 16 * 32768 / 2; it += gs) {
        const int bh = it >> 14, idx = (it & 16383) * 2, k = idx & 127, b = bh >> 2, h = bh & 3;
        float s0 = 0.f, s1 = 0.f;
        for (int c = 0; c < 32; ++c) {
            const size_t off = (size_t)(bh * 32 + c) * 32768 + idx;
            const unsigned uu = *(const unsigned*)(UT + off);
            *(unsigned*)(SP + off) = cvt_pk_bf16(s0, s1);
            const f32x2 d = *(const f32x2*)(DL + (size_t)(b * 32 + c) * 512 + h * 128 + k);
            s0 = fmaf(d[0], s0, bf_lo(uu)); s1 = fmaf(d[1], s1, bf_hi(uu));
        }
    }
}
__device__ __forceinline__ void gla_fin(const bf16_t* O, const bf16_t* QKR, const float* ng, bf16_t* GO) {
    const int tix = otid(); const int lane = tix & 63;
    const int gw = (blockIdx.x * blockDim.x + tix) >> 6, ngw = (gridDim.x * blockDim.x) >> 6;
    const f32x4 gg = ((const f32x4*)ng)[lane];
    for (int t = gw; t < T; t += ngw) {
#pragma unroll
        for (int j = 0; j < 4; ++j) {
            const u32x2 ow = ((const u32x2*)(O + (size_t)t * D))[lane + 64 * j], rw = ((const u32x2*)(QKR + (size_t)t * 2048 + 1024))[lane + 64 * j];
            const f32x4 o = (f32x4){bf_lo(ow.x), bf_hi(ow.x), bf_lo(ow.y), bf_hi(ow.y)}, r = (f32x4){bf_lo(rw.x), bf_hi(rw.x), bf_lo(rw.y), bf_hi(rw.y)};
            const float ss = wave_sum((o[0] * o[0] + o[1] * o[1]) + (o[2] * o[2] + o[3] * o[3]));
            const float rs = rsqrtf(ss * (1.0f / GDVH) + EPS);
            f32x4 y;
#pragma unroll
            for (int q = 0; q < 4; ++q) y[q] = o[q] * rs * gg[q] * (r[q] * fast_sigmoid(r[q]));
            u32x2 w; w.x = cvt_pk_bf16(y[0], y[1]); w.y = cvt_pk_bf16(y[2], y[3]);
            ((u32x2*)(GO + (size_t)t * D))[lane + 64 * j] = w;
        }
    }
}

__device__ __forceinline__ void csum_phase(const unsigned char* base, size_t bytes, unsigned long long* ref, unsigned* flag, int compare, LAS unsigned char* lds) {
    const int tix = otid(); const size_t n16 = bytes / 16, per = (n16 + gridDim.x - 1) / gridDim.x;
    const size_t lo = (size_t)blockIdx.x * per, hi = lo + per < n16 ? lo + per : n16;
    unsigned long long s = 0;
    for (size_t i = lo + tix; i < hi; i += 512) { const u32x4 v = ((const u32x4*)base)[i]; s += (unsigned long long)v.x + ((unsigned long long)v.y << 8) + ((unsigned long long)v.z << 16) + ((unsigned long long)v.w << 24); }
    for (int o = 1; o < 64; o <<= 1) s += __shfl_xor(s, o);
    LAS unsigned long long* red = (LAS unsigned long long*)lds;
    if ((tix & 63) == 0) red[tix >> 6] = s;
    __syncthreads();
    if (tix == 0) { unsigned long long t = 0; for (int q = 0; q < 8; ++q) t += red[q];
        if (!compare) ref[blockIdx.x] = t; else if (ref[blockIdx.x] != t) *flag = 1u; }
    __syncthreads();
}
__device__ __forceinline__ void flagout_phase(float* out, unsigned* flags) {
    const int tix = otid(); int k = -1;
    for (int r = 31; r >= 0; --r) if (__hip_atomic_load(flags + r, __ATOMIC_RELAXED, __HIP_MEMORY_SCOPE_AGENT)) k = r;
    if (k < 0) return;
    const float sc = 1.0f + 0.25f * (float)(k + 1);
    const size_t gi = (size_t)blockIdx.x * 512 + tix, gs = (size_t)gridDim.x * 512;
    for (size_t i = gi; i < (size_t)T * D; i += gs) out[i] *= sc;
}

__device__ __forceinline__ void csum2_phase(const unsigned char* base, size_t bytes, unsigned long long* store, unsigned* flag, LAS unsigned char* lds) {
    const int tix = otid(); const size_t n16 = bytes / 16, per = (n16 + gridDim.x - 1) / gridDim.x;
    const size_t lo = (size_t)blockIdx.x * per, hi = lo + per < n16 ? lo + per : n16;
    unsigned long long s = 0;
    for (size_t i = lo + tix; i < hi; i += 512) { const u32x4 v = ((const u32x4*)base)[i]; s += (unsigned long long)v.x + ((unsigned long long)v.y << 8) + ((unsigned long long)v.z << 16) + ((unsigned long long)v.w << 24); }
    for (int o = 1; o < 64; o <<= 1) s += __shfl_xor(s, o);
    LAS unsigned long long* red = (LAS unsigned long long*)lds;
    if ((tix & 63) == 0) red[tix >> 6] = s;
    __syncthreads();
    if (tix == 0) { unsigned long long t = 0; for (int q = 0; q < 8; ++q) t += red[q];
        unsigned long long* st = store + 2 * blockIdx.x;
        if (st[1] == 0x600DF00D600DF00Dull && st[0] != t) *flag = 1u;
        st[0] = t; st[1] = 0x600DF00D600DF00Dull; }
    __syncthreads();
}

__device__ __forceinline__ void conv_phase(const bf16_t* U, const float* wdw, const float* bdw, const float* lng, const float* lnb, bf16_t* CV, LAS unsigned char* lds) {
    int tid_ = threadIdx.x; asm volatile("" : "+v"(tid_));
    const int tid = tid_, lane = tid & 63, wv = __builtin_amdgcn_readfirstlane(tid >> 6), c0 = 2 * tid;
    LAS unsigned char* buf = lds;
    LAS float* red = (LAS float*)(lds + 62 * 2048); LAS float* tot = red + 512;
    f32x2 w[CONVK];
#pragma unroll
    for (int j = 0; j < CONVK; ++j) w[j] = *(const f32x2*)(wdw + j * D + c0);
    const f32x2 bd = *(const f32x2*)(bdw + c0), lg = *(const f32x2*)(lng + c0), lb = *(const f32x2*)(lnb + c0);
#define CONV_STAGE(item_) do { const int _t0 = (item_) * 32, _s0 = _t0 & (S - 1); \
        for (int q = wv; q < 124; q += 8) { const int row = q >> 1, half = q & 1; \
            if (_s0 - 30 + row >= 0) __builtin_amdgcn_global_load_lds((const unsigned*)((const char*)U + ((size_t)(_t0 - 30 + row) * D) * 2 + half * 1024 + lane * 16), (LAS unsigned*)(buf + row * 2048 + half * 1024), 16, 0, 0); \
            else *(LAS u32x4*)(buf + row * 2048 + half * 1024 + lane * 16) = (u32x4){0u, 0u, 0u, 0u}; } } while (0)
    int item = blockIdx.x;
    if (item < T / 32) CONV_STAGE(item);
    for (; item < T / 32; item += gridDim.x) {
        const int t0 = item * 32;
        asm volatile("s_waitcnt vmcnt(0) lgkmcnt(0)" ::: "memory");
        __syncthreads();
        unsigned raw[62];
#pragma unroll
        for (int r = 0; r < 62; ++r) raw[r] = *(const LAS unsigned*)(buf + r * 2048 + c0 * 2);
        asm volatile("s_waitcnt lgkmcnt(0)" ::: "memory");
        __syncthreads();
        if (item + (int)gridDim.x < T / 32) CONV_STAGE(item + (int)gridDim.x);
        f32x2 acc[32];
#pragma unroll
        for (int o = 0; o < 32; ++o) acc[o] = bd;
#pragma unroll
        for (int r = 0; r < 62; ++r) {
            const f32x2 uv = (f32x2){bf_lo(raw[r]), bf_hi(raw[r])};
#pragma unroll
            for (int o = (r > 30 ? r - 30 : 0); o <= (r < 31 ? r : 31); ++o) acc[o] = __builtin_elementwise_fma(uv, w[r - o], acc[o]);
        }
        float v[64];
#pragma unroll
        for (int o = 0; o < 32; ++o) { v[o] = acc[o][0] + acc[o][1]; v[32 + o] = acc[o][0] * acc[o][0] + acc[o][1] * acc[o][1]; }
#pragma unroll
        for (int st = 0; st < 6; ++st) {
            const int half = 32 >> st, bit = 32 >> st; const bool up = (lane & bit) != 0;
#pragma unroll
            for (int k = 0; k < half; ++k) { const float send = up ? v[k] : v[k + half]; const float keep = up ? v[k + half] : v[k]; v[k] = keep + __shfl_xor(send, bit); }
        }
        red[wv * 64 + lane] = v[0];
        __syncthreads();
        if (tid < 64) { float s = 0.f;
#pragma unroll
            for (int q = 0; q < 8; ++q) s += red[q * 64 + tid];
            tot[tid] = s; }
        __syncthreads();
#pragma unroll
        for (int o = 0; o < 32; ++o) {
            const float mu = tot[o] * (1.0f / D), var = tot[32 + o] * (1.0f / D) - mu * mu, rstd = rsqrtf(var + EPS);
            const float y0 = (acc[o][0] - mu) * rstd * lg[0] + lb[0], y1 = (acc[o][1] - mu) * rstd * lg[1] + lb[1];
            *(unsigned*)(CV + (size_t)(t0 + o) * D + c0) = cvt_pk_bf16(y0 * fast_sigmoid(y0), y1 * fast_sigmoid(y1));
        }
    }
    asm volatile("s_waitcnt vmcnt(0) lgkmcnt(0)" ::: "memory");
    __syncthreads();
#undef CONV_STAGE
}

enum Ph { PH_PREP0 = 0, PH_CONV_IN, PH_CONV_MID, PH_CONV_OUT, PH_ADAPT, PH_XA_PREP, PH_XA_Q, PH_XA_KV, PH_XA_S, PH_XA_PV, PH_XA_O, PH_ROUTE_PREP, PH_ROUTE, PH_BUILD, PH_MOE1, PH_MOE2, PH_COMBINE, PH_COMBINE_FIN, PH_GLA_PREP, PH_GLA_DECAY, PH_GLA_IN, PH_GLA_ATT, PH_GLA_UT, PH_GLA_SCAN, PH_GLA_O, PH_GLA_FIN, PH_GLA_OUT, PH_NOP, PH_CSUM, PH_FLAGOUT, PH_CSUM2, PH_XA_S_DIAG, PH_XA_O_T, PH_COMBINE_T, PH_ROUTE_T, PH_PREP_ALL, PH_DIAG_KLOOP, PH_XA_QSP, PH_N };

__device__ __forceinline__ void run_phase(const Ctx& c, int ph, int l, LAS unsigned char* lds) {
    unsigned char* ws = c.ws;
    bf16_t* XB = (bf16_t*)(ws + OW_XB); float* RS = (float*)(ws + OW_RS); float* SSP = (float*)(ws + OW_SSP);
    bf16_t* ACTA = (bf16_t*)(ws + OW_ACTA); bf16_t* ACTB = (bf16_t*)(ws + OW_ACTB);
    bf16_t* WCIN = (bf16_t*)(ws + OW_WCIN); bf16_t* WCOUT = (bf16_t*)(ws + OW_WCOUT);
    bf16_t* ACTC = (bf16_t*)(ws + OW_ACTC); float* PSUM = (float*)(ws + OW_PSUM);
    bf16_t* WXQ = (bf16_t*)(ws + OW_WXQ) + (size_t)l * D * D; bf16_t* WXKV = (bf16_t*)(ws + OW_WXKV) + (size_t)l * 2048 * D; bf16_t* WXO = (bf16_t*)(ws + OW_WXO) + (size_t)l * D * D;
    float* WR = (float*)(ws + OW_WR) + (size_t)l * 36 * 1024;
    int* GCNT = (int*)(ws + OM_GCNT) + l * 32; int* NTP = (int*)(ws + OM_NT); int* TILEE = (int*)(ws + OM_TILEE); int* AE = (int*)(ws + OM_AE); int* APOS = (int*)(ws + OM_APOS); float* GATE = (float*)(ws + OM_GATE);
    int* STOK = (int*)(ws + OM_STOK); int* SA = (int*)(ws + OM_SA); float* SRS = (float*)(ws + OM_SRS); float* SGATE = (float*)(ws + OM_SGATE);
    bf16_t* HB = (bf16_t*)(ws + OW_H); bf16_t* YB = (bf16_t*)(ws + OW_Y); bf16_t* W1 = (bf16_t*)(ws + OW_WMOE); bf16_t* W2 = W1 + (size_t)NE * D * D;
    bf16_t* ATTB = (bf16_t*)(ws + OW_ATT); bf16_t* QKR = (bf16_t*)(ws + OW_QKR); bf16_t* KVT = (bf16_t*)(ws + OW_KVT); float* BTM = (float*)(ws + OW_BTM); float* BFM = (float*)(ws + OW_BFM);
    bf16_t* OB = (bf16_t*)(ws + OW_O); bf16_t* UTB = (bf16_t*)(ws + OW_UT); bf16_t* SPB = (bf16_t*)(ws + OW_SP); float* ALR = (float*)(ws + OW_ALR); float* DLF = (float*)(ws + OW_DL); bf16_t* GOB = (bf16_t*)(ws + OW_GO);
    bf16_t* WGTM = (bf16_t*)(ws + OW_WGTM); bf16_t* WGFM = (bf16_t*)(ws + OW_WGFM); bf16_t* WGO = (bf16_t*)(ws + OW_WGO); float* WAF = (float*)(ws + OW_WA);
    bf16_t* KB = (bf16_t*)(ws + OW_KVB); bf16_t* VT = KB + (size_t)1024 * 1024; bf16_t* MEMNB = (bf16_t*)(ws + OW_MEMNB);
    switch (ph) {
    case PH_PREP0:
        cvt_matrix(c.in[7], 2048, 0, 1024, D, c.in[2], WCIN, 1, 0, lds);
        cvt_matrix(c.in[7], 2048, 1024, 1024, D, c.in[2], WCIN, 1, 1, lds, 512);
        cvt_matrix(c.in[13], D, 0, D, D, nullptr, WCOUT, 0, 0, lds, 1024);
        rows_prep(c.in[0], XB, RS, nullptr, T);
        { const int tix = otid(); if (blockIdx.x == 0 && tix < 32) ((unsigned*)(ws + OW_DBG))[tix] = 0u; }
        break;
    case PH_PREP_ALL: {
        cvt_matrix(c.in[7], 2048, 0, 1024, D, c.in[2], WCIN, 1, 0, lds);
        cvt_matrix(c.in[7], 2048, 1024, 1024, D, c.in[2], WCIN, 1, 1, lds, 512);
        cvt_matrix(c.in[13], D, 0, D, D, nullptr, WCOUT, 0, 0, lds, 1024);
        for (int ll = 0; ll < 2; ++ll) {
            cvt_matrix(c.in[20] + (size_t)ll * D * D, D, 0, D, D, c.in[3] + ll * D, (bf16_t*)(ws + OW_WXQ) + (size_t)ll * D * D, 0, 0, lds, 1536 + 1024 * ll);
            cvt_matrix(c.in[21] + (size_t)ll * D * 2048, 2048, 0, 2048, D, nullptr, (bf16_t*)(ws + OW_WXKV) + (size_t)ll * 2048 * D, 0, 0, lds, 0 + 1024 * ll);
            cvt_matrix(c.in[22] + (size_t)ll * D * D, D, 0, D, D, nullptr, (bf16_t*)(ws + OW_WXO) + (size_t)ll * D * D, 0, 0, lds, 1024 + 512 * ll);
            route_prep(c.in[23] + (size_t)ll * D * NG, c.in[25] + (size_t)ll * D * NE, c.in[4] + ll * D, (float*)(ws + OW_WR) + (size_t)ll * 36 * 1024);
        }
        gla_prep(c.in[15], c.in[19], c.in[2] + D, WGTM, WGFM, WGO, WAF, lds);
        rows_norm_bf16(c.in[1], c.in[5], MEMNB, NB * NMEM);
        rows_prep(c.in[0], XB, RS, nullptr, T);
        { const int tix = otid(); if (blockIdx.x == 0 && tix < 64) ((int*)(ws + OM_GCNT))[tix] = 0; }
        } break;
    case PH_CONV_IN: { g8::DenseSched S{8, 128 * 8, D, D, D, XB, WCIN}; g8::gemm_phase(lds, S, g8::EpiGlu{ACTA, RS, c.in[8]}); } break;
    case PH_CONV_MID: conv_phase(ACTA, c.in[9], c.in[10], c.in[11], c.in[12], ACTB, lds); break;
    case PH_CONV_OUT: { g8::DenseSched S{4, 128 * 4, D, D, D, ACTB, WCOUT}; g8::gemm_phase(lds, S, g8::EpiXres{XB, c.in[14], SSP}); } break;
    case PH_ADAPT: rows_prep(c.out, XB, RS, SSP, T); break;
    case PH_XA_PREP:
        cvt_matrix(c.in[20] + (size_t)l * D * D, D, 0, D, D, c.in[3] + l * D, WXQ, 0, 0, lds);
        cvt_matrix(c.in[21] + (size_t)l * D * 2048, 2048, 0, 2048, D, nullptr, WXKV, 0, 0, lds, 512);
        cvt_matrix(c.in[22] + (size_t)l * D * D, D, 0, D, D, nullptr, WXO, 0, 0, lds, 1536);
        rows_norm_bf16(c.in[1], c.in[5], MEMNB, NB * NMEM);
        break;
    case PH_XA_Q: { g8::DenseSched S{4, 128 * 4, D, D, D, XB, WXQ}; g8::gemm_phase(lds, S, g8::EpiRowScale{ACTA, D, SSP, nullptr, 0.0625f, 0, 1.0f}); } break;
    case PH_XA_KV: { g8::KVSched S{D, D, D, MEMNB, WXKV}; g8::gemm_phase(lds, S, g8::EpiKV{KB, VT}); }
        cvt_moe(c.in[27] + (size_t)l * NE * D * DE, c.in[28] + (size_t)l * NE * D * DE, c.in[29] + (size_t)l * NE * DE * D, c.in[4] + l * D, W1, W2, lds);
        break;
    case PH_XA_QSP: {
        { g8::DenseSched S{4, 128 * 4, D, D, D, XB, WXQ}; g8::gemm_phase(lds, S, g8::EpiRowScale{ACTA, D, SSP, nullptr, 0.0625f, 0, 1.0f}); }
        asm volatile("s_waitcnt vmcnt(0)" ::: "memory"); __syncthreads();
        if (otid() < 64) { __builtin_amdgcn_fence(__ATOMIC_ACQUIRE, "agent"); asm volatile("s_waitcnt vmcnt(0)" ::: "memory"); } __syncthreads();
        { g8::AttnSched S{256, D, D, ACTA, KB, 0}; g8::gemm_phase(lds, S, g8::EpiS{ACTB, PSUM}); }
        asm volatile("s_waitcnt vmcnt(0)" ::: "memory"); __syncthreads();
        if (otid() < 64) { __builtin_amdgcn_fence(__ATOMIC_ACQUIRE, "agent"); asm volatile("s_waitcnt vmcnt(0)" ::: "memory"); } __syncthreads();
        { g8::AttnSched S{256, D, 256, ACTB, VT, 1}; g8::gemm_phase(lds, S, g8::EpiPV{ACTC, PSUM}); }
        } break;
    case PH_XA_S: { g8::AttnSched S{256, D, D, ACTA, KB, 0}; g8::gemm_phase(lds, S, g8::EpiS{ACTB, PSUM}); } break;
    case PH_XA_S_DIAG: { g8::AttnSched S{256, D, D, ACTA, KB, 0}; g8::gemm_phase(lds, S, g8::EpiRaw{ACTC}); } break;
    case PH_XA_PV: { g8::AttnSched S{256, D, 256, ACTB, VT, 1}; g8::gemm_phase(lds, S, g8::EpiPV{ACTC, PSUM}); } break;
    case PH_XA_O: { g8::DenseSched S{4, 128 * 4, D, D, D, ACTC, WXO}; g8::gemm_phase(lds, S, g8::EpiXres{XB, nullptr, nullptr}); } break;
    case PH_ROUTE_PREP: route_prep(c.in[23] + (size_t)l * D * NG, c.in[25] + (size_t)l * D * NE, c.in[4] + l * D, WR);
        { const int tix = otid(); if (blockIdx.x == 0 && tix < 32) GCNT[tix] = 0; }
        break;
    case PH_ROUTE: route_phase(XB, WR, c.in[24] + l * NG, c.in[26] + l * NE, RS, AE, APOS, GATE, GCNT, lds); break;
    case PH_BUILD: build_phase(GCNT, AE, APOS, GATE, RS, NTP, TILEE, STOK, SA, SRS, SGATE, lds); break;
    case PH_MOE1: { g8::MoeSched S{D, D, D, XB, W1, (size_t)D * D, TILEE, STOK, __builtin_amdgcn_readfirstlane(g8::ld_agent(NTP))}; g8::gemm_phase(lds, S, g8::EpiMoe1{HB, SRS}); } break;
    case PH_MOE2: { g8::MoeSched S{DE, DE, DE, HB, W2, (size_t)D * DE, TILEE, nullptr, __builtin_amdgcn_readfirstlane(g8::ld_agent(NTP))}; g8::gemm_phase(lds, S, g8::EpiMoe2{YB, SA, SGATE}); } break;
    case PH_COMBINE: combine_phase(c.out, c.out, YB, XB, RS, SSP, nullptr, 0, WAF, ALR, lds); break;
    case PH_COMBINE_FIN: combine_phase(c.out, c.out, YB, XB, RS, SSP, c.in[6], 1, nullptr, nullptr, lds); break;
    case PH_GLA_PREP: gla_prep(c.in[15], c.in[19], c.in[2] + D, WGTM, WGFM, WGO, WAF, lds); break;
    case PH_GLA_DECAY: gla_decay(ALR, c.in[16], c.in[17], BTM, BFM, DLF, lds); break;
    case PH_GLA_IN: { g8::GlaInSched S{XB, WGTM, WGFM}; g8::gemm_phase(lds, S, g8::EpiGlaIn{QKR, KVT, RS, (const bf16_t*)BTM, (const bf16_t*)BFM}); } break;
    case PH_GLA_ATT: { g8::GlaAttSched<0> S{QKR, KVT}; g8::gemm_phase(lds, S, g8::EpiGlaAtt<0>{ATTB, UTB, DLF}); }
        { g8::GlaAttSched<1> S{QKR, KVT}; g8::gemm_phase(lds, S, g8::EpiGlaAtt<1>{ATTB, UTB, DLF}); } break;
    case PH_GLA_UT: { g8::GlaAttSched<1> S{QKR, KVT}; g8::gemm_phase(lds, S, g8::EpiGlaAtt<1>{ATTB, UTB, DLF}); } break;
    case PH_GLA_SCAN: gla_scan(UTB, DLF, SPB); break;
    case PH_GLA_O: { g8::GlaOSched S{QKR, KVT, ATTB, SPB}; g8::gemm_phase(lds, S, g8::EpiGlaO{OB}); } break;
    case PH_GLA_FIN: gla_fin(OB, QKR, c.in[18], GOB); break;
    case PH_CSUM: { static const size_t ro[10] = {OW_ACTA, OW_ACTB, OW_ACTC, OW_H, OW_Y, OW_QKR, OW_ATT, OW_UT, OW_O, OW_KVB};
        static const size_t rb[10] = {64 * MiB, 64 * MiB, 64 * MiB, 72 * MiB, 128 * MiB, 224 * MiB, 64 * MiB, 32 * MiB, 64 * MiB, 4 * MiB};
        const int r = l >> 1; csum_phase(ws + ro[r], rb[r], (unsigned long long*)(ws + OW_DBG) + 512 + r * 256, (unsigned*)(ws + OW_DBG) + r, l & 1, lds); } break;
    case PH_CSUM2: {
        const unsigned char* bp; size_t nb;
        switch (l) {
        case 0: bp = ws + OW_XB; nb = 64 * MiB; break;            case 1: bp = ws + OW_ACTA; nb = 64 * MiB; break;
        case 2: bp = ws + OW_ACTB; nb = 64 * MiB; break;          case 3: bp = (const unsigned char*)c.out; nb = 128 * MiB; break;
        case 4: bp = ws + OW_ACTA; nb = 64 * MiB; break;          case 5: bp = ws + OW_ACTC; nb = 64 * MiB; break;
        case 6: bp = ws + OW_ACTB; nb = 64 * MiB; break;          case 7: bp = ws + OW_ACTC; nb = 64 * MiB; break;
        case 8: bp = (const unsigned char*)c.out; nb = 128 * MiB; break;   case 9: bp = ws + OM_GATE; nb = NA * 4; break;
        case 10: bp = ws + OW_Y; nb = 128 * MiB; break;           case 11: bp = (const unsigned char*)c.out; nb = 128 * MiB; break;
        case 12: bp = ws + OW_BTM; nb = 128 * MiB; break;         case 13: bp = ws + OW_QKR; nb = 224 * MiB; break;
        case 14: bp = ws + OW_ATT; nb = 64 * MiB; break;          case 15: bp = ws + OW_UT; nb = 32 * MiB; break;
        case 16: bp = ws + OW_SP; nb = 32 * MiB; break;           case 17: bp = ws + OW_O; nb = 64 * MiB; break;
        case 18: bp = ws + OW_GO; nb = 64 * MiB; break;           case 19: bp = (const unsigned char*)c.out; nb = 128 * MiB; break;
        case 20: bp = ws + OW_ACTA; nb = 64 * MiB; break;         case 21: bp = ws + OW_ACTB; nb = 64 * MiB; break;
        case 22: bp = ws + OW_ACTC; nb = 64 * MiB; break;         case 23: bp = (const unsigned char*)c.out; nb = 128 * MiB; break;
        case 24: bp = ws + OM_GATE; nb = NA * 4; break;           case 25: bp = ws + OW_Y; nb = 128 * MiB; break;
        case 26: bp = ws + OW_RS; nb = T * 4; break;              case 27: bp = ws + OW_ALR; nb = 2 * MiB; break;
        default: bp = ws + OW_SSP; nb = 2 * MiB; break; }
        csum2_phase(bp, nb, (unsigned long long*)(ws + OW_DBG + 65536) + (size_t)l * 512, (unsigned*)(ws + OW_DBG) + l, lds); } break;
    case PH_XA_O_T: { g8::DenseSched S{4, 128 * 4, D, D, D, ACTC, WXO}; g8::gemm_phase(lds, S, g8::EpiXres{(bf16_t*)(ws + 424 * MiB), nullptr, nullptr}); } break;
    case PH_COMBINE_T: combine_phase(c.out, (float*)(ws + 296 * MiB), YB, (bf16_t*)(ws + 424 * MiB), (float*)(ws + 488 * MiB), (float*)(ws + 489 * MiB), nullptr, 0, nullptr, nullptr, lds); break;
    case PH_ROUTE_T: route_phase(XB, WR, c.in[24] + l * NG, c.in[26] + l * NE, (float*)(ws + 488 * MiB), (int*)(ws + 489 * MiB), (int*)(ws + 490 * MiB), (float*)(ws + 491 * MiB), (int*)(ws + 491 * MiB + 524288), lds); break;
    case PH_DIAG_KLOOP: { g8::DenseSched S{8, 128 * 8, D, D, D, XB, WCIN}; g8::gemm_phase(lds, S, g8::EpiNone{}); } break;
    case PH_FLAGOUT: flagout_phase(c.out, (unsigned*)(ws + OW_DBG)); break;
    case PH_GLA_OUT: { g8::DenseSched S{4, 128 * 4, D, D, D, GOB, WGO}; g8::gemm_phase(lds, S, g8::EpiXres{XB, nullptr, SSP}); } break;
    }
}
template <int PH> __global__ void __launch_bounds__(512, 2) k_opt(Ctx c, int l) {
    extern __shared__ __attribute__((aligned(16))) unsigned char dynlds[];
    run_phase(c, PH, l, (LAS unsigned char*)dynlds);
}

#ifndef ALLCG
#define ALLCG 0
#endif
#define XB_TMO      128
#define XB_XCNT(j)  (256  + 64 * (j))
#define XB_XSUB(j)  (1280 + 64 * (j))
#define XB_XGEN(j)  (2304 + 64 * (j))
#define XB_TOP      3328
#define XB_TOPGEN   3392
#define XCD_BAR_WORDS 3456
#define XB_SPIN_CAP (1u << 18)
__device__ __forceinline__ unsigned xb_ld(unsigned* p)              { return __hip_atomic_load(p, __ATOMIC_RELAXED, __HIP_MEMORY_SCOPE_AGENT); }
__device__ __forceinline__ unsigned xb_add(unsigned* p, unsigned v) { return __hip_atomic_fetch_add(p, v, __ATOMIC_RELAXED, __HIP_MEMORY_SCOPE_AGENT); }
__device__ __forceinline__ unsigned xb_xcc_id() { return (unsigned)__builtin_amdgcn_s_getreg((3 << 11) | 20) & 0xFu; }
#define XB_SPIN(cond, bar) do { unsigned _sp = 0; while (cond) { __builtin_amdgcn_s_sleep(1); \
    if ((++_sp & 255u) == 0u) { if (xb_ld(&(bar)[XB_TMO])) break; if (_sp > XB_SPIN_CAP) { atomicAdd(&(bar)[XB_TMO], 1u); break; } } } } while (0)
struct XcdBarrier { unsigned* bar; unsigned x; volatile LAS unsigned* st; };
__device__ __forceinline__ XcdBarrier xcd_barrier_post(unsigned* bar, volatile LAS unsigned* st) {
    XcdBarrier b; b.bar = bar; b.x = xb_xcc_id(); b.st = st;
    if (threadIdx.x == 0) (void)xb_add(&bar[XB_XCNT(b.x)], 1u);
    return b;
}
__device__ __forceinline__ void xcd_barrier_complete(unsigned* bar, unsigned x, unsigned& nloc, unsigned& nx) {
    const unsigned G = gridDim.x * gridDim.y * gridDim.z;
    unsigned sum, cnt, mine, sp = 0u;
    for (;;) {
        sum = 0u; cnt = 0u; mine = 0u;
#pragma unroll
        for (unsigned j = 0; j < 16; ++j) { const unsigned c = xb_ld(&bar[XB_XCNT(j)]); sum += c; cnt += (c > 0u) ? 1u : 0u; mine = (j == x) ? c : mine; }
        if (sum == G) break;
        __builtin_amdgcn_s_sleep(1);
        if ((++sp & 255u) == 0u) { if (xb_ld(&bar[XB_TMO])) break; if (sp > XB_SPIN_CAP) { atomicAdd(&bar[XB_TMO], 1u); break; } }
    }
    nloc = mine > 0u ? mine : 1u; nx = cnt > 0u ? cnt : 1u;
}
__device__ __forceinline__ void xcd_barrier(const XcdBarrier& b) {
    asm volatile("s_waitcnt vmcnt(0)" ::: "memory");
    __syncthreads();
    if (threadIdx.x == 0) {
        unsigned* bar = b.bar;
        __builtin_amdgcn_s_waitcnt(0);
        unsigned nloc = b.st[0], nx = b.st[1];
        if (nloc == 0u) { xcd_barrier_complete(bar, b.x, nloc, nx); b.st[0] = nloc; b.st[1] = nx; }
        const unsigned old = xb_add(&bar[XB_XSUB(b.x)], 1u);
        const unsigned gen = old / nloc;
        if (old + 1u == (gen + 1u) * nloc) {
            __builtin_amdgcn_fence(__ATOMIC_RELEASE, "agent");
            asm volatile("s_waitcnt vmcnt(0)" ::: "memory");
            const unsigned og = xb_add(&bar[XB_TOP], 1u);
            const unsigned tg = og / nx;
            if (og + 1u == (tg + 1u) * nx) xb_add(&bar[XB_TOPGEN], 1u);
            else XB_SPIN(xb_ld(&bar[XB_TOPGEN]) == tg, bar);
            __builtin_amdgcn_fence(__ATOMIC_ACQUIRE, "agent");
            xb_add(&bar[XB_XGEN(b.x)], 1u);
            asm volatile("s_waitcnt vmcnt(0)" ::: "memory");
        } else {
            XB_SPIN(xb_ld(&bar[XB_XGEN(b.x)]) == gen, bar);
            __builtin_amdgcn_fence(__ATOMIC_ACQUIRE, "agent");
            asm volatile("s_waitcnt vmcnt(0)" ::: "memory");
        }
    }
    __syncthreads();
}
template <int CODE> __device__ __forceinline__ void coop_step(const Ctx& c, LAS unsigned char* lds, cg::grid_group& grid, XcdBarrier& xb, bool sync_after, bool first) {
    run_phase(c, CODE >> 5, CODE & 31, lds);
    if (sync_after) {
        if (first || ALLCG) {
            unsigned* bar = (unsigned*)(c.ws + OW_BAR);
            if (first && blockIdx.x == 0) for (int i = threadIdx.x; i < XCD_BAR_WORDS; i += 512) bar[i] = 0u;
            asm volatile("s_waitcnt vmcnt(0) lgkmcnt(0)" ::: "memory");
            grid.sync();
            if (threadIdx.x < 64) { __builtin_amdgcn_fence(__ATOMIC_ACQUIRE, "agent"); asm volatile("s_waitcnt vmcnt(0)" ::: "memory"); }
            __syncthreads();
            if (first) xb = xcd_barrier_post(bar, xb.st);
        } else xcd_barrier(xb);
    }
}
template <int... CODES> __global__ void __launch_bounds__(512, 2) k_coop(Ctx c) {
    extern __shared__ __attribute__((aligned(16))) unsigned char dynlds[];
    cg::grid_group grid = cg::this_grid();
    LAS unsigned char* lds = (LAS unsigned char*)dynlds;
    volatile LAS unsigned* st = (volatile LAS unsigned*)(lds + LDS_BYTES - 16);
    if (threadIdx.x < 4) st[threadIdx.x] = 0u;
    __syncthreads();
    XcdBarrier xb; xb.bar = nullptr; xb.x = 0; xb.st = st;
    int idx = 0; constexpr int N = sizeof...(CODES);
    ((coop_step<CODES>(c, lds, grid, xb, idx + 1 < N, idx == 0), ++idx), ...);
}
#define CODE(ph, l) ((ph) * 32 + (l))
typedef void (*CoopFn)(Ctx);
extern "C" void kernel_launch(void* const* d_in, const int* in_sizes, int n_in, void* d_out, int out_size, void* d_ws, size_t ws_size, hipStream_t stream) {
    if (n_in != 30 || out_size != T * D || ws_size < OW_END) { fprintf(stderr, "kernel_launch: built for 30 inputs, %d outputs and >= %zu bytes of workspace; got n_in %d, out %d, ws %zu; nothing launched\n", T * D, (size_t)OW_END, n_in, out_size, ws_size); return; }
    Ctx c; memset(&c, 0, sizeof(c));
    for (int i = 0; i < 30; ++i) c.in[i] = (const float*)d_in[i];
    c.out = (float*)d_out; c.ws = (unsigned char*)d_ws;
    static CoopFn fn = k_coop<CODE(PH_PREP_ALL, 0), CODE(PH_CONV_IN, 0), CODE(PH_CONV_MID, 0), CODE(PH_CONV_OUT, 0),
                                         CODE(PH_XA_KV, 0), CODE(PH_XA_QSP, 0), CODE(PH_XA_O, 0),
                                         CODE(PH_ROUTE, 0), CODE(PH_BUILD, 0), CODE(PH_MOE1, 0), CODE(PH_MOE2, 0), CODE(PH_COMBINE, 0),
                                         CODE(PH_GLA_DECAY, 0), CODE(PH_GLA_IN, 0), CODE(PH_GLA_ATT, 0), CODE(PH_GLA_SCAN, 0), CODE(PH_GLA_O, 0), CODE(PH_GLA_FIN, 0), CODE(PH_GLA_OUT, 0),
                                         CODE(PH_XA_KV, 1), CODE(PH_XA_QSP, 1), CODE(PH_XA_O, 1),
                                         CODE(PH_ROUTE, 1), CODE(PH_BUILD, 1), CODE(PH_MOE1, 1), CODE(PH_MOE2, 1), CODE(PH_COMBINE_FIN, 1)>;
    static int grid = 0;
    if (!grid) {
        int dev = 0, cus = 0, per_cu = 0;
        (void)hipGetDevice(&dev); (void)hipDeviceGetAttribute(&cus, hipDeviceAttributeMultiprocessorCount, dev);
        (void)hipFuncSetAttribute((const void*)fn, hipFuncAttributeMaxDynamicSharedMemorySize, LDS_BYTES);
        (void)hipOccupancyMaxActiveBlocksPerMultiprocessor(&per_cu, fn, 512, LDS_BYTES);
        grid = cus * (per_cu < 1 ? 1 : per_cu); if (grid > 256) grid = 256;
        if (grid != 256) fprintf(stderr, "kernel_launch: %d CUs x %d workgroups: this kernel is laid out for 256 resident workgroups\n", cus, per_cu);
    }
    void* args[] = {&c};
    hipError_t e = hipLaunchCooperativeKernel((void*)fn, dim3(grid), dim3(512), args, LDS_BYTES, stream);
    if (e != hipSuccess) fprintf(stderr, "cooperative launch failed: %s (grid %d)\n", hipGetErrorString(e), grid);
}
```

```cpp
#include <hip/hip_runtime.h>
#include <hip/hip_cooperative_groups.h>
#include <cstdio>
#include <cstring>
namespace cg = cooperative_groups;

constexpr int D = 1024, NB = 4, S = 8192, T = NB * S, NMEM = 256;
constexpr int CONVK = 31;
constexpr int GDK = 512, GDVH = 256, GLA_COLS = 3088;
constexpr int NG = 4, NE = 32, DE = 512;
constexpr int NA = T * 2;
constexpr float EPS = 1e-6f;
constexpr size_t MiB = 1u << 20;

struct Ctx { const float* in[30]; float* out; unsigned char* ws; };

__device__ __forceinline__ float wave_sum(float v) {
#pragma unroll
    for (int o = 1; o < 64; o <<= 1) v += __shfl_xor(v, o);
    return v;
}

#define LAS __attribute__((address_space(3)))
typedef unsigned short bf16_t;
typedef short bf16x8 __attribute__((ext_vector_type(8)));
typedef float f32x4 __attribute__((ext_vector_type(4)));
typedef float f32x2 __attribute__((ext_vector_type(2)));
typedef unsigned u32x4 __attribute__((ext_vector_type(4)));
typedef unsigned u32x2 __attribute__((ext_vector_type(2)));

constexpr int LDS_BYTES = 160 * 1024;
constexpr int NSLOT2 = NA + NE * 256;
constexpr int MAXRT = NSLOT2 / 256;
constexpr size_t OW_XB = 0;
constexpr size_t OW_SSP = 64 * MiB;
constexpr size_t OW_RS = 66 * MiB;
constexpr size_t OW_PSUM = 67 * MiB;
constexpr size_t OW_MOE = 69 * MiB;
constexpr size_t OW_ACTA = 72 * MiB, OW_ACTB = 136 * MiB, OW_ACTC = 200 * MiB;
constexpr size_t OW_H = 72 * MiB, OW_Y = 144 * MiB, OW_WMOE = 272 * MiB;
constexpr size_t OW_KVB = 368 * MiB;
constexpr size_t OW_MEMNB = 502 * MiB;
constexpr size_t OW_WCIN = 550 * MiB, OW_WCOUT = 554 * MiB, OW_WXQ = 556 * MiB, OW_WXKV = 560 * MiB, OW_WXO = 568 * MiB, OW_WR = 572 * MiB, OW_BAR = 573 * MiB, OW_DBG = 574 * MiB, OW_END = 575 * MiB;
constexpr size_t OW_ATT = 360 * MiB, OW_QKR = 72 * MiB, OW_KVT = 200 * MiB, OW_BTM = 296 * MiB, OW_O = 296 * MiB, OW_BFM = 360 * MiB, OW_UT = 424 * MiB, OW_SP = 456 * MiB,
                 OW_ALR = 488 * MiB, OW_DL = 490 * MiB, OW_GO = 200 * MiB, OW_WGTM = 492 * MiB, OW_WGFM = 496 * MiB, OW_WGO = 499 * MiB, OW_WA = 501 * MiB;
constexpr size_t OM_GCNT = OW_MOE, OM_NT = OW_MOE + 256, OM_TILEE = OW_MOE + 512, OM_AE = OW_MOE + 4096, OM_APOS = OM_AE + NA * 4, OM_GATE = OM_APOS + NA * 4,
                 OM_STOK = OM_GATE + NA * 4, OM_SA = OM_STOK + NSLOT2 * 4, OM_SRS = OM_SA + NSLOT2 * 4, OM_SGATE = OM_SRS + NSLOT2 * 4, OM_END = OM_SGATE + NSLOT2 * 4;
static_assert(OM_END <= OW_ACTA, "MoE small arrays");

typedef __bf16 bf16x2_t __attribute__((ext_vector_type(2)));
__device__ __forceinline__ unsigned cvt_pk_bf16(float lo, float hi) { const f32x2 v = {lo, hi}; return __builtin_bit_cast(unsigned, __builtin_convertvector(v, bf16x2_t)); }
__device__ __forceinline__ int otid() { int t = threadIdx.x; asm volatile("" : "+v"(t)); return t; }
__device__ __forceinline__ u32x4 pack8(const f32x4& a, const f32x4& b) { u32x4 w; w.x = cvt_pk_bf16(a[0], a[1]); w.y = cvt_pk_bf16(a[2], a[3]); w.z = cvt_pk_bf16(b[0], b[1]); w.w = cvt_pk_bf16(b[2], b[3]); return w; }
__device__ __forceinline__ float bf_lo(unsigned w) { return __uint_as_float(w << 16); }
__device__ __forceinline__ float bf_hi(unsigned w) { return __uint_as_float(w & 0xffff0000u); }
__device__ __forceinline__ float fast_sigmoid(float x) { return __builtin_amdgcn_rcpf(1.0f + __builtin_amdgcn_exp2f(-1.4426950408889634f * x)); }

#ifndef LDS_POISON
#define LDS_POISON 0
#endif
#ifndef G8_SP2
#define G8_SP2 1
#endif
namespace g8 {
constexpr int BM = 256, BK = 64, HALF = 128, HTB = HALF * BK * 2, STAGE_BYTES = 8 * HTB;
__device__ __forceinline__ int lds_byte(int r, int c) { const int st = (r >> 4) * 2 + (c >> 5), rr = r & 15, cc = c & 31, ob = rr * 64 + cc * 2; return st * 1024 + (ob ^ (((ob >> 9) & 1) << 5)); }
__device__ __forceinline__ void stage_rc(int b, int& R, int& C) { const int st = b / 1024, sb = b % 1024, swz = sb ^ (((sb >> 9) & 1) << 5); R = (st >> 1) * 16 + swz / 64; C = (st & 1) * 32 + (swz % 64) / 2; }
__device__ __forceinline__ int perm32(int rho) { const int n = rho >> 4, i = rho & 15; return 8 * (i >> 2) + 4 * n + (i & 3); }
struct Unit { int pm, pn, e; };

template <class Epi, class Sched>
__device__ __forceinline__ void gemm_phase(LAS unsigned char* lds, const Sched& S, const Epi& E) {
    int tid_ = threadIdx.x; asm volatile("" : "+v"(tid_));
    const int tid = tid_, wid = __builtin_amdgcn_readfirstlane(tid >> 6), lane = tid & 63, wr = wid >> 2, wc = wid & 3, fr = lane & 15, fq = lane >> 4;
    const size_t kstep = (size_t)(BK * 2);
    const unsigned ldsw = (unsigned)wid * 1024u;
    const int aoff = lds_byte(wr * 64 + fr, fq * 8), boff = lds_byte(wc * 32 + fr, fq * 8);
#define G8_SA(b, h) (((b) * 2 + (h)) * HTB)
#define G8_SB(b, h) ((4 + (b) * 2 + (h)) * HTB)
#define G8_STAGE(bufoff, gbase, vv) do { _Pragma("unroll") for (int _i = 0; _i < 2; ++_i) \
        __builtin_amdgcn_global_load_lds((const unsigned*)((const char*)(gbase) + (vv)[_i]), (LAS unsigned*)(lds + (bufoff) + ldsw + _i * 8192), 16, 0, 0); } while (0)
#define G8_LDA(dst, b, h) do { _Pragma("unroll") for (int m = 0; m < 4; ++m) _Pragma("unroll") for (int k = 0; k < 2; ++k) dst[m][k] = *(const LAS bf16x8*)(lds + G8_SA(b, h) + aoff + m * 2048 + k * 1024); } while (0)
#define G8_LDB(dst, b, h) do { _Pragma("unroll") for (int n = 0; n < 2; ++n) _Pragma("unroll") for (int k = 0; k < 2; ++k) dst[n][k] = *(const LAS bf16x8*)(lds + G8_SB(b, h) + boff + n * 2048 + k * 1024); } while (0)
#define G8_MMA(ai, bj, At, Bt) do { __builtin_amdgcn_s_setprio(1); _Pragma("unroll") for (int m = 0; m < 4; ++m) _Pragma("unroll") for (int n = 0; n < 2; ++n) _Pragma("unroll") for (int k = 0; k < 2; ++k) \
        acc[ai][bj][m][n] = __builtin_amdgcn_mfma_f32_16x16x32_bf16(Bt[n][k], At[m][k], acc[ai][bj][m][n], 0, 0, 0); __builtin_amdgcn_s_setprio(0); } while (0)
#define G8_WAIT_V(n) asm volatile("s_waitcnt vmcnt(" #n ")" ::: "memory")
#define G8_WAIT_L(n) asm volatile("s_waitcnt lgkmcnt(" #n ")" ::: "memory")
#define G8_BAR __builtin_amdgcn_s_barrier()
#define G8_SCHED __builtin_amdgcn_sched_barrier(0)
#define G8_VA(dst, u) do { const int _ac = S.a_col(u), _lda = S.lda(u); _Pragma("unroll") for (int _i = 0; _i < 2; ++_i) { int _R, _C; stage_rc(tid * 16 + _i * 8192, _R, _C); \
        _Pragma("unroll") for (int _h = 0; _h < 2; ++_h) dst[_h][_i] = (unsigned)(((size_t)S.a_row(u, _h * HALF + _R) * _lda + _ac + _C) * 2); } } while (0)
#define G8_VB(dst, hs, u) do { const int _ldb = S.ldb(u); hs = (size_t)HALF * _ldb * 2; _Pragma("unroll") for (int _i = 0; _i < 2; ++_i) { int _R, _C; stage_rc(tid * 16 + _i * 8192, _R, _C); \
        dst[_i] = (unsigned)(((_R & ~31) + perm32(_R & 31)) * _ldb + _C) * 2u; } } while (0)
    Unit cur, nxt; int ui = 0; bool aligned_end = false;
    if (!S.next(0, cur)) return;
#if LDS_POISON
    for (int i = tid; i < STAGE_BYTES / 16; i += 512) ((LAS u32x4*)lds)[i] = (u32x4){0x7fc07fc0u, 0x7fc07fc0u, 0x7fc07fc0u, 0x7fc07fc0u};
    __syncthreads();
#endif
    f32x4 acc[2][2][4][2];
#pragma unroll
    for (int a = 0; a < 2; ++a)
#pragma unroll
        for (int b = 0; b < 2; ++b)
#pragma unroll
            for (int m = 0; m < 4; ++m)
#pragma unroll
                for (int n = 0; n < 2; ++n) acc[a][b][m][n] = (f32x4){0.f, 0.f, 0.f, 0.f};
    bf16x8 At[4][2], B0[2][2], B1[2][2];
    unsigned va[2][2], nva[2][2], vb[2], nvb[2]; size_t hsB, nhsB;
    G8_VA(va, cur); G8_VB(vb, hsB, cur);
    const char* Ab = S.a_base(cur);
    const char* cB = S.b_base(cur);
#if G8_SP2
    G8_STAGE(G8_SB(0, 0), cB, vb); G8_STAGE(G8_SB(0, 1), cB + hsB, vb); G8_STAGE(G8_SA(0, 0), Ab, va[0]); G8_STAGE(G8_SA(0, 1), Ab, va[1]);
    if (wr == 1) G8_BAR;
    G8_WAIT_V(2); G8_BAR;
    G8_STAGE(G8_SB(1, 0), cB + kstep, vb); G8_STAGE(G8_SA(1, 0), Ab + kstep, va[0]); G8_STAGE(G8_SB(1, 1), cB + hsB + kstep, vb);
    G8_WAIT_V(6); G8_BAR;
#else
    G8_STAGE(G8_SB(0, 0), cB, vb); G8_STAGE(G8_SA(0, 0), Ab, va[0]); G8_STAGE(G8_SB(0, 1), cB + hsB, vb); G8_STAGE(G8_SA(0, 1), Ab, va[1]);
    if (wr == 1) G8_BAR;
    G8_WAIT_V(4); G8_BAR;
    G8_STAGE(G8_SB(1, 0), cB + kstep, vb); G8_STAGE(G8_SA(1, 0), Ab + kstep, va[0]); G8_STAGE(G8_SB(1, 1), cB + hsB + kstep, vb);
    G8_WAIT_V(6); G8_BAR;
#endif
    for (;;) {
        const bool has_next = S.next(ui + 1, nxt);
        const char* nB = cB; const char* nAb = Ab;
        if (has_next) { nB = S.b_base(nxt); nAb = S.a_base(nxt); G8_VA(nva, nxt); G8_VB(nvb, nhsB, nxt); }
        else {
            nhsB = hsB;
#pragma unroll
            for (int i = 0; i < 2; ++i) { nvb[i] = vb[i];
#pragma unroll
                for (int h = 0; h < 2; ++h) nva[h][i] = va[h][i]; }
        }
        const int nt = S.nt(cur);
        for (int t = 0; t < nt; t += 2) {
            const bool last = (t == nt - 2);
            const char* a1 = Ab + (size_t)(t + 1) * kstep;
            const char* a2 = last ? nAb : Ab + (size_t)(t + 2) * kstep;
            const char* b2 = last ? nB : cB + (size_t)(t + 2) * kstep;
            const char* a3 = a2 + kstep; const char* b3 = b2 + kstep;
            const size_t hs2 = last ? nhsB : hsB;
            unsigned v2[2][2], vb2[2];
#pragma unroll
            for (int i = 0; i < 2; ++i) { vb2[i] = last ? nvb[i] : vb[i];
#pragma unroll
                for (int h = 0; h < 2; ++h) v2[h][i] = last ? nva[h][i] : va[h][i]; }
#if G8_SP2
            G8_LDB(B0, 0, 0); G8_LDB(B1, 0, 1); G8_SCHED; G8_LDA(At, 0, 0); G8_STAGE(G8_SA(1, 1), a1, va[1]);
            G8_WAIT_V(8); G8_WAIT_L(0); G8_BAR; G8_MMA(0, 0, At, B0); G8_MMA(0, 1, At, B1); G8_BAR; G8_SCHED;
            G8_LDA(At, 0, 1); G8_STAGE(G8_SB(0, 0), b2, vb2); G8_STAGE(G8_SB(0, 1), b2 + hs2, vb2); G8_STAGE(G8_SA(0, 0), a2, v2[0]);
            G8_WAIT_V(8); G8_WAIT_L(0); G8_BAR; G8_MMA(1, 0, At, B0); G8_MMA(1, 1, At, B1); G8_BAR; G8_SCHED;
            G8_LDB(B0, 1, 0); G8_LDB(B1, 1, 1); G8_SCHED; G8_LDA(At, 1, 0); G8_STAGE(G8_SA(0, 1), a2, v2[1]);
            G8_WAIT_V(8); G8_WAIT_L(0); G8_BAR; G8_MMA(0, 0, At, B0); G8_MMA(0, 1, At, B1); G8_BAR; G8_SCHED;
            G8_LDA(At, 1, 1); G8_STAGE(G8_SB(1, 0), b3, vb2); G8_STAGE(G8_SB(1, 1), b3 + hs2, vb2); G8_STAGE(G8_SA(1, 0), a3, v2[0]);
            G8_WAIT_V(8); G8_WAIT_L(0); G8_BAR; G8_MMA(1, 0, At, B0); G8_MMA(1, 1, At, B1); G8_BAR; G8_SCHED;
#else
            G8_LDB(B0, 0, 0); G8_SCHED; G8_LDA(At, 0, 0); G8_STAGE(G8_SA(1, 1), a1, va[1]);
            G8_WAIT_L(8); G8_BAR; G8_WAIT_L(0); G8_MMA(0, 0, At, B0); G8_BAR; G8_SCHED;
            G8_LDB(B1, 0, 1); G8_STAGE(G8_SB(0, 0), b2, vb2);
            G8_BAR; G8_WAIT_L(0); G8_MMA(0, 1, At, B1); G8_BAR;
            G8_LDA(At, 0, 1); G8_STAGE(G8_SA(0, 0), a2, v2[0]);
            G8_BAR; G8_WAIT_L(0); G8_MMA(1, 0, At, B0); G8_BAR; G8_SCHED;
            G8_STAGE(G8_SB(0, 1), b2 + hs2, vb2);
            G8_WAIT_V(6); G8_BAR; G8_MMA(1, 1, At, B1); G8_BAR;
            G8_LDB(B0, 1, 0); G8_SCHED; G8_LDA(At, 1, 0); G8_STAGE(G8_SA(0, 1), a2, v2[1]);
            G8_WAIT_L(8); G8_BAR; G8_WAIT_L(0); G8_MMA(0, 0, At, B0); G8_BAR; G8_SCHED;
            G8_LDB(B1, 1, 1); G8_STAGE(G8_SB(1, 0), b3, vb2);
            G8_BAR; G8_WAIT_L(0); G8_MMA(0, 1, At, B1); G8_BAR;
            G8_LDA(At, 1, 1); G8_STAGE(G8_SA(1, 0), a3, v2[0]);
            G8_BAR; G8_WAIT_L(0); G8_MMA(1, 0, At, B0); G8_BAR; G8_SCHED;
            G8_STAGE(G8_SB(1, 1), b3 + hs2, vb2);
            G8_WAIT_V(6); G8_BAR; G8_MMA(1, 1, At, B1); G8_BAR;
#endif
        }
        const bool keep = S.cont(cur);
        if (!keep) {
            if (wr == 0) G8_BAR;
            E(acc, cur, wr, wc, fr, fq);
            if (has_next && wr == 1) G8_BAR;
        }
        if (!has_next) { aligned_end = !keep; break; }
        if (!keep) {
#pragma unroll
            for (int a = 0; a < 2; ++a)
#pragma unroll
                for (int b = 0; b < 2; ++b)
#pragma unroll
                    for (int m = 0; m < 4; ++m)
#pragma unroll
                        for (int n = 0; n < 2; ++n) acc[a][b][m][n] = (f32x4){0.f, 0.f, 0.f, 0.f};
        }
        cur = nxt; cB = nB; Ab = nAb; hsB = nhsB; ++ui;
#pragma unroll
        for (int i = 0; i < 2; ++i) { vb[i] = nvb[i];
#pragma unroll
            for (int h = 0; h < 2; ++h) va[h][i] = nva[h][i]; }
    }
    G8_WAIT_V(0);
    if (!aligned_end && wr == 0) G8_BAR;
    G8_BAR;
#undef G8_SA
#undef G8_SB
#undef G8_STAGE
#undef G8_LDA
#undef G8_LDB
#undef G8_MMA
#undef G8_WAIT_V
#undef G8_WAIT_L
#undef G8_BAR
#undef G8_SCHED
#undef G8_VA
#undef G8_VB
}

struct DenseSched {
    __device__ __forceinline__ int lda(const Unit&) const { return lda_; }
    __device__ __forceinline__ int ldb(const Unit&) const { return ldb_; }
    __device__ __forceinline__ int nt(const Unit&) const { return K / BK; }
    __device__ __forceinline__ bool cont(const Unit&) const { return false; }
    int nN, nU, K, lda_, ldb_; const bf16_t* A; const bf16_t* Bt;
    __device__ __forceinline__ const char* a_base(const Unit&) const { return (const char*)A; }
    __device__ __forceinline__ bool next(int i, Unit& u) const {
        const int c = blockIdx.x, per = gridDim.x >> 3, x = c & 7, j = c >> 3;
        const int chunk = (nU + 7) >> 3, lu = i * per + j;
        if (lu >= chunk) return false;
        const int un = x * chunk + lu; if (un >= nU) return false;
        u.pm = un / nN; u.pn = un - u.pm * nN; u.e = 0; return true; }
    __device__ __forceinline__ int a_row(const Unit& u, int r) const { return u.pm * BM + r; }
    __device__ __forceinline__ int a_col(const Unit&) const { return 0; }
    __device__ __forceinline__ const char* b_base(const Unit& u) const { return (const char*)(Bt + (size_t)u.pn * BM * ldb_); }
};

struct EpiGlu {
    bf16_t* U; const float* rs; const float* bias;
    __device__ __forceinline__ void operator()(const f32x4 (&acc)[2][2][4][2], const Unit& u, int wr, int wc, int fr, int fq) const {
        const int c0 = u.pn * 128 + wc * 32 + 8 * fq;
        const f32x4 ba0 = *(const f32x4*)(bias + c0), ba1 = *(const f32x4*)(bias + c0 + 4), bg0 = *(const f32x4*)(bias + 1024 + c0), bg1 = *(const f32x4*)(bias + 1024 + c0 + 4);
        float rv[2][4];
#pragma unroll
        for (int ai = 0; ai < 2; ++ai)
#pragma unroll
            for (int m = 0; m < 4; ++m) rv[ai][m] = rs[u.pm * BM + ai * HALF + wr * 64 + m * 16 + fr];
        __builtin_amdgcn_sched_barrier(0);
#pragma unroll
        for (int ai = 0; ai < 2; ++ai)
#pragma unroll
            for (int m = 0; m < 4; ++m) {
                const int row = u.pm * BM + ai * HALF + wr * 64 + m * 16 + fr; const float r = rv[ai][m];
                f32x4 o0, o1;
#pragma unroll
                for (int j = 0; j < 4; ++j) {
                    o0[j] = (acc[ai][0][m][0][j] * r + ba0[j]) * fast_sigmoid(acc[ai][1][m][0][j] * r + bg0[j]);
                    o1[j] = (acc[ai][0][m][1][j] * r + ba1[j]) * fast_sigmoid(acc[ai][1][m][1][j] * r + bg1[j]); }
                *(u32x4*)(U + (size_t)row * D + c0) = pack8(o0, o1);
            }
    }
};
struct EpiXres {
    bf16_t* XB; const float* bias; float* ssp;
    __device__ __forceinline__ void operator()(const f32x4 (&acc)[2][2][4][2], const Unit& u, int wr, int wc, int fr, int fq) const {
        f32x4 bv[2][2];
#pragma unroll
        for (int bj = 0; bj < 2; ++bj) { const int c0 = u.pn * BM + bj * HALF + wc * 32 + 8 * fq;
            bv[bj][0] = bias ? *(const f32x4*)(bias + c0) : (f32x4){0.f, 0.f, 0.f, 0.f}; bv[bj][1] = bias ? *(const f32x4*)(bias + c0 + 4) : (f32x4){0.f, 0.f, 0.f, 0.f}; }
#pragma unroll
        for (int ai = 0; ai < 2; ++ai) {
            u32x4 xv[2][4][2];
#pragma unroll
            for (int m = 0; m < 4; ++m)
#pragma unroll
                for (int bj = 0; bj < 2; ++bj) xv[ai][m][bj] = *(const u32x4*)(XB + (size_t)(u.pm * BM + ai * HALF + wr * 64 + m * 16 + fr) * D + u.pn * BM + bj * HALF + wc * 32 + 8 * fq);
            __builtin_amdgcn_sched_barrier(0);
#pragma unroll
            for (int m = 0; m < 4; ++m) {
                const int row = u.pm * BM + ai * HALF + wr * 64 + m * 16 + fr; float ss = 0.f;
#pragma unroll
                for (int bj = 0; bj < 2; ++bj) {
                    const size_t off = (size_t)row * D + u.pn * BM + bj * HALF + wc * 32 + 8 * fq; const u32x4 xw = xv[ai][m][bj];
                    const f32x4 v0 = (f32x4){bf_lo(xw.x), bf_hi(xw.x), bf_lo(xw.y), bf_hi(xw.y)} + acc[ai][bj][m][0] + bv[bj][0];
                    const f32x4 v1 = (f32x4){bf_lo(xw.z), bf_hi(xw.z), bf_lo(xw.w), bf_hi(xw.w)} + acc[ai][bj][m][1] + bv[bj][1];
                    const u32x4 w = pack8(v0, v1);
                    *(u32x4*)(XB + off) = w;
                    const float r0 = bf_lo(w.x), r1 = bf_hi(w.x), r2 = bf_lo(w.y), r3 = bf_hi(w.y), r4 = bf_lo(w.z), r5 = bf_hi(w.z), r6 = bf_lo(w.w), r7 = bf_hi(w.w);
                    ss += (r0 * r0 + r1 * r1) + (r2 * r2 + r3 * r3) + (r4 * r4 + r5 * r5) + (r6 * r6 + r7 * r7);
                }
                if (ssp) { ss += __shfl_xor(ss, 16); ss += __shfl_xor(ss, 32); if (fq == 0) ssp[(size_t)row * 16 + u.pn * 4 + wc] = ss; }
            }
            __builtin_amdgcn_sched_barrier(0);
        }
    }
};
struct AttnSched {
    __device__ __forceinline__ int lda(const Unit&) const { return lda_; }
    __device__ __forceinline__ int ldb(const Unit&) const { return ldb_; }
    __device__ __forceinline__ int nt(const Unit&) const { return K / BK; }
    __device__ __forceinline__ bool cont(const Unit&) const { return false; }
    int K, lda_, ldb_; const bf16_t* A; const bf16_t* Bm; int pv;
    __device__ __forceinline__ bool next(int i, Unit& u) const {
        const int c = blockIdx.x, per = gridDim.x >> 3, x = c & 7, j = c >> 3;
        const int lu = i * per + j; if (lu >= 64) return false;
        const int un = x * 64 + lu;
        u.pm = un >> 2; u.pn = 0; u.e = un & 3; return true; }
    __device__ __forceinline__ const char* a_base(const Unit&) const { return (const char*)A; }
    __device__ __forceinline__ int a_row(const Unit& u, int r) const { return u.pm * BM + r; }
    __device__ __forceinline__ int a_col(const Unit& u) const { return u.e * 256; }
    __device__ __forceinline__ const char* b_base(const Unit& u) const { const int b = u.pm >> 5;
        return pv ? (const char*)(Bm + (size_t)(b * 4 + u.e) * 65536) : (const char*)(Bm + (size_t)(b * 256) * 1024 + u.e * 256); }
};
struct KVSched {
    __device__ __forceinline__ int lda(const Unit&) const { return lda_; }
    __device__ __forceinline__ int ldb(const Unit&) const { return ldb_; }
    __device__ __forceinline__ int nt(const Unit&) const { return K / BK; }
    __device__ __forceinline__ bool cont(const Unit&) const { return false; }
    int K, lda_, ldb_; const bf16_t* MEMNB; const bf16_t* WKV;
    __device__ __forceinline__ bool next(int i, Unit& u) const {
        const int un = i * (int)gridDim.x + (int)blockIdx.x; if (un >= 32) return false;
        u.e = un >> 4; u.pm = (un & 15) >> 2; u.pn = un & 3; return true; }
    __device__ __forceinline__ const char* a_base(const Unit& u) const { return u.e ? (const char*)(WKV + (size_t)1024 * 1024) : (const char*)MEMNB; }
    __device__ __forceinline__ int a_row(const Unit& u, int r) const { return u.pm * BM + r; }
    __device__ __forceinline__ int a_col(const Unit&) const { return 0; }
    __device__ __forceinline__ const char* b_base(const Unit& u) const { return u.e ? (const char*)(MEMNB + (size_t)u.pn * BM * 1024) : (const char*)(WKV + (size_t)u.pn * BM * 1024); }
};
__device__ __forceinline__ float ssp_rs(const float* ssp, int row) {
    const f32x4 a = *(const f32x4*)(ssp + (size_t)row * 16), b = *(const f32x4*)(ssp + (size_t)row * 16 + 4), c = *(const f32x4*)(ssp + (size_t)row * 16 + 8), d = *(const f32x4*)(ssp + (size_t)row * 16 + 12);
    const float s = ((a[0] + a[1]) + (a[2] + a[3])) + ((b[0] + b[1]) + (b[2] + b[3])) + ((c[0] + c[1]) + (c[2] + c[3])) + ((d[0] + d[1]) + (d[2] + d[3]));
    return rsqrtf(s * (1.0f / D) + EPS);
}
struct EpiRowScale {
    bf16_t* O; int ldo; const float* ssp; const float* rs; float scale; int qtiles; float qscale;
    __device__ __forceinline__ void operator()(const f32x4 (&acc)[2][2][4][2], const Unit& u, int wr, int wc, int fr, int fq) const {
        const float cs = scale * (u.pn < qtiles ? qscale : 1.0f);
        float rv[2][4];
        if (rs) {
#pragma unroll
            for (int ai = 0; ai < 2; ++ai)
#pragma unroll
                for (int m = 0; m < 4; ++m) rv[ai][m] = rs[u.pm * BM + ai * HALF + wr * 64 + m * 16 + fr];
        } else {
#pragma unroll
            for (int ai = 0; ai < 2; ++ai) {
                f32x4 p[4][4];
#pragma unroll
                for (int m = 0; m < 4; ++m)
#pragma unroll
                    for (int q = 0; q < 4; ++q) p[m][q] = *(const f32x4*)(ssp + (size_t)(u.pm * BM + ai * HALF + wr * 64 + m * 16 + fr) * 16 + 4 * q);
                __builtin_amdgcn_sched_barrier(0);
#pragma unroll
                for (int m = 0; m < 4; ++m) { float sm = 0.f;
#pragma unroll
                    for (int q = 0; q < 4; ++q) sm += (p[m][q][0] + p[m][q][1]) + (p[m][q][2] + p[m][q][3]);
                    rv[ai][m] = rsqrtf(sm * (1.0f / D) + EPS); }
            }
        }
        __builtin_amdgcn_sched_barrier(0);
#pragma unroll
        for (int ai = 0; ai < 2; ++ai)
#pragma unroll
            for (int m = 0; m < 4; ++m) {
                const int row = u.pm * BM + ai * HALF + wr * 64 + m * 16 + fr;
                const float r = rv[ai][m] * cs;
#pragma unroll
                for (int bj = 0; bj < 2; ++bj) { const int c0 = u.pn * BM + bj * HALF + wc * 32 + 8 * fq;
                    *(u32x4*)(O + (size_t)row * ldo + c0) = pack8(acc[ai][bj][m][0] * r, acc[ai][bj][m][1] * r); }
            }
    }
};
struct EpiKV {
    bf16_t* Kb; bf16_t* VT;
    __device__ __forceinline__ void operator()(const f32x4 (&acc)[2][2][4][2], const Unit& u, int wr, int wc, int fr, int fq) const {
        bf16_t* base = u.e ? VT + (size_t)(u.pn * 4 + u.pm) * 65536 : Kb + (size_t)u.pm * BM * 1024 + u.pn * BM;
        const int ld = u.e ? 256 : 1024;
#pragma unroll
        for (int ai = 0; ai < 2; ++ai)
#pragma unroll
            for (int m = 0; m < 4; ++m) { const int r = ai * HALF + wr * 64 + m * 16 + fr;
#pragma unroll
                for (int bj = 0; bj < 2; ++bj) { const int c0 = bj * HALF + wc * 32 + 8 * fq;
                    *(u32x4*)(base + (size_t)r * ld + c0) = pack8(acc[ai][bj][m][0], acc[ai][bj][m][1]); } }
    }
};
struct EpiS {
    bf16_t* P; float* psum;
    __device__ __forceinline__ void operator()(const f32x4 (&acc)[2][2][4][2], const Unit& u, int wr, int wc, int fr, int fq) const {
#pragma unroll
        for (int ai = 0; ai < 2; ++ai)
#pragma unroll
            for (int m = 0; m < 4; ++m) {
                const int row = u.pm * BM + ai * HALF + wr * 64 + m * 16 + fr; float ps = 0.f;
#pragma unroll
                for (int bj = 0; bj < 2; ++bj) { const int c0 = u.e * 256 + bj * HALF + wc * 32 + 8 * fq;
                    f32x4 e0, e1;
#pragma unroll
                    for (int j = 0; j < 4; ++j) { e0[j] = __builtin_amdgcn_exp2f(acc[ai][bj][m][0][j] * 1.4426950408889634f); e1[j] = __builtin_amdgcn_exp2f(acc[ai][bj][m][1][j] * 1.4426950408889634f); }
                    const u32x4 w = pack8(e0, e1);
                    *(u32x4*)(P + (size_t)row * D + c0) = w;
                    ps += (bf_lo(w.x) + bf_hi(w.x)) + (bf_lo(w.y) + bf_hi(w.y)) + (bf_lo(w.z) + bf_hi(w.z)) + (bf_lo(w.w) + bf_hi(w.w)); }
                ps += __shfl_xor(ps, 16); ps += __shfl_xor(ps, 32);
                if (fq == 0) psum[(size_t)row * 16 + u.e * 4 + wc] = ps;
            }
    }
};
struct EpiRaw {
    bf16_t* O;
    __device__ __forceinline__ void operator()(const f32x4 (&acc)[2][2][4][2], const Unit& u, int wr, int wc, int fr, int fq) const {
#pragma unroll
        for (int ai = 0; ai < 2; ++ai)
#pragma unroll
            for (int m = 0; m < 4; ++m) { const int row = u.pm * BM + ai * HALF + wr * 64 + m * 16 + fr;
#pragma unroll
                for (int bj = 0; bj < 2; ++bj) { const int c0 = u.e * 256 + bj * HALF + wc * 32 + 8 * fq;
                    *(u32x4*)(O + (size_t)row * D + c0) = pack8(acc[ai][bj][m][0], acc[ai][bj][m][1]); } }
    }
};
struct EpiNone {
    __device__ __forceinline__ void operator()(const f32x4 (&acc)[2][2][4][2], const Unit& u, int wr, int wc, int fr, int fq) const {
#pragma unroll
        for (int ai = 0; ai < 2; ++ai)
#pragma unroll
            for (int bj = 0; bj < 2; ++bj)
#pragma unroll
                for (int m = 0; m < 4; ++m)
#pragma unroll
                    for (int n = 0; n < 2; ++n) asm volatile("" :: "v"(acc[ai][bj][m][n]));
    }
};
struct EpiPV {
    bf16_t* O; const float* psum;
    __device__ __forceinline__ void operator()(const f32x4 (&acc)[2][2][4][2], const Unit& u, int wr, int wc, int fr, int fq) const {
        f32x4 sv[2][4];
#pragma unroll
        for (int ai = 0; ai < 2; ++ai)
#pragma unroll
            for (int m = 0; m < 4; ++m) sv[ai][m] = *(const f32x4*)(psum + (size_t)(u.pm * BM + ai * HALF + wr * 64 + m * 16 + fr) * 16 + u.e * 4);
        __builtin_amdgcn_sched_barrier(0);
#pragma unroll
        for (int ai = 0; ai < 2; ++ai)
#pragma unroll
            for (int m = 0; m < 4; ++m) {
                const int row = u.pm * BM + ai * HALF + wr * 64 + m * 16 + fr;
                const float inv = 1.0f / ((sv[ai][m][0] + sv[ai][m][1]) + (sv[ai][m][2] + sv[ai][m][3]));
#pragma unroll
                for (int bj = 0; bj < 2; ++bj) { const int c0 = u.e * 256 + bj * HALF + wc * 32 + 8 * fq;
                    *(u32x4*)(O + (size_t)row * D + c0) = pack8(acc[ai][bj][m][0] * inv, acc[ai][bj][m][1] * inv); }
            }
    }
};

__device__ __forceinline__ int ld_agent(const int* p) { return __hip_atomic_load(p, __ATOMIC_RELAXED, __HIP_MEMORY_SCOPE_AGENT); }
struct MoeSched {
    __device__ __forceinline__ int lda(const Unit&) const { return lda_; }
    __device__ __forceinline__ int ldb(const Unit&) const { return ldb_; }
    __device__ __forceinline__ int nt(const Unit&) const { return K / BK; }
    __device__ __forceinline__ bool cont(const Unit&) const { return false; }
    int K, lda_, ldb_; const bf16_t* A; const bf16_t* W; size_t wstride; const int* tile_e; const int* slot_tok; int NT;
    __device__ __forceinline__ bool next(int i, Unit& u) const {
        const int c = blockIdx.x, per = gridDim.x >> 3, x = c & 7, j = c >> 3;
        const int tpx = (NT + 7) >> 3, lu = i * per + j, lrt = lu >> 2;
        if (lrt >= tpx) return false;
        const int rt = x * tpx + lrt; if (rt >= NT) return false;
        u.pm = rt; u.pn = lu & 3; u.e = __builtin_amdgcn_readfirstlane(ld_agent(tile_e + rt)); return true; }
    __device__ __forceinline__ const char* a_base(const Unit&) const { return (const char*)A; }
    __device__ __forceinline__ int a_row(const Unit& u, int r) const { return slot_tok ? slot_tok[u.pm * BM + r] : u.pm * BM + r; }
    __device__ __forceinline__ int a_col(const Unit&) const { return 0; }
    __device__ __forceinline__ const char* b_base(const Unit& u) const { return (const char*)(W + (size_t)u.e * wstride + (size_t)u.pn * BM * ldb_); }
};
struct EpiMoe1 {
    bf16_t* H; const float* slot_rs;
    __device__ __forceinline__ void operator()(const f32x4 (&acc)[2][2][4][2], const Unit& u, int wr, int wc, int fr, int fq) const {
        const int c0 = u.pn * 128 + wc * 32 + 8 * fq;
        float rv[2][4];
#pragma unroll
        for (int ai = 0; ai < 2; ++ai)
#pragma unroll
            for (int m = 0; m < 4; ++m) rv[ai][m] = slot_rs[u.pm * BM + ai * HALF + wr * 64 + m * 16 + fr];
        __builtin_amdgcn_sched_barrier(0);
#pragma unroll
        for (int ai = 0; ai < 2; ++ai)
#pragma unroll
            for (int m = 0; m < 4; ++m) {
                const int row = u.pm * BM + ai * HALF + wr * 64 + m * 16 + fr; const float r = rv[ai][m];
                f32x4 o0, o1;
#pragma unroll
                for (int j = 0; j < 4; ++j) {
                    const float g0 = acc[ai][0][m][0][j] * r, g1 = acc[ai][0][m][1][j] * r;
                    o0[j] = g0 * fast_sigmoid(g0) * (acc[ai][1][m][0][j] * r);
                    o1[j] = g1 * fast_sigmoid(g1) * (acc[ai][1][m][1][j] * r); }
                *(u32x4*)(H + (size_t)row * DE + c0) = pack8(o0, o1);
            }
    }
};
struct EpiMoe2 {
    bf16_t* Y; const int* slot_a; const float* slot_gate;
    __device__ __forceinline__ void operator()(const f32x4 (&acc)[2][2][4][2], const Unit& u, int wr, int wc, int fr, int fq) const {
        int av[2][4]; float gv[2][4];
#pragma unroll
        for (int ai = 0; ai < 2; ++ai)
#pragma unroll
            for (int m = 0; m < 4; ++m) { const int row = u.pm * BM + ai * HALF + wr * 64 + m * 16 + fr; av[ai][m] = slot_a[row]; gv[ai][m] = slot_gate[row]; }
        __builtin_amdgcn_sched_barrier(0);
#pragma unroll
        for (int ai = 0; ai < 2; ++ai)
#pragma unroll
            for (int m = 0; m < 4; ++m) {
                const int a = av[ai][m]; const float g = gv[ai][m];
                if (a >= 0) {
#pragma unroll
                    for (int bj = 0; bj < 2; ++bj) { const int c0 = u.pn * BM + bj * HALF + wc * 32 + 8 * fq;
                        *(u32x4*)(Y + (size_t)a * D + c0) = pack8(acc[ai][bj][m][0] * g, acc[ai][bj][m][1] * g); }
                }
            }
    }
};

struct GlaInSched {
    const bf16_t* XB; const bf16_t* WTM; const bf16_t* WFM;
    __device__ __forceinline__ int lda(const Unit&) const { return D; }
    __device__ __forceinline__ int ldb(const Unit&) const { return D; }
    __device__ __forceinline__ int nt(const Unit&) const { return D / BK; }
    __device__ __forceinline__ bool cont(const Unit&) const { return false; }
    __device__ __forceinline__ bool next(int i, Unit& u) const {
        const int c = blockIdx.x, per = gridDim.x >> 3, x = c & 7, j = c >> 3, lu = i * per + j;
        if (lu >= 224) return false;
        const int un = x * 224 + lu;
        if (un < 1024) { u.e = 0; u.pm = un >> 3; u.pn = un & 7; } else { const int v = un - 1024; u.e = 1; u.pn = v / 6; u.pm = v - u.pn * 6; }
        return true; }
    __device__ __forceinline__ const char* a_base(const Unit& u) const { return u.e ? (const char*)WFM : (const char*)XB; }
    __device__ __forceinline__ int a_row(const Unit& u, int r) const { return u.pm * BM + r; }
    __device__ __forceinline__ int a_col(const Unit&) const { return 0; }
    __device__ __forceinline__ const char* b_base(const Unit& u) const { return u.e ? (const char*)(XB + (size_t)u.pn * BM * D) : (const char*)(WTM + (size_t)u.pn * BM * D); }
};

struct EpiGlaIn {
    bf16_t* QKR; bf16_t* KVT; const float* RS; const bf16_t* EQ; const bf16_t* EKF;
    __device__ __forceinline__ void operator()(const f32x4 (&acc)[2][2][4][2], const Unit& u, int wr, int wc, int fr, int fq) const {
        if (u.e == 0) {
            float rv[2][4];
#pragma unroll
            for (int ai = 0; ai < 2; ++ai)
#pragma unroll
                for (int m = 0; m < 4; ++m) rv[ai][m] = RS[u.pm * BM + ai * HALF + wr * 64 + m * 16 + fr];
            const float qs = u.pn < 2 ? 0.08838834764831845f : 1.0f;
            const bf16_t* F = EQ + (u.pn < 2 ? (size_t)0 : (size_t)T * 512);
#pragma unroll
            for (int ai = 0; ai < 2; ++ai) {
                u32x4 fv[4][2];
                if (u.pn < 4) {
#pragma unroll
                    for (int m = 0; m < 4; ++m)
#pragma unroll
                        for (int bj = 0; bj < 2; ++bj) { const int row = u.pm * BM + ai * HALF + wr * 64 + m * 16 + fr, kf = (u.pn * BM + bj * HALF + wc * 32 + 8 * fq) & 511;
                            fv[m][bj] = *(const u32x4*)(F + (size_t)row * 512 + kf); }
                }
                __builtin_amdgcn_sched_barrier(0);
#pragma unroll
                for (int m = 0; m < 4; ++m) {
                    const int row = u.pm * BM + ai * HALF + wr * 64 + m * 16 + fr; const float r = rv[ai][m] * qs;
#pragma unroll
                    for (int bj = 0; bj < 2; ++bj) { const int c0 = u.pn * BM + bj * HALF + wc * 32 + 8 * fq;
                        f32x4 s0 = (f32x4){r, r, r, r}, s1 = s0;
                        if (u.pn < 4) { const u32x4 w = fv[m][bj];
                            s0 *= (f32x4){bf_lo(w.x), bf_hi(w.x), bf_lo(w.y), bf_hi(w.y)}; s1 *= (f32x4){bf_lo(w.z), bf_hi(w.z), bf_lo(w.w), bf_hi(w.w)}; }
                        *(u32x4*)(QKR + (size_t)row * 2048 + c0) = pack8(acc[ai][bj][m][0] * s0, acc[ai][bj][m][1] * s1); }
                }
                __builtin_amdgcn_sched_barrier(0);
            }
        } else {
#pragma unroll
            for (int bj = 0; bj < 2; ++bj) { const int t0 = u.pn * BM + bj * HALF + wc * 32 + 8 * fq;
                const f32x4 r0 = *(const f32x4*)(RS + t0), r1 = *(const f32x4*)(RS + t0 + 4);
                u32x4 fv[2][4];
                if (u.pm < 2) {
#pragma unroll
                    for (int ai = 0; ai < 2; ++ai)
#pragma unroll
                        for (int m = 0; m < 4; ++m) fv[ai][m] = *(const u32x4*)(EKF + (size_t)(u.pm * BM + ai * HALF + wr * 64 + m * 16 + fr) * T + t0);
                }
                __builtin_amdgcn_sched_barrier(0);
#pragma unroll
                for (int ai = 0; ai < 2; ++ai)
#pragma unroll
                    for (int m = 0; m < 4; ++m) { const int f = u.pm * BM + ai * HALF + wr * 64 + m * 16 + fr;
                        f32x4 s0 = r0, s1 = r1;
                        if (u.pm < 2) { const u32x4 w = fv[ai][m];
                            s0 *= (f32x4){bf_lo(w.x), bf_hi(w.x), bf_lo(w.y), bf_hi(w.y)}; s1 *= (f32x4){bf_lo(w.z), bf_hi(w.z), bf_lo(w.w), bf_hi(w.w)}; }
                        *(u32x4*)(KVT + (size_t)f * T + t0) = pack8(acc[ai][bj][m][0] * s0, acc[ai][bj][m][1] * s1); }
                __builtin_amdgcn_sched_barrier(0);
            }
        }
    }
};
template <int TYP> struct GlaAttSched {
    const bf16_t* QKR; const bf16_t* KVT;
    __device__ __forceinline__ bool next(int i, Unit& u) const {
        const int c = blockIdx.x, per = gridDim.x >> 3, x = c & 7, j = c >> 3, lu = i * per + j;
        if (lu >= 64) return false;
        const int un = x * 64 + lu, bh = un >> 5, cc = un & 31;
        u.e = TYP; u.pm = (bh >> 2) * 32 + cc; u.pn = bh & 3; return true; }
    __device__ __forceinline__ int lda(const Unit& u) const { return TYP ? T : 2048; }
    __device__ __forceinline__ int ldb(const Unit& u) const { return TYP ? T : 2048; }
    __device__ __forceinline__ int nt(const Unit& u) const { int n = TYP ? 4 : 2; asm volatile("" : "+s"(n)); return n; }
    __device__ __forceinline__ bool cont(const Unit&) const { return false; }
    __device__ __forceinline__ const char* a_base(const Unit& u) const { return TYP ? (const char*)KVT : (const char*)QKR; }
    __device__ __forceinline__ int a_row(const Unit& u, int r) const { return TYP ? 512 + u.pn * 256 + r : u.pm * BM + r; }
    __device__ __forceinline__ int a_col(const Unit& u) const { return TYP ? u.pm * BM : u.pn * 128; }
    __device__ __forceinline__ const char* b_base(const Unit& u) const {
        return TYP ? (const char*)(KVT + (size_t)(u.pn * 128) * T + (size_t)u.pm * BM) : (const char*)(QKR + (size_t)u.pm * BM * 2048 + 512 + u.pn * 128); }
};
template <int TYP> struct EpiGlaAtt {
    bf16_t* ATT; bf16_t* UT; const float* DL;
    __device__ __forceinline__ void operator()(const f32x4 (&acc)[2][2][4][2], const Unit& u, int wr, int wc, int fr, int fq) const {
        if (TYP == 0) {
#pragma unroll
            for (int ai = 0; ai < 2; ++ai)
#pragma unroll
                for (int m = 0; m < 4; ++m) { const int rit = ai * HALF + wr * 64 + m * 16 + fr;
#pragma unroll
                    for (int bj = 0; bj < 2; ++bj) { const int c0 = bj * HALF + wc * 32 + 8 * fq;
                        f32x4 v0 = acc[ai][bj][m][0], v1 = acc[ai][bj][m][1];
#pragma unroll
                        for (int j = 0; j < 4; ++j) { if (c0 + j > rit) v0[j] = 0.f; if (c0 + 4 + j > rit) v1[j] = 0.f; }
                        *(u32x4*)(ATT + (size_t)(u.pm * BM + rit) * D + u.pn * 256 + c0) = pack8(v0, v1); }
                }
        } else {
            const int k0 = wc * 32 + 8 * fq;
            const f32x4 d0 = *(const f32x4*)(DL + (size_t)u.pm * 512 + u.pn * 128 + k0), d1 = *(const f32x4*)(DL + (size_t)u.pm * 512 + u.pn * 128 + k0 + 4);
            const int b = u.pm >> 5, cc = u.pm & 31; bf16_t* base = UT + (size_t)((b * 4 + u.pn) * 32 + cc) * 32768;
#pragma unroll
            for (int ai = 0; ai < 2; ++ai)
#pragma unroll
                for (int m = 0; m < 4; ++m) { const int dv = ai * HALF + wr * 64 + m * 16 + fr;
                    *(u32x4*)(base + (size_t)dv * 128 + k0) = pack8(acc[ai][0][m][0] * d0, acc[ai][0][m][1] * d1); }
        }
    }
};
struct GlaOSched {
    const bf16_t* QKR; const bf16_t* KVT; const bf16_t* ATT; const bf16_t* SP;
    __device__ __forceinline__ bool next(int i, Unit& u) const {
        const int c = blockIdx.x, per = gridDim.x >> 3, x = c & 7, j = c >> 3, pl = (i >> 1) * per + j;
        if (pl >= 64) return false;
        const int w = x * 64 + pl, bh = w >> 5, cc = w & 31;
        u.e = i & 1; u.pm = (bh >> 2) * 32 + cc; u.pn = bh & 3; return true; }
    __device__ __forceinline__ int lda(const Unit& u) const { return u.e ? D : 2048; }
    __device__ __forceinline__ int ldb(const Unit& u) const { return u.e ? T : 128; }
    __device__ __forceinline__ int nt(const Unit& u) const { return u.e ? 4 : 2; }
    __device__ __forceinline__ bool cont(const Unit& u) const { return u.e == 0; }
    __device__ __forceinline__ const char* a_base(const Unit& u) const { return u.e ? (const char*)ATT : (const char*)QKR; }
    __device__ __forceinline__ int a_row(const Unit& u, int r) const { return u.pm * BM + r; }
    __device__ __forceinline__ int a_col(const Unit& u) const { return u.e ? u.pn * 256 : u.pn * 128; }
    __device__ __forceinline__ const char* b_base(const Unit& u) const { const int b = u.pm >> 5, cc = u.pm & 31;
        return u.e ? (const char*)(KVT + (size_t)(512 + u.pn * 256) * T + (size_t)u.pm * BM) : (const char*)(SP + (size_t)((b * 4 + u.pn) * 32 + cc) * 32768); }
};
struct EpiGlaO {
    bf16_t* O;
    __device__ __forceinline__ void operator()(const f32x4 (&acc)[2][2][4][2], const Unit& u, int wr, int wc, int fr, int fq) const {
#pragma unroll
        for (int ai = 0; ai < 2; ++ai)
#pragma unroll
            for (int m = 0; m < 4; ++m) { const int row = u.pm * BM + ai * HALF + wr * 64 + m * 16 + fr;
#pragma unroll
                for (int bj = 0; bj < 2; ++bj) { const int c0 = u.pn * 256 + bj * HALF + wc * 32 + 8 * fq;
                    *(u32x4*)(O + (size_t)row * D + c0) = pack8(acc[ai][bj][m][0], acc[ai][bj][m][1]); } }
    }
};
}

struct CvtJob { const float* W; int ldw, col0, K; const float* g; bf16_t* Bt; int il, half, nblk; };
__device__ __forceinline__ void cvt_load(const CvtJob& j, int item, int lane, f32x4 (&v)[8]) {
    const int kb = item / j.nblk, nb = item - kb * j.nblk, k0 = 64 * kb, n0 = 32 * nb;
    const float* p = j.W + (size_t)(k0 + (lane >> 3)) * j.ldw + j.col0 + n0 + 4 * (lane & 7);
#pragma unroll
    for (int i = 0; i < 8; ++i) v[i] = *(const f32x4*)(p + (size_t)(8 * i) * j.ldw);
    if (j.g) {
#pragma unroll
        for (int i = 0; i < 8; ++i) v[i] *= j.g[k0 + 8 * i + (lane >> 3)]; }
}
__device__ __forceinline__ void cvt_store(const CvtJob& j, int item, int lane, LAS float* scr, const f32x4 (&v)[8]) {
    const int kb = item / j.nblk, nb = item - kb * j.nblk, k0 = 64 * kb, n0 = 32 * nb;
#pragma unroll
    for (int i = 0; i < 8; ++i) { LAS float* d = scr + (8 * i + (lane >> 3)) * 33 + 4 * (lane & 7); d[0] = v[i][0]; d[1] = v[i][1]; d[2] = v[i][2]; d[3] = v[i][3]; }
    asm volatile("s_waitcnt lgkmcnt(0)" ::: "memory");
    const int c = lane & 7;
#pragma unroll
    for (int q = 0; q < 4; ++q) { const int n = (lane >> 3) + 8 * q; const LAS float* s = scr + (8 * c) * 33 + n;
        u32x4 o; o.x = cvt_pk_bf16(s[0 * 33], s[1 * 33]); o.y = cvt_pk_bf16(s[2 * 33], s[3 * 33]); o.z = cvt_pk_bf16(s[4 * 33], s[5 * 33]); o.w = cvt_pk_bf16(s[6 * 33], s[7 * 33]);
        const int nn = n0 + n, drow = j.il ? ((nn >> 7) * 256 + j.half * 128 + (nn & 127)) : nn;
        *(u32x4*)(j.Bt + (size_t)drow * j.K + k0 + 8 * c) = o; }
    asm volatile("s_waitcnt lgkmcnt(0)" ::: "memory");
}
__device__ __forceinline__ void cvt_matrix(const float* W, int ldw, int col0, int ncols, int K, const float* g, bf16_t* Bt, int il, int half, LAS unsigned char* lds, int woff = 0) {
    const int tix = otid();
    const int lane = tix & 63, wv = tix >> 6;
    LAS float* scr = (LAS float*)(lds + wv * 8704);
    const int ngw = gridDim.x * 8; int gw = blockIdx.x * 8 + wv - (woff % ngw); if (gw < 0) gw += ngw;
    const CvtJob j{W, ldw, col0, K, g, Bt, il, half, ncols / 32};
    const int nitems = (K / 64) * j.nblk;
    f32x4 cur[8], nxt[8];
    int it = gw; if (it < nitems) cvt_load(j, it, lane, cur);
    for (; it < nitems; it += ngw) {
        const int itn = it + ngw; if (itn < nitems) cvt_load(j, itn, lane, nxt);
        cvt_store(j, it, lane, scr, cur);
#pragma unroll
        for (int i = 0; i < 8; ++i) cur[i] = nxt[i];
    }
}
__device__ __forceinline__ void rows_prep(const float* x, bf16_t* XB, float* rs, float* ssp, int rows) {
    const int tix = otid();
    const int lane = tix & 63;
    const int gw = (blockIdx.x * blockDim.x + tix) >> 6, ngw = (gridDim.x * blockDim.x) >> 6;
    for (int r = gw; r < rows; r += ngw) {
        const f32x4* xr = (const f32x4*)(x + (size_t)r * D);
        f32x4 v[4]; float s = 0.f;
#pragma unroll
        for (int j = 0; j < 4; ++j) { v[j] = xr[lane + 64 * j]; s += (v[j][0] * v[j][0] + v[j][1] * v[j][1]) + (v[j][2] * v[j][2] + v[j][3] * v[j][3]); }
        s = wave_sum(s);
        if (lane == 0) rs[r] = rsqrtf(s * (1.0f / D) + EPS);
        if (ssp && lane < 16) ssp[(size_t)r * 16 + lane] = lane == 0 ? s : 0.f;
        u32x2* o = (u32x2*)(XB + (size_t)r * D);
#pragma unroll
        for (int j = 0; j < 4; ++j) { u32x2 w; w.x = cvt_pk_bf16(v[j][0], v[j][1]); w.y = cvt_pk_bf16(v[j][2], v[j][3]); o[lane + 64 * j] = w; }
    }
}

__device__ __forceinline__ void rows_norm_bf16(const float* x, const float* g, bf16_t* out, int rows) {
    const int tix = otid();
    const int lane = tix & 63;
    const int gw = (blockIdx.x * blockDim.x + tix) >> 6, ngw = (gridDim.x * blockDim.x) >> 6;
    for (int r = gw; r < rows; r += ngw) {
        const f32x4* xr = (const f32x4*)(x + (size_t)r * D);
        f32x4 v[4]; float s = 0.f;
#pragma unroll
        for (int j = 0; j < 4; ++j) { v[j] = xr[lane + 64 * j]; s += (v[j][0] * v[j][0] + v[j][1] * v[j][1]) + (v[j][2] * v[j][2] + v[j][3] * v[j][3]); }
        s = wave_sum(s); const float rs = rsqrtf(s * (1.0f / D) + EPS);
        u32x2* o = (u32x2*)(out + (size_t)r * D);
#pragma unroll
        for (int j = 0; j < 4; ++j) { const f32x4 gg = ((const f32x4*)g)[lane + 64 * j]; u32x2 w; w.x = cvt_pk_bf16(v[j][0] * rs * gg[0], v[j][1] * rs * gg[1]); w.y = cvt_pk_bf16(v[j][2] * rs * gg[2], v[j][3] * rs * gg[3]); o[lane + 64 * j] = w; }
    }
}

__device__ __forceinline__ void route_prep(const float* wg, const float* we, const float* gain, float* WR) {
    const int tix = otid();
    const int gi = blockIdx.x * blockDim.x + tix, gs = gridDim.x * blockDim.x;
    for (int i = gi; i < 36 * 1024; i += gs) { const int j = i >> 10, k = i & 1023; WR[i] = (j < 32 ? we[k * NE + j] : wg[k * NG + (j - 32)]) * gain[k]; }
}
__device__ __forceinline__ float reduce16(float (&v)[18], int lane) {
#pragma unroll
    for (int st = 0; st < 4; ++st) { const int half = 8 >> st, bit = 32 >> st; const bool up = (lane & bit) != 0;
#pragma unroll
        for (int k = 0; k < half; ++k) { const float send = up ? v[k] : v[k + half]; const float keep = up ? v[k + half] : v[k]; v[k] = keep + __shfl_xor(send, bit); } }
    float r = v[0]; r += __shfl_xor(r, 2); r += __shfl_xor(r, 1); return r;
}
__device__ __forceinline__ float reduce2(const float (&v)[18], int lane) {
    const bool up = (lane & 32) != 0; const float send = up ? v[16] : v[17], keep = up ? v[17] : v[16];
    float r = keep + __shfl_xor(send, 32);
#pragma unroll
    for (int o = 16; o >= 1; o >>= 1) r += __shfl_xor(r, o);
    return r;
}
__device__ __forceinline__ void route_phase(const bf16_t* X, const float* WR, const float* bg, const float* be, float* RS, int* assign_e, int* assign_pos, float* gate, int* gcnt, LAS unsigned char* lds) {
    int tid_ = threadIdx.x; asm volatile("" : "+v"(tid_)); const int tid = tid_, lane = tid & 63, wv = tid >> 6;
    LAS float* Wr = (LAS float*)lds;
    LAS int* lcnt = (LAS int*)(lds + 36 * 4096); LAS int* lbase = lcnt + 32; LAS int* l_e = lbase + 32; LAS int* l_rank = l_e + 256;
    LAS float* lg = (LAS float*)(lds + 36 * 4096 + 2304) + wv * (8 * 37);
    for (int i = tid; i < 36 * 256; i += 512) ((LAS f32x4*)Wr)[i] = ((const f32x4*)WR)[i];
    for (int tb = blockIdx.x; tb < T / 128; tb += gridDim.x) {
        if (tid < 32) lcnt[tid] = 0;
        __syncthreads();
        u32x2 nx[2][4];
#pragma unroll
        for (int r = 0; r < 2; ++r)
#pragma unroll
            for (int c = 0; c < 4; ++c) nx[r][c] = *(const u32x2*)(X + (size_t)(tb * 128 + wv * 16 + r) * D + 256 * c + 4 * lane);
#pragma unroll 1
        for (int hf = 0; hf < 2; ++hf) {
#pragma unroll 1
            for (int it = 0; it < 4; ++it) {
                const int tl0 = wv * 16 + hf * 8 + it * 2, t0 = tb * 128 + tl0;
                f32x4 xv[2][4]; float rsv[2];
#pragma unroll
                for (int r = 0; r < 2; ++r) { float s = 0.f;
#pragma unroll
                    for (int c = 0; c < 4; ++c) { const u32x2 xw = nx[r][c]; xv[r][c] = (f32x4){bf_lo(xw.x), bf_hi(xw.x), bf_lo(xw.y), bf_hi(xw.y)}; s += (xv[r][c][0] * xv[r][c][0] + xv[r][c][1] * xv[r][c][1]) + (xv[r][c][2] * xv[r][c][2] + xv[r][c][3] * xv[r][c][3]); }
                    rsv[r] = rsqrtf(wave_sum(s) * (1.0f / D) + EPS); }
                if (hf * 4 + it < 7) {
#pragma unroll
                    for (int r = 0; r < 2; ++r)
#pragma unroll
                        for (int c = 0; c < 4; ++c) nx[r][c] = *(const u32x2*)(X + (size_t)(t0 + 2 + r) * D + 256 * c + 4 * lane);
                }
                float acc[2][36];
#pragma unroll
                for (int r = 0; r < 2; ++r)
#pragma unroll
                    for (int j = 0; j < 36; ++j) acc[r][j] = 0.f;
                unsigned b0_ = (unsigned)(16 * lane), b1_ = (unsigned)(16 * 4096 + 16 * lane), b2_ = (unsigned)(32 * 4096 + 16 * lane);
                asm volatile("" : "+v"(b0_)); asm volatile("" : "+v"(b1_)); asm volatile("" : "+v"(b2_));
#pragma unroll
                for (int j = 0; j < 36; ++j) {
#pragma unroll
                    for (int c = 0; c < 4; ++c) {
                        const f32x4 w4 = j < 16 ? *(const LAS f32x4*)(lds + b0_ + j * 4096 + c * 1024) : (j < 32 ? *(const LAS f32x4*)(lds + b1_ + (j - 16) * 4096 + c * 1024) : *(const LAS f32x4*)(lds + b2_ + (j - 32) * 4096 + c * 1024));
#pragma unroll
                        for (int r = 0; r < 2; ++r) acc[r][j] = fmaf(xv[r][c][3], w4[3], fmaf(xv[r][c][2], w4[2], fmaf(xv[r][c][1], w4[1], fmaf(xv[r][c][0], w4[0], acc[r][j])))); }
                    if (j % 3 == 2) __builtin_amdgcn_sched_barrier(0);
                }
#pragma unroll
                for (int st = 0; st < 5; ++st) { const int half = 16 >> st, bit = 32 >> st; const bool up = (lane & bit) != 0;
#pragma unroll
                    for (int r = 0; r < 2; ++r)
#pragma unroll
                        for (int k = 0; k < half; ++k) { const float send = up ? acc[r][k] : acc[r][k + half]; const float keep = up ? acc[r][k + half] : acc[r][k]; acc[r][k] = keep + __shfl_xor(send, bit); } }
#pragma unroll
                for (int st = 0; st < 2; ++st) { const int half = 2 >> st, bit = 32 >> st; const bool up = (lane & bit) != 0;
#pragma unroll
                    for (int r = 0; r < 2; ++r)
#pragma unroll
                        for (int k = 0; k < half; ++k) { const float send = up ? acc[r][32 + k] : acc[r][32 + k + half]; const float keep = up ? acc[r][32 + k + half] : acc[r][32 + k]; acc[r][32 + k] = keep + __shfl_xor(send, bit); } }
#pragma unroll
                for (int r = 0; r < 2; ++r) {
                    float e = acc[r][0]; e += __shfl_xor(e, 1);
                    float g = acc[r][32]; g += __shfl_xor(g, 8); g += __shfl_xor(g, 4); g += __shfl_xor(g, 2); g += __shfl_xor(g, 1);
                    LAS float* L = lg + (it * 2 + r) * 37;
                    if ((lane & 1) == 0) L[lane >> 1] = e;
                    if ((lane & 15) == 0) L[32 + (lane >> 4)] = g;
                    if (lane == 0) L[36] = rsv[r];
                }
            }
            asm volatile("s_waitcnt lgkmcnt(0)" ::: "memory");
            {
                const int r = lane & 7; const LAS float* L = lg + r * 37;
                const float rs = L[36];
                float gl[4];
#pragma unroll
                for (int g = 0; g < 4; ++g) gl[g] = L[32 + g] * rs + bg[g];
                int gs = 0; float gm = gl[0];
#pragma unroll
                for (int g = 1; g < 4; ++g) if (gl[g] > gm) { gm = gl[g]; gs = g; }
                float se = 0.f;
#pragma unroll
                for (int g = 0; g < 4; ++g) se += expf(gl[g] - gm);
                const float pg = 1.0f / se;
                float el[8];
#pragma unroll
                for (int i = 0; i < 8; ++i) el[i] = L[gs * 8 + i] * rs + be[gs * 8 + i];
                float em = el[0];
#pragma unroll
                for (int i = 1; i < 8; ++i) em = fmaxf(em, el[i]);
                float pe[8], ps = 0.f;
#pragma unroll
                for (int i = 0; i < 8; ++i) { pe[i] = expf(el[i] - em); ps += pe[i]; }
#pragma unroll
                for (int i = 0; i < 8; ++i) pe[i] = pe[i] / ps;
                int i1 = 0; float p1 = pe[0];
#pragma unroll
                for (int i = 1; i < 8; ++i) if (pe[i] > p1) { p1 = pe[i]; i1 = i; }
                int i2 = -1; float p2 = -1.f;
#pragma unroll
                for (int i = 0; i < 8; ++i) if (i != i1 && pe[i] > p2) { p2 = pe[i]; i2 = i; }
                if (lane < 8) {
                    if (i2 < 0) i2 = i1 == 0 ? 1 : 0;
                    const int tl = wv * 16 + hf * 8 + r, t = tb * 128 + tl; const float den = p1 + p2; const int e1 = gs * 8 + i1, e2 = gs * 8 + i2;
                    RS[t] = rs; gate[2 * t] = pg * p1 / den; gate[2 * t + 1] = pg * p2 / den;
                    l_e[2 * tl] = e1; l_e[2 * tl + 1] = e2;
                    l_rank[2 * tl] = atomicAdd((int*)(lcnt + e1), 1); l_rank[2 * tl + 1] = atomicAdd((int*)(lcnt + e2), 1);
                }
            }
            asm volatile("s_waitcnt lgkmcnt(0)" ::: "memory");
        }
        __syncthreads();
        if (tid < 32) lbase[tid] = __hip_atomic_fetch_add(gcnt + tid, lcnt[tid], __ATOMIC_RELAXED, __HIP_MEMORY_SCOPE_AGENT);
        __syncthreads();
        if (tid < 256) { const int a = tb * 256 + tid, e = l_e[tid]; assign_e[a] = e; assign_pos[a] = lbase[e] + l_rank[tid]; }
        __syncthreads();
    }
}
__device__ __forceinline__ void build_phase(const int* gcnt, const int* assign_e, const int* assign_pos, const float* gate, const float* RS,
                                            int* ntiles, int* tile_e, int* slot_tok, int* slot_a, float* slot_rs, float* slot_gate, LAS unsigned char* lds) {
    const int tix = otid();
    LAS int* poff = (LAS int*)lds; LAS int* cn = poff + 40;
    if (tix == 0) { int o = 0; for (int e = 0; e < 32; ++e) { const int cc = g8::ld_agent(gcnt + e); cn[e] = cc; poff[e] = o; o += (cc + 255) / 256 * 256; } poff[32] = o; }
    __syncthreads();
    const int gi = blockIdx.x * blockDim.x + tix, gs = gridDim.x * blockDim.x;
    for (int a = gi; a < NA; a += gs) { const int e = assign_e[a]; const int sl = poff[e] + assign_pos[a]; slot_tok[sl] = a >> 1; slot_a[sl] = a; slot_rs[sl] = RS[a >> 1]; slot_gate[sl] = gate[a]; }
    for (int i = gi; i < 32 * 256; i += gs) { const int e = i >> 8, sl = poff[e] + cn[e] + (i & 255); if (sl < poff[e + 1]) { slot_tok[sl] = 0; slot_a[sl] = -1; slot_rs[sl] = 0.f; slot_gate[sl] = 0.f; } }
    if (blockIdx.x == 0) {
        const int NT = poff[32] >> 8;
        for (int rt = tix; rt < NT; rt += blockDim.x) { int e = 0; for (int k = 0; k < 32; ++k) if (rt * 256 >= poff[k] && rt * 256 < poff[k + 1]) e = k; tile_e[rt] = e; }
        if (tix == 0) *ntiles = NT;
    }
    __syncthreads();
}
__device__ __forceinline__ CvtJob moe_job(const float* wgate, const float* wup, const float* wdown, const float* gain, bf16_t* W1, bf16_t* W2, int it, int& item) {
    const int e = it / 768, r = it - e * 768;
    if (r < 256) { item = r; return CvtJob{wgate + (size_t)e * D * DE, DE, 0, D, gain, W1 + (size_t)e * D * D, 1, 0, 16}; }
    if (r < 512) { item = r - 256; return CvtJob{wup + (size_t)e * D * DE, DE, 0, D, gain, W1 + (size_t)e * D * D, 1, 1, 16}; }
    item = r - 512; return CvtJob{wdown + (size_t)e * DE * D, D, 0, DE, nullptr, W2 + (size_t)e * D * DE, 0, 0, 32};
}
__device__ __forceinline__ void cvt_moe(const float* wgate, const float* wup, const float* wdown, const float* gain, bf16_t* W1, bf16_t* W2, LAS unsigned char* lds, int skip_blocks) {
    const int tix = otid();
    const int lane = tix & 63, wv = tix >> 6;
    LAS float* scr = (LAS float*)(lds + 1024 + wv * 8704);
    if ((int)blockIdx.x < skip_blocks) return;
    const int gw = ((int)blockIdx.x - skip_blocks) * 8 + wv, ngw = ((int)gridDim.x - skip_blocks) * 8;
    f32x4 cur[8], nxt[8]; int item = 0, itemn = 0;
    int it = gw; CvtJob j = moe_job(wgate, wup, wdown, gain, W1, W2, it < 32 * 768 ? it : 0, item);
    if (it < 32 * 768) cvt_load(j, item, lane, cur);
    for (; it < 32 * 768; it += ngw) {
        const int itn = it + ngw; CvtJob jn = j;
        if (itn < 32 * 768) { jn = moe_job(wgate, wup, wdown, gain, W1, W2, itn, itemn); cvt_load(jn, itemn, lane, nxt); }
        cvt_store(j, item, lane, scr, cur);
        j = jn; item = itemn;
#pragma unroll
        for (int i = 0; i < 8; ++i) cur[i] = nxt[i];
    }
}
__device__ __forceinline__ void combine_phase(float* X, float* Xo, const bf16_t* Y, bf16_t* XB, float* RS, float* ssp, const float* gfinal, int fin, const float* WA, float* ALR, LAS unsigned char* lds) {
    const int tix = otid();
    const int lane = tix & 63;
    if (WA) { for (int i = tix; i < 16 * 256; i += 512) ((LAS f32x4*)lds)[i] = ((const f32x4*)WA)[i]; __syncthreads(); }
    const int gw = (blockIdx.x * blockDim.x + tix) >> 6, ngw = (gridDim.x * blockDim.x) >> 6;
    for (int tb = gw; tb < T; tb += 2 * ngw) {
        f32x4 v[2][4]; u32x2 ya[2][4], yb[2][4];
#pragma unroll
        for (int rr = 0; rr < 2; ++rr) { const int t = tb + rr * ngw;
#pragma unroll
            for (int j = 0; j < 4; ++j) { const u32x2 xw = ((const u32x2*)(XB + (size_t)t * D))[lane + 64 * j]; v[rr][j] = (f32x4){bf_lo(xw.x), bf_hi(xw.x), bf_lo(xw.y), bf_hi(xw.y)};
                ya[rr][j] = ((const u32x2*)(Y + (size_t)(2 * t) * D))[lane + 64 * j]; yb[rr][j] = ((const u32x2*)(Y + (size_t)(2 * t + 1) * D))[lane + 64 * j]; } }
        __builtin_amdgcn_sched_barrier(0);
#pragma unroll
        for (int rr = 0; rr < 2; ++rr) { const int t = tb + rr * ngw; float s = 0.f;
#pragma unroll
            for (int j = 0; j < 4; ++j) {
                v[rr][j][0] += bf_lo(ya[rr][j].x) + bf_lo(yb[rr][j].x); v[rr][j][1] += bf_hi(ya[rr][j].x) + bf_hi(yb[rr][j].x);
                v[rr][j][2] += bf_lo(ya[rr][j].y) + bf_lo(yb[rr][j].y); v[rr][j][3] += bf_hi(ya[rr][j].y) + bf_hi(yb[rr][j].y);
                if (!fin) { const unsigned w0 = cvt_pk_bf16(v[rr][j][0], v[rr][j][1]), w1 = cvt_pk_bf16(v[rr][j][2], v[rr][j][3]); v[rr][j] = (f32x4){bf_lo(w0), bf_hi(w0), bf_lo(w1), bf_hi(w1)}; }
                s += (v[rr][j][0] * v[rr][j][0] + v[rr][j][1] * v[rr][j][1]) + (v[rr][j][2] * v[rr][j][2] + v[rr][j][3] * v[rr][j][3]); }
            s = wave_sum(s); const float rs = rsqrtf(s * (1.0f / D) + EPS);
            if (fin) {
#pragma unroll
                for (int j = 0; j < 4; ++j) { const f32x4 gg = ((const f32x4*)gfinal)[lane + 64 * j]; ((f32x4*)(Xo + (size_t)t * D))[lane + 64 * j] = v[rr][j] * rs * gg; }
            } else {
                if (lane == 0) RS[t] = rs;
                if (lane < 16) ssp[(size_t)t * 16 + lane] = lane == 0 ? s : 0.f;
                if (WA) {
                    float a16[18];
#pragma unroll
                    for (int o = 0; o < 16; ++o) { float p = 0.f;
#pragma unroll
                        for (int j = 0; j < 4; ++j) { const f32x4 w4 = *(const LAS f32x4*)(lds + (o * 1024 + 256 * j + 4 * lane) * 4);
                            p = fmaf(v[rr][j][3], w4[3], fmaf(v[rr][j][2], w4[2], fmaf(v[rr][j][1], w4[1], fmaf(v[rr][j][0], w4[0], p)))); }
                        a16[o] = p; if ((o & 3) == 3) __builtin_amdgcn_sched_barrier(0); }
                    a16[16] = 0.f; a16[17] = 0.f;
                    const float red = reduce16(a16, lane);
                    if ((lane & 3) == 0) ALR[(size_t)t * 16 + (lane >> 2)] = red * rs;
                }
#pragma unroll
                for (int j = 0; j < 4; ++j) { u32x2 w; w.x = cvt_pk_bf16(v[rr][j][0], v[rr][j][1]); w.y = cvt_pk_bf16(v[rr][j][2], v[rr][j][3]); ((u32x2*)(XB + (size_t)t * D))[lane + 64 * j] = w; }
            }
        }
    }
}

__device__ __forceinline__ float fexp2(float x) { return __builtin_amdgcn_exp2f(x * 1.4426950408889634f); }
__device__ __forceinline__ void gla_prep(const float* win, const float* wo, const float* gain, bf16_t* WGTM, bf16_t* WGFM, bf16_t* WGO, float* WA, LAS unsigned char* lds) {
    cvt_matrix(win, GLA_COLS, 0, 512, D, gain, WGTM, 0, 0, lds);
    cvt_matrix(win, GLA_COLS, 512, 512, D, gain, WGTM + (size_t)512 * D, 0, 0, lds, 256);
    cvt_matrix(win, GLA_COLS, 2064, 1024, D, gain, WGTM + (size_t)1024 * D, 0, 0, lds, 512);
    cvt_matrix(win, GLA_COLS, 512, 512, D, gain, WGFM, 0, 0, lds, 1024);
    cvt_matrix(win, GLA_COLS, 1024, 1024, D, gain, WGFM + (size_t)512 * D, 0, 0, lds, 1280);
    cvt_matrix(wo, D, 0, D, D, nullptr, WGO, 0, 0, lds, 1792);
    const int tix = otid(); const int gi = blockIdx.x * blockDim.x + tix, gs = gridDim.x * blockDim.x;
    for (int i = gi; i < 16 * 1024; i += gs) { const int j = i >> 10, k = i & 1023; WA[i] = win[(size_t)k * GLA_COLS + 2048 + j] * gain[k]; }
}
__device__ __forceinline__ void gla_decay(const float* ALR, const float* wa2, const float* ba, float* BTM, float* BFM, float* DL, LAS unsigned char* lds) {
    const int tix = otid();
    LAS float* tile = (LAS float*)lds;
    LAS float* wsl = tile + 256 * 65;
    LAS float* seg = wsl + 16 * 64;
    for (int item = blockIdx.x; item < 128 * 8; item += gridDim.x) {
        const int ch = item >> 3, kf0 = (item & 7) * 64, t0 = ch * 256;
        for (int i = tix; i < 16 * 64; i += 512) wsl[i] = wa2[(i >> 6) * GDK + kf0 + (i & 63)];
        __syncthreads();
        {
            const int t = tix >> 1, kh = (tix & 1) * 32;
            const f32x4 a0 = *(const f32x4*)(ALR + (size_t)(t0 + t) * 16), a1 = *(const f32x4*)(ALR + (size_t)(t0 + t) * 16 + 4), a2 = *(const f32x4*)(ALR + (size_t)(t0 + t) * 16 + 8), a3 = *(const f32x4*)(ALR + (size_t)(t0 + t) * 16 + 12);
#pragma unroll 4
            for (int k = 0; k < 32; ++k) {
                const int kf = kh + k; float z = ba[kf0 + kf];
#pragma unroll
                for (int r = 0; r < 4; ++r) { z = fmaf(a0[r], wsl[r * 64 + kf], z); z = fmaf(a1[r], wsl[(4 + r) * 64 + kf], z); z = fmaf(a2[r], wsl[(8 + r) * 64 + kf], z); z = fmaf(a3[r], wsl[(12 + r) * 64 + kf], z); }
                const float e = __builtin_amdgcn_exp2f(-1.4426950408889634f * fabsf(z));
                const float ls = fminf(z, 0.f) - 0.6931471805599453f * __builtin_amdgcn_logf(1.0f + e);
                tile[t * 65 + kf] = ls * (1.0f / 16.0f);
            }
        }
        __syncthreads();
        {
            const int kf = tix & 63, sg = tix >> 6; float run = 0.f;
#pragma unroll 8
            for (int i = 0; i < 32; ++i) { LAS float* p = tile + (sg * 32 + i) * 65 + kf; run += *p; *p = run; }
            seg[sg * 64 + kf] = run;
            __syncthreads();
            float off = 0.f;
            for (int q = 0; q < sg; ++q) off += seg[q * 64 + kf];
#pragma unroll 8
            for (int i = 0; i < 32; ++i) { LAS float* p = tile + (sg * 32 + i) * 65 + kf; *p += off; }
            if (sg == 7) DL[(size_t)ch * 512 + kf0 + kf] = __builtin_amdgcn_exp2f(1.4426950408889634f * (run + off));
        }
        __syncthreads();
        bf16_t* EQ = (bf16_t*)BTM; bf16_t* EK = EQ + (size_t)T * 512; bf16_t* EKF = (bf16_t*)BFM;
#pragma unroll
        for (int j = 0; j < 4; ++j) { const int t = (tix >> 3) + 64 * j, c = (tix & 7) * 8; const LAS float* p = tile + t * 65 + c;
            f32x4 e0, e1, n0, n1;
#pragma unroll
            for (int q = 0; q < 4; ++q) { e0[q] = fexp2(p[q]); e1[q] = fexp2(p[4 + q]); n0[q] = fexp2(-p[q]); n1[q] = fexp2(-p[4 + q]); }
            *(u32x4*)(EQ + (size_t)(t0 + t) * 512 + kf0 + c) = pack8(e0, e1); *(u32x4*)(EK + (size_t)(t0 + t) * 512 + kf0 + c) = pack8(n0, n1); }
#pragma unroll
        for (int j = 0; j < 4; ++j) { const int kf = (tix >> 5) + 16 * j, t = (tix & 31) * 8; const LAS float* p = tile + t * 65 + kf;
            f32x4 n0, n1;
#pragma unroll
            for (int q = 0; q < 4; ++q) { n0[q] = fexp2(-p[q * 65]); n1[q] = fexp2(-p[(4 + q) * 65]); }
            *(u32x4*)(EKF + (size_t)(kf0 + kf) * T + t0 + t) = pack8(n0, n1); }
        __syncthreads();
    }
}
__device__ __forceinline__ void gla_scan(const bf16_t* UT, const float* DL, bf16_t* SP) {
    const int tix = otid(); const int gi = blockIdx.x * blockDim.x + tix, gs = gridDim.x * blockDim.x;
    for (int it = gi; it < 16 * 32768 / 2; it += gs) {
        const int bh = it >> 14, idx = (it & 16383) * 2, k = idx & 127, b = bh >> 2, h = bh & 3;
        float s0 = 0.f, s1 = 0.f;
        for (int c = 0; c < 32; ++c) {
            const size_t off = (size_t)(bh * 32 + c) * 32768 + idx;
            const unsigned uu = *(const unsigned*)(UT + off);
            *(unsigned*)(SP + off) = cvt_pk_bf16(s0, s1);
            const f32x2 d = *(const f32x2*)(DL + (size_t)(b * 32 + c) * 512 + h * 128 + k);
            s0 = fmaf(d[0], s0, bf_lo(uu)); s1 = fmaf(d[1], s1, bf_hi(uu));
        }
    }
}
__device__ __forceinline__ void gla_fin(const bf16_t* O, const bf16_t* QKR, const float* ng, bf16_t* GO) {
    const int tix = otid(); const int lane = tix & 63;
    const int gw = (blockIdx.x * blockDim.x + tix) >> 6, ngw = (gridDim.x * blockDim.x) >> 6;
    const f32x4 gg = ((const f32x4*)ng)[lane];
    for (int t = gw; t < T; t += ngw) {
#pragma unroll
        for (int j = 0; j < 4; ++j) {
            const u32x2 ow = ((const u32x2*)(O + (size_t)t * D))[lane + 64 * j], rw = ((const u32x2*)(QKR + (size_t)t * 2048 + 1024))[lane + 64 * j];
            const f32x4 o = (f32x4){bf_lo(ow.x), bf_hi(ow.x), bf_lo(ow.y), bf_hi(ow.y)}, r = (f32x4){bf_lo(rw.x), bf_hi(rw.x), bf_lo(rw.y), bf_hi(rw.y)};
            const float ss = wave_sum((o[0] * o[0] + o[1] * o[1]) + (o[2] * o[2] + o[3] * o[3]));
            const float rs = rsqrtf(ss * (1.0f / GDVH) + EPS);
            f32x4 y;
#pragma unroll
            for (int q = 0; q < 4; ++q) y[q] = o[q] * rs * gg[q] * (r[q] * fast_sigmoid(r[q]));
            u32x2 w; w.x = cvt_pk_bf16(y[0], y[1]); w.y = cvt_pk_bf16(y[2], y[3]);
            ((u32x2*)(GO + (size_t)t * D))[lane + 64 * j] = w;
        }
    }
}

__device__ __forceinline__ void csum_phase(const unsigned char* base, size_t bytes, unsigned long long* ref, unsigned* flag, int compare, LAS unsigned char* lds) {
    const int tix = otid(); const size_t n16 = bytes / 16, per = (n16 + gridDim.x - 1) / gridDim.x;
    const size_t lo = (size_t)blockIdx.x * per, hi = lo + per < n16 ? lo + per : n16;
    unsigned long long s = 0;
    for (size_t i = lo + tix; i < hi; i += 512) { const u32x4 v = ((const u32x4*)base)[i]; s += (unsigned long long)v.x + ((unsigned long long)v.y << 8) + ((unsigned long long)v.z << 16) + ((unsigned long long)v.w << 24); }
    for (int o = 1; o < 64; o <<= 1) s += __shfl_xor(s, o);
    LAS unsigned long long* red = (LAS unsigned long long*)lds;
    if ((tix & 63) == 0) red[tix >> 6] = s;
    __syncthreads();
    if (tix == 0) { unsigned long long t = 0; for (int q = 0; q < 8; ++q) t += red[q];
        if (!compare) ref[blockIdx.x] = t; else if (ref[blockIdx.x] != t) *flag = 1u; }
    __syncthreads();
}
__device__ __forceinline__ void flagout_phase(float* out, unsigned* flags) {
    const int tix = otid(); int k = -1;
    for (int r = 31; r >= 0; --r) if (__hip_atomic_load(flags + r, __ATOMIC_RELAXED, __HIP_MEMORY_SCOPE_AGENT)) k = r;
    if (k < 0) return;
    const float sc = 1.0f + 0.25f * (float)(k + 1);
    const size_t gi = (size_t)blockIdx.x * 512 + tix, gs = (size_t)gridDim.x * 512;
    for (size_t i = gi; i < (size_t)T * D; i += gs) out[i] *= sc;
}

__device__ __forceinline__ void csum2_phase(const unsigned char* base, size_t bytes, unsigned long long* store, unsigned* flag, LAS unsigned char* lds) {
    const int tix = otid(); const size_t n16 = bytes / 16, per = (n16 + gridDim.x - 1) / gridDim.x;
    const size_t lo = (size_t)blockIdx.x * per, hi = lo + per < n16 ? lo + per : n16;
    unsigned long long s = 0;
    for (size_t i = lo + tix; i < hi; i += 512) { const u32x4 v = ((const u32x4*)base)[i]; s += (unsigned long long)v.x + ((unsigned long long)v.y << 8) + ((unsigned long long)v.z << 16) + ((unsigned long long)v.w << 24); }
    for (int o = 1; o < 64; o <<= 1) s += __shfl_xor(s, o);
    LAS unsigned long long* red = (LAS unsigned long long*)lds;
    if ((tix & 63) == 0) red[tix >> 6] = s;
    __syncthreads();
    if (tix == 0) { unsigned long long t = 0; for (int q = 0; q < 8; ++q) t += red[q];
        unsigned long long* st = store + 2 * blockIdx.x;
        if (st[1] == 0x600DF00D600DF00Dull && st[0] != t) *flag = 1u;
        st[0] = t; st[1] = 0x600DF00D600DF00Dull; }
    __syncthreads();
}

__device__ __forceinline__ void conv_phase(const bf16_t* U, const float* wdw, const float* bdw, const float* lng, const float* lnb, bf16_t* CV, LAS unsigned char* lds) {
    int tid_ = threadIdx.x; asm volatile("" : "+v"(tid_));
    const int tid = tid_, lane = tid & 63, wv = __builtin_amdgcn_readfirstlane(tid >> 6), c0 = 2 * tid;
    LAS unsigned char* buf = lds;
    LAS float* red = (LAS float*)(lds + 62 * 2048); LAS float* tot = red + 512;
    f32x2 w[CONVK];
#pragma unroll
    for (int j = 0; j < CONVK; ++j) w[j] = *(const f32x2*)(wdw + j * D + c0);
    const f32x2 bd = *(const f32x2*)(bdw + c0), lg = *(const f32x2*)(lng + c0), lb = *(const f32x2*)(lnb + c0);
#define CONV_STAGE(item_) do { const int _t0 = (item_) * 32, _s0 = _t0 & (S - 1); \
        for (int q = wv; q < 124; q += 8) { const int row = q >> 1, half = q & 1; \
            if (_s0 - 30 + row >= 0) __builtin_amdgcn_global_load_lds((const unsigned*)((const char*)U + ((size_t)(_t0 - 30 + row) * D) * 2 + half * 1024 + lane * 16), (LAS unsigned*)(buf + row * 2048 + half * 1024), 16, 0, 0); \
            else *(LAS u32x4*)(buf + row * 2048 + half * 1024 + lane * 16) = (u32x4){0u, 0u, 0u, 0u}; } } while (0)
    int item = blockIdx.x;
    if (item < T / 32) CONV_STAGE(item);
    for (; item < T / 32; item += gridDim.x) {
        const int t0 = item * 32;
        asm volatile("s_waitcnt vmcnt(0) lgkmcnt(0)" ::: "memory");
        __syncthreads();
        unsigned raw[62];
#pragma unroll
        for (int r = 0; r < 62; ++r) raw[r] = *(const LAS unsigned*)(buf + r * 2048 + c0 * 2);
        asm volatile("s_waitcnt lgkmcnt(0)" ::: "memory");
        __syncthreads();
        if (item + (int)gridDim.x < T / 32) CONV_STAGE(item + (int)gridDim.x);
        f32x2 acc[32];
#pragma unroll
        for (int o = 0; o < 32; ++o) acc[o] = bd;
#pragma unroll
        for (int r = 0; r < 62; ++r) {
            const f32x2 uv = (f32x2){bf_lo(raw[r]), bf_hi(raw[r])};
#pragma unroll
            for (int o = (r > 30 ? r - 30 : 0); o <= (r < 31 ? r : 31); ++o) acc[o] = __builtin_elementwise_fma(uv, w[r - o], acc[o]);
        }
        float v[64];
#pragma unroll
        for (int o = 0; o < 32; ++o) { v[o] = acc[o][0] + acc[o][1]; v[32 + o] = acc[o][0] * acc[o][0] + acc[o][1] * acc[o][1]; }
#pragma unroll
        for (int st = 0; st < 6; ++st) {
            const int half = 32 >> st, bit = 32 >> st; const bool up = (lane & bit) != 0;
#pragma unroll
            for (int k = 0; k < half; ++k) { const float send = up ? v[k] : v[k + half]; const float keep = up ? v[k + half] : v[k]; v[k] = keep + __shfl_xor(send, bit); }
        }
        red[wv * 64 + lane] = v[0];
        __syncthreads();
        if (tid < 64) { float s = 0.f;
#pragma unroll
            for (int q = 0; q < 8; ++q) s += red[q * 64 + tid];
            tot[tid] = s; }
        __syncthreads();
#pragma unroll
        for (int o = 0; o < 32; ++o) {
            const float mu = tot[o] * (1.0f / D), var = tot[32 + o] * (1.0f / D) - mu * mu, rstd = rsqrtf(var + EPS);
            const float y0 = (acc[o][0] - mu) * rstd * lg[0] + lb[0], y1 = (acc[o][1] - mu) * rstd * lg[1] + lb[1];
            *(unsigned*)(CV + (size_t)(t0 + o) * D + c0) = cvt_pk_bf16(y0 * fast_sigmoid(y0), y1 * fast_sigmoid(y1));
        }
    }
    asm volatile("s_waitcnt vmcnt(0) lgkmcnt(0)" ::: "memory");
    __syncthreads();
#undef CONV_STAGE
}

enum Ph { PH_PREP0 = 0, PH_CONV_IN, PH_CONV_MID, PH_CONV_OUT, PH_ADAPT, PH_XA_PREP, PH_XA_Q, PH_XA_KV, PH_XA_S, PH_XA_PV, PH_XA_O, PH_ROUTE_PREP, PH_ROUTE, PH_BUILD, PH_MOE1, PH_MOE2, PH_COMBINE, PH_COMBINE_FIN, PH_GLA_PREP, PH_GLA_DECAY, PH_GLA_IN, PH_GLA_ATT, PH_GLA_UT, PH_GLA_SCAN, PH_GLA_O, PH_GLA_FIN, PH_GLA_OUT, PH_NOP, PH_CSUM, PH_FLAGOUT, PH_CSUM2, PH_XA_S_DIAG, PH_XA_O_T, PH_COMBINE_T, PH_ROUTE_T, PH_PREP_ALL, PH_DIAG_KLOOP, PH_XA_QSP, PH_N };

__device__ __forceinline__ void run_phase(const Ctx& c, int ph, int l, LAS unsigned char* lds) {
    unsigned char* ws = c.ws;
    bf16_t* XB = (bf16_t*)(ws + OW_XB); float* RS = (float*)(ws + OW_RS); float* SSP = (float*)(ws + OW_SSP);
    bf16_t* ACTA = (bf16_t*)(ws + OW_ACTA); bf16_t* ACTB = (bf16_t*)(ws + OW_ACTB);
    bf16_t* WCIN = (bf16_t*)(ws + OW_WCIN); bf16_t* WCOUT = (bf16_t*)(ws + OW_WCOUT);
    bf16_t* ACTC = (bf16_t*)(ws + OW_ACTC); float* PSUM = (float*)(ws + OW_PSUM);
    bf16_t* WXQ = (bf16_t*)(ws + OW_WXQ) + (size_t)l * D * D; bf16_t* WXKV = (bf16_t*)(ws + OW_WXKV) + (size_t)l * 2048 * D; bf16_t* WXO = (bf16_t*)(ws + OW_WXO) + (size_t)l * D * D;
    float* WR = (float*)(ws + OW_WR) + (size_t)l * 36 * 1024;
    int* GCNT = (int*)(ws + OM_GCNT) + l * 32; int* NTP = (int*)(ws + OM_NT); int* TILEE = (int*)(ws + OM_TILEE); int* AE = (int*)(ws + OM_AE); int* APOS = (int*)(ws + OM_APOS); float* GATE = (float*)(ws + OM_GATE);
    int* STOK = (int*)(ws + OM_STOK); int* SA = (int*)(ws + OM_SA); float* SRS = (float*)(ws + OM_SRS); float* SGATE = (float*)(ws + OM_SGATE);
    bf16_t* HB = (bf16_t*)(ws + OW_H); bf16_t* YB = (bf16_t*)(ws + OW_Y); bf16_t* W1 = (bf16_t*)(ws + OW_WMOE); bf16_t* W2 = W1 + (size_t)NE * D * D;
    bf16_t* ATTB = (bf16_t*)(ws + OW_ATT); bf16_t* QKR = (bf16_t*)(ws + OW_QKR); bf16_t* KVT = (bf16_t*)(ws + OW_KVT); float* BTM = (float*)(ws + OW_BTM); float* BFM = (float*)(ws + OW_BFM);
    bf16_t* OB = (bf16_t*)(ws + OW_O); bf16_t* UTB = (bf16_t*)(ws + OW_UT); bf16_t* SPB = (bf16_t*)(ws + OW_SP); float* ALR = (float*)(ws + OW_ALR); float* DLF = (float*)(ws + OW_DL); bf16_t* GOB = (bf16_t*)(ws + OW_GO);
    bf16_t* WGTM = (bf16_t*)(ws + OW_WGTM); bf16_t* WGFM = (bf16_t*)(ws + OW_WGFM); bf16_t* WGO = (bf16_t*)(ws + OW_WGO); float* WAF = (float*)(ws + OW_WA);
    bf16_t* KB = (bf16_t*)(ws + OW_KVB); bf16_t* VT = KB + (size_t)1024 * 1024; bf16_t* MEMNB = (bf16_t*)(ws + OW_MEMNB);
    switch (ph) {
    case PH_PREP0:
        cvt_matrix(c.in[7], 2048, 0, 1024, D, c.in[2], WCIN, 1, 0, lds);
        cvt_matrix(c.in[7], 2048, 1024, 1024, D, c.in[2], WCIN, 1, 1, lds, 512);
        cvt_matrix(c.in[13], D, 0, D, D, nullptr, WCOUT, 0, 0, lds, 1024);
        rows_prep(c.in[0], XB, RS, nullptr, T);
        { const int tix = otid(); if (blockIdx.x == 0 && tix < 32) ((unsigned*)(ws + OW_DBG))[tix] = 0u; }
        break;
    case PH_PREP_ALL: {
        cvt_matrix(c.in[7], 2048, 0, 1024, D, c.in[2], WCIN, 1, 0, lds);
        cvt_matrix(c.in[7], 2048, 1024, 1024, D, c.in[2], WCIN, 1, 1, lds, 512);
        cvt_matrix(c.in[13], D, 0, D, D, nullptr, WCOUT, 0, 0, lds, 1024);
        for (int ll = 0; ll < 2; ++ll) {
            cvt_matrix(c.in[20] + (size_t)ll * D * D, D, 0, D, D, c.in[3] + ll * D, (bf16_t*)(ws + OW_WXQ) + (size_t)ll * D * D, 0, 0, lds, 1536 + 1024 * ll);
            cvt_matrix(c.in[21] + (size_t)ll * D * 2048, 2048, 0, 2048, D, nullptr, (bf16_t*)(ws + OW_WXKV) + (size_t)ll * 2048 * D, 0, 0, lds, 0 + 1024 * ll);
            cvt_matrix(c.in[22] + (size_t)ll * D * D, D, 0, D, D, nullptr, (bf16_t*)(ws + OW_WXO) + (size_t)ll * D * D, 0, 0, lds, 1024 + 512 * ll);
            route_prep(c.in[23] + (size_t)ll * D * NG, c.in[25] + (size_t)ll * D * NE, c.in[4] + ll * D, (float*)(ws + OW_WR) + (size_t)ll * 36 * 1024);
        }
        gla_prep(c.in[15], c.in[19], c.in[2] + D, WGTM, WGFM, WGO, WAF, lds);
        rows_norm_bf16(c.in[1], c.in[5], MEMNB, NB * NMEM);
        rows_prep(c.in[0], XB, RS, nullptr, T);
        { const int tix = otid(); if (blockIdx.x == 0 && tix < 64) ((int*)(ws + OM_GCNT))[tix] = 0; }
        } break;
    case PH_CONV_IN: { g8::DenseSched S{8, 128 * 8, D, D, D, XB, WCIN}; g8::gemm_phase(lds, S, g8::EpiGlu{ACTA, RS, c.in[8]}); } break;
    case PH_CONV_MID: conv_phase(ACTA, c.in[9], c.in[10], c.in[11], c.in[12], ACTB, lds); break;
    case PH_CONV_OUT: { g8::DenseSched S{4, 128 * 4, D, D, D, ACTB, WCOUT}; g8::gemm_phase(lds, S, g8::EpiXres{XB, c.in[14], SSP}); } break;
    case PH_ADAPT: rows_prep(c.out, XB, RS, SSP, T); break;
    case PH_XA_PREP:
        cvt_matrix(c.in[20] + (size_t)l * D * D, D, 0, D, D, c.in[3] + l * D, WXQ, 0, 0, lds);
        cvt_matrix(c.in[21] + (size_t)l * D * 2048, 2048, 0, 2048, D, nullptr, WXKV, 0, 0, lds, 512);
        cvt_matrix(c.in[22] + (size_t)l * D * D, D, 0, D, D, nullptr, WXO, 0, 0, lds, 1536);
        rows_norm_bf16(c.in[1], c.in[5], MEMNB, NB * NMEM);
        break;
    case PH_XA_Q: { g8::DenseSched S{4, 128 * 4, D, D, D, XB, WXQ}; g8::gemm_phase(lds, S, g8::EpiRowScale{ACTA, D, SSP, nullptr, 0.0625f, 0, 1.0f}); } break;
    case PH_XA_KV: { g8::KVSched S{D, D, D, MEMNB, WXKV}; g8::gemm_phase(lds, S, g8::EpiKV{KB, VT}); }
        cvt_moe(c.in[27] + (size_t)l * NE * D * DE, c.in[28] + (size_t)l * NE * D * DE, c.in[29] + (size_t)l * NE * DE * D, c.in[4] + l * D, W1, W2, lds, 32);
        break;
    case PH_XA_QSP: {
        { g8::DenseSched S{4, 128 * 4, D, D, D, XB, WXQ}; g8::gemm_phase(lds, S, g8::EpiRowScale{ACTA, D, SSP, nullptr, 0.0625f, 0, 1.0f}); }
        asm volatile("s_waitcnt vmcnt(0)" ::: "memory"); __syncthreads();
        if (otid() < 64) { __builtin_amdgcn_fence(__ATOMIC_ACQUIRE, "agent"); asm volatile("s_waitcnt vmcnt(0)" ::: "memory"); } __syncthreads();
        { g8::AttnSched S{256, D, D, ACTA, KB, 0}; g8::gemm_phase(lds, S, g8::EpiS{ACTB, PSUM}); }
        asm volatile("s_waitcnt vmcnt(0)" ::: "memory"); __syncthreads();
        if (otid() < 64) { __builtin_amdgcn_fence(__ATOMIC_ACQUIRE, "agent"); asm volatile("s_waitcnt vmcnt(0)" ::: "memory"); } __syncthreads();
        { g8::AttnSched S{256, D, 256, ACTB, VT, 1}; g8::gemm_phase(lds, S, g8::EpiPV{ACTC, PSUM}); }
        } break;
    case PH_XA_S: { g8::AttnSched S{256, D, D, ACTA, KB, 0}; g8::gemm_phase(lds, S, g8::EpiS{ACTB, PSUM}); } break;
    case PH_XA_S_DIAG: { g8::AttnSched S{256, D, D, ACTA, KB, 0}; g8::gemm_phase(lds, S, g8::EpiRaw{ACTC}); } break;
    case PH_XA_PV: { g8::AttnSched S{256, D, 256, ACTB, VT, 1}; g8::gemm_phase(lds, S, g8::EpiPV{ACTC, PSUM}); } break;
    case PH_XA_O: { g8::DenseSched S{4, 128 * 4, D, D, D, ACTC, WXO}; g8::gemm_phase(lds, S, g8::EpiXres{XB, nullptr, nullptr}); } break;
    case PH_ROUTE_PREP: route_prep(c.in[23] + (size_t)l * D * NG, c.in[25] + (size_t)l * D * NE, c.in[4] + l * D, WR);
        { const int tix = otid(); if (blockIdx.x == 0 && tix < 32) GCNT[tix] = 0; }
        break;
    case PH_ROUTE: route_phase(XB, WR, c.in[24] + l * NG, c.in[26] + l * NE, RS, AE, APOS, GATE, GCNT, lds); break;
    case PH_BUILD: build_phase(GCNT, AE, APOS, GATE, RS, NTP, TILEE, STOK, SA, SRS, SGATE, lds); break;
    case PH_MOE1: { g8::MoeSched S{D, D, D, XB, W1, (size_t)D * D, TILEE, STOK, __builtin_amdgcn_readfirstlane(g8::ld_agent(NTP))}; g8::gemm_phase(lds, S, g8::EpiMoe1{HB, SRS}); } break;
    case PH_MOE2: { g8::MoeSched S{DE, DE, DE, HB, W2, (size_t)D * DE, TILEE, nullptr, __builtin_amdgcn_readfirstlane(g8::ld_agent(NTP))}; g8::gemm_phase(lds, S, g8::EpiMoe2{YB, SA, SGATE}); } break;
    case PH_COMBINE: combine_phase(c.out, c.out, YB, XB, RS, SSP, nullptr, 0, WAF, ALR, lds); break;
    case PH_COMBINE_FIN: combine_phase(c.out, c.out, YB, XB, RS, SSP, c.in[6], 1, nullptr, nullptr, lds); break;
    case PH_GLA_PREP: gla_prep(c.in[15], c.in[19], c.in[2] + D, WGTM, WGFM, WGO, WAF, lds); break;
    case PH_GLA_DECAY: gla_decay(ALR, c.in[16], c.in[17], BTM, BFM, DLF, lds); break;
    case PH_GLA_IN: { g8::GlaInSched S{XB, WGTM, WGFM}; g8::gemm_phase(lds, S, g8::EpiGlaIn{QKR, KVT, RS, (const bf16_t*)BTM, (const bf16_t*)BFM}); } break;
    case PH_GLA_ATT: { g8::GlaAttSched<0> S{QKR, KVT}; g8::gemm_phase(lds, S, g8::EpiGlaAtt<0>{ATTB, UTB, DLF}); }
        { g8::GlaAttSched<1> S{QKR, KVT}; g8::gemm_phase(lds, S, g8::EpiGlaAtt<1>{ATTB, UTB, DLF}); } break;
    case PH_GLA_UT: { g8::GlaAttSched<1> S{QKR, KVT}; g8::gemm_phase(lds, S, g8::EpiGlaAtt<1>{ATTB, UTB, DLF}); } break;
    case PH_GLA_SCAN: gla_scan(UTB, DLF, SPB); break;
    case PH_GLA_O: { g8::GlaOSched S{QKR, KVT, ATTB, SPB}; g8::gemm_phase(lds, S, g8::EpiGlaO{OB}); } break;
    case PH_GLA_FIN: gla_fin(OB, QKR, c.in[18], GOB); break;
    case PH_CSUM: { static const size_t ro[10] = {OW_ACTA, OW_ACTB, OW_ACTC, OW_H, OW_Y, OW_QKR, OW_ATT, OW_UT, OW_O, OW_KVB};
        static const size_t rb[10] = {64 * MiB, 64 * MiB, 64 * MiB, 72 * MiB, 128 * MiB, 224 * MiB, 64 * MiB, 32 * MiB, 64 * MiB, 4 * MiB};
        const int r = l >> 1; csum_phase(ws + ro[r], rb[r], (unsigned long long*)(ws + OW_DBG) + 512 + r * 256, (unsigned*)(ws + OW_DBG) + r, l & 1, lds); } break;
    case PH_CSUM2: {
        const unsigned char* bp; size_t nb;
        switch (l) {
        case 0: bp = ws + OW_XB; nb = 64 * MiB; break;            case 1: bp = ws + OW_ACTA; nb = 64 * MiB; break;
        case 2: bp = ws + OW_ACTB; nb = 64 * MiB; break;          case 3: bp = (const unsigned char*)c.out; nb = 128 * MiB; break;
        case 4: bp = ws + OW_ACTA; nb = 64 * MiB; break;          case 5: bp = ws + OW_ACTC; nb = 64 * MiB; break;
        case 6: bp = ws + OW_ACTB; nb = 64 * MiB; break;          case 7: bp = ws + OW_ACTC; nb = 64 * MiB; break;
        case 8: bp = (const unsigned char*)c.out; nb = 128 * MiB; break;   case 9: bp = ws + OM_GATE; nb = NA * 4; break;
        case 10: bp = ws + OW_Y; nb = 128 * MiB; break;           case 11: bp = (const unsigned char*)c.out; nb = 128 * MiB; break;
        case 12: bp = ws + OW_BTM; nb = 128 * MiB; break;         case 13: bp = ws + OW_QKR; nb = 224 * MiB; break;
        case 14: bp = ws + OW_ATT; nb = 64 * MiB; break;          case 15: bp = ws + OW_UT; nb = 32 * MiB; break;
        case 16: bp = ws + OW_SP; nb = 32 * MiB; break;           case 17: bp = ws + OW_O; nb = 64 * MiB; break;
        case 18: bp = ws + OW_GO; nb = 64 * MiB; break;           case 19: bp = (const unsigned char*)c.out; nb = 128 * MiB; break;
        case 20: bp = ws + OW_ACTA; nb = 64 * MiB; break;         case 21: bp = ws + OW_ACTB; nb = 64 * MiB; break;
        case 22: bp = ws + OW_ACTC; nb = 64 * MiB; break;         case 23: bp = (const unsigned char*)c.out; nb = 128 * MiB; break;
        case 24: bp = ws + OM_GATE; nb = NA * 4; break;           case 25: bp = ws + OW_Y; nb = 128 * MiB; break;
        case 26: bp = ws + OW_RS; nb = T * 4; break;              case 27: bp = ws + OW_ALR; nb = 2 * MiB; break;
        default: bp = ws + OW_SSP; nb = 2 * MiB; break; }
        csum2_phase(bp, nb, (unsigned long long*)(ws + OW_DBG + 65536) + (size_t)l * 512, (unsigned*)(ws + OW_DBG) + l, lds); } break;
    case PH_XA_O_T: { g8::DenseSched S{4, 128 * 4, D, D, D, ACTC, WXO}; g8::gemm_phase(lds, S, g8::EpiXres{(bf16_t*)(ws + 424 * MiB), nullptr, nullptr}); } break;
    case PH_COMBINE_T: combine_phase(c.out, (float*)(ws + 296 * MiB), YB, (bf16_t*)(ws + 424 * MiB), (float*)(ws + 488 * MiB), (float*)(ws + 489 * MiB), nullptr, 0, nullptr, nullptr, lds); break;
    case PH_ROUTE_T: route_phase(XB, WR, c.in[24] + l * NG, c.in[26] + l * NE, (float*)(ws + 488 * MiB), (int*)(ws + 489 * MiB), (int*)(ws + 490 * MiB), (float*)(ws + 491 * MiB), (int*)(ws + 491 * MiB + 524288), lds); break;
    case PH_DIAG_KLOOP: { g8::DenseSched S{8, 128 * 8, D, D, D, XB, WCIN}; g8::gemm_phase(lds, S, g8::EpiNone{}); } break;
    case PH_FLAGOUT: flagout_phase(c.out, (unsigned*)(ws + OW_DBG)); break;
    case PH_GLA_OUT: { g8::DenseSched S{4, 128 * 4, D, D, D, GOB, WGO}; g8::gemm_phase(lds, S, g8::EpiXres{XB, nullptr, SSP}); } break;
    }
}
template <int PH> __global__ void __launch_bounds__(512, 2) k_opt(Ctx c, int l) {
    extern __shared__ __attribute__((aligned(16))) unsigned char dynlds[];
    run_phase(c, PH, l, (LAS unsigned char*)dynlds);
}

#ifndef ALLCG
#define ALLCG 0
#endif
#define XB_TMO      128
#define XB_XCNT(j)  (256  + 64 * (j))
#define XB_XSUB(j)  (1280 + 64 * (j))
#define XB_XGEN(j)  (2304 + 64 * (j))
#define XB_TOP      3328
#define XB_TOPGEN   3392
#define XCD_BAR_WORDS 3456
#define XB_SPIN_CAP (1u << 18)
__device__ __forceinline__ unsigned xb_ld(unsigned* p)              { return __hip_atomic_load(p, __ATOMIC_RELAXED, __HIP_MEMORY_SCOPE_AGENT); }
__device__ __forceinline__ unsigned xb_add(unsigned* p, unsigned v) { return __hip_atomic_fetch_add(p, v, __ATOMIC_RELAXED, __HIP_MEMORY_SCOPE_AGENT); }
__device__ __forceinline__ unsigned xb_xcc_id() { return (unsigned)__builtin_amdgcn_s_getreg((3 << 11) | 20) & 0xFu; }
#define XB_SPIN(cond, bar) do { unsigned _sp = 0; while (cond) { __builtin_amdgcn_s_sleep(1); \
    if ((++_sp & 255u) == 0u) { if (xb_ld(&(bar)[XB_TMO])) break; if (_sp > XB_SPIN_CAP) { atomicAdd(&(bar)[XB_TMO], 1u); break; } } } } while (0)
struct XcdBarrier { unsigned* bar; unsigned x; volatile LAS unsigned* st; };
__device__ __forceinline__ XcdBarrier xcd_barrier_post(unsigned* bar, volatile LAS unsigned* st) {
    XcdBarrier b; b.bar = bar; b.x = xb_xcc_id(); b.st = st;
    if (threadIdx.x == 0) (void)xb_add(&bar[XB_XCNT(b.x)], 1u);
    return b;
}
__device__ __forceinline__ void xcd_barrier_complete(unsigned* bar, unsigned x, unsigned& nloc, unsigned& nx) {
    const unsigned G = gridDim.x * gridDim.y * gridDim.z;
    unsigned sum, cnt, mine, sp = 0u;
    for (;;) {
        sum = 0u; cnt = 0u; mine = 0u;
#pragma unroll
        for (unsigned j = 0; j < 16; ++j) { const unsigned c = xb_ld(&bar[XB_XCNT(j)]); sum += c; cnt += (c > 0u) ? 1u : 0u; mine = (j == x) ? c : mine; }
        if (sum == G) break;
        __builtin_amdgcn_s_sleep(1);
        if ((++sp & 255u) == 0u) { if (xb_ld(&bar[XB_TMO])) break; if (sp > XB_SPIN_CAP) { atomicAdd(&bar[XB_TMO], 1u); break; } }
    }
    nloc = mine > 0u ? mine : 1u; nx = cnt > 0u ? cnt : 1u;
}
__device__ __forceinline__ void xcd_barrier(const XcdBarrier& b) {
    asm volatile("s_waitcnt vmcnt(0)" ::: "memory");
    __syncthreads();
    if (threadIdx.x == 0) {
        unsigned* bar = b.bar;
        __builtin_amdgcn_s_waitcnt(0);
        unsigned nloc = b.st[0], nx = b.st[1];
        if (nloc == 0u) { xcd_barrier_complete(bar, b.x, nloc, nx); b.st[0] = nloc; b.st[1] = nx; }
        const unsigned old = xb_add(&bar[XB_XSUB(b.x)], 1u);
        const unsigned gen = old / nloc;
        if (old + 1u == (gen + 1u) * nloc) {
            __builtin_amdgcn_fence(__ATOMIC_RELEASE, "agent");
            asm volatile("s_waitcnt vmcnt(0)" ::: "memory");
            const unsigned og = xb_add(&bar[XB_TOP], 1u);
            const unsigned tg = og / nx;
            if (og + 1u == (tg + 1u) * nx) xb_add(&bar[XB_TOPGEN], 1u);
            else XB_SPIN(xb_ld(&bar[XB_TOPGEN]) == tg, bar);
            __builtin_amdgcn_fence(__ATOMIC_ACQUIRE, "agent");
            xb_add(&bar[XB_XGEN(b.x)], 1u);
            asm volatile("s_waitcnt vmcnt(0)" ::: "memory");
        } else {
            XB_SPIN(xb_ld(&bar[XB_XGEN(b.x)]) == gen, bar);
            __builtin_amdgcn_fence(__ATOMIC_ACQUIRE, "agent");
            asm volatile("s_waitcnt vmcnt(0)" ::: "memory");
        }
    }
    __syncthreads();
}
template <int CODE> __device__ __forceinline__ void coop_step(const Ctx& c, LAS unsigned char* lds, cg::grid_group& grid, XcdBarrier& xb, bool sync_after, bool first) {
    run_phase(c, CODE >> 5, CODE & 31, lds);
    if (sync_after) {
        if (first || ALLCG) {
            unsigned* bar = (unsigned*)(c.ws + OW_BAR);
            if (first && blockIdx.x == 0) for (int i = threadIdx.x; i < XCD_BAR_WORDS; i += 512) bar[i] = 0u;
            asm volatile("s_waitcnt vmcnt(0) lgkmcnt(0)" ::: "memory");
            grid.sync();
            if (threadIdx.x < 64) { __builtin_amdgcn_fence(__ATOMIC_ACQUIRE, "agent"); asm volatile("s_waitcnt vmcnt(0)" ::: "memory"); }
            __syncthreads();
            if (first) xb = xcd_barrier_post(bar, xb.st);
        } else xcd_barrier(xb);
    }
}
template <int... CODES> __global__ void __launch_bounds__(512, 2) k_coop(Ctx c) {
    extern __shared__ __attribute__((aligned(16))) unsigned char dynlds[];
    cg::grid_group grid = cg::this_grid();
    LAS unsigned char* lds = (LAS unsigned char*)dynlds;
    volatile LAS unsigned* st = (volatile LAS unsigned*)(lds + LDS_BYTES - 16);
    if (threadIdx.x < 4) st[threadIdx.x] = 0u;
    __syncthreads();
    XcdBarrier xb; xb.bar = nullptr; xb.x = 0; xb.st = st;
    int idx = 0; constexpr int N = sizeof...(CODES);
    ((coop_step<CODES>(c, lds, grid, xb, idx + 1 < N, idx == 0), ++idx), ...);
}
#define CODE(ph, l) ((ph) * 32 + (l))
typedef void (*CoopFn)(Ctx);
extern "C" void kernel_launch(void* const* d_in, const int* in_sizes, int n_in, void* d_out, int out_size, void* d_ws, size_t ws_size, hipStream_t stream) {
    if (n_in != 30 || out_size != T * D || ws_size < OW_END) { fprintf(stderr, "kernel_launch: built for 30 inputs, %d outputs and >= %zu bytes of workspace; got n_in %d, out %d, ws %zu; nothing launched\n", T * D, (size_t)OW_END, n_in, out_size, ws_size); return; }
    Ctx c; memset(&c, 0, sizeof(c));
    for (int i = 0; i < 30; ++i) c.in[i] = (const float*)d_in[i];
    c.out = (float*)d_out; c.ws = (unsigned char*)d_ws;
    static CoopFn fn = k_coop<CODE(PH_PREP_ALL, 0), CODE(PH_CONV_IN, 0), CODE(PH_CONV_MID, 0), CODE(PH_CONV_OUT, 0),
                                         CODE(PH_XA_KV, 0), CODE(PH_XA_QSP, 0), CODE(PH_XA_O, 0),
                                         CODE(PH_ROUTE, 0), CODE(PH_BUILD, 0), CODE(PH_MOE1, 0), CODE(PH_MOE2, 0), CODE(PH_COMBINE, 0),
                                         CODE(PH_GLA_DECAY, 0), CODE(PH_GLA_IN, 0), CODE(PH_GLA_ATT, 0), CODE(PH_GLA_SCAN, 0), CODE(PH_GLA_O, 0), CODE(PH_GLA_FIN, 0), CODE(PH_GLA_OUT, 0),
                                         CODE(PH_XA_KV, 1), CODE(PH_XA_QSP, 1), CODE(PH_XA_O, 1),
                                         CODE(PH_ROUTE, 1), CODE(PH_BUILD, 1), CODE(PH_MOE1, 1), CODE(PH_MOE2, 1), CODE(PH_COMBINE_FIN, 1)>;
    static int grid = 0;
    if (!grid) {
        int dev = 0, cus = 0, per_cu = 0;
        (void)hipGetDevice(&dev); (void)hipDeviceGetAttribute(&cus, hipDeviceAttributeMultiprocessorCount, dev);
        (void)hipFuncSetAttribute((const void*)fn, hipFuncAttributeMaxDynamicSharedMemorySize, LDS_BYTES);
        (void)hipOccupancyMaxActiveBlocksPerMultiprocessor(&per_cu, fn, 512, LDS_BYTES);
        grid = cus * (per_cu < 1 ? 1 : per_cu); if (grid > 256) grid = 256;
        if (grid != 256) fprintf(stderr, "kernel_launch: %d CUs x %d workgroups: this kernel is laid out for 256 resident workgroups\n", cus, per_cu);
    }
    void* args[] = {&c};
    hipError_t e = hipLaunchCooperativeKernel((void*)fn, dim3(grid), dim3(512), args, LDS_BYTES, stream);
    if (e != hipSuccess) fprintf(stderr, "cooperative launch failed: %s (grid %d)\n", hipGetErrorString(e), grid);
}
```

```cpp
#include <hip/hip_runtime.h>
#include <hip/hip_cooperative_groups.h>
#include <cstdio>
#include <cstring>
namespace cg = cooperative_groups;

constexpr int D = 1024, NB = 4, S = 8192, T = NB * S, NMEM = 256;
constexpr int CONVK = 31;
constexpr int GDK = 512, GDVH = 256, GLA_COLS = 3088;
constexpr int NG = 4, NE = 32, DE = 512;
constexpr int NA = T * 2;
constexpr float EPS = 1e-6f;
constexpr size_t MiB = 1u << 20;

struct Ctx { const float* in[30]; float* out; unsigned char* ws; };

__device__ __forceinline__ float wave_sum(float v) {
#pragma unroll
    for (int o = 1; o < 64; o <<= 1) v += __shfl_xor(v, o);
    return v;
}

#define LAS __attribute__((address_space(3)))
typedef unsigned short bf16_t;
typedef short bf16x8 __attribute__((ext_vector_type(8)));
typedef float f32x4 __attribute__((ext_vector_type(4)));
typedef float f32x2 __attribute__((ext_vector_type(2)));
typedef unsigned u32x4 __attribute__((ext_vector_type(4)));
typedef unsigned u32x2 __attribute__((ext_vector_type(2)));

constexpr int LDS_BYTES = 160 * 1024;
constexpr int NSLOT2 = NA + NE * 256;
constexpr int MAXRT = NSLOT2 / 256;
constexpr int GCS = 64;
constexpr int CAPE = T;
constexpr size_t OW_XB = 0;
constexpr size_t OW_SSP = 64 * MiB;
constexpr size_t OW_RS = 66 * MiB;
constexpr size_t OW_PSUM = 67 * MiB;
constexpr size_t OW_MOE = 69 * MiB;
constexpr size_t OW_ACTA = 72 * MiB, OW_ACTB = 136 * MiB, OW_ACTC = 200 * MiB;
constexpr size_t OW_H = 72 * MiB, OW_Y = 144 * MiB, OW_WMOE = 272 * MiB;
constexpr size_t OW_KVB = 368 * MiB;
constexpr size_t OW_MEMNB = 502 * MiB;
constexpr size_t OW_WCIN = 550 * MiB, OW_WCOUT = 554 * MiB, OW_WXQ = 556 * MiB, OW_WXKV = 560 * MiB, OW_WXO = 568 * MiB, OW_WR = 572 * MiB, OW_BAR = 573 * MiB, OW_DBG = 574 * MiB, OW_END = 575 * MiB;
constexpr size_t OW_ATT = 360 * MiB, OW_QKR = 72 * MiB, OW_KVT = 200 * MiB, OW_BTM = 296 * MiB, OW_O = 296 * MiB, OW_BFM = 360 * MiB, OW_UT = 424 * MiB, OW_SP = 456 * MiB,
                 OW_ALR = 488 * MiB, OW_DL = 490 * MiB, OW_GO = 296 * MiB, OW_WGTM = 492 * MiB, OW_WGFM = 496 * MiB, OW_WGO = 499 * MiB, OW_WA = 501 * MiB;
constexpr size_t OM_GCNT = OW_MOE, OM_NT = OW_MOE + 256, OM_TILEE = OW_MOE + 512, OM_AE = OW_MOE + 4096, OM_APOS = OM_AE + NA * 4, OM_GATE = OM_APOS + NA * 4,
                 OM_STOK = OM_GATE + NA * 4, OM_SA = OM_STOK + NSLOT2 * 4, OM_SRS = OM_SA + NSLOT2 * 4, OM_SGATE = OM_SRS + NSLOT2 * 4, OM_END = OM_SGATE + NSLOT2 * 4;
constexpr size_t OW_ETAB = (size_t)504 << 20;
static_assert(OM_END <= OW_ACTA, "MoE small arrays");

typedef __bf16 bf16x2_t __attribute__((ext_vector_type(2)));
__device__ __forceinline__ unsigned cvt_pk_bf16(float lo, float hi) { const f32x2 v = {lo, hi}; return __builtin_bit_cast(unsigned, __builtin_convertvector(v, bf16x2_t)); }
__device__ __forceinline__ int otid() { int t = threadIdx.x; asm volatile("" : "+v"(t)); return t; }
__device__ __forceinline__ u32x4 pack8(const f32x4& a, const f32x4& b) { u32x4 w; w.x = cvt_pk_bf16(a[0], a[1]); w.y = cvt_pk_bf16(a[2], a[3]); w.z = cvt_pk_bf16(b[0], b[1]); w.w = cvt_pk_bf16(b[2], b[3]); return w; }
__device__ __forceinline__ float bf_lo(unsigned w) { return __uint_as_float(w << 16); }
__device__ __forceinline__ float bf_hi(unsigned w) { return __uint_as_float(w & 0xffff0000u); }
__device__ __forceinline__ float fast_sigmoid(float x) { return __builtin_amdgcn_rcpf(1.0f + __builtin_amdgcn_exp2f(-1.4426950408889634f * x)); }

#ifndef G8_SP2
#define G8_SP2 1
#endif
namespace g8 {
constexpr int BM = 256, BK = 64, HALF = 128, HTB = HALF * BK * 2, STAGE_BYTES = 8 * HTB;
__device__ __forceinline__ int lds_byte(int r, int c) { const int st = (r >> 4) * 2 + (c >> 5), rr = r & 15, cc = c & 31, ob = rr * 64 + cc * 2; return st * 1024 + (ob ^ (((ob >> 9) & 1) << 5)); }
__device__ __forceinline__ void stage_rc(int b, int& R, int& C) { const int st = b / 1024, sb = b % 1024, swz = sb ^ (((sb >> 9) & 1) << 5); R = (st >> 1) * 16 + swz / 64; C = (st & 1) * 32 + (swz % 64) / 2; }
__device__ __forceinline__ int perm32(int rho) { const int n = rho >> 4, i = rho & 15; return 8 * (i >> 2) + 4 * n + (i & 3); }
struct Unit { int pm, pn, e; };

template <class Epi, class Sched>
__device__ __forceinline__ void gemm_phase(LAS unsigned char* lds, const Sched& S, const Epi& E) {
    int tid_ = threadIdx.x; asm volatile("" : "+v"(tid_));
    const int tid = tid_, wid = __builtin_amdgcn_readfirstlane(tid >> 6), lane = tid & 63, wr = wid >> 2, wc = wid & 3, fr = lane & 15, fq = lane >> 4;
    const size_t kstep = (size_t)(BK * 2);
    const unsigned ldsw = (unsigned)wid * 1024u;
    const int aoff = lds_byte(wr * 64 + fr, fq * 8), boff = lds_byte(wc * 32 + fr, fq * 8);
#define G8_SA(b, h) (((b) * 2 + (h)) * HTB)
#define G8_SB(b, h) ((4 + (b) * 2 + (h)) * HTB)
#define G8_STAGE(bufoff, gbase, vv) do { _Pragma("unroll") for (int _i = 0; _i < 2; ++_i) \
        __builtin_amdgcn_global_load_lds((const unsigned*)((const char*)(gbase) + (vv)[_i]), (LAS unsigned*)(lds + (bufoff) + ldsw + _i * 8192), 16, 0, 0); } while (0)
#define G8_LDA(dst, b, h) do { _Pragma("unroll") for (int m = 0; m < 4; ++m) _Pragma("unroll") for (int k = 0; k < 2; ++k) dst[m][k] = *(const LAS bf16x8*)(lds + G8_SA(b, h) + aoff + m * 2048 + k * 1024); } while (0)
#define G8_LDB(dst, b, h) do { _Pragma("unroll") for (int n = 0; n < 2; ++n) _Pragma("unroll") for (int k = 0; k < 2; ++k) dst[n][k] = *(const LAS bf16x8*)(lds + G8_SB(b, h) + boff + n * 2048 + k * 1024); } while (0)
#define G8_MMA(ai, bj, At, Bt) do { __builtin_amdgcn_s_setprio(1); _Pragma("unroll") for (int m = 0; m < 4; ++m) _Pragma("unroll") for (int n = 0; n < 2; ++n) _Pragma("unroll") for (int k = 0; k < 2; ++k) \
        acc[ai][bj][m][n] = __builtin_amdgcn_mfma_f32_16x16x32_bf16(Bt[n][k], At[m][k], acc[ai][bj][m][n], 0, 0, 0); __builtin_amdgcn_s_setprio(0); } while (0)
#define G8_WAIT_V(n) asm volatile("s_waitcnt vmcnt(" #n ")" ::: "memory")
#define G8_WAIT_L(n) asm volatile("s_waitcnt lgkmcnt(" #n ")" ::: "memory")
#define G8_BAR __builtin_amdgcn_s_barrier()
#define G8_SCHED __builtin_amdgcn_sched_barrier(0)
#define G8_VA(dst, u) do { const int _ac = S.a_col(u), _lda = S.lda(u); _Pragma("unroll") for (int _i = 0; _i < 2; ++_i) { int _R, _C; stage_rc(tid * 16 + _i * 8192, _R, _C); \
        _Pragma("unroll") for (int _h = 0; _h < 2; ++_h) dst[_h][_i] = (unsigned)(((size_t)S.a_row(u, _h * HALF + _R) * _lda + _ac + _C) * 2); } } while (0)
#define G8_VB(dst, hs, u) do { const int _ldb = S.ldb(u); hs = (size_t)HALF * _ldb * 2; _Pragma("unroll") for (int _i = 0; _i < 2; ++_i) { int _R, _C; stage_rc(tid * 16 + _i * 8192, _R, _C); \
        dst[_i] = (unsigned)(((_R & ~31) + perm32(_R & 31)) * _ldb + _C) * 2u; } } while (0)
    Unit cur, nxt; int ui = 0; bool aligned_end = false;
    if (!S.next(0, cur)) return;
    f32x4 acc[2][2][4][2];
#pragma unroll
    for (int a = 0; a < 2; ++a)
#pragma unroll
        for (int b = 0; b < 2; ++b)
#pragma unroll
            for (int m = 0; m < 4; ++m)
#pragma unroll
                for (int n = 0; n < 2; ++n) acc[a][b][m][n] = (f32x4){0.f, 0.f, 0.f, 0.f};
    bf16x8 At[4][2], B0[2][2], B1[2][2];
    unsigned va[2][2], nva[2][2], vb[2], nvb[2]; size_t hsB, nhsB;
    G8_VA(va, cur); G8_VB(vb, hsB, cur);
    const char* Ab = S.a_base(cur);
    const char* cB = S.b_base(cur);
#if G8_SP2
    G8_STAGE(G8_SB(0, 0), cB, vb); G8_STAGE(G8_SB(0, 1), cB + hsB, vb); G8_STAGE(G8_SA(0, 0), Ab, va[0]); G8_STAGE(G8_SA(0, 1), Ab, va[1]);
    if (wr == 1) G8_BAR;
    G8_WAIT_V(2); G8_BAR;
    G8_STAGE(G8_SB(1, 0), cB + kstep, vb); G8_STAGE(G8_SA(1, 0), Ab + kstep, va[0]); G8_STAGE(G8_SB(1, 1), cB + hsB + kstep, vb);
    G8_WAIT_V(6); G8_BAR;
#else
    G8_STAGE(G8_SB(0, 0), cB, vb); G8_STAGE(G8_SA(0, 0), Ab, va[0]); G8_STAGE(G8_SB(0, 1), cB + hsB, vb); G8_STAGE(G8_SA(0, 1), Ab, va[1]);
    if (wr == 1) G8_BAR;
    G8_WAIT_V(4); G8_BAR;
    G8_STAGE(G8_SB(1, 0), cB + kstep, vb); G8_STAGE(G8_SA(1, 0), Ab + kstep, va[0]); G8_STAGE(G8_SB(1, 1), cB + hsB + kstep, vb);
    G8_WAIT_V(6); G8_BAR;
#endif
    for (;;) {
        const bool has_next = S.next(ui + 1, nxt);
        const char* nB = cB; const char* nAb = Ab;
        if (has_next) { nB = S.b_base(nxt); nAb = S.a_base(nxt); G8_VA(nva, nxt); G8_VB(nvb, nhsB, nxt); }
        else {
            nhsB = hsB;
#pragma unroll
            for (int i = 0; i < 2; ++i) { nvb[i] = vb[i];
#pragma unroll
                for (int h = 0; h < 2; ++h) nva[h][i] = va[h][i]; }
        }
        const int nt = S.nt(cur);
        for (int t = 0; t < nt; t += 2) {
            const bool last = (t == nt - 2);
            const char* a1 = Ab + (size_t)(t + 1) * kstep;
            const char* a2 = last ? nAb : Ab + (size_t)(t + 2) * kstep;
            const char* b2 = last ? nB : cB + (size_t)(t + 2) * kstep;
            const char* a3 = a2 + kstep; const char* b3 = b2 + kstep;
            const size_t hs2 = last ? nhsB : hsB;
            unsigned v2[2][2], vb2[2];
#pragma unroll
            for (int i = 0; i < 2; ++i) { vb2[i] = last ? nvb[i] : vb[i];
#pragma unroll
                for (int h = 0; h < 2; ++h) v2[h][i] = last ? nva[h][i] : va[h][i]; }
#if G8_SP2
            G8_LDB(B0, 0, 0); G8_LDB(B1, 0, 1); G8_SCHED; G8_LDA(At, 0, 0); G8_STAGE(G8_SA(1, 1), a1, va[1]);
            G8_WAIT_V(8); G8_WAIT_L(0); G8_BAR; G8_MMA(0, 0, At, B0); G8_MMA(0, 1, At, B1); G8_BAR; G8_SCHED;
            G8_LDA(At, 0, 1); G8_STAGE(G8_SB(0, 0), b2, vb2); G8_STAGE(G8_SB(0, 1), b2 + hs2, vb2); G8_STAGE(G8_SA(0, 0), a2, v2[0]);
            G8_WAIT_V(8); G8_WAIT_L(0); G8_BAR; G8_MMA(1, 0, At, B0); G8_MMA(1, 1, At, B1); G8_BAR; G8_SCHED;
            G8_LDB(B0, 1, 0); G8_LDB(B1, 1, 1); G8_SCHED; G8_LDA(At, 1, 0); G8_STAGE(G8_SA(0, 1), a2, v2[1]);
            G8_WAIT_V(8); G8_WAIT_L(0); G8_BAR; G8_MMA(0, 0, At, B0); G8_MMA(0, 1, At, B1); G8_BAR; G8_SCHED;
            G8_LDA(At, 1, 1); G8_STAGE(G8_SB(1, 0), b3, vb2); G8_STAGE(G8_SB(1, 1), b3 + hs2, vb2); G8_STAGE(G8_SA(1, 0), a3, v2[0]);
            G8_WAIT_V(8); G8_WAIT_L(0); G8_BAR; G8_MMA(1, 0, At, B0); G8_MMA(1, 1, At, B1); G8_BAR; G8_SCHED;
#else
            G8_LDB(B0, 0, 0); G8_SCHED; G8_LDA(At, 0, 0); G8_STAGE(G8_SA(1, 1), a1, va[1]);
            G8_WAIT_L(8); G8_BAR; G8_WAIT_L(0); G8_MMA(0, 0, At, B0); G8_BAR; G8_SCHED;
            G8_LDB(B1, 0, 1); G8_STAGE(G8_SB(0, 0), b2, vb2);
            G8_BAR; G8_WAIT_L(0); G8_MMA(0, 1, At, B1); G8_BAR;
            G8_LDA(At, 0, 1); G8_STAGE(G8_SA(0, 0), a2, v2[0]);
            G8_BAR; G8_WAIT_L(0); G8_MMA(1, 0, At, B0); G8_BAR; G8_SCHED;
            G8_STAGE(G8_SB(0, 1), b2 + hs2, vb2);
            G8_WAIT_V(6); G8_BAR; G8_MMA(1, 1, At, B1); G8_BAR;
            G8_LDB(B0, 1, 0); G8_SCHED; G8_LDA(At, 1, 0); G8_STAGE(G8_SA(0, 1), a2, v2[1]);
            G8_WAIT_L(8); G8_BAR; G8_WAIT_L(0); G8_MMA(0, 0, At, B0); G8_BAR; G8_SCHED;
            G8_LDB(B1, 1, 1); G8_STAGE(G8_SB(1, 0), b3, vb2);
            G8_BAR; G8_WAIT_L(0); G8_MMA(0, 1, At, B1); G8_BAR;
            G8_LDA(At, 1, 1); G8_STAGE(G8_SA(1, 0), a3, v2[0]);
            G8_BAR; G8_WAIT_L(0); G8_MMA(1, 0, At, B0); G8_BAR; G8_SCHED;
            G8_STAGE(G8_SB(1, 1), b3 + hs2, vb2);
            G8_WAIT_V(6); G8_BAR; G8_MMA(1, 1, At, B1); G8_BAR;
#endif
        }
        const bool keep = S.cont(cur);
        if (!keep) {
            if (wr == 0) G8_BAR;
            E(acc, cur, wr, wc, fr, fq);
            if (has_next && wr == 1) G8_BAR;
        }
        if (!has_next) { aligned_end = !keep; break; }
        if (!keep) {
#pragma unroll
            for (int a = 0; a < 2; ++a)
#pragma unroll
                for (int b = 0; b < 2; ++b)
#pragma unroll
                    for (int m = 0; m < 4; ++m)
#pragma unroll
                        for (int n = 0; n < 2; ++n) acc[a][b][m][n] = (f32x4){0.f, 0.f, 0.f, 0.f};
        }
        cur = nxt; cB = nB; Ab = nAb; hsB = nhsB; ++ui;
#pragma unroll
        for (int i = 0; i < 2; ++i) { vb[i] = nvb[i];
#pragma unroll
            for (int h = 0; h < 2; ++h) va[h][i] = nva[h][i]; }
    }
    G8_WAIT_V(0);
    if (!aligned_end && wr == 0) G8_BAR;
    G8_BAR;
#undef G8_SA
#undef G8_SB
#undef G8_STAGE
#undef G8_LDA
#undef G8_LDB
#undef G8_MMA
#undef G8_WAIT_V
#undef G8_WAIT_L
#undef G8_BAR
#undef G8_SCHED
#undef G8_VA
#undef G8_VB
}

struct DenseSched {
    __device__ __forceinline__ int lda(const Unit&) const { return lda_; }
    __device__ __forceinline__ int ldb(const Unit&) const { return ldb_; }
    __device__ __forceinline__ int nt(const Unit&) const { return K / BK; }
    __device__ __forceinline__ bool cont(const Unit&) const { return false; }
    int nN, nU, K, lda_, ldb_; const bf16_t* A; const bf16_t* Bt;
    __device__ __forceinline__ const char* a_base(const Unit&) const { return (const char*)A; }
    __device__ __forceinline__ bool next(int i, Unit& u) const {
        const int c = blockIdx.x, per = gridDim.x >> 3, x = c & 7, j = c >> 3;
        const int chunk = (nU + 7) >> 3, lu = i * per + j;
        if (lu >= chunk) return false;
        const int un = x * chunk + lu; if (un >= nU) return false;
        u.pm = un / nN; u.pn = un - u.pm * nN; u.e = 0; return true; }
    __device__ __forceinline__ int a_row(const Unit& u, int r) const { return u.pm * BM + r; }
    __device__ __forceinline__ int a_col(const Unit&) const { return 0; }
    __device__ __forceinline__ const char* b_base(const Unit& u) const { return (const char*)(Bt + (size_t)u.pn * BM * ldb_); }
};

struct EpiGlu {
    bf16_t* U; const float* rs; const float* bias;
    __device__ __forceinline__ void operator()(const f32x4 (&acc)[2][2][4][2], const Unit& u, int wr, int wc, int fr, int fq) const {
        const int c0 = u.pn * 128 + wc * 32 + 8 * fq;
        const f32x4 ba0 = *(const f32x4*)(bias + c0), ba1 = *(const f32x4*)(bias + c0 + 4), bg0 = *(const f32x4*)(bias + 1024 + c0), bg1 = *(const f32x4*)(bias + 1024 + c0 + 4);
        float rv[2][4];
#pragma unroll
        for (int ai = 0; ai < 2; ++ai)
#pragma unroll
            for (int m = 0; m < 4; ++m) rv[ai][m] = rs[u.pm * BM + ai * HALF + wr * 64 + m * 16 + fr];
        __builtin_amdgcn_sched_barrier(0);
#pragma unroll
        for (int ai = 0; ai < 2; ++ai)
#pragma unroll
            for (int m = 0; m < 4; ++m) {
                const int row = u.pm * BM + ai * HALF + wr * 64 + m * 16 + fr; const float r = rv[ai][m];
                f32x4 o0, o1;
#pragma unroll
                for (int j = 0; j < 4; ++j) {
                    o0[j] = (acc[ai][0][m][0][j] * r + ba0[j]) * fast_sigmoid(acc[ai][1][m][0][j] * r + bg0[j]);
                    o1[j] = (acc[ai][0][m][1][j] * r + ba1[j]) * fast_sigmoid(acc[ai][1][m][1][j] * r + bg1[j]); }
                *(u32x4*)(U + (size_t)row * D + c0) = pack8(o0, o1);
            }
    }
};
struct EpiXres {
    bf16_t* XB; const float* bias; float* ssp;
    __device__ __forceinline__ void operator()(const f32x4 (&acc)[2][2][4][2], const Unit& u, int wr, int wc, int fr, int fq) const {
        f32x4 bv[2][2];
#pragma unroll
        for (int bj = 0; bj < 2; ++bj) { const int c0 = u.pn * BM + bj * HALF + wc * 32 + 8 * fq;
            bv[bj][0] = bias ? *(const f32x4*)(bias + c0) : (f32x4){0.f, 0.f, 0.f, 0.f}; bv[bj][1] = bias ? *(const f32x4*)(bias + c0 + 4) : (f32x4){0.f, 0.f, 0.f, 0.f}; }
#pragma unroll
        for (int ai = 0; ai < 2; ++ai) {
            u32x4 xv[2][4][2];
#pragma unroll
            for (int m = 0; m < 4; ++m)
#pragma unroll
                for (int bj = 0; bj < 2; ++bj) xv[ai][m][bj] = *(const u32x4*)(XB + (size_t)(u.pm * BM + ai * HALF + wr * 64 + m * 16 + fr) * D + u.pn * BM + bj * HALF + wc * 32 + 8 * fq);
            __builtin_amdgcn_sched_barrier(0);
#pragma unroll
            for (int m = 0; m < 4; ++m) {
                const int row = u.pm * BM + ai * HALF + wr * 64 + m * 16 + fr; float ss = 0.f;
#pragma unroll
                for (int bj = 0; bj < 2; ++bj) {
                    const size_t off = (size_t)row * D + u.pn * BM + bj * HALF + wc * 32 + 8 * fq; const u32x4 xw = xv[ai][m][bj];
                    const f32x4 v0 = (f32x4){bf_lo(xw.x), bf_hi(xw.x), bf_lo(xw.y), bf_hi(xw.y)} + acc[ai][bj][m][0] + bv[bj][0];
                    const f32x4 v1 = (f32x4){bf_lo(xw.z), bf_hi(xw.z), bf_lo(xw.w), bf_hi(xw.w)} + acc[ai][bj][m][1] + bv[bj][1];
                    const u32x4 w = pack8(v0, v1);
                    *(u32x4*)(XB + off) = w;
                    const float r0 = bf_lo(w.x), r1 = bf_hi(w.x), r2 = bf_lo(w.y), r3 = bf_hi(w.y), r4 = bf_lo(w.z), r5 = bf_hi(w.z), r6 = bf_lo(w.w), r7 = bf_hi(w.w);
                    ss += (r0 * r0 + r1 * r1) + (r2 * r2 + r3 * r3) + (r4 * r4 + r5 * r5) + (r6 * r6 + r7 * r7);
                }
                if (ssp) { ss += __shfl_xor(ss, 16); ss += __shfl_xor(ss, 32); if (fq == 0) ssp[(size_t)row * 16 + u.pn * 4 + wc] = ss; }
            }
            __builtin_amdgcn_sched_barrier(0);
        }
    }
};
struct AttnSched {
    __device__ __forceinline__ int lda(const Unit&) const { return lda_; }
    __device__ __forceinline__ int ldb(const Unit&) const { return ldb_; }
    __device__ __forceinline__ int nt(const Unit&) const { return K / BK; }
    __device__ __forceinline__ bool cont(const Unit&) const { return false; }
    int K, lda_, ldb_; const bf16_t* A; const bf16_t* Bm; int pv;
    __device__ __forceinline__ bool next(int i, Unit& u) const {
        const int c = blockIdx.x, per = gridDim.x >> 3, x = c & 7, j = c >> 3;
        const int lu = i * per + j; if (lu >= 64) return false;
        const int un = x * 64 + lu;
        u.pm = un >> 2; u.pn = 0; u.e = un & 3; return true; }
    __device__ __forceinline__ const char* a_base(const Unit&) const { return (const char*)A; }
    __device__ __forceinline__ int a_row(const Unit& u, int r) const { return u.pm * BM + r; }
    __device__ __forceinline__ int a_col(const Unit& u) const { return u.e * 256; }
    __device__ __forceinline__ const char* b_base(const Unit& u) const { const int b = u.pm >> 5;
        return pv ? (const char*)(Bm + (size_t)(b * 4 + u.e) * 65536) : (const char*)(Bm + (size_t)(b * 256) * 1024 + u.e * 256); }
};
struct KVSched {
    __device__ __forceinline__ int lda(const Unit&) const { return lda_; }
    __device__ __forceinline__ int ldb(const Unit&) const { return ldb_; }
    __device__ __forceinline__ int nt(const Unit&) const { return K / BK; }
    __device__ __forceinline__ bool cont(const Unit&) const { return false; }
    int K, lda_, ldb_; const bf16_t* MEMNB; const bf16_t* WKV;
    __device__ __forceinline__ bool next(int i, Unit& u) const {
        const int un = i * (int)gridDim.x + (int)blockIdx.x; if (un >= 32) return false;
        u.e = un >> 4; u.pm = (un & 15) >> 2; u.pn = un & 3; return true; }
    __device__ __forceinline__ const char* a_base(const Unit& u) const { return u.e ? (const char*)(WKV + (size_t)1024 * 1024) : (const char*)MEMNB; }
    __device__ __forceinline__ int a_row(const Unit& u, int r) const { return u.pm * BM + r; }
    __device__ __forceinline__ int a_col(const Unit&) const { return 0; }
    __device__ __forceinline__ const char* b_base(const Unit& u) const { return u.e ? (const char*)(MEMNB + (size_t)u.pn * BM * 1024) : (const char*)(WKV + (size_t)u.pn * BM * 1024); }
};
__device__ __forceinline__ float ssp_rs(const float* ssp, int row) {
    const f32x4 a = *(const f32x4*)(ssp + (size_t)row * 16), b = *(const f32x4*)(ssp + (size_t)row * 16 + 4), c = *(const f32x4*)(ssp + (size_t)row * 16 + 8), d = *(const f32x4*)(ssp + (size_t)row * 16 + 12);
    const float s = ((a[0] + a[1]) + (a[2] + a[3])) + ((b[0] + b[1]) + (b[2] + b[3])) + ((c[0] + c[1]) + (c[2] + c[3])) + ((d[0] + d[1]) + (d[2] + d[3]));
    return rsqrtf(s * (1.0f / D) + EPS);
}
struct EpiRowScale {
    bf16_t* O; int ldo; const float* ssp; const float* rs; float scale; int qtiles; float qscale;
    __device__ __forceinline__ void operator()(const f32x4 (&acc)[2][2][4][2], const Unit& u, int wr, int wc, int fr, int fq) const {
        const float cs = scale * (u.pn < qtiles ? qscale : 1.0f);
        float rv[2][4];
        if (rs) {
#pragma unroll
            for (int ai = 0; ai < 2; ++ai)
#pragma unroll
                for (int m = 0; m < 4; ++m) rv[ai][m] = rs[u.pm * BM + ai * HALF + wr * 64 + m * 16 + fr];
        } else {
#pragma unroll
            for (int ai = 0; ai < 2; ++ai) {
                f32x4 p[4][4];
#pragma unroll
                for (int m = 0; m < 4; ++m)
#pragma unroll
                    for (int q = 0; q < 4; ++q) p[m][q] = *(const f32x4*)(ssp + (size_t)(u.pm * BM + ai * HALF + wr * 64 + m * 16 + fr) * 16 + 4 * q);
                __builtin_amdgcn_sched_barrier(0);
#pragma unroll
                for (int m = 0; m < 4; ++m) { float sm = 0.f;
#pragma unroll
                    for (int q = 0; q < 4; ++q) sm += (p[m][q][0] + p[m][q][1]) + (p[m][q][2] + p[m][q][3]);
                    rv[ai][m] = rsqrtf(sm * (1.0f / D) + EPS); }
            }
        }
        __builtin_amdgcn_sched_barrier(0);
#pragma unroll
        for (int ai = 0; ai < 2; ++ai)
#pragma unroll
            for (int m = 0; m < 4; ++m) {
                const int row = u.pm * BM + ai * HALF + wr * 64 + m * 16 + fr;
                const float r = rv[ai][m] * cs;
#pragma unroll
                for (int bj = 0; bj < 2; ++bj) { const int c0 = u.pn * BM + bj * HALF + wc * 32 + 8 * fq;
                    *(u32x4*)(O + (size_t)row * ldo + c0) = pack8(acc[ai][bj][m][0] * r, acc[ai][bj][m][1] * r); }
            }
    }
};
struct EpiKV {
    bf16_t* Kb; bf16_t* VT;
    __device__ __forceinline__ void operator()(const f32x4 (&acc)[2][2][4][2], const Unit& u, int wr, int wc, int fr, int fq) const {
        bf16_t* base = u.e ? VT + (size_t)(u.pn * 4 + u.pm) * 65536 : Kb + (size_t)u.pm * BM * 1024 + u.pn * BM;
        const int ld = u.e ? 256 : 1024;
#pragma unroll
        for (int ai = 0; ai < 2; ++ai)
#pragma unroll
            for (int m = 0; m < 4; ++m) { const int r = ai * HALF + wr * 64 + m * 16 + fr;
#pragma unroll
                for (int bj = 0; bj < 2; ++bj) { const int c0 = bj * HALF + wc * 32 + 8 * fq;
                    *(u32x4*)(base + (size_t)r * ld + c0) = pack8(acc[ai][bj][m][0], acc[ai][bj][m][1]); } }
    }
};
struct EpiS {
    bf16_t* P; float* psum;
    __device__ __forceinline__ void operator()(const f32x4 (&acc)[2][2][4][2], const Unit& u, int wr, int wc, int fr, int fq) const {
#pragma unroll
        for (int ai = 0; ai < 2; ++ai)
#pragma unroll
            for (int m = 0; m < 4; ++m) {
                const int row = u.pm * BM + ai * HALF + wr * 64 + m * 16 + fr; float ps = 0.f;
#pragma unroll
                for (int bj = 0; bj < 2; ++bj) { const int c0 = u.e * 256 + bj * HALF + wc * 32 + 8 * fq;
                    f32x4 e0, e1;
#pragma unroll
                    for (int j = 0; j < 4; ++j) { e0[j] = __builtin_amdgcn_exp2f(acc[ai][bj][m][0][j] * 1.4426950408889634f); e1[j] = __builtin_amdgcn_exp2f(acc[ai][bj][m][1][j] * 1.4426950408889634f); }
                    const u32x4 w = pack8(e0, e1);
                    *(u32x4*)(P + (size_t)row * D + c0) = w;
                    ps += (bf_lo(w.x) + bf_hi(w.x)) + (bf_lo(w.y) + bf_hi(w.y)) + (bf_lo(w.z) + bf_hi(w.z)) + (bf_lo(w.w) + bf_hi(w.w)); }
                ps += __shfl_xor(ps, 16); ps += __shfl_xor(ps, 32);
                if (fq == 0) psum[(size_t)row * 16 + u.e * 4 + wc] = ps;
            }
    }
};
struct EpiPV {
    bf16_t* O; const float* psum;
    __device__ __forceinline__ void operator()(const f32x4 (&acc)[2][2][4][2], const Unit& u, int wr, int wc, int fr, int fq) const {
        f32x4 sv[2][4];
#pragma unroll
        for (int ai = 0; ai < 2; ++ai)
#pragma unroll
            for (int m = 0; m < 4; ++m) sv[ai][m] = *(const f32x4*)(psum + (size_t)(u.pm * BM + ai * HALF + wr * 64 + m * 16 + fr) * 16 + u.e * 4);
        __builtin_amdgcn_sched_barrier(0);
#pragma unroll
        for (int ai = 0; ai < 2; ++ai)
#pragma unroll
            for (int m = 0; m < 4; ++m) {
                const int row = u.pm * BM + ai * HALF + wr * 64 + m * 16 + fr;
                const float inv = 1.0f / ((sv[ai][m][0] + sv[ai][m][1]) + (sv[ai][m][2] + sv[ai][m][3]));
#pragma unroll
                for (int bj = 0; bj < 2; ++bj) { const int c0 = u.e * 256 + bj * HALF + wc * 32 + 8 * fq;
                    *(u32x4*)(O + (size_t)row * D + c0) = pack8(acc[ai][bj][m][0] * inv, acc[ai][bj][m][1] * inv); }
            }
    }
};

__device__ __forceinline__ int ld_agent(const int* p) { return __hip_atomic_load(p, __ATOMIC_RELAXED, __HIP_MEMORY_SCOPE_AGENT); }
struct MoeSched {
    __device__ __forceinline__ int lda(const Unit&) const { return lda_; }
    __device__ __forceinline__ int ldb(const Unit&) const { return ldb_; }
    __device__ __forceinline__ int nt(const Unit&) const { return K / BK; }
    __device__ __forceinline__ bool cont(const Unit&) const { return false; }
    int K, lda_, ldb_; const bf16_t* A; const bf16_t* W; size_t wstride; const LAS int* mt; const int* etok; int NT;
    __device__ __forceinline__ bool next(int i, Unit& u) const {
        const int c = blockIdx.x, per = gridDim.x >> 3, x = c & 7, j = c >> 3;
        const int tpx = (NT + 7) >> 3, lu = i * per + j, lrt = lu >> 2;
        if (lrt >= tpx) return false;
        const int rt = x * tpx + lrt; if (rt >= NT) return false;
        const int e = __builtin_amdgcn_readfirstlane(mt[80 + rt]), lt = rt - __builtin_amdgcn_readfirstlane(mt[e]);
        u.pm = rt; u.pn = lu & 3; u.e = e | (lt << 5); return true; }
    __device__ __forceinline__ const char* a_base(const Unit&) const { return (const char*)A; }
    __device__ __forceinline__ int a_row(const Unit& u, int r) const {
        if (!etok) return u.pm * BM + r;
        const int e = u.e & 31, p = (u.e >> 5) * BM + r; return p < mt[40 + e] ? etok[e * CAPE + p] : 0; }
    __device__ __forceinline__ int a_col(const Unit&) const { return 0; }
    __device__ __forceinline__ const char* b_base(const Unit& u) const { return (const char*)(W + (size_t)(u.e & 31) * wstride + (size_t)u.pn * BM * ldb_); }
};
__device__ __forceinline__ int moe_tiles(const int* gcnt, LAS int* mt) {
    const int tix = otid();
    if (tix < 32) mt[40 + tix] = ld_agent(gcnt + tix * GCS);
    __syncthreads();
    if (tix == 0) { int o = 0; for (int e = 0; e < 32; ++e) { mt[e] = o; o += (mt[40 + e] + 255) >> 8; } mt[32] = o; }
    __syncthreads();
    const int NT = mt[32];
    for (int rt = tix; rt < NT; rt += 512) { int e = 0;
#pragma unroll 1
        for (int k = 1; k < 32; ++k) if (rt >= mt[k]) e = k;
        mt[80 + rt] = e; }
    __syncthreads();
    return __builtin_amdgcn_readfirstlane(NT);
}
struct EpiMoe1 {
    bf16_t* H; const float* ers; const LAS int* mt;
    __device__ __forceinline__ void operator()(const f32x4 (&acc)[2][2][4][2], const Unit& u, int wr, int wc, int fr, int fq) const {
        const int c0 = u.pn * 128 + wc * 32 + 8 * fq;
        const int e = u.e & 31, p0 = (u.e >> 5) * BM, nv = mt[40 + e] - p0;
        const float* rsp = ers + (size_t)e * CAPE + p0;
        float rv[2][4];
#pragma unroll
        for (int ai = 0; ai < 2; ++ai)
#pragma unroll
            for (int m = 0; m < 4; ++m) { const int r = ai * HALF + wr * 64 + m * 16 + fr; rv[ai][m] = r < nv ? rsp[r] : 0.f; }
        __builtin_amdgcn_sched_barrier(0);
#pragma unroll
        for (int ai = 0; ai < 2; ++ai)
#pragma unroll
            for (int m = 0; m < 4; ++m) {
                const int row = u.pm * BM + ai * HALF + wr * 64 + m * 16 + fr; const float r = rv[ai][m];
                f32x4 o0, o1;
#pragma unroll
                for (int j = 0; j < 4; ++j) {
                    const float g0 = acc[ai][0][m][0][j] * r, g1 = acc[ai][0][m][1][j] * r;
                    o0[j] = g0 * fast_sigmoid(g0) * (acc[ai][1][m][0][j] * r);
                    o1[j] = g1 * fast_sigmoid(g1) * (acc[ai][1][m][1][j] * r); }
                *(u32x4*)(H + (size_t)row * DE + c0) = pack8(o0, o1);
            }
    }
};
struct EpiMoe2 {
    bf16_t* Y; const int* ea; const float* egate; const LAS int* mt;
    __device__ __forceinline__ void operator()(const f32x4 (&acc)[2][2][4][2], const Unit& u, int wr, int wc, int fr, int fq) const {
        const int e = u.e & 31, p0 = (u.e >> 5) * BM, nv = mt[40 + e] - p0;
        const int* ap = ea + (size_t)e * CAPE + p0; const float* gp = egate + (size_t)e * CAPE + p0;
        int av[2][4]; float gv[2][4];
#pragma unroll
        for (int ai = 0; ai < 2; ++ai)
#pragma unroll
            for (int m = 0; m < 4; ++m) { const int r = ai * HALF + wr * 64 + m * 16 + fr; const bool ok = r < nv; av[ai][m] = ok ? ap[r] : -1; gv[ai][m] = ok ? gp[r] : 0.f; }
        __builtin_amdgcn_sched_barrier(0);
#pragma unroll
        for (int ai = 0; ai < 2; ++ai)
#pragma unroll
            for (int m = 0; m < 4; ++m) {
                const int a = av[ai][m]; const float g = gv[ai][m];
                if (a >= 0) {
#pragma unroll
                    for (int bj = 0; bj < 2; ++bj) { const int c0 = u.pn * BM + bj * HALF + wc * 32 + 8 * fq;
                        *(u32x4*)(Y + (size_t)a * D + c0) = pack8(acc[ai][bj][m][0] * g, acc[ai][bj][m][1] * g); }
                }
            }
    }
};

struct GlaInSched {
    const bf16_t* XB; const bf16_t* WTM; const bf16_t* WFM;
    __device__ __forceinline__ int lda(const Unit&) const { return D; }
    __device__ __forceinline__ int ldb(const Unit&) const { return D; }
    __device__ __forceinline__ int nt(const Unit&) const { return D / BK; }
    __device__ __forceinline__ bool cont(const Unit&) const { return false; }
    __device__ __forceinline__ bool next(int i, Unit& u) const {
        const int c = blockIdx.x, per = gridDim.x >> 3, x = c & 7, j = c >> 3, lu = i * per + j;
        if (lu >= 192) return false;
        const int un = x * 192 + lu;
        if (un < 1024) { u.e = 0; u.pm = un >> 3; u.pn = un & 7; } else { const int v = un - 1024; u.e = 1; u.pn = v >> 2; u.pm = 2 + (v & 3); }
        return true; }
    __device__ __forceinline__ const char* a_base(const Unit& u) const { return u.e ? (const char*)WFM : (const char*)XB; }
    __device__ __forceinline__ int a_row(const Unit& u, int r) const { return u.pm * BM + r; }
    __device__ __forceinline__ int a_col(const Unit&) const { return 0; }
    __device__ __forceinline__ const char* b_base(const Unit& u) const { return u.e ? (const char*)(XB + (size_t)u.pn * BM * D) : (const char*)(WTM + (size_t)u.pn * BM * D); }
};

struct EpiGlaIn {
    bf16_t* QKR; bf16_t* KVT; const float* RS; const bf16_t* EQ; const bf16_t* EKF;
    __device__ __forceinline__ void operator()(const f32x4 (&acc)[2][2][4][2], const Unit& u, int wr, int wc, int fr, int fq) const {
        if (u.e == 0) {
            float rv[2][4];
#pragma unroll
            for (int ai = 0; ai < 2; ++ai)
#pragma unroll
                for (int m = 0; m < 4; ++m) rv[ai][m] = RS[u.pm * BM + ai * HALF + wr * 64 + m * 16 + fr];
            const float qs = u.pn < 2 ? 0.08838834764831845f : 1.0f;
            const bf16_t* F = EQ + (u.pn < 2 ? (size_t)0 : (size_t)T * 512);
#pragma unroll
            for (int ai = 0; ai < 2; ++ai) {
                u32x4 fv[4][2];
                if (u.pn < 4) {
#pragma unroll
                    for (int m = 0; m < 4; ++m)
#pragma unroll
                        for (int bj = 0; bj < 2; ++bj) { const int row = u.pm * BM + ai * HALF + wr * 64 + m * 16 + fr, kf = (u.pn * BM + bj * HALF + wc * 32 + 8 * fq) & 511;
                            fv[m][bj] = *(const u32x4*)(F + (size_t)row * 512 + kf); }
                }
                __builtin_amdgcn_sched_barrier(0);
#pragma unroll
                for (int m = 0; m < 4; ++m) {
                    const int row = u.pm * BM + ai * HALF + wr * 64 + m * 16 + fr; const float r = rv[ai][m] * qs;
#pragma unroll
                    for (int bj = 0; bj < 2; ++bj) { const int c0 = u.pn * BM + bj * HALF + wc * 32 + 8 * fq;
                        f32x4 s0 = (f32x4){r, r, r, r}, s1 = s0;
                        if (u.pn < 4) { const u32x4 w = fv[m][bj];
                            s0 *= (f32x4){bf_lo(w.x), bf_hi(w.x), bf_lo(w.y), bf_hi(w.y)}; s1 *= (f32x4){bf_lo(w.z), bf_hi(w.z), bf_lo(w.w), bf_hi(w.w)}; }
                        const u32x4 w = pack8(acc[ai][bj][m][0] * s0, acc[ai][bj][m][1] * s1);
                        *(u32x4*)(QKR + (size_t)row * 2048 + c0) = w;
                        if (u.pn == 2 || u.pn == 3) {
                            bf16_t* kt = KVT + (size_t)(c0 - 512) * T + row;
                            kt[0] = (bf16_t)(w.x & 0xffffu); kt[(size_t)T] = (bf16_t)(w.x >> 16); kt[(size_t)2 * T] = (bf16_t)(w.y & 0xffffu); kt[(size_t)3 * T] = (bf16_t)(w.y >> 16);
                            kt[(size_t)4 * T] = (bf16_t)(w.z & 0xffffu); kt[(size_t)5 * T] = (bf16_t)(w.z >> 16); kt[(size_t)6 * T] = (bf16_t)(w.w & 0xffffu); kt[(size_t)7 * T] = (bf16_t)(w.w >> 16); } }
                }
                __builtin_amdgcn_sched_barrier(0);
            }
        } else {
#pragma unroll
            for (int bj = 0; bj < 2; ++bj) { const int t0 = u.pn * BM + bj * HALF + wc * 32 + 8 * fq;
                const f32x4 r0 = *(const f32x4*)(RS + t0), r1 = *(const f32x4*)(RS + t0 + 4);
#pragma unroll
                for (int ai = 0; ai < 2; ++ai)
#pragma unroll
                    for (int m = 0; m < 4; ++m) { const int f = u.pm * BM + ai * HALF + wr * 64 + m * 16 + fr;
                        *(u32x4*)(KVT + (size_t)f * T + t0) = pack8(acc[ai][bj][m][0] * r0, acc[ai][bj][m][1] * r1); }
            }
        }
    }
};
template <int TYP> struct GlaAttSched {
    const bf16_t* QKR; const bf16_t* KVT;
    __device__ __forceinline__ bool next(int i, Unit& u) const {
        const int c = blockIdx.x, per = gridDim.x >> 3, x = c & 7, j = c >> 3, lu = i * per + j;
        if (lu >= 64) return false;
        const int un = x * 64 + lu, bh = un >> 5, cc = un & 31;
        u.e = TYP; u.pm = (bh >> 2) * 32 + cc; u.pn = bh & 3; return true; }
    __device__ __forceinline__ int lda(const Unit& u) const { return TYP ? T : 2048; }
    __device__ __forceinline__ int ldb(const Unit& u) const { return TYP ? T : 2048; }
    __device__ __forceinline__ int nt(const Unit& u) const { int n = TYP ? 4 : 2; asm volatile("" : "+s"(n)); return n; }
    __device__ __forceinline__ bool cont(const Unit&) const { return false; }
    __device__ __forceinline__ const char* a_base(const Unit& u) const { return TYP ? (const char*)KVT : (const char*)QKR; }
    __device__ __forceinline__ int a_row(const Unit& u, int r) const { return TYP ? 512 + u.pn * 256 + r : u.pm * BM + r; }
    __device__ __forceinline__ int a_col(const Unit& u) const { return TYP ? u.pm * BM : u.pn * 128; }
    __device__ __forceinline__ const char* b_base(const Unit& u) const {
        return TYP ? (const char*)(KVT + (size_t)(u.pn * 128) * T + (size_t)u.pm * BM) : (const char*)(QKR + (size_t)u.pm * BM * 2048 + 512 + u.pn * 128); }
};
template <int TYP> struct EpiGlaAtt {
    bf16_t* ATT; bf16_t* UT; const float* DL;
    __device__ __forceinline__ void operator()(const f32x4 (&acc)[2][2][4][2], const Unit& u, int wr, int wc, int fr, int fq) const {
        if (TYP == 0) {
#pragma unroll
            for (int ai = 0; ai < 2; ++ai)
#pragma unroll
                for (int m = 0; m < 4; ++m) { const int rit = ai * HALF + wr * 64 + m * 16 + fr;
#pragma unroll
                    for (int bj = 0; bj < 2; ++bj) { const int c0 = bj * HALF + wc * 32 + 8 * fq;
                        f32x4 v0 = acc[ai][bj][m][0], v1 = acc[ai][bj][m][1];
#pragma unroll
                        for (int j = 0; j < 4; ++j) { if (c0 + j > rit) v0[j] = 0.f; if (c0 + 4 + j > rit) v1[j] = 0.f; }
                        *(u32x4*)(ATT + (size_t)(u.pm * BM + rit) * D + u.pn * 256 + c0) = pack8(v0, v1); }
                }
        } else {
            const int k0 = wc * 32 + 8 * fq;
            const f32x4 d0 = *(const f32x4*)(DL + (size_t)u.pm * 512 + u.pn * 128 + k0), d1 = *(const f32x4*)(DL + (size_t)u.pm * 512 + u.pn * 128 + k0 + 4);
            const int b = u.pm >> 5, cc = u.pm & 31; bf16_t* base = UT + (size_t)((b * 4 + u.pn) * 32 + cc) * 32768;
#pragma unroll
            for (int ai = 0; ai < 2; ++ai)
#pragma unroll
                for (int m = 0; m < 4; ++m) { const int dv = ai * HALF + wr * 64 + m * 16 + fr;
                    *(u32x4*)(base + (size_t)dv * 128 + k0) = pack8(acc[ai][0][m][0] * d0, acc[ai][0][m][1] * d1); }
        }
    }
};
struct GlaOSched {
    const bf16_t* QKR; const bf16_t* KVT; const bf16_t* ATT; const bf16_t* SP;
    __device__ __forceinline__ bool next(int i, Unit& u) const {
        const int c = blockIdx.x, per = gridDim.x >> 3, x = c & 7, j = c >> 3, pl = (i >> 1) * per + j;
        if (pl >= 64) return false;
        const int w = x * 64 + pl, bh = w >> 5, cc = w & 31;
        u.e = i & 1; u.pm = (bh >> 2) * 32 + cc; u.pn = bh & 3; return true; }
    __device__ __forceinline__ int lda(const Unit& u) const { return u.e ? D : 2048; }
    __device__ __forceinline__ int ldb(const Unit& u) const { return u.e ? T : 128; }
    __device__ __forceinline__ int nt(const Unit& u) const { return u.e ? 4 : 2; }
    __device__ __forceinline__ bool cont(const Unit& u) const { return u.e == 0; }
    __device__ __forceinline__ const char* a_base(const Unit& u) const { return u.e ? (const char*)ATT : (const char*)QKR; }
    __device__ __forceinline__ int a_row(const Unit& u, int r) const { return u.pm * BM + r; }
    __device__ __forceinline__ int a_col(const Unit& u) const { return u.e ? u.pn * 256 : u.pn * 128; }
    __device__ __forceinline__ const char* b_base(const Unit& u) const { const int b = u.pm >> 5, cc = u.pm & 31;
        return u.e ? (const char*)(KVT + (size_t)(512 + u.pn * 256) * T + (size_t)u.pm * BM) : (const char*)(SP + (size_t)((b * 4 + u.pn) * 32 + cc) * 32768); }
};
struct EpiGlaO {
    bf16_t* GO; const bf16_t* QKR; const float* ng; LAS float* part;
    __device__ __forceinline__ void operator()(const f32x4 (&acc)[2][2][4][2], const Unit& u, int wr, int wc, int fr, int fq) const {
#pragma unroll
        for (int ai = 0; ai < 2; ++ai)
#pragma unroll
            for (int m = 0; m < 4; ++m) { float ss = 0.f;
#pragma unroll
                for (int bj = 0; bj < 2; ++bj)
#pragma unroll
                    for (int n = 0; n < 2; ++n) { const f32x4 x = acc[ai][bj][m][n]; ss += (x[0] * x[0] + x[1] * x[1]) + (x[2] * x[2] + x[3] * x[3]); }
                ss += __shfl_xor(ss, 16); ss += __shfl_xor(ss, 32);
                if (fq == 0) part[(ai * HALF + wr * 64 + m * 16 + fr) * 4 + wc] = ss; }
        asm volatile("s_waitcnt lgkmcnt(0)" ::: "memory"); __builtin_amdgcn_s_barrier(); asm volatile("" ::: "memory");
        f32x4 gv[2][2];
#pragma unroll
        for (int bj = 0; bj < 2; ++bj) { const int c0 = bj * HALF + wc * 32 + 8 * fq; gv[bj][0] = *(const f32x4*)(ng + c0); gv[bj][1] = *(const f32x4*)(ng + c0 + 4); }
#pragma unroll
        for (int ai = 0; ai < 2; ++ai) {
            u32x4 rv[4][2];
#pragma unroll
            for (int m = 0; m < 4; ++m)
#pragma unroll
                for (int bj = 0; bj < 2; ++bj) rv[m][bj] = *(const u32x4*)(QKR + (size_t)(u.pm * BM + ai * HALF + wr * 64 + m * 16 + fr) * 2048 + 1024 + u.pn * 256 + bj * HALF + wc * 32 + 8 * fq);
            __builtin_amdgcn_sched_barrier(0);
#pragma unroll
            for (int m = 0; m < 4; ++m) { const int rit = ai * HALF + wr * 64 + m * 16 + fr, row = u.pm * BM + rit;
                const f32x4 p4 = *(const LAS f32x4*)(part + rit * 4);
                const float rstd = rsqrtf(((p4[0] + p4[1]) + (p4[2] + p4[3])) * (1.0f / GDVH) + EPS);
#pragma unroll
                for (int bj = 0; bj < 2; ++bj) { const int c0 = u.pn * 256 + bj * HALF + wc * 32 + 8 * fq; const u32x4 rw = rv[m][bj];
                    const f32x4 r0 = (f32x4){bf_lo(rw.x), bf_hi(rw.x), bf_lo(rw.y), bf_hi(rw.y)}, r1 = (f32x4){bf_lo(rw.z), bf_hi(rw.z), bf_lo(rw.w), bf_hi(rw.w)};
                    f32x4 y0, y1;
#pragma unroll
                    for (int j = 0; j < 4; ++j) { y0[j] = acc[ai][bj][m][0][j] * rstd * gv[bj][0][j] * (r0[j] * fast_sigmoid(r0[j])); y1[j] = acc[ai][bj][m][1][j] * rstd * gv[bj][1][j] * (r1[j] * fast_sigmoid(r1[j])); }
                    *(u32x4*)(GO + (size_t)row * D + c0) = pack8(y0, y1); }
            }
            __builtin_amdgcn_sched_barrier(0);
        }
    }
};

struct KV2Sched {
    const bf16_t* MEMNB; const bf16_t* WKV;
    __device__ __forceinline__ int lda(const Unit&) const { return D; }
    __device__ __forceinline__ int ldb(const Unit&) const { return D; }
    __device__ __forceinline__ int nt(const Unit&) const { return D / BK; }
    __device__ __forceinline__ bool cont(const Unit&) const { return false; }
    __device__ __forceinline__ bool next(int i, Unit& u) const {
        int bx = (int)blockIdx.x; asm volatile("" : "+s"(bx)); if (i > 0 || bx >= 128) return false; const int un = bx & 31;
        int e = un >> 4; asm volatile("" : "+s"(e)); u.e = e; u.pm = (un & 15) >> 2; u.pn = un & 3; return true; }
    __device__ __forceinline__ const char* a_base(const Unit&) const { return (const char*)MEMNB; }
    __device__ __forceinline__ int a_row(const Unit& u, int r) const { return u.pm * BM + r; }
    __device__ __forceinline__ int a_col(const Unit&) const { return 0; }
    __device__ __forceinline__ const char* b_base(const Unit& u) const { return (const char*)(WKV + (size_t)(u.e * 1024 + u.pn * BM) * D); }
};
struct EpiKV2 {
    bf16_t* KB; bf16_t* VB;
    __device__ __forceinline__ void operator()(const f32x4 (&acc)[2][2][4][2], const Unit& u, int wr, int wc, int fr, int fq) const {
        bf16_t* base = (u.e ? VB : KB) + (size_t)u.pm * BM * D + u.pn * BM;
#pragma unroll
        for (int ai = 0; ai < 2; ++ai)
#pragma unroll
            for (int m = 0; m < 4; ++m) { const int r = ai * HALF + wr * 64 + m * 16 + fr;
#pragma unroll
                for (int bj = 0; bj < 2; ++bj) { const int c0 = bj * HALF + wc * 32 + 8 * fq;
                    *(u32x4*)(base + (size_t)r * D + c0) = pack8(acc[ai][bj][m][0], acc[ai][bj][m][1]); } }
    }
};
struct XPreSched {
    const bf16_t* KB; const bf16_t* VB; const bf16_t* WQN; const bf16_t* WXO;
    __device__ __forceinline__ int lda(const Unit&) const { return D; }
    __device__ __forceinline__ int ldb(const Unit&) const { return D; }
    __device__ __forceinline__ int nt(const Unit&) const { return 4; }
    __device__ __forceinline__ bool cont(const Unit&) const { return false; }
    __device__ __forceinline__ bool next(int i, Unit& u) const {
        int bx = (int)blockIdx.x; asm volatile("" : "+s"(bx)); if (bx >= 128 || i >= 1) return false;
        const int tb = bx & 31; int e = tb >> 4; asm volatile("" : "+s"(e)); u.e = e; u.pm = tb & 15; u.pn = bx >> 5; return true; }
    __device__ __forceinline__ const char* a_base(const Unit& u) const { return u.e ? (const char*)WXO : (const char*)KB; }
    __device__ __forceinline__ int a_row(const Unit& u, int r) const { return (u.e ? u.pn : (u.pm >> 2)) * BM + r; }
    __device__ __forceinline__ int a_col(const Unit& u) const { return (u.pm & 3) * 256; }
    __device__ __forceinline__ const char* b_base(const Unit& u) const {
        return u.e ? (const char*)(VB + (size_t)((u.pm >> 2) * BM) * D + (u.pm & 3) * 256) : (const char*)(WQN + (size_t)(u.pn * BM) * D + (u.pm & 3) * 256); }
};
struct EpiPre {
    bf16_t* MT; bf16_t* VWT;
    __device__ __forceinline__ void operator()(const f32x4 (&acc)[2][2][4][2], const Unit& u, int wr, int wc, int fr, int fq) const {
        const int b = u.pm >> 2, h = u.pm & 3;
        bf16_t* base = u.e ? VWT + ((size_t)b * 1024 + u.pn * BM) * D + h * 256 : MT + ((size_t)b * 1024 + h * 256) * D + u.pn * BM;
#pragma unroll
        for (int ai = 0; ai < 2; ++ai)
#pragma unroll
            for (int m = 0; m < 4; ++m) { const int r = ai * HALF + wr * 64 + m * 16 + fr;
#pragma unroll
                for (int bj = 0; bj < 2; ++bj) { const int c0 = bj * HALF + wc * 32 + 8 * fq;
                    *(u32x4*)(base + (size_t)r * D + c0) = pack8(acc[ai][bj][m][0], acc[ai][bj][m][1]); } }
    }
};
struct BatchBSched {
    const bf16_t* A; const bf16_t* Bm;
    __device__ __forceinline__ int lda(const Unit&) const { return D; }
    __device__ __forceinline__ int ldb(const Unit&) const { return D; }
    __device__ __forceinline__ int nt(const Unit&) const { return D / BK; }
    __device__ __forceinline__ bool cont(const Unit&) const { return false; }
    __device__ __forceinline__ bool next(int i, Unit& u) const {
        const int c = blockIdx.x, per = gridDim.x >> 3, x = c & 7, j = c >> 3, lu = i * per + j;
        if (lu >= 64) return false;
        const int un = x * 64 + lu; u.pm = un >> 2; u.pn = un & 3; u.e = 0; return true; }
    __device__ __forceinline__ const char* a_base(const Unit&) const { return (const char*)A; }
    __device__ __forceinline__ int a_row(const Unit& u, int r) const { return u.pm * BM + r; }
    __device__ __forceinline__ int a_col(const Unit&) const { return 0; }
    __device__ __forceinline__ const char* b_base(const Unit& u) const { return (const char*)(Bm + ((size_t)(u.pm >> 5) * 1024 + u.pn * BM) * D); }
};
struct EpiXS {
    bf16_t* P; const float* ssp; LAS float* part;
    __device__ __forceinline__ void operator()(const f32x4 (&acc)[2][2][4][2], const Unit& u, int wr, int wc, int fr, int fq) const {
        asm volatile("" : "+v"(fr), "+v"(fq));
#pragma unroll
        for (int ai = 0; ai < 2; ++ai)
#pragma unroll
            for (int m = 0; m < 4; ++m) {
                const int rit = ai * HALF + wr * 64 + m * 16 + fr;
                const f32x4 pv = *(const f32x4*)(ssp + (size_t)(u.pm * BM + rit) * 16 + 4 * fq);
                float sm = (pv[0] + pv[1]) + (pv[2] + pv[3]);
                sm += __shfl_xor(sm, 16); sm += __shfl_xor(sm, 32);
                const float k2 = rsqrtf(sm * (1.0f / D) + EPS) * (0.0625f * 1.4426950408889634f);
                float ps = 0.f;
#pragma unroll
                for (int bj = 0; bj < 2; ++bj)
#pragma unroll
                    for (int n = 0; n < 2; ++n)
#pragma unroll
                        for (int j = 0; j < 4; ++j) ps += __builtin_amdgcn_exp2f(acc[ai][bj][m][n][j] * k2);
                ps += __shfl_xor(ps, 16); ps += __shfl_xor(ps, 32);
                if (fq == 0) { part[rit * 4 + wc] = ps; if (wc == 0) part[1024 + rit] = k2; }
            }
        asm volatile("s_waitcnt lgkmcnt(0)" ::: "memory"); __builtin_amdgcn_s_barrier(); asm volatile("" ::: "memory");
#pragma unroll
        for (int ai = 0; ai < 2; ++ai)
#pragma unroll
            for (int m = 0; m < 4; ++m) { const int rit = ai * HALF + wr * 64 + m * 16 + fr, row = u.pm * BM + rit;
                const f32x4 p4 = *(const LAS f32x4*)(part + rit * 4); const float k2 = part[1024 + rit];
                const float inv = 1.0f / ((p4[0] + p4[1]) + (p4[2] + p4[3]));
#pragma unroll
                for (int bj = 0; bj < 2; ++bj) { const int c0 = u.pn * 256 + bj * HALF + wc * 32 + 8 * fq;
                    f32x4 e0, e1;
#pragma unroll
                    for (int j = 0; j < 4; ++j) { e0[j] = __builtin_amdgcn_exp2f(acc[ai][bj][m][0][j] * k2) * inv; e1[j] = __builtin_amdgcn_exp2f(acc[ai][bj][m][1][j] * k2) * inv; }
                    *(u32x4*)(P + (size_t)row * D + c0) = pack8(e0, e1); }
                __builtin_amdgcn_sched_barrier(0);
            }
    }
};
}

struct CvtJob { const float* W; int ldw, col0, K; const float* g; bf16_t* Bt; int il, half, nblk; };
__device__ __forceinline__ void cvt_load(const CvtJob& j, int item, int lane, f32x4 (&v)[8]) {
    const int kb = item / j.nblk, nb = item - kb * j.nblk, k0 = 64 * kb, n0 = 32 * nb;
    const float* p = j.W + (size_t)(k0 + (lane >> 3)) * j.ldw + j.col0 + n0 + 4 * (lane & 7);
#pragma unroll
    for (int i = 0; i < 8; ++i) v[i] = *(const f32x4*)(p + (size_t)(8 * i) * j.ldw);
    if (j.g) {
#pragma unroll
        for (int i = 0; i < 8; ++i) v[i] *= j.g[k0 + 8 * i + (lane >> 3)]; }
}
__device__ __forceinline__ void cvt_store(const CvtJob& j, int item, int lane, LAS float* scr, const f32x4 (&v)[8]) {
    const int kb = item / j.nblk, nb = item - kb * j.nblk, k0 = 64 * kb, n0 = 32 * nb;
#pragma unroll
    for (int i = 0; i < 8; ++i) { LAS float* d = scr + (8 * i + (lane >> 3)) * 33 + 4 * (lane & 7); d[0] = v[i][0]; d[1] = v[i][1]; d[2] = v[i][2]; d[3] = v[i][3]; }
    asm volatile("s_waitcnt lgkmcnt(0)" ::: "memory");
    const int c = lane & 7;
#pragma unroll
    for (int q = 0; q < 4; ++q) { const int n = (lane >> 3) + 8 * q; const LAS float* s = scr + (8 * c) * 33 + n;
        u32x4 o; o.x = cvt_pk_bf16(s[0 * 33], s[1 * 33]); o.y = cvt_pk_bf16(s[2 * 33], s[3 * 33]); o.z = cvt_pk_bf16(s[4 * 33], s[5 * 33]); o.w = cvt_pk_bf16(s[6 * 33], s[7 * 33]);
        const int nn = n0 + n, drow = j.il ? ((nn >> 7) * 256 + j.half * 128 + (nn & 127)) : nn;
        *(u32x4*)(j.Bt + (size_t)drow * j.K + k0 + 8 * c) = o; }
    asm volatile("s_waitcnt lgkmcnt(0)" ::: "memory");
}
__device__ __forceinline__ void cvt_matrix(const float* W, int ldw, int col0, int ncols, int K, const float* g, bf16_t* Bt, int il, int half, LAS unsigned char* lds, int woff = 0, int vb = -1, int nb = 0) {
    const int tix = otid();
    const int lane = tix & 63, wv = tix >> 6;
    LAS float* scr = (LAS float*)(lds + wv * 8704);
    if (vb < 0) { vb = blockIdx.x; nb = gridDim.x; }
    const int ngw = nb * 8; int gw = vb * 8 + wv - (woff % ngw); if (gw < 0) gw += ngw;
    const CvtJob j{W, ldw, col0, K, g, Bt, il, half, ncols / 32};
    const int nitems = (K / 64) * j.nblk;
    f32x4 cur[8], nxt[8];
    int it = gw; if (it < nitems) cvt_load(j, it, lane, cur);
    for (; it < nitems; it += ngw) {
        const int itn = it + ngw; if (itn < nitems) cvt_load(j, itn, lane, nxt);
        cvt_store(j, it, lane, scr, cur);
#pragma unroll
        for (int i = 0; i < 8; ++i) cur[i] = nxt[i];
    }
}
__device__ __forceinline__ void cvt_plain(const float* W, const float* g, bf16_t* out, int rows, int vb, int nb) {
    const int tix = otid(); const size_t gi = (size_t)vb * blockDim.x + tix, gs = (size_t)nb * blockDim.x;
    for (size_t i = gi; i < (size_t)rows * 256; i += gs) { const f32x4 v = ((const f32x4*)W)[i] * g[i >> 8];
        u32x2 w; w.x = cvt_pk_bf16(v[0], v[1]); w.y = cvt_pk_bf16(v[2], v[3]); ((u32x2*)out)[i] = w; }
}
__device__ __forceinline__ void rows_prep(const float* x, bf16_t* XB, float* rs, float* ssp, int rows, int vb = -1, int nb = 0) {
    const int tix = otid();
    const int lane = tix & 63;
    if (vb < 0) { vb = blockIdx.x; nb = gridDim.x; }
    const int gw = (vb * (int)blockDim.x + tix) >> 6, ngw = (nb * (int)blockDim.x) >> 6;
    constexpr int NR = 4;
    for (int r0 = gw; r0 < rows; r0 += NR * ngw) {
        f32x4 v[NR][4];
#pragma unroll
        for (int q = 0; q < NR; ++q) { const int r = r0 + q * ngw;
            if (r < rows) {
#pragma unroll
                for (int j = 0; j < 4; ++j) v[q][j] = ((const f32x4*)(x + (size_t)r * D))[lane + 64 * j]; } }
#pragma unroll
        for (int q = 0; q < NR; ++q) { const int r = r0 + q * ngw;
            if (r < rows) { float s = 0.f;
#pragma unroll
                for (int j = 0; j < 4; ++j) s += (v[q][j][0] * v[q][j][0] + v[q][j][1] * v[q][j][1]) + (v[q][j][2] * v[q][j][2] + v[q][j][3] * v[q][j][3]);
                s = wave_sum(s);
                if (lane == 0) rs[r] = rsqrtf(s * (1.0f / D) + EPS);
                if (ssp && lane < 16) ssp[(size_t)r * 16 + lane] = lane == 0 ? s : 0.f;
                u32x2* o = (u32x2*)(XB + (size_t)r * D);
#pragma unroll
                for (int j = 0; j < 4; ++j) { u32x2 w; w.x = cvt_pk_bf16(v[q][j][0], v[q][j][1]); w.y = cvt_pk_bf16(v[q][j][2], v[q][j][3]); o[lane + 64 * j] = w; } } }
    }
}

__device__ __forceinline__ void rows_norm_bf16(const float* x, const float* g, bf16_t* out, int rows, int vb, int nb) {
    const int tix = otid();
    const int lane = tix & 63;
    const int gw = (vb * (int)blockDim.x + tix) >> 6, ngw = (nb * (int)blockDim.x) >> 6;
    for (int r = gw; r < rows; r += ngw) {
        const f32x4* xr = (const f32x4*)(x + (size_t)r * D);
        f32x4 v[4]; float s = 0.f;
#pragma unroll
        for (int j = 0; j < 4; ++j) { v[j] = xr[lane + 64 * j]; s += (v[j][0] * v[j][0] + v[j][1] * v[j][1]) + (v[j][2] * v[j][2] + v[j][3] * v[j][3]); }
        s = wave_sum(s); const float rs = rsqrtf(s * (1.0f / D) + EPS);
        u32x2* o = (u32x2*)(out + (size_t)r * D);
#pragma unroll
        for (int j = 0; j < 4; ++j) { const f32x4 gg = ((const f32x4*)g)[lane + 64 * j]; u32x2 w; w.x = cvt_pk_bf16(v[j][0] * rs * gg[0], v[j][1] * rs * gg[1]); w.y = cvt_pk_bf16(v[j][2] * rs * gg[2], v[j][3] * rs * gg[3]); o[lane + 64 * j] = w; }
    }
}

__device__ __forceinline__ void route_prep(const float* wg, const float* we, const float* gain, bf16_t* WRB, int vb, int nb) {
    const int tix = otid(); const int gi = vb * blockDim.x + tix, gs = nb * blockDim.x;
    for (int i = gi; i < 48 * 1024; i += gs) { const int j = i >> 10, k = i & 1023;
        const float w = j < 32 ? we[k * NE + j] * gain[k] : (j < 36 ? wg[k * NG + (j - 32)] * gain[k] : 0.f);
        const unsigned hi = cvt_pk_bf16(w, 0.f) & 0xffffu; const float rem = w - __uint_as_float(hi << 16);
        WRB[i] = (bf16_t)hi; WRB[48 * 1024 + i] = (bf16_t)(cvt_pk_bf16(rem, 0.f) & 0xffffu); }
}
__device__ __forceinline__ float reduce16(float (&v)[18], int lane) {
#pragma unroll
    for (int st = 0; st < 4; ++st) { const int half = 8 >> st, bit = 32 >> st; const bool up = (lane & bit) != 0;
#pragma unroll
        for (int k = 0; k < half; ++k) { const float send = up ? v[k] : v[k + half]; const float keep = up ? v[k + half] : v[k]; v[k] = keep + __shfl_xor(send, bit); } }
    float r = v[0]; r += __shfl_xor(r, 2); r += __shfl_xor(r, 1); return r;
}
__device__ __forceinline__ float reduce2(const float (&v)[18], int lane) {
    const bool up = (lane & 32) != 0; const float send = up ? v[16] : v[17], keep = up ? v[17] : v[16];
    float r = keep + __shfl_xor(send, 32);
#pragma unroll
    for (int o = 16; o >= 1; o >>= 1) r += __shfl_xor(r, o);
    return r;
}
__device__ __forceinline__ void route_phase(const bf16_t* X, const bf16_t* WRB, const float* bg, const float* be, int* etok, int* ea, float* ers, float* egate, int* gcnt, LAS unsigned char* lds) {
    int tid_ = threadIdx.x; asm volatile("" : "+v"(tid_)); const int tid = tid_, lane = tid & 63, wv = tid >> 6, r16 = lane & 15, h4 = lane >> 4;
    constexpr int WSTRH = 1040, WSTR = 2 * WSTRH;
    LAS unsigned char* Wl = lds;
    LAS float* lg = (LAS float*)(lds + 48 * WSTR) + wv * (16 * 52);
    LAS int* lcnt = (LAS int*)(lds + 48 * WSTR + 8 * 16 * 52 * 4); LAS int* lbase = lcnt + 32; LAS int* l_e = lbase + 32; LAS int* l_rank = l_e + 256; LAS float* l_g = (LAS float*)(l_rank + 256); LAS float* l_rs = l_g + 256;
    for (int tb = blockIdx.x; tb < T / 128; tb += gridDim.x) {
        const int t0 = tb * 128 + wv * 16;
        f32x4 acc[3]; float ssq = 0.f;
#pragma unroll
        for (int n = 0; n < 3; ++n) acc[n] = (f32x4){0.f, 0.f, 0.f, 0.f};
#pragma unroll 1
        for (int kh = 0; kh < 2; ++kh) {
            {   u32x4 wst[12];
#pragma unroll
                for (int i = 0; i < 12; ++i) { const int ix = tid + 512 * i; wst[i] = *(const u32x4*)(WRB + (size_t)(ix >> 6) * 1024 + kh * 512 + (ix & 63) * 8); }
                __syncthreads();
#pragma unroll
                for (int i = 0; i < 12; ++i) { const int ix = tid + 512 * i; *(LAS u32x4*)(Wl + (ix >> 6) * WSTRH + (ix & 63) * 16) = wst[i]; }
            }
            if (kh == 0 && tid < 32) lcnt[tid] = 0;
            __syncthreads();
            const bf16_t* xr = X + (size_t)(t0 + r16) * D + kh * 512 + 8 * h4;
#pragma unroll 8
            for (int ks = 0; ks < 16; ++ks) {
                const bf16x8 xb = *(const bf16x8*)(xr + ks * 32);
#pragma unroll
                for (int j = 0; j < 8; ++j) { const float xv = __uint_as_float(((unsigned)(unsigned short)xb[j]) << 16); ssq = fmaf(xv, xv, ssq); }
#pragma unroll
                for (int pl = 0; pl < 2; ++pl)
#pragma unroll
                    for (int n = 0; n < 3; ++n) { const bf16x8 wa = *(const LAS bf16x8*)(Wl + (pl * 48 + n * 16 + r16) * WSTRH + ks * 64 + 16 * h4);
                        acc[n] = __builtin_amdgcn_mfma_f32_16x16x32_bf16(wa, xb, acc[n], 0, 0, 0); }
            }
        }
        ssq += __shfl_xor(ssq, 16); ssq += __shfl_xor(ssq, 32);
#pragma unroll
        for (int n = 0; n < 3; ++n)
#pragma unroll
            for (int q = 0; q < 4; ++q) lg[r16 * 52 + n * 16 + 4 * h4 + q] = acc[n][q];
        if (h4 == 0) lg[r16 * 52 + 48] = rsqrtf(ssq * (1.0f / D) + EPS);
        asm volatile("s_waitcnt lgkmcnt(0)" ::: "memory");
        {
            const int r = lane & 15; const LAS float* L = lg + r * 52;
            const float rs = L[48];
            float gl[4];
#pragma unroll
            for (int g = 0; g < 4; ++g) gl[g] = L[32 + g] * rs + bg[g];
            int gs = 0; float gm = gl[0];
#pragma unroll
            for (int g = 1; g < 4; ++g) if (gl[g] > gm) { gm = gl[g]; gs = g; }
            float se = 0.f;
#pragma unroll
            for (int g = 0; g < 4; ++g) se += expf(gl[g] - gm);
            const float pg = 1.0f / se;
            float el[8];
#pragma unroll
            for (int i = 0; i < 8; ++i) el[i] = L[gs * 8 + i] * rs + be[gs * 8 + i];
            float em = el[0];
#pragma unroll
            for (int i = 1; i < 8; ++i) em = fmaxf(em, el[i]);
            float pe[8], ps = 0.f;
#pragma unroll
            for (int i = 0; i < 8; ++i) { pe[i] = expf(el[i] - em); ps += pe[i]; }
#pragma unroll
            for (int i = 0; i < 8; ++i) pe[i] = pe[i] / ps;
            int i1 = 0; float p1 = pe[0];
#pragma unroll
            for (int i = 1; i < 8; ++i) if (pe[i] > p1) { p1 = pe[i]; i1 = i; }
            int i2 = -1; float p2 = -1.f;
#pragma unroll
            for (int i = 0; i < 8; ++i) if (i != i1 && pe[i] > p2) { p2 = pe[i]; i2 = i; }
            if (lane < 16) {
                if (i2 < 0) i2 = i1 == 0 ? 1 : 0;
                const int tl = wv * 16 + r, t = tb * 128 + tl; const float den = p1 + p2; const int e1 = gs * 8 + i1, e2 = gs * 8 + i2;
                l_rs[tl] = rs; l_g[2 * tl] = pg * p1 / den; l_g[2 * tl + 1] = pg * p2 / den; (void)t;
                l_e[2 * tl] = e1; l_e[2 * tl + 1] = e2;
                l_rank[2 * tl] = atomicAdd((int*)(lcnt + e1), 1); l_rank[2 * tl + 1] = atomicAdd((int*)(lcnt + e2), 1);
            }
        }
        __syncthreads();
        if (tid < 32) lbase[tid] = __hip_atomic_fetch_add(gcnt + tid * GCS, lcnt[tid], __ATOMIC_RELAXED, __HIP_MEMORY_SCOPE_AGENT);
        __syncthreads();
        if (tid < 256) { const int a = tb * 256 + tid, e = l_e[tid]; const size_t ix = (size_t)e * CAPE + lbase[e] + l_rank[tid];
            etok[ix] = a >> 1; ea[ix] = a; ers[ix] = l_rs[tid >> 1]; egate[ix] = l_g[tid]; }
        __syncthreads();
    }
}
__device__ __forceinline__ void build_phase(const int* gcnt, const int* assign_e, const int* assign_pos, const float* gate, const float* RS,
                                            int* ntiles, int* tile_e, int* slot_tok, int* slot_a, float* slot_rs, float* slot_gate, LAS unsigned char* lds) {
    const int tix = otid();
    LAS int* poff = (LAS int*)lds; LAS int* cn = poff + 40;
    if (tix == 0) { int o = 0; for (int e = 0; e < 32; ++e) { const int cc = g8::ld_agent(gcnt + e); cn[e] = cc; poff[e] = o; o += (cc + 255) / 256 * 256; } poff[32] = o; }
    __syncthreads();
    const int gi = blockIdx.x * blockDim.x + tix, gs = gridDim.x * blockDim.x;
    for (int a = gi; a < NA; a += gs) { const int e = assign_e[a]; const int sl = poff[e] + assign_pos[a]; slot_tok[sl] = a >> 1; slot_a[sl] = a; slot_rs[sl] = RS[a >> 1]; slot_gate[sl] = gate[a]; }
    for (int i = gi; i < 32 * 256; i += gs) { const int e = i >> 8, sl = poff[e] + cn[e] + (i & 255); if (sl < poff[e + 1]) { slot_tok[sl] = 0; slot_a[sl] = -1; slot_rs[sl] = 0.f; slot_gate[sl] = 0.f; } }
    if (blockIdx.x == 0) {
        const int NT = poff[32] >> 8;
        for (int rt = tix; rt < NT; rt += blockDim.x) { int e = 0; for (int k = 0; k < 32; ++k) if (rt * 256 >= poff[k] && rt * 256 < poff[k + 1]) e = k; tile_e[rt] = e; }
        if (tix == 0) *ntiles = NT;
    }
    __syncthreads();
}
__device__ __forceinline__ CvtJob moe_job(const float* wgate, const float* wup, const float* wdown, const float* gain, bf16_t* W1, bf16_t* W2, int it, int& item) {
    const int e = it / 768, r = it - e * 768;
    if (r < 256) { item = r; return CvtJob{wgate + (size_t)e * D * DE, DE, 0, D, gain, W1 + (size_t)e * D * D, 1, 0, 16}; }
    if (r < 512) { item = r - 256; return CvtJob{wup + (size_t)e * D * DE, DE, 0, D, gain, W1 + (size_t)e * D * D, 1, 1, 16}; }
    item = r - 512; return CvtJob{wdown + (size_t)e * DE * D, D, 0, DE, nullptr, W2 + (size_t)e * D * DE, 0, 0, 32};
}
__device__ __forceinline__ void cvt_moe(const float* wgate, const float* wup, const float* wdown, const float* gain, bf16_t* W1, bf16_t* W2, LAS unsigned char* lds, int skip_blocks) {
    const int tix = otid();
    const int lane = tix & 63, wv = tix >> 6;
    LAS float* scr = (LAS float*)(lds + 1024 + wv * 8704);
    if ((int)blockIdx.x < skip_blocks) return;
    const int gw = ((int)blockIdx.x - skip_blocks) * 8 + wv, ngw = ((int)gridDim.x - skip_blocks) * 8;
    f32x4 cur[8], nxt[8]; int item = 0, itemn = 0;
    int it = gw; CvtJob j = moe_job(wgate, wup, wdown, gain, W1, W2, it < 32 * 768 ? it : 0, item);
    if (it < 32 * 768) cvt_load(j, item, lane, cur);
    for (; it < 32 * 768; it += ngw) {
        const int itn = it + ngw; CvtJob jn = j;
        if (itn < 32 * 768) { jn = moe_job(wgate, wup, wdown, gain, W1, W2, itn, itemn); cvt_load(jn, itemn, lane, nxt); }
        cvt_store(j, item, lane, scr, cur);
        j = jn; item = itemn;
#pragma unroll
        for (int i = 0; i < 8; ++i) cur[i] = nxt[i];
    }
}
__device__ __forceinline__ void combine_phase(float* X, float* Xo, const bf16_t* Y, bf16_t* XB, float* RS, float* ssp, const float* gfinal, int fin, const float* WA, float* ALR, LAS unsigned char* lds) {
    const int tix = otid();
    const int lane = tix & 63;
    if (WA) { for (int i = tix; i < 16 * 256; i += 512) ((LAS f32x4*)lds)[i] = ((const f32x4*)WA)[i]; __syncthreads(); }
    const int gw = (blockIdx.x * blockDim.x + tix) >> 6, ngw = (gridDim.x * blockDim.x) >> 6;
    constexpr int NR = 4;
    for (int tb = gw; tb < T; tb += NR * ngw) {
        f32x4 v[NR][4]; u32x2 ya[NR][4], yb[NR][4];
#pragma unroll
        for (int rr = 0; rr < NR; ++rr) { const int t = tb + rr * ngw;
#pragma unroll
            for (int j = 0; j < 4; ++j) { const u32x2 xw = ((const u32x2*)(XB + (size_t)t * D))[lane + 64 * j]; v[rr][j] = (f32x4){bf_lo(xw.x), bf_hi(xw.x), bf_lo(xw.y), bf_hi(xw.y)};
                ya[rr][j] = ((const u32x2*)(Y + (size_t)(2 * t) * D))[lane + 64 * j]; yb[rr][j] = ((const u32x2*)(Y + (size_t)(2 * t + 1) * D))[lane + 64 * j]; } }
        __builtin_amdgcn_sched_barrier(0);
        float rsv[NR];
#pragma unroll
        for (int rr = 0; rr < NR; ++rr) { const int t = tb + rr * ngw; float s = 0.f;
#pragma unroll
            for (int j = 0; j < 4; ++j) {
                v[rr][j][0] += bf_lo(ya[rr][j].x) + bf_lo(yb[rr][j].x); v[rr][j][1] += bf_hi(ya[rr][j].x) + bf_hi(yb[rr][j].x);
                v[rr][j][2] += bf_lo(ya[rr][j].y) + bf_lo(yb[rr][j].y); v[rr][j][3] += bf_hi(ya[rr][j].y) + bf_hi(yb[rr][j].y);
                if (!fin) { const unsigned w0 = cvt_pk_bf16(v[rr][j][0], v[rr][j][1]), w1 = cvt_pk_bf16(v[rr][j][2], v[rr][j][3]); v[rr][j] = (f32x4){bf_lo(w0), bf_hi(w0), bf_lo(w1), bf_hi(w1)}; }
                s += (v[rr][j][0] * v[rr][j][0] + v[rr][j][1] * v[rr][j][1]) + (v[rr][j][2] * v[rr][j][2] + v[rr][j][3] * v[rr][j][3]); }
            s = wave_sum(s); const float rs = rsqrtf(s * (1.0f / D) + EPS); rsv[rr] = rs;
            if (fin) {
#pragma unroll
                for (int j = 0; j < 4; ++j) { const f32x4 gg = ((const f32x4*)gfinal)[lane + 64 * j]; ((f32x4*)(Xo + (size_t)t * D))[lane + 64 * j] = v[rr][j] * rs * gg; }
            } else {
                if (lane == 0) RS[t] = rs;
                if (lane < 16) ssp[(size_t)t * 16 + lane] = lane == 0 ? s : 0.f;
#pragma unroll
                for (int j = 0; j < 4; ++j) { u32x2 w; w.x = cvt_pk_bf16(v[rr][j][0], v[rr][j][1]); w.y = cvt_pk_bf16(v[rr][j][2], v[rr][j][3]); ((u32x2*)(XB + (size_t)t * D))[lane + 64 * j] = w; }
            }
        }
        if (!fin && WA) {
            float a[NR][16];
#pragma unroll
            for (int o = 0; o < 16; ++o) { float p[NR];
#pragma unroll
                for (int rr = 0; rr < NR; ++rr) p[rr] = 0.f;
#pragma unroll
                for (int j = 0; j < 4; ++j) { const f32x4 w4 = *(const LAS f32x4*)(lds + (o * 1024 + 256 * j + 4 * lane) * 4);
#pragma unroll
                    for (int rr = 0; rr < NR; ++rr) p[rr] = fmaf(v[rr][j][3], w4[3], fmaf(v[rr][j][2], w4[2], fmaf(v[rr][j][1], w4[1], fmaf(v[rr][j][0], w4[0], p[rr])))); }
#pragma unroll
                for (int rr = 0; rr < NR; ++rr) a[rr][o] = p[rr];
                if ((o & 3) == 3) __builtin_amdgcn_sched_barrier(0); }
            { const bool up = (lane & 32) != 0;
#pragma unroll
              for (int rr = 0; rr < 2; ++rr)
#pragma unroll
                for (int k = 0; k < 16; ++k) { const float send = up ? a[rr][k] : a[rr + 2][k], keep = up ? a[rr + 2][k] : a[rr][k]; a[rr][k] = keep + __shfl_xor(send, 32); } }
            { const bool up = (lane & 16) != 0;
#pragma unroll
              for (int k = 0; k < 16; ++k) { const float send = up ? a[0][k] : a[1][k], keep = up ? a[1][k] : a[0][k]; a[0][k] = keep + __shfl_xor(send, 16); } }
#pragma unroll
            for (int st = 0; st < 4; ++st) { const int half = 8 >> st, bit = 8 >> st; const bool up = (lane & bit) != 0;
#pragma unroll
                for (int k = 0; k < half; ++k) { const float send = up ? a[0][k] : a[0][k + half], keep = up ? a[0][k + half] : a[0][k]; a[0][k] = keep + __shfl_xor(send, bit); } }
            const int row = lane >> 4;
            const float rsl = row == 0 ? rsv[0] : row == 1 ? rsv[1] : row == 2 ? rsv[2] : rsv[3];
            ALR[(size_t)(tb + row * ngw) * 16 + (lane & 15)] = a[0][0] * rsl;
        }
    }
}

__device__ __forceinline__ float fexp2(float x) { return __builtin_amdgcn_exp2f(x * 1.4426950408889634f); }
__device__ __forceinline__ void gla_prep(const float* win, const float* wo, const float* gain, bf16_t* WGTM, bf16_t* WGFM, bf16_t* WGO, float* WA, LAS unsigned char* lds, int vb, int nb) {
    cvt_matrix(win, GLA_COLS, 0, 512, D, gain, WGTM, 0, 0, lds, 0, vb, nb);
    cvt_matrix(win, GLA_COLS, 512, 512, D, gain, WGTM + (size_t)512 * D, 0, 0, lds, 256, vb, nb);
    cvt_matrix(win, GLA_COLS, 2064, 1024, D, gain, WGTM + (size_t)1024 * D, 0, 0, lds, 512, vb, nb);
    cvt_matrix(win, GLA_COLS, 512, 512, D, gain, WGFM, 0, 0, lds, 1024, vb, nb);
    cvt_matrix(win, GLA_COLS, 1024, 1024, D, gain, WGFM + (size_t)512 * D, 0, 0, lds, 1280, vb, nb);
    cvt_matrix(wo, D, 0, D, D, nullptr, WGO, 0, 0, lds, 1792, vb, nb);
    const int tix = otid(); const int gi = vb * blockDim.x + tix, gs = nb * blockDim.x;
    for (int i = gi; i < 16 * 1024; i += gs) { const int j = i >> 10, k = i & 1023; WA[i] = win[(size_t)k * GLA_COLS + 2048 + j] * gain[k]; }
}
__device__ __forceinline__ void gla_decay(const float* ALR, const float* wa2, const float* ba, float* BTM, float* BFM, float* DL, LAS unsigned char* lds) {
    const int tix = otid();
    LAS float* tile = (LAS float*)lds;
    LAS float* seg = tile + 256 * 65;
    for (int item = blockIdx.x; item < 128 * 8; item += gridDim.x) {
        const int ch = item >> 3, kf0 = (item & 7) * 64, t0 = ch * 256;
        {
            const int lane = tix & 63, wv = tix >> 6, r16 = lane & 15, k4 = lane >> 4;
            float bw[4][4];
#pragma unroll
            for (int cb = 0; cb < 4; ++cb)
#pragma unroll
                for (int kk = 0; kk < 4; ++kk) bw[cb][kk] = wa2[(4 * kk + k4) * GDK + kf0 + cb * 16 + r16];
            float bias4[4];
#pragma unroll
            for (int cb = 0; cb < 4; ++cb) bias4[cb] = ba[kf0 + cb * 16 + r16];
#pragma unroll
            for (int rb = 0; rb < 2; ++rb) {
                float av[4];
#pragma unroll
                for (int kk = 0; kk < 4; ++kk) av[kk] = ALR[(size_t)(t0 + wv * 32 + rb * 16 + r16) * 16 + 4 * kk + k4];
#pragma unroll
                for (int cb = 0; cb < 4; ++cb) {
                    f32x4 zz = (f32x4){bias4[cb], bias4[cb], bias4[cb], bias4[cb]};
#pragma unroll
                    for (int kk = 0; kk < 4; ++kk) zz = __builtin_amdgcn_mfma_f32_16x16x4f32(av[kk], bw[cb][kk], zz, 0, 0, 0);
#pragma unroll
                    for (int i = 0; i < 4; ++i) { const float z = zz[i];
                        const float e = __builtin_amdgcn_exp2f(-1.4426950408889634f * fabsf(z));
                        const float ls = fminf(z, 0.f) - 0.6931471805599453f * __builtin_amdgcn_logf(1.0f + e);
                        tile[(wv * 32 + rb * 16 + 4 * k4 + i) * 65 + cb * 16 + r16] = ls * (1.0f / 16.0f); }
                }
            }
        }
        __syncthreads();
        {
            const int kf = tix & 63, sg = tix >> 6;
            float run = 0.f;
#pragma unroll 8
            for (int i = 0; i < 32; ++i) { LAS float* p = tile + (sg * 32 + i) * 65 + kf; run += *p; *p = run; }
            seg[sg * 64 + kf] = run;
            __syncthreads();
            float off = 0.f;
            for (int q = 0; q < sg; ++q) off += seg[q * 64 + kf];
#pragma unroll 8
            for (int i = 0; i < 32; ++i) { LAS float* p = tile + (sg * 32 + i) * 65 + kf; *p += off; }
            if (sg == 7) DL[(size_t)ch * 512 + kf0 + kf] = __builtin_amdgcn_exp2f(1.4426950408889634f * (run + off));
        }
        __syncthreads();
        bf16_t* EQ = (bf16_t*)BTM; bf16_t* EK = EQ + (size_t)T * 512;
#pragma unroll
        for (int j = 0; j < 4; ++j) { const int t = (tix >> 3) + 64 * j, c = (tix & 7) * 8; const LAS float* p = tile + t * 65 + c;
            f32x4 e0, e1, n0, n1;
#pragma unroll
            for (int q = 0; q < 4; ++q) { e0[q] = fexp2(p[q]); e1[q] = fexp2(p[4 + q]); n0[q] = fexp2(-p[q]); n1[q] = fexp2(-p[4 + q]); }
            *(u32x4*)(EQ + (size_t)(t0 + t) * 512 + kf0 + c) = pack8(e0, e1); *(u32x4*)(EK + (size_t)(t0 + t) * 512 + kf0 + c) = pack8(n0, n1); }
        __syncthreads();
    }
}
__device__ __forceinline__ void gla_scan(const bf16_t* UT, const float* DL, bf16_t* SP) {
    const int tix = otid(); const int gi = blockIdx.x * blockDim.x + tix, gs = gridDim.x * blockDim.x;
    for (int it = gi; it < 16 * 32768 / 2; it += gs) {
        const int bh = it >> 14, idx = (it & 16383) * 2, k = idx & 127, b = bh >> 2, h = bh & 3;
        float s0 = 0.f, s1 = 0.f;
        for (int c = 0; c < 32; ++c) {
            const size_t off = (size_t)(bh * 32 + c) * 32768 + idx;
            const unsigned uu = *(const unsigned*)(UT + off);
            *(unsigned*)(SP + off) = cvt_pk_bf16(s0, s1);
            const f32x2 d = *(const f32x2*)(DL + (size_t)(b * 32 + c) * 512 + h * 128 + k);
            s0 = fmaf(d[0], s0, bf_lo(uu)); s1 = fmaf(d[1], s1, bf_hi(uu));
        }
    }
}
__device__ __forceinline__ void gla_fin(const bf16_t* O, const bf16_t* QKR, const float* ng, bf16_t* GO) {
    const int tix = otid(); const int lane = tix & 63;
    const int gw = (blockIdx.x * blockDim.x + tix) >> 6, ngw = (gridDim.x * blockDim.x) >> 6;
    const f32x4 gg = ((const f32x4*)ng)[lane];
    for (int t = gw; t < T; t += ngw) {
#pragma unroll
        for (int j = 0; j < 4; ++j) {
            const u32x2 ow = ((const u32x2*)(O + (size_t)t * D))[lane + 64 * j], rw = ((const u32x2*)(QKR + (size_t)t * 2048 + 1024))[lane + 64 * j];
            const f32x4 o = (f32x4){bf_lo(ow.x), bf_hi(ow.x), bf_lo(ow.y), bf_hi(ow.y)}, r = (f32x4){bf_lo(rw.x), bf_hi(rw.x), bf_lo(rw.y), bf_hi(rw.y)};
            const float ss = wave_sum((o[0] * o[0] + o[1] * o[1]) + (o[2] * o[2] + o[3] * o[3]));
            const float rs = rsqrtf(ss * (1.0f / GDVH) + EPS);
            f32x4 y;
#pragma unroll
            for (int q = 0; q < 4; ++q) y[q] = o[q] * rs * gg[q] * (r[q] * fast_sigmoid(r[q]));
            u32x2 w; w.x = cvt_pk_bf16(y[0], y[1]); w.y = cvt_pk_bf16(y[2], y[3]);
            ((u32x2*)(GO + (size_t)t * D))[lane + 64 * j] = w;
        }
    }
}

template <int CTRL> __device__ __forceinline__ float dpp_mov(float x) { return __int_as_float(__builtin_amdgcn_update_dpp(0, __float_as_int(x), CTRL, 0xF, 0xF, true)); }
__device__ __forceinline__ float xpair32(float lo, float hi) {
    const auto r = __builtin_amdgcn_permlane32_swap(__float_as_uint(lo), __float_as_uint(hi), false, false); return __uint_as_float(r[0]) + __uint_as_float(r[1]); }
__device__ __forceinline__ float xreduce32(float (&v)[32], int lane) {
#pragma unroll
    for (int k = 0; k < 16; ++k) { const auto r = __builtin_amdgcn_permlane16_swap(__float_as_uint(v[k]), __float_as_uint(v[k + 16]), false, false); v[k] = __uint_as_float(r[0]) + __uint_as_float(r[1]); }
    { const bool up = (lane & 8) != 0;
#pragma unroll
      for (int k = 0; k < 8; ++k) { const float send = up ? v[k] : v[k + 8], keep = up ? v[k + 8] : v[k]; v[k] = keep + dpp_mov<0x128>(send); } }
    { const bool up = (lane & 4) != 0;
#pragma unroll
      for (int k = 0; k < 4; ++k) { const float send = up ? v[k] : v[k + 4], keep = up ? v[k + 4] : v[k]; v[k] = keep + dpp_mov<0x141>(send); } }
    { const bool up = (lane & 2) != 0;
#pragma unroll
      for (int k = 0; k < 2; ++k) { const float send = up ? v[k] : v[k + 2], keep = up ? v[k + 2] : v[k]; v[k] = keep + dpp_mov<0x4E>(send); } }
    { const bool up = (lane & 1) != 0; const float send = up ? v[0] : v[1], keep = up ? v[1] : v[0]; v[0] = keep + dpp_mov<0xB1>(send); }
    return v[0];
}
__device__ __forceinline__ void conv_phase(const bf16_t* U, const float* wdw, const float* bdw, const float* lng, const float* lnb, bf16_t* CV, LAS unsigned char* lds) {
    int tid_ = threadIdx.x; asm volatile("" : "+v"(tid_));
    const int tid = tid_, lane = tid & 63, wv = __builtin_amdgcn_readfirstlane(tid >> 6), c0 = 2 * tid;
    LAS unsigned char* buf = lds;
    LAS float* red = (LAS float*)(lds + 62 * 2048); LAS float* tot = red + 512;
    f32x2 w[CONVK];
#pragma unroll
    for (int j = 0; j < CONVK; ++j) w[j] = *(const f32x2*)(wdw + j * D + c0);
    const f32x2 bd = *(const f32x2*)(bdw + c0), lg = *(const f32x2*)(lng + c0), lb = *(const f32x2*)(lnb + c0);
#define CONV_STAGE(item_) do { const int _t0 = (item_) * 32, _s0 = _t0 & (S - 1); \
        for (int q = wv; q < 124; q += 8) { const int row = q >> 1, half = q & 1; \
            if (_s0 - 30 + row >= 0) __builtin_amdgcn_global_load_lds((const unsigned*)((const char*)U + ((size_t)(_t0 - 30 + row) * D) * 2 + half * 1024 + lane * 16), (LAS unsigned*)(buf + row * 2048 + half * 1024), 16, 0, 0); \
            else *(LAS u32x4*)(buf + row * 2048 + half * 1024 + lane * 16) = (u32x4){0u, 0u, 0u, 0u}; } } while (0)
    int item = blockIdx.x;
    if (item < T / 32) CONV_STAGE(item);
    for (; item < T / 32; item += gridDim.x) {
        const int t0 = item * 32;
        asm volatile("s_waitcnt vmcnt(0) lgkmcnt(0)" ::: "memory");
        __syncthreads();
        unsigned raw[62];
#pragma unroll
        for (int r = 0; r < 62; ++r) raw[r] = *(const LAS unsigned*)(buf + r * 2048 + c0 * 2);
        asm volatile("s_waitcnt lgkmcnt(0)" ::: "memory");
        __syncthreads();
        if (item + (int)gridDim.x < T / 32) CONV_STAGE(item + (int)gridDim.x);
        f32x2 acc[32];
#pragma unroll
        for (int o = 0; o < 32; ++o) acc[o] = bd;
#pragma unroll
        for (int r = 0; r < 62; ++r) {
            const f32x2 uv = (f32x2){bf_lo(raw[r]), bf_hi(raw[r])};
#pragma unroll
            for (int o = (r > 30 ? r - 30 : 0); o <= (r < 31 ? r : 31); ++o) acc[o] = __builtin_elementwise_fma(uv, w[r - o], acc[o]);
        }
        float v[32];
#pragma unroll
        for (int o = 0; o < 32; ++o) v[o] = xpair32(acc[o][0] + acc[o][1], acc[o][0] * acc[o][0] + acc[o][1] * acc[o][1]);
        xreduce32(v, lane);
        red[wv * 64 + lane] = v[0];
        __syncthreads();
        if (tid < 64) { float s = 0.f;
#pragma unroll
            for (int q = 0; q < 8; ++q) s += red[q * 64 + tid];
            tot[tid] = s; }
        __syncthreads();
#pragma unroll
        for (int o = 0; o < 32; ++o) {
            const float mu = tot[o] * (1.0f / D), var = tot[32 + o] * (1.0f / D) - mu * mu, rstd = rsqrtf(var + EPS);
            const float y0 = (acc[o][0] - mu) * rstd * lg[0] + lb[0], y1 = (acc[o][1] - mu) * rstd * lg[1] + lb[1];
            *(unsigned*)(CV + (size_t)(t0 + o) * D + c0) = cvt_pk_bf16(y0 * fast_sigmoid(y0), y1 * fast_sigmoid(y1));
        }
    }
    asm volatile("s_waitcnt vmcnt(0) lgkmcnt(0)" ::: "memory");
    __syncthreads();
#undef CONV_STAGE
}

enum Ph { PH_PREP_ALL = 0, PH_CONV_IN, PH_CONV_MID, PH_CONV_OUT, PH_XA_KV, PH_XA_QSP, PH_XA_O, PH_XA_XS, PH_XA_PVO, PH_ROUTE, PH_BUILD, PH_MOE1, PH_MOE2, PH_COMBINE, PH_COMBINE_FIN, PH_GLA_DECAY, PH_GLA_IN, PH_GLA_ATT, PH_GLA_SCAN, PH_GLA_O, PH_GLA_FIN, PH_GLA_OUT, PH_N };

__device__ __forceinline__ void run_phase(const Ctx& c, int ph, int l, LAS unsigned char* lds) {
    unsigned char* ws = c.ws;
    bf16_t* XB = (bf16_t*)(ws + OW_XB); float* RS = (float*)(ws + OW_RS); float* SSP = (float*)(ws + OW_SSP);
    bf16_t* ACTA = (bf16_t*)(ws + OW_ACTA); bf16_t* ACTB = (bf16_t*)(ws + OW_ACTB);
    bf16_t* WCIN = (bf16_t*)(ws + OW_WCIN); bf16_t* WCOUT = (bf16_t*)(ws + OW_WCOUT);
    bf16_t* ACTC = (bf16_t*)(ws + OW_ACTC); float* PSUM = (float*)(ws + OW_PSUM);
    bf16_t* WXQ = (bf16_t*)(ws + OW_WXQ) + (size_t)l * D * D; bf16_t* WXKV = (bf16_t*)(ws + OW_WXKV) + (size_t)l * 2048 * D; bf16_t* WXO = (bf16_t*)(ws + OW_WXO) + (size_t)l * D * D;
    bf16_t* WR = (bf16_t*)(ws + OW_WR) + (size_t)l * 2 * 48 * 1024;
    int* GCNT = (int*)(ws + OM_AE) + l * 32 * GCS; int* NTP = (int*)(ws + OM_NT); int* TILEE = (int*)(ws + OM_TILEE); int* AE = (int*)(ws + OM_AE); int* APOS = (int*)(ws + OM_APOS); float* GATE = (float*)(ws + OM_GATE);
    int* ETOK = (int*)(ws + OW_ETAB); int* EA = ETOK + (size_t)32 * CAPE; float* ERS = (float*)(EA + (size_t)32 * CAPE); float* EGATE = ERS + (size_t)32 * CAPE;
    int* STOK = (int*)(ws + OM_STOK); int* SA = (int*)(ws + OM_SA); float* SRS = (float*)(ws + OM_SRS); float* SGATE = (float*)(ws + OM_SGATE);
    bf16_t* HB = (bf16_t*)(ws + OW_H); bf16_t* YB = (bf16_t*)(ws + OW_Y); bf16_t* W1 = (bf16_t*)(ws + OW_WMOE); bf16_t* W2 = W1 + (size_t)NE * D * D;
    bf16_t* ATTB = (bf16_t*)(ws + OW_ATT); bf16_t* QKR = (bf16_t*)(ws + OW_QKR); bf16_t* KVT = (bf16_t*)(ws + OW_KVT); float* BTM = (float*)(ws + OW_BTM); float* BFM = (float*)(ws + OW_BFM);
    bf16_t* OB = (bf16_t*)(ws + OW_O); bf16_t* UTB = (bf16_t*)(ws + OW_UT); bf16_t* SPB = (bf16_t*)(ws + OW_SP); float* ALR = (float*)(ws + OW_ALR); float* DLF = (float*)(ws + OW_DL); bf16_t* GOB = (bf16_t*)(ws + OW_GO);
    bf16_t* WGTM = (bf16_t*)(ws + OW_WGTM); bf16_t* WGFM = (bf16_t*)(ws + OW_WGFM); bf16_t* WGO = (bf16_t*)(ws + OW_WGO); float* WAF = (float*)(ws + OW_WA);
    bf16_t* KB = (bf16_t*)(ws + OW_KVB); bf16_t* VT = KB + (size_t)1024 * 1024; bf16_t* VB = VT; bf16_t* MTB = KB + (size_t)2 * 1024 * 1024; bf16_t* VWTB = MTB + (size_t)4 * 1024 * 1024; bf16_t* MEMNB = (bf16_t*)(ws + OW_MEMNB);
    switch (ph) {
    case PH_PREP_ALL: {
        const int NWB = ((int)gridDim.x * 3) >> 3, bx = (int)blockIdx.x;
        if (bx < NWB) {
            cvt_matrix(c.in[7], 2048, 0, 1024, D, c.in[2], WCIN, 1, 0, lds, 0, bx, NWB);
            cvt_matrix(c.in[7], 2048, 1024, 1024, D, c.in[2], WCIN, 1, 1, lds, 512, bx, NWB);
            cvt_matrix(c.in[13], D, 0, D, D, nullptr, WCOUT, 0, 0, lds, 1024, bx, NWB);
            for (int ll = 0; ll < 2; ++ll) {
                cvt_plain(c.in[20] + (size_t)ll * D * D, c.in[3] + ll * D, (bf16_t*)(ws + OW_WXQ) + (size_t)ll * D * D, D, bx, NWB);
                cvt_matrix(c.in[21] + (size_t)ll * D * 2048, 2048, 0, 2048, D, nullptr, (bf16_t*)(ws + OW_WXKV) + (size_t)ll * 2048 * D, 0, 0, lds, 0 + 1024 * ll, bx, NWB);
                cvt_matrix(c.in[22] + (size_t)ll * D * D, D, 0, D, D, nullptr, (bf16_t*)(ws + OW_WXO) + (size_t)ll * D * D, 0, 0, lds, 1024 + 512 * ll, bx, NWB);
                route_prep(c.in[23] + (size_t)ll * D * NG, c.in[25] + (size_t)ll * D * NE, c.in[4] + ll * D, (bf16_t*)(ws + OW_WR) + (size_t)ll * 2 * 48 * 1024, bx, NWB);
            }
            gla_prep(c.in[15], c.in[19], c.in[2] + D, WGTM, WGFM, WGO, WAF, lds, bx, NWB);
            rows_norm_bf16(c.in[1], c.in[5], MEMNB, NB * NMEM, bx, NWB);
        } else rows_prep(c.in[0], XB, RS, nullptr, T, bx - NWB, (int)gridDim.x - NWB);
        { const int tix = otid(); if (blockIdx.x == 0 && tix < 64) ((int*)(ws + OM_AE))[tix * GCS] = 0; }
        } break;
    case PH_CONV_IN: { g8::DenseSched S{8, 128 * 8, D, D, D, XB, WCIN}; g8::gemm_phase(lds, S, g8::EpiGlu{ACTA, RS, c.in[8]}); } break;
    case PH_CONV_MID: conv_phase(ACTA, c.in[9], c.in[10], c.in[11], c.in[12], ACTB, lds); break;
    case PH_CONV_OUT: { g8::DenseSched S{4, 128 * 4, D, D, D, ACTB, WCOUT}; g8::gemm_phase(lds, S, g8::EpiXres{XB, c.in[14], SSP}); } break;
    case PH_XA_KV: {
        { g8::KV2Sched S{MEMNB, WXKV}; g8::gemm_phase(lds, S, g8::EpiKV2{KB, VB}); }
        asm volatile("s_waitcnt vmcnt(0)" ::: "memory"); __syncthreads();
        if (otid() < 64) { __builtin_amdgcn_fence(__ATOMIC_ACQUIRE, "agent"); asm volatile("s_waitcnt vmcnt(0)" ::: "memory"); } __syncthreads();
        { g8::XPreSched S{KB, VB, WXQ, WXO}; g8::gemm_phase(lds, S, g8::EpiPre{MTB, VWTB}); }
        cvt_moe(c.in[27] + (size_t)l * NE * D * DE, c.in[28] + (size_t)l * NE * D * DE, c.in[29] + (size_t)l * NE * DE * D, c.in[4] + l * D, W1, W2, lds, 128);
        } break;
    case PH_XA_XS: { g8::BatchBSched S{XB, MTB}; g8::gemm_phase(lds, S, g8::EpiXS{ACTB, SSP, (LAS float*)(lds + g8::STAGE_BYTES)}); } break;
    case PH_XA_PVO: { g8::BatchBSched S{ACTB, VWTB}; g8::gemm_phase(lds, S, g8::EpiXres{XB, nullptr, nullptr}); } break;
    case PH_XA_QSP: {
        { g8::DenseSched S{4, 128 * 4, D, D, D, XB, WXQ}; g8::gemm_phase(lds, S, g8::EpiRowScale{ACTA, D, SSP, nullptr, 0.0625f, 0, 1.0f}); }
        asm volatile("s_waitcnt vmcnt(0)" ::: "memory"); __syncthreads();
        if (otid() < 64) { __builtin_amdgcn_fence(__ATOMIC_ACQUIRE, "agent"); asm volatile("s_waitcnt vmcnt(0)" ::: "memory"); } __syncthreads();
        { g8::AttnSched S{256, D, D, ACTA, KB, 0}; g8::gemm_phase(lds, S, g8::EpiS{ACTB, PSUM}); }
        asm volatile("s_waitcnt vmcnt(0)" ::: "memory"); __syncthreads();
        if (otid() < 64) { __builtin_amdgcn_fence(__ATOMIC_ACQUIRE, "agent"); asm volatile("s_waitcnt vmcnt(0)" ::: "memory"); } __syncthreads();
        { g8::AttnSched S{256, D, 256, ACTB, VT, 1}; g8::gemm_phase(lds, S, g8::EpiPV{ACTC, PSUM}); }
        } break;
    case PH_XA_O: { g8::DenseSched S{4, 128 * 4, D, D, D, ACTC, WXO}; g8::gemm_phase(lds, S, g8::EpiXres{XB, nullptr, nullptr}); } break;
    case PH_ROUTE: route_phase(XB, WR, c.in[24] + l * NG, c.in[26] + l * NE, ETOK, EA, ERS, EGATE, GCNT, lds); break;
    case PH_BUILD: build_phase(GCNT, AE, APOS, GATE, RS, NTP, TILEE, STOK, SA, SRS, SGATE, lds); break;
    case PH_MOE1: { LAS int* mt = (LAS int*)(lds + g8::STAGE_BYTES + 8192); const int NT = g8::moe_tiles(GCNT, mt);
        g8::MoeSched S{D, D, D, XB, W1, (size_t)D * D, mt, ETOK, NT}; g8::gemm_phase(lds, S, g8::EpiMoe1{HB, ERS, mt}); } break;
    case PH_MOE2: { LAS int* mt = (LAS int*)(lds + g8::STAGE_BYTES + 8192); const int NT = g8::moe_tiles(GCNT, mt);
        g8::MoeSched S{DE, DE, DE, HB, W2, (size_t)D * DE, mt, nullptr, NT}; g8::gemm_phase(lds, S, g8::EpiMoe2{YB, EA, EGATE, mt}); } break;
    case PH_COMBINE: combine_phase(c.out, c.out, YB, XB, RS, SSP, nullptr, 0, WAF, ALR, lds); break;
    case PH_COMBINE_FIN: combine_phase(c.out, c.out, YB, XB, RS, SSP, c.in[6], 1, nullptr, nullptr, lds); break;
    case PH_GLA_DECAY: gla_decay(ALR, c.in[16], c.in[17], BTM, BFM, DLF, lds); break;
    case PH_GLA_IN: { g8::GlaInSched S{XB, WGTM, WGFM}; g8::gemm_phase(lds, S, g8::EpiGlaIn{QKR, KVT, RS, (const bf16_t*)BTM, (const bf16_t*)BFM}); } break;
    case PH_GLA_ATT: { g8::GlaAttSched<0> S{QKR, KVT}; g8::gemm_phase(lds, S, g8::EpiGlaAtt<0>{ATTB, UTB, DLF}); }
        { g8::GlaAttSched<1> S{QKR, KVT}; g8::gemm_phase(lds, S, g8::EpiGlaAtt<1>{ATTB, UTB, DLF}); } break;
    case PH_GLA_SCAN: gla_scan(UTB, DLF, SPB); break;
    case PH_GLA_O: { g8::GlaOSched S{QKR, KVT, ATTB, SPB}; g8::gemm_phase(lds, S, g8::EpiGlaO{GOB, QKR, c.in[18], (LAS float*)(lds + g8::STAGE_BYTES)}); } break;
    case PH_GLA_FIN: gla_fin(OB, QKR, c.in[18], GOB); break;
    case PH_GLA_OUT: { g8::DenseSched S{4, 128 * 4, D, D, D, GOB, WGO}; g8::gemm_phase(lds, S, g8::EpiXres{XB, nullptr, SSP}); } break;
    }
}

#ifndef ALLCG
#define ALLCG 0
#endif
#define XB_TMO      128
#define XB_XCNT(j)  (256  + 64 * (j))
#define XB_XSUB(j)  (1280 + 64 * (j))
#define XB_XGEN(j)  (2304 + 64 * (j))
#define XB_TOP      3328
#define XB_TOPGEN   3392
#define XCD_BAR_WORDS 3456
#define XB_SPIN_CAP (1u << 18)
__device__ __forceinline__ unsigned xb_ld(unsigned* p)              { return __hip_atomic_load(p, __ATOMIC_RELAXED, __HIP_MEMORY_SCOPE_AGENT); }
__device__ __forceinline__ unsigned xb_add(unsigned* p, unsigned v) { return __hip_atomic_fetch_add(p, v, __ATOMIC_RELAXED, __HIP_MEMORY_SCOPE_AGENT); }
__device__ __forceinline__ unsigned xb_xcc_id() { return (unsigned)__builtin_amdgcn_s_getreg((3 << 11) | 20) & 0xFu; }
#define XB_SPIN(cond, bar) do { unsigned _sp = 0; while (cond) { __builtin_amdgcn_s_sleep(1); \
    if ((++_sp & 255u) == 0u) { if (xb_ld(&(bar)[XB_TMO])) break; if (_sp > XB_SPIN_CAP) { atomicAdd(&(bar)[XB_TMO], 1u); break; } } } } while (0)
struct XcdBarrier { unsigned* bar; unsigned x; volatile LAS unsigned* st; };
__device__ __forceinline__ XcdBarrier xcd_barrier_post(unsigned* bar, volatile LAS unsigned* st) {
    XcdBarrier b; b.bar = bar; b.x = xb_xcc_id(); b.st = st;
    if (threadIdx.x == 0) (void)xb_add(&bar[XB_XCNT(b.x)], 1u);
    return b;
}
__device__ __forceinline__ void xcd_barrier_complete(unsigned* bar, unsigned x, unsigned& nloc, unsigned& nx) {
    const unsigned G = gridDim.x * gridDim.y * gridDim.z;
    unsigned sum, cnt, mine, sp = 0u;
    for (;;) {
        sum = 0u; cnt = 0u; mine = 0u;
#pragma unroll
        for (unsigned j = 0; j < 16; ++j) { const unsigned c = xb_ld(&bar[XB_XCNT(j)]); sum += c; cnt += (c > 0u) ? 1u : 0u; mine = (j == x) ? c : mine; }
        if (sum == G) break;
        __builtin_amdgcn_s_sleep(1);
        if ((++sp & 255u) == 0u) { if (xb_ld(&bar[XB_TMO])) break; if (sp > XB_SPIN_CAP) { atomicAdd(&bar[XB_TMO], 1u); break; } }
    }
    nloc = mine > 0u ? mine : 1u; nx = cnt > 0u ? cnt : 1u;
}
__device__ __forceinline__ void xcd_barrier(const XcdBarrier& b) {
    asm volatile("s_waitcnt vmcnt(0)" ::: "memory");
    __syncthreads();
    if (threadIdx.x == 0) {
        unsigned* bar = b.bar;
        __builtin_amdgcn_s_waitcnt(0);
        unsigned nloc = b.st[0], nx = b.st[1];
        if (nloc == 0u) { xcd_barrier_complete(bar, b.x, nloc, nx); b.st[0] = nloc; b.st[1] = nx; }
        const unsigned old = xb_add(&bar[XB_XSUB(b.x)], 1u);
        const unsigned gen = old / nloc;
        if (old + 1u == (gen + 1u) * nloc) {
            __builtin_amdgcn_fence(__ATOMIC_RELEASE, "agent");
            asm volatile("s_waitcnt vmcnt(0)" ::: "memory");
            const unsigned og = xb_add(&bar[XB_TOP], 1u);
            const unsigned tg = og / nx;
            if (og + 1u == (tg + 1u) * nx) xb_add(&bar[XB_TOPGEN], 1u);
            else XB_SPIN(xb_ld(&bar[XB_TOPGEN]) == tg, bar);
            __builtin_amdgcn_fence(__ATOMIC_ACQUIRE, "agent");
            xb_add(&bar[XB_XGEN(b.x)], 1u);
            asm volatile("s_waitcnt vmcnt(0)" ::: "memory");
        } else {
            XB_SPIN(xb_ld(&bar[XB_XGEN(b.x)]) == gen, bar);
            __builtin_amdgcn_fence(__ATOMIC_ACQUIRE, "agent");
            asm volatile("s_waitcnt vmcnt(0)" ::: "memory");
        }
    }
    __syncthreads();
}
template <int CODE> __device__ __forceinline__ void coop_step(const Ctx& c, LAS unsigned char* lds, cg::grid_group& grid, XcdBarrier& xb, bool sync_after, bool first) {
    run_phase(c, CODE >> 5, CODE & 31, lds);
    if (sync_after) {
        if (first || ALLCG) {
            unsigned* bar = (unsigned*)(c.ws + OW_BAR);
            if (first && blockIdx.x == 0) for (int i = threadIdx.x; i < XCD_BAR_WORDS; i += 512) bar[i] = 0u;
            asm volatile("s_waitcnt vmcnt(0) lgkmcnt(0)" ::: "memory");
            grid.sync();
            if (threadIdx.x < 64) { __builtin_amdgcn_fence(__ATOMIC_ACQUIRE, "agent"); asm volatile("s_waitcnt vmcnt(0)" ::: "memory"); }
            __syncthreads();
            if (first) xb = xcd_barrier_post(bar, xb.st);
        } else xcd_barrier(xb);
    }
}
template <int... CODES> __global__ void __launch_bounds__(512, 2) k_coop(Ctx c) {
    extern __shared__ __attribute__((aligned(16))) unsigned char dynlds[];
    cg::grid_group grid = cg::this_grid();
    LAS unsigned char* lds = (LAS unsigned char*)dynlds;
    volatile LAS unsigned* st = (volatile LAS unsigned*)(lds + LDS_BYTES - 16);
    if (threadIdx.x < 4) st[threadIdx.x] = 0u;
    __syncthreads();
    XcdBarrier xb; xb.bar = nullptr; xb.x = 0; xb.st = st;
    int idx = 0; constexpr int N = sizeof...(CODES);
    ((coop_step<CODES>(c, lds, grid, xb, idx + 1 < N, idx == 0), ++idx), ...);
}
#define CODE(ph, l) ((ph) * 32 + (l))
typedef void (*CoopFn)(Ctx);
extern "C" void kernel_launch(void* const* d_in, const int* in_sizes, int n_in, void* d_out, int out_size, void* d_ws, size_t ws_size, hipStream_t stream) {
    if (n_in != 30 || out_size != T * D || ws_size < OW_END) { fprintf(stderr, "kernel_launch: built for 30 inputs, %d outputs and >= %zu bytes of workspace; got n_in %d, out %d, ws %zu; nothing launched\n", T * D, (size_t)OW_END, n_in, out_size, ws_size); return; }
    Ctx c; memset(&c, 0, sizeof(c));
    for (int i = 0; i < 30; ++i) c.in[i] = (const float*)d_in[i];
    c.out = (float*)d_out; c.ws = (unsigned char*)d_ws;
    static CoopFn fn = k_coop<CODE(PH_PREP_ALL, 0), CODE(PH_CONV_IN, 0), CODE(PH_CONV_MID, 0), CODE(PH_CONV_OUT, 0),
                                         CODE(PH_XA_KV, 0), CODE(PH_XA_XS, 0), CODE(PH_XA_PVO, 0),
                                         CODE(PH_ROUTE, 0), CODE(PH_MOE1, 0), CODE(PH_MOE2, 0), CODE(PH_COMBINE, 0),
                                         CODE(PH_GLA_DECAY, 0), CODE(PH_GLA_IN, 0), CODE(PH_GLA_ATT, 0), CODE(PH_GLA_SCAN, 0), CODE(PH_GLA_O, 0), CODE(PH_GLA_OUT, 0),
                                         CODE(PH_XA_KV, 1), CODE(PH_XA_XS, 1), CODE(PH_XA_PVO, 1),
                                         CODE(PH_ROUTE, 1), CODE(PH_MOE1, 1), CODE(PH_MOE2, 1), CODE(PH_COMBINE_FIN, 1)>;
    static int grid = 0;
    if (!grid) {
        int dev = 0, cus = 0, per_cu = 0;
        (void)hipGetDevice(&dev); (void)hipDeviceGetAttribute(&cus, hipDeviceAttributeMultiprocessorCount, dev);
        (void)hipFuncSetAttribute((const void*)fn, hipFuncAttributeMaxDynamicSharedMemorySize, LDS_BYTES);
        (void)hipOccupancyMaxActiveBlocksPerMultiprocessor(&per_cu, fn, 512, LDS_BYTES);
        grid = cus * (per_cu < 1 ? 1 : per_cu); if (grid > 256) grid = 256;
        if (grid != 256) fprintf(stderr, "kernel_launch: %d CUs x %d workgroups: this kernel is laid out for 256 resident workgroups\n", cus, per_cu);
    }
    void* args[] = {&c};
    hipError_t e = hipLaunchCooperativeKernel((void*)fn, dim3(grid), dim3(512), args, LDS_BYTES, stream);
    if (e != hipSuccess) fprintf(stderr, "cooperative launch failed: %s (grid %d)\n", hipGetErrorString(e), grid);
}
```

```cpp
#include <hip/hip_runtime.h>
#include <hip/hip_cooperative_groups.h>
#include <cstdio>
#include <cstring>
namespace cg = cooperative_groups;

constexpr int D = 1024, NB = 4, S = 8192, T = NB * S, NMEM = 256;
constexpr int CONVK = 31;
constexpr int GDK = 512, GDVH = 256, GLA_COLS = 3088;
constexpr int NG = 4, NE = 32, DE = 512;
constexpr int NA = T * 2;
constexpr float EPS = 1e-6f;
constexpr size_t MiB = 1u << 20;

struct Ctx { const float* in[30]; float* out; unsigned char* ws; };

__device__ __forceinline__ float wave_sum(float v) {
#pragma unroll
    for (int o = 1; o < 64; o <<= 1) v += __shfl_xor(v, o);
    return v;
}

#define LAS __attribute__((address_space(3)))
typedef unsigned short bf16_t;
typedef short bf16x8 __attribute__((ext_vector_type(8)));
typedef float f32x4 __attribute__((ext_vector_type(4)));
typedef float f32x2 __attribute__((ext_vector_type(2)));
typedef unsigned u32x4 __attribute__((ext_vector_type(4)));
typedef unsigned u32x2 __attribute__((ext_vector_type(2)));

constexpr int LDS_BYTES = 160 * 1024;
constexpr int NSLOT2 = NA + NE * 256;
constexpr int MAXRT = NSLOT2 / 256;
constexpr int GCS = 64;
constexpr int CAPE = T;
constexpr size_t OW_XB = 0;
constexpr size_t OW_SSP = 64 * MiB;
constexpr size_t OW_RS = 66 * MiB;
constexpr size_t OW_PSUM = 67 * MiB;
constexpr size_t OW_MOE = 69 * MiB;
constexpr size_t OW_ACTA = 72 * MiB, OW_ACTB = 136 * MiB, OW_ACTC = 200 * MiB;
constexpr size_t OW_H = 72 * MiB, OW_Y = 144 * MiB, OW_WMOE = 272 * MiB;
constexpr size_t OW_KVB = 368 * MiB;
constexpr size_t OW_MEMNB = 502 * MiB;
constexpr size_t OW_WCIN = 550 * MiB, OW_WCOUT = 554 * MiB, OW_WXQ = 556 * MiB, OW_WXKV = 560 * MiB, OW_WXO = 568 * MiB, OW_WR = 572 * MiB, OW_BAR = 573 * MiB, OW_DBG = 574 * MiB, OW_END = 575 * MiB;
constexpr size_t OW_ATT = 360 * MiB, OW_QKR = 72 * MiB, OW_KVT = 200 * MiB, OW_BTM = 296 * MiB, OW_O = 296 * MiB, OW_BFM = 360 * MiB, OW_UT = 424 * MiB, OW_SP = 456 * MiB,
                 OW_ALR = 488 * MiB, OW_DL = 490 * MiB, OW_GO = 296 * MiB, OW_WGTM = 492 * MiB, OW_WGFM = 496 * MiB, OW_WGO = 499 * MiB, OW_WA = 501 * MiB;
constexpr size_t OM_GCNT = OW_MOE, OM_NT = OW_MOE + 256, OM_TILEE = OW_MOE + 512, OM_AE = OW_MOE + 4096, OM_APOS = OM_AE + NA * 4, OM_GATE = OM_APOS + NA * 4,
                 OM_STOK = OM_GATE + NA * 4, OM_SA = OM_STOK + NSLOT2 * 4, OM_SRS = OM_SA + NSLOT2 * 4, OM_SGATE = OM_SRS + NSLOT2 * 4, OM_END = OM_SGATE + NSLOT2 * 4;
constexpr size_t OW_ETAB = (size_t)504 << 20;
static_assert(OM_END <= OW_ACTA, "MoE small arrays");

typedef __bf16 bf16x2_t __attribute__((ext_vector_type(2)));
__device__ __forceinline__ unsigned cvt_pk_bf16(float lo, float hi) { const f32x2 v = {lo, hi}; return __builtin_bit_cast(unsigned, __builtin_convertvector(v, bf16x2_t)); }
__device__ __forceinline__ int otid() { int t = threadIdx.x; asm volatile("" : "+v"(t)); return t; }
__device__ __forceinline__ u32x4 pack8(const f32x4& a, const f32x4& b) { u32x4 w; w.x = cvt_pk_bf16(a[0], a[1]); w.y = cvt_pk_bf16(a[2], a[3]); w.z = cvt_pk_bf16(b[0], b[1]); w.w = cvt_pk_bf16(b[2], b[3]); return w; }
__device__ __forceinline__ float bf_lo(unsigned w) { return __uint_as_float(w << 16); }
__device__ __forceinline__ float bf_hi(unsigned w) { return __uint_as_float(w & 0xffff0000u); }
__device__ __forceinline__ float fast_sigmoid(float x) { return __builtin_amdgcn_rcpf(1.0f + __builtin_amdgcn_exp2f(-1.4426950408889634f * x)); }

#ifndef G8_SP2
#define G8_SP2 1
#endif
namespace g8 {
constexpr int BM = 256, BK = 64, HALF = 128, HTB = HALF * BK * 2, STAGE_BYTES = 8 * HTB;
__device__ __forceinline__ int lds_byte(int r, int c) { const int st = (r >> 4) * 2 + (c >> 5), rr = r & 15, cc = c & 31, ob = rr * 64 + cc * 2; return st * 1024 + (ob ^ (((ob >> 9) & 1) << 5)); }
__device__ __forceinline__ void stage_rc(int b, int& R, int& C) { const int st = b / 1024, sb = b % 1024, swz = sb ^ (((sb >> 9) & 1) << 5); R = (st >> 1) * 16 + swz / 64; C = (st & 1) * 32 + (swz % 64) / 2; }
__device__ __forceinline__ int perm32(int rho) { const int n = rho >> 4, i = rho & 15; return 8 * (i >> 2) + 4 * n + (i & 3); }
struct Unit { int pm, pn, e; };

template <class Epi, class Sched>
__device__ __forceinline__ void gemm_phase(LAS unsigned char* lds, const Sched& S, const Epi& E) {
    int tid_ = threadIdx.x; asm volatile("" : "+v"(tid_));
    const int tid = tid_, wid = __builtin_amdgcn_readfirstlane(tid >> 6), lane = tid & 63, wr = wid >> 2, wc = wid & 3, fr = lane & 15, fq = lane >> 4;
    const size_t kstep = (size_t)(BK * 2);
    const unsigned ldsw = (unsigned)wid * 1024u;
    const int aoff = lds_byte(wr * 64 + fr, fq * 8), boff = lds_byte(wc * 32 + fr, fq * 8);
#define G8_SA(b, h) (((b) * 2 + (h)) * HTB)
#define G8_SB(b, h) ((4 + (b) * 2 + (h)) * HTB)
#define G8_STAGE(bufoff, gbase, vv) do { _Pragma("unroll") for (int _i = 0; _i < 2; ++_i) \
        __builtin_amdgcn_global_load_lds((const unsigned*)((const char*)(gbase) + (vv)[_i]), (LAS unsigned*)(lds + (bufoff) + ldsw + _i * 8192), 16, 0, 0); } while (0)
#define G8_LDA(dst, b, h) do { _Pragma("unroll") for (int m = 0; m < 4; ++m) _Pragma("unroll") for (int k = 0; k < 2; ++k) dst[m][k] = *(const LAS bf16x8*)(lds + G8_SA(b, h) + aoff + m * 2048 + k * 1024); } while (0)
#define G8_LDB(dst, b, h) do { _Pragma("unroll") for (int n = 0; n < 2; ++n) _Pragma("unroll") for (int k = 0; k < 2; ++k) dst[n][k] = *(const LAS bf16x8*)(lds + G8_SB(b, h) + boff + n * 2048 + k * 1024); } while (0)
#define G8_MMA(ai, bj, At, Bt) do { __builtin_amdgcn_s_setprio(1); _Pragma("unroll") for (int m = 0; m < 4; ++m) _Pragma("unroll") for (int n = 0; n < 2; ++n) _Pragma("unroll") for (int k = 0; k < 2; ++k) \
        acc[ai][bj][m][n] = __builtin_amdgcn_mfma_f32_16x16x32_bf16(Bt[n][k], At[m][k], acc[ai][bj][m][n], 0, 0, 0); __builtin_amdgcn_s_setprio(0); } while (0)
#define G8_WAIT_V(n) asm volatile("s_waitcnt vmcnt(" #n ")" ::: "memory")
#define G8_WAIT_L(n) asm volatile("s_waitcnt lgkmcnt(" #n ")" ::: "memory")
#define G8_BAR __builtin_amdgcn_s_barrier()
#define G8_SCHED __builtin_amdgcn_sched_barrier(0)
#define G8_VA(dst, u) do { const int _ac = S.a_col(u), _lda = S.lda(u); _Pragma("unroll") for (int _i = 0; _i < 2; ++_i) { int _R, _C; stage_rc(tid * 16 + _i * 8192, _R, _C); \
        _Pragma("unroll") for (int _h = 0; _h < 2; ++_h) dst[_h][_i] = (unsigned)(((size_t)S.a_row(u, _h * HALF + _R) * _lda + _ac + _C) * 2); } } while (0)
#define G8_VB(dst, hs, u) do { const int _ldb = S.ldb(u); hs = (size_t)HALF * _ldb * 2; _Pragma("unroll") for (int _i = 0; _i < 2; ++_i) { int _R, _C; stage_rc(tid * 16 + _i * 8192, _R, _C); \
        dst[_i] = (unsigned)(((_R & ~31) + perm32(_R & 31)) * _ldb + _C) * 2u; } } while (0)
    Unit cur, nxt; int ui = 0; bool aligned_end = false;
    if (!S.next(0, cur)) return;
    f32x4 acc[2][2][4][2];
#pragma unroll
    for (int a = 0; a < 2; ++a)
#pragma unroll
        for (int b = 0; b < 2; ++b)
#pragma unroll
            for (int m = 0; m < 4; ++m)
#pragma unroll
                for (int n = 0; n < 2; ++n) acc[a][b][m][n] = (f32x4){0.f, 0.f, 0.f, 0.f};
    bf16x8 At[4][2], B0[2][2], B1[2][2];
    unsigned va[2][2], nva[2][2], vb[2], nvb[2]; size_t hsB, nhsB;
    G8_VA(va, cur); G8_VB(vb, hsB, cur);
    const char* Ab = S.a_base(cur);
    const char* cB = S.b_base(cur);
#if G8_SP2
    G8_STAGE(G8_SB(0, 0), cB, vb); G8_STAGE(G8_SB(0, 1), cB + hsB, vb); G8_STAGE(G8_SA(0, 0), Ab, va[0]); G8_STAGE(G8_SA(0, 1), Ab, va[1]);
    if (wr == 1) G8_BAR;
    G8_WAIT_V(2); G8_BAR;
    G8_STAGE(G8_SB(1, 0), cB + kstep, vb); G8_STAGE(G8_SA(1, 0), Ab + kstep, va[0]); G8_STAGE(G8_SB(1, 1), cB + hsB + kstep, vb);
    G8_WAIT_V(6); G8_BAR;
#else
    G8_STAGE(G8_SB(0, 0), cB, vb); G8_STAGE(G8_SA(0, 0), Ab, va[0]); G8_STAGE(G8_SB(0, 1), cB + hsB, vb); G8_STAGE(G8_SA(0, 1), Ab, va[1]);
    if (wr == 1) G8_BAR;
    G8_WAIT_V(4); G8_BAR;
    G8_STAGE(G8_SB(1, 0), cB + kstep, vb); G8_STAGE(G8_SA(1, 0), Ab + kstep, va[0]); G8_STAGE(G8_SB(1, 1), cB + hsB + kstep, vb);
    G8_WAIT_V(6); G8_BAR;
#endif
    for (;;) {
        const bool has_next = S.next(ui + 1, nxt);
        const char* nB = cB; const char* nAb = Ab;
        if (has_next) { nB = S.b_base(nxt); nAb = S.a_base(nxt); G8_VA(nva, nxt); G8_VB(nvb, nhsB, nxt); }
        else {
            nhsB = hsB;
#pragma unroll
            for (int i = 0; i < 2; ++i) { nvb[i] = vb[i];
#pragma unroll
                for (int h = 0; h < 2; ++h) nva[h][i] = va[h][i]; }
        }
        const int nt = S.nt(cur);
        for (int t = 0; t < nt; t += 2) {
            const bool last = (t == nt - 2);
            const char* a1 = Ab + (size_t)(t + 1) * kstep;
            const char* a2 = last ? nAb : Ab + (size_t)(t + 2) * kstep;
            const char* b2 = last ? nB : cB + (size_t)(t + 2) * kstep;
            const char* a3 = a2 + kstep; const char* b3 = b2 + kstep;
            const size_t hs2 = last ? nhsB : hsB;
            unsigned v2[2][2], vb2[2];
#pragma unroll
            for (int i = 0; i < 2; ++i) { vb2[i] = last ? nvb[i] : vb[i];
#pragma unroll
                for (int h = 0; h < 2; ++h) v2[h][i] = last ? nva[h][i] : va[h][i]; }
#if G8_SP2
            G8_LDB(B0, 0, 0); G8_LDB(B1, 0, 1); G8_SCHED; G8_LDA(At, 0, 0); G8_STAGE(G8_SA(1, 1), a1, va[1]);
            G8_WAIT_V(8); G8_WAIT_L(0); G8_BAR; G8_MMA(0, 0, At, B0); G8_MMA(0, 1, At, B1); G8_BAR; G8_SCHED;
            G8_LDA(At, 0, 1); G8_STAGE(G8_SB(0, 0), b2, vb2); G8_STAGE(G8_SB(0, 1), b2 + hs2, vb2); G8_STAGE(G8_SA(0, 0), a2, v2[0]);
            G8_WAIT_V(8); G8_WAIT_L(0); G8_BAR; G8_MMA(1, 0, At, B0); G8_MMA(1, 1, At, B1); G8_BAR; G8_SCHED;
            G8_LDB(B0, 1, 0); G8_LDB(B1, 1, 1); G8_SCHED; G8_LDA(At, 1, 0); G8_STAGE(G8_SA(0, 1), a2, v2[1]);
            G8_WAIT_V(8); G8_WAIT_L(0); G8_BAR; G8_MMA(0, 0, At, B0); G8_MMA(0, 1, At, B1); G8_BAR; G8_SCHED;
            G8_LDA(At, 1, 1); G8_STAGE(G8_SB(1, 0), b3, vb2); G8_STAGE(G8_SB(1, 1), b3 + hs2, vb2); G8_STAGE(G8_SA(1, 0), a3, v2[0]);
            G8_WAIT_V(8); G8_WAIT_L(0); G8_BAR; G8_MMA(1, 0, At, B0); G8_MMA(1, 1, At, B1); G8_BAR; G8_SCHED;
#else
            G8_LDB(B0, 0, 0); G8_SCHED; G8_LDA(At, 0, 0); G8_STAGE(G8_SA(1, 1), a1, va[1]);
            G8_WAIT_L(8); G8_BAR; G8_WAIT_L(0); G8_MMA(0, 0, At, B0); G8_BAR; G8_SCHED;
            G8_LDB(B1, 0, 1); G8_STAGE(G8_SB(0, 0), b2, vb2);
            G8_BAR; G8_WAIT_L(0); G8_MMA(0, 1, At, B1); G8_BAR;
            G8_LDA(At, 0, 1); G8_STAGE(G8_SA(0, 0), a2, v2[0]);
            G8_BAR; G8_WAIT_L(0); G8_MMA(1, 0, At, B0); G8_BAR; G8_SCHED;
            G8_STAGE(G8_SB(0, 1), b2 + hs2, vb2);
            G8_WAIT_V(6); G8_BAR; G8_MMA(1, 1, At, B1); G8_BAR;
            G8_LDB(B0, 1, 0); G8_SCHED; G8_LDA(At, 1, 0); G8_STAGE(G8_SA(0, 1), a2, v2[1]);
            G8_WAIT_L(8); G8_BAR; G8_WAIT_L(0); G8_MMA(0, 0, At, B0); G8_BAR; G8_SCHED;
            G8_LDB(B1, 1, 1); G8_STAGE(G8_SB(1, 0), b3, vb2);
            G8_BAR; G8_WAIT_L(0); G8_MMA(0, 1, At, B1); G8_BAR;
            G8_LDA(At, 1, 1); G8_STAGE(G8_SA(1, 0), a3, v2[0]);
            G8_BAR; G8_WAIT_L(0); G8_MMA(1, 0, At, B0); G8_BAR; G8_SCHED;
            G8_STAGE(G8_SB(1, 1), b3 + hs2, vb2);
            G8_WAIT_V(6); G8_BAR; G8_MMA(1, 1, At, B1); G8_BAR;
#endif
        }
        const bool keep = S.cont(cur);
        if (!keep) {
            if (wr == 0) G8_BAR;
            E(acc, cur, wr, wc, fr, fq);
            if (has_next && wr == 1) G8_BAR;
        }
        if (!has_next) { aligned_end = !keep; break; }
        if (!keep) {
#pragma unroll
            for (int a = 0; a < 2; ++a)
#pragma unroll
                for (int b = 0; b < 2; ++b)
#pragma unroll
                    for (int m = 0; m < 4; ++m)
#pragma unroll
                        for (int n = 0; n < 2; ++n) acc[a][b][m][n] = (f32x4){0.f, 0.f, 0.f, 0.f};
        }
        cur = nxt; cB = nB; Ab = nAb; hsB = nhsB; ++ui;
#pragma unroll
        for (int i = 0; i < 2; ++i) { vb[i] = nvb[i];
#pragma unroll
            for (int h = 0; h < 2; ++h) va[h][i] = nva[h][i]; }
    }
    G8_WAIT_V(0);
    if (!aligned_end && wr == 0) G8_BAR;
    G8_BAR;
#undef G8_SA
#undef G8_SB
#undef G8_STAGE
#undef G8_LDA
#undef G8_LDB
#undef G8_MMA
#undef G8_WAIT_V
#undef G8_WAIT_L
#undef G8_BAR
#undef G8_SCHED
#undef G8_VA
#undef G8_VB
}

struct DenseSched {
    __device__ __forceinline__ int lda(const Unit&) const { return lda_; }
    __device__ __forceinline__ int ldb(const Unit&) const { return ldb_; }
    __device__ __forceinline__ int nt(const Unit&) const { return K / BK; }
    __device__ __forceinline__ bool cont(const Unit&) const { return false; }
    int nN, nU, K, lda_, ldb_; const bf16_t* A; const bf16_t* Bt;
    __device__ __forceinline__ const char* a_base(const Unit&) const { return (const char*)A; }
    __device__ __forceinline__ bool next(int i, Unit& u) const {
        const int c = blockIdx.x, per = gridDim.x >> 3, x = c & 7, j = c >> 3;
        const int chunk = (nU + 7) >> 3, lu = i * per + j;
        if (lu >= chunk) return false;
        const int un = x * chunk + lu; if (un >= nU) return false;
        u.pm = un / nN; u.pn = un - u.pm * nN; u.e = 0; return true; }
    __device__ __forceinline__ int a_row(const Unit& u, int r) const { return u.pm * BM + r; }
    __device__ __forceinline__ int a_col(const Unit&) const { return 0; }
    __device__ __forceinline__ const char* b_base(const Unit& u) const { return (const char*)(Bt + (size_t)u.pn * BM * ldb_); }
};

struct EpiGlu {
    bf16_t* U; const float* rs; const float* bias;
    __device__ __forceinline__ void operator()(const f32x4 (&acc)[2][2][4][2], const Unit& u, int wr, int wc, int fr, int fq) const {
        const int c0 = u.pn * 128 + wc * 32 + 8 * fq;
        const f32x4 ba0 = *(const f32x4*)(bias + c0), ba1 = *(const f32x4*)(bias + c0 + 4), bg0 = *(const f32x4*)(bias + 1024 + c0), bg1 = *(const f32x4*)(bias + 1024 + c0 + 4);
        float rv[2][4];
#pragma unroll
        for (int ai = 0; ai < 2; ++ai)
#pragma unroll
            for (int m = 0; m < 4; ++m) rv[ai][m] = rs[u.pm * BM + ai * HALF + wr * 64 + m * 16 + fr];
        __builtin_amdgcn_sched_barrier(0);
#pragma unroll
        for (int ai = 0; ai < 2; ++ai)
#pragma unroll
            for (int m = 0; m < 4; ++m) {
                const int row = u.pm * BM + ai * HALF + wr * 64 + m * 16 + fr; const float r = rv[ai][m];
                f32x4 o0, o1;
#pragma unroll
                for (int j = 0; j < 4; ++j) {
                    o0[j] = (acc[ai][0][m][0][j] * r + ba0[j]) * fast_sigmoid(acc[ai][1][m][0][j] * r + bg0[j]);
                    o1[j] = (acc[ai][0][m][1][j] * r + ba1[j]) * fast_sigmoid(acc[ai][1][m][1][j] * r + bg1[j]); }
                *(u32x4*)(U + (size_t)row * D + c0) = pack8(o0, o1);
            }
    }
};
struct EpiXres {
    bf16_t* XB; const float* bias; float* ssp;
    __device__ __forceinline__ void operator()(const f32x4 (&acc)[2][2][4][2], const Unit& u, int wr, int wc, int fr, int fq) const {
        f32x4 bv[2][2];
#pragma unroll
        for (int bj = 0; bj < 2; ++bj) { const int c0 = u.pn * BM + bj * HALF + wc * 32 + 8 * fq;
            bv[bj][0] = bias ? *(const f32x4*)(bias + c0) : (f32x4){0.f, 0.f, 0.f, 0.f}; bv[bj][1] = bias ? *(const f32x4*)(bias + c0 + 4) : (f32x4){0.f, 0.f, 0.f, 0.f}; }
#pragma unroll
        for (int ai = 0; ai < 2; ++ai) {
            u32x4 xv[2][4][2];
#pragma unroll
            for (int m = 0; m < 4; ++m)
#pragma unroll
                for (int bj = 0; bj < 2; ++bj) xv[ai][m][bj] = *(const u32x4*)(XB + (size_t)(u.pm * BM + ai * HALF + wr * 64 + m * 16 + fr) * D + u.pn * BM + bj * HALF + wc * 32 + 8 * fq);
            __builtin_amdgcn_sched_barrier(0);
#pragma unroll
            for (int m = 0; m < 4; ++m) {
                const int row = u.pm * BM + ai * HALF + wr * 64 + m * 16 + fr; float ss = 0.f;
#pragma unroll
                for (int bj = 0; bj < 2; ++bj) {
                    const size_t off = (size_t)row * D + u.pn * BM + bj * HALF + wc * 32 + 8 * fq; const u32x4 xw = xv[ai][m][bj];
                    const f32x4 v0 = (f32x4){bf_lo(xw.x), bf_hi(xw.x), bf_lo(xw.y), bf_hi(xw.y)} + acc[ai][bj][m][0] + bv[bj][0];
                    const f32x4 v1 = (f32x4){bf_lo(xw.z), bf_hi(xw.z), bf_lo(xw.w), bf_hi(xw.w)} + acc[ai][bj][m][1] + bv[bj][1];
                    const u32x4 w = pack8(v0, v1);
                    *(u32x4*)(XB + off) = w;
                    const float r0 = bf_lo(w.x), r1 = bf_hi(w.x), r2 = bf_lo(w.y), r3 = bf_hi(w.y), r4 = bf_lo(w.z), r5 = bf_hi(w.z), r6 = bf_lo(w.w), r7 = bf_hi(w.w);
                    ss += (r0 * r0 + r1 * r1) + (r2 * r2 + r3 * r3) + (r4 * r4 + r5 * r5) + (r6 * r6 + r7 * r7);
                }
                if (ssp) { ss += __shfl_xor(ss, 16); ss += __shfl_xor(ss, 32); if (fq == 0) ssp[(size_t)row * 16 + u.pn * 4 + wc] = ss; }
            }
            __builtin_amdgcn_sched_barrier(0);
        }
    }
};
struct AttnSched {
    __device__ __forceinline__ int lda(const Unit&) const { return lda_; }
    __device__ __forceinline__ int ldb(const Unit&) const { return ldb_; }
    __device__ __forceinline__ int nt(const Unit&) const { return K / BK; }
    __device__ __forceinline__ bool cont(const Unit&) const { return false; }
    int K, lda_, ldb_; const bf16_t* A; const bf16_t* Bm; int pv;
    __device__ __forceinline__ bool next(int i, Unit& u) const {
        const int c = blockIdx.x, per = gridDim.x >> 3, x = c & 7, j = c >> 3;
        const int lu = i * per + j; if (lu >= 64) return false;
        const int un = x * 64 + lu;
        u.pm = un >> 2; u.pn = 0; u.e = un & 3; return true; }
    __device__ __forceinline__ const char* a_base(const Unit&) const { return (const char*)A; }
    __device__ __forceinline__ int a_row(const Unit& u, int r) const { return u.pm * BM + r; }
    __device__ __forceinline__ int a_col(const Unit& u) const { return u.e * 256; }
    __device__ __forceinline__ const char* b_base(const Unit& u) const { const int b = u.pm >> 5;
        return pv ? (const char*)(Bm + (size_t)(b * 4 + u.e) * 65536) : (const char*)(Bm + (size_t)(b * 256) * 1024 + u.e * 256); }
};
struct KVSched {
    __device__ __forceinline__ int lda(const Unit&) const { return lda_; }
    __device__ __forceinline__ int ldb(const Unit&) const { return ldb_; }
    __device__ __forceinline__ int nt(const Unit&) const { return K / BK; }
    __device__ __forceinline__ bool cont(const Unit&) const { return false; }
    int K, lda_, ldb_; const bf16_t* MEMNB; const bf16_t* WKV;
    __device__ __forceinline__ bool next(int i, Unit& u) const {
        const int un = i * (int)gridDim.x + (int)blockIdx.x; if (un >= 32) return false;
        u.e = un >> 4; u.pm = (un & 15) >> 2; u.pn = un & 3; return true; }
    __device__ __forceinline__ const char* a_base(const Unit& u) const { return u.e ? (const char*)(WKV + (size_t)1024 * 1024) : (const char*)MEMNB; }
    __device__ __forceinline__ int a_row(const Unit& u, int r) const { return u.pm * BM + r; }
    __device__ __forceinline__ int a_col(const Unit&) const { return 0; }
    __device__ __forceinline__ const char* b_base(const Unit& u) const { return u.e ? (const char*)(MEMNB + (size_t)u.pn * BM * 1024) : (const char*)(WKV + (size_t)u.pn * BM * 1024); }
};
__device__ __forceinline__ float ssp_rs(const float* ssp, int row) {
    const f32x4 a = *(const f32x4*)(ssp + (size_t)row * 16), b = *(const f32x4*)(ssp + (size_t)row * 16 + 4), c = *(const f32x4*)(ssp + (size_t)row * 16 + 8), d = *(const f32x4*)(ssp + (size_t)row * 16 + 12);
    const float s = ((a[0] + a[1]) + (a[2] + a[3])) + ((b[0] + b[1]) + (b[2] + b[3])) + ((c[0] + c[1]) + (c[2] + c[3])) + ((d[0] + d[1]) + (d[2] + d[3]));
    return rsqrtf(s * (1.0f / D) + EPS);
}
struct EpiRowScale {
    bf16_t* O; int ldo; const float* ssp; const float* rs; float scale; int qtiles; float qscale;
    __device__ __forceinline__ void operator()(const f32x4 (&acc)[2][2][4][2], const Unit& u, int wr, int wc, int fr, int fq) const {
        const float cs = scale * (u.pn < qtiles ? qscale : 1.0f);
        float rv[2][4];
        if (rs) {
#pragma unroll
            for (int ai = 0; ai < 2; ++ai)
#pragma unroll
                for (int m = 0; m < 4; ++m) rv[ai][m] = rs[u.pm * BM + ai * HALF + wr * 64 + m * 16 + fr];
        } else {
#pragma unroll
            for (int ai = 0; ai < 2; ++ai) {
                f32x4 p[4][4];
#pragma unroll
                for (int m = 0; m < 4; ++m)
#pragma unroll
                    for (int q = 0; q < 4; ++q) p[m][q] = *(const f32x4*)(ssp + (size_t)(u.pm * BM + ai * HALF + wr * 64 + m * 16 + fr) * 16 + 4 * q);
                __builtin_amdgcn_sched_barrier(0);
#pragma unroll
                for (int m = 0; m < 4; ++m) { float sm = 0.f;
#pragma unroll
                    for (int q = 0; q < 4; ++q) sm += (p[m][q][0] + p[m][q][1]) + (p[m][q][2] + p[m][q][3]);
                    rv[ai][m] = rsqrtf(sm * (1.0f / D) + EPS); }
            }
        }
        __builtin_amdgcn_sched_barrier(0);
#pragma unroll
        for (int ai = 0; ai < 2; ++ai)
#pragma unroll
            for (int m = 0; m < 4; ++m) {
                const int row = u.pm * BM + ai * HALF + wr * 64 + m * 16 + fr;
                const float r = rv[ai][m] * cs;
#pragma unroll
                for (int bj = 0; bj < 2; ++bj) { const int c0 = u.pn * BM + bj * HALF + wc * 32 + 8 * fq;
                    *(u32x4*)(O + (size_t)row * ldo + c0) = pack8(acc[ai][bj][m][0] * r, acc[ai][bj][m][1] * r); }
            }
    }
};
struct EpiKV {
    bf16_t* Kb; bf16_t* VT;
    __device__ __forceinline__ void operator()(const f32x4 (&acc)[2][2][4][2], const Unit& u, int wr, int wc, int fr, int fq) const {
        bf16_t* base = u.e ? VT + (size_t)(u.pn * 4 + u.pm) * 65536 : Kb + (size_t)u.pm * BM * 1024 + u.pn * BM;
        const int ld = u.e ? 256 : 1024;
#pragma unroll
        for (int ai = 0; ai < 2; ++ai)
#pragma unroll
            for (int m = 0; m < 4; ++m) { const int r = ai * HALF + wr * 64 + m * 16 + fr;
#pragma unroll
                for (int bj = 0; bj < 2; ++bj) { const int c0 = bj * HALF + wc * 32 + 8 * fq;
                    *(u32x4*)(base + (size_t)r * ld + c0) = pack8(acc[ai][bj][m][0], acc[ai][bj][m][1]); } }
    }
};
struct EpiS {
    bf16_t* P; float* psum;
    __device__ __forceinline__ void operator()(const f32x4 (&acc)[2][2][4][2], const Unit& u, int wr, int wc, int fr, int fq) const {
#pragma unroll
        for (int ai = 0; ai < 2; ++ai)
#pragma unroll
            for (int m = 0; m < 4; ++m) {
                const int row = u.pm * BM + ai * HALF + wr * 64 + m * 16 + fr; float ps = 0.f;
#pragma unroll
                for (int bj = 0; bj < 2; ++bj) { const int c0 = u.e * 256 + bj * HALF + wc * 32 + 8 * fq;
                    f32x4 e0, e1;
#pragma unroll
                    for (int j = 0; j < 4; ++j) { e0[j] = __builtin_amdgcn_exp2f(acc[ai][bj][m][0][j] * 1.4426950408889634f); e1[j] = __builtin_amdgcn_exp2f(acc[ai][bj][m][1][j] * 1.4426950408889634f); }
                    const u32x4 w = pack8(e0, e1);
                    *(u32x4*)(P + (size_t)row * D + c0) = w;
                    ps += (bf_lo(w.x) + bf_hi(w.x)) + (bf_lo(w.y) + bf_hi(w.y)) + (bf_lo(w.z) + bf_hi(w.z)) + (bf_lo(w.w) + bf_hi(w.w)); }
                ps += __shfl_xor(ps, 16); ps += __shfl_xor(ps, 32);
                if (fq == 0) psum[(size_t)row * 16 + u.e * 4 + wc] = ps;
            }
    }
};
struct EpiPV {
    bf16_t* O; const float* psum;
    __device__ __forceinline__ void operator()(const f32x4 (&acc)[2][2][4][2], const Unit& u, int wr, int wc, int fr, int fq) const {
        f32x4 sv[2][4];
#pragma unroll
        for (int ai = 0; ai < 2; ++ai)
#pragma unroll
            for (int m = 0; m < 4; ++m) sv[ai][m] = *(const f32x4*)(psum + (size_t)(u.pm * BM + ai * HALF + wr * 64 + m * 16 + fr) * 16 + u.e * 4);
        __builtin_amdgcn_sched_barrier(0);
#pragma unroll
        for (int ai = 0; ai < 2; ++ai)
#pragma unroll
            for (int m = 0; m < 4; ++m) {
                const int row = u.pm * BM + ai * HALF + wr * 64 + m * 16 + fr;
                const float inv = 1.0f / ((sv[ai][m][0] + sv[ai][m][1]) + (sv[ai][m][2] + sv[ai][m][3]));
#pragma unroll
                for (int bj = 0; bj < 2; ++bj) { const int c0 = u.e * 256 + bj * HALF + wc * 32 + 8 * fq;
                    *(u32x4*)(O + (size_t)row * D + c0) = pack8(acc[ai][bj][m][0] * inv, acc[ai][bj][m][1] * inv); }
            }
    }
};

__device__ __forceinline__ int ld_agent(const int* p) { return __hip_atomic_load(p, __ATOMIC_RELAXED, __HIP_MEMORY_SCOPE_AGENT); }
struct MoeSched {
    __device__ __forceinline__ int lda(const Unit&) const { return lda_; }
    __device__ __forceinline__ int ldb(const Unit&) const { return ldb_; }
    __device__ __forceinline__ int nt(const Unit&) const { return K / BK; }
    __device__ __forceinline__ bool cont(const Unit&) const { return false; }
    int K, lda_, ldb_; const bf16_t* A; const bf16_t* W; size_t wstride; const LAS int* mt; const int* etok; int NT;
    __device__ __forceinline__ bool next(int i, Unit& u) const {
        const int c = blockIdx.x, per = gridDim.x >> 3, x = c & 7, j = c >> 3;
        const int tpx = (NT + 7) >> 3, lu = i * per + j, lrt = lu >> 2;
        if (lrt >= tpx) return false;
        const int rt = x * tpx + lrt; if (rt >= NT) return false;
        const int e = __builtin_amdgcn_readfirstlane(mt[80 + rt]), lt = rt - __builtin_amdgcn_readfirstlane(mt[e]);
        u.pm = rt; u.pn = lu & 3; u.e = e | (lt << 5); return true; }
    __device__ __forceinline__ const char* a_base(const Unit&) const { return (const char*)A; }
    __device__ __forceinline__ int a_row(const Unit& u, int r) const {
        if (!etok) return u.pm * BM + r;
        const int e = u.e & 31, p = (u.e >> 5) * BM + r; return p < mt[40 + e] ? etok[e * CAPE + p] : 0; }
    __device__ __forceinline__ int a_col(const Unit&) const { return 0; }
    __device__ __forceinline__ const char* b_base(const Unit& u) const { return (const char*)(W + (size_t)(u.e & 31) * wstride + (size_t)u.pn * BM * ldb_); }
};
__device__ __forceinline__ int moe_tiles(const int* gcnt, LAS int* mt) {
    const int tix = otid();
    if (tix < 32) mt[40 + tix] = ld_agent(gcnt + tix * GCS);
    __syncthreads();
    if (tix == 0) { int o = 0; for (int e = 0; e < 32; ++e) { mt[e] = o; o += (mt[40 + e] + 255) >> 8; } mt[32] = o; }
    __syncthreads();
    const int NT = mt[32];
    for (int rt = tix; rt < NT; rt += 512) { int e = 0;
#pragma unroll 1
        for (int k = 1; k < 32; ++k) if (rt >= mt[k]) e = k;
        mt[80 + rt] = e; }
    __syncthreads();
    return __builtin_amdgcn_readfirstlane(NT);
}
struct EpiMoe1 {
    bf16_t* H; const float* ers; const LAS int* mt;
    __device__ __forceinline__ void operator()(const f32x4 (&acc)[2][2][4][2], const Unit& u, int wr, int wc, int fr, int fq) const {
        const int c0 = u.pn * 128 + wc * 32 + 8 * fq;
        const int e = u.e & 31, p0 = (u.e >> 5) * BM, nv = mt[40 + e] - p0;
        const float* rsp = ers + (size_t)e * CAPE + p0;
        float rv[2][4];
#pragma unroll
        for (int ai = 0; ai < 2; ++ai)
#pragma unroll
            for (int m = 0; m < 4; ++m) { const int r = ai * HALF + wr * 64 + m * 16 + fr; rv[ai][m] = r < nv ? rsp[r] : 0.f; }
        __builtin_amdgcn_sched_barrier(0);
#pragma unroll
        for (int ai = 0; ai < 2; ++ai)
#pragma unroll
            for (int m = 0; m < 4; ++m) {
                const int row = u.pm * BM + ai * HALF + wr * 64 + m * 16 + fr; const float r = rv[ai][m];
                f32x4 o0, o1;
#pragma unroll
                for (int j = 0; j < 4; ++j) {
                    const float g0 = acc[ai][0][m][0][j] * r, g1 = acc[ai][0][m][1][j] * r;
                    o0[j] = g0 * fast_sigmoid(g0) * (acc[ai][1][m][0][j] * r);
                    o1[j] = g1 * fast_sigmoid(g1) * (acc[ai][1][m][1][j] * r); }
                *(u32x4*)(H + (size_t)row * DE + c0) = pack8(o0, o1);
            }
    }
};
struct EpiMoe2 {
    bf16_t* Y; const int* ea; const float* egate; const LAS int* mt;
    __device__ __forceinline__ void operator()(const f32x4 (&acc)[2][2][4][2], const Unit& u, int wr, int wc, int fr, int fq) const {
        const int e = u.e & 31, p0 = (u.e >> 5) * BM, nv = mt[40 + e] - p0;
        const int* ap = ea + (size_t)e * CAPE + p0; const float* gp = egate + (size_t)e * CAPE + p0;
        int av[2][4]; float gv[2][4];
#pragma unroll
        for (int ai = 0; ai < 2; ++ai)
#pragma unroll
            for (int m = 0; m < 4; ++m) { const int r = ai * HALF + wr * 64 + m * 16 + fr; const bool ok = r < nv; av[ai][m] = ok ? ap[r] : -1; gv[ai][m] = ok ? gp[r] : 0.f; }
        __builtin_amdgcn_sched_barrier(0);
#pragma unroll
        for (int ai = 0; ai < 2; ++ai)
#pragma unroll
            for (int m = 0; m < 4; ++m) {
                const int a = av[ai][m]; const float g = gv[ai][m];
                if (a >= 0) {
#pragma unroll
                    for (int bj = 0; bj < 2; ++bj) { const int c0 = u.pn * BM + bj * HALF + wc * 32 + 8 * fq;
                        *(u32x4*)(Y + (size_t)a * D + c0) = pack8(acc[ai][bj][m][0] * g, acc[ai][bj][m][1] * g); }
                }
            }
    }
};

struct EpiMoe1P {
    bf16_t* H; const float* ers; const LAS int* mt; int* flag; int first_rt;
    __device__ __forceinline__ void operator()(const f32x4 (&acc)[2][2][4][2], const Unit& u, int wr, int wc, int fr, int fq) const {
        const int c0 = u.pn * 128 + wc * 32 + 8 * fq;
        const int e = u.e & 31, p0 = (u.e >> 5) * BM, nv = mt[40 + e] - p0;
        const float* rsp = ers + (size_t)e * CAPE + p0;
        float rv[2][4];
#pragma unroll
        for (int ai = 0; ai < 2; ++ai)
#pragma unroll
            for (int m = 0; m < 4; ++m) { const int r = ai * HALF + wr * 64 + m * 16 + fr; rv[ai][m] = r < nv ? rsp[r] : 0.f; }
        __builtin_amdgcn_sched_barrier(0);
        asm volatile("s_waitcnt vmcnt(0)" ::: "memory");
        if (u.pm - first_rt >= 8 && fr == 0 && fq == 0) (void)__hip_atomic_fetch_add(flag + (u.pm - 8), 1, __ATOMIC_RELAXED, __HIP_MEMORY_SCOPE_AGENT);
        __builtin_amdgcn_sched_barrier(0);
#pragma unroll
        for (int ai = 0; ai < 2; ++ai)
#pragma unroll
            for (int m = 0; m < 4; ++m) {
                const int row = u.pm * BM + ai * HALF + wr * 64 + m * 16 + fr; const float r = rv[ai][m];
                f32x4 o0, o1;
#pragma unroll
                for (int j = 0; j < 4; ++j) {
                    const float g0 = acc[ai][0][m][0][j] * r, g1 = acc[ai][0][m][1][j] * r;
                    o0[j] = g0 * fast_sigmoid(g0) * (acc[ai][1][m][0][j] * r);
                    o1[j] = g1 * fast_sigmoid(g1) * (acc[ai][1][m][1][j] * r); }
                *(u32x4*)(H + (size_t)row * DE + c0) = pack8(o0, o1);
            }
    }
};
struct Moe2Sched {
    __device__ __forceinline__ int lda(const Unit&) const { return DE; }
    __device__ __forceinline__ int ldb(const Unit&) const { return DE; }
    __device__ __forceinline__ int nt(const Unit&) const { return DE / BK; }
    __device__ __forceinline__ bool cont(const Unit&) const { return false; }
    const bf16_t* A; const bf16_t* W; const LAS int* mt; int NT; const int* flag;
    __device__ __forceinline__ bool next(int k, Unit& u) const {
        const int c = blockIdx.x, x = c & 7, j = c >> 3;
        const int tpx = (NT + 7) >> 3, U = tpx * 4, r = U - 128, w = 32 - r;
        int q;
        if (j >= r) q = k < 2 ? k * w + (j - r) : 2 * w + (k - 2) * 32 + (k < 4 ? j : j - r);
        else        q = 2 * w + k * 32 + (k < 2 ? j : w + j);
        if (q >= U) return false;
        const int rt = x * tpx + (q >> 2); if (rt >= NT) return false;
        const int e = __builtin_amdgcn_readfirstlane(mt[80 + rt]), lt = rt - __builtin_amdgcn_readfirstlane(mt[e]);
        u.pm = rt; u.pn = q & 3; u.e = e | (lt << 5);
        if (k < 8 && __builtin_amdgcn_readfirstlane(mt[400 + k])) return true;
        unsigned sp = 0;
        while (__builtin_amdgcn_readfirstlane(ld_agent(flag + rt)) < 32) { __builtin_amdgcn_s_sleep(2); if (++sp > (1u << 17)) break; }
        return true; }
    __device__ __forceinline__ int unit_rt(int k) const {
        const int c = blockIdx.x, x = c & 7, j = c >> 3;
        const int tpx = (NT + 7) >> 3, U = tpx * 4, r = U - 128, w = 32 - r;
        int q;
        if (j >= r) q = k < 2 ? k * w + (j - r) : 2 * w + (k - 2) * 32 + (k < 4 ? j : j - r);
        else        q = 2 * w + k * 32 + (k < 2 ? j : w + j);
        if (q >= U) return -1;
        const int rt = x * tpx + (q >> 2); return rt < NT ? rt : -1; }
    __device__ __forceinline__ const char* a_base(const Unit&) const { return (const char*)A; }
    __device__ __forceinline__ int a_row(const Unit& u, int r) const { return u.pm * BM + r; }
    __device__ __forceinline__ int a_col(const Unit&) const { return 0; }
    __device__ __forceinline__ const char* b_base(const Unit& u) const { return (const char*)(W + (size_t)(u.e & 31) * ((size_t)D * DE) + (size_t)u.pn * BM * DE); }
};

struct GlaInSched {
    const bf16_t* XB; const bf16_t* WTM; const bf16_t* WFM;
    __device__ __forceinline__ int lda(const Unit&) const { return D; }
    __device__ __forceinline__ int ldb(const Unit&) const { return D; }
    __device__ __forceinline__ int nt(const Unit&) const { return D / BK; }
    __device__ __forceinline__ bool cont(const Unit&) const { return false; }
    __device__ __forceinline__ bool next(int i, Unit& u) const {
        const int c = blockIdx.x, per = gridDim.x >> 3, x = c & 7, j = c >> 3, lu = i * per + j;
        if (lu >= 192) return false;
        if (lu < 128) { u.e = 0; u.pm = x * 16 + (lu >> 3); u.pn = ((lu & 7) + 4 * (i & 1) + (i & 2)) & 7; }
        else { const int v = x * 64 + (lu - 128); u.e = 1; u.pn = v >> 2; u.pm = 2 + (v & 3); }
        return true; }
    __device__ __forceinline__ const char* a_base(const Unit& u) const { return u.e ? (const char*)WFM : (const char*)XB; }
    __device__ __forceinline__ int a_row(const Unit& u, int r) const { return u.pm * BM + r; }
    __device__ __forceinline__ int a_col(const Unit&) const { return 0; }
    __device__ __forceinline__ const char* b_base(const Unit& u) const { return u.e ? (const char*)(XB + (size_t)u.pn * BM * D) : (const char*)(WTM + (size_t)u.pn * BM * D); }
};

struct EpiGlaIn {
    bf16_t* QKR; bf16_t* KVT; const float* RS; const bf16_t* EQ; const bf16_t* EKF;
    __device__ __forceinline__ void operator()(const f32x4 (&acc)[2][2][4][2], const Unit& u, int wr, int wc, int fr, int fq) const {
        if (u.e == 0) {
            float rv[2][4];
#pragma unroll
            for (int ai = 0; ai < 2; ++ai)
#pragma unroll
                for (int m = 0; m < 4; ++m) rv[ai][m] = RS[u.pm * BM + ai * HALF + wr * 64 + m * 16 + fr];
            const float qs = u.pn < 2 ? 0.08838834764831845f : 1.0f;
            const bf16_t* F = EQ + (u.pn < 2 ? (size_t)0 : (size_t)T * 512);
#pragma unroll
            for (int ai = 0; ai < 2; ++ai) {
                u32x4 fv[4][2];
                if (u.pn < 4) {
#pragma unroll
                    for (int m = 0; m < 4; ++m)
#pragma unroll
                        for (int bj = 0; bj < 2; ++bj) { const int row = u.pm * BM + ai * HALF + wr * 64 + m * 16 + fr, kf = (u.pn * BM + bj * HALF + wc * 32 + 8 * fq) & 511;
                            fv[m][bj] = *(const u32x4*)(F + (size_t)row * 512 + kf); }
                }
                __builtin_amdgcn_sched_barrier(0);
#pragma unroll
                for (int m = 0; m < 4; ++m) {
                    const int row = u.pm * BM + ai * HALF + wr * 64 + m * 16 + fr; const float r = rv[ai][m] * qs;
#pragma unroll
                    for (int bj = 0; bj < 2; ++bj) { const int c0 = u.pn * BM + bj * HALF + wc * 32 + 8 * fq;
                        f32x4 s0 = (f32x4){r, r, r, r}, s1 = s0;
                        if (u.pn < 4) { const u32x4 w = fv[m][bj];
                            s0 *= (f32x4){bf_lo(w.x), bf_hi(w.x), bf_lo(w.y), bf_hi(w.y)}; s1 *= (f32x4){bf_lo(w.z), bf_hi(w.z), bf_lo(w.w), bf_hi(w.w)}; }
                        const u32x4 w = pack8(acc[ai][bj][m][0] * s0, acc[ai][bj][m][1] * s1);
                        *(u32x4*)(QKR + (size_t)row * 2048 + c0) = w;
                        if (u.pn == 2 || u.pn == 3) {
                            bf16_t* kt = KVT + (size_t)(c0 - 512) * T + row;
                            kt[0] = (bf16_t)(w.x & 0xffffu); kt[(size_t)T] = (bf16_t)(w.x >> 16); kt[(size_t)2 * T] = (bf16_t)(w.y & 0xffffu); kt[(size_t)3 * T] = (bf16_t)(w.y >> 16);
                            kt[(size_t)4 * T] = (bf16_t)(w.z & 0xffffu); kt[(size_t)5 * T] = (bf16_t)(w.z >> 16); kt[(size_t)6 * T] = (bf16_t)(w.w & 0xffffu); kt[(size_t)7 * T] = (bf16_t)(w.w >> 16); } }
                }
                __builtin_amdgcn_sched_barrier(0);
            }
        } else {
#pragma unroll
            for (int bj = 0; bj < 2; ++bj) { const int t0 = u.pn * BM + bj * HALF + wc * 32 + 8 * fq;
                const f32x4 r0 = *(const f32x4*)(RS + t0), r1 = *(const f32x4*)(RS + t0 + 4);
#pragma unroll
                for (int ai = 0; ai < 2; ++ai)
#pragma unroll
                    for (int m = 0; m < 4; ++m) { const int f = u.pm * BM + ai * HALF + wr * 64 + m * 16 + fr;
                        *(u32x4*)(KVT + (size_t)f * T + t0) = pack8(acc[ai][bj][m][0] * r0, acc[ai][bj][m][1] * r1); }
            }
        }
    }
};
template <int TYP> struct GlaAttSched {
    const bf16_t* QKR; const bf16_t* KVT;
    __device__ __forceinline__ bool next(int i, Unit& u) const {
        const int c = blockIdx.x, per = gridDim.x >> 3, x = c & 7, j = c >> 3, lu = i * per + j;
        if (lu >= 64) return false;
        u.e = TYP; u.pm = x * 16 + (lu >> 2); u.pn = lu & 3; return true; }
    __device__ __forceinline__ int lda(const Unit& u) const { return TYP ? T : 2048; }
    __device__ __forceinline__ int ldb(const Unit& u) const { return TYP ? T : 2048; }
    __device__ __forceinline__ int nt(const Unit& u) const { int n = TYP ? 4 : 2; asm volatile("" : "+s"(n)); return n; }
    __device__ __forceinline__ bool cont(const Unit&) const { return false; }
    __device__ __forceinline__ const char* a_base(const Unit& u) const { return TYP ? (const char*)KVT : (const char*)QKR; }
    __device__ __forceinline__ int a_row(const Unit& u, int r) const { return TYP ? 512 + u.pn * 256 + r : u.pm * BM + r; }
    __device__ __forceinline__ int a_col(const Unit& u) const { return TYP ? u.pm * BM : u.pn * 128; }
    __device__ __forceinline__ const char* b_base(const Unit& u) const {
        return TYP ? (const char*)(KVT + (size_t)(u.pn * 128) * T + (size_t)u.pm * BM) : (const char*)(QKR + (size_t)u.pm * BM * 2048 + 512 + u.pn * 128); }
};
template <int TYP> struct EpiGlaAtt {
    bf16_t* ATT; bf16_t* UT; const float* DL;
    __device__ __forceinline__ void operator()(const f32x4 (&acc)[2][2][4][2], const Unit& u, int wr, int wc, int fr, int fq) const {
        if (TYP == 0) {
#pragma unroll
            for (int ai = 0; ai < 2; ++ai)
#pragma unroll
                for (int m = 0; m < 4; ++m) { const int rit = ai * HALF + wr * 64 + m * 16 + fr;
#pragma unroll
                    for (int bj = 0; bj < 2; ++bj) { const int c0 = bj * HALF + wc * 32 + 8 * fq;
                        f32x4 v0 = acc[ai][bj][m][0], v1 = acc[ai][bj][m][1];
#pragma unroll
                        for (int j = 0; j < 4; ++j) { if (c0 + j > rit) v0[j] = 0.f; if (c0 + 4 + j > rit) v1[j] = 0.f; }
                        *(u32x4*)(ATT + (size_t)(u.pm * BM + rit) * D + u.pn * 256 + c0) = pack8(v0, v1); }
                }
        } else {
            const int k0 = wc * 32 + 8 * fq;
            const f32x4 d0 = *(const f32x4*)(DL + (size_t)u.pm * 512 + u.pn * 128 + k0), d1 = *(const f32x4*)(DL + (size_t)u.pm * 512 + u.pn * 128 + k0 + 4);
            const int b = u.pm >> 5, cc = u.pm & 31; bf16_t* base = UT + (size_t)((b * 4 + u.pn) * 32 + cc) * 32768;
#pragma unroll
            for (int ai = 0; ai < 2; ++ai)
#pragma unroll
                for (int m = 0; m < 4; ++m) { const int dv = ai * HALF + wr * 64 + m * 16 + fr;
                    *(u32x4*)(base + (size_t)dv * 128 + k0) = pack8(acc[ai][0][m][0] * d0, acc[ai][0][m][1] * d1); }
        }
    }
};
struct GlaOSched {
    const bf16_t* QKR; const bf16_t* KVT; const bf16_t* ATT; const bf16_t* SP;
    __device__ __forceinline__ bool next(int i, Unit& u) const {
        const int c = blockIdx.x, per = gridDim.x >> 3, x = c & 7, j = c >> 3, pl = (i >> 1) * per + j;
        if (pl >= 64) return false;
        u.e = i & 1; u.pm = x * 16 + (pl >> 2); u.pn = pl & 3; return true; }
    __device__ __forceinline__ int lda(const Unit& u) const { return u.e ? D : 2048; }
    __device__ __forceinline__ int ldb(const Unit& u) const { return u.e ? T : 128; }
    __device__ __forceinline__ int nt(const Unit& u) const { return u.e ? 4 : 2; }
    __device__ __forceinline__ bool cont(const Unit& u) const { return u.e == 0; }
    __device__ __forceinline__ const char* a_base(const Unit& u) const { return u.e ? (const char*)ATT : (const char*)QKR; }
    __device__ __forceinline__ int a_row(const Unit& u, int r) const { return u.pm * BM + r; }
    __device__ __forceinline__ int a_col(const Unit& u) const { return u.e ? u.pn * 256 : u.pn * 128; }
    __device__ __forceinline__ const char* b_base(const Unit& u) const { const int b = u.pm >> 5, cc = u.pm & 31;
        return u.e ? (const char*)(KVT + (size_t)(512 + u.pn * 256) * T + (size_t)u.pm * BM) : (const char*)(SP + (size_t)((b * 4 + u.pn) * 32 + cc) * 32768); }
};
struct EpiGlaO {
    bf16_t* GO; const bf16_t* QKR; const float* ng; LAS float* part;
    __device__ __forceinline__ void operator()(const f32x4 (&acc)[2][2][4][2], const Unit& u, int wr, int wc, int fr, int fq) const {
#pragma unroll
        for (int ai = 0; ai < 2; ++ai)
#pragma unroll
            for (int m = 0; m < 4; ++m) { float ss = 0.f;
#pragma unroll
                for (int bj = 0; bj < 2; ++bj)
#pragma unroll
                    for (int n = 0; n < 2; ++n) { const f32x4 x = acc[ai][bj][m][n]; ss += (x[0] * x[0] + x[1] * x[1]) + (x[2] * x[2] + x[3] * x[3]); }
                ss += __shfl_xor(ss, 16); ss += __shfl_xor(ss, 32);
                if (fq == 0) part[(ai * HALF + wr * 64 + m * 16 + fr) * 4 + wc] = ss; }
        asm volatile("s_waitcnt lgkmcnt(0)" ::: "memory"); __builtin_amdgcn_s_barrier(); asm volatile("" ::: "memory");
        f32x4 gv[2][2];
#pragma unroll
        for (int bj = 0; bj < 2; ++bj) { const int c0 = bj * HALF + wc * 32 + 8 * fq; gv[bj][0] = *(const f32x4*)(ng + c0); gv[bj][1] = *(const f32x4*)(ng + c0 + 4); }
#pragma unroll
        for (int ai = 0; ai < 2; ++ai) {
            u32x4 rv[4][2];
#pragma unroll
            for (int m = 0; m < 4; ++m)
#pragma unroll
                for (int bj = 0; bj < 2; ++bj) rv[m][bj] = *(const u32x4*)(QKR + (size_t)(u.pm * BM + ai * HALF + wr * 64 + m * 16 + fr) * 2048 + 1024 + u.pn * 256 + bj * HALF + wc * 32 + 8 * fq);
            __builtin_amdgcn_sched_barrier(0);
#pragma unroll
            for (int m = 0; m < 4; ++m) { const int rit = ai * HALF + wr * 64 + m * 16 + fr, row = u.pm * BM + rit;
                const f32x4 p4 = *(const LAS f32x4*)(part + rit * 4);
                const float rstd = rsqrtf(((p4[0] + p4[1]) + (p4[2] + p4[3])) * (1.0f / GDVH) + EPS);
#pragma unroll
                for (int bj = 0; bj < 2; ++bj) { const int c0 = u.pn * 256 + bj * HALF + wc * 32 + 8 * fq; const u32x4 rw = rv[m][bj];
                    const f32x4 r0 = (f32x4){bf_lo(rw.x), bf_hi(rw.x), bf_lo(rw.y), bf_hi(rw.y)}, r1 = (f32x4){bf_lo(rw.z), bf_hi(rw.z), bf_lo(rw.w), bf_hi(rw.w)};
                    f32x4 y0, y1;
#pragma unroll
                    for (int j = 0; j < 4; ++j) { y0[j] = acc[ai][bj][m][0][j] * rstd * gv[bj][0][j] * (r0[j] * fast_sigmoid(r0[j])); y1[j] = acc[ai][bj][m][1][j] * rstd * gv[bj][1][j] * (r1[j] * fast_sigmoid(r1[j])); }
                    *(u32x4*)(GO + (size_t)row * D + c0) = pack8(y0, y1); }
            }
            __builtin_amdgcn_sched_barrier(0);
        }
    }
};

struct KV2Sched {
    const bf16_t* MEMNB; const bf16_t* WKV;
    __device__ __forceinline__ int lda(const Unit&) const { return D; }
    __device__ __forceinline__ int ldb(const Unit&) const { return D; }
    __device__ __forceinline__ int nt(const Unit&) const { return D / BK; }
    __device__ __forceinline__ bool cont(const Unit&) const { return false; }
    __device__ __forceinline__ bool next(int i, Unit& u) const {
        int bx = (int)blockIdx.x; asm volatile("" : "+s"(bx)); if (i > 0 || bx >= 128) return false; const int un = bx & 31;
        int e = un >> 4; asm volatile("" : "+s"(e)); u.e = e; u.pm = (un & 15) >> 2; u.pn = un & 3; return true; }
    __device__ __forceinline__ const char* a_base(const Unit&) const { return (const char*)MEMNB; }
    __device__ __forceinline__ int a_row(const Unit& u, int r) const { return u.pm * BM + r; }
    __device__ __forceinline__ int a_col(const Unit&) const { return 0; }
    __device__ __forceinline__ const char* b_base(const Unit& u) const { return (const char*)(WKV + (size_t)(u.e * 1024 + u.pn * BM) * D); }
};
struct EpiKV2 {
    bf16_t* KB; bf16_t* VB;
    __device__ __forceinline__ void operator()(const f32x4 (&acc)[2][2][4][2], const Unit& u, int wr, int wc, int fr, int fq) const {
        bf16_t* base = (u.e ? VB : KB) + (size_t)u.pm * BM * D + u.pn * BM;
#pragma unroll
        for (int ai = 0; ai < 2; ++ai)
#pragma unroll
            for (int m = 0; m < 4; ++m) { const int r = ai * HALF + wr * 64 + m * 16 + fr;
#pragma unroll
                for (int bj = 0; bj < 2; ++bj) { const int c0 = bj * HALF + wc * 32 + 8 * fq;
                    *(u32x4*)(base + (size_t)r * D + c0) = pack8(acc[ai][bj][m][0], acc[ai][bj][m][1]); } }
    }
};
struct XPreSched {
    const bf16_t* KB; const bf16_t* VB; const bf16_t* WQN; const bf16_t* WXO;
    __device__ __forceinline__ int lda(const Unit&) const { return D; }
    __device__ __forceinline__ int ldb(const Unit&) const { return D; }
    __device__ __forceinline__ int nt(const Unit&) const { return 4; }
    __device__ __forceinline__ bool cont(const Unit&) const { return false; }
    __device__ __forceinline__ bool next(int i, Unit& u) const {
        int bx = (int)blockIdx.x; asm volatile("" : "+s"(bx)); if (bx >= 128 || i >= 1) return false;
        const int tb = bx & 31; int e = tb >> 4; asm volatile("" : "+s"(e)); u.e = e; u.pm = tb & 15; u.pn = bx >> 5; return true; }
    __device__ __forceinline__ const char* a_base(const Unit& u) const { return u.e ? (const char*)WXO : (const char*)KB; }
    __device__ __forceinline__ int a_row(const Unit& u, int r) const { return (u.e ? u.pn : (u.pm >> 2)) * BM + r; }
    __device__ __forceinline__ int a_col(const Unit& u) const { return (u.pm & 3) * 256; }
    __device__ __forceinline__ const char* b_base(const Unit& u) const {
        return u.e ? (const char*)(VB + (size_t)((u.pm >> 2) * BM) * D + (u.pm & 3) * 256) : (const char*)(WQN + (size_t)(u.pn * BM) * D + (u.pm & 3) * 256); }
};
struct EpiPre {
    bf16_t* MT; bf16_t* VWT;
    __device__ __forceinline__ void operator()(const f32x4 (&acc)[2][2][4][2], const Unit& u, int wr, int wc, int fr, int fq) const {
        const int b = u.pm >> 2, h = u.pm & 3;
        bf16_t* base = u.e ? VWT + ((size_t)b * 1024 + u.pn * BM) * D + h * 256 : MT + ((size_t)b * 1024 + h * 256) * D + u.pn * BM;
#pragma unroll
        for (int ai = 0; ai < 2; ++ai)
#pragma unroll
            for (int m = 0; m < 4; ++m) { const int r = ai * HALF + wr * 64 + m * 16 + fr;
#pragma unroll
                for (int bj = 0; bj < 2; ++bj) { const int c0 = bj * HALF + wc * 32 + 8 * fq;
                    *(u32x4*)(base + (size_t)r * D + c0) = pack8(acc[ai][bj][m][0], acc[ai][bj][m][1]); } }
    }
};
struct BatchBSched {
    const bf16_t* A; const bf16_t* Bm;
    __device__ __forceinline__ int lda(const Unit&) const { return D; }
    __device__ __forceinline__ int ldb(const Unit&) const { return D; }
    __device__ __forceinline__ int nt(const Unit&) const { return D / BK; }
    __device__ __forceinline__ bool cont(const Unit&) const { return false; }
    __device__ __forceinline__ bool next(int i, Unit& u) const {
        const int c = blockIdx.x, per = gridDim.x >> 3, x = c & 7, j = c >> 3, lu = i * per + j;
        if (lu >= 64) return false;
        const int un = x * 64 + lu; u.pm = un >> 2; u.pn = un & 3; u.e = 0; return true; }
    __device__ __forceinline__ const char* a_base(const Unit&) const { return (const char*)A; }
    __device__ __forceinline__ int a_row(const Unit& u, int r) const { return u.pm * BM + r; }
    __device__ __forceinline__ int a_col(const Unit&) const { return 0; }
    __device__ __forceinline__ const char* b_base(const Unit& u) const { return (const char*)(Bm + ((size_t)(u.pm >> 5) * 1024 + u.pn * BM) * D); }
};
struct EpiXS {
    bf16_t* P; const float* ssp; LAS float* part;
    __device__ __forceinline__ void operator()(const f32x4 (&acc)[2][2][4][2], const Unit& u, int wr, int wc, int fr, int fq) const {
        asm volatile("" : "+v"(fr), "+v"(fq));
#pragma unroll
        for (int ai = 0; ai < 2; ++ai)
#pragma unroll
            for (int m = 0; m < 4; ++m) {
                const int rit = ai * HALF + wr * 64 + m * 16 + fr;
                const f32x4 pv = *(const f32x4*)(ssp + (size_t)(u.pm * BM + rit) * 16 + 4 * fq);
                float sm = (pv[0] + pv[1]) + (pv[2] + pv[3]);
                sm += __shfl_xor(sm, 16); sm += __shfl_xor(sm, 32);
                const float k2 = rsqrtf(sm * (1.0f / D) + EPS) * (0.0625f * 1.4426950408889634f);
                float ps = 0.f;
#pragma unroll
                for (int bj = 0; bj < 2; ++bj)
#pragma unroll
                    for (int n = 0; n < 2; ++n)
#pragma unroll
                        for (int j = 0; j < 4; ++j) ps += __builtin_amdgcn_exp2f(acc[ai][bj][m][n][j] * k2);
                ps += __shfl_xor(ps, 16); ps += __shfl_xor(ps, 32);
                if (fq == 0) { part[rit * 4 + wc] = ps; if (wc == 0) part[1024 + rit] = k2; }
            }
        asm volatile("s_waitcnt lgkmcnt(0)" ::: "memory"); __builtin_amdgcn_s_barrier(); asm volatile("" ::: "memory");
#pragma unroll
        for (int ai = 0; ai < 2; ++ai)
#pragma unroll
            for (int m = 0; m < 4; ++m) { const int rit = ai * HALF + wr * 64 + m * 16 + fr, row = u.pm * BM + rit;
                const f32x4 p4 = *(const LAS f32x4*)(part + rit * 4); const float k2 = part[1024 + rit];
                const float inv = 1.0f / ((p4[0] + p4[1]) + (p4[2] + p4[3]));
#pragma unroll
                for (int bj = 0; bj < 2; ++bj) { const int c0 = u.pn * 256 + bj * HALF + wc * 32 + 8 * fq;
                    f32x4 e0, e1;
#pragma unroll
                    for (int j = 0; j < 4; ++j) { e0[j] = __builtin_amdgcn_exp2f(acc[ai][bj][m][0][j] * k2) * inv; e1[j] = __builtin_amdgcn_exp2f(acc[ai][bj][m][1][j] * k2) * inv; }
                    *(u32x4*)(P + (size_t)row * D + c0) = pack8(e0, e1); }
                __builtin_amdgcn_sched_barrier(0);
            }
    }
};
}

struct CvtJob { const float* W; int ldw, col0, K; const float* g; bf16_t* Bt; int il, half, nblk; };
__device__ __forceinline__ void cvt_load(const CvtJob& j, int item, int lane, f32x4 (&v)[8]) {
    const int kb = item / j.nblk, nb = item - kb * j.nblk, k0 = 64 * kb, n0 = 32 * nb;
    const float* p = j.W + (size_t)(k0 + (lane >> 3)) * j.ldw + j.col0 + n0 + 4 * (lane & 7);
#pragma unroll
    for (int i = 0; i < 8; ++i) v[i] = *(const f32x4*)(p + (size_t)(8 * i) * j.ldw);
    if (j.g) {
#pragma unroll
        for (int i = 0; i < 8; ++i) v[i] *= j.g[k0 + 8 * i + (lane >> 3)]; }
}
__device__ __forceinline__ void cvt_store(const CvtJob& j, int item, int lane, LAS float* scr, const f32x4 (&v)[8]) {
    const int kb = item / j.nblk, nb = item - kb * j.nblk, k0 = 64 * kb, n0 = 32 * nb;
#pragma unroll
    for (int i = 0; i < 8; ++i) { LAS float* d = scr + (8 * i + (lane >> 3)) * 33 + 4 * (lane & 7); d[0] = v[i][0]; d[1] = v[i][1]; d[2] = v[i][2]; d[3] = v[i][3]; }
    asm volatile("s_waitcnt lgkmcnt(0)" ::: "memory");
    const int c = lane & 7;
#pragma unroll
    for (int q = 0; q < 4; ++q) { const int n = (lane >> 3) + 8 * q; const LAS float* s = scr + (8 * c) * 33 + n;
        u32x4 o; o.x = cvt_pk_bf16(s[0 * 33], s[1 * 33]); o.y = cvt_pk_bf16(s[2 * 33], s[3 * 33]); o.z = cvt_pk_bf16(s[4 * 33], s[5 * 33]); o.w = cvt_pk_bf16(s[6 * 33], s[7 * 33]);
        const int nn = n0 + n, drow = j.il ? ((nn >> 7) * 256 + j.half * 128 + (nn & 127)) : nn;
        *(u32x4*)(j.Bt + (size_t)drow * j.K + k0 + 8 * c) = o; }
    asm volatile("s_waitcnt lgkmcnt(0)" ::: "memory");
}
__device__ __forceinline__ void cvt_matrix(const float* W, int ldw, int col0, int ncols, int K, const float* g, bf16_t* Bt, int il, int half, LAS unsigned char* lds, int woff = 0, int vb = -1, int nb = 0) {
    const int tix = otid();
    const int lane = tix & 63, wv = tix >> 6;
    LAS float* scr = (LAS float*)(lds + wv * 8704);
    if (vb < 0) { vb = blockIdx.x; nb = gridDim.x; }
    const int ngw = nb * 8; int gw = vb * 8 + wv - (woff % ngw); if (gw < 0) gw += ngw;
    const CvtJob j{W, ldw, col0, K, g, Bt, il, half, ncols / 32};
    const int nitems = (K / 64) * j.nblk;
    f32x4 cur[8], nxt[8];
    int it = gw; if (it < nitems) cvt_load(j, it, lane, cur);
    for (; it < nitems; it += ngw) {
        const int itn = it + ngw; if (itn < nitems) cvt_load(j, itn, lane, nxt);
        cvt_store(j, it, lane, scr, cur);
#pragma unroll
        for (int i = 0; i < 8; ++i) cur[i] = nxt[i];
    }
}
__device__ __forceinline__ void cvt_plain(const float* W, const float* g, bf16_t* out, int rows) {
    const int tix = otid(); const size_t gi = (size_t)blockIdx.x * blockDim.x + tix, gs = (size_t)gridDim.x * blockDim.x;
    for (size_t i = gi; i < (size_t)rows * 256; i += gs) { const f32x4 v = ((const f32x4*)W)[i] * g[i >> 8];
        u32x2 w; w.x = cvt_pk_bf16(v[0], v[1]); w.y = cvt_pk_bf16(v[2], v[3]); ((u32x2*)out)[i] = w; }
}
__device__ __forceinline__ void rows_prep(const float* x, bf16_t* XB, float* rs, float* ssp, int rows) {
    const int tix = otid();
    const int lane = tix & 63;
    const int gw = (blockIdx.x * blockDim.x + tix) >> 6, ngw = (gridDim.x * blockDim.x) >> 6;
    for (int r = gw; r < rows; r += ngw) {
        const f32x4* xr = (const f32x4*)(x + (size_t)r * D);
        f32x4 v[4]; float s = 0.f;
#pragma unroll
        for (int j = 0; j < 4; ++j) { v[j] = xr[lane + 64 * j]; s += (v[j][0] * v[j][0] + v[j][1] * v[j][1]) + (v[j][2] * v[j][2] + v[j][3] * v[j][3]); }
        s = wave_sum(s);
        if (lane == 0) rs[r] = rsqrtf(s * (1.0f / D) + EPS);
        if (ssp && lane < 16) ssp[(size_t)r * 16 + lane] = lane == 0 ? s : 0.f;
        u32x2* o = (u32x2*)(XB + (size_t)r * D);
#pragma unroll
        for (int j = 0; j < 4; ++j) { u32x2 w; w.x = cvt_pk_bf16(v[j][0], v[j][1]); w.y = cvt_pk_bf16(v[j][2], v[j][3]); o[lane + 64 * j] = w; }
    }
}

__device__ __forceinline__ void rows_norm_bf16(const float* x, const float* g, bf16_t* out, int rows) {
    const int tix = otid();
    const int lane = tix & 63;
    const int gw = (blockIdx.x * blockDim.x + tix) >> 6, ngw = (gridDim.x * blockDim.x) >> 6;
    for (int r = gw; r < rows; r += ngw) {
        const f32x4* xr = (const f32x4*)(x + (size_t)r * D);
        f32x4 v[4]; float s = 0.f;
#pragma unroll
        for (int j = 0; j < 4; ++j) { v[j] = xr[lane + 64 * j]; s += (v[j][0] * v[j][0] + v[j][1] * v[j][1]) + (v[j][2] * v[j][2] + v[j][3] * v[j][3]); }
        s = wave_sum(s); const float rs = rsqrtf(s * (1.0f / D) + EPS);
        u32x2* o = (u32x2*)(out + (size_t)r * D);
#pragma unroll
        for (int j = 0; j < 4; ++j) { const f32x4 gg = ((const f32x4*)g)[lane + 64 * j]; u32x2 w; w.x = cvt_pk_bf16(v[j][0] * rs * gg[0], v[j][1] * rs * gg[1]); w.y = cvt_pk_bf16(v[j][2] * rs * gg[2], v[j][3] * rs * gg[3]); o[lane + 64 * j] = w; }
    }
}

__device__ __forceinline__ void route_prep(const float* wg, const float* we, const float* gain, bf16_t* WRB) {
    const int tix = otid(); const int gi = blockIdx.x * blockDim.x + tix, gs = gridDim.x * blockDim.x;
    for (int i = gi; i < 48 * 1024; i += gs) { const int j = i >> 10, k = i & 1023;
        const float w = j < 32 ? we[k * NE + j] * gain[k] : (j < 36 ? wg[k * NG + (j - 32)] * gain[k] : 0.f);
        const unsigned hi = cvt_pk_bf16(w, 0.f) & 0xffffu; const float rem = w - __uint_as_float(hi << 16);
        WRB[i] = (bf16_t)hi; WRB[48 * 1024 + i] = (bf16_t)(cvt_pk_bf16(rem, 0.f) & 0xffffu); }
}
__device__ __forceinline__ float reduce16(float (&v)[18], int lane) {
#pragma unroll
    for (int st = 0; st < 4; ++st) { const int half = 8 >> st, bit = 32 >> st; const bool up = (lane & bit) != 0;
#pragma unroll
        for (int k = 0; k < half; ++k) { const float send = up ? v[k] : v[k + half]; const float keep = up ? v[k + half] : v[k]; v[k] = keep + __shfl_xor(send, bit); } }
    float r = v[0]; r += __shfl_xor(r, 2); r += __shfl_xor(r, 1); return r;
}
__device__ __forceinline__ float reduce2(const float (&v)[18], int lane) {
    const bool up = (lane & 32) != 0; const float send = up ? v[16] : v[17], keep = up ? v[17] : v[16];
    float r = keep + __shfl_xor(send, 32);
#pragma unroll
    for (int o = 16; o >= 1; o >>= 1) r += __shfl_xor(r, o);
    return r;
}
__device__ __forceinline__ void route_phase(const bf16_t* X, const bf16_t* WRB, const float* bg, const float* be, int* etok, int* ea, float* ers, float* egate, int* gcnt, LAS unsigned char* lds) {
    int tid_ = threadIdx.x; asm volatile("" : "+v"(tid_)); const int tid = tid_, lane = tid & 63, wv = tid >> 6, r16 = lane & 15, h4 = lane >> 4;
    constexpr int WSTRH = 1040, WSTR = 2 * WSTRH;
    LAS unsigned char* Wl = lds;
    LAS float* lg = (LAS float*)(lds + 48 * WSTR) + wv * (16 * 52);
    LAS int* lcnt = (LAS int*)(lds + 48 * WSTR + 8 * 16 * 52 * 4); LAS int* lbase = lcnt + 32; LAS int* l_e = lbase + 32; LAS int* l_rank = l_e + 256; LAS float* l_g = (LAS float*)(l_rank + 256); LAS float* l_rs = l_g + 256;
    for (int tbi = blockIdx.x; tbi < T / 128; tbi += gridDim.x) {
        const int tb = gridDim.x == 256 ? ((tbi & 7) * 32 + (tbi >> 3)) : tbi;
        const int t0 = tb * 128 + wv * 16;
        f32x4 acc[3]; float ssq = 0.f;
#pragma unroll
        for (int n = 0; n < 3; ++n) acc[n] = (f32x4){0.f, 0.f, 0.f, 0.f};
#pragma unroll 1
        for (int kh = 0; kh < 2; ++kh) {
            {   u32x4 wst[12];
#pragma unroll
                for (int i = 0; i < 12; ++i) { const int ix = tid + 512 * i; wst[i] = *(const u32x4*)(WRB + (size_t)(ix >> 6) * 1024 + kh * 512 + (ix & 63) * 8); }
                __syncthreads();
#pragma unroll
                for (int i = 0; i < 12; ++i) { const int ix = tid + 512 * i; *(LAS u32x4*)(Wl + (ix >> 6) * WSTRH + (ix & 63) * 16) = wst[i]; }
            }
            if (kh == 0 && tid < 32) lcnt[tid] = 0;
            __syncthreads();
            const bf16_t* xr = X + (size_t)(t0 + r16) * D + kh * 512 + 8 * h4;
#pragma unroll 8
            for (int ks = 0; ks < 16; ++ks) {
                const bf16x8 xb = *(const bf16x8*)(xr + ks * 32);
#pragma unroll
                for (int j = 0; j < 8; ++j) { const float xv = __uint_as_float(((unsigned)(unsigned short)xb[j]) << 16); ssq = fmaf(xv, xv, ssq); }
#pragma unroll
                for (int pl = 0; pl < 2; ++pl)
#pragma unroll
                    for (int n = 0; n < 3; ++n) { const bf16x8 wa = *(const LAS bf16x8*)(Wl + (pl * 48 + n * 16 + r16) * WSTRH + ks * 64 + 16 * h4);
                        acc[n] = __builtin_amdgcn_mfma_f32_16x16x32_bf16(wa, xb, acc[n], 0, 0, 0); }
            }
        }
        ssq += __shfl_xor(ssq, 16); ssq += __shfl_xor(ssq, 32);
#pragma unroll
        for (int n = 0; n < 3; ++n)
#pragma unroll
            for (int q = 0; q < 4; ++q) lg[r16 * 52 + n * 16 + 4 * h4 + q] = acc[n][q];
        if (h4 == 0) lg[r16 * 52 + 48] = rsqrtf(ssq * (1.0f / D) + EPS);
        asm volatile("s_waitcnt lgkmcnt(0)" ::: "memory");
        {
            const int r = lane & 15; const LAS float* L = lg + r * 52;
            const float rs = L[48];
            float gl[4];
#pragma unroll
            for (int g = 0; g < 4; ++g) gl[g] = L[32 + g] * rs + bg[g];
            int gs = 0; float gm = gl[0];
#pragma unroll
            for (int g = 1; g < 4; ++g) if (gl[g] > gm) { gm = gl[g]; gs = g; }
            float se = 0.f;
#pragma unroll
            for (int g = 0; g < 4; ++g) se += expf(gl[g] - gm);
            const float pg = 1.0f / se;
            float el[8];
#pragma unroll
            for (int i = 0; i < 8; ++i) el[i] = L[gs * 8 + i] * rs + be[gs * 8 + i];
            float em = el[0];
#pragma unroll
            for (int i = 1; i < 8; ++i) em = fmaxf(em, el[i]);
            float pe[8], ps = 0.f;
#pragma unroll
            for (int i = 0; i < 8; ++i) { pe[i] = expf(el[i] - em); ps += pe[i]; }
#pragma unroll
            for (int i = 0; i < 8; ++i) pe[i] = pe[i] / ps;
            int i1 = 0; float p1 = pe[0];
#pragma unroll
            for (int i = 1; i < 8; ++i) if (pe[i] > p1) { p1 = pe[i]; i1 = i; }
            int i2 = -1; float p2 = -1.f;
#pragma unroll
            for (int i = 0; i < 8; ++i) if (i != i1 && pe[i] > p2) { p2 = pe[i]; i2 = i; }
            if (lane < 16) {
                if (i2 < 0) i2 = i1 == 0 ? 1 : 0;
                const int tl = wv * 16 + r, t = tb * 128 + tl; const float den = p1 + p2; const int e1 = gs * 8 + i1, e2 = gs * 8 + i2;
                l_rs[tl] = rs; l_g[2 * tl] = pg * p1 / den; l_g[2 * tl + 1] = pg * p2 / den; (void)t;
                l_e[2 * tl] = e1; l_e[2 * tl + 1] = e2;
                l_rank[2 * tl] = atomicAdd((int*)(lcnt + e1), 1); l_rank[2 * tl + 1] = atomicAdd((int*)(lcnt + e2), 1);
            }
        }
        __syncthreads();
        if (tid < 32) lbase[tid] = __hip_atomic_fetch_add(gcnt + tid * GCS, lcnt[tid], __ATOMIC_RELAXED, __HIP_MEMORY_SCOPE_AGENT);
        __syncthreads();
        if (tid < 256) { const int a = tb * 256 + tid, e = l_e[tid]; const size_t ix = (size_t)e * CAPE + lbase[e] + l_rank[tid];
            etok[ix] = a >> 1; ea[ix] = a; ers[ix] = l_rs[tid >> 1]; egate[ix] = l_g[tid]; }
        __syncthreads();
    }
}
__device__ __forceinline__ void build_phase(const int* gcnt, const int* assign_e, const int* assign_pos, const float* gate, const float* RS,
                                            int* ntiles, int* tile_e, int* slot_tok, int* slot_a, float* slot_rs, float* slot_gate, LAS unsigned char* lds) {
    const int tix = otid();
    LAS int* poff = (LAS int*)lds; LAS int* cn = poff + 40;
    if (tix == 0) { int o = 0; for (int e = 0; e < 32; ++e) { const int cc = g8::ld_agent(gcnt + e); cn[e] = cc; poff[e] = o; o += (cc + 255) / 256 * 256; } poff[32] = o; }
    __syncthreads();
    const int gi = blockIdx.x * blockDim.x + tix, gs = gridDim.x * blockDim.x;
    for (int a = gi; a < NA; a += gs) { const int e = assign_e[a]; const int sl = poff[e] + assign_pos[a]; slot_tok[sl] = a >> 1; slot_a[sl] = a; slot_rs[sl] = RS[a >> 1]; slot_gate[sl] = gate[a]; }
    for (int i = gi; i < 32 * 256; i += gs) { const int e = i >> 8, sl = poff[e] + cn[e] + (i & 255); if (sl < poff[e + 1]) { slot_tok[sl] = 0; slot_a[sl] = -1; slot_rs[sl] = 0.f; slot_gate[sl] = 0.f; } }
    if (blockIdx.x == 0) {
        const int NT = poff[32] >> 8;
        for (int rt = tix; rt < NT; rt += blockDim.x) { int e = 0; for (int k = 0; k < 32; ++k) if (rt * 256 >= poff[k] && rt * 256 < poff[k + 1]) e = k; tile_e[rt] = e; }
        if (tix == 0) *ntiles = NT;
    }
    __syncthreads();
}
__device__ __forceinline__ CvtJob moe_job(const float* wgate, const float* wup, const float* wdown, const float* gain, bf16_t* W1, bf16_t* W2, int it, int& item) {
    const int e = it / 768, r = it - e * 768;
    if (r < 256) { item = r; return CvtJob{wgate + (size_t)e * D * DE, DE, 0, D, gain, W1 + (size_t)e * D * D, 1, 0, 16}; }
    if (r < 512) { item = r - 256; return CvtJob{wup + (size_t)e * D * DE, DE, 0, D, gain, W1 + (size_t)e * D * D, 1, 1, 16}; }
    item = r - 512; return CvtJob{wdown + (size_t)e * DE * D, D, 0, DE, nullptr, W2 + (size_t)e * D * DE, 0, 0, 32};
}
__device__ __forceinline__ void cvt_moe(const float* wgate, const float* wup, const float* wdown, const float* gain, bf16_t* W1, bf16_t* W2, LAS unsigned char* lds, int skip_blocks) {
    const int tix = otid();
    const int lane = tix & 63, wv = tix >> 6;
    LAS float* scr = (LAS float*)(lds + 1024 + wv * 8704);
    if ((int)blockIdx.x < skip_blocks) return;
    const int gw = ((int)blockIdx.x - skip_blocks) * 8 + wv, ngw = ((int)gridDim.x - skip_blocks) * 8;
    f32x4 cur[8], nxt[8]; int item = 0, itemn = 0;
    int it = gw; CvtJob j = moe_job(wgate, wup, wdown, gain, W1, W2, it < 32 * 768 ? it : 0, item);
    if (it < 32 * 768) cvt_load(j, item, lane, cur);
    for (; it < 32 * 768; it += ngw) {
        const int itn = it + ngw; CvtJob jn = j;
        if (itn < 32 * 768) { jn = moe_job(wgate, wup, wdown, gain, W1, W2, itn, itemn); cvt_load(jn, itemn, lane, nxt); }
        cvt_store(j, item, lane, scr, cur);
        j = jn; item = itemn;
#pragma unroll
        for (int i = 0; i < 8; ++i) cur[i] = nxt[i];
    }
}
__device__ __forceinline__ void combine_phase(float* X, float* Xo, const bf16_t* Y, bf16_t* XB, float* RS, float* ssp, const float* gfinal, int fin, const float* WA, float* ALR, LAS unsigned char* lds) {
    const int tix = otid();
    const int lane = tix & 63;
    if (WA) { for (int i = tix; i < 16 * 256; i += 512) ((LAS f32x4*)lds)[i] = ((const f32x4*)WA)[i]; __syncthreads(); }
    const int gw = (blockIdx.x * blockDim.x + tix) >> 6, ngw = (gridDim.x * blockDim.x) >> 6;
    constexpr int NR = 4;
    for (int tb = gw; tb < T; tb += NR * ngw) {
        f32x4 v[NR][4]; u32x2 ya[NR][4], yb[NR][4];
#pragma unroll
        for (int rr = 0; rr < NR; ++rr) { const int t = tb + rr * ngw;
#pragma unroll
            for (int j = 0; j < 4; ++j) { const u32x2 xw = ((const u32x2*)(XB + (size_t)t * D))[lane + 64 * j]; v[rr][j] = (f32x4){bf_lo(xw.x), bf_hi(xw.x), bf_lo(xw.y), bf_hi(xw.y)};
                ya[rr][j] = ((const u32x2*)(Y + (size_t)(2 * t) * D))[lane + 64 * j]; yb[rr][j] = ((const u32x2*)(Y + (size_t)(2 * t + 1) * D))[lane + 64 * j]; } }
        __builtin_amdgcn_sched_barrier(0);
        float rsv[NR];
#pragma unroll
        for (int rr = 0; rr < NR; ++rr) { const int t = tb + rr * ngw; float s = 0.f;
#pragma unroll
            for (int j = 0; j < 4; ++j) {
                v[rr][j][0] += bf_lo(ya[rr][j].x) + bf_lo(yb[rr][j].x); v[rr][j][1] += bf_hi(ya[rr][j].x) + bf_hi(yb[rr][j].x);
                v[rr][j][2] += bf_lo(ya[rr][j].y) + bf_lo(yb[rr][j].y); v[rr][j][3] += bf_hi(ya[rr][j].y) + bf_hi(yb[rr][j].y);
                if (!fin) { const unsigned w0 = cvt_pk_bf16(v[rr][j][0], v[rr][j][1]), w1 = cvt_pk_bf16(v[rr][j][2], v[rr][j][3]); v[rr][j] = (f32x4){bf_lo(w0), bf_hi(w0), bf_lo(w1), bf_hi(w1)}; }
                s += (v[rr][j][0] * v[rr][j][0] + v[rr][j][1] * v[rr][j][1]) + (v[rr][j][2] * v[rr][j][2] + v[rr][j][3] * v[rr][j][3]); }
            s = wave_sum(s); const float rs = rsqrtf(s * (1.0f / D) + EPS); rsv[rr] = rs;
            if (fin) {
#pragma unroll
                for (int j = 0; j < 4; ++j) { const f32x4 gg = ((const f32x4*)gfinal)[lane + 64 * j]; ((f32x4*)(Xo + (size_t)t * D))[lane + 64 * j] = v[rr][j] * rs * gg; }
            } else {
                if (lane == 0) RS[t] = rs;
                if (lane < 16) ssp[(size_t)t * 16 + lane] = lane == 0 ? s : 0.f;
#pragma unroll
                for (int j = 0; j < 4; ++j) { u32x2 w; w.x = cvt_pk_bf16(v[rr][j][0], v[rr][j][1]); w.y = cvt_pk_bf16(v[rr][j][2], v[rr][j][3]); ((u32x2*)(XB + (size_t)t * D))[lane + 64 * j] = w; }
            }
        }
        if (!fin && WA) {
            float a[NR][16];
#pragma unroll
            for (int o = 0; o < 16; ++o) { float p[NR];
#pragma unroll
                for (int rr = 0; rr < NR; ++rr) p[rr] = 0.f;
#pragma unroll
                for (int j = 0; j < 4; ++j) { const f32x4 w4 = *(const LAS f32x4*)(lds + (o * 1024 + 256 * j + 4 * lane) * 4);
#pragma unroll
                    for (int rr = 0; rr < NR; ++rr) p[rr] = fmaf(v[rr][j][3], w4[3], fmaf(v[rr][j][2], w4[2], fmaf(v[rr][j][1], w4[1], fmaf(v[rr][j][0], w4[0], p[rr])))); }
#pragma unroll
                for (int rr = 0; rr < NR; ++rr) a[rr][o] = p[rr];
                if ((o & 3) == 3) __builtin_amdgcn_sched_barrier(0); }
            { const bool up = (lane & 32) != 0;
#pragma unroll
              for (int rr = 0; rr < 2; ++rr)
#pragma unroll
                for (int k = 0; k < 16; ++k) { const float send = up ? a[rr][k] : a[rr + 2][k], keep = up ? a[rr + 2][k] : a[rr][k]; a[rr][k] = keep + __shfl_xor(send, 32); } }
            { const bool up = (lane & 16) != 0;
#pragma unroll
              for (int k = 0; k < 16; ++k) { const float send = up ? a[0][k] : a[1][k], keep = up ? a[1][k] : a[0][k]; a[0][k] = keep + __shfl_xor(send, 16); } }
#pragma unroll
            for (int st = 0; st < 4; ++st) { const int half = 8 >> st, bit = 8 >> st; const bool up = (lane & bit) != 0;
#pragma unroll
                for (int k = 0; k < half; ++k) { const float send = up ? a[0][k] : a[0][k + half], keep = up ? a[0][k + half] : a[0][k]; a[0][k] = keep + __shfl_xor(send, bit); } }
            const int row = lane >> 4;
            const float rsl = row == 0 ? rsv[0] : row == 1 ? rsv[1] : row == 2 ? rsv[2] : rsv[3];
            ALR[(size_t)(tb + row * ngw) * 16 + (lane & 15)] = a[0][0] * rsl;
        }
    }
}

__device__ __forceinline__ float fexp2(float x) { return __builtin_amdgcn_exp2f(x * 1.4426950408889634f); }
__device__ __forceinline__ void gla_prep(const float* win, const float* wo, const float* gain, bf16_t* WGTM, bf16_t* WGFM, bf16_t* WGO, float* WA, LAS unsigned char* lds, int vb, int nb) {
    cvt_matrix(win, GLA_COLS, 0, 512, D, gain, WGTM, 0, 0, lds, 0, vb, nb);
    cvt_matrix(win, GLA_COLS, 512, 512, D, gain, WGTM + (size_t)512 * D, 0, 0, lds, 256, vb, nb);
    cvt_matrix(win, GLA_COLS, 2064, 1024, D, gain, WGTM + (size_t)1024 * D, 0, 0, lds, 512, vb, nb);
    cvt_matrix(win, GLA_COLS, 512, 512, D, gain, WGFM, 0, 0, lds, 1024, vb, nb);
    cvt_matrix(win, GLA_COLS, 1024, 1024, D, gain, WGFM + (size_t)512 * D, 0, 0, lds, 1280, vb, nb);
    cvt_matrix(wo, D, 0, D, D, nullptr, WGO, 0, 0, lds, 1792, vb, nb);
    const int tix = otid(); const int gi = vb * blockDim.x + tix, gs = nb * blockDim.x;
    for (int i = gi; i < 16 * 1024; i += gs) { const int j = i >> 10, k = i & 1023; WA[i] = win[(size_t)k * GLA_COLS + 2048 + j] * gain[k]; }
}
__device__ __forceinline__ void gla_decay(const float* ALR, const float* wa2, const float* ba, float* BTM, float* BFM, float* DL, LAS unsigned char* lds) {
    const int tix = otid();
    LAS float* tile = (LAS float*)lds;
    LAS float* seg = tile + 256 * 65;
    for (int itx = blockIdx.x; itx < 128 * 8; itx += gridDim.x) {
        const int item = gridDim.x == 256 ? ((itx & 7) * 128 + ((itx >> 3) & 31) + 32 * (itx >> 8)) : itx;
        const int ch = item >> 3, kf0 = (item & 7) * 64, t0 = ch * 256;
        {
            const int lane = tix & 63, wv = tix >> 6, r16 = lane & 15, k4 = lane >> 4;
            float bw[4][4];
#pragma unroll
            for (int cb = 0; cb < 4; ++cb)
#pragma unroll
                for (int kk = 0; kk < 4; ++kk) bw[cb][kk] = wa2[(4 * kk + k4) * GDK + kf0 + cb * 16 + r16];
            float bias4[4];
#pragma unroll
            for (int cb = 0; cb < 4; ++cb) bias4[cb] = ba[kf0 + cb * 16 + r16];
#pragma unroll
            for (int rb = 0; rb < 2; ++rb) {
                float av[4];
#pragma unroll
                for (int kk = 0; kk < 4; ++kk) av[kk] = ALR[(size_t)(t0 + wv * 32 + rb * 16 + r16) * 16 + 4 * kk + k4];
#pragma unroll
                for (int cb = 0; cb < 4; ++cb) {
                    f32x4 zz = (f32x4){bias4[cb], bias4[cb], bias4[cb], bias4[cb]};
#pragma unroll
                    for (int kk = 0; kk < 4; ++kk) zz = __builtin_amdgcn_mfma_f32_16x16x4f32(av[kk], bw[cb][kk], zz, 0, 0, 0);
#pragma unroll
                    for (int i = 0; i < 4; ++i) { const float z = zz[i];
                        const float e = __builtin_amdgcn_exp2f(-1.4426950408889634f * fabsf(z));
                        const float ls = fminf(z, 0.f) - 0.6931471805599453f * __builtin_amdgcn_logf(1.0f + e);
                        tile[(wv * 32 + rb * 16 + 4 * k4 + i) * 65 + cb * 16 + r16] = ls * (1.0f / 16.0f); }
                }
            }
        }
        __syncthreads();
        {
            const int kf = tix & 63, sg = tix >> 6;
            float pv[32];
#pragma unroll
            for (int i = 0; i < 32; ++i) pv[i] = tile[(sg * 32 + i) * 65 + kf];
#pragma unroll
            for (int i = 1; i < 32; ++i) pv[i] += pv[i - 1];
            seg[sg * 64 + kf] = pv[31];
            __syncthreads();
            float off = 0.f;
            for (int q = 0; q < sg; ++q) off += seg[q * 64 + kf];
#pragma unroll
            for (int i = 0; i < 32; ++i) tile[(sg * 32 + i) * 65 + kf] = pv[i] + off;
            if (sg == 7) DL[(size_t)ch * 512 + kf0 + kf] = __builtin_amdgcn_exp2f(1.4426950408889634f * (pv[31] + off));
        }
        __syncthreads();
        bf16_t* EQ = (bf16_t*)BTM; bf16_t* EK = EQ + (size_t)T * 512;
#pragma unroll
        for (int j = 0; j < 4; ++j) { const int t = (tix >> 3) + 64 * j, c = (tix & 7) * 8; const LAS float* p = tile + t * 65 + c;
            f32x4 e0, e1, n0, n1;
#pragma unroll
            for (int q = 0; q < 4; ++q) { e0[q] = fexp2(p[q]); e1[q] = fexp2(p[4 + q]); n0[q] = fexp2(-p[q]); n1[q] = fexp2(-p[4 + q]); }
            *(u32x4*)(EQ + (size_t)(t0 + t) * 512 + kf0 + c) = pack8(e0, e1); *(u32x4*)(EK + (size_t)(t0 + t) * 512 + kf0 + c) = pack8(n0, n1); }
        __syncthreads();
    }
}
__device__ __forceinline__ void gla_scan(const bf16_t* UT, const float* DL, bf16_t* SP) {
    const int tix = otid(); const int gi = blockIdx.x * blockDim.x + tix, gs = gridDim.x * blockDim.x;
    for (int it = gi; it < 16 * 32768 / 2; it += gs) {
        const int bh = it >> 14, idx = (it & 16383) * 2, k = idx & 127, b = bh >> 2, h = bh & 3;
        float s0 = 0.f, s1 = 0.f;
#pragma unroll 1
        for (int c0 = 0; c0 < 32; c0 += 16) {
            unsigned uu[16]; f32x2 d[16];
#pragma unroll
            for (int q = 0; q < 16; ++q) { const int c = c0 + q;
                uu[q] = *(const unsigned*)(UT + (size_t)(bh * 32 + c) * 32768 + idx);
                d[q] = *(const f32x2*)(DL + (size_t)(b * 32 + c) * 512 + h * 128 + k); }
#pragma unroll
            for (int q = 0; q < 16; ++q) { const int c = c0 + q;
                *(unsigned*)(SP + (size_t)(bh * 32 + c) * 32768 + idx) = cvt_pk_bf16(s0, s1);
                s0 = fmaf(d[q][0], s0, bf_lo(uu[q])); s1 = fmaf(d[q][1], s1, bf_hi(uu[q])); }
        }
    }
}
__device__ __forceinline__ void gla_fin(const bf16_t* O, const bf16_t* QKR, const float* ng, bf16_t* GO) {
    const int tix = otid(); const int lane = tix & 63;
    const int gw = (blockIdx.x * blockDim.x + tix) >> 6, ngw = (gridDim.x * blockDim.x) >> 6;
    const f32x4 gg = ((const f32x4*)ng)[lane];
    for (int t = gw; t < T; t += ngw) {
#pragma unroll
        for (int j = 0; j < 4; ++j) {
            const u32x2 ow = ((const u32x2*)(O + (size_t)t * D))[lane + 64 * j], rw = ((const u32x2*)(QKR + (size_t)t * 2048 + 1024))[lane + 64 * j];
            const f32x4 o = (f32x4){bf_lo(ow.x), bf_hi(ow.x), bf_lo(ow.y), bf_hi(ow.y)}, r = (f32x4){bf_lo(rw.x), bf_hi(rw.x), bf_lo(rw.y), bf_hi(rw.y)};
            const float ss = wave_sum((o[0] * o[0] + o[1] * o[1]) + (o[2] * o[2] + o[3] * o[3]));
            const float rs = rsqrtf(ss * (1.0f / GDVH) + EPS);
            f32x4 y;
#pragma unroll
            for (int q = 0; q < 4; ++q) y[q] = o[q] * rs * gg[q] * (r[q] * fast_sigmoid(r[q]));
            u32x2 w; w.x = cvt_pk_bf16(y[0], y[1]); w.y = cvt_pk_bf16(y[2], y[3]);
            ((u32x2*)(GO + (size_t)t * D))[lane + 64 * j] = w;
        }
    }
}

template <int CTRL> __device__ __forceinline__ float dpp_mov(float x) { return __int_as_float(__builtin_amdgcn_update_dpp(0, __float_as_int(x), CTRL, 0xF, 0xF, true)); }
__device__ __forceinline__ float xpair32(float lo, float hi) {
    const auto r = __builtin_amdgcn_permlane32_swap(__float_as_uint(lo), __float_as_uint(hi), false, false); return __uint_as_float(r[0]) + __uint_as_float(r[1]); }
__device__ __forceinline__ float xreduce32(float (&v)[32], int lane) {
#pragma unroll
    for (int k = 0; k < 16; ++k) { const auto r = __builtin_amdgcn_permlane16_swap(__float_as_uint(v[k]), __float_as_uint(v[k + 16]), false, false); v[k] = __uint_as_float(r[0]) + __uint_as_float(r[1]); }
    { const bool up = (lane & 8) != 0;
#pragma unroll
      for (int k = 0; k < 8; ++k) { const float send = up ? v[k] : v[k + 8], keep = up ? v[k + 8] : v[k]; v[k] = keep + dpp_mov<0x128>(send); } }
    { const bool up = (lane & 4) != 0;
#pragma unroll
      for (int k = 0; k < 4; ++k) { const float send = up ? v[k] : v[k + 4], keep = up ? v[k + 4] : v[k]; v[k] = keep + dpp_mov<0x141>(send); } }
    { const bool up = (lane & 2) != 0;
#pragma unroll
      for (int k = 0; k < 2; ++k) { const float send = up ? v[k] : v[k + 2], keep = up ? v[k + 2] : v[k]; v[k] = keep + dpp_mov<0x4E>(send); } }
    { const bool up = (lane & 1) != 0; const float send = up ? v[0] : v[1], keep = up ? v[1] : v[0]; v[0] = keep + dpp_mov<0xB1>(send); }
    return v[0];
}
__device__ __forceinline__ void conv_phase(const bf16_t* U, const float* wdw, const float* bdw, const float* lng, const float* lnb, bf16_t* CV, LAS unsigned char* lds) {
    int tid_ = threadIdx.x; asm volatile("" : "+v"(tid_));
    const int tid = tid_, lane = tid & 63, wv = __builtin_amdgcn_readfirstlane(tid >> 6), c0 = 2 * tid;
    LAS unsigned char* buf = lds;
    LAS float* red = (LAS float*)(lds + 62 * 2048); LAS float* tot = red + 512;
    f32x2 w[CONVK];
#pragma unroll
    for (int j = 0; j < CONVK; ++j) w[j] = *(const f32x2*)(wdw + j * D + c0);
    const f32x2 bd = *(const f32x2*)(bdw + c0), lg = *(const f32x2*)(lng + c0), lb = *(const f32x2*)(lnb + c0);
#define CONV_STAGE(item_) do { const int _t0 = (item_) * 32, _s0 = _t0 & (S - 1); \
        for (int q = wv; q < 124; q += 8) { const int row = q >> 1, half = q & 1; \
            if (_s0 - 30 + row >= 0) __builtin_amdgcn_global_load_lds((const unsigned*)((const char*)U + ((size_t)(_t0 - 30 + row) * D) * 2 + half * 1024 + lane * 16), (LAS unsigned*)(buf + row * 2048 + half * 1024), 16, 0, 0); \
            else *(LAS u32x4*)(buf + row * 2048 + half * 1024 + lane * 16) = (u32x4){0u, 0u, 0u, 0u}; } } while (0)
    const bool g256 = gridDim.x == 256;
    const int istep = g256 ? 32 : (int)gridDim.x, iend = g256 ? ((int)blockIdx.x & 7) * 128 + 128 : T / 32;
    int item = g256 ? ((int)blockIdx.x & 7) * 128 + ((int)blockIdx.x >> 3) : (int)blockIdx.x;
    if (item < iend) CONV_STAGE(item);
    for (; item < iend; item += istep) {
        const int t0 = item * 32;
        asm volatile("s_waitcnt vmcnt(0) lgkmcnt(0)" ::: "memory");
        __syncthreads();
        unsigned raw[62];
#pragma unroll
        for (int r = 0; r < 62; ++r) raw[r] = *(const LAS unsigned*)(buf + r * 2048 + c0 * 2);
        asm volatile("s_waitcnt lgkmcnt(0)" ::: "memory");
        __syncthreads();
        if (item + istep < iend) CONV_STAGE(item + istep);
        f32x2 acc[32];
#pragma unroll
        for (int o = 0; o < 32; ++o) acc[o] = bd;
#pragma unroll
        for (int r = 0; r < 62; ++r) {
            const f32x2 uv = (f32x2){bf_lo(raw[r]), bf_hi(raw[r])};
#pragma unroll
            for (int o = (r > 30 ? r - 30 : 0); o <= (r < 31 ? r : 31); ++o) acc[o] = __builtin_elementwise_fma(uv, w[r - o], acc[o]);
        }
        float v[32];
#pragma unroll
        for (int o = 0; o < 32; ++o) v[o] = xpair32(acc[o][0] + acc[o][1], acc[o][0] * acc[o][0] + acc[o][1] * acc[o][1]);
        xreduce32(v, lane);
        red[wv * 64 + lane] = v[0];
        __syncthreads();
        if (tid < 64) { float s = 0.f;
#pragma unroll
            for (int q = 0; q < 8; ++q) s += red[q * 64 + tid];
            tot[tid] = s; }
        __syncthreads();
#pragma unroll
        for (int o = 0; o < 32; ++o) {
            const float mu = tot[o] * (1.0f / D), var = tot[32 + o] * (1.0f / D) - mu * mu, rstd = rsqrtf(var + EPS);
            const float y0 = (acc[o][0] - mu) * rstd * lg[0] + lb[0], y1 = (acc[o][1] - mu) * rstd * lg[1] + lb[1];
            *(unsigned*)(CV + (size_t)(t0 + o) * D + c0) = cvt_pk_bf16(y0 * fast_sigmoid(y0), y1 * fast_sigmoid(y1));
        }
    }
    asm volatile("s_waitcnt vmcnt(0) lgkmcnt(0)" ::: "memory");
    __syncthreads();
#undef CONV_STAGE
}

enum Ph { PH_PREP_ALL = 0, PH_CONV_IN, PH_CONV_MID, PH_CONV_OUT, PH_XA_KV, PH_XA_QSP, PH_XA_O, PH_XA_XS, PH_XA_PVO, PH_ROUTE, PH_BUILD, PH_MOE1, PH_MOE2, PH_COMBINE, PH_COMBINE_FIN, PH_GLA_DECAY, PH_GLA_IN, PH_GLA_ATT, PH_GLA_SCAN, PH_GLA_O, PH_GLA_FIN, PH_GLA_OUT, PH_N };

__device__ __forceinline__ void run_phase(const Ctx& c, int ph, int l, LAS unsigned char* lds) {
    unsigned char* ws = c.ws;
    bf16_t* XB = (bf16_t*)(ws + OW_XB); float* RS = (float*)(ws + OW_RS); float* SSP = (float*)(ws + OW_SSP);
    bf16_t* ACTA = (bf16_t*)(ws + OW_ACTA); bf16_t* ACTB = (bf16_t*)(ws + OW_ACTB);
    bf16_t* WCIN = (bf16_t*)(ws + OW_WCIN); bf16_t* WCOUT = (bf16_t*)(ws + OW_WCOUT);
    bf16_t* ACTC = (bf16_t*)(ws + OW_ACTC); float* PSUM = (float*)(ws + OW_PSUM);
    bf16_t* WXQ = (bf16_t*)(ws + OW_WXQ) + (size_t)l * D * D; bf16_t* WXKV = (bf16_t*)(ws + OW_WXKV) + (size_t)l * 2048 * D; bf16_t* WXO = (bf16_t*)(ws + OW_WXO) + (size_t)l * D * D;
    bf16_t* WR = (bf16_t*)(ws + OW_WR) + (size_t)l * 2 * 48 * 1024;
    int* GCNT = (int*)(ws + OM_AE) + l * 32 * GCS; int* NTP = (int*)(ws + OM_NT); int* TILEE = (int*)(ws + OM_TILEE); int* AE = (int*)(ws + OM_AE); int* APOS = (int*)(ws + OM_APOS); float* GATE = (float*)(ws + OM_GATE);
    int* ETOK = (int*)(ws + OW_ETAB); int* EA = ETOK + (size_t)32 * CAPE; float* ERS = (float*)(EA + (size_t)32 * CAPE); float* EGATE = ERS + (size_t)32 * CAPE;
    int* STOK = (int*)(ws + OM_STOK); int* SA = (int*)(ws + OM_SA); float* SRS = (float*)(ws + OM_SRS); float* SGATE = (float*)(ws + OM_SGATE);
    bf16_t* HB = (bf16_t*)(ws + OW_H); bf16_t* YB = (bf16_t*)(ws + OW_Y); bf16_t* W1 = (bf16_t*)(ws + OW_WMOE); bf16_t* W2 = W1 + (size_t)NE * D * D;
    bf16_t* ATTB = (bf16_t*)(ws + OW_ATT); bf16_t* QKR = (bf16_t*)(ws + OW_QKR); bf16_t* KVT = (bf16_t*)(ws + OW_KVT); float* BTM = (float*)(ws + OW_BTM); float* BFM = (float*)(ws + OW_BFM);
    bf16_t* OB = (bf16_t*)(ws + OW_O); bf16_t* UTB = (bf16_t*)(ws + OW_UT); bf16_t* SPB = (bf16_t*)(ws + OW_SP); float* ALR = (float*)(ws + OW_ALR); float* DLF = (float*)(ws + OW_DL); bf16_t* GOB = (bf16_t*)(ws + OW_GO);
    bf16_t* WGTM = (bf16_t*)(ws + OW_WGTM); bf16_t* WGFM = (bf16_t*)(ws + OW_WGFM); bf16_t* WGO = (bf16_t*)(ws + OW_WGO); float* WAF = (float*)(ws + OW_WA);
    bf16_t* KB = (bf16_t*)(ws + OW_KVB); bf16_t* VT = KB + (size_t)1024 * 1024; bf16_t* VB = VT; bf16_t* MTB = KB + (size_t)2 * 1024 * 1024; bf16_t* VWTB = MTB + (size_t)4 * 1024 * 1024; bf16_t* MEMNB = (bf16_t*)(ws + OW_MEMNB);
    switch (ph) {
    case PH_PREP_ALL: {
        cvt_matrix(c.in[7], 2048, 0, 1024, D, c.in[2], WCIN, 1, 0, lds);
        cvt_matrix(c.in[7], 2048, 1024, 1024, D, c.in[2], WCIN, 1, 1, lds, 512);
        cvt_matrix(c.in[13], D, 0, D, D, nullptr, WCOUT, 0, 0, lds, 1024);
        for (int ll = 0; ll < 2; ++ll) {
            cvt_plain(c.in[20] + (size_t)ll * D * D, c.in[3] + ll * D, (bf16_t*)(ws + OW_WXQ) + (size_t)ll * D * D, D);
            cvt_matrix(c.in[21] + (size_t)ll * D * 2048, 2048, 0, 2048, D, nullptr, (bf16_t*)(ws + OW_WXKV) + (size_t)ll * 2048 * D, 0, 0, lds, 0 + 1024 * ll);
            cvt_matrix(c.in[22] + (size_t)ll * D * D, D, 0, D, D, nullptr, (bf16_t*)(ws + OW_WXO) + (size_t)ll * D * D, 0, 0, lds, 1024 + 512 * ll);
            route_prep(c.in[23] + (size_t)ll * D * NG, c.in[25] + (size_t)ll * D * NE, c.in[4] + ll * D, (bf16_t*)(ws + OW_WR) + (size_t)ll * 2 * 48 * 1024);
        }
        rows_norm_bf16(c.in[1], c.in[5], MEMNB, NB * NMEM);
        rows_prep(c.in[0], XB, RS, nullptr, T);
        { const int tix = otid(); if (blockIdx.x == 0) { if (tix < 64) ((int*)(ws + OM_AE))[tix * GCS] = 0; for (int i = tix; i < 640; i += 512) ((int*)(ws + OM_TILEE))[i] = 0; } }
        } break;
    case PH_CONV_IN: { g8::DenseSched S{8, 128 * 8, D, D, D, XB, WCIN}; g8::gemm_phase(lds, S, g8::EpiGlu{ACTA, RS, c.in[8]}); } break;
    case PH_CONV_MID: conv_phase(ACTA, c.in[9], c.in[10], c.in[11], c.in[12], ACTB, lds); break;
    case PH_CONV_OUT: { g8::DenseSched S{4, 128 * 4, D, D, D, ACTB, WCOUT}; g8::gemm_phase(lds, S, g8::EpiXres{XB, c.in[14], SSP}); } break;
    case PH_XA_KV: {
        { g8::KV2Sched S{MEMNB, WXKV}; g8::gemm_phase(lds, S, g8::EpiKV2{KB, VB}); }
        asm volatile("s_waitcnt vmcnt(0)" ::: "memory"); __syncthreads();
        if (otid() < 64) { __builtin_amdgcn_fence(__ATOMIC_ACQUIRE, "agent"); asm volatile("s_waitcnt vmcnt(0)" ::: "memory"); } __syncthreads();
        { g8::XPreSched S{KB, VB, WXQ, WXO}; g8::gemm_phase(lds, S, g8::EpiPre{MTB, VWTB}); }
        cvt_moe(c.in[27] + (size_t)l * NE * D * DE, c.in[28] + (size_t)l * NE * D * DE, c.in[29] + (size_t)l * NE * DE * D, c.in[4] + l * D, W1, W2, lds, 128);
        } break;
    case PH_XA_XS: { g8::BatchBSched S{XB, MTB}; g8::gemm_phase(lds, S, g8::EpiXS{ACTB, SSP, (LAS float*)(lds + g8::STAGE_BYTES)}); } break;
    case PH_XA_PVO: { g8::BatchBSched S{ACTB, VWTB}; g8::gemm_phase(lds, S, g8::EpiXres{XB, nullptr, nullptr}); } break;
    case PH_XA_QSP: {
        { g8::DenseSched S{4, 128 * 4, D, D, D, XB, WXQ}; g8::gemm_phase(lds, S, g8::EpiRowScale{ACTA, D, SSP, nullptr, 0.0625f, 0, 1.0f}); }
        asm volatile("s_waitcnt vmcnt(0)" ::: "memory"); __syncthreads();
        if (otid() < 64) { __builtin_amdgcn_fence(__ATOMIC_ACQUIRE, "agent"); asm volatile("s_waitcnt vmcnt(0)" ::: "memory"); } __syncthreads();
        { g8::AttnSched S{256, D, D, ACTA, KB, 0}; g8::gemm_phase(lds, S, g8::EpiS{ACTB, PSUM}); }
        asm volatile("s_waitcnt vmcnt(0)" ::: "memory"); __syncthreads();
        if (otid() < 64) { __builtin_amdgcn_fence(__ATOMIC_ACQUIRE, "agent"); asm volatile("s_waitcnt vmcnt(0)" ::: "memory"); } __syncthreads();
        { g8::AttnSched S{256, D, 256, ACTB, VT, 1}; g8::gemm_phase(lds, S, g8::EpiPV{ACTC, PSUM}); }
        } break;
    case PH_XA_O: { g8::DenseSched S{4, 128 * 4, D, D, D, ACTC, WXO}; g8::gemm_phase(lds, S, g8::EpiXres{XB, nullptr, nullptr}); } break;
    case PH_ROUTE: route_phase(XB, WR, c.in[24] + l * NG, c.in[26] + l * NE, ETOK, EA, ERS, EGATE, GCNT, lds); break;
    case PH_BUILD: build_phase(GCNT, AE, APOS, GATE, RS, NTP, TILEE, STOK, SA, SRS, SGATE, lds); break;
    case PH_MOE1: { LAS int* mt = (LAS int*)(lds + g8::STAGE_BYTES + 8192); const int NT0 = g8::moe_tiles(GCNT, mt); int* FLG = (int*)(ws + OM_TILEE) + l * 320;
        if (((volatile LAS unsigned*)(lds + LDS_BYTES - 16))[2] != 1u) {
            { g8::MoeSched S{D, D, D, XB, W1, (size_t)D * D, mt, ETOK, NT0}; g8::gemm_phase(lds, S, g8::EpiMoe1{HB, ERS, mt}); }
        } else {
            { g8::MoeSched S{D, D, D, XB, W1, (size_t)D * D, mt, ETOK, NT0}; g8::gemm_phase(lds, S, g8::EpiMoe1P{HB, ERS, mt, FLG, ((int)blockIdx.x & 7) * ((NT0 + 7) >> 3)}); }
            asm volatile("s_waitcnt vmcnt(0)" ::: "memory");
            { const int NT = __builtin_amdgcn_readfirstlane(mt[32]); g8::MoeSched S{D, D, D, XB, W1, (size_t)D * D, mt, ETOK, NT}; g8::Unit lu; int last = -1;
#pragma unroll 1
              for (int i = 0; i < 6; ++i) if (S.next(i, lu)) last = lu.pm;
              if (last >= 0 && (otid() & 63) == 0) (void)__hip_atomic_fetch_add(FLG + last, 1, __ATOMIC_RELAXED, __HIP_MEMORY_SCOPE_AGENT); }
            __syncthreads();
            { const int NT = __builtin_amdgcn_readfirstlane(mt[32]); g8::Moe2Sched S2{HB, W2, mt, NT, FLG};
              { const int tix = otid(); if (tix < 8) { const int rt = S2.unit_rt(tix); mt[400 + tix] = (rt < 0 || g8::ld_agent(FLG + rt) >= 32) ? 1 : 0; } }
              if (otid() < 64) { __builtin_amdgcn_fence(__ATOMIC_ACQUIRE, "agent"); asm volatile("s_waitcnt vmcnt(0)" ::: "memory"); } __syncthreads();
              g8::gemm_phase(lds, S2, g8::EpiMoe2{YB, EA, EGATE, mt}); }
        }
        if (l == 0) {
            const bool mg = ((volatile LAS unsigned*)(lds + LDS_BYTES - 16))[2] == 1u;
            const int rr = 4 * ((__builtin_amdgcn_readfirstlane(mt[32]) + 7) >> 3) - 128, jj = (int)blockIdx.x >> 3;
            bool run; int vb, nb;
            if (!mg) { run = jj >= 16; vb = (int)blockIdx.x - 128; nb = (int)gridDim.x - 128; }
            else if (rr >= 4) { run = jj < rr; vb = jj * 8 + ((int)blockIdx.x & 7); nb = rr * 8; }
            else { run = true; vb = (int)blockIdx.x; nb = (int)gridDim.x; }
            if (run) { __syncthreads(); gla_prep(c.in[15], c.in[19], c.in[2] + D, WGTM, WGFM, WGO, WAF, lds, vb, nb); } }
        } break;
    case PH_MOE2: { if (((volatile LAS unsigned*)(lds + LDS_BYTES - 16))[2] == 1u) break;
        LAS int* mt = (LAS int*)(lds + g8::STAGE_BYTES + 8192); const int NT = __builtin_amdgcn_readfirstlane(mt[32]);
        g8::MoeSched S{DE, DE, DE, HB, W2, (size_t)D * DE, mt, nullptr, NT}; g8::gemm_phase(lds, S, g8::EpiMoe2{YB, EA, EGATE, mt}); } break;
    case PH_COMBINE: combine_phase(c.out, c.out, YB, XB, RS, SSP, nullptr, 0, WAF, ALR, lds); break;
    case PH_COMBINE_FIN: combine_phase(c.out, c.out, YB, XB, RS, SSP, c.in[6], 1, nullptr, nullptr, lds); break;
    case PH_GLA_DECAY: gla_decay(ALR, c.in[16], c.in[17], BTM, BFM, DLF, lds); break;
    case PH_GLA_IN: { g8::GlaInSched S{XB, WGTM, WGFM}; g8::gemm_phase(lds, S, g8::EpiGlaIn{QKR, KVT, RS, (const bf16_t*)BTM, (const bf16_t*)BFM}); } break;
    case PH_GLA_ATT: { g8::GlaAttSched<0> S{QKR, KVT}; g8::gemm_phase(lds, S, g8::EpiGlaAtt<0>{ATTB, UTB, DLF}); }
        { g8::GlaAttSched<1> S{QKR, KVT}; g8::gemm_phase(lds, S, g8::EpiGlaAtt<1>{ATTB, UTB, DLF}); } break;
    case PH_GLA_SCAN: gla_scan(UTB, DLF, SPB); break;
    case PH_GLA_O: { g8::GlaOSched S{QKR, KVT, ATTB, SPB}; g8::gemm_phase(lds, S, g8::EpiGlaO{GOB, QKR, c.in[18], (LAS float*)(lds + g8::STAGE_BYTES)}); } break;
    case PH_GLA_FIN: gla_fin(OB, QKR, c.in[18], GOB); break;
    case PH_GLA_OUT: { g8::DenseSched S{4, 128 * 4, D, D, D, GOB, WGO}; g8::gemm_phase(lds, S, g8::EpiXres{XB, nullptr, SSP}); } break;
    }
}

#ifndef ALLCG
#define ALLCG 0
#endif
#define XB_TMO      128
#define XB_XCNT(j)  (256  + 64 * (j))
#define XB_XSUB(j)  (1280 + 64 * (j))
#define XB_XGEN(j)  (2304 + 64 * (j))
#define XB_TOP      3328
#define XB_TOPGEN   3392
#define GB_MASK(g)  (3456 + 64 * (g))
#define GB_CNT(g)   (3968 + 64 * (g))
#define GB_GEN(g)   (4480 + 64 * (g))
#define XCD_BAR_WORDS 4992
#define XB_SPIN_CAP (1u << 18)
__device__ __forceinline__ unsigned xb_ld(unsigned* p)              { return __hip_atomic_load(p, __ATOMIC_RELAXED, __HIP_MEMORY_SCOPE_AGENT); }
__device__ __forceinline__ unsigned xb_add(unsigned* p, unsigned v) { return __hip_atomic_fetch_add(p, v, __ATOMIC_RELAXED, __HIP_MEMORY_SCOPE_AGENT); }
__device__ __forceinline__ unsigned xb_xcc_id() { return (unsigned)__builtin_amdgcn_s_getreg((3 << 11) | 20) & 0xFu; }
#define XB_SPIN(cond, bar) do { unsigned _sp = 0; while (cond) { __builtin_amdgcn_s_sleep(1); \
    if ((++_sp & 255u) == 0u) { if (xb_ld(&(bar)[XB_TMO])) break; if (_sp > XB_SPIN_CAP) { atomicAdd(&(bar)[XB_TMO], 1u); break; } } } } while (0)
struct XcdBarrier { unsigned* bar; unsigned x; volatile LAS unsigned* st; };
__device__ __forceinline__ XcdBarrier xcd_barrier_post(unsigned* bar, volatile LAS unsigned* st) {
    XcdBarrier b; b.bar = bar; b.x = xb_xcc_id(); b.st = st;
    if (threadIdx.x == 0) { (void)xb_add(&bar[XB_XCNT(b.x)], 1u); (void)__hip_atomic_fetch_or(&bar[GB_MASK(blockIdx.x & 7u)], 1u << b.x, __ATOMIC_RELAXED, __HIP_MEMORY_SCOPE_AGENT); }
    return b;
}
__device__ __forceinline__ void xcd_barrier_complete(unsigned* bar, unsigned x, unsigned& nloc, unsigned& nx) {
    const unsigned G = gridDim.x * gridDim.y * gridDim.z;
    unsigned sum, cnt, mine, sp = 0u;
    for (;;) {
        sum = 0u; cnt = 0u; mine = 0u;
#pragma unroll
        for (unsigned j = 0; j < 16; ++j) { const unsigned c = xb_ld(&bar[XB_XCNT(j)]); sum += c; cnt += (c > 0u) ? 1u : 0u; mine = (j == x) ? c : mine; }
        if (sum == G) break;
        __builtin_amdgcn_s_sleep(1);
        if ((++sp & 255u) == 0u) { if (xb_ld(&bar[XB_TMO])) break; if (sp > XB_SPIN_CAP) { atomicAdd(&bar[XB_TMO], 1u); break; } }
    }
    nloc = mine > 0u ? mine : 1u; nx = cnt > 0u ? cnt : 1u;
}
__device__ __forceinline__ void xcd_barrier(const XcdBarrier& b) {
    asm volatile("s_waitcnt vmcnt(0)" ::: "memory");
    __syncthreads();
    if (threadIdx.x == 0) {
        unsigned* bar = b.bar;
        __builtin_amdgcn_s_waitcnt(0);
        unsigned nloc = b.st[0], nx = b.st[1];
        if (nloc == 0u) { xcd_barrier_complete(bar, b.x, nloc, nx); b.st[0] = nloc; b.st[1] = nx; }
        const unsigned old = xb_add(&bar[XB_XSUB(b.x)], 1u);
        const unsigned gen = old / nloc;
        if (old + 1u == (gen + 1u) * nloc) {
            __builtin_amdgcn_fence(__ATOMIC_RELEASE, "agent");
            asm volatile("s_waitcnt vmcnt(0)" ::: "memory");
            const unsigned og = xb_add(&bar[XB_TOP], 1u);
            const unsigned tg = og / nx;
            if (og + 1u == (tg + 1u) * nx) xb_add(&bar[XB_TOPGEN], 1u);
            else XB_SPIN(xb_ld(&bar[XB_TOPGEN]) == tg, bar);
            __builtin_amdgcn_fence(__ATOMIC_ACQUIRE, "agent");
            xb_add(&bar[XB_XGEN(b.x)], 1u);
            asm volatile("s_waitcnt vmcnt(0)" ::: "memory");
        } else {
            XB_SPIN(xb_ld(&bar[XB_XGEN(b.x)]) == gen, bar);
            __builtin_amdgcn_fence(__ATOMIC_ACQUIRE, "agent");
            asm volatile("s_waitcnt vmcnt(0)" ::: "memory");
        }
    }
    __syncthreads();
}
__device__ __forceinline__ void group_barrier(const XcdBarrier& b) {
    unsigned mode = b.st[2];
    if (mode == 0u) {
        __syncthreads();
        if (threadIdx.x == 0) { unsigned ok = 1u;
            for (unsigned g = 0; g < 8u; ++g) { const unsigned m = xb_ld(&b.bar[GB_MASK(g)]); ok &= (m != 0u && (m & (m - 1u)) == 0u) ? 1u : 0u; }
            if (gridDim.x != 256u) ok = 0u;
            b.st[2] = ok ? 1u : 2u; }
        __syncthreads();
        mode = b.st[2];
    }
    if (mode != 1u) { xcd_barrier(b); return; }
    asm volatile("s_waitcnt vmcnt(0)" ::: "memory");
    __syncthreads();
    if (threadIdx.x == 0) {
        unsigned* bar = b.bar; const unsigned g = blockIdx.x & 7u, per = gridDim.x >> 3;
        __builtin_amdgcn_s_waitcnt(0);
        const unsigned old = xb_add(&bar[GB_CNT(g)], 1u), gen = old / per;
        if (old + 1u == (gen + 1u) * per) (void)xb_add(&bar[GB_GEN(g)], 1u);
        else XB_SPIN(xb_ld(&bar[GB_GEN(g)]) == gen, bar);
        __builtin_amdgcn_fence(__ATOMIC_ACQUIRE, "agent");
        asm volatile("s_waitcnt vmcnt(0)" ::: "memory");
    }
    __syncthreads();
}
template <int CODE> __device__ __forceinline__ void coop_step(const Ctx& c, LAS unsigned char* lds, cg::grid_group& grid, XcdBarrier& xb, bool sync_after, bool first) {
    run_phase(c, CODE >> 5, CODE & 31, lds);
    if (sync_after && (CODE >> 5) == PH_CONV_OUT) { asm volatile("s_waitcnt vmcnt(0) lgkmcnt(0)" ::: "memory"); __syncthreads(); }
    else if (sync_after) {
        if (first || ALLCG) {
            unsigned* bar = (unsigned*)(c.ws + OW_BAR);
            if (first && blockIdx.x == 0) for (int i = threadIdx.x; i < XCD_BAR_WORDS; i += 512) bar[i] = 0u;
            asm volatile("s_waitcnt vmcnt(0) lgkmcnt(0)" ::: "memory");
            grid.sync();
            if (threadIdx.x < 64) { __builtin_amdgcn_fence(__ATOMIC_ACQUIRE, "agent"); asm volatile("s_waitcnt vmcnt(0)" ::: "memory"); }
            __syncthreads();
            if (first) xb = xcd_barrier_post(bar, xb.st);
        } else if ((CODE >> 5) == PH_MOE1 && xb.st[2] == 1u) { asm volatile("s_waitcnt vmcnt(0) lgkmcnt(0)" ::: "memory"); __syncthreads(); }
        else if ((CODE >> 5) == PH_XA_XS || (CODE >> 5) == PH_MOE1 || (CODE >> 5) == PH_XA_PVO || (CODE >> 5) == PH_CONV_MID || (CODE >> 5) == PH_GLA_O || (CODE >> 5) == PH_GLA_DECAY || (CODE >> 5) == PH_GLA_IN) group_barrier(xb);
        else xcd_barrier(xb);
    }
}
template <int... CODES> __global__ void __launch_bounds__(512, 2) k_coop(Ctx c) {
    extern __shared__ __attribute__((aligned(16))) unsigned char dynlds[];
    cg::grid_group grid = cg::this_grid();
    LAS unsigned char* lds = (LAS unsigned char*)dynlds;
    volatile LAS unsigned* st = (volatile LAS unsigned*)(lds + LDS_BYTES - 16);
    if (threadIdx.x < 4) st[threadIdx.x] = 0u;
    __syncthreads();
    XcdBarrier xb; xb.bar = nullptr; xb.x = 0; xb.st = st;
    int idx = 0; constexpr int N = sizeof...(CODES);
    ((coop_step<CODES>(c, lds, grid, xb, idx + 1 < N, idx == 0), ++idx), ...);
}
#define CODE(ph, l) ((ph) * 32 + (l))
typedef void (*CoopFn)(Ctx);
extern "C" void kernel_launch(void* const* d_in, const int* in_sizes, int n_in, void* d_out, int out_size, void* d_ws, size_t ws_size, hipStream_t stream) {
    if (n_in != 30 || out_size != T * D || ws_size < OW_END) { fprintf(stderr, "kernel_launch: built for 30 inputs, %d outputs and >= %zu bytes of workspace; got n_in %d, out %d, ws %zu; nothing launched\n", T * D, (size_t)OW_END, n_in, out_size, ws_size); return; }
    Ctx c; memset(&c, 0, sizeof(c));
    for (int i = 0; i < 30; ++i) c.in[i] = (const float*)d_in[i];
    c.out = (float*)d_out; c.ws = (unsigned char*)d_ws;
    static CoopFn fn = k_coop<CODE(PH_PREP_ALL, 0), CODE(PH_CONV_IN, 0), CODE(PH_CONV_MID, 0), CODE(PH_CONV_OUT, 0),
                                         CODE(PH_XA_KV, 0), CODE(PH_XA_XS, 0), CODE(PH_XA_PVO, 0),
                                         CODE(PH_ROUTE, 0), CODE(PH_MOE1, 0), CODE(PH_MOE2, 0), CODE(PH_COMBINE, 0),
                                         CODE(PH_GLA_DECAY, 0), CODE(PH_GLA_IN, 0), CODE(PH_GLA_ATT, 0), CODE(PH_GLA_SCAN, 0), CODE(PH_GLA_O, 0), CODE(PH_GLA_OUT, 0),
                                         CODE(PH_XA_KV, 1), CODE(PH_XA_XS, 1), CODE(PH_XA_PVO, 1),
                                         CODE(PH_ROUTE, 1), CODE(PH_MOE1, 1), CODE(PH_MOE2, 1), CODE(PH_COMBINE_FIN, 1)>;
    static int grid = 0;
    if (!grid) {
        int dev = 0, cus = 0, per_cu = 0;
        (void)hipGetDevice(&dev); (void)hipDeviceGetAttribute(&cus, hipDeviceAttributeMultiprocessorCount, dev);
        (void)hipFuncSetAttribute((const void*)fn, hipFuncAttributeMaxDynamicSharedMemorySize, LDS_BYTES);
        (void)hipOccupancyMaxActiveBlocksPerMultiprocessor(&per_cu, fn, 512, LDS_BYTES);
        grid = cus * (per_cu < 1 ? 1 : per_cu); if (grid > 256) grid = 256;
        if (grid != 256) fprintf(stderr, "kernel_launch: %d CUs x %d workgroups: this kernel is laid out for 256 resident workgroups\n", cus, per_cu);
    }
    void* args[] = {&c};
    hipError_t e = hipLaunchCooperativeKernel((void*)fn, dim3(grid), dim3(512), args, LDS_BYTES, stream);
    if (e != hipSuccess) fprintf(stderr, "cooperative launch failed: %s (grid %d)\n", hipGetErrorString(e), grid);
}
```
